# Optimizing an MI355X kernel written in HIP

```python
import math
import jax
import jax.numpy as jnp
from jax import lax
import numpy as np

D_MODEL = 1024
BATCH = 4
SEQ = 8192
DEPTH = 1

MIX_WIDTH = D_MODEL
RWKV_WIDTH = MIX_WIDTH // 2
RWKV_HEAD_DIM = 64
RWKV_HEADS = RWKV_WIDTH // RWKV_HEAD_DIM
DECAY_LORA = 64
ICLR_LORA = 64
GATE_LORA = 128
RWKV_PROJ = 3 * RWKV_WIDTH + DECAY_LORA + ICLR_LORA + GATE_LORA
S5_WIDTH = MIX_WIDTH - RWKV_WIDTH
S5_GROUP = 16
S5_GROUPS = S5_WIDTH // S5_GROUP
S5_STATE = 64
IN_PROJ = RWKV_PROJ + S5_WIDTH
N_EXPERTS = 256
TOP_K = 8
ROUTE_GROUPS = 8
ROUTE_TOPK_GROUPS = 4
EXPERT_FF = 256
SHARED_FF = 256
ROUTE_SCALE = 2.5
DISPATCH_BLOCK = 128
NORM_EPS = 1e-6
LNX_EPS = 64e-5
L2_EPS = 1e-12
S5_MAX_REAL = -1e-4
N_MODS = 6

kernel_name = "hybrid_rwkv7_s5_moe_block"


def _f32(t):
    return t.astype(jnp.float32)


def rms_norm(x, gain):
    xf = _f32(x)
    y = xf * lax.rsqrt(jnp.mean(xf * xf, axis=-1, keepdims=True) + NORM_EPS)
    return (y * _f32(gain)).astype(x.dtype)


def token_shift(z):
    return jnp.pad(z, ((0, 0), (1, 0), (0, 0)))[:, :-1]


def rwkv7_recurrence(r, w, k, v, a, b):
    bsz, _, nh, n = r.shape

    def step(state, inp):
        r_t, w_t, k_t, v_t, a_t, b_t = inp
        sa = jnp.einsum("bhvk,bhk->bhv", state, a_t)
        state = (state * w_t[:, :, None, :] + sa[..., None] * b_t[:, :, None, :]
                 + v_t[..., None] * k_t[:, :, None, :])
        return state, jnp.einsum("bhvk,bhk->bhv", state, r_t)

    xs = tuple(jnp.swapaxes(z, 0, 1) for z in (r, w, k, v, a, b))
    s0 = jnp.zeros((bsz, nh, n, n), jnp.float32)
    _, y = lax.scan(step, s0, xs)
    return jnp.swapaxes(y, 0, 1)


def rwkv7_mixer(p, mu, w0, w2, a0, a2, g2, k_k, k_a, r_k, ln_w, ln_b):
    bsz, seq, _ = p.shape
    p = _f32(p)
    p = p + (token_shift(p) - p) * _f32(mu)
    cuts = [RWKV_WIDTH, 2 * RWKV_WIDTH, 3 * RWKV_WIDTH, 3 * RWKV_WIDTH + DECAY_LORA,
            3 * RWKV_WIDTH + DECAY_LORA + ICLR_LORA]
    r, k, v, w_lo, a_lo, g_lo = jnp.split(p, cuts, axis=-1)
    log_w = -jax.nn.softplus(-(_f32(w0) + jnp.tanh(w_lo) @ _f32(w2))) - 0.5
    decay = jnp.exp(-jnp.exp(log_w))
    iclr = jax.nn.sigmoid(_f32(a0) + a_lo @ _f32(a2))
    gate = jax.nn.sigmoid(g_lo) @ _f32(g2)

    def heads(t):
        return t.reshape(bsz, seq, RWKV_HEADS, RWKV_HEAD_DIM)

    kk = heads(k * _f32(k_k))
    kk = kk / jnp.maximum(jnp.sqrt(jnp.sum(kk * kk, axis=-1, keepdims=True)), L2_EPS)
    k = k * (1.0 + (iclr - 1.0) * _f32(k_a))
    r, k, v, decay, iclr = heads(r), heads(k), heads(v), heads(decay), heads(iclr)
    y = rwkv7_recurrence(r, decay, k, v, -kk, kk * iclr)
    mean = jnp.mean(y, axis=-1, keepdims=True)
    var = jnp.mean(jnp.square(y - mean), axis=-1, keepdims=True)
    y = ((y - mean) * lax.rsqrt(var + LNX_EPS)).reshape(bsz, seq, RWKV_WIDTH)
    y = y * _f32(ln_w) + _f32(ln_b)
    bonus = jnp.sum(r * k * _f32(r_k), axis=-1, keepdims=True) * v
    return (y + bonus.reshape(bsz, seq, RWKV_WIDTH)) * gate


def s5_mixer(u, log_dt, a_re, a_im, b_re, b_im, c_re, c_im, d, w_glu, b_glu):
    bsz, seq, _ = u.shape
    u = _f32(u)
    ug = u.reshape(bsz, seq, S5_GROUPS, S5_GROUP)
    dt = jnp.exp(_f32(log_dt))[:, None]
    lam_re = jnp.minimum(_f32(a_re), S5_MAX_REAL)
    lam_im = _f32(a_im)
    mag = jnp.exp(lam_re * dt)
    ang = lam_im * dt
    ab_re, ab_im = mag * jnp.cos(ang), mag * jnp.sin(ang)
    den = lam_re * lam_re + lam_im * lam_im
    n_re, n_im = ab_re - 1.0, ab_im
    q_re = (n_re * lam_re + n_im * lam_im) / den
    q_im = (n_im * lam_re - n_re * lam_im) / den
    br, bi = _f32(b_re), _f32(b_im)
    bb_re = q_re[..., None] * br - q_im[..., None] * bi
    bb_im = q_re[..., None] * bi + q_im[..., None] * br
    bu_re = jnp.einsum("bsgc,gpc->sbgp", ug, bb_re)
    bu_im = jnp.einsum("bsgc,gpc->sbgp", ug, bb_im)
    at_re = jnp.broadcast_to(ab_re, (seq, 1, S5_GROUPS, S5_STATE))
    at_im = jnp.broadcast_to(ab_im, (seq, 1, S5_GROUPS, S5_STATE))

    def combine(e1, e2):
        a1r, a1i, b1r, b1i = e1
        a2r, a2i, b2r, b2i = e2
        return (a2r * a1r - a2i * a1i, a2r * a1i + a2i * a1r,
                a2r * b1r - a2i * b1i + b2r, a2r * b1i + a2i * b1r + b2i)

    _, _, xr, xi = lax.associative_scan(combine, (at_re, at_im, bu_re, bu_im), axis=0)
    y = (jnp.einsum("sbgp,gcp->bsgc", xr, _f32(c_re))
         - jnp.einsum("sbgp,gcp->bsgc", xi, _f32(c_im)))
    y = y.reshape(bsz, seq, S5_WIDTH) + _f32(d) * u
    y = jax.nn.gelu(y)
    return y * jax.nn.sigmoid(y @ _f32(w_glu) + _f32(b_glu))


def route_tokens(h, w_router, router_bias):
    t = h.shape[0]
    scores = jax.nn.sigmoid(_f32(h) @ _f32(w_router))
    choice = scores + _f32(router_bias)
    grp = choice.reshape(t, ROUTE_GROUPS, N_EXPERTS // ROUTE_GROUPS)
    grp_score = jnp.sum(lax.top_k(grp, 2)[0], axis=-1)
    _, grp_idx = lax.top_k(grp_score, ROUTE_TOPK_GROUPS)
    grp_mask = jnp.any(grp_idx[..., None] == jnp.arange(ROUTE_GROUPS), axis=-2)
    exp_mask = jnp.repeat(grp_mask, N_EXPERTS // ROUTE_GROUPS, axis=-1)
    _, top_idx = lax.top_k(jnp.where(exp_mask, choice, -jnp.inf), TOP_K)
    top_w = jnp.take_along_axis(scores, top_idx, axis=-1)
    top_w = top_w / jnp.sum(top_w, axis=-1, keepdims=True) * ROUTE_SCALE
    return top_idx.astype(jnp.int32), top_w


def routed_experts(h, top_idx, top_w, w_gate, w_up, w_down):
    t, dm = h.shape
    n_assign = t * TOP_K
    flat_e = top_idx.reshape(n_assign)
    flat_w = top_w.reshape(n_assign)
    flat_tok = jnp.repeat(jnp.arange(t, dtype=jnp.int32), TOP_K)
    order = jnp.argsort(flat_e)
    se, stok, sw = flat_e[order], flat_tok[order], flat_w[order]
    counts = jnp.bincount(flat_e, length=N_EXPERTS).astype(jnp.int32)
    padded = (counts + DISPATCH_BLOCK - 1) // DISPATCH_BLOCK * DISPATCH_BLOCK
    pad_end = jnp.cumsum(padded)
    pad_start = pad_end - padded
    grp_start = jnp.cumsum(counts) - counts
    dest = pad_start[se] + jnp.arange(n_assign, dtype=jnp.int32) - grp_start[se]
    n_blocks = -(-n_assign // DISPATCH_BLOCK) + N_EXPERTS
    n_rows = n_blocks * DISPATCH_BLOCK
    row_tok = jnp.full((n_rows,), t, jnp.int32).at[dest].set(stok)
    row_w = jnp.zeros((n_rows,), jnp.float32).at[dest].set(sw)
    block_start = jnp.arange(n_blocks, dtype=jnp.int32) * DISPATCH_BLOCK
    block_e = jnp.minimum(jnp.searchsorted(pad_end, block_start, side="right"),
                          N_EXPERTS - 1).astype(jnp.int32)
    h_pad = jnp.concatenate([h, jnp.zeros((1, dm), h.dtype)], axis=0)

    def body(acc, blk):
        tok, wt, e = blk
        xb = h_pad[tok]
        hid = jax.nn.silu(xb @ w_gate[e]) * (xb @ w_up[e])
        yb = hid @ w_down[e]
        return acc.at[tok].add(_f32(yb) * wt[:, None]), None

    acc0 = jnp.zeros((t + 1, dm), jnp.float32)
    acc, _ = lax.scan(body, acc0, (row_tok.reshape(n_blocks, DISPATCH_BLOCK),
                                   row_w.reshape(n_blocks, DISPATCH_BLOCK), block_e))
    return acc[:t]


def moe_ffn(h, w_router, router_bias, w_gate, w_up, w_down, ws_gate, ws_up, ws_down):
    top_idx, top_w = route_tokens(h, w_router, router_bias)
    shared = (jax.nn.silu(h @ ws_gate) * (h @ ws_up)) @ ws_down
    routed = routed_experts(h, top_idx, top_w, w_gate, w_up, w_down)
    return (_f32(shared) + routed).astype(h.dtype)


def setup_inputs(seed: int = 0) -> dict:
    key = jax.random.key(seed)
    keys = jax.random.split(key, 48)
    counter = [0]

    def nk():
        k = keys[counter[0]]
        counter[0] += 1
        return k

    def nrm(shape, scale):
        return jax.random.normal(nk(), shape, jnp.float32) * scale

    def unif(shape, lo, hi):
        return jax.random.uniform(nk(), shape, jnp.float32, lo, hi)

    L, D = DEPTH, D_MODEL
    w0_base = jnp.tile(jnp.linspace(-6.0, -1.0, RWKV_HEAD_DIM, dtype=jnp.float32), RWKV_HEADS)
    a_im_base = jnp.pi * jnp.arange(S5_STATE, dtype=jnp.float32)
    return {
        "x": nrm((BATCH, SEQ, D), 1.0),
        "c": nrm((BATCH, D), 1.0),
        "w_ada": nrm((L, D, N_MODS * D), 0.5 * D ** -0.5),
        "b_ada": nrm((L, N_MODS * D), 0.01),
        "g_pre_mix": 1.0 + nrm((L, D), 0.05),
        "g_post_mix": 1.0 + nrm((L, D), 0.05),
        "g_pre_ffn": 1.0 + nrm((L, D), 0.05),
        "g_post_ffn": 1.0 + nrm((L, D), 0.05),
        "w_in": nrm((L, D, IN_PROJ), D ** -0.5),
        "mu_shift": unif((L, RWKV_PROJ), 0.0, 1.0),
        "rwkv_w0": w0_base + nrm((L, RWKV_WIDTH), 0.1),
        "rwkv_w2": nrm((L, DECAY_LORA, RWKV_WIDTH), 0.5 * DECAY_LORA ** -0.5),
        "rwkv_a0": nrm((L, RWKV_WIDTH), 0.1),
        "rwkv_a2": nrm((L, ICLR_LORA, RWKV_WIDTH), ICLR_LORA ** -0.5),
        "rwkv_g2": nrm((L, GATE_LORA, RWKV_WIDTH), GATE_LORA ** -0.5),
        "rwkv_k_k": 0.85 + nrm((L, RWKV_WIDTH), 0.05),
        "rwkv_k_a": 1.0 + nrm((L, RWKV_WIDTH), 0.05),
        "rwkv_r_k": nrm((L, RWKV_HEADS, RWKV_HEAD_DIM), 0.1),
        "rwkv_ln_w": 1.0 + nrm((L, RWKV_WIDTH), 0.05),
        "rwkv_ln_b": nrm((L, RWKV_WIDTH), 0.01),
        "s5_log_dt": unif((L, S5_GROUPS), math.log(1e-3), math.log(1e-1)),
        "s5_a_re": -0.5 + nrm((L, S5_GROUPS, S5_STATE), 0.01),
        "s5_a_im": a_im_base + nrm((L, S5_GROUPS, S5_STATE), 0.01),
        "s5_b_re": nrm((L, S5_GROUPS, S5_STATE, S5_GROUP), (2 * S5_GROUP) ** -0.5),
        "s5_b_im": nrm((L, S5_GROUPS, S5_STATE, S5_GROUP), (2 * S5_GROUP) ** -0.5),
        "s5_c_re": nrm((L, S5_GROUPS, S5_GROUP, S5_STATE), 0.7),
        "s5_c_im": nrm((L, S5_GROUPS, S5_GROUP, S5_STATE), 0.7),
        "s5_d": nrm((L, S5_WIDTH), 1.0),
        "s5_w_glu": nrm((L, S5_WIDTH, S5_WIDTH), S5_WIDTH ** -0.5),
        "s5_b_glu": nrm((L, S5_WIDTH), 0.01),
        "w_out": nrm((L, MIX_WIDTH, D), MIX_WIDTH ** -0.5),
        "w_router": nrm((L, D, N_EXPERTS), D ** -0.5),
        "router_bias": nrm((L, N_EXPERTS), 0.01),
        "w_gate": nrm((L, N_EXPERTS, D, EXPERT_FF), D ** -0.5),
        "w_up": nrm((L, N_EXPERTS, D, EXPERT_FF), D ** -0.5),
        "w_down": nrm((L, N_EXPERTS, EXPERT_FF, D), EXPERT_FF ** -0.5),
        "ws_gate": nrm((L, D, SHARED_FF), D ** -0.5),
        "ws_up": nrm((L, D, SHARED_FF), D ** -0.5),
        "ws_down": nrm((L, SHARED_FF, D), SHARED_FF ** -0.5),
    }


def reference(x, c, w_ada, b_ada, g_pre_mix, g_post_mix, g_pre_ffn, g_post_ffn, w_in,
              mu_shift, rwkv_w0, rwkv_w2, rwkv_a0, rwkv_a2, rwkv_g2, rwkv_k_k, rwkv_k_a,
              rwkv_r_k, rwkv_ln_w, rwkv_ln_b, s5_log_dt, s5_a_re, s5_a_im, s5_b_re, s5_b_im,
              s5_c_re, s5_c_im, s5_d, s5_w_glu, s5_b_glu, w_out, w_router, router_bias,
              w_gate, w_up, w_down, ws_gate, ws_up, ws_down):
    bsz, seq, dm = x.shape
    for l in range(DEPTH):
        mods = jax.nn.silu(c) @ w_ada[l] + b_ada[l]
        sh_m, sc_m, gt_m, sh_f, sc_f, gt_f = [m[:, None, :] for m in jnp.split(mods, N_MODS, axis=-1)]

        h = rms_norm(x, g_pre_mix[l]) * (1.0 + sc_m) + sh_m
        proj = h @ w_in[l]
        y_rwkv = rwkv7_mixer(proj[..., :RWKV_PROJ], mu_shift[l], rwkv_w0[l], rwkv_w2[l],
                             rwkv_a0[l], rwkv_a2[l], rwkv_g2[l], rwkv_k_k[l], rwkv_k_a[l],
                             rwkv_r_k[l], rwkv_ln_w[l], rwkv_ln_b[l])
        y_s5 = s5_mixer(proj[..., RWKV_PROJ:], s5_log_dt[l], s5_a_re[l], s5_a_im[l],
                        s5_b_re[l], s5_b_im[l], s5_c_re[l], s5_c_im[l], s5_d[l],
                        s5_w_glu[l], s5_b_glu[l])
        mixed = jnp.concatenate([y_rwkv, y_s5], axis=-1).astype(x.dtype) @ w_out[l]
        x = x + gt_m * rms_norm(mixed, g_post_mix[l])

        h = rms_norm(x, g_pre_ffn[l]) * (1.0 + sc_f) + sh_f
        y = moe_ffn(h.reshape(bsz * seq, dm), w_router[l], router_bias[l], w_gate[l],
                    w_up[l], w_down[l], ws_gate[l], ws_up[l], ws_down[l]).reshape(bsz, seq, dm)
        x = x + gt_f * rms_norm(y, g_post_ffn[l])
    return x
```

```cpp
#include <hip/hip_runtime.h>
#include <cstdint>
#include <cstdio>

#define LAS __attribute__((address_space(3)))

constexpr int D = 1024, BATCH = 4, SEQ = 8192, T = BATCH * SEQ;
constexpr int RW = 512, NH = 8;
constexpr int RPROJ = 1792, NPROJ = 2304;
constexpr int S5NG = 32, S5P = 64;
constexpr int NE = 256, EFF = 256;
constexpr int NMODS = 6 * D;
constexpr int S5CL = 128, S5NC = SEQ / S5CL;

constexpr size_t MiB = 1u << 20;
constexpr size_t WS_CTL = 0, CTL_BYTES = 1 * MiB;
constexpr size_t WS_COUNTS = 64 * 1024;
constexpr size_t WS_MODS = 1 * MiB;
constexpr size_t WS_S5AB = 1 * MiB + 128 * 1024;
constexpr size_t WS_S5POW = 1 * MiB + 160 * 1024;
constexpr size_t WS_S5BB = 1 * MiB + 256 * 1024;
constexpr size_t WS_S5E = 2 * MiB;
constexpr size_t WS_S5X0 = 6 * MiB;
constexpr size_t WS_A = 16 * MiB;
constexpr size_t WS_PROJ = 144 * MiB;
constexpr size_t WS_RW = 432 * MiB;
constexpr size_t RWSZ = (size_t)T * RW * 4;
constexpr size_t WS_YEXP = 144 * MiB;
constexpr size_t WS_HID = 656 * MiB;
constexpr size_t WS_SHOUT = 784 * MiB;
constexpr size_t WS_YS5 = 944 * MiB;
constexpr size_t WS_HS = 944 * MiB;
constexpr size_t WS_LOGITS = 976 * MiB;
constexpr size_t WS_IDX = 1008 * MiB;
constexpr size_t WS_WT = 1009 * MiB;
constexpr size_t WS_SLOT = 1010 * MiB;
constexpr size_t WS_END = 1011 * MiB;

constexpr int LDS_BYTES = 132096;
constexpr int LDS_CTL_OFF = 131072;

#define XB_TMO      128
#define XB_XCNT(j)  (256  + 64 * (j))
#define XB_XSUB(j)  (1280 + 64 * (j))
#define XB_XGEN(j)  (2304 + 64 * (j))
#define XB_TOP      3328
#define XB_TOPGEN   3392
#define XCD_BAR_WORDS 3456
#define XB_SPIN_CAP (1u << 24)

__device__ __forceinline__ unsigned xb_ld(unsigned* p)              { return __hip_atomic_load(p, __ATOMIC_RELAXED, __HIP_MEMORY_SCOPE_AGENT); }
__device__ __forceinline__ unsigned xb_add(unsigned* p, unsigned v) { return __hip_atomic_fetch_add(p, v, __ATOMIC_RELAXED, __HIP_MEMORY_SCOPE_AGENT); }
__device__ __forceinline__ unsigned xb_xcc_id() { return (unsigned)__builtin_amdgcn_s_getreg((3 << 11) | 20) & 0xFu; }
#define XB_SPIN(cond, bar) do { unsigned _sp = 0; while (cond) { __builtin_amdgcn_s_sleep(1); \
    if ((++_sp & 255u) == 0u) { if (xb_ld(&(bar)[XB_TMO])) break; if (_sp > XB_SPIN_CAP) { atomicAdd(&(bar)[XB_TMO], 1u); break; } } } } while (0)

struct XcdBarrier { unsigned* bar; unsigned x; volatile LAS unsigned* st; };

__device__ __forceinline__ XcdBarrier xcd_barrier_post(unsigned* bar, volatile LAS unsigned* st) {
    XcdBarrier b; b.bar = bar; b.x = xb_xcc_id(); b.st = st;
    if (threadIdx.x == 0) (void)xb_add(&bar[XB_XCNT(b.x)], 1u);
    return b;
}
__device__ __forceinline__ void xcd_barrier_complete(unsigned* bar, unsigned x, unsigned& nloc, unsigned& nx) {
    const unsigned G = gridDim.x * gridDim.y * gridDim.z;
    unsigned sum, cnt, mine, sp = 0u;
    for (;;) {
        sum = 0u; cnt = 0u; mine = 0u;
#pragma unroll
        for (unsigned j = 0; j < 16; ++j) { const unsigned c = xb_ld(&bar[XB_XCNT(j)]); sum += c; cnt += (c > 0u) ? 1u : 0u; mine = (j == x) ? c : mine; }
        if (sum == G) break;
        __builtin_amdgcn_s_sleep(1);
        if ((++sp & 255u) == 0u) { if (xb_ld(&bar[XB_TMO])) break; if (sp > XB_SPIN_CAP) { atomicAdd(&bar[XB_TMO], 1u); break; } }
    }
    nloc = mine > 0u ? mine : 1u; nx = cnt > 0u ? cnt : 1u;
}
__device__ __forceinline__ void xcd_barrier(const XcdBarrier& b) {
    asm volatile("s_waitcnt vmcnt(0)" ::: "memory");
    __syncthreads();
    if (threadIdx.x == 0) {
        unsigned* bar = b.bar;
        __builtin_amdgcn_s_waitcnt(0);
        unsigned nloc = b.st[0], nx = b.st[1];
        if (nloc == 0u) { xcd_barrier_complete(bar, b.x, nloc, nx); b.st[0] = nloc; b.st[1] = nx; }
        const unsigned old = xb_add(&bar[XB_XSUB(b.x)], 1u);
        const unsigned gen = old / nloc;
        if (old + 1u == (gen + 1u) * nloc) {
            __builtin_amdgcn_fence(__ATOMIC_RELEASE, "agent");
            asm volatile("s_waitcnt vmcnt(0)" ::: "memory");
            const unsigned og = xb_add(&bar[XB_TOP], 1u);
            const unsigned tg = og / nx;
            if (og + 1u == (tg + 1u) * nx) xb_add(&bar[XB_TOPGEN], 1u);
            else XB_SPIN(xb_ld(&bar[XB_TOPGEN]) == tg, bar);
            __builtin_amdgcn_fence(__ATOMIC_ACQUIRE, "agent");
            xb_add(&bar[XB_XGEN(b.x)], 1u);
            asm volatile("s_waitcnt vmcnt(0)" ::: "memory");
        } else {
            XB_SPIN(xb_ld(&bar[XB_XGEN(b.x)]) == gen, bar);
            __builtin_amdgcn_fence(__ATOMIC_ACQUIRE, "agent");
            asm volatile("s_waitcnt vmcnt(0)" ::: "memory");
        }
    }
    __syncthreads();
}

typedef unsigned short bf16_t;
__device__ __forceinline__ unsigned f2bf(float f) { unsigned u = __builtin_bit_cast(unsigned, f); return (u + 0x7fffu + ((u >> 16) & 1u)) >> 16; }
__device__ __forceinline__ float bf2f(unsigned h) { return __builtin_bit_cast(float, h << 16); }
__device__ __forceinline__ float wave_sum(float v) {
#pragma unroll
    for (int o = 1; o < 64; o <<= 1) v += __shfl_xor(v, o);
    return v;
}
__device__ __forceinline__ float sigmoidf_(float x) { return 1.0f / (1.0f + expf(-x)); }
__device__ __forceinline__ float siluf_(float x) { return x / (1.0f + expf(-x)); }
__device__ __forceinline__ float softplusf_(float x) { return fmaxf(x, 0.0f) + log1pf(expf(-fabsf(x))); }
__device__ __forceinline__ float geluf_(float x) { const float u = 0.7978845608028654f * (x + 0.044715f * x * x * x); return 0.5f * x * (1.0f + tanhf(u)); }

struct Args { const float* in[39]; float* out; unsigned char* ws; int lo, hi; };

struct Ctx {
    const float* const* in; float* out; unsigned char* ws;
    LAS unsigned char* lds; float* sm;
    int tid, lane, wid, bid, G;
};

template <int NB, class AF, class BF, class BF2, class EF>
__device__ __forceinline__ void gemm_tile(float* sm, int K, AF af, BF bf, BF2 bf2, EF ef) {
    float* As = sm;
    float* Bs = sm + 16 * 132;
    float* Bs2 = Bs + 16 * 68;
    const int tid = threadIdx.x, ty = tid >> 4, tx = tid & 15;
    const int am = tid >> 2, ak = (tid & 3) * 4;
    const int bt = tid & 255, bk = bt >> 4, bn = (bt & 15) * 4;
    float acc[4][4], acc2[4][4];
#pragma unroll
    for (int i = 0; i < 4; ++i)
#pragma unroll
        for (int j = 0; j < 4; ++j) { acc[i][j] = 0.f; acc2[i][j] = 0.f; }
    float4 av = af(am, ak);
    float4 bv = make_float4(0.f, 0.f, 0.f, 0.f);
    if (tid < 256) bv = bf(bk, bn); else if (NB == 2) bv = bf2(bk, bn);
    for (int k0 = 0; k0 < K; k0 += 16) {
        __syncthreads();
        As[(ak + 0) * 132 + am] = av.x; As[(ak + 1) * 132 + am] = av.y; As[(ak + 2) * 132 + am] = av.z; As[(ak + 3) * 132 + am] = av.w;
        if (tid < 256) *(float4*)&Bs[bk * 68 + bn] = bv; else if (NB == 2) *(float4*)&Bs2[bk * 68 + bn] = bv;
        __syncthreads();
        if (k0 + 16 < K) {
            av = af(am, k0 + 16 + ak);
            if (tid < 256) bv = bf(k0 + 16 + bk, bn); else if (NB == 2) bv = bf2(k0 + 16 + bk, bn);
        }
#pragma unroll
        for (int kk = 0; kk < 16; ++kk) {
            const float4 a = *(const float4*)&As[kk * 132 + ty * 4];
            const float4 b = *(const float4*)&Bs[kk * 68 + tx * 4];
            const float aa[4] = {a.x, a.y, a.z, a.w};
            const float bb[4] = {b.x, b.y, b.z, b.w};
#pragma unroll
            for (int i = 0; i < 4; ++i)
#pragma unroll
                for (int j = 0; j < 4; ++j) acc[i][j] = fmaf(aa[i], bb[j], acc[i][j]);
            if (NB == 2) {
                const float4 b2 = *(const float4*)&Bs2[kk * 68 + tx * 4];
                const float bb2[4] = {b2.x, b2.y, b2.z, b2.w};
#pragma unroll
                for (int i = 0; i < 4; ++i)
#pragma unroll
                    for (int j = 0; j < 4; ++j) acc2[i][j] = fmaf(aa[i], bb2[j], acc2[i][j]);
            }
        }
    }
#pragma unroll
    for (int i = 0; i < 4; ++i)
        ef(ty * 4 + i, tx * 4, make_float4(acc[i][0], acc[i][1], acc[i][2], acc[i][3]), make_float4(acc2[i][0], acc2[i][1], acc2[i][2], acc2[i][3]));
}

__device__ __forceinline__ void phase0(const Ctx& c) {
    const float* cc = c.in[1]; const float* w_ada = c.in[2]; const float* b_ada = c.in[3];
    float* mods = (float*)(c.ws + WS_MODS);
    const int gt = c.bid * 512 + c.tid, NT = c.G * 512;
    for (int idx = gt; idx < BATCH * NMODS; idx += NT) {
        const int b = idx / NMODS, j = idx % NMODS;
        float acc = 0.f;
        for (int k = 0; k < D; ++k) acc = fmaf(siluf_(cc[b * D + k]), w_ada[(size_t)k * NMODS + j], acc);
        mods[idx] = acc + b_ada[j];
    }
    const float* log_dt = c.in[20]; const float* a_re = c.in[21]; const float* a_im = c.in[22];
    const float* b_re = c.in[23]; const float* b_im = c.in[24];
    float* ab = (float*)(c.ws + WS_S5AB); float* apow = (float*)(c.ws + WS_S5POW); float* bb = (float*)(c.ws + WS_S5BB);
    for (int idx = gt; idx < S5NG * S5P; idx += NT) {
        const int g = idx / S5P;
        const double dt = exp((double)log_dt[g]);
        const double lre = fmin((double)a_re[idx], -1e-4), lim = (double)a_im[idx];
        const double mag = exp(lre * dt), ang = lim * dt;
        const double abr = mag * cos(ang), abi = mag * sin(ang);
        const double den = lre * lre + lim * lim;
        const double nre = abr - 1.0, nim = abi;
        const double qre = (nre * lre + nim * lim) / den, qim = (nim * lre - nre * lim) / den;
        ab[idx * 2 + 0] = (float)abr; ab[idx * 2 + 1] = (float)abi;
        double pr = abr, pi = abi;
        for (int s = 0; s < 7; ++s) { const double nr = pr * pr - pi * pi, ni = 2.0 * pr * pi; pr = nr; pi = ni; }
        apow[idx * 2 + 0] = (float)pr; apow[idx * 2 + 1] = (float)pi;
        for (int ch = 0; ch < 16; ++ch) {
            const double br = (double)b_re[idx * 16 + ch], bi = (double)b_im[idx * 16 + ch];
            bb[idx * 32 + ch] = (float)(qre * br - qim * bi);
            bb[idx * 32 + 16 + ch] = (float)(qre * bi + qim * br);
        }
    }
}

__device__ __forceinline__ void phase1(const Ctx& c) {
    const float* x = c.in[0]; const float* g = c.in[4];
    const float* mods = (const float*)(c.ws + WS_MODS);
    float* xn = (float*)(c.ws + WS_A);
    const int gw = c.bid * 8 + c.wid, NW = c.G * 8;
    for (int t = gw; t < T; t += NW) {
        const int b = t / SEQ;
        const float4* xr = (const float4*)(x + (size_t)t * D) + c.lane;
        float4 v[4]; float ss = 0.f;
#pragma unroll
        for (int j = 0; j < 4; ++j) { v[j] = xr[64 * j]; ss += v[j].x * v[j].x + v[j].y * v[j].y + v[j].z * v[j].z + v[j].w * v[j].w; }
        const float rstd = rsqrtf(wave_sum(ss) * (1.0f / D) + 1e-6f);
        float4* o = (float4*)(xn + (size_t)t * D) + c.lane;
#pragma unroll
        for (int j = 0; j < 4; ++j) {
            const int k = (c.lane + 64 * j) * 4;
            const float4 gg = *(const float4*)(g + k);
            const float4 sh = *(const float4*)(mods + b * NMODS + k);
            const float4 sc = *(const float4*)(mods + b * NMODS + D + k);
            float4 r;
            r.x = v[j].x * rstd * gg.x * (1.f + sc.x) + sh.x; r.y = v[j].y * rstd * gg.y * (1.f + sc.y) + sh.y;
            r.z = v[j].z * rstd * gg.z * (1.f + sc.z) + sh.z; r.w = v[j].w * rstd * gg.w * (1.f + sc.w) + sh.w;
            o[64 * j] = r;
        }
    }
}

__device__ __forceinline__ void phase2(const Ctx& c) {
    const float* xn = (const float*)(c.ws + WS_A); const float* w = c.in[8];
    float* proj = (float*)(c.ws + WS_PROJ);
    constexpr int NT_ = NPROJ / 64, NITEMS = (T / 128) * NT_;
    for (int it = c.bid; it < NITEMS; it += c.G) {
        const int mt = it / NT_, nt = it % NT_;
        const float* A = xn + (size_t)mt * 128 * D; const float* B = w + nt * 64; float* C = proj + (size_t)mt * 128 * NPROJ + nt * 64;
        gemm_tile<1>(c.sm, D,
            [&](int m, int k) { return *(const float4*)(A + (size_t)m * D + k); },
            [&](int k, int n) { return *(const float4*)(B + (size_t)k * NPROJ + n); },
            [&](int k, int n) { return make_float4(0.f, 0.f, 0.f, 0.f); },
            [&](int m, int n, float4 a, float4) { *(float4*)(C + (size_t)m * NPROJ + n) = a; });
    }
}

__device__ __forceinline__ void phase3(const Ctx& c) {
    const float* proj = (const float*)(c.ws + WS_PROJ);
    const float* mu = c.in[9]; const float* w0 = c.in[10]; const float* w2 = c.in[11]; const float* a0 = c.in[12]; const float* a2 = c.in[13];
    const float* g2 = c.in[14]; const float* k_k = c.in[15]; const float* k_a = c.in[16];
    float* rw_r = (float*)(c.ws + WS_RW + 0 * RWSZ); float* rw_w = (float*)(c.ws + WS_RW + 1 * RWSZ); float* rw_k = (float*)(c.ws + WS_RW + 2 * RWSZ);
    float* rw_v = (float*)(c.ws + WS_RW + 3 * RWSZ); float* rw_a = (float*)(c.ws + WS_RW + 4 * RWSZ); float* rw_b = (float*)(c.ws + WS_RW + 5 * RWSZ);
    float* rw_g = (float*)(c.ws + WS_RW + 6 * RWSZ);
    float* lo = c.sm;
    const int n = c.tid;
    for (int it = c.bid; it < T / 8; it += c.G) {
        const int t0 = it * 8;
        __syncthreads();
        if (n < 256) {
            const int col = 1536 + n; const float m_ = mu[col];
#pragma unroll
            for (int tk = 0; tk < 8; ++tk) {
                const int t = t0 + tk;
                const float p = proj[(size_t)t * NPROJ + col];
                const float pv = (t % SEQ == 0) ? 0.f : proj[(size_t)(t - 1) * NPROJ + col];
                const float ps = p + (pv - p) * m_;
                float v = ps;
                if (n < 64) v = tanhf(ps); else if (n >= 128) v = sigmoidf_(ps);
                lo[tk * 256 + n] = v;
            }
        }
        __syncthreads();
        float wl[8], al[8], gl[8];
#pragma unroll
        for (int tk = 0; tk < 8; ++tk) { wl[tk] = 0.f; al[tk] = 0.f; gl[tk] = 0.f; }
        for (int j = 0; j < 64; ++j) {
            const float wv = w2[j * RW + n], av = a2[j * RW + n];
#pragma unroll
            for (int tk = 0; tk < 8; ++tk) { wl[tk] = fmaf(lo[tk * 256 + j], wv, wl[tk]); al[tk] = fmaf(lo[tk * 256 + 64 + j], av, al[tk]); }
        }
        for (int j = 0; j < 128; ++j) {
            const float gv = g2[j * RW + n];
#pragma unroll
            for (int tk = 0; tk < 8; ++tk) gl[tk] = fmaf(lo[tk * 256 + 128 + j], gv, gl[tk]);
        }
        const float mur = mu[n], muk = mu[512 + n], muv = mu[1024 + n];
        const float w0n = w0[n], a0n = a0[n], kkn = k_k[n], kan = k_a[n];
#pragma unroll
        for (int tk = 0; tk < 8; ++tk) {
            const int t = t0 + tk; const bool first = (t % SEQ == 0);
            const float* pr = proj + (size_t)t * NPROJ; const float* pp = proj + (size_t)(first ? t : t - 1) * NPROJ;
            float r = pr[n], k = pr[512 + n], v = pr[1024 + n];
            const float r1 = first ? 0.f : pp[n], k1 = first ? 0.f : pp[512 + n], v1 = first ? 0.f : pp[1024 + n];
            r = r + (r1 - r) * mur; k = k + (k1 - k) * muk; v = v + (v1 - v) * muv;
            const float wa = w0n + wl[tk];
            const float logw = -softplusf_(-wa) - 0.5f;
            const float decay = expf(-expf(logw));
            const float iclr = sigmoidf_(a0n + al[tk]);
            float kk = k * kkn;
            const float ss = wave_sum(kk * kk);
            kk = kk / fmaxf(sqrtf(ss), 1e-12f);
            const float kf = k * (1.f + (iclr - 1.f) * kan);
            const size_t o = (size_t)t * RW + n;
            rw_r[o] = r; rw_w[o] = decay; rw_k[o] = kf; rw_v[o] = v; rw_a[o] = -kk; rw_b[o] = kk * iclr; rw_g[o] = gl[tk];
        }
    }
    const float* ab = (const float*)(c.ws + WS_S5AB); const float* bbp = (const float*)(c.ws + WS_S5BB);
    float* E = (float*)(c.ws + WS_S5E);
    const int gw = c.bid * 8 + c.wid, NW = c.G * 8;
    for (int it = gw; it < BATCH * S5NG * S5NC; it += NW) {
        const int ch = it % S5NC, g = (it / S5NC) % S5NG, b = it / (S5NC * S5NG);
        const int p = c.lane;
        float bbr[16], bbi[16];
#pragma unroll
        for (int q = 0; q < 4; ++q) {
            const float4 v1 = *(const float4*)(bbp + (size_t)(g * 64 + p) * 32 + q * 4), v2 = *(const float4*)(bbp + (size_t)(g * 64 + p) * 32 + 16 + q * 4);
            bbr[q * 4 + 0] = v1.x; bbr[q * 4 + 1] = v1.y; bbr[q * 4 + 2] = v1.z; bbr[q * 4 + 3] = v1.w;
            bbi[q * 4 + 0] = v2.x; bbi[q * 4 + 1] = v2.y; bbi[q * 4 + 2] = v2.z; bbi[q * 4 + 3] = v2.w;
        }
        const float ar = ab[(g * 64 + p) * 2], ai = ab[(g * 64 + p) * 2 + 1];
        float xr = 0.f, xi = 0.f;
        const float* up = proj + (size_t)(b * SEQ + ch * S5CL) * NPROJ + RPROJ + g * 16;
        for (int s = 0; s < S5CL; ++s) {
            const float4 u0 = *(const float4*)(up + (size_t)s * NPROJ), u1 = *(const float4*)(up + (size_t)s * NPROJ + 4), u2 = *(const float4*)(up + (size_t)s * NPROJ + 8), u3 = *(const float4*)(up + (size_t)s * NPROJ + 12);
            const float u[16] = {u0.x, u0.y, u0.z, u0.w, u1.x, u1.y, u1.z, u1.w, u2.x, u2.y, u2.z, u2.w, u3.x, u3.y, u3.z, u3.w};
            float br = 0.f, bi = 0.f;
#pragma unroll
            for (int q = 0; q < 16; ++q) { br = fmaf(bbr[q], u[q], br); bi = fmaf(bbi[q], u[q], bi); }
            const float nr = ar * xr - ai * xi + br, ni = ar * xi + ai * xr + bi;
            xr = nr; xi = ni;
        }
        *(float2*)(E + (size_t)it * 128 + p * 2) = make_float2(xr, xi);
    }
}

__device__ __forceinline__ void phase4(const Ctx& c) {
    const float* __restrict__ rw_r = (const float*)(c.ws + WS_RW + 0 * RWSZ); const float* __restrict__ rw_w = (const float*)(c.ws + WS_RW + 1 * RWSZ);
    const float* __restrict__ rw_k = (const float*)(c.ws + WS_RW + 2 * RWSZ); const float* __restrict__ rw_v = (const float*)(c.ws + WS_RW + 3 * RWSZ);
    const float* __restrict__ rw_a = (const float*)(c.ws + WS_RW + 4 * RWSZ); const float* __restrict__ rw_b = (const float*)(c.ws + WS_RW + 5 * RWSZ);
    float* __restrict__ rw_y = (float*)(c.ws + WS_RW + 7 * RWSZ);
    for (int task = c.wid * c.G + c.bid; task < 512 + BATCH * S5NG; task += c.G * 8) {
        if (task < 512) {
            const int bh = task >> 4, rg = task & 15, b = bh >> 3, h = bh & 7;
            const int row = rg * 4 + (c.lane >> 4), kq = c.lane & 15;
            const size_t base = (size_t)(b * SEQ) * RW + h * 64;
            const float* W = rw_w + base + kq * 4; const float* A = rw_a + base + kq * 4; const float* Bv = rw_b + base + kq * 4;
            const float* Kf = rw_k + base + kq * 4; const float* R = rw_r + base + kq * 4; const float* V = rw_v + base + row; float* Y = rw_y + base + row;
            float S0 = 0.f, S1 = 0.f, S2 = 0.f, S3 = 0.f;
#pragma unroll 4
            for (int t = 0; t < SEQ; ++t) {
                const size_t o = (size_t)t * RW;
                const float4 w = *(const float4*)(W + o), a = *(const float4*)(A + o), bb = *(const float4*)(Bv + o), k = *(const float4*)(Kf + o), r = *(const float4*)(R + o);
                const float v = V[o];
                float sa = S0 * a.x + S1 * a.y + S2 * a.z + S3 * a.w;
                sa += __shfl_xor(sa, 1); sa += __shfl_xor(sa, 2); sa += __shfl_xor(sa, 4); sa += __shfl_xor(sa, 8);
                S0 = S0 * w.x + sa * bb.x + v * k.x; S1 = S1 * w.y + sa * bb.y + v * k.y;
                S2 = S2 * w.z + sa * bb.z + v * k.z; S3 = S3 * w.w + sa * bb.w + v * k.w;
                float y = S0 * r.x + S1 * r.y + S2 * r.z + S3 * r.w;
                y += __shfl_xor(y, 1); y += __shfl_xor(y, 2); y += __shfl_xor(y, 4); y += __shfl_xor(y, 8);
                if (kq == 0) Y[o] = y;
            }
        } else {
            const int bg = task - 512, g = bg % S5NG, p = c.lane;
            const float* apow = (const float*)(c.ws + WS_S5POW);
            const float* E = (const float*)(c.ws + WS_S5E); float* X0 = (float*)(c.ws + WS_S5X0);
            const float pr = apow[(g * 64 + p) * 2], pi = apow[(g * 64 + p) * 2 + 1];
            float xr = 0.f, xi = 0.f;
            for (int ch = 0; ch < S5NC; ++ch) {
                const size_t o = ((size_t)bg * S5NC + ch) * 128 + p * 2;
                *(float2*)(X0 + o) = make_float2(xr, xi);
                const float2 e = *(const float2*)(E + o);
                const float nr = pr * xr - pi * xi + e.x, ni = pr * xi + pi * xr + e.y;
                xr = nr; xi = ni;
            }
        }
    }
}

__device__ __forceinline__ void phase5(const Ctx& c) {
    const float* rw_r = (const float*)(c.ws + WS_RW + 0 * RWSZ); const float* rw_k = (const float*)(c.ws + WS_RW + 2 * RWSZ);
    const float* rw_v = (const float*)(c.ws + WS_RW + 3 * RWSZ); const float* rw_g = (const float*)(c.ws + WS_RW + 6 * RWSZ);
    const float* rw_y = (const float*)(c.ws + WS_RW + 7 * RWSZ);
    const float* r_k = c.in[17]; const float* ln_w = c.in[18]; const float* ln_b = c.in[19];
    float* ycat = (float*)(c.ws + WS_A);
    const int gw = c.bid * 8 + c.wid, NW = c.G * 8;
    for (int it = gw; it < T * NH; it += NW) {
        const int t = it >> 3, h = it & 7, hn = h * 64 + c.lane;
        const size_t o = (size_t)t * RW + hn;
        const float y = rw_y[o];
        const float mean = wave_sum(y) * (1.f / 64.f);
        const float d = y - mean;
        const float var = wave_sum(d * d) * (1.f / 64.f);
        const float yn = d * rsqrtf(var + 64e-5f) * ln_w[hn] + ln_b[hn];
        const float v = rw_v[o];
        const float bonus = wave_sum(rw_r[o] * rw_k[o] * r_k[hn]) * v;
        ycat[(size_t)t * D + hn] = (yn + bonus) * rw_g[o];
    }
    const float* proj = (const float*)(c.ws + WS_PROJ);
    const float* ab = (const float*)(c.ws + WS_S5AB); const float* bbp = (const float*)(c.ws + WS_S5BB); const float* X0 = (const float*)(c.ws + WS_S5X0);
    const float* c_re = c.in[25]; const float* c_im = c.in[26]; const float* dd = c.in[27];
    float* ys5 = (float*)(c.ws + WS_YS5);
    float* Cm = c.sm + c.wid * (16 * 132 + 4 * 128);
    float* Xs = Cm + 16 * 132;
    for (int it = gw; it < BATCH * S5NG * S5NC; it += NW) {
        const int ch = it % S5NC, g = (it / S5NC) % S5NG, b = it / (S5NC * S5NG);
        const int p = c.lane;
#pragma unroll
        for (int cc = 0; cc < 16; ++cc) { Cm[cc * 132 + p] = c_re[(g * 16 + cc) * 64 + p]; Cm[cc * 132 + 64 + p] = -c_im[(g * 16 + cc) * 64 + p]; }
        float bbr[16], bbi[16];
#pragma unroll
        for (int q = 0; q < 4; ++q) {
            const float4 v1 = *(const float4*)(bbp + (size_t)(g * 64 + p) * 32 + q * 4), v2 = *(const float4*)(bbp + (size_t)(g * 64 + p) * 32 + 16 + q * 4);
            bbr[q * 4 + 0] = v1.x; bbr[q * 4 + 1] = v1.y; bbr[q * 4 + 2] = v1.z; bbr[q * 4 + 3] = v1.w;
            bbi[q * 4 + 0] = v2.x; bbi[q * 4 + 1] = v2.y; bbi[q * 4 + 2] = v2.z; bbi[q * 4 + 3] = v2.w;
        }
        const float ar = ab[(g * 64 + p) * 2], ai = ab[(g * 64 + p) * 2 + 1];
        const float2 x0 = *(const float2*)(X0 + (size_t)it * 128 + p * 2);
        float xr = x0.x, xi = x0.y;
        const int tb = b * SEQ + ch * S5CL;
        const float* up = proj + (size_t)tb * NPROJ + RPROJ + g * 16;
        const int cc = c.lane & 15, tq = c.lane >> 4;
        const float dv = dd[g * 16 + cc];
        for (int s0 = 0; s0 < S5CL; s0 += 4) {
#pragma unroll
            for (int s1 = 0; s1 < 4; ++s1) {
                const int s = s0 + s1;
                const float4 u0 = *(const float4*)(up + (size_t)s * NPROJ), u1 = *(const float4*)(up + (size_t)s * NPROJ + 4), u2 = *(const float4*)(up + (size_t)s * NPROJ + 8), u3 = *(const float4*)(up + (size_t)s * NPROJ + 12);
                const float u[16] = {u0.x, u0.y, u0.z, u0.w, u1.x, u1.y, u1.z, u1.w, u2.x, u2.y, u2.z, u2.w, u3.x, u3.y, u3.z, u3.w};
                float br = 0.f, bi = 0.f;
#pragma unroll
                for (int q = 0; q < 16; ++q) { br = fmaf(bbr[q], u[q], br); bi = fmaf(bbi[q], u[q], bi); }
                const float nr = ar * xr - ai * xi + br, ni = ar * xi + ai * xr + bi;
                xr = nr; xi = ni;
                Xs[s1 * 128 + p] = xr; Xs[s1 * 128 + 64 + p] = xi;
            }
            __builtin_amdgcn_wave_barrier();
            asm volatile("s_waitcnt lgkmcnt(0)" ::: "memory");
            float y = 0.f;
#pragma unroll 8
            for (int q = 0; q < 128; q += 4) {
                const float4 cv = *(const float4*)&Cm[cc * 132 + q];
                const float4 xv = *(const float4*)&Xs[tq * 128 + q];
                y = fmaf(cv.x, xv.x, y); y = fmaf(cv.y, xv.y, y); y = fmaf(cv.z, xv.z, y); y = fmaf(cv.w, xv.w, y);
            }
            const int t = tb + s0 + tq;
            const float uu = proj[(size_t)t * NPROJ + RPROJ + g * 16 + cc];
            ys5[(size_t)t * 512 + g * 16 + cc] = geluf_(y + dv * uu);
            __builtin_amdgcn_wave_barrier();
            asm volatile("s_waitcnt lgkmcnt(0)" ::: "memory");
        }
    }
}

__device__ __forceinline__ void phase6(const Ctx& c) {
    const float* ys5 = (const float*)(c.ws + WS_YS5); const float* w = c.in[28]; const float* bg = c.in[29];
    float* ycat = (float*)(c.ws + WS_A);
    constexpr int NT_ = 512 / 64, NITEMS = (T / 128) * NT_;
    for (int it = c.bid; it < NITEMS; it += c.G) {
        const int mt = it / NT_, nt = it % NT_;
        const float* A = ys5 + (size_t)mt * 128 * 512; const float* B = w + nt * 64;
        gemm_tile<1>(c.sm, 512,
            [&](int m, int k) { return *(const float4*)(A + (size_t)m * 512 + k); },
            [&](int k, int n) { return *(const float4*)(B + (size_t)k * 512 + n); },
            [&](int k, int n) { return make_float4(0.f, 0.f, 0.f, 0.f); },
            [&](int m, int n, float4 a, float4) {
                const float4 yv = *(const float4*)(A + (size_t)m * 512 + nt * 64 + n);
                const float4 bv = *(const float4*)(bg + nt * 64 + n);
                float4 o; o.x = yv.x * sigmoidf_(a.x + bv.x); o.y = yv.y * sigmoidf_(a.y + bv.y); o.z = yv.z * sigmoidf_(a.z + bv.z); o.w = yv.w * sigmoidf_(a.w + bv.w);
                *(float4*)(ycat + (size_t)(mt * 128 + m) * D + 512 + nt * 64 + n) = o; });
    }
}

__device__ __forceinline__ void phase7(const Ctx& c) {
    const float* ycat = (const float*)(c.ws + WS_A); const float* w = c.in[30];
    float* mixed = (float*)(c.ws + WS_PROJ);
    constexpr int NT_ = D / 64, NITEMS = (T / 128) * NT_;
    for (int it = c.bid; it < NITEMS; it += c.G) {
        const int mt = it / NT_, nt = it % NT_;
        const float* A = ycat + (size_t)mt * 128 * D; const float* B = w + nt * 64; float* C = mixed + (size_t)mt * 128 * D + nt * 64;
        gemm_tile<1>(c.sm, D,
            [&](int m, int k) { return *(const float4*)(A + (size_t)m * D + k); },
            [&](int k, int n) { return *(const float4*)(B + (size_t)k * D + n); },
            [&](int k, int n) { return make_float4(0.f, 0.f, 0.f, 0.f); },
            [&](int m, int n, float4 a, float4) { *(float4*)(C + (size_t)m * D + n) = a; });
    }
}

__device__ __forceinline__ void phase8(const Ctx& c) {
    const float* x = c.in[0]; const float* gpm = c.in[5]; const float* gpf = c.in[6];
    const float* mods = (const float*)(c.ws + WS_MODS); const float* mixed = (const float*)(c.ws + WS_PROJ);
    float* h2 = (float*)(c.ws + WS_A); float* x1o = c.out;
    const int gw = c.bid * 8 + c.wid, NW = c.G * 8;
    for (int t = gw; t < T; t += NW) {
        const int b = t / SEQ;
        const float4* mr = (const float4*)(mixed + (size_t)t * D) + c.lane;
        const float4* xr = (const float4*)(x + (size_t)t * D) + c.lane;
        float4 m[4], v[4]; float ss = 0.f;
#pragma unroll
        for (int j = 0; j < 4; ++j) { m[j] = mr[64 * j]; v[j] = xr[64 * j]; ss += m[j].x * m[j].x + m[j].y * m[j].y + m[j].z * m[j].z + m[j].w * m[j].w; }
        const float rstd = rsqrtf(wave_sum(ss) * (1.0f / D) + 1e-6f);
        float s1 = 0.f;
#pragma unroll
        for (int j = 0; j < 4; ++j) {
            const int k = (c.lane + 64 * j) * 4;
            const float4 gg = *(const float4*)(gpm + k);
            const float4 gt = *(const float4*)(mods + b * NMODS + 2 * D + k);
            v[j].x += gt.x * (m[j].x * rstd * gg.x); v[j].y += gt.y * (m[j].y * rstd * gg.y);
            v[j].z += gt.z * (m[j].z * rstd * gg.z); v[j].w += gt.w * (m[j].w * rstd * gg.w);
            s1 += v[j].x * v[j].x + v[j].y * v[j].y + v[j].z * v[j].z + v[j].w * v[j].w;
            ((float4*)(x1o + (size_t)t * D) + c.lane)[64 * j] = v[j];
        }
        const float rstd1 = rsqrtf(wave_sum(s1) * (1.0f / D) + 1e-6f);
#pragma unroll
        for (int j = 0; j < 4; ++j) {
            const int k = (c.lane + 64 * j) * 4;
            const float4 gg = *(const float4*)(gpf + k);
            const float4 sh = *(const float4*)(mods + b * NMODS + 3 * D + k);
            const float4 sc = *(const float4*)(mods + b * NMODS + 4 * D + k);
            float4 r;
            r.x = v[j].x * rstd1 * gg.x * (1.f + sc.x) + sh.x; r.y = v[j].y * rstd1 * gg.y * (1.f + sc.y) + sh.y;
            r.z = v[j].z * rstd1 * gg.z * (1.f + sc.z) + sh.z; r.w = v[j].w * rstd1 * gg.w * (1.f + sc.w) + sh.w;
            ((float4*)(h2 + (size_t)t * D) + c.lane)[64 * j] = r;
        }
    }
}

__device__ __forceinline__ void phase9(const Ctx& c) {
    const float* h2 = (const float*)(c.ws + WS_A); const float* wr = c.in[31]; const float* wg = c.in[36]; const float* wu = c.in[37];
    float* logits = (float*)(c.ws + WS_LOGITS); float* hs = (float*)(c.ws + WS_HS);
    constexpr int NT_ = 256 / 64, NI1 = (T / 128) * NT_;
    for (int it = c.bid; it < 2 * NI1; it += c.G) {
        const int which = it / NI1, r = it % NI1, mt = r / NT_, nt = r % NT_;
        const float* A = h2 + (size_t)mt * 128 * D;
        if (which == 0) {
            const float* B = wr + nt * 64; float* C = logits + (size_t)mt * 128 * 256 + nt * 64;
            gemm_tile<1>(c.sm, D,
                [&](int m, int k) { return *(const float4*)(A + (size_t)m * D + k); },
                [&](int k, int n) { return *(const float4*)(B + (size_t)k * 256 + n); },
                [&](int k, int n) { return make_float4(0.f, 0.f, 0.f, 0.f); },
                [&](int m, int n, float4 a, float4) { *(float4*)(C + (size_t)m * 256 + n) = a; });
        } else {
            const float* B = wg + nt * 64; const float* B2 = wu + nt * 64; float* C = hs + (size_t)mt * 128 * 256 + nt * 64;
            gemm_tile<2>(c.sm, D,
                [&](int m, int k) { return *(const float4*)(A + (size_t)m * D + k); },
                [&](int k, int n) { return *(const float4*)(B + (size_t)k * 256 + n); },
                [&](int k, int n) { return *(const float4*)(B2 + (size_t)k * 256 + n); },
                [&](int m, int n, float4 a, float4 u) {
                    float4 o; o.x = siluf_(a.x) * u.x; o.y = siluf_(a.y) * u.y; o.z = siluf_(a.z) * u.z; o.w = siluf_(a.w) * u.w;
                    *(float4*)(C + (size_t)m * 256 + n) = o; });
        }
    }
}

__device__ __forceinline__ void phase10(const Ctx& c) {
    const float* logits = (const float*)(c.ws + WS_LOGITS); const float* rb = c.in[32];
    int* idx = (int*)(c.ws + WS_IDX); float* wt = (float*)(c.ws + WS_WT); unsigned* counts = (unsigned*)(c.ws + WS_COUNTS);
    const int gw = c.bid * 8 + c.wid, NW = c.G * 8, l = c.lane;
    const float4 bias = *(const float4*)(rb + l * 4);
    for (int t = gw; t < T; t += NW) {
        const float4 lg = *(const float4*)(logits + (size_t)t * 256 + l * 4);
        float s[4] = {sigmoidf_(lg.x), sigmoidf_(lg.y), sigmoidf_(lg.z), sigmoidf_(lg.w)};
        float ch[4] = {s[0] + bias.x, s[1] + bias.y, s[2] + bias.z, s[3] + bias.w};
        float a1 = fmaxf(ch[0], ch[1]), a2 = fminf(ch[0], ch[1]);
        { const float b1 = fmaxf(ch[2], ch[3]), b2 = fminf(ch[2], ch[3]); const float n1 = fmaxf(a1, b1), n2 = fmaxf(fminf(a1, b1), fmaxf(a2, b2)); a1 = n1; a2 = n2; }
#pragma unroll
        for (int o = 1; o < 8; o <<= 1) { const float b1 = __shfl_xor(a1, o), b2 = __shfl_xor(a2, o); const float n1 = fmaxf(a1, b1), n2 = fmaxf(fminf(a1, b1), fmaxf(a2, b2)); a1 = n1; a2 = n2; }
        const float gs = a1 + a2; const int myg = l >> 3;
        int rank = 0;
#pragma unroll
        for (int g = 0; g < 8; ++g) { const float og = __shfl(gs, g * 8); rank += (og > gs || (og == gs && g < myg)) ? 1 : 0; }
        const bool sel = rank < 4;
        float mc[4];
#pragma unroll
        for (int i = 0; i < 4; ++i) mc[i] = sel ? ch[i] : -INFINITY;
        float sk[8]; int ek[8]; float ssum = 0.f;
#pragma unroll
        for (int k = 0; k < 8; ++k) {
            float bv = mc[0]; int be = l * 4;
#pragma unroll
            for (int i = 1; i < 4; ++i) if (mc[i] > bv) { bv = mc[i]; be = l * 4 + i; }
#pragma unroll
            for (int o = 1; o < 64; o <<= 1) { const float ov = __shfl_xor(bv, o); const int oe = __shfl_xor(be, o); if (ov > bv || (ov == bv && oe < be)) { bv = ov; be = oe; } }
            const int ii = be & 3;
            float sv = s[0]; sv = (ii == 1) ? s[1] : sv; sv = (ii == 2) ? s[2] : sv; sv = (ii == 3) ? s[3] : sv;
            sv = __shfl(sv, be >> 2);
            if ((be >> 2) == l) {
#pragma unroll
                for (int i = 0; i < 4; ++i) if (i == ii) mc[i] = -INFINITY;
            }
            sk[k] = sv; ek[k] = be; ssum += sv;
        }
        if (l == 0) {
            const float inv = 2.5f / ssum;
#pragma unroll
            for (int k = 0; k < 8; ++k) { idx[t * 8 + k] = ek[k]; wt[t * 8 + k] = sk[k] * inv; atomicAdd(&counts[ek[k]], 1u); }
        }
    }
}

__device__ __forceinline__ void build_offsets(const Ctx& c, int* smi) {
    const unsigned* counts = (const unsigned*)(c.ws + WS_COUNTS);
    __syncthreads();
    if (c.tid == 0) {
        int o = 0, tl = 0;
        for (int e = 0; e < NE; ++e) { const int cn = (int)counts[e]; smi[e] = o; smi[260 + e] = tl; o += cn; tl += (cn + 127) >> 7; }
        smi[NE] = o; smi[260 + NE] = tl;
    }
    __syncthreads();
}

__device__ __forceinline__ void phase11(const Ctx& c) {
    int* smi = (int*)c.sm + 8192;
    build_offsets(c, smi);
    const int* idx = (const int*)(c.ws + WS_IDX); int* slot = (int*)(c.ws + WS_SLOT); unsigned* cursor = (unsigned*)(c.ws + WS_COUNTS) + 256;
    const int gt = c.bid * 512 + c.tid, NT = c.G * 512;
    for (int a = gt; a < T * 8; a += NT) {
        const int e = idx[a];
        const unsigned pos = atomicAdd(&cursor[e], 1u);
        slot[smi[e] + (int)pos] = a;
    }
}

__device__ __forceinline__ void phase12(const Ctx& c) {
    int* smi = (int*)c.sm + 8192;
    build_offsets(c, smi);
    const float* h2 = (const float*)(c.ws + WS_A); const float* wg = c.in[33]; const float* wu = c.in[34];
    const int* slot = (const int*)(c.ws + WS_SLOT); bf16_t* hid = (bf16_t*)(c.ws + WS_HID);
    const int ntiles = smi[260 + NE];
    for (int it = c.bid; it < ntiles * 4; it += c.G) {
        const int tile = it >> 2, nt = it & 3;
        int lo = 0, hi = NE;
        while (hi - lo > 1) { const int mid = (lo + hi) >> 1; if (smi[260 + mid] <= tile) lo = mid; else hi = mid; }
        const int e = lo, s0 = smi[e] + (tile - smi[260 + e]) * 128, send = smi[e + 1];
        const int am = c.tid >> 2;
        const float* arow = (s0 + am < send) ? h2 + (size_t)(slot[s0 + am] >> 3) * D : nullptr;
        const float* B = wg + (size_t)e * D * EFF + nt * 64; const float* B2 = wu + (size_t)e * D * EFF + nt * 64;
        gemm_tile<2>(c.sm, D,
            [&](int m, int k) { return arow ? *(const float4*)(arow + k) : make_float4(0.f, 0.f, 0.f, 0.f); },
            [&](int k, int n) { return *(const float4*)(B + (size_t)k * EFF + n); },
            [&](int k, int n) { return *(const float4*)(B2 + (size_t)k * EFF + n); },
            [&](int m, int n, float4 a, float4 u) {
                if (s0 + m < send) {
                    uint2 o; o.x = f2bf(siluf_(a.x) * u.x) | (f2bf(siluf_(a.y) * u.y) << 16); o.y = f2bf(siluf_(a.z) * u.z) | (f2bf(siluf_(a.w) * u.w) << 16);
                    *(uint2*)(hid + (size_t)(s0 + m) * EFF + nt * 64 + n) = o; } });
    }
}

__device__ __forceinline__ void phase13(const Ctx& c) {
    int* smi = (int*)c.sm + 8192;
    build_offsets(c, smi);
    const float* wd = c.in[35]; const float* wsd = c.in[38];
    const int* slot = (const int*)(c.ws + WS_SLOT); const bf16_t* hid = (const bf16_t*)(c.ws + WS_HID);
    const float* wt = (const float*)(c.ws + WS_WT); bf16_t* yexp = (bf16_t*)(c.ws + WS_YEXP);
    const float* hs = (const float*)(c.ws + WS_HS); float* shout = (float*)(c.ws + WS_SHOUT);
    const int ntiles = smi[260 + NE];
    const int NI1 = ntiles * 16, NI2 = (T / 128) * 16;
    for (int it = c.bid; it < NI1 + NI2; it += c.G) {
        if (it < NI1) {
            const int tile = it >> 4, nt = it & 15;
            int lo = 0, hi = NE;
            while (hi - lo > 1) { const int mid = (lo + hi) >> 1; if (smi[260 + mid] <= tile) lo = mid; else hi = mid; }
            const int e = lo, s0 = smi[e] + (tile - smi[260 + e]) * 128, send = smi[e + 1];
            const int am = c.tid >> 2;
            const bf16_t* arow = (s0 + am < send) ? hid + (size_t)(s0 + am) * EFF : nullptr;
            const float* B = wd + (size_t)e * EFF * D + nt * 64;
            gemm_tile<1>(c.sm, EFF,
                [&](int m, int k) { if (!arow) return make_float4(0.f, 0.f, 0.f, 0.f); const uint2 v = *(const uint2*)(arow + k);
                                    return make_float4(bf2f(v.x & 0xffffu), bf2f(v.x >> 16), bf2f(v.y & 0xffffu), bf2f(v.y >> 16)); },
                [&](int k, int n) { return *(const float4*)(B + (size_t)k * D + n); },
                [&](int k, int n) { return make_float4(0.f, 0.f, 0.f, 0.f); },
                [&](int m, int n, float4 a, float4) {
                    if (s0 + m < send) {
                        const int aid = slot[s0 + m]; const float w = wt[aid];
                        uint2 o; o.x = f2bf(a.x * w) | (f2bf(a.y * w) << 16); o.y = f2bf(a.z * w) | (f2bf(a.w * w) << 16);
                        *(uint2*)(yexp + (size_t)aid * D + nt * 64 + n) = o; } });
        } else {
            const int r = it - NI1, mt = r >> 4, nt = r & 15;
            const float* A = hs + (size_t)mt * 128 * 256; const float* B = wsd + nt * 64; float* C = shout + (size_t)mt * 128 * D + nt * 64;
            gemm_tile<1>(c.sm, 256,
                [&](int m, int k) { return *(const float4*)(A + (size_t)m * 256 + k); },
                [&](int k, int n) { return *(const float4*)(B + (size_t)k * D + n); },
                [&](int k, int n) { return make_float4(0.f, 0.f, 0.f, 0.f); },
                [&](int m, int n, float4 a, float4) { *(float4*)(C + (size_t)m * D + n) = a; });
        }
    }
}

__device__ __forceinline__ void phase14(const Ctx& c) {
    const float* gq = c.in[7]; const float* mods = (const float*)(c.ws + WS_MODS);
    const float* shout = (const float*)(c.ws + WS_SHOUT); const bf16_t* yexp = (const bf16_t*)(c.ws + WS_YEXP);
    float* out = c.out;
    const int gw = c.bid * 8 + c.wid, NW = c.G * 8;
    for (int t = gw; t < T; t += NW) {
        const int b = t / SEQ;
        float4 y[4]; float ss = 0.f;
#pragma unroll
        for (int j = 0; j < 4; ++j) {
            const int k = (c.lane + 64 * j) * 4;
            float4 a = *(const float4*)(shout + (size_t)t * D + k);
#pragma unroll
            for (int q = 0; q < 8; ++q) {
                const uint2 v = *(const uint2*)(yexp + (size_t)(t * 8 + q) * D + k);
                a.x += bf2f(v.x & 0xffffu); a.y += bf2f(v.x >> 16); a.z += bf2f(v.y & 0xffffu); a.w += bf2f(v.y >> 16);
            }
            y[j] = a; ss += a.x * a.x + a.y * a.y + a.z * a.z + a.w * a.w;
        }
        const float rstd = rsqrtf(wave_sum(ss) * (1.0f / D) + 1e-6f);
#pragma unroll
        for (int j = 0; j < 4; ++j) {
            const int k = (c.lane + 64 * j) * 4;
            const float4 gg = *(const float4*)(gq + k);
            const float4 gt = *(const float4*)(mods + b * NMODS + 5 * D + k);
            float4 x1 = *(const float4*)(out + (size_t)t * D + k);
            x1.x += gt.x * (y[j].x * rstd * gg.x); x1.y += gt.y * (y[j].y * rstd * gg.y);
            x1.z += gt.z * (y[j].z * rstd * gg.z); x1.w += gt.w * (y[j].w * rstd * gg.w);
            *(float4*)(out + (size_t)t * D + k) = x1;
        }
    }
}

constexpr int NPHASES = 15;

__global__ void __launch_bounds__(512) mega(Args args) {
    extern __shared__ __attribute__((aligned(16))) unsigned char lds_raw[];
    Ctx c;
    c.in = args.in; c.out = args.out; c.ws = args.ws;
    c.lds = (LAS unsigned char*)lds_raw; c.sm = (float*)lds_raw;
    c.tid = threadIdx.x; c.lane = c.tid & 63; c.wid = __builtin_amdgcn_readfirstlane(c.tid >> 6); c.bid = blockIdx.x; c.G = gridDim.x;
    volatile LAS unsigned* st = (volatile LAS unsigned*)(c.lds + LDS_CTL_OFF);
    if (c.tid < 4) st[c.tid] = 0u;
    __syncthreads();
    XcdBarrier bar; bar.bar = (unsigned*)(args.ws + WS_CTL); bar.x = 0; bar.st = st;
    const bool multi = (args.hi - args.lo) > 1;
    if (multi) bar = xcd_barrier_post((unsigned*)(args.ws + WS_CTL), st);
    const int lo = args.lo, hi = args.hi;
#define RUN_PHASE(k, call) if (lo <= (k) && (k) < hi) { call; if ((k) + 1 < hi) xcd_barrier(bar); }
    RUN_PHASE(0, phase0(c))
    RUN_PHASE(1, phase1(c))
    RUN_PHASE(2, phase2(c))
    RUN_PHASE(3, phase3(c))
    RUN_PHASE(4, phase4(c))
    RUN_PHASE(5, phase5(c))
    RUN_PHASE(6, phase6(c))
    RUN_PHASE(7, phase7(c))
    RUN_PHASE(8, phase8(c))
    RUN_PHASE(9, phase9(c))
    RUN_PHASE(10, phase10(c))
    RUN_PHASE(11, phase11(c))
    RUN_PHASE(12, phase12(c))
    RUN_PHASE(13, phase13(c))
    RUN_PHASE(14, phase14(c))
#undef RUN_PHASE
}

#ifndef N_LAUNCH_MODE
#define N_LAUNCH_MODE 15
#endif

extern "C" void kernel_launch(void* const* d_in, const int* in_sizes, int n_in, void* d_out, int out_size, void* d_ws, size_t ws_size, hipStream_t stream) {
    static int grid = 0;
    if (grid == 0) {
        if (n_in != 39 || out_size != T * D || ws_size < WS_END) { fprintf(stderr, "kernel_launch: unexpected shapes n_in %d out %d ws %zu\n", n_in, out_size, ws_size); grid = -1; return; }
        int dev = 0, cus = 0, per_cu = 0;
        if (hipGetDevice(&dev) != hipSuccess || hipDeviceGetAttribute(&cus, hipDeviceAttributeMultiprocessorCount, dev) != hipSuccess) { grid = -1; return; }
        if (hipFuncSetAttribute((const void*)mega, hipFuncAttributeMaxDynamicSharedMemorySize, LDS_BYTES) != hipSuccess) { grid = -1; return; }
        if (hipOccupancyMaxActiveBlocksPerMultiprocessor(&per_cu, (const void*)mega, 512, LDS_BYTES) != hipSuccess || per_cu < 1) { fprintf(stderr, "kernel_launch: occupancy query says %d\n", per_cu); }
        (void)hipGetLastError();
        grid = cus;
    }
    if (grid < 0) return;
    (void)hipMemsetAsync((char*)d_ws + WS_CTL, 0, CTL_BYTES, stream);
    Args a{};
    for (int i = 0; i < 39; ++i) a.in[i] = (const float*)d_in[i];
    a.out = (float*)d_out; a.ws = (unsigned char*)d_ws;
    if (N_LAUNCH_MODE == 1) {
        a.lo = 0; a.hi = NPHASES;
        hipLaunchKernelGGL(mega, dim3(grid), dim3(512), LDS_BYTES, stream, a);
    } else {
        for (int ph = 0; ph < NPHASES; ++ph) {
            a.lo = ph; a.hi = ph + 1;
            hipLaunchKernelGGL(mega, dim3(grid), dim3(512), LDS_BYTES, stream, a);
        }
    }
}
```

```cpp
#include <hip/hip_runtime.h>
#include <cstdint>
#include <cstdio>

#define LAS __attribute__((address_space(3)))

constexpr int D = 1024, BATCH = 4, SEQ = 8192, T = BATCH * SEQ;
constexpr int RW = 512, NH = 8;
constexpr int RPROJ = 1792, NPROJ = 2304;
constexpr int S5NG = 32, S5P = 64;
constexpr int NE = 256, EFF = 256;
constexpr int NMODS = 6 * D;
constexpr int S5CL = 128, S5NC = SEQ / S5CL;

constexpr size_t MiB = 1u << 20;
constexpr size_t WS_CTL = 0, CTL_BYTES = 1 * MiB;
constexpr size_t WS_COUNTS = 64 * 1024;
constexpr size_t WS_MODS = 1 * MiB;
constexpr size_t WS_S5AB = 1 * MiB + 128 * 1024;
constexpr size_t WS_S5POW = 1 * MiB + 160 * 1024;
constexpr size_t WS_S5BB = 1 * MiB + 256 * 1024;
constexpr size_t WS_S5E = 2 * MiB;
constexpr size_t WS_S5X0 = 6 * MiB;
constexpr size_t WS_A = 16 * MiB;
constexpr size_t WS_PROJ = 144 * MiB;
constexpr size_t WS_RW = 432 * MiB;
constexpr size_t RWSZ = (size_t)T * RW * 4;
constexpr size_t WS_YEXP = 144 * MiB;
constexpr size_t WS_HID = 656 * MiB;
constexpr size_t WS_SHOUT = 784 * MiB;
constexpr size_t WS_YS5 = 944 * MiB;
constexpr size_t WS_HS = 944 * MiB;
constexpr size_t WS_LOGITS = 976 * MiB;
constexpr size_t WS_IDX = 1008 * MiB;
constexpr size_t WS_WT = 1009 * MiB;
constexpr size_t WS_SLOT = 1010 * MiB;
constexpr size_t WS_END = 1011 * MiB;

constexpr int LDS_BYTES = 132096;
constexpr int LDS_CTL_OFF = 131072;

#define XB_TMO      128
#define XB_XCNT(j)  (256  + 64 * (j))
#define XB_XSUB(j)  (1280 + 64 * (j))
#define XB_XGEN(j)  (2304 + 64 * (j))
#define XB_TOP      3328
#define XB_TOPGEN   3392
#define XCD_BAR_WORDS 3456
#define XB_SPIN_CAP (1u << 24)

__device__ __forceinline__ unsigned xb_ld(unsigned* p)              { return __hip_atomic_load(p, __ATOMIC_RELAXED, __HIP_MEMORY_SCOPE_AGENT); }
__device__ __forceinline__ unsigned xb_add(unsigned* p, unsigned v) { return __hip_atomic_fetch_add(p, v, __ATOMIC_RELAXED, __HIP_MEMORY_SCOPE_AGENT); }
__device__ __forceinline__ unsigned xb_xcc_id() { return (unsigned)__builtin_amdgcn_s_getreg((3 << 11) | 20) & 0xFu; }
#define XB_SPIN(cond, bar) do { unsigned _sp = 0; while (cond) { __builtin_amdgcn_s_sleep(1); \
    if ((++_sp & 255u) == 0u) { if (xb_ld(&(bar)[XB_TMO])) break; if (_sp > XB_SPIN_CAP) { atomicAdd(&(bar)[XB_TMO], 1u); break; } } } } while (0)

struct XcdBarrier { unsigned* bar; unsigned x; volatile LAS unsigned* st; };

__device__ __forceinline__ XcdBarrier xcd_barrier_post(unsigned* bar, volatile LAS unsigned* st) {
    XcdBarrier b; b.bar = bar; b.x = xb_xcc_id(); b.st = st;
    if (threadIdx.x == 0) (void)xb_add(&bar[XB_XCNT(b.x)], 1u);
    return b;
}
__device__ __forceinline__ void xcd_barrier_complete(unsigned* bar, unsigned x, unsigned& nloc, unsigned& nx) {
    const unsigned G = gridDim.x * gridDim.y * gridDim.z;
    unsigned sum, cnt, mine, sp = 0u;
    for (;;) {
        sum = 0u; cnt = 0u; mine = 0u;
#pragma unroll
        for (unsigned j = 0; j < 16; ++j) { const unsigned c = xb_ld(&bar[XB_XCNT(j)]); sum += c; cnt += (c > 0u) ? 1u : 0u; mine = (j == x) ? c : mine; }
        if (sum == G) break;
        __builtin_amdgcn_s_sleep(1);
        if ((++sp & 255u) == 0u) { if (xb_ld(&bar[XB_TMO])) break; if (sp > XB_SPIN_CAP) { atomicAdd(&bar[XB_TMO], 1u); break; } }
    }
    nloc = mine > 0u ? mine : 1u; nx = cnt > 0u ? cnt : 1u;
}
__device__ __forceinline__ void xcd_barrier(const XcdBarrier& b) {
    asm volatile("s_waitcnt vmcnt(0)" ::: "memory");
    __syncthreads();
    if (threadIdx.x == 0) {
        unsigned* bar = b.bar;
        __builtin_amdgcn_s_waitcnt(0);
        unsigned nloc = b.st[0], nx = b.st[1];
        if (nloc == 0u) { xcd_barrier_complete(bar, b.x, nloc, nx); b.st[0] = nloc; b.st[1] = nx; }
        const unsigned old = xb_add(&bar[XB_XSUB(b.x)], 1u);
        const unsigned gen = old / nloc;
        if (old + 1u == (gen + 1u) * nloc) {
            __builtin_amdgcn_fence(__ATOMIC_RELEASE, "agent");
            asm volatile("s_waitcnt vmcnt(0)" ::: "memory");
            const unsigned og = xb_add(&bar[XB_TOP], 1u);
            const unsigned tg = og / nx;
            if (og + 1u == (tg + 1u) * nx) xb_add(&bar[XB_TOPGEN], 1u);
            else XB_SPIN(xb_ld(&bar[XB_TOPGEN]) == tg, bar);
            __builtin_amdgcn_fence(__ATOMIC_ACQUIRE, "agent");
            xb_add(&bar[XB_XGEN(b.x)], 1u);
            asm volatile("s_waitcnt vmcnt(0)" ::: "memory");
        } else {
            XB_SPIN(xb_ld(&bar[XB_XGEN(b.x)]) == gen, bar);
            __builtin_amdgcn_fence(__ATOMIC_ACQUIRE, "agent");
            asm volatile("s_waitcnt vmcnt(0)" ::: "memory");
        }
    }
    __syncthreads();
}

typedef unsigned short bf16_t;
__device__ __forceinline__ unsigned f2bf(float f) { unsigned u = __builtin_bit_cast(unsigned, f); return (u + 0x7fffu + ((u >> 16) & 1u)) >> 16; }
__device__ __forceinline__ float bf2f(unsigned h) { return __builtin_bit_cast(float, h << 16); }
__device__ __forceinline__ float wave_sum(float v) {
#pragma unroll
    for (int o = 1; o < 64; o <<= 1) v += __shfl_xor(v, o);
    return v;
}
__device__ __forceinline__ float sigmoidf_(float x) { return 1.0f / (1.0f + expf(-x)); }
__device__ __forceinline__ float siluf_(float x) { return x / (1.0f + expf(-x)); }
__device__ __forceinline__ float softplusf_(float x) { return fmaxf(x, 0.0f) + log1pf(expf(-fabsf(x))); }
__device__ __forceinline__ float geluf_(float x) { const float u = 0.7978845608028654f * (x + 0.044715f * x * x * x); return 0.5f * x * (1.0f + tanhf(u)); }

struct Args { const float* in[39]; float* out; unsigned char* ws; int lo, hi; };

struct Ctx {
    const float* const* in; float* out; unsigned char* ws;
    LAS unsigned char* lds; float* sm;
    int tid, lane, wid, bid, G;
};

template <int NB, class AF, class BF, class BF2, class EF>
__device__ __forceinline__ void gemm_tile(float* sm, int K, AF af, BF bf, BF2 bf2, EF ef) {
    float* As = sm;
    float* Bs = sm + 16 * 132;
    float* Bs2 = Bs + 16 * 68;
    const int tid = threadIdx.x, ty = tid >> 4, tx = tid & 15;
    const int am = tid >> 2, ak = (tid & 3) * 4;
    const int bt = tid & 255, bk = bt >> 4, bn = (bt & 15) * 4;
    float acc[4][4], acc2[4][4];
#pragma unroll
    for (int i = 0; i < 4; ++i)
#pragma unroll
        for (int j = 0; j < 4; ++j) { acc[i][j] = 0.f; acc2[i][j] = 0.f; }
    float4 av = af(am, ak);
    float4 bv = make_float4(0.f, 0.f, 0.f, 0.f);
    if (tid < 256) bv = bf(bk, bn); else if (NB == 2) bv = bf2(bk, bn);
    for (int k0 = 0; k0 < K; k0 += 16) {
        __syncthreads();
        As[(ak + 0) * 132 + am] = av.x; As[(ak + 1) * 132 + am] = av.y; As[(ak + 2) * 132 + am] = av.z; As[(ak + 3) * 132 + am] = av.w;
        if (tid < 256) *(float4*)&Bs[bk * 68 + bn] = bv; else if (NB == 2) *(float4*)&Bs2[bk * 68 + bn] = bv;
        __syncthreads();
        if (k0 + 16 < K) {
            av = af(am, k0 + 16 + ak);
            if (tid < 256) bv = bf(k0 + 16 + bk, bn); else if (NB == 2) bv = bf2(k0 + 16 + bk, bn);
        }
#pragma unroll
        for (int kk = 0; kk < 16; ++kk) {
            const float4 a = *(const float4*)&As[kk * 132 + ty * 4];
            const float4 b = *(const float4*)&Bs[kk * 68 + tx * 4];
            const float aa[4] = {a.x, a.y, a.z, a.w};
            const float bb[4] = {b.x, b.y, b.z, b.w};
#pragma unroll
            for (int i = 0; i < 4; ++i)
#pragma unroll
                for (int j = 0; j < 4; ++j) acc[i][j] = fmaf(aa[i], bb[j], acc[i][j]);
            if (NB == 2) {
                const float4 b2 = *(const float4*)&Bs2[kk * 68 + tx * 4];
                const float bb2[4] = {b2.x, b2.y, b2.z, b2.w};
#pragma unroll
                for (int i = 0; i < 4; ++i)
#pragma unroll
                    for (int j = 0; j < 4; ++j) acc2[i][j] = fmaf(aa[i], bb2[j], acc2[i][j]);
            }
        }
    }
#pragma unroll
    for (int i = 0; i < 4; ++i)
        ef(ty * 4 + i, tx * 4, make_float4(acc[i][0], acc[i][1], acc[i][2], acc[i][3]), make_float4(acc2[i][0], acc2[i][1], acc2[i][2], acc2[i][3]));
}

__device__ __forceinline__ void phase0(const Ctx& c) {
    const float* cc = c.in[1]; const float* w_ada = c.in[2]; const float* b_ada = c.in[3];
    float* mods = (float*)(c.ws + WS_MODS);
    const int gt = c.bid * 512 + c.tid, NT = c.G * 512;
    for (int idx = gt; idx < BATCH * NMODS; idx += NT) {
        const int b = idx / NMODS, j = idx % NMODS;
        float acc = 0.f;
        for (int k = 0; k < D; ++k) acc = fmaf(siluf_(cc[b * D + k]), w_ada[(size_t)k * NMODS + j], acc);
        mods[idx] = acc + b_ada[j];
    }
    const float* log_dt = c.in[20]; const float* a_re = c.in[21]; const float* a_im = c.in[22];
    const float* b_re = c.in[23]; const float* b_im = c.in[24];
    float* ab = (float*)(c.ws + WS_S5AB); float* apow = (float*)(c.ws + WS_S5POW); float* bb = (float*)(c.ws + WS_S5BB);
    for (int idx = gt; idx < S5NG * S5P; idx += NT) {
        const int g = idx / S5P;
        const double dt = exp((double)log_dt[g]);
        const double lre = fmin((double)a_re[idx], -1e-4), lim = (double)a_im[idx];
        const double mag = exp(lre * dt), ang = lim * dt;
        const double abr = mag * cos(ang), abi = mag * sin(ang);
        const double den = lre * lre + lim * lim;
        const double nre = abr - 1.0, nim = abi;
        const double qre = (nre * lre + nim * lim) / den, qim = (nim * lre - nre * lim) / den;
        ab[idx * 2 + 0] = (float)abr; ab[idx * 2 + 1] = (float)abi;
        double pr = abr, pi = abi;
        for (int s = 0; s < 7; ++s) { const double nr = pr * pr - pi * pi, ni = 2.0 * pr * pi; pr = nr; pi = ni; }
        apow[idx * 2 + 0] = (float)pr; apow[idx * 2 + 1] = (float)pi;
        for (int ch = 0; ch < 16; ++ch) {
            const double br = (double)b_re[idx * 16 + ch], bi = (double)b_im[idx * 16 + ch];
            bb[idx * 32 + ch] = (float)(qre * br - qim * bi);
            bb[idx * 32 + 16 + ch] = (float)(qre * bi + qim * br);
        }
    }
}

__device__ __forceinline__ void phase1(const Ctx& c) {
    const float* x = c.in[0]; const float* g = c.in[4];
    const float* mods = (const float*)(c.ws + WS_MODS);
    float* xn = (float*)(c.ws + WS_A);
    const int gw = c.bid * 8 + c.wid, NW = c.G * 8;
    for (int t = gw; t < T; t += NW) {
        const int b = t / SEQ;
        const float4* xr = (const float4*)(x + (size_t)t * D) + c.lane;
        float4 v[4]; float ss = 0.f;
#pragma unroll
        for (int j = 0; j < 4; ++j) { v[j] = xr[64 * j]; ss += v[j].x * v[j].x + v[j].y * v[j].y + v[j].z * v[j].z + v[j].w * v[j].w; }
        const float rstd = rsqrtf(wave_sum(ss) * (1.0f / D) + 1e-6f);
        float4* o = (float4*)(xn + (size_t)t * D) + c.lane;
#pragma unroll
        for (int j = 0; j < 4; ++j) {
            const int k = (c.lane + 64 * j) * 4;
            const float4 gg = *(const float4*)(g + k);
            const float4 sh = *(const float4*)(mods + b * NMODS + k);
            const float4 sc = *(const float4*)(mods + b * NMODS + D + k);
            float4 r;
            r.x = v[j].x * rstd * gg.x * (1.f + sc.x) + sh.x; r.y = v[j].y * rstd * gg.y * (1.f + sc.y) + sh.y;
            r.z = v[j].z * rstd * gg.z * (1.f + sc.z) + sh.z; r.w = v[j].w * rstd * gg.w * (1.f + sc.w) + sh.w;
            o[64 * j] = r;
        }
    }
}

__device__ __forceinline__ void phase2(const Ctx& c) {
    const float* xn = (const float*)(c.ws + WS_A); const float* w = c.in[8];
    float* proj = (float*)(c.ws + WS_PROJ);
    constexpr int NT_ = NPROJ / 64, NITEMS = (T / 128) * NT_;
    for (int it = c.bid; it < NITEMS; it += c.G) {
        const int mt = it / NT_, nt = it % NT_;
        const float* A = xn + (size_t)mt * 128 * D; const float* B = w + nt * 64; float* C = proj + (size_t)mt * 128 * NPROJ + nt * 64;
        gemm_tile<1>(c.sm, D,
            [&](int m, int k) { return *(const float4*)(A + (size_t)m * D + k); },
            [&](int k, int n) { return *(const float4*)(B + (size_t)k * NPROJ + n); },
            [&](int k, int n) { return make_float4(0.f, 0.f, 0.f, 0.f); },
            [&](int m, int n, float4 a, float4) { *(float4*)(C + (size_t)m * NPROJ + n) = a; });
    }
}

__device__ __forceinline__ void phase3(const Ctx& c) {
    const float* proj = (const float*)(c.ws + WS_PROJ);
    const float* mu = c.in[9]; const float* w0 = c.in[10]; const float* w2 = c.in[11]; const float* a0 = c.in[12]; const float* a2 = c.in[13];
    const float* g2 = c.in[14]; const float* k_k = c.in[15]; const float* k_a = c.in[16];
    float* rw_r = (float*)(c.ws + WS_RW + 0 * RWSZ); float* rw_w = (float*)(c.ws + WS_RW + 1 * RWSZ); float* rw_k = (float*)(c.ws + WS_RW + 2 * RWSZ);
    float* rw_v = (float*)(c.ws + WS_RW + 3 * RWSZ); float* rw_a = (float*)(c.ws + WS_RW + 4 * RWSZ); float* rw_b = (float*)(c.ws + WS_RW + 5 * RWSZ);
    float* rw_g = (float*)(c.ws + WS_RW + 6 * RWSZ);
    float* lo = c.sm;
    const int n = c.tid;
    for (int it = c.bid; it < T / 8; it += c.G) {
        const int t0 = it * 8;
        __syncthreads();
        if (n < 256) {
            const int col = 1536 + n; const float m_ = mu[col];
#pragma unroll
            for (int tk = 0; tk < 8; ++tk) {
                const int t = t0 + tk;
                const float p = proj[(size_t)t * NPROJ + col];
                const float pv = (t % SEQ == 0) ? 0.f : proj[(size_t)(t - 1) * NPROJ + col];
                const float ps = p + (pv - p) * m_;
                float v = ps;
                if (n < 64) v = tanhf(ps); else if (n >= 128) v = sigmoidf_(ps);
                lo[tk * 256 + n] = v;
            }
        }
        __syncthreads();
        float wl[8], al[8], gl[8];
#pragma unroll
        for (int tk = 0; tk < 8; ++tk) { wl[tk] = 0.f; al[tk] = 0.f; gl[tk] = 0.f; }
        for (int j = 0; j < 64; ++j) {
            const float wv = w2[j * RW + n], av = a2[j * RW + n];
#pragma unroll
            for (int tk = 0; tk < 8; ++tk) { wl[tk] = fmaf(lo[tk * 256 + j], wv, wl[tk]); al[tk] = fmaf(lo[tk * 256 + 64 + j], av, al[tk]); }
        }
        for (int j = 0; j < 128; ++j) {
            const float gv = g2[j * RW + n];
#pragma unroll
            for (int tk = 0; tk < 8; ++tk) gl[tk] = fmaf(lo[tk * 256 + 128 + j], gv, gl[tk]);
        }
        const float mur = mu[n], muk = mu[512 + n], muv = mu[1024 + n];
        const float w0n = w0[n], a0n = a0[n], kkn = k_k[n], kan = k_a[n];
#pragma unroll
        for (int tk = 0; tk < 8; ++tk) {
            const int t = t0 + tk; const bool first = (t % SEQ == 0);
            const float* pr = proj + (size_t)t * NPROJ; const float* pp = proj + (size_t)(first ? t : t - 1) * NPROJ;
            float r = pr[n], k = pr[512 + n], v = pr[1024 + n];
            const float r1 = first ? 0.f : pp[n], k1 = first ? 0.f : pp[512 + n], v1 = first ? 0.f : pp[1024 + n];
            r = r + (r1 - r) * mur; k = k + (k1 - k) * muk; v = v + (v1 - v) * muv;
            const float wa = w0n + wl[tk];
            const float logw = -softplusf_(-wa) - 0.5f;
            const float decay = expf(-expf(logw));
            const float iclr = sigmoidf_(a0n + al[tk]);
            float kk = k * kkn;
            const float ss = wave_sum(kk * kk);
            kk = kk / fmaxf(sqrtf(ss), 1e-12f);
            const float kf = k * (1.f + (iclr - 1.f) * kan);
            const size_t o = (size_t)t * RW + n;
            rw_r[o] = r; rw_w[o] = decay; rw_k[o] = kf; rw_v[o] = v; rw_a[o] = -kk; rw_b[o] = kk * iclr; rw_g[o] = gl[tk];
        }
    }
    const float* ab = (const float*)(c.ws + WS_S5AB); const float* bbp = (const float*)(c.ws + WS_S5BB);
    float* E = (float*)(c.ws + WS_S5E);
    const int gw = c.bid * 8 + c.wid, NW = c.G * 8;
    for (int it = gw; it < BATCH * S5NG * S5NC; it += NW) {
        const int ch = it % S5NC, g = (it / S5NC) % S5NG, b = it / (S5NC * S5NG);
        const int p = c.lane;
        float bbr[16], bbi[16];
#pragma unroll
        for (int q = 0; q < 4; ++q) {
            const float4 v1 = *(const float4*)(bbp + (size_t)(g * 64 + p) * 32 + q * 4), v2 = *(const float4*)(bbp + (size_t)(g * 64 + p) * 32 + 16 + q * 4);
            bbr[q * 4 + 0] = v1.x; bbr[q * 4 + 1] = v1.y; bbr[q * 4 + 2] = v1.z; bbr[q * 4 + 3] = v1.w;
            bbi[q * 4 + 0] = v2.x; bbi[q * 4 + 1] = v2.y; bbi[q * 4 + 2] = v2.z; bbi[q * 4 + 3] = v2.w;
        }
        const float ar = ab[(g * 64 + p) * 2], ai = ab[(g * 64 + p) * 2 + 1];
        float xr = 0.f, xi = 0.f;
        const float* up = proj + (size_t)(b * SEQ + ch * S5CL) * NPROJ + RPROJ + g * 16;
        for (int s = 0; s < S5CL; ++s) {
            const float4 u0 = *(const float4*)(up + (size_t)s * NPROJ), u1 = *(const float4*)(up + (size_t)s * NPROJ + 4), u2 = *(const float4*)(up + (size_t)s * NPROJ + 8), u3 = *(const float4*)(up + (size_t)s * NPROJ + 12);
            const float u[16] = {u0.x, u0.y, u0.z, u0.w, u1.x, u1.y, u1.z, u1.w, u2.x, u2.y, u2.z, u2.w, u3.x, u3.y, u3.z, u3.w};
            float br = 0.f, bi = 0.f;
#pragma unroll
            for (int q = 0; q < 16; ++q) { br = fmaf(bbr[q], u[q], br); bi = fmaf(bbi[q], u[q], bi); }
            const float nr = ar * xr - ai * xi + br, ni = ar * xi + ai * xr + bi;
            xr = nr; xi = ni;
        }
        *(float2*)(E + (size_t)it * 128 + p * 2) = make_float2(xr, xi);
    }
}

__device__ __forceinline__ void phase4(const Ctx& c) {
    const float* __restrict__ rw_r = (const float*)(c.ws + WS_RW + 0 * RWSZ); const float* __restrict__ rw_w = (const float*)(c.ws + WS_RW + 1 * RWSZ);
    const float* __restrict__ rw_k = (const float*)(c.ws + WS_RW + 2 * RWSZ); const float* __restrict__ rw_v = (const float*)(c.ws + WS_RW + 3 * RWSZ);
    const float* __restrict__ rw_a = (const float*)(c.ws + WS_RW + 4 * RWSZ); const float* __restrict__ rw_b = (const float*)(c.ws + WS_RW + 5 * RWSZ);
    float* __restrict__ rw_y = (float*)(c.ws + WS_RW + 7 * RWSZ);
    for (int task = c.wid * c.G + c.bid; task < 512 + BATCH * S5NG; task += c.G * 8) {
        if (task < 512) {
            const int bh = task >> 4, rg = task & 15, b = bh >> 3, h = bh & 7;
            const int row = rg * 4 + (c.lane >> 4), kq = c.lane & 15;
            const size_t base = (size_t)(b * SEQ) * RW + h * 64;
            const float* W = rw_w + base + kq * 4; const float* A = rw_a + base + kq * 4; const float* Bv = rw_b + base + kq * 4;
            const float* Kf = rw_k + base + kq * 4; const float* R = rw_r + base + kq * 4; const float* V = rw_v + base + row; float* Y = rw_y + base + row;
            float S0 = 0.f, S1 = 0.f, S2 = 0.f, S3 = 0.f;
#pragma unroll 4
            for (int t = 0; t < SEQ; ++t) {
                const size_t o = (size_t)t * RW;
                const float4 w = *(const float4*)(W + o), a = *(const float4*)(A + o), bb = *(const float4*)(Bv + o), k = *(const float4*)(Kf + o), r = *(const float4*)(R + o);
                const float v = V[o];
                float sa = S0 * a.x + S1 * a.y + S2 * a.z + S3 * a.w;
                sa += __shfl_xor(sa, 1); sa += __shfl_xor(sa, 2); sa += __shfl_xor(sa, 4); sa += __shfl_xor(sa, 8);
                S0 = S0 * w.x + sa * bb.x + v * k.x; S1 = S1 * w.y + sa * bb.y + v * k.y;
                S2 = S2 * w.z + sa * bb.z + v * k.z; S3 = S3 * w.w + sa * bb.w + v * k.w;
                float y = S0 * r.x + S1 * r.y + S2 * r.z + S3 * r.w;
                y += __shfl_xor(y, 1); y += __shfl_xor(y, 2); y += __shfl_xor(y, 4); y += __shfl_xor(y, 8);
                if (kq == 0) Y[o] = y;
            }
        } else {
            const int bg = task - 512, g = bg % S5NG, p = c.lane;
            const float* apow = (const float*)(c.ws + WS_S5POW);
            const float* E = (const float*)(c.ws + WS_S5E); float* X0 = (float*)(c.ws + WS_S5X0);
            const float pr = apow[(g * 64 + p) * 2], pi = apow[(g * 64 + p) * 2 + 1];
            float xr = 0.f, xi = 0.f;
            for (int ch = 0; ch < S5NC; ++ch) {
                const size_t o = ((size_t)bg * S5NC + ch) * 128 + p * 2;
                *(float2*)(X0 + o) = make_float2(xr, xi);
                const float2 e = *(const float2*)(E + o);
                const float nr = pr * xr - pi * xi + e.x, ni = pr * xi + pi * xr + e.y;
                xr = nr; xi = ni;
            }
        }
    }
}

__device__ __forceinline__ void phase5(const Ctx& c) {
    const float* rw_r = (const float*)(c.ws + WS_RW + 0 * RWSZ); const float* rw_k = (const float*)(c.ws + WS_RW + 2 * RWSZ);
    const float* rw_v = (const float*)(c.ws + WS_RW + 3 * RWSZ); const float* rw_g = (const float*)(c.ws + WS_RW + 6 * RWSZ);
    const float* rw_y = (const float*)(c.ws + WS_RW + 7 * RWSZ);
    const float* r_k = c.in[17]; const float* ln_w = c.in[18]; const float* ln_b = c.in[19];
    float* ycat = (float*)(c.ws + WS_A);
    const int gw = c.bid * 8 + c.wid, NW = c.G * 8;
    for (int it = gw; it < T * NH; it += NW) {
        const int t = it >> 3, h = it & 7, hn = h * 64 + c.lane;
        const size_t o = (size_t)t * RW + hn;
        const float y = rw_y[o];
        const float mean = wave_sum(y) * (1.f / 64.f);
        const float d = y - mean;
        const float var = wave_sum(d * d) * (1.f / 64.f);
        const float yn = d * rsqrtf(var + 64e-5f) * ln_w[hn] + ln_b[hn];
        const float v = rw_v[o];
        const float bonus = wave_sum(rw_r[o] * rw_k[o] * r_k[hn]) * v;
        ycat[(size_t)t * D + hn] = (yn + bonus) * rw_g[o];
    }
    const float* proj = (const float*)(c.ws + WS_PROJ);
    const float* ab = (const float*)(c.ws + WS_S5AB); const float* bbp = (const float*)(c.ws + WS_S5BB); const float* X0 = (const float*)(c.ws + WS_S5X0);
    const float* c_re = c.in[25]; const float* c_im = c.in[26]; const float* dd = c.in[27];
    float* ys5 = (float*)(c.ws + WS_YS5);
    float* Cm = c.sm + c.wid * (16 * 132 + 4 * 128);
    float* Xs = Cm + 16 * 132;
    for (int it = gw; it < BATCH * S5NG * S5NC; it += NW) {
        const int ch = it % S5NC, g = (it / S5NC) % S5NG, b = it / (S5NC * S5NG);
        const int p = c.lane;
#pragma unroll
        for (int cc = 0; cc < 16; ++cc) { Cm[cc * 132 + p] = c_re[(g * 16 + cc) * 64 + p]; Cm[cc * 132 + 64 + p] = -c_im[(g * 16 + cc) * 64 + p]; }
        float bbr[16], bbi[16];
#pragma unroll
        for (int q = 0; q < 4; ++q) {
            const float4 v1 = *(const float4*)(bbp + (size_t)(g * 64 + p) * 32 + q * 4), v2 = *(const float4*)(bbp + (size_t)(g * 64 + p) * 32 + 16 + q * 4);
            bbr[q * 4 + 0] = v1.x; bbr[q * 4 + 1] = v1.y; bbr[q * 4 + 2] = v1.z; bbr[q * 4 + 3] = v1.w;
            bbi[q * 4 + 0] = v2.x; bbi[q * 4 + 1] = v2.y; bbi[q * 4 + 2] = v2.z; bbi[q * 4 + 3] = v2.w;
        }
        const float ar = ab[(g * 64 + p) * 2], ai = ab[(g * 64 + p) * 2 + 1];
        const float2 x0 = *(const float2*)(X0 + (size_t)it * 128 + p * 2);
        float xr = x0.x, xi = x0.y;
        const int tb = b * SEQ + ch * S5CL;
        const float* up = proj + (size_t)tb * NPROJ + RPROJ + g * 16;
        const int cc = c.lane & 15, tq = c.lane >> 4;
        const float dv = dd[g * 16 + cc];
        for (int s0 = 0; s0 < S5CL; s0 += 4) {
#pragma unroll
            for (int s1 = 0; s1 < 4; ++s1) {
                const int s = s0 + s1;
                const float4 u0 = *(const float4*)(up + (size_t)s * NPROJ), u1 = *(const float4*)(up + (size_t)s * NPROJ + 4), u2 = *(const float4*)(up + (size_t)s * NPROJ + 8), u3 = *(const float4*)(up + (size_t)s * NPROJ + 12);
                const float u[16] = {u0.x, u0.y, u0.z, u0.w, u1.x, u1.y, u1.z, u1.w, u2.x, u2.y, u2.z, u2.w, u3.x, u3.y, u3.z, u3.w};
                float br = 0.f, bi = 0.f;
#pragma unroll
                for (int q = 0; q < 16; ++q) { br = fmaf(bbr[q], u[q], br); bi = fmaf(bbi[q], u[q], bi); }
                const float nr = ar * xr - ai * xi + br, ni = ar * xi + ai * xr + bi;
                xr = nr; xi = ni;
                Xs[s1 * 128 + p] = xr; Xs[s1 * 128 + 64 + p] = xi;
            }
            __builtin_amdgcn_wave_barrier();
            asm volatile("s_waitcnt lgkmcnt(0)" ::: "memory");
            float y = 0.f;
#pragma unroll 8
            for (int q = 0; q < 128; q += 4) {
                const float4 cv = *(const float4*)&Cm[cc * 132 + q];
                const float4 xv = *(const float4*)&Xs[tq * 128 + q];
                y = fmaf(cv.x, xv.x, y); y = fmaf(cv.y, xv.y, y); y = fmaf(cv.z, xv.z, y); y = fmaf(cv.w, xv.w, y);
            }
            const int t = tb + s0 + tq;
            const float uu = proj[(size_t)t * NPROJ + RPROJ + g * 16 + cc];
            ys5[(size_t)t * 512 + g * 16 + cc] = geluf_(y + dv * uu);
            __builtin_amdgcn_wave_barrier();
            asm volatile("s_waitcnt lgkmcnt(0)" ::: "memory");
        }
    }
}

__device__ __forceinline__ void phase6(const Ctx& c) {
    const float* ys5 = (const float*)(c.ws + WS_YS5); const float* w = c.in[28]; const float* bg = c.in[29];
    float* ycat = (float*)(c.ws + WS_A);
    constexpr int NT_ = 512 / 64, NITEMS = (T / 128) * NT_;
    for (int it = c.bid; it < NITEMS; it += c.G) {
        const int mt = it / NT_, nt = it % NT_;
        const float* A = ys5 + (size_t)mt * 128 * 512; const float* B = w + nt * 64;
        gemm_tile<1>(c.sm, 512,
            [&](int m, int k) { return *(const float4*)(A + (size_t)m * 512 + k); },
            [&](int k, int n) { return *(const float4*)(B + (size_t)k * 512 + n); },
            [&](int k, int n) { return make_float4(0.f, 0.f, 0.f, 0.f); },
            [&](int m, int n, float4 a, float4) {
                const float4 yv = *(const float4*)(A + (size_t)m * 512 + nt * 64 + n);
                const float4 bv = *(const float4*)(bg + nt * 64 + n);
                float4 o; o.x = yv.x * sigmoidf_(a.x + bv.x); o.y = yv.y * sigmoidf_(a.y + bv.y); o.z = yv.z * sigmoidf_(a.z + bv.z); o.w = yv.w * sigmoidf_(a.w + bv.w);
                *(float4*)(ycat + (size_t)(mt * 128 + m) * D + 512 + nt * 64 + n) = o; });
    }
}

__device__ __forceinline__ void phase7(const Ctx& c) {
    const float* ycat = (const float*)(c.ws + WS_A); const float* w = c.in[30];
    float* mixed = (float*)(c.ws + WS_PROJ);
    constexpr int NT_ = D / 64, NITEMS = (T / 128) * NT_;
    for (int it = c.bid; it < NITEMS; it += c.G) {
        const int mt = it / NT_, nt = it % NT_;
        const float* A = ycat + (size_t)mt * 128 * D; const float* B = w + nt * 64; float* C = mixed + (size_t)mt * 128 * D + nt * 64;
        gemm_tile<1>(c.sm, D,
            [&](int m, int k) { return *(const float4*)(A + (size_t)m * D + k); },
            [&](int k, int n) { return *(const float4*)(B + (size_t)k * D + n); },
            [&](int k, int n) { return make_float4(0.f, 0.f, 0.f, 0.f); },
            [&](int m, int n, float4 a, float4) { *(float4*)(C + (size_t)m * D + n) = a; });
    }
}

__device__ __forceinline__ void phase8(const Ctx& c) {
    const float* x = c.in[0]; const float* gpm = c.in[5]; const float* gpf = c.in[6];
    const float* mods = (const float*)(c.ws + WS_MODS); const float* mixed = (const float*)(c.ws + WS_PROJ);
    float* h2 = (float*)(c.ws + WS_A); float* x1o = c.out;
    const int gw = c.bid * 8 + c.wid, NW = c.G * 8;
    for (int t = gw; t < T; t += NW) {
        const int b = t / SEQ;
        const float4* mr = (const float4*)(mixed + (size_t)t * D) + c.lane;
        const float4* xr = (const float4*)(x + (size_t)t * D) + c.lane;
        float4 m[4], v[4]; float ss = 0.f;
#pragma unroll
        for (int j = 0; j < 4; ++j) { m[j] = mr[64 * j]; v[j] = xr[64 * j]; ss += m[j].x * m[j].x + m[j].y * m[j].y + m[j].z * m[j].z + m[j].w * m[j].w; }
        const float rstd = rsqrtf(wave_sum(ss) * (1.0f / D) + 1e-6f);
        float s1 = 0.f;
#pragma unroll
        for (int j = 0; j < 4; ++j) {
            const int k = (c.lane + 64 * j) * 4;
            const float4 gg = *(const float4*)(gpm + k);
            const float4 gt = *(const float4*)(mods + b * NMODS + 2 * D + k);
            v[j].x += gt.x * (m[j].x * rstd * gg.x); v[j].y += gt.y * (m[j].y * rstd * gg.y);
            v[j].z += gt.z * (m[j].z * rstd * gg.z); v[j].w += gt.w * (m[j].w * rstd * gg.w);
            s1 += v[j].x * v[j].x + v[j].y * v[j].y + v[j].z * v[j].z + v[j].w * v[j].w;
            ((float4*)(x1o + (size_t)t * D) + c.lane)[64 * j] = v[j];
        }
        const float rstd1 = rsqrtf(wave_sum(s1) * (1.0f / D) + 1e-6f);
#pragma unroll
        for (int j = 0; j < 4; ++j) {
            const int k = (c.lane + 64 * j) * 4;
            const float4 gg = *(const float4*)(gpf + k);
            const float4 sh = *(const float4*)(mods + b * NMODS + 3 * D + k);
            const float4 sc = *(const float4*)(mods + b * NMODS + 4 * D + k);
            float4 r;
            r.x = v[j].x * rstd1 * gg.x * (1.f + sc.x) + sh.x; r.y = v[j].y * rstd1 * gg.y * (1.f + sc.y) + sh.y;
            r.z = v[j].z * rstd1 * gg.z * (1.f + sc.z) + sh.z; r.w = v[j].w * rstd1 * gg.w * (1.f + sc.w) + sh.w;
            ((float4*)(h2 + (size_t)t * D) + c.lane)[64 * j] = r;
        }
    }
}

__device__ __forceinline__ void phase9(const Ctx& c) {
    const float* h2 = (const float*)(c.ws + WS_A); const float* wr = c.in[31]; const float* wg = c.in[36]; const float* wu = c.in[37];
    float* logits = (float*)(c.ws + WS_LOGITS); float* hs = (float*)(c.ws + WS_HS);
    constexpr int NT_ = 256 / 64, NI1 = (T / 128) * NT_;
    for (int it = c.bid; it < 2 * NI1; it += c.G) {
        const int which = it / NI1, r = it % NI1, mt = r / NT_, nt = r % NT_;
        const float* A = h2 + (size_t)mt * 128 * D;
        if (which == 0) {
            const float* B = wr + nt * 64; float* C = logits + (size_t)mt * 128 * 256 + nt * 64;
            gemm_tile<1>(c.sm, D,
                [&](int m, int k) { return *(const float4*)(A + (size_t)m * D + k); },
                [&](int k, int n) { return *(const float4*)(B + (size_t)k * 256 + n); },
                [&](int k, int n) { return make_float4(0.f, 0.f, 0.f, 0.f); },
                [&](int m, int n, float4 a, float4) { *(float4*)(C + (size_t)m * 256 + n) = a; });
        } else {
            const float* B = wg + nt * 64; const float* B2 = wu + nt * 64; float* C = hs + (size_t)mt * 128 * 256 + nt * 64;
            gemm_tile<2>(c.sm, D,
                [&](int m, int k) { return *(const float4*)(A + (size_t)m * D + k); },
                [&](int k, int n) { return *(const float4*)(B + (size_t)k * 256 + n); },
                [&](int k, int n) { return *(const float4*)(B2 + (size_t)k * 256 + n); },
                [&](int m, int n, float4 a, float4 u) {
                    float4 o; o.x = siluf_(a.x) * u.x; o.y = siluf_(a.y) * u.y; o.z = siluf_(a.z) * u.z; o.w = siluf_(a.w) * u.w;
                    *(float4*)(C + (size_t)m * 256 + n) = o; });
        }
    }
}

__device__ __forceinline__ void phase10(const Ctx& c) {
    const float* logits = (const float*)(c.ws + WS_LOGITS); const float* rb = c.in[32];
    int* idx = (int*)(c.ws + WS_IDX); float* wt = (float*)(c.ws + WS_WT); unsigned* counts = (unsigned*)(c.ws + WS_COUNTS);
    const int gw = c.bid * 8 + c.wid, NW = c.G * 8, l = c.lane;
    const float4 bias = *(const float4*)(rb + l * 4);
    for (int t = gw; t < T; t += NW) {
        const float4 lg = *(const float4*)(logits + (size_t)t * 256 + l * 4);
        float s[4] = {sigmoidf_(lg.x), sigmoidf_(lg.y), sigmoidf_(lg.z), sigmoidf_(lg.w)};
        float ch[4] = {s[0] + bias.x, s[1] + bias.y, s[2] + bias.z, s[3] + bias.w};
        float a1 = fmaxf(ch[0], ch[1]), a2 = fminf(ch[0], ch[1]);
        { const float b1 = fmaxf(ch[2], ch[3]), b2 = fminf(ch[2], ch[3]); const float n1 = fmaxf(a1, b1), n2 = fmaxf(fminf(a1, b1), fmaxf(a2, b2)); a1 = n1; a2 = n2; }
#pragma unroll
        for (int o = 1; o < 8; o <<= 1) { const float b1 = __shfl_xor(a1, o), b2 = __shfl_xor(a2, o); const float n1 = fmaxf(a1, b1), n2 = fmaxf(fminf(a1, b1), fmaxf(a2, b2)); a1 = n1; a2 = n2; }
        const float gs = a1 + a2; const int myg = l >> 3;
        int rank = 0;
#pragma unroll
        for (int g = 0; g < 8; ++g) { const float og = __shfl(gs, g * 8); rank += (og > gs || (og == gs && g < myg)) ? 1 : 0; }
        const bool sel = rank < 4;
        float mc[4];
#pragma unroll
        for (int i = 0; i < 4; ++i) mc[i] = sel ? ch[i] : -INFINITY;
        float sk[8]; int ek[8]; float ssum = 0.f;
#pragma unroll
        for (int k = 0; k < 8; ++k) {
            float bv = mc[0]; int be = l * 4;
#pragma unroll
            for (int i = 1; i < 4; ++i) if (mc[i] > bv) { bv = mc[i]; be = l * 4 + i; }
#pragma unroll
            for (int o = 1; o < 64; o <<= 1) { const float ov = __shfl_xor(bv, o); const int oe = __shfl_xor(be, o); if (ov > bv || (ov == bv && oe < be)) { bv = ov; be = oe; } }
            const int ii = be & 3;
            float sv = s[0]; sv = (ii == 1) ? s[1] : sv; sv = (ii == 2) ? s[2] : sv; sv = (ii == 3) ? s[3] : sv;
            sv = __shfl(sv, be >> 2);
            if ((be >> 2) == l) {
#pragma unroll
                for (int i = 0; i < 4; ++i) if (i == ii) mc[i] = -INFINITY;
            }
            sk[k] = sv; ek[k] = be; ssum += sv;
        }
        if (l == 0) {
            const float inv = 2.5f / ssum;
#pragma unroll
            for (int k = 0; k < 8; ++k) { idx[t * 8 + k] = ek[k]; wt[t * 8 + k] = sk[k] * inv; atomicAdd(&counts[ek[k]], 1u); }
        }
    }
}

__device__ __forceinline__ void build_offsets(const Ctx& c, int* smi) {
    const unsigned* counts = (const unsigned*)(c.ws + WS_COUNTS);
    __syncthreads();
    if (c.tid == 0) {
        int o = 0, tl = 0;
        for (int e = 0; e < NE; ++e) { const int cn = (int)counts[e]; smi[e] = o; smi[260 + e] = tl; o += cn; tl += (cn + 127) >> 7; }
        smi[NE] = o; smi[260 + NE] = tl;
    }
    __syncthreads();
}

__device__ __forceinline__ void phase11(const Ctx& c) {
    int* smi = (int*)c.sm + 8192;
    build_offsets(c, smi);
    const int* idx = (const int*)(c.ws + WS_IDX); int* slot = (int*)(c.ws + WS_SLOT); unsigned* cursor = (unsigned*)(c.ws + WS_COUNTS) + 256;
    const int gt = c.bid * 512 + c.tid, NT = c.G * 512;
    for (int a = gt; a < T * 8; a += NT) {
        const int e = idx[a];
        const unsigned pos = atomicAdd(&cursor[e], 1u);
        slot[smi[e] + (int)pos] = a;
    }
}

__device__ __forceinline__ void phase12(const Ctx& c) {
    int* smi = (int*)c.sm + 8192;
    build_offsets(c, smi);
    const float* h2 = (const float*)(c.ws + WS_A); const float* wg = c.in[33]; const float* wu = c.in[34];
    const int* slot = (const int*)(c.ws + WS_SLOT); bf16_t* hid = (bf16_t*)(c.ws + WS_HID);
    const int ntiles = smi[260 + NE];
    for (int it = c.bid; it < ntiles * 4; it += c.G) {
        const int tile = it >> 2, nt = it & 3;
        int lo = 0, hi = NE;
        while (hi - lo > 1) { const int mid = (lo + hi) >> 1; if (smi[260 + mid] <= tile) lo = mid; else hi = mid; }
        const int e = lo, s0 = smi[e] + (tile - smi[260 + e]) * 128, send = smi[e + 1];
        const int am = c.tid >> 2;
        const float* arow = (s0 + am < send) ? h2 + (size_t)(slot[s0 + am] >> 3) * D : nullptr;
        const float* B = wg + (size_t)e * D * EFF + nt * 64; const float* B2 = wu + (size_t)e * D * EFF + nt * 64;
        gemm_tile<2>(c.sm, D,
            [&](int m, int k) { return arow ? *(const float4*)(arow + k) : make_float4(0.f, 0.f, 0.f, 0.f); },
            [&](int k, int n) { return *(const float4*)(B + (size_t)k * EFF + n); },
            [&](int k, int n) { return *(const float4*)(B2 + (size_t)k * EFF + n); },
            [&](int m, int n, float4 a, float4 u) {
                if (s0 + m < send) {
                    uint2 o; o.x = f2bf(siluf_(a.x) * u.x) | (f2bf(siluf_(a.y) * u.y) << 16); o.y = f2bf(siluf_(a.z) * u.z) | (f2bf(siluf_(a.w) * u.w) << 16);
                    *(uint2*)(hid + (size_t)(s0 + m) * EFF + nt * 64 + n) = o; } });
    }
}

__device__ __forceinline__ void phase13(const Ctx& c) {
    int* smi = (int*)c.sm + 8192;
    build_offsets(c, smi);
    const float* wd = c.in[35]; const float* wsd = c.in[38];
    const int* slot = (const int*)(c.ws + WS_SLOT); const bf16_t* hid = (const bf16_t*)(c.ws + WS_HID);
    const float* wt = (const float*)(c.ws + WS_WT); bf16_t* yexp = (bf16_t*)(c.ws + WS_YEXP);
    const float* hs = (const float*)(c.ws + WS_HS); float* shout = (float*)(c.ws + WS_SHOUT);
    const int ntiles = smi[260 + NE];
    const int NI1 = ntiles * 16, NI2 = (T / 128) * 16;
    for (int it = c.bid; it < NI1 + NI2; it += c.G) {
        if (it < NI1) {
            const int tile = it >> 4, nt = it & 15;
            int lo = 0, hi = NE;
            while (hi - lo > 1) { const int mid = (lo + hi) >> 1; if (smi[260 + mid] <= tile) lo = mid; else hi = mid; }
            const int e = lo, s0 = smi[e] + (tile - smi[260 + e]) * 128, send = smi[e + 1];
            const int am = c.tid >> 2;
            const bf16_t* arow = (s0 + am < send) ? hid + (size_t)(s0 + am) * EFF : nullptr;
            const float* B = wd + (size_t)e * EFF * D + nt * 64;
            gemm_tile<1>(c.sm, EFF,
                [&](int m, int k) { if (!arow) return make_float4(0.f, 0.f, 0.f, 0.f); const uint2 v = *(const uint2*)(arow + k);
                                    return make_float4(bf2f(v.x & 0xffffu), bf2f(v.x >> 16), bf2f(v.y & 0xffffu), bf2f(v.y >> 16)); },
                [&](int k, int n) { return *(const float4*)(B + (size_t)k * D + n); },
                [&](int k, int n) { return make_float4(0.f, 0.f, 0.f, 0.f); },
                [&](int m, int n, float4 a, float4) {
                    if (s0 + m < send) {
                        const int aid = slot[s0 + m]; const float w = wt[aid];
                        uint2 o; o.x = f2bf(a.x * w) | (f2bf(a.y * w) << 16); o.y = f2bf(a.z * w) | (f2bf(a.w * w) << 16);
                        *(uint2*)(yexp + (size_t)aid * D + nt * 64 + n) = o; } });
        } else {
            const int r = it - NI1, mt = r >> 4, nt = r & 15;
            const float* A = hs + (size_t)mt * 128 * 256; const float* B = wsd + nt * 64; float* C = shout + (size_t)mt * 128 * D + nt * 64;
            gemm_tile<1>(c.sm, 256,
                [&](int m, int k) { return *(const float4*)(A + (size_t)m * 256 + k); },
                [&](int k, int n) { return *(const float4*)(B + (size_t)k * D + n); },
                [&](int k, int n) { return make_float4(0.f, 0.f, 0.f, 0.f); },
                [&](int m, int n, float4 a, float4) { *(float4*)(C + (size_t)m * D + n) = a; });
        }
    }
}

__device__ __forceinline__ void phase14(const Ctx& c) {
    const float* gq = c.in[7]; const float* mods = (const float*)(c.ws + WS_MODS);
    const float* shout = (const float*)(c.ws + WS_SHOUT); const bf16_t* yexp = (const bf16_t*)(c.ws + WS_YEXP);
    float* out = c.out;
    const int gw = c.bid * 8 + c.wid, NW = c.G * 8;
    for (int t = gw; t < T; t += NW) {
        const int b = t / SEQ;
        float4 y[4]; float ss = 0.f;
#pragma unroll
        for (int j = 0; j < 4; ++j) {
            const int k = (c.lane + 64 * j) * 4;
            float4 a = *(const float4*)(shout + (size_t)t * D + k);
#pragma unroll
            for (int q = 0; q < 8; ++q) {
                const uint2 v = *(const uint2*)(yexp + (size_t)(t * 8 + q) * D + k);
                a.x += bf2f(v.x & 0xffffu); a.y += bf2f(v.x >> 16); a.z += bf2f(v.y & 0xffffu); a.w += bf2f(v.y >> 16);
            }
            y[j] = a; ss += a.x * a.x + a.y * a.y + a.z * a.z + a.w * a.w;
        }
        const float rstd = rsqrtf(wave_sum(ss) * (1.0f / D) + 1e-6f);
#pragma unroll
        for (int j = 0; j < 4; ++j) {
            const int k = (c.lane + 64 * j) * 4;
            const float4 gg = *(const float4*)(gq + k);
            const float4 gt = *(const float4*)(mods + b * NMODS + 5 * D + k);
            float4 x1 = *(const float4*)(out + (size_t)t * D + k);
            x1.x += gt.x * (y[j].x * rstd * gg.x); x1.y += gt.y * (y[j].y * rstd * gg.y);
            x1.z += gt.z * (y[j].z * rstd * gg.z); x1.w += gt.w * (y[j].w * rstd * gg.w);
            *(float4*)(out + (size_t)t * D + k) = x1;
        }
    }
}

constexpr int NPHASES = 15;

__global__ void __launch_bounds__(512) mega(Args args) {
    extern __shared__ __attribute__((aligned(16))) unsigned char lds_raw[];
    Ctx c;
    c.in = args.in; c.out = args.out; c.ws = args.ws;
    c.lds = (LAS unsigned char*)lds_raw; c.sm = (float*)lds_raw;
    c.tid = threadIdx.x; c.lane = c.tid & 63; c.wid = __builtin_amdgcn_readfirstlane(c.tid >> 6); c.bid = blockIdx.x; c.G = gridDim.x;
    volatile LAS unsigned* st = (volatile LAS unsigned*)(c.lds + LDS_CTL_OFF);
    if (c.tid < 4) st[c.tid] = 0u;
    __syncthreads();
    XcdBarrier bar; bar.bar = (unsigned*)(args.ws + WS_CTL); bar.x = 0; bar.st = st;
    const bool multi = (args.hi - args.lo) > 1;
    if (multi) bar = xcd_barrier_post((unsigned*)(args.ws + WS_CTL), st);
    const int lo = args.lo, hi = args.hi;
#define RUN_PHASE(k, call) if (lo <= (k) && (k) < hi) { call; if ((k) + 1 < hi) xcd_barrier(bar); }
    RUN_PHASE(0, phase0(c))
    RUN_PHASE(1, phase1(c))
    RUN_PHASE(2, phase2(c))
    RUN_PHASE(3, phase3(c))
    RUN_PHASE(4, phase4(c))
    RUN_PHASE(5, phase5(c))
    RUN_PHASE(6, phase6(c))
    RUN_PHASE(7, phase7(c))
    RUN_PHASE(8, phase8(c))
    RUN_PHASE(9, phase9(c))
    RUN_PHASE(10, phase10(c))
    RUN_PHASE(11, phase11(c))
    RUN_PHASE(12, phase12(c))
    RUN_PHASE(13, phase13(c))
    RUN_PHASE(14, phase14(c))
#undef RUN_PHASE
}

#ifndef N_LAUNCH_MODE
#define N_LAUNCH_MODE 1
#endif

extern "C" void kernel_launch(void* const* d_in, const int* in_sizes, int n_in, void* d_out, int out_size, void* d_ws, size_t ws_size, hipStream_t stream) {
    static int grid = 0;
    if (grid == 0) {
        if (n_in != 39 || out_size != T * D || ws_size < WS_END) { fprintf(stderr, "kernel_launch: unexpected shapes n_in %d out %d ws %zu\n", n_in, out_size, ws_size); grid = -1; return; }
        int dev = 0, cus = 0, per_cu = 0;
        if (hipGetDevice(&dev) != hipSuccess || hipDeviceGetAttribute(&cus, hipDeviceAttributeMultiprocessorCount, dev) != hipSuccess) { grid = -1; return; }
        if (hipFuncSetAttribute((const void*)mega, hipFuncAttributeMaxDynamicSharedMemorySize, LDS_BYTES) != hipSuccess) { grid = -1; return; }
        if (hipOccupancyMaxActiveBlocksPerMultiprocessor(&per_cu, (const void*)mega, 512, LDS_BYTES) != hipSuccess || per_cu < 1) { fprintf(stderr, "kernel_launch: occupancy query says %d\n", per_cu); }
        (void)hipGetLastError();
        grid = cus;
    }
    if (grid < 0) return;
    (void)hipMemsetAsync((char*)d_ws + WS_CTL, 0, CTL_BYTES, stream);
    Args a{};
    for (int i = 0; i < 39; ++i) a.in[i] = (const float*)d_in[i];
    a.out = (float*)d_out; a.ws = (unsigned char*)d_ws;
    if (N_LAUNCH_MODE == 1) {
        a.lo = 0; a.hi = NPHASES;
        hipLaunchKernelGGL(mega, dim3(grid), dim3(512), LDS_BYTES, stream, a);
    } else {
        for (int ph = 0; ph < NPHASES; ++ph) {
            a.lo = ph; a.hi = ph + 1;
            hipLaunchKernelGGL(mega, dim3(grid), dim3(512), LDS_BYTES, stream, a);
        }
    }
}
```

```cpp
#include <hip/hip_runtime.h>
#include <cstdint>
#include <cstdio>

#define LAS __attribute__((address_space(3)))

constexpr int D = 1024, BATCH = 4, SEQ = 8192, T = BATCH * SEQ;
constexpr int RW = 512, NH = 8;
constexpr int RPROJ = 1792, NPROJ = 2304;
constexpr int S5NG = 32, S5P = 64;
constexpr int NE = 256, EFF = 256;
constexpr int NMODS = 6 * D;
constexpr int S5CL = 128, S5NC = SEQ / S5CL;

constexpr size_t MiB = 1u << 20;
constexpr size_t WS_CTL = 0, CTL_BYTES = 1 * MiB;
constexpr size_t WS_COUNTS = 64 * 1024;
constexpr size_t WS_MODS = 1 * MiB;
constexpr size_t WS_S5AB = 1 * MiB + 128 * 1024;
constexpr size_t WS_S5POW = 1 * MiB + 160 * 1024;
constexpr size_t WS_S5BB = 1 * MiB + 256 * 1024;
constexpr size_t WS_S5E = 2 * MiB;
constexpr size_t WS_S5X0 = 6 * MiB;
constexpr size_t WS_WIN_T = 10 * MiB;
constexpr size_t WS_WOUT_T = 15 * MiB;
constexpr size_t WS_WGLU_T = 17 * MiB;
constexpr size_t WS_WSGU_T = 18 * MiB;
constexpr size_t WS_WSD_T = 19 * MiB;
constexpr size_t WS_WR_T = 20 * MiB;
constexpr size_t WS_WED = 24 * MiB;
constexpr size_t WS_WEGU = 152 * MiB;
constexpr size_t WS_A = 408 * MiB;
constexpr size_t WS_YS5 = WS_A + 64 * MiB;
constexpr size_t WS_PROJ = 536 * MiB;
constexpr size_t WS_RW = 680 * MiB;
constexpr size_t RWSZ = (size_t)T * RW * 4;
constexpr size_t RWSZH = (size_t)T * RW * 2;
constexpr size_t WS_RW_W = WS_RW, WS_RW_Y = WS_RW + RWSZ, WS_RW_R = WS_RW + 2 * RWSZ, WS_RW_K = WS_RW_R + RWSZH, WS_RW_V = WS_RW_K + RWSZH,
                 WS_RW_A = WS_RW_V + RWSZH, WS_RW_B = WS_RW_A + RWSZH, WS_RW_G = WS_RW_B + RWSZH;
constexpr size_t WS_PLOG = 680 * MiB;
constexpr size_t WS_SHOUT = 680 * MiB;
constexpr size_t WS_HS = 808 * MiB;
constexpr size_t WS_IDX = 824 * MiB;
constexpr size_t WS_WT = 825 * MiB;
constexpr size_t WS_SLOTP = 826 * MiB;
constexpr size_t WS_UEXP = 827 * MiB + 512 * 1024;
constexpr size_t WS_HID = 840 * MiB;
constexpr size_t WS_YEXP = 152 * MiB;
constexpr size_t WS_END = 1000 * MiB;

constexpr int LDS_BYTES = 132096;
constexpr int LDS_CTL_OFF = 131072;

#define XB_TMO      128
#define XB_XCNT(j)  (256  + 64 * (j))
#define XB_XSUB(j)  (1280 + 64 * (j))
#define XB_XGEN(j)  (2304 + 64 * (j))
#define XB_TOP      3328
#define XB_TOPGEN   3392
#define XCD_BAR_WORDS 3456
#define XB_SPIN_CAP (1u << 24)

__device__ __forceinline__ unsigned xb_ld(unsigned* p)              { return __hip_atomic_load(p, __ATOMIC_RELAXED, __HIP_MEMORY_SCOPE_AGENT); }
__device__ __forceinline__ unsigned xb_add(unsigned* p, unsigned v) { return __hip_atomic_fetch_add(p, v, __ATOMIC_RELAXED, __HIP_MEMORY_SCOPE_AGENT); }
__device__ __forceinline__ unsigned xb_xcc_id() { return (unsigned)__builtin_amdgcn_s_getreg((3 << 11) | 20) & 0xFu; }
#define XB_SPIN(cond, bar) do { unsigned _sp = 0; while (cond) { __builtin_amdgcn_s_sleep(1); \
    if ((++_sp & 255u) == 0u) { if (xb_ld(&(bar)[XB_TMO])) break; if (_sp > XB_SPIN_CAP) { atomicAdd(&(bar)[XB_TMO], 1u); break; } } } } while (0)

struct XcdBarrier { unsigned* bar; unsigned x; volatile LAS unsigned* st; };

__device__ __forceinline__ XcdBarrier xcd_barrier_post(unsigned* bar, volatile LAS unsigned* st) {
    XcdBarrier b; b.bar = bar; b.x = xb_xcc_id(); b.st = st;
    if (threadIdx.x == 0) (void)xb_add(&bar[XB_XCNT(b.x)], 1u);
    return b;
}
__device__ __forceinline__ void xcd_barrier_complete(unsigned* bar, unsigned x, unsigned& nloc, unsigned& nx) {
    const unsigned G = gridDim.x * gridDim.y * gridDim.z;
    unsigned sum, cnt, mine, sp = 0u;
    for (;;) {
        sum = 0u; cnt = 0u; mine = 0u;
#pragma unroll
        for (unsigned j = 0; j < 16; ++j) { const unsigned c = xb_ld(&bar[XB_XCNT(j)]); sum += c; cnt += (c > 0u) ? 1u : 0u; mine = (j == x) ? c : mine; }
        if (sum == G) break;
        __builtin_amdgcn_s_sleep(1);
        if ((++sp & 255u) == 0u) { if (xb_ld(&bar[XB_TMO])) break; if (sp > XB_SPIN_CAP) { atomicAdd(&bar[XB_TMO], 1u); break; } }
    }
    nloc = mine > 0u ? mine : 1u; nx = cnt > 0u ? cnt : 1u;
}
__device__ __forceinline__ void xcd_barrier(const XcdBarrier& b) {
    asm volatile("s_waitcnt vmcnt(0)" ::: "memory");
    __syncthreads();
    if (threadIdx.x == 0) {
        unsigned* bar = b.bar;
        __builtin_amdgcn_s_waitcnt(0);
        unsigned nloc = b.st[0], nx = b.st[1];
        if (nloc == 0u) { xcd_barrier_complete(bar, b.x, nloc, nx); b.st[0] = nloc; b.st[1] = nx; }
        const unsigned old = xb_add(&bar[XB_XSUB(b.x)], 1u);
        const unsigned gen = old / nloc;
        if (old + 1u == (gen + 1u) * nloc) {
            __builtin_amdgcn_fence(__ATOMIC_RELEASE, "agent");
            asm volatile("s_waitcnt vmcnt(0)" ::: "memory");
            const unsigned og = xb_add(&bar[XB_TOP], 1u);
            const unsigned tg = og / nx;
            if (og + 1u == (tg + 1u) * nx) xb_add(&bar[XB_TOPGEN], 1u);
            else XB_SPIN(xb_ld(&bar[XB_TOPGEN]) == tg, bar);
            __builtin_amdgcn_fence(__ATOMIC_ACQUIRE, "agent");
            xb_add(&bar[XB_XGEN(b.x)], 1u);
            asm volatile("s_waitcnt vmcnt(0)" ::: "memory");
        } else {
            XB_SPIN(xb_ld(&bar[XB_XGEN(b.x)]) == gen, bar);
            __builtin_amdgcn_fence(__ATOMIC_ACQUIRE, "agent");
            asm volatile("s_waitcnt vmcnt(0)" ::: "memory");
        }
    }
    __syncthreads();
}

namespace pg8 {
#define PG8_LAS __attribute__((address_space(3)))
typedef unsigned short bf16_t;
typedef short bf16x8 __attribute__((ext_vector_type(8)));
typedef float f32x4 __attribute__((ext_vector_type(4)));
typedef unsigned u32x4 __attribute__((ext_vector_type(4)));
constexpr int BM = 256, BK = 64, HALF = 128, HTB = HALF * BK * 2  , STAGE_BYTES = 8 * HTB, NXCD = 8, WGM = 8;

__host__ __device__ __forceinline__ int lds_byte(int r, int c) { const int st = (r >> 4) * 2 + (c >> 5), rr = r & 15, cc = c & 31, ob = rr * 64 + cc * 2; return st * 1024 + (ob ^ (((ob >> 9) & 1) << 5)); }
__host__ __device__ __forceinline__ void stage_rc(int b, int& R, int& C) { const int st = b / 1024, sb = b % 1024, swz = sb ^ (((sb >> 9) & 1) << 5); R = (st >> 1) * 16 + swz / 64; C = (st & 1) * 32 + (swz % 64) / 2; }
__host__ __device__ __forceinline__ int perm32(int rho) { const int n = rho >> 4, i = rho & 15; return 8 * (i >> 2) + 4 * n + (i & 3); }

struct Unit { int pm, pn; };
struct Gemm { const bf16_t* A; const bf16_t* Bt; int M, N, K; const int* rowtab = nullptr; };

struct StaticOrder {
    int nM, nN, nwg, G, c;
    __host__ __device__ void init(int M, int N, int G_, int c_) { nM = M / BM; nN = N / BM; nwg = nM * nN; G = G_; c = c_; }
    __host__ __device__ bool next(int i, Unit& u) const {
        const long L = (long)i * G + c; if (L >= nwg) return false;
        int wgid = (int)L; { const int q = nwg / NXCD, r = nwg % NXCD, xcd = wgid % NXCD, off = wgid / NXCD; wgid = (xcd < r ? xcd * (q + 1) : r * (q + 1) + (xcd - r) * q) + off; }
        const int nig = WGM * nN, gid = wgid / nig, fm = gid * WGM, gsz = (nM - fm) < WGM ? (nM - fm) : WGM;
        u.pm = fm + ((wgid % nig) % gsz); u.pn = (wgid % nig) / gsz; return true;
    }
    __device__ __forceinline__ void a_ready(const Unit&) const {}
    __device__ __forceinline__ void done(const Unit&) const {}
};

__device__ __forceinline__ unsigned cvt_pk_bf16(float lo, float hi) { unsigned r; asm volatile("v_cvt_pk_bf16_f32 %0, %1, %2" : "=v"(r) : "v"(lo), "v"(hi)); return r; }
typedef float f32x2 __attribute__((ext_vector_type(2)));
__device__ __forceinline__ f32x2 gelu_pk(f32x2 v) {
    const f32x2 av = __builtin_elementwise_abs(v), d = av * 0.2316418882f + 1.0f;
    f32x2 t; t.x = __builtin_amdgcn_rcpf(d.x); t.y = __builtin_amdgcn_rcpf(d.y);
    f32x2 q = t * 0.5307027145f + (-0.7265760135f); q = q * t + 0.7107068705f; q = q * t + (-0.142248368f); q = q * t + 0.127414796f; q = q * t;
    const f32x2 s = (v * v) * (-0.72134752044f);
    f32x2 e; e.x = __builtin_amdgcn_exp2f(s.x); e.y = __builtin_amdgcn_exp2f(s.y);
    const f32x2 m = v * (q * e), r = v - m;
    f32x2 o; o.x = v.x < 0.f ? m.x : r.x; o.y = v.y < 0.f ? m.y : r.y; return o;
}

template <int ACT  > struct EpiBf16 {
    static constexpr bool PERM = true, AFTER_DRAIN = false; static_assert(ACT == 0 || ACT == 1, "EpiBf16: ACT is 0 (none) or 1 (gelu_pk)");
    bf16_t* O; int ldc; const float* bias; int split_cols; size_t split_stride; float scale0;
    __device__ __forceinline__ void operator()(const f32x4 (&acc)[2][2][4][2], const Unit& u, int wr, int wc, int fr, int fq) const {
        const int row0 = u.pm * BM + wr * 64 + fr; int colt = u.pn * BM; bf16_t* base = O;
        float sc = 1.f; if (split_cols) { const int t = colt / split_cols; base += (size_t)t * split_stride; colt -= t * split_cols; if (t == 0) sc = scale0; }
        const int col0 = colt + wc * 32 + 8 * fq, bcol0 = u.pn * BM + wc * 32 + 8 * fq;
        f32x4 bv[2][2];
#pragma unroll
        for (int bj = 0; bj < 2; ++bj)
#pragma unroll
            for (int n = 0; n < 2; ++n) bv[bj][n] = bias ? *(const f32x4*)(bias + bcol0 + bj * HALF + 4 * n) : (f32x4){0.f, 0.f, 0.f, 0.f};
#pragma unroll
        for (int ai = 0; ai < 2; ++ai)
#pragma unroll
            for (int m = 0; m < 4; ++m) { bf16_t* rowp = base + (size_t)(row0 + ai * HALF + m * 16) * ldc + col0;
#pragma unroll
                for (int bj = 0; bj < 2; ++bj) { f32x4 v0 = acc[ai][bj][m][0] + bv[bj][0], v1 = acc[ai][bj][m][1] + bv[bj][1];
                    if (ACT == 1) { f32x2 a = gelu_pk((f32x2){v0[0], v0[1]}), b = gelu_pk((f32x2){v0[2], v0[3]}), c = gelu_pk((f32x2){v1[0], v1[1]}), d = gelu_pk((f32x2){v1[2], v1[3]});
                        v0 = (f32x4){a.x, a.y, b.x, b.y}; v1 = (f32x4){c.x, c.y, d.x, d.y}; }
                    v0 = v0 * sc; v1 = v1 * sc; u32x4 w; w.x = cvt_pk_bf16(v0[0], v0[1]); w.y = cvt_pk_bf16(v0[2], v0[3]); w.z = cvt_pk_bf16(v1[0], v1[1]); w.w = cvt_pk_bf16(v1[2], v1[3]);
                    *(u32x4*)(rowp + bj * HALF) = w; } }
    }
};

struct EpiF32 {
    static constexpr bool PERM = false, AFTER_DRAIN = false;
    float* C; int ldc;
    __device__ __forceinline__ void operator()(const f32x4 (&acc)[2][2][4][2], const Unit& u, int wr, int wc, int fr, int fq) const {
        const int row0 = u.pm * BM + wr * 64 + fr, col0 = u.pn * BM + wc * 32 + 4 * fq;
#pragma unroll
        for (int ai = 0; ai < 2; ++ai)
#pragma unroll
            for (int m = 0; m < 4; ++m) { float* rowp = C + (size_t)(row0 + ai * HALF + m * 16) * ldc + col0;
#pragma unroll
                for (int bj = 0; bj < 2; ++bj)
#pragma unroll
                    for (int n = 0; n < 2; ++n) *(f32x4*)(rowp + bj * HALF + n * 16) = acc[ai][bj][m][n]; }
    }
};
__device__ __forceinline__ float fast_sigmoid(float x) { return __builtin_amdgcn_rcpf(1.0f + __builtin_amdgcn_exp2f(-1.4426950408889634f * x)); }
struct EpiSwiGLU {
    static constexpr bool PERM = true, AFTER_DRAIN = false;
    bf16_t* O; int ldo;
    __device__ __forceinline__ void operator()(const f32x4 (&acc)[2][2][4][2], const Unit& u, int wr, int wc, int fr, int fq) const {
        const int row0 = u.pm * BM + wr * 64 + fr, col0 = (u.pn & 1) * HALF + wc * 32 + 8 * fq;
#pragma unroll
        for (int ai = 0; ai < 2; ++ai)
#pragma unroll
            for (int m = 0; m < 4; ++m) {
                bf16_t* rowp = O + (size_t)(row0 + ai * HALF + m * 16) * ldo + col0;
                const f32x4 g0 = acc[ai][0][m][0], g1 = acc[ai][0][m][1], u0 = acc[ai][1][m][0], u1 = acc[ai][1][m][1];
                float r[8];
#pragma unroll
                for (int i = 0; i < 4; ++i) { r[i] = g0[i] * fast_sigmoid(g0[i]) * u0[i]; r[4 + i] = g1[i] * fast_sigmoid(g1[i]) * u1[i]; }
                u32x4 w; w.x = cvt_pk_bf16(r[0], r[1]); w.y = cvt_pk_bf16(r[2], r[3]); w.z = cvt_pk_bf16(r[4], r[5]); w.w = cvt_pk_bf16(r[6], r[7]);
                *(u32x4*)rowp = w;
            }
    }
};
struct EpiScatter {
    static constexpr bool PERM = true, AFTER_DRAIN = false;
    const int* slotp; const float* wt; bf16_t* Y; int ldy;
    __device__ __forceinline__ void operator()(const f32x4 (&acc)[2][2][4][2], const Unit& u, int wr, int wc, int fr, int fq) const {
        int t2 = threadIdx.x; asm volatile("" : "+v"(t2));
        const int fr2 = t2 & 15, fq2 = (t2 >> 4) & 3, wc2 = (t2 >> 6) & 3, wr2 = (t2 >> 8) & 1;
        const int col0 = (u.pn & 3) * BM + wc2 * 32 + 8 * fq2;
        const int rbase = u.pm * BM + wr2 * 64 + fr2;
#pragma unroll
        for (int ai = 0; ai < 2; ++ai)
#pragma unroll
            for (int m = 0; m < 4; ++m) {
                const int aid = slotp[rbase + ai * HALF + m * 16];
                if (aid >= 0) {
                    const float w = wt[aid];
                    bf16_t* rowp = Y + (size_t)aid * ldy + col0;
#pragma unroll
                    for (int bj = 0; bj < 2; ++bj) {
                        const f32x4 v0 = acc[ai][bj][m][0] * w, v1 = acc[ai][bj][m][1] * w;
                        u32x4 o; o.x = cvt_pk_bf16(v0[0], v0[1]); o.y = cvt_pk_bf16(v0[2], v0[3]); o.z = cvt_pk_bf16(v1[0], v1[1]); o.w = cvt_pk_bf16(v1[2], v1[3]);
                        *(u32x4*)(rowp + bj * HALF) = o;
                    }
                }
            }
    }
};
struct ExpertOrder {
    const int* uexp; int NU, npn, G, c;
    __device__ __forceinline__ bool next(int i, Unit& u) const {
        const int L = i * G + c; if (L >= NU * npn) return false;
        const int uu = L / npn, pl = L % npn;
        u.pm = uu; u.pn = __builtin_amdgcn_readfirstlane(uexp[uu]) * npn + pl; return true;
    }
    __device__ __forceinline__ void a_ready(const Unit&) const {}
    __device__ __forceinline__ void done(const Unit&) const {}
};
struct EpiGLU {
    static constexpr bool PERM = true, AFTER_DRAIN = false;
    const bf16_t* Y; int ldy; const float* bias; bf16_t* O; int ldo; int ocol0;
    __device__ __forceinline__ void operator()(const f32x4 (&acc)[2][2][4][2], const Unit& u, int wr, int wc, int fr, int fq) const {
        const int row0 = u.pm * BM + wr * 64 + fr, col0 = u.pn * BM + wc * 32 + 8 * fq;
#pragma unroll
        for (int bj = 0; bj < 2; ++bj) {
            const f32x4 b0 = *(const f32x4*)(bias + col0 + bj * HALF), b1 = *(const f32x4*)(bias + col0 + bj * HALF + 4);
#pragma unroll
            for (int ai = 0; ai < 2; ++ai)
#pragma unroll
                for (int m = 0; m < 4; ++m) {
                    const size_t row = (size_t)(row0 + ai * HALF + m * 16);
                    const u32x4 yv = *(const u32x4*)(Y + row * ldy + col0 + bj * HALF);
                    const f32x4 z0 = acc[ai][bj][m][0] + b0, z1 = acc[ai][bj][m][1] + b1;
                    float y[8] = {__builtin_bit_cast(float, yv.x << 16), __builtin_bit_cast(float, yv.x & 0xffff0000u), __builtin_bit_cast(float, yv.y << 16), __builtin_bit_cast(float, yv.y & 0xffff0000u),
                                  __builtin_bit_cast(float, yv.z << 16), __builtin_bit_cast(float, yv.z & 0xffff0000u), __builtin_bit_cast(float, yv.w << 16), __builtin_bit_cast(float, yv.w & 0xffff0000u)};
                    float r[8];
#pragma unroll
                    for (int i = 0; i < 4; ++i) { r[i] = y[i] * fast_sigmoid(z0[i]); r[4 + i] = y[4 + i] * fast_sigmoid(z1[i]); }
                    u32x4 w; w.x = cvt_pk_bf16(r[0], r[1]); w.y = cvt_pk_bf16(r[2], r[3]); w.z = cvt_pk_bf16(r[4], r[5]); w.w = cvt_pk_bf16(r[6], r[7]);
                    *(u32x4*)(O + row * ldo + ocol0 + col0 + bj * HALF) = w;
                }
        }
    }
};
template <class Epi, class Sched, bool ALIGN_EPI = false, bool SP2 = false, bool GATHER = false>
__device__ __forceinline__ void gemm_phase(PG8_LAS unsigned char* lds, const Gemm g, const Sched& S, const Epi& E) {
    int tid_ = threadIdx.x; asm volatile("" : "+v"(tid_));
    const int tid = tid_, wid = __builtin_amdgcn_readfirstlane(tid >> 6), lane = tid & 63, wr = wid >> 2, wc = wid & 3, fr = lane & 15, fq = lane >> 4;
    const int K = g.K, nt = K / BK;
    unsigned voffA[2], voffB[2];
#pragma unroll
    for (int i = 0; i < 2; ++i) { int R, C; stage_rc(tid * 16 + i * 8192, R, C); const int Rb = Epi::PERM ? ((R & ~31) + perm32(R & 31)) : R;
        voffA[i] = (unsigned)(R * K + C) * 2u; voffB[i] = (unsigned)(Rb * K + C) * 2u; }
    const size_t kstep = (size_t)(BK * 2);
    const size_t hstep = (size_t)HALF * K * 2;
    const size_t tstep = 2 * hstep;
    const unsigned ldsw = (unsigned)wid * 1024u;
    const int aoff = lds_byte(wr * 64 + fr, fq * 8), boff = lds_byte(wc * 32 + fr, fq * 8);
#define PG8_SA(b, h) (((b) * 2 + (h)) * HTB)
#define PG8_SB(b, h) ((4 + (b) * 2 + (h)) * HTB)
#define PG8_STAGE(bufoff, gbase, voff) do { _Pragma("unroll") for (int _i = 0; _i < 2; ++_i) \
        __builtin_amdgcn_global_load_lds((const unsigned*)((const char*)(gbase) + (voff)[_i]), (PG8_LAS unsigned*)(lds + (bufoff) + ldsw + _i * 8192), 16, 0, 0); } while (0)
#define PG8_STAGE_A(bufoff, kptr, h, NEXTSEL) do { if constexpr (GATHER) { const unsigned _p = (NEXTSEL) ? gnxt[h] : gcur[h]; const unsigned _v[2] = { (_p & 0xffffu) * (unsigned)(2 * K) + gC2, (_p >> 16) * (unsigned)(2 * K) + gC2 }; PG8_STAGE(bufoff, kptr, _v); } \
        else { PG8_STAGE(bufoff, (kptr) + (h) * hstep, voffA); } } while (0)
#define PG8_LDA(dst, b, h) do { _Pragma("unroll") for (int m = 0; m < 4; ++m) _Pragma("unroll") for (int k = 0; k < 2; ++k) dst[m][k] = *(const PG8_LAS bf16x8*)(lds + PG8_SA(b, h) + aoff + m * 2048 + k * 1024); } while (0)
#define PG8_LDB(dst, b, h) do { _Pragma("unroll") for (int n = 0; n < 2; ++n) _Pragma("unroll") for (int k = 0; k < 2; ++k) dst[n][k] = *(const PG8_LAS bf16x8*)(lds + PG8_SB(b, h) + boff + n * 2048 + k * 1024); } while (0)
#define PG8_MMA(ai, bj, At, Bt) do { __builtin_amdgcn_s_setprio(1); _Pragma("unroll") for (int m = 0; m < 4; ++m) _Pragma("unroll") for (int n = 0; n < 2; ++n) _Pragma("unroll") for (int k = 0; k < 2; ++k) \
        acc[ai][bj][m][n] = __builtin_amdgcn_mfma_f32_16x16x32_bf16(Bt[n][k], At[m][k], acc[ai][bj][m][n], 0, 0, 0); __builtin_amdgcn_s_setprio(0); } while (0)
#define PG8_WAIT_V(n) asm volatile("s_waitcnt vmcnt(" #n ")" ::: "memory")
#define PG8_WAIT_L(n) asm volatile("s_waitcnt lgkmcnt(" #n ")" ::: "memory")
#define PG8_BAR __builtin_amdgcn_s_barrier()
#define PG8_SCHED __builtin_amdgcn_sched_barrier(0)
    unsigned gcur[2], gnxt[2], gC2 = 0;
    if constexpr (GATHER) { int R, C; stage_rc(tid * 16, R, C); gC2 = (unsigned)C * 2u; }
    auto load_gather = [&](int pm, unsigned (&dst)[2]) {
        int R, C; stage_rc(tid * 16, R, C);
#pragma unroll
        for (int h = 0; h < 2; ++h) { int a0 = g.rowtab[pm * BM + h * HALF + R], a1 = g.rowtab[pm * BM + h * HALF + R + 64]; a0 = a0 < 0 ? 0 : a0; a1 = a1 < 0 ? 0 : a1; dst[h] = (unsigned)(a0 >> 3) | ((unsigned)(a1 >> 3) << 16); }
    };
    Unit cur, nxt; int ui = 0;
    if (!S.next(0, cur)) return;
    f32x4 acc[2][2][4][2];
#pragma unroll
    for (int a = 0; a < 2; ++a)
#pragma unroll
        for (int b = 0; b < 2; ++b)
#pragma unroll
            for (int m = 0; m < 4; ++m)
#pragma unroll
                for (int n = 0; n < 2; ++n) acc[a][b][m][n] = (f32x4){0.f, 0.f, 0.f, 0.f};
    bf16x8 At[4][2], B0[2][2], B1[2][2];
    const char* cA = (const char*)g.A + (GATHER ? (size_t)0 : (size_t)cur.pm * tstep); const char* cB = (const char*)g.Bt + (size_t)cur.pn * tstep;
    if constexpr (GATHER) { load_gather(cur.pm, gcur); }
    S.a_ready(cur);
    if constexpr (SP2) {
        PG8_STAGE(PG8_SB(0, 0), cB, voffB); PG8_STAGE(PG8_SB(0, 1), cB + hstep, voffB); PG8_STAGE_A(PG8_SA(0, 0), cA, 0, false); PG8_STAGE_A(PG8_SA(0, 1), cA, 1, false);
        if (wr == 1) PG8_BAR;
        PG8_WAIT_V(2); PG8_BAR;
        PG8_STAGE(PG8_SB(1, 0), cB + kstep, voffB); PG8_STAGE_A(PG8_SA(1, 0), cA + kstep, 0, false); PG8_STAGE(PG8_SB(1, 1), cB + hstep + kstep, voffB);
        PG8_WAIT_V(6); PG8_BAR;
    } else {
        PG8_STAGE(PG8_SB(0, 0), cB, voffB); PG8_STAGE_A(PG8_SA(0, 0), cA, 0, false); PG8_STAGE(PG8_SB(0, 1), cB + hstep, voffB); PG8_STAGE_A(PG8_SA(0, 1), cA, 1, false);
        if (wr == 1) PG8_BAR;
        PG8_WAIT_V(4); PG8_BAR;
        PG8_STAGE(PG8_SB(1, 0), cB + kstep, voffB); PG8_STAGE_A(PG8_SA(1, 0), cA + kstep, 0, false); PG8_STAGE(PG8_SB(1, 1), cB + hstep + kstep, voffB);
        PG8_WAIT_V(6); PG8_BAR;
    }
    for (;;) {
        const bool has_next = S.next(ui + 1, nxt);
        const char* nA = (has_next && !GATHER) ? (const char*)g.A + (size_t)nxt.pm * tstep : cA; const char* nB = has_next ? (const char*)g.Bt + (size_t)nxt.pn * tstep : cB;
        if constexpr (GATHER) { if (has_next) load_gather(nxt.pm, gnxt); else {
#pragma unroll
            for (int h = 0; h < 2; ++h) { gnxt[h] = gcur[h]; } } }
        for (int t = 0; t < nt; t += 2) {
            const bool last = (t == nt - 2);
            const char* a1 = cA + (size_t)(t + 1) * kstep;
            const char* a2 = last ? nA : cA + (size_t)(t + 2) * kstep; const char* b2 = last ? nB : cB + (size_t)(t + 2) * kstep;
            const char* a3 = a2 + kstep; const char* b3 = b2 + kstep;
            if (last && has_next) S.a_ready(nxt);
            if constexpr (SP2) {
            PG8_LDB(B0, 0, 0); PG8_LDB(B1, 0, 1); PG8_SCHED; PG8_LDA(At, 0, 0); PG8_STAGE_A(PG8_SA(1, 1), a1, 1, false);
            PG8_WAIT_V(8); PG8_WAIT_L(0); PG8_BAR; PG8_MMA(0, 0, At, B0); PG8_MMA(0, 1, At, B1); PG8_BAR; PG8_SCHED;
            PG8_LDA(At, 0, 1); PG8_STAGE(PG8_SB(0, 0), b2, voffB); PG8_STAGE(PG8_SB(0, 1), b2 + hstep, voffB); PG8_STAGE_A(PG8_SA(0, 0), a2, 0, last);
            PG8_WAIT_V(8); PG8_WAIT_L(0); PG8_BAR; PG8_MMA(1, 0, At, B0); PG8_MMA(1, 1, At, B1); PG8_BAR; PG8_SCHED;
            PG8_LDB(B0, 1, 0); PG8_LDB(B1, 1, 1); PG8_SCHED; PG8_LDA(At, 1, 0); PG8_STAGE_A(PG8_SA(0, 1), a2, 1, last);
            PG8_WAIT_V(8); PG8_WAIT_L(0); PG8_BAR; PG8_MMA(0, 0, At, B0); PG8_MMA(0, 1, At, B1); PG8_BAR; PG8_SCHED;
            PG8_LDA(At, 1, 1); PG8_STAGE(PG8_SB(1, 0), b3, voffB); PG8_STAGE(PG8_SB(1, 1), b3 + hstep, voffB); PG8_STAGE_A(PG8_SA(1, 0), a3, 0, last);
            PG8_WAIT_V(8); PG8_WAIT_L(0); PG8_BAR; PG8_MMA(1, 0, At, B0); PG8_MMA(1, 1, At, B1); PG8_BAR; PG8_SCHED;
            } else {
            PG8_LDB(B0, 0, 0); PG8_SCHED; PG8_LDA(At, 0, 0); PG8_STAGE_A(PG8_SA(1, 1), a1, 1, false);
            PG8_WAIT_L(8); PG8_BAR; PG8_WAIT_L(0); PG8_MMA(0, 0, At, B0); PG8_BAR; PG8_SCHED;
            PG8_LDB(B1, 0, 1); PG8_STAGE(PG8_SB(0, 0), b2, voffB);
            PG8_BAR; PG8_WAIT_L(0); PG8_MMA(0, 1, At, B1); PG8_BAR;
            PG8_LDA(At, 0, 1); PG8_STAGE_A(PG8_SA(0, 0), a2, 0, last);
            PG8_BAR; PG8_WAIT_L(0); PG8_MMA(1, 0, At, B0); PG8_BAR; PG8_SCHED;
            PG8_STAGE(PG8_SB(0, 1), b2 + hstep, voffB);
            PG8_WAIT_V(6); PG8_BAR; PG8_MMA(1, 1, At, B1); PG8_BAR;
            PG8_LDB(B0, 1, 0); PG8_SCHED; PG8_LDA(At, 1, 0); PG8_STAGE_A(PG8_SA(0, 1), a2, 1, last);
            PG8_WAIT_L(8); PG8_BAR; PG8_WAIT_L(0); PG8_MMA(0, 0, At, B0); PG8_BAR; PG8_SCHED;
            PG8_LDB(B1, 1, 1); PG8_STAGE(PG8_SB(1, 0), b3, voffB);
            PG8_BAR; PG8_WAIT_L(0); PG8_MMA(0, 1, At, B1); PG8_BAR;
            PG8_LDA(At, 1, 1); PG8_STAGE_A(PG8_SA(1, 0), a3, 0, last);
            PG8_BAR; PG8_WAIT_L(0); PG8_MMA(1, 0, At, B0); PG8_BAR; PG8_SCHED;
            PG8_STAGE(PG8_SB(1, 1), b3 + hstep, voffB);
            PG8_WAIT_V(6); PG8_BAR; PG8_MMA(1, 1, At, B1); PG8_BAR;
            }
        }
        if constexpr (ALIGN_EPI) { if (wr == 0) PG8_BAR; }
        if constexpr (!Epi::AFTER_DRAIN) { E(acc, cur, wr, wc, fr, fq); S.done(cur); }
        if (!has_next) break;
#pragma unroll
        for (int a = 0; a < 2; ++a)
#pragma unroll
            for (int b = 0; b < 2; ++b)
#pragma unroll
                for (int m = 0; m < 4; ++m)
#pragma unroll
                    for (int n = 0; n < 2; ++n) acc[a][b][m][n] = (f32x4){0.f, 0.f, 0.f, 0.f};
        cur = nxt; cA = nA; cB = nB; ++ui;
        if constexpr (GATHER) {
#pragma unroll
            for (int h = 0; h < 2; ++h) { gcur[h] = gnxt[h]; } }
        if constexpr (ALIGN_EPI) { if (wr == 1) PG8_BAR; }
    }
    PG8_WAIT_V(0);
    if constexpr (!ALIGN_EPI) { if (wr == 0) PG8_BAR; }
    PG8_BAR;
    if constexpr (Epi::AFTER_DRAIN) { E.fused(acc, cur, wr, wc, fr, fq, lds, wid, lane); S.done(cur); }
#undef PG8_SA
#undef PG8_SB
#undef PG8_STAGE
#undef PG8_STAGE_A
#undef PG8_LDA
#undef PG8_LDB
#undef PG8_MMA
#undef PG8_WAIT_V
#undef PG8_WAIT_L
#undef PG8_BAR
#undef PG8_SCHED
}
}

typedef unsigned short bf16_t;
__device__ __forceinline__ unsigned f2bf(float f) { unsigned u = __builtin_bit_cast(unsigned, f); return (u + 0x7fffu + ((u >> 16) & 1u)) >> 16; }
__device__ __forceinline__ float bf2f(unsigned h) { return __builtin_bit_cast(float, h << 16); }
__device__ __forceinline__ float wave_sum(float v) {
#pragma unroll
    for (int o = 1; o < 64; o <<= 1) v += __shfl_xor(v, o);
    return v;
}
__device__ __forceinline__ float sigmoidf_(float x) { return 1.0f / (1.0f + expf(-x)); }
__device__ __forceinline__ float siluf_(float x) { return x / (1.0f + expf(-x)); }
__device__ __forceinline__ float softplusf_(float x) { return fmaxf(x, 0.0f) + log1pf(expf(-fabsf(x))); }
__device__ __forceinline__ float geluf_(float x) { const float u = 0.7978845608028654f * (x + 0.044715f * x * x * x); return 0.5f * x * (1.0f + tanhf(u)); }

struct Args { const float* in[39]; float* out; unsigned char* ws; int lo, hi; };

struct Ctx {
    const float* const* in; float* out; unsigned char* ws;
    LAS unsigned char* lds; float* sm;
    int tid, lane, wid, bid, G;
};

__device__ __forceinline__ unsigned pk2(float lo, float hi) { return f2bf(lo) | (f2bf(hi) << 16); }
__device__ __forceinline__ float ldbf(const bf16_t* p) { return bf2f((unsigned)*p); }
__device__ __forceinline__ float4 ldbf4(const bf16_t* p) { const uint2 v = *(const uint2*)p; return make_float4(bf2f(v.x & 0xffffu), bf2f(v.x >> 16), bf2f(v.y & 0xffffu), bf2f(v.y >> 16)); }

template <int NB, class AF, class BF, class BF2, class EF>
__device__ __forceinline__ void gemm_tile(float* sm, int K, AF af, BF bf, BF2 bf2, EF ef) {
    float* As = sm;
    float* Bs = sm + 16 * 132;
    float* Bs2 = Bs + 16 * 68;
    const int tid = threadIdx.x, ty = tid >> 4, tx = tid & 15;
    const int am = tid >> 2, ak = (tid & 3) * 4;
    const int bt = tid & 255, bk = bt >> 4, bn = (bt & 15) * 4;
    float acc[4][4], acc2[4][4];
#pragma unroll
    for (int i = 0; i < 4; ++i)
#pragma unroll
        for (int j = 0; j < 4; ++j) { acc[i][j] = 0.f; acc2[i][j] = 0.f; }
    float4 av = af(am, ak);
    float4 bv = make_float4(0.f, 0.f, 0.f, 0.f);
    if (tid < 256) bv = bf(bk, bn); else if (NB == 2) bv = bf2(bk, bn);
    for (int k0 = 0; k0 < K; k0 += 16) {
        __syncthreads();
        As[(ak + 0) * 132 + am] = av.x; As[(ak + 1) * 132 + am] = av.y; As[(ak + 2) * 132 + am] = av.z; As[(ak + 3) * 132 + am] = av.w;
        if (tid < 256) *(float4*)&Bs[bk * 68 + bn] = bv; else if (NB == 2) *(float4*)&Bs2[bk * 68 + bn] = bv;
        __syncthreads();
        if (k0 + 16 < K) {
            av = af(am, k0 + 16 + ak);
            if (tid < 256) bv = bf(k0 + 16 + bk, bn); else if (NB == 2) bv = bf2(k0 + 16 + bk, bn);
        }
#pragma unroll
        for (int kk = 0; kk < 16; ++kk) {
            const float4 a = *(const float4*)&As[kk * 132 + ty * 4];
            const float4 b = *(const float4*)&Bs[kk * 68 + tx * 4];
            const float aa[4] = {a.x, a.y, a.z, a.w};
            const float bb[4] = {b.x, b.y, b.z, b.w};
#pragma unroll
            for (int i = 0; i < 4; ++i)
#pragma unroll
                for (int j = 0; j < 4; ++j) acc[i][j] = fmaf(aa[i], bb[j], acc[i][j]);
            if (NB == 2) {
                const float4 b2 = *(const float4*)&Bs2[kk * 68 + tx * 4];
                const float bb2[4] = {b2.x, b2.y, b2.z, b2.w};
#pragma unroll
                for (int i = 0; i < 4; ++i)
#pragma unroll
                    for (int j = 0; j < 4; ++j) acc2[i][j] = fmaf(aa[i], bb2[j], acc2[i][j]);
            }
        }
    }
#pragma unroll
    for (int i = 0; i < 4; ++i)
        ef(ty * 4 + i, tx * 4, make_float4(acc[i][0], acc[i][1], acc[i][2], acc[i][3]), make_float4(acc2[i][0], acc2[i][1], acc2[i][2], acc2[i][3]));
}

template <bool RES, class RM>
__device__ __forceinline__ void transpose_item(const float* W, int K, int N, bf16_t* WT, RM rowmap, float* scr, int item, int lane) {
    const int nblk = N / 32, kb = item / nblk, nb = item % nblk, k0 = 64 * kb, n0 = 32 * nb;
#pragma unroll 8
    for (int i = 0; i < 32; ++i) { const int kk = 2 * i + (lane >> 5); scr[kk * 33 + (lane & 31)] = W[(size_t)(k0 + kk) * N + n0 + (lane & 31)]; }
    asm volatile("s_waitcnt lgkmcnt(0)" ::: "memory");
    const int c = lane & 7;
    const int r0 = rowmap(n0);
#pragma unroll
    for (int j = 0; j < 4; ++j) {
        const int n = (lane >> 3) + 8 * j; const float* s = scr + (8 * c) * 33 + n;
        float v[8];
#pragma unroll
        for (int q = 0; q < 8; ++q) { v[q] = s[q * 33]; if (RES) v[q] = v[q] - bf2f(f2bf(v[q])); }
        uint4 o; o.x = pk2(v[0], v[1]); o.y = pk2(v[2], v[3]); o.z = pk2(v[4], v[5]); o.w = pk2(v[6], v[7]);
        *(uint4*)(WT + (size_t)(r0 + n) * K + k0 + 8 * c) = o;
    }
    asm volatile("s_waitcnt lgkmcnt(0)" ::: "memory");
}

__device__ __forceinline__ void phase0(const Ctx& c) {
    const float* cc = c.in[1]; const float* w_ada = c.in[2]; const float* b_ada = c.in[3];
    float* mods = (float*)(c.ws + WS_MODS);
    const int gt = c.bid * 512 + c.tid, NT = c.G * 512;
    for (int idx = gt; idx < BATCH * NMODS; idx += NT) {
        const int b = idx / NMODS, j = idx % NMODS;
        float acc = 0.f;
        for (int k = 0; k < D; ++k) acc = fmaf(siluf_(cc[b * D + k]), w_ada[(size_t)k * NMODS + j], acc);
        mods[idx] = acc + b_ada[j];
    }
    const float* log_dt = c.in[20]; const float* a_re = c.in[21]; const float* a_im = c.in[22];
    const float* b_re = c.in[23]; const float* b_im = c.in[24];
    float* ab = (float*)(c.ws + WS_S5AB); float* apow = (float*)(c.ws + WS_S5POW); float* bb = (float*)(c.ws + WS_S5BB);
    for (int idx = gt; idx < S5NG * S5P; idx += NT) {
        const int g = idx / S5P;
        const double dt = exp((double)log_dt[g]);
        const double lre = fmin((double)a_re[idx], -1e-4), lim = (double)a_im[idx];
        const double mag = exp(lre * dt), ang = lim * dt;
        const double abr = mag * cos(ang), abi = mag * sin(ang);
        const double den = lre * lre + lim * lim;
        const double nre = abr - 1.0, nim = abi;
        const double qre = (nre * lre + nim * lim) / den, qim = (nim * lre - nre * lim) / den;
        ab[idx * 2 + 0] = (float)abr; ab[idx * 2 + 1] = (float)abi;
        double pr = abr, pi = abi;
        for (int s = 0; s < 7; ++s) { const double nr = pr * pr - pi * pi, ni = 2.0 * pr * pi; pr = nr; pi = ni; }
        apow[idx * 2 + 0] = (float)pr; apow[idx * 2 + 1] = (float)pi;
        for (int ch = 0; ch < 16; ++ch) {
            const double br = (double)b_re[idx * 16 + ch], bi = (double)b_im[idx * 16 + ch];
            bb[idx * 32 + ch] = (float)(qre * br - qim * bi);
            bb[idx * 32 + 16 + ch] = (float)(qre * bi + qim * br);
        }
    }
    float* scr = c.sm + c.wid * (64 * 33);
    const int gw = c.bid * 8 + c.wid, NW = c.G * 8;
    constexpr int I_IN = (D / 64) * (NPROJ / 32), I_OUT = (D / 64) * (D / 32), I_GLU = (512 / 64) * (512 / 32), I_SG = (D / 64) * (256 / 32), I_SD = (256 / 64) * (D / 32), I_R = (D / 64) * (256 / 32);
    constexpr int NIT = I_IN + I_OUT + I_GLU + 2 * I_SG + I_SD + 2 * I_R;
    for (int it = gw; it < NIT; it += NW) {
        int r = it;
        if (r < I_IN) { transpose_item<false>(c.in[8], D, NPROJ, (bf16_t*)(c.ws + WS_WIN_T), [](int n) { return n; }, scr, r, c.lane); continue; } r -= I_IN;
        if (r < I_OUT) { transpose_item<false>(c.in[30], D, D, (bf16_t*)(c.ws + WS_WOUT_T), [](int n) { return n; }, scr, r, c.lane); continue; } r -= I_OUT;
        if (r < I_GLU) { transpose_item<false>(c.in[28], 512, 512, (bf16_t*)(c.ws + WS_WGLU_T), [](int n) { return n; }, scr, r, c.lane); continue; } r -= I_GLU;
        if (r < I_SG) { transpose_item<false>(c.in[36], D, 256, (bf16_t*)(c.ws + WS_WSGU_T), [](int n) { return (n >> 7) * 256 + (n & 127); }, scr, r, c.lane); continue; } r -= I_SG;
        if (r < I_SG) { transpose_item<false>(c.in[37], D, 256, (bf16_t*)(c.ws + WS_WSGU_T), [](int n) { return (n >> 7) * 256 + 128 + (n & 127); }, scr, r, c.lane); continue; } r -= I_SG;
        if (r < I_SD) { transpose_item<false>(c.in[38], 256, D, (bf16_t*)(c.ws + WS_WSD_T), [](int n) { return n; }, scr, r, c.lane); continue; } r -= I_SD;
        if (r < I_R) { transpose_item<false>(c.in[31], D, 256, (bf16_t*)(c.ws + WS_WR_T), [](int n) { return n; }, scr, r, c.lane); continue; } r -= I_R;
        transpose_item<true>(c.in[31], D, 256, (bf16_t*)(c.ws + WS_WR_T), [](int n) { return 256 + n; }, scr, r, c.lane);
    }
    for (int it = gw; it < NE * 384; it += NW) {
        const int e = it / 384, r = it % 384;
        if (r < 128) transpose_item<false>(c.in[33] + (size_t)e * D * EFF, D, EFF, (bf16_t*)(c.ws + WS_WEGU) + (size_t)e * 512 * D, [](int n) { return (n >> 7) * 256 + (n & 127); }, scr, r, c.lane);
        else if (r < 256) transpose_item<false>(c.in[34] + (size_t)e * D * EFF, D, EFF, (bf16_t*)(c.ws + WS_WEGU) + (size_t)e * 512 * D, [](int n) { return (n >> 7) * 256 + 128 + (n & 127); }, scr, r - 128, c.lane);
        else transpose_item<false>(c.in[35] + (size_t)e * EFF * D, EFF, D, (bf16_t*)(c.ws + WS_WED) + (size_t)e * D * EFF, [](int n) { return n; }, scr, r - 256, c.lane);
    }
}

__device__ __forceinline__ void phase1(const Ctx& c) {
    const float* x = c.in[0]; const float* g = c.in[4];
    const float* mods = (const float*)(c.ws + WS_MODS);
    bf16_t* xn = (bf16_t*)(c.ws + WS_A);
    const int gw = c.bid * 8 + c.wid, NW = c.G * 8;
    for (int t = gw; t < T; t += NW) {
        const int b = t / SEQ;
        const float4* xr = (const float4*)(x + (size_t)t * D) + c.lane;
        float4 v[4]; float ss = 0.f;
#pragma unroll
        for (int j = 0; j < 4; ++j) { v[j] = xr[64 * j]; ss += v[j].x * v[j].x + v[j].y * v[j].y + v[j].z * v[j].z + v[j].w * v[j].w; }
        const float rstd = rsqrtf(wave_sum(ss) * (1.0f / D) + 1e-6f);
        uint2* o = (uint2*)(xn + (size_t)t * D) + c.lane;
#pragma unroll
        for (int j = 0; j < 4; ++j) {
            const int k = (c.lane + 64 * j) * 4;
            const float4 gg = *(const float4*)(g + k);
            const float4 sh = *(const float4*)(mods + b * NMODS + k);
            const float4 sc = *(const float4*)(mods + b * NMODS + D + k);
            float4 r;
            r.x = v[j].x * rstd * gg.x * (1.f + sc.x) + sh.x; r.y = v[j].y * rstd * gg.y * (1.f + sc.y) + sh.y;
            r.z = v[j].z * rstd * gg.z * (1.f + sc.z) + sh.z; r.w = v[j].w * rstd * gg.w * (1.f + sc.w) + sh.w;
            o[64 * j] = make_uint2(pk2(r.x, r.y), pk2(r.z, r.w));
        }
    }
}

__device__ __forceinline__ void phase2(const Ctx& c) {
    pg8::Gemm g{(const bf16_t*)(c.ws + WS_A), (const bf16_t*)(c.ws + WS_WIN_T), T, NPROJ, D};
    pg8::StaticOrder S; S.init(T, NPROJ, c.G, c.bid);
    pg8::EpiBf16<0> E{(bf16_t*)(c.ws + WS_PROJ), NPROJ, nullptr, 0, 0, 1.f};
    pg8::gemm_phase<pg8::EpiBf16<0>, pg8::StaticOrder, true, true>(c.lds, g, S, E);
}

__device__ __forceinline__ void ld_u16(const bf16_t* p, float (&u)[16]) {
    const uint4 a = *(const uint4*)p, b = *(const uint4*)(p + 8);
    u[0] = bf2f(a.x & 0xffffu); u[1] = bf2f(a.x >> 16); u[2] = bf2f(a.y & 0xffffu); u[3] = bf2f(a.y >> 16);
    u[4] = bf2f(a.z & 0xffffu); u[5] = bf2f(a.z >> 16); u[6] = bf2f(a.w & 0xffffu); u[7] = bf2f(a.w >> 16);
    u[8] = bf2f(b.x & 0xffffu); u[9] = bf2f(b.x >> 16); u[10] = bf2f(b.y & 0xffffu); u[11] = bf2f(b.y >> 16);
    u[12] = bf2f(b.z & 0xffffu); u[13] = bf2f(b.z >> 16); u[14] = bf2f(b.w & 0xffffu); u[15] = bf2f(b.w >> 16);
}
__device__ __forceinline__ void phase3(const Ctx& c) {
    const bf16_t* proj = (const bf16_t*)(c.ws + WS_PROJ);
    const float* mu = c.in[9]; const float* w0 = c.in[10]; const float* w2 = c.in[11]; const float* a0 = c.in[12]; const float* a2 = c.in[13];
    const float* g2 = c.in[14]; const float* k_k = c.in[15]; const float* k_a = c.in[16];
    float* rw_w = (float*)(c.ws + WS_RW_W);
    bf16_t* rw_r = (bf16_t*)(c.ws + WS_RW_R); bf16_t* rw_k = (bf16_t*)(c.ws + WS_RW_K); bf16_t* rw_v = (bf16_t*)(c.ws + WS_RW_V);
    bf16_t* rw_a = (bf16_t*)(c.ws + WS_RW_A); bf16_t* rw_b = (bf16_t*)(c.ws + WS_RW_B); bf16_t* rw_g = (bf16_t*)(c.ws + WS_RW_G);
    float* lo = c.sm;
    const int n = c.tid;
    for (int it = c.bid; it < T / 8; it += c.G) {
        const int t0 = it * 8;
        __syncthreads();
        if (n < 256) {
            const int col = 1536 + n; const float m_ = mu[col];
#pragma unroll
            for (int tk = 0; tk < 8; ++tk) {
                const int t = t0 + tk;
                const float p = ldbf(proj + (size_t)t * NPROJ + col);
                const float pv = (t % SEQ == 0) ? 0.f : ldbf(proj + (size_t)(t - 1) * NPROJ + col);
                const float ps = p + (pv - p) * m_;
                float v = ps;
                if (n < 64) v = tanhf(ps); else if (n >= 128) v = sigmoidf_(ps);
                lo[tk * 256 + n] = v;
            }
        }
        __syncthreads();
        float wl[8], al[8], gl[8];
#pragma unroll
        for (int tk = 0; tk < 8; ++tk) { wl[tk] = 0.f; al[tk] = 0.f; gl[tk] = 0.f; }
        for (int j = 0; j < 64; ++j) {
            const float wv = w2[j * RW + n], av = a2[j * RW + n];
#pragma unroll
            for (int tk = 0; tk < 8; ++tk) { wl[tk] = fmaf(lo[tk * 256 + j], wv, wl[tk]); al[tk] = fmaf(lo[tk * 256 + 64 + j], av, al[tk]); }
        }
        for (int j = 0; j < 128; ++j) {
            const float gv = g2[j * RW + n];
#pragma unroll
            for (int tk = 0; tk < 8; ++tk) gl[tk] = fmaf(lo[tk * 256 + 128 + j], gv, gl[tk]);
        }
        const float mur = mu[n], muk = mu[512 + n], muv = mu[1024 + n];
        const float w0n = w0[n], a0n = a0[n], kkn = k_k[n], kan = k_a[n];
#pragma unroll
        for (int tk = 0; tk < 8; ++tk) {
            const int t = t0 + tk; const bool first = (t % SEQ == 0);
            const bf16_t* pr = proj + (size_t)t * NPROJ; const bf16_t* pp = proj + (size_t)(first ? t : t - 1) * NPROJ;
            float r = ldbf(pr + n), k = ldbf(pr + 512 + n), v = ldbf(pr + 1024 + n);
            const float r1 = first ? 0.f : ldbf(pp + n), k1 = first ? 0.f : ldbf(pp + 512 + n), v1 = first ? 0.f : ldbf(pp + 1024 + n);
            r = r + (r1 - r) * mur; k = k + (k1 - k) * muk; v = v + (v1 - v) * muv;
            const float wa = w0n + wl[tk];
            const float logw = -softplusf_(-wa) - 0.5f;
            const float decay = expf(-expf(logw));
            const float iclr = sigmoidf_(a0n + al[tk]);
            float kk = k * kkn;
            const float ss = wave_sum(kk * kk);
            kk = kk / fmaxf(sqrtf(ss), 1e-12f);
            const float kf = k * (1.f + (iclr - 1.f) * kan);
            const size_t o = (size_t)t * RW + n;
            rw_w[o] = decay; rw_r[o] = (bf16_t)f2bf(r); rw_k[o] = (bf16_t)f2bf(kf); rw_v[o] = (bf16_t)f2bf(v); rw_a[o] = (bf16_t)f2bf(-kk); rw_b[o] = (bf16_t)f2bf(kk * iclr); rw_g[o] = (bf16_t)f2bf(gl[tk]);
        }
    }
    const float* ab = (const float*)(c.ws + WS_S5AB); const float* bbp = (const float*)(c.ws + WS_S5BB);
    float* E = (float*)(c.ws + WS_S5E);
    const int gw = c.bid * 8 + c.wid, NW = c.G * 8;
    for (int it = gw; it < BATCH * S5NG * S5NC; it += NW) {
        const int ch = it % S5NC, g = (it / S5NC) % S5NG, b = it / (S5NC * S5NG);
        const int p = c.lane;
        float bbr[16], bbi[16];
#pragma unroll
        for (int q = 0; q < 4; ++q) {
            const float4 v1 = *(const float4*)(bbp + (size_t)(g * 64 + p) * 32 + q * 4), v2 = *(const float4*)(bbp + (size_t)(g * 64 + p) * 32 + 16 + q * 4);
            bbr[q * 4 + 0] = v1.x; bbr[q * 4 + 1] = v1.y; bbr[q * 4 + 2] = v1.z; bbr[q * 4 + 3] = v1.w;
            bbi[q * 4 + 0] = v2.x; bbi[q * 4 + 1] = v2.y; bbi[q * 4 + 2] = v2.z; bbi[q * 4 + 3] = v2.w;
        }
        const float ar = ab[(g * 64 + p) * 2], ai = ab[(g * 64 + p) * 2 + 1];
        float xr = 0.f, xi = 0.f;
        const bf16_t* up = proj + (size_t)(b * SEQ + ch * S5CL) * NPROJ + RPROJ + g * 16;
        for (int s = 0; s < S5CL; ++s) {
            float u[16]; ld_u16(up + (size_t)s * NPROJ, u);
            float br = 0.f, bi = 0.f;
#pragma unroll
            for (int q = 0; q < 16; ++q) { br = fmaf(bbr[q], u[q], br); bi = fmaf(bbi[q], u[q], bi); }
            const float nr = ar * xr - ai * xi + br, ni = ar * xi + ai * xr + bi;
            xr = nr; xi = ni;
        }
        *(float2*)(E + (size_t)it * 128 + p * 2) = make_float2(xr, xi);
    }
}

__device__ __forceinline__ void phase4(const Ctx& c) {
    const float* __restrict__ rw_w = (const float*)(c.ws + WS_RW_W);
    const bf16_t* __restrict__ rw_r = (const bf16_t*)(c.ws + WS_RW_R); const bf16_t* __restrict__ rw_k = (const bf16_t*)(c.ws + WS_RW_K); const bf16_t* __restrict__ rw_v = (const bf16_t*)(c.ws + WS_RW_V);
    const bf16_t* __restrict__ rw_a = (const bf16_t*)(c.ws + WS_RW_A); const bf16_t* __restrict__ rw_b = (const bf16_t*)(c.ws + WS_RW_B);
    float* __restrict__ rw_y = (float*)(c.ws + WS_RW_Y);
    for (int task = c.wid * c.G + c.bid; task < 512 + BATCH * S5NG; task += c.G * 8) {
        if (task < 512) {
            const int bh = task >> 4, rg = task & 15, b = bh >> 3, h = bh & 7;
            const int row = rg * 4 + (c.lane >> 4), kq = c.lane & 15;
            const size_t base = (size_t)(b * SEQ) * RW + h * 64;
            const float* W = rw_w + base + kq * 4; const bf16_t* A = rw_a + base + kq * 4; const bf16_t* Bv = rw_b + base + kq * 4;
            const bf16_t* Kf = rw_k + base + kq * 4; const bf16_t* R = rw_r + base + kq * 4; const bf16_t* V = rw_v + base + row; float* Y = rw_y + base + row;
            float S0 = 0.f, S1 = 0.f, S2 = 0.f, S3 = 0.f;
#pragma unroll 4
            for (int t = 0; t < SEQ; ++t) {
                const size_t o = (size_t)t * RW;
                const float4 w = *(const float4*)(W + o), a = ldbf4(A + o), bb = ldbf4(Bv + o), k = ldbf4(Kf + o), r = ldbf4(R + o);
                const float v = ldbf(V + o);
                float sa = S0 * a.x + S1 * a.y + S2 * a.z + S3 * a.w;
                sa += __shfl_xor(sa, 1); sa += __shfl_xor(sa, 2); sa += __shfl_xor(sa, 4); sa += __shfl_xor(sa, 8);
                S0 = S0 * w.x + sa * bb.x + v * k.x; S1 = S1 * w.y + sa * bb.y + v * k.y;
                S2 = S2 * w.z + sa * bb.z + v * k.z; S3 = S3 * w.w + sa * bb.w + v * k.w;
                float y = S0 * r.x + S1 * r.y + S2 * r.z + S3 * r.w;
                y += __shfl_xor(y, 1); y += __shfl_xor(y, 2); y += __shfl_xor(y, 4); y += __shfl_xor(y, 8);
                if (kq == 0) Y[o] = y;
            }
        } else {
            const int bg = task - 512, g = bg % S5NG, p = c.lane;
            const float* apow = (const float*)(c.ws + WS_S5POW);
            const float* E = (const float*)(c.ws + WS_S5E); float* X0 = (float*)(c.ws + WS_S5X0);
            const float pr = apow[(g * 64 + p) * 2], pi = apow[(g * 64 + p) * 2 + 1];
            float xr = 0.f, xi = 0.f;
            for (int ch = 0; ch < S5NC; ++ch) {
                const size_t o = ((size_t)bg * S5NC + ch) * 128 + p * 2;
                *(float2*)(X0 + o) = make_float2(xr, xi);
                const float2 e = *(const float2*)(E + o);
                const float nr = pr * xr - pi * xi + e.x, ni = pr * xi + pi * xr + e.y;
                xr = nr; xi = ni;
            }
        }
    }
}

__device__ __forceinline__ void phase5(const Ctx& c) {
    const bf16_t* rw_r = (const bf16_t*)(c.ws + WS_RW_R); const bf16_t* rw_k = (const bf16_t*)(c.ws + WS_RW_K);
    const bf16_t* rw_v = (const bf16_t*)(c.ws + WS_RW_V); const bf16_t* rw_g = (const bf16_t*)(c.ws + WS_RW_G);
    const float* rw_y = (const float*)(c.ws + WS_RW_Y);
    const float* r_k = c.in[17]; const float* ln_w = c.in[18]; const float* ln_b = c.in[19];
    bf16_t* ycat = (bf16_t*)(c.ws + WS_A);
    const int gw = c.bid * 8 + c.wid, NW = c.G * 8;
    for (int it = gw; it < T * NH; it += NW) {
        const int t = it >> 3, h = it & 7, hn = h * 64 + c.lane;
        const size_t o = (size_t)t * RW + hn;
        const float y = rw_y[o];
        const float mean = wave_sum(y) * (1.f / 64.f);
        const float d = y - mean;
        const float var = wave_sum(d * d) * (1.f / 64.f);
        const float yn = d * rsqrtf(var + 64e-5f) * ln_w[hn] + ln_b[hn];
        const float v = ldbf(rw_v + o);
        const float bonus = wave_sum(ldbf(rw_r + o) * ldbf(rw_k + o) * r_k[hn]) * v;
        ycat[(size_t)t * D + hn] = (bf16_t)f2bf((yn + bonus) * ldbf(rw_g + o));
    }
    const bf16_t* proj = (const bf16_t*)(c.ws + WS_PROJ);
    const float* ab = (const float*)(c.ws + WS_S5AB); const float* bbp = (const float*)(c.ws + WS_S5BB); const float* X0 = (const float*)(c.ws + WS_S5X0);
    const float* c_re = c.in[25]; const float* c_im = c.in[26]; const float* dd = c.in[27];
    bf16_t* ys5 = (bf16_t*)(c.ws + WS_YS5);
    float* Cm = c.sm + c.wid * (16 * 132 + 4 * 128);
    float* Xs = Cm + 16 * 132;
    for (int it = gw; it < BATCH * S5NG * S5NC; it += NW) {
        const int ch = it % S5NC, g = (it / S5NC) % S5NG, b = it / (S5NC * S5NG);
        const int p = c.lane;
#pragma unroll
        for (int cc = 0; cc < 16; ++cc) { Cm[cc * 132 + p] = c_re[(g * 16 + cc) * 64 + p]; Cm[cc * 132 + 64 + p] = -c_im[(g * 16 + cc) * 64 + p]; }
        float bbr[16], bbi[16];
#pragma unroll
        for (int q = 0; q < 4; ++q) {
            const float4 v1 = *(const float4*)(bbp + (size_t)(g * 64 + p) * 32 + q * 4), v2 = *(const float4*)(bbp + (size_t)(g * 64 + p) * 32 + 16 + q * 4);
            bbr[q * 4 + 0] = v1.x; bbr[q * 4 + 1] = v1.y; bbr[q * 4 + 2] = v1.z; bbr[q * 4 + 3] = v1.w;
            bbi[q * 4 + 0] = v2.x; bbi[q * 4 + 1] = v2.y; bbi[q * 4 + 2] = v2.z; bbi[q * 4 + 3] = v2.w;
        }
        const float ar = ab[(g * 64 + p) * 2], ai = ab[(g * 64 + p) * 2 + 1];
        const float2 x0 = *(const float2*)(X0 + (size_t)it * 128 + p * 2);
        float xr = x0.x, xi = x0.y;
        const int tb = b * SEQ + ch * S5CL;
        const bf16_t* up = proj + (size_t)tb * NPROJ + RPROJ + g * 16;
        const int cc = c.lane & 15, tq = c.lane >> 4;
        const float dv = dd[g * 16 + cc];
        for (int s0 = 0; s0 < S5CL; s0 += 4) {
#pragma unroll
            for (int s1 = 0; s1 < 4; ++s1) {
                const int s = s0 + s1;
                float u[16]; ld_u16(up + (size_t)s * NPROJ, u);
                float br = 0.f, bi = 0.f;
#pragma unroll
                for (int q = 0; q < 16; ++q) { br = fmaf(bbr[q], u[q], br); bi = fmaf(bbi[q], u[q], bi); }
                const float nr = ar * xr - ai * xi + br, ni = ar * xi + ai * xr + bi;
                xr = nr; xi = ni;
                Xs[s1 * 128 + p] = xr; Xs[s1 * 128 + 64 + p] = xi;
            }
            __builtin_amdgcn_wave_barrier();
            asm volatile("s_waitcnt lgkmcnt(0)" ::: "memory");
            float y = 0.f;
#pragma unroll 8
            for (int q = 0; q < 128; q += 4) {
                const float4 cv = *(const float4*)&Cm[cc * 132 + q];
                const float4 xv = *(const float4*)&Xs[tq * 128 + q];
                y = fmaf(cv.x, xv.x, y); y = fmaf(cv.y, xv.y, y); y = fmaf(cv.z, xv.z, y); y = fmaf(cv.w, xv.w, y);
            }
            const int t = tb + s0 + tq;
            const float uu = ldbf(proj + (size_t)t * NPROJ + RPROJ + g * 16 + cc);
            ys5[(size_t)t * 512 + g * 16 + cc] = (bf16_t)f2bf(geluf_(y + dv * uu));
            __builtin_amdgcn_wave_barrier();
            asm volatile("s_waitcnt lgkmcnt(0)" ::: "memory");
        }
    }
}

__device__ __forceinline__ void phase6(const Ctx& c) {
    pg8::Gemm g{(const bf16_t*)(c.ws + WS_YS5), (const bf16_t*)(c.ws + WS_WGLU_T), T, 512, 512};
    pg8::StaticOrder S; S.init(T, 512, c.G, c.bid);
    pg8::EpiGLU E{(const bf16_t*)(c.ws + WS_YS5), 512, c.in[29], (bf16_t*)(c.ws + WS_A), D, 512};
    pg8::gemm_phase<pg8::EpiGLU, pg8::StaticOrder, true, true>(c.lds, g, S, E);
}

__device__ __forceinline__ void phase7(const Ctx& c) {
    pg8::Gemm g{(const bf16_t*)(c.ws + WS_A), (const bf16_t*)(c.ws + WS_WOUT_T), T, D, D};
    pg8::StaticOrder S; S.init(T, D, c.G, c.bid);
    pg8::EpiF32 E{(float*)(c.ws + WS_PROJ), D};
    pg8::gemm_phase<pg8::EpiF32, pg8::StaticOrder, true, true>(c.lds, g, S, E);
}

__device__ __forceinline__ void phase8(const Ctx& c) {
    const float* x = c.in[0]; const float* gpm = c.in[5]; const float* gpf = c.in[6];
    const float* mods = (const float*)(c.ws + WS_MODS); const float* mixed = (const float*)(c.ws + WS_PROJ);
    bf16_t* h2 = (bf16_t*)(c.ws + WS_A); float* x1o = c.out;
    const int gw = c.bid * 8 + c.wid, NW = c.G * 8;
    for (int t = gw; t < T; t += NW) {
        const int b = t / SEQ;
        const float4* mr = (const float4*)(mixed + (size_t)t * D) + c.lane;
        const float4* xr = (const float4*)(x + (size_t)t * D) + c.lane;
        float4 m[4], v[4]; float ss = 0.f;
#pragma unroll
        for (int j = 0; j < 4; ++j) { m[j] = mr[64 * j]; v[j] = xr[64 * j]; ss += m[j].x * m[j].x + m[j].y * m[j].y + m[j].z * m[j].z + m[j].w * m[j].w; }
        const float rstd = rsqrtf(wave_sum(ss) * (1.0f / D) + 1e-6f);
        float s1 = 0.f;
#pragma unroll
        for (int j = 0; j < 4; ++j) {
            const int k = (c.lane + 64 * j) * 4;
            const float4 gg = *(const float4*)(gpm + k);
            const float4 gt = *(const float4*)(mods + b * NMODS + 2 * D + k);
            v[j].x += gt.x * (m[j].x * rstd * gg.x); v[j].y += gt.y * (m[j].y * rstd * gg.y);
            v[j].z += gt.z * (m[j].z * rstd * gg.z); v[j].w += gt.w * (m[j].w * rstd * gg.w);
            s1 += v[j].x * v[j].x + v[j].y * v[j].y + v[j].z * v[j].z + v[j].w * v[j].w;
            ((float4*)(x1o + (size_t)t * D) + c.lane)[64 * j] = v[j];
        }
        const float rstd1 = rsqrtf(wave_sum(s1) * (1.0f / D) + 1e-6f);
#pragma unroll
        for (int j = 0; j < 4; ++j) {
            const int k = (c.lane + 64 * j) * 4;
            const float4 gg = *(const float4*)(gpf + k);
            const float4 sh = *(const float4*)(mods + b * NMODS + 3 * D + k);
            const float4 sc = *(const float4*)(mods + b * NMODS + 4 * D + k);
            float r[4];
            r[0] = v[j].x * rstd1 * gg.x * (1.f + sc.x) + sh.x; r[1] = v[j].y * rstd1 * gg.y * (1.f + sc.y) + sh.y;
            r[2] = v[j].z * rstd1 * gg.z * (1.f + sc.z) + sh.z; r[3] = v[j].w * rstd1 * gg.w * (1.f + sc.w) + sh.w;
            unsigned hi[4]; float lo[4];
#pragma unroll
            for (int q = 0; q < 4; ++q) { hi[q] = f2bf(r[q]); lo[q] = r[q] - bf2f(hi[q]); }
            ((uint2*)(h2 + (size_t)t * D) + c.lane)[64 * j] = make_uint2(hi[0] | (hi[1] << 16), hi[2] | (hi[3] << 16));
            ((uint2*)(h2 + (size_t)(T + t) * D) + c.lane)[64 * j] = make_uint2(pk2(lo[0], lo[1]), pk2(lo[2], lo[3]));
        }
    }
}

__device__ __forceinline__ void phase9(const Ctx& c) {
    {
        pg8::Gemm g{(const bf16_t*)(c.ws + WS_A), (const bf16_t*)(c.ws + WS_WR_T), 2 * T, 512, D};
        pg8::StaticOrder S; S.init(2 * T, 512, c.G, c.bid);
        pg8::EpiF32 E{(float*)(c.ws + WS_PLOG), 512};
        pg8::gemm_phase<pg8::EpiF32, pg8::StaticOrder, true, true>(c.lds, g, S, E);
    }
    __syncthreads();
    {
        pg8::Gemm g{(const bf16_t*)(c.ws + WS_A), (const bf16_t*)(c.ws + WS_WSGU_T), T, 512, D};
        pg8::StaticOrder S; S.init(T, 512, c.G, c.bid);
        pg8::EpiSwiGLU E{(bf16_t*)(c.ws + WS_HS), 256};
        pg8::gemm_phase<pg8::EpiSwiGLU, pg8::StaticOrder, true, true>(c.lds, g, S, E);
    }
}

__device__ __forceinline__ void phase10(const Ctx& c) {
    const float* plog = (const float*)(c.ws + WS_PLOG); const float* rb = c.in[32];
    int* idx = (int*)(c.ws + WS_IDX); float* wt = (float*)(c.ws + WS_WT); unsigned* counts = (unsigned*)(c.ws + WS_COUNTS);
    const int gw = c.bid * 8 + c.wid, NW = c.G * 8, l = c.lane;
    const float4 bias = *(const float4*)(rb + l * 4);
    for (int t = gw; t < T; t += NW) {
        const float4 p0 = *(const float4*)(plog + (size_t)t * 512 + l * 4), p1 = *(const float4*)(plog + (size_t)t * 512 + 256 + l * 4);
        const float4 p2 = *(const float4*)(plog + (size_t)(T + t) * 512 + l * 4), p3 = *(const float4*)(plog + (size_t)(T + t) * 512 + 256 + l * 4);
        const float lg[4] = {p0.x + (p1.x + p2.x + p3.x), p0.y + (p1.y + p2.y + p3.y), p0.z + (p1.z + p2.z + p3.z), p0.w + (p1.w + p2.w + p3.w)};
        float s[4] = {sigmoidf_(lg[0]), sigmoidf_(lg[1]), sigmoidf_(lg[2]), sigmoidf_(lg[3])};
        float ch[4] = {s[0] + bias.x, s[1] + bias.y, s[2] + bias.z, s[3] + bias.w};
        float a1 = fmaxf(ch[0], ch[1]), a2 = fminf(ch[0], ch[1]);
        { const float b1 = fmaxf(ch[2], ch[3]), b2 = fminf(ch[2], ch[3]); const float n1 = fmaxf(a1, b1), n2 = fmaxf(fminf(a1, b1), fmaxf(a2, b2)); a1 = n1; a2 = n2; }
#pragma unroll
        for (int o = 1; o < 8; o <<= 1) { const float b1 = __shfl_xor(a1, o), b2 = __shfl_xor(a2, o); const float n1 = fmaxf(a1, b1), n2 = fmaxf(fminf(a1, b1), fmaxf(a2, b2)); a1 = n1; a2 = n2; }
        const float gs = a1 + a2; const int myg = l >> 3;
        int rank = 0;
#pragma unroll
        for (int g = 0; g < 8; ++g) { const float og = __shfl(gs, g * 8); rank += (og > gs || (og == gs && g < myg)) ? 1 : 0; }
        const bool sel = rank < 4;
        float mc[4];
#pragma unroll
        for (int i = 0; i < 4; ++i) mc[i] = sel ? ch[i] : -INFINITY;
        float sk[8]; int ek[8]; float ssum = 0.f;
#pragma unroll
        for (int k = 0; k < 8; ++k) {
            float bv = mc[0]; int be = l * 4;
#pragma unroll
            for (int i = 1; i < 4; ++i) if (mc[i] > bv) { bv = mc[i]; be = l * 4 + i; }
#pragma unroll
            for (int o = 1; o < 64; o <<= 1) { const float ov = __shfl_xor(bv, o); const int oe = __shfl_xor(be, o); if (ov > bv || (ov == bv && oe < be)) { bv = ov; be = oe; } }
            const int ii = be & 3;
            float sv = s[0]; sv = (ii == 1) ? s[1] : sv; sv = (ii == 2) ? s[2] : sv; sv = (ii == 3) ? s[3] : sv;
            sv = __shfl(sv, be >> 2);
            if ((be >> 2) == l) {
#pragma unroll
                for (int i = 0; i < 4; ++i) if (i == ii) mc[i] = -INFINITY;
            }
            sk[k] = sv; ek[k] = be; ssum += sv;
        }
        if (l == 0) {
            const float inv = 2.5f / ssum;
#pragma unroll
            for (int k = 0; k < 8; ++k) { idx[t * 8 + k] = ek[k]; wt[t * 8 + k] = sk[k] * inv; atomicAdd(&counts[ek[k]], 1u); }
        }
    }
}

__device__ __forceinline__ void build_ustart(const Ctx& c, int* smi) {
    const unsigned* counts = (const unsigned*)(c.ws + WS_COUNTS);
    __syncthreads();
    if (c.tid == 0) {
        int u = 0;
        for (int e = 0; e < NE; ++e) { smi[e] = u; u += ((int)counts[e] + 255) >> 8; }
        smi[NE] = u;
    }
    __syncthreads();
}

__device__ __forceinline__ void phase11(const Ctx& c) {
    int* smi = (int*)c.sm;
    build_ustart(c, smi);
    const int* idx = (const int*)(c.ws + WS_IDX); int* slotp = (int*)(c.ws + WS_SLOTP); int* uexp = (int*)(c.ws + WS_UEXP);
    unsigned* cursor = (unsigned*)(c.ws + WS_COUNTS) + 256; const unsigned* counts = (const unsigned*)(c.ws + WS_COUNTS);
    const int gt = c.bid * 512 + c.tid, NT = c.G * 512;
    for (int a = gt; a < T * 8; a += NT) {
        const int e = idx[a];
        const unsigned pos = atomicAdd(&cursor[e], 1u);
        slotp[smi[e] * 256 + (int)pos] = a;
    }
    for (int e = gt; e < NE; e += NT) {
        const int u0 = smi[e], u1 = smi[e + 1], cn = (int)counts[e];
        for (int p = cn; p < (u1 - u0) * 256; ++p) slotp[u0 * 256 + p] = -1;
        for (int u = u0; u < u1; ++u) uexp[u] = e;
    }
    if (gt == 0) uexp[2048] = smi[NE];
}

__device__ __forceinline__ void phase12(const Ctx& c) {
    const int* uexp = (const int*)(c.ws + WS_UEXP);
    const int NU = __builtin_amdgcn_readfirstlane(uexp[2048]);
    const int vcu = (c.G % 8 == 0) ? (c.bid % 8) * (c.G / 8) + c.bid / 8 : c.bid;
    pg8::Gemm g{(const bf16_t*)(c.ws + WS_A), (const bf16_t*)(c.ws + WS_WEGU), 0, 0, D, (const int*)(c.ws + WS_SLOTP)};
    pg8::ExpertOrder S{uexp, NU, 2, c.G, vcu};
    pg8::EpiSwiGLU E{(bf16_t*)(c.ws + WS_HID), 256};
    pg8::gemm_phase<pg8::EpiSwiGLU, pg8::ExpertOrder, true, true, true>(c.lds, g, S, E);
}

__device__ __forceinline__ void phase13(const Ctx& c) {
    {
        const int* uexp = (const int*)(c.ws + WS_UEXP);
        const int NU = __builtin_amdgcn_readfirstlane(uexp[2048]);
        const int vcu = (c.G % 8 == 0) ? (c.bid % 8) * (c.G / 8) + c.bid / 8 : c.bid;
        pg8::Gemm g{(const bf16_t*)(c.ws + WS_HID), (const bf16_t*)(c.ws + WS_WED), 0, 0, EFF};
        pg8::ExpertOrder S{uexp, NU, 4, c.G, vcu};
        pg8::EpiScatter E{(const int*)(c.ws + WS_SLOTP), (const float*)(c.ws + WS_WT), (bf16_t*)(c.ws + WS_YEXP), D};
        pg8::gemm_phase<pg8::EpiScatter, pg8::ExpertOrder, true, true>(c.lds, g, S, E);
    }
    __syncthreads();
    {
        pg8::Gemm g{(const bf16_t*)(c.ws + WS_HS), (const bf16_t*)(c.ws + WS_WSD_T), T, D, 256};
        pg8::StaticOrder S; S.init(T, D, c.G, c.bid);
        pg8::EpiF32 E{(float*)(c.ws + WS_SHOUT), D};
        pg8::gemm_phase<pg8::EpiF32, pg8::StaticOrder, true, true>(c.lds, g, S, E);
    }
}

__device__ __forceinline__ void phase14(const Ctx& c) {
    const float* gq = c.in[7]; const float* mods = (const float*)(c.ws + WS_MODS);
    const float* shout = (const float*)(c.ws + WS_SHOUT); const bf16_t* yexp = (const bf16_t*)(c.ws + WS_YEXP);
    float* out = c.out;
    const int gw = c.bid * 8 + c.wid, NW = c.G * 8;
    for (int t = gw; t < T; t += NW) {
        const int b = t / SEQ;
        float4 y[4]; float ss = 0.f;
#pragma unroll
        for (int j = 0; j < 4; ++j) {
            const int k = (c.lane + 64 * j) * 4;
            float4 a = *(const float4*)(shout + (size_t)t * D + k);
#pragma unroll
            for (int q = 0; q < 8; ++q) {
                const float4 v = ldbf4(yexp + (size_t)(t * 8 + q) * D + k);
                a.x += v.x; a.y += v.y; a.z += v.z; a.w += v.w;
            }
            y[j] = a; ss += a.x * a.x + a.y * a.y + a.z * a.z + a.w * a.w;
        }
        const float rstd = rsqrtf(wave_sum(ss) * (1.0f / D) + 1e-6f);
#pragma unroll
        for (int j = 0; j < 4; ++j) {
            const int k = (c.lane + 64 * j) * 4;
            const float4 gg = *(const float4*)(gq + k);
            const float4 gt = *(const float4*)(mods + b * NMODS + 5 * D + k);
            float4 x1 = *(const float4*)(out + (size_t)t * D + k);
            x1.x += gt.x * (y[j].x * rstd * gg.x); x1.y += gt.y * (y[j].y * rstd * gg.y);
            x1.z += gt.z * (y[j].z * rstd * gg.z); x1.w += gt.w * (y[j].w * rstd * gg.w);
            *(float4*)(out + (size_t)t * D + k) = x1;
        }
    }
}

constexpr int NPHASES = 15;

__global__ void __launch_bounds__(512, 2) mega(Args args) {
    extern __shared__ __attribute__((aligned(16))) unsigned char lds_raw[];
    Ctx c;
    c.in = args.in; c.out = args.out; c.ws = args.ws;
    c.lds = (LAS unsigned char*)lds_raw; c.sm = (float*)lds_raw;
    c.tid = threadIdx.x; c.lane = c.tid & 63; c.wid = __builtin_amdgcn_readfirstlane(c.tid >> 6); c.bid = blockIdx.x; c.G = gridDim.x;
    volatile LAS unsigned* st = (volatile LAS unsigned*)(c.lds + LDS_CTL_OFF);
    if (c.tid < 4) st[c.tid] = 0u;
    __syncthreads();
    XcdBarrier bar; bar.bar = (unsigned*)(args.ws + WS_CTL); bar.x = 0; bar.st = st;
    const bool multi = (args.hi - args.lo) > 1;
    if (multi) bar = xcd_barrier_post((unsigned*)(args.ws + WS_CTL), st);
    const int lo = args.lo, hi = args.hi;
#define RUN_PHASE(k, call) if (lo <= (k) && (k) < hi) { call; if ((k) + 1 < hi) xcd_barrier(bar); }
    RUN_PHASE(0, phase0(c))
    RUN_PHASE(1, phase1(c))
    RUN_PHASE(2, phase2(c))
    RUN_PHASE(3, phase3(c))
    RUN_PHASE(4, phase4(c))
    RUN_PHASE(5, phase5(c))
    RUN_PHASE(6, phase6(c))
    RUN_PHASE(7, phase7(c))
    RUN_PHASE(8, phase8(c))
    RUN_PHASE(9, phase9(c))
    RUN_PHASE(10, phase10(c))
    RUN_PHASE(11, phase11(c))
    RUN_PHASE(12, phase12(c))
    RUN_PHASE(13, phase13(c))
    RUN_PHASE(14, phase14(c))
#undef RUN_PHASE
}

#ifndef N_LAUNCH_MODE
#define N_LAUNCH_MODE 1
#endif

extern "C" void kernel_launch(void* const* d_in, const int* in_sizes, int n_in, void* d_out, int out_size, void* d_ws, size_t ws_size, hipStream_t stream) {
    static int grid = 0;
    if (grid == 0) {
        if (n_in != 39 || out_size != T * D || ws_size < WS_END) { fprintf(stderr, "kernel_launch: unexpected shapes n_in %d out %d ws %zu\n", n_in, out_size, ws_size); grid = -1; return; }
        int dev = 0, cus = 0, per_cu = 0;
        if (hipGetDevice(&dev) != hipSuccess || hipDeviceGetAttribute(&cus, hipDeviceAttributeMultiprocessorCount, dev) != hipSuccess) { grid = -1; return; }
        if (hipFuncSetAttribute((const void*)mega, hipFuncAttributeMaxDynamicSharedMemorySize, LDS_BYTES) != hipSuccess) { grid = -1; return; }
        if (hipOccupancyMaxActiveBlocksPerMultiprocessor(&per_cu, (const void*)mega, 512, LDS_BYTES) != hipSuccess || per_cu < 1) { fprintf(stderr, "kernel_launch: occupancy query says %d\n", per_cu); }
        (void)hipGetLastError();
        grid = cus;
    }
    if (grid < 0) return;
    (void)hipMemsetAsync((char*)d_ws + WS_CTL, 0, CTL_BYTES, stream);
    Args a{};
    for (int i = 0; i < 39; ++i) a.in[i] = (const float*)d_in[i];
    a.out = (float*)d_out; a.ws = (unsigned char*)d_ws;
    if (N_LAUNCH_MODE == 1) {
        a.lo = 0; a.hi = NPHASES;
        hipLaunchKernelGGL(mega, dim3(grid), dim3(512), LDS_BYTES, stream, a);
    } else {
        for (int ph = 0; ph < NPHASES; ++ph) {
            a.lo = ph; a.hi = ph + 1;
            hipLaunchKernelGGL(mega, dim3(grid), dim3(512), LDS_BYTES, stream, a);
        }
    }
}
```

```cpp
#include <hip/hip_runtime.h>
#include <cstdint>
#include <cstdio>

#define LAS __attribute__((address_space(3)))

constexpr int D = 1024, BATCH = 4, SEQ = 8192, T = BATCH * SEQ;
constexpr int RW = 512, NH = 8;
constexpr int RPROJ = 1792, NPROJ = 2304;
constexpr int S5NG = 32, S5P = 64;
constexpr int NE = 256, EFF = 256;
constexpr int NMODS = 6 * D;
constexpr int S5CL = 128, S5NC = SEQ / S5CL;

constexpr size_t MiB = 1u << 20;
constexpr size_t WS_CTL = 0, CTL_BYTES = 1 * MiB;
constexpr size_t WS_COUNTS = 64 * 1024;
constexpr size_t WS_MODS = 1 * MiB;
constexpr size_t WS_S5AB = 1 * MiB + 128 * 1024;
constexpr size_t WS_S5POW = 1 * MiB + 160 * 1024;
constexpr size_t WS_S5BB = 1 * MiB + 256 * 1024;
constexpr size_t WS_S5E = 2 * MiB;
constexpr size_t WS_S5X0 = 6 * MiB;
constexpr size_t WS_WIN_T = 10 * MiB;
constexpr size_t WS_WOUT_T = 15 * MiB;
constexpr size_t WS_WGLU_T = 17 * MiB;
constexpr size_t WS_WSGU_T = 18 * MiB;
constexpr size_t WS_WSD_T = 19 * MiB;
constexpr size_t WS_WR_T = 20 * MiB;
constexpr size_t WS_WED = 24 * MiB;
constexpr size_t WS_WEGU = 152 * MiB;
constexpr size_t WS_A = 408 * MiB;
constexpr size_t WS_YS5 = WS_A + 64 * MiB;
constexpr size_t WS_PROJ = 536 * MiB;
constexpr size_t WS_RW = 680 * MiB;
constexpr size_t RWSZ = (size_t)T * RW * 4;
constexpr size_t RWSZH = (size_t)T * RW * 2;
constexpr size_t WS_RW_W = WS_RW, WS_RW_Y = WS_RW + RWSZ, WS_RW_R = WS_RW + 2 * RWSZ, WS_RW_K = WS_RW_R + RWSZH, WS_RW_V = WS_RW_K + RWSZH,
                 WS_RW_A = WS_RW_V + RWSZH, WS_RW_B = WS_RW_A + RWSZH, WS_RW_G = WS_RW_B + RWSZH;
constexpr size_t WS_PLOG = 680 * MiB;
constexpr size_t WS_SHOUT = 680 * MiB;
constexpr size_t WS_HS = 808 * MiB;
constexpr size_t WS_IDX = 824 * MiB;
constexpr size_t WS_WT = 825 * MiB;
constexpr size_t WS_SLOTP = 826 * MiB;
constexpr size_t WS_UEXP = 827 * MiB + 512 * 1024;
constexpr size_t WS_HID = 840 * MiB;
constexpr size_t WS_YEXP = 152 * MiB;
constexpr size_t WS_END = 1000 * MiB;

constexpr int LDS_BYTES = 132096;
constexpr int LDS_CTL_OFF = 131072;

#define XB_TMO      128
#define XB_XCNT(j)  (256  + 64 * (j))
#define XB_XSUB(j)  (1280 + 64 * (j))
#define XB_XGEN(j)  (2304 + 64 * (j))
#define XB_TOP      3328
#define XB_TOPGEN   3392
#define XCD_BAR_WORDS 3456
#define XB_SPIN_CAP (1u << 24)

__device__ __forceinline__ unsigned xb_ld(unsigned* p)              { return __hip_atomic_load(p, __ATOMIC_RELAXED, __HIP_MEMORY_SCOPE_AGENT); }
__device__ __forceinline__ unsigned xb_add(unsigned* p, unsigned v) { return __hip_atomic_fetch_add(p, v, __ATOMIC_RELAXED, __HIP_MEMORY_SCOPE_AGENT); }
__device__ __forceinline__ unsigned xb_xcc_id() { return (unsigned)__builtin_amdgcn_s_getreg((3 << 11) | 20) & 0xFu; }
#define XB_SPIN(cond, bar) do { unsigned _sp = 0; while (cond) { __builtin_amdgcn_s_sleep(1); \
    if ((++_sp & 255u) == 0u) { if (xb_ld(&(bar)[XB_TMO])) break; if (_sp > XB_SPIN_CAP) { atomicAdd(&(bar)[XB_TMO], 1u); break; } } } } while (0)

struct XcdBarrier { unsigned* bar; unsigned x; volatile LAS unsigned* st; };

__device__ __forceinline__ XcdBarrier xcd_barrier_post(unsigned* bar, volatile LAS unsigned* st) {
    XcdBarrier b; b.bar = bar; b.x = xb_xcc_id(); b.st = st;
    if (threadIdx.x == 0) (void)xb_add(&bar[XB_XCNT(b.x)], 1u);
    return b;
}
__device__ __forceinline__ void xcd_barrier_complete(unsigned* bar, unsigned x, unsigned& nloc, unsigned& nx) {
    const unsigned G = gridDim.x * gridDim.y * gridDim.z;
    unsigned sum, cnt, mine, sp = 0u;
    for (;;) {
        sum = 0u; cnt = 0u; mine = 0u;
#pragma unroll
        for (unsigned j = 0; j < 16; ++j) { const unsigned c = xb_ld(&bar[XB_XCNT(j)]); sum += c; cnt += (c > 0u) ? 1u : 0u; mine = (j == x) ? c : mine; }
        if (sum == G) break;
        __builtin_amdgcn_s_sleep(1);
        if ((++sp & 255u) == 0u) { if (xb_ld(&bar[XB_TMO])) break; if (sp > XB_SPIN_CAP) { atomicAdd(&bar[XB_TMO], 1u); break; } }
    }
    nloc = mine > 0u ? mine : 1u; nx = cnt > 0u ? cnt : 1u;
}
__device__ __forceinline__ void xcd_barrier(const XcdBarrier& b) {
    asm volatile("s_waitcnt vmcnt(0)" ::: "memory");
    __syncthreads();
    if (threadIdx.x == 0) {
        unsigned* bar = b.bar;
        __builtin_amdgcn_s_waitcnt(0);
        unsigned nloc = b.st[0], nx = b.st[1];
        if (nloc == 0u) { xcd_barrier_complete(bar, b.x, nloc, nx); b.st[0] = nloc; b.st[1] = nx; }
        const unsigned old = xb_add(&bar[XB_XSUB(b.x)], 1u);
        const unsigned gen = old / nloc;
        if (old + 1u == (gen + 1u) * nloc) {
            __builtin_amdgcn_fence(__ATOMIC_RELEASE, "agent");
            asm volatile("s_waitcnt vmcnt(0)" ::: "memory");
            const unsigned og = xb_add(&bar[XB_TOP], 1u);
            const unsigned tg = og / nx;
            if (og + 1u == (tg + 1u) * nx) xb_add(&bar[XB_TOPGEN], 1u);
            else XB_SPIN(xb_ld(&bar[XB_TOPGEN]) == tg, bar);
            __builtin_amdgcn_fence(__ATOMIC_ACQUIRE, "agent");
            xb_add(&bar[XB_XGEN(b.x)], 1u);
            asm volatile("s_waitcnt vmcnt(0)" ::: "memory");
        } else {
            XB_SPIN(xb_ld(&bar[XB_XGEN(b.x)]) == gen, bar);
            __builtin_amdgcn_fence(__ATOMIC_ACQUIRE, "agent");
            asm volatile("s_waitcnt vmcnt(0)" ::: "memory");
        }
    }
    __syncthreads();
}

namespace pg8 {
#define PG8_LAS __attribute__((address_space(3)))
typedef unsigned short bf16_t;
typedef short bf16x8 __attribute__((ext_vector_type(8)));
typedef float f32x4 __attribute__((ext_vector_type(4)));
typedef unsigned u32x4 __attribute__((ext_vector_type(4)));
constexpr int BM = 256, BK = 64, HALF = 128, HTB = HALF * BK * 2  , STAGE_BYTES = 8 * HTB, NXCD = 8, WGM = 8;

__host__ __device__ __forceinline__ int lds_byte(int r, int c) { const int st = (r >> 4) * 2 + (c >> 5), rr = r & 15, cc = c & 31, ob = rr * 64 + cc * 2; return st * 1024 + (ob ^ (((ob >> 9) & 1) << 5)); }
__host__ __device__ __forceinline__ void stage_rc(int b, int& R, int& C) { const int st = b / 1024, sb = b % 1024, swz = sb ^ (((sb >> 9) & 1) << 5); R = (st >> 1) * 16 + swz / 64; C = (st & 1) * 32 + (swz % 64) / 2; }
__host__ __device__ __forceinline__ int perm32(int rho) { const int n = rho >> 4, i = rho & 15; return 8 * (i >> 2) + 4 * n + (i & 3); }

struct Unit { int pm, pn; };
struct Gemm { const bf16_t* A; const bf16_t* Bt; int M, N, K; const int* rowtab = nullptr; };

struct StaticOrder {
    int nM, nN, nwg, G, c;
    __host__ __device__ void init(int M, int N, int G_, int c_) { nM = M / BM; nN = N / BM; nwg = nM * nN; G = G_; c = c_; }
    __host__ __device__ bool next(int i, Unit& u) const {
        const long L = (long)i * G + c; if (L >= nwg) return false;
        int wgid = (int)L; { const int q = nwg / NXCD, r = nwg % NXCD, xcd = wgid % NXCD, off = wgid / NXCD; wgid = (xcd < r ? xcd * (q + 1) : r * (q + 1) + (xcd - r) * q) + off; }
        const int nig = WGM * nN, gid = wgid / nig, fm = gid * WGM, gsz = (nM - fm) < WGM ? (nM - fm) : WGM;
        u.pm = fm + ((wgid % nig) % gsz); u.pn = (wgid % nig) / gsz; return true;
    }
    __device__ __forceinline__ void a_ready(const Unit&) const {}
    __device__ __forceinline__ void done(const Unit&) const {}
};

__device__ __forceinline__ unsigned cvt_pk_bf16(float lo, float hi) { unsigned r; asm volatile("v_cvt_pk_bf16_f32 %0, %1, %2" : "=v"(r) : "v"(lo), "v"(hi)); return r; }
typedef float f32x2 __attribute__((ext_vector_type(2)));
__device__ __forceinline__ f32x2 gelu_pk(f32x2 v) {
    const f32x2 av = __builtin_elementwise_abs(v), d = av * 0.2316418882f + 1.0f;
    f32x2 t; t.x = __builtin_amdgcn_rcpf(d.x); t.y = __builtin_amdgcn_rcpf(d.y);
    f32x2 q = t * 0.5307027145f + (-0.7265760135f); q = q * t + 0.7107068705f; q = q * t + (-0.142248368f); q = q * t + 0.127414796f; q = q * t;
    const f32x2 s = (v * v) * (-0.72134752044f);
    f32x2 e; e.x = __builtin_amdgcn_exp2f(s.x); e.y = __builtin_amdgcn_exp2f(s.y);
    const f32x2 m = v * (q * e), r = v - m;
    f32x2 o; o.x = v.x < 0.f ? m.x : r.x; o.y = v.y < 0.f ? m.y : r.y; return o;
}

template <int ACT  > struct EpiBf16 {
    static constexpr bool PERM = true, AFTER_DRAIN = false; static_assert(ACT == 0 || ACT == 1, "EpiBf16: ACT is 0 (none) or 1 (gelu_pk)");
    bf16_t* O; int ldc; const float* bias; int split_cols; size_t split_stride; float scale0;
    __device__ __forceinline__ void operator()(const f32x4 (&acc)[2][2][4][2], const Unit& u, int wr, int wc, int fr, int fq) const {
        const int row0 = u.pm * BM + wr * 64 + fr; int colt = u.pn * BM; bf16_t* base = O;
        float sc = 1.f; if (split_cols) { const int t = colt / split_cols; base += (size_t)t * split_stride; colt -= t * split_cols; if (t == 0) sc = scale0; }
        const int col0 = colt + wc * 32 + 8 * fq, bcol0 = u.pn * BM + wc * 32 + 8 * fq;
        f32x4 bv[2][2];
#pragma unroll
        for (int bj = 0; bj < 2; ++bj)
#pragma unroll
            for (int n = 0; n < 2; ++n) bv[bj][n] = bias ? *(const f32x4*)(bias + bcol0 + bj * HALF + 4 * n) : (f32x4){0.f, 0.f, 0.f, 0.f};
#pragma unroll
        for (int ai = 0; ai < 2; ++ai)
#pragma unroll
            for (int m = 0; m < 4; ++m) { bf16_t* rowp = base + (size_t)(row0 + ai * HALF + m * 16) * ldc + col0;
#pragma unroll
                for (int bj = 0; bj < 2; ++bj) { f32x4 v0 = acc[ai][bj][m][0] + bv[bj][0], v1 = acc[ai][bj][m][1] + bv[bj][1];
                    if (ACT == 1) { f32x2 a = gelu_pk((f32x2){v0[0], v0[1]}), b = gelu_pk((f32x2){v0[2], v0[3]}), c = gelu_pk((f32x2){v1[0], v1[1]}), d = gelu_pk((f32x2){v1[2], v1[3]});
                        v0 = (f32x4){a.x, a.y, b.x, b.y}; v1 = (f32x4){c.x, c.y, d.x, d.y}; }
                    v0 = v0 * sc; v1 = v1 * sc; u32x4 w; w.x = cvt_pk_bf16(v0[0], v0[1]); w.y = cvt_pk_bf16(v0[2], v0[3]); w.z = cvt_pk_bf16(v1[0], v1[1]); w.w = cvt_pk_bf16(v1[2], v1[3]);
                    *(u32x4*)(rowp + bj * HALF) = w; } }
    }
};

struct EpiF32 {
    static constexpr bool PERM = false, AFTER_DRAIN = false;
    float* C; int ldc;
    __device__ __forceinline__ void operator()(const f32x4 (&acc)[2][2][4][2], const Unit& u, int wr, int wc, int fr, int fq) const {
        const int row0 = u.pm * BM + wr * 64 + fr, col0 = u.pn * BM + wc * 32 + 4 * fq;
#pragma unroll
        for (int ai = 0; ai < 2; ++ai)
#pragma unroll
            for (int m = 0; m < 4; ++m) { float* rowp = C + (size_t)(row0 + ai * HALF + m * 16) * ldc + col0;
#pragma unroll
                for (int bj = 0; bj < 2; ++bj)
#pragma unroll
                    for (int n = 0; n < 2; ++n) *(f32x4*)(rowp + bj * HALF + n * 16) = acc[ai][bj][m][n]; }
    }
};
__device__ __forceinline__ float fast_sigmoid(float x) { return __builtin_amdgcn_rcpf(1.0f + __builtin_amdgcn_exp2f(-1.4426950408889634f * x)); }
struct EpiSwiGLU {
    static constexpr bool PERM = true, AFTER_DRAIN = false;
    bf16_t* O; int ldo;
    __device__ __forceinline__ void operator()(const f32x4 (&acc)[2][2][4][2], const Unit& u, int wr, int wc, int fr, int fq) const {
        const int row0 = u.pm * BM + wr * 64 + fr, col0 = (u.pn & 1) * HALF + wc * 32 + 8 * fq;
#pragma unroll
        for (int ai = 0; ai < 2; ++ai)
#pragma unroll
            for (int m = 0; m < 4; ++m) {
                bf16_t* rowp = O + (size_t)(row0 + ai * HALF + m * 16) * ldo + col0;
                const f32x4 g0 = acc[ai][0][m][0], g1 = acc[ai][0][m][1], u0 = acc[ai][1][m][0], u1 = acc[ai][1][m][1];
                float r[8];
#pragma unroll
                for (int i = 0; i < 4; ++i) { r[i] = g0[i] * fast_sigmoid(g0[i]) * u0[i]; r[4 + i] = g1[i] * fast_sigmoid(g1[i]) * u1[i]; }
                u32x4 w; w.x = cvt_pk_bf16(r[0], r[1]); w.y = cvt_pk_bf16(r[2], r[3]); w.z = cvt_pk_bf16(r[4], r[5]); w.w = cvt_pk_bf16(r[6], r[7]);
                *(u32x4*)rowp = w;
            }
    }
};
struct EpiScatter {
    static constexpr bool PERM = true, AFTER_DRAIN = false;
    const int* slotp; const float* wt; bf16_t* Y; int ldy;
    __device__ __forceinline__ void operator()(const f32x4 (&acc)[2][2][4][2], const Unit& u, int wr, int wc, int fr, int fq) const {
        int t2 = threadIdx.x; asm volatile("" : "+v"(t2));
        const int fr2 = t2 & 15, fq2 = (t2 >> 4) & 3, wc2 = (t2 >> 6) & 3, wr2 = (t2 >> 8) & 1;
        const int col0 = (u.pn & 3) * BM + wc2 * 32 + 8 * fq2;
        const int rbase = u.pm * BM + wr2 * 64 + fr2;
#pragma unroll
        for (int ai = 0; ai < 2; ++ai)
#pragma unroll
            for (int m = 0; m < 4; ++m) {
                const int aid = slotp[rbase + ai * HALF + m * 16];
                if (aid >= 0) {
                    const float w = wt[aid];
                    bf16_t* rowp = Y + (size_t)aid * ldy + col0;
#pragma unroll
                    for (int bj = 0; bj < 2; ++bj) {
                        const f32x4 v0 = acc[ai][bj][m][0] * w, v1 = acc[ai][bj][m][1] * w;
                        u32x4 o; o.x = cvt_pk_bf16(v0[0], v0[1]); o.y = cvt_pk_bf16(v0[2], v0[3]); o.z = cvt_pk_bf16(v1[0], v1[1]); o.w = cvt_pk_bf16(v1[2], v1[3]);
                        *(u32x4*)(rowp + bj * HALF) = o;
                    }
                }
            }
    }
};
struct ExpertOrder {
    const int* uexp; int NU, npn, G, c;
    __device__ __forceinline__ bool next(int i, Unit& u) const {
        const int L = i * G + c; if (L >= NU * npn) return false;
        const int uu = L / npn, pl = L % npn;
        u.pm = uu; u.pn = __builtin_amdgcn_readfirstlane(uexp[uu]) * npn + pl; return true;
    }
    __device__ __forceinline__ void a_ready(const Unit&) const {}
    __device__ __forceinline__ void done(const Unit&) const {}
};
struct EpiGLU {
    static constexpr bool PERM = true, AFTER_DRAIN = false;
    const bf16_t* Y; int ldy; const float* bias; bf16_t* O; int ldo; int ocol0;
    __device__ __forceinline__ void operator()(const f32x4 (&acc)[2][2][4][2], const Unit& u, int wr, int wc, int fr, int fq) const {
        const int row0 = u.pm * BM + wr * 64 + fr, col0 = u.pn * BM + wc * 32 + 8 * fq;
#pragma unroll
        for (int bj = 0; bj < 2; ++bj) {
            const f32x4 b0 = *(const f32x4*)(bias + col0 + bj * HALF), b1 = *(const f32x4*)(bias + col0 + bj * HALF + 4);
#pragma unroll
            for (int ai = 0; ai < 2; ++ai)
#pragma unroll
                for (int m = 0; m < 4; ++m) {
                    const size_t row = (size_t)(row0 + ai * HALF + m * 16);
                    const u32x4 yv = *(const u32x4*)(Y + row * ldy + col0 + bj * HALF);
                    const f32x4 z0 = acc[ai][bj][m][0] + b0, z1 = acc[ai][bj][m][1] + b1;
                    float y[8] = {__builtin_bit_cast(float, yv.x << 16), __builtin_bit_cast(float, yv.x & 0xffff0000u), __builtin_bit_cast(float, yv.y << 16), __builtin_bit_cast(float, yv.y & 0xffff0000u),
                                  __builtin_bit_cast(float, yv.z << 16), __builtin_bit_cast(float, yv.z & 0xffff0000u), __builtin_bit_cast(float, yv.w << 16), __builtin_bit_cast(float, yv.w & 0xffff0000u)};
                    float r[8];
#pragma unroll
                    for (int i = 0; i < 4; ++i) { r[i] = y[i] * fast_sigmoid(z0[i]); r[4 + i] = y[4 + i] * fast_sigmoid(z1[i]); }
                    u32x4 w; w.x = cvt_pk_bf16(r[0], r[1]); w.y = cvt_pk_bf16(r[2], r[3]); w.z = cvt_pk_bf16(r[4], r[5]); w.w = cvt_pk_bf16(r[6], r[7]);
                    *(u32x4*)(O + row * ldo + ocol0 + col0 + bj * HALF) = w;
                }
        }
    }
};
template <class Epi, class Sched, bool ALIGN_EPI = false, bool SP2 = false, bool GATHER = false>
__device__ __forceinline__ void gemm_phase(PG8_LAS unsigned char* lds, const Gemm g, const Sched& S, const Epi& E) {
    int tid_ = threadIdx.x; asm volatile("" : "+v"(tid_));
    const int tid = tid_, wid = __builtin_amdgcn_readfirstlane(tid >> 6), lane = tid & 63, wr = wid >> 2, wc = wid & 3, fr = lane & 15, fq = lane >> 4;
    const int K = g.K, nt = K / BK;
    unsigned voffA[2], voffB[2];
#pragma unroll
    for (int i = 0; i < 2; ++i) { int R, C; stage_rc(tid * 16 + i * 8192, R, C); const int Rb = Epi::PERM ? ((R & ~31) + perm32(R & 31)) : R;
        voffA[i] = (unsigned)(R * K + C) * 2u; voffB[i] = (unsigned)(Rb * K + C) * 2u; }
    const size_t kstep = (size_t)(BK * 2);
    const size_t hstep = (size_t)HALF * K * 2;
    const size_t tstep = 2 * hstep;
    const unsigned ldsw = (unsigned)wid * 1024u;
    const int aoff = lds_byte(wr * 64 + fr, fq * 8), boff = lds_byte(wc * 32 + fr, fq * 8);
#define PG8_SA(b, h) (((b) * 2 + (h)) * HTB)
#define PG8_SB(b, h) ((4 + (b) * 2 + (h)) * HTB)
#define PG8_STAGE(bufoff, gbase, voff) do { _Pragma("unroll") for (int _i = 0; _i < 2; ++_i) \
        __builtin_amdgcn_global_load_lds((const unsigned*)((const char*)(gbase) + (voff)[_i]), (PG8_LAS unsigned*)(lds + (bufoff) + ldsw + _i * 8192), 16, 0, 0); } while (0)
#define PG8_STAGE_A(bufoff, kptr, h, NEXTSEL) do { if constexpr (GATHER) { const unsigned _p = (NEXTSEL) ? gnxt[h] : gcur[h]; const unsigned _v[2] = { (_p & 0xffffu) * (unsigned)(2 * K) + gC2, (_p >> 16) * (unsigned)(2 * K) + gC2 }; PG8_STAGE(bufoff, kptr, _v); } \
        else { PG8_STAGE(bufoff, (kptr) + (h) * hstep, voffA); } } while (0)
#define PG8_LDA(dst, b, h) do { _Pragma("unroll") for (int m = 0; m < 4; ++m) _Pragma("unroll") for (int k = 0; k < 2; ++k) dst[m][k] = *(const PG8_LAS bf16x8*)(lds + PG8_SA(b, h) + aoff + m * 2048 + k * 1024); } while (0)
#define PG8_LDB(dst, b, h) do { _Pragma("unroll") for (int n = 0; n < 2; ++n) _Pragma("unroll") for (int k = 0; k < 2; ++k) dst[n][k] = *(const PG8_LAS bf16x8*)(lds + PG8_SB(b, h) + boff + n * 2048 + k * 1024); } while (0)
#define PG8_MMA(ai, bj, At, Bt) do { __builtin_amdgcn_s_setprio(1); _Pragma("unroll") for (int m = 0; m < 4; ++m) _Pragma("unroll") for (int n = 0; n < 2; ++n) _Pragma("unroll") for (int k = 0; k < 2; ++k) \
        acc[ai][bj][m][n] = __builtin_amdgcn_mfma_f32_16x16x32_bf16(Bt[n][k], At[m][k], acc[ai][bj][m][n], 0, 0, 0); __builtin_amdgcn_s_setprio(0); } while (0)
#define PG8_WAIT_V(n) asm volatile("s_waitcnt vmcnt(" #n ")" ::: "memory")
#define PG8_WAIT_L(n) asm volatile("s_waitcnt lgkmcnt(" #n ")" ::: "memory")
#define PG8_BAR __builtin_amdgcn_s_barrier()
#define PG8_SCHED __builtin_amdgcn_sched_barrier(0)
    unsigned gcur[2], gnxt[2], gC2 = 0;
    if constexpr (GATHER) { int R, C; stage_rc(tid * 16, R, C); gC2 = (unsigned)C * 2u; }
    auto load_gather = [&](int pm, unsigned (&dst)[2]) {
        int R, C; stage_rc(tid * 16, R, C);
#pragma unroll
        for (int h = 0; h < 2; ++h) { int a0 = g.rowtab[pm * BM + h * HALF + R], a1 = g.rowtab[pm * BM + h * HALF + R + 64]; a0 = a0 < 0 ? 0 : a0; a1 = a1 < 0 ? 0 : a1; dst[h] = (unsigned)(a0 >> 3) | ((unsigned)(a1 >> 3) << 16); }
    };
    Unit cur, nxt; int ui = 0;
    if (!S.next(0, cur)) return;
    f32x4 acc[2][2][4][2];
#pragma unroll
    for (int a = 0; a < 2; ++a)
#pragma unroll
        for (int b = 0; b < 2; ++b)
#pragma unroll
            for (int m = 0; m < 4; ++m)
#pragma unroll
                for (int n = 0; n < 2; ++n) acc[a][b][m][n] = (f32x4){0.f, 0.f, 0.f, 0.f};
    bf16x8 At[4][2], B0[2][2], B1[2][2];
    const char* cA = (const char*)g.A + (GATHER ? (size_t)0 : (size_t)cur.pm * tstep); const char* cB = (const char*)g.Bt + (size_t)cur.pn * tstep;
    if constexpr (GATHER) { load_gather(cur.pm, gcur); }
    S.a_ready(cur);
    if constexpr (SP2) {
        PG8_STAGE(PG8_SB(0, 0), cB, voffB); PG8_STAGE(PG8_SB(0, 1), cB + hstep, voffB); PG8_STAGE_A(PG8_SA(0, 0), cA, 0, false); PG8_STAGE_A(PG8_SA(0, 1), cA, 1, false);
        if (wr == 1) PG8_BAR;
        PG8_WAIT_V(2); PG8_BAR;
        PG8_STAGE(PG8_SB(1, 0), cB + kstep, voffB); PG8_STAGE_A(PG8_SA(1, 0), cA + kstep, 0, false); PG8_STAGE(PG8_SB(1, 1), cB + hstep + kstep, voffB);
        PG8_WAIT_V(6); PG8_BAR;
    } else {
        PG8_STAGE(PG8_SB(0, 0), cB, voffB); PG8_STAGE_A(PG8_SA(0, 0), cA, 0, false); PG8_STAGE(PG8_SB(0, 1), cB + hstep, voffB); PG8_STAGE_A(PG8_SA(0, 1), cA, 1, false);
        if (wr == 1) PG8_BAR;
        PG8_WAIT_V(4); PG8_BAR;
        PG8_STAGE(PG8_SB(1, 0), cB + kstep, voffB); PG8_STAGE_A(PG8_SA(1, 0), cA + kstep, 0, false); PG8_STAGE(PG8_SB(1, 1), cB + hstep + kstep, voffB);
        PG8_WAIT_V(6); PG8_BAR;
    }
    for (;;) {
        const bool has_next = S.next(ui + 1, nxt);
        const char* nA = (has_next && !GATHER) ? (const char*)g.A + (size_t)nxt.pm * tstep : cA; const char* nB = has_next ? (const char*)g.Bt + (size_t)nxt.pn * tstep : cB;
        if constexpr (GATHER) { if (has_next) load_gather(nxt.pm, gnxt); else {
#pragma unroll
            for (int h = 0; h < 2; ++h) { gnxt[h] = gcur[h]; } } }
        for (int t = 0; t < nt; t += 2) {
            const bool last = (t == nt - 2);
            const char* a1 = cA + (size_t)(t + 1) * kstep;
            const char* a2 = last ? nA : cA + (size_t)(t + 2) * kstep; const char* b2 = last ? nB : cB + (size_t)(t + 2) * kstep;
            const char* a3 = a2 + kstep; const char* b3 = b2 + kstep;
            if (last && has_next) S.a_ready(nxt);
            if constexpr (SP2) {
            PG8_LDB(B0, 0, 0); PG8_LDB(B1, 0, 1); PG8_SCHED; PG8_LDA(At, 0, 0); PG8_STAGE_A(PG8_SA(1, 1), a1, 1, false);
            PG8_WAIT_V(8); PG8_WAIT_L(0); PG8_BAR; PG8_MMA(0, 0, At, B0); PG8_MMA(0, 1, At, B1); PG8_BAR; PG8_SCHED;
            PG8_LDA(At, 0, 1); PG8_STAGE(PG8_SB(0, 0), b2, voffB); PG8_STAGE(PG8_SB(0, 1), b2 + hstep, voffB); PG8_STAGE_A(PG8_SA(0, 0), a2, 0, last);
            PG8_WAIT_V(8); PG8_WAIT_L(0); PG8_BAR; PG8_MMA(1, 0, At, B0); PG8_MMA(1, 1, At, B1); PG8_BAR; PG8_SCHED;
            PG8_LDB(B0, 1, 0); PG8_LDB(B1, 1, 1); PG8_SCHED; PG8_LDA(At, 1, 0); PG8_STAGE_A(PG8_SA(0, 1), a2, 1, last);
            PG8_WAIT_V(8); PG8_WAIT_L(0); PG8_BAR; PG8_MMA(0, 0, At, B0); PG8_MMA(0, 1, At, B1); PG8_BAR; PG8_SCHED;
            PG8_LDA(At, 1, 1); PG8_STAGE(PG8_SB(1, 0), b3, voffB); PG8_STAGE(PG8_SB(1, 1), b3 + hstep, voffB); PG8_STAGE_A(PG8_SA(1, 0), a3, 0, last);
            PG8_WAIT_V(8); PG8_WAIT_L(0); PG8_BAR; PG8_MMA(1, 0, At, B0); PG8_MMA(1, 1, At, B1); PG8_BAR; PG8_SCHED;
            } else {
            PG8_LDB(B0, 0, 0); PG8_SCHED; PG8_LDA(At, 0, 0); PG8_STAGE_A(PG8_SA(1, 1), a1, 1, false);
            PG8_WAIT_L(8); PG8_BAR; PG8_WAIT_L(0); PG8_MMA(0, 0, At, B0); PG8_BAR; PG8_SCHED;
            PG8_LDB(B1, 0, 1); PG8_STAGE(PG8_SB(0, 0), b2, voffB);
            PG8_BAR; PG8_WAIT_L(0); PG8_MMA(0, 1, At, B1); PG8_BAR;
            PG8_LDA(At, 0, 1); PG8_STAGE_A(PG8_SA(0, 0), a2, 0, last);
            PG8_BAR; PG8_WAIT_L(0); PG8_MMA(1, 0, At, B0); PG8_BAR; PG8_SCHED;
            PG8_STAGE(PG8_SB(0, 1), b2 + hstep, voffB);
            PG8_WAIT_V(6); PG8_BAR; PG8_MMA(1, 1, At, B1); PG8_BAR;
            PG8_LDB(B0, 1, 0); PG8_SCHED; PG8_LDA(At, 1, 0); PG8_STAGE_A(PG8_SA(0, 1), a2, 1, last);
            PG8_WAIT_L(8); PG8_BAR; PG8_WAIT_L(0); PG8_MMA(0, 0, At, B0); PG8_BAR; PG8_SCHED;
            PG8_LDB(B1, 1, 1); PG8_STAGE(PG8_SB(1, 0), b3, voffB);
            PG8_BAR; PG8_WAIT_L(0); PG8_MMA(0, 1, At, B1); PG8_BAR;
            PG8_LDA(At, 1, 1); PG8_STAGE_A(PG8_SA(1, 0), a3, 0, last);
            PG8_BAR; PG8_WAIT_L(0); PG8_MMA(1, 0, At, B0); PG8_BAR; PG8_SCHED;
            PG8_STAGE(PG8_SB(1, 1), b3 + hstep, voffB);
            PG8_WAIT_V(6); PG8_BAR; PG8_MMA(1, 1, At, B1); PG8_BAR;
            }
        }
        if constexpr (ALIGN_EPI) { if (wr == 0) PG8_BAR; }
        if constexpr (!Epi::AFTER_DRAIN) { E(acc, cur, wr, wc, fr, fq); S.done(cur); }
        if (!has_next) break;
#pragma unroll
        for (int a = 0; a < 2; ++a)
#pragma unroll
            for (int b = 0; b < 2; ++b)
#pragma unroll
                for (int m = 0; m < 4; ++m)
#pragma unroll
                    for (int n = 0; n < 2; ++n) acc[a][b][m][n] = (f32x4){0.f, 0.f, 0.f, 0.f};
        cur = nxt; cA = nA; cB = nB; ++ui;
        if constexpr (GATHER) {
#pragma unroll
            for (int h = 0; h < 2; ++h) { gcur[h] = gnxt[h]; } }
        if constexpr (ALIGN_EPI) { if (wr == 1) PG8_BAR; }
    }
    PG8_WAIT_V(0);
    if constexpr (!ALIGN_EPI) { if (wr == 0) PG8_BAR; }
    PG8_BAR;
    if constexpr (Epi::AFTER_DRAIN) { E.fused(acc, cur, wr, wc, fr, fq, lds, wid, lane); S.done(cur); }
#undef PG8_SA
#undef PG8_SB
#undef PG8_STAGE
#undef PG8_STAGE_A
#undef PG8_LDA
#undef PG8_LDB
#undef PG8_MMA
#undef PG8_WAIT_V
#undef PG8_WAIT_L
#undef PG8_BAR
#undef PG8_SCHED
}
}

typedef unsigned short bf16_t;
__device__ __forceinline__ unsigned f2bf(float f) { unsigned u = __builtin_bit_cast(unsigned, f); return (u + 0x7fffu + ((u >> 16) & 1u)) >> 16; }
__device__ __forceinline__ float bf2f(unsigned h) { return __builtin_bit_cast(float, h << 16); }
__device__ __forceinline__ float wave_sum(float v) {
#pragma unroll
    for (int o = 1; o < 64; o <<= 1) v += __shfl_xor(v, o);
    return v;
}
__device__ __forceinline__ float sigmoidf_(float x) { return 1.0f / (1.0f + expf(-x)); }
__device__ __forceinline__ float siluf_(float x) { return x / (1.0f + expf(-x)); }
__device__ __forceinline__ float softplusf_(float x) { return fmaxf(x, 0.0f) + log1pf(expf(-fabsf(x))); }
__device__ __forceinline__ float geluf_(float x) { const float u = 0.7978845608028654f * (x + 0.044715f * x * x * x); return 0.5f * x * (1.0f + tanhf(u)); }

struct Args { const float* in[39]; float* out; unsigned char* ws; int lo, hi; };

struct Ctx {
    const float* const* in; float* out; unsigned char* ws;
    LAS unsigned char* lds; float* sm;
    int tid, lane, wid, bid, G;
};

__device__ __forceinline__ unsigned pk2(float lo, float hi) { return f2bf(lo) | (f2bf(hi) << 16); }
__device__ __forceinline__ float ldbf(const bf16_t* p) { return bf2f((unsigned)*p); }
__device__ __forceinline__ float4 ldbf4(const bf16_t* p) { const uint2 v = *(const uint2*)p; return make_float4(bf2f(v.x & 0xffffu), bf2f(v.x >> 16), bf2f(v.y & 0xffffu), bf2f(v.y >> 16)); }

template <int NB, class AF, class BF, class BF2, class EF>
__device__ __forceinline__ void gemm_tile(float* sm, int K, AF af, BF bf, BF2 bf2, EF ef) {
    float* As = sm;
    float* Bs = sm + 16 * 132;
    float* Bs2 = Bs + 16 * 68;
    const int tid = threadIdx.x, ty = tid >> 4, tx = tid & 15;
    const int am = tid >> 2, ak = (tid & 3) * 4;
    const int bt = tid & 255, bk = bt >> 4, bn = (bt & 15) * 4;
    float acc[4][4], acc2[4][4];
#pragma unroll
    for (int i = 0; i < 4; ++i)
#pragma unroll
        for (int j = 0; j < 4; ++j) { acc[i][j] = 0.f; acc2[i][j] = 0.f; }
    float4 av = af(am, ak);
    float4 bv = make_float4(0.f, 0.f, 0.f, 0.f);
    if (tid < 256) bv = bf(bk, bn); else if (NB == 2) bv = bf2(bk, bn);
    for (int k0 = 0; k0 < K; k0 += 16) {
        __syncthreads();
        As[(ak + 0) * 132 + am] = av.x; As[(ak + 1) * 132 + am] = av.y; As[(ak + 2) * 132 + am] = av.z; As[(ak + 3) * 132 + am] = av.w;
        if (tid < 256) *(float4*)&Bs[bk * 68 + bn] = bv; else if (NB == 2) *(float4*)&Bs2[bk * 68 + bn] = bv;
        __syncthreads();
        if (k0 + 16 < K) {
            av = af(am, k0 + 16 + ak);
            if (tid < 256) bv = bf(k0 + 16 + bk, bn); else if (NB == 2) bv = bf2(k0 + 16 + bk, bn);
        }
#pragma unroll
        for (int kk = 0; kk < 16; ++kk) {
            const float4 a = *(const float4*)&As[kk * 132 + ty * 4];
            const float4 b = *(const float4*)&Bs[kk * 68 + tx * 4];
            const float aa[4] = {a.x, a.y, a.z, a.w};
            const float bb[4] = {b.x, b.y, b.z, b.w};
#pragma unroll
            for (int i = 0; i < 4; ++i)
#pragma unroll
                for (int j = 0; j < 4; ++j) acc[i][j] = fmaf(aa[i], bb[j], acc[i][j]);
            if (NB == 2) {
                const float4 b2 = *(const float4*)&Bs2[kk * 68 + tx * 4];
                const float bb2[4] = {b2.x, b2.y, b2.z, b2.w};
#pragma unroll
                for (int i = 0; i < 4; ++i)
#pragma unroll
                    for (int j = 0; j < 4; ++j) acc2[i][j] = fmaf(aa[i], bb2[j], acc2[i][j]);
            }
        }
    }
#pragma unroll
    for (int i = 0; i < 4; ++i)
        ef(ty * 4 + i, tx * 4, make_float4(acc[i][0], acc[i][1], acc[i][2], acc[i][3]), make_float4(acc2[i][0], acc2[i][1], acc2[i][2], acc2[i][3]));
}

template <bool RES, class RM>
__device__ __forceinline__ void transpose_item(const float* W, int K, int N, bf16_t* WT, RM rowmap, float* scr, int item, int lane) {
    const int nblk = N / 32, kb = item / nblk, nb = item % nblk, k0 = 64 * kb, n0 = 32 * nb;
#pragma unroll 8
    for (int i = 0; i < 32; ++i) { const int kk = 2 * i + (lane >> 5); scr[kk * 33 + (lane & 31)] = W[(size_t)(k0 + kk) * N + n0 + (lane & 31)]; }
    asm volatile("s_waitcnt lgkmcnt(0)" ::: "memory");
    const int c = lane & 7;
    const int r0 = rowmap(n0);
#pragma unroll
    for (int j = 0; j < 4; ++j) {
        const int n = (lane >> 3) + 8 * j; const float* s = scr + (8 * c) * 33 + n;
        float v[8];
#pragma unroll
        for (int q = 0; q < 8; ++q) { v[q] = s[q * 33]; if (RES) v[q] = v[q] - bf2f(f2bf(v[q])); }
        uint4 o; o.x = pk2(v[0], v[1]); o.y = pk2(v[2], v[3]); o.z = pk2(v[4], v[5]); o.w = pk2(v[6], v[7]);
        *(uint4*)(WT + (size_t)(r0 + n) * K + k0 + 8 * c) = o;
    }
    asm volatile("s_waitcnt lgkmcnt(0)" ::: "memory");
}

__device__ __forceinline__ void phase0(const Ctx& c) {
    const float* cc = c.in[1]; const float* w_ada = c.in[2]; const float* b_ada = c.in[3];
    float* mods = (float*)(c.ws + WS_MODS);
    const int gt = c.bid * 512 + c.tid, NT = c.G * 512;
    for (int idx = gt; idx < BATCH * NMODS; idx += NT) {
        const int b = idx / NMODS, j = idx % NMODS;
        float acc = 0.f;
        for (int k = 0; k < D; ++k) acc = fmaf(siluf_(cc[b * D + k]), w_ada[(size_t)k * NMODS + j], acc);
        mods[idx] = acc + b_ada[j];
    }
    const float* log_dt = c.in[20]; const float* a_re = c.in[21]; const float* a_im = c.in[22];
    const float* b_re = c.in[23]; const float* b_im = c.in[24];
    float* ab = (float*)(c.ws + WS_S5AB); float* apow = (float*)(c.ws + WS_S5POW); float* bb = (float*)(c.ws + WS_S5BB);
    for (int idx = gt; idx < S5NG * S5P; idx += NT) {
        const int g = idx / S5P;
        const double dt = exp((double)log_dt[g]);
        const double lre = fmin((double)a_re[idx], -1e-4), lim = (double)a_im[idx];
        const double mag = exp(lre * dt), ang = lim * dt;
        const double abr = mag * cos(ang), abi = mag * sin(ang);
        const double den = lre * lre + lim * lim;
        const double nre = abr - 1.0, nim = abi;
        const double qre = (nre * lre + nim * lim) / den, qim = (nim * lre - nre * lim) / den;
        ab[idx * 2 + 0] = (float)abr; ab[idx * 2 + 1] = (float)abi;
        double pr = abr, pi = abi;
        for (int s = 0; s < 7; ++s) { const double nr = pr * pr - pi * pi, ni = 2.0 * pr * pi; pr = nr; pi = ni; }
        apow[idx * 2 + 0] = (float)pr; apow[idx * 2 + 1] = (float)pi;
        for (int ch = 0; ch < 16; ++ch) {
            const double br = (double)b_re[idx * 16 + ch], bi = (double)b_im[idx * 16 + ch];
            bb[idx * 32 + ch] = (float)(qre * br - qim * bi);
            bb[idx * 32 + 16 + ch] = (float)(qre * bi + qim * br);
        }
    }
    float* scr = c.sm + c.wid * (64 * 33);
    const int gw = c.bid * 8 + c.wid, NW = c.G * 8;
    constexpr int I_IN = (D / 64) * (NPROJ / 32), I_OUT = (D / 64) * (D / 32), I_GLU = (512 / 64) * (512 / 32), I_SG = (D / 64) * (256 / 32), I_SD = (256 / 64) * (D / 32), I_R = (D / 64) * (256 / 32);
    constexpr int NIT = I_IN + I_OUT + I_GLU + 2 * I_SG + I_SD + 2 * I_R;
    for (int it = gw; it < NIT; it += NW) {
        int r = it;
        if (r < I_IN) { transpose_item<false>(c.in[8], D, NPROJ, (bf16_t*)(c.ws + WS_WIN_T), [](int n) { return n; }, scr, r, c.lane); continue; } r -= I_IN;
        if (r < I_OUT) { transpose_item<false>(c.in[30], D, D, (bf16_t*)(c.ws + WS_WOUT_T), [](int n) { return n; }, scr, r, c.lane); continue; } r -= I_OUT;
        if (r < I_GLU) { transpose_item<false>(c.in[28], 512, 512, (bf16_t*)(c.ws + WS_WGLU_T), [](int n) { return n; }, scr, r, c.lane); continue; } r -= I_GLU;
        if (r < I_SG) { transpose_item<false>(c.in[36], D, 256, (bf16_t*)(c.ws + WS_WSGU_T), [](int n) { return (n >> 7) * 256 + (n & 127); }, scr, r, c.lane); continue; } r -= I_SG;
        if (r < I_SG) { transpose_item<false>(c.in[37], D, 256, (bf16_t*)(c.ws + WS_WSGU_T), [](int n) { return (n >> 7) * 256 + 128 + (n & 127); }, scr, r, c.lane); continue; } r -= I_SG;
        if (r < I_SD) { transpose_item<false>(c.in[38], 256, D, (bf16_t*)(c.ws + WS_WSD_T), [](int n) { return n; }, scr, r, c.lane); continue; } r -= I_SD;
        if (r < I_R) { transpose_item<false>(c.in[31], D, 256, (bf16_t*)(c.ws + WS_WR_T), [](int n) { return n; }, scr, r, c.lane); continue; } r -= I_R;
        transpose_item<true>(c.in[31], D, 256, (bf16_t*)(c.ws + WS_WR_T), [](int n) { return 256 + n; }, scr, r, c.lane);
    }
    for (int it = gw; it < NE * 384; it += NW) {
        const int e = it / 384, r = it % 384;
        if (r < 128) transpose_item<false>(c.in[33] + (size_t)e * D * EFF, D, EFF, (bf16_t*)(c.ws + WS_WEGU) + (size_t)e * 512 * D, [](int n) { return (n >> 7) * 256 + (n & 127); }, scr, r, c.lane);
        else if (r < 256) transpose_item<false>(c.in[34] + (size_t)e * D * EFF, D, EFF, (bf16_t*)(c.ws + WS_WEGU) + (size_t)e * 512 * D, [](int n) { return (n >> 7) * 256 + 128 + (n & 127); }, scr, r - 128, c.lane);
        else transpose_item<false>(c.in[35] + (size_t)e * EFF * D, EFF, D, (bf16_t*)(c.ws + WS_WED) + (size_t)e * D * EFF, [](int n) { return n; }, scr, r - 256, c.lane);
    }
}

__device__ __forceinline__ void phase1(const Ctx& c) {
    const float* x = c.in[0]; const float* g = c.in[4];
    const float* mods = (const float*)(c.ws + WS_MODS);
    bf16_t* xn = (bf16_t*)(c.ws + WS_A);
    const int gw = c.bid * 8 + c.wid, NW = c.G * 8;
    for (int t = gw; t < T; t += NW) {
        const int b = t / SEQ;
        const float4* xr = (const float4*)(x + (size_t)t * D) + c.lane;
        float4 v[4]; float ss = 0.f;
#pragma unroll
        for (int j = 0; j < 4; ++j) { v[j] = xr[64 * j]; ss += v[j].x * v[j].x + v[j].y * v[j].y + v[j].z * v[j].z + v[j].w * v[j].w; }
        const float rstd = rsqrtf(wave_sum(ss) * (1.0f / D) + 1e-6f);
        uint2* o = (uint2*)(xn + (size_t)t * D) + c.lane;
#pragma unroll
        for (int j = 0; j < 4; ++j) {
            const int k = (c.lane + 64 * j) * 4;
            const float4 gg = *(const float4*)(g + k);
            const float4 sh = *(const float4*)(mods + b * NMODS + k);
            const float4 sc = *(const float4*)(mods + b * NMODS + D + k);
            float4 r;
            r.x = v[j].x * rstd * gg.x * (1.f + sc.x) + sh.x; r.y = v[j].y * rstd * gg.y * (1.f + sc.y) + sh.y;
            r.z = v[j].z * rstd * gg.z * (1.f + sc.z) + sh.z; r.w = v[j].w * rstd * gg.w * (1.f + sc.w) + sh.w;
            o[64 * j] = make_uint2(pk2(r.x, r.y), pk2(r.z, r.w));
        }
    }
}

__device__ __forceinline__ void phase2(const Ctx& c) {
    pg8::Gemm g{(const bf16_t*)(c.ws + WS_A), (const bf16_t*)(c.ws + WS_WIN_T), T, NPROJ, D};
    pg8::StaticOrder S; S.init(T, NPROJ, c.G, c.bid);
    pg8::EpiBf16<0> E{(bf16_t*)(c.ws + WS_PROJ), NPROJ, nullptr, 0, 0, 1.f};
    pg8::gemm_phase<pg8::EpiBf16<0>, pg8::StaticOrder, true, true>(c.lds, g, S, E);
}

__device__ __forceinline__ void ld_u16(const bf16_t* p, float (&u)[16]) {
    const uint4 a = *(const uint4*)p, b = *(const uint4*)(p + 8);
    u[0] = bf2f(a.x & 0xffffu); u[1] = bf2f(a.x >> 16); u[2] = bf2f(a.y & 0xffffu); u[3] = bf2f(a.y >> 16);
    u[4] = bf2f(a.z & 0xffffu); u[5] = bf2f(a.z >> 16); u[6] = bf2f(a.w & 0xffffu); u[7] = bf2f(a.w >> 16);
    u[8] = bf2f(b.x & 0xffffu); u[9] = bf2f(b.x >> 16); u[10] = bf2f(b.y & 0xffffu); u[11] = bf2f(b.y >> 16);
    u[12] = bf2f(b.z & 0xffffu); u[13] = bf2f(b.z >> 16); u[14] = bf2f(b.w & 0xffffu); u[15] = bf2f(b.w >> 16);
}
__device__ __forceinline__ void phase3(const Ctx& c) {
    const bf16_t* proj = (const bf16_t*)(c.ws + WS_PROJ);
    const float* mu = c.in[9]; const float* w0 = c.in[10]; const float* w2 = c.in[11]; const float* a0 = c.in[12]; const float* a2 = c.in[13];
    const float* g2 = c.in[14]; const float* k_k = c.in[15]; const float* k_a = c.in[16];
    float* rw_w = (float*)(c.ws + WS_RW_W);
    bf16_t* rw_r = (bf16_t*)(c.ws + WS_RW_R); bf16_t* rw_k = (bf16_t*)(c.ws + WS_RW_K); bf16_t* rw_v = (bf16_t*)(c.ws + WS_RW_V);
    bf16_t* rw_a = (bf16_t*)(c.ws + WS_RW_A); bf16_t* rw_b = (bf16_t*)(c.ws + WS_RW_B); bf16_t* rw_g = (bf16_t*)(c.ws + WS_RW_G);
    float* lo = c.sm;
    const int n = c.tid;
    for (int it = c.bid; it < T / 8; it += c.G) {
        const int t0 = it * 8;
        __syncthreads();
        if (n < 256) {
            const int col = 1536 + n; const float m_ = mu[col];
#pragma unroll
            for (int tk = 0; tk < 8; ++tk) {
                const int t = t0 + tk;
                const float p = ldbf(proj + (size_t)t * NPROJ + col);
                const float pv = (t % SEQ == 0) ? 0.f : ldbf(proj + (size_t)(t - 1) * NPROJ + col);
                const float ps = p + (pv - p) * m_;
                float v = ps;
                if (n < 64) v = tanhf(ps); else if (n >= 128) v = sigmoidf_(ps);
                lo[tk * 256 + n] = v;
            }
        }
        __syncthreads();
        float wl[8], al[8], gl[8];
#pragma unroll
        for (int tk = 0; tk < 8; ++tk) { wl[tk] = 0.f; al[tk] = 0.f; gl[tk] = 0.f; }
        for (int j = 0; j < 64; ++j) {
            const float wv = w2[j * RW + n], av = a2[j * RW + n];
#pragma unroll
            for (int tk = 0; tk < 8; ++tk) { wl[tk] = fmaf(lo[tk * 256 + j], wv, wl[tk]); al[tk] = fmaf(lo[tk * 256 + 64 + j], av, al[tk]); }
        }
        for (int j = 0; j < 128; ++j) {
            const float gv = g2[j * RW + n];
#pragma unroll
            for (int tk = 0; tk < 8; ++tk) gl[tk] = fmaf(lo[tk * 256 + 128 + j], gv, gl[tk]);
        }
        const float mur = mu[n], muk = mu[512 + n], muv = mu[1024 + n];
        const float w0n = w0[n], a0n = a0[n], kkn = k_k[n], kan = k_a[n];
#pragma unroll
        for (int tk = 0; tk < 8; ++tk) {
            const int t = t0 + tk; const bool first = (t % SEQ == 0);
            const bf16_t* pr = proj + (size_t)t * NPROJ; const bf16_t* pp = proj + (size_t)(first ? t : t - 1) * NPROJ;
            float r = ldbf(pr + n), k = ldbf(pr + 512 + n), v = ldbf(pr + 1024 + n);
            const float r1 = first ? 0.f : ldbf(pp + n), k1 = first ? 0.f : ldbf(pp + 512 + n), v1 = first ? 0.f : ldbf(pp + 1024 + n);
            r = r + (r1 - r) * mur; k = k + (k1 - k) * muk; v = v + (v1 - v) * muv;
            const float wa = w0n + wl[tk];
            const float logw = -softplusf_(-wa) - 0.5f;
            const float decay = expf(-expf(logw));
            const float iclr = sigmoidf_(a0n + al[tk]);
            float kk = k * kkn;
            const float ss = wave_sum(kk * kk);
            kk = kk / fmaxf(sqrtf(ss), 1e-12f);
            const float kf = k * (1.f + (iclr - 1.f) * kan);
            const size_t o = (size_t)t * RW + n;
            rw_w[o] = decay; rw_r[o] = (bf16_t)f2bf(r); rw_k[o] = (bf16_t)f2bf(kf); rw_v[o] = (bf16_t)f2bf(v); rw_a[o] = (bf16_t)f2bf(-kk); rw_b[o] = (bf16_t)f2bf(kk * iclr); rw_g[o] = (bf16_t)f2bf(gl[tk]);
        }
    }
    const float* ab = (const float*)(c.ws + WS_S5AB); const float* bbp = (const float*)(c.ws + WS_S5BB);
    float* E = (float*)(c.ws + WS_S5E);
    const int gw = c.bid * 8 + c.wid, NW = c.G * 8;
    for (int it = gw; it < BATCH * S5NG * S5NC; it += NW) {
        const int ch = it % S5NC, g = (it / S5NC) % S5NG, b = it / (S5NC * S5NG);
        const int p = c.lane;
        float bbr[16], bbi[16];
#pragma unroll
        for (int q = 0; q < 4; ++q) {
            const float4 v1 = *(const float4*)(bbp + (size_t)(g * 64 + p) * 32 + q * 4), v2 = *(const float4*)(bbp + (size_t)(g * 64 + p) * 32 + 16 + q * 4);
            bbr[q * 4 + 0] = v1.x; bbr[q * 4 + 1] = v1.y; bbr[q * 4 + 2] = v1.z; bbr[q * 4 + 3] = v1.w;
            bbi[q * 4 + 0] = v2.x; bbi[q * 4 + 1] = v2.y; bbi[q * 4 + 2] = v2.z; bbi[q * 4 + 3] = v2.w;
        }
        const float ar = ab[(g * 64 + p) * 2], ai = ab[(g * 64 + p) * 2 + 1];
        float xr = 0.f, xi = 0.f;
        const bf16_t* up = proj + (size_t)(b * SEQ + ch * S5CL) * NPROJ + RPROJ + g * 16;
        for (int s = 0; s < S5CL; ++s) {
            float u[16]; ld_u16(up + (size_t)s * NPROJ, u);
            float br = 0.f, bi = 0.f;
#pragma unroll
            for (int q = 0; q < 16; ++q) { br = fmaf(bbr[q], u[q], br); bi = fmaf(bbi[q], u[q], bi); }
            const float nr = ar * xr - ai * xi + br, ni = ar * xi + ai * xr + bi;
            xr = nr; xi = ni;
        }
        *(float2*)(E + (size_t)it * 128 + p * 2) = make_float2(xr, xi);
    }
}

typedef float f2v __attribute__((ext_vector_type(2)));
__device__ __forceinline__ float dpp_add16(float v) {
    v += __builtin_bit_cast(float, __builtin_amdgcn_mov_dpp(__builtin_bit_cast(int, v), 0xB1, 0xf, 0xf, true));
    v += __builtin_bit_cast(float, __builtin_amdgcn_mov_dpp(__builtin_bit_cast(int, v), 0x4E, 0xf, 0xf, true));
    v += __builtin_bit_cast(float, __builtin_amdgcn_mov_dpp(__builtin_bit_cast(int, v), 0x141, 0xf, 0xf, true));
    v += __builtin_bit_cast(float, __builtin_amdgcn_mov_dpp(__builtin_bit_cast(int, v), 0x140, 0xf, 0xf, true));
    return v;
}
constexpr int RTS = 32;
constexpr int RTILE = 6 * RTS * 64;
__device__ __forceinline__ void phase4(const Ctx& c) {
    const float* __restrict__ rw_w = (const float*)(c.ws + WS_RW_W);
    const bf16_t* __restrict__ rw_bf = (const bf16_t*)(c.ws + WS_RW_R);
    float* __restrict__ rw_y = (float*)(c.ws + WS_RW_Y);
    float* tile = c.sm;
    constexpr size_t ARR = (size_t)T * RW;
    for (int item = c.bid; item < BATCH * NH * 8; item += c.G) {
        const int bh = item >> 3, rb = (item & 7) * 8, b = bh >> 3, h = bh & 7;
        const size_t base = (size_t)(b * SEQ) * RW + h * 64;
        const int lt = c.tid - 128;
        uint4 reg[5];
        auto issue = [&](int tl) {
#pragma unroll
            for (int i = 0; i < 5; ++i) {
                const int it = lt + 384 * i;
                if (it < 512) { const int t = it >> 4, c4 = it & 15; reg[i] = *(const uint4*)(rw_w + base + (size_t)(tl * RTS + t) * RW + c4 * 4); }
                else if (it < 1792) { const int j = it - 512, arr = j >> 8, rem = j & 255, t = rem >> 3, c8 = rem & 7;
                    const int ga = (arr == 0) ? 3 : (arr == 1) ? 4 : (arr == 2) ? 1 : (arr == 3) ? 0 : 2;
                    reg[i] = *(const uint4*)(rw_bf + (size_t)ga * ARR + base + (size_t)(tl * RTS + t) * RW + c8 * 8); }
            }
        };
        auto commit = [&](int buf) {
            float* tb = tile + buf * RTILE;
#pragma unroll
            for (int i = 0; i < 5; ++i) {
                const int it = lt + 384 * i;
                if (it < 512) { const int t = it >> 4, c4 = it & 15; *(uint4*)(tb + t * 64 + c4 * 4) = reg[i]; }
                else if (it < 1792) { const int j = it - 512, arr = j >> 8, rem = j & 255, t = rem >> 3, c8 = rem & 7;
                    float* d = tb + (arr + 1) * RTS * 64 + t * 64 + c8 * 8;
                    const uint4 v = reg[i];
                    *(float4*)d = make_float4(bf2f(v.x & 0xffffu), bf2f(v.x >> 16), bf2f(v.y & 0xffffu), bf2f(v.y >> 16));
                    *(float4*)(d + 4) = make_float4(bf2f(v.z & 0xffffu), bf2f(v.z >> 16), bf2f(v.w & 0xffffu), bf2f(v.w >> 16)); }
            }
        };
        __syncthreads();
        if (c.wid >= 2) { issue(0); commit(0); issue(1); }
        __syncthreads();
        const int row = rb + (c.wid & 1) * 4 + (c.lane >> 4), kq = c.lane & 15;
        f2v S01 = {0.f, 0.f}, S23 = {0.f, 0.f};
        float* Y = rw_y + base + row;
        constexpr int NTL = SEQ / RTS;
        for (int tl = 0; tl < NTL; ++tl) {
            if (c.wid < 2) {
                const float* tb = tile + (tl & 1) * RTILE;
#pragma unroll 4
                for (int t = 0; t < RTS; ++t) {
                    const float4 w = *(const float4*)(tb + 0 * RTS * 64 + t * 64 + kq * 4), a = *(const float4*)(tb + 1 * RTS * 64 + t * 64 + kq * 4);
                    const float4 bb = *(const float4*)(tb + 2 * RTS * 64 + t * 64 + kq * 4), k = *(const float4*)(tb + 3 * RTS * 64 + t * 64 + kq * 4);
                    const float4 r = *(const float4*)(tb + 4 * RTS * 64 + t * 64 + kq * 4);
                    const float v = tb[5 * RTS * 64 + t * 64 + row];
                    const f2v a01 = {a.x, a.y}, a23 = {a.z, a.w}, w01 = {w.x, w.y}, w23 = {w.z, w.w}, b01 = {bb.x, bb.y}, b23 = {bb.z, bb.w};
                    const f2v k01 = {k.x, k.y}, k23 = {k.z, k.w}, r01 = {r.x, r.y}, r23 = {r.z, r.w};
                    f2v p = S01 * a01; p = __builtin_elementwise_fma(S23, a23, p);
                    const float sa = dpp_add16(p.x + p.y);
                    const f2v vv = {v, v}, sav = {sa, sa};
                    S01 = __builtin_elementwise_fma(S01, w01, vv * k01); S23 = __builtin_elementwise_fma(S23, w23, vv * k23);
                    S01 = __builtin_elementwise_fma(sav, b01, S01); S23 = __builtin_elementwise_fma(sav, b23, S23);
                    f2v q = S01 * r01; q = __builtin_elementwise_fma(S23, r23, q);
                    const float y = dpp_add16(q.x + q.y);
                    if (kq == 0) Y[(size_t)(tl * RTS + t) * RW] = y;
                }
            } else {
                if (tl + 1 < NTL) commit((tl + 1) & 1);
                if (tl + 2 < NTL) issue(tl + 2);
            }
            __syncthreads();
        }
    }
}

__device__ __forceinline__ void phase5(const Ctx& c) {
    const bf16_t* rw_r = (const bf16_t*)(c.ws + WS_RW_R); const bf16_t* rw_k = (const bf16_t*)(c.ws + WS_RW_K);
    const bf16_t* rw_v = (const bf16_t*)(c.ws + WS_RW_V); const bf16_t* rw_g = (const bf16_t*)(c.ws + WS_RW_G);
    const float* rw_y = (const float*)(c.ws + WS_RW_Y);
    const float* r_k = c.in[17]; const float* ln_w = c.in[18]; const float* ln_b = c.in[19];
    bf16_t* ycat = (bf16_t*)(c.ws + WS_A);
    const int gw = c.bid * 8 + c.wid, NW = c.G * 8;
    for (int it = gw; it < T * NH; it += NW) {
        const int t = it >> 3, h = it & 7, hn = h * 64 + c.lane;
        const size_t o = (size_t)t * RW + hn;
        const float y = rw_y[o];
        const float mean = wave_sum(y) * (1.f / 64.f);
        const float d = y - mean;
        const float var = wave_sum(d * d) * (1.f / 64.f);
        const float yn = d * rsqrtf(var + 64e-5f) * ln_w[hn] + ln_b[hn];
        const float v = ldbf(rw_v + o);
        const float bonus = wave_sum(ldbf(rw_r + o) * ldbf(rw_k + o) * r_k[hn]) * v;
        ycat[(size_t)t * D + hn] = (bf16_t)f2bf((yn + bonus) * ldbf(rw_g + o));
    }
    const bf16_t* proj = (const bf16_t*)(c.ws + WS_PROJ);
    const float* ab = (const float*)(c.ws + WS_S5AB); const float* bbp = (const float*)(c.ws + WS_S5BB); const float* Ein = (const float*)(c.ws + WS_S5E); const float* apow = (const float*)(c.ws + WS_S5POW);
    const float* c_re = c.in[25]; const float* c_im = c.in[26]; const float* dd = c.in[27];
    bf16_t* ys5 = (bf16_t*)(c.ws + WS_YS5);
    float* Cm = c.sm + c.wid * (16 * 132 + 4 * 128);
    float* Xs = Cm + 16 * 132;
    for (int it = gw; it < BATCH * S5NG * S5NC; it += NW) {
        const int ch = it % S5NC, g = (it / S5NC) % S5NG, b = it / (S5NC * S5NG);
        const int p = c.lane;
#pragma unroll
        for (int cc = 0; cc < 16; ++cc) { Cm[cc * 132 + p] = c_re[(g * 16 + cc) * 64 + p]; Cm[cc * 132 + 64 + p] = -c_im[(g * 16 + cc) * 64 + p]; }
        float bbr[16], bbi[16];
#pragma unroll
        for (int q = 0; q < 4; ++q) {
            const float4 v1 = *(const float4*)(bbp + (size_t)(g * 64 + p) * 32 + q * 4), v2 = *(const float4*)(bbp + (size_t)(g * 64 + p) * 32 + 16 + q * 4);
            bbr[q * 4 + 0] = v1.x; bbr[q * 4 + 1] = v1.y; bbr[q * 4 + 2] = v1.z; bbr[q * 4 + 3] = v1.w;
            bbi[q * 4 + 0] = v2.x; bbi[q * 4 + 1] = v2.y; bbi[q * 4 + 2] = v2.z; bbi[q * 4 + 3] = v2.w;
        }
        const float ar = ab[(g * 64 + p) * 2], ai = ab[(g * 64 + p) * 2 + 1];
        float xr = 0.f, xi = 0.f;
        {
            const float pr = apow[(g * 64 + p) * 2], pi = apow[(g * 64 + p) * 2 + 1];
            const float* Eb = Ein + ((size_t)(b * S5NG + g) * S5NC) * 128 + p * 2;
            for (int j = 0; j < ch; ++j) { const float2 e = *(const float2*)(Eb + (size_t)j * 128); const float nr = pr * xr - pi * xi + e.x, ni = pr * xi + pi * xr + e.y; xr = nr; xi = ni; }
        }
        const int tb = b * SEQ + ch * S5CL;
        const bf16_t* up = proj + (size_t)tb * NPROJ + RPROJ + g * 16;
        const int cc = c.lane & 15, tq = c.lane >> 4;
        const float dv = dd[g * 16 + cc];
        for (int s0 = 0; s0 < S5CL; s0 += 4) {
#pragma unroll
            for (int s1 = 0; s1 < 4; ++s1) {
                const int s = s0 + s1;
                float u[16]; ld_u16(up + (size_t)s * NPROJ, u);
                float br = 0.f, bi = 0.f;
#pragma unroll
                for (int q = 0; q < 16; ++q) { br = fmaf(bbr[q], u[q], br); bi = fmaf(bbi[q], u[q], bi); }
                const float nr = ar * xr - ai * xi + br, ni = ar * xi + ai * xr + bi;
                xr = nr; xi = ni;
                Xs[s1 * 128 + p] = xr; Xs[s1 * 128 + 64 + p] = xi;
            }
            __builtin_amdgcn_wave_barrier();
            asm volatile("s_waitcnt lgkmcnt(0)" ::: "memory");
            float y = 0.f;
#pragma unroll 8
            for (int q = 0; q < 128; q += 4) {
                const float4 cv = *(const float4*)&Cm[cc * 132 + q];
                const float4 xv = *(const float4*)&Xs[tq * 128 + q];
                y = fmaf(cv.x, xv.x, y); y = fmaf(cv.y, xv.y, y); y = fmaf(cv.z, xv.z, y); y = fmaf(cv.w, xv.w, y);
            }
            const int t = tb + s0 + tq;
            const float uu = ldbf(proj + (size_t)t * NPROJ + RPROJ + g * 16 + cc);
            ys5[(size_t)t * 512 + g * 16 + cc] = (bf16_t)f2bf(geluf_(y + dv * uu));
            __builtin_amdgcn_wave_barrier();
            asm volatile("s_waitcnt lgkmcnt(0)" ::: "memory");
        }
    }
}

__device__ __forceinline__ void phase6(const Ctx& c) {
    pg8::Gemm g{(const bf16_t*)(c.ws + WS_YS5), (const bf16_t*)(c.ws + WS_WGLU_T), T, 512, 512};
    pg8::StaticOrder S; S.init(T, 512, c.G, c.bid);
    pg8::EpiGLU E{(const bf16_t*)(c.ws + WS_YS5), 512, c.in[29], (bf16_t*)(c.ws + WS_A), D, 512};
    pg8::gemm_phase<pg8::EpiGLU, pg8::StaticOrder, true, true>(c.lds, g, S, E);
}

__device__ __forceinline__ void phase7(const Ctx& c) {
    pg8::Gemm g{(const bf16_t*)(c.ws + WS_A), (const bf16_t*)(c.ws + WS_WOUT_T), T, D, D};
    pg8::StaticOrder S; S.init(T, D, c.G, c.bid);
    pg8::EpiF32 E{(float*)(c.ws + WS_PROJ), D};
    pg8::gemm_phase<pg8::EpiF32, pg8::StaticOrder, true, true>(c.lds, g, S, E);
}

__device__ __forceinline__ void phase8(const Ctx& c) {
    const float* x = c.in[0]; const float* gpm = c.in[5]; const float* gpf = c.in[6];
    const float* mods = (const float*)(c.ws + WS_MODS); const float* mixed = (const float*)(c.ws + WS_PROJ);
    bf16_t* h2 = (bf16_t*)(c.ws + WS_A); float* x1o = c.out;
    const int gw = c.bid * 8 + c.wid, NW = c.G * 8;
    for (int t = gw; t < T; t += NW) {
        const int b = t / SEQ;
        const float4* mr = (const float4*)(mixed + (size_t)t * D) + c.lane;
        const float4* xr = (const float4*)(x + (size_t)t * D) + c.lane;
        float4 m[4], v[4]; float ss = 0.f;
#pragma unroll
        for (int j = 0; j < 4; ++j) { m[j] = mr[64 * j]; v[j] = xr[64 * j]; ss += m[j].x * m[j].x + m[j].y * m[j].y + m[j].z * m[j].z + m[j].w * m[j].w; }
        const float rstd = rsqrtf(wave_sum(ss) * (1.0f / D) + 1e-6f);
        float s1 = 0.f;
#pragma unroll
        for (int j = 0; j < 4; ++j) {
            const int k = (c.lane + 64 * j) * 4;
            const float4 gg = *(const float4*)(gpm + k);
            const float4 gt = *(const float4*)(mods + b * NMODS + 2 * D + k);
            v[j].x += gt.x * (m[j].x * rstd * gg.x); v[j].y += gt.y * (m[j].y * rstd * gg.y);
            v[j].z += gt.z * (m[j].z * rstd * gg.z); v[j].w += gt.w * (m[j].w * rstd * gg.w);
            s1 += v[j].x * v[j].x + v[j].y * v[j].y + v[j].z * v[j].z + v[j].w * v[j].w;
            ((float4*)(x1o + (size_t)t * D) + c.lane)[64 * j] = v[j];
        }
        const float rstd1 = rsqrtf(wave_sum(s1) * (1.0f / D) + 1e-6f);
#pragma unroll
        for (int j = 0; j < 4; ++j) {
            const int k = (c.lane + 64 * j) * 4;
            const float4 gg = *(const float4*)(gpf + k);
            const float4 sh = *(const float4*)(mods + b * NMODS + 3 * D + k);
            const float4 sc = *(const float4*)(mods + b * NMODS + 4 * D + k);
            float r[4];
            r[0] = v[j].x * rstd1 * gg.x * (1.f + sc.x) + sh.x; r[1] = v[j].y * rstd1 * gg.y * (1.f + sc.y) + sh.y;
            r[2] = v[j].z * rstd1 * gg.z * (1.f + sc.z) + sh.z; r[3] = v[j].w * rstd1 * gg.w * (1.f + sc.w) + sh.w;
            unsigned hi[4]; float lo[4];
#pragma unroll
            for (int q = 0; q < 4; ++q) { hi[q] = f2bf(r[q]); lo[q] = r[q] - bf2f(hi[q]); }
            ((uint2*)(h2 + (size_t)t * D) + c.lane)[64 * j] = make_uint2(hi[0] | (hi[1] << 16), hi[2] | (hi[3] << 16));
            ((uint2*)(h2 + (size_t)(T + t) * D) + c.lane)[64 * j] = make_uint2(pk2(lo[0], lo[1]), pk2(lo[2], lo[3]));
        }
    }
}

__device__ __forceinline__ void phase9(const Ctx& c) {
    {
        pg8::Gemm g{(const bf16_t*)(c.ws + WS_A), (const bf16_t*)(c.ws + WS_WR_T), 2 * T, 512, D};
        pg8::StaticOrder S; S.init(2 * T, 512, c.G, c.bid);
        pg8::EpiF32 E{(float*)(c.ws + WS_PLOG), 512};
        pg8::gemm_phase<pg8::EpiF32, pg8::StaticOrder, true, true>(c.lds, g, S, E);
    }
    __syncthreads();
    {
        pg8::Gemm g{(const bf16_t*)(c.ws + WS_A), (const bf16_t*)(c.ws + WS_WSGU_T), T, 512, D};
        pg8::StaticOrder S; S.init(T, 512, c.G, c.bid);
        pg8::EpiSwiGLU E{(bf16_t*)(c.ws + WS_HS), 256};
        pg8::gemm_phase<pg8::EpiSwiGLU, pg8::StaticOrder, true, true>(c.lds, g, S, E);
    }
}

__device__ __forceinline__ void phase10(const Ctx& c) {
    const float* plog = (const float*)(c.ws + WS_PLOG); const float* rb = c.in[32];
    int* idx = (int*)(c.ws + WS_IDX); float* wt = (float*)(c.ws + WS_WT); unsigned* counts = (unsigned*)(c.ws + WS_COUNTS);
    const int gw = c.bid * 8 + c.wid, NW = c.G * 8, l = c.lane;
    const float4 bias = *(const float4*)(rb + l * 4);
    for (int t = gw; t < T; t += NW) {
        const float4 p0 = *(const float4*)(plog + (size_t)t * 512 + l * 4), p1 = *(const float4*)(plog + (size_t)t * 512 + 256 + l * 4);
        const float4 p2 = *(const float4*)(plog + (size_t)(T + t) * 512 + l * 4), p3 = *(const float4*)(plog + (size_t)(T + t) * 512 + 256 + l * 4);
        const float lg[4] = {p0.x + (p1.x + p2.x + p3.x), p0.y + (p1.y + p2.y + p3.y), p0.z + (p1.z + p2.z + p3.z), p0.w + (p1.w + p2.w + p3.w)};
        float s[4] = {sigmoidf_(lg[0]), sigmoidf_(lg[1]), sigmoidf_(lg[2]), sigmoidf_(lg[3])};
        float ch[4] = {s[0] + bias.x, s[1] + bias.y, s[2] + bias.z, s[3] + bias.w};
        float a1 = fmaxf(ch[0], ch[1]), a2 = fminf(ch[0], ch[1]);
        { const float b1 = fmaxf(ch[2], ch[3]), b2 = fminf(ch[2], ch[3]); const float n1 = fmaxf(a1, b1), n2 = fmaxf(fminf(a1, b1), fmaxf(a2, b2)); a1 = n1; a2 = n2; }
#pragma unroll
        for (int o = 1; o < 8; o <<= 1) { const float b1 = __shfl_xor(a1, o), b2 = __shfl_xor(a2, o); const float n1 = fmaxf(a1, b1), n2 = fmaxf(fminf(a1, b1), fmaxf(a2, b2)); a1 = n1; a2 = n2; }
        const float gs = a1 + a2; const int myg = l >> 3;
        int rank = 0;
#pragma unroll
        for (int g = 0; g < 8; ++g) { const float og = __shfl(gs, g * 8); rank += (og > gs || (og == gs && g < myg)) ? 1 : 0; }
        const bool sel = rank < 4;
        float mc[4];
#pragma unroll
        for (int i = 0; i < 4; ++i) mc[i] = sel ? ch[i] : -INFINITY;
        float sk[8]; int ek[8]; float ssum = 0.f;
#pragma unroll
        for (int k = 0; k < 8; ++k) {
            float bv = mc[0]; int be = l * 4;
#pragma unroll
            for (int i = 1; i < 4; ++i) if (mc[i] > bv) { bv = mc[i]; be = l * 4 + i; }
#pragma unroll
            for (int o = 1; o < 64; o <<= 1) { const float ov = __shfl_xor(bv, o); const int oe = __shfl_xor(be, o); if (ov > bv || (ov == bv && oe < be)) { bv = ov; be = oe; } }
            const int ii = be & 3;
            float sv = s[0]; sv = (ii == 1) ? s[1] : sv; sv = (ii == 2) ? s[2] : sv; sv = (ii == 3) ? s[3] : sv;
            sv = __shfl(sv, be >> 2);
            if ((be >> 2) == l) {
#pragma unroll
                for (int i = 0; i < 4; ++i) if (i == ii) mc[i] = -INFINITY;
            }
            sk[k] = sv; ek[k] = be; ssum += sv;
        }
        if (l == 0) {
            const float inv = 2.5f / ssum;
#pragma unroll
            for (int k = 0; k < 8; ++k) { idx[t * 8 + k] = ek[k]; wt[t * 8 + k] = sk[k] * inv; atomicAdd(&counts[ek[k]], 1u); }
        }
    }
}

__device__ __forceinline__ void build_ustart(const Ctx& c, int* smi) {
    const unsigned* counts = (const unsigned*)(c.ws + WS_COUNTS);
    __syncthreads();
    if (c.tid == 0) {
        int u = 0;
        for (int e = 0; e < NE; ++e) { smi[e] = u; u += ((int)counts[e] + 255) >> 8; }
        smi[NE] = u;
    }
    __syncthreads();
}

__device__ __forceinline__ void phase11(const Ctx& c) {
    int* smi = (int*)c.sm;
    build_ustart(c, smi);
    const int* idx = (const int*)(c.ws + WS_IDX); int* slotp = (int*)(c.ws + WS_SLOTP); int* uexp = (int*)(c.ws + WS_UEXP);
    unsigned* cursor = (unsigned*)(c.ws + WS_COUNTS) + 256; const unsigned* counts = (const unsigned*)(c.ws + WS_COUNTS);
    const int gt = c.bid * 512 + c.tid, NT = c.G * 512;
    for (int a = gt; a < T * 8; a += NT) {
        const int e = idx[a];
        const unsigned pos = atomicAdd(&cursor[e], 1u);
        slotp[smi[e] * 256 + (int)pos] = a;
    }
    for (int e = gt; e < NE; e += NT) {
        const int u0 = smi[e], u1 = smi[e + 1], cn = (int)counts[e];
        for (int p = cn; p < (u1 - u0) * 256; ++p) slotp[u0 * 256 + p] = -1;
        for (int u = u0; u < u1; ++u) uexp[u] = e;
    }
    if (gt == 0) uexp[2048] = smi[NE];
}

__device__ __forceinline__ void phase12(const Ctx& c) {
    const int* uexp = (const int*)(c.ws + WS_UEXP);
    const int NU = __builtin_amdgcn_readfirstlane(uexp[2048]);
    const int vcu = (c.G % 8 == 0) ? (c.bid % 8) * (c.G / 8) + c.bid / 8 : c.bid;
    pg8::Gemm g{(const bf16_t*)(c.ws + WS_A), (const bf16_t*)(c.ws + WS_WEGU), 0, 0, D, (const int*)(c.ws + WS_SLOTP)};
    pg8::ExpertOrder S{uexp, NU, 2, c.G, vcu};
    pg8::EpiSwiGLU E{(bf16_t*)(c.ws + WS_HID), 256};
    pg8::gemm_phase<pg8::EpiSwiGLU, pg8::ExpertOrder, true, true, true>(c.lds, g, S, E);
}

__device__ __forceinline__ void phase13(const Ctx& c) {
    {
        const int* uexp = (const int*)(c.ws + WS_UEXP);
        const int NU = __builtin_amdgcn_readfirstlane(uexp[2048]);
        const int vcu = (c.G % 8 == 0) ? (c.bid % 8) * (c.G / 8) + c.bid / 8 : c.bid;
        pg8::Gemm g{(const bf16_t*)(c.ws + WS_HID), (const bf16_t*)(c.ws + WS_WED), 0, 0, EFF};
        pg8::ExpertOrder S{uexp, NU, 4, c.G, vcu};
        pg8::EpiScatter E{(const int*)(c.ws + WS_SLOTP), (const float*)(c.ws + WS_WT), (bf16_t*)(c.ws + WS_YEXP), D};
        pg8::gemm_phase<pg8::EpiScatter, pg8::ExpertOrder, true, true>(c.lds, g, S, E);
    }
    __syncthreads();
    {
        pg8::Gemm g{(const bf16_t*)(c.ws + WS_HS), (const bf16_t*)(c.ws + WS_WSD_T), T, D, 256};
        pg8::StaticOrder S; S.init(T, D, c.G, c.bid);
        pg8::EpiF32 E{(float*)(c.ws + WS_SHOUT), D};
        pg8::gemm_phase<pg8::EpiF32, pg8::StaticOrder, true, true>(c.lds, g, S, E);
    }
}

__device__ __forceinline__ void phase14(const Ctx& c) {
    const float* gq = c.in[7]; const float* mods = (const float*)(c.ws + WS_MODS);
    const float* shout = (const float*)(c.ws + WS_SHOUT); const bf16_t* yexp = (const bf16_t*)(c.ws + WS_YEXP);
    float* out = c.out;
    const int gw = c.bid * 8 + c.wid, NW = c.G * 8;
    for (int t = gw; t < T; t += NW) {
        const int b = t / SEQ;
        float4 y[4]; float ss = 0.f;
#pragma unroll
        for (int j = 0; j < 4; ++j) {
            const int k = (c.lane + 64 * j) * 4;
            float4 a = *(const float4*)(shout + (size_t)t * D + k);
#pragma unroll
            for (int q = 0; q < 8; ++q) {
                const float4 v = ldbf4(yexp + (size_t)(t * 8 + q) * D + k);
                a.x += v.x; a.y += v.y; a.z += v.z; a.w += v.w;
            }
            y[j] = a; ss += a.x * a.x + a.y * a.y + a.z * a.z + a.w * a.w;
        }
        const float rstd = rsqrtf(wave_sum(ss) * (1.0f / D) + 1e-6f);
#pragma unroll
        for (int j = 0; j < 4; ++j) {
            const int k = (c.lane + 64 * j) * 4;
            const float4 gg = *(const float4*)(gq + k);
            const float4 gt = *(const float4*)(mods + b * NMODS + 5 * D + k);
            float4 x1 = *(const float4*)(out + (size_t)t * D + k);
            x1.x += gt.x * (y[j].x * rstd * gg.x); x1.y += gt.y * (y[j].y * rstd * gg.y);
            x1.z += gt.z * (y[j].z * rstd * gg.z); x1.w += gt.w * (y[j].w * rstd * gg.w);
            *(float4*)(out + (size_t)t * D + k) = x1;
        }
    }
}

constexpr int NPHASES = 15;

__global__ void __launch_bounds__(512, 2) mega(Args args) {
    extern __shared__ __attribute__((aligned(16))) unsigned char lds_raw[];
    Ctx c;
    c.in = args.in; c.out = args.out; c.ws = args.ws;
    c.lds = (LAS unsigned char*)lds_raw; c.sm = (float*)lds_raw;
    c.tid = threadIdx.x; c.lane = c.tid & 63; c.wid = __builtin_amdgcn_readfirstlane(c.tid >> 6); c.bid = blockIdx.x; c.G = gridDim.x;
    volatile LAS unsigned* st = (volatile LAS unsigned*)(c.lds + LDS_CTL_OFF);
    if (c.tid < 4) st[c.tid] = 0u;
    __syncthreads();
    XcdBarrier bar; bar.bar = (unsigned*)(args.ws + WS_CTL); bar.x = 0; bar.st = st;
    const bool multi = (args.hi - args.lo) > 1;
    if (multi) bar = xcd_barrier_post((unsigned*)(args.ws + WS_CTL), st);
    const int lo = args.lo, hi = args.hi;
#ifndef REPEAT_PHASE
#define REPEAT_PHASE -1
#endif
#define RUN_PHASE(k, call) if (lo <= (k) && (k) < hi) { if ((k) == REPEAT_PHASE) { call; xcd_barrier(bar); } call; if ((k) + 1 < hi) xcd_barrier(bar); }
    RUN_PHASE(0, phase0(c))
    RUN_PHASE(1, phase1(c))
    RUN_PHASE(2, phase2(c))
    RUN_PHASE(3, phase3(c))
    RUN_PHASE(4, phase4(c))
    RUN_PHASE(5, phase5(c))
    RUN_PHASE(6, phase6(c))
    RUN_PHASE(7, phase7(c))
    RUN_PHASE(8, phase8(c))
    RUN_PHASE(9, phase9(c))
    RUN_PHASE(10, phase10(c))
    RUN_PHASE(11, phase11(c))
    RUN_PHASE(12, phase12(c))
    RUN_PHASE(13, phase13(c))
    RUN_PHASE(14, phase14(c))
#undef RUN_PHASE
}

#ifndef N_LAUNCH_MODE
#define N_LAUNCH_MODE 1
#endif

extern "C" void kernel_launch(void* const* d_in, const int* in_sizes, int n_in, void* d_out, int out_size, void* d_ws, size_t ws_size, hipStream_t stream) {
    static int grid = 0;
    if (grid == 0) {
        if (n_in != 39 || out_size != T * D || ws_size < WS_END) { fprintf(stderr, "kernel_launch: unexpected shapes n_in %d out %d ws %zu\n", n_in, out_size, ws_size); grid = -1; return; }
        int dev = 0, cus = 0, per_cu = 0;
        if (hipGetDevice(&dev) != hipSuccess || hipDeviceGetAttribute(&cus, hipDeviceAttributeMultiprocessorCount, dev) != hipSuccess) { grid = -1; return; }
        if (hipFuncSetAttribute((const void*)mega, hipFuncAttributeMaxDynamicSharedMemorySize, LDS_BYTES) != hipSuccess) { grid = -1; return; }
        if (hipOccupancyMaxActiveBlocksPerMultiprocessor(&per_cu, (const void*)mega, 512, LDS_BYTES) != hipSuccess || per_cu < 1) { fprintf(stderr, "kernel_launch: occupancy query says %d\n", per_cu); }
        (void)hipGetLastError();
        grid = cus;
    }
    if (grid < 0) return;
    (void)hipMemsetAsync((char*)d_ws + WS_CTL, 0, CTL_BYTES, stream);
    Args a{};
    for (int i = 0; i < 39; ++i) a.in[i] = (const float*)d_in[i];
    a.out = (float*)d_out; a.ws = (unsigned char*)d_ws;
    if (N_LAUNCH_MODE == 1) {
        a.lo = 0; a.hi = NPHASES;
        hipLaunchKernelGGL(mega, dim3(grid), dim3(512), LDS_BYTES, stream, a);
    } else {
        for (int ph = 0; ph < NPHASES; ++ph) {
            a.lo = ph; a.hi = ph + 1;
            hipLaunchKernelGGL(mega, dim3(grid), dim3(512), LDS_BYTES, stream, a);
        }
    }
}
```

```cpp
#include <hip/hip_runtime.h>
#include <cstdint>
#include <cstdio>

#define LAS __attribute__((address_space(3)))

constexpr int D = 1024, BATCH = 4, SEQ = 8192, T = BATCH * SEQ;
constexpr int RW = 512, NH = 8;
constexpr int RPROJ = 1792, NPROJ = 2304;
constexpr int S5NG = 32, S5P = 64;
constexpr int NE = 256, EFF = 256;
constexpr int NMODS = 6 * D;
constexpr int S5L = 32;

constexpr size_t MiB = 1u << 20;
constexpr size_t WS_CTL = 0, CTL_BYTES = 1 * MiB;
constexpr size_t WS_COUNTS = 64 * 1024;
constexpr size_t WS_MODS = 1 * MiB;
constexpr size_t WS_HMAT = 2 * MiB;
constexpr size_t WS_WIN_T = 12 * MiB;
constexpr size_t WS_WOUT_T = 17 * MiB;
constexpr size_t WS_WGLU_T = 19 * MiB;
constexpr size_t WS_WSGU_T = 19 * MiB + 512 * 1024;
constexpr size_t WS_WSD_T = 20 * MiB + 512 * 1024;
constexpr size_t WS_WR_T = 21 * MiB;
constexpr size_t WS_LORA_BT = 22 * MiB;
constexpr size_t WS_APOW = 23 * MiB;
constexpr size_t WS_KMAT = 1000 * MiB;
constexpr size_t WS_MODSP = 1020 * MiB;
constexpr size_t WS_S5BB = 1022 * MiB;
constexpr size_t WS_KLAG = 1022 * MiB + 512 * 1024;
constexpr size_t OUT_UX = 0;
constexpr size_t OUT_E = 40 * MiB;
constexpr size_t OUT_ALORA = 56 * MiB;
constexpr size_t WS_WED = 24 * MiB;
constexpr size_t WS_WEGU = 152 * MiB;
constexpr size_t WS_A = 408 * MiB;
constexpr size_t WS_YS5 = WS_A + 64 * MiB;
constexpr size_t WS_PROJ = 536 * MiB;
constexpr size_t WS_RW = 680 * MiB;
constexpr size_t RWSZ = (size_t)T * RW * 4;
constexpr size_t RWSZH = (size_t)T * RW * 2;
constexpr size_t WS_RW_W = WS_RW, WS_RW_Y = WS_RW + RWSZ, WS_RW_R = WS_RW + 2 * RWSZ, WS_RW_K = WS_RW_R + RWSZH, WS_RW_V = WS_RW_K + RWSZH,
                 WS_RW_A = WS_RW_V + RWSZH, WS_RW_B = WS_RW_A + RWSZH, WS_RW_G = WS_RW_B + RWSZH;
constexpr size_t WS_PLOG = 680 * MiB;
constexpr size_t WS_SHOUT = 680 * MiB;
constexpr size_t WS_HS = 808 * MiB;
constexpr size_t WS_IDX = 824 * MiB;
constexpr size_t WS_WT = 825 * MiB;
constexpr size_t WS_SLOTP = 826 * MiB;
constexpr size_t WS_UEXP = 827 * MiB + 512 * 1024;
constexpr size_t WS_HID = 840 * MiB;
constexpr size_t WS_YEXP = 152 * MiB;
constexpr size_t WS_END = 1023 * MiB + 512 * 1024;

constexpr int LDS_BYTES = 132096;
constexpr int LDS_CTL_OFF = 131072;

#define XB_TMO      128
#define XB_XCNT(j)  (256  + 64 * (j))
#define XB_XSUB(j)  (1280 + 64 * (j))
#define XB_XGEN(j)  (2304 + 64 * (j))
#define XB_TOP      3328
#define XB_TOPGEN   3392
#define XCD_BAR_WORDS 3456
#define XB_SPIN_CAP (1u << 24)

__device__ __forceinline__ unsigned xb_ld(unsigned* p)              { return __hip_atomic_load(p, __ATOMIC_RELAXED, __HIP_MEMORY_SCOPE_AGENT); }
__device__ __forceinline__ unsigned xb_add(unsigned* p, unsigned v) { return __hip_atomic_fetch_add(p, v, __ATOMIC_RELAXED, __HIP_MEMORY_SCOPE_AGENT); }
__device__ __forceinline__ unsigned xb_xcc_id() { return (unsigned)__builtin_amdgcn_s_getreg((3 << 11) | 20) & 0xFu; }
#define XB_SPIN(cond, bar) do { unsigned _sp = 0; while (cond) { __builtin_amdgcn_s_sleep(1); \
    if ((++_sp & 255u) == 0u) { if (xb_ld(&(bar)[XB_TMO])) break; if (_sp > XB_SPIN_CAP) { atomicAdd(&(bar)[XB_TMO], 1u); break; } } } } while (0)

struct XcdBarrier { unsigned* bar; unsigned x; volatile LAS unsigned* st; };

__device__ __forceinline__ XcdBarrier xcd_barrier_post(unsigned* bar, volatile LAS unsigned* st) {
    XcdBarrier b; b.bar = bar; b.x = xb_xcc_id(); b.st = st;
    if (threadIdx.x == 0) (void)xb_add(&bar[XB_XCNT(b.x)], 1u);
    return b;
}
__device__ __forceinline__ void xcd_barrier_complete(unsigned* bar, unsigned x, unsigned& nloc, unsigned& nx) {
    const unsigned G = gridDim.x * gridDim.y * gridDim.z;
    unsigned sum, cnt, mine, sp = 0u;
    for (;;) {
        sum = 0u; cnt = 0u; mine = 0u;
#pragma unroll
        for (unsigned j = 0; j < 16; ++j) { const unsigned c = xb_ld(&bar[XB_XCNT(j)]); sum += c; cnt += (c > 0u) ? 1u : 0u; mine = (j == x) ? c : mine; }
        if (sum == G) break;
        __builtin_amdgcn_s_sleep(1);
        if ((++sp & 255u) == 0u) { if (xb_ld(&bar[XB_TMO])) break; if (sp > XB_SPIN_CAP) { atomicAdd(&bar[XB_TMO], 1u); break; } }
    }
    nloc = mine > 0u ? mine : 1u; nx = cnt > 0u ? cnt : 1u;
}
__device__ __forceinline__ void xcd_barrier(const XcdBarrier& b) {
    asm volatile("s_waitcnt vmcnt(0)" ::: "memory");
    __syncthreads();
    if (threadIdx.x == 0) {
        unsigned* bar = b.bar;
        __builtin_amdgcn_s_waitcnt(0);
        unsigned nloc = b.st[0], nx = b.st[1];
        if (nloc == 0u) { xcd_barrier_complete(bar, b.x, nloc, nx); b.st[0] = nloc; b.st[1] = nx; }
        const unsigned old = xb_add(&bar[XB_XSUB(b.x)], 1u);
        const unsigned gen = old / nloc;
        if (old + 1u == (gen + 1u) * nloc) {
            __builtin_amdgcn_fence(__ATOMIC_RELEASE, "agent");
            asm volatile("s_waitcnt vmcnt(0)" ::: "memory");
            const unsigned og = xb_add(&bar[XB_TOP], 1u);
            const unsigned tg = og / nx;
            if (og + 1u == (tg + 1u) * nx) xb_add(&bar[XB_TOPGEN], 1u);
            else XB_SPIN(xb_ld(&bar[XB_TOPGEN]) == tg, bar);
            __builtin_amdgcn_fence(__ATOMIC_ACQUIRE, "agent");
            xb_add(&bar[XB_XGEN(b.x)], 1u);
            asm volatile("s_waitcnt vmcnt(0)" ::: "memory");
        } else {
            XB_SPIN(xb_ld(&bar[XB_XGEN(b.x)]) == gen, bar);
            __builtin_amdgcn_fence(__ATOMIC_ACQUIRE, "agent");
            asm volatile("s_waitcnt vmcnt(0)" ::: "memory");
        }
    }
    __syncthreads();
}

namespace pg8 {
#define PG8_LAS __attribute__((address_space(3)))
typedef unsigned short bf16_t;
typedef short bf16x8 __attribute__((ext_vector_type(8)));
typedef float f32x4 __attribute__((ext_vector_type(4)));
typedef unsigned u32x4 __attribute__((ext_vector_type(4)));
constexpr int BM = 256, BK = 64, HALF = 128, HTB = HALF * BK * 2  , STAGE_BYTES = 8 * HTB, NXCD = 8, WGM = 8;

__host__ __device__ __forceinline__ int lds_byte(int r, int c) { const int st = (r >> 4) * 2 + (c >> 5), rr = r & 15, cc = c & 31, ob = rr * 64 + cc * 2; return st * 1024 + (ob ^ (((ob >> 9) & 1) << 5)); }
__host__ __device__ __forceinline__ void stage_rc(int b, int& R, int& C) { const int st = b / 1024, sb = b % 1024, swz = sb ^ (((sb >> 9) & 1) << 5); R = (st >> 1) * 16 + swz / 64; C = (st & 1) * 32 + (swz % 64) / 2; }
__host__ __device__ __forceinline__ int perm32(int rho) { const int n = rho >> 4, i = rho & 15; return 8 * (i >> 2) + 4 * n + (i & 3); }

struct Unit { int pm, pn; };
struct Gemm { const bf16_t* A; const bf16_t* Bt; int M, N, K; const int* rowtab = nullptr; };

struct StaticOrder {
    int nM, nN, nwg, G, c;
    __host__ __device__ void init(int M, int N, int G_, int c_) { nM = M / BM; nN = N / BM; nwg = nM * nN; G = G_; c = c_; }
    __host__ __device__ bool next(int i, Unit& u) const {
        const long L = (long)i * G + c; if (L >= nwg) return false;
        int wgid = (int)L; { const int q = nwg / NXCD, r = nwg % NXCD, xcd = wgid % NXCD, off = wgid / NXCD; wgid = (xcd < r ? xcd * (q + 1) : r * (q + 1) + (xcd - r) * q) + off; }
        const int nig = WGM * nN, gid = wgid / nig, fm = gid * WGM, gsz = (nM - fm) < WGM ? (nM - fm) : WGM;
        u.pm = fm + ((wgid % nig) % gsz); u.pn = (wgid % nig) / gsz; return true;
    }
    __device__ __forceinline__ void a_ready(const Unit&) const {}
    __device__ __forceinline__ void done(const Unit&) const {}
};

__device__ __forceinline__ unsigned cvt_pk_bf16(float lo, float hi) { unsigned r; asm volatile("v_cvt_pk_bf16_f32 %0, %1, %2" : "=v"(r) : "v"(lo), "v"(hi)); return r; }
typedef float f32x2 __attribute__((ext_vector_type(2)));
__device__ __forceinline__ f32x2 gelu_pk(f32x2 v) {
    const f32x2 av = __builtin_elementwise_abs(v), d = av * 0.2316418882f + 1.0f;
    f32x2 t; t.x = __builtin_amdgcn_rcpf(d.x); t.y = __builtin_amdgcn_rcpf(d.y);
    f32x2 q = t * 0.5307027145f + (-0.7265760135f); q = q * t + 0.7107068705f; q = q * t + (-0.142248368f); q = q * t + 0.127414796f; q = q * t;
    const f32x2 s = (v * v) * (-0.72134752044f);
    f32x2 e; e.x = __builtin_amdgcn_exp2f(s.x); e.y = __builtin_amdgcn_exp2f(s.y);
    const f32x2 m = v * (q * e), r = v - m;
    f32x2 o; o.x = v.x < 0.f ? m.x : r.x; o.y = v.y < 0.f ? m.y : r.y; return o;
}

template <int ACT  > struct EpiBf16 {
    static constexpr bool PERM = true, AFTER_DRAIN = false; static_assert(ACT == 0 || ACT == 1, "EpiBf16: ACT is 0 (none) or 1 (gelu_pk)");
    bf16_t* O; int ldc; const float* bias; int split_cols; size_t split_stride; float scale0;
    __device__ __forceinline__ void operator()(const f32x4 (&acc)[2][2][4][2], const Unit& u, int wr, int wc, int fr, int fq) const {
        const int row0 = u.pm * BM + wr * 64 + fr; int colt = u.pn * BM; bf16_t* base = O;
        float sc = 1.f; if (split_cols) { const int t = colt / split_cols; base += (size_t)t * split_stride; colt -= t * split_cols; if (t == 0) sc = scale0; }
        const int col0 = colt + wc * 32 + 8 * fq, bcol0 = u.pn * BM + wc * 32 + 8 * fq;
        f32x4 bv[2][2];
#pragma unroll
        for (int bj = 0; bj < 2; ++bj)
#pragma unroll
            for (int n = 0; n < 2; ++n) bv[bj][n] = bias ? *(const f32x4*)(bias + bcol0 + bj * HALF + 4 * n) : (f32x4){0.f, 0.f, 0.f, 0.f};
#pragma unroll
        for (int ai = 0; ai < 2; ++ai)
#pragma unroll
            for (int m = 0; m < 4; ++m) { bf16_t* rowp = base + (size_t)(row0 + ai * HALF + m * 16) * ldc + col0;
#pragma unroll
                for (int bj = 0; bj < 2; ++bj) { f32x4 v0 = acc[ai][bj][m][0] + bv[bj][0], v1 = acc[ai][bj][m][1] + bv[bj][1];
                    if (ACT == 1) { f32x2 a = gelu_pk((f32x2){v0[0], v0[1]}), b = gelu_pk((f32x2){v0[2], v0[3]}), c = gelu_pk((f32x2){v1[0], v1[1]}), d = gelu_pk((f32x2){v1[2], v1[3]});
                        v0 = (f32x4){a.x, a.y, b.x, b.y}; v1 = (f32x4){c.x, c.y, d.x, d.y}; }
                    v0 = v0 * sc; v1 = v1 * sc; u32x4 w; w.x = cvt_pk_bf16(v0[0], v0[1]); w.y = cvt_pk_bf16(v0[2], v0[3]); w.z = cvt_pk_bf16(v1[0], v1[1]); w.w = cvt_pk_bf16(v1[2], v1[3]);
                    *(u32x4*)(rowp + bj * HALF) = w; } }
    }
};

struct EpiF32 {
    static constexpr bool PERM = false, AFTER_DRAIN = false;
    float* C; int ldc;
    __device__ __forceinline__ void operator()(const f32x4 (&acc)[2][2][4][2], const Unit& u, int wr, int wc, int fr, int fq) const {
        const int row0 = u.pm * BM + wr * 64 + fr, col0 = u.pn * BM + wc * 32 + 4 * fq;
#pragma unroll
        for (int ai = 0; ai < 2; ++ai)
#pragma unroll
            for (int m = 0; m < 4; ++m) { float* rowp = C + (size_t)(row0 + ai * HALF + m * 16) * ldc + col0;
#pragma unroll
                for (int bj = 0; bj < 2; ++bj)
#pragma unroll
                    for (int n = 0; n < 2; ++n) *(f32x4*)(rowp + bj * HALF + n * 16) = acc[ai][bj][m][n]; }
    }
};
__device__ __forceinline__ float fast_sigmoid(float x) { return __builtin_amdgcn_rcpf(1.0f + __builtin_amdgcn_exp2f(-1.4426950408889634f * x)); }
struct EpiSwiGLU {
    static constexpr bool PERM = true, AFTER_DRAIN = false;
    bf16_t* O; int ldo;
    __device__ __forceinline__ void operator()(const f32x4 (&acc)[2][2][4][2], const Unit& u, int wr, int wc, int fr, int fq) const {
        const int row0 = u.pm * BM + wr * 64 + fr, col0 = (u.pn & 1) * HALF + wc * 32 + 8 * fq;
#pragma unroll
        for (int ai = 0; ai < 2; ++ai)
#pragma unroll
            for (int m = 0; m < 4; ++m) {
                bf16_t* rowp = O + (size_t)(row0 + ai * HALF + m * 16) * ldo + col0;
                const f32x4 g0 = acc[ai][0][m][0], g1 = acc[ai][0][m][1], u0 = acc[ai][1][m][0], u1 = acc[ai][1][m][1];
                float r[8];
#pragma unroll
                for (int i = 0; i < 4; ++i) { r[i] = g0[i] * fast_sigmoid(g0[i]) * u0[i]; r[4 + i] = g1[i] * fast_sigmoid(g1[i]) * u1[i]; }
                u32x4 w; w.x = cvt_pk_bf16(r[0], r[1]); w.y = cvt_pk_bf16(r[2], r[3]); w.z = cvt_pk_bf16(r[4], r[5]); w.w = cvt_pk_bf16(r[6], r[7]);
                *(u32x4*)rowp = w;
            }
    }
};
struct EpiScatter {
    static constexpr bool PERM = true, AFTER_DRAIN = false;
    const int* slotp; const float* wt; bf16_t* Y; int ldy;
    __device__ __forceinline__ void operator()(const f32x4 (&acc)[2][2][4][2], const Unit& u, int wr, int wc, int fr, int fq) const {
        int t2 = threadIdx.x; asm volatile("" : "+v"(t2));
        const int fr2 = t2 & 15, fq2 = (t2 >> 4) & 3, wc2 = (t2 >> 6) & 3, wr2 = (t2 >> 8) & 1;
        const int col0 = (u.pn & 3) * BM + wc2 * 32 + 8 * fq2;
        const int rbase = u.pm * BM + wr2 * 64 + fr2;
#pragma unroll
        for (int ai = 0; ai < 2; ++ai)
#pragma unroll
            for (int m = 0; m < 4; ++m) {
                const int aid = slotp[rbase + ai * HALF + m * 16];
                if (aid >= 0) {
                    const float w = wt[aid];
                    bf16_t* rowp = Y + (size_t)aid * ldy + col0;
#pragma unroll
                    for (int bj = 0; bj < 2; ++bj) {
                        const f32x4 v0 = acc[ai][bj][m][0] * w, v1 = acc[ai][bj][m][1] * w;
                        u32x4 o; o.x = cvt_pk_bf16(v0[0], v0[1]); o.y = cvt_pk_bf16(v0[2], v0[3]); o.z = cvt_pk_bf16(v1[0], v1[1]); o.w = cvt_pk_bf16(v1[2], v1[3]);
                        *(u32x4*)(rowp + bj * HALF) = o;
                    }
                }
            }
    }
};
struct ExpertOrder {
    const int* uexp; int NU, npn, G, c;
    __device__ __forceinline__ bool next(int i, Unit& u) const {
        const int L = i * G + c; if (L >= NU * npn) return false;
        const int uu = L / npn, pl = L % npn;
        u.pm = uu; u.pn = __builtin_amdgcn_readfirstlane(uexp[uu]) * npn + pl; return true;
    }
    __device__ __forceinline__ void a_ready(const Unit&) const {}
    __device__ __forceinline__ void done(const Unit&) const {}
};
struct S5Order {
    int NUNITS, npn, G, c;
    __device__ __forceinline__ bool next(int i, Unit& u) const {
        const int L = i * G + c; if (L >= NUNITS) return false;
        u.pm = L / npn; u.pn = (u.pm >> 2) * npn + L % npn; return true;
    }
    __device__ __forceinline__ void a_ready(const Unit&) const {}
    __device__ __forceinline__ void done(const Unit&) const {}
};
struct EpiS5E {
    static constexpr bool PERM = false, AFTER_DRAIN = false;
    float* E;
    __device__ __forceinline__ void operator()(const f32x4 (&acc)[2][2][4][2], const Unit& u, int wr, int wc, int fr, int fq) const {
        const int row0 = u.pm * BM + wr * 64 + fr, col0 = wc * 32 + 4 * fq;
#pragma unroll
        for (int ai = 0; ai < 2; ++ai)
#pragma unroll
            for (int m = 0; m < 4; ++m) { float* rowp = E + (size_t)(row0 + ai * HALF + m * 16) * 128 + col0;
#pragma unroll
                for (int n = 0; n < 2; ++n) *(f32x4*)(rowp + n * 16) = acc[ai][0][m][n]; }
    }
};
struct EpiS5Out {
    static constexpr bool PERM = true, AFTER_DRAIN = false;
    bf16_t* Y;
    __device__ __forceinline__ void operator()(const f32x4 (&acc)[2][2][4][2], const Unit& u, int wr, int wc, int fr, int fq) const {
        const int g = u.pm >> 2;
#pragma unroll
        for (int ai = 0; ai < 2; ++ai)
#pragma unroll
            for (int m = 0; m < 4; ++m) {
                const int r = (u.pm & 3) * BM + ai * HALF + wr * 64 + m * 16 + fr, b = r >> 8, chunk = r & 255;
#pragma unroll
                for (int bj = 0; bj < 2; ++bj) {
                    const int colg = (u.pn & 1) * BM + bj * HALF + wc * 32 + 8 * fq, t = colg >> 4, c0 = colg & 15;
                    const f32x4 v0 = acc[ai][bj][m][0], v1 = acc[ai][bj][m][1];
                    float x[8] = {v0[0], v0[1], v0[2], v0[3], v1[0], v1[1], v1[2], v1[3]};
#pragma unroll
                    for (int i = 0; i < 8; ++i) { const float z = x[i]; x[i] = z * fast_sigmoid(1.5957691216057308f * (z + 0.044715f * z * z * z)); }
                    u32x4 w; w.x = cvt_pk_bf16(x[0], x[1]); w.y = cvt_pk_bf16(x[2], x[3]); w.z = cvt_pk_bf16(x[4], x[5]); w.w = cvt_pk_bf16(x[6], x[7]);
                    *(u32x4*)(Y + ((size_t)(b * 8192 + chunk * 32 + t)) * 512 + g * 16 + c0) = w;
                }
            }
    }
};
struct EpiLora {
    static constexpr bool PERM = true, AFTER_DRAIN = false;
    const float* w0; const float* a0; const float* k_a; float* W; bf16_t* Kp; const bf16_t* A; bf16_t* B; bf16_t* Gt;
    __device__ __forceinline__ void operator()(const f32x4 (&acc)[2][2][4][2], const Unit& u, int wr, int wc, int fr, int fq) const {
        const int seg = u.pn >> 1;
#pragma unroll
        for (int bj = 0; bj < 2; ++bj) {
            const int nn = (u.pn & 1) * BM + bj * HALF + wc * 32 + 8 * fq;
            float p0[8], p1[8];
            if (seg == 0) { const f32x4 a = *(const f32x4*)(w0 + nn), b = *(const f32x4*)(w0 + nn + 4); p0[0] = a[0]; p0[1] = a[1]; p0[2] = a[2]; p0[3] = a[3]; p0[4] = b[0]; p0[5] = b[1]; p0[6] = b[2]; p0[7] = b[3]; }
            else if (seg == 1) { const f32x4 a = *(const f32x4*)(a0 + nn), b = *(const f32x4*)(a0 + nn + 4), cc = *(const f32x4*)(k_a + nn), d = *(const f32x4*)(k_a + nn + 4);
                p0[0] = a[0]; p0[1] = a[1]; p0[2] = a[2]; p0[3] = a[3]; p0[4] = b[0]; p0[5] = b[1]; p0[6] = b[2]; p0[7] = b[3];
                p1[0] = cc[0]; p1[1] = cc[1]; p1[2] = cc[2]; p1[3] = cc[3]; p1[4] = d[0]; p1[5] = d[1]; p1[6] = d[2]; p1[7] = d[3]; }
#pragma unroll
            for (int ai = 0; ai < 2; ++ai)
#pragma unroll
                for (int m = 0; m < 4; ++m) {
                    const size_t off = (size_t)(u.pm * BM + ai * HALF + wr * 64 + m * 16 + fr) * 512 + nn;
                    const f32x4 v0 = acc[ai][bj][m][0], v1 = acc[ai][bj][m][1];
                    const float x[8] = {v0[0], v0[1], v0[2], v0[3], v1[0], v1[1], v1[2], v1[3]};
                    if (seg == 0) {
                        float o[8];
#pragma unroll
                        for (int i = 0; i < 8; ++i) { const float wa = p0[i] + x[i];
                            const float sp = __logf(1.0f + __expf(-wa));
                            o[i] = __expf(-__expf(-sp - 0.5f)); }
                        *(f32x4*)(W + off) = (f32x4){o[0], o[1], o[2], o[3]}; *(f32x4*)(W + off + 4) = (f32x4){o[4], o[5], o[6], o[7]};
                    } else if (seg == 1) {
                        const u32x4 kv = *(const u32x4*)(Kp + off), av = *(const u32x4*)(A + off);
                        const float k[8] = {__builtin_bit_cast(float, kv.x << 16), __builtin_bit_cast(float, kv.x & 0xffff0000u), __builtin_bit_cast(float, kv.y << 16), __builtin_bit_cast(float, kv.y & 0xffff0000u),
                                            __builtin_bit_cast(float, kv.z << 16), __builtin_bit_cast(float, kv.z & 0xffff0000u), __builtin_bit_cast(float, kv.w << 16), __builtin_bit_cast(float, kv.w & 0xffff0000u)};
                        const float a[8] = {__builtin_bit_cast(float, av.x << 16), __builtin_bit_cast(float, av.x & 0xffff0000u), __builtin_bit_cast(float, av.y << 16), __builtin_bit_cast(float, av.y & 0xffff0000u),
                                            __builtin_bit_cast(float, av.z << 16), __builtin_bit_cast(float, av.z & 0xffff0000u), __builtin_bit_cast(float, av.w << 16), __builtin_bit_cast(float, av.w & 0xffff0000u)};
                        float kf[8], bo[8];
#pragma unroll
                        for (int i = 0; i < 8; ++i) { const float ic = fast_sigmoid(p0[i] + x[i]); kf[i] = k[i] * (1.0f + (ic - 1.0f) * p1[i]); bo[i] = -a[i] * ic; }
                        u32x4 w; w.x = cvt_pk_bf16(kf[0], kf[1]); w.y = cvt_pk_bf16(kf[2], kf[3]); w.z = cvt_pk_bf16(kf[4], kf[5]); w.w = cvt_pk_bf16(kf[6], kf[7]);
                        *(u32x4*)(Kp + off) = w;
                        w.x = cvt_pk_bf16(bo[0], bo[1]); w.y = cvt_pk_bf16(bo[2], bo[3]); w.z = cvt_pk_bf16(bo[4], bo[5]); w.w = cvt_pk_bf16(bo[6], bo[7]);
                        *(u32x4*)(B + off) = w;
                    } else {
                        u32x4 w; w.x = cvt_pk_bf16(x[0], x[1]); w.y = cvt_pk_bf16(x[2], x[3]); w.z = cvt_pk_bf16(x[4], x[5]); w.w = cvt_pk_bf16(x[6], x[7]);
                        *(u32x4*)(Gt + off) = w;
                    }
                }
        }
    }
};
struct EpiGLU {
    static constexpr bool PERM = true, AFTER_DRAIN = false;
    const bf16_t* Y; int ldy; const float* bias; bf16_t* O; int ldo; int ocol0;
    __device__ __forceinline__ void operator()(const f32x4 (&acc)[2][2][4][2], const Unit& u, int wr, int wc, int fr, int fq) const {
        const int row0 = u.pm * BM + wr * 64 + fr, col0 = u.pn * BM + wc * 32 + 8 * fq;
#pragma unroll
        for (int bj = 0; bj < 2; ++bj) {
            const f32x4 b0 = *(const f32x4*)(bias + col0 + bj * HALF), b1 = *(const f32x4*)(bias + col0 + bj * HALF + 4);
#pragma unroll
            for (int ai = 0; ai < 2; ++ai)
#pragma unroll
                for (int m = 0; m < 4; ++m) {
                    const size_t row = (size_t)(row0 + ai * HALF + m * 16);
                    const u32x4 yv = *(const u32x4*)(Y + row * ldy + col0 + bj * HALF);
                    const f32x4 z0 = acc[ai][bj][m][0] + b0, z1 = acc[ai][bj][m][1] + b1;
                    float y[8] = {__builtin_bit_cast(float, yv.x << 16), __builtin_bit_cast(float, yv.x & 0xffff0000u), __builtin_bit_cast(float, yv.y << 16), __builtin_bit_cast(float, yv.y & 0xffff0000u),
                                  __builtin_bit_cast(float, yv.z << 16), __builtin_bit_cast(float, yv.z & 0xffff0000u), __builtin_bit_cast(float, yv.w << 16), __builtin_bit_cast(float, yv.w & 0xffff0000u)};
                    float r[8];
#pragma unroll
                    for (int i = 0; i < 4; ++i) { r[i] = y[i] * fast_sigmoid(z0[i]); r[4 + i] = y[4 + i] * fast_sigmoid(z1[i]); }
                    u32x4 w; w.x = cvt_pk_bf16(r[0], r[1]); w.y = cvt_pk_bf16(r[2], r[3]); w.z = cvt_pk_bf16(r[4], r[5]); w.w = cvt_pk_bf16(r[6], r[7]);
                    *(u32x4*)(O + row * ldo + ocol0 + col0 + bj * HALF) = w;
                }
        }
    }
};
template <class Epi, class Sched, bool ALIGN_EPI = false, bool SP2 = false, bool GATHER = false>
__device__ __forceinline__ void gemm_phase(PG8_LAS unsigned char* lds, const Gemm g, const Sched& S, const Epi& E) {
    int tid_ = threadIdx.x; asm volatile("" : "+v"(tid_));
    const int tid = tid_, wid = __builtin_amdgcn_readfirstlane(tid >> 6), lane = tid & 63, wr = wid >> 2, wc = wid & 3, fr = lane & 15, fq = lane >> 4;
    const int K = g.K, nt = K / BK;
    unsigned voffA[2], voffB[2];
#pragma unroll
    for (int i = 0; i < 2; ++i) { int R, C; stage_rc(tid * 16 + i * 8192, R, C); const int Rb = Epi::PERM ? ((R & ~31) + perm32(R & 31)) : R;
        voffA[i] = (unsigned)(R * K + C) * 2u; voffB[i] = (unsigned)(Rb * K + C) * 2u; }
    const size_t kstep = (size_t)(BK * 2);
    const size_t hstep = (size_t)HALF * K * 2;
    const size_t tstep = 2 * hstep;
    const unsigned ldsw = (unsigned)wid * 1024u;
    const int aoff = lds_byte(wr * 64 + fr, fq * 8), boff = lds_byte(wc * 32 + fr, fq * 8);
#define PG8_SA(b, h) (((b) * 2 + (h)) * HTB)
#define PG8_SB(b, h) ((4 + (b) * 2 + (h)) * HTB)
#define PG8_STAGE(bufoff, gbase, voff) do { _Pragma("unroll") for (int _i = 0; _i < 2; ++_i) \
        __builtin_amdgcn_global_load_lds((const unsigned*)((const char*)(gbase) + (voff)[_i]), (PG8_LAS unsigned*)(lds + (bufoff) + ldsw + _i * 8192), 16, 0, 0); } while (0)
#define PG8_STAGE_A(bufoff, kptr, h, NEXTSEL) do { if constexpr (GATHER) { const unsigned _p = (NEXTSEL) ? gnxt[h] : gcur[h]; const unsigned _v[2] = { (_p & 0xffffu) * (unsigned)(2 * K) + gC2, (_p >> 16) * (unsigned)(2 * K) + gC2 }; PG8_STAGE(bufoff, kptr, _v); } \
        else { PG8_STAGE(bufoff, (kptr) + (h) * hstep, voffA); } } while (0)
#define PG8_LDA(dst, b, h) do { _Pragma("unroll") for (int m = 0; m < 4; ++m) _Pragma("unroll") for (int k = 0; k < 2; ++k) dst[m][k] = *(const PG8_LAS bf16x8*)(lds + PG8_SA(b, h) + aoff + m * 2048 + k * 1024); } while (0)
#define PG8_LDB(dst, b, h) do { _Pragma("unroll") for (int n = 0; n < 2; ++n) _Pragma("unroll") for (int k = 0; k < 2; ++k) dst[n][k] = *(const PG8_LAS bf16x8*)(lds + PG8_SB(b, h) + boff + n * 2048 + k * 1024); } while (0)
#define PG8_MMA(ai, bj, At, Bt) do { __builtin_amdgcn_s_setprio(1); _Pragma("unroll") for (int m = 0; m < 4; ++m) _Pragma("unroll") for (int n = 0; n < 2; ++n) _Pragma("unroll") for (int k = 0; k < 2; ++k) \
        acc[ai][bj][m][n] = __builtin_amdgcn_mfma_f32_16x16x32_bf16(Bt[n][k], At[m][k], acc[ai][bj][m][n], 0, 0, 0); __builtin_amdgcn_s_setprio(0); } while (0)
#define PG8_WAIT_V(n) asm volatile("s_waitcnt vmcnt(" #n ")" ::: "memory")
#define PG8_WAIT_L(n) asm volatile("s_waitcnt lgkmcnt(" #n ")" ::: "memory")
#define PG8_BAR __builtin_amdgcn_s_barrier()
#define PG8_SCHED __builtin_amdgcn_sched_barrier(0)
    unsigned gcur[2], gnxt[2], gC2 = 0;
    if constexpr (GATHER) { int R, C; stage_rc(tid * 16, R, C); gC2 = (unsigned)C * 2u; }
    auto load_gather = [&](int pm, unsigned (&dst)[2]) {
        int R, C; stage_rc(tid * 16, R, C);
#pragma unroll
        for (int h = 0; h < 2; ++h) { int a0 = g.rowtab[pm * BM + h * HALF + R], a1 = g.rowtab[pm * BM + h * HALF + R + 64]; a0 = a0 < 0 ? 0 : a0; a1 = a1 < 0 ? 0 : a1; dst[h] = (unsigned)(a0 >> 3) | ((unsigned)(a1 >> 3) << 16); }
    };
    Unit cur, nxt; int ui = 0;
    if (!S.next(0, cur)) return;
    f32x4 acc[2][2][4][2];
#pragma unroll
    for (int a = 0; a < 2; ++a)
#pragma unroll
        for (int b = 0; b < 2; ++b)
#pragma unroll
            for (int m = 0; m < 4; ++m)
#pragma unroll
                for (int n = 0; n < 2; ++n) acc[a][b][m][n] = (f32x4){0.f, 0.f, 0.f, 0.f};
    bf16x8 At[4][2], B0[2][2], B1[2][2];
    const char* cA = (const char*)g.A + (GATHER ? (size_t)0 : (size_t)cur.pm * tstep); const char* cB = (const char*)g.Bt + (size_t)cur.pn * tstep;
    if constexpr (GATHER) { load_gather(cur.pm, gcur); }
    S.a_ready(cur);
    if constexpr (SP2) {
        PG8_STAGE(PG8_SB(0, 0), cB, voffB); PG8_STAGE(PG8_SB(0, 1), cB + hstep, voffB); PG8_STAGE_A(PG8_SA(0, 0), cA, 0, false); PG8_STAGE_A(PG8_SA(0, 1), cA, 1, false);
        if (wr == 1) PG8_BAR;
        PG8_WAIT_V(2); PG8_BAR;
        PG8_STAGE(PG8_SB(1, 0), cB + kstep, voffB); PG8_STAGE_A(PG8_SA(1, 0), cA + kstep, 0, false); PG8_STAGE(PG8_SB(1, 1), cB + hstep + kstep, voffB);
        PG8_WAIT_V(6); PG8_BAR;
    } else {
        PG8_STAGE(PG8_SB(0, 0), cB, voffB); PG8_STAGE_A(PG8_SA(0, 0), cA, 0, false); PG8_STAGE(PG8_SB(0, 1), cB + hstep, voffB); PG8_STAGE_A(PG8_SA(0, 1), cA, 1, false);
        if (wr == 1) PG8_BAR;
        PG8_WAIT_V(4); PG8_BAR;
        PG8_STAGE(PG8_SB(1, 0), cB + kstep, voffB); PG8_STAGE_A(PG8_SA(1, 0), cA + kstep, 0, false); PG8_STAGE(PG8_SB(1, 1), cB + hstep + kstep, voffB);
        PG8_WAIT_V(6); PG8_BAR;
    }
    for (;;) {
        const bool has_next = S.next(ui + 1, nxt);
        const char* nA = (has_next && !GATHER) ? (const char*)g.A + (size_t)nxt.pm * tstep : cA; const char* nB = has_next ? (const char*)g.Bt + (size_t)nxt.pn * tstep : cB;
        if constexpr (GATHER) { if (has_next) load_gather(nxt.pm, gnxt); else {
#pragma unroll
            for (int h = 0; h < 2; ++h) { gnxt[h] = gcur[h]; } } }
        for (int t = 0; t < nt; t += 2) {
            const bool last = (t == nt - 2);
            const char* a1 = cA + (size_t)(t + 1) * kstep;
            const char* a2 = last ? nA : cA + (size_t)(t + 2) * kstep; const char* b2 = last ? nB : cB + (size_t)(t + 2) * kstep;
            const char* a3 = a2 + kstep; const char* b3 = b2 + kstep;
            if (last && has_next) S.a_ready(nxt);
            if constexpr (SP2) {
            PG8_LDB(B0, 0, 0); PG8_LDB(B1, 0, 1); PG8_SCHED; PG8_LDA(At, 0, 0); PG8_STAGE_A(PG8_SA(1, 1), a1, 1, false);
            PG8_WAIT_V(8); PG8_WAIT_L(0); PG8_BAR; PG8_MMA(0, 0, At, B0); PG8_MMA(0, 1, At, B1); PG8_BAR; PG8_SCHED;
            PG8_LDA(At, 0, 1); PG8_STAGE(PG8_SB(0, 0), b2, voffB); PG8_STAGE(PG8_SB(0, 1), b2 + hstep, voffB); PG8_STAGE_A(PG8_SA(0, 0), a2, 0, last);
            PG8_WAIT_V(8); PG8_WAIT_L(0); PG8_BAR; PG8_MMA(1, 0, At, B0); PG8_MMA(1, 1, At, B1); PG8_BAR; PG8_SCHED;
            PG8_LDB(B0, 1, 0); PG8_LDB(B1, 1, 1); PG8_SCHED; PG8_LDA(At, 1, 0); PG8_STAGE_A(PG8_SA(0, 1), a2, 1, last);
            PG8_WAIT_V(8); PG8_WAIT_L(0); PG8_BAR; PG8_MMA(0, 0, At, B0); PG8_MMA(0, 1, At, B1); PG8_BAR; PG8_SCHED;
            PG8_LDA(At, 1, 1); PG8_STAGE(PG8_SB(1, 0), b3, voffB); PG8_STAGE(PG8_SB(1, 1), b3 + hstep, voffB); PG8_STAGE_A(PG8_SA(1, 0), a3, 0, last);
            PG8_WAIT_V(8); PG8_WAIT_L(0); PG8_BAR; PG8_MMA(1, 0, At, B0); PG8_MMA(1, 1, At, B1); PG8_BAR; PG8_SCHED;
            } else {
            PG8_LDB(B0, 0, 0); PG8_SCHED; PG8_LDA(At, 0, 0); PG8_STAGE_A(PG8_SA(1, 1), a1, 1, false);
            PG8_WAIT_L(8); PG8_BAR; PG8_WAIT_L(0); PG8_MMA(0, 0, At, B0); PG8_BAR; PG8_SCHED;
            PG8_LDB(B1, 0, 1); PG8_STAGE(PG8_SB(0, 0), b2, voffB);
            PG8_BAR; PG8_WAIT_L(0); PG8_MMA(0, 1, At, B1); PG8_BAR;
            PG8_LDA(At, 0, 1); PG8_STAGE_A(PG8_SA(0, 0), a2, 0, last);
            PG8_BAR; PG8_WAIT_L(0); PG8_MMA(1, 0, At, B0); PG8_BAR; PG8_SCHED;
            PG8_STAGE(PG8_SB(0, 1), b2 + hstep, voffB);
            PG8_WAIT_V(6); PG8_BAR; PG8_MMA(1, 1, At, B1); PG8_BAR;
            PG8_LDB(B0, 1, 0); PG8_SCHED; PG8_LDA(At, 1, 0); PG8_STAGE_A(PG8_SA(0, 1), a2, 1, last);
            PG8_WAIT_L(8); PG8_BAR; PG8_WAIT_L(0); PG8_MMA(0, 0, At, B0); PG8_BAR; PG8_SCHED;
            PG8_LDB(B1, 1, 1); PG8_STAGE(PG8_SB(1, 0), b3, voffB);
            PG8_BAR; PG8_WAIT_L(0); PG8_MMA(0, 1, At, B1); PG8_BAR;
            PG8_LDA(At, 1, 1); PG8_STAGE_A(PG8_SA(1, 0), a3, 0, last);
            PG8_BAR; PG8_WAIT_L(0); PG8_MMA(1, 0, At, B0); PG8_BAR; PG8_SCHED;
            PG8_STAGE(PG8_SB(1, 1), b3 + hstep, voffB);
            PG8_WAIT_V(6); PG8_BAR; PG8_MMA(1, 1, At, B1); PG8_BAR;
            }
        }
        if constexpr (ALIGN_EPI) { if (wr == 0) PG8_BAR; }
        if constexpr (!Epi::AFTER_DRAIN) { E(acc, cur, wr, wc, fr, fq); S.done(cur); }
        if (!has_next) break;
#pragma unroll
        for (int a = 0; a < 2; ++a)
#pragma unroll
            for (int b = 0; b < 2; ++b)
#pragma unroll
                for (int m = 0; m < 4; ++m)
#pragma unroll
                    for (int n = 0; n < 2; ++n) acc[a][b][m][n] = (f32x4){0.f, 0.f, 0.f, 0.f};
        cur = nxt; cA = nA; cB = nB; ++ui;
        if constexpr (GATHER) {
#pragma unroll
            for (int h = 0; h < 2; ++h) { gcur[h] = gnxt[h]; } }
        if constexpr (ALIGN_EPI) { if (wr == 1) PG8_BAR; }
    }
    PG8_WAIT_V(0);
    if constexpr (!ALIGN_EPI) { if (wr == 0) PG8_BAR; }
    PG8_BAR;
    if constexpr (Epi::AFTER_DRAIN) { E.fused(acc, cur, wr, wc, fr, fq, lds, wid, lane); S.done(cur); }
#undef PG8_SA
#undef PG8_SB
#undef PG8_STAGE
#undef PG8_STAGE_A
#undef PG8_LDA
#undef PG8_LDB
#undef PG8_MMA
#undef PG8_WAIT_V
#undef PG8_WAIT_L
#undef PG8_BAR
#undef PG8_SCHED
}
}

typedef unsigned short bf16_t;
__device__ __forceinline__ unsigned f2bf(float f) { unsigned u = __builtin_bit_cast(unsigned, f); return (u + 0x7fffu + ((u >> 16) & 1u)) >> 16; }
__device__ __forceinline__ float bf2f(unsigned h) { return __builtin_bit_cast(float, h << 16); }
__device__ __forceinline__ float wave_sum(float v) {
#pragma unroll
    for (int o = 1; o < 64; o <<= 1) v += __shfl_xor(v, o);
    return v;
}
__device__ __forceinline__ float sigmoidf_(float x) { return 1.0f / (1.0f + expf(-x)); }
__device__ __forceinline__ float siluf_(float x) { return x / (1.0f + expf(-x)); }
__device__ __forceinline__ float softplusf_(float x) { return fmaxf(x, 0.0f) + log1pf(expf(-fabsf(x))); }
__device__ __forceinline__ float geluf_(float x) { const float u = 0.7978845608028654f * (x + 0.044715f * x * x * x); return 0.5f * x * (1.0f + tanhf(u)); }

struct Args { const float* in[39]; float* out; unsigned char* ws; int lo, hi; };

struct Ctx {
    const float* const* in; float* out; unsigned char* ws;
    LAS unsigned char* lds; float* sm;
    int tid, lane, wid, bid, G;
};

__device__ __forceinline__ unsigned pk2(float lo, float hi) { return f2bf(lo) | (f2bf(hi) << 16); }
__device__ __forceinline__ float ldbf(const bf16_t* p) { return bf2f((unsigned)*p); }
__device__ __forceinline__ float4 ldbf4(const bf16_t* p) { const uint2 v = *(const uint2*)p; return make_float4(bf2f(v.x & 0xffffu), bf2f(v.x >> 16), bf2f(v.y & 0xffffu), bf2f(v.y >> 16)); }

template <int NB, class AF, class BF, class BF2, class EF>
__device__ __forceinline__ void gemm_tile(float* sm, int K, AF af, BF bf, BF2 bf2, EF ef) {
    float* As = sm;
    float* Bs = sm + 16 * 132;
    float* Bs2 = Bs + 16 * 68;
    const int tid = threadIdx.x, ty = tid >> 4, tx = tid & 15;
    const int am = tid >> 2, ak = (tid & 3) * 4;
    const int bt = tid & 255, bk = bt >> 4, bn = (bt & 15) * 4;
    float acc[4][4], acc2[4][4];
#pragma unroll
    for (int i = 0; i < 4; ++i)
#pragma unroll
        for (int j = 0; j < 4; ++j) { acc[i][j] = 0.f; acc2[i][j] = 0.f; }
    float4 av = af(am, ak);
    float4 bv = make_float4(0.f, 0.f, 0.f, 0.f);
    if (tid < 256) bv = bf(bk, bn); else if (NB == 2) bv = bf2(bk, bn);
    for (int k0 = 0; k0 < K; k0 += 16) {
        __syncthreads();
        As[(ak + 0) * 132 + am] = av.x; As[(ak + 1) * 132 + am] = av.y; As[(ak + 2) * 132 + am] = av.z; As[(ak + 3) * 132 + am] = av.w;
        if (tid < 256) *(float4*)&Bs[bk * 68 + bn] = bv; else if (NB == 2) *(float4*)&Bs2[bk * 68 + bn] = bv;
        __syncthreads();
        if (k0 + 16 < K) {
            av = af(am, k0 + 16 + ak);
            if (tid < 256) bv = bf(k0 + 16 + bk, bn); else if (NB == 2) bv = bf2(k0 + 16 + bk, bn);
        }
#pragma unroll
        for (int kk = 0; kk < 16; ++kk) {
            const float4 a = *(const float4*)&As[kk * 132 + ty * 4];
            const float4 b = *(const float4*)&Bs[kk * 68 + tx * 4];
            const float aa[4] = {a.x, a.y, a.z, a.w};
            const float bb[4] = {b.x, b.y, b.z, b.w};
#pragma unroll
            for (int i = 0; i < 4; ++i)
#pragma unroll
                for (int j = 0; j < 4; ++j) acc[i][j] = fmaf(aa[i], bb[j], acc[i][j]);
            if (NB == 2) {
                const float4 b2 = *(const float4*)&Bs2[kk * 68 + tx * 4];
                const float bb2[4] = {b2.x, b2.y, b2.z, b2.w};
#pragma unroll
                for (int i = 0; i < 4; ++i)
#pragma unroll
                    for (int j = 0; j < 4; ++j) acc2[i][j] = fmaf(aa[i], bb2[j], acc2[i][j]);
            }
        }
    }
#pragma unroll
    for (int i = 0; i < 4; ++i)
        ef(ty * 4 + i, tx * 4, make_float4(acc[i][0], acc[i][1], acc[i][2], acc[i][3]), make_float4(acc2[i][0], acc2[i][1], acc2[i][2], acc2[i][3]));
}

template <bool RES, class RM>
__device__ __forceinline__ void transpose_item(const float* W, int K, int N, bf16_t* WT, RM rowmap, float* scr, int item, int lane) {
    const int nblk = N / 32, kb = item / nblk, nb = item % nblk, k0 = 64 * kb, n0 = 32 * nb;
#pragma unroll 8
    for (int i = 0; i < 32; ++i) { const int kk = 2 * i + (lane >> 5); scr[kk * 33 + (lane & 31)] = W[(size_t)(k0 + kk) * N + n0 + (lane & 31)]; }
    asm volatile("s_waitcnt lgkmcnt(0)" ::: "memory");
    const int c = lane & 7;
    const int r0 = rowmap(n0);
#pragma unroll
    for (int j = 0; j < 4; ++j) {
        const int n = (lane >> 3) + 8 * j; const float* s = scr + (8 * c) * 33 + n;
        float v[8];
#pragma unroll
        for (int q = 0; q < 8; ++q) { v[q] = s[q * 33]; if (RES) v[q] = v[q] - bf2f(f2bf(v[q])); }
        uint4 o; o.x = pk2(v[0], v[1]); o.y = pk2(v[2], v[3]); o.z = pk2(v[4], v[5]); o.w = pk2(v[6], v[7]);
        *(uint4*)(WT + (size_t)(r0 + n) * K + k0 + 8 * c) = o;
    }
    asm volatile("s_waitcnt lgkmcnt(0)" ::: "memory");
}

__device__ __forceinline__ void phase0(const Ctx& c) {
    const int gt = c.bid * 512 + c.tid, NT = c.G * 512;
    const int gw = c.bid * 8 + c.wid, NW = c.G * 8;
    {
        const float* cc = c.in[1]; const float* w_ada = c.in[2];
        float* modsp = (float*)(c.ws + WS_MODSP);
        for (int task = gw; task < 96 * 16; task += NW) {
            const int cg = task % 96, ks = task / 96, j = cg * 64 + c.lane;
            float a0 = 0.f, a1 = 0.f, a2 = 0.f, a3 = 0.f;
#pragma unroll 4
            for (int k = ks * 64; k < ks * 64 + 64; ++k) {
                const float wv = w_ada[(size_t)k * NMODS + j];
                a0 = fmaf(siluf_(cc[k]), wv, a0); a1 = fmaf(siluf_(cc[D + k]), wv, a1); a2 = fmaf(siluf_(cc[2 * D + k]), wv, a2); a3 = fmaf(siluf_(cc[3 * D + k]), wv, a3);
            }
            modsp[(ks * 4 + 0) * NMODS + j] = a0; modsp[(ks * 4 + 1) * NMODS + j] = a1; modsp[(ks * 4 + 2) * NMODS + j] = a2; modsp[(ks * 4 + 3) * NMODS + j] = a3;
        }
    }
    {
        const float* log_dt = c.in[20]; const float* a_re = c.in[21]; const float* a_im = c.in[22];
        const float* b_re = c.in[23]; const float* b_im = c.in[24];
        float* apow = (float*)(c.ws + WS_APOW); float* bb = (float*)(c.ws + WS_S5BB);
        for (int idx = gt; idx < S5NG * S5P; idx += NT) {
            const int g = idx / S5P, p = idx % S5P;
            const double dt = exp((double)log_dt[g]);
            const double lre = fmin((double)a_re[idx], -1e-4), lim = (double)a_im[idx];
            const double mag = exp(lre * dt), ang = lim * dt;
            const double abr = mag * cos(ang), abi = mag * sin(ang);
            const double den = lre * lre + lim * lim;
            const double nre = abr - 1.0, nim = abi;
            const double qre = (nre * lre + nim * lim) / den, qim = (nim * lre - nre * lim) / den;
            double pr = 1.0, pi = 0.0;
            for (int j = 0; j <= S5L; ++j) {
                apow[((size_t)(g * (S5L + 1) + j) * 64 + p) * 2 + 0] = (float)pr; apow[((size_t)(g * (S5L + 1) + j) * 64 + p) * 2 + 1] = (float)pi;
                const double nr = pr * abr - pi * abi, ni = pr * abi + pi * abr; pr = nr; pi = ni;
            }
            for (int ch = 0; ch < 16; ++ch) {
                const double br = (double)b_re[idx * 16 + ch], bi = (double)b_im[idx * 16 + ch];
                bb[idx * 32 + ch] = (float)(qre * br - qim * bi);
                bb[idx * 32 + 16 + ch] = (float)(qre * bi + qim * br);
            }
        }
    }
    {
        const float* w2 = c.in[11]; const float* a2 = c.in[13]; const float* g2 = c.in[14];
        bf16_t* bt = (bf16_t*)(c.ws + WS_LORA_BT);
        for (int it = gt; it < 1536 * 32; it += NT) {
            const int n = it >> 5, c0 = (it & 31) * 8;
            float v[8];
#pragma unroll
            for (int i = 0; i < 8; ++i) {
                const int col = c0 + i; float x = 0.f;
                if (n < 512) { if (col < 64) x = w2[col * RW + n]; }
                else if (n < 1024) { if (col >= 64 && col < 128) x = a2[(col - 64) * RW + (n - 512)]; }
                else { if (col >= 128) x = g2[(col - 128) * RW + (n - 1024)]; }
                v[i] = x;
            }
            *(uint4*)(bt + (size_t)n * 256 + c0) = make_uint4(pk2(v[0], v[1]), pk2(v[2], v[3]), pk2(v[4], v[5]), pk2(v[6], v[7]));
        }
    }
    float* scr = c.sm + c.wid * (64 * 33);
    constexpr int I_IN = (D / 64) * (NPROJ / 32), I_OUT = (D / 64) * (D / 32), I_GLU = (512 / 64) * (512 / 32), I_SG = (D / 64) * (256 / 32), I_SD = (256 / 64) * (D / 32), I_R = (D / 64) * (256 / 32);
    constexpr int NIT = I_IN + I_OUT + I_GLU + 2 * I_SG + I_SD + 2 * I_R;
    for (int it = gw; it < NIT; it += NW) {
        int r = it;
        if (r < I_IN) { transpose_item<false>(c.in[8], D, NPROJ, (bf16_t*)(c.ws + WS_WIN_T), [](int n) { return n; }, scr, r, c.lane); continue; } r -= I_IN;
        if (r < I_OUT) { transpose_item<false>(c.in[30], D, D, (bf16_t*)(c.ws + WS_WOUT_T), [](int n) { return n; }, scr, r, c.lane); continue; } r -= I_OUT;
        if (r < I_GLU) { transpose_item<false>(c.in[28], 512, 512, (bf16_t*)(c.ws + WS_WGLU_T), [](int n) { return n; }, scr, r, c.lane); continue; } r -= I_GLU;
        if (r < I_SG) { transpose_item<false>(c.in[36], D, 256, (bf16_t*)(c.ws + WS_WSGU_T), [](int n) { return (n >> 7) * 256 + (n & 127); }, scr, r, c.lane); continue; } r -= I_SG;
        if (r < I_SG) { transpose_item<false>(c.in[37], D, 256, (bf16_t*)(c.ws + WS_WSGU_T), [](int n) { return (n >> 7) * 256 + 128 + (n & 127); }, scr, r, c.lane); continue; } r -= I_SG;
        if (r < I_SD) { transpose_item<false>(c.in[38], 256, D, (bf16_t*)(c.ws + WS_WSD_T), [](int n) { return n; }, scr, r, c.lane); continue; } r -= I_SD;
        if (r < I_R) { transpose_item<false>(c.in[31], D, 256, (bf16_t*)(c.ws + WS_WR_T), [](int n) { return n; }, scr, r, c.lane); continue; } r -= I_R;
        transpose_item<true>(c.in[31], D, 256, (bf16_t*)(c.ws + WS_WR_T), [](int n) { return 256 + n; }, scr, r, c.lane);
    }
    for (int it = gw; it < NE * 384; it += NW) {
        const int e = it / 384, r = it % 384;
        if (r < 128) transpose_item<false>(c.in[33] + (size_t)e * D * EFF, D, EFF, (bf16_t*)(c.ws + WS_WEGU) + (size_t)e * 512 * D, [](int n) { return (n >> 7) * 256 + (n & 127); }, scr, r, c.lane);
        else if (r < 256) transpose_item<false>(c.in[34] + (size_t)e * D * EFF, D, EFF, (bf16_t*)(c.ws + WS_WEGU) + (size_t)e * 512 * D, [](int n) { return (n >> 7) * 256 + 128 + (n & 127); }, scr, r - 128, c.lane);
        else transpose_item<false>(c.in[35] + (size_t)e * EFF * D, EFF, D, (bf16_t*)(c.ws + WS_WED) + (size_t)e * D * EFF, [](int n) { return n; }, scr, r - 256, c.lane);
    }
}

__device__ __forceinline__ void phase1(const Ctx& c) {
    const int gt = c.bid * 512 + c.tid, NT = c.G * 512;
    const int gw = c.bid * 8 + c.wid, NW = c.G * 8;
    const float* modsp = (const float*)(c.ws + WS_MODSP); const float* b_ada = c.in[3]; float* mods = (float*)(c.ws + WS_MODS);
    for (int idx = gt; idx < BATCH * NMODS; idx += NT) {
        const int b = idx / NMODS, j = idx % NMODS;
        float acc = 0.f;
#pragma unroll
        for (int ks = 0; ks < 16; ++ks) acc += modsp[(ks * 4 + b) * NMODS + j];
        mods[idx] = acc + b_ada[j];
    }
    const float* apow = (const float*)(c.ws + WS_APOW); const float* bb = (const float*)(c.ws + WS_S5BB);
    const float* c_re = c.in[25]; const float* c_im = c.in[26];
    float* klag = (float*)(c.ws + WS_KLAG);
    for (int task = gw; task < S5NG * S5L; task += NW) {
        const int g = task / S5L, j = task % S5L, cc = c.lane >> 2, cq = (c.lane & 3) * 4;
        float acc[4] = {0.f, 0.f, 0.f, 0.f};
        for (int p = 0; p < 64; ++p) {
            const float ar = apow[((size_t)(g * (S5L + 1) + j) * 64 + p) * 2], ai = apow[((size_t)(g * (S5L + 1) + j) * 64 + p) * 2 + 1];
            const float cr = c_re[(g * 16 + cc) * 64 + p], ci = c_im[(g * 16 + cc) * 64 + p];
            const float4 br = *(const float4*)(bb + (size_t)(g * 64 + p) * 32 + cq), bi = *(const float4*)(bb + (size_t)(g * 64 + p) * 32 + 16 + cq);
            const float er = cr * ar - ci * ai, ei = cr * ai + ci * ar;
            acc[0] += er * br.x - ei * bi.x; acc[1] += er * br.y - ei * bi.y; acc[2] += er * br.z - ei * bi.z; acc[3] += er * br.w - ei * bi.w;
        }
        *(float4*)(klag + ((size_t)(g * S5L + j) * 16 + cc) * 16 + cq) = make_float4(acc[0], acc[1], acc[2], acc[3]);
    }
}

__device__ __forceinline__ void phase2(const Ctx& c) {
    const float* x = c.in[0]; const float* g = c.in[4];
    const float* mods = (const float*)(c.ws + WS_MODS);
    bf16_t* xn = (bf16_t*)(c.ws + WS_A);
    const int gw = c.bid * 8 + c.wid, NW = c.G * 8;
    for (int t = gw; t < T; t += NW) {
        const int b = t / SEQ;
        const float4* xr = (const float4*)(x + (size_t)t * D) + c.lane;
        float4 v[4]; float ss = 0.f;
#pragma unroll
        for (int j = 0; j < 4; ++j) { v[j] = xr[64 * j]; ss += v[j].x * v[j].x + v[j].y * v[j].y + v[j].z * v[j].z + v[j].w * v[j].w; }
        const float rstd = rsqrtf(wave_sum(ss) * (1.0f / D) + 1e-6f);
        uint2* o = (uint2*)(xn + (size_t)t * D) + c.lane;
#pragma unroll
        for (int j = 0; j < 4; ++j) {
            const int k = (c.lane + 64 * j) * 4;
            const float4 gg = *(const float4*)(g + k);
            const float4 sh = *(const float4*)(mods + b * NMODS + k);
            const float4 sc = *(const float4*)(mods + b * NMODS + D + k);
            float4 r;
            r.x = v[j].x * rstd * gg.x * (1.f + sc.x) + sh.x; r.y = v[j].y * rstd * gg.y * (1.f + sc.y) + sh.y;
            r.z = v[j].z * rstd * gg.z * (1.f + sc.z) + sh.z; r.w = v[j].w * rstd * gg.w * (1.f + sc.w) + sh.w;
            o[64 * j] = make_uint2(pk2(r.x, r.y), pk2(r.z, r.w));
        }
    }
    const int gt = c.bid * 512 + c.tid, NT = c.G * 512;
    const float* apow = (const float*)(c.ws + WS_APOW); const float* bb = (const float*)(c.ws + WS_S5BB); const float* klag = (const float*)(c.ws + WS_KLAG);
    const float* c_re = c.in[25]; const float* c_im = c.in[26]; const float* dd = c.in[27];
    bf16_t* kmat = (bf16_t*)(c.ws + WS_KMAT); bf16_t* hmat = (bf16_t*)(c.ws + WS_HMAT);
    for (int it = gt; it < S5NG * 512 * 80; it += NT) {
        const int row = it / 80, ch = it % 80, g = row >> 9, t = (row >> 4) & 31, cc = row & 15, col0 = ch * 8;
        float v[8];
        if (col0 < 512) {
            const int s = col0 >> 4, c0 = col0 & 15;
            if (s > t) {
#pragma unroll
                for (int i = 0; i < 8; ++i) v[i] = 0.f;
            } else {
                const float4 k0 = *(const float4*)(klag + ((size_t)(g * S5L + (t - s)) * 16 + cc) * 16 + c0), k1 = *(const float4*)(klag + ((size_t)(g * S5L + (t - s)) * 16 + cc) * 16 + c0 + 4);
                v[0] = k0.x; v[1] = k0.y; v[2] = k0.z; v[3] = k0.w; v[4] = k1.x; v[5] = k1.y; v[6] = k1.z; v[7] = k1.w;
                if (s == t) {
                    const float dv = dd[g * 16 + cc];
#pragma unroll
                    for (int i = 0; i < 8; ++i) if (c0 + i == cc) v[i] += dv;
                }
            }
        } else {
            const int q0 = col0 - 512;
#pragma unroll
            for (int i = 0; i < 8; ++i) {
                const int q = q0 + i, p = q & 63;
                const float ar = apow[((size_t)(g * (S5L + 1) + t + 1) * 64 + p) * 2], ai = apow[((size_t)(g * (S5L + 1) + t + 1) * 64 + p) * 2 + 1];
                const float cr = c_re[(g * 16 + cc) * 64 + p], ci = c_im[(g * 16 + cc) * 64 + p];
                v[i] = (q < 64) ? (cr * ar - ci * ai) : -(cr * ai + ci * ar);
            }
        }
        *(uint4*)(kmat + (size_t)row * 640 + col0) = make_uint4(pk2(v[0], v[1]), pk2(v[2], v[3]), pk2(v[4], v[5]), pk2(v[6], v[7]));
    }
    for (int it = gt; it < S5NG * 256 * 80; it += NT) {
        const int row = it / 80, ch = it % 80, g = row >> 8, q = row & 255, col0 = ch * 8;
        float v[8];
#pragma unroll
        for (int i = 0; i < 8; ++i) v[i] = 0.f;
        if (q < 128 && col0 < 512) {
            const int s = col0 >> 4, c0 = col0 & 15, p = q & 63;
            const float ar = apow[((size_t)(g * (S5L + 1) + (S5L - 1 - s)) * 64 + p) * 2], ai = apow[((size_t)(g * (S5L + 1) + (S5L - 1 - s)) * 64 + p) * 2 + 1];
#pragma unroll
            for (int i = 0; i < 8; ++i) {
                const float br = bb[(size_t)(g * 64 + p) * 32 + c0 + i], bi = bb[(size_t)(g * 64 + p) * 32 + 16 + c0 + i];
                v[i] = (q < 64) ? (ar * br - ai * bi) : (ar * bi + ai * br);
            }
        }
        *(uint4*)(hmat + (size_t)row * 640 + col0) = make_uint4(pk2(v[0], v[1]), pk2(v[2], v[3]), pk2(v[4], v[5]), pk2(v[6], v[7]));
    }
}

__device__ __forceinline__ void phase3(const Ctx& c) {
    pg8::Gemm g{(const bf16_t*)(c.ws + WS_A), (const bf16_t*)(c.ws + WS_WIN_T), T, NPROJ, D};
    pg8::StaticOrder S; S.init(T, NPROJ, c.G, c.bid);
    pg8::EpiBf16<0> E{(bf16_t*)(c.ws + WS_PROJ), NPROJ, nullptr, 0, 0, 1.f};
    pg8::gemm_phase<pg8::EpiBf16<0>, pg8::StaticOrder, true, true>(c.lds, g, S, E);
}

__device__ __forceinline__ void unpack8(const uint4 a, float (&u)[8]) {
    u[0] = bf2f(a.x & 0xffffu); u[1] = bf2f(a.x >> 16); u[2] = bf2f(a.y & 0xffffu); u[3] = bf2f(a.y >> 16);
    u[4] = bf2f(a.z & 0xffffu); u[5] = bf2f(a.z >> 16); u[6] = bf2f(a.w & 0xffffu); u[7] = bf2f(a.w >> 16);
}
__device__ __forceinline__ uint4 pack8(const float (&v)[8]) { return make_uint4(pk2(v[0], v[1]), pk2(v[2], v[3]), pk2(v[4], v[5]), pk2(v[6], v[7])); }
__device__ __forceinline__ void phase4(const Ctx& c) {
    const bf16_t* proj = (const bf16_t*)(c.ws + WS_PROJ);
    const float* mu = c.in[9]; const float* k_k = c.in[15];
    bf16_t* rw_r = (bf16_t*)(c.ws + WS_RW_R); bf16_t* rw_k = (bf16_t*)(c.ws + WS_RW_K); bf16_t* rw_v = (bf16_t*)(c.ws + WS_RW_V); bf16_t* rw_a = (bf16_t*)(c.ws + WS_RW_A);
    bf16_t* alora = (bf16_t*)((unsigned char*)c.out + OUT_ALORA);
    const int gw = c.bid * 8 + c.wid, NW = c.G * 8;
    for (int t = gw; t < T; t += NW) {
        const bool first = (t % SEQ == 0);
        const bf16_t* pr = proj + (size_t)t * NPROJ; const bf16_t* pp = proj + (size_t)(first ? t : t - 1) * NPROJ;
#pragma unroll
        for (int j = 0; j < 4; ++j) {
            const int cidx = c.lane + 64 * j;
            if (cidx < 224) {
                const int col = cidx * 8;
                float p[8], q[8], ps[8];
                unpack8(*(const uint4*)(pr + col), p); unpack8(*(const uint4*)(pp + col), q);
                const float4 m0 = *(const float4*)(mu + col), m1 = *(const float4*)(mu + col + 4);
                const float mm[8] = {m0.x, m0.y, m0.z, m0.w, m1.x, m1.y, m1.z, m1.w};
#pragma unroll
                for (int i = 0; i < 8; ++i) { const float pv = first ? 0.f : q[i]; ps[i] = p[i] + (pv - p[i]) * mm[i]; }
                if (j == 0) *(uint4*)(rw_r + (size_t)t * RW + col) = pack8(ps);
                else if (j == 1) {
                    const int cl = col - 512;
                    *(uint4*)(rw_k + (size_t)t * RW + cl) = pack8(ps);
                    const float4 k0 = *(const float4*)(k_k + cl), k1 = *(const float4*)(k_k + cl + 4);
                    const float kk8[8] = {k0.x, k0.y, k0.z, k0.w, k1.x, k1.y, k1.z, k1.w};
                    float kk[8]; float ss = 0.f;
#pragma unroll
                    for (int i = 0; i < 8; ++i) { kk[i] = ps[i] * kk8[i]; ss += kk[i] * kk[i]; }
                    ss += __shfl_xor(ss, 1); ss += __shfl_xor(ss, 2); ss += __shfl_xor(ss, 4);
                    const float inv = -1.0f / fmaxf(sqrtf(ss), 1e-12f);
#pragma unroll
                    for (int i = 0; i < 8; ++i) kk[i] *= inv;
                    *(uint4*)(rw_a + (size_t)t * RW + cl) = pack8(kk);
                } else if (j == 2) *(uint4*)(rw_v + (size_t)t * RW + (col - 1024)) = pack8(ps);
                else {
                    const int cl = col - 1536;
                    float o[8];
#pragma unroll
                    for (int i = 0; i < 8; ++i) o[i] = (cl < 64) ? tanhf(ps[i]) : (cl < 128) ? ps[i] : sigmoidf_(ps[i]);
                    *(uint4*)(alora + (size_t)t * 256 + cl) = pack8(o);
                }
            }
        }
    }
    bf16_t* ux = (bf16_t*)((unsigned char*)c.out + OUT_UX);
    const int gt = c.bid * 512 + c.tid, NT = c.G * 512;
    for (int it = gt; it < T * 64; it += NT) {
        const int t = it >> 6, g = (it >> 1) & 31, hf = it & 1;
        const int b = t / SEQ, s = t % S5L, chunk = (t % SEQ) / S5L;
        const uint4 v = *(const uint4*)(proj + (size_t)t * NPROJ + RPROJ + g * 16 + hf * 8);
        *(uint4*)(ux + ((size_t)(g * 1024 + b * 256 + chunk)) * 640 + s * 16 + hf * 8) = v;
    }
    for (int it = gt; it < S5NG * 1024 * 16; it += NT) {
        const int row = it >> 4, ch = it & 15;
        *(uint4*)(ux + (size_t)row * 640 + 512 + ch * 8) = make_uint4(0u, 0u, 0u, 0u);
    }
}

__device__ __forceinline__ void phase5(const Ctx& c) {
    {
        pg8::Gemm g{(const bf16_t*)((unsigned char*)c.out + OUT_ALORA), (const bf16_t*)(c.ws + WS_LORA_BT), T, 1536, 256};
        pg8::StaticOrder S; S.init(T, 1536, c.G, c.bid);
        pg8::EpiLora E{c.in[10], c.in[12], c.in[16], (float*)(c.ws + WS_RW_W), (bf16_t*)(c.ws + WS_RW_K), (const bf16_t*)(c.ws + WS_RW_A), (bf16_t*)(c.ws + WS_RW_B), (bf16_t*)(c.ws + WS_RW_G)};
        pg8::gemm_phase<pg8::EpiLora, pg8::StaticOrder, true, true>(c.lds, g, S, E);
    }
    __syncthreads();
    {
        pg8::Gemm g{(const bf16_t*)((unsigned char*)c.out + OUT_UX), (const bf16_t*)(c.ws + WS_HMAT), 0, 0, 640};
        pg8::S5Order S{128, 1, c.G, c.bid};
        pg8::EpiS5E E{(float*)((unsigned char*)c.out + OUT_E)};
        pg8::gemm_phase<pg8::EpiS5E, pg8::S5Order, true, true>(c.lds, g, S, E);
    }
}

typedef float f2v __attribute__((ext_vector_type(2)));
__device__ __forceinline__ float dpp_add16(float v) {
    v += __builtin_bit_cast(float, __builtin_amdgcn_mov_dpp(__builtin_bit_cast(int, v), 0xB1, 0xf, 0xf, true));
    v += __builtin_bit_cast(float, __builtin_amdgcn_mov_dpp(__builtin_bit_cast(int, v), 0x4E, 0xf, 0xf, true));
    v += __builtin_bit_cast(float, __builtin_amdgcn_mov_dpp(__builtin_bit_cast(int, v), 0x141, 0xf, 0xf, true));
    v += __builtin_bit_cast(float, __builtin_amdgcn_mov_dpp(__builtin_bit_cast(int, v), 0x140, 0xf, 0xf, true));
    return v;
}
constexpr int RTS = 32;
constexpr int RTILE = 6 * RTS * 64;
__device__ __forceinline__ void phase6(const Ctx& c) {
    {
        const float* apow = (const float*)(c.ws + WS_APOW); const float* E = (const float*)((const unsigned char*)c.out + OUT_E);
        bf16_t* ux = (bf16_t*)((unsigned char*)c.out + OUT_UX);
        for (int task = c.bid * 8 + c.wid; task < S5NG * BATCH; task += c.G * 8) {
            const int g = task >> 2, b = task & 3, p = c.lane;
            const float pr = apow[((size_t)(g * (S5L + 1) + S5L) * 64 + p) * 2], pi = apow[((size_t)(g * (S5L + 1) + S5L) * 64 + p) * 2 + 1];
            float xr = 0.f, xi = 0.f;
            const size_t row0 = (size_t)g * 1024 + b * 256;
            for (int ch0 = 0; ch0 < 256; ch0 += 8) {
                float er[8], ei[8];
#pragma unroll
                for (int q = 0; q < 8; ++q) { er[q] = E[(row0 + ch0 + q) * 128 + p]; ei[q] = E[(row0 + ch0 + q) * 128 + 64 + p]; }
#pragma unroll
                for (int q = 0; q < 8; ++q) {
                    ux[(row0 + ch0 + q) * 640 + 512 + p] = (bf16_t)f2bf(xr); ux[(row0 + ch0 + q) * 640 + 576 + p] = (bf16_t)f2bf(xi);
                    const float nr = pr * xr - pi * xi + er[q], ni = pr * xi + pi * xr + ei[q]; xr = nr; xi = ni;
                }
            }
        }
    }
    const float* __restrict__ rw_w = (const float*)(c.ws + WS_RW_W);
    const bf16_t* __restrict__ rw_bf = (const bf16_t*)(c.ws + WS_RW_R);
    float* __restrict__ rw_y = (float*)(c.ws + WS_RW_Y);
    float* tile = c.sm;
    constexpr size_t ARR = (size_t)T * RW;
    for (int item = c.bid; item < BATCH * NH * 8; item += c.G) {
        const int bh = item >> 3, rb = (item & 7) * 8, b = bh >> 3, h = bh & 7;
        const size_t base = (size_t)(b * SEQ) * RW + h * 64;
        const int lt = c.tid - 128;
        uint4 reg[5];
        auto issue = [&](int tl) {
#pragma unroll
            for (int i = 0; i < 5; ++i) {
                const int it = lt + 384 * i;
                if (it < 512) { const int t = it >> 4, c4 = it & 15; reg[i] = *(const uint4*)(rw_w + base + (size_t)(tl * RTS + t) * RW + c4 * 4); }
                else if (it < 1792) { const int j = it - 512, arr = j >> 8, rem = j & 255, t = rem >> 3, c8 = rem & 7;
                    const int ga = (arr == 0) ? 3 : (arr == 1) ? 4 : (arr == 2) ? 1 : (arr == 3) ? 0 : 2;
                    reg[i] = *(const uint4*)(rw_bf + (size_t)ga * ARR + base + (size_t)(tl * RTS + t) * RW + c8 * 8); }
            }
        };
        auto commit = [&](int buf) {
            float* tb = tile + buf * RTILE;
#pragma unroll
            for (int i = 0; i < 5; ++i) {
                const int it = lt + 384 * i;
                if (it < 512) { const int t = it >> 4, c4 = it & 15; *(uint4*)(tb + t * 64 + c4 * 4) = reg[i]; }
                else if (it < 1792) { const int j = it - 512, arr = j >> 8, rem = j & 255, t = rem >> 3, c8 = rem & 7;
                    float* d = tb + (arr + 1) * RTS * 64 + t * 64 + c8 * 8;
                    const uint4 v = reg[i];
                    *(float4*)d = make_float4(bf2f(v.x & 0xffffu), bf2f(v.x >> 16), bf2f(v.y & 0xffffu), bf2f(v.y >> 16));
                    *(float4*)(d + 4) = make_float4(bf2f(v.z & 0xffffu), bf2f(v.z >> 16), bf2f(v.w & 0xffffu), bf2f(v.w >> 16)); }
            }
        };
        __syncthreads();
        if (c.wid >= 2) { issue(0); commit(0); issue(1); }
        __syncthreads();
        const int row = rb + (c.wid & 1) * 4 + (c.lane >> 4), kq = c.lane & 15;
        f2v S01 = {0.f, 0.f}, S23 = {0.f, 0.f};
        float* Y = rw_y + base + row;
        constexpr int NTL = SEQ / RTS;
        for (int tl = 0; tl < NTL; ++tl) {
            if (c.wid < 2) {
                const float* tb = tile + (tl & 1) * RTILE + kq * 4;
                const float* tv = tile + (tl & 1) * RTILE + 5 * RTS * 64 + row;
                float4 w = *(const float4*)(tb), a = *(const float4*)(tb + 1 * RTS * 64), bb = *(const float4*)(tb + 2 * RTS * 64), k = *(const float4*)(tb + 3 * RTS * 64), r = *(const float4*)(tb + 4 * RTS * 64);
                float v = tv[0];
                float ysel = 0.f;
#pragma unroll
                for (int t = 0; t < RTS; ++t) {
                    const int tn = (t + 1 < RTS) ? t + 1 : t;
                    const float4 wn = *(const float4*)(tb + tn * 64), an = *(const float4*)(tb + 1 * RTS * 64 + tn * 64), bn = *(const float4*)(tb + 2 * RTS * 64 + tn * 64);
                    const float4 kn = *(const float4*)(tb + 3 * RTS * 64 + tn * 64), rn = *(const float4*)(tb + 4 * RTS * 64 + tn * 64);
                    const float vn = tv[tn * 64];
                    const f2v a01 = {a.x, a.y}, a23 = {a.z, a.w}, w01 = {w.x, w.y}, w23 = {w.z, w.w}, b01 = {bb.x, bb.y}, b23 = {bb.z, bb.w};
                    const f2v k01 = {k.x, k.y}, k23 = {k.z, k.w}, r01 = {r.x, r.y}, r23 = {r.z, r.w};
                    f2v p = S01 * a01; p = __builtin_elementwise_fma(S23, a23, p);
                    const float sa = dpp_add16(p.x + p.y);
                    const f2v vv = {v, v}, sav = {sa, sa};
                    S01 = __builtin_elementwise_fma(S01, w01, vv * k01); S23 = __builtin_elementwise_fma(S23, w23, vv * k23);
                    S01 = __builtin_elementwise_fma(sav, b01, S01); S23 = __builtin_elementwise_fma(sav, b23, S23);
                    f2v q = S01 * r01; q = __builtin_elementwise_fma(S23, r23, q);
                    const float y = dpp_add16(q.x + q.y);
                    ysel = (kq == (t & 15)) ? y : ysel;
                    if ((t & 15) == 15) Y[(size_t)(tl * RTS + (t - 15) + kq) * RW] = ysel;
                    w = wn; a = an; bb = bn; k = kn; r = rn; v = vn;
                }
            } else {
                if (tl + 1 < NTL) commit((tl + 1) & 1);
                if (tl + 2 < NTL) issue(tl + 2);
            }
            __syncthreads();
        }
    }
}

__device__ __forceinline__ void phase7(const Ctx& c) {
    {
        pg8::Gemm g{(const bf16_t*)((unsigned char*)c.out + OUT_UX), (const bf16_t*)(c.ws + WS_KMAT), 0, 0, 640};
        pg8::S5Order S{256, 2, c.G, c.bid};
        pg8::EpiS5Out E{(bf16_t*)(c.ws + WS_YS5)};
        pg8::gemm_phase<pg8::EpiS5Out, pg8::S5Order, true, true>(c.lds, g, S, E);
    }
    __syncthreads();
    const bf16_t* rw_r = (const bf16_t*)(c.ws + WS_RW_R); const bf16_t* rw_k = (const bf16_t*)(c.ws + WS_RW_K);
    const bf16_t* rw_v = (const bf16_t*)(c.ws + WS_RW_V); const bf16_t* rw_g = (const bf16_t*)(c.ws + WS_RW_G);
    const float* rw_y = (const float*)(c.ws + WS_RW_Y);
    const float* r_k = c.in[17]; const float* ln_w = c.in[18]; const float* ln_b = c.in[19];
    bf16_t* ycat = (bf16_t*)(c.ws + WS_A);
    const int gw = c.bid * 8 + c.wid, NW = c.G * 8;
    for (int it = gw; it < T * NH; it += NW) {
        const int t = it >> 3, h = it & 7, hn = h * 64 + c.lane;
        const size_t o = (size_t)t * RW + hn;
        const float y = rw_y[o];
        const float mean = wave_sum(y) * (1.f / 64.f);
        const float d = y - mean;
        const float var = wave_sum(d * d) * (1.f / 64.f);
        const float yn = d * rsqrtf(var + 64e-5f) * ln_w[hn] + ln_b[hn];
        const float v = ldbf(rw_v + o);
        const float bonus = wave_sum(ldbf(rw_r + o) * ldbf(rw_k + o) * r_k[hn]) * v;
        ycat[(size_t)t * D + hn] = (bf16_t)f2bf((yn + bonus) * ldbf(rw_g + o));
    }
}

__device__ __forceinline__ void phase8(const Ctx& c) {
    pg8::Gemm g{(const bf16_t*)(c.ws + WS_YS5), (const bf16_t*)(c.ws + WS_WGLU_T), T, 512, 512};
    pg8::StaticOrder S; S.init(T, 512, c.G, c.bid);
    pg8::EpiGLU E{(const bf16_t*)(c.ws + WS_YS5), 512, c.in[29], (bf16_t*)(c.ws + WS_A), D, 512};
    pg8::gemm_phase<pg8::EpiGLU, pg8::StaticOrder, true, true>(c.lds, g, S, E);
}

__device__ __forceinline__ void phase9(const Ctx& c) {
    pg8::Gemm g{(const bf16_t*)(c.ws + WS_A), (const bf16_t*)(c.ws + WS_WOUT_T), T, D, D};
    pg8::StaticOrder S; S.init(T, D, c.G, c.bid);
    pg8::EpiF32 E{(float*)(c.ws + WS_PROJ), D};
    pg8::gemm_phase<pg8::EpiF32, pg8::StaticOrder, true, true>(c.lds, g, S, E);
}

__device__ __forceinline__ void phase10(const Ctx& c) {
    const float* x = c.in[0]; const float* gpm = c.in[5]; const float* gpf = c.in[6];
    const float* mods = (const float*)(c.ws + WS_MODS); const float* mixed = (const float*)(c.ws + WS_PROJ);
    bf16_t* h2 = (bf16_t*)(c.ws + WS_A); float* x1o = c.out;
    const int gw = c.bid * 8 + c.wid, NW = c.G * 8;
    for (int t = gw; t < T; t += NW) {
        const int b = t / SEQ;
        const float4* mr = (const float4*)(mixed + (size_t)t * D) + c.lane;
        const float4* xr = (const float4*)(x + (size_t)t * D) + c.lane;
        float4 m[4], v[4]; float ss = 0.f;
#pragma unroll
        for (int j = 0; j < 4; ++j) { m[j] = mr[64 * j]; v[j] = xr[64 * j]; ss += m[j].x * m[j].x + m[j].y * m[j].y + m[j].z * m[j].z + m[j].w * m[j].w; }
        const float rstd = rsqrtf(wave_sum(ss) * (1.0f / D) + 1e-6f);
        float s1 = 0.f;
#pragma unroll
        for (int j = 0; j < 4; ++j) {
            const int k = (c.lane + 64 * j) * 4;
            const float4 gg = *(const float4*)(gpm + k);
            const float4 gt = *(const float4*)(mods + b * NMODS + 2 * D + k);
            v[j].x += gt.x * (m[j].x * rstd * gg.x); v[j].y += gt.y * (m[j].y * rstd * gg.y);
            v[j].z += gt.z * (m[j].z * rstd * gg.z); v[j].w += gt.w * (m[j].w * rstd * gg.w);
            s1 += v[j].x * v[j].x + v[j].y * v[j].y + v[j].z * v[j].z + v[j].w * v[j].w;
            ((float4*)(x1o + (size_t)t * D) + c.lane)[64 * j] = v[j];
        }
        const float rstd1 = rsqrtf(wave_sum(s1) * (1.0f / D) + 1e-6f);
#pragma unroll
        for (int j = 0; j < 4; ++j) {
            const int k = (c.lane + 64 * j) * 4;
            const float4 gg = *(const float4*)(gpf + k);
            const float4 sh = *(const float4*)(mods + b * NMODS + 3 * D + k);
            const float4 sc = *(const float4*)(mods + b * NMODS + 4 * D + k);
            float r[4];
            r[0] = v[j].x * rstd1 * gg.x * (1.f + sc.x) + sh.x; r[1] = v[j].y * rstd1 * gg.y * (1.f + sc.y) + sh.y;
            r[2] = v[j].z * rstd1 * gg.z * (1.f + sc.z) + sh.z; r[3] = v[j].w * rstd1 * gg.w * (1.f + sc.w) + sh.w;
            unsigned hi[4]; float lo[4];
#pragma unroll
            for (int q = 0; q < 4; ++q) { hi[q] = f2bf(r[q]); lo[q] = r[q] - bf2f(hi[q]); }
            ((uint2*)(h2 + (size_t)t * D) + c.lane)[64 * j] = make_uint2(hi[0] | (hi[1] << 16), hi[2] | (hi[3] << 16));
            ((uint2*)(h2 + (size_t)(T + t) * D) + c.lane)[64 * j] = make_uint2(pk2(lo[0], lo[1]), pk2(lo[2], lo[3]));
        }
    }
}

__device__ __forceinline__ void phase11(const Ctx& c) {
    {
        pg8::Gemm g{(const bf16_t*)(c.ws + WS_A), (const bf16_t*)(c.ws + WS_WR_T), 2 * T, 512, D};
        pg8::StaticOrder S; S.init(2 * T, 512, c.G, c.bid);
        pg8::EpiF32 E{(float*)(c.ws + WS_PLOG), 512};
        pg8::gemm_phase<pg8::EpiF32, pg8::StaticOrder, true, true>(c.lds, g, S, E);
    }
    __syncthreads();
    {
        pg8::Gemm g{(const bf16_t*)(c.ws + WS_A), (const bf16_t*)(c.ws + WS_WSGU_T), T, 512, D};
        pg8::StaticOrder S; S.init(T, 512, c.G, c.bid);
        pg8::EpiSwiGLU E{(bf16_t*)(c.ws + WS_HS), 256};
        pg8::gemm_phase<pg8::EpiSwiGLU, pg8::StaticOrder, true, true>(c.lds, g, S, E);
    }
}

__device__ __forceinline__ void phase12(const Ctx& c) {
    const float* plog = (const float*)(c.ws + WS_PLOG); const float* rb = c.in[32];
    int* idx = (int*)(c.ws + WS_IDX); float* wt = (float*)(c.ws + WS_WT); unsigned* counts = (unsigned*)(c.ws + WS_COUNTS);
    const int gw = c.bid * 8 + c.wid, NW = c.G * 8, l = c.lane;
    const float4 bias = *(const float4*)(rb + l * 4);
    for (int t = gw; t < T; t += NW) {
        const float4 p0 = *(const float4*)(plog + (size_t)t * 512 + l * 4), p1 = *(const float4*)(plog + (size_t)t * 512 + 256 + l * 4);
        const float4 p2 = *(const float4*)(plog + (size_t)(T + t) * 512 + l * 4), p3 = *(const float4*)(plog + (size_t)(T + t) * 512 + 256 + l * 4);
        const float lg[4] = {p0.x + (p1.x + p2.x + p3.x), p0.y + (p1.y + p2.y + p3.y), p0.z + (p1.z + p2.z + p3.z), p0.w + (p1.w + p2.w + p3.w)};
        float s[4] = {sigmoidf_(lg[0]), sigmoidf_(lg[1]), sigmoidf_(lg[2]), sigmoidf_(lg[3])};
        float ch[4] = {s[0] + bias.x, s[1] + bias.y, s[2] + bias.z, s[3] + bias.w};
        float a1 = fmaxf(ch[0], ch[1]), a2 = fminf(ch[0], ch[1]);
        { const float b1 = fmaxf(ch[2], ch[3]), b2 = fminf(ch[2], ch[3]); const float n1 = fmaxf(a1, b1), n2 = fmaxf(fminf(a1, b1), fmaxf(a2, b2)); a1 = n1; a2 = n2; }
#pragma unroll
        for (int o = 1; o < 8; o <<= 1) { const float b1 = __shfl_xor(a1, o), b2 = __shfl_xor(a2, o); const float n1 = fmaxf(a1, b1), n2 = fmaxf(fminf(a1, b1), fmaxf(a2, b2)); a1 = n1; a2 = n2; }
        const float gs = a1 + a2; const int myg = l >> 3;
        int rank = 0;
#pragma unroll
        for (int g = 0; g < 8; ++g) { const float og = __shfl(gs, g * 8); rank += (og > gs || (og == gs && g < myg)) ? 1 : 0; }
        const bool sel = rank < 4;
        float mc[4];
#pragma unroll
        for (int i = 0; i < 4; ++i) mc[i] = sel ? ch[i] : -INFINITY;
        float sk[8]; int ek[8]; float ssum = 0.f;
#pragma unroll
        for (int k = 0; k < 8; ++k) {
            float bv = mc[0]; int be = l * 4;
#pragma unroll
            for (int i = 1; i < 4; ++i) if (mc[i] > bv) { bv = mc[i]; be = l * 4 + i; }
#pragma unroll
            for (int o = 1; o < 64; o <<= 1) { const float ov = __shfl_xor(bv, o); const int oe = __shfl_xor(be, o); if (ov > bv || (ov == bv && oe < be)) { bv = ov; be = oe; } }
            const int ii = be & 3;
            float sv = s[0]; sv = (ii == 1) ? s[1] : sv; sv = (ii == 2) ? s[2] : sv; sv = (ii == 3) ? s[3] : sv;
            sv = __shfl(sv, be >> 2);
            if ((be >> 2) == l) {
#pragma unroll
                for (int i = 0; i < 4; ++i) if (i == ii) mc[i] = -INFINITY;
            }
            sk[k] = sv; ek[k] = be; ssum += sv;
        }
        if (l == 0) {
            const float inv = 2.5f / ssum;
#pragma unroll
            for (int k = 0; k < 8; ++k) { idx[t * 8 + k] = ek[k]; wt[t * 8 + k] = sk[k] * inv; atomicAdd(&counts[ek[k]], 1u); }
        }
    }
}

__device__ __forceinline__ void build_ustart(const Ctx& c, int* smi) {
    const unsigned* counts = (const unsigned*)(c.ws + WS_COUNTS);
    __syncthreads();
    if (c.tid == 0) {
        int u = 0;
        for (int e = 0; e < NE; ++e) { smi[e] = u; u += ((int)counts[e] + 255) >> 8; }
        smi[NE] = u;
    }
    __syncthreads();
}

__device__ __forceinline__ void phase13(const Ctx& c) {
    int* smi = (int*)c.sm;
    build_ustart(c, smi);
    const int* idx = (const int*)(c.ws + WS_IDX); int* slotp = (int*)(c.ws + WS_SLOTP); int* uexp = (int*)(c.ws + WS_UEXP);
    unsigned* cursor = (unsigned*)(c.ws + WS_COUNTS) + 256; const unsigned* counts = (const unsigned*)(c.ws + WS_COUNTS);
    const int gt = c.bid * 512 + c.tid, NT = c.G * 512;
    for (int a = gt; a < T * 8; a += NT) {
        const int e = idx[a];
        const unsigned pos = atomicAdd(&cursor[e], 1u);
        slotp[smi[e] * 256 + (int)pos] = a;
    }
    for (int e = gt; e < NE; e += NT) {
        const int u0 = smi[e], u1 = smi[e + 1], cn = (int)counts[e];
        for (int p = cn; p < (u1 - u0) * 256; ++p) slotp[u0 * 256 + p] = -1;
        for (int u = u0; u < u1; ++u) uexp[u] = e;
    }
    if (gt == 0) uexp[2048] = smi[NE];
}

__device__ __forceinline__ void phase14(const Ctx& c) {
    const int* uexp = (const int*)(c.ws + WS_UEXP);
    const int NU = __builtin_amdgcn_readfirstlane(uexp[2048]);
    const int vcu = (c.G % 8 == 0) ? (c.bid % 8) * (c.G / 8) + c.bid / 8 : c.bid;
    pg8::Gemm g{(const bf16_t*)(c.ws + WS_A), (const bf16_t*)(c.ws + WS_WEGU), 0, 0, D, (const int*)(c.ws + WS_SLOTP)};
    pg8::ExpertOrder S{uexp, NU, 2, c.G, vcu};
    pg8::EpiSwiGLU E{(bf16_t*)(c.ws + WS_HID), 256};
    pg8::gemm_phase<pg8::EpiSwiGLU, pg8::ExpertOrder, true, true, true>(c.lds, g, S, E);
}

__device__ __forceinline__ void phase15(const Ctx& c) {
    {
        const int* uexp = (const int*)(c.ws + WS_UEXP);
        const int NU = __builtin_amdgcn_readfirstlane(uexp[2048]);
        const int vcu = (c.G % 8 == 0) ? (c.bid % 8) * (c.G / 8) + c.bid / 8 : c.bid;
        pg8::Gemm g{(const bf16_t*)(c.ws + WS_HID), (const bf16_t*)(c.ws + WS_WED), 0, 0, EFF};
        pg8::ExpertOrder S{uexp, NU, 4, c.G, vcu};
        pg8::EpiScatter E{(const int*)(c.ws + WS_SLOTP), (const float*)(c.ws + WS_WT), (bf16_t*)(c.ws + WS_YEXP), D};
        pg8::gemm_phase<pg8::EpiScatter, pg8::ExpertOrder, true, true>(c.lds, g, S, E);
    }
    __syncthreads();
    {
        pg8::Gemm g{(const bf16_t*)(c.ws + WS_HS), (const bf16_t*)(c.ws + WS_WSD_T), T, D, 256};
        pg8::StaticOrder S; S.init(T, D, c.G, c.bid);
        pg8::EpiF32 E{(float*)(c.ws + WS_SHOUT), D};
        pg8::gemm_phase<pg8::EpiF32, pg8::StaticOrder, true, true>(c.lds, g, S, E);
    }
}

__device__ __forceinline__ void phase16(const Ctx& c) {
    const float* gq = c.in[7]; const float* mods = (const float*)(c.ws + WS_MODS);
    const float* shout = (const float*)(c.ws + WS_SHOUT); const bf16_t* yexp = (const bf16_t*)(c.ws + WS_YEXP);
    float* out = c.out;
    const int gw = c.bid * 8 + c.wid, NW = c.G * 8;
    for (int t = gw; t < T; t += NW) {
        const int b = t / SEQ;
        float4 y[4]; float ss = 0.f;
#pragma unroll
        for (int j = 0; j < 4; ++j) {
            const int k = (c.lane + 64 * j) * 4;
            float4 a = *(const float4*)(shout + (size_t)t * D + k);
#pragma unroll
            for (int q = 0; q < 8; ++q) {
                const float4 v = ldbf4(yexp + (size_t)(t * 8 + q) * D + k);
                a.x += v.x; a.y += v.y; a.z += v.z; a.w += v.w;
            }
            y[j] = a; ss += a.x * a.x + a.y * a.y + a.z * a.z + a.w * a.w;
        }
        const float rstd = rsqrtf(wave_sum(ss) * (1.0f / D) + 1e-6f);
#pragma unroll
        for (int j = 0; j < 4; ++j) {
            const int k = (c.lane + 64 * j) * 4;
            const float4 gg = *(const float4*)(gq + k);
            const float4 gt = *(const float4*)(mods + b * NMODS + 5 * D + k);
            float4 x1 = *(const float4*)(out + (size_t)t * D + k);
            x1.x += gt.x * (y[j].x * rstd * gg.x); x1.y += gt.y * (y[j].y * rstd * gg.y);
            x1.z += gt.z * (y[j].z * rstd * gg.z); x1.w += gt.w * (y[j].w * rstd * gg.w);
            *(float4*)(out + (size_t)t * D + k) = x1;
        }
    }
}

constexpr int NPHASES = 17;

__global__ void __launch_bounds__(512, 2) mega(Args args) {
    extern __shared__ __attribute__((aligned(16))) unsigned char lds_raw[];
    Ctx c;
    c.in = args.in; c.out = args.out; c.ws = args.ws;
    c.lds = (LAS unsigned char*)lds_raw; c.sm = (float*)lds_raw;
    c.tid = threadIdx.x; c.lane = c.tid & 63; c.wid = __builtin_amdgcn_readfirstlane(c.tid >> 6); c.bid = blockIdx.x; c.G = gridDim.x;
    volatile LAS unsigned* st = (volatile LAS unsigned*)(c.lds + LDS_CTL_OFF);
    if (c.tid < 4) st[c.tid] = 0u;
    __syncthreads();
    XcdBarrier bar; bar.bar = (unsigned*)(args.ws + WS_CTL); bar.x = 0; bar.st = st;
    const bool multi = (args.hi - args.lo) > 1;
    if (multi) bar = xcd_barrier_post((unsigned*)(args.ws + WS_CTL), st);
    const int lo = args.lo, hi = args.hi;
#ifndef REPEAT_PHASE
#define REPEAT_PHASE -1
#endif
#define RUN_PHASE(k, call) if (lo <= (k) && (k) < hi) { if ((k) == REPEAT_PHASE) { call; xcd_barrier(bar); } call; if ((k) + 1 < hi) xcd_barrier(bar); }
    RUN_PHASE(0, phase0(c))
    RUN_PHASE(1, phase1(c))
    RUN_PHASE(2, phase2(c))
    RUN_PHASE(3, phase3(c))
    RUN_PHASE(4, phase4(c))
    RUN_PHASE(5, phase5(c))
    RUN_PHASE(6, phase6(c))
    RUN_PHASE(7, phase7(c))
    RUN_PHASE(8, phase8(c))
    RUN_PHASE(9, phase9(c))
    RUN_PHASE(10, phase10(c))
    RUN_PHASE(11, phase11(c))
    RUN_PHASE(12, phase12(c))
    RUN_PHASE(13, phase13(c))
    RUN_PHASE(14, phase14(c))
    RUN_PHASE(15, phase15(c))
    RUN_PHASE(16, phase16(c))
#undef RUN_PHASE
}

#ifndef N_LAUNCH_MODE
#define N_LAUNCH_MODE 1
#endif

extern "C" void kernel_launch(void* const* d_in, const int* in_sizes, int n_in, void* d_out, int out_size, void* d_ws, size_t ws_size, hipStream_t stream) {
    static int grid = 0;
    if (grid == 0) {
        if (n_in != 39 || out_size != T * D || ws_size < WS_END) { fprintf(stderr, "kernel_launch: unexpected shapes n_in %d out %d ws %zu\n", n_in, out_size, ws_size); grid = -1; return; }
        int dev = 0, cus = 0, per_cu = 0;
        if (hipGetDevice(&dev) != hipSuccess || hipDeviceGetAttribute(&cus, hipDeviceAttributeMultiprocessorCount, dev) != hipSuccess) { grid = -1; return; }
        if (hipFuncSetAttribute((const void*)mega, hipFuncAttributeMaxDynamicSharedMemorySize, LDS_BYTES) != hipSuccess) { grid = -1; return; }
        if (hipOccupancyMaxActiveBlocksPerMultiprocessor(&per_cu, (const void*)mega, 512, LDS_BYTES) != hipSuccess || per_cu < 1) { fprintf(stderr, "kernel_launch: occupancy query says %d\n", per_cu); }
        (void)hipGetLastError();
        grid = cus;
    }
    if (grid < 0) return;
    (void)hipMemsetAsync((char*)d_ws + WS_CTL, 0, CTL_BYTES, stream);
    Args a{};
    for (int i = 0; i < 39; ++i) a.in[i] = (const float*)d_in[i];
    a.out = (float*)d_out; a.ws = (unsigned char*)d_ws;
    if (N_LAUNCH_MODE == 1) {
        a.lo = 0; a.hi = NPHASES;
        hipLaunchKernelGGL(mega, dim3(grid), dim3(512), LDS_BYTES, stream, a);
    } else {
        for (int ph = 0; ph < NPHASES; ++ph) {
            a.lo = ph; a.hi = ph + 1;
            hipLaunchKernelGGL(mega, dim3(grid), dim3(512), LDS_BYTES, stream, a);
        }
    }
}
```

```cpp
#include <hip/hip_runtime.h>
#include <cstdint>
#include <cstdio>

#define LAS __attribute__((address_space(3)))

constexpr int D = 1024, BATCH = 4, SEQ = 8192, T = BATCH * SEQ;
constexpr int RW = 512, NH = 8;
constexpr int RPROJ = 1792, NPROJ = 2304;
constexpr int S5NG = 32, S5P = 64;
constexpr int NE = 256, EFF = 256;
constexpr int NMODS = 6 * D;
constexpr int S5L = 32;

constexpr size_t MiB = 1u << 20;
constexpr size_t WS_CTL = 0, CTL_BYTES = 1 * MiB;
constexpr size_t WS_COUNTS = 64 * 1024;
constexpr size_t WS_MODS = 1 * MiB;
constexpr size_t WS_HMAT = 2 * MiB;
constexpr size_t WS_WIN_T = 12 * MiB;
constexpr size_t WS_WOUT_T = 17 * MiB;
constexpr size_t WS_WGLU_T = 19 * MiB;
constexpr size_t WS_WSGU_T = 19 * MiB + 512 * 1024;
constexpr size_t WS_WSD_T = 20 * MiB + 512 * 1024;
constexpr size_t WS_WR_T = 21 * MiB;
constexpr size_t WS_LORA_BT = 22 * MiB;
constexpr size_t WS_APOW = 23 * MiB;
constexpr size_t WS_KMAT = 1000 * MiB;
constexpr size_t WS_MODSP = 1020 * MiB;
constexpr size_t WS_S5BB = 1022 * MiB;
constexpr size_t WS_KLAG = 1022 * MiB + 512 * 1024;
constexpr size_t OUT_UX = 0;
constexpr size_t OUT_E = 40 * MiB;
constexpr size_t OUT_ALORA = 56 * MiB;
constexpr size_t WS_WED = 24 * MiB;
constexpr size_t WS_WEGU = 152 * MiB;
constexpr size_t WS_A = 408 * MiB;
constexpr size_t WS_YS5 = WS_A + 64 * MiB;
constexpr size_t WS_PROJ = 536 * MiB;
constexpr size_t WS_RW = 680 * MiB;
constexpr size_t RWSZ = (size_t)T * RW * 4;
constexpr size_t RWSZH = (size_t)T * RW * 2;
constexpr size_t WS_RW_W = WS_RW, WS_RW_Y = WS_RW + RWSZ, WS_RW_R = WS_RW + 2 * RWSZ, WS_RW_K = WS_RW_R + RWSZH, WS_RW_V = WS_RW_K + RWSZH,
                 WS_RW_A = WS_RW_V + RWSZH, WS_RW_B = WS_RW_A + RWSZH, WS_RW_G = WS_RW_B + RWSZH;
constexpr size_t WS_PLOG = 680 * MiB;
constexpr size_t WS_SHOUT = 680 * MiB;
constexpr size_t WS_HS = 808 * MiB;
constexpr size_t WS_IDX = 824 * MiB;
constexpr size_t WS_WT = 825 * MiB;
constexpr size_t WS_SLOTP = 826 * MiB;
constexpr size_t WS_UEXP = 827 * MiB + 512 * 1024;
constexpr size_t WS_HID = 840 * MiB;
constexpr size_t WS_YEXP = 152 * MiB;
constexpr size_t WS_END = 1023 * MiB + 512 * 1024;

constexpr int LDS_BYTES = 132096;
constexpr int LDS_CTL_OFF = 131072;

#define XB_TMO      128
#define XB_XCNT(j)  (256  + 64 * (j))
#define XB_XSUB(j)  (1280 + 64 * (j))
#define XB_XGEN(j)  (2304 + 64 * (j))
#define XB_TOP      3328
#define XB_TOPGEN   3392
#define XCD_BAR_WORDS 3456
#define XB_SPIN_CAP (1u << 24)

__device__ __forceinline__ unsigned xb_ld(unsigned* p)              { return __hip_atomic_load(p, __ATOMIC_RELAXED, __HIP_MEMORY_SCOPE_AGENT); }
__device__ __forceinline__ unsigned xb_add(unsigned* p, unsigned v) { return __hip_atomic_fetch_add(p, v, __ATOMIC_RELAXED, __HIP_MEMORY_SCOPE_AGENT); }
__device__ __forceinline__ unsigned xb_xcc_id() { return (unsigned)__builtin_amdgcn_s_getreg((3 << 11) | 20) & 0xFu; }
#define XB_SPIN(cond, bar) do { unsigned _sp = 0; while (cond) { __builtin_amdgcn_s_sleep(1); \
    if ((++_sp & 255u) == 0u) { if (xb_ld(&(bar)[XB_TMO])) break; if (_sp > XB_SPIN_CAP) { atomicAdd(&(bar)[XB_TMO], 1u); break; } } } } while (0)

struct XcdBarrier { unsigned* bar; unsigned x; volatile LAS unsigned* st; };

__device__ __forceinline__ XcdBarrier xcd_barrier_post(unsigned* bar, volatile LAS unsigned* st) {
    XcdBarrier b; b.bar = bar; b.x = xb_xcc_id(); b.st = st;
    if (threadIdx.x == 0) (void)xb_add(&bar[XB_XCNT(b.x)], 1u);
    return b;
}
__device__ __forceinline__ void xcd_barrier_complete(unsigned* bar, unsigned x, unsigned& nloc, unsigned& nx) {
    const unsigned G = gridDim.x * gridDim.y * gridDim.z;
    unsigned sum, cnt, mine, sp = 0u;
    for (;;) {
        sum = 0u; cnt = 0u; mine = 0u;
#pragma unroll
        for (unsigned j = 0; j < 16; ++j) { const unsigned c = xb_ld(&bar[XB_XCNT(j)]); sum += c; cnt += (c > 0u) ? 1u : 0u; mine = (j == x) ? c : mine; }
        if (sum == G) break;
        __builtin_amdgcn_s_sleep(1);
        if ((++sp & 255u) == 0u) { if (xb_ld(&bar[XB_TMO])) break; if (sp > XB_SPIN_CAP) { atomicAdd(&bar[XB_TMO], 1u); break; } }
    }
    nloc = mine > 0u ? mine : 1u; nx = cnt > 0u ? cnt : 1u;
}
__device__ __forceinline__ void xcd_barrier(const XcdBarrier& b) {
    asm volatile("s_waitcnt vmcnt(0)" ::: "memory");
    __syncthreads();
    if (threadIdx.x == 0) {
        unsigned* bar = b.bar;
        __builtin_amdgcn_s_waitcnt(0);
        unsigned nloc = b.st[0], nx = b.st[1];
        if (nloc == 0u) { xcd_barrier_complete(bar, b.x, nloc, nx); b.st[0] = nloc; b.st[1] = nx; }
        const unsigned old = xb_add(&bar[XB_XSUB(b.x)], 1u);
        const unsigned gen = old / nloc;
        if (old + 1u == (gen + 1u) * nloc) {
            __builtin_amdgcn_fence(__ATOMIC_RELEASE, "agent");
            asm volatile("s_waitcnt vmcnt(0)" ::: "memory");
            const unsigned og = xb_add(&bar[XB_TOP], 1u);
            const unsigned tg = og / nx;
            if (og + 1u == (tg + 1u) * nx) xb_add(&bar[XB_TOPGEN], 1u);
            else XB_SPIN(xb_ld(&bar[XB_TOPGEN]) == tg, bar);
            __builtin_amdgcn_fence(__ATOMIC_ACQUIRE, "agent");
            xb_add(&bar[XB_XGEN(b.x)], 1u);
            asm volatile("s_waitcnt vmcnt(0)" ::: "memory");
        } else {
            XB_SPIN(xb_ld(&bar[XB_XGEN(b.x)]) == gen, bar);
            __builtin_amdgcn_fence(__ATOMIC_ACQUIRE, "agent");
            asm volatile("s_waitcnt vmcnt(0)" ::: "memory");
        }
    }
    __syncthreads();
}

namespace pg8 {
#define PG8_LAS __attribute__((address_space(3)))
typedef unsigned short bf16_t;
typedef short bf16x8 __attribute__((ext_vector_type(8)));
typedef float f32x4 __attribute__((ext_vector_type(4)));
typedef unsigned u32x4 __attribute__((ext_vector_type(4)));
constexpr int BM = 256, BK = 64, HALF = 128, HTB = HALF * BK * 2  , STAGE_BYTES = 8 * HTB, NXCD = 8, WGM = 8;

__host__ __device__ __forceinline__ int lds_byte(int r, int c) { const int st = (r >> 4) * 2 + (c >> 5), rr = r & 15, cc = c & 31, ob = rr * 64 + cc * 2; return st * 1024 + (ob ^ (((ob >> 9) & 1) << 5)); }
__host__ __device__ __forceinline__ void stage_rc(int b, int& R, int& C) { const int st = b / 1024, sb = b % 1024, swz = sb ^ (((sb >> 9) & 1) << 5); R = (st >> 1) * 16 + swz / 64; C = (st & 1) * 32 + (swz % 64) / 2; }
__host__ __device__ __forceinline__ int perm32(int rho) { const int n = rho >> 4, i = rho & 15; return 8 * (i >> 2) + 4 * n + (i & 3); }

struct Unit { int pm, pn; };
struct Gemm { const bf16_t* A; const bf16_t* Bt; int M, N, K; const int* rowtab = nullptr; };

struct StaticOrder {
    int nM, nN, nwg, G, c;
    __host__ __device__ void init(int M, int N, int G_, int c_) { nM = M / BM; nN = N / BM; nwg = nM * nN; G = G_; c = c_; }
    __host__ __device__ bool next(int i, Unit& u) const {
        const long L = (long)i * G + c; if (L >= nwg) return false;
        int wgid = (int)L; { const int q = nwg / NXCD, r = nwg % NXCD, xcd = wgid % NXCD, off = wgid / NXCD; wgid = (xcd < r ? xcd * (q + 1) : r * (q + 1) + (xcd - r) * q) + off; }
        const int nig = WGM * nN, gid = wgid / nig, fm = gid * WGM, gsz = (nM - fm) < WGM ? (nM - fm) : WGM;
        u.pm = fm + ((wgid % nig) % gsz); u.pn = (wgid % nig) / gsz; return true;
    }
    __device__ __forceinline__ void a_ready(const Unit&) const {}
    __device__ __forceinline__ void done(const Unit&) const {}
};

__device__ __forceinline__ unsigned cvt_pk_bf16(float lo, float hi) { unsigned r; asm volatile("v_cvt_pk_bf16_f32 %0, %1, %2" : "=v"(r) : "v"(lo), "v"(hi)); return r; }
typedef float f32x2 __attribute__((ext_vector_type(2)));
__device__ __forceinline__ f32x2 gelu_pk(f32x2 v) {
    const f32x2 av = __builtin_elementwise_abs(v), d = av * 0.2316418882f + 1.0f;
    f32x2 t; t.x = __builtin_amdgcn_rcpf(d.x); t.y = __builtin_amdgcn_rcpf(d.y);
    f32x2 q = t * 0.5307027145f + (-0.7265760135f); q = q * t + 0.7107068705f; q = q * t + (-0.142248368f); q = q * t + 0.127414796f; q = q * t;
    const f32x2 s = (v * v) * (-0.72134752044f);
    f32x2 e; e.x = __builtin_amdgcn_exp2f(s.x); e.y = __builtin_amdgcn_exp2f(s.y);
    const f32x2 m = v * (q * e), r = v - m;
    f32x2 o; o.x = v.x < 0.f ? m.x : r.x; o.y = v.y < 0.f ? m.y : r.y; return o;
}

template <int ACT  > struct EpiBf16 {
    static constexpr bool PERM = true, AFTER_DRAIN = false; static_assert(ACT == 0 || ACT == 1, "EpiBf16: ACT is 0 (none) or 1 (gelu_pk)");
    bf16_t* O; int ldc; const float* bias; int split_cols; size_t split_stride; float scale0;
    __device__ __forceinline__ void operator()(const f32x4 (&acc)[2][2][4][2], const Unit& u, int wr, int wc, int fr, int fq) const {
        const int row0 = u.pm * BM + wr * 64 + fr; int colt = u.pn * BM; bf16_t* base = O;
        float sc = 1.f; if (split_cols) { const int t = colt / split_cols; base += (size_t)t * split_stride; colt -= t * split_cols; if (t == 0) sc = scale0; }
        const int col0 = colt + wc * 32 + 8 * fq, bcol0 = u.pn * BM + wc * 32 + 8 * fq;
        f32x4 bv[2][2];
#pragma unroll
        for (int bj = 0; bj < 2; ++bj)
#pragma unroll
            for (int n = 0; n < 2; ++n) bv[bj][n] = bias ? *(const f32x4*)(bias + bcol0 + bj * HALF + 4 * n) : (f32x4){0.f, 0.f, 0.f, 0.f};
#pragma unroll
        for (int ai = 0; ai < 2; ++ai)
#pragma unroll
            for (int m = 0; m < 4; ++m) { bf16_t* rowp = base + (size_t)(row0 + ai * HALF + m * 16) * ldc + col0;
#pragma unroll
                for (int bj = 0; bj < 2; ++bj) { f32x4 v0 = acc[ai][bj][m][0] + bv[bj][0], v1 = acc[ai][bj][m][1] + bv[bj][1];
                    if (ACT == 1) { f32x2 a = gelu_pk((f32x2){v0[0], v0[1]}), b = gelu_pk((f32x2){v0[2], v0[3]}), c = gelu_pk((f32x2){v1[0], v1[1]}), d = gelu_pk((f32x2){v1[2], v1[3]});
                        v0 = (f32x4){a.x, a.y, b.x, b.y}; v1 = (f32x4){c.x, c.y, d.x, d.y}; }
                    v0 = v0 * sc; v1 = v1 * sc; u32x4 w; w.x = cvt_pk_bf16(v0[0], v0[1]); w.y = cvt_pk_bf16(v0[2], v0[3]); w.z = cvt_pk_bf16(v1[0], v1[1]); w.w = cvt_pk_bf16(v1[2], v1[3]);
                    *(u32x4*)(rowp + bj * HALF) = w; } }
    }
};

struct EpiF32 {
    static constexpr bool PERM = false, AFTER_DRAIN = false;
    float* C; int ldc;
    __device__ __forceinline__ void operator()(const f32x4 (&acc)[2][2][4][2], const Unit& u, int wr, int wc, int fr, int fq) const {
        const int row0 = u.pm * BM + wr * 64 + fr, col0 = u.pn * BM + wc * 32 + 4 * fq;
#pragma unroll
        for (int ai = 0; ai < 2; ++ai)
#pragma unroll
            for (int m = 0; m < 4; ++m) { float* rowp = C + (size_t)(row0 + ai * HALF + m * 16) * ldc + col0;
#pragma unroll
                for (int bj = 0; bj < 2; ++bj)
#pragma unroll
                    for (int n = 0; n < 2; ++n) *(f32x4*)(rowp + bj * HALF + n * 16) = acc[ai][bj][m][n]; }
    }
};
__device__ __forceinline__ float fast_sigmoid(float x) { return __builtin_amdgcn_rcpf(1.0f + __builtin_amdgcn_exp2f(-1.4426950408889634f * x)); }
struct EpiSwiGLU {
    static constexpr bool PERM = true, AFTER_DRAIN = false;
    bf16_t* O; int ldo;
    __device__ __forceinline__ void operator()(const f32x4 (&acc)[2][2][4][2], const Unit& u, int wr, int wc, int fr, int fq) const {
        const int row0 = u.pm * BM + wr * 64 + fr, col0 = (u.pn & 1) * HALF + wc * 32 + 8 * fq;
#pragma unroll
        for (int ai = 0; ai < 2; ++ai)
#pragma unroll
            for (int m = 0; m < 4; ++m) {
                bf16_t* rowp = O + (size_t)(row0 + ai * HALF + m * 16) * ldo + col0;
                const f32x4 g0 = acc[ai][0][m][0], g1 = acc[ai][0][m][1], u0 = acc[ai][1][m][0], u1 = acc[ai][1][m][1];
                float r[8];
#pragma unroll
                for (int i = 0; i < 4; ++i) { r[i] = g0[i] * fast_sigmoid(g0[i]) * u0[i]; r[4 + i] = g1[i] * fast_sigmoid(g1[i]) * u1[i]; }
                u32x4 w; w.x = cvt_pk_bf16(r[0], r[1]); w.y = cvt_pk_bf16(r[2], r[3]); w.z = cvt_pk_bf16(r[4], r[5]); w.w = cvt_pk_bf16(r[6], r[7]);
                *(u32x4*)rowp = w;
            }
    }
};
struct EpiScatter {
    static constexpr bool PERM = true, AFTER_DRAIN = false;
    const int* slotp; const float* wt; bf16_t* Y; int ldy;
    __device__ __forceinline__ void operator()(const f32x4 (&acc)[2][2][4][2], const Unit& u, int wr, int wc, int fr, int fq) const {
        int t2 = threadIdx.x; asm volatile("" : "+v"(t2));
        const int fr2 = t2 & 15, fq2 = (t2 >> 4) & 3, wc2 = (t2 >> 6) & 3, wr2 = (t2 >> 8) & 1;
        const int col0 = (u.pn & 3) * BM + wc2 * 32 + 8 * fq2;
        const int rbase = u.pm * BM + wr2 * 64 + fr2;
#pragma unroll
        for (int ai = 0; ai < 2; ++ai)
#pragma unroll
            for (int m = 0; m < 4; ++m) {
                const int aid = slotp[rbase + ai * HALF + m * 16];
                if (aid >= 0) {
                    const float w = wt[aid];
                    bf16_t* rowp = Y + (size_t)aid * ldy + col0;
#pragma unroll
                    for (int bj = 0; bj < 2; ++bj) {
                        const f32x4 v0 = acc[ai][bj][m][0] * w, v1 = acc[ai][bj][m][1] * w;
                        u32x4 o; o.x = cvt_pk_bf16(v0[0], v0[1]); o.y = cvt_pk_bf16(v0[2], v0[3]); o.z = cvt_pk_bf16(v1[0], v1[1]); o.w = cvt_pk_bf16(v1[2], v1[3]);
                        *(u32x4*)(rowp + bj * HALF) = o;
                    }
                }
            }
    }
};
struct ExpertOrder {
    const int* uexp; int NU, npn, G, c;
    __device__ __forceinline__ bool next(int i, Unit& u) const {
        const int L = i * G + c; if (L >= NU * npn) return false;
        const int uu = L / npn, pl = L % npn;
        u.pm = uu; u.pn = __builtin_amdgcn_readfirstlane(uexp[uu]) * npn + pl; return true;
    }
    __device__ __forceinline__ void a_ready(const Unit&) const {}
    __device__ __forceinline__ void done(const Unit&) const {}
};
struct S5Order {
    int NUNITS, npn, G, c;
    __device__ __forceinline__ bool next(int i, Unit& u) const {
        const int L = i * G + c; if (L >= NUNITS) return false;
        u.pm = L / npn; u.pn = (u.pm >> 2) * npn + L % npn; return true;
    }
    __device__ __forceinline__ void a_ready(const Unit&) const {}
    __device__ __forceinline__ void done(const Unit&) const {}
};
struct EpiS5E {
    static constexpr bool PERM = false, AFTER_DRAIN = false;
    float* E;
    __device__ __forceinline__ void operator()(const f32x4 (&acc)[2][2][4][2], const Unit& u, int wr, int wc, int fr, int fq) const {
        const int row0 = u.pm * BM + wr * 64 + fr, col0 = wc * 32 + 4 * fq;
#pragma unroll
        for (int ai = 0; ai < 2; ++ai)
#pragma unroll
            for (int m = 0; m < 4; ++m) { float* rowp = E + (size_t)(row0 + ai * HALF + m * 16) * 128 + col0;
#pragma unroll
                for (int n = 0; n < 2; ++n) *(f32x4*)(rowp + n * 16) = acc[ai][0][m][n]; }
    }
};
struct EpiS5Out {
    static constexpr bool PERM = true, AFTER_DRAIN = false;
    bf16_t* Y;
    __device__ __forceinline__ void operator()(const f32x4 (&acc)[2][2][4][2], const Unit& u, int wr, int wc, int fr, int fq) const {
        const int g = u.pm >> 2;
#pragma unroll
        for (int ai = 0; ai < 2; ++ai)
#pragma unroll
            for (int m = 0; m < 4; ++m) {
                const int r = (u.pm & 3) * BM + ai * HALF + wr * 64 + m * 16 + fr, b = r >> 8, chunk = r & 255;
#pragma unroll
                for (int bj = 0; bj < 2; ++bj) {
                    const int colg = (u.pn & 1) * BM + bj * HALF + wc * 32 + 8 * fq, t = colg >> 4, c0 = colg & 15;
                    const f32x4 v0 = acc[ai][bj][m][0], v1 = acc[ai][bj][m][1];
                    float x[8] = {v0[0], v0[1], v0[2], v0[3], v1[0], v1[1], v1[2], v1[3]};
#pragma unroll
                    for (int i = 0; i < 8; ++i) { const float z = x[i]; x[i] = z * fast_sigmoid(1.5957691216057308f * (z + 0.044715f * z * z * z)); }
                    u32x4 w; w.x = cvt_pk_bf16(x[0], x[1]); w.y = cvt_pk_bf16(x[2], x[3]); w.z = cvt_pk_bf16(x[4], x[5]); w.w = cvt_pk_bf16(x[6], x[7]);
                    *(u32x4*)(Y + ((size_t)(b * 8192 + chunk * 32 + t)) * 512 + g * 16 + c0) = w;
                }
            }
    }
};
struct EpiLora {
    static constexpr bool PERM = true, AFTER_DRAIN = false;
    const float* w0; const float* a0; const float* k_a; float* W; bf16_t* Kp; const bf16_t* A; bf16_t* B; bf16_t* Gt;
    __device__ __forceinline__ void operator()(const f32x4 (&acc)[2][2][4][2], const Unit& u, int wr, int wc, int fr, int fq) const {
        const int seg = u.pn >> 1;
#pragma unroll
        for (int bj = 0; bj < 2; ++bj) {
            const int nn = (u.pn & 1) * BM + bj * HALF + wc * 32 + 8 * fq;
            float p0[8], p1[8];
            if (seg == 0) { const f32x4 a = *(const f32x4*)(w0 + nn), b = *(const f32x4*)(w0 + nn + 4); p0[0] = a[0]; p0[1] = a[1]; p0[2] = a[2]; p0[3] = a[3]; p0[4] = b[0]; p0[5] = b[1]; p0[6] = b[2]; p0[7] = b[3]; }
            else if (seg == 1) { const f32x4 a = *(const f32x4*)(a0 + nn), b = *(const f32x4*)(a0 + nn + 4), cc = *(const f32x4*)(k_a + nn), d = *(const f32x4*)(k_a + nn + 4);
                p0[0] = a[0]; p0[1] = a[1]; p0[2] = a[2]; p0[3] = a[3]; p0[4] = b[0]; p0[5] = b[1]; p0[6] = b[2]; p0[7] = b[3];
                p1[0] = cc[0]; p1[1] = cc[1]; p1[2] = cc[2]; p1[3] = cc[3]; p1[4] = d[0]; p1[5] = d[1]; p1[6] = d[2]; p1[7] = d[3]; }
#pragma unroll
            for (int ai = 0; ai < 2; ++ai)
#pragma unroll
                for (int m = 0; m < 4; ++m) {
                    const size_t off = (size_t)(u.pm * BM + ai * HALF + wr * 64 + m * 16 + fr) * 512 + nn;
                    const f32x4 v0 = acc[ai][bj][m][0], v1 = acc[ai][bj][m][1];
                    const float x[8] = {v0[0], v0[1], v0[2], v0[3], v1[0], v1[1], v1[2], v1[3]};
                    if (seg == 0) {
                        float o[8];
#pragma unroll
                        for (int i = 0; i < 8; ++i) { const float wa = p0[i] + x[i];
                            const float sp = __logf(1.0f + __expf(-wa));
                            o[i] = __expf(-__expf(-sp - 0.5f)); }
                        *(f32x4*)(W + off) = (f32x4){o[0], o[1], o[2], o[3]}; *(f32x4*)(W + off + 4) = (f32x4){o[4], o[5], o[6], o[7]};
                    } else if (seg == 1) {
                        const u32x4 kv = *(const u32x4*)(Kp + off), av = *(const u32x4*)(A + off);
                        const float k[8] = {__builtin_bit_cast(float, kv.x << 16), __builtin_bit_cast(float, kv.x & 0xffff0000u), __builtin_bit_cast(float, kv.y << 16), __builtin_bit_cast(float, kv.y & 0xffff0000u),
                                            __builtin_bit_cast(float, kv.z << 16), __builtin_bit_cast(float, kv.z & 0xffff0000u), __builtin_bit_cast(float, kv.w << 16), __builtin_bit_cast(float, kv.w & 0xffff0000u)};
                        const float a[8] = {__builtin_bit_cast(float, av.x << 16), __builtin_bit_cast(float, av.x & 0xffff0000u), __builtin_bit_cast(float, av.y << 16), __builtin_bit_cast(float, av.y & 0xffff0000u),
                                            __builtin_bit_cast(float, av.z << 16), __builtin_bit_cast(float, av.z & 0xffff0000u), __builtin_bit_cast(float, av.w << 16), __builtin_bit_cast(float, av.w & 0xffff0000u)};
                        float kf[8], bo[8];
#pragma unroll
                        for (int i = 0; i < 8; ++i) { const float ic = fast_sigmoid(p0[i] + x[i]); kf[i] = k[i] * (1.0f + (ic - 1.0f) * p1[i]); bo[i] = -a[i] * ic; }
                        u32x4 w; w.x = cvt_pk_bf16(kf[0], kf[1]); w.y = cvt_pk_bf16(kf[2], kf[3]); w.z = cvt_pk_bf16(kf[4], kf[5]); w.w = cvt_pk_bf16(kf[6], kf[7]);
                        *(u32x4*)(Kp + off) = w;
                        w.x = cvt_pk_bf16(bo[0], bo[1]); w.y = cvt_pk_bf16(bo[2], bo[3]); w.z = cvt_pk_bf16(bo[4], bo[5]); w.w = cvt_pk_bf16(bo[6], bo[7]);
                        *(u32x4*)(B + off) = w;
                    } else {
                        u32x4 w; w.x = cvt_pk_bf16(x[0], x[1]); w.y = cvt_pk_bf16(x[2], x[3]); w.z = cvt_pk_bf16(x[4], x[5]); w.w = cvt_pk_bf16(x[6], x[7]);
                        *(u32x4*)(Gt + off) = w;
                    }
                }
        }
    }
};
struct EpiGLU {
    static constexpr bool PERM = true, AFTER_DRAIN = false;
    const bf16_t* Y; int ldy; const float* bias; bf16_t* O; int ldo; int ocol0;
    __device__ __forceinline__ void operator()(const f32x4 (&acc)[2][2][4][2], const Unit& u, int wr, int wc, int fr, int fq) const {
        const int row0 = u.pm * BM + wr * 64 + fr, col0 = u.pn * BM + wc * 32 + 8 * fq;
#pragma unroll
        for (int bj = 0; bj < 2; ++bj) {
            const f32x4 b0 = *(const f32x4*)(bias + col0 + bj * HALF), b1 = *(const f32x4*)(bias + col0 + bj * HALF + 4);
#pragma unroll
            for (int ai = 0; ai < 2; ++ai)
#pragma unroll
                for (int m = 0; m < 4; ++m) {
                    const size_t row = (size_t)(row0 + ai * HALF + m * 16);
                    const u32x4 yv = *(const u32x4*)(Y + row * ldy + col0 + bj * HALF);
                    const f32x4 z0 = acc[ai][bj][m][0] + b0, z1 = acc[ai][bj][m][1] + b1;
                    float y[8] = {__builtin_bit_cast(float, yv.x << 16), __builtin_bit_cast(float, yv.x & 0xffff0000u), __builtin_bit_cast(float, yv.y << 16), __builtin_bit_cast(float, yv.y & 0xffff0000u),
                                  __builtin_bit_cast(float, yv.z << 16), __builtin_bit_cast(float, yv.z & 0xffff0000u), __builtin_bit_cast(float, yv.w << 16), __builtin_bit_cast(float, yv.w & 0xffff0000u)};
                    float r[8];
#pragma unroll
                    for (int i = 0; i < 4; ++i) { r[i] = y[i] * fast_sigmoid(z0[i]); r[4 + i] = y[4 + i] * fast_sigmoid(z1[i]); }
                    u32x4 w; w.x = cvt_pk_bf16(r[0], r[1]); w.y = cvt_pk_bf16(r[2], r[3]); w.z = cvt_pk_bf16(r[4], r[5]); w.w = cvt_pk_bf16(r[6], r[7]);
                    *(u32x4*)(O + row * ldo + ocol0 + col0 + bj * HALF) = w;
                }
        }
    }
};
template <class Epi, class Sched, bool ALIGN_EPI = false, bool SP2 = false, bool GATHER = false>
__device__ __forceinline__ void gemm_phase(PG8_LAS unsigned char* lds, const Gemm g, const Sched& S, const Epi& E) {
    int tid_ = threadIdx.x; asm volatile("" : "+v"(tid_));
    const int tid = tid_, wid = __builtin_amdgcn_readfirstlane(tid >> 6), lane = tid & 63, wr = wid >> 2, wc = wid & 3, fr = lane & 15, fq = lane >> 4;
    const int K = g.K, nt = K / BK;
    unsigned voffA[2], voffB[2];
#pragma unroll
    for (int i = 0; i < 2; ++i) { int R, C; stage_rc(tid * 16 + i * 8192, R, C); const int Rb = Epi::PERM ? ((R & ~31) + perm32(R & 31)) : R;
        voffA[i] = (unsigned)(R * K + C) * 2u; voffB[i] = (unsigned)(Rb * K + C) * 2u; }
    const size_t kstep = (size_t)(BK * 2);
    const size_t hstep = (size_t)HALF * K * 2;
    const size_t tstep = 2 * hstep;
    const unsigned ldsw = (unsigned)wid * 1024u;
    const int aoff = lds_byte(wr * 64 + fr, fq * 8), boff = lds_byte(wc * 32 + fr, fq * 8);
#define PG8_SA(b, h) (((b) * 2 + (h)) * HTB)
#define PG8_SB(b, h) ((4 + (b) * 2 + (h)) * HTB)
#define PG8_STAGE(bufoff, gbase, voff) do { _Pragma("unroll") for (int _i = 0; _i < 2; ++_i) \
        __builtin_amdgcn_global_load_lds((const unsigned*)((const char*)(gbase) + (voff)[_i]), (PG8_LAS unsigned*)(lds + (bufoff) + ldsw + _i * 8192), 16, 0, 0); } while (0)
#define PG8_STAGE_A(bufoff, kptr, h, NEXTSEL) do { if constexpr (GATHER) { const unsigned _p = (NEXTSEL) ? gnxt[h] : gcur[h]; const unsigned _v[2] = { (_p & 0xffffu) * (unsigned)(2 * K) + gC2, (_p >> 16) * (unsigned)(2 * K) + gC2 }; PG8_STAGE(bufoff, kptr, _v); } \
        else { PG8_STAGE(bufoff, (kptr) + (h) * hstep, voffA); } } while (0)
#define PG8_LDA(dst, b, h) do { _Pragma("unroll") for (int m = 0; m < 4; ++m) _Pragma("unroll") for (int k = 0; k < 2; ++k) dst[m][k] = *(const PG8_LAS bf16x8*)(lds + PG8_SA(b, h) + aoff + m * 2048 + k * 1024); } while (0)
#define PG8_LDB(dst, b, h) do { _Pragma("unroll") for (int n = 0; n < 2; ++n) _Pragma("unroll") for (int k = 0; k < 2; ++k) dst[n][k] = *(const PG8_LAS bf16x8*)(lds + PG8_SB(b, h) + boff + n * 2048 + k * 1024); } while (0)
#define PG8_MMA(ai, bj, At, Bt) do { __builtin_amdgcn_s_setprio(1); _Pragma("unroll") for (int m = 0; m < 4; ++m) _Pragma("unroll") for (int n = 0; n < 2; ++n) _Pragma("unroll") for (int k = 0; k < 2; ++k) \
        acc[ai][bj][m][n] = __builtin_amdgcn_mfma_f32_16x16x32_bf16(Bt[n][k], At[m][k], acc[ai][bj][m][n], 0, 0, 0); __builtin_amdgcn_s_setprio(0); } while (0)
#define PG8_WAIT_V(n) asm volatile("s_waitcnt vmcnt(" #n ")" ::: "memory")
#define PG8_WAIT_L(n) asm volatile("s_waitcnt lgkmcnt(" #n ")" ::: "memory")
#define PG8_BAR __builtin_amdgcn_s_barrier()
#define PG8_SCHED __builtin_amdgcn_sched_barrier(0)
    unsigned gcur[2], gnxt[2], gC2 = 0;
    if constexpr (GATHER) { int R, C; stage_rc(tid * 16, R, C); gC2 = (unsigned)C * 2u; }
    auto load_gather = [&](int pm, unsigned (&dst)[2]) {
        int R, C; stage_rc(tid * 16, R, C);
#pragma unroll
        for (int h = 0; h < 2; ++h) { int a0 = g.rowtab[pm * BM + h * HALF + R], a1 = g.rowtab[pm * BM + h * HALF + R + 64]; a0 = a0 < 0 ? 0 : a0; a1 = a1 < 0 ? 0 : a1; dst[h] = (unsigned)(a0 >> 3) | ((unsigned)(a1 >> 3) << 16); }
    };
    Unit cur, nxt; int ui = 0;
    if (!S.next(0, cur)) return;
    f32x4 acc[2][2][4][2];
#pragma unroll
    for (int a = 0; a < 2; ++a)
#pragma unroll
        for (int b = 0; b < 2; ++b)
#pragma unroll
            for (int m = 0; m < 4; ++m)
#pragma unroll
                for (int n = 0; n < 2; ++n) acc[a][b][m][n] = (f32x4){0.f, 0.f, 0.f, 0.f};
    bf16x8 At[4][2], B0[2][2], B1[2][2];
    const char* cA = (const char*)g.A + (GATHER ? (size_t)0 : (size_t)cur.pm * tstep); const char* cB = (const char*)g.Bt + (size_t)cur.pn * tstep;
    if constexpr (GATHER) { load_gather(cur.pm, gcur); }
    S.a_ready(cur);
    if constexpr (SP2) {
        PG8_STAGE(PG8_SB(0, 0), cB, voffB); PG8_STAGE(PG8_SB(0, 1), cB + hstep, voffB); PG8_STAGE_A(PG8_SA(0, 0), cA, 0, false); PG8_STAGE_A(PG8_SA(0, 1), cA, 1, false);
        if (wr == 1) PG8_BAR;
        PG8_WAIT_V(2); PG8_BAR;
        PG8_STAGE(PG8_SB(1, 0), cB + kstep, voffB); PG8_STAGE_A(PG8_SA(1, 0), cA + kstep, 0, false); PG8_STAGE(PG8_SB(1, 1), cB + hstep + kstep, voffB);
        PG8_WAIT_V(6); PG8_BAR;
    } else {
        PG8_STAGE(PG8_SB(0, 0), cB, voffB); PG8_STAGE_A(PG8_SA(0, 0), cA, 0, false); PG8_STAGE(PG8_SB(0, 1), cB + hstep, voffB); PG8_STAGE_A(PG8_SA(0, 1), cA, 1, false);
        if (wr == 1) PG8_BAR;
        PG8_WAIT_V(4); PG8_BAR;
        PG8_STAGE(PG8_SB(1, 0), cB + kstep, voffB); PG8_STAGE_A(PG8_SA(1, 0), cA + kstep, 0, false); PG8_STAGE(PG8_SB(1, 1), cB + hstep + kstep, voffB);
        PG8_WAIT_V(6); PG8_BAR;
    }
    for (;;) {
        const bool has_next = S.next(ui + 1, nxt);
        const char* nA = (has_next && !GATHER) ? (const char*)g.A + (size_t)nxt.pm * tstep : cA; const char* nB = has_next ? (const char*)g.Bt + (size_t)nxt.pn * tstep : cB;
        if constexpr (GATHER) { if (has_next) load_gather(nxt.pm, gnxt); else {
#pragma unroll
            for (int h = 0; h < 2; ++h) { gnxt[h] = gcur[h]; } } }
        for (int t = 0; t < nt; t += 2) {
            const bool last = (t == nt - 2);
            const char* a1 = cA + (size_t)(t + 1) * kstep;
            const char* a2 = last ? nA : cA + (size_t)(t + 2) * kstep; const char* b2 = last ? nB : cB + (size_t)(t + 2) * kstep;
            const char* a3 = a2 + kstep; const char* b3 = b2 + kstep;
            if (last && has_next) S.a_ready(nxt);
            if constexpr (SP2) {
            PG8_LDB(B0, 0, 0); PG8_LDB(B1, 0, 1); PG8_SCHED; PG8_LDA(At, 0, 0); PG8_STAGE_A(PG8_SA(1, 1), a1, 1, false);
            PG8_WAIT_V(8); PG8_WAIT_L(0); PG8_BAR; PG8_MMA(0, 0, At, B0); PG8_MMA(0, 1, At, B1); PG8_BAR; PG8_SCHED;
            PG8_LDA(At, 0, 1); PG8_STAGE(PG8_SB(0, 0), b2, voffB); PG8_STAGE(PG8_SB(0, 1), b2 + hstep, voffB); PG8_STAGE_A(PG8_SA(0, 0), a2, 0, last);
            PG8_WAIT_V(8); PG8_WAIT_L(0); PG8_BAR; PG8_MMA(1, 0, At, B0); PG8_MMA(1, 1, At, B1); PG8_BAR; PG8_SCHED;
            PG8_LDB(B0, 1, 0); PG8_LDB(B1, 1, 1); PG8_SCHED; PG8_LDA(At, 1, 0); PG8_STAGE_A(PG8_SA(0, 1), a2, 1, last);
            PG8_WAIT_V(8); PG8_WAIT_L(0); PG8_BAR; PG8_MMA(0, 0, At, B0); PG8_MMA(0, 1, At, B1); PG8_BAR; PG8_SCHED;
            PG8_LDA(At, 1, 1); PG8_STAGE(PG8_SB(1, 0), b3, voffB); PG8_STAGE(PG8_SB(1, 1), b3 + hstep, voffB); PG8_STAGE_A(PG8_SA(1, 0), a3, 0, last);
            PG8_WAIT_V(8); PG8_WAIT_L(0); PG8_BAR; PG8_MMA(1, 0, At, B0); PG8_MMA(1, 1, At, B1); PG8_BAR; PG8_SCHED;
            } else {
            PG8_LDB(B0, 0, 0); PG8_SCHED; PG8_LDA(At, 0, 0); PG8_STAGE_A(PG8_SA(1, 1), a1, 1, false);
            PG8_WAIT_L(8); PG8_BAR; PG8_WAIT_L(0); PG8_MMA(0, 0, At, B0); PG8_BAR; PG8_SCHED;
            PG8_LDB(B1, 0, 1); PG8_STAGE(PG8_SB(0, 0), b2, voffB);
            PG8_BAR; PG8_WAIT_L(0); PG8_MMA(0, 1, At, B1); PG8_BAR;
            PG8_LDA(At, 0, 1); PG8_STAGE_A(PG8_SA(0, 0), a2, 0, last);
            PG8_BAR; PG8_WAIT_L(0); PG8_MMA(1, 0, At, B0); PG8_BAR; PG8_SCHED;
            PG8_STAGE(PG8_SB(0, 1), b2 + hstep, voffB);
            PG8_WAIT_V(6); PG8_BAR; PG8_MMA(1, 1, At, B1); PG8_BAR;
            PG8_LDB(B0, 1, 0); PG8_SCHED; PG8_LDA(At, 1, 0); PG8_STAGE_A(PG8_SA(0, 1), a2, 1, last);
            PG8_WAIT_L(8); PG8_BAR; PG8_WAIT_L(0); PG8_MMA(0, 0, At, B0); PG8_BAR; PG8_SCHED;
            PG8_LDB(B1, 1, 1); PG8_STAGE(PG8_SB(1, 0), b3, voffB);
            PG8_BAR; PG8_WAIT_L(0); PG8_MMA(0, 1, At, B1); PG8_BAR;
            PG8_LDA(At, 1, 1); PG8_STAGE_A(PG8_SA(1, 0), a3, 0, last);
            PG8_BAR; PG8_WAIT_L(0); PG8_MMA(1, 0, At, B0); PG8_BAR; PG8_SCHED;
            PG8_STAGE(PG8_SB(1, 1), b3 + hstep, voffB);
            PG8_WAIT_V(6); PG8_BAR; PG8_MMA(1, 1, At, B1); PG8_BAR;
            }
        }
        if constexpr (ALIGN_EPI) { if (wr == 0) PG8_BAR; }
        if constexpr (!Epi::AFTER_DRAIN) { E(acc, cur, wr, wc, fr, fq); S.done(cur); }
        if (!has_next) break;
#pragma unroll
        for (int a = 0; a < 2; ++a)
#pragma unroll
            for (int b = 0; b < 2; ++b)
#pragma unroll
                for (int m = 0; m < 4; ++m)
#pragma unroll
                    for (int n = 0; n < 2; ++n) acc[a][b][m][n] = (f32x4){0.f, 0.f, 0.f, 0.f};
        cur = nxt; cA = nA; cB = nB; ++ui;
        if constexpr (GATHER) {
#pragma unroll
            for (int h = 0; h < 2; ++h) { gcur[h] = gnxt[h]; } }
        if constexpr (ALIGN_EPI) { if (wr == 1) PG8_BAR; }
    }
    PG8_WAIT_V(0);
    if constexpr (!ALIGN_EPI) { if (wr == 0) PG8_BAR; }
    PG8_BAR;
    if constexpr (Epi::AFTER_DRAIN) { E.fused(acc, cur, wr, wc, fr, fq, lds, wid, lane); S.done(cur); }
#undef PG8_SA
#undef PG8_SB
#undef PG8_STAGE
#undef PG8_STAGE_A
#undef PG8_LDA
#undef PG8_LDB
#undef PG8_MMA
#undef PG8_WAIT_V
#undef PG8_WAIT_L
#undef PG8_BAR
#undef PG8_SCHED
}
}

typedef unsigned short bf16_t;
__device__ __forceinline__ unsigned f2bf(float f) { unsigned u = __builtin_bit_cast(unsigned, f); return (u + 0x7fffu + ((u >> 16) & 1u)) >> 16; }
__device__ __forceinline__ float bf2f(unsigned h) { return __builtin_bit_cast(float, h << 16); }
__device__ __forceinline__ float wave_sum(float v) {
#pragma unroll
    for (int o = 1; o < 64; o <<= 1) v += __shfl_xor(v, o);
    return v;
}
__device__ __forceinline__ float sigmoidf_(float x) { return 1.0f / (1.0f + expf(-x)); }
__device__ __forceinline__ float siluf_(float x) { return x / (1.0f + expf(-x)); }
__device__ __forceinline__ float softplusf_(float x) { return fmaxf(x, 0.0f) + log1pf(expf(-fabsf(x))); }
__device__ __forceinline__ float geluf_(float x) { const float u = 0.7978845608028654f * (x + 0.044715f * x * x * x); return 0.5f * x * (1.0f + tanhf(u)); }

struct Args { const float* in[39]; float* out; unsigned char* ws; int lo, hi; };

struct Ctx {
    const float* const* in; float* out; unsigned char* ws;
    LAS unsigned char* lds; float* sm;
    int tid, lane, wid, bid, G;
};

__device__ __forceinline__ unsigned pk2(float lo, float hi) { return f2bf(lo) | (f2bf(hi) << 16); }
__device__ __forceinline__ float ldbf(const bf16_t* p) { return bf2f((unsigned)*p); }
__device__ __forceinline__ float4 ldbf4(const bf16_t* p) { const uint2 v = *(const uint2*)p; return make_float4(bf2f(v.x & 0xffffu), bf2f(v.x >> 16), bf2f(v.y & 0xffffu), bf2f(v.y >> 16)); }

template <int NB, class AF, class BF, class BF2, class EF>
__device__ __forceinline__ void gemm_tile(float* sm, int K, AF af, BF bf, BF2 bf2, EF ef) {
    float* As = sm;
    float* Bs = sm + 16 * 132;
    float* Bs2 = Bs + 16 * 68;
    const int tid = threadIdx.x, ty = tid >> 4, tx = tid & 15;
    const int am = tid >> 2, ak = (tid & 3) * 4;
    const int bt = tid & 255, bk = bt >> 4, bn = (bt & 15) * 4;
    float acc[4][4], acc2[4][4];
#pragma unroll
    for (int i = 0; i < 4; ++i)
#pragma unroll
        for (int j = 0; j < 4; ++j) { acc[i][j] = 0.f; acc2[i][j] = 0.f; }
    float4 av = af(am, ak);
    float4 bv = make_float4(0.f, 0.f, 0.f, 0.f);
    if (tid < 256) bv = bf(bk, bn); else if (NB == 2) bv = bf2(bk, bn);
    for (int k0 = 0; k0 < K; k0 += 16) {
        __syncthreads();
        As[(ak + 0) * 132 + am] = av.x; As[(ak + 1) * 132 + am] = av.y; As[(ak + 2) * 132 + am] = av.z; As[(ak + 3) * 132 + am] = av.w;
        if (tid < 256) *(float4*)&Bs[bk * 68 + bn] = bv; else if (NB == 2) *(float4*)&Bs2[bk * 68 + bn] = bv;
        __syncthreads();
        if (k0 + 16 < K) {
            av = af(am, k0 + 16 + ak);
            if (tid < 256) bv = bf(k0 + 16 + bk, bn); else if (NB == 2) bv = bf2(k0 + 16 + bk, bn);
        }
#pragma unroll
        for (int kk = 0; kk < 16; ++kk) {
            const float4 a = *(const float4*)&As[kk * 132 + ty * 4];
            const float4 b = *(const float4*)&Bs[kk * 68 + tx * 4];
            const float aa[4] = {a.x, a.y, a.z, a.w};
            const float bb[4] = {b.x, b.y, b.z, b.w};
#pragma unroll
            for (int i = 0; i < 4; ++i)
#pragma unroll
                for (int j = 0; j < 4; ++j) acc[i][j] = fmaf(aa[i], bb[j], acc[i][j]);
            if (NB == 2) {
                const float4 b2 = *(const float4*)&Bs2[kk * 68 + tx * 4];
                const float bb2[4] = {b2.x, b2.y, b2.z, b2.w};
#pragma unroll
                for (int i = 0; i < 4; ++i)
#pragma unroll
                    for (int j = 0; j < 4; ++j) acc2[i][j] = fmaf(aa[i], bb2[j], acc2[i][j]);
            }
        }
    }
#pragma unroll
    for (int i = 0; i < 4; ++i)
        ef(ty * 4 + i, tx * 4, make_float4(acc[i][0], acc[i][1], acc[i][2], acc[i][3]), make_float4(acc2[i][0], acc2[i][1], acc2[i][2], acc2[i][3]));
}

template <bool RES, class RM>
__device__ __forceinline__ void transpose_item(const float* W, int K, int N, bf16_t* WT, RM rowmap, float* scr, int item, int lane) {
    const int nblk = N / 32, kb = item / nblk, nb = item % nblk, k0 = 64 * kb, n0 = 32 * nb;
#pragma unroll 8
    for (int i = 0; i < 32; ++i) { const int kk = 2 * i + (lane >> 5); scr[kk * 33 + (lane & 31)] = W[(size_t)(k0 + kk) * N + n0 + (lane & 31)]; }
    asm volatile("s_waitcnt lgkmcnt(0)" ::: "memory");
    const int c = lane & 7;
    const int r0 = rowmap(n0);
#pragma unroll
    for (int j = 0; j < 4; ++j) {
        const int n = (lane >> 3) + 8 * j; const float* s = scr + (8 * c) * 33 + n;
        float v[8];
#pragma unroll
        for (int q = 0; q < 8; ++q) { v[q] = s[q * 33]; if (RES) v[q] = v[q] - bf2f(f2bf(v[q])); }
        uint4 o; o.x = pk2(v[0], v[1]); o.y = pk2(v[2], v[3]); o.z = pk2(v[4], v[5]); o.w = pk2(v[6], v[7]);
        *(uint4*)(WT + (size_t)(r0 + n) * K + k0 + 8 * c) = o;
    }
    asm volatile("s_waitcnt lgkmcnt(0)" ::: "memory");
}

__device__ __forceinline__ void phase0(const Ctx& c) {
    const int gt = c.bid * 512 + c.tid, NT = c.G * 512;
    const int gw = c.bid * 8 + c.wid, NW = c.G * 8;
    {
        const float* cc = c.in[1]; const float* w_ada = c.in[2];
        float* modsp = (float*)(c.ws + WS_MODSP);
        for (int task = gw; task < 96 * 16; task += NW) {
            const int cg = task % 96, ks = task / 96, j = cg * 64 + c.lane;
            float a0 = 0.f, a1 = 0.f, a2 = 0.f, a3 = 0.f;
#pragma unroll 4
            for (int k = ks * 64; k < ks * 64 + 64; ++k) {
                const float wv = w_ada[(size_t)k * NMODS + j];
                a0 = fmaf(siluf_(cc[k]), wv, a0); a1 = fmaf(siluf_(cc[D + k]), wv, a1); a2 = fmaf(siluf_(cc[2 * D + k]), wv, a2); a3 = fmaf(siluf_(cc[3 * D + k]), wv, a3);
            }
            modsp[(ks * 4 + 0) * NMODS + j] = a0; modsp[(ks * 4 + 1) * NMODS + j] = a1; modsp[(ks * 4 + 2) * NMODS + j] = a2; modsp[(ks * 4 + 3) * NMODS + j] = a3;
        }
    }
    {
        const float* log_dt = c.in[20]; const float* a_re = c.in[21]; const float* a_im = c.in[22];
        const float* b_re = c.in[23]; const float* b_im = c.in[24];
        float* apow = (float*)(c.ws + WS_APOW); float* bb = (float*)(c.ws + WS_S5BB);
        for (int idx = gt; idx < S5NG * S5P; idx += NT) {
            const int g = idx / S5P, p = idx % S5P;
            const double dt = exp((double)log_dt[g]);
            const double lre = fmin((double)a_re[idx], -1e-4), lim = (double)a_im[idx];
            const double mag = exp(lre * dt), ang = lim * dt;
            const double abr = mag * cos(ang), abi = mag * sin(ang);
            const double den = lre * lre + lim * lim;
            const double nre = abr - 1.0, nim = abi;
            const double qre = (nre * lre + nim * lim) / den, qim = (nim * lre - nre * lim) / den;
            double pr = 1.0, pi = 0.0;
            for (int j = 0; j <= S5L; ++j) {
                apow[((size_t)(g * (S5L + 1) + j) * 64 + p) * 2 + 0] = (float)pr; apow[((size_t)(g * (S5L + 1) + j) * 64 + p) * 2 + 1] = (float)pi;
                const double nr = pr * abr - pi * abi, ni = pr * abi + pi * abr; pr = nr; pi = ni;
            }
            for (int ch = 0; ch < 16; ++ch) {
                const double br = (double)b_re[idx * 16 + ch], bi = (double)b_im[idx * 16 + ch];
                bb[idx * 32 + ch] = (float)(qre * br - qim * bi);
                bb[idx * 32 + 16 + ch] = (float)(qre * bi + qim * br);
            }
        }
    }
    {
        const float* w2 = c.in[11]; const float* a2 = c.in[13]; const float* g2 = c.in[14];
        bf16_t* bt = (bf16_t*)(c.ws + WS_LORA_BT);
        for (int it = gt; it < 1536 * 32; it += NT) {
            const int n = it >> 5, c0 = (it & 31) * 8;
            float v[8];
#pragma unroll
            for (int i = 0; i < 8; ++i) {
                const int col = c0 + i; float x = 0.f;
                if (n < 512) { if (col < 64) x = w2[col * RW + n]; }
                else if (n < 1024) { if (col >= 64 && col < 128) x = a2[(col - 64) * RW + (n - 512)]; }
                else { if (col >= 128) x = g2[(col - 128) * RW + (n - 1024)]; }
                v[i] = x;
            }
            *(uint4*)(bt + (size_t)n * 256 + c0) = make_uint4(pk2(v[0], v[1]), pk2(v[2], v[3]), pk2(v[4], v[5]), pk2(v[6], v[7]));
        }
    }
    float* scr = c.sm + c.wid * (64 * 33);
    constexpr int I_IN = (D / 64) * (NPROJ / 32), I_OUT = (D / 64) * (D / 32), I_GLU = (512 / 64) * (512 / 32), I_SG = (D / 64) * (256 / 32), I_SD = (256 / 64) * (D / 32), I_R = (D / 64) * (256 / 32);
    constexpr int NIT = I_IN + I_OUT + I_GLU + 2 * I_SG + I_SD + 2 * I_R;
    for (int it = gw; it < NIT; it += NW) {
        int r = it;
        if (r < I_IN) { transpose_item<false>(c.in[8], D, NPROJ, (bf16_t*)(c.ws + WS_WIN_T), [](int n) { return n; }, scr, r, c.lane); continue; } r -= I_IN;
        if (r < I_OUT) { transpose_item<false>(c.in[30], D, D, (bf16_t*)(c.ws + WS_WOUT_T), [](int n) { return n; }, scr, r, c.lane); continue; } r -= I_OUT;
        if (r < I_GLU) { transpose_item<false>(c.in[28], 512, 512, (bf16_t*)(c.ws + WS_WGLU_T), [](int n) { return n; }, scr, r, c.lane); continue; } r -= I_GLU;
        if (r < I_SG) { transpose_item<false>(c.in[36], D, 256, (bf16_t*)(c.ws + WS_WSGU_T), [](int n) { return (n >> 7) * 256 + (n & 127); }, scr, r, c.lane); continue; } r -= I_SG;
        if (r < I_SG) { transpose_item<false>(c.in[37], D, 256, (bf16_t*)(c.ws + WS_WSGU_T), [](int n) { return (n >> 7) * 256 + 128 + (n & 127); }, scr, r, c.lane); continue; } r -= I_SG;
        if (r < I_SD) { transpose_item<false>(c.in[38], 256, D, (bf16_t*)(c.ws + WS_WSD_T), [](int n) { return n; }, scr, r, c.lane); continue; } r -= I_SD;
        if (r < I_R) { transpose_item<false>(c.in[31], D, 256, (bf16_t*)(c.ws + WS_WR_T), [](int n) { return n; }, scr, r, c.lane); continue; } r -= I_R;
        transpose_item<true>(c.in[31], D, 256, (bf16_t*)(c.ws + WS_WR_T), [](int n) { return 256 + n; }, scr, r, c.lane);
    }
    for (int it = gw; it < NE * 384; it += NW) {
        const int e = it / 384, r = it % 384;
        if (r < 128) transpose_item<false>(c.in[33] + (size_t)e * D * EFF, D, EFF, (bf16_t*)(c.ws + WS_WEGU) + (size_t)e * 512 * D, [](int n) { return (n >> 7) * 256 + (n & 127); }, scr, r, c.lane);
        else if (r < 256) transpose_item<false>(c.in[34] + (size_t)e * D * EFF, D, EFF, (bf16_t*)(c.ws + WS_WEGU) + (size_t)e * 512 * D, [](int n) { return (n >> 7) * 256 + 128 + (n & 127); }, scr, r - 128, c.lane);
        else transpose_item<false>(c.in[35] + (size_t)e * EFF * D, EFF, D, (bf16_t*)(c.ws + WS_WED) + (size_t)e * D * EFF, [](int n) { return n; }, scr, r - 256, c.lane);
    }
}

__device__ __forceinline__ void phase1(const Ctx& c) {
    const int gt = c.bid * 512 + c.tid, NT = c.G * 512;
    const int gw = c.bid * 8 + c.wid, NW = c.G * 8;
    const float* modsp = (const float*)(c.ws + WS_MODSP); const float* b_ada = c.in[3]; float* mods = (float*)(c.ws + WS_MODS);
    for (int idx = gt; idx < BATCH * NMODS; idx += NT) {
        const int b = idx / NMODS, j = idx % NMODS;
        float acc = 0.f;
#pragma unroll
        for (int ks = 0; ks < 16; ++ks) acc += modsp[(ks * 4 + b) * NMODS + j];
        mods[idx] = acc + b_ada[j];
    }
    const float* apow = (const float*)(c.ws + WS_APOW); const float* bb = (const float*)(c.ws + WS_S5BB);
    const float* c_re = c.in[25]; const float* c_im = c.in[26];
    float* klag = (float*)(c.ws + WS_KLAG);
    for (int task = gw; task < S5NG * S5L; task += NW) {
        const int g = task / S5L, j = task % S5L, cc = c.lane >> 2, cq = (c.lane & 3) * 4;
        float acc[4] = {0.f, 0.f, 0.f, 0.f};
        for (int p = 0; p < 64; ++p) {
            const float ar = apow[((size_t)(g * (S5L + 1) + j) * 64 + p) * 2], ai = apow[((size_t)(g * (S5L + 1) + j) * 64 + p) * 2 + 1];
            const float cr = c_re[(g * 16 + cc) * 64 + p], ci = c_im[(g * 16 + cc) * 64 + p];
            const float4 br = *(const float4*)(bb + (size_t)(g * 64 + p) * 32 + cq), bi = *(const float4*)(bb + (size_t)(g * 64 + p) * 32 + 16 + cq);
            const float er = cr * ar - ci * ai, ei = cr * ai + ci * ar;
            acc[0] += er * br.x - ei * bi.x; acc[1] += er * br.y - ei * bi.y; acc[2] += er * br.z - ei * bi.z; acc[3] += er * br.w - ei * bi.w;
        }
        *(float4*)(klag + ((size_t)(g * S5L + j) * 16 + cc) * 16 + cq) = make_float4(acc[0], acc[1], acc[2], acc[3]);
    }
}

__device__ __forceinline__ void phase2(const Ctx& c) {
    const float* x = c.in[0]; const float* g = c.in[4];
    const float* mods = (const float*)(c.ws + WS_MODS);
    bf16_t* xn = (bf16_t*)(c.ws + WS_A);
    const int gw = c.bid * 8 + c.wid, NW = c.G * 8;
    for (int t = gw; t < T; t += NW) {
        const int b = t / SEQ;
        const float4* xr = (const float4*)(x + (size_t)t * D) + c.lane;
        float4 v[4]; float ss = 0.f;
#pragma unroll
        for (int j = 0; j < 4; ++j) { v[j] = xr[64 * j]; ss += v[j].x * v[j].x + v[j].y * v[j].y + v[j].z * v[j].z + v[j].w * v[j].w; }
        const float rstd = rsqrtf(wave_sum(ss) * (1.0f / D) + 1e-6f);
        uint2* o = (uint2*)(xn + (size_t)t * D) + c.lane;
#pragma unroll
        for (int j = 0; j < 4; ++j) {
            const int k = (c.lane + 64 * j) * 4;
            const float4 gg = *(const float4*)(g + k);
            const float4 sh = *(const float4*)(mods + b * NMODS + k);
            const float4 sc = *(const float4*)(mods + b * NMODS + D + k);
            float4 r;
            r.x = v[j].x * rstd * gg.x * (1.f + sc.x) + sh.x; r.y = v[j].y * rstd * gg.y * (1.f + sc.y) + sh.y;
            r.z = v[j].z * rstd * gg.z * (1.f + sc.z) + sh.z; r.w = v[j].w * rstd * gg.w * (1.f + sc.w) + sh.w;
            o[64 * j] = make_uint2(pk2(r.x, r.y), pk2(r.z, r.w));
        }
    }
    const int gt = c.bid * 512 + c.tid, NT = c.G * 512;
    const float* apow = (const float*)(c.ws + WS_APOW); const float* bb = (const float*)(c.ws + WS_S5BB); const float* klag = (const float*)(c.ws + WS_KLAG);
    const float* c_re = c.in[25]; const float* c_im = c.in[26]; const float* dd = c.in[27];
    bf16_t* kmat = (bf16_t*)(c.ws + WS_KMAT); bf16_t* hmat = (bf16_t*)(c.ws + WS_HMAT);
    for (int it = gt; it < S5NG * 512 * 80; it += NT) {
        const int row = it / 80, ch = it % 80, g = row >> 9, t = (row >> 4) & 31, cc = row & 15, col0 = ch * 8;
        float v[8];
        if (col0 < 512) {
            const int s = col0 >> 4, c0 = col0 & 15;
            if (s > t) {
#pragma unroll
                for (int i = 0; i < 8; ++i) v[i] = 0.f;
            } else {
                const float4 k0 = *(const float4*)(klag + ((size_t)(g * S5L + (t - s)) * 16 + cc) * 16 + c0), k1 = *(const float4*)(klag + ((size_t)(g * S5L + (t - s)) * 16 + cc) * 16 + c0 + 4);
                v[0] = k0.x; v[1] = k0.y; v[2] = k0.z; v[3] = k0.w; v[4] = k1.x; v[5] = k1.y; v[6] = k1.z; v[7] = k1.w;
                if (s == t) {
                    const float dv = dd[g * 16 + cc];
#pragma unroll
                    for (int i = 0; i < 8; ++i) if (c0 + i == cc) v[i] += dv;
                }
            }
        } else {
            const int q0 = col0 - 512;
#pragma unroll
            for (int i = 0; i < 8; ++i) {
                const int q = q0 + i, p = q & 63;
                const float ar = apow[((size_t)(g * (S5L + 1) + t + 1) * 64 + p) * 2], ai = apow[((size_t)(g * (S5L + 1) + t + 1) * 64 + p) * 2 + 1];
                const float cr = c_re[(g * 16 + cc) * 64 + p], ci = c_im[(g * 16 + cc) * 64 + p];
                v[i] = (q < 64) ? (cr * ar - ci * ai) : -(cr * ai + ci * ar);
            }
        }
        *(uint4*)(kmat + (size_t)row * 640 + col0) = make_uint4(pk2(v[0], v[1]), pk2(v[2], v[3]), pk2(v[4], v[5]), pk2(v[6], v[7]));
    }
    for (int it = gt; it < S5NG * 256 * 80; it += NT) {
        const int row = it / 80, ch = it % 80, g = row >> 8, q = row & 255, col0 = ch * 8;
        float v[8];
#pragma unroll
        for (int i = 0; i < 8; ++i) v[i] = 0.f;
        if (q < 128 && col0 < 512) {
            const int s = col0 >> 4, c0 = col0 & 15, p = q & 63;
            const float ar = apow[((size_t)(g * (S5L + 1) + (S5L - 1 - s)) * 64 + p) * 2], ai = apow[((size_t)(g * (S5L + 1) + (S5L - 1 - s)) * 64 + p) * 2 + 1];
#pragma unroll
            for (int i = 0; i < 8; ++i) {
                const float br = bb[(size_t)(g * 64 + p) * 32 + c0 + i], bi = bb[(size_t)(g * 64 + p) * 32 + 16 + c0 + i];
                v[i] = (q < 64) ? (ar * br - ai * bi) : (ar * bi + ai * br);
            }
        }
        *(uint4*)(hmat + (size_t)row * 640 + col0) = make_uint4(pk2(v[0], v[1]), pk2(v[2], v[3]), pk2(v[4], v[5]), pk2(v[6], v[7]));
    }
}

__device__ __forceinline__ void phase3(const Ctx& c) {
    pg8::Gemm g{(const bf16_t*)(c.ws + WS_A), (const bf16_t*)(c.ws + WS_WIN_T), T, NPROJ, D};
    pg8::StaticOrder S; S.init(T, NPROJ, c.G, c.bid);
    pg8::EpiBf16<0> E{(bf16_t*)(c.ws + WS_PROJ), NPROJ, nullptr, 0, 0, 1.f};
    pg8::gemm_phase<pg8::EpiBf16<0>, pg8::StaticOrder, true, true>(c.lds, g, S, E);
}

__device__ __forceinline__ void unpack8(const uint4 a, float (&u)[8]) {
    u[0] = bf2f(a.x & 0xffffu); u[1] = bf2f(a.x >> 16); u[2] = bf2f(a.y & 0xffffu); u[3] = bf2f(a.y >> 16);
    u[4] = bf2f(a.z & 0xffffu); u[5] = bf2f(a.z >> 16); u[6] = bf2f(a.w & 0xffffu); u[7] = bf2f(a.w >> 16);
}
__device__ __forceinline__ uint4 pack8(const float (&v)[8]) { return make_uint4(pk2(v[0], v[1]), pk2(v[2], v[3]), pk2(v[4], v[5]), pk2(v[6], v[7])); }
__device__ __forceinline__ void phase4(const Ctx& c) {
    const bf16_t* proj = (const bf16_t*)(c.ws + WS_PROJ);
    const float* mu = c.in[9]; const float* k_k = c.in[15];
    bf16_t* rw_r = (bf16_t*)(c.ws + WS_RW_R); bf16_t* rw_k = (bf16_t*)(c.ws + WS_RW_K); bf16_t* rw_v = (bf16_t*)(c.ws + WS_RW_V); bf16_t* rw_a = (bf16_t*)(c.ws + WS_RW_A);
    bf16_t* alora = (bf16_t*)((unsigned char*)c.out + OUT_ALORA);
    const int gw = c.bid * 8 + c.wid, NW = c.G * 8;
    for (int t = gw; t < T; t += NW) {
        const bool first = (t % SEQ == 0);
        const bf16_t* pr = proj + (size_t)t * NPROJ; const bf16_t* pp = proj + (size_t)(first ? t : t - 1) * NPROJ;
#pragma unroll
        for (int j = 0; j < 4; ++j) {
            const int cidx = c.lane + 64 * j;
            if (cidx < 224) {
                const int col = cidx * 8;
                float p[8], q[8], ps[8];
                unpack8(*(const uint4*)(pr + col), p); unpack8(*(const uint4*)(pp + col), q);
                const float4 m0 = *(const float4*)(mu + col), m1 = *(const float4*)(mu + col + 4);
                const float mm[8] = {m0.x, m0.y, m0.z, m0.w, m1.x, m1.y, m1.z, m1.w};
#pragma unroll
                for (int i = 0; i < 8; ++i) { const float pv = first ? 0.f : q[i]; ps[i] = p[i] + (pv - p[i]) * mm[i]; }
                if (j == 0) *(uint4*)(rw_r + (size_t)t * RW + col) = pack8(ps);
                else if (j == 1) {
                    const int cl = col - 512;
                    *(uint4*)(rw_k + (size_t)t * RW + cl) = pack8(ps);
                    const float4 k0 = *(const float4*)(k_k + cl), k1 = *(const float4*)(k_k + cl + 4);
                    const float kk8[8] = {k0.x, k0.y, k0.z, k0.w, k1.x, k1.y, k1.z, k1.w};
                    float kk[8]; float ss = 0.f;
#pragma unroll
                    for (int i = 0; i < 8; ++i) { kk[i] = ps[i] * kk8[i]; ss += kk[i] * kk[i]; }
                    ss += __shfl_xor(ss, 1); ss += __shfl_xor(ss, 2); ss += __shfl_xor(ss, 4);
                    const float inv = -1.0f / fmaxf(sqrtf(ss), 1e-12f);
#pragma unroll
                    for (int i = 0; i < 8; ++i) kk[i] *= inv;
                    *(uint4*)(rw_a + (size_t)t * RW + cl) = pack8(kk);
                } else if (j == 2) *(uint4*)(rw_v + (size_t)t * RW + (col - 1024)) = pack8(ps);
                else {
                    const int cl = col - 1536;
                    float o[8];
#pragma unroll
                    for (int i = 0; i < 8; ++i) o[i] = (cl < 64) ? tanhf(ps[i]) : (cl < 128) ? ps[i] : sigmoidf_(ps[i]);
                    *(uint4*)(alora + (size_t)t * 256 + cl) = pack8(o);
                }
            }
        }
    }
    bf16_t* ux = (bf16_t*)((unsigned char*)c.out + OUT_UX);
    const int gt = c.bid * 512 + c.tid, NT = c.G * 512;
    for (int it = gt; it < T * 64; it += NT) {
        const int t = it >> 6, g = (it >> 1) & 31, hf = it & 1;
        const int b = t / SEQ, s = t % S5L, chunk = (t % SEQ) / S5L;
        const uint4 v = *(const uint4*)(proj + (size_t)t * NPROJ + RPROJ + g * 16 + hf * 8);
        *(uint4*)(ux + ((size_t)(g * 1024 + b * 256 + chunk)) * 640 + s * 16 + hf * 8) = v;
    }
    for (int it = gt; it < S5NG * 1024 * 16; it += NT) {
        const int row = it >> 4, ch = it & 15;
        *(uint4*)(ux + (size_t)row * 640 + 512 + ch * 8) = make_uint4(0u, 0u, 0u, 0u);
    }
}

__device__ __forceinline__ void phase5(const Ctx& c) {
    {
        pg8::Gemm g{(const bf16_t*)((unsigned char*)c.out + OUT_ALORA), (const bf16_t*)(c.ws + WS_LORA_BT), T, 1536, 256};
        pg8::StaticOrder S; S.init(T, 1536, c.G, c.bid);
        pg8::EpiLora E{c.in[10], c.in[12], c.in[16], (float*)(c.ws + WS_RW_W), (bf16_t*)(c.ws + WS_RW_K), (const bf16_t*)(c.ws + WS_RW_A), (bf16_t*)(c.ws + WS_RW_B), (bf16_t*)(c.ws + WS_RW_G)};
        pg8::gemm_phase<pg8::EpiLora, pg8::StaticOrder, true, true>(c.lds, g, S, E);
    }
    __syncthreads();
    {
        pg8::Gemm g{(const bf16_t*)((unsigned char*)c.out + OUT_UX), (const bf16_t*)(c.ws + WS_HMAT), 0, 0, 640};
        pg8::S5Order S{128, 1, c.G, c.bid};
        pg8::EpiS5E E{(float*)((unsigned char*)c.out + OUT_E)};
        pg8::gemm_phase<pg8::EpiS5E, pg8::S5Order, true, true>(c.lds, g, S, E);
    }
}

typedef float f2v __attribute__((ext_vector_type(2)));
__device__ __forceinline__ float dpp_add16(float v) {
    v += __builtin_bit_cast(float, __builtin_amdgcn_mov_dpp(__builtin_bit_cast(int, v), 0xB1, 0xf, 0xf, true));
    v += __builtin_bit_cast(float, __builtin_amdgcn_mov_dpp(__builtin_bit_cast(int, v), 0x4E, 0xf, 0xf, true));
    v += __builtin_bit_cast(float, __builtin_amdgcn_mov_dpp(__builtin_bit_cast(int, v), 0x141, 0xf, 0xf, true));
    v += __builtin_bit_cast(float, __builtin_amdgcn_mov_dpp(__builtin_bit_cast(int, v), 0x140, 0xf, 0xf, true));
    return v;
}
constexpr int RTS = 32;
constexpr int RTILE = 6 * RTS * 64;
__device__ __forceinline__ void phase6(const Ctx& c) {
    {
        const float* apow = (const float*)(c.ws + WS_APOW); const float* E = (const float*)((const unsigned char*)c.out + OUT_E);
        bf16_t* ux = (bf16_t*)((unsigned char*)c.out + OUT_UX);
        for (int task = c.bid * 8 + c.wid; task < S5NG * BATCH; task += c.G * 8) {
            const int g = task >> 2, b = task & 3, p = c.lane;
            const float pr = apow[((size_t)(g * (S5L + 1) + S5L) * 64 + p) * 2], pi = apow[((size_t)(g * (S5L + 1) + S5L) * 64 + p) * 2 + 1];
            float xr = 0.f, xi = 0.f;
            const size_t row0 = (size_t)g * 1024 + b * 256;
            for (int ch0 = 0; ch0 < 256; ch0 += 8) {
                float er[8], ei[8];
#pragma unroll
                for (int q = 0; q < 8; ++q) { er[q] = E[(row0 + ch0 + q) * 128 + p]; ei[q] = E[(row0 + ch0 + q) * 128 + 64 + p]; }
#pragma unroll
                for (int q = 0; q < 8; ++q) {
                    ux[(row0 + ch0 + q) * 640 + 512 + p] = (bf16_t)f2bf(xr); ux[(row0 + ch0 + q) * 640 + 576 + p] = (bf16_t)f2bf(xi);
                    const float nr = pr * xr - pi * xi + er[q], ni = pr * xi + pi * xr + ei[q]; xr = nr; xi = ni;
                }
            }
        }
    }
    const float* __restrict__ rw_w = (const float*)(c.ws + WS_RW_W);
    const bf16_t* __restrict__ rw_bf = (const bf16_t*)(c.ws + WS_RW_R);
    float* __restrict__ rw_y = (float*)(c.ws + WS_RW_Y);
    float* tile = c.sm;
    constexpr size_t ARR = (size_t)T * RW;
    for (int item = c.bid; item < BATCH * NH * 8; item += c.G) {
        const int bh = item >> 3, rb = (item & 7) * 8, b = bh >> 3, h = bh & 7;
        const size_t base = (size_t)(b * SEQ) * RW + h * 64;
        const int lt = c.tid - 128;
        uint4 reg[5];
        auto issue = [&](int tl) {
#pragma unroll
            for (int i = 0; i < 5; ++i) {
                const int it = lt + 384 * i;
                if (it < 512) { const int t = it >> 4, c4 = it & 15; reg[i] = *(const uint4*)(rw_w + base + (size_t)(tl * RTS + t) * RW + c4 * 4); }
                else if (it < 1792) { const int j = it - 512, arr = j >> 8, rem = j & 255, t = rem >> 3, c8 = rem & 7;
                    const int ga = (arr == 0) ? 3 : (arr == 1) ? 4 : (arr == 2) ? 1 : (arr == 3) ? 0 : 2;
                    reg[i] = *(const uint4*)(rw_bf + (size_t)ga * ARR + base + (size_t)(tl * RTS + t) * RW + c8 * 8); }
            }
        };
        auto commit = [&](int buf) {
            float* tb = tile + buf * RTILE;
#pragma unroll
            for (int i = 0; i < 5; ++i) {
                const int it = lt + 384 * i;
                if (it < 512) { const int t = it >> 4, c4 = it & 15; *(uint4*)(tb + t * 64 + c4 * 4) = reg[i]; }
                else if (it < 1792) { const int j = it - 512, arr = j >> 8, rem = j & 255, t = rem >> 3, c8 = rem & 7;
                    float* d = tb + (arr + 1) * RTS * 64 + t * 64 + c8 * 8;
                    const uint4 v = reg[i];
                    *(float4*)d = make_float4(bf2f(v.x & 0xffffu), bf2f(v.x >> 16), bf2f(v.y & 0xffffu), bf2f(v.y >> 16));
                    *(float4*)(d + 4) = make_float4(bf2f(v.z & 0xffffu), bf2f(v.z >> 16), bf2f(v.w & 0xffffu), bf2f(v.w >> 16)); }
            }
        };
        __syncthreads();
        if (c.wid >= 2) { issue(0); commit(0); issue(1); }
        __syncthreads();
        const int row = rb + (c.wid & 1) * 4 + (c.lane >> 4), kq = c.lane & 15;
        f2v S01 = {0.f, 0.f}, S23 = {0.f, 0.f};
        float* Y = rw_y + base + row;
        constexpr int NTL = SEQ / RTS;
        for (int tl = 0; tl < NTL; ++tl) {
            if (c.wid < 2) {
                const float* tb = tile + (tl & 1) * RTILE + kq * 4;
                const float* tv = tile + (tl & 1) * RTILE + 5 * RTS * 64 + row;
                float4 w = *(const float4*)(tb), a = *(const float4*)(tb + 1 * RTS * 64), bb = *(const float4*)(tb + 2 * RTS * 64), k = *(const float4*)(tb + 3 * RTS * 64), r = *(const float4*)(tb + 4 * RTS * 64);
                float v = tv[0];
                float ysel = 0.f;
#pragma unroll
                for (int t = 0; t < RTS; ++t) {
                    const int tn = (t + 1 < RTS) ? t + 1 : t;
                    const float4 wn = *(const float4*)(tb + tn * 64), an = *(const float4*)(tb + 1 * RTS * 64 + tn * 64), bn = *(const float4*)(tb + 2 * RTS * 64 + tn * 64);
                    const float4 kn = *(const float4*)(tb + 3 * RTS * 64 + tn * 64), rn = *(const float4*)(tb + 4 * RTS * 64 + tn * 64);
                    const float vn = tv[tn * 64];
                    const f2v a01 = {a.x, a.y}, a23 = {a.z, a.w}, w01 = {w.x, w.y}, w23 = {w.z, w.w}, b01 = {bb.x, bb.y}, b23 = {bb.z, bb.w};
                    const f2v k01 = {k.x, k.y}, k23 = {k.z, k.w}, r01 = {r.x, r.y}, r23 = {r.z, r.w};
                    f2v p = S01 * a01; p = __builtin_elementwise_fma(S23, a23, p);
                    const float sa = dpp_add16(p.x + p.y);
                    const f2v vv = {v, v}, sav = {sa, sa};
                    S01 = __builtin_elementwise_fma(S01, w01, vv * k01); S23 = __builtin_elementwise_fma(S23, w23, vv * k23);
                    S01 = __builtin_elementwise_fma(sav, b01, S01); S23 = __builtin_elementwise_fma(sav, b23, S23);
                    f2v q = S01 * r01; q = __builtin_elementwise_fma(S23, r23, q);
                    const float y = dpp_add16(q.x + q.y);
                    ysel = (kq == (t & 15)) ? y : ysel;
                    if ((t & 15) == 15) Y[(size_t)(tl * RTS + (t - 15) + kq) * RW] = ysel;
                    w = wn; a = an; bb = bn; k = kn; r = rn; v = vn;
                }
            } else {
                if (tl + 1 < NTL) commit((tl + 1) & 1);
                if (tl + 2 < NTL) issue(tl + 2);
            }
            __syncthreads();
        }
    }
}

__device__ __forceinline__ void phase7(const Ctx& c) {
    {
        pg8::Gemm g{(const bf16_t*)((unsigned char*)c.out + OUT_UX), (const bf16_t*)(c.ws + WS_KMAT), 0, 0, 640};
        pg8::S5Order S{256, 2, c.G, c.bid};
        pg8::EpiS5Out E{(bf16_t*)(c.ws + WS_YS5)};
        pg8::gemm_phase<pg8::EpiS5Out, pg8::S5Order, true, true>(c.lds, g, S, E);
    }
    __syncthreads();
    const bf16_t* rw_r = (const bf16_t*)(c.ws + WS_RW_R); const bf16_t* rw_k = (const bf16_t*)(c.ws + WS_RW_K);
    const bf16_t* rw_v = (const bf16_t*)(c.ws + WS_RW_V); const bf16_t* rw_g = (const bf16_t*)(c.ws + WS_RW_G);
    const float* rw_y = (const float*)(c.ws + WS_RW_Y);
    const float* r_k = c.in[17]; const float* ln_w = c.in[18]; const float* ln_b = c.in[19];
    bf16_t* ycat = (bf16_t*)(c.ws + WS_A);
    const int gw = c.bid * 8 + c.wid, NW = c.G * 8;
    for (int it = gw; it < T * NH; it += NW) {
        const int t = it >> 3, h = it & 7, hn = h * 64 + c.lane;
        const size_t o = (size_t)t * RW + hn;
        const float y = rw_y[o];
        const float mean = wave_sum(y) * (1.f / 64.f);
        const float d = y - mean;
        const float var = wave_sum(d * d) * (1.f / 64.f);
        const float yn = d * rsqrtf(var + 64e-5f) * ln_w[hn] + ln_b[hn];
        const float v = ldbf(rw_v + o);
        const float bonus = wave_sum(ldbf(rw_r + o) * ldbf(rw_k + o) * r_k[hn]) * v;
        ycat[(size_t)t * D + hn] = (bf16_t)f2bf((yn + bonus) * ldbf(rw_g + o));
    }
}

__device__ __forceinline__ void phase8(const Ctx& c) {
    pg8::Gemm g{(const bf16_t*)(c.ws + WS_YS5), (const bf16_t*)(c.ws + WS_WGLU_T), T, 512, 512};
    pg8::StaticOrder S; S.init(T, 512, c.G, c.bid);
    pg8::EpiGLU E{(const bf16_t*)(c.ws + WS_YS5), 512, c.in[29], (bf16_t*)(c.ws + WS_A), D, 512};
    pg8::gemm_phase<pg8::EpiGLU, pg8::StaticOrder, true, true>(c.lds, g, S, E);
}

__device__ __forceinline__ void phase9(const Ctx& c) {
    pg8::Gemm g{(const bf16_t*)(c.ws + WS_A), (const bf16_t*)(c.ws + WS_WOUT_T), T, D, D};
    pg8::StaticOrder S; S.init(T, D, c.G, c.bid);
    pg8::EpiF32 E{(float*)(c.ws + WS_PROJ), D};
    pg8::gemm_phase<pg8::EpiF32, pg8::StaticOrder, true, true>(c.lds, g, S, E);
}

__device__ __forceinline__ void phase10(const Ctx& c) {
    const float* x = c.in[0]; const float* gpm = c.in[5]; const float* gpf = c.in[6];
    const float* mods = (const float*)(c.ws + WS_MODS); const float* mixed = (const float*)(c.ws + WS_PROJ);
    bf16_t* h2 = (bf16_t*)(c.ws + WS_A); float* x1o = c.out;
    const int gw = c.bid * 8 + c.wid, NW = c.G * 8;
    for (int t = gw; t < T; t += NW) {
        const int b = t / SEQ;
        const float4* mr = (const float4*)(mixed + (size_t)t * D) + c.lane;
        const float4* xr = (const float4*)(x + (size_t)t * D) + c.lane;
        float4 m[4], v[4]; float ss = 0.f;
#pragma unroll
        for (int j = 0; j < 4; ++j) { m[j] = mr[64 * j]; v[j] = xr[64 * j]; ss += m[j].x * m[j].x + m[j].y * m[j].y + m[j].z * m[j].z + m[j].w * m[j].w; }
        const float rstd = rsqrtf(wave_sum(ss) * (1.0f / D) + 1e-6f);
        float s1 = 0.f;
#pragma unroll
        for (int j = 0; j < 4; ++j) {
            const int k = (c.lane + 64 * j) * 4;
            const float4 gg = *(const float4*)(gpm + k);
            const float4 gt = *(const float4*)(mods + b * NMODS + 2 * D + k);
            v[j].x += gt.x * (m[j].x * rstd * gg.x); v[j].y += gt.y * (m[j].y * rstd * gg.y);
            v[j].z += gt.z * (m[j].z * rstd * gg.z); v[j].w += gt.w * (m[j].w * rstd * gg.w);
            s1 += v[j].x * v[j].x + v[j].y * v[j].y + v[j].z * v[j].z + v[j].w * v[j].w;
            ((float4*)(x1o + (size_t)t * D) + c.lane)[64 * j] = v[j];
        }
        const float rstd1 = rsqrtf(wave_sum(s1) * (1.0f / D) + 1e-6f);
#pragma unroll
        for (int j = 0; j < 4; ++j) {
            const int k = (c.lane + 64 * j) * 4;
            const float4 gg = *(const float4*)(gpf + k);
            const float4 sh = *(const float4*)(mods + b * NMODS + 3 * D + k);
            const float4 sc = *(const float4*)(mods + b * NMODS + 4 * D + k);
            float r[4];
            r[0] = v[j].x * rstd1 * gg.x * (1.f + sc.x) + sh.x; r[1] = v[j].y * rstd1 * gg.y * (1.f + sc.y) + sh.y;
            r[2] = v[j].z * rstd1 * gg.z * (1.f + sc.z) + sh.z; r[3] = v[j].w * rstd1 * gg.w * (1.f + sc.w) + sh.w;
            unsigned hi[4]; float lo[4];
#pragma unroll
            for (int q = 0; q < 4; ++q) { hi[q] = f2bf(r[q]); lo[q] = r[q] - bf2f(hi[q]); }
            ((uint2*)(h2 + (size_t)t * D) + c.lane)[64 * j] = make_uint2(hi[0] | (hi[1] << 16), hi[2] | (hi[3] << 16));
            ((uint2*)(h2 + (size_t)(T + t) * D) + c.lane)[64 * j] = make_uint2(pk2(lo[0], lo[1]), pk2(lo[2], lo[3]));
        }
    }
}

__device__ __forceinline__ void phase11(const Ctx& c) {
    {
        pg8::Gemm g{(const bf16_t*)(c.ws + WS_A), (const bf16_t*)(c.ws + WS_WR_T), 2 * T, 512, D};
        pg8::StaticOrder S; S.init(2 * T, 512, c.G, c.bid);
        pg8::EpiF32 E{(float*)(c.ws + WS_PLOG), 512};
        pg8::gemm_phase<pg8::EpiF32, pg8::StaticOrder, true, true>(c.lds, g, S, E);
    }
    __syncthreads();
    {
        pg8::Gemm g{(const bf16_t*)(c.ws + WS_A), (const bf16_t*)(c.ws + WS_WSGU_T), T, 512, D};
        pg8::StaticOrder S; S.init(T, 512, c.G, c.bid);
        pg8::EpiSwiGLU E{(bf16_t*)(c.ws + WS_HS), 256};
        pg8::gemm_phase<pg8::EpiSwiGLU, pg8::StaticOrder, true, true>(c.lds, g, S, E);
    }
}

#define DPPU(v, ctrl) ((unsigned)__builtin_amdgcn_mov_dpp((int)(v), (ctrl), 0xf, 0xf, true))
#define DPPF(v, ctrl) __builtin_bit_cast(float, __builtin_amdgcn_mov_dpp(__builtin_bit_cast(int, (v)), (ctrl), 0xf, 0xf, true))
__device__ __forceinline__ unsigned fkey(float f) { const unsigned u = __builtin_bit_cast(unsigned, f); return u ^ ((u >> 31) ? 0xffffffffu : 0x80000000u); }
__device__ __forceinline__ unsigned wave_umax(unsigned v) {
    v = max(v, DPPU(v, 0xB1)); v = max(v, DPPU(v, 0x4E)); v = max(v, DPPU(v, 0x141)); v = max(v, DPPU(v, 0x140));
    const unsigned a = __builtin_amdgcn_readlane(v, 0), b = __builtin_amdgcn_readlane(v, 16), c = __builtin_amdgcn_readlane(v, 32), d = __builtin_amdgcn_readlane(v, 48);
    return max(max(a, b), max(c, d));
}
__device__ __forceinline__ unsigned wave_umin(unsigned v) {
    v = min(v, DPPU(v, 0xB1)); v = min(v, DPPU(v, 0x4E)); v = min(v, DPPU(v, 0x141)); v = min(v, DPPU(v, 0x140));
    const unsigned a = __builtin_amdgcn_readlane(v, 0), b = __builtin_amdgcn_readlane(v, 16), c = __builtin_amdgcn_readlane(v, 32), d = __builtin_amdgcn_readlane(v, 48);
    return min(min(a, b), min(c, d));
}
__device__ __forceinline__ void phase12(const Ctx& c) {
    const float* plog = (const float*)(c.ws + WS_PLOG); const float* rb = c.in[32];
    int* idx = (int*)(c.ws + WS_IDX); float* wt = (float*)(c.ws + WS_WT); unsigned* counts = (unsigned*)(c.ws + WS_COUNTS);
    const int gw = c.bid * 8 + c.wid, NW = c.G * 8, l = c.lane;
    const float4 bias = *(const float4*)(rb + l * 4);
    for (int t = gw; t < T; t += NW) {
        const float4 p0 = *(const float4*)(plog + (size_t)t * 512 + l * 4), p1 = *(const float4*)(plog + (size_t)t * 512 + 256 + l * 4);
        const float4 p2 = *(const float4*)(plog + (size_t)(T + t) * 512 + l * 4), p3 = *(const float4*)(plog + (size_t)(T + t) * 512 + 256 + l * 4);
        const float lg[4] = {p0.x + (p1.x + p2.x + p3.x), p0.y + (p1.y + p2.y + p3.y), p0.z + (p1.z + p2.z + p3.z), p0.w + (p1.w + p2.w + p3.w)};
        float s[4] = {sigmoidf_(lg[0]), sigmoidf_(lg[1]), sigmoidf_(lg[2]), sigmoidf_(lg[3])};
        float ch[4] = {s[0] + bias.x, s[1] + bias.y, s[2] + bias.z, s[3] + bias.w};
        float a1 = fmaxf(ch[0], ch[1]), a2 = fminf(ch[0], ch[1]);
        { const float b1 = fmaxf(ch[2], ch[3]), b2 = fminf(ch[2], ch[3]); const float n1 = fmaxf(a1, b1), n2 = fmaxf(fminf(a1, b1), fmaxf(a2, b2)); a1 = n1; a2 = n2; }
        { const float b1 = DPPF(a1, 0xB1), b2 = DPPF(a2, 0xB1); const float n1 = fmaxf(a1, b1), n2 = fmaxf(fminf(a1, b1), fmaxf(a2, b2)); a1 = n1; a2 = n2; }
        { const float b1 = DPPF(a1, 0x4E), b2 = DPPF(a2, 0x4E); const float n1 = fmaxf(a1, b1), n2 = fmaxf(fminf(a1, b1), fmaxf(a2, b2)); a1 = n1; a2 = n2; }
        { const float b1 = DPPF(a1, 0x141), b2 = DPPF(a2, 0x141); const float n1 = fmaxf(a1, b1), n2 = fmaxf(fminf(a1, b1), fmaxf(a2, b2)); a1 = n1; a2 = n2; }
        const float gs = a1 + a2; const int myg = l >> 3;
        int rank = 0;
#pragma unroll
        for (int g = 0; g < 8; ++g) { const float og = __builtin_bit_cast(float, __builtin_amdgcn_readlane(__builtin_bit_cast(int, gs), g * 8)); rank += (og > gs || (og == gs && g < myg)) ? 1 : 0; }
        const bool sel = rank < 4;
        unsigned mk[4];
#pragma unroll
        for (int i = 0; i < 4; ++i) mk[i] = sel ? fkey(ch[i]) : 0u;
        float sk[8]; int ek[8]; float ssum = 0.f;
#pragma unroll
        for (int k = 0; k < 8; ++k) {
            const unsigned lm = max(max(mk[0], mk[1]), max(mk[2], mk[3]));
            const unsigned m = wave_umax(lm);
            unsigned cand = 1023u;
#pragma unroll
            for (int i = 3; i >= 0; --i) if (mk[i] == m) cand = (unsigned)(l * 4 + i);
            const int be = (int)wave_umin(cand);
            const int ii = be & 3;
            float sv = s[0]; sv = (ii == 1) ? s[1] : sv; sv = (ii == 2) ? s[2] : sv; sv = (ii == 3) ? s[3] : sv;
            sv = __builtin_bit_cast(float, __builtin_amdgcn_readlane(__builtin_bit_cast(int, sv), be >> 2));
            if ((be >> 2) == l) {
#pragma unroll
                for (int i = 0; i < 4; ++i) if (i == ii) mk[i] = 0u;
            }
            sk[k] = sv; ek[k] = be; ssum += sv;
        }
        if (l == 0) {
            const float inv = 2.5f / ssum;
#pragma unroll
            for (int k = 0; k < 8; ++k) { idx[t * 8 + k] = ek[k]; wt[t * 8 + k] = sk[k] * inv; atomicAdd(&counts[ek[k]], 1u); }
        }
    }
}

__device__ __forceinline__ void build_ustart(const Ctx& c, int* smi) {
    const unsigned* counts = (const unsigned*)(c.ws + WS_COUNTS);
    __syncthreads();
    if (c.tid < NE) smi[300 + c.tid] = ((int)counts[c.tid] + 255) >> 8;
    __syncthreads();
    if (c.tid < 64) {
        const int l = c.tid; const int u0 = smi[300 + l * 4], u1 = smi[300 + l * 4 + 1], u2 = smi[300 + l * 4 + 2], u3 = smi[300 + l * 4 + 3];
        const int tot = u0 + u1 + u2 + u3; int inc = tot;
#pragma unroll
        for (int o = 1; o < 64; o <<= 1) { const int v = __shfl_up(inc, o); if (l >= o) inc += v; }
        const int ex = inc - tot;
        smi[l * 4] = ex; smi[l * 4 + 1] = ex + u0; smi[l * 4 + 2] = ex + u0 + u1; smi[l * 4 + 3] = ex + u0 + u1 + u2;
        if (l == 63) smi[NE] = inc;
    }
    __syncthreads();
}

__device__ __forceinline__ void phase13(const Ctx& c) {
    int* smi = (int*)c.sm;
    build_ustart(c, smi);
    const int* idx = (const int*)(c.ws + WS_IDX); int* slotp = (int*)(c.ws + WS_SLOTP); int* uexp = (int*)(c.ws + WS_UEXP);
    unsigned* cursor = (unsigned*)(c.ws + WS_COUNTS) + 256; const unsigned* counts = (const unsigned*)(c.ws + WS_COUNTS);
    const int gt = c.bid * 512 + c.tid, NT = c.G * 512;
    for (int a = gt; a < T * 8; a += NT) {
        const int e = idx[a];
        const unsigned pos = atomicAdd(&cursor[e], 1u);
        slotp[smi[e] * 256 + (int)pos] = a;
    }
    for (int e = gt; e < NE; e += NT) {
        const int u0 = smi[e], u1 = smi[e + 1], cn = (int)counts[e];
        for (int p = cn; p < (u1 - u0) * 256; ++p) slotp[u0 * 256 + p] = -1;
        for (int u = u0; u < u1; ++u) uexp[u] = e;
    }
    if (gt == 0) uexp[2048] = smi[NE];
}

__device__ __forceinline__ void phase14(const Ctx& c) {
    const int* uexp = (const int*)(c.ws + WS_UEXP);
    const int NU = __builtin_amdgcn_readfirstlane(uexp[2048]);
    const int vcu = (c.G % 8 == 0) ? (c.bid % 8) * (c.G / 8) + c.bid / 8 : c.bid;
    pg8::Gemm g{(const bf16_t*)(c.ws + WS_A), (const bf16_t*)(c.ws + WS_WEGU), 0, 0, D, (const int*)(c.ws + WS_SLOTP)};
    pg8::ExpertOrder S{uexp, NU, 2, c.G, vcu};
    pg8::EpiSwiGLU E{(bf16_t*)(c.ws + WS_HID), 256};
    pg8::gemm_phase<pg8::EpiSwiGLU, pg8::ExpertOrder, true, true, true>(c.lds, g, S, E);
}

__device__ __forceinline__ void phase15(const Ctx& c) {
    {
        const int* uexp = (const int*)(c.ws + WS_UEXP);
        const int NU = __builtin_amdgcn_readfirstlane(uexp[2048]);
        const int vcu = (c.G % 8 == 0) ? (c.bid % 8) * (c.G / 8) + c.bid / 8 : c.bid;
        pg8::Gemm g{(const bf16_t*)(c.ws + WS_HID), (const bf16_t*)(c.ws + WS_WED), 0, 0, EFF};
        pg8::ExpertOrder S{uexp, NU, 4, c.G, vcu};
        pg8::EpiScatter E{(const int*)(c.ws + WS_SLOTP), (const float*)(c.ws + WS_WT), (bf16_t*)(c.ws + WS_YEXP), D};
        pg8::gemm_phase<pg8::EpiScatter, pg8::ExpertOrder, true, true>(c.lds, g, S, E);
    }
    __syncthreads();
    {
        pg8::Gemm g{(const bf16_t*)(c.ws + WS_HS), (const bf16_t*)(c.ws + WS_WSD_T), T, D, 256};
        pg8::StaticOrder S; S.init(T, D, c.G, c.bid);
        pg8::EpiF32 E{(float*)(c.ws + WS_SHOUT), D};
        pg8::gemm_phase<pg8::EpiF32, pg8::StaticOrder, true, true>(c.lds, g, S, E);
    }
}

__device__ __forceinline__ void phase16(const Ctx& c) {
    const float* gq = c.in[7]; const float* mods = (const float*)(c.ws + WS_MODS);
    const float* shout = (const float*)(c.ws + WS_SHOUT); const bf16_t* yexp = (const bf16_t*)(c.ws + WS_YEXP);
    float* out = c.out;
    const int gw = c.bid * 8 + c.wid, NW = c.G * 8;
    for (int t = gw; t < T; t += NW) {
        const int b = t / SEQ;
        float4 y[4]; float ss = 0.f;
#pragma unroll
        for (int j = 0; j < 4; ++j) {
            const int k = (c.lane + 64 * j) * 4;
            float4 a = *(const float4*)(shout + (size_t)t * D + k);
#pragma unroll
            for (int q = 0; q < 8; ++q) {
                const float4 v = ldbf4(yexp + (size_t)(t * 8 + q) * D + k);
                a.x += v.x; a.y += v.y; a.z += v.z; a.w += v.w;
            }
            y[j] = a; ss += a.x * a.x + a.y * a.y + a.z * a.z + a.w * a.w;
        }
        const float rstd = rsqrtf(wave_sum(ss) * (1.0f / D) + 1e-6f);
#pragma unroll
        for (int j = 0; j < 4; ++j) {
            const int k = (c.lane + 64 * j) * 4;
            const float4 gg = *(const float4*)(gq + k);
            const float4 gt = *(const float4*)(mods + b * NMODS + 5 * D + k);
            float4 x1 = *(const float4*)(out + (size_t)t * D + k);
            x1.x += gt.x * (y[j].x * rstd * gg.x); x1.y += gt.y * (y[j].y * rstd * gg.y);
            x1.z += gt.z * (y[j].z * rstd * gg.z); x1.w += gt.w * (y[j].w * rstd * gg.w);
            *(float4*)(out + (size_t)t * D + k) = x1;
        }
    }
}

constexpr int NPHASES = 17;

__global__ void __launch_bounds__(512, 2) mega(Args args) {
    extern __shared__ __attribute__((aligned(16))) unsigned char lds_raw[];
    Ctx c;
    c.in = args.in; c.out = args.out; c.ws = args.ws;
    c.lds = (LAS unsigned char*)lds_raw; c.sm = (float*)lds_raw;
    c.tid = threadIdx.x; c.lane = c.tid & 63; c.wid = __builtin_amdgcn_readfirstlane(c.tid >> 6); c.bid = blockIdx.x; c.G = gridDim.x;
    volatile LAS unsigned* st = (volatile LAS unsigned*)(c.lds + LDS_CTL_OFF);
    if (c.tid < 4) st[c.tid] = 0u;
    __syncthreads();
    XcdBarrier bar; bar.bar = (unsigned*)(args.ws + WS_CTL); bar.x = 0; bar.st = st;
    const bool multi = (args.hi - args.lo) > 1;
    if (multi) bar = xcd_barrier_post((unsigned*)(args.ws + WS_CTL), st);
    const int lo = args.lo, hi = args.hi;
#ifndef REPEAT_PHASE
#define REPEAT_PHASE -1
#endif
#define RUN_PHASE(k, call) if (lo <= (k) && (k) < hi) { if ((k) == REPEAT_PHASE) { call; xcd_barrier(bar); } call; if ((k) + 1 < hi) xcd_barrier(bar); }
    RUN_PHASE(0, phase0(c))
    RUN_PHASE(1, phase1(c))
    RUN_PHASE(2, phase2(c))
    RUN_PHASE(3, phase3(c))
    RUN_PHASE(4, phase4(c))
    RUN_PHASE(5, phase5(c))
    RUN_PHASE(6, phase6(c))
    RUN_PHASE(7, phase7(c))
    RUN_PHASE(8, phase8(c))
    RUN_PHASE(9, phase9(c))
    RUN_PHASE(10, phase10(c))
    RUN_PHASE(11, phase11(c))
    RUN_PHASE(12, phase12(c))
    RUN_PHASE(13, phase13(c))
    RUN_PHASE(14, phase14(c))
    RUN_PHASE(15, phase15(c))
    RUN_PHASE(16, phase16(c))
#undef RUN_PHASE
}

#ifndef N_LAUNCH_MODE
#define N_LAUNCH_MODE 1
#endif

extern "C" void kernel_launch(void* const* d_in, const int* in_sizes, int n_in, void* d_out, int out_size, void* d_ws, size_t ws_size, hipStream_t stream) {
    static int grid = 0;
    if (grid == 0) {
        if (n_in != 39 || out_size != T * D || ws_size < WS_END) { fprintf(stderr, "kernel_launch: unexpected shapes n_in %d out %d ws %zu\n", n_in, out_size, ws_size); grid = -1; return; }
        int dev = 0, cus = 0, per_cu = 0;
        if (hipGetDevice(&dev) != hipSuccess || hipDeviceGetAttribute(&cus, hipDeviceAttributeMultiprocessorCount, dev) != hipSuccess) { grid = -1; return; }
        if (hipFuncSetAttribute((const void*)mega, hipFuncAttributeMaxDynamicSharedMemorySize, LDS_BYTES) != hipSuccess) { grid = -1; return; }
        if (hipOccupancyMaxActiveBlocksPerMultiprocessor(&per_cu, (const void*)mega, 512, LDS_BYTES) != hipSuccess || per_cu < 1) { fprintf(stderr, "kernel_launch: occupancy query says %d\n", per_cu); }
        (void)hipGetLastError();
        grid = cus;
    }
    if (grid < 0) return;
    (void)hipMemsetAsync((char*)d_ws + WS_CTL, 0, CTL_BYTES, stream);
    Args a{};
    for (int i = 0; i < 39; ++i) a.in[i] = (const float*)d_in[i];
    a.out = (float*)d_out; a.ws = (unsigned char*)d_ws;
    if (N_LAUNCH_MODE == 1) {
        a.lo = 0; a.hi = NPHASES;
        hipLaunchKernelGGL(mega, dim3(grid), dim3(512), LDS_BYTES, stream, a);
    } else {
        for (int ph = 0; ph < NPHASES; ++ph) {
            a.lo = ph; a.hi = ph + 1;
            hipLaunchKernelGGL(mega, dim3(grid), dim3(512), LDS_BYTES, stream, a);
        }
    }
}
```

```cpp
#include <hip/hip_runtime.h>
#include <cstdint>
#include <cstdio>

#define LAS __attribute__((address_space(3)))

constexpr int D = 1024, BATCH = 4, SEQ = 8192, T = BATCH * SEQ;
constexpr int RW = 512, NH = 8;
constexpr int RPROJ = 1792, NPROJ = 2304;
constexpr int S5NG = 32, S5P = 64;
constexpr int NE = 256, EFF = 256;
constexpr int NMODS = 6 * D;
constexpr int S5L = 32;

constexpr size_t MiB = 1u << 20;
constexpr size_t WS_CTL = 0, CTL_BYTES = 1 * MiB;
constexpr size_t WS_COUNTS = 64 * 1024;
constexpr size_t WS_MODS = 1 * MiB;
constexpr size_t WS_HMAT = 2 * MiB;
constexpr size_t WS_WIN_T = 12 * MiB;
constexpr size_t WS_WOUT_T = 17 * MiB;
constexpr size_t WS_WGLU_T = 19 * MiB;
constexpr size_t WS_WSGU_T = 19 * MiB + 512 * 1024;
constexpr size_t WS_WSD_T = 20 * MiB + 512 * 1024;
constexpr size_t WS_WR_T = 21 * MiB;
constexpr size_t WS_LORA_BT = 22 * MiB;
constexpr size_t WS_APOW = 23 * MiB;
constexpr size_t WS_KMAT = 1000 * MiB;
constexpr size_t WS_MODSP = 1020 * MiB;
constexpr size_t WS_S5BB = 1022 * MiB;
constexpr size_t WS_KLAG = 1022 * MiB + 512 * 1024;
constexpr size_t OUT_UX = 0;
constexpr size_t OUT_E = 40 * MiB;
constexpr size_t OUT_ALORA = 56 * MiB;
constexpr size_t WS_WED = 24 * MiB;
constexpr size_t WS_WEGU = 152 * MiB;
constexpr size_t WS_A = 408 * MiB;
constexpr size_t WS_YS5 = WS_A + 64 * MiB;
constexpr size_t WS_PROJ = 536 * MiB;
constexpr size_t WS_RW = 680 * MiB;
constexpr size_t RWSZ = (size_t)T * RW * 4;
constexpr size_t RWSZH = (size_t)T * RW * 2;
constexpr size_t WS_RW_W = WS_RW, WS_RW_Y = WS_RW + RWSZ, WS_RW_R = WS_RW + 2 * RWSZ, WS_RW_K = WS_RW_R + RWSZH, WS_RW_V = WS_RW_K + RWSZH,
                 WS_RW_A = WS_RW_V + RWSZH, WS_RW_B = WS_RW_A + RWSZH, WS_RW_G = WS_RW_B + RWSZH;
constexpr size_t WS_CM = WS_PROJ, WS_CN = WS_PROJ + 32 * MiB, WS_CQ = WS_PROJ + 64 * MiB, WS_CY = WS_PROJ + 96 * MiB;
constexpr size_t WS_CS = WS_RW_Y, WS_CBON = WS_RW_Y + 32 * MiB;
constexpr size_t WS_PLOG = 680 * MiB;
constexpr size_t WS_SHOUT = 680 * MiB;
constexpr size_t WS_HS = 808 * MiB;
constexpr size_t WS_IDX = 824 * MiB;
constexpr size_t WS_WT = 825 * MiB;
constexpr size_t WS_SLOTP = 826 * MiB;
constexpr size_t WS_UEXP = 827 * MiB + 512 * 1024;
constexpr size_t WS_HID = 840 * MiB;
constexpr size_t WS_YEXP = 152 * MiB;
constexpr size_t WS_END = 1023 * MiB + 512 * 1024;

constexpr int LDS_BYTES = 132096;
constexpr int LDS_CTL_OFF = 131072;

#define XB_TMO      128
#define XB_XCNT(j)  (256  + 64 * (j))
#define XB_XSUB(j)  (1280 + 64 * (j))
#define XB_XGEN(j)  (2304 + 64 * (j))
#define XB_TOP      3328
#define XB_TOPGEN   3392
#define XCD_BAR_WORDS 3456
#define XB_SPIN_CAP (1u << 24)

__device__ __forceinline__ unsigned xb_ld(unsigned* p)              { return __hip_atomic_load(p, __ATOMIC_RELAXED, __HIP_MEMORY_SCOPE_AGENT); }
__device__ __forceinline__ unsigned xb_add(unsigned* p, unsigned v) { return __hip_atomic_fetch_add(p, v, __ATOMIC_RELAXED, __HIP_MEMORY_SCOPE_AGENT); }
__device__ __forceinline__ unsigned xb_xcc_id() { return (unsigned)__builtin_amdgcn_s_getreg((3 << 11) | 20) & 0xFu; }
#define XB_SPIN(cond, bar) do { unsigned _sp = 0; while (cond) { __builtin_amdgcn_s_sleep(1); \
    if ((++_sp & 255u) == 0u) { if (xb_ld(&(bar)[XB_TMO])) break; if (_sp > XB_SPIN_CAP) { atomicAdd(&(bar)[XB_TMO], 1u); break; } } } } while (0)

struct XcdBarrier { unsigned* bar; unsigned x; volatile LAS unsigned* st; };

__device__ __forceinline__ XcdBarrier xcd_barrier_post(unsigned* bar, volatile LAS unsigned* st) {
    XcdBarrier b; b.bar = bar; b.x = xb_xcc_id(); b.st = st;
    if (threadIdx.x == 0) (void)xb_add(&bar[XB_XCNT(b.x)], 1u);
    return b;
}
__device__ __forceinline__ void xcd_barrier_complete(unsigned* bar, unsigned x, unsigned& nloc, unsigned& nx) {
    const unsigned G = gridDim.x * gridDim.y * gridDim.z;
    unsigned sum, cnt, mine, sp = 0u;
    for (;;) {
        sum = 0u; cnt = 0u; mine = 0u;
#pragma unroll
        for (unsigned j = 0; j < 16; ++j) { const unsigned c = xb_ld(&bar[XB_XCNT(j)]); sum += c; cnt += (c > 0u) ? 1u : 0u; mine = (j == x) ? c : mine; }
        if (sum == G) break;
        __builtin_amdgcn_s_sleep(1);
        if ((++sp & 255u) == 0u) { if (xb_ld(&bar[XB_TMO])) break; if (sp > XB_SPIN_CAP) { atomicAdd(&bar[XB_TMO], 1u); break; } }
    }
    nloc = mine > 0u ? mine : 1u; nx = cnt > 0u ? cnt : 1u;
}
__device__ __forceinline__ void xcd_barrier(const XcdBarrier& b) {
    asm volatile("s_waitcnt vmcnt(0)" ::: "memory");
    __syncthreads();
    if (threadIdx.x == 0) {
        unsigned* bar = b.bar;
        __builtin_amdgcn_s_waitcnt(0);
        unsigned nloc = b.st[0], nx = b.st[1];
        if (nloc == 0u) { xcd_barrier_complete(bar, b.x, nloc, nx); b.st[0] = nloc; b.st[1] = nx; }
        const unsigned old = xb_add(&bar[XB_XSUB(b.x)], 1u);
        const unsigned gen = old / nloc;
        if (old + 1u == (gen + 1u) * nloc) {
            __builtin_amdgcn_fence(__ATOMIC_RELEASE, "agent");
            asm volatile("s_waitcnt vmcnt(0)" ::: "memory");
            const unsigned og = xb_add(&bar[XB_TOP], 1u);
            const unsigned tg = og / nx;
            if (og + 1u == (tg + 1u) * nx) xb_add(&bar[XB_TOPGEN], 1u);
            else XB_SPIN(xb_ld(&bar[XB_TOPGEN]) == tg, bar);
            __builtin_amdgcn_fence(__ATOMIC_ACQUIRE, "agent");
            xb_add(&bar[XB_XGEN(b.x)], 1u);
            asm volatile("s_waitcnt vmcnt(0)" ::: "memory");
        } else {
            XB_SPIN(xb_ld(&bar[XB_XGEN(b.x)]) == gen, bar);
            __builtin_amdgcn_fence(__ATOMIC_ACQUIRE, "agent");
            asm volatile("s_waitcnt vmcnt(0)" ::: "memory");
        }
    }
    __syncthreads();
}

namespace pg8 {
#define PG8_LAS __attribute__((address_space(3)))
typedef unsigned short bf16_t;
typedef short bf16x8 __attribute__((ext_vector_type(8)));
typedef float f32x4 __attribute__((ext_vector_type(4)));
typedef unsigned u32x4 __attribute__((ext_vector_type(4)));
constexpr int BM = 256, BK = 64, HALF = 128, HTB = HALF * BK * 2  , STAGE_BYTES = 8 * HTB, NXCD = 8, WGM = 8;

__host__ __device__ __forceinline__ int lds_byte(int r, int c) { const int st = (r >> 4) * 2 + (c >> 5), rr = r & 15, cc = c & 31, ob = rr * 64 + cc * 2; return st * 1024 + (ob ^ (((ob >> 9) & 1) << 5)); }
__host__ __device__ __forceinline__ void stage_rc(int b, int& R, int& C) { const int st = b / 1024, sb = b % 1024, swz = sb ^ (((sb >> 9) & 1) << 5); R = (st >> 1) * 16 + swz / 64; C = (st & 1) * 32 + (swz % 64) / 2; }
__host__ __device__ __forceinline__ int perm32(int rho) { const int n = rho >> 4, i = rho & 15; return 8 * (i >> 2) + 4 * n + (i & 3); }

struct Unit { int pm, pn; };
struct Gemm { const bf16_t* A; const bf16_t* Bt; int M, N, K; const int* rowtab = nullptr; };

struct StaticOrder {
    int nM, nN, nwg, G, c;
    __host__ __device__ void init(int M, int N, int G_, int c_) { nM = M / BM; nN = N / BM; nwg = nM * nN; G = G_; c = c_; }
    __host__ __device__ bool next(int i, Unit& u) const {
        const long L = (long)i * G + c; if (L >= nwg) return false;
        int wgid = (int)L; { const int q = nwg / NXCD, r = nwg % NXCD, xcd = wgid % NXCD, off = wgid / NXCD; wgid = (xcd < r ? xcd * (q + 1) : r * (q + 1) + (xcd - r) * q) + off; }
        const int nig = WGM * nN, gid = wgid / nig, fm = gid * WGM, gsz = (nM - fm) < WGM ? (nM - fm) : WGM;
        u.pm = fm + ((wgid % nig) % gsz); u.pn = (wgid % nig) / gsz; return true;
    }
    __device__ __forceinline__ void a_ready(const Unit&) const {}
    __device__ __forceinline__ void done(const Unit&) const {}
};

__device__ __forceinline__ unsigned cvt_pk_bf16(float lo, float hi) { unsigned r; asm volatile("v_cvt_pk_bf16_f32 %0, %1, %2" : "=v"(r) : "v"(lo), "v"(hi)); return r; }
typedef float f32x2 __attribute__((ext_vector_type(2)));
__device__ __forceinline__ f32x2 gelu_pk(f32x2 v) {
    const f32x2 av = __builtin_elementwise_abs(v), d = av * 0.2316418882f + 1.0f;
    f32x2 t; t.x = __builtin_amdgcn_rcpf(d.x); t.y = __builtin_amdgcn_rcpf(d.y);
    f32x2 q = t * 0.5307027145f + (-0.7265760135f); q = q * t + 0.7107068705f; q = q * t + (-0.142248368f); q = q * t + 0.127414796f; q = q * t;
    const f32x2 s = (v * v) * (-0.72134752044f);
    f32x2 e; e.x = __builtin_amdgcn_exp2f(s.x); e.y = __builtin_amdgcn_exp2f(s.y);
    const f32x2 m = v * (q * e), r = v - m;
    f32x2 o; o.x = v.x < 0.f ? m.x : r.x; o.y = v.y < 0.f ? m.y : r.y; return o;
}

template <int ACT  > struct EpiBf16 {
    static constexpr bool PERM = true, AFTER_DRAIN = false; static_assert(ACT == 0 || ACT == 1, "EpiBf16: ACT is 0 (none) or 1 (gelu_pk)");
    bf16_t* O; int ldc; const float* bias; int split_cols; size_t split_stride; float scale0;
    __device__ __forceinline__ void operator()(const f32x4 (&acc)[2][2][4][2], const Unit& u, int wr, int wc, int fr, int fq) const {
        const int row0 = u.pm * BM + wr * 64 + fr; int colt = u.pn * BM; bf16_t* base = O;
        float sc = 1.f; if (split_cols) { const int t = colt / split_cols; base += (size_t)t * split_stride; colt -= t * split_cols; if (t == 0) sc = scale0; }
        const int col0 = colt + wc * 32 + 8 * fq, bcol0 = u.pn * BM + wc * 32 + 8 * fq;
        f32x4 bv[2][2];
#pragma unroll
        for (int bj = 0; bj < 2; ++bj)
#pragma unroll
            for (int n = 0; n < 2; ++n) bv[bj][n] = bias ? *(const f32x4*)(bias + bcol0 + bj * HALF + 4 * n) : (f32x4){0.f, 0.f, 0.f, 0.f};
#pragma unroll
        for (int ai = 0; ai < 2; ++ai)
#pragma unroll
            for (int m = 0; m < 4; ++m) { bf16_t* rowp = base + (size_t)(row0 + ai * HALF + m * 16) * ldc + col0;
#pragma unroll
                for (int bj = 0; bj < 2; ++bj) { f32x4 v0 = acc[ai][bj][m][0] + bv[bj][0], v1 = acc[ai][bj][m][1] + bv[bj][1];
                    if (ACT == 1) { f32x2 a = gelu_pk((f32x2){v0[0], v0[1]}), b = gelu_pk((f32x2){v0[2], v0[3]}), c = gelu_pk((f32x2){v1[0], v1[1]}), d = gelu_pk((f32x2){v1[2], v1[3]});
                        v0 = (f32x4){a.x, a.y, b.x, b.y}; v1 = (f32x4){c.x, c.y, d.x, d.y}; }
                    v0 = v0 * sc; v1 = v1 * sc; u32x4 w; w.x = cvt_pk_bf16(v0[0], v0[1]); w.y = cvt_pk_bf16(v0[2], v0[3]); w.z = cvt_pk_bf16(v1[0], v1[1]); w.w = cvt_pk_bf16(v1[2], v1[3]);
                    *(u32x4*)(rowp + bj * HALF) = w; } }
    }
};

struct EpiF32 {
    static constexpr bool PERM = false, AFTER_DRAIN = false;
    float* C; int ldc;
    __device__ __forceinline__ void operator()(const f32x4 (&acc)[2][2][4][2], const Unit& u, int wr, int wc, int fr, int fq) const {
        const int row0 = u.pm * BM + wr * 64 + fr, col0 = u.pn * BM + wc * 32 + 4 * fq;
#pragma unroll
        for (int ai = 0; ai < 2; ++ai)
#pragma unroll
            for (int m = 0; m < 4; ++m) { float* rowp = C + (size_t)(row0 + ai * HALF + m * 16) * ldc + col0;
#pragma unroll
                for (int bj = 0; bj < 2; ++bj)
#pragma unroll
                    for (int n = 0; n < 2; ++n) *(f32x4*)(rowp + bj * HALF + n * 16) = acc[ai][bj][m][n]; }
    }
};
__device__ __forceinline__ float fast_sigmoid(float x) { return __builtin_amdgcn_rcpf(1.0f + __builtin_amdgcn_exp2f(-1.4426950408889634f * x)); }
struct EpiSwiGLU {
    static constexpr bool PERM = true, AFTER_DRAIN = false;
    bf16_t* O; int ldo;
    __device__ __forceinline__ void operator()(const f32x4 (&acc)[2][2][4][2], const Unit& u, int wr, int wc, int fr, int fq) const {
        const int row0 = u.pm * BM + wr * 64 + fr, col0 = (u.pn & 1) * HALF + wc * 32 + 8 * fq;
#pragma unroll
        for (int ai = 0; ai < 2; ++ai)
#pragma unroll
            for (int m = 0; m < 4; ++m) {
                bf16_t* rowp = O + (size_t)(row0 + ai * HALF + m * 16) * ldo + col0;
                const f32x4 g0 = acc[ai][0][m][0], g1 = acc[ai][0][m][1], u0 = acc[ai][1][m][0], u1 = acc[ai][1][m][1];
                float r[8];
#pragma unroll
                for (int i = 0; i < 4; ++i) { r[i] = g0[i] * fast_sigmoid(g0[i]) * u0[i]; r[4 + i] = g1[i] * fast_sigmoid(g1[i]) * u1[i]; }
                u32x4 w; w.x = cvt_pk_bf16(r[0], r[1]); w.y = cvt_pk_bf16(r[2], r[3]); w.z = cvt_pk_bf16(r[4], r[5]); w.w = cvt_pk_bf16(r[6], r[7]);
                *(u32x4*)rowp = w;
            }
    }
};
struct EpiScatter {
    static constexpr bool PERM = true, AFTER_DRAIN = false;
    const int* slotp; const float* wt; bf16_t* Y; int ldy;
    __device__ __forceinline__ void operator()(const f32x4 (&acc)[2][2][4][2], const Unit& u, int wr, int wc, int fr, int fq) const {
        int t2 = threadIdx.x; asm volatile("" : "+v"(t2));
        const int fr2 = t2 & 15, fq2 = (t2 >> 4) & 3, wc2 = (t2 >> 6) & 3, wr2 = (t2 >> 8) & 1;
        const int col0 = (u.pn & 3) * BM + wc2 * 32 + 8 * fq2;
        const int rbase = u.pm * BM + wr2 * 64 + fr2;
#pragma unroll
        for (int ai = 0; ai < 2; ++ai)
#pragma unroll
            for (int m = 0; m < 4; ++m) {
                const int aid = slotp[rbase + ai * HALF + m * 16];
                if (aid >= 0) {
                    const float w = wt[aid];
                    bf16_t* rowp = Y + (size_t)aid * ldy + col0;
#pragma unroll
                    for (int bj = 0; bj < 2; ++bj) {
                        const f32x4 v0 = acc[ai][bj][m][0] * w, v1 = acc[ai][bj][m][1] * w;
                        u32x4 o; o.x = cvt_pk_bf16(v0[0], v0[1]); o.y = cvt_pk_bf16(v0[2], v0[3]); o.z = cvt_pk_bf16(v1[0], v1[1]); o.w = cvt_pk_bf16(v1[2], v1[3]);
                        *(u32x4*)(rowp + bj * HALF) = o;
                    }
                }
            }
    }
};
struct ExpertOrder {
    const int* uexp; int NU, npn, G, c;
    __device__ __forceinline__ bool next(int i, Unit& u) const {
        const int L = i * G + c; if (L >= NU * npn) return false;
        const int uu = L / npn, pl = L % npn;
        u.pm = uu; u.pn = __builtin_amdgcn_readfirstlane(uexp[uu]) * npn + pl; return true;
    }
    __device__ __forceinline__ void a_ready(const Unit&) const {}
    __device__ __forceinline__ void done(const Unit&) const {}
};
struct S5Order {
    int NUNITS, npn, G, c;
    __device__ __forceinline__ bool next(int i, Unit& u) const {
        const int L = i * G + c; if (L >= NUNITS) return false;
        u.pm = L / npn; u.pn = (u.pm >> 2) * npn + L % npn; return true;
    }
    __device__ __forceinline__ void a_ready(const Unit&) const {}
    __device__ __forceinline__ void done(const Unit&) const {}
};
struct EpiS5E {
    static constexpr bool PERM = false, AFTER_DRAIN = false;
    float* E;
    __device__ __forceinline__ void operator()(const f32x4 (&acc)[2][2][4][2], const Unit& u, int wr, int wc, int fr, int fq) const {
        const int row0 = u.pm * BM + wr * 64 + fr, col0 = wc * 32 + 4 * fq;
#pragma unroll
        for (int ai = 0; ai < 2; ++ai)
#pragma unroll
            for (int m = 0; m < 4; ++m) { float* rowp = E + (size_t)(row0 + ai * HALF + m * 16) * 128 + col0;
#pragma unroll
                for (int n = 0; n < 2; ++n) *(f32x4*)(rowp + n * 16) = acc[ai][0][m][n]; }
    }
};
struct EpiS5Out {
    static constexpr bool PERM = true, AFTER_DRAIN = false;
    bf16_t* Y;
    __device__ __forceinline__ void operator()(const f32x4 (&acc)[2][2][4][2], const Unit& u, int wr, int wc, int fr, int fq) const {
        const int g = u.pm >> 2;
#pragma unroll
        for (int ai = 0; ai < 2; ++ai)
#pragma unroll
            for (int m = 0; m < 4; ++m) {
                const int r = (u.pm & 3) * BM + ai * HALF + wr * 64 + m * 16 + fr, b = r >> 8, chunk = r & 255;
#pragma unroll
                for (int bj = 0; bj < 2; ++bj) {
                    const int colg = (u.pn & 1) * BM + bj * HALF + wc * 32 + 8 * fq, t = colg >> 4, c0 = colg & 15;
                    const f32x4 v0 = acc[ai][bj][m][0], v1 = acc[ai][bj][m][1];
                    float x[8] = {v0[0], v0[1], v0[2], v0[3], v1[0], v1[1], v1[2], v1[3]};
#pragma unroll
                    for (int i = 0; i < 8; ++i) { const float z = x[i]; x[i] = z * fast_sigmoid(1.5957691216057308f * (z + 0.044715f * z * z * z)); }
                    u32x4 w; w.x = cvt_pk_bf16(x[0], x[1]); w.y = cvt_pk_bf16(x[2], x[3]); w.z = cvt_pk_bf16(x[4], x[5]); w.w = cvt_pk_bf16(x[6], x[7]);
                    *(u32x4*)(Y + ((size_t)(b * 8192 + chunk * 32 + t)) * 512 + g * 16 + c0) = w;
                }
            }
    }
};
struct EpiLora {
    static constexpr bool PERM = true, AFTER_DRAIN = false;
    const float* w0; const float* a0; const float* k_a; float* W; bf16_t* Kp; const bf16_t* A; bf16_t* B; bf16_t* Gt;
    __device__ __forceinline__ void operator()(const f32x4 (&acc)[2][2][4][2], const Unit& u, int wr, int wc, int fr, int fq) const {
        const int seg = u.pn >> 1;
#pragma unroll
        for (int bj = 0; bj < 2; ++bj) {
            const int nn = (u.pn & 1) * BM + bj * HALF + wc * 32 + 8 * fq;
            float p0[8], p1[8];
            if (seg == 0) { const f32x4 a = *(const f32x4*)(w0 + nn), b = *(const f32x4*)(w0 + nn + 4); p0[0] = a[0]; p0[1] = a[1]; p0[2] = a[2]; p0[3] = a[3]; p0[4] = b[0]; p0[5] = b[1]; p0[6] = b[2]; p0[7] = b[3]; }
            else if (seg == 1) { const f32x4 a = *(const f32x4*)(a0 + nn), b = *(const f32x4*)(a0 + nn + 4), cc = *(const f32x4*)(k_a + nn), d = *(const f32x4*)(k_a + nn + 4);
                p0[0] = a[0]; p0[1] = a[1]; p0[2] = a[2]; p0[3] = a[3]; p0[4] = b[0]; p0[5] = b[1]; p0[6] = b[2]; p0[7] = b[3];
                p1[0] = cc[0]; p1[1] = cc[1]; p1[2] = cc[2]; p1[3] = cc[3]; p1[4] = d[0]; p1[5] = d[1]; p1[6] = d[2]; p1[7] = d[3]; }
#pragma unroll
            for (int ai = 0; ai < 2; ++ai)
#pragma unroll
                for (int m = 0; m < 4; ++m) {
                    const size_t off = (size_t)(u.pm * BM + ai * HALF + wr * 64 + m * 16 + fr) * 512 + nn;
                    const f32x4 v0 = acc[ai][bj][m][0], v1 = acc[ai][bj][m][1];
                    const float x[8] = {v0[0], v0[1], v0[2], v0[3], v1[0], v1[1], v1[2], v1[3]};
                    if (seg == 0) {
                        float o[8];
#pragma unroll
                        for (int i = 0; i < 8; ++i) { const float wa = p0[i] + x[i];
                            const float sp = __logf(1.0f + __expf(-wa));
                            o[i] = __expf(-__expf(-sp - 0.5f)); }
                        *(f32x4*)(W + off) = (f32x4){o[0], o[1], o[2], o[3]}; *(f32x4*)(W + off + 4) = (f32x4){o[4], o[5], o[6], o[7]};
                    } else if (seg == 1) {
                        const u32x4 kv = *(const u32x4*)(Kp + off), av = *(const u32x4*)(A + off);
                        const float k[8] = {__builtin_bit_cast(float, kv.x << 16), __builtin_bit_cast(float, kv.x & 0xffff0000u), __builtin_bit_cast(float, kv.y << 16), __builtin_bit_cast(float, kv.y & 0xffff0000u),
                                            __builtin_bit_cast(float, kv.z << 16), __builtin_bit_cast(float, kv.z & 0xffff0000u), __builtin_bit_cast(float, kv.w << 16), __builtin_bit_cast(float, kv.w & 0xffff0000u)};
                        const float a[8] = {__builtin_bit_cast(float, av.x << 16), __builtin_bit_cast(float, av.x & 0xffff0000u), __builtin_bit_cast(float, av.y << 16), __builtin_bit_cast(float, av.y & 0xffff0000u),
                                            __builtin_bit_cast(float, av.z << 16), __builtin_bit_cast(float, av.z & 0xffff0000u), __builtin_bit_cast(float, av.w << 16), __builtin_bit_cast(float, av.w & 0xffff0000u)};
                        float kf[8], bo[8];
#pragma unroll
                        for (int i = 0; i < 8; ++i) { const float ic = fast_sigmoid(p0[i] + x[i]); kf[i] = k[i] * (1.0f + (ic - 1.0f) * p1[i]); bo[i] = -a[i] * ic; }
                        u32x4 w; w.x = cvt_pk_bf16(kf[0], kf[1]); w.y = cvt_pk_bf16(kf[2], kf[3]); w.z = cvt_pk_bf16(kf[4], kf[5]); w.w = cvt_pk_bf16(kf[6], kf[7]);
                        *(u32x4*)(Kp + off) = w;
                        w.x = cvt_pk_bf16(bo[0], bo[1]); w.y = cvt_pk_bf16(bo[2], bo[3]); w.z = cvt_pk_bf16(bo[4], bo[5]); w.w = cvt_pk_bf16(bo[6], bo[7]);
                        *(u32x4*)(B + off) = w;
                    } else {
                        u32x4 w; w.x = cvt_pk_bf16(x[0], x[1]); w.y = cvt_pk_bf16(x[2], x[3]); w.z = cvt_pk_bf16(x[4], x[5]); w.w = cvt_pk_bf16(x[6], x[7]);
                        *(u32x4*)(Gt + off) = w;
                    }
                }
        }
    }
};
struct EpiGLU {
    static constexpr bool PERM = true, AFTER_DRAIN = false;
    const bf16_t* Y; int ldy; const float* bias; bf16_t* O; int ldo; int ocol0;
    __device__ __forceinline__ void operator()(const f32x4 (&acc)[2][2][4][2], const Unit& u, int wr, int wc, int fr, int fq) const {
        const int row0 = u.pm * BM + wr * 64 + fr, col0 = u.pn * BM + wc * 32 + 8 * fq;
#pragma unroll
        for (int bj = 0; bj < 2; ++bj) {
            const f32x4 b0 = *(const f32x4*)(bias + col0 + bj * HALF), b1 = *(const f32x4*)(bias + col0 + bj * HALF + 4);
#pragma unroll
            for (int ai = 0; ai < 2; ++ai)
#pragma unroll
                for (int m = 0; m < 4; ++m) {
                    const size_t row = (size_t)(row0 + ai * HALF + m * 16);
                    const u32x4 yv = *(const u32x4*)(Y + row * ldy + col0 + bj * HALF);
                    const f32x4 z0 = acc[ai][bj][m][0] + b0, z1 = acc[ai][bj][m][1] + b1;
                    float y[8] = {__builtin_bit_cast(float, yv.x << 16), __builtin_bit_cast(float, yv.x & 0xffff0000u), __builtin_bit_cast(float, yv.y << 16), __builtin_bit_cast(float, yv.y & 0xffff0000u),
                                  __builtin_bit_cast(float, yv.z << 16), __builtin_bit_cast(float, yv.z & 0xffff0000u), __builtin_bit_cast(float, yv.w << 16), __builtin_bit_cast(float, yv.w & 0xffff0000u)};
                    float r[8];
#pragma unroll
                    for (int i = 0; i < 4; ++i) { r[i] = y[i] * fast_sigmoid(z0[i]); r[4 + i] = y[4 + i] * fast_sigmoid(z1[i]); }
                    u32x4 w; w.x = cvt_pk_bf16(r[0], r[1]); w.y = cvt_pk_bf16(r[2], r[3]); w.z = cvt_pk_bf16(r[4], r[5]); w.w = cvt_pk_bf16(r[6], r[7]);
                    *(u32x4*)(O + row * ldo + ocol0 + col0 + bj * HALF) = w;
                }
        }
    }
};
template <class Epi, class Sched, bool ALIGN_EPI = false, bool SP2 = false, bool GATHER = false>
__device__ __forceinline__ void gemm_phase(PG8_LAS unsigned char* lds, const Gemm g, const Sched& S, const Epi& E) {
    int tid_ = threadIdx.x; asm volatile("" : "+v"(tid_));
    const int tid = tid_, wid = __builtin_amdgcn_readfirstlane(tid >> 6), lane = tid & 63, wr = wid >> 2, wc = wid & 3, fr = lane & 15, fq = lane >> 4;
    const int K = g.K, nt = K / BK;
    unsigned voffA[2], voffB[2];
#pragma unroll
    for (int i = 0; i < 2; ++i) { int R, C; stage_rc(tid * 16 + i * 8192, R, C); const int Rb = Epi::PERM ? ((R & ~31) + perm32(R & 31)) : R;
        voffA[i] = (unsigned)(R * K + C) * 2u; voffB[i] = (unsigned)(Rb * K + C) * 2u; }
    const size_t kstep = (size_t)(BK * 2);
    const size_t hstep = (size_t)HALF * K * 2;
    const size_t tstep = 2 * hstep;
    const unsigned ldsw = (unsigned)wid * 1024u;
    const int aoff = lds_byte(wr * 64 + fr, fq * 8), boff = lds_byte(wc * 32 + fr, fq * 8);
#define PG8_SA(b, h) (((b) * 2 + (h)) * HTB)
#define PG8_SB(b, h) ((4 + (b) * 2 + (h)) * HTB)
#define PG8_STAGE(bufoff, gbase, voff) do { _Pragma("unroll") for (int _i = 0; _i < 2; ++_i) \
        __builtin_amdgcn_global_load_lds((const unsigned*)((const char*)(gbase) + (voff)[_i]), (PG8_LAS unsigned*)(lds + (bufoff) + ldsw + _i * 8192), 16, 0, 0); } while (0)
#define PG8_STAGE_A(bufoff, kptr, h, NEXTSEL) do { if constexpr (GATHER) { const unsigned _p = (NEXTSEL) ? gnxt[h] : gcur[h]; const unsigned _v[2] = { (_p & 0xffffu) * (unsigned)(2 * K) + gC2, (_p >> 16) * (unsigned)(2 * K) + gC2 }; PG8_STAGE(bufoff, kptr, _v); } \
        else { PG8_STAGE(bufoff, (kptr) + (h) * hstep, voffA); } } while (0)
#define PG8_LDA(dst, b, h) do { _Pragma("unroll") for (int m = 0; m < 4; ++m) _Pragma("unroll") for (int k = 0; k < 2; ++k) dst[m][k] = *(const PG8_LAS bf16x8*)(lds + PG8_SA(b, h) + aoff + m * 2048 + k * 1024); } while (0)
#define PG8_LDB(dst, b, h) do { _Pragma("unroll") for (int n = 0; n < 2; ++n) _Pragma("unroll") for (int k = 0; k < 2; ++k) dst[n][k] = *(const PG8_LAS bf16x8*)(lds + PG8_SB(b, h) + boff + n * 2048 + k * 1024); } while (0)
#define PG8_MMA(ai, bj, At, Bt) do { __builtin_amdgcn_s_setprio(1); _Pragma("unroll") for (int m = 0; m < 4; ++m) _Pragma("unroll") for (int n = 0; n < 2; ++n) _Pragma("unroll") for (int k = 0; k < 2; ++k) \
        acc[ai][bj][m][n] = __builtin_amdgcn_mfma_f32_16x16x32_bf16(Bt[n][k], At[m][k], acc[ai][bj][m][n], 0, 0, 0); __builtin_amdgcn_s_setprio(0); } while (0)
#define PG8_WAIT_V(n) asm volatile("s_waitcnt vmcnt(" #n ")" ::: "memory")
#define PG8_WAIT_L(n) asm volatile("s_waitcnt lgkmcnt(" #n ")" ::: "memory")
#define PG8_BAR __builtin_amdgcn_s_barrier()
#define PG8_SCHED __builtin_amdgcn_sched_barrier(0)
    unsigned gcur[2], gnxt[2], gC2 = 0;
    if constexpr (GATHER) { int R, C; stage_rc(tid * 16, R, C); gC2 = (unsigned)C * 2u; }
    auto load_gather = [&](int pm, unsigned (&dst)[2]) {
        int R, C; stage_rc(tid * 16, R, C);
#pragma unroll
        for (int h = 0; h < 2; ++h) { int a0 = g.rowtab[pm * BM + h * HALF + R], a1 = g.rowtab[pm * BM + h * HALF + R + 64]; a0 = a0 < 0 ? 0 : a0; a1 = a1 < 0 ? 0 : a1; dst[h] = (unsigned)(a0 >> 3) | ((unsigned)(a1 >> 3) << 16); }
    };
    Unit cur, nxt; int ui = 0;
    if (!S.next(0, cur)) return;
    f32x4 acc[2][2][4][2];
#pragma unroll
    for (int a = 0; a < 2; ++a)
#pragma unroll
        for (int b = 0; b < 2; ++b)
#pragma unroll
            for (int m = 0; m < 4; ++m)
#pragma unroll
                for (int n = 0; n < 2; ++n) acc[a][b][m][n] = (f32x4){0.f, 0.f, 0.f, 0.f};
    bf16x8 At[4][2], B0[2][2], B1[2][2];
    const char* cA = (const char*)g.A + (GATHER ? (size_t)0 : (size_t)cur.pm * tstep); const char* cB = (const char*)g.Bt + (size_t)cur.pn * tstep;
    if constexpr (GATHER) { load_gather(cur.pm, gcur); }
    S.a_ready(cur);
    if constexpr (SP2) {
        PG8_STAGE(PG8_SB(0, 0), cB, voffB); PG8_STAGE(PG8_SB(0, 1), cB + hstep, voffB); PG8_STAGE_A(PG8_SA(0, 0), cA, 0, false); PG8_STAGE_A(PG8_SA(0, 1), cA, 1, false);
        if (wr == 1) PG8_BAR;
        PG8_WAIT_V(2); PG8_BAR;
        PG8_STAGE(PG8_SB(1, 0), cB + kstep, voffB); PG8_STAGE_A(PG8_SA(1, 0), cA + kstep, 0, false); PG8_STAGE(PG8_SB(1, 1), cB + hstep + kstep, voffB);
        PG8_WAIT_V(6); PG8_BAR;
    } else {
        PG8_STAGE(PG8_SB(0, 0), cB, voffB); PG8_STAGE_A(PG8_SA(0, 0), cA, 0, false); PG8_STAGE(PG8_SB(0, 1), cB + hstep, voffB); PG8_STAGE_A(PG8_SA(0, 1), cA, 1, false);
        if (wr == 1) PG8_BAR;
        PG8_WAIT_V(4); PG8_BAR;
        PG8_STAGE(PG8_SB(1, 0), cB + kstep, voffB); PG8_STAGE_A(PG8_SA(1, 0), cA + kstep, 0, false); PG8_STAGE(PG8_SB(1, 1), cB + hstep + kstep, voffB);
        PG8_WAIT_V(6); PG8_BAR;
    }
    for (;;) {
        const bool has_next = S.next(ui + 1, nxt);
        const char* nA = (has_next && !GATHER) ? (const char*)g.A + (size_t)nxt.pm * tstep : cA; const char* nB = has_next ? (const char*)g.Bt + (size_t)nxt.pn * tstep : cB;
        if constexpr (GATHER) { if (has_next) load_gather(nxt.pm, gnxt); else {
#pragma unroll
            for (int h = 0; h < 2; ++h) { gnxt[h] = gcur[h]; } } }
        for (int t = 0; t < nt; t += 2) {
            const bool last = (t == nt - 2);
            const char* a1 = cA + (size_t)(t + 1) * kstep;
            const char* a2 = last ? nA : cA + (size_t)(t + 2) * kstep; const char* b2 = last ? nB : cB + (size_t)(t + 2) * kstep;
            const char* a3 = a2 + kstep; const char* b3 = b2 + kstep;
            if (last && has_next) S.a_ready(nxt);
            if constexpr (SP2) {
            PG8_LDB(B0, 0, 0); PG8_LDB(B1, 0, 1); PG8_SCHED; PG8_LDA(At, 0, 0); PG8_STAGE_A(PG8_SA(1, 1), a1, 1, false);
            PG8_WAIT_V(8); PG8_WAIT_L(0); PG8_BAR; PG8_MMA(0, 0, At, B0); PG8_MMA(0, 1, At, B1); PG8_BAR; PG8_SCHED;
            PG8_LDA(At, 0, 1); PG8_STAGE(PG8_SB(0, 0), b2, voffB); PG8_STAGE(PG8_SB(0, 1), b2 + hstep, voffB); PG8_STAGE_A(PG8_SA(0, 0), a2, 0, last);
            PG8_WAIT_V(8); PG8_WAIT_L(0); PG8_BAR; PG8_MMA(1, 0, At, B0); PG8_MMA(1, 1, At, B1); PG8_BAR; PG8_SCHED;
            PG8_LDB(B0, 1, 0); PG8_LDB(B1, 1, 1); PG8_SCHED; PG8_LDA(At, 1, 0); PG8_STAGE_A(PG8_SA(0, 1), a2, 1, last);
            PG8_WAIT_V(8); PG8_WAIT_L(0); PG8_BAR; PG8_MMA(0, 0, At, B0); PG8_MMA(0, 1, At, B1); PG8_BAR; PG8_SCHED;
            PG8_LDA(At, 1, 1); PG8_STAGE(PG8_SB(1, 0), b3, voffB); PG8_STAGE(PG8_SB(1, 1), b3 + hstep, voffB); PG8_STAGE_A(PG8_SA(1, 0), a3, 0, last);
            PG8_WAIT_V(8); PG8_WAIT_L(0); PG8_BAR; PG8_MMA(1, 0, At, B0); PG8_MMA(1, 1, At, B1); PG8_BAR; PG8_SCHED;
            } else {
            PG8_LDB(B0, 0, 0); PG8_SCHED; PG8_LDA(At, 0, 0); PG8_STAGE_A(PG8_SA(1, 1), a1, 1, false);
            PG8_WAIT_L(8); PG8_BAR; PG8_WAIT_L(0); PG8_MMA(0, 0, At, B0); PG8_BAR; PG8_SCHED;
            PG8_LDB(B1, 0, 1); PG8_STAGE(PG8_SB(0, 0), b2, voffB);
            PG8_BAR; PG8_WAIT_L(0); PG8_MMA(0, 1, At, B1); PG8_BAR;
            PG8_LDA(At, 0, 1); PG8_STAGE_A(PG8_SA(0, 0), a2, 0, last);
            PG8_BAR; PG8_WAIT_L(0); PG8_MMA(1, 0, At, B0); PG8_BAR; PG8_SCHED;
            PG8_STAGE(PG8_SB(0, 1), b2 + hstep, voffB);
            PG8_WAIT_V(6); PG8_BAR; PG8_MMA(1, 1, At, B1); PG8_BAR;
            PG8_LDB(B0, 1, 0); PG8_SCHED; PG8_LDA(At, 1, 0); PG8_STAGE_A(PG8_SA(0, 1), a2, 1, last);
            PG8_WAIT_L(8); PG8_BAR; PG8_WAIT_L(0); PG8_MMA(0, 0, At, B0); PG8_BAR; PG8_SCHED;
            PG8_LDB(B1, 1, 1); PG8_STAGE(PG8_SB(1, 0), b3, voffB);
            PG8_BAR; PG8_WAIT_L(0); PG8_MMA(0, 1, At, B1); PG8_BAR;
            PG8_LDA(At, 1, 1); PG8_STAGE_A(PG8_SA(1, 0), a3, 0, last);
            PG8_BAR; PG8_WAIT_L(0); PG8_MMA(1, 0, At, B0); PG8_BAR; PG8_SCHED;
            PG8_STAGE(PG8_SB(1, 1), b3 + hstep, voffB);
            PG8_WAIT_V(6); PG8_BAR; PG8_MMA(1, 1, At, B1); PG8_BAR;
            }
        }
        if constexpr (ALIGN_EPI) { if (wr == 0) PG8_BAR; }
        if constexpr (!Epi::AFTER_DRAIN) { E(acc, cur, wr, wc, fr, fq); S.done(cur); }
        if (!has_next) break;
#pragma unroll
        for (int a = 0; a < 2; ++a)
#pragma unroll
            for (int b = 0; b < 2; ++b)
#pragma unroll
                for (int m = 0; m < 4; ++m)
#pragma unroll
                    for (int n = 0; n < 2; ++n) acc[a][b][m][n] = (f32x4){0.f, 0.f, 0.f, 0.f};
        cur = nxt; cA = nA; cB = nB; ++ui;
        if constexpr (GATHER) {
#pragma unroll
            for (int h = 0; h < 2; ++h) { gcur[h] = gnxt[h]; } }
        if constexpr (ALIGN_EPI) { if (wr == 1) PG8_BAR; }
    }
    PG8_WAIT_V(0);
    if constexpr (!ALIGN_EPI) { if (wr == 0) PG8_BAR; }
    PG8_BAR;
    if constexpr (Epi::AFTER_DRAIN) { E.fused(acc, cur, wr, wc, fr, fq, lds, wid, lane); S.done(cur); }
#undef PG8_SA
#undef PG8_SB
#undef PG8_STAGE
#undef PG8_STAGE_A
#undef PG8_LDA
#undef PG8_LDB
#undef PG8_MMA
#undef PG8_WAIT_V
#undef PG8_WAIT_L
#undef PG8_BAR
#undef PG8_SCHED
}
}

typedef unsigned short bf16_t;
__device__ __forceinline__ unsigned f2bf(float f) { unsigned u = __builtin_bit_cast(unsigned, f); return (u + 0x7fffu + ((u >> 16) & 1u)) >> 16; }
__device__ __forceinline__ float bf2f(unsigned h) { return __builtin_bit_cast(float, h << 16); }
__device__ __forceinline__ float wave_sum(float v) {
#pragma unroll
    for (int o = 1; o < 64; o <<= 1) v += __shfl_xor(v, o);
    return v;
}
__device__ __forceinline__ float sigmoidf_(float x) { return 1.0f / (1.0f + expf(-x)); }
__device__ __forceinline__ float siluf_(float x) { return x / (1.0f + expf(-x)); }
__device__ __forceinline__ float softplusf_(float x) { return fmaxf(x, 0.0f) + log1pf(expf(-fabsf(x))); }
__device__ __forceinline__ float geluf_(float x) { const float u = 0.7978845608028654f * (x + 0.044715f * x * x * x); return 0.5f * x * (1.0f + tanhf(u)); }

struct Args { const float* in[39]; float* out; unsigned char* ws; int lo, hi; };

struct Ctx {
    const float* const* in; float* out; unsigned char* ws;
    LAS unsigned char* lds; float* sm;
    int tid, lane, wid, bid, G;
};

__device__ __forceinline__ unsigned pk2(float lo, float hi) { return f2bf(lo) | (f2bf(hi) << 16); }
__device__ __forceinline__ float ldbf(const bf16_t* p) { return bf2f((unsigned)*p); }
__device__ __forceinline__ float4 ldbf4(const bf16_t* p) { const uint2 v = *(const uint2*)p; return make_float4(bf2f(v.x & 0xffffu), bf2f(v.x >> 16), bf2f(v.y & 0xffffu), bf2f(v.y >> 16)); }

template <int NB, class AF, class BF, class BF2, class EF>
__device__ __forceinline__ void gemm_tile(float* sm, int K, AF af, BF bf, BF2 bf2, EF ef) {
    float* As = sm;
    float* Bs = sm + 16 * 132;
    float* Bs2 = Bs + 16 * 68;
    const int tid = threadIdx.x, ty = tid >> 4, tx = tid & 15;
    const int am = tid >> 2, ak = (tid & 3) * 4;
    const int bt = tid & 255, bk = bt >> 4, bn = (bt & 15) * 4;
    float acc[4][4], acc2[4][4];
#pragma unroll
    for (int i = 0; i < 4; ++i)
#pragma unroll
        for (int j = 0; j < 4; ++j) { acc[i][j] = 0.f; acc2[i][j] = 0.f; }
    float4 av = af(am, ak);
    float4 bv = make_float4(0.f, 0.f, 0.f, 0.f);
    if (tid < 256) bv = bf(bk, bn); else if (NB == 2) bv = bf2(bk, bn);
    for (int k0 = 0; k0 < K; k0 += 16) {
        __syncthreads();
        As[(ak + 0) * 132 + am] = av.x; As[(ak + 1) * 132 + am] = av.y; As[(ak + 2) * 132 + am] = av.z; As[(ak + 3) * 132 + am] = av.w;
        if (tid < 256) *(float4*)&Bs[bk * 68 + bn] = bv; else if (NB == 2) *(float4*)&Bs2[bk * 68 + bn] = bv;
        __syncthreads();
        if (k0 + 16 < K) {
            av = af(am, k0 + 16 + ak);
            if (tid < 256) bv = bf(k0 + 16 + bk, bn); else if (NB == 2) bv = bf2(k0 + 16 + bk, bn);
        }
#pragma unroll
        for (int kk = 0; kk < 16; ++kk) {
            const float4 a = *(const float4*)&As[kk * 132 + ty * 4];
            const float4 b = *(const float4*)&Bs[kk * 68 + tx * 4];
            const float aa[4] = {a.x, a.y, a.z, a.w};
            const float bb[4] = {b.x, b.y, b.z, b.w};
#pragma unroll
            for (int i = 0; i < 4; ++i)
#pragma unroll
                for (int j = 0; j < 4; ++j) acc[i][j] = fmaf(aa[i], bb[j], acc[i][j]);
            if (NB == 2) {
                const float4 b2 = *(const float4*)&Bs2[kk * 68 + tx * 4];
                const float bb2[4] = {b2.x, b2.y, b2.z, b2.w};
#pragma unroll
                for (int i = 0; i < 4; ++i)
#pragma unroll
                    for (int j = 0; j < 4; ++j) acc2[i][j] = fmaf(aa[i], bb2[j], acc2[i][j]);
            }
        }
    }
#pragma unroll
    for (int i = 0; i < 4; ++i)
        ef(ty * 4 + i, tx * 4, make_float4(acc[i][0], acc[i][1], acc[i][2], acc[i][3]), make_float4(acc2[i][0], acc2[i][1], acc2[i][2], acc2[i][3]));
}

template <bool RES, class RM>
__device__ __forceinline__ void transpose_item(const float* W, int K, int N, bf16_t* WT, RM rowmap, float* scr, int item, int lane) {
    const int nblk = N / 32, kb = item / nblk, nb = item % nblk, k0 = 64 * kb, n0 = 32 * nb;
#pragma unroll 8
    for (int i = 0; i < 32; ++i) { const int kk = 2 * i + (lane >> 5); scr[kk * 33 + (lane & 31)] = W[(size_t)(k0 + kk) * N + n0 + (lane & 31)]; }
    asm volatile("s_waitcnt lgkmcnt(0)" ::: "memory");
    const int c = lane & 7;
    const int r0 = rowmap(n0);
#pragma unroll
    for (int j = 0; j < 4; ++j) {
        const int n = (lane >> 3) + 8 * j; const float* s = scr + (8 * c) * 33 + n;
        float v[8];
#pragma unroll
        for (int q = 0; q < 8; ++q) { v[q] = s[q * 33]; if (RES) v[q] = v[q] - bf2f(f2bf(v[q])); }
        uint4 o; o.x = pk2(v[0], v[1]); o.y = pk2(v[2], v[3]); o.z = pk2(v[4], v[5]); o.w = pk2(v[6], v[7]);
        *(uint4*)(WT + (size_t)(r0 + n) * K + k0 + 8 * c) = o;
    }
    asm volatile("s_waitcnt lgkmcnt(0)" ::: "memory");
}

__device__ __forceinline__ void phase0(const Ctx& c) {
    const int gt = c.bid * 512 + c.tid, NT = c.G * 512;
    const int gw = c.bid * 8 + c.wid, NW = c.G * 8;
    {
        const float* cc = c.in[1]; const float* w_ada = c.in[2];
        float* modsp = (float*)(c.ws + WS_MODSP);
        for (int task = gw; task < 96 * 16; task += NW) {
            const int cg = task % 96, ks = task / 96, j = cg * 64 + c.lane;
            float a0 = 0.f, a1 = 0.f, a2 = 0.f, a3 = 0.f;
#pragma unroll 4
            for (int k = ks * 64; k < ks * 64 + 64; ++k) {
                const float wv = w_ada[(size_t)k * NMODS + j];
                a0 = fmaf(siluf_(cc[k]), wv, a0); a1 = fmaf(siluf_(cc[D + k]), wv, a1); a2 = fmaf(siluf_(cc[2 * D + k]), wv, a2); a3 = fmaf(siluf_(cc[3 * D + k]), wv, a3);
            }
            modsp[(ks * 4 + 0) * NMODS + j] = a0; modsp[(ks * 4 + 1) * NMODS + j] = a1; modsp[(ks * 4 + 2) * NMODS + j] = a2; modsp[(ks * 4 + 3) * NMODS + j] = a3;
        }
    }
    {
        const float* log_dt = c.in[20]; const float* a_re = c.in[21]; const float* a_im = c.in[22];
        const float* b_re = c.in[23]; const float* b_im = c.in[24];
        float* apow = (float*)(c.ws + WS_APOW); float* bb = (float*)(c.ws + WS_S5BB);
        for (int idx = gt; idx < S5NG * S5P; idx += NT) {
            const int g = idx / S5P, p = idx % S5P;
            const double dt = exp((double)log_dt[g]);
            const double lre = fmin((double)a_re[idx], -1e-4), lim = (double)a_im[idx];
            const double mag = exp(lre * dt), ang = lim * dt;
            const double abr = mag * cos(ang), abi = mag * sin(ang);
            const double den = lre * lre + lim * lim;
            const double nre = abr - 1.0, nim = abi;
            const double qre = (nre * lre + nim * lim) / den, qim = (nim * lre - nre * lim) / den;
            double pr = 1.0, pi = 0.0;
            for (int j = 0; j <= S5L; ++j) {
                apow[((size_t)(g * (S5L + 1) + j) * 64 + p) * 2 + 0] = (float)pr; apow[((size_t)(g * (S5L + 1) + j) * 64 + p) * 2 + 1] = (float)pi;
                const double nr = pr * abr - pi * abi, ni = pr * abi + pi * abr; pr = nr; pi = ni;
            }
            for (int ch = 0; ch < 16; ++ch) {
                const double br = (double)b_re[idx * 16 + ch], bi = (double)b_im[idx * 16 + ch];
                bb[idx * 32 + ch] = (float)(qre * br - qim * bi);
                bb[idx * 32 + 16 + ch] = (float)(qre * bi + qim * br);
            }
        }
    }
    {
        const float* w2 = c.in[11]; const float* a2 = c.in[13]; const float* g2 = c.in[14];
        bf16_t* bt = (bf16_t*)(c.ws + WS_LORA_BT);
        for (int it = gt; it < 1536 * 32; it += NT) {
            const int n = it >> 5, c0 = (it & 31) * 8;
            float v[8];
#pragma unroll
            for (int i = 0; i < 8; ++i) {
                const int col = c0 + i; float x = 0.f;
                if (n < 512) { if (col < 64) x = w2[col * RW + n]; }
                else if (n < 1024) { if (col >= 64 && col < 128) x = a2[(col - 64) * RW + (n - 512)]; }
                else { if (col >= 128) x = g2[(col - 128) * RW + (n - 1024)]; }
                v[i] = x;
            }
            *(uint4*)(bt + (size_t)n * 256 + c0) = make_uint4(pk2(v[0], v[1]), pk2(v[2], v[3]), pk2(v[4], v[5]), pk2(v[6], v[7]));
        }
    }
    float* scr = c.sm + c.wid * (64 * 33);
    constexpr int I_IN = (D / 64) * (NPROJ / 32), I_OUT = (D / 64) * (D / 32), I_GLU = (512 / 64) * (512 / 32), I_SG = (D / 64) * (256 / 32), I_SD = (256 / 64) * (D / 32), I_R = (D / 64) * (256 / 32);
    constexpr int NIT = I_IN + I_OUT + I_GLU + 2 * I_SG + I_SD + 2 * I_R;
    for (int it = gw; it < NIT; it += NW) {
        int r = it;
        if (r < I_IN) { transpose_item<false>(c.in[8], D, NPROJ, (bf16_t*)(c.ws + WS_WIN_T), [](int n) { return n; }, scr, r, c.lane); continue; } r -= I_IN;
        if (r < I_OUT) { transpose_item<false>(c.in[30], D, D, (bf16_t*)(c.ws + WS_WOUT_T), [](int n) { return n; }, scr, r, c.lane); continue; } r -= I_OUT;
        if (r < I_GLU) { transpose_item<false>(c.in[28], 512, 512, (bf16_t*)(c.ws + WS_WGLU_T), [](int n) { return n; }, scr, r, c.lane); continue; } r -= I_GLU;
        if (r < I_SG) { transpose_item<false>(c.in[36], D, 256, (bf16_t*)(c.ws + WS_WSGU_T), [](int n) { return (n >> 7) * 256 + (n & 127); }, scr, r, c.lane); continue; } r -= I_SG;
        if (r < I_SG) { transpose_item<false>(c.in[37], D, 256, (bf16_t*)(c.ws + WS_WSGU_T), [](int n) { return (n >> 7) * 256 + 128 + (n & 127); }, scr, r, c.lane); continue; } r -= I_SG;
        if (r < I_SD) { transpose_item<false>(c.in[38], 256, D, (bf16_t*)(c.ws + WS_WSD_T), [](int n) { return n; }, scr, r, c.lane); continue; } r -= I_SD;
        if (r < I_R) { transpose_item<false>(c.in[31], D, 256, (bf16_t*)(c.ws + WS_WR_T), [](int n) { return n; }, scr, r, c.lane); continue; } r -= I_R;
        transpose_item<true>(c.in[31], D, 256, (bf16_t*)(c.ws + WS_WR_T), [](int n) { return 256 + n; }, scr, r, c.lane);
    }
    for (int it = gw; it < NE * 384; it += NW) {
        const int e = it / 384, r = it % 384;
        if (r < 128) transpose_item<false>(c.in[33] + (size_t)e * D * EFF, D, EFF, (bf16_t*)(c.ws + WS_WEGU) + (size_t)e * 512 * D, [](int n) { return (n >> 7) * 256 + (n & 127); }, scr, r, c.lane);
        else if (r < 256) transpose_item<false>(c.in[34] + (size_t)e * D * EFF, D, EFF, (bf16_t*)(c.ws + WS_WEGU) + (size_t)e * 512 * D, [](int n) { return (n >> 7) * 256 + 128 + (n & 127); }, scr, r - 128, c.lane);
        else transpose_item<false>(c.in[35] + (size_t)e * EFF * D, EFF, D, (bf16_t*)(c.ws + WS_WED) + (size_t)e * D * EFF, [](int n) { return n; }, scr, r - 256, c.lane);
    }
}

__device__ __forceinline__ void phase1(const Ctx& c) {
    const int gt = c.bid * 512 + c.tid, NT = c.G * 512;
    const int gw = c.bid * 8 + c.wid, NW = c.G * 8;
    const float* modsp = (const float*)(c.ws + WS_MODSP); const float* b_ada = c.in[3]; float* mods = (float*)(c.ws + WS_MODS);
    for (int idx = gt; idx < BATCH * NMODS; idx += NT) {
        const int b = idx / NMODS, j = idx % NMODS;
        float acc = 0.f;
#pragma unroll
        for (int ks = 0; ks < 16; ++ks) acc += modsp[(ks * 4 + b) * NMODS + j];
        mods[idx] = acc + b_ada[j];
    }
    const float* apow = (const float*)(c.ws + WS_APOW); const float* bb = (const float*)(c.ws + WS_S5BB);
    const float* c_re = c.in[25]; const float* c_im = c.in[26];
    float* klag = (float*)(c.ws + WS_KLAG);
    for (int task = gw; task < S5NG * S5L; task += NW) {
        const int g = task / S5L, j = task % S5L, cc = c.lane >> 2, cq = (c.lane & 3) * 4;
        float acc[4] = {0.f, 0.f, 0.f, 0.f};
        for (int p = 0; p < 64; ++p) {
            const float ar = apow[((size_t)(g * (S5L + 1) + j) * 64 + p) * 2], ai = apow[((size_t)(g * (S5L + 1) + j) * 64 + p) * 2 + 1];
            const float cr = c_re[(g * 16 + cc) * 64 + p], ci = c_im[(g * 16 + cc) * 64 + p];
            const float4 br = *(const float4*)(bb + (size_t)(g * 64 + p) * 32 + cq), bi = *(const float4*)(bb + (size_t)(g * 64 + p) * 32 + 16 + cq);
            const float er = cr * ar - ci * ai, ei = cr * ai + ci * ar;
            acc[0] += er * br.x - ei * bi.x; acc[1] += er * br.y - ei * bi.y; acc[2] += er * br.z - ei * bi.z; acc[3] += er * br.w - ei * bi.w;
        }
        *(float4*)(klag + ((size_t)(g * S5L + j) * 16 + cc) * 16 + cq) = make_float4(acc[0], acc[1], acc[2], acc[3]);
    }
}

__device__ __forceinline__ void phase2(const Ctx& c) {
    const float* x = c.in[0]; const float* g = c.in[4];
    const float* mods = (const float*)(c.ws + WS_MODS);
    bf16_t* xn = (bf16_t*)(c.ws + WS_A);
    const int gw = c.bid * 8 + c.wid, NW = c.G * 8;
    for (int t = gw; t < T; t += NW) {
        const int b = t / SEQ;
        const float4* xr = (const float4*)(x + (size_t)t * D) + c.lane;
        float4 v[4]; float ss = 0.f;
#pragma unroll
        for (int j = 0; j < 4; ++j) { v[j] = xr[64 * j]; ss += v[j].x * v[j].x + v[j].y * v[j].y + v[j].z * v[j].z + v[j].w * v[j].w; }
        const float rstd = rsqrtf(wave_sum(ss) * (1.0f / D) + 1e-6f);
        uint2* o = (uint2*)(xn + (size_t)t * D) + c.lane;
#pragma unroll
        for (int j = 0; j < 4; ++j) {
            const int k = (c.lane + 64 * j) * 4;
            const float4 gg = *(const float4*)(g + k);
            const float4 sh = *(const float4*)(mods + b * NMODS + k);
            const float4 sc = *(const float4*)(mods + b * NMODS + D + k);
            float4 r;
            r.x = v[j].x * rstd * gg.x * (1.f + sc.x) + sh.x; r.y = v[j].y * rstd * gg.y * (1.f + sc.y) + sh.y;
            r.z = v[j].z * rstd * gg.z * (1.f + sc.z) + sh.z; r.w = v[j].w * rstd * gg.w * (1.f + sc.w) + sh.w;
            o[64 * j] = make_uint2(pk2(r.x, r.y), pk2(r.z, r.w));
        }
    }
    const int gt = c.bid * 512 + c.tid, NT = c.G * 512;
    const float* apow = (const float*)(c.ws + WS_APOW); const float* bb = (const float*)(c.ws + WS_S5BB); const float* klag = (const float*)(c.ws + WS_KLAG);
    const float* c_re = c.in[25]; const float* c_im = c.in[26]; const float* dd = c.in[27];
    bf16_t* kmat = (bf16_t*)(c.ws + WS_KMAT); bf16_t* hmat = (bf16_t*)(c.ws + WS_HMAT);
    for (int it = gt; it < S5NG * 512 * 80; it += NT) {
        const int row = it / 80, ch = it % 80, g = row >> 9, t = (row >> 4) & 31, cc = row & 15, col0 = ch * 8;
        float v[8];
        if (col0 < 512) {
            const int s = col0 >> 4, c0 = col0 & 15;
            if (s > t) {
#pragma unroll
                for (int i = 0; i < 8; ++i) v[i] = 0.f;
            } else {
                const float4 k0 = *(const float4*)(klag + ((size_t)(g * S5L + (t - s)) * 16 + cc) * 16 + c0), k1 = *(const float4*)(klag + ((size_t)(g * S5L + (t - s)) * 16 + cc) * 16 + c0 + 4);
                v[0] = k0.x; v[1] = k0.y; v[2] = k0.z; v[3] = k0.w; v[4] = k1.x; v[5] = k1.y; v[6] = k1.z; v[7] = k1.w;
                if (s == t) {
                    const float dv = dd[g * 16 + cc];
#pragma unroll
                    for (int i = 0; i < 8; ++i) if (c0 + i == cc) v[i] += dv;
                }
            }
        } else {
            const int q0 = col0 - 512;
#pragma unroll
            for (int i = 0; i < 8; ++i) {
                const int q = q0 + i, p = q & 63;
                const float ar = apow[((size_t)(g * (S5L + 1) + t + 1) * 64 + p) * 2], ai = apow[((size_t)(g * (S5L + 1) + t + 1) * 64 + p) * 2 + 1];
                const float cr = c_re[(g * 16 + cc) * 64 + p], ci = c_im[(g * 16 + cc) * 64 + p];
                v[i] = (q < 64) ? (cr * ar - ci * ai) : -(cr * ai + ci * ar);
            }
        }
        *(uint4*)(kmat + (size_t)row * 640 + col0) = make_uint4(pk2(v[0], v[1]), pk2(v[2], v[3]), pk2(v[4], v[5]), pk2(v[6], v[7]));
    }
    for (int it = gt; it < S5NG * 256 * 80; it += NT) {
        const int row = it / 80, ch = it % 80, g = row >> 8, q = row & 255, col0 = ch * 8;
        float v[8];
#pragma unroll
        for (int i = 0; i < 8; ++i) v[i] = 0.f;
        if (q < 128 && col0 < 512) {
            const int s = col0 >> 4, c0 = col0 & 15, p = q & 63;
            const float ar = apow[((size_t)(g * (S5L + 1) + (S5L - 1 - s)) * 64 + p) * 2], ai = apow[((size_t)(g * (S5L + 1) + (S5L - 1 - s)) * 64 + p) * 2 + 1];
#pragma unroll
            for (int i = 0; i < 8; ++i) {
                const float br = bb[(size_t)(g * 64 + p) * 32 + c0 + i], bi = bb[(size_t)(g * 64 + p) * 32 + 16 + c0 + i];
                v[i] = (q < 64) ? (ar * br - ai * bi) : (ar * bi + ai * br);
            }
        }
        *(uint4*)(hmat + (size_t)row * 640 + col0) = make_uint4(pk2(v[0], v[1]), pk2(v[2], v[3]), pk2(v[4], v[5]), pk2(v[6], v[7]));
    }
}

__device__ __forceinline__ void phase3(const Ctx& c) {
    pg8::Gemm g{(const bf16_t*)(c.ws + WS_A), (const bf16_t*)(c.ws + WS_WIN_T), T, NPROJ, D};
    pg8::StaticOrder S; S.init(T, NPROJ, c.G, c.bid);
    pg8::EpiBf16<0> E{(bf16_t*)(c.ws + WS_PROJ), NPROJ, nullptr, 0, 0, 1.f};
    pg8::gemm_phase<pg8::EpiBf16<0>, pg8::StaticOrder, true, true>(c.lds, g, S, E);
}

__device__ __forceinline__ void unpack8(const uint4 a, float (&u)[8]) {
    u[0] = bf2f(a.x & 0xffffu); u[1] = bf2f(a.x >> 16); u[2] = bf2f(a.y & 0xffffu); u[3] = bf2f(a.y >> 16);
    u[4] = bf2f(a.z & 0xffffu); u[5] = bf2f(a.z >> 16); u[6] = bf2f(a.w & 0xffffu); u[7] = bf2f(a.w >> 16);
}
__device__ __forceinline__ uint4 pack8(const float (&v)[8]) { return make_uint4(pk2(v[0], v[1]), pk2(v[2], v[3]), pk2(v[4], v[5]), pk2(v[6], v[7])); }
__device__ __forceinline__ void phase4(const Ctx& c) {
    const bf16_t* proj = (const bf16_t*)(c.ws + WS_PROJ);
    const float* mu = c.in[9]; const float* k_k = c.in[15];
    bf16_t* rw_r = (bf16_t*)(c.ws + WS_RW_R); bf16_t* rw_k = (bf16_t*)(c.ws + WS_RW_K); bf16_t* rw_v = (bf16_t*)(c.ws + WS_RW_V); bf16_t* rw_a = (bf16_t*)(c.ws + WS_RW_A);
    bf16_t* alora = (bf16_t*)((unsigned char*)c.out + OUT_ALORA);
    const int gw = c.bid * 8 + c.wid, NW = c.G * 8;
    for (int t = gw; t < T; t += NW) {
        const bool first = (t % SEQ == 0);
        const bf16_t* pr = proj + (size_t)t * NPROJ; const bf16_t* pp = proj + (size_t)(first ? t : t - 1) * NPROJ;
#pragma unroll
        for (int j = 0; j < 4; ++j) {
            const int cidx = c.lane + 64 * j;
            if (cidx < 224) {
                const int col = cidx * 8;
                float p[8], q[8], ps[8];
                unpack8(*(const uint4*)(pr + col), p); unpack8(*(const uint4*)(pp + col), q);
                const float4 m0 = *(const float4*)(mu + col), m1 = *(const float4*)(mu + col + 4);
                const float mm[8] = {m0.x, m0.y, m0.z, m0.w, m1.x, m1.y, m1.z, m1.w};
#pragma unroll
                for (int i = 0; i < 8; ++i) { const float pv = first ? 0.f : q[i]; ps[i] = p[i] + (pv - p[i]) * mm[i]; }
                if (j == 0) *(uint4*)(rw_r + (size_t)t * RW + col) = pack8(ps);
                else if (j == 1) {
                    const int cl = col - 512;
                    *(uint4*)(rw_k + (size_t)t * RW + cl) = pack8(ps);
                    const float4 k0 = *(const float4*)(k_k + cl), k1 = *(const float4*)(k_k + cl + 4);
                    const float kk8[8] = {k0.x, k0.y, k0.z, k0.w, k1.x, k1.y, k1.z, k1.w};
                    float kk[8]; float ss = 0.f;
#pragma unroll
                    for (int i = 0; i < 8; ++i) { kk[i] = ps[i] * kk8[i]; ss += kk[i] * kk[i]; }
                    ss += __shfl_xor(ss, 1); ss += __shfl_xor(ss, 2); ss += __shfl_xor(ss, 4);
                    const float inv = -1.0f / fmaxf(sqrtf(ss), 1e-12f);
#pragma unroll
                    for (int i = 0; i < 8; ++i) kk[i] *= inv;
                    *(uint4*)(rw_a + (size_t)t * RW + cl) = pack8(kk);
                } else if (j == 2) *(uint4*)(rw_v + (size_t)t * RW + (col - 1024)) = pack8(ps);
                else {
                    const int cl = col - 1536;
                    float o[8];
#pragma unroll
                    for (int i = 0; i < 8; ++i) o[i] = (cl < 64) ? tanhf(ps[i]) : (cl < 128) ? ps[i] : sigmoidf_(ps[i]);
                    *(uint4*)(alora + (size_t)t * 256 + cl) = pack8(o);
                }
            }
        }
    }
    bf16_t* ux = (bf16_t*)((unsigned char*)c.out + OUT_UX);
    const int gt = c.bid * 512 + c.tid, NT = c.G * 512;
    for (int it = gt; it < T * 64; it += NT) {
        const int t = it >> 6, g = (it >> 1) & 31, hf = it & 1;
        const int b = t / SEQ, s = t % S5L, chunk = (t % SEQ) / S5L;
        const uint4 v = *(const uint4*)(proj + (size_t)t * NPROJ + RPROJ + g * 16 + hf * 8);
        *(uint4*)(ux + ((size_t)(g * 1024 + b * 256 + chunk)) * 640 + s * 16 + hf * 8) = v;
    }
    for (int it = gt; it < S5NG * 1024 * 16; it += NT) {
        const int row = it >> 4, ch = it & 15;
        *(uint4*)(ux + (size_t)row * 640 + 512 + ch * 8) = make_uint4(0u, 0u, 0u, 0u);
    }
}

__device__ __forceinline__ void phase5(const Ctx& c) {
    {
        pg8::Gemm g{(const bf16_t*)((unsigned char*)c.out + OUT_ALORA), (const bf16_t*)(c.ws + WS_LORA_BT), T, 1536, 256};
        pg8::StaticOrder S; S.init(T, 1536, c.G, c.bid);
        pg8::EpiLora E{c.in[10], c.in[12], c.in[16], (float*)(c.ws + WS_RW_W), (bf16_t*)(c.ws + WS_RW_K), (const bf16_t*)(c.ws + WS_RW_A), (bf16_t*)(c.ws + WS_RW_B), (bf16_t*)(c.ws + WS_RW_G)};
        pg8::gemm_phase<pg8::EpiLora, pg8::StaticOrder, true, true>(c.lds, g, S, E);
    }
    __syncthreads();
    {
        pg8::Gemm g{(const bf16_t*)((unsigned char*)c.out + OUT_UX), (const bf16_t*)(c.ws + WS_HMAT), 0, 0, 640};
        pg8::S5Order S{128, 1, c.G, c.bid};
        pg8::EpiS5E E{(float*)((unsigned char*)c.out + OUT_E)};
        pg8::gemm_phase<pg8::EpiS5E, pg8::S5Order, true, true>(c.lds, g, S, E);
    }
}

typedef float f2v __attribute__((ext_vector_type(2)));
__device__ __forceinline__ float dpp_add16(float v) {
    v += __builtin_bit_cast(float, __builtin_amdgcn_mov_dpp(__builtin_bit_cast(int, v), 0xB1, 0xf, 0xf, true));
    v += __builtin_bit_cast(float, __builtin_amdgcn_mov_dpp(__builtin_bit_cast(int, v), 0x4E, 0xf, 0xf, true));
    v += __builtin_bit_cast(float, __builtin_amdgcn_mov_dpp(__builtin_bit_cast(int, v), 0x141, 0xf, 0xf, true));
    v += __builtin_bit_cast(float, __builtin_amdgcn_mov_dpp(__builtin_bit_cast(int, v), 0x140, 0xf, 0xf, true));
    return v;
}
constexpr int RTS = 32;
constexpr int RTILE = 6 * RTS * 64;
typedef short bf16x8_t __attribute__((ext_vector_type(8)));
typedef float f32x4_t __attribute__((ext_vector_type(4)));
#define MFMA16(a, b, c) __builtin_amdgcn_mfma_f32_16x16x32_bf16((a), (b), (c), 0, 0, 0)
constexpr int CL = 64, CLD = 72, CSLOT = 64 * CLD * 2;
constexpr int C_DIAG = 13 * CSLOT, C_DM = C_DIAG + 4096, C_GL = C_DM + 2048, C_SEGP = C_GL + 256;
static_assert(C_SEGP + 2048 <= 131072, "rwkv chunk LDS map");
__device__ __forceinline__ bf16x8_t ldsfrag(LAS const unsigned char* slot, int row, int col) { return *(LAS const bf16x8_t*)(slot + (row * CLD + col) * 2); }
typedef unsigned u32x4_t __attribute__((ext_vector_type(4)));
typedef unsigned u32x2_t __attribute__((ext_vector_type(2)));
__device__ __forceinline__ void lds_st16(LAS unsigned char* p, uint4 v) { *(LAS u32x4_t*)p = (u32x4_t){v.x, v.y, v.z, v.w}; }
__device__ __forceinline__ void lds_st8(LAS unsigned char* p, uint2 v) { *(LAS u32x2_t*)p = (u32x2_t){v.x, v.y}; }
__device__ __forceinline__ uint2 lds_ld8(LAS const unsigned char* p) { const u32x2_t v = *(LAS const u32x2_t*)p; return make_uint2(v.x, v.y); }
__device__ __forceinline__ bf16x8_t zfrag() { return (bf16x8_t){0, 0, 0, 0, 0, 0, 0, 0}; }
__device__ __forceinline__ uint2 pack4(float a, float b, float c, float d) { return make_uint2(pk2(a, b), pk2(c, d)); }
__device__ __forceinline__ float wave_sum_u(float v) {
    v = dpp_add16(v);
    return __builtin_bit_cast(float, __builtin_amdgcn_readlane(__builtin_bit_cast(int, v), 0)) + __builtin_bit_cast(float, __builtin_amdgcn_readlane(__builtin_bit_cast(int, v), 16))
         + __builtin_bit_cast(float, __builtin_amdgcn_readlane(__builtin_bit_cast(int, v), 32)) + __builtin_bit_cast(float, __builtin_amdgcn_readlane(__builtin_bit_cast(int, v), 48));
}

__device__ __forceinline__ void rwkv_phaseA(const Ctx& c) {
    const float* __restrict__ rw_w = (const float*)(c.ws + WS_RW_W);
    const bf16_t* __restrict__ rw_r = (const bf16_t*)(c.ws + WS_RW_R); const bf16_t* __restrict__ rw_k = (const bf16_t*)(c.ws + WS_RW_K); const bf16_t* __restrict__ rw_v = (const bf16_t*)(c.ws + WS_RW_V);
    const bf16_t* __restrict__ rw_a = (const bf16_t*)(c.ws + WS_RW_A); const bf16_t* __restrict__ rw_b = (const bf16_t*)(c.ws + WS_RW_B);
    const float* r_k = c.in[17];
    bf16_t* Mq = (bf16_t*)(c.ws + WS_CM); bf16_t* NTq = (bf16_t*)(c.ws + WS_CN); bf16_t* Qq = (bf16_t*)(c.ws + WS_CQ); bf16_t* YTq = (bf16_t*)(c.ws + WS_CY); float* bon = (float*)(c.ws + WS_CBON);
    LAS unsigned char* L = c.lds;
    LAS unsigned char* sAt = L + 0 * CSLOT; LAS unsigned char* sBt = L + 1 * CSLOT; LAS unsigned char* sKt = L + 2 * CSLOT; LAS unsigned char* sRt = L + 3 * CSLOT;
    LAS unsigned char* sBtT = L + 4 * CSLOT; LAS unsigned char* sKtT = L + 5 * CSLOT; LAS unsigned char* sVT = L + 6 * CSLOT;
    LAS unsigned char* sA4 = L + 7 * CSLOT;
    LAS unsigned char* sRHST = L + 11 * CSLOT;
    LAS unsigned char* sXT = L + 0 * CSLOT;
    LAS unsigned char* sAD = L + 2 * CSLOT;
    LAS float* sDIAG = (LAS float*)(L + C_DIAG); LAS bf16_t* sDM = (LAS bf16_t*)(L + C_DM); LAS float* sGL = (LAS float*)(L + C_GL); LAS float* sSEGP = (LAS float*)(L + C_SEGP);
    const int tid = c.tid, w = c.wid, lane = c.lane, lr = lane & 15, lq = lane >> 4;
    for (int ci = c.bid; ci < BATCH * NH * (SEQ / CL); ci += c.G) {
        const int bh = ci >> 7, chunk = ci & 127, b = bh >> 3, h = bh & 7;
        const size_t gbase = (size_t)(b * SEQ + chunk * CL) * RW + h * 64;
        {
            const int kc = tid & 63, seg = tid >> 6;
            float p[8];
#pragma unroll
            for (int j = 0; j < 8; ++j) { const float wv = rw_w[gbase + (size_t)(8 * seg + j) * RW + kc]; p[j] = (j == 0) ? wv : p[j - 1] * wv; }
            sSEGP[seg * 64 + kc] = p[7];
            for (int i = tid; i < 4 * CSLOT / 16; i += 512) lds_st16(sA4 + i * 16, make_uint4(0u, 0u, 0u, 0u));
            __syncthreads();
            float pre = 1.0f;
#pragma unroll
            for (int s = 0; s < 7; ++s) { const float sp = sSEGP[s * 64 + kc]; pre = (s < seg) ? pre * sp : pre; }
            float atT[8], btT[8], ktT[8], vT[8];
            const float rkv = r_k[h * 64 + kc];
#pragma unroll
            for (int j = 0; j < 8; ++j) {
                const int t = 8 * seg + j; const size_t o = gbase + (size_t)t * RW + kc;
                const float G = pre * p[j], Gm1 = (j == 0) ? pre : pre * p[j - 1], inv = 1.0f / G;
                const float av = ldbf(rw_a + o), bv = ldbf(rw_b + o), kv = ldbf(rw_k + o), rv = ldbf(rw_r + o), vv = ldbf(rw_v + o);
                const float at = av * Gm1, bt = bv * inv, kt = kv * inv, rt = rv * G;
                *(LAS bf16_t*)(sAt + (t * CLD + kc) * 2) = (bf16_t)f2bf(at); *(LAS bf16_t*)(sBt + (t * CLD + kc) * 2) = (bf16_t)f2bf(bt);
                *(LAS bf16_t*)(sKt + (t * CLD + kc) * 2) = (bf16_t)f2bf(kt); *(LAS bf16_t*)(sRt + (t * CLD + kc) * 2) = (bf16_t)f2bf(rt);
                atT[j] = at; btT[j] = bt; ktT[j] = kt; vT[j] = vv;
                const float bs = wave_sum_u(rv * kv * rkv);
                if (lane == 0) bon[(size_t)ci * CL + t] = bs;
            }
            lds_st16(sRHST + (kc * CLD + 8 * seg) * 2, pack8(atT)); lds_st16(sBtT + (kc * CLD + 8 * seg) * 2, pack8(btT));
            lds_st16(sKtT + (kc * CLD + 8 * seg) * 2, pack8(ktT)); lds_st16(sVT + (kc * CLD + 8 * seg) * 2, pack8(vT));
            if (seg == 7) sGL[kc] = pre * p[7];
            __syncthreads();
        }
        for (int idx = w; idx < 40; idx += 8) {
            const int m = idx / 10, pr = idx % 10;
            const int ti = (pr >= 6) ? 3 : (pr >= 3) ? 2 : (pr >= 1) ? 1 : 0, si = pr - ti * (ti + 1) / 2;
            LAS const unsigned char* X = (m < 2) ? sAt : sRt; LAS const unsigned char* Y = (m & 1) ? sKt : sBt;
            f32x4_t acc = {0.f, 0.f, 0.f, 0.f};
#pragma unroll
            for (int ks = 0; ks < 2; ++ks) acc = MFMA16(ldsfrag(Y, 16 * si + lr, 32 * ks + 8 * lq), ldsfrag(X, 16 * ti + lr, 32 * ks + 8 * lq), acc);
            const int t = 16 * ti + lr, s0 = 16 * si + 4 * lq;
            float o[4];
#pragma unroll
            for (int rg = 0; rg < 4; ++rg) { const int s = s0 + rg; const bool keep = (m < 2) ? (s < t) : (s <= t); o[rg] = keep ? acc[rg] : 0.f; }
            lds_st8(sA4 + m * CSLOT + (t * CLD + s0) * 2, pack4(o[0], o[1], o[2], o[3]));
            if (m == 0 && ti == si) *(LAS f32x4_t*)(sDIAG + (ti * 16 + lr) * 16 + 4 * lq) = (f32x4_t){o[0], o[1], o[2], o[3]};
        }
        __syncthreads();
        if (w == 0) {
            float x[16];
#pragma unroll
            for (int r = 0; r < 16; ++r) {
                float acc = (r == lr) ? 1.0f : 0.0f;
                float nrow[16];
#pragma unroll
                for (int q4 = 0; q4 < 4; ++q4) { const f32x4_t nv = *(LAS const f32x4_t*)(sDIAG + (lq * 16 + r) * 16 + 4 * q4); nrow[4 * q4] = nv[0]; nrow[4 * q4 + 1] = nv[1]; nrow[4 * q4 + 2] = nv[2]; nrow[4 * q4 + 3] = nv[3]; }
#pragma unroll
                for (int s = 0; s < 16; ++s) if (s < r) acc = fmaf(nrow[s], x[s], acc);
                x[r] = acc;
                sDM[(lq * 16 + r) * 16 + lr] = (bf16_t)f2bf(acc);
            }
        } else {
            for (int idx = w - 1; idx < 16; idx += 7) {
                const int ti = idx >> 2, vi = idx & 3;
                f32x4_t acc = {0.f, 0.f, 0.f, 0.f};
#pragma unroll
                for (int ks = 0; ks < 2; ++ks) acc = MFMA16(ldsfrag(sA4 + 1 * CSLOT, 16 * ti + lr, 32 * ks + 8 * lq), ldsfrag(sVT, 16 * vi + lr, 32 * ks + 8 * lq), acc);
                lds_st8(sRHST + ((64 + 16 * vi + lr) * CLD + 16 * ti + 4 * lq) * 2, pack4(acc[0], acc[1], acc[2], acc[3]));
            }
        }
        __syncthreads();
        f32x4_t rd[4];
#pragma unroll
        for (int i = 0; i < 4; ++i) {
            bf16x8_t fa = zfrag(), fb = zfrag();
            if (lq < 2) { fa = *(LAS const bf16x8_t*)(sDM + (i * 16 + lr) * 16 + 8 * lq); fb = ldsfrag(sRHST, 16 * w + lr, 16 * i + 8 * lq); }
            rd[i] = MFMA16(fa, fb, ((f32x4_t){0.f, 0.f, 0.f, 0.f}));
        }
        if (w < 6) {
            const int i = (w >= 3) ? 3 : (w >= 1) ? 2 : 1, j = w - (i - 1) * i / 2;
            bf16x8_t fa = zfrag(), fb = zfrag();
            if (lq < 2) {
                fa = *(LAS const bf16x8_t*)(sDM + (i * 16 + lr) * 16 + 8 * lq);
#pragma unroll
                for (int jj = 0; jj < 8; ++jj) fb[jj] = (short)*(LAS const bf16_t*)(sA4 + ((16 * i + 8 * lq + jj) * CLD + 16 * j + lr) * 2);
            }
            const f32x4_t acc = MFMA16(fa, fb, ((f32x4_t){0.f, 0.f, 0.f, 0.f}));
#pragma unroll
            for (int rg = 0; rg < 4; ++rg) *(LAS bf16_t*)(sAD + ((16 * i + 4 * lq + rg) * CLD + 16 * j + lr) * 2) = (bf16_t)f2bf(acc[rg]);
        }
        __syncthreads();
#pragma unroll
        for (int i = 0; i < 4; ++i) {
            f32x4_t acc = rd[i];
            if (i >= 1) {
                bf16x8_t fa = zfrag(), fb = zfrag();
                if (8 * lq < 16 * i) { fa = ldsfrag(sAD, 16 * i + lr, 8 * lq); fb = ldsfrag(sXT, 16 * w + lr, 8 * lq); }
                acc = MFMA16(fa, fb, acc);
            }
            if (i == 3) {
                bf16x8_t fa = zfrag(), fb = zfrag();
                if (lq < 2) { fa = ldsfrag(sAD, 48 + lr, 32 + 8 * lq); fb = ldsfrag(sXT, 16 * w + lr, 32 + 8 * lq); }
                acc = MFMA16(fa, fb, acc);
            }
            lds_st8(sXT + ((16 * w + lr) * CLD + 16 * i + 4 * lq) * 2, pack4(acc[0], acc[1], acc[2], acc[3]));
            asm volatile("s_waitcnt lgkmcnt(0)" ::: "memory");
        }
        __syncthreads();
#pragma unroll
        for (int i = 0; i < 8; ++i) {
            const int kind = i >> 1, tile = w + 8 * (i & 1), r4 = tile >> 2, c4 = tile & 3;
            f32x4_t acc = {0.f, 0.f, 0.f, 0.f};
            if (kind == 0) {
#pragma unroll
                for (int ks = 0; ks < 2; ++ks) acc = MFMA16(ldsfrag(sXT, 16 * r4 + lr, 32 * ks + 8 * lq), ldsfrag(sBtT, 16 * c4 + lr, 32 * ks + 8 * lq), acc);
                const int k = 16 * c4 + lr, kp0 = 16 * r4 + 4 * lq; const float gl = sGL[k];
                float o[4];
#pragma unroll
                for (int rg = 0; rg < 4; ++rg) o[rg] = gl * (acc[rg] + ((k == kp0 + rg) ? 1.0f : 0.0f));
                *(uint2*)(Mq + (size_t)ci * 4096 + k * 64 + kp0) = pack4(o[0], o[1], o[2], o[3]);
            } else if (kind == 1) {
#pragma unroll
                for (int ks = 0; ks < 2; ++ks) {
                    acc = MFMA16(ldsfrag(sBtT, 16 * r4 + lr, 32 * ks + 8 * lq), ldsfrag(sXT, 64 + 16 * c4 + lr, 32 * ks + 8 * lq), acc);
                    acc = MFMA16(ldsfrag(sKtT, 16 * r4 + lr, 32 * ks + 8 * lq), ldsfrag(sVT, 16 * c4 + lr, 32 * ks + 8 * lq), acc);
                }
                const int k0 = 16 * r4 + 4 * lq; const f32x4_t gl = *(LAS const f32x4_t*)(sGL + k0);
                *(uint2*)(NTq + (size_t)ci * 4096 + (16 * c4 + lr) * 64 + k0) = pack4(gl[0] * acc[0], gl[1] * acc[1], gl[2] * acc[2], gl[3] * acc[3]);
            } else if (kind == 2) {
#pragma unroll
                for (int ks = 0; ks < 2; ++ks) acc = MFMA16(ldsfrag(sXT, 16 * r4 + lr, 32 * ks + 8 * lq), ldsfrag(sA4 + 2 * CSLOT, 16 * c4 + lr, 32 * ks + 8 * lq), acc);
                const int t = 16 * c4 + lr, kp0 = 16 * r4 + 4 * lq;
                const uint2 rv = lds_ld8(sRt + (t * CLD + kp0) * 2);
                *(uint2*)(Qq + (size_t)ci * 4096 + t * 64 + kp0) = pack4(acc[0] + bf2f(rv.x & 0xffffu), acc[1] + bf2f(rv.x >> 16), acc[2] + bf2f(rv.y & 0xffffu), acc[3] + bf2f(rv.y >> 16));
            } else {
#pragma unroll
                for (int ks = 0; ks < 2; ++ks) {
                    acc = MFMA16(ldsfrag(sA4 + 2 * CSLOT, 16 * r4 + lr, 32 * ks + 8 * lq), ldsfrag(sXT, 64 + 16 * c4 + lr, 32 * ks + 8 * lq), acc);
                    acc = MFMA16(ldsfrag(sA4 + 3 * CSLOT, 16 * r4 + lr, 32 * ks + 8 * lq), ldsfrag(sVT, 16 * c4 + lr, 32 * ks + 8 * lq), acc);
                }
                *(uint2*)(YTq + (size_t)ci * 4096 + (16 * c4 + lr) * 64 + 16 * r4 + 4 * lq) = pack4(acc[0], acc[1], acc[2], acc[3]);
            }
        }
        __syncthreads();
    }
}

__device__ __forceinline__ void rwkv_phaseB(const Ctx& c) {
    const bf16_t* __restrict__ Mq = (const bf16_t*)(c.ws + WS_CM); const bf16_t* __restrict__ NTq = (const bf16_t*)(c.ws + WS_CN); bf16_t* __restrict__ Sst = (bf16_t*)(c.ws + WS_CS);
    const int w = c.wid, lane = c.lane, lr = lane & 15, lq = lane >> 4;
    LAS unsigned char* sS = c.lds + 65536 + w * (16 * CLD * 2);
    for (int bh = c.bid; bh < BATCH * NH; bh += c.G) {
        if (w < 4) {
            bf16x8_t sB0 = zfrag(), sB1 = zfrag();
            bf16x8_t ma[4][2]; uint2 nv[4];
            {
                const size_t ci = (size_t)bh * (SEQ / CL);
#pragma unroll
                for (int kt = 0; kt < 4; ++kt) {
#pragma unroll
                    for (int ks = 0; ks < 2; ++ks) ma[kt][ks] = *(const bf16x8_t*)(Mq + ci * 4096 + (16 * kt + lr) * 64 + 32 * ks + 8 * lq);
                    nv[kt] = *(const uint2*)(NTq + ci * 4096 + (16 * w + lr) * 64 + 16 * kt + 4 * lq);
                }
            }
            for (int chunk = 0; chunk < SEQ / CL; ++chunk) {
                const size_t ci = (size_t)bh * (SEQ / CL) + chunk;
                const size_t cn = (chunk + 1 < SEQ / CL) ? ci + 1 : ci;
                bf16x8_t man[4][2]; uint2 nvn[4];
#pragma unroll
                for (int kt = 0; kt < 4; ++kt) {
#pragma unroll
                    for (int ks = 0; ks < 2; ++ks) man[kt][ks] = *(const bf16x8_t*)(Mq + cn * 4096 + (16 * kt + lr) * 64 + 32 * ks + 8 * lq);
                    nvn[kt] = *(const uint2*)(NTq + cn * 4096 + (16 * w + lr) * 64 + 16 * kt + 4 * lq);
                }
                *(bf16x8_t*)(Sst + ci * 4096 + (16 * w + lr) * 64 + 8 * lq) = sB0; *(bf16x8_t*)(Sst + ci * 4096 + (16 * w + lr) * 64 + 32 + 8 * lq) = sB1;
#pragma unroll
                for (int kt = 0; kt < 4; ++kt) {
                    f32x4_t acc = {bf2f(nv[kt].x & 0xffffu), bf2f(nv[kt].x >> 16), bf2f(nv[kt].y & 0xffffu), bf2f(nv[kt].y >> 16)};
                    acc = MFMA16(ma[kt][0], sB0, acc); acc = MFMA16(ma[kt][1], sB1, acc);
                    lds_st8(sS + (lr * CLD + 16 * kt + 4 * lq) * 2, pack4(acc[0], acc[1], acc[2], acc[3]));
                }
                asm volatile("s_waitcnt lgkmcnt(0)" ::: "memory");
                sB0 = ldsfrag(sS, lr, 8 * lq); sB1 = ldsfrag(sS, lr, 32 + 8 * lq);
                asm volatile("s_waitcnt lgkmcnt(0)" ::: "memory");
#pragma unroll
                for (int kt = 0; kt < 4; ++kt) { ma[kt][0] = man[kt][0]; ma[kt][1] = man[kt][1]; nv[kt] = nvn[kt]; }
            }
        }
    }
}

__device__ __forceinline__ void rwkv_phaseC(const Ctx& c) {
    const bf16_t* __restrict__ Qq = (const bf16_t*)(c.ws + WS_CQ); const bf16_t* __restrict__ YTq = (const bf16_t*)(c.ws + WS_CY); const bf16_t* __restrict__ Sst = (const bf16_t*)(c.ws + WS_CS);
    const float* __restrict__ bon = (const float*)(c.ws + WS_CBON);
    const bf16_t* rw_v = (const bf16_t*)(c.ws + WS_RW_V); const bf16_t* rw_g = (const bf16_t*)(c.ws + WS_RW_G);
    const float* ln_w = c.in[18]; const float* ln_b = c.in[19];
    bf16_t* ycat = (bf16_t*)(c.ws + WS_A);
    const int w = c.wid, lane = c.lane, lr = lane & 15, lq = lane >> 4;
    LAS float* sY = (LAS float*)(c.lds + w * (16 * 68 * 4));
    const int gw = c.bid * 8 + c.wid, NW = c.G * 8;
    for (int task = gw; task < BATCH * NH * (SEQ / CL) * 4; task += NW) {
        const size_t ci = (size_t)(task >> 2); const int tt = task & 3;
        const int bh = (int)(ci >> 7), chunk = (int)(ci & 127), b = bh >> 3, h = bh & 7;
        bf16x8_t qa[2];
#pragma unroll
        for (int ks = 0; ks < 2; ++ks) qa[ks] = *(const bf16x8_t*)(Qq + ci * 4096 + (16 * tt + lr) * 64 + 32 * ks + 8 * lq);
#pragma unroll
        for (int vt = 0; vt < 4; ++vt) {
            const uint2 yv = *(const uint2*)(YTq + ci * 4096 + (16 * vt + lr) * 64 + 16 * tt + 4 * lq);
            f32x4_t acc = {bf2f(yv.x & 0xffffu), bf2f(yv.x >> 16), bf2f(yv.y & 0xffffu), bf2f(yv.y >> 16)};
#pragma unroll
            for (int ks = 0; ks < 2; ++ks) acc = MFMA16(qa[ks], *(const bf16x8_t*)(Sst + ci * 4096 + (16 * vt + lr) * 64 + 32 * ks + 8 * lq), acc);
#pragma unroll
            for (int rg = 0; rg < 4; ++rg) sY[(4 * lq + rg) * 68 + 16 * vt + lr] = acc[rg];
        }
        asm volatile("s_waitcnt lgkmcnt(0)" ::: "memory");
        const int hn = h * 64 + lane;
        const float lw = ln_w[hn], lb = ln_b[hn];
#pragma unroll 4
        for (int tr = 0; tr < 16; ++tr) {
            const int t = chunk * CL + 16 * tt + tr; const size_t tok = (size_t)b * SEQ + t;
            const float y = sY[tr * 68 + lane];
            const float mean = wave_sum_u(y) * (1.f / 64.f);
            const float d = y - mean;
            const float var = wave_sum_u(d * d) * (1.f / 64.f);
            const float yn = d * rsqrtf(var + 64e-5f) * lw + lb;
            const float bonus = bon[ci * CL + 16 * tt + tr] * ldbf(rw_v + tok * RW + hn);
            ycat[tok * D + hn] = (bf16_t)f2bf((yn + bonus) * ldbf(rw_g + tok * RW + hn));
        }
        asm volatile("s_waitcnt lgkmcnt(0)" ::: "memory");
    }
}

__device__ __forceinline__ void phase6a(const Ctx& c) { rwkv_phaseA(c); }

__device__ __forceinline__ void phase6b(const Ctx& c) {
    {
        const float* apow = (const float*)(c.ws + WS_APOW); const float* E = (const float*)((const unsigned char*)c.out + OUT_E);
        bf16_t* ux = (bf16_t*)((unsigned char*)c.out + OUT_UX);
        for (int task = c.bid * 8 + c.wid; task < S5NG * BATCH; task += c.G * 8) {
            const int g = task >> 2, b = task & 3, p = c.lane;
            const float pr = apow[((size_t)(g * (S5L + 1) + S5L) * 64 + p) * 2], pi = apow[((size_t)(g * (S5L + 1) + S5L) * 64 + p) * 2 + 1];
            float xr = 0.f, xi = 0.f;
            const size_t row0 = (size_t)g * 1024 + b * 256;
            for (int ch0 = 0; ch0 < 256; ch0 += 8) {
                float er[8], ei[8];
#pragma unroll
                for (int q = 0; q < 8; ++q) { er[q] = E[(row0 + ch0 + q) * 128 + p]; ei[q] = E[(row0 + ch0 + q) * 128 + 64 + p]; }
#pragma unroll
                for (int q = 0; q < 8; ++q) {
                    ux[(row0 + ch0 + q) * 640 + 512 + p] = (bf16_t)f2bf(xr); ux[(row0 + ch0 + q) * 640 + 576 + p] = (bf16_t)f2bf(xi);
                    const float nr = pr * xr - pi * xi + er[q], ni = pr * xi + pi * xr + ei[q]; xr = nr; xi = ni;
                }
            }
        }
    }
    rwkv_phaseB(c);
}

__device__ __forceinline__ void phase7(const Ctx& c) {
    {
        pg8::Gemm g{(const bf16_t*)((unsigned char*)c.out + OUT_UX), (const bf16_t*)(c.ws + WS_KMAT), 0, 0, 640};
        pg8::S5Order S{256, 2, c.G, c.bid};
        pg8::EpiS5Out E{(bf16_t*)(c.ws + WS_YS5)};
        pg8::gemm_phase<pg8::EpiS5Out, pg8::S5Order, true, true>(c.lds, g, S, E);
    }
    __syncthreads();
    rwkv_phaseC(c);
}

__device__ __forceinline__ void phase8(const Ctx& c) {
    pg8::Gemm g{(const bf16_t*)(c.ws + WS_YS5), (const bf16_t*)(c.ws + WS_WGLU_T), T, 512, 512};
    pg8::StaticOrder S; S.init(T, 512, c.G, c.bid);
    pg8::EpiGLU E{(const bf16_t*)(c.ws + WS_YS5), 512, c.in[29], (bf16_t*)(c.ws + WS_A), D, 512};
    pg8::gemm_phase<pg8::EpiGLU, pg8::StaticOrder, true, true>(c.lds, g, S, E);
}

__device__ __forceinline__ void phase9(const Ctx& c) {
    pg8::Gemm g{(const bf16_t*)(c.ws + WS_A), (const bf16_t*)(c.ws + WS_WOUT_T), T, D, D};
    pg8::StaticOrder S; S.init(T, D, c.G, c.bid);
    pg8::EpiF32 E{(float*)(c.ws + WS_PROJ), D};
    pg8::gemm_phase<pg8::EpiF32, pg8::StaticOrder, true, true>(c.lds, g, S, E);
}

__device__ __forceinline__ void phase10(const Ctx& c) {
    const float* x = c.in[0]; const float* gpm = c.in[5]; const float* gpf = c.in[6];
    const float* mods = (const float*)(c.ws + WS_MODS); const float* mixed = (const float*)(c.ws + WS_PROJ);
    bf16_t* h2 = (bf16_t*)(c.ws + WS_A); float* x1o = c.out;
    const int gw = c.bid * 8 + c.wid, NW = c.G * 8;
    for (int t = gw; t < T; t += NW) {
        const int b = t / SEQ;
        const float4* mr = (const float4*)(mixed + (size_t)t * D) + c.lane;
        const float4* xr = (const float4*)(x + (size_t)t * D) + c.lane;
        float4 m[4], v[4]; float ss = 0.f;
#pragma unroll
        for (int j = 0; j < 4; ++j) { m[j] = mr[64 * j]; v[j] = xr[64 * j]; ss += m[j].x * m[j].x + m[j].y * m[j].y + m[j].z * m[j].z + m[j].w * m[j].w; }
        const float rstd = rsqrtf(wave_sum(ss) * (1.0f / D) + 1e-6f);
        float s1 = 0.f;
#pragma unroll
        for (int j = 0; j < 4; ++j) {
            const int k = (c.lane + 64 * j) * 4;
            const float4 gg = *(const float4*)(gpm + k);
            const float4 gt = *(const float4*)(mods + b * NMODS + 2 * D + k);
            v[j].x += gt.x * (m[j].x * rstd * gg.x); v[j].y += gt.y * (m[j].y * rstd * gg.y);
            v[j].z += gt.z * (m[j].z * rstd * gg.z); v[j].w += gt.w * (m[j].w * rstd * gg.w);
            s1 += v[j].x * v[j].x + v[j].y * v[j].y + v[j].z * v[j].z + v[j].w * v[j].w;
            ((float4*)(x1o + (size_t)t * D) + c.lane)[64 * j] = v[j];
        }
        const float rstd1 = rsqrtf(wave_sum(s1) * (1.0f / D) + 1e-6f);
#pragma unroll
        for (int j = 0; j < 4; ++j) {
            const int k = (c.lane + 64 * j) * 4;
            const float4 gg = *(const float4*)(gpf + k);
            const float4 sh = *(const float4*)(mods + b * NMODS + 3 * D + k);
            const float4 sc = *(const float4*)(mods + b * NMODS + 4 * D + k);
            float r[4];
            r[0] = v[j].x * rstd1 * gg.x * (1.f + sc.x) + sh.x; r[1] = v[j].y * rstd1 * gg.y * (1.f + sc.y) + sh.y;
            r[2] = v[j].z * rstd1 * gg.z * (1.f + sc.z) + sh.z; r[3] = v[j].w * rstd1 * gg.w * (1.f + sc.w) + sh.w;
            unsigned hi[4]; float lo[4];
#pragma unroll
            for (int q = 0; q < 4; ++q) { hi[q] = f2bf(r[q]); lo[q] = r[q] - bf2f(hi[q]); }
            ((uint2*)(h2 + (size_t)t * D) + c.lane)[64 * j] = make_uint2(hi[0] | (hi[1] << 16), hi[2] | (hi[3] << 16));
            ((uint2*)(h2 + (size_t)(T + t) * D) + c.lane)[64 * j] = make_uint2(pk2(lo[0], lo[1]), pk2(lo[2], lo[3]));
        }
    }
}

__device__ __forceinline__ void phase11(const Ctx& c) {
    {
        pg8::Gemm g{(const bf16_t*)(c.ws + WS_A), (const bf16_t*)(c.ws + WS_WR_T), 2 * T, 512, D};
        pg8::StaticOrder S; S.init(2 * T, 512, c.G, c.bid);
        pg8::EpiF32 E{(float*)(c.ws + WS_PLOG), 512};
        pg8::gemm_phase<pg8::EpiF32, pg8::StaticOrder, true, true>(c.lds, g, S, E);
    }
    __syncthreads();
    {
        pg8::Gemm g{(const bf16_t*)(c.ws + WS_A), (const bf16_t*)(c.ws + WS_WSGU_T), T, 512, D};
        pg8::StaticOrder S; S.init(T, 512, c.G, c.bid);
        pg8::EpiSwiGLU E{(bf16_t*)(c.ws + WS_HS), 256};
        pg8::gemm_phase<pg8::EpiSwiGLU, pg8::StaticOrder, true, true>(c.lds, g, S, E);
    }
}

#define DPPU(v, ctrl) ((unsigned)__builtin_amdgcn_mov_dpp((int)(v), (ctrl), 0xf, 0xf, true))
#define DPPF(v, ctrl) __builtin_bit_cast(float, __builtin_amdgcn_mov_dpp(__builtin_bit_cast(int, (v)), (ctrl), 0xf, 0xf, true))
__device__ __forceinline__ unsigned fkey(float f) { const unsigned u = __builtin_bit_cast(unsigned, f); return u ^ ((u >> 31) ? 0xffffffffu : 0x80000000u); }
__device__ __forceinline__ unsigned wave_umax(unsigned v) {
    v = max(v, DPPU(v, 0xB1)); v = max(v, DPPU(v, 0x4E)); v = max(v, DPPU(v, 0x141)); v = max(v, DPPU(v, 0x140));
    const unsigned a = __builtin_amdgcn_readlane(v, 0), b = __builtin_amdgcn_readlane(v, 16), c = __builtin_amdgcn_readlane(v, 32), d = __builtin_amdgcn_readlane(v, 48);
    return max(max(a, b), max(c, d));
}
__device__ __forceinline__ unsigned wave_umin(unsigned v) {
    v = min(v, DPPU(v, 0xB1)); v = min(v, DPPU(v, 0x4E)); v = min(v, DPPU(v, 0x141)); v = min(v, DPPU(v, 0x140));
    const unsigned a = __builtin_amdgcn_readlane(v, 0), b = __builtin_amdgcn_readlane(v, 16), c = __builtin_amdgcn_readlane(v, 32), d = __builtin_amdgcn_readlane(v, 48);
    return min(min(a, b), min(c, d));
}
__device__ __forceinline__ void phase12(const Ctx& c) {
    const float* plog = (const float*)(c.ws + WS_PLOG); const float* rb = c.in[32];
    int* idx = (int*)(c.ws + WS_IDX); float* wt = (float*)(c.ws + WS_WT); unsigned* counts = (unsigned*)(c.ws + WS_COUNTS);
    const int gw = c.bid * 8 + c.wid, NW = c.G * 8, l = c.lane;
    const float4 bias = *(const float4*)(rb + l * 4);
    for (int t = gw; t < T; t += NW) {
        const float4 p0 = *(const float4*)(plog + (size_t)t * 512 + l * 4), p1 = *(const float4*)(plog + (size_t)t * 512 + 256 + l * 4);
        const float4 p2 = *(const float4*)(plog + (size_t)(T + t) * 512 + l * 4), p3 = *(const float4*)(plog + (size_t)(T + t) * 512 + 256 + l * 4);
        const float lg[4] = {p0.x + (p1.x + p2.x + p3.x), p0.y + (p1.y + p2.y + p3.y), p0.z + (p1.z + p2.z + p3.z), p0.w + (p1.w + p2.w + p3.w)};
        float s[4] = {sigmoidf_(lg[0]), sigmoidf_(lg[1]), sigmoidf_(lg[2]), sigmoidf_(lg[3])};
        float ch[4] = {s[0] + bias.x, s[1] + bias.y, s[2] + bias.z, s[3] + bias.w};
        float a1 = fmaxf(ch[0], ch[1]), a2 = fminf(ch[0], ch[1]);
        { const float b1 = fmaxf(ch[2], ch[3]), b2 = fminf(ch[2], ch[3]); const float n1 = fmaxf(a1, b1), n2 = fmaxf(fminf(a1, b1), fmaxf(a2, b2)); a1 = n1; a2 = n2; }
        { const float b1 = DPPF(a1, 0xB1), b2 = DPPF(a2, 0xB1); const float n1 = fmaxf(a1, b1), n2 = fmaxf(fminf(a1, b1), fmaxf(a2, b2)); a1 = n1; a2 = n2; }
        { const float b1 = DPPF(a1, 0x4E), b2 = DPPF(a2, 0x4E); const float n1 = fmaxf(a1, b1), n2 = fmaxf(fminf(a1, b1), fmaxf(a2, b2)); a1 = n1; a2 = n2; }
        { const float b1 = DPPF(a1, 0x141), b2 = DPPF(a2, 0x141); const float n1 = fmaxf(a1, b1), n2 = fmaxf(fminf(a1, b1), fmaxf(a2, b2)); a1 = n1; a2 = n2; }
        const float gs = a1 + a2; const int myg = l >> 3;
        int rank = 0;
#pragma unroll
        for (int g = 0; g < 8; ++g) { const float og = __builtin_bit_cast(float, __builtin_amdgcn_readlane(__builtin_bit_cast(int, gs), g * 8)); rank += (og > gs || (og == gs && g < myg)) ? 1 : 0; }
        const bool sel = rank < 4;
        unsigned mk[4];
#pragma unroll
        for (int i = 0; i < 4; ++i) mk[i] = sel ? fkey(ch[i]) : 0u;
        float sk[8]; int ek[8]; float ssum = 0.f;
#pragma unroll
        for (int k = 0; k < 8; ++k) {
            const unsigned lm = max(max(mk[0], mk[1]), max(mk[2], mk[3]));
            const unsigned m = wave_umax(lm);
            unsigned cand = 1023u;
#pragma unroll
            for (int i = 3; i >= 0; --i) if (mk[i] == m) cand = (unsigned)(l * 4 + i);
            const int be = (int)wave_umin(cand);
            const int ii = be & 3;
            float sv = s[0]; sv = (ii == 1) ? s[1] : sv; sv = (ii == 2) ? s[2] : sv; sv = (ii == 3) ? s[3] : sv;
            sv = __builtin_bit_cast(float, __builtin_amdgcn_readlane(__builtin_bit_cast(int, sv), be >> 2));
            if ((be >> 2) == l) {
#pragma unroll
                for (int i = 0; i < 4; ++i) if (i == ii) mk[i] = 0u;
            }
            sk[k] = sv; ek[k] = be; ssum += sv;
        }
        if (l == 0) {
            const float inv = 2.5f / ssum;
#pragma unroll
            for (int k = 0; k < 8; ++k) { idx[t * 8 + k] = ek[k]; wt[t * 8 + k] = sk[k] * inv; atomicAdd(&counts[ek[k]], 1u); }
        }
    }
}

__device__ __forceinline__ void build_ustart(const Ctx& c, int* smi) {
    const unsigned* counts = (const unsigned*)(c.ws + WS_COUNTS);
    __syncthreads();
    if (c.tid < NE) smi[300 + c.tid] = ((int)counts[c.tid] + 255) >> 8;
    __syncthreads();
    if (c.tid < 64) {
        const int l = c.tid; const int u0 = smi[300 + l * 4], u1 = smi[300 + l * 4 + 1], u2 = smi[300 + l * 4 + 2], u3 = smi[300 + l * 4 + 3];
        const int tot = u0 + u1 + u2 + u3; int inc = tot;
#pragma unroll
        for (int o = 1; o < 64; o <<= 1) { const int v = __shfl_up(inc, o); if (l >= o) inc += v; }
        const int ex = inc - tot;
        smi[l * 4] = ex; smi[l * 4 + 1] = ex + u0; smi[l * 4 + 2] = ex + u0 + u1; smi[l * 4 + 3] = ex + u0 + u1 + u2;
        if (l == 63) smi[NE] = inc;
    }
    __syncthreads();
}

__device__ __forceinline__ void phase13(const Ctx& c) {
    int* smi = (int*)c.sm;
    build_ustart(c, smi);
    const int* idx = (const int*)(c.ws + WS_IDX); int* slotp = (int*)(c.ws + WS_SLOTP); int* uexp = (int*)(c.ws + WS_UEXP);
    unsigned* cursor = (unsigned*)(c.ws + WS_COUNTS) + 256; const unsigned* counts = (const unsigned*)(c.ws + WS_COUNTS);
    const int gt = c.bid * 512 + c.tid, NT = c.G * 512;
    for (int a = gt; a < T * 8; a += NT) {
        const int e = idx[a];
        const unsigned pos = atomicAdd(&cursor[e], 1u);
        slotp[smi[e] * 256 + (int)pos] = a;
    }
    for (int e = gt; e < NE; e += NT) {
        const int u0 = smi[e], u1 = smi[e + 1], cn = (int)counts[e];
        for (int p = cn; p < (u1 - u0) * 256; ++p) slotp[u0 * 256 + p] = -1;
        for (int u = u0; u < u1; ++u) uexp[u] = e;
    }
    if (gt == 0) uexp[2048] = smi[NE];
}

__device__ __forceinline__ void phase14(const Ctx& c) {
    const int* uexp = (const int*)(c.ws + WS_UEXP);
    const int NU = __builtin_amdgcn_readfirstlane(uexp[2048]);
    const int vcu = (c.G % 8 == 0) ? (c.bid % 8) * (c.G / 8) + c.bid / 8 : c.bid;
    pg8::Gemm g{(const bf16_t*)(c.ws + WS_A), (const bf16_t*)(c.ws + WS_WEGU), 0, 0, D, (const int*)(c.ws + WS_SLOTP)};
    pg8::ExpertOrder S{uexp, NU, 2, c.G, vcu};
    pg8::EpiSwiGLU E{(bf16_t*)(c.ws + WS_HID), 256};
    pg8::gemm_phase<pg8::EpiSwiGLU, pg8::ExpertOrder, true, true, true>(c.lds, g, S, E);
}

__device__ __forceinline__ void phase15(const Ctx& c) {
    {
        const int* uexp = (const int*)(c.ws + WS_UEXP);
        const int NU = __builtin_amdgcn_readfirstlane(uexp[2048]);
        const int vcu = (c.G % 8 == 0) ? (c.bid % 8) * (c.G / 8) + c.bid / 8 : c.bid;
        pg8::Gemm g{(const bf16_t*)(c.ws + WS_HID), (const bf16_t*)(c.ws + WS_WED), 0, 0, EFF};
        pg8::ExpertOrder S{uexp, NU, 4, c.G, vcu};
        pg8::EpiScatter E{(const int*)(c.ws + WS_SLOTP), (const float*)(c.ws + WS_WT), (bf16_t*)(c.ws + WS_YEXP), D};
        pg8::gemm_phase<pg8::EpiScatter, pg8::ExpertOrder, true, true>(c.lds, g, S, E);
    }
    __syncthreads();
    {
        pg8::Gemm g{(const bf16_t*)(c.ws + WS_HS), (const bf16_t*)(c.ws + WS_WSD_T), T, D, 256};
        pg8::StaticOrder S; S.init(T, D, c.G, c.bid);
        pg8::EpiF32 E{(float*)(c.ws + WS_SHOUT), D};
        pg8::gemm_phase<pg8::EpiF32, pg8::StaticOrder, true, true>(c.lds, g, S, E);
    }
}

__device__ __forceinline__ void phase16(const Ctx& c) {
    const float* gq = c.in[7]; const float* mods = (const float*)(c.ws + WS_MODS);
    const float* shout = (const float*)(c.ws + WS_SHOUT); const bf16_t* yexp = (const bf16_t*)(c.ws + WS_YEXP);
    float* out = c.out;
    const int gw = c.bid * 8 + c.wid, NW = c.G * 8;
    for (int t = gw; t < T; t += NW) {
        const int b = t / SEQ;
        float4 y[4]; float ss = 0.f;
#pragma unroll
        for (int j = 0; j < 4; ++j) {
            const int k = (c.lane + 64 * j) * 4;
            float4 a = *(const float4*)(shout + (size_t)t * D + k);
#pragma unroll
            for (int q = 0; q < 8; ++q) {
                const float4 v = ldbf4(yexp + (size_t)(t * 8 + q) * D + k);
                a.x += v.x; a.y += v.y; a.z += v.z; a.w += v.w;
            }
            y[j] = a; ss += a.x * a.x + a.y * a.y + a.z * a.z + a.w * a.w;
        }
        const float rstd = rsqrtf(wave_sum(ss) * (1.0f / D) + 1e-6f);
#pragma unroll
        for (int j = 0; j < 4; ++j) {
            const int k = (c.lane + 64 * j) * 4;
            const float4 gg = *(const float4*)(gq + k);
            const float4 gt = *(const float4*)(mods + b * NMODS + 5 * D + k);
            float4 x1 = *(const float4*)(out + (size_t)t * D + k);
            x1.x += gt.x * (y[j].x * rstd * gg.x); x1.y += gt.y * (y[j].y * rstd * gg.y);
            x1.z += gt.z * (y[j].z * rstd * gg.z); x1.w += gt.w * (y[j].w * rstd * gg.w);
            *(float4*)(out + (size_t)t * D + k) = x1;
        }
    }
}

constexpr int NPHASES = 18;

__global__ void __launch_bounds__(512, 2) mega(Args args) {
    extern __shared__ __attribute__((aligned(16))) unsigned char lds_raw[];
    Ctx c;
    c.in = args.in; c.out = args.out; c.ws = args.ws;
    c.lds = (LAS unsigned char*)lds_raw; c.sm = (float*)lds_raw;
    c.tid = threadIdx.x; c.lane = c.tid & 63; c.wid = __builtin_amdgcn_readfirstlane(c.tid >> 6); c.bid = blockIdx.x; c.G = gridDim.x;
    volatile LAS unsigned* st = (volatile LAS unsigned*)(c.lds + LDS_CTL_OFF);
    if (c.tid < 4) st[c.tid] = 0u;
    __syncthreads();
    XcdBarrier bar; bar.bar = (unsigned*)(args.ws + WS_CTL); bar.x = 0; bar.st = st;
    const bool multi = (args.hi - args.lo) > 1;
    if (multi) bar = xcd_barrier_post((unsigned*)(args.ws + WS_CTL), st);
    const int lo = args.lo, hi = args.hi;
#ifndef REPEAT_PHASE
#define REPEAT_PHASE -1
#endif
#define RUN_PHASE(k, call) if (lo <= (k) && (k) < hi) { if ((k) == REPEAT_PHASE) { call; xcd_barrier(bar); } call; if ((k) + 1 < hi) xcd_barrier(bar); }
    RUN_PHASE(0, phase0(c))
    RUN_PHASE(1, phase1(c))
    RUN_PHASE(2, phase2(c))
    RUN_PHASE(3, phase3(c))
    RUN_PHASE(4, phase4(c))
    RUN_PHASE(5, phase5(c))
    RUN_PHASE(6, phase6a(c))
    RUN_PHASE(7, phase6b(c))
    RUN_PHASE(8, phase7(c))
    RUN_PHASE(9, phase8(c))
    RUN_PHASE(10, phase9(c))
    RUN_PHASE(11, phase10(c))
    RUN_PHASE(12, phase11(c))
    RUN_PHASE(13, phase12(c))
    RUN_PHASE(14, phase13(c))
    RUN_PHASE(15, phase14(c))
    RUN_PHASE(16, phase15(c))
    RUN_PHASE(17, phase16(c))
#undef RUN_PHASE
}

#ifndef N_LAUNCH_MODE
#define N_LAUNCH_MODE 1
#endif

extern "C" void kernel_launch(void* const* d_in, const int* in_sizes, int n_in, void* d_out, int out_size, void* d_ws, size_t ws_size, hipStream_t stream) {
    static int grid = 0;
    if (grid == 0) {
        if (n_in != 39 || out_size != T * D || ws_size < WS_END) { fprintf(stderr, "kernel_launch: unexpected shapes n_in %d out %d ws %zu\n", n_in, out_size, ws_size); grid = -1; return; }
        int dev = 0, cus = 0, per_cu = 0;
        if (hipGetDevice(&dev) != hipSuccess || hipDeviceGetAttribute(&cus, hipDeviceAttributeMultiprocessorCount, dev) != hipSuccess) { grid = -1; return; }
        if (hipFuncSetAttribute((const void*)mega, hipFuncAttributeMaxDynamicSharedMemorySize, LDS_BYTES) != hipSuccess) { grid = -1; return; }
        if (hipOccupancyMaxActiveBlocksPerMultiprocessor(&per_cu, (const void*)mega, 512, LDS_BYTES) != hipSuccess || per_cu < 1) { fprintf(stderr, "kernel_launch: occupancy query says %d\n", per_cu); }
        (void)hipGetLastError();
        grid = cus;
    }
    if (grid < 0) return;
    (void)hipMemsetAsync((char*)d_ws + WS_CTL, 0, CTL_BYTES, stream);
    Args a{};
    for (int i = 0; i < 39; ++i) a.in[i] = (const float*)d_in[i];
    a.out = (float*)d_out; a.ws = (unsigned char*)d_ws;
    if (N_LAUNCH_MODE == 1) {
        a.lo = 0; a.hi = NPHASES;
        hipLaunchKernelGGL(mega, dim3(grid), dim3(512), LDS_BYTES, stream, a);
    } else {
        for (int ph = 0; ph < NPHASES; ++ph) {
            a.lo = ph; a.hi = ph + 1;
            hipLaunchKernelGGL(mega, dim3(grid), dim3(512), LDS_BYTES, stream, a);
        }
    }
}
```

```cpp
#include <hip/hip_runtime.h>
#include <cstdint>
#include <cstdio>

#define LAS __attribute__((address_space(3)))

constexpr int D = 1024, BATCH = 4, SEQ = 8192, T = BATCH * SEQ;
constexpr int RW = 512, NH = 8;
constexpr int RPROJ = 1792, NPROJ = 2304;
constexpr int S5NG = 32, S5P = 64;
constexpr int NE = 256, EFF = 256;
constexpr int NMODS = 6 * D;
constexpr int S5L = 32;

constexpr size_t MiB = 1u << 20;
constexpr size_t WS_CTL = 0, CTL_BYTES = 1 * MiB;
constexpr size_t WS_COUNTS = 64 * 1024;
constexpr size_t WS_MODS = 1 * MiB;
constexpr size_t WS_HMAT = 2 * MiB;
constexpr size_t WS_WIN_T = 12 * MiB;
constexpr size_t WS_WOUT_T = 17 * MiB;
constexpr size_t WS_WGLU_T = 19 * MiB;
constexpr size_t WS_WSGU_T = 19 * MiB + 512 * 1024;
constexpr size_t WS_WSD_T = 20 * MiB + 512 * 1024;
constexpr size_t WS_WR_T = 21 * MiB;
constexpr size_t WS_LORA_BT = 22 * MiB;
constexpr size_t WS_APOW = 23 * MiB;
constexpr size_t WS_KMAT = 1000 * MiB;
constexpr size_t WS_MODSP = 1020 * MiB;
constexpr size_t WS_S5BB = 1022 * MiB;
constexpr size_t WS_KLAG = 1022 * MiB + 512 * 1024;
constexpr size_t OUT_UX = 0;
constexpr size_t OUT_E = 40 * MiB;
constexpr size_t OUT_ALORA = 56 * MiB;
constexpr size_t WS_WED = 24 * MiB;
constexpr size_t WS_WEGU = 152 * MiB;
constexpr size_t WS_A = 408 * MiB;
constexpr size_t WS_YS5 = WS_A + 64 * MiB;
constexpr size_t WS_PROJ = 536 * MiB;
constexpr size_t WS_RW = 680 * MiB;
constexpr size_t RWSZ = (size_t)T * RW * 4;
constexpr size_t RWSZH = (size_t)T * RW * 2;
constexpr size_t WS_RW_W = WS_RW, WS_RW_Y = WS_RW + RWSZ, WS_RW_R = WS_RW + 2 * RWSZ, WS_RW_K = WS_RW_R + RWSZH, WS_RW_V = WS_RW_K + RWSZH,
                 WS_RW_A = WS_RW_V + RWSZH, WS_RW_B = WS_RW_A + RWSZH, WS_RW_G = WS_RW_B + RWSZH;
constexpr size_t WS_CM = WS_PROJ, WS_CN = WS_PROJ + 32 * MiB, WS_CQ = WS_PROJ + 64 * MiB, WS_CY = WS_PROJ + 96 * MiB;
constexpr size_t WS_CS = WS_RW_Y, WS_CBON = WS_RW_Y + 32 * MiB;
constexpr size_t WS_PLOG = 680 * MiB;
constexpr size_t WS_SHOUT = 680 * MiB;
constexpr size_t WS_HS = 808 * MiB;
constexpr size_t WS_IDX = 824 * MiB;
constexpr size_t WS_WT = 825 * MiB;
constexpr size_t WS_SLOTP = 826 * MiB;
constexpr size_t WS_UEXP = 827 * MiB + 512 * 1024;
constexpr size_t WS_HID = 840 * MiB;
constexpr size_t WS_YEXP = 152 * MiB;
constexpr size_t WS_END = 1023 * MiB + 512 * 1024;

constexpr int LDS_BYTES = 132096;
constexpr int LDS_CTL_OFF = 131072;

#define XB_TMO      128
#define XB_XCNT(j)  (256  + 64 * (j))
#define XB_XSUB(j)  (1280 + 64 * (j))
#define XB_XGEN(j)  (2304 + 64 * (j))
#define XB_TOP      3328
#define XB_TOPGEN   3392
#define XCD_BAR_WORDS 3456
#define XB_SPIN_CAP (1u << 24)

__device__ __forceinline__ unsigned xb_ld(unsigned* p)              { return __hip_atomic_load(p, __ATOMIC_RELAXED, __HIP_MEMORY_SCOPE_AGENT); }
__device__ __forceinline__ unsigned xb_add(unsigned* p, unsigned v) { return __hip_atomic_fetch_add(p, v, __ATOMIC_RELAXED, __HIP_MEMORY_SCOPE_AGENT); }
__device__ __forceinline__ unsigned xb_xcc_id() { return (unsigned)__builtin_amdgcn_s_getreg((3 << 11) | 20) & 0xFu; }
#define XB_SPIN(cond, bar) do { unsigned _sp = 0; while (cond) { __builtin_amdgcn_s_sleep(1); \
    if ((++_sp & 255u) == 0u) { if (xb_ld(&(bar)[XB_TMO])) break; if (_sp > XB_SPIN_CAP) { atomicAdd(&(bar)[XB_TMO], 1u); break; } } } } while (0)

struct XcdBarrier { unsigned* bar; unsigned x; volatile LAS unsigned* st; };

__device__ __forceinline__ XcdBarrier xcd_barrier_post(unsigned* bar, volatile LAS unsigned* st) {
    XcdBarrier b; b.bar = bar; b.x = xb_xcc_id(); b.st = st;
    if (threadIdx.x == 0) (void)xb_add(&bar[XB_XCNT(b.x)], 1u);
    return b;
}
__device__ __forceinline__ void xcd_barrier_complete(unsigned* bar, unsigned x, unsigned& nloc, unsigned& nx) {
    const unsigned G = gridDim.x * gridDim.y * gridDim.z;
    unsigned sum, cnt, mine, sp = 0u;
    for (;;) {
        sum = 0u; cnt = 0u; mine = 0u;
#pragma unroll
        for (unsigned j = 0; j < 16; ++j) { const unsigned c = xb_ld(&bar[XB_XCNT(j)]); sum += c; cnt += (c > 0u) ? 1u : 0u; mine = (j == x) ? c : mine; }
        if (sum == G) break;
        __builtin_amdgcn_s_sleep(1);
        if ((++sp & 255u) == 0u) { if (xb_ld(&bar[XB_TMO])) break; if (sp > XB_SPIN_CAP) { atomicAdd(&bar[XB_TMO], 1u); break; } }
    }
    nloc = mine > 0u ? mine : 1u; nx = cnt > 0u ? cnt : 1u;
}
__device__ __forceinline__ void xcd_barrier(const XcdBarrier& b) {
    asm volatile("s_waitcnt vmcnt(0)" ::: "memory");
    __syncthreads();
    if (threadIdx.x == 0) {
        unsigned* bar = b.bar;
        __builtin_amdgcn_s_waitcnt(0);
        unsigned nloc = b.st[0], nx = b.st[1];
        if (nloc == 0u) { xcd_barrier_complete(bar, b.x, nloc, nx); b.st[0] = nloc; b.st[1] = nx; }
        const unsigned old = xb_add(&bar[XB_XSUB(b.x)], 1u);
        const unsigned gen = old / nloc;
        if (old + 1u == (gen + 1u) * nloc) {
            __builtin_amdgcn_fence(__ATOMIC_RELEASE, "agent");
            asm volatile("s_waitcnt vmcnt(0)" ::: "memory");
            const unsigned og = xb_add(&bar[XB_TOP], 1u);
            const unsigned tg = og / nx;
            if (og + 1u == (tg + 1u) * nx) xb_add(&bar[XB_TOPGEN], 1u);
            else XB_SPIN(xb_ld(&bar[XB_TOPGEN]) == tg, bar);
            __builtin_amdgcn_fence(__ATOMIC_ACQUIRE, "agent");
            xb_add(&bar[XB_XGEN(b.x)], 1u);
            asm volatile("s_waitcnt vmcnt(0)" ::: "memory");
        } else {
            XB_SPIN(xb_ld(&bar[XB_XGEN(b.x)]) == gen, bar);
            __builtin_amdgcn_fence(__ATOMIC_ACQUIRE, "agent");
            asm volatile("s_waitcnt vmcnt(0)" ::: "memory");
        }
    }
    __syncthreads();
}

namespace pg8 {
#define PG8_LAS __attribute__((address_space(3)))
typedef unsigned short bf16_t;
typedef short bf16x8 __attribute__((ext_vector_type(8)));
typedef float f32x4 __attribute__((ext_vector_type(4)));
typedef unsigned u32x4 __attribute__((ext_vector_type(4)));
constexpr int BM = 256, BK = 64, HALF = 128, HTB = HALF * BK * 2  , STAGE_BYTES = 8 * HTB, NXCD = 8, WGM = 8;

__host__ __device__ __forceinline__ int lds_byte(int r, int c) { const int st = (r >> 4) * 2 + (c >> 5), rr = r & 15, cc = c & 31, ob = rr * 64 + cc * 2; return st * 1024 + (ob ^ (((ob >> 9) & 1) << 5)); }
__host__ __device__ __forceinline__ void stage_rc(int b, int& R, int& C) { const int st = b / 1024, sb = b % 1024, swz = sb ^ (((sb >> 9) & 1) << 5); R = (st >> 1) * 16 + swz / 64; C = (st & 1) * 32 + (swz % 64) / 2; }
__host__ __device__ __forceinline__ int perm32(int rho) { const int n = rho >> 4, i = rho & 15; return 8 * (i >> 2) + 4 * n + (i & 3); }

struct Unit { int pm, pn; };
struct Gemm { const bf16_t* A; const bf16_t* Bt; int M, N, K; const int* rowtab = nullptr; };

struct StaticOrder {
    int nM, nN, nwg, G, c;
    __host__ __device__ void init(int M, int N, int G_, int c_) { nM = M / BM; nN = N / BM; nwg = nM * nN; G = G_; c = c_; }
    __host__ __device__ bool next(int i, Unit& u) const {
        const long L = (long)i * G + c; if (L >= nwg) return false;
        int wgid = (int)L; { const int q = nwg / NXCD, r = nwg % NXCD, xcd = wgid % NXCD, off = wgid / NXCD; wgid = (xcd < r ? xcd * (q + 1) : r * (q + 1) + (xcd - r) * q) + off; }
        const int nig = WGM * nN, gid = wgid / nig, fm = gid * WGM, gsz = (nM - fm) < WGM ? (nM - fm) : WGM;
        u.pm = fm + ((wgid % nig) % gsz); u.pn = (wgid % nig) / gsz; return true;
    }
    __device__ __forceinline__ void a_ready(const Unit&) const {}
    __device__ __forceinline__ void done(const Unit&) const {}
};

__device__ __forceinline__ unsigned cvt_pk_bf16(float lo, float hi) { unsigned r; asm volatile("v_cvt_pk_bf16_f32 %0, %1, %2" : "=v"(r) : "v"(lo), "v"(hi)); return r; }
typedef float f32x2 __attribute__((ext_vector_type(2)));
__device__ __forceinline__ f32x2 gelu_pk(f32x2 v) {
    const f32x2 av = __builtin_elementwise_abs(v), d = av * 0.2316418882f + 1.0f;
    f32x2 t; t.x = __builtin_amdgcn_rcpf(d.x); t.y = __builtin_amdgcn_rcpf(d.y);
    f32x2 q = t * 0.5307027145f + (-0.7265760135f); q = q * t + 0.7107068705f; q = q * t + (-0.142248368f); q = q * t + 0.127414796f; q = q * t;
    const f32x2 s = (v * v) * (-0.72134752044f);
    f32x2 e; e.x = __builtin_amdgcn_exp2f(s.x); e.y = __builtin_amdgcn_exp2f(s.y);
    const f32x2 m = v * (q * e), r = v - m;
    f32x2 o; o.x = v.x < 0.f ? m.x : r.x; o.y = v.y < 0.f ? m.y : r.y; return o;
}

template <int ACT  > struct EpiBf16 {
    static constexpr bool PERM = true, AFTER_DRAIN = false; static_assert(ACT == 0 || ACT == 1, "EpiBf16: ACT is 0 (none) or 1 (gelu_pk)");
    bf16_t* O; int ldc; const float* bias; int split_cols; size_t split_stride; float scale0;
    __device__ __forceinline__ void operator()(const f32x4 (&acc)[2][2][4][2], const Unit& u, int wr, int wc, int fr, int fq) const {
        const int row0 = u.pm * BM + wr * 64 + fr; int colt = u.pn * BM; bf16_t* base = O;
        float sc = 1.f; if (split_cols) { const int t = colt / split_cols; base += (size_t)t * split_stride; colt -= t * split_cols; if (t == 0) sc = scale0; }
        const int col0 = colt + wc * 32 + 8 * fq, bcol0 = u.pn * BM + wc * 32 + 8 * fq;
        f32x4 bv[2][2];
#pragma unroll
        for (int bj = 0; bj < 2; ++bj)
#pragma unroll
            for (int n = 0; n < 2; ++n) bv[bj][n] = bias ? *(const f32x4*)(bias + bcol0 + bj * HALF + 4 * n) : (f32x4){0.f, 0.f, 0.f, 0.f};
#pragma unroll
        for (int ai = 0; ai < 2; ++ai)
#pragma unroll
            for (int m = 0; m < 4; ++m) { bf16_t* rowp = base + (size_t)(row0 + ai * HALF + m * 16) * ldc + col0;
#pragma unroll
                for (int bj = 0; bj < 2; ++bj) { f32x4 v0 = acc[ai][bj][m][0] + bv[bj][0], v1 = acc[ai][bj][m][1] + bv[bj][1];
                    if (ACT == 1) { f32x2 a = gelu_pk((f32x2){v0[0], v0[1]}), b = gelu_pk((f32x2){v0[2], v0[3]}), c = gelu_pk((f32x2){v1[0], v1[1]}), d = gelu_pk((f32x2){v1[2], v1[3]});
                        v0 = (f32x4){a.x, a.y, b.x, b.y}; v1 = (f32x4){c.x, c.y, d.x, d.y}; }
                    v0 = v0 * sc; v1 = v1 * sc; u32x4 w; w.x = cvt_pk_bf16(v0[0], v0[1]); w.y = cvt_pk_bf16(v0[2], v0[3]); w.z = cvt_pk_bf16(v1[0], v1[1]); w.w = cvt_pk_bf16(v1[2], v1[3]);
                    *(u32x4*)(rowp + bj * HALF) = w; } }
    }
};

struct EpiF32 {
    static constexpr bool PERM = false, AFTER_DRAIN = false;
    float* C; int ldc;
    __device__ __forceinline__ void operator()(const f32x4 (&acc)[2][2][4][2], const Unit& u, int wr, int wc, int fr, int fq) const {
        const int row0 = u.pm * BM + wr * 64 + fr, col0 = u.pn * BM + wc * 32 + 4 * fq;
#pragma unroll
        for (int ai = 0; ai < 2; ++ai)
#pragma unroll
            for (int m = 0; m < 4; ++m) { float* rowp = C + (size_t)(row0 + ai * HALF + m * 16) * ldc + col0;
#pragma unroll
                for (int bj = 0; bj < 2; ++bj)
#pragma unroll
                    for (int n = 0; n < 2; ++n) *(f32x4*)(rowp + bj * HALF + n * 16) = acc[ai][bj][m][n]; }
    }
};
__device__ __forceinline__ float fast_sigmoid(float x) { return __builtin_amdgcn_rcpf(1.0f + __builtin_amdgcn_exp2f(-1.4426950408889634f * x)); }
struct EpiSwiGLU {
    static constexpr bool PERM = true, AFTER_DRAIN = false;
    bf16_t* O; int ldo;
    __device__ __forceinline__ void operator()(const f32x4 (&acc)[2][2][4][2], const Unit& u, int wr, int wc, int fr, int fq) const {
        const int row0 = u.pm * BM + wr * 64 + fr, col0 = (u.pn & 1) * HALF + wc * 32 + 8 * fq;
#pragma unroll
        for (int ai = 0; ai < 2; ++ai)
#pragma unroll
            for (int m = 0; m < 4; ++m) {
                bf16_t* rowp = O + (size_t)(row0 + ai * HALF + m * 16) * ldo + col0;
                const f32x4 g0 = acc[ai][0][m][0], g1 = acc[ai][0][m][1], u0 = acc[ai][1][m][0], u1 = acc[ai][1][m][1];
                float r[8];
#pragma unroll
                for (int i = 0; i < 4; ++i) { r[i] = g0[i] * fast_sigmoid(g0[i]) * u0[i]; r[4 + i] = g1[i] * fast_sigmoid(g1[i]) * u1[i]; }
                u32x4 w; w.x = cvt_pk_bf16(r[0], r[1]); w.y = cvt_pk_bf16(r[2], r[3]); w.z = cvt_pk_bf16(r[4], r[5]); w.w = cvt_pk_bf16(r[6], r[7]);
                *(u32x4*)rowp = w;
            }
    }
};
struct EpiScatter {
    static constexpr bool PERM = true, AFTER_DRAIN = false;
    const int* slotp; const float* wt; bf16_t* Y; int ldy;
    __device__ __forceinline__ void operator()(const f32x4 (&acc)[2][2][4][2], const Unit& u, int wr, int wc, int fr, int fq) const {
        int t2 = threadIdx.x; asm volatile("" : "+v"(t2));
        const int fr2 = t2 & 15, fq2 = (t2 >> 4) & 3, wc2 = (t2 >> 6) & 3, wr2 = (t2 >> 8) & 1;
        const int col0 = (u.pn & 3) * BM + wc2 * 32 + 8 * fq2;
        const int rbase = u.pm * BM + wr2 * 64 + fr2;
#pragma unroll
        for (int ai = 0; ai < 2; ++ai)
#pragma unroll
            for (int m = 0; m < 4; ++m) {
                const int aid = slotp[rbase + ai * HALF + m * 16];
                if (aid >= 0) {
                    const float w = wt[aid];
                    bf16_t* rowp = Y + (size_t)aid * ldy + col0;
#pragma unroll
                    for (int bj = 0; bj < 2; ++bj) {
                        const f32x4 v0 = acc[ai][bj][m][0] * w, v1 = acc[ai][bj][m][1] * w;
                        u32x4 o; o.x = cvt_pk_bf16(v0[0], v0[1]); o.y = cvt_pk_bf16(v0[2], v0[3]); o.z = cvt_pk_bf16(v1[0], v1[1]); o.w = cvt_pk_bf16(v1[2], v1[3]);
                        *(u32x4*)(rowp + bj * HALF) = o;
                    }
                }
            }
    }
};
struct ExpertOrder {
    const int* uexp; int NU, npn, G, c;
    __device__ __forceinline__ bool next(int i, Unit& u) const {
        const int L = i * G + c; if (L >= NU * npn) return false;
        const int uu = L / npn, pl = L % npn;
        u.pm = uu; u.pn = __builtin_amdgcn_readfirstlane(uexp[uu]) * npn + pl; return true;
    }
    __device__ __forceinline__ void a_ready(const Unit&) const {}
    __device__ __forceinline__ void done(const Unit&) const {}
};
struct S5Order {
    int NUNITS, npn, G, c;
    __device__ __forceinline__ bool next(int i, Unit& u) const {
        const int L = i * G + c; if (L >= NUNITS) return false;
        u.pm = L / npn; u.pn = (u.pm >> 2) * npn + L % npn; return true;
    }
    __device__ __forceinline__ void a_ready(const Unit&) const {}
    __device__ __forceinline__ void done(const Unit&) const {}
};
struct EpiS5E {
    static constexpr bool PERM = false, AFTER_DRAIN = false;
    float* E;
    __device__ __forceinline__ void operator()(const f32x4 (&acc)[2][2][4][2], const Unit& u, int wr, int wc, int fr, int fq) const {
        const int row0 = u.pm * BM + wr * 64 + fr, col0 = wc * 32 + 4 * fq;
#pragma unroll
        for (int ai = 0; ai < 2; ++ai)
#pragma unroll
            for (int m = 0; m < 4; ++m) { float* rowp = E + (size_t)(row0 + ai * HALF + m * 16) * 128 + col0;
#pragma unroll
                for (int n = 0; n < 2; ++n) *(f32x4*)(rowp + n * 16) = acc[ai][0][m][n]; }
    }
};
struct EpiS5Out {
    static constexpr bool PERM = true, AFTER_DRAIN = false;
    bf16_t* Y;
    __device__ __forceinline__ void operator()(const f32x4 (&acc)[2][2][4][2], const Unit& u, int wr, int wc, int fr, int fq) const {
        const int g = u.pm >> 2;
#pragma unroll
        for (int ai = 0; ai < 2; ++ai)
#pragma unroll
            for (int m = 0; m < 4; ++m) {
                const int r = (u.pm & 3) * BM + ai * HALF + wr * 64 + m * 16 + fr, b = r >> 8, chunk = r & 255;
#pragma unroll
                for (int bj = 0; bj < 2; ++bj) {
                    const int colg = (u.pn & 1) * BM + bj * HALF + wc * 32 + 8 * fq, t = colg >> 4, c0 = colg & 15;
                    const f32x4 v0 = acc[ai][bj][m][0], v1 = acc[ai][bj][m][1];
                    float x[8] = {v0[0], v0[1], v0[2], v0[3], v1[0], v1[1], v1[2], v1[3]};
#pragma unroll
                    for (int i = 0; i < 8; ++i) { const float z = x[i]; x[i] = z * fast_sigmoid(1.5957691216057308f * (z + 0.044715f * z * z * z)); }
                    u32x4 w; w.x = cvt_pk_bf16(x[0], x[1]); w.y = cvt_pk_bf16(x[2], x[3]); w.z = cvt_pk_bf16(x[4], x[5]); w.w = cvt_pk_bf16(x[6], x[7]);
                    *(u32x4*)(Y + ((size_t)(b * 8192 + chunk * 32 + t)) * 512 + g * 16 + c0) = w;
                }
            }
    }
};
struct EpiLora {
    static constexpr bool PERM = true, AFTER_DRAIN = false;
    const float* w0; const float* a0; const float* k_a; float* W; bf16_t* Kp; const bf16_t* A; bf16_t* B; bf16_t* Gt;
    __device__ __forceinline__ void operator()(const f32x4 (&acc)[2][2][4][2], const Unit& u, int wr, int wc, int fr, int fq) const {
        const int seg = u.pn >> 1;
#pragma unroll
        for (int bj = 0; bj < 2; ++bj) {
            const int nn = (u.pn & 1) * BM + bj * HALF + wc * 32 + 8 * fq;
            float p0[8], p1[8];
            if (seg == 0) { const f32x4 a = *(const f32x4*)(w0 + nn), b = *(const f32x4*)(w0 + nn + 4); p0[0] = a[0]; p0[1] = a[1]; p0[2] = a[2]; p0[3] = a[3]; p0[4] = b[0]; p0[5] = b[1]; p0[6] = b[2]; p0[7] = b[3]; }
            else if (seg == 1) { const f32x4 a = *(const f32x4*)(a0 + nn), b = *(const f32x4*)(a0 + nn + 4), cc = *(const f32x4*)(k_a + nn), d = *(const f32x4*)(k_a + nn + 4);
                p0[0] = a[0]; p0[1] = a[1]; p0[2] = a[2]; p0[3] = a[3]; p0[4] = b[0]; p0[5] = b[1]; p0[6] = b[2]; p0[7] = b[3];
                p1[0] = cc[0]; p1[1] = cc[1]; p1[2] = cc[2]; p1[3] = cc[3]; p1[4] = d[0]; p1[5] = d[1]; p1[6] = d[2]; p1[7] = d[3]; }
#pragma unroll
            for (int ai = 0; ai < 2; ++ai)
#pragma unroll
                for (int m = 0; m < 4; ++m) {
                    const size_t off = (size_t)(u.pm * BM + ai * HALF + wr * 64 + m * 16 + fr) * 512 + nn;
                    const f32x4 v0 = acc[ai][bj][m][0], v1 = acc[ai][bj][m][1];
                    const float x[8] = {v0[0], v0[1], v0[2], v0[3], v1[0], v1[1], v1[2], v1[3]};
                    if (seg == 0) {
                        float o[8];
#pragma unroll
                        for (int i = 0; i < 8; ++i) { const float wa = p0[i] + x[i];
                            const float sp = __logf(1.0f + __expf(-wa));
                            o[i] = __expf(-__expf(-sp - 0.5f)); }
                        *(f32x4*)(W + off) = (f32x4){o[0], o[1], o[2], o[3]}; *(f32x4*)(W + off + 4) = (f32x4){o[4], o[5], o[6], o[7]};
                    } else if (seg == 1) {
                        const u32x4 kv = *(const u32x4*)(Kp + off), av = *(const u32x4*)(A + off);
                        const float k[8] = {__builtin_bit_cast(float, kv.x << 16), __builtin_bit_cast(float, kv.x & 0xffff0000u), __builtin_bit_cast(float, kv.y << 16), __builtin_bit_cast(float, kv.y & 0xffff0000u),
                                            __builtin_bit_cast(float, kv.z << 16), __builtin_bit_cast(float, kv.z & 0xffff0000u), __builtin_bit_cast(float, kv.w << 16), __builtin_bit_cast(float, kv.w & 0xffff0000u)};
                        const float a[8] = {__builtin_bit_cast(float, av.x << 16), __builtin_bit_cast(float, av.x & 0xffff0000u), __builtin_bit_cast(float, av.y << 16), __builtin_bit_cast(float, av.y & 0xffff0000u),
                                            __builtin_bit_cast(float, av.z << 16), __builtin_bit_cast(float, av.z & 0xffff0000u), __builtin_bit_cast(float, av.w << 16), __builtin_bit_cast(float, av.w & 0xffff0000u)};
                        float kf[8], bo[8];
#pragma unroll
                        for (int i = 0; i < 8; ++i) { const float ic = fast_sigmoid(p0[i] + x[i]); kf[i] = k[i] * (1.0f + (ic - 1.0f) * p1[i]); bo[i] = -a[i] * ic; }
                        u32x4 w; w.x = cvt_pk_bf16(kf[0], kf[1]); w.y = cvt_pk_bf16(kf[2], kf[3]); w.z = cvt_pk_bf16(kf[4], kf[5]); w.w = cvt_pk_bf16(kf[6], kf[7]);
                        *(u32x4*)(Kp + off) = w;
                        w.x = cvt_pk_bf16(bo[0], bo[1]); w.y = cvt_pk_bf16(bo[2], bo[3]); w.z = cvt_pk_bf16(bo[4], bo[5]); w.w = cvt_pk_bf16(bo[6], bo[7]);
                        *(u32x4*)(B + off) = w;
                    } else {
                        u32x4 w; w.x = cvt_pk_bf16(x[0], x[1]); w.y = cvt_pk_bf16(x[2], x[3]); w.z = cvt_pk_bf16(x[4], x[5]); w.w = cvt_pk_bf16(x[6], x[7]);
                        *(u32x4*)(Gt + off) = w;
                    }
                }
        }
    }
};
struct EpiGLU {
    static constexpr bool PERM = true, AFTER_DRAIN = false;
    const bf16_t* Y; int ldy; const float* bias; bf16_t* O; int ldo; int ocol0;
    __device__ __forceinline__ void operator()(const f32x4 (&acc)[2][2][4][2], const Unit& u, int wr, int wc, int fr, int fq) const {
        const int row0 = u.pm * BM + wr * 64 + fr, col0 = u.pn * BM + wc * 32 + 8 * fq;
#pragma unroll
        for (int bj = 0; bj < 2; ++bj) {
            const f32x4 b0 = *(const f32x4*)(bias + col0 + bj * HALF), b1 = *(const f32x4*)(bias + col0 + bj * HALF + 4);
#pragma unroll
            for (int ai = 0; ai < 2; ++ai)
#pragma unroll
                for (int m = 0; m < 4; ++m) {
                    const size_t row = (size_t)(row0 + ai * HALF + m * 16);
                    const u32x4 yv = *(const u32x4*)(Y + row * ldy + col0 + bj * HALF);
                    const f32x4 z0 = acc[ai][bj][m][0] + b0, z1 = acc[ai][bj][m][1] + b1;
                    float y[8] = {__builtin_bit_cast(float, yv.x << 16), __builtin_bit_cast(float, yv.x & 0xffff0000u), __builtin_bit_cast(float, yv.y << 16), __builtin_bit_cast(float, yv.y & 0xffff0000u),
                                  __builtin_bit_cast(float, yv.z << 16), __builtin_bit_cast(float, yv.z & 0xffff0000u), __builtin_bit_cast(float, yv.w << 16), __builtin_bit_cast(float, yv.w & 0xffff0000u)};
                    float r[8];
#pragma unroll
                    for (int i = 0; i < 4; ++i) { r[i] = y[i] * fast_sigmoid(z0[i]); r[4 + i] = y[4 + i] * fast_sigmoid(z1[i]); }
                    u32x4 w; w.x = cvt_pk_bf16(r[0], r[1]); w.y = cvt_pk_bf16(r[2], r[3]); w.z = cvt_pk_bf16(r[4], r[5]); w.w = cvt_pk_bf16(r[6], r[7]);
                    *(u32x4*)(O + row * ldo + ocol0 + col0 + bj * HALF) = w;
                }
        }
    }
};
template <class Epi, class Sched, bool ALIGN_EPI = false, bool SP2 = false, bool GATHER = false>
__device__ __forceinline__ void gemm_phase(PG8_LAS unsigned char* lds, const Gemm g, const Sched& S, const Epi& E) {
    int tid_ = threadIdx.x; asm volatile("" : "+v"(tid_));
    const int tid = tid_, wid = __builtin_amdgcn_readfirstlane(tid >> 6), lane = tid & 63, wr = wid >> 2, wc = wid & 3, fr = lane & 15, fq = lane >> 4;
    const int K = g.K, nt = K / BK;
    unsigned voffA[2], voffB[2];
#pragma unroll
    for (int i = 0; i < 2; ++i) { int R, C; stage_rc(tid * 16 + i * 8192, R, C); const int Rb = Epi::PERM ? ((R & ~31) + perm32(R & 31)) : R;
        voffA[i] = (unsigned)(R * K + C) * 2u; voffB[i] = (unsigned)(Rb * K + C) * 2u; }
    const size_t kstep = (size_t)(BK * 2);
    const size_t hstep = (size_t)HALF * K * 2;
    const size_t tstep = 2 * hstep;
    const unsigned ldsw = (unsigned)wid * 1024u;
    const int aoff = lds_byte(wr * 64 + fr, fq * 8), boff = lds_byte(wc * 32 + fr, fq * 8);
#define PG8_SA(b, h) (((b) * 2 + (h)) * HTB)
#define PG8_SB(b, h) ((4 + (b) * 2 + (h)) * HTB)
#define PG8_STAGE(bufoff, gbase, voff) do { _Pragma("unroll") for (int _i = 0; _i < 2; ++_i) \
        __builtin_amdgcn_global_load_lds((const unsigned*)((const char*)(gbase) + (voff)[_i]), (PG8_LAS unsigned*)(lds + (bufoff) + ldsw + _i * 8192), 16, 0, 0); } while (0)
#define PG8_STAGE_A(bufoff, kptr, h, NEXTSEL) do { if constexpr (GATHER) { const unsigned _p = (NEXTSEL) ? gnxt[h] : gcur[h]; const unsigned _v[2] = { (_p & 0xffffu) * (unsigned)(2 * K) + gC2, (_p >> 16) * (unsigned)(2 * K) + gC2 }; PG8_STAGE(bufoff, kptr, _v); } \
        else { PG8_STAGE(bufoff, (kptr) + (h) * hstep, voffA); } } while (0)
#define PG8_LDA(dst, b, h) do { _Pragma("unroll") for (int m = 0; m < 4; ++m) _Pragma("unroll") for (int k = 0; k < 2; ++k) dst[m][k] = *(const PG8_LAS bf16x8*)(lds + PG8_SA(b, h) + aoff + m * 2048 + k * 1024); } while (0)
#define PG8_LDB(dst, b, h) do { _Pragma("unroll") for (int n = 0; n < 2; ++n) _Pragma("unroll") for (int k = 0; k < 2; ++k) dst[n][k] = *(const PG8_LAS bf16x8*)(lds + PG8_SB(b, h) + boff + n * 2048 + k * 1024); } while (0)
#define PG8_MMA(ai, bj, At, Bt) do { __builtin_amdgcn_s_setprio(1); _Pragma("unroll") for (int m = 0; m < 4; ++m) _Pragma("unroll") for (int n = 0; n < 2; ++n) _Pragma("unroll") for (int k = 0; k < 2; ++k) \
        acc[ai][bj][m][n] = __builtin_amdgcn_mfma_f32_16x16x32_bf16(Bt[n][k], At[m][k], acc[ai][bj][m][n], 0, 0, 0); __builtin_amdgcn_s_setprio(0); } while (0)
#define PG8_WAIT_V(n) asm volatile("s_waitcnt vmcnt(" #n ")" ::: "memory")
#define PG8_WAIT_L(n) asm volatile("s_waitcnt lgkmcnt(" #n ")" ::: "memory")
#define PG8_BAR __builtin_amdgcn_s_barrier()
#define PG8_SCHED __builtin_amdgcn_sched_barrier(0)
    unsigned gcur[2], gnxt[2], gC2 = 0;
    if constexpr (GATHER) { int R, C; stage_rc(tid * 16, R, C); gC2 = (unsigned)C * 2u; }
    auto load_gather = [&](int pm, unsigned (&dst)[2]) {
        int R, C; stage_rc(tid * 16, R, C);
#pragma unroll
        for (int h = 0; h < 2; ++h) { int a0 = g.rowtab[pm * BM + h * HALF + R], a1 = g.rowtab[pm * BM + h * HALF + R + 64]; a0 = a0 < 0 ? 0 : a0; a1 = a1 < 0 ? 0 : a1; dst[h] = (unsigned)(a0 >> 3) | ((unsigned)(a1 >> 3) << 16); }
    };
    Unit cur, nxt; int ui = 0;
    if (!S.next(0, cur)) return;
    f32x4 acc[2][2][4][2];
#pragma unroll
    for (int a = 0; a < 2; ++a)
#pragma unroll
        for (int b = 0; b < 2; ++b)
#pragma unroll
            for (int m = 0; m < 4; ++m)
#pragma unroll
                for (int n = 0; n < 2; ++n) acc[a][b][m][n] = (f32x4){0.f, 0.f, 0.f, 0.f};
    bf16x8 At[4][2], B0[2][2], B1[2][2];
    const char* cA = (const char*)g.A + (GATHER ? (size_t)0 : (size_t)cur.pm * tstep); const char* cB = (const char*)g.Bt + (size_t)cur.pn * tstep;
    if constexpr (GATHER) { load_gather(cur.pm, gcur); }
    S.a_ready(cur);
    if constexpr (SP2) {
        PG8_STAGE(PG8_SB(0, 0), cB, voffB); PG8_STAGE(PG8_SB(0, 1), cB + hstep, voffB); PG8_STAGE_A(PG8_SA(0, 0), cA, 0, false); PG8_STAGE_A(PG8_SA(0, 1), cA, 1, false);
        if (wr == 1) PG8_BAR;
        PG8_WAIT_V(2); PG8_BAR;
        PG8_STAGE(PG8_SB(1, 0), cB + kstep, voffB); PG8_STAGE_A(PG8_SA(1, 0), cA + kstep, 0, false); PG8_STAGE(PG8_SB(1, 1), cB + hstep + kstep, voffB);
        PG8_WAIT_V(6); PG8_BAR;
    } else {
        PG8_STAGE(PG8_SB(0, 0), cB, voffB); PG8_STAGE_A(PG8_SA(0, 0), cA, 0, false); PG8_STAGE(PG8_SB(0, 1), cB + hstep, voffB); PG8_STAGE_A(PG8_SA(0, 1), cA, 1, false);
        if (wr == 1) PG8_BAR;
        PG8_WAIT_V(4); PG8_BAR;
        PG8_STAGE(PG8_SB(1, 0), cB + kstep, voffB); PG8_STAGE_A(PG8_SA(1, 0), cA + kstep, 0, false); PG8_STAGE(PG8_SB(1, 1), cB + hstep + kstep, voffB);
        PG8_WAIT_V(6); PG8_BAR;
    }
    for (;;) {
        const bool has_next = S.next(ui + 1, nxt);
        const char* nA = (has_next && !GATHER) ? (const char*)g.A + (size_t)nxt.pm * tstep : cA; const char* nB = has_next ? (const char*)g.Bt + (size_t)nxt.pn * tstep : cB;
        if constexpr (GATHER) { if (has_next) load_gather(nxt.pm, gnxt); else {
#pragma unroll
            for (int h = 0; h < 2; ++h) { gnxt[h] = gcur[h]; } } }
        for (int t = 0; t < nt; t += 2) {
            const bool last = (t == nt - 2);
            const char* a1 = cA + (size_t)(t + 1) * kstep;
            const char* a2 = last ? nA : cA + (size_t)(t + 2) * kstep; const char* b2 = last ? nB : cB + (size_t)(t + 2) * kstep;
            const char* a3 = a2 + kstep; const char* b3 = b2 + kstep;
            if (last && has_next) S.a_ready(nxt);
            if constexpr (SP2) {
            PG8_LDB(B0, 0, 0); PG8_LDB(B1, 0, 1); PG8_SCHED; PG8_LDA(At, 0, 0); PG8_STAGE_A(PG8_SA(1, 1), a1, 1, false);
            PG8_WAIT_V(8); PG8_WAIT_L(0); PG8_BAR; PG8_MMA(0, 0, At, B0); PG8_MMA(0, 1, At, B1); PG8_BAR; PG8_SCHED;
            PG8_LDA(At, 0, 1); PG8_STAGE(PG8_SB(0, 0), b2, voffB); PG8_STAGE(PG8_SB(0, 1), b2 + hstep, voffB); PG8_STAGE_A(PG8_SA(0, 0), a2, 0, last);
            PG8_WAIT_V(8); PG8_WAIT_L(0); PG8_BAR; PG8_MMA(1, 0, At, B0); PG8_MMA(1, 1, At, B1); PG8_BAR; PG8_SCHED;
            PG8_LDB(B0, 1, 0); PG8_LDB(B1, 1, 1); PG8_SCHED; PG8_LDA(At, 1, 0); PG8_STAGE_A(PG8_SA(0, 1), a2, 1, last);
            PG8_WAIT_V(8); PG8_WAIT_L(0); PG8_BAR; PG8_MMA(0, 0, At, B0); PG8_MMA(0, 1, At, B1); PG8_BAR; PG8_SCHED;
            PG8_LDA(At, 1, 1); PG8_STAGE(PG8_SB(1, 0), b3, voffB); PG8_STAGE(PG8_SB(1, 1), b3 + hstep, voffB); PG8_STAGE_A(PG8_SA(1, 0), a3, 0, last);
            PG8_WAIT_V(8); PG8_WAIT_L(0); PG8_BAR; PG8_MMA(1, 0, At, B0); PG8_MMA(1, 1, At, B1); PG8_BAR; PG8_SCHED;
            } else {
            PG8_LDB(B0, 0, 0); PG8_SCHED; PG8_LDA(At, 0, 0); PG8_STAGE_A(PG8_SA(1, 1), a1, 1, false);
            PG8_WAIT_L(8); PG8_BAR; PG8_WAIT_L(0); PG8_MMA(0, 0, At, B0); PG8_BAR; PG8_SCHED;
            PG8_LDB(B1, 0, 1); PG8_STAGE(PG8_SB(0, 0), b2, voffB);
            PG8_BAR; PG8_WAIT_L(0); PG8_MMA(0, 1, At, B1); PG8_BAR;
            PG8_LDA(At, 0, 1); PG8_STAGE_A(PG8_SA(0, 0), a2, 0, last);
            PG8_BAR; PG8_WAIT_L(0); PG8_MMA(1, 0, At, B0); PG8_BAR; PG8_SCHED;
            PG8_STAGE(PG8_SB(0, 1), b2 + hstep, voffB);
            PG8_WAIT_V(6); PG8_BAR; PG8_MMA(1, 1, At, B1); PG8_BAR;
            PG8_LDB(B0, 1, 0); PG8_SCHED; PG8_LDA(At, 1, 0); PG8_STAGE_A(PG8_SA(0, 1), a2, 1, last);
            PG8_WAIT_L(8); PG8_BAR; PG8_WAIT_L(0); PG8_MMA(0, 0, At, B0); PG8_BAR; PG8_SCHED;
            PG8_LDB(B1, 1, 1); PG8_STAGE(PG8_SB(1, 0), b3, voffB);
            PG8_BAR; PG8_WAIT_L(0); PG8_MMA(0, 1, At, B1); PG8_BAR;
            PG8_LDA(At, 1, 1); PG8_STAGE_A(PG8_SA(1, 0), a3, 0, last);
            PG8_BAR; PG8_WAIT_L(0); PG8_MMA(1, 0, At, B0); PG8_BAR; PG8_SCHED;
            PG8_STAGE(PG8_SB(1, 1), b3 + hstep, voffB);
            PG8_WAIT_V(6); PG8_BAR; PG8_MMA(1, 1, At, B1); PG8_BAR;
            }
        }
        if constexpr (ALIGN_EPI) { if (wr == 0) PG8_BAR; }
        if constexpr (!Epi::AFTER_DRAIN) { E(acc, cur, wr, wc, fr, fq); S.done(cur); }
        if (!has_next) break;
#pragma unroll
        for (int a = 0; a < 2; ++a)
#pragma unroll
            for (int b = 0; b < 2; ++b)
#pragma unroll
                for (int m = 0; m < 4; ++m)
#pragma unroll
                    for (int n = 0; n < 2; ++n) acc[a][b][m][n] = (f32x4){0.f, 0.f, 0.f, 0.f};
        cur = nxt; cA = nA; cB = nB; ++ui;
        if constexpr (GATHER) {
#pragma unroll
            for (int h = 0; h < 2; ++h) { gcur[h] = gnxt[h]; } }
        if constexpr (ALIGN_EPI) { if (wr == 1) PG8_BAR; }
    }
    PG8_WAIT_V(0);
    if constexpr (!ALIGN_EPI) { if (wr == 0) PG8_BAR; }
    PG8_BAR;
    if constexpr (Epi::AFTER_DRAIN) { E.fused(acc, cur, wr, wc, fr, fq, lds, wid, lane); S.done(cur); }
#undef PG8_SA
#undef PG8_SB
#undef PG8_STAGE
#undef PG8_STAGE_A
#undef PG8_LDA
#undef PG8_LDB
#undef PG8_MMA
#undef PG8_WAIT_V
#undef PG8_WAIT_L
#undef PG8_BAR
#undef PG8_SCHED
}
}

typedef unsigned short bf16_t;
__device__ __forceinline__ unsigned f2bf(float f) { unsigned u = __builtin_bit_cast(unsigned, f); return (u + 0x7fffu + ((u >> 16) & 1u)) >> 16; }
__device__ __forceinline__ float bf2f(unsigned h) { return __builtin_bit_cast(float, h << 16); }
__device__ __forceinline__ float wave_sum(float v) {
#pragma unroll
    for (int o = 1; o < 64; o <<= 1) v += __shfl_xor(v, o);
    return v;
}
__device__ __forceinline__ float sigmoidf_(float x) { return 1.0f / (1.0f + expf(-x)); }
__device__ __forceinline__ float siluf_(float x) { return x / (1.0f + expf(-x)); }
__device__ __forceinline__ float softplusf_(float x) { return fmaxf(x, 0.0f) + log1pf(expf(-fabsf(x))); }
__device__ __forceinline__ float geluf_(float x) { const float u = 0.7978845608028654f * (x + 0.044715f * x * x * x); return 0.5f * x * (1.0f + tanhf(u)); }

struct Args { const float* in[39]; float* out; unsigned char* ws; int lo, hi; };

struct Ctx {
    const float* const* in; float* out; unsigned char* ws;
    LAS unsigned char* lds; float* sm;
    int tid, lane, wid, bid, G;
};

__device__ __forceinline__ unsigned pk2(float lo, float hi) { return f2bf(lo) | (f2bf(hi) << 16); }
__device__ __forceinline__ float ldbf(const bf16_t* p) { return bf2f((unsigned)*p); }
__device__ __forceinline__ float4 ldbf4(const bf16_t* p) { const uint2 v = *(const uint2*)p; return make_float4(bf2f(v.x & 0xffffu), bf2f(v.x >> 16), bf2f(v.y & 0xffffu), bf2f(v.y >> 16)); }

template <int NB, class AF, class BF, class BF2, class EF>
__device__ __forceinline__ void gemm_tile(float* sm, int K, AF af, BF bf, BF2 bf2, EF ef) {
    float* As = sm;
    float* Bs = sm + 16 * 132;
    float* Bs2 = Bs + 16 * 68;
    const int tid = threadIdx.x, ty = tid >> 4, tx = tid & 15;
    const int am = tid >> 2, ak = (tid & 3) * 4;
    const int bt = tid & 255, bk = bt >> 4, bn = (bt & 15) * 4;
    float acc[4][4], acc2[4][4];
#pragma unroll
    for (int i = 0; i < 4; ++i)
#pragma unroll
        for (int j = 0; j < 4; ++j) { acc[i][j] = 0.f; acc2[i][j] = 0.f; }
    float4 av = af(am, ak);
    float4 bv = make_float4(0.f, 0.f, 0.f, 0.f);
    if (tid < 256) bv = bf(bk, bn); else if (NB == 2) bv = bf2(bk, bn);
    for (int k0 = 0; k0 < K; k0 += 16) {
        __syncthreads();
        As[(ak + 0) * 132 + am] = av.x; As[(ak + 1) * 132 + am] = av.y; As[(ak + 2) * 132 + am] = av.z; As[(ak + 3) * 132 + am] = av.w;
        if (tid < 256) *(float4*)&Bs[bk * 68 + bn] = bv; else if (NB == 2) *(float4*)&Bs2[bk * 68 + bn] = bv;
        __syncthreads();
        if (k0 + 16 < K) {
            av = af(am, k0 + 16 + ak);
            if (tid < 256) bv = bf(k0 + 16 + bk, bn); else if (NB == 2) bv = bf2(k0 + 16 + bk, bn);
        }
#pragma unroll
        for (int kk = 0; kk < 16; ++kk) {
            const float4 a = *(const float4*)&As[kk * 132 + ty * 4];
            const float4 b = *(const float4*)&Bs[kk * 68 + tx * 4];
            const float aa[4] = {a.x, a.y, a.z, a.w};
            const float bb[4] = {b.x, b.y, b.z, b.w};
#pragma unroll
            for (int i = 0; i < 4; ++i)
#pragma unroll
                for (int j = 0; j < 4; ++j) acc[i][j] = fmaf(aa[i], bb[j], acc[i][j]);
            if (NB == 2) {
                const float4 b2 = *(const float4*)&Bs2[kk * 68 + tx * 4];
                const float bb2[4] = {b2.x, b2.y, b2.z, b2.w};
#pragma unroll
                for (int i = 0; i < 4; ++i)
#pragma unroll
                    for (int j = 0; j < 4; ++j) acc2[i][j] = fmaf(aa[i], bb2[j], acc2[i][j]);
            }
        }
    }
#pragma unroll
    for (int i = 0; i < 4; ++i)
        ef(ty * 4 + i, tx * 4, make_float4(acc[i][0], acc[i][1], acc[i][2], acc[i][3]), make_float4(acc2[i][0], acc2[i][1], acc2[i][2], acc2[i][3]));
}

template <bool RES, class RM>
__device__ __forceinline__ void transpose_item(const float* W, int K, int N, bf16_t* WT, RM rowmap, float* scr, int item, int lane) {
    const int nblk = N / 32, kb = item / nblk, nb = item % nblk, k0 = 64 * kb, n0 = 32 * nb;
#pragma unroll 8
    for (int i = 0; i < 32; ++i) { const int kk = 2 * i + (lane >> 5); scr[kk * 33 + (lane & 31)] = W[(size_t)(k0 + kk) * N + n0 + (lane & 31)]; }
    asm volatile("s_waitcnt lgkmcnt(0)" ::: "memory");
    const int c = lane & 7;
    const int r0 = rowmap(n0);
#pragma unroll
    for (int j = 0; j < 4; ++j) {
        const int n = (lane >> 3) + 8 * j; const float* s = scr + (8 * c) * 33 + n;
        float v[8];
#pragma unroll
        for (int q = 0; q < 8; ++q) { v[q] = s[q * 33]; if (RES) v[q] = v[q] - bf2f(f2bf(v[q])); }
        uint4 o; o.x = pk2(v[0], v[1]); o.y = pk2(v[2], v[3]); o.z = pk2(v[4], v[5]); o.w = pk2(v[6], v[7]);
        *(uint4*)(WT + (size_t)(r0 + n) * K + k0 + 8 * c) = o;
    }
    asm volatile("s_waitcnt lgkmcnt(0)" ::: "memory");
}

__device__ __forceinline__ void convert_expert_weights(const Ctx& c, int first, int stride) {
    float* scr = c.sm + c.wid * (64 * 33);
    for (int it = first; it < NE * 384; it += stride) {
        const int e = it / 384, r = it % 384;
        if (r < 128) transpose_item<false>(c.in[33] + (size_t)e * D * EFF, D, EFF, (bf16_t*)(c.ws + WS_WEGU) + (size_t)e * 512 * D, [](int n) { return (n >> 7) * 256 + (n & 127); }, scr, r, c.lane);
        else if (r < 256) transpose_item<false>(c.in[34] + (size_t)e * D * EFF, D, EFF, (bf16_t*)(c.ws + WS_WEGU) + (size_t)e * 512 * D, [](int n) { return (n >> 7) * 256 + 128 + (n & 127); }, scr, r - 128, c.lane);
        else transpose_item<false>(c.in[35] + (size_t)e * EFF * D, EFF, D, (bf16_t*)(c.ws + WS_WED) + (size_t)e * D * EFF, [](int n) { return n; }, scr, r - 256, c.lane);
    }
}

__device__ __forceinline__ void phase0(const Ctx& c) {
    const int gt = c.bid * 512 + c.tid, NT = c.G * 512;
    const int gw = c.bid * 8 + c.wid, NW = c.G * 8;
    {
        const float* cc = c.in[1]; const float* w_ada = c.in[2];
        float* modsp = (float*)(c.ws + WS_MODSP);
        for (int task = gw; task < 96 * 16; task += NW) {
            const int cg = task % 96, ks = task / 96, j = cg * 64 + c.lane;
            float a0 = 0.f, a1 = 0.f, a2 = 0.f, a3 = 0.f;
#pragma unroll 4
            for (int k = ks * 64; k < ks * 64 + 64; ++k) {
                const float wv = w_ada[(size_t)k * NMODS + j];
                a0 = fmaf(siluf_(cc[k]), wv, a0); a1 = fmaf(siluf_(cc[D + k]), wv, a1); a2 = fmaf(siluf_(cc[2 * D + k]), wv, a2); a3 = fmaf(siluf_(cc[3 * D + k]), wv, a3);
            }
            modsp[(ks * 4 + 0) * NMODS + j] = a0; modsp[(ks * 4 + 1) * NMODS + j] = a1; modsp[(ks * 4 + 2) * NMODS + j] = a2; modsp[(ks * 4 + 3) * NMODS + j] = a3;
        }
    }
    {
        const float* log_dt = c.in[20]; const float* a_re = c.in[21]; const float* a_im = c.in[22];
        const float* b_re = c.in[23]; const float* b_im = c.in[24];
        float* apow = (float*)(c.ws + WS_APOW); float* bb = (float*)(c.ws + WS_S5BB);
        for (int idx = gt; idx < S5NG * S5P; idx += NT) {
            const int g = idx / S5P, p = idx % S5P;
            const double dt = exp((double)log_dt[g]);
            const double lre = fmin((double)a_re[idx], -1e-4), lim = (double)a_im[idx];
            const double mag = exp(lre * dt), ang = lim * dt;
            const double abr = mag * cos(ang), abi = mag * sin(ang);
            const double den = lre * lre + lim * lim;
            const double nre = abr - 1.0, nim = abi;
            const double qre = (nre * lre + nim * lim) / den, qim = (nim * lre - nre * lim) / den;
            double pr = 1.0, pi = 0.0;
            for (int j = 0; j <= S5L; ++j) {
                apow[((size_t)(g * (S5L + 1) + j) * 64 + p) * 2 + 0] = (float)pr; apow[((size_t)(g * (S5L + 1) + j) * 64 + p) * 2 + 1] = (float)pi;
                const double nr = pr * abr - pi * abi, ni = pr * abi + pi * abr; pr = nr; pi = ni;
            }
            for (int ch = 0; ch < 16; ++ch) {
                const double br = (double)b_re[idx * 16 + ch], bi = (double)b_im[idx * 16 + ch];
                bb[idx * 32 + ch] = (float)(qre * br - qim * bi);
                bb[idx * 32 + 16 + ch] = (float)(qre * bi + qim * br);
            }
        }
    }
    {
        const float* w2 = c.in[11]; const float* a2 = c.in[13]; const float* g2 = c.in[14];
        bf16_t* bt = (bf16_t*)(c.ws + WS_LORA_BT);
        for (int it = gt; it < 1536 * 32; it += NT) {
            const int n = it >> 5, c0 = (it & 31) * 8;
            float v[8];
#pragma unroll
            for (int i = 0; i < 8; ++i) {
                const int col = c0 + i; float x = 0.f;
                if (n < 512) { if (col < 64) x = w2[col * RW + n]; }
                else if (n < 1024) { if (col >= 64 && col < 128) x = a2[(col - 64) * RW + (n - 512)]; }
                else { if (col >= 128) x = g2[(col - 128) * RW + (n - 1024)]; }
                v[i] = x;
            }
            *(uint4*)(bt + (size_t)n * 256 + c0) = make_uint4(pk2(v[0], v[1]), pk2(v[2], v[3]), pk2(v[4], v[5]), pk2(v[6], v[7]));
        }
    }
    float* scr = c.sm + c.wid * (64 * 33);
    constexpr int I_IN = (D / 64) * (NPROJ / 32), I_OUT = (D / 64) * (D / 32), I_GLU = (512 / 64) * (512 / 32), I_SG = (D / 64) * (256 / 32), I_SD = (256 / 64) * (D / 32), I_R = (D / 64) * (256 / 32);
    constexpr int NIT = I_IN + I_OUT + I_GLU + 2 * I_SG + I_SD + 2 * I_R;
    for (int it = gw; it < NIT; it += NW) {
        int r = it;
        if (r < I_IN) { transpose_item<false>(c.in[8], D, NPROJ, (bf16_t*)(c.ws + WS_WIN_T), [](int n) { return n; }, scr, r, c.lane); continue; } r -= I_IN;
        if (r < I_OUT) { transpose_item<false>(c.in[30], D, D, (bf16_t*)(c.ws + WS_WOUT_T), [](int n) { return n; }, scr, r, c.lane); continue; } r -= I_OUT;
        if (r < I_GLU) { transpose_item<false>(c.in[28], 512, 512, (bf16_t*)(c.ws + WS_WGLU_T), [](int n) { return n; }, scr, r, c.lane); continue; } r -= I_GLU;
        if (r < I_SG) { transpose_item<false>(c.in[36], D, 256, (bf16_t*)(c.ws + WS_WSGU_T), [](int n) { return (n >> 7) * 256 + (n & 127); }, scr, r, c.lane); continue; } r -= I_SG;
        if (r < I_SG) { transpose_item<false>(c.in[37], D, 256, (bf16_t*)(c.ws + WS_WSGU_T), [](int n) { return (n >> 7) * 256 + 128 + (n & 127); }, scr, r, c.lane); continue; } r -= I_SG;
        if (r < I_SD) { transpose_item<false>(c.in[38], 256, D, (bf16_t*)(c.ws + WS_WSD_T), [](int n) { return n; }, scr, r, c.lane); continue; } r -= I_SD;
        if (r < I_R) { transpose_item<false>(c.in[31], D, 256, (bf16_t*)(c.ws + WS_WR_T), [](int n) { return n; }, scr, r, c.lane); continue; } r -= I_R;
        transpose_item<true>(c.in[31], D, 256, (bf16_t*)(c.ws + WS_WR_T), [](int n) { return 256 + n; }, scr, r, c.lane);
    }
}

__device__ __forceinline__ void phase1(const Ctx& c) {
    const int gt = c.bid * 512 + c.tid, NT = c.G * 512;
    const int gw = c.bid * 8 + c.wid, NW = c.G * 8;
    const float* modsp = (const float*)(c.ws + WS_MODSP); const float* b_ada = c.in[3]; float* mods = (float*)(c.ws + WS_MODS);
    for (int idx = gt; idx < BATCH * NMODS; idx += NT) {
        const int b = idx / NMODS, j = idx % NMODS;
        float acc = 0.f;
#pragma unroll
        for (int ks = 0; ks < 16; ++ks) acc += modsp[(ks * 4 + b) * NMODS + j];
        mods[idx] = acc + b_ada[j];
    }
    const float* apow = (const float*)(c.ws + WS_APOW); const float* bb = (const float*)(c.ws + WS_S5BB);
    const float* c_re = c.in[25]; const float* c_im = c.in[26];
    float* klag = (float*)(c.ws + WS_KLAG);
    for (int task = gw; task < S5NG * S5L; task += NW) {
        const int g = task / S5L, j = task % S5L, cc = c.lane >> 2, cq = (c.lane & 3) * 4;
        float acc[4] = {0.f, 0.f, 0.f, 0.f};
        for (int p = 0; p < 64; ++p) {
            const float ar = apow[((size_t)(g * (S5L + 1) + j) * 64 + p) * 2], ai = apow[((size_t)(g * (S5L + 1) + j) * 64 + p) * 2 + 1];
            const float cr = c_re[(g * 16 + cc) * 64 + p], ci = c_im[(g * 16 + cc) * 64 + p];
            const float4 br = *(const float4*)(bb + (size_t)(g * 64 + p) * 32 + cq), bi = *(const float4*)(bb + (size_t)(g * 64 + p) * 32 + 16 + cq);
            const float er = cr * ar - ci * ai, ei = cr * ai + ci * ar;
            acc[0] += er * br.x - ei * bi.x; acc[1] += er * br.y - ei * bi.y; acc[2] += er * br.z - ei * bi.z; acc[3] += er * br.w - ei * bi.w;
        }
        *(float4*)(klag + ((size_t)(g * S5L + j) * 16 + cc) * 16 + cq) = make_float4(acc[0], acc[1], acc[2], acc[3]);
    }
}

__device__ __forceinline__ void phase2(const Ctx& c) {
    const float* x = c.in[0]; const float* g = c.in[4];
    const float* mods = (const float*)(c.ws + WS_MODS);
    bf16_t* xn = (bf16_t*)(c.ws + WS_A);
    const int gw = c.bid * 8 + c.wid, NW = c.G * 8;
    for (int t = gw; t < T; t += NW) {
        const int b = t / SEQ;
        const float4* xr = (const float4*)(x + (size_t)t * D) + c.lane;
        float4 v[4]; float ss = 0.f;
#pragma unroll
        for (int j = 0; j < 4; ++j) { v[j] = xr[64 * j]; ss += v[j].x * v[j].x + v[j].y * v[j].y + v[j].z * v[j].z + v[j].w * v[j].w; }
        const float rstd = rsqrtf(wave_sum(ss) * (1.0f / D) + 1e-6f);
        uint2* o = (uint2*)(xn + (size_t)t * D) + c.lane;
#pragma unroll
        for (int j = 0; j < 4; ++j) {
            const int k = (c.lane + 64 * j) * 4;
            const float4 gg = *(const float4*)(g + k);
            const float4 sh = *(const float4*)(mods + b * NMODS + k);
            const float4 sc = *(const float4*)(mods + b * NMODS + D + k);
            float4 r;
            r.x = v[j].x * rstd * gg.x * (1.f + sc.x) + sh.x; r.y = v[j].y * rstd * gg.y * (1.f + sc.y) + sh.y;
            r.z = v[j].z * rstd * gg.z * (1.f + sc.z) + sh.z; r.w = v[j].w * rstd * gg.w * (1.f + sc.w) + sh.w;
            o[64 * j] = make_uint2(pk2(r.x, r.y), pk2(r.z, r.w));
        }
    }
    const int gt = c.bid * 512 + c.tid, NT = c.G * 512;
    const float* apow = (const float*)(c.ws + WS_APOW); const float* bb = (const float*)(c.ws + WS_S5BB); const float* klag = (const float*)(c.ws + WS_KLAG);
    const float* c_re = c.in[25]; const float* c_im = c.in[26]; const float* dd = c.in[27];
    bf16_t* kmat = (bf16_t*)(c.ws + WS_KMAT); bf16_t* hmat = (bf16_t*)(c.ws + WS_HMAT);
    for (int it = gt; it < S5NG * 512 * 80; it += NT) {
        const int row = it / 80, ch = it % 80, g = row >> 9, t = (row >> 4) & 31, cc = row & 15, col0 = ch * 8;
        float v[8];
        if (col0 < 512) {
            const int s = col0 >> 4, c0 = col0 & 15;
            if (s > t) {
#pragma unroll
                for (int i = 0; i < 8; ++i) v[i] = 0.f;
            } else {
                const float4 k0 = *(const float4*)(klag + ((size_t)(g * S5L + (t - s)) * 16 + cc) * 16 + c0), k1 = *(const float4*)(klag + ((size_t)(g * S5L + (t - s)) * 16 + cc) * 16 + c0 + 4);
                v[0] = k0.x; v[1] = k0.y; v[2] = k0.z; v[3] = k0.w; v[4] = k1.x; v[5] = k1.y; v[6] = k1.z; v[7] = k1.w;
                if (s == t) {
                    const float dv = dd[g * 16 + cc];
#pragma unroll
                    for (int i = 0; i < 8; ++i) if (c0 + i == cc) v[i] += dv;
                }
            }
        } else {
            const int q0 = col0 - 512;
#pragma unroll
            for (int i = 0; i < 8; ++i) {
                const int q = q0 + i, p = q & 63;
                const float ar = apow[((size_t)(g * (S5L + 1) + t + 1) * 64 + p) * 2], ai = apow[((size_t)(g * (S5L + 1) + t + 1) * 64 + p) * 2 + 1];
                const float cr = c_re[(g * 16 + cc) * 64 + p], ci = c_im[(g * 16 + cc) * 64 + p];
                v[i] = (q < 64) ? (cr * ar - ci * ai) : -(cr * ai + ci * ar);
            }
        }
        *(uint4*)(kmat + (size_t)row * 640 + col0) = make_uint4(pk2(v[0], v[1]), pk2(v[2], v[3]), pk2(v[4], v[5]), pk2(v[6], v[7]));
    }
    for (int it = gt; it < S5NG * 256 * 80; it += NT) {
        const int row = it / 80, ch = it % 80, g = row >> 8, q = row & 255, col0 = ch * 8;
        float v[8];
#pragma unroll
        for (int i = 0; i < 8; ++i) v[i] = 0.f;
        if (q < 128 && col0 < 512) {
            const int s = col0 >> 4, c0 = col0 & 15, p = q & 63;
            const float ar = apow[((size_t)(g * (S5L + 1) + (S5L - 1 - s)) * 64 + p) * 2], ai = apow[((size_t)(g * (S5L + 1) + (S5L - 1 - s)) * 64 + p) * 2 + 1];
#pragma unroll
            for (int i = 0; i < 8; ++i) {
                const float br = bb[(size_t)(g * 64 + p) * 32 + c0 + i], bi = bb[(size_t)(g * 64 + p) * 32 + 16 + c0 + i];
                v[i] = (q < 64) ? (ar * br - ai * bi) : (ar * bi + ai * br);
            }
        }
        *(uint4*)(hmat + (size_t)row * 640 + col0) = make_uint4(pk2(v[0], v[1]), pk2(v[2], v[3]), pk2(v[4], v[5]), pk2(v[6], v[7]));
    }
}

__device__ __forceinline__ void phase3(const Ctx& c) {
    pg8::Gemm g{(const bf16_t*)(c.ws + WS_A), (const bf16_t*)(c.ws + WS_WIN_T), T, NPROJ, D};
    pg8::StaticOrder S; S.init(T, NPROJ, c.G, c.bid);
    pg8::EpiBf16<0> E{(bf16_t*)(c.ws + WS_PROJ), NPROJ, nullptr, 0, 0, 1.f};
    pg8::gemm_phase<pg8::EpiBf16<0>, pg8::StaticOrder, true, true>(c.lds, g, S, E);
}

__device__ __forceinline__ void unpack8(const uint4 a, float (&u)[8]) {
    u[0] = bf2f(a.x & 0xffffu); u[1] = bf2f(a.x >> 16); u[2] = bf2f(a.y & 0xffffu); u[3] = bf2f(a.y >> 16);
    u[4] = bf2f(a.z & 0xffffu); u[5] = bf2f(a.z >> 16); u[6] = bf2f(a.w & 0xffffu); u[7] = bf2f(a.w >> 16);
}
__device__ __forceinline__ uint4 pack8(const float (&v)[8]) { return make_uint4(pk2(v[0], v[1]), pk2(v[2], v[3]), pk2(v[4], v[5]), pk2(v[6], v[7])); }
__device__ __forceinline__ void phase4(const Ctx& c) {
    const bf16_t* proj = (const bf16_t*)(c.ws + WS_PROJ);
    const float* mu = c.in[9]; const float* k_k = c.in[15];
    bf16_t* rw_r = (bf16_t*)(c.ws + WS_RW_R); bf16_t* rw_k = (bf16_t*)(c.ws + WS_RW_K); bf16_t* rw_v = (bf16_t*)(c.ws + WS_RW_V); bf16_t* rw_a = (bf16_t*)(c.ws + WS_RW_A);
    bf16_t* alora = (bf16_t*)((unsigned char*)c.out + OUT_ALORA);
    const int gw = c.bid * 8 + c.wid, NW = c.G * 8;
    for (int t = gw; t < T; t += NW) {
        const bool first = (t % SEQ == 0);
        const bf16_t* pr = proj + (size_t)t * NPROJ; const bf16_t* pp = proj + (size_t)(first ? t : t - 1) * NPROJ;
#pragma unroll
        for (int j = 0; j < 4; ++j) {
            const int cidx = c.lane + 64 * j;
            if (cidx < 224) {
                const int col = cidx * 8;
                float p[8], q[8], ps[8];
                unpack8(*(const uint4*)(pr + col), p); unpack8(*(const uint4*)(pp + col), q);
                const float4 m0 = *(const float4*)(mu + col), m1 = *(const float4*)(mu + col + 4);
                const float mm[8] = {m0.x, m0.y, m0.z, m0.w, m1.x, m1.y, m1.z, m1.w};
#pragma unroll
                for (int i = 0; i < 8; ++i) { const float pv = first ? 0.f : q[i]; ps[i] = p[i] + (pv - p[i]) * mm[i]; }
                if (j == 0) *(uint4*)(rw_r + (size_t)t * RW + col) = pack8(ps);
                else if (j == 1) {
                    const int cl = col - 512;
                    *(uint4*)(rw_k + (size_t)t * RW + cl) = pack8(ps);
                    const float4 k0 = *(const float4*)(k_k + cl), k1 = *(const float4*)(k_k + cl + 4);
                    const float kk8[8] = {k0.x, k0.y, k0.z, k0.w, k1.x, k1.y, k1.z, k1.w};
                    float kk[8]; float ss = 0.f;
#pragma unroll
                    for (int i = 0; i < 8; ++i) { kk[i] = ps[i] * kk8[i]; ss += kk[i] * kk[i]; }
                    ss += __shfl_xor(ss, 1); ss += __shfl_xor(ss, 2); ss += __shfl_xor(ss, 4);
                    const float inv = -1.0f / fmaxf(sqrtf(ss), 1e-12f);
#pragma unroll
                    for (int i = 0; i < 8; ++i) kk[i] *= inv;
                    *(uint4*)(rw_a + (size_t)t * RW + cl) = pack8(kk);
                } else if (j == 2) *(uint4*)(rw_v + (size_t)t * RW + (col - 1024)) = pack8(ps);
                else {
                    const int cl = col - 1536;
                    float o[8];
#pragma unroll
                    for (int i = 0; i < 8; ++i) o[i] = (cl < 64) ? tanhf(ps[i]) : (cl < 128) ? ps[i] : sigmoidf_(ps[i]);
                    *(uint4*)(alora + (size_t)t * 256 + cl) = pack8(o);
                }
            }
        }
    }
    bf16_t* ux = (bf16_t*)((unsigned char*)c.out + OUT_UX);
    const int gt = c.bid * 512 + c.tid, NT = c.G * 512;
    for (int it = gt; it < T * 64; it += NT) {
        const int t = it >> 6, g = (it >> 1) & 31, hf = it & 1;
        const int b = t / SEQ, s = t % S5L, chunk = (t % SEQ) / S5L;
        const uint4 v = *(const uint4*)(proj + (size_t)t * NPROJ + RPROJ + g * 16 + hf * 8);
        *(uint4*)(ux + ((size_t)(g * 1024 + b * 256 + chunk)) * 640 + s * 16 + hf * 8) = v;
    }
    for (int it = gt; it < S5NG * 1024 * 16; it += NT) {
        const int row = it >> 4, ch = it & 15;
        *(uint4*)(ux + (size_t)row * 640 + 512 + ch * 8) = make_uint4(0u, 0u, 0u, 0u);
    }
}

__device__ __forceinline__ void phase5(const Ctx& c) {
    {
        pg8::Gemm g{(const bf16_t*)((unsigned char*)c.out + OUT_ALORA), (const bf16_t*)(c.ws + WS_LORA_BT), T, 1536, 256};
        pg8::StaticOrder S; S.init(T, 1536, c.G, c.bid);
        pg8::EpiLora E{c.in[10], c.in[12], c.in[16], (float*)(c.ws + WS_RW_W), (bf16_t*)(c.ws + WS_RW_K), (const bf16_t*)(c.ws + WS_RW_A), (bf16_t*)(c.ws + WS_RW_B), (bf16_t*)(c.ws + WS_RW_G)};
        pg8::gemm_phase<pg8::EpiLora, pg8::StaticOrder, true, true>(c.lds, g, S, E);
    }
    __syncthreads();
    {
        pg8::Gemm g{(const bf16_t*)((unsigned char*)c.out + OUT_UX), (const bf16_t*)(c.ws + WS_HMAT), 0, 0, 640};
        pg8::S5Order S{128, 1, c.G, c.bid};
        pg8::EpiS5E E{(float*)((unsigned char*)c.out + OUT_E)};
        pg8::gemm_phase<pg8::EpiS5E, pg8::S5Order, true, true>(c.lds, g, S, E);
    }
}

typedef float f2v __attribute__((ext_vector_type(2)));
__device__ __forceinline__ float dpp_add16(float v) {
    v += __builtin_bit_cast(float, __builtin_amdgcn_mov_dpp(__builtin_bit_cast(int, v), 0xB1, 0xf, 0xf, true));
    v += __builtin_bit_cast(float, __builtin_amdgcn_mov_dpp(__builtin_bit_cast(int, v), 0x4E, 0xf, 0xf, true));
    v += __builtin_bit_cast(float, __builtin_amdgcn_mov_dpp(__builtin_bit_cast(int, v), 0x141, 0xf, 0xf, true));
    v += __builtin_bit_cast(float, __builtin_amdgcn_mov_dpp(__builtin_bit_cast(int, v), 0x140, 0xf, 0xf, true));
    return v;
}
constexpr int RTS = 32;
constexpr int RTILE = 6 * RTS * 64;
typedef short bf16x8_t __attribute__((ext_vector_type(8)));
typedef float f32x4_t __attribute__((ext_vector_type(4)));
#define MFMA16(a, b, c) __builtin_amdgcn_mfma_f32_16x16x32_bf16((a), (b), (c), 0, 0, 0)
constexpr int CL = 64, CLD = 72, CSLOT = 64 * CLD * 2;
constexpr int C_DIAG = 13 * CSLOT, C_DM = C_DIAG + 4096, C_GL = C_DM + 2048, C_SEGP = C_GL + 256;
static_assert(C_SEGP + 2048 <= 131072, "rwkv chunk LDS map");
__device__ __forceinline__ bf16x8_t ldsfrag(LAS const unsigned char* slot, int row, int col) { return *(LAS const bf16x8_t*)(slot + (row * CLD + col) * 2); }
typedef unsigned u32x4_t __attribute__((ext_vector_type(4)));
typedef unsigned u32x2_t __attribute__((ext_vector_type(2)));
__device__ __forceinline__ void lds_st16(LAS unsigned char* p, uint4 v) { *(LAS u32x4_t*)p = (u32x4_t){v.x, v.y, v.z, v.w}; }
__device__ __forceinline__ void lds_st8(LAS unsigned char* p, uint2 v) { *(LAS u32x2_t*)p = (u32x2_t){v.x, v.y}; }
__device__ __forceinline__ uint2 lds_ld8(LAS const unsigned char* p) { const u32x2_t v = *(LAS const u32x2_t*)p; return make_uint2(v.x, v.y); }
__device__ __forceinline__ bf16x8_t zfrag() { return (bf16x8_t){0, 0, 0, 0, 0, 0, 0, 0}; }
__device__ __forceinline__ uint2 pack4(float a, float b, float c, float d) { return make_uint2(pk2(a, b), pk2(c, d)); }
__device__ __forceinline__ float wave_sum_u(float v) {
    v = dpp_add16(v);
    return __builtin_bit_cast(float, __builtin_amdgcn_readlane(__builtin_bit_cast(int, v), 0)) + __builtin_bit_cast(float, __builtin_amdgcn_readlane(__builtin_bit_cast(int, v), 16))
         + __builtin_bit_cast(float, __builtin_amdgcn_readlane(__builtin_bit_cast(int, v), 32)) + __builtin_bit_cast(float, __builtin_amdgcn_readlane(__builtin_bit_cast(int, v), 48));
}

__device__ __forceinline__ void rwkv_phaseA(const Ctx& c) {
    const float* __restrict__ rw_w = (const float*)(c.ws + WS_RW_W);
    const bf16_t* __restrict__ rw_r = (const bf16_t*)(c.ws + WS_RW_R); const bf16_t* __restrict__ rw_k = (const bf16_t*)(c.ws + WS_RW_K); const bf16_t* __restrict__ rw_v = (const bf16_t*)(c.ws + WS_RW_V);
    const bf16_t* __restrict__ rw_a = (const bf16_t*)(c.ws + WS_RW_A); const bf16_t* __restrict__ rw_b = (const bf16_t*)(c.ws + WS_RW_B);
    const float* r_k = c.in[17];
    bf16_t* Mq = (bf16_t*)(c.ws + WS_CM); bf16_t* NTq = (bf16_t*)(c.ws + WS_CN); bf16_t* Qq = (bf16_t*)(c.ws + WS_CQ); bf16_t* YTq = (bf16_t*)(c.ws + WS_CY); float* bon = (float*)(c.ws + WS_CBON);
    LAS unsigned char* L = c.lds;
    LAS unsigned char* sAt = L + 0 * CSLOT; LAS unsigned char* sBt = L + 1 * CSLOT; LAS unsigned char* sKt = L + 2 * CSLOT; LAS unsigned char* sRt = L + 3 * CSLOT;
    LAS unsigned char* sBtT = L + 4 * CSLOT; LAS unsigned char* sKtT = L + 5 * CSLOT; LAS unsigned char* sVT = L + 6 * CSLOT;
    LAS unsigned char* sA4 = L + 7 * CSLOT;
    LAS unsigned char* sRHST = L + 11 * CSLOT;
    LAS unsigned char* sXT = L + 0 * CSLOT;
    LAS unsigned char* sAD = L + 2 * CSLOT;
    LAS float* sDIAG = (LAS float*)(L + C_DIAG); LAS bf16_t* sDM = (LAS bf16_t*)(L + C_DM); LAS float* sGL = (LAS float*)(L + C_GL); LAS float* sSEGP = (LAS float*)(L + C_SEGP);
    const int tid = c.tid, w = c.wid, lane = c.lane, lr = lane & 15, lq = lane >> 4;
    for (int ci = c.bid; ci < BATCH * NH * (SEQ / CL); ci += c.G) {
        const int bh = ci >> 7, chunk = ci & 127, b = bh >> 3, h = bh & 7;
        const size_t gbase = (size_t)(b * SEQ + chunk * CL) * RW + h * 64;
        {
            const int kc = tid & 63, seg = tid >> 6;
            float p[8];
#pragma unroll
            for (int j = 0; j < 8; ++j) { const float wv = rw_w[gbase + (size_t)(8 * seg + j) * RW + kc]; p[j] = (j == 0) ? wv : p[j - 1] * wv; }
            sSEGP[seg * 64 + kc] = p[7];
            for (int i = tid; i < 4 * CSLOT / 16; i += 512) lds_st16(sA4 + i * 16, make_uint4(0u, 0u, 0u, 0u));
            __syncthreads();
            float pre = 1.0f;
#pragma unroll
            for (int s = 0; s < 7; ++s) { const float sp = sSEGP[s * 64 + kc]; pre = (s < seg) ? pre * sp : pre; }
            float atT[8], btT[8], ktT[8], vT[8];
            const float rkv = r_k[h * 64 + kc];
#pragma unroll
            for (int j = 0; j < 8; ++j) {
                const int t = 8 * seg + j; const size_t o = gbase + (size_t)t * RW + kc;
                const float G = pre * p[j], Gm1 = (j == 0) ? pre : pre * p[j - 1], inv = 1.0f / G;
                const float av = ldbf(rw_a + o), bv = ldbf(rw_b + o), kv = ldbf(rw_k + o), rv = ldbf(rw_r + o), vv = ldbf(rw_v + o);
                const float at = av * Gm1, bt = bv * inv, kt = kv * inv, rt = rv * G;
                *(LAS bf16_t*)(sAt + (t * CLD + kc) * 2) = (bf16_t)f2bf(at); *(LAS bf16_t*)(sBt + (t * CLD + kc) * 2) = (bf16_t)f2bf(bt);
                *(LAS bf16_t*)(sKt + (t * CLD + kc) * 2) = (bf16_t)f2bf(kt); *(LAS bf16_t*)(sRt + (t * CLD + kc) * 2) = (bf16_t)f2bf(rt);
                atT[j] = at; btT[j] = bt; ktT[j] = kt; vT[j] = vv;
                const float bs = wave_sum_u(rv * kv * rkv);
                if (lane == 0) bon[(size_t)ci * CL + t] = bs;
            }
            lds_st16(sRHST + (kc * CLD + 8 * seg) * 2, pack8(atT)); lds_st16(sBtT + (kc * CLD + 8 * seg) * 2, pack8(btT));
            lds_st16(sKtT + (kc * CLD + 8 * seg) * 2, pack8(ktT)); lds_st16(sVT + (kc * CLD + 8 * seg) * 2, pack8(vT));
            if (seg == 7) sGL[kc] = pre * p[7];
            __syncthreads();
        }
        for (int idx = w; idx < 40; idx += 8) {
            const int m = idx / 10, pr = idx % 10;
            const int ti = (pr >= 6) ? 3 : (pr >= 3) ? 2 : (pr >= 1) ? 1 : 0, si = pr - ti * (ti + 1) / 2;
            LAS const unsigned char* X = (m < 2) ? sAt : sRt; LAS const unsigned char* Y = (m & 1) ? sKt : sBt;
            f32x4_t acc = {0.f, 0.f, 0.f, 0.f};
#pragma unroll
            for (int ks = 0; ks < 2; ++ks) acc = MFMA16(ldsfrag(Y, 16 * si + lr, 32 * ks + 8 * lq), ldsfrag(X, 16 * ti + lr, 32 * ks + 8 * lq), acc);
            const int t = 16 * ti + lr, s0 = 16 * si + 4 * lq;
            float o[4];
#pragma unroll
            for (int rg = 0; rg < 4; ++rg) { const int s = s0 + rg; const bool keep = (m < 2) ? (s < t) : (s <= t); o[rg] = keep ? acc[rg] : 0.f; }
            lds_st8(sA4 + m * CSLOT + (t * CLD + s0) * 2, pack4(o[0], o[1], o[2], o[3]));
            if (m == 0 && ti == si) *(LAS f32x4_t*)(sDIAG + (ti * 16 + lr) * 16 + 4 * lq) = (f32x4_t){o[0], o[1], o[2], o[3]};
        }
        __syncthreads();
        if (w == 0) {
            float x[16];
#pragma unroll
            for (int r = 0; r < 16; ++r) {
                float acc = (r == lr) ? 1.0f : 0.0f;
                float nrow[16];
#pragma unroll
                for (int q4 = 0; q4 < 4; ++q4) { const f32x4_t nv = *(LAS const f32x4_t*)(sDIAG + (lq * 16 + r) * 16 + 4 * q4); nrow[4 * q4] = nv[0]; nrow[4 * q4 + 1] = nv[1]; nrow[4 * q4 + 2] = nv[2]; nrow[4 * q4 + 3] = nv[3]; }
#pragma unroll
                for (int s = 0; s < 16; ++s) if (s < r) acc = fmaf(nrow[s], x[s], acc);
                x[r] = acc;
                sDM[(lq * 16 + r) * 16 + lr] = (bf16_t)f2bf(acc);
            }
        } else {
            for (int idx = w - 1; idx < 16; idx += 7) {
                const int ti = idx >> 2, vi = idx & 3;
                f32x4_t acc = {0.f, 0.f, 0.f, 0.f};
#pragma unroll
                for (int ks = 0; ks < 2; ++ks) acc = MFMA16(ldsfrag(sA4 + 1 * CSLOT, 16 * ti + lr, 32 * ks + 8 * lq), ldsfrag(sVT, 16 * vi + lr, 32 * ks + 8 * lq), acc);
                lds_st8(sRHST + ((64 + 16 * vi + lr) * CLD + 16 * ti + 4 * lq) * 2, pack4(acc[0], acc[1], acc[2], acc[3]));
            }
        }
        __syncthreads();
        f32x4_t rd[4];
#pragma unroll
        for (int i = 0; i < 4; ++i) {
            bf16x8_t fa = zfrag(), fb = zfrag();
            if (lq < 2) { fa = *(LAS const bf16x8_t*)(sDM + (i * 16 + lr) * 16 + 8 * lq); fb = ldsfrag(sRHST, 16 * w + lr, 16 * i + 8 * lq); }
            rd[i] = MFMA16(fa, fb, ((f32x4_t){0.f, 0.f, 0.f, 0.f}));
        }
        if (w < 6) {
            const int i = (w >= 3) ? 3 : (w >= 1) ? 2 : 1, j = w - (i - 1) * i / 2;
            bf16x8_t fa = zfrag(), fb = zfrag();
            if (lq < 2) {
                fa = *(LAS const bf16x8_t*)(sDM + (i * 16 + lr) * 16 + 8 * lq);
#pragma unroll
                for (int jj = 0; jj < 8; ++jj) fb[jj] = (short)*(LAS const bf16_t*)(sA4 + ((16 * i + 8 * lq + jj) * CLD + 16 * j + lr) * 2);
            }
            const f32x4_t acc = MFMA16(fa, fb, ((f32x4_t){0.f, 0.f, 0.f, 0.f}));
#pragma unroll
            for (int rg = 0; rg < 4; ++rg) *(LAS bf16_t*)(sAD + ((16 * i + 4 * lq + rg) * CLD + 16 * j + lr) * 2) = (bf16_t)f2bf(acc[rg]);
        }
        __syncthreads();
#pragma unroll
        for (int i = 0; i < 4; ++i) {
            f32x4_t acc = rd[i];
            if (i >= 1) {
                bf16x8_t fa = zfrag(), fb = zfrag();
                if (8 * lq < 16 * i) { fa = ldsfrag(sAD, 16 * i + lr, 8 * lq); fb = ldsfrag(sXT, 16 * w + lr, 8 * lq); }
                acc = MFMA16(fa, fb, acc);
            }
            if (i == 3) {
                bf16x8_t fa = zfrag(), fb = zfrag();
                if (lq < 2) { fa = ldsfrag(sAD, 48 + lr, 32 + 8 * lq); fb = ldsfrag(sXT, 16 * w + lr, 32 + 8 * lq); }
                acc = MFMA16(fa, fb, acc);
            }
            lds_st8(sXT + ((16 * w + lr) * CLD + 16 * i + 4 * lq) * 2, pack4(acc[0], acc[1], acc[2], acc[3]));
            asm volatile("s_waitcnt lgkmcnt(0)" ::: "memory");
        }
        __syncthreads();
#pragma unroll
        for (int i = 0; i < 8; ++i) {
            const int kind = i >> 1, tile = w + 8 * (i & 1), r4 = tile >> 2, c4 = tile & 3;
            f32x4_t acc = {0.f, 0.f, 0.f, 0.f};
            if (kind == 0) {
#pragma unroll
                for (int ks = 0; ks < 2; ++ks) acc = MFMA16(ldsfrag(sXT, 16 * r4 + lr, 32 * ks + 8 * lq), ldsfrag(sBtT, 16 * c4 + lr, 32 * ks + 8 * lq), acc);
                const int k = 16 * c4 + lr, kp0 = 16 * r4 + 4 * lq; const float gl = sGL[k];
                float o[4];
#pragma unroll
                for (int rg = 0; rg < 4; ++rg) o[rg] = gl * (acc[rg] + ((k == kp0 + rg) ? 1.0f : 0.0f));
                *(uint2*)(Mq + (size_t)ci * 4096 + k * 64 + kp0) = pack4(o[0], o[1], o[2], o[3]);
            } else if (kind == 1) {
#pragma unroll
                for (int ks = 0; ks < 2; ++ks) {
                    acc = MFMA16(ldsfrag(sBtT, 16 * r4 + lr, 32 * ks + 8 * lq), ldsfrag(sXT, 64 + 16 * c4 + lr, 32 * ks + 8 * lq), acc);
                    acc = MFMA16(ldsfrag(sKtT, 16 * r4 + lr, 32 * ks + 8 * lq), ldsfrag(sVT, 16 * c4 + lr, 32 * ks + 8 * lq), acc);
                }
                const int k0 = 16 * r4 + 4 * lq; const f32x4_t gl = *(LAS const f32x4_t*)(sGL + k0);
                *(uint2*)(NTq + (size_t)ci * 4096 + (16 * c4 + lr) * 64 + k0) = pack4(gl[0] * acc[0], gl[1] * acc[1], gl[2] * acc[2], gl[3] * acc[3]);
            } else if (kind == 2) {
#pragma unroll
                for (int ks = 0; ks < 2; ++ks) acc = MFMA16(ldsfrag(sXT, 16 * r4 + lr, 32 * ks + 8 * lq), ldsfrag(sA4 + 2 * CSLOT, 16 * c4 + lr, 32 * ks + 8 * lq), acc);
                const int t = 16 * c4 + lr, kp0 = 16 * r4 + 4 * lq;
                const uint2 rv = lds_ld8(sRt + (t * CLD + kp0) * 2);
                *(uint2*)(Qq + (size_t)ci * 4096 + t * 64 + kp0) = pack4(acc[0] + bf2f(rv.x & 0xffffu), acc[1] + bf2f(rv.x >> 16), acc[2] + bf2f(rv.y & 0xffffu), acc[3] + bf2f(rv.y >> 16));
            } else {
#pragma unroll
                for (int ks = 0; ks < 2; ++ks) {
                    acc = MFMA16(ldsfrag(sA4 + 2 * CSLOT, 16 * r4 + lr, 32 * ks + 8 * lq), ldsfrag(sXT, 64 + 16 * c4 + lr, 32 * ks + 8 * lq), acc);
                    acc = MFMA16(ldsfrag(sA4 + 3 * CSLOT, 16 * r4 + lr, 32 * ks + 8 * lq), ldsfrag(sVT, 16 * c4 + lr, 32 * ks + 8 * lq), acc);
                }
                *(uint2*)(YTq + (size_t)ci * 4096 + (16 * c4 + lr) * 64 + 16 * r4 + 4 * lq) = pack4(acc[0], acc[1], acc[2], acc[3]);
            }
        }
        __syncthreads();
    }
}

__device__ __forceinline__ void rwkv_phaseB(const Ctx& c, const int bh, const int w) {
    const bf16_t* __restrict__ Mq = (const bf16_t*)(c.ws + WS_CM); const bf16_t* __restrict__ NTq = (const bf16_t*)(c.ws + WS_CN); bf16_t* __restrict__ Sst = (bf16_t*)(c.ws + WS_CS);
    const int lane = c.lane, lr = lane & 15, lq = lane >> 4;
    LAS unsigned char* sS = c.lds + 69632 + c.wid * (16 * CLD * 2);
    {
        {
            bf16x8_t sB0 = zfrag(), sB1 = zfrag();
            bf16x8_t ma[4][4][2]; uint2 nv[4][4];
            const size_t ci0 = (size_t)bh * (SEQ / CL);
#define RB_LOAD(slot, cidx) do { _Pragma("unroll") for (int kt = 0; kt < 4; ++kt) { _Pragma("unroll") for (int ks = 0; ks < 2; ++ks) \
                ma[slot][kt][ks] = *(const bf16x8_t*)(Mq + (cidx) * 4096 + (16 * kt + lr) * 64 + 32 * ks + 8 * lq); nv[slot][kt] = *(const uint2*)(NTq + (cidx) * 4096 + (16 * w + lr) * 64 + 16 * kt + 4 * lq); } } while (0)
#pragma unroll
            for (int sl = 0; sl < 4; ++sl) RB_LOAD(sl, ci0 + sl);
#pragma unroll
            for (int chunk = 0; chunk < SEQ / CL; chunk += 4) {
#pragma unroll
                for (int sl = 0; sl < 4; ++sl) {
                    const size_t ci = ci0 + chunk + sl;
                    *(bf16x8_t*)(Sst + ci * 4096 + (16 * w + lr) * 64 + 8 * lq) = sB0; *(bf16x8_t*)(Sst + ci * 4096 + (16 * w + lr) * 64 + 32 + 8 * lq) = sB1;
#pragma unroll
                    for (int kt = 0; kt < 4; ++kt) {
                        f32x4_t acc = {bf2f(nv[sl][kt].x & 0xffffu), bf2f(nv[sl][kt].x >> 16), bf2f(nv[sl][kt].y & 0xffffu), bf2f(nv[sl][kt].y >> 16)};
                        acc = MFMA16(ma[sl][kt][0], sB0, acc); acc = MFMA16(ma[sl][kt][1], sB1, acc);
                        lds_st8(sS + (lr * CLD + 16 * kt + 4 * lq) * 2, pack4(acc[0], acc[1], acc[2], acc[3]));
                    }
                    const size_t cn = (chunk + sl + 4 < SEQ / CL) ? ci + 4 : ci;
                    RB_LOAD(sl, cn);
                    asm volatile("s_waitcnt lgkmcnt(0)" ::: "memory");
                    sB0 = ldsfrag(sS, lr, 8 * lq); sB1 = ldsfrag(sS, lr, 32 + 8 * lq);
                    asm volatile("s_waitcnt lgkmcnt(0)" ::: "memory");
                }
            }
#undef RB_LOAD
        }
    }
}

__device__ __forceinline__ void rwkv_phaseC(const Ctx& c) {
    const bf16_t* __restrict__ Qq = (const bf16_t*)(c.ws + WS_CQ); const bf16_t* __restrict__ YTq = (const bf16_t*)(c.ws + WS_CY); const bf16_t* __restrict__ Sst = (const bf16_t*)(c.ws + WS_CS);
    const float* __restrict__ bon = (const float*)(c.ws + WS_CBON);
    const bf16_t* rw_v = (const bf16_t*)(c.ws + WS_RW_V); const bf16_t* rw_g = (const bf16_t*)(c.ws + WS_RW_G);
    const float* ln_w = c.in[18]; const float* ln_b = c.in[19];
    bf16_t* ycat = (bf16_t*)(c.ws + WS_A);
    const int w = c.wid, lane = c.lane, lr = lane & 15, lq = lane >> 4;
    LAS float* sY = (LAS float*)(c.lds + w * (16 * 68 * 4));
    const int gw = c.bid * 8 + c.wid, NW = c.G * 8;
    for (int task = gw; task < BATCH * NH * (SEQ / CL) * 4; task += NW) {
        const size_t ci = (size_t)(task >> 2); const int tt = task & 3;
        const int bh = (int)(ci >> 7), chunk = (int)(ci & 127), b = bh >> 3, h = bh & 7;
        bf16x8_t qa[2];
#pragma unroll
        for (int ks = 0; ks < 2; ++ks) qa[ks] = *(const bf16x8_t*)(Qq + ci * 4096 + (16 * tt + lr) * 64 + 32 * ks + 8 * lq);
#pragma unroll
        for (int vt = 0; vt < 4; ++vt) {
            const uint2 yv = *(const uint2*)(YTq + ci * 4096 + (16 * vt + lr) * 64 + 16 * tt + 4 * lq);
            f32x4_t acc = {bf2f(yv.x & 0xffffu), bf2f(yv.x >> 16), bf2f(yv.y & 0xffffu), bf2f(yv.y >> 16)};
#pragma unroll
            for (int ks = 0; ks < 2; ++ks) acc = MFMA16(qa[ks], *(const bf16x8_t*)(Sst + ci * 4096 + (16 * vt + lr) * 64 + 32 * ks + 8 * lq), acc);
#pragma unroll
            for (int rg = 0; rg < 4; ++rg) sY[(4 * lq + rg) * 68 + 16 * vt + lr] = acc[rg];
        }
        asm volatile("s_waitcnt lgkmcnt(0)" ::: "memory");
        const int hn = h * 64 + lane;
        const float lw = ln_w[hn], lb = ln_b[hn];
#pragma unroll 4
        for (int tr = 0; tr < 16; ++tr) {
            const int t = chunk * CL + 16 * tt + tr; const size_t tok = (size_t)b * SEQ + t;
            const float y = sY[tr * 68 + lane];
            const float mean = wave_sum_u(y) * (1.f / 64.f);
            const float d = y - mean;
            const float var = wave_sum_u(d * d) * (1.f / 64.f);
            const float yn = d * rsqrtf(var + 64e-5f) * lw + lb;
            const float bonus = bon[ci * CL + 16 * tt + tr] * ldbf(rw_v + tok * RW + hn);
            ycat[tok * D + hn] = (bf16_t)f2bf((yn + bonus) * ldbf(rw_g + tok * RW + hn));
        }
        asm volatile("s_waitcnt lgkmcnt(0)" ::: "memory");
    }
}

__device__ __forceinline__ void phase6a(const Ctx& c) { rwkv_phaseA(c); }

__device__ __forceinline__ void phase6b(const Ctx& c) {
    if (c.wid == 0) {
        for (int tk = c.bid; tk < 2 * S5NG * BATCH; tk += c.G) {
            if (tk < BATCH * NH * 4) { rwkv_phaseB(c, tk >> 2, tk & 3); continue; }
            const float* apow = (const float*)(c.ws + WS_APOW); const float* E = (const float*)((const unsigned char*)c.out + OUT_E);
            bf16_t* ux = (bf16_t*)((unsigned char*)c.out + OUT_UX);
            const int task = tk - BATCH * NH * 4;
            const int g = task >> 2, b = task & 3, p = c.lane;
            const float pr = apow[((size_t)(g * (S5L + 1) + S5L) * 64 + p) * 2], pi = apow[((size_t)(g * (S5L + 1) + S5L) * 64 + p) * 2 + 1];
            float xr = 0.f, xi = 0.f;
            const size_t row0 = (size_t)g * 1024 + b * 256;
            float er[2][8], ei[2][8];
#pragma unroll
            for (int q = 0; q < 8; ++q) { er[0][q] = E[(row0 + q) * 128 + p]; ei[0][q] = E[(row0 + q) * 128 + 64 + p]; }
#pragma unroll
            for (int bt = 0; bt < 32; ++bt) {
                const int cur = bt & 1, nx = cur ^ 1, ch0 = bt * 8;
                if (bt + 1 < 32) {
#pragma unroll
                    for (int q = 0; q < 8; ++q) { er[nx][q] = E[(row0 + ch0 + 8 + q) * 128 + p]; ei[nx][q] = E[(row0 + ch0 + 8 + q) * 128 + 64 + p]; }
                }
#pragma unroll
                for (int q = 0; q < 8; ++q) {
                    ux[(row0 + ch0 + q) * 640 + 512 + p] = (bf16_t)f2bf(xr); ux[(row0 + ch0 + q) * 640 + 576 + p] = (bf16_t)f2bf(xi);
                    const float nr = pr * xr - pi * xi + er[cur][q], ni = pr * xi + pi * xr + ei[cur][q]; xr = nr; xi = ni;
                }
            }
        }
    } else {
        convert_expert_weights(c, c.bid * 7 + (c.wid - 1), c.G * 7);
    }
}

__device__ __forceinline__ void phase7(const Ctx& c) {
    {
        pg8::Gemm g{(const bf16_t*)((unsigned char*)c.out + OUT_UX), (const bf16_t*)(c.ws + WS_KMAT), 0, 0, 640};
        pg8::S5Order S{256, 2, c.G, c.bid};
        pg8::EpiS5Out E{(bf16_t*)(c.ws + WS_YS5)};
        pg8::gemm_phase<pg8::EpiS5Out, pg8::S5Order, true, true>(c.lds, g, S, E);
    }
    __syncthreads();
    rwkv_phaseC(c);
}

__device__ __forceinline__ void phase8(const Ctx& c) {
    pg8::Gemm g{(const bf16_t*)(c.ws + WS_YS5), (const bf16_t*)(c.ws + WS_WGLU_T), T, 512, 512};
    pg8::StaticOrder S; S.init(T, 512, c.G, c.bid);
    pg8::EpiGLU E{(const bf16_t*)(c.ws + WS_YS5), 512, c.in[29], (bf16_t*)(c.ws + WS_A), D, 512};
    pg8::gemm_phase<pg8::EpiGLU, pg8::StaticOrder, true, true>(c.lds, g, S, E);
}

__device__ __forceinline__ void phase9(const Ctx& c) {
    pg8::Gemm g{(const bf16_t*)(c.ws + WS_A), (const bf16_t*)(c.ws + WS_WOUT_T), T, D, D};
    pg8::StaticOrder S; S.init(T, D, c.G, c.bid);
    pg8::EpiF32 E{(float*)(c.ws + WS_PROJ), D};
    pg8::gemm_phase<pg8::EpiF32, pg8::StaticOrder, true, true>(c.lds, g, S, E);
}

__device__ __forceinline__ void phase10(const Ctx& c) {
    const float* x = c.in[0]; const float* gpm = c.in[5]; const float* gpf = c.in[6];
    const float* mods = (const float*)(c.ws + WS_MODS); const float* mixed = (const float*)(c.ws + WS_PROJ);
    bf16_t* h2 = (bf16_t*)(c.ws + WS_A); float* x1o = c.out;
    const int gw = c.bid * 8 + c.wid, NW = c.G * 8;
    for (int t = gw; t < T; t += NW) {
        const int b = t / SEQ;
        const float4* mr = (const float4*)(mixed + (size_t)t * D) + c.lane;
        const float4* xr = (const float4*)(x + (size_t)t * D) + c.lane;
        float4 m[4], v[4]; float ss = 0.f;
#pragma unroll
        for (int j = 0; j < 4; ++j) { m[j] = mr[64 * j]; v[j] = xr[64 * j]; ss += m[j].x * m[j].x + m[j].y * m[j].y + m[j].z * m[j].z + m[j].w * m[j].w; }
        const float rstd = rsqrtf(wave_sum(ss) * (1.0f / D) + 1e-6f);
        float s1 = 0.f;
#pragma unroll
        for (int j = 0; j < 4; ++j) {
            const int k = (c.lane + 64 * j) * 4;
            const float4 gg = *(const float4*)(gpm + k);
            const float4 gt = *(const float4*)(mods + b * NMODS + 2 * D + k);
            v[j].x += gt.x * (m[j].x * rstd * gg.x); v[j].y += gt.y * (m[j].y * rstd * gg.y);
            v[j].z += gt.z * (m[j].z * rstd * gg.z); v[j].w += gt.w * (m[j].w * rstd * gg.w);
            s1 += v[j].x * v[j].x + v[j].y * v[j].y + v[j].z * v[j].z + v[j].w * v[j].w;
            ((float4*)(x1o + (size_t)t * D) + c.lane)[64 * j] = v[j];
        }
        const float rstd1 = rsqrtf(wave_sum(s1) * (1.0f / D) + 1e-6f);
#pragma unroll
        for (int j = 0; j < 4; ++j) {
            const int k = (c.lane + 64 * j) * 4;
            const float4 gg = *(const float4*)(gpf + k);
            const float4 sh = *(const float4*)(mods + b * NMODS + 3 * D + k);
            const float4 sc = *(const float4*)(mods + b * NMODS + 4 * D + k);
            float r[4];
            r[0] = v[j].x * rstd1 * gg.x * (1.f + sc.x) + sh.x; r[1] = v[j].y * rstd1 * gg.y * (1.f + sc.y) + sh.y;
            r[2] = v[j].z * rstd1 * gg.z * (1.f + sc.z) + sh.z; r[3] = v[j].w * rstd1 * gg.w * (1.f + sc.w) + sh.w;
            unsigned hi[4]; float lo[4];
#pragma unroll
            for (int q = 0; q < 4; ++q) { hi[q] = f2bf(r[q]); lo[q] = r[q] - bf2f(hi[q]); }
            ((uint2*)(h2 + (size_t)t * D) + c.lane)[64 * j] = make_uint2(hi[0] | (hi[1] << 16), hi[2] | (hi[3] << 16));
            ((uint2*)(h2 + (size_t)(T + t) * D) + c.lane)[64 * j] = make_uint2(pk2(lo[0], lo[1]), pk2(lo[2], lo[3]));
        }
    }
}

__device__ __forceinline__ void phase11(const Ctx& c) {
    {
        pg8::Gemm g{(const bf16_t*)(c.ws + WS_A), (const bf16_t*)(c.ws + WS_WR_T), 2 * T, 512, D};
        pg8::StaticOrder S; S.init(2 * T, 512, c.G, c.bid);
        pg8::EpiF32 E{(float*)(c.ws + WS_PLOG), 512};
        pg8::gemm_phase<pg8::EpiF32, pg8::StaticOrder, true, true>(c.lds, g, S, E);
    }
    __syncthreads();
    {
        pg8::Gemm g{(const bf16_t*)(c.ws + WS_A), (const bf16_t*)(c.ws + WS_WSGU_T), T, 512, D};
        pg8::StaticOrder S; S.init(T, 512, c.G, c.bid);
        pg8::EpiSwiGLU E{(bf16_t*)(c.ws + WS_HS), 256};
        pg8::gemm_phase<pg8::EpiSwiGLU, pg8::StaticOrder, true, true>(c.lds, g, S, E);
    }
}

#define DPPU(v, ctrl) ((unsigned)__builtin_amdgcn_mov_dpp((int)(v), (ctrl), 0xf, 0xf, true))
#define DPPF(v, ctrl) __builtin_bit_cast(float, __builtin_amdgcn_mov_dpp(__builtin_bit_cast(int, (v)), (ctrl), 0xf, 0xf, true))
__device__ __forceinline__ unsigned fkey(float f) { const unsigned u = __builtin_bit_cast(unsigned, f); return u ^ ((u >> 31) ? 0xffffffffu : 0x80000000u); }
__device__ __forceinline__ unsigned wave_umax(unsigned v) {
    v = max(v, DPPU(v, 0xB1)); v = max(v, DPPU(v, 0x4E)); v = max(v, DPPU(v, 0x141)); v = max(v, DPPU(v, 0x140));
    const unsigned a = __builtin_amdgcn_readlane(v, 0), b = __builtin_amdgcn_readlane(v, 16), c = __builtin_amdgcn_readlane(v, 32), d = __builtin_amdgcn_readlane(v, 48);
    return max(max(a, b), max(c, d));
}
__device__ __forceinline__ unsigned wave_umin(unsigned v) {
    v = min(v, DPPU(v, 0xB1)); v = min(v, DPPU(v, 0x4E)); v = min(v, DPPU(v, 0x141)); v = min(v, DPPU(v, 0x140));
    const unsigned a = __builtin_amdgcn_readlane(v, 0), b = __builtin_amdgcn_readlane(v, 16), c = __builtin_amdgcn_readlane(v, 32), d = __builtin_amdgcn_readlane(v, 48);
    return min(min(a, b), min(c, d));
}
__device__ __forceinline__ void phase12(const Ctx& c) {
    const float* plog = (const float*)(c.ws + WS_PLOG); const float* rb = c.in[32];
    int* idx = (int*)(c.ws + WS_IDX); float* wt = (float*)(c.ws + WS_WT); unsigned* counts = (unsigned*)(c.ws + WS_COUNTS);
    const int gw = c.bid * 8 + c.wid, NW = c.G * 8, l = c.lane;
    const float4 bias = *(const float4*)(rb + l * 4);
    for (int t = gw; t < T; t += NW) {
        const float4 p0 = *(const float4*)(plog + (size_t)t * 512 + l * 4), p1 = *(const float4*)(plog + (size_t)t * 512 + 256 + l * 4);
        const float4 p2 = *(const float4*)(plog + (size_t)(T + t) * 512 + l * 4), p3 = *(const float4*)(plog + (size_t)(T + t) * 512 + 256 + l * 4);
        const float lg[4] = {p0.x + (p1.x + p2.x + p3.x), p0.y + (p1.y + p2.y + p3.y), p0.z + (p1.z + p2.z + p3.z), p0.w + (p1.w + p2.w + p3.w)};
        float s[4] = {sigmoidf_(lg[0]), sigmoidf_(lg[1]), sigmoidf_(lg[2]), sigmoidf_(lg[3])};
        float ch[4] = {s[0] + bias.x, s[1] + bias.y, s[2] + bias.z, s[3] + bias.w};
        float a1 = fmaxf(ch[0], ch[1]), a2 = fminf(ch[0], ch[1]);
        { const float b1 = fmaxf(ch[2], ch[3]), b2 = fminf(ch[2], ch[3]); const float n1 = fmaxf(a1, b1), n2 = fmaxf(fminf(a1, b1), fmaxf(a2, b2)); a1 = n1; a2 = n2; }
        { const float b1 = DPPF(a1, 0xB1), b2 = DPPF(a2, 0xB1); const float n1 = fmaxf(a1, b1), n2 = fmaxf(fminf(a1, b1), fmaxf(a2, b2)); a1 = n1; a2 = n2; }
        { const float b1 = DPPF(a1, 0x4E), b2 = DPPF(a2, 0x4E); const float n1 = fmaxf(a1, b1), n2 = fmaxf(fminf(a1, b1), fmaxf(a2, b2)); a1 = n1; a2 = n2; }
        { const float b1 = DPPF(a1, 0x141), b2 = DPPF(a2, 0x141); const float n1 = fmaxf(a1, b1), n2 = fmaxf(fminf(a1, b1), fmaxf(a2, b2)); a1 = n1; a2 = n2; }
        const float gs = a1 + a2; const int myg = l >> 3;
        int rank = 0;
#pragma unroll
        for (int g = 0; g < 8; ++g) { const float og = __builtin_bit_cast(float, __builtin_amdgcn_readlane(__builtin_bit_cast(int, gs), g * 8)); rank += (og > gs || (og == gs && g < myg)) ? 1 : 0; }
        const bool sel = rank < 4;
        unsigned mk[4];
#pragma unroll
        for (int i = 0; i < 4; ++i) mk[i] = sel ? fkey(ch[i]) : 0u;
        float sk[8]; int ek[8]; float ssum = 0.f;
#pragma unroll
        for (int k = 0; k < 8; ++k) {
            const unsigned lm = max(max(mk[0], mk[1]), max(mk[2], mk[3]));
            const unsigned m = wave_umax(lm);
            unsigned cand = 1023u;
#pragma unroll
            for (int i = 3; i >= 0; --i) if (mk[i] == m) cand = (unsigned)(l * 4 + i);
            const int be = (int)wave_umin(cand);
            const int ii = be & 3;
            float sv = s[0]; sv = (ii == 1) ? s[1] : sv; sv = (ii == 2) ? s[2] : sv; sv = (ii == 3) ? s[3] : sv;
            sv = __builtin_bit_cast(float, __builtin_amdgcn_readlane(__builtin_bit_cast(int, sv), be >> 2));
            if ((be >> 2) == l) {
#pragma unroll
                for (int i = 0; i < 4; ++i) if (i == ii) mk[i] = 0u;
            }
            sk[k] = sv; ek[k] = be; ssum += sv;
        }
        if (l == 0) {
            const float inv = 2.5f / ssum;
#pragma unroll
            for (int k = 0; k < 8; ++k) { idx[t * 8 + k] = ek[k]; wt[t * 8 + k] = sk[k] * inv; atomicAdd(&counts[ek[k]], 1u); }
        }
    }
}

__device__ __forceinline__ void build_ustart(const Ctx& c, int* smi) {
    const unsigned* counts = (const unsigned*)(c.ws + WS_COUNTS);
    __syncthreads();
    if (c.tid < NE) smi[300 + c.tid] = ((int)counts[c.tid] + 255) >> 8;
    __syncthreads();
    if (c.tid < 64) {
        const int l = c.tid; const int u0 = smi[300 + l * 4], u1 = smi[300 + l * 4 + 1], u2 = smi[300 + l * 4 + 2], u3 = smi[300 + l * 4 + 3];
        const int tot = u0 + u1 + u2 + u3; int inc = tot;
#pragma unroll
        for (int o = 1; o < 64; o <<= 1) { const int v = __shfl_up(inc, o); if (l >= o) inc += v; }
        const int ex = inc - tot;
        smi[l * 4] = ex; smi[l * 4 + 1] = ex + u0; smi[l * 4 + 2] = ex + u0 + u1; smi[l * 4 + 3] = ex + u0 + u1 + u2;
        if (l == 63) smi[NE] = inc;
    }
    __syncthreads();
}

__device__ __forceinline__ void phase13(const Ctx& c) {
    int* smi = (int*)c.sm;
    build_ustart(c, smi);
    const int* idx = (const int*)(c.ws + WS_IDX); int* slotp = (int*)(c.ws + WS_SLOTP); int* uexp = (int*)(c.ws + WS_UEXP);
    unsigned* cursor = (unsigned*)(c.ws + WS_COUNTS) + 256; const unsigned* counts = (const unsigned*)(c.ws + WS_COUNTS);
    const int gt = c.bid * 512 + c.tid, NT = c.G * 512;
    for (int a = gt; a < T * 8; a += NT) {
        const int e = idx[a];
        const unsigned pos = atomicAdd(&cursor[e], 1u);
        slotp[smi[e] * 256 + (int)pos] = a;
    }
    for (int e = gt; e < NE; e += NT) {
        const int u0 = smi[e], u1 = smi[e + 1], cn = (int)counts[e];
        for (int p = cn; p < (u1 - u0) * 256; ++p) slotp[u0 * 256 + p] = -1;
        for (int u = u0; u < u1; ++u) uexp[u] = e;
    }
    if (gt == 0) uexp[2048] = smi[NE];
}

__device__ __forceinline__ void phase14(const Ctx& c) {
    const int* uexp = (const int*)(c.ws + WS_UEXP);
    const int NU = __builtin_amdgcn_readfirstlane(uexp[2048]);
    const int vcu = (c.G % 8 == 0) ? (c.bid % 8) * (c.G / 8) + c.bid / 8 : c.bid;
    pg8::Gemm g{(const bf16_t*)(c.ws + WS_A), (const bf16_t*)(c.ws + WS_WEGU), 0, 0, D, (const int*)(c.ws + WS_SLOTP)};
    pg8::ExpertOrder S{uexp, NU, 2, c.G, vcu};
    pg8::EpiSwiGLU E{(bf16_t*)(c.ws + WS_HID), 256};
    pg8::gemm_phase<pg8::EpiSwiGLU, pg8::ExpertOrder, true, true, true>(c.lds, g, S, E);
}

__device__ __forceinline__ void phase15(const Ctx& c) {
    {
        const int* uexp = (const int*)(c.ws + WS_UEXP);
        const int NU = __builtin_amdgcn_readfirstlane(uexp[2048]);
        const int vcu = (c.G % 8 == 0) ? (c.bid % 8) * (c.G / 8) + c.bid / 8 : c.bid;
        pg8::Gemm g{(const bf16_t*)(c.ws + WS_HID), (const bf16_t*)(c.ws + WS_WED), 0, 0, EFF};
        pg8::ExpertOrder S{uexp, NU, 4, c.G, vcu};
        pg8::EpiScatter E{(const int*)(c.ws + WS_SLOTP), (const float*)(c.ws + WS_WT), (bf16_t*)(c.ws + WS_YEXP), D};
        pg8::gemm_phase<pg8::EpiScatter, pg8::ExpertOrder, true, true>(c.lds, g, S, E);
    }
    __syncthreads();
    {
        pg8::Gemm g{(const bf16_t*)(c.ws + WS_HS), (const bf16_t*)(c.ws + WS_WSD_T), T, D, 256};
        pg8::StaticOrder S; S.init(T, D, c.G, c.bid);
        pg8::EpiF32 E{(float*)(c.ws + WS_SHOUT), D};
        pg8::gemm_phase<pg8::EpiF32, pg8::StaticOrder, true, true>(c.lds, g, S, E);
    }
}

__device__ __forceinline__ void phase16(const Ctx& c) {
    const float* gq = c.in[7]; const float* mods = (const float*)(c.ws + WS_MODS);
    const float* shout = (const float*)(c.ws + WS_SHOUT); const bf16_t* yexp = (const bf16_t*)(c.ws + WS_YEXP);
    float* out = c.out;
    const int gw = c.bid * 8 + c.wid, NW = c.G * 8;
    for (int t = gw; t < T; t += NW) {
        const int b = t / SEQ;
        float4 y[4]; float ss = 0.f;
#pragma unroll
        for (int j = 0; j < 4; ++j) {
            const int k = (c.lane + 64 * j) * 4;
            float4 a = *(const float4*)(shout + (size_t)t * D + k);
#pragma unroll
            for (int q = 0; q < 8; ++q) {
                const float4 v = ldbf4(yexp + (size_t)(t * 8 + q) * D + k);
                a.x += v.x; a.y += v.y; a.z += v.z; a.w += v.w;
            }
            y[j] = a; ss += a.x * a.x + a.y * a.y + a.z * a.z + a.w * a.w;
        }
        const float rstd = rsqrtf(wave_sum(ss) * (1.0f / D) + 1e-6f);
#pragma unroll
        for (int j = 0; j < 4; ++j) {
            const int k = (c.lane + 64 * j) * 4;
            const float4 gg = *(const float4*)(gq + k);
            const float4 gt = *(const float4*)(mods + b * NMODS + 5 * D + k);
            float4 x1 = *(const float4*)(out + (size_t)t * D + k);
            x1.x += gt.x * (y[j].x * rstd * gg.x); x1.y += gt.y * (y[j].y * rstd * gg.y);
            x1.z += gt.z * (y[j].z * rstd * gg.z); x1.w += gt.w * (y[j].w * rstd * gg.w);
            *(float4*)(out + (size_t)t * D + k) = x1;
        }
    }
}

constexpr int NPHASES = 18;

__global__ void __launch_bounds__(512, 2) mega(Args args) {
    extern __shared__ __attribute__((aligned(16))) unsigned char lds_raw[];
    Ctx c;
    c.in = args.in; c.out = args.out; c.ws = args.ws;
    c.lds = (LAS unsigned char*)lds_raw; c.sm = (float*)lds_raw;
    c.tid = threadIdx.x; c.lane = c.tid & 63; c.wid = __builtin_amdgcn_readfirstlane(c.tid >> 6); c.bid = blockIdx.x; c.G = gridDim.x;
    volatile LAS unsigned* st = (volatile LAS unsigned*)(c.lds + LDS_CTL_OFF);
    if (c.tid < 4) st[c.tid] = 0u;
    __syncthreads();
    XcdBarrier bar; bar.bar = (unsigned*)(args.ws + WS_CTL); bar.x = 0; bar.st = st;
    const bool multi = (args.hi - args.lo) > 1;
    if (multi) bar = xcd_barrier_post((unsigned*)(args.ws + WS_CTL), st);
    const int lo = args.lo, hi = args.hi;
#ifndef REPEAT_PHASE
#define REPEAT_PHASE -1
#endif
#define LAUNDER() do { int t_ = threadIdx.x; asm volatile("" : "+v"(t_)); c.tid = t_; c.lane = t_ & 63; int b_ = blockIdx.x; asm volatile("" : "+s"(b_)); c.bid = b_; } while (0)
#define RUN_PHASE(k, call) if (lo <= (k) && (k) < hi) { if ((k) == REPEAT_PHASE) { LAUNDER(); call; xcd_barrier(bar); } LAUNDER(); call; if ((k) + 1 < hi) xcd_barrier(bar); }
    RUN_PHASE(0, phase0(c))
    RUN_PHASE(1, phase1(c))
    RUN_PHASE(2, phase2(c))
    RUN_PHASE(3, phase3(c))
    RUN_PHASE(4, phase4(c))
    RUN_PHASE(5, phase5(c))
    RUN_PHASE(6, phase6a(c))
    RUN_PHASE(7, phase6b(c))
    RUN_PHASE(8, phase7(c))
    RUN_PHASE(9, phase8(c))
    RUN_PHASE(10, phase9(c))
    RUN_PHASE(11, phase10(c))
    RUN_PHASE(12, phase11(c))
    RUN_PHASE(13, phase12(c))
    RUN_PHASE(14, phase13(c))
    RUN_PHASE(15, phase14(c))
    RUN_PHASE(16, phase15(c))
    RUN_PHASE(17, phase16(c))
#undef RUN_PHASE
}

#ifndef N_LAUNCH_MODE
#define N_LAUNCH_MODE 1
#endif

extern "C" void kernel_launch(void* const* d_in, const int* in_sizes, int n_in, void* d_out, int out_size, void* d_ws, size_t ws_size, hipStream_t stream) {
    static int grid = 0;
    if (grid == 0) {
        if (n_in != 39 || out_size != T * D || ws_size < WS_END) { fprintf(stderr, "kernel_launch: unexpected shapes n_in %d out %d ws %zu\n", n_in, out_size, ws_size); grid = -1; return; }
        int dev = 0, cus = 0, per_cu = 0;
        if (hipGetDevice(&dev) != hipSuccess || hipDeviceGetAttribute(&cus, hipDeviceAttributeMultiprocessorCount, dev) != hipSuccess) { grid = -1; return; }
        if (hipFuncSetAttribute((const void*)mega, hipFuncAttributeMaxDynamicSharedMemorySize, LDS_BYTES) != hipSuccess) { grid = -1; return; }
        if (hipOccupancyMaxActiveBlocksPerMultiprocessor(&per_cu, (const void*)mega, 512, LDS_BYTES) != hipSuccess || per_cu < 1) { fprintf(stderr, "kernel_launch: occupancy query says %d\n", per_cu); }
        (void)hipGetLastError();
        grid = cus;
    }
    if (grid < 0) return;
    (void)hipMemsetAsync((char*)d_ws + WS_CTL, 0, CTL_BYTES, stream);
    Args a{};
    for (int i = 0; i < 39; ++i) a.in[i] = (const float*)d_in[i];
    a.out = (float*)d_out; a.ws = (unsigned char*)d_ws;
    if (N_LAUNCH_MODE == 1) {
        a.lo = 0; a.hi = NPHASES;
        hipLaunchKernelGGL(mega, dim3(grid), dim3(512), LDS_BYTES, stream, a);
    } else {
        for (int ph = 0; ph < NPHASES; ++ph) {
            a.lo = ph; a.hi = ph + 1;
            hipLaunchKernelGGL(mega, dim3(grid), dim3(512), LDS_BYTES, stream, a);
        }
    }
}
```

```cpp
#include <hip/hip_runtime.h>
#include <cstdint>
#include <cstdio>

#define LAS __attribute__((address_space(3)))

constexpr int D = 1024, BATCH = 4, SEQ = 8192, T = BATCH * SEQ;
constexpr int RW = 512, NH = 8;
constexpr int RPROJ = 1792, NPROJ = 2304;
constexpr int S5NG = 32, S5P = 64;
constexpr int NE = 256, EFF = 256;
constexpr int NMODS = 6 * D;
constexpr int S5L = 32;

constexpr size_t MiB = 1u << 20;
constexpr size_t WS_CTL = 0, CTL_BYTES = 1 * MiB;
constexpr size_t WS_COUNTS = 64 * 1024;
constexpr size_t WS_MODS = 1 * MiB;
constexpr size_t WS_HMAT = 2 * MiB;
constexpr size_t WS_WIN_T = 12 * MiB;
constexpr size_t WS_WOUT_T = 17 * MiB;
constexpr size_t WS_WGLU_T = 19 * MiB;
constexpr size_t WS_WSGU_T = 19 * MiB + 512 * 1024;
constexpr size_t WS_WSD_T = 20 * MiB + 512 * 1024;
constexpr size_t WS_WR_T = 21 * MiB;
constexpr size_t WS_LORA_BT = 22 * MiB;
constexpr size_t WS_APOW = 23 * MiB;
constexpr size_t WS_KMAT = 1000 * MiB;
constexpr size_t WS_MODSP = 1020 * MiB;
constexpr size_t WS_S5BB = 1022 * MiB;
constexpr size_t WS_KLAG = 1022 * MiB + 512 * 1024;
constexpr size_t OUT_UX = 0;
constexpr size_t OUT_E = 40 * MiB;
constexpr size_t OUT_ALORA = 56 * MiB;
constexpr size_t OUT_KF = 72 * MiB;
constexpr size_t WS_WED = 24 * MiB;
constexpr size_t WS_WEGU = 152 * MiB;
constexpr size_t WS_A = 408 * MiB;
constexpr size_t WS_YS5 = WS_A + 64 * MiB;
constexpr size_t WS_PROJ = 536 * MiB;
constexpr size_t WS_RW = 680 * MiB;
constexpr size_t RWSZ = (size_t)T * RW * 4;
constexpr size_t RWSZH = (size_t)T * RW * 2;
constexpr size_t WS_RW_W = WS_RW, WS_RW_Y = WS_RW + RWSZ, WS_RW_R = WS_RW + 2 * RWSZ, WS_RW_K = WS_RW_R + RWSZH, WS_RW_V = WS_RW_K + RWSZH,
                 WS_RW_A = WS_RW_V + RWSZH, WS_RW_B = WS_RW_A + RWSZH, WS_RW_G = WS_RW_B + RWSZH;
constexpr size_t WS_CM = WS_PROJ, WS_CN = WS_PROJ + 32 * MiB, WS_CQ = WS_PROJ + 64 * MiB, WS_CY = WS_PROJ + 96 * MiB;
constexpr size_t WS_CS = WS_RW_Y, WS_CBON = WS_RW_Y + 32 * MiB;
constexpr size_t WS_PLOG = 680 * MiB;
constexpr size_t WS_SHOUT = 680 * MiB;
constexpr size_t WS_HS = 808 * MiB;
constexpr size_t WS_IDX = 824 * MiB;
constexpr size_t WS_WT = 825 * MiB;
constexpr size_t WS_SLOTP = 826 * MiB;
constexpr size_t WS_UEXP = 827 * MiB + 512 * 1024;
constexpr size_t WS_SLOTW = 828 * MiB;
constexpr size_t WS_HIST = 831 * MiB;
constexpr size_t WS_HID = 840 * MiB;
constexpr size_t WS_YEXP = 152 * MiB;
constexpr size_t WS_END = 1023 * MiB + 512 * 1024;

constexpr int LDS_BYTES = 132096;
constexpr int LDS_CTL_OFF = 131072;

#define XB_TMO      128
#define XB_XCNT(j)  (256  + 64 * (j))
#define XB_XSUB(j)  (1280 + 64 * (j))
#define XB_XGEN(j)  (2304 + 64 * (j))
#define XB_TOP      3328
#define XB_TOPGEN   3392
#define XCD_BAR_WORDS 3456
#define XB_SPIN_CAP (1u << 24)

__device__ __forceinline__ unsigned xb_ld(unsigned* p)              { return __hip_atomic_load(p, __ATOMIC_RELAXED, __HIP_MEMORY_SCOPE_AGENT); }
__device__ __forceinline__ unsigned xb_add(unsigned* p, unsigned v) { return __hip_atomic_fetch_add(p, v, __ATOMIC_RELAXED, __HIP_MEMORY_SCOPE_AGENT); }
__device__ __forceinline__ unsigned xb_xcc_id() { return (unsigned)__builtin_amdgcn_s_getreg((3 << 11) | 20) & 0xFu; }
#define XB_SPIN(cond, bar) do { unsigned _sp = 0; while (cond) { __builtin_amdgcn_s_sleep(1); \
    if ((++_sp & 255u) == 0u) { if (xb_ld(&(bar)[XB_TMO])) break; if (_sp > XB_SPIN_CAP) { atomicAdd(&(bar)[XB_TMO], 1u); break; } } } } while (0)

struct XcdBarrier { unsigned* bar; unsigned x; volatile LAS unsigned* st; };

__device__ __forceinline__ XcdBarrier xcd_barrier_post(unsigned* bar, volatile LAS unsigned* st) {
    XcdBarrier b; b.bar = bar; b.x = xb_xcc_id(); b.st = st;
    if (threadIdx.x == 0) (void)xb_add(&bar[XB_XCNT(b.x)], 1u);
    return b;
}
__device__ __forceinline__ void xcd_barrier_complete(unsigned* bar, unsigned x, unsigned& nloc, unsigned& nx) {
    const unsigned G = gridDim.x * gridDim.y * gridDim.z;
    unsigned sum, cnt, mine, sp = 0u;
    for (;;) {
        sum = 0u; cnt = 0u; mine = 0u;
#pragma unroll
        for (unsigned j = 0; j < 16; ++j) { const unsigned c = xb_ld(&bar[XB_XCNT(j)]); sum += c; cnt += (c > 0u) ? 1u : 0u; mine = (j == x) ? c : mine; }
        if (sum == G) break;
        __builtin_amdgcn_s_sleep(1);
        if ((++sp & 255u) == 0u) { if (xb_ld(&bar[XB_TMO])) break; if (sp > XB_SPIN_CAP) { atomicAdd(&bar[XB_TMO], 1u); break; } }
    }
    nloc = mine > 0u ? mine : 1u; nx = cnt > 0u ? cnt : 1u;
}
__device__ __forceinline__ void xcd_barrier(const XcdBarrier& b) {
    asm volatile("s_waitcnt vmcnt(0)" ::: "memory");
    __syncthreads();
    if (threadIdx.x == 0) {
        unsigned* bar = b.bar;
        __builtin_amdgcn_s_waitcnt(0);
        unsigned nloc = b.st[0], nx = b.st[1];
        if (nloc == 0u) { xcd_barrier_complete(bar, b.x, nloc, nx); b.st[0] = nloc; b.st[1] = nx; }
        const unsigned old = xb_add(&bar[XB_XSUB(b.x)], 1u);
        const unsigned gen = old / nloc;
        if (old + 1u == (gen + 1u) * nloc) {
            __builtin_amdgcn_fence(__ATOMIC_RELEASE, "agent");
            asm volatile("s_waitcnt vmcnt(0)" ::: "memory");
            const unsigned og = xb_add(&bar[XB_TOP], 1u);
            const unsigned tg = og / nx;
            if (og + 1u == (tg + 1u) * nx) xb_add(&bar[XB_TOPGEN], 1u);
            else XB_SPIN(xb_ld(&bar[XB_TOPGEN]) == tg, bar);
            __builtin_amdgcn_fence(__ATOMIC_ACQUIRE, "agent");
            xb_add(&bar[XB_XGEN(b.x)], 1u);
            asm volatile("s_waitcnt vmcnt(0)" ::: "memory");
        } else {
            XB_SPIN(xb_ld(&bar[XB_XGEN(b.x)]) == gen, bar);
            __builtin_amdgcn_fence(__ATOMIC_ACQUIRE, "agent");
            asm volatile("s_waitcnt vmcnt(0)" ::: "memory");
        }
    }
    __syncthreads();
}

namespace pg8 {
#define PG8_LAS __attribute__((address_space(3)))
typedef unsigned short bf16_t;
typedef short bf16x8 __attribute__((ext_vector_type(8)));
typedef float f32x4 __attribute__((ext_vector_type(4)));
typedef unsigned u32x4 __attribute__((ext_vector_type(4)));
constexpr int BM = 256, BK = 64, HALF = 128, HTB = HALF * BK * 2  , STAGE_BYTES = 8 * HTB, NXCD = 8, WGM = 8;

__host__ __device__ __forceinline__ int lds_byte(int r, int c) { const int st = (r >> 4) * 2 + (c >> 5), rr = r & 15, cc = c & 31, ob = rr * 64 + cc * 2; return st * 1024 + (ob ^ (((ob >> 9) & 1) << 5)); }
__host__ __device__ __forceinline__ void stage_rc(int b, int& R, int& C) { const int st = b / 1024, sb = b % 1024, swz = sb ^ (((sb >> 9) & 1) << 5); R = (st >> 1) * 16 + swz / 64; C = (st & 1) * 32 + (swz % 64) / 2; }
__host__ __device__ __forceinline__ int perm32(int rho) { const int n = rho >> 4, i = rho & 15; return 8 * (i >> 2) + 4 * n + (i & 3); }

struct Unit { int pm, pn; };
struct Gemm { const bf16_t* A; const bf16_t* Bt; int M, N, K; const int* rowtab = nullptr; };

struct StaticOrder {
    int nM, nN, nwg, G, c;
    __host__ __device__ void init(int M, int N, int G_, int c_) { nM = M / BM; nN = N / BM; nwg = nM * nN; G = G_; c = c_; }
    __host__ __device__ bool next(int i, Unit& u) const {
        const long L = (long)i * G + c; if (L >= nwg) return false;
        int wgid = (int)L; { const int q = nwg / NXCD, r = nwg % NXCD, xcd = wgid % NXCD, off = wgid / NXCD; wgid = (xcd < r ? xcd * (q + 1) : r * (q + 1) + (xcd - r) * q) + off; }
        const int nig = WGM * nN, gid = wgid / nig, fm = gid * WGM, gsz = (nM - fm) < WGM ? (nM - fm) : WGM;
        u.pm = fm + ((wgid % nig) % gsz); u.pn = (wgid % nig) / gsz; return true;
    }
    __device__ __forceinline__ void a_ready(const Unit&) const {}
    __device__ __forceinline__ void done(const Unit&) const {}
};

__device__ __forceinline__ unsigned cvt_pk_bf16(float lo, float hi) { unsigned r; asm volatile("v_cvt_pk_bf16_f32 %0, %1, %2" : "=v"(r) : "v"(lo), "v"(hi)); return r; }
typedef float f32x2 __attribute__((ext_vector_type(2)));
__device__ __forceinline__ f32x2 gelu_pk(f32x2 v) {
    const f32x2 av = __builtin_elementwise_abs(v), d = av * 0.2316418882f + 1.0f;
    f32x2 t; t.x = __builtin_amdgcn_rcpf(d.x); t.y = __builtin_amdgcn_rcpf(d.y);
    f32x2 q = t * 0.5307027145f + (-0.7265760135f); q = q * t + 0.7107068705f; q = q * t + (-0.142248368f); q = q * t + 0.127414796f; q = q * t;
    const f32x2 s = (v * v) * (-0.72134752044f);
    f32x2 e; e.x = __builtin_amdgcn_exp2f(s.x); e.y = __builtin_amdgcn_exp2f(s.y);
    const f32x2 m = v * (q * e), r = v - m;
    f32x2 o; o.x = v.x < 0.f ? m.x : r.x; o.y = v.y < 0.f ? m.y : r.y; return o;
}

template <int ACT  > struct EpiBf16 {
    static constexpr bool PERM = true, AFTER_DRAIN = false; static_assert(ACT == 0 || ACT == 1, "EpiBf16: ACT is 0 (none) or 1 (gelu_pk)");
    bf16_t* O; int ldc; const float* bias; int split_cols; size_t split_stride; float scale0;
    __device__ __forceinline__ void operator()(const f32x4 (&acc)[2][2][4][2], const Unit& u, int wr, int wc, int fr, int fq) const {
        const int row0 = u.pm * BM + wr * 64 + fr; int colt = u.pn * BM; bf16_t* base = O;
        float sc = 1.f; if (split_cols) { const int t = colt / split_cols; base += (size_t)t * split_stride; colt -= t * split_cols; if (t == 0) sc = scale0; }
        const int col0 = colt + wc * 32 + 8 * fq, bcol0 = u.pn * BM + wc * 32 + 8 * fq;
        f32x4 bv[2][2];
#pragma unroll
        for (int bj = 0; bj < 2; ++bj)
#pragma unroll
            for (int n = 0; n < 2; ++n) bv[bj][n] = bias ? *(const f32x4*)(bias + bcol0 + bj * HALF + 4 * n) : (f32x4){0.f, 0.f, 0.f, 0.f};
#pragma unroll
        for (int ai = 0; ai < 2; ++ai)
#pragma unroll
            for (int m = 0; m < 4; ++m) { bf16_t* rowp = base + (size_t)(row0 + ai * HALF + m * 16) * ldc + col0;
#pragma unroll
                for (int bj = 0; bj < 2; ++bj) { f32x4 v0 = acc[ai][bj][m][0] + bv[bj][0], v1 = acc[ai][bj][m][1] + bv[bj][1];
                    if (ACT == 1) { f32x2 a = gelu_pk((f32x2){v0[0], v0[1]}), b = gelu_pk((f32x2){v0[2], v0[3]}), c = gelu_pk((f32x2){v1[0], v1[1]}), d = gelu_pk((f32x2){v1[2], v1[3]});
                        v0 = (f32x4){a.x, a.y, b.x, b.y}; v1 = (f32x4){c.x, c.y, d.x, d.y}; }
                    v0 = v0 * sc; v1 = v1 * sc; u32x4 w; w.x = cvt_pk_bf16(v0[0], v0[1]); w.y = cvt_pk_bf16(v0[2], v0[3]); w.z = cvt_pk_bf16(v1[0], v1[1]); w.w = cvt_pk_bf16(v1[2], v1[3]);
                    *(u32x4*)(rowp + bj * HALF) = w; } }
    }
};

struct EpiF32 {
    static constexpr bool PERM = false, AFTER_DRAIN = false;
    float* C; int ldc;
    __device__ __forceinline__ void operator()(const f32x4 (&acc)[2][2][4][2], const Unit& u, int wr, int wc, int fr, int fq) const {
        const int row0 = u.pm * BM + wr * 64 + fr, col0 = u.pn * BM + wc * 32 + 4 * fq;
#pragma unroll
        for (int ai = 0; ai < 2; ++ai)
#pragma unroll
            for (int m = 0; m < 4; ++m) { float* rowp = C + (size_t)(row0 + ai * HALF + m * 16) * ldc + col0;
#pragma unroll
                for (int bj = 0; bj < 2; ++bj)
#pragma unroll
                    for (int n = 0; n < 2; ++n) *(f32x4*)(rowp + bj * HALF + n * 16) = acc[ai][bj][m][n]; }
    }
};
__device__ __forceinline__ float fast_sigmoid(float x) { return __builtin_amdgcn_rcpf(1.0f + __builtin_amdgcn_exp2f(-1.4426950408889634f * x)); }
struct EpiSwiGLU {
    static constexpr bool PERM = true, AFTER_DRAIN = false;
    bf16_t* O; int ldo;
    __device__ __forceinline__ void operator()(const f32x4 (&acc)[2][2][4][2], const Unit& u, int wr, int wc, int fr, int fq) const {
        const int row0 = u.pm * BM + wr * 64 + fr, col0 = (u.pn & 1) * HALF + wc * 32 + 8 * fq;
#pragma unroll
        for (int ai = 0; ai < 2; ++ai)
#pragma unroll
            for (int m = 0; m < 4; ++m) {
                bf16_t* rowp = O + (size_t)(row0 + ai * HALF + m * 16) * ldo + col0;
                const f32x4 g0 = acc[ai][0][m][0], g1 = acc[ai][0][m][1], u0 = acc[ai][1][m][0], u1 = acc[ai][1][m][1];
                float r[8];
#pragma unroll
                for (int i = 0; i < 4; ++i) { r[i] = g0[i] * fast_sigmoid(g0[i]) * u0[i]; r[4 + i] = g1[i] * fast_sigmoid(g1[i]) * u1[i]; }
                u32x4 w; w.x = cvt_pk_bf16(r[0], r[1]); w.y = cvt_pk_bf16(r[2], r[3]); w.z = cvt_pk_bf16(r[4], r[5]); w.w = cvt_pk_bf16(r[6], r[7]);
                *(u32x4*)rowp = w;
            }
    }
};
struct EpiScatter {
    static constexpr bool PERM = true, AFTER_DRAIN = false;
    const int* slotw; bf16_t* Y; int ldy;
    __device__ __forceinline__ void operator()(const f32x4 (&acc)[2][2][4][2], const Unit& u, int wr, int wc, int fr, int fq) const {
        int t2 = threadIdx.x; asm volatile("" : "+v"(t2));
        const int fr2 = t2 & 15, fq2 = (t2 >> 4) & 3, wc2 = (t2 >> 6) & 3, wr2 = (t2 >> 8) & 1;
        const int col0 = (u.pn & 3) * BM + wc2 * 32 + 8 * fq2;
        const int rbase = u.pm * BM + wr2 * 64 + fr2;
        typedef int i32x2 __attribute__((ext_vector_type(2)));
        i32x2 rec[2][4];
#pragma unroll
        for (int ai = 0; ai < 2; ++ai)
#pragma unroll
            for (int m = 0; m < 4; ++m) rec[ai][m] = *(const i32x2*)(slotw + 2 * (size_t)(rbase + ai * HALF + m * 16));
#pragma unroll
        for (int ai = 0; ai < 2; ++ai)
#pragma unroll
            for (int m = 0; m < 4; ++m) {
                const int aid = rec[ai][m].x;
                if (aid >= 0) {
                    const int wbits = rec[ai][m].y;
                    const float w = __int_as_float(wbits);
                    bf16_t* rowp = Y + (size_t)aid * ldy + col0;
#pragma unroll
                    for (int bj = 0; bj < 2; ++bj) {
                        const f32x4 v0 = acc[ai][bj][m][0] * w, v1 = acc[ai][bj][m][1] * w;
                        u32x4 o; o.x = cvt_pk_bf16(v0[0], v0[1]); o.y = cvt_pk_bf16(v0[2], v0[3]); o.z = cvt_pk_bf16(v1[0], v1[1]); o.w = cvt_pk_bf16(v1[2], v1[3]);
                        *(u32x4*)(rowp + bj * HALF) = o;
                    }
                }
            }
    }
};
struct ExpertOrder {
    const int* uexp; int NU, npn, G, c;
    __device__ __forceinline__ bool next(int i, Unit& u) const {
        const int L = i * G + c; if (L >= NU * npn) return false;
        const int uu = L / npn, pl = L % npn;
        u.pm = uu; u.pn = __builtin_amdgcn_readfirstlane(uexp[uu]) * npn + pl; return true;
    }
    __device__ __forceinline__ void a_ready(const Unit&) const {}
    __device__ __forceinline__ void done(const Unit&) const {}
};
struct S5Order {
    int NUNITS, npn, G, c;
    __device__ __forceinline__ bool next(int i, Unit& u) const {
        const int L = i * G + c; if (L >= NUNITS) return false;
        u.pm = L / npn; u.pn = (u.pm >> 2) * npn + L % npn; return true;
    }
    __device__ __forceinline__ void a_ready(const Unit&) const {}
    __device__ __forceinline__ void done(const Unit&) const {}
};
struct EpiS5E {
    static constexpr bool PERM = false, AFTER_DRAIN = false;
    float* E;
    __device__ __forceinline__ void operator()(const f32x4 (&acc)[2][2][4][2], const Unit& u, int wr, int wc, int fr, int fq) const {
        const int row0 = u.pm * BM + wr * 64 + fr, col0 = wc * 32 + 4 * fq;
#pragma unroll
        for (int ai = 0; ai < 2; ++ai)
#pragma unroll
            for (int m = 0; m < 4; ++m) { float* rowp = E + (size_t)(row0 + ai * HALF + m * 16) * 128 + col0;
#pragma unroll
                for (int n = 0; n < 2; ++n) *(f32x4*)(rowp + n * 16) = acc[ai][0][m][n]; }
    }
};
struct EpiS5Out {
    static constexpr bool PERM = true, AFTER_DRAIN = false;
    bf16_t* Y;
    __device__ __forceinline__ void operator()(const f32x4 (&acc)[2][2][4][2], const Unit& u, int wr, int wc, int fr, int fq) const {
        const int g = u.pm >> 2;
#pragma unroll
        for (int ai = 0; ai < 2; ++ai)
#pragma unroll
            for (int m = 0; m < 4; ++m) {
                const int r = (u.pm & 3) * BM + ai * HALF + wr * 64 + m * 16 + fr, b = r >> 8, chunk = r & 255;
#pragma unroll
                for (int bj = 0; bj < 2; ++bj) {
                    const int colg = (u.pn & 1) * BM + bj * HALF + wc * 32 + 8 * fq, t = colg >> 4, c0 = colg & 15;
                    const f32x4 v0 = acc[ai][bj][m][0], v1 = acc[ai][bj][m][1];
                    float x[8] = {v0[0], v0[1], v0[2], v0[3], v1[0], v1[1], v1[2], v1[3]};
#pragma unroll
                    for (int i = 0; i < 8; ++i) { const float z = x[i]; x[i] = z * fast_sigmoid(1.5957691216057308f * (z + 0.044715f * z * z * z)); }
                    u32x4 w; w.x = cvt_pk_bf16(x[0], x[1]); w.y = cvt_pk_bf16(x[2], x[3]); w.z = cvt_pk_bf16(x[4], x[5]); w.w = cvt_pk_bf16(x[6], x[7]);
                    *(u32x4*)(Y + ((size_t)(b * 8192 + chunk * 32 + t)) * 512 + g * 16 + c0) = w;
                }
            }
    }
};
struct EpiLora {
    static constexpr bool PERM = true, AFTER_DRAIN = false;
    const float* w0; const float* a0; const float* k_a; float* W; const bf16_t* Kp; bf16_t* Kf; const bf16_t* A; bf16_t* B; bf16_t* Gt;
    __device__ __forceinline__ void operator()(const f32x4 (&acc)[2][2][4][2], const Unit& u, int wr, int wc, int fr, int fq) const {
        const int seg = u.pn >> 1;
#pragma unroll
        for (int bj = 0; bj < 2; ++bj) {
            const int nn = (u.pn & 1) * BM + bj * HALF + wc * 32 + 8 * fq;
            float p0[8], p1[8];
            if (seg == 0) { const f32x4 a = *(const f32x4*)(w0 + nn), b = *(const f32x4*)(w0 + nn + 4); p0[0] = a[0]; p0[1] = a[1]; p0[2] = a[2]; p0[3] = a[3]; p0[4] = b[0]; p0[5] = b[1]; p0[6] = b[2]; p0[7] = b[3]; }
            else if (seg == 1) { const f32x4 a = *(const f32x4*)(a0 + nn), b = *(const f32x4*)(a0 + nn + 4), cc = *(const f32x4*)(k_a + nn), d = *(const f32x4*)(k_a + nn + 4);
                p0[0] = a[0]; p0[1] = a[1]; p0[2] = a[2]; p0[3] = a[3]; p0[4] = b[0]; p0[5] = b[1]; p0[6] = b[2]; p0[7] = b[3];
                p1[0] = cc[0]; p1[1] = cc[1]; p1[2] = cc[2]; p1[3] = cc[3]; p1[4] = d[0]; p1[5] = d[1]; p1[6] = d[2]; p1[7] = d[3]; }
#pragma unroll
            for (int ai = 0; ai < 2; ++ai)
#pragma unroll
                for (int m = 0; m < 4; ++m) {
                    const size_t off = (size_t)(u.pm * BM + ai * HALF + wr * 64 + m * 16 + fr) * 512 + nn;
                    const f32x4 v0 = acc[ai][bj][m][0], v1 = acc[ai][bj][m][1];
                    const float x[8] = {v0[0], v0[1], v0[2], v0[3], v1[0], v1[1], v1[2], v1[3]};
                    if (seg == 0) {
                        float o[8];
#pragma unroll
                        for (int i = 0; i < 8; ++i) { const float wa = p0[i] + x[i];
                            const float sp = __logf(1.0f + __expf(-wa));
                            o[i] = __expf(-__expf(-sp - 0.5f)); }
                        *(f32x4*)(W + off) = (f32x4){o[0], o[1], o[2], o[3]}; *(f32x4*)(W + off + 4) = (f32x4){o[4], o[5], o[6], o[7]};
                    } else if (seg == 1) {
                        const u32x4 kv = *(const u32x4*)(Kp + off), av = *(const u32x4*)(A + off);
                        const float k[8] = {__builtin_bit_cast(float, kv.x << 16), __builtin_bit_cast(float, kv.x & 0xffff0000u), __builtin_bit_cast(float, kv.y << 16), __builtin_bit_cast(float, kv.y & 0xffff0000u),
                                            __builtin_bit_cast(float, kv.z << 16), __builtin_bit_cast(float, kv.z & 0xffff0000u), __builtin_bit_cast(float, kv.w << 16), __builtin_bit_cast(float, kv.w & 0xffff0000u)};
                        const float a[8] = {__builtin_bit_cast(float, av.x << 16), __builtin_bit_cast(float, av.x & 0xffff0000u), __builtin_bit_cast(float, av.y << 16), __builtin_bit_cast(float, av.y & 0xffff0000u),
                                            __builtin_bit_cast(float, av.z << 16), __builtin_bit_cast(float, av.z & 0xffff0000u), __builtin_bit_cast(float, av.w << 16), __builtin_bit_cast(float, av.w & 0xffff0000u)};
                        float kf[8], bo[8];
#pragma unroll
                        for (int i = 0; i < 8; ++i) { const float ic = fast_sigmoid(p0[i] + x[i]); kf[i] = k[i] * (1.0f + (ic - 1.0f) * p1[i]); bo[i] = -a[i] * ic; }
                        u32x4 w; w.x = cvt_pk_bf16(kf[0], kf[1]); w.y = cvt_pk_bf16(kf[2], kf[3]); w.z = cvt_pk_bf16(kf[4], kf[5]); w.w = cvt_pk_bf16(kf[6], kf[7]);
                        *(u32x4*)(Kf + off) = w;
                        w.x = cvt_pk_bf16(bo[0], bo[1]); w.y = cvt_pk_bf16(bo[2], bo[3]); w.z = cvt_pk_bf16(bo[4], bo[5]); w.w = cvt_pk_bf16(bo[6], bo[7]);
                        *(u32x4*)(B + off) = w;
                    } else {
                        u32x4 w; w.x = cvt_pk_bf16(x[0], x[1]); w.y = cvt_pk_bf16(x[2], x[3]); w.z = cvt_pk_bf16(x[4], x[5]); w.w = cvt_pk_bf16(x[6], x[7]);
                        *(u32x4*)(Gt + off) = w;
                    }
                }
        }
    }
};
struct EpiGLU {
    static constexpr bool PERM = true, AFTER_DRAIN = false;
    const bf16_t* Y; int ldy; const float* bias; bf16_t* O; int ldo; int ocol0;
    __device__ __forceinline__ void operator()(const f32x4 (&acc)[2][2][4][2], const Unit& u, int wr, int wc, int fr, int fq) const {
        const int row0 = u.pm * BM + wr * 64 + fr, col0 = u.pn * BM + wc * 32 + 8 * fq;
#pragma unroll
        for (int bj = 0; bj < 2; ++bj) {
            const f32x4 b0 = *(const f32x4*)(bias + col0 + bj * HALF), b1 = *(const f32x4*)(bias + col0 + bj * HALF + 4);
#pragma unroll
            for (int ai = 0; ai < 2; ++ai)
#pragma unroll
                for (int m = 0; m < 4; ++m) {
                    const size_t row = (size_t)(row0 + ai * HALF + m * 16);
                    const u32x4 yv = *(const u32x4*)(Y + row * ldy + col0 + bj * HALF);
                    const f32x4 z0 = acc[ai][bj][m][0] + b0, z1 = acc[ai][bj][m][1] + b1;
                    float y[8] = {__builtin_bit_cast(float, yv.x << 16), __builtin_bit_cast(float, yv.x & 0xffff0000u), __builtin_bit_cast(float, yv.y << 16), __builtin_bit_cast(float, yv.y & 0xffff0000u),
                                  __builtin_bit_cast(float, yv.z << 16), __builtin_bit_cast(float, yv.z & 0xffff0000u), __builtin_bit_cast(float, yv.w << 16), __builtin_bit_cast(float, yv.w & 0xffff0000u)};
                    float r[8];
#pragma unroll
                    for (int i = 0; i < 4; ++i) { r[i] = y[i] * fast_sigmoid(z0[i]); r[4 + i] = y[4 + i] * fast_sigmoid(z1[i]); }
                    u32x4 w; w.x = cvt_pk_bf16(r[0], r[1]); w.y = cvt_pk_bf16(r[2], r[3]); w.z = cvt_pk_bf16(r[4], r[5]); w.w = cvt_pk_bf16(r[6], r[7]);
                    *(u32x4*)(O + row * ldo + ocol0 + col0 + bj * HALF) = w;
                }
        }
    }
};
template <class Epi, class Sched, bool ALIGN_EPI = false, bool SP2 = false, bool GATHER = false>
__device__ __forceinline__ void gemm_phase(PG8_LAS unsigned char* lds, const Gemm g, const Sched& S, const Epi& E) {
    int tid_ = threadIdx.x; asm volatile("" : "+v"(tid_));
    const int tid = tid_, wid = __builtin_amdgcn_readfirstlane(tid >> 6), lane = tid & 63, wr = wid >> 2, wc = wid & 3, fr = lane & 15, fq = lane >> 4;
    const int K = g.K, nt = K / BK;
    unsigned voffA[2], voffB[2];
#pragma unroll
    for (int i = 0; i < 2; ++i) { int R, C; stage_rc(tid * 16 + i * 8192, R, C); const int Rb = Epi::PERM ? ((R & ~31) + perm32(R & 31)) : R;
        voffA[i] = (unsigned)(R * K + C) * 2u; voffB[i] = (unsigned)(Rb * K + C) * 2u; }
    const size_t kstep = (size_t)(BK * 2);
    const size_t hstep = (size_t)HALF * K * 2;
    const size_t tstep = 2 * hstep;
    const unsigned ldsw = (unsigned)wid * 1024u;
    const int aoff = lds_byte(wr * 64 + fr, fq * 8), boff = lds_byte(wc * 32 + fr, fq * 8);
#define PG8_SA(b, h) (((b) * 2 + (h)) * HTB)
#define PG8_SB(b, h) ((4 + (b) * 2 + (h)) * HTB)
#define PG8_STAGE(bufoff, gbase, voff) do { _Pragma("unroll") for (int _i = 0; _i < 2; ++_i) \
        __builtin_amdgcn_global_load_lds((const unsigned*)((const char*)(gbase) + (voff)[_i]), (PG8_LAS unsigned*)(lds + (bufoff) + ldsw + _i * 8192), 16, 0, 0); } while (0)
#define PG8_STAGE_A(bufoff, kptr, h, NEXTSEL) do { if constexpr (GATHER) { const unsigned _p = (NEXTSEL) ? gnxt[h] : gcur[h]; const unsigned _v[2] = { (_p & 0xffffu) * (unsigned)(2 * K) + gC2, (_p >> 16) * (unsigned)(2 * K) + gC2 }; PG8_STAGE(bufoff, kptr, _v); } \
        else { PG8_STAGE(bufoff, (kptr) + (h) * hstep, voffA); } } while (0)
#define PG8_LDA(dst, b, h) do { _Pragma("unroll") for (int m = 0; m < 4; ++m) _Pragma("unroll") for (int k = 0; k < 2; ++k) dst[m][k] = *(const PG8_LAS bf16x8*)(lds + PG8_SA(b, h) + aoff + m * 2048 + k * 1024); } while (0)
#define PG8_LDB(dst, b, h) do { _Pragma("unroll") for (int n = 0; n < 2; ++n) _Pragma("unroll") for (int k = 0; k < 2; ++k) dst[n][k] = *(const PG8_LAS bf16x8*)(lds + PG8_SB(b, h) + boff + n * 2048 + k * 1024); } while (0)
#define PG8_MMA(ai, bj, At, Bt) do { __builtin_amdgcn_s_setprio(1); _Pragma("unroll") for (int m = 0; m < 4; ++m) _Pragma("unroll") for (int n = 0; n < 2; ++n) _Pragma("unroll") for (int k = 0; k < 2; ++k) \
        acc[ai][bj][m][n] = __builtin_amdgcn_mfma_f32_16x16x32_bf16(Bt[n][k], At[m][k], acc[ai][bj][m][n], 0, 0, 0); __builtin_amdgcn_s_setprio(0); } while (0)
#define PG8_WAIT_V(n) asm volatile("s_waitcnt vmcnt(" #n ")" ::: "memory")
#define PG8_WAIT_L(n) asm volatile("s_waitcnt lgkmcnt(" #n ")" ::: "memory")
#define PG8_BAR __builtin_amdgcn_s_barrier()
#define PG8_SCHED __builtin_amdgcn_sched_barrier(0)
    unsigned gcur[2], gnxt[2], gC2 = 0;
    if constexpr (GATHER) { int R, C; stage_rc(tid * 16, R, C); gC2 = (unsigned)C * 2u; }
    auto load_gather = [&](int pm, unsigned (&dst)[2]) {
        int R, C; stage_rc(tid * 16, R, C);
#pragma unroll
        for (int h = 0; h < 2; ++h) { int a0 = g.rowtab[pm * BM + h * HALF + R], a1 = g.rowtab[pm * BM + h * HALF + R + 64]; a0 = a0 < 0 ? 0 : a0; a1 = a1 < 0 ? 0 : a1; dst[h] = (unsigned)(a0 >> 3) | ((unsigned)(a1 >> 3) << 16); }
    };
    Unit cur, nxt; int ui = 0;
    if (!S.next(0, cur)) return;
    f32x4 acc[2][2][4][2];
#pragma unroll
    for (int a = 0; a < 2; ++a)
#pragma unroll
        for (int b = 0; b < 2; ++b)
#pragma unroll
            for (int m = 0; m < 4; ++m)
#pragma unroll
                for (int n = 0; n < 2; ++n) acc[a][b][m][n] = (f32x4){0.f, 0.f, 0.f, 0.f};
    bf16x8 At[4][2], B0[2][2], B1[2][2];
    const char* cA = (const char*)g.A + (GATHER ? (size_t)0 : (size_t)cur.pm * tstep); const char* cB = (const char*)g.Bt + (size_t)cur.pn * tstep;
    if constexpr (GATHER) { load_gather(cur.pm, gcur); }
    S.a_ready(cur);
    if constexpr (SP2) {
        PG8_STAGE(PG8_SB(0, 0), cB, voffB); PG8_STAGE(PG8_SB(0, 1), cB + hstep, voffB); PG8_STAGE_A(PG8_SA(0, 0), cA, 0, false); PG8_STAGE_A(PG8_SA(0, 1), cA, 1, false);
        if (wr == 1) PG8_BAR;
        PG8_WAIT_V(2); PG8_BAR;
        PG8_STAGE(PG8_SB(1, 0), cB + kstep, voffB); PG8_STAGE_A(PG8_SA(1, 0), cA + kstep, 0, false); PG8_STAGE(PG8_SB(1, 1), cB + hstep + kstep, voffB);
        PG8_WAIT_V(6); PG8_BAR;
    } else {
        PG8_STAGE(PG8_SB(0, 0), cB, voffB); PG8_STAGE_A(PG8_SA(0, 0), cA, 0, false); PG8_STAGE(PG8_SB(0, 1), cB + hstep, voffB); PG8_STAGE_A(PG8_SA(0, 1), cA, 1, false);
        if (wr == 1) PG8_BAR;
        PG8_WAIT_V(4); PG8_BAR;
        PG8_STAGE(PG8_SB(1, 0), cB + kstep, voffB); PG8_STAGE_A(PG8_SA(1, 0), cA + kstep, 0, false); PG8_STAGE(PG8_SB(1, 1), cB + hstep + kstep, voffB);
        PG8_WAIT_V(6); PG8_BAR;
    }
    for (;;) {
        const bool has_next = S.next(ui + 1, nxt);
        const char* nA = (has_next && !GATHER) ? (const char*)g.A + (size_t)nxt.pm * tstep : cA; const char* nB = has_next ? (const char*)g.Bt + (size_t)nxt.pn * tstep : cB;
        if constexpr (GATHER) { if (has_next) load_gather(nxt.pm, gnxt); else {
#pragma unroll
            for (int h = 0; h < 2; ++h) { gnxt[h] = gcur[h]; } } }
        for (int t = 0; t < nt; t += 2) {
            const bool last = (t == nt - 2);
            const char* a1 = cA + (size_t)(t + 1) * kstep;
            const char* a2 = last ? nA : cA + (size_t)(t + 2) * kstep; const char* b2 = last ? nB : cB + (size_t)(t + 2) * kstep;
            const char* a3 = a2 + kstep; const char* b3 = b2 + kstep;
            if (last && has_next) S.a_ready(nxt);
            if constexpr (SP2) {
            PG8_LDB(B0, 0, 0); PG8_LDB(B1, 0, 1); PG8_SCHED; PG8_LDA(At, 0, 0); PG8_STAGE_A(PG8_SA(1, 1), a1, 1, false);
            PG8_WAIT_V(8); PG8_WAIT_L(0); PG8_BAR; PG8_MMA(0, 0, At, B0); PG8_MMA(0, 1, At, B1); PG8_BAR; PG8_SCHED;
            PG8_LDA(At, 0, 1); PG8_STAGE(PG8_SB(0, 0), b2, voffB); PG8_STAGE(PG8_SB(0, 1), b2 + hstep, voffB); PG8_STAGE_A(PG8_SA(0, 0), a2, 0, last);
            PG8_WAIT_V(8); PG8_WAIT_L(0); PG8_BAR; PG8_MMA(1, 0, At, B0); PG8_MMA(1, 1, At, B1); PG8_BAR; PG8_SCHED;
            PG8_LDB(B0, 1, 0); PG8_LDB(B1, 1, 1); PG8_SCHED; PG8_LDA(At, 1, 0); PG8_STAGE_A(PG8_SA(0, 1), a2, 1, last);
            PG8_WAIT_V(8); PG8_WAIT_L(0); PG8_BAR; PG8_MMA(0, 0, At, B0); PG8_MMA(0, 1, At, B1); PG8_BAR; PG8_SCHED;
            PG8_LDA(At, 1, 1); PG8_STAGE(PG8_SB(1, 0), b3, voffB); PG8_STAGE(PG8_SB(1, 1), b3 + hstep, voffB); PG8_STAGE_A(PG8_SA(1, 0), a3, 0, last);
            PG8_WAIT_V(8); PG8_WAIT_L(0); PG8_BAR; PG8_MMA(1, 0, At, B0); PG8_MMA(1, 1, At, B1); PG8_BAR; PG8_SCHED;
            } else {
            PG8_LDB(B0, 0, 0); PG8_SCHED; PG8_LDA(At, 0, 0); PG8_STAGE_A(PG8_SA(1, 1), a1, 1, false);
            PG8_WAIT_L(8); PG8_BAR; PG8_WAIT_L(0); PG8_MMA(0, 0, At, B0); PG8_BAR; PG8_SCHED;
            PG8_LDB(B1, 0, 1); PG8_STAGE(PG8_SB(0, 0), b2, voffB);
            PG8_BAR; PG8_WAIT_L(0); PG8_MMA(0, 1, At, B1); PG8_BAR;
            PG8_LDA(At, 0, 1); PG8_STAGE_A(PG8_SA(0, 0), a2, 0, last);
            PG8_BAR; PG8_WAIT_L(0); PG8_MMA(1, 0, At, B0); PG8_BAR; PG8_SCHED;
            PG8_STAGE(PG8_SB(0, 1), b2 + hstep, voffB);
            PG8_WAIT_V(6); PG8_BAR; PG8_MMA(1, 1, At, B1); PG8_BAR;
            PG8_LDB(B0, 1, 0); PG8_SCHED; PG8_LDA(At, 1, 0); PG8_STAGE_A(PG8_SA(0, 1), a2, 1, last);
            PG8_WAIT_L(8); PG8_BAR; PG8_WAIT_L(0); PG8_MMA(0, 0, At, B0); PG8_BAR; PG8_SCHED;
            PG8_LDB(B1, 1, 1); PG8_STAGE(PG8_SB(1, 0), b3, voffB);
            PG8_BAR; PG8_WAIT_L(0); PG8_MMA(0, 1, At, B1); PG8_BAR;
            PG8_LDA(At, 1, 1); PG8_STAGE_A(PG8_SA(1, 0), a3, 0, last);
            PG8_BAR; PG8_WAIT_L(0); PG8_MMA(1, 0, At, B0); PG8_BAR; PG8_SCHED;
            PG8_STAGE(PG8_SB(1, 1), b3 + hstep, voffB);
            PG8_WAIT_V(6); PG8_BAR; PG8_MMA(1, 1, At, B1); PG8_BAR;
            }
        }
        if constexpr (ALIGN_EPI) { if (wr == 0) PG8_BAR; }
        if constexpr (!Epi::AFTER_DRAIN) { E(acc, cur, wr, wc, fr, fq); S.done(cur); }
        if (!has_next) break;
#pragma unroll
        for (int a = 0; a < 2; ++a)
#pragma unroll
            for (int b = 0; b < 2; ++b)
#pragma unroll
                for (int m = 0; m < 4; ++m)
#pragma unroll
                    for (int n = 0; n < 2; ++n) acc[a][b][m][n] = (f32x4){0.f, 0.f, 0.f, 0.f};
        cur = nxt; cA = nA; cB = nB; ++ui;
        if constexpr (GATHER) {
#pragma unroll
            for (int h = 0; h < 2; ++h) { gcur[h] = gnxt[h]; } }
        if constexpr (ALIGN_EPI) { if (wr == 1) PG8_BAR; }
    }
    PG8_WAIT_V(0);
    if constexpr (!ALIGN_EPI) { if (wr == 0) PG8_BAR; }
    PG8_BAR;
    if constexpr (Epi::AFTER_DRAIN) { E.fused(acc, cur, wr, wc, fr, fq, lds, wid, lane); S.done(cur); }
#undef PG8_SA
#undef PG8_SB
#undef PG8_STAGE
#undef PG8_STAGE_A
#undef PG8_LDA
#undef PG8_LDB
#undef PG8_MMA
#undef PG8_WAIT_V
#undef PG8_WAIT_L
#undef PG8_BAR
#undef PG8_SCHED
}
}

typedef unsigned short bf16_t;
__device__ __forceinline__ unsigned f2bf(float f) { unsigned u = __builtin_bit_cast(unsigned, f); return (u + 0x7fffu + ((u >> 16) & 1u)) >> 16; }
__device__ __forceinline__ float bf2f(unsigned h) { return __builtin_bit_cast(float, h << 16); }
__device__ __forceinline__ float wave_sum(float v) {
#pragma unroll
    for (int o = 1; o < 64; o <<= 1) v += __shfl_xor(v, o);
    return v;
}
__device__ __forceinline__ float sigmoidf_(float x) { return 1.0f / (1.0f + expf(-x)); }
__device__ __forceinline__ float siluf_(float x) { return x / (1.0f + expf(-x)); }
__device__ __forceinline__ float softplusf_(float x) { return fmaxf(x, 0.0f) + log1pf(expf(-fabsf(x))); }
__device__ __forceinline__ float geluf_(float x) { const float u = 0.7978845608028654f * (x + 0.044715f * x * x * x); return 0.5f * x * (1.0f + tanhf(u)); }

struct Args { const float* in[39]; float* out; unsigned char* ws; int lo, hi; };

struct Ctx {
    const float* const* in; float* out; unsigned char* ws;
    LAS unsigned char* lds; float* sm;
    int tid, lane, wid, bid, G, dry;
};

__device__ __forceinline__ unsigned pk2(float lo, float hi) { return f2bf(lo) | (f2bf(hi) << 16); }
__device__ __forceinline__ float ldbf(const bf16_t* p) { return bf2f((unsigned)*p); }
__device__ __forceinline__ float4 ldbf4(const bf16_t* p) { const uint2 v = *(const uint2*)p; return make_float4(bf2f(v.x & 0xffffu), bf2f(v.x >> 16), bf2f(v.y & 0xffffu), bf2f(v.y >> 16)); }

template <int NB, class AF, class BF, class BF2, class EF>
__device__ __forceinline__ void gemm_tile(float* sm, int K, AF af, BF bf, BF2 bf2, EF ef) {
    float* As = sm;
    float* Bs = sm + 16 * 132;
    float* Bs2 = Bs + 16 * 68;
    const int tid = threadIdx.x, ty = tid >> 4, tx = tid & 15;
    const int am = tid >> 2, ak = (tid & 3) * 4;
    const int bt = tid & 255, bk = bt >> 4, bn = (bt & 15) * 4;
    float acc[4][4], acc2[4][4];
#pragma unroll
    for (int i = 0; i < 4; ++i)
#pragma unroll
        for (int j = 0; j < 4; ++j) { acc[i][j] = 0.f; acc2[i][j] = 0.f; }
    float4 av = af(am, ak);
    float4 bv = make_float4(0.f, 0.f, 0.f, 0.f);
    if (tid < 256) bv = bf(bk, bn); else if (NB == 2) bv = bf2(bk, bn);
    for (int k0 = 0; k0 < K; k0 += 16) {
        __syncthreads();
        As[(ak + 0) * 132 + am] = av.x; As[(ak + 1) * 132 + am] = av.y; As[(ak + 2) * 132 + am] = av.z; As[(ak + 3) * 132 + am] = av.w;
        if (tid < 256) *(float4*)&Bs[bk * 68 + bn] = bv; else if (NB == 2) *(float4*)&Bs2[bk * 68 + bn] = bv;
        __syncthreads();
        if (k0 + 16 < K) {
            av = af(am, k0 + 16 + ak);
            if (tid < 256) bv = bf(k0 + 16 + bk, bn); else if (NB == 2) bv = bf2(k0 + 16 + bk, bn);
        }
#pragma unroll
        for (int kk = 0; kk < 16; ++kk) {
            const float4 a = *(const float4*)&As[kk * 132 + ty * 4];
            const float4 b = *(const float4*)&Bs[kk * 68 + tx * 4];
            const float aa[4] = {a.x, a.y, a.z, a.w};
            const float bb[4] = {b.x, b.y, b.z, b.w};
#pragma unroll
            for (int i = 0; i < 4; ++i)
#pragma unroll
                for (int j = 0; j < 4; ++j) acc[i][j] = fmaf(aa[i], bb[j], acc[i][j]);
            if (NB == 2) {
                const float4 b2 = *(const float4*)&Bs2[kk * 68 + tx * 4];
                const float bb2[4] = {b2.x, b2.y, b2.z, b2.w};
#pragma unroll
                for (int i = 0; i < 4; ++i)
#pragma unroll
                    for (int j = 0; j < 4; ++j) acc2[i][j] = fmaf(aa[i], bb2[j], acc2[i][j]);
            }
        }
    }
#pragma unroll
    for (int i = 0; i < 4; ++i)
        ef(ty * 4 + i, tx * 4, make_float4(acc[i][0], acc[i][1], acc[i][2], acc[i][3]), make_float4(acc2[i][0], acc2[i][1], acc2[i][2], acc2[i][3]));
}

template <bool RES, class RM>
__device__ __forceinline__ void transpose_item(const float* W, int K, int N, bf16_t* WT, RM rowmap, float* scr, int item, int lane) {
    const int nblk = N / 32, kb = item / nblk, nb = item % nblk, k0 = 64 * kb, n0 = 32 * nb;
#pragma unroll 8
    for (int i = 0; i < 32; ++i) { const int kk = 2 * i + (lane >> 5); scr[kk * 33 + (lane & 31)] = W[(size_t)(k0 + kk) * N + n0 + (lane & 31)]; }
    asm volatile("s_waitcnt lgkmcnt(0)" ::: "memory");
    const int c = lane & 7;
    const int r0 = rowmap(n0);
#pragma unroll
    for (int j = 0; j < 4; ++j) {
        const int n = (lane >> 3) + 8 * j; const float* s = scr + (8 * c) * 33 + n;
        float v[8];
#pragma unroll
        for (int q = 0; q < 8; ++q) { v[q] = s[q * 33]; if (RES) v[q] = v[q] - bf2f(f2bf(v[q])); }
        uint4 o; o.x = pk2(v[0], v[1]); o.y = pk2(v[2], v[3]); o.z = pk2(v[4], v[5]); o.w = pk2(v[6], v[7]);
        *(uint4*)(WT + (size_t)(r0 + n) * K + k0 + 8 * c) = o;
    }
    asm volatile("s_waitcnt lgkmcnt(0)" ::: "memory");
}

__device__ __forceinline__ void convert_expert_weights(const Ctx& c, int first, int stride) {
    float* scr = c.sm + c.wid * (64 * 33);
    for (int it = first; it < NE * 384; it += stride) {
        const int e = it / 384, r = it % 384;
        if (r < 128) transpose_item<false>(c.in[33] + (size_t)e * D * EFF, D, EFF, (bf16_t*)(c.ws + WS_WEGU) + (size_t)e * 512 * D, [](int n) { return (n >> 7) * 256 + (n & 127); }, scr, r, c.lane);
        else if (r < 256) transpose_item<false>(c.in[34] + (size_t)e * D * EFF, D, EFF, (bf16_t*)(c.ws + WS_WEGU) + (size_t)e * 512 * D, [](int n) { return (n >> 7) * 256 + 128 + (n & 127); }, scr, r - 128, c.lane);
        else transpose_item<false>(c.in[35] + (size_t)e * EFF * D, EFF, D, (bf16_t*)(c.ws + WS_WED) + (size_t)e * D * EFF, [](int n) { return n; }, scr, r - 256, c.lane);
    }
}

__device__ __forceinline__ void phase0(const Ctx& c) {
    const int gt = c.bid * 512 + c.tid, NT = c.G * 512;
    const int gw = c.bid * 8 + c.wid, NW = c.G * 8;
    {
        const float* cc = c.in[1]; const float* w_ada = c.in[2];
        float* modsp = (float*)(c.ws + WS_MODSP);
        for (int task = gw; task < 96 * 16; task += NW) {
            const int cg = task % 96, ks = task / 96, j = cg * 64 + c.lane;
            float a0 = 0.f, a1 = 0.f, a2 = 0.f, a3 = 0.f;
#pragma unroll 4
            for (int k = ks * 64; k < ks * 64 + 64; ++k) {
                const float wv = w_ada[(size_t)k * NMODS + j];
                a0 = fmaf(siluf_(cc[k]), wv, a0); a1 = fmaf(siluf_(cc[D + k]), wv, a1); a2 = fmaf(siluf_(cc[2 * D + k]), wv, a2); a3 = fmaf(siluf_(cc[3 * D + k]), wv, a3);
            }
            modsp[(ks * 4 + 0) * NMODS + j] = a0; modsp[(ks * 4 + 1) * NMODS + j] = a1; modsp[(ks * 4 + 2) * NMODS + j] = a2; modsp[(ks * 4 + 3) * NMODS + j] = a3;
        }
    }
    {
        const float* log_dt = c.in[20]; const float* a_re = c.in[21]; const float* a_im = c.in[22];
        const float* b_re = c.in[23]; const float* b_im = c.in[24];
        float* apow = (float*)(c.ws + WS_APOW); float* bb = (float*)(c.ws + WS_S5BB);
        for (int idx = gt; idx < S5NG * S5P; idx += NT) {
            const int g = idx / S5P, p = idx % S5P;
            const double dt = exp((double)log_dt[g]);
            const double lre = fmin((double)a_re[idx], -1e-4), lim = (double)a_im[idx];
            const double mag = exp(lre * dt), ang = lim * dt;
            const double abr = mag * cos(ang), abi = mag * sin(ang);
            const double den = lre * lre + lim * lim;
            const double nre = abr - 1.0, nim = abi;
            const double qre = (nre * lre + nim * lim) / den, qim = (nim * lre - nre * lim) / den;
            double pr = 1.0, pi = 0.0;
            for (int j = 0; j <= S5L; ++j) {
                apow[((size_t)(g * (S5L + 1) + j) * 64 + p) * 2 + 0] = (float)pr; apow[((size_t)(g * (S5L + 1) + j) * 64 + p) * 2 + 1] = (float)pi;
                const double nr = pr * abr - pi * abi, ni = pr * abi + pi * abr; pr = nr; pi = ni;
            }
            for (int ch = 0; ch < 16; ++ch) {
                const double br = (double)b_re[idx * 16 + ch], bi = (double)b_im[idx * 16 + ch];
                bb[idx * 32 + ch] = (float)(qre * br - qim * bi);
                bb[idx * 32 + 16 + ch] = (float)(qre * bi + qim * br);
            }
        }
    }
    {
        const float* w2 = c.in[11]; const float* a2 = c.in[13]; const float* g2 = c.in[14];
        bf16_t* bt = (bf16_t*)(c.ws + WS_LORA_BT);
        for (int it = gt; it < 1536 * 32; it += NT) {
            const int n = it >> 5, c0 = (it & 31) * 8;
            float v[8];
#pragma unroll
            for (int i = 0; i < 8; ++i) {
                const int col = c0 + i; float x = 0.f;
                if (n < 512) { if (col < 64) x = w2[col * RW + n]; }
                else if (n < 1024) { if (col >= 64 && col < 128) x = a2[(col - 64) * RW + (n - 512)]; }
                else { if (col >= 128) x = g2[(col - 128) * RW + (n - 1024)]; }
                v[i] = x;
            }
            *(uint4*)(bt + (size_t)n * 256 + c0) = make_uint4(pk2(v[0], v[1]), pk2(v[2], v[3]), pk2(v[4], v[5]), pk2(v[6], v[7]));
        }
    }
    float* scr = c.sm + c.wid * (64 * 33);
    constexpr int I_IN = (D / 64) * (NPROJ / 32), I_OUT = (D / 64) * (D / 32), I_GLU = (512 / 64) * (512 / 32), I_SG = (D / 64) * (256 / 32), I_SD = (256 / 64) * (D / 32), I_R = (D / 64) * (256 / 32);
    constexpr int NIT = I_IN + I_OUT + I_GLU + 2 * I_SG + I_SD + 2 * I_R;
    for (int it = gw; it < NIT; it += NW) {
        int r = it;
        if (r < I_IN) { transpose_item<false>(c.in[8], D, NPROJ, (bf16_t*)(c.ws + WS_WIN_T), [](int n) { return n; }, scr, r, c.lane); continue; } r -= I_IN;
        if (r < I_OUT) { transpose_item<false>(c.in[30], D, D, (bf16_t*)(c.ws + WS_WOUT_T), [](int n) { return n; }, scr, r, c.lane); continue; } r -= I_OUT;
        if (r < I_GLU) { transpose_item<false>(c.in[28], 512, 512, (bf16_t*)(c.ws + WS_WGLU_T), [](int n) { return n; }, scr, r, c.lane); continue; } r -= I_GLU;
        if (r < I_SG) { transpose_item<false>(c.in[36], D, 256, (bf16_t*)(c.ws + WS_WSGU_T), [](int n) { return (n >> 7) * 256 + (n & 127); }, scr, r, c.lane); continue; } r -= I_SG;
        if (r < I_SG) { transpose_item<false>(c.in[37], D, 256, (bf16_t*)(c.ws + WS_WSGU_T), [](int n) { return (n >> 7) * 256 + 128 + (n & 127); }, scr, r, c.lane); continue; } r -= I_SG;
        if (r < I_SD) { transpose_item<false>(c.in[38], 256, D, (bf16_t*)(c.ws + WS_WSD_T), [](int n) { return n; }, scr, r, c.lane); continue; } r -= I_SD;
        if (r < I_R) { transpose_item<false>(c.in[31], D, 256, (bf16_t*)(c.ws + WS_WR_T), [](int n) { return n; }, scr, r, c.lane); continue; } r -= I_R;
        transpose_item<true>(c.in[31], D, 256, (bf16_t*)(c.ws + WS_WR_T), [](int n) { return 256 + n; }, scr, r, c.lane);
    }
}

__device__ __forceinline__ void phase1(const Ctx& c) {
    const int gt = c.bid * 512 + c.tid, NT = c.G * 512;
    const int gw = c.bid * 8 + c.wid, NW = c.G * 8;
    const float* modsp = (const float*)(c.ws + WS_MODSP); const float* b_ada = c.in[3]; float* mods = (float*)(c.ws + WS_MODS);
    for (int idx = gt; idx < BATCH * NMODS; idx += NT) {
        const int b = idx / NMODS, j = idx % NMODS;
        float acc = 0.f;
#pragma unroll
        for (int ks = 0; ks < 16; ++ks) acc += modsp[(ks * 4 + b) * NMODS + j];
        mods[idx] = acc + b_ada[j];
    }
    const float* apow = (const float*)(c.ws + WS_APOW); const float* bb = (const float*)(c.ws + WS_S5BB);
    const float* c_re = c.in[25]; const float* c_im = c.in[26];
    float* klag = (float*)(c.ws + WS_KLAG);
    for (int task = gw; task < S5NG * S5L; task += NW) {
        const int g = task / S5L, j = task % S5L, cc = c.lane >> 2, cq = (c.lane & 3) * 4;
        float acc[4] = {0.f, 0.f, 0.f, 0.f};
        for (int p = 0; p < 64; ++p) {
            const float ar = apow[((size_t)(g * (S5L + 1) + j) * 64 + p) * 2], ai = apow[((size_t)(g * (S5L + 1) + j) * 64 + p) * 2 + 1];
            const float cr = c_re[(g * 16 + cc) * 64 + p], ci = c_im[(g * 16 + cc) * 64 + p];
            const float4 br = *(const float4*)(bb + (size_t)(g * 64 + p) * 32 + cq), bi = *(const float4*)(bb + (size_t)(g * 64 + p) * 32 + 16 + cq);
            const float er = cr * ar - ci * ai, ei = cr * ai + ci * ar;
            acc[0] += er * br.x - ei * bi.x; acc[1] += er * br.y - ei * bi.y; acc[2] += er * br.z - ei * bi.z; acc[3] += er * br.w - ei * bi.w;
        }
        *(float4*)(klag + ((size_t)(g * S5L + j) * 16 + cc) * 16 + cq) = make_float4(acc[0], acc[1], acc[2], acc[3]);
    }
}

__device__ __forceinline__ void phase2(const Ctx& c) {
    const float* x = c.in[0]; const float* g = c.in[4];
    const float* mods = (const float*)(c.ws + WS_MODS);
    bf16_t* xn = (bf16_t*)(c.ws + WS_A);
    const int gw = c.bid * 8 + c.wid, NW = c.G * 8;
    for (int t = gw; t < T; t += NW) {
        const int b = t / SEQ;
        const float4* xr = (const float4*)(x + (size_t)t * D) + c.lane;
        float4 v[4]; float ss = 0.f;
#pragma unroll
        for (int j = 0; j < 4; ++j) { v[j] = xr[64 * j]; ss += v[j].x * v[j].x + v[j].y * v[j].y + v[j].z * v[j].z + v[j].w * v[j].w; }
        const float rstd = rsqrtf(wave_sum(ss) * (1.0f / D) + 1e-6f);
        uint2* o = (uint2*)(xn + (size_t)t * D) + c.lane;
#pragma unroll
        for (int j = 0; j < 4; ++j) {
            const int k = (c.lane + 64 * j) * 4;
            const float4 gg = *(const float4*)(g + k);
            const float4 sh = *(const float4*)(mods + b * NMODS + k);
            const float4 sc = *(const float4*)(mods + b * NMODS + D + k);
            float4 r;
            r.x = v[j].x * rstd * gg.x * (1.f + sc.x) + sh.x; r.y = v[j].y * rstd * gg.y * (1.f + sc.y) + sh.y;
            r.z = v[j].z * rstd * gg.z * (1.f + sc.z) + sh.z; r.w = v[j].w * rstd * gg.w * (1.f + sc.w) + sh.w;
            o[64 * j] = make_uint2(pk2(r.x, r.y), pk2(r.z, r.w));
        }
    }
    const int gt = c.bid * 512 + c.tid, NT = c.G * 512;
    const float* apow = (const float*)(c.ws + WS_APOW); const float* bb = (const float*)(c.ws + WS_S5BB); const float* klag = (const float*)(c.ws + WS_KLAG);
    const float* c_re = c.in[25]; const float* c_im = c.in[26]; const float* dd = c.in[27];
    bf16_t* kmat = (bf16_t*)(c.ws + WS_KMAT); bf16_t* hmat = (bf16_t*)(c.ws + WS_HMAT);
    for (int it = gt; it < S5NG * 512 * 80; it += NT) {
        const int row = it / 80, ch = it % 80, g = row >> 9, t = (row >> 4) & 31, cc = row & 15, col0 = ch * 8;
        float v[8];
        if (col0 < 512) {
            const int s = col0 >> 4, c0 = col0 & 15;
            if (s > t) {
#pragma unroll
                for (int i = 0; i < 8; ++i) v[i] = 0.f;
            } else {
                const float4 k0 = *(const float4*)(klag + ((size_t)(g * S5L + (t - s)) * 16 + cc) * 16 + c0), k1 = *(const float4*)(klag + ((size_t)(g * S5L + (t - s)) * 16 + cc) * 16 + c0 + 4);
                v[0] = k0.x; v[1] = k0.y; v[2] = k0.z; v[3] = k0.w; v[4] = k1.x; v[5] = k1.y; v[6] = k1.z; v[7] = k1.w;
                if (s == t) {
                    const float dv = dd[g * 16 + cc];
#pragma unroll
                    for (int i = 0; i < 8; ++i) if (c0 + i == cc) v[i] += dv;
                }
            }
        } else {
            const int q0 = col0 - 512;
#pragma unroll
            for (int i = 0; i < 8; ++i) {
                const int q = q0 + i, p = q & 63;
                const float ar = apow[((size_t)(g * (S5L + 1) + t + 1) * 64 + p) * 2], ai = apow[((size_t)(g * (S5L + 1) + t + 1) * 64 + p) * 2 + 1];
                const float cr = c_re[(g * 16 + cc) * 64 + p], ci = c_im[(g * 16 + cc) * 64 + p];
                v[i] = (q < 64) ? (cr * ar - ci * ai) : -(cr * ai + ci * ar);
            }
        }
        *(uint4*)(kmat + (size_t)row * 640 + col0) = make_uint4(pk2(v[0], v[1]), pk2(v[2], v[3]), pk2(v[4], v[5]), pk2(v[6], v[7]));
    }
    for (int it = gt; it < S5NG * 256 * 80; it += NT) {
        const int row = it / 80, ch = it % 80, g = row >> 8, q = row & 255, col0 = ch * 8;
        float v[8];
#pragma unroll
        for (int i = 0; i < 8; ++i) v[i] = 0.f;
        if (q < 128 && col0 < 512) {
            const int s = col0 >> 4, c0 = col0 & 15, p = q & 63;
            const float ar = apow[((size_t)(g * (S5L + 1) + (S5L - 1 - s)) * 64 + p) * 2], ai = apow[((size_t)(g * (S5L + 1) + (S5L - 1 - s)) * 64 + p) * 2 + 1];
#pragma unroll
            for (int i = 0; i < 8; ++i) {
                const float br = bb[(size_t)(g * 64 + p) * 32 + c0 + i], bi = bb[(size_t)(g * 64 + p) * 32 + 16 + c0 + i];
                v[i] = (q < 64) ? (ar * br - ai * bi) : (ar * bi + ai * br);
            }
        }
        *(uint4*)(hmat + (size_t)row * 640 + col0) = make_uint4(pk2(v[0], v[1]), pk2(v[2], v[3]), pk2(v[4], v[5]), pk2(v[6], v[7]));
    }
}

__device__ __forceinline__ void phase3(const Ctx& c) {
    pg8::Gemm g{(const bf16_t*)(c.ws + WS_A), (const bf16_t*)(c.ws + WS_WIN_T), T, NPROJ, D};
    pg8::StaticOrder S; S.init(T, NPROJ, c.G, c.bid);
    pg8::EpiBf16<0> E{(bf16_t*)(c.ws + WS_PROJ), NPROJ, nullptr, 0, 0, 1.f};
    pg8::gemm_phase<pg8::EpiBf16<0>, pg8::StaticOrder, true, true>(c.lds, g, S, E);
}

__device__ __forceinline__ void unpack8(const uint4 a, float (&u)[8]) {
    u[0] = bf2f(a.x & 0xffffu); u[1] = bf2f(a.x >> 16); u[2] = bf2f(a.y & 0xffffu); u[3] = bf2f(a.y >> 16);
    u[4] = bf2f(a.z & 0xffffu); u[5] = bf2f(a.z >> 16); u[6] = bf2f(a.w & 0xffffu); u[7] = bf2f(a.w >> 16);
}
__device__ __forceinline__ uint4 pack8(const float (&v)[8]) { return make_uint4(pk2(v[0], v[1]), pk2(v[2], v[3]), pk2(v[4], v[5]), pk2(v[6], v[7])); }
__device__ __forceinline__ void phase4(const Ctx& c) {
    const bf16_t* proj = (const bf16_t*)(c.ws + WS_PROJ);
    const float* mu = c.in[9]; const float* k_k = c.in[15];
    bf16_t* rw_r = (bf16_t*)(c.ws + WS_RW_R); bf16_t* rw_k = (bf16_t*)(c.ws + WS_RW_K); bf16_t* rw_v = (bf16_t*)(c.ws + WS_RW_V); bf16_t* rw_a = (bf16_t*)(c.ws + WS_RW_A);
    bf16_t* alora = (bf16_t*)((unsigned char*)c.out + OUT_ALORA);
    const int gw = c.bid * 8 + c.wid, NW = c.G * 8;
    for (int t = gw; t < T; t += NW) {
        const bool first = (t % SEQ == 0);
        const bf16_t* pr = proj + (size_t)t * NPROJ; const bf16_t* pp = proj + (size_t)(first ? t : t - 1) * NPROJ;
#pragma unroll
        for (int j = 0; j < 4; ++j) {
            const int cidx = c.lane + 64 * j;
            if (cidx < 224) {
                const int col = cidx * 8;
                float p[8], q[8], ps[8];
                unpack8(*(const uint4*)(pr + col), p); unpack8(*(const uint4*)(pp + col), q);
                const float4 m0 = *(const float4*)(mu + col), m1 = *(const float4*)(mu + col + 4);
                const float mm[8] = {m0.x, m0.y, m0.z, m0.w, m1.x, m1.y, m1.z, m1.w};
#pragma unroll
                for (int i = 0; i < 8; ++i) { const float pv = first ? 0.f : q[i]; ps[i] = p[i] + (pv - p[i]) * mm[i]; }
                if (j == 0) *(uint4*)(rw_r + (size_t)t * RW + col) = pack8(ps);
                else if (j == 1) {
                    const int cl = col - 512;
                    *(uint4*)(rw_k + (size_t)t * RW + cl) = pack8(ps);
                    const float4 k0 = *(const float4*)(k_k + cl), k1 = *(const float4*)(k_k + cl + 4);
                    const float kk8[8] = {k0.x, k0.y, k0.z, k0.w, k1.x, k1.y, k1.z, k1.w};
                    float kk[8]; float ss = 0.f;
#pragma unroll
                    for (int i = 0; i < 8; ++i) { kk[i] = ps[i] * kk8[i]; ss += kk[i] * kk[i]; }
                    ss += __shfl_xor(ss, 1); ss += __shfl_xor(ss, 2); ss += __shfl_xor(ss, 4);
                    const float inv = -1.0f / fmaxf(sqrtf(ss), 1e-12f);
#pragma unroll
                    for (int i = 0; i < 8; ++i) kk[i] *= inv;
                    *(uint4*)(rw_a + (size_t)t * RW + cl) = pack8(kk);
                } else if (j == 2) *(uint4*)(rw_v + (size_t)t * RW + (col - 1024)) = pack8(ps);
                else {
                    const int cl = col - 1536;
                    float o[8];
#pragma unroll
                    for (int i = 0; i < 8; ++i) o[i] = (cl < 64) ? tanhf(ps[i]) : (cl < 128) ? ps[i] : sigmoidf_(ps[i]);
                    *(uint4*)(alora + (size_t)t * 256 + cl) = pack8(o);
                }
            }
        }
    }
    bf16_t* ux = (bf16_t*)((unsigned char*)c.out + OUT_UX);
    const int gt = c.bid * 512 + c.tid, NT = c.G * 512;
    for (int it = gt; it < T * 64; it += NT) {
        const int t = it >> 6, g = (it >> 1) & 31, hf = it & 1;
        const int b = t / SEQ, s = t % S5L, chunk = (t % SEQ) / S5L;
        const uint4 v = *(const uint4*)(proj + (size_t)t * NPROJ + RPROJ + g * 16 + hf * 8);
        *(uint4*)(ux + ((size_t)(g * 1024 + b * 256 + chunk)) * 640 + s * 16 + hf * 8) = v;
    }
    for (int it = gt; it < S5NG * 1024 * 16; it += NT) {
        const int row = it >> 4, ch = it & 15;
        *(uint4*)(ux + (size_t)row * 640 + 512 + ch * 8) = make_uint4(0u, 0u, 0u, 0u);
    }
}

__device__ __forceinline__ void phase5(const Ctx& c) {
    {
        pg8::Gemm g{(const bf16_t*)((unsigned char*)c.out + OUT_ALORA), (const bf16_t*)(c.ws + WS_LORA_BT), T, 1536, 256};
        pg8::StaticOrder S; S.init(T, 1536, c.G, c.bid);
        pg8::EpiLora E{c.in[10], c.in[12], c.in[16], (float*)(c.ws + WS_RW_W), (const bf16_t*)(c.ws + WS_RW_K), (bf16_t*)((unsigned char*)c.out + OUT_KF), (const bf16_t*)(c.ws + WS_RW_A), (bf16_t*)(c.ws + WS_RW_B), (bf16_t*)(c.ws + WS_RW_G)};
        pg8::gemm_phase<pg8::EpiLora, pg8::StaticOrder, true, true>(c.lds, g, S, E);
    }
    __syncthreads();
    {
        pg8::Gemm g{(const bf16_t*)((unsigned char*)c.out + OUT_UX), (const bf16_t*)(c.ws + WS_HMAT), 0, 0, 640};
        pg8::S5Order S{128, 1, c.G, c.bid};
        pg8::EpiS5E E{(float*)((unsigned char*)c.out + OUT_E)};
        pg8::gemm_phase<pg8::EpiS5E, pg8::S5Order, true, true>(c.lds, g, S, E);
    }
}

typedef float f2v __attribute__((ext_vector_type(2)));
__device__ __forceinline__ float dpp_add16(float v) {
    v += __builtin_bit_cast(float, __builtin_amdgcn_mov_dpp(__builtin_bit_cast(int, v), 0xB1, 0xf, 0xf, true));
    v += __builtin_bit_cast(float, __builtin_amdgcn_mov_dpp(__builtin_bit_cast(int, v), 0x4E, 0xf, 0xf, true));
    v += __builtin_bit_cast(float, __builtin_amdgcn_mov_dpp(__builtin_bit_cast(int, v), 0x141, 0xf, 0xf, true));
    v += __builtin_bit_cast(float, __builtin_amdgcn_mov_dpp(__builtin_bit_cast(int, v), 0x140, 0xf, 0xf, true));
    return v;
}
constexpr int RTS = 32;
constexpr int RTILE = 6 * RTS * 64;
typedef short bf16x8_t __attribute__((ext_vector_type(8)));
typedef float f32x4_t __attribute__((ext_vector_type(4)));
#define MFMA16(a, b, c) __builtin_amdgcn_mfma_f32_16x16x32_bf16((a), (b), (c), 0, 0, 0)
constexpr int CL = 64, CLD = 72, CSLOT = 64 * CLD * 2;
constexpr int C_DIAG = 13 * CSLOT, C_DM = C_DIAG + 4096, C_GL = C_DM + 2048, C_SEGP = C_GL + 256;
static_assert(C_SEGP + 2048 <= 131072, "rwkv chunk LDS map");
__device__ __forceinline__ bf16x8_t ldsfrag(LAS const unsigned char* slot, int row, int col) { return *(LAS const bf16x8_t*)(slot + (row * CLD + col) * 2); }
typedef unsigned u32x4_t __attribute__((ext_vector_type(4)));
typedef unsigned u32x2_t __attribute__((ext_vector_type(2)));
__device__ __forceinline__ void lds_st16(LAS unsigned char* p, uint4 v) { *(LAS u32x4_t*)p = (u32x4_t){v.x, v.y, v.z, v.w}; }
__device__ __forceinline__ void lds_st8(LAS unsigned char* p, uint2 v) { *(LAS u32x2_t*)p = (u32x2_t){v.x, v.y}; }
__device__ __forceinline__ uint2 lds_ld8(LAS const unsigned char* p) { const u32x2_t v = *(LAS const u32x2_t*)p; return make_uint2(v.x, v.y); }
__device__ __forceinline__ bf16x8_t zfrag() { return (bf16x8_t){0, 0, 0, 0, 0, 0, 0, 0}; }
__device__ __forceinline__ uint2 pack4(float a, float b, float c, float d) { return make_uint2(pk2(a, b), pk2(c, d)); }
__device__ __forceinline__ float wave_sum_u(float v) {
    v = dpp_add16(v);
    return __builtin_bit_cast(float, __builtin_amdgcn_readlane(__builtin_bit_cast(int, v), 0)) + __builtin_bit_cast(float, __builtin_amdgcn_readlane(__builtin_bit_cast(int, v), 16))
         + __builtin_bit_cast(float, __builtin_amdgcn_readlane(__builtin_bit_cast(int, v), 32)) + __builtin_bit_cast(float, __builtin_amdgcn_readlane(__builtin_bit_cast(int, v), 48));
}

__device__ __forceinline__ void rwkv_phaseA(const Ctx& c) {
    const float* __restrict__ rw_w = (const float*)(c.ws + WS_RW_W);
    const bf16_t* __restrict__ rw_r = (const bf16_t*)(c.ws + WS_RW_R); const bf16_t* __restrict__ rw_k = (const bf16_t*)((const unsigned char*)c.out + OUT_KF); const bf16_t* __restrict__ rw_v = (const bf16_t*)(c.ws + WS_RW_V);
    const bf16_t* __restrict__ rw_a = (const bf16_t*)(c.ws + WS_RW_A); const bf16_t* __restrict__ rw_b = (const bf16_t*)(c.ws + WS_RW_B);
    const float* r_k = c.in[17];
    bf16_t* Mq = (bf16_t*)(c.ws + WS_CM); bf16_t* NTq = (bf16_t*)(c.ws + WS_CN); bf16_t* Qq = (bf16_t*)(c.ws + WS_CQ); bf16_t* YTq = (bf16_t*)(c.ws + WS_CY); float* bon = (float*)(c.ws + WS_CBON);
    LAS unsigned char* L = c.lds;
    LAS unsigned char* sAt = L + 0 * CSLOT; LAS unsigned char* sBt = L + 1 * CSLOT; LAS unsigned char* sKt = L + 2 * CSLOT; LAS unsigned char* sRt = L + 3 * CSLOT;
    LAS unsigned char* sBtT = L + 4 * CSLOT; LAS unsigned char* sKtT = L + 5 * CSLOT; LAS unsigned char* sVT = L + 6 * CSLOT;
    LAS unsigned char* sA4 = L + 7 * CSLOT;
    LAS unsigned char* sRHST = L + 11 * CSLOT;
    LAS unsigned char* sXT = L + 0 * CSLOT;
    LAS unsigned char* sAD = L + 2 * CSLOT;
    LAS float* sDIAG = (LAS float*)(L + C_DIAG); LAS bf16_t* sDM = (LAS bf16_t*)(L + C_DM); LAS float* sGL = (LAS float*)(L + C_GL); LAS float* sSEGP = (LAS float*)(L + C_SEGP);
    const int tid = c.tid, w = c.wid, lane = c.lane, lr = lane & 15, lq = lane >> 4;
    for (int ci = c.bid; ci < BATCH * NH * (SEQ / CL); ci += c.G) {
        const int bh = ci >> 7, chunk = ci & 127, b = bh >> 3, h = bh & 7;
        const size_t gbase = (size_t)(b * SEQ + chunk * CL) * RW + h * 64;
        {
            const int kc = tid & 63, seg = tid >> 6;
            float p[8];
#pragma unroll
            for (int j = 0; j < 8; ++j) { const float wv = rw_w[gbase + (size_t)(8 * seg + j) * RW + kc]; p[j] = (j == 0) ? wv : p[j - 1] * wv; }
            sSEGP[seg * 64 + kc] = p[7];
            for (int i = tid; i < 4 * CSLOT / 16; i += 512) lds_st16(sA4 + i * 16, make_uint4(0u, 0u, 0u, 0u));
            __syncthreads();
            float pre = 1.0f;
#pragma unroll
            for (int s = 0; s < 7; ++s) { const float sp = sSEGP[s * 64 + kc]; pre = (s < seg) ? pre * sp : pre; }
            float atT[8], btT[8], ktT[8], vT[8];
            const float rkv = r_k[h * 64 + kc];
#pragma unroll
            for (int j = 0; j < 8; ++j) {
                const int t = 8 * seg + j; const size_t o = gbase + (size_t)t * RW + kc;
                const float G = pre * p[j], Gm1 = (j == 0) ? pre : pre * p[j - 1], inv = 1.0f / G;
                const float av = ldbf(rw_a + o), bv = ldbf(rw_b + o), kv = ldbf(rw_k + o), rv = ldbf(rw_r + o), vv = ldbf(rw_v + o);
                const float at = av * Gm1, bt = bv * inv, kt = kv * inv, rt = rv * G;
                *(LAS bf16_t*)(sAt + (t * CLD + kc) * 2) = (bf16_t)f2bf(at); *(LAS bf16_t*)(sBt + (t * CLD + kc) * 2) = (bf16_t)f2bf(bt);
                *(LAS bf16_t*)(sKt + (t * CLD + kc) * 2) = (bf16_t)f2bf(kt); *(LAS bf16_t*)(sRt + (t * CLD + kc) * 2) = (bf16_t)f2bf(rt);
                atT[j] = at; btT[j] = bt; ktT[j] = kt; vT[j] = vv;
                const float bs = wave_sum_u(rv * kv * rkv);
                if (lane == 0) bon[(size_t)ci * CL + t] = bs;
            }
            lds_st16(sRHST + (kc * CLD + 8 * seg) * 2, pack8(atT)); lds_st16(sBtT + (kc * CLD + 8 * seg) * 2, pack8(btT));
            lds_st16(sKtT + (kc * CLD + 8 * seg) * 2, pack8(ktT)); lds_st16(sVT + (kc * CLD + 8 * seg) * 2, pack8(vT));
            if (seg == 7) sGL[kc] = pre * p[7];
            __syncthreads();
        }
        for (int idx = w; idx < 40; idx += 8) {
            const int m = idx / 10, pr = idx % 10;
            const int ti = (pr >= 6) ? 3 : (pr >= 3) ? 2 : (pr >= 1) ? 1 : 0, si = pr - ti * (ti + 1) / 2;
            LAS const unsigned char* X = (m < 2) ? sAt : sRt; LAS const unsigned char* Y = (m & 1) ? sKt : sBt;
            f32x4_t acc = {0.f, 0.f, 0.f, 0.f};
#pragma unroll
            for (int ks = 0; ks < 2; ++ks) acc = MFMA16(ldsfrag(Y, 16 * si + lr, 32 * ks + 8 * lq), ldsfrag(X, 16 * ti + lr, 32 * ks + 8 * lq), acc);
            const int t = 16 * ti + lr, s0 = 16 * si + 4 * lq;
            float o[4];
#pragma unroll
            for (int rg = 0; rg < 4; ++rg) { const int s = s0 + rg; const bool keep = (m < 2) ? (s < t) : (s <= t); o[rg] = keep ? acc[rg] : 0.f; }
            lds_st8(sA4 + m * CSLOT + (t * CLD + s0) * 2, pack4(o[0], o[1], o[2], o[3]));
            if (m == 0 && ti == si) *(LAS f32x4_t*)(sDIAG + (ti * 16 + lr) * 16 + 4 * lq) = (f32x4_t){o[0], o[1], o[2], o[3]};
        }
        __syncthreads();
        if (w == 0) {
            float x[16];
#pragma unroll
            for (int r = 0; r < 16; ++r) {
                float acc = (r == lr) ? 1.0f : 0.0f;
                float nrow[16];
#pragma unroll
                for (int q4 = 0; q4 < 4; ++q4) { const f32x4_t nv = *(LAS const f32x4_t*)(sDIAG + (lq * 16 + r) * 16 + 4 * q4); nrow[4 * q4] = nv[0]; nrow[4 * q4 + 1] = nv[1]; nrow[4 * q4 + 2] = nv[2]; nrow[4 * q4 + 3] = nv[3]; }
#pragma unroll
                for (int s = 0; s < 16; ++s) if (s < r) acc = fmaf(nrow[s], x[s], acc);
                x[r] = acc;
                sDM[(lq * 16 + r) * 16 + lr] = (bf16_t)f2bf(acc);
            }
        } else {
            for (int idx = w - 1; idx < 16; idx += 7) {
                const int ti = idx >> 2, vi = idx & 3;
                f32x4_t acc = {0.f, 0.f, 0.f, 0.f};
#pragma unroll
                for (int ks = 0; ks < 2; ++ks) acc = MFMA16(ldsfrag(sA4 + 1 * CSLOT, 16 * ti + lr, 32 * ks + 8 * lq), ldsfrag(sVT, 16 * vi + lr, 32 * ks + 8 * lq), acc);
                lds_st8(sRHST + ((64 + 16 * vi + lr) * CLD + 16 * ti + 4 * lq) * 2, pack4(acc[0], acc[1], acc[2], acc[3]));
            }
        }
        __syncthreads();
        f32x4_t rd[4];
#pragma unroll
        for (int i = 0; i < 4; ++i) {
            bf16x8_t fa = zfrag(), fb = zfrag();
            if (lq < 2) { fa = *(LAS const bf16x8_t*)(sDM + (i * 16 + lr) * 16 + 8 * lq); fb = ldsfrag(sRHST, 16 * w + lr, 16 * i + 8 * lq); }
            rd[i] = MFMA16(fa, fb, ((f32x4_t){0.f, 0.f, 0.f, 0.f}));
        }
        if (w < 6) {
            const int i = (w >= 3) ? 3 : (w >= 1) ? 2 : 1, j = w - (i - 1) * i / 2;
            bf16x8_t fa = zfrag(), fb = zfrag();
            if (lq < 2) {
                fa = *(LAS const bf16x8_t*)(sDM + (i * 16 + lr) * 16 + 8 * lq);
#pragma unroll
                for (int jj = 0; jj < 8; ++jj) fb[jj] = (short)*(LAS const bf16_t*)(sA4 + ((16 * i + 8 * lq + jj) * CLD + 16 * j + lr) * 2);
            }
            const f32x4_t acc = MFMA16(fa, fb, ((f32x4_t){0.f, 0.f, 0.f, 0.f}));
#pragma unroll
            for (int rg = 0; rg < 4; ++rg) *(LAS bf16_t*)(sAD + ((16 * i + 4 * lq + rg) * CLD + 16 * j + lr) * 2) = (bf16_t)f2bf(acc[rg]);
        }
        __syncthreads();
#pragma unroll
        for (int i = 0; i < 4; ++i) {
            f32x4_t acc = rd[i];
            if (i >= 1) {
                bf16x8_t fa = zfrag(), fb = zfrag();
                if (8 * lq < 16 * i) { fa = ldsfrag(sAD, 16 * i + lr, 8 * lq); fb = ldsfrag(sXT, 16 * w + lr, 8 * lq); }
                acc = MFMA16(fa, fb, acc);
            }
            if (i == 3) {
                bf16x8_t fa = zfrag(), fb = zfrag();
                if (lq < 2) { fa = ldsfrag(sAD, 48 + lr, 32 + 8 * lq); fb = ldsfrag(sXT, 16 * w + lr, 32 + 8 * lq); }
                acc = MFMA16(fa, fb, acc);
            }
            lds_st8(sXT + ((16 * w + lr) * CLD + 16 * i + 4 * lq) * 2, pack4(acc[0], acc[1], acc[2], acc[3]));
            asm volatile("s_waitcnt lgkmcnt(0)" ::: "memory");
        }
        __syncthreads();
#pragma unroll
        for (int i = 0; i < 8; ++i) {
            const int kind = i >> 1, tile = w + 8 * (i & 1), r4 = tile >> 2, c4 = tile & 3;
            f32x4_t acc = {0.f, 0.f, 0.f, 0.f};
            if (kind == 0) {
#pragma unroll
                for (int ks = 0; ks < 2; ++ks) acc = MFMA16(ldsfrag(sXT, 16 * r4 + lr, 32 * ks + 8 * lq), ldsfrag(sBtT, 16 * c4 + lr, 32 * ks + 8 * lq), acc);
                const int k = 16 * c4 + lr, kp0 = 16 * r4 + 4 * lq; const float gl = sGL[k];
                float o[4];
#pragma unroll
                for (int rg = 0; rg < 4; ++rg) o[rg] = gl * (acc[rg] + ((k == kp0 + rg) ? 1.0f : 0.0f));
                *(uint2*)(Mq + (size_t)ci * 4096 + k * 64 + kp0) = pack4(o[0], o[1], o[2], o[3]);
            } else if (kind == 1) {
#pragma unroll
                for (int ks = 0; ks < 2; ++ks) {
                    acc = MFMA16(ldsfrag(sBtT, 16 * r4 + lr, 32 * ks + 8 * lq), ldsfrag(sXT, 64 + 16 * c4 + lr, 32 * ks + 8 * lq), acc);
                    acc = MFMA16(ldsfrag(sKtT, 16 * r4 + lr, 32 * ks + 8 * lq), ldsfrag(sVT, 16 * c4 + lr, 32 * ks + 8 * lq), acc);
                }
                const int k0 = 16 * r4 + 4 * lq; const f32x4_t gl = *(LAS const f32x4_t*)(sGL + k0);
                *(uint2*)(NTq + (size_t)ci * 4096 + (16 * c4 + lr) * 64 + k0) = pack4(gl[0] * acc[0], gl[1] * acc[1], gl[2] * acc[2], gl[3] * acc[3]);
            } else if (kind == 2) {
#pragma unroll
                for (int ks = 0; ks < 2; ++ks) acc = MFMA16(ldsfrag(sXT, 16 * r4 + lr, 32 * ks + 8 * lq), ldsfrag(sA4 + 2 * CSLOT, 16 * c4 + lr, 32 * ks + 8 * lq), acc);
                const int t = 16 * c4 + lr, kp0 = 16 * r4 + 4 * lq;
                const uint2 rv = lds_ld8(sRt + (t * CLD + kp0) * 2);
                *(uint2*)(Qq + (size_t)ci * 4096 + t * 64 + kp0) = pack4(acc[0] + bf2f(rv.x & 0xffffu), acc[1] + bf2f(rv.x >> 16), acc[2] + bf2f(rv.y & 0xffffu), acc[3] + bf2f(rv.y >> 16));
            } else {
#pragma unroll
                for (int ks = 0; ks < 2; ++ks) {
                    acc = MFMA16(ldsfrag(sA4 + 2 * CSLOT, 16 * r4 + lr, 32 * ks + 8 * lq), ldsfrag(sXT, 64 + 16 * c4 + lr, 32 * ks + 8 * lq), acc);
                    acc = MFMA16(ldsfrag(sA4 + 3 * CSLOT, 16 * r4 + lr, 32 * ks + 8 * lq), ldsfrag(sVT, 16 * c4 + lr, 32 * ks + 8 * lq), acc);
                }
                *(uint2*)(YTq + (size_t)ci * 4096 + (16 * c4 + lr) * 64 + 16 * r4 + 4 * lq) = pack4(acc[0], acc[1], acc[2], acc[3]);
            }
        }
        __syncthreads();
    }
}

__device__ __forceinline__ void rwkv_phaseB(const Ctx& c, const int bh, const int w) {
    const bf16_t* __restrict__ Mq = (const bf16_t*)(c.ws + WS_CM); const bf16_t* __restrict__ NTq = (const bf16_t*)(c.ws + WS_CN); bf16_t* __restrict__ Sst = (bf16_t*)(c.ws + WS_CS);
    const int lane = c.lane, lr = lane & 15, lq = lane >> 4;
    LAS unsigned char* sS = c.lds + 69632 + c.wid * (16 * CLD * 2);
    {
        {
            bf16x8_t sB0 = zfrag(), sB1 = zfrag();
            bf16x8_t ma[4][4][2]; uint2 nv[4][4];
            const size_t ci0 = (size_t)bh * (SEQ / CL);
#define RB_LOAD(slot, cidx) do { _Pragma("unroll") for (int kt = 0; kt < 4; ++kt) { _Pragma("unroll") for (int ks = 0; ks < 2; ++ks) \
                ma[slot][kt][ks] = *(const bf16x8_t*)(Mq + (cidx) * 4096 + (16 * kt + lr) * 64 + 32 * ks + 8 * lq); nv[slot][kt] = *(const uint2*)(NTq + (cidx) * 4096 + (16 * w + lr) * 64 + 16 * kt + 4 * lq); } } while (0)
#pragma unroll
            for (int sl = 0; sl < 4; ++sl) RB_LOAD(sl, ci0 + sl);
#pragma unroll
            for (int chunk = 0; chunk < SEQ / CL; chunk += 4) {
#pragma unroll
                for (int sl = 0; sl < 4; ++sl) {
                    const size_t ci = ci0 + chunk + sl;
                    *(bf16x8_t*)(Sst + ci * 4096 + (16 * w + lr) * 64 + 8 * lq) = sB0; *(bf16x8_t*)(Sst + ci * 4096 + (16 * w + lr) * 64 + 32 + 8 * lq) = sB1;
#pragma unroll
                    for (int kt = 0; kt < 4; ++kt) {
                        f32x4_t acc = {bf2f(nv[sl][kt].x & 0xffffu), bf2f(nv[sl][kt].x >> 16), bf2f(nv[sl][kt].y & 0xffffu), bf2f(nv[sl][kt].y >> 16)};
                        acc = MFMA16(ma[sl][kt][0], sB0, acc); acc = MFMA16(ma[sl][kt][1], sB1, acc);
                        lds_st8(sS + (lr * CLD + 16 * kt + 4 * lq) * 2, pack4(acc[0], acc[1], acc[2], acc[3]));
                    }
                    const size_t cn = (chunk + sl + 4 < SEQ / CL) ? ci + 4 : ci;
                    RB_LOAD(sl, cn);
                    asm volatile("s_waitcnt lgkmcnt(0)" ::: "memory");
                    sB0 = ldsfrag(sS, lr, 8 * lq); sB1 = ldsfrag(sS, lr, 32 + 8 * lq);
                    asm volatile("s_waitcnt lgkmcnt(0)" ::: "memory");
                }
            }
#undef RB_LOAD
        }
    }
}

__device__ __forceinline__ void rwkv_phaseC(const Ctx& c) {
    const bf16_t* __restrict__ Qq = (const bf16_t*)(c.ws + WS_CQ); const bf16_t* __restrict__ YTq = (const bf16_t*)(c.ws + WS_CY); const bf16_t* __restrict__ Sst = (const bf16_t*)(c.ws + WS_CS);
    const float* __restrict__ bon = (const float*)(c.ws + WS_CBON);
    const bf16_t* rw_v = (const bf16_t*)(c.ws + WS_RW_V); const bf16_t* rw_g = (const bf16_t*)(c.ws + WS_RW_G);
    const float* ln_w = c.in[18]; const float* ln_b = c.in[19];
    bf16_t* ycat = (bf16_t*)(c.ws + WS_A);
    const int w = c.wid, lane = c.lane, lr = lane & 15, lq = lane >> 4;
    LAS float* sY = (LAS float*)(c.lds + w * (16 * 68 * 4));
    const int gw = c.bid * 8 + c.wid, NW = c.G * 8;
    for (int task = gw; task < BATCH * NH * (SEQ / CL) * 4; task += NW) {
        const size_t ci = (size_t)(task >> 2); const int tt = task & 3;
        const int bh = (int)(ci >> 7), chunk = (int)(ci & 127), b = bh >> 3, h = bh & 7;
        bf16x8_t qa[2];
#pragma unroll
        for (int ks = 0; ks < 2; ++ks) qa[ks] = *(const bf16x8_t*)(Qq + ci * 4096 + (16 * tt + lr) * 64 + 32 * ks + 8 * lq);
#pragma unroll
        for (int vt = 0; vt < 4; ++vt) {
            const uint2 yv = *(const uint2*)(YTq + ci * 4096 + (16 * vt + lr) * 64 + 16 * tt + 4 * lq);
            f32x4_t acc = {bf2f(yv.x & 0xffffu), bf2f(yv.x >> 16), bf2f(yv.y & 0xffffu), bf2f(yv.y >> 16)};
#pragma unroll
            for (int ks = 0; ks < 2; ++ks) acc = MFMA16(qa[ks], *(const bf16x8_t*)(Sst + ci * 4096 + (16 * vt + lr) * 64 + 32 * ks + 8 * lq), acc);
#pragma unroll
            for (int rg = 0; rg < 4; ++rg) sY[(4 * lq + rg) * 68 + 16 * vt + lr] = acc[rg];
        }
        asm volatile("s_waitcnt lgkmcnt(0)" ::: "memory");
        const int hn = h * 64 + lane;
        const float lw = ln_w[hn], lb = ln_b[hn];
#pragma unroll 4
        for (int tr = 0; tr < 16; ++tr) {
            const int t = chunk * CL + 16 * tt + tr; const size_t tok = (size_t)b * SEQ + t;
            const float y = sY[tr * 68 + lane];
            const float mean = wave_sum_u(y) * (1.f / 64.f);
            const float d = y - mean;
            const float var = wave_sum_u(d * d) * (1.f / 64.f);
            const float yn = d * rsqrtf(var + 64e-5f) * lw + lb;
            const float bonus = bon[ci * CL + 16 * tt + tr] * ldbf(rw_v + tok * RW + hn);
            ycat[tok * D + hn] = (bf16_t)f2bf((yn + bonus) * ldbf(rw_g + tok * RW + hn));
        }
        asm volatile("s_waitcnt lgkmcnt(0)" ::: "memory");
    }
}

__device__ __forceinline__ void phase6a(const Ctx& c) { rwkv_phaseA(c); }

__device__ __forceinline__ void phase6b(const Ctx& c) {
    if (c.wid == 0) {
        for (int tk = c.bid; tk < 2 * S5NG * BATCH; tk += c.G) {
            if (tk < BATCH * NH * 4) { rwkv_phaseB(c, tk >> 2, tk & 3); continue; }
            const float* apow = (const float*)(c.ws + WS_APOW); const float* E = (const float*)((const unsigned char*)c.out + OUT_E);
            bf16_t* ux = (bf16_t*)((unsigned char*)c.out + OUT_UX);
            const int task = tk - BATCH * NH * 4;
            const int g = task >> 2, b = task & 3, p = c.lane;
            const float pr = apow[((size_t)(g * (S5L + 1) + S5L) * 64 + p) * 2], pi = apow[((size_t)(g * (S5L + 1) + S5L) * 64 + p) * 2 + 1];
            float xr = 0.f, xi = 0.f;
            const size_t row0 = (size_t)g * 1024 + b * 256;
            float er[2][8], ei[2][8];
#pragma unroll
            for (int q = 0; q < 8; ++q) { er[0][q] = E[(row0 + q) * 128 + p]; ei[0][q] = E[(row0 + q) * 128 + 64 + p]; }
#pragma unroll
            for (int bt = 0; bt < 32; ++bt) {
                const int cur = bt & 1, nx = cur ^ 1, ch0 = bt * 8;
                if (bt + 1 < 32) {
#pragma unroll
                    for (int q = 0; q < 8; ++q) { er[nx][q] = E[(row0 + ch0 + 8 + q) * 128 + p]; ei[nx][q] = E[(row0 + ch0 + 8 + q) * 128 + 64 + p]; }
                }
#pragma unroll
                for (int q = 0; q < 8; ++q) {
                    ux[(row0 + ch0 + q) * 640 + 512 + p] = (bf16_t)f2bf(xr); ux[(row0 + ch0 + q) * 640 + 576 + p] = (bf16_t)f2bf(xi);
                    const float nr = pr * xr - pi * xi + er[cur][q], ni = pr * xi + pi * xr + ei[cur][q]; xr = nr; xi = ni;
                }
            }
        }
    } else {
        convert_expert_weights(c, c.bid * 7 + (c.wid - 1), c.G * 7);
    }
}

__device__ __forceinline__ void phase7(const Ctx& c) {
    {
        pg8::Gemm g{(const bf16_t*)((unsigned char*)c.out + OUT_UX), (const bf16_t*)(c.ws + WS_KMAT), 0, 0, 640};
        pg8::S5Order S{256, 2, c.G, c.bid};
        pg8::EpiS5Out E{(bf16_t*)(c.ws + WS_YS5)};
        pg8::gemm_phase<pg8::EpiS5Out, pg8::S5Order, true, true>(c.lds, g, S, E);
    }
    __syncthreads();
    rwkv_phaseC(c);
}

__device__ __forceinline__ void phase8(const Ctx& c) {
    pg8::Gemm g{(const bf16_t*)(c.ws + WS_YS5), (const bf16_t*)(c.ws + WS_WGLU_T), T, 512, 512};
    pg8::StaticOrder S; S.init(T, 512, c.G, c.bid);
    pg8::EpiGLU E{(const bf16_t*)(c.ws + WS_YS5), 512, c.in[29], (bf16_t*)(c.ws + WS_A), D, 512};
    pg8::gemm_phase<pg8::EpiGLU, pg8::StaticOrder, true, true>(c.lds, g, S, E);
}

__device__ __forceinline__ void phase9(const Ctx& c) {
    pg8::Gemm g{(const bf16_t*)(c.ws + WS_A), (const bf16_t*)(c.ws + WS_WOUT_T), T, D, D};
    pg8::StaticOrder S; S.init(T, D, c.G, c.bid);
    pg8::EpiF32 E{(float*)(c.ws + WS_PROJ), D};
    pg8::gemm_phase<pg8::EpiF32, pg8::StaticOrder, true, true>(c.lds, g, S, E);
}

__device__ __forceinline__ void phase10(const Ctx& c) {
    const float* x = c.in[0]; const float* gpm = c.in[5]; const float* gpf = c.in[6];
    const float* mods = (const float*)(c.ws + WS_MODS); const float* mixed = (const float*)(c.ws + WS_PROJ);
    bf16_t* h2 = (bf16_t*)(c.ws + WS_A); float* x1o = c.out;
    const int gw = c.bid * 8 + c.wid, NW = c.G * 8;
    for (int t = gw; t < T; t += NW) {
        const int b = t / SEQ;
        const float4* mr = (const float4*)(mixed + (size_t)t * D) + c.lane;
        const float4* xr = (const float4*)(x + (size_t)t * D) + c.lane;
        float4 m[4], v[4]; float ss = 0.f;
#pragma unroll
        for (int j = 0; j < 4; ++j) { m[j] = mr[64 * j]; v[j] = xr[64 * j]; ss += m[j].x * m[j].x + m[j].y * m[j].y + m[j].z * m[j].z + m[j].w * m[j].w; }
        const float rstd = rsqrtf(wave_sum(ss) * (1.0f / D) + 1e-6f);
        float s1 = 0.f;
#pragma unroll
        for (int j = 0; j < 4; ++j) {
            const int k = (c.lane + 64 * j) * 4;
            const float4 gg = *(const float4*)(gpm + k);
            const float4 gt = *(const float4*)(mods + b * NMODS + 2 * D + k);
            v[j].x += gt.x * (m[j].x * rstd * gg.x); v[j].y += gt.y * (m[j].y * rstd * gg.y);
            v[j].z += gt.z * (m[j].z * rstd * gg.z); v[j].w += gt.w * (m[j].w * rstd * gg.w);
            s1 += v[j].x * v[j].x + v[j].y * v[j].y + v[j].z * v[j].z + v[j].w * v[j].w;
            ((float4*)(x1o + (size_t)t * D) + c.lane)[64 * j] = v[j];
        }
        const float rstd1 = rsqrtf(wave_sum(s1) * (1.0f / D) + 1e-6f);
#pragma unroll
        for (int j = 0; j < 4; ++j) {
            const int k = (c.lane + 64 * j) * 4;
            const float4 gg = *(const float4*)(gpf + k);
            const float4 sh = *(const float4*)(mods + b * NMODS + 3 * D + k);
            const float4 sc = *(const float4*)(mods + b * NMODS + 4 * D + k);
            float r[4];
            r[0] = v[j].x * rstd1 * gg.x * (1.f + sc.x) + sh.x; r[1] = v[j].y * rstd1 * gg.y * (1.f + sc.y) + sh.y;
            r[2] = v[j].z * rstd1 * gg.z * (1.f + sc.z) + sh.z; r[3] = v[j].w * rstd1 * gg.w * (1.f + sc.w) + sh.w;
            unsigned hi[4]; float lo[4];
#pragma unroll
            for (int q = 0; q < 4; ++q) { hi[q] = f2bf(r[q]); lo[q] = r[q] - bf2f(hi[q]); }
            ((uint2*)(h2 + (size_t)t * D) + c.lane)[64 * j] = make_uint2(hi[0] | (hi[1] << 16), hi[2] | (hi[3] << 16));
            ((uint2*)(h2 + (size_t)(T + t) * D) + c.lane)[64 * j] = make_uint2(pk2(lo[0], lo[1]), pk2(lo[2], lo[3]));
        }
    }
}

__device__ __forceinline__ void phase11(const Ctx& c) {
    {
        pg8::Gemm g{(const bf16_t*)(c.ws + WS_A), (const bf16_t*)(c.ws + WS_WR_T), 2 * T, 512, D};
        pg8::StaticOrder S; S.init(2 * T, 512, c.G, c.bid);
        pg8::EpiF32 E{(float*)(c.ws + WS_PLOG), 512};
        pg8::gemm_phase<pg8::EpiF32, pg8::StaticOrder, true, true>(c.lds, g, S, E);
    }
    __syncthreads();
    {
        pg8::Gemm g{(const bf16_t*)(c.ws + WS_A), (const bf16_t*)(c.ws + WS_WSGU_T), T, 512, D};
        pg8::StaticOrder S; S.init(T, 512, c.G, c.bid);
        pg8::EpiSwiGLU E{(bf16_t*)(c.ws + WS_HS), 256};
        pg8::gemm_phase<pg8::EpiSwiGLU, pg8::StaticOrder, true, true>(c.lds, g, S, E);
    }
}

#define DPPU(v, ctrl) ((unsigned)__builtin_amdgcn_mov_dpp((int)(v), (ctrl), 0xf, 0xf, true))
#define DPPF(v, ctrl) __builtin_bit_cast(float, __builtin_amdgcn_mov_dpp(__builtin_bit_cast(int, (v)), (ctrl), 0xf, 0xf, true))
__device__ __forceinline__ unsigned fkey(float f) { const unsigned u = __builtin_bit_cast(unsigned, f); return u ^ ((u >> 31) ? 0xffffffffu : 0x80000000u); }
__device__ __forceinline__ unsigned wave_umax(unsigned v) {
    v = max(v, DPPU(v, 0xB1)); v = max(v, DPPU(v, 0x4E)); v = max(v, DPPU(v, 0x141)); v = max(v, DPPU(v, 0x140));
    const unsigned a = __builtin_amdgcn_readlane(v, 0), b = __builtin_amdgcn_readlane(v, 16), c = __builtin_amdgcn_readlane(v, 32), d = __builtin_amdgcn_readlane(v, 48);
    return max(max(a, b), max(c, d));
}
__device__ __forceinline__ unsigned wave_umin(unsigned v) {
    v = min(v, DPPU(v, 0xB1)); v = min(v, DPPU(v, 0x4E)); v = min(v, DPPU(v, 0x141)); v = min(v, DPPU(v, 0x140));
    const unsigned a = __builtin_amdgcn_readlane(v, 0), b = __builtin_amdgcn_readlane(v, 16), c = __builtin_amdgcn_readlane(v, 32), d = __builtin_amdgcn_readlane(v, 48);
    return min(min(a, b), min(c, d));
}
__device__ __forceinline__ void phase12(const Ctx& c) {
    const float* plog = (const float*)(c.ws + WS_PLOG); const float* rb = c.in[32];
    int* idx = (int*)(c.ws + WS_IDX); float* wt = (float*)(c.ws + WS_WT);
    LAS int* lhist = (LAS int*)c.lds;
    __syncthreads();
    if (c.tid < NE) lhist[c.tid] = 0;
    __syncthreads();
    const int gw = c.bid * 8 + c.wid, NW = c.G * 8, l = c.lane;
    const float4 bias = *(const float4*)(rb + l * 4);
    for (int t = gw; t < T; t += NW) {
        const float4 p0 = *(const float4*)(plog + (size_t)t * 512 + l * 4), p1 = *(const float4*)(plog + (size_t)t * 512 + 256 + l * 4);
        const float4 p2 = *(const float4*)(plog + (size_t)(T + t) * 512 + l * 4), p3 = *(const float4*)(plog + (size_t)(T + t) * 512 + 256 + l * 4);
        const float lg[4] = {p0.x + (p1.x + p2.x + p3.x), p0.y + (p1.y + p2.y + p3.y), p0.z + (p1.z + p2.z + p3.z), p0.w + (p1.w + p2.w + p3.w)};
        float s[4] = {sigmoidf_(lg[0]), sigmoidf_(lg[1]), sigmoidf_(lg[2]), sigmoidf_(lg[3])};
        float ch[4] = {s[0] + bias.x, s[1] + bias.y, s[2] + bias.z, s[3] + bias.w};
        float a1 = fmaxf(ch[0], ch[1]), a2 = fminf(ch[0], ch[1]);
        { const float b1 = fmaxf(ch[2], ch[3]), b2 = fminf(ch[2], ch[3]); const float n1 = fmaxf(a1, b1), n2 = fmaxf(fminf(a1, b1), fmaxf(a2, b2)); a1 = n1; a2 = n2; }
        { const float b1 = DPPF(a1, 0xB1), b2 = DPPF(a2, 0xB1); const float n1 = fmaxf(a1, b1), n2 = fmaxf(fminf(a1, b1), fmaxf(a2, b2)); a1 = n1; a2 = n2; }
        { const float b1 = DPPF(a1, 0x4E), b2 = DPPF(a2, 0x4E); const float n1 = fmaxf(a1, b1), n2 = fmaxf(fminf(a1, b1), fmaxf(a2, b2)); a1 = n1; a2 = n2; }
        { const float b1 = DPPF(a1, 0x141), b2 = DPPF(a2, 0x141); const float n1 = fmaxf(a1, b1), n2 = fmaxf(fminf(a1, b1), fmaxf(a2, b2)); a1 = n1; a2 = n2; }
        const float gs = a1 + a2; const int myg = l >> 3;
        int rank = 0;
#pragma unroll
        for (int g = 0; g < 8; ++g) { const float og = __builtin_bit_cast(float, __builtin_amdgcn_readlane(__builtin_bit_cast(int, gs), g * 8)); rank += (og > gs || (og == gs && g < myg)) ? 1 : 0; }
        const bool sel = rank < 4;
        unsigned mk[4];
#pragma unroll
        for (int i = 0; i < 4; ++i) mk[i] = sel ? fkey(ch[i]) : 0u;
        float sk[8]; int ek[8]; float ssum = 0.f;
#pragma unroll
        for (int k = 0; k < 8; ++k) {
            const unsigned lm = max(max(mk[0], mk[1]), max(mk[2], mk[3]));
            const unsigned m = wave_umax(lm);
            unsigned cand = 1023u;
#pragma unroll
            for (int i = 3; i >= 0; --i) if (mk[i] == m) cand = (unsigned)(l * 4 + i);
            const int be = (int)wave_umin(cand);
            const int ii = be & 3;
            float sv = s[0]; sv = (ii == 1) ? s[1] : sv; sv = (ii == 2) ? s[2] : sv; sv = (ii == 3) ? s[3] : sv;
            sv = __builtin_bit_cast(float, __builtin_amdgcn_readlane(__builtin_bit_cast(int, sv), be >> 2));
            if ((be >> 2) == l) {
#pragma unroll
                for (int i = 0; i < 4; ++i) if (i == ii) mk[i] = 0u;
            }
            sk[k] = sv; ek[k] = be; ssum += sv;
        }
        if (l == 0) {
            const float inv = 2.5f / ssum;
#pragma unroll
            for (int k = 0; k < 8; ++k) { idx[t * 8 + k] = ek[k]; wt[t * 8 + k] = sk[k] * inv; __hip_atomic_fetch_add(lhist + ek[k], 1, __ATOMIC_RELAXED, __HIP_MEMORY_SCOPE_WORKGROUP); }
        }
    }
    __syncthreads();
    if (c.tid < NE) ((int*)(c.ws + WS_HIST))[c.bid * NE + c.tid] = lhist[c.tid];
}

__device__ __forceinline__ void phase13(const Ctx& c) {
    int* smi = (int*)c.sm;
    const int* hist = (const int*)(c.ws + WS_HIST);
    __syncthreads();
    if (c.tid < NE) {
        int tot = 0, base = 0;
        for (int bb = 0; bb < c.G; ++bb) { const int v = hist[bb * NE + c.tid]; tot += v; base += (bb < c.bid) ? v : 0; }
        smi[600 + c.tid] = tot; smi[900 + c.tid] = base; smi[1200 + c.tid] = 0; smi[300 + c.tid] = (tot + 255) >> 8;
    }
    __syncthreads();
    if (c.tid < 64) {
        const int l = c.tid; const int u0 = smi[300 + l * 4], u1 = smi[300 + l * 4 + 1], u2 = smi[300 + l * 4 + 2], u3 = smi[300 + l * 4 + 3];
        const int tot = u0 + u1 + u2 + u3; int inc = tot;
#pragma unroll
        for (int o = 1; o < 64; o <<= 1) { const int v = __shfl_up(inc, o); if (l >= o) inc += v; }
        const int ex = inc - tot;
        smi[l * 4] = ex; smi[l * 4 + 1] = ex + u0; smi[l * 4 + 2] = ex + u0 + u1; smi[l * 4 + 3] = ex + u0 + u1 + u2;
        if (l == 63) smi[NE] = inc;
    }
    __syncthreads();
    const int* idx = (const int*)(c.ws + WS_IDX); int* slotp = (int*)(c.ws + WS_SLOTP); int* uexp = (int*)(c.ws + WS_UEXP); int* slotw = (int*)(c.ws + WS_SLOTW); const float* wt = (const float*)(c.ws + WS_WT);
    const int gw = c.bid * 8 + c.wid, NW = c.G * 8;
    for (int t = gw; t < T; t += NW) {
        if (c.lane < 8) {
            const int a = t * 8 + c.lane, e = idx[a];
            const int pos = smi[900 + e] + __hip_atomic_fetch_add(smi + 1200 + e, 1, __ATOMIC_RELAXED, __HIP_MEMORY_SCOPE_WORKGROUP);
            const int slot = smi[e] * 256 + pos;
            slotp[slot] = a;
            *(int2*)(slotw + 2 * (size_t)slot) = make_int2(a, __float_as_int(wt[a]));
        }
    }
    const int gt = c.bid * 512 + c.tid, NT = c.G * 512;
    for (int e = gt; e < NE; e += NT) {
        const int u0 = smi[e], u1 = smi[e + 1], cn = smi[600 + e];
        for (int p = cn; p < (u1 - u0) * 256; ++p) { slotp[u0 * 256 + p] = -1; *(int2*)(slotw + 2 * (size_t)(u0 * 256 + p)) = make_int2(-1, 0); }
        for (int u = u0; u < u1; ++u) uexp[u] = e;
    }
    if (gt == 0) uexp[2048] = smi[NE];
}

__device__ __forceinline__ void phase14(const Ctx& c) {
    const int* uexp = (const int*)(c.ws + WS_UEXP);
    const int NU = __builtin_amdgcn_readfirstlane(uexp[2048]);
    const int vcu = (c.G % 8 == 0) ? (c.bid % 8) * (c.G / 8) + c.bid / 8 : c.bid;
    pg8::Gemm g{(const bf16_t*)(c.ws + WS_A), (const bf16_t*)(c.ws + WS_WEGU), 0, 0, D, (const int*)(c.ws + WS_SLOTP)};
    pg8::ExpertOrder S{uexp, NU, 2, c.G, vcu};
    pg8::EpiSwiGLU E{(bf16_t*)(c.ws + WS_HID), 256};
    pg8::gemm_phase<pg8::EpiSwiGLU, pg8::ExpertOrder, true, true, true>(c.lds, g, S, E);
}

__device__ __forceinline__ void phase15(const Ctx& c) {
    {
        const int* uexp = (const int*)(c.ws + WS_UEXP);
        const int NU = __builtin_amdgcn_readfirstlane(uexp[2048]);
        const int vcu = (c.G % 8 == 0) ? (c.bid % 8) * (c.G / 8) + c.bid / 8 : c.bid;
        pg8::Gemm g{(const bf16_t*)(c.ws + WS_HID), (const bf16_t*)(c.ws + WS_WED), 0, 0, EFF};
        pg8::ExpertOrder S{uexp, NU, 4, c.G, vcu};
        pg8::EpiScatter E{(const int*)(c.ws + WS_SLOTW), (bf16_t*)(c.ws + WS_YEXP), D};
        pg8::gemm_phase<pg8::EpiScatter, pg8::ExpertOrder, true, true>(c.lds, g, S, E);
    }
    __syncthreads();
    {
        pg8::Gemm g{(const bf16_t*)(c.ws + WS_HS), (const bf16_t*)(c.ws + WS_WSD_T), T, D, 256};
        pg8::StaticOrder S; S.init(T, D, c.G, c.bid);
        pg8::EpiF32 E{(float*)(c.ws + WS_SHOUT), D};
        pg8::gemm_phase<pg8::EpiF32, pg8::StaticOrder, true, true>(c.lds, g, S, E);
    }
}

__device__ __forceinline__ void phase16(const Ctx& c) {
    const float* gq = c.in[7]; const float* mods = (const float*)(c.ws + WS_MODS);
    const float* shout = (const float*)(c.ws + WS_SHOUT); const bf16_t* yexp = (const bf16_t*)(c.ws + WS_YEXP);
    float* out = c.out; float* dst = c.dry ? (float*)(c.ws + WS_PROJ) : c.out;
    const int gw = c.bid * 8 + c.wid, NW = c.G * 8;
    for (int t = gw; t < T; t += NW) {
        const int b = t / SEQ;
        float4 y[4]; float ss = 0.f;
#pragma unroll
        for (int j = 0; j < 4; ++j) {
            const int k = (c.lane + 64 * j) * 4;
            float4 a = *(const float4*)(shout + (size_t)t * D + k);
#pragma unroll
            for (int q = 0; q < 8; ++q) {
                const float4 v = ldbf4(yexp + (size_t)(t * 8 + q) * D + k);
                a.x += v.x; a.y += v.y; a.z += v.z; a.w += v.w;
            }
            y[j] = a; ss += a.x * a.x + a.y * a.y + a.z * a.z + a.w * a.w;
        }
        const float rstd = rsqrtf(wave_sum(ss) * (1.0f / D) + 1e-6f);
#pragma unroll
        for (int j = 0; j < 4; ++j) {
            const int k = (c.lane + 64 * j) * 4;
            const float4 gg = *(const float4*)(gq + k);
            const float4 gt = *(const float4*)(mods + b * NMODS + 5 * D + k);
            float4 x1 = *(const float4*)(out + (size_t)t * D + k);
            x1.x += gt.x * (y[j].x * rstd * gg.x); x1.y += gt.y * (y[j].y * rstd * gg.y);
            x1.z += gt.z * (y[j].z * rstd * gg.z); x1.w += gt.w * (y[j].w * rstd * gg.w);
            *(float4*)(dst + (size_t)t * D + k) = x1;
        }
    }
}

constexpr int NPHASES = 18;
__device__ __forceinline__ void probe_reset(const Ctx& c, int k) {
    unsigned* counts = (unsigned*)(c.ws + WS_COUNTS);
    if (k == 13 && c.bid == 0 && c.tid < 256) counts[c.tid] = 0u;
    if (k == 14 && c.bid == 0 && c.tid < 256) counts[256 + c.tid] = 0u;
}

__global__ void __launch_bounds__(512, 2) mega(Args args) {
    extern __shared__ __attribute__((aligned(16))) unsigned char lds_raw[];
    Ctx c;
    c.in = args.in; c.out = args.out; c.ws = args.ws;
    c.lds = (LAS unsigned char*)lds_raw; c.sm = (float*)lds_raw;
    c.dry = 0;
    c.tid = threadIdx.x; c.lane = c.tid & 63; c.wid = __builtin_amdgcn_readfirstlane(c.tid >> 6); c.bid = blockIdx.x; c.G = gridDim.x;
    volatile LAS unsigned* st = (volatile LAS unsigned*)(c.lds + LDS_CTL_OFF);
    if (c.tid < 4) st[c.tid] = 0u;
    __syncthreads();
    XcdBarrier bar; bar.bar = (unsigned*)(args.ws + WS_CTL); bar.x = 0; bar.st = st;
    const bool multi = (args.hi - args.lo) > 1;
    if (multi) bar = xcd_barrier_post((unsigned*)(args.ws + WS_CTL), st);
    const int lo = args.lo, hi = args.hi;
#ifndef REPEAT_PHASE
#define REPEAT_PHASE -1
#endif
#define LAUNDER() do { int t_ = threadIdx.x; asm volatile("" : "+v"(t_)); c.tid = t_; c.lane = t_ & 63; int b_ = blockIdx.x; asm volatile("" : "+s"(b_)); c.bid = b_; } while (0)
#define RUN_PHASE(k, call) if (lo <= (k) && (k) < hi) { if ((k) == REPEAT_PHASE) { LAUNDER(); c.dry = 1; call; c.dry = 0; xcd_barrier(bar); probe_reset(c, (k)); xcd_barrier(bar); } LAUNDER(); call; if ((k) + 1 < hi) xcd_barrier(bar); }
    RUN_PHASE(0, phase0(c))
    RUN_PHASE(1, phase1(c))
    RUN_PHASE(2, phase2(c))
    RUN_PHASE(3, phase3(c))
    RUN_PHASE(4, phase4(c))
    RUN_PHASE(5, phase5(c))
    RUN_PHASE(6, phase6a(c))
    RUN_PHASE(7, phase6b(c))
    RUN_PHASE(8, phase7(c))
    RUN_PHASE(9, phase8(c))
    RUN_PHASE(10, phase9(c))
    RUN_PHASE(11, phase10(c))
    RUN_PHASE(12, phase11(c))
    RUN_PHASE(13, phase12(c))
    RUN_PHASE(14, phase13(c))
    RUN_PHASE(15, phase14(c))
    RUN_PHASE(16, phase15(c))
    RUN_PHASE(17, phase16(c))
#undef RUN_PHASE
}

#ifndef N_LAUNCH_MODE
#define N_LAUNCH_MODE 1
#endif

extern "C" void kernel_launch(void* const* d_in, const int* in_sizes, int n_in, void* d_out, int out_size, void* d_ws, size_t ws_size, hipStream_t stream) {
    static int grid = 0;
    if (grid == 0) {
        if (n_in != 39 || out_size != T * D || ws_size < WS_END) { fprintf(stderr, "kernel_launch: unexpected shapes n_in %d out %d ws %zu\n", n_in, out_size, ws_size); grid = -1; return; }
        int dev = 0, cus = 0, per_cu = 0;
        if (hipGetDevice(&dev) != hipSuccess || hipDeviceGetAttribute(&cus, hipDeviceAttributeMultiprocessorCount, dev) != hipSuccess) { grid = -1; return; }
        if (hipFuncSetAttribute((const void*)mega, hipFuncAttributeMaxDynamicSharedMemorySize, LDS_BYTES) != hipSuccess) { grid = -1; return; }
        if (hipOccupancyMaxActiveBlocksPerMultiprocessor(&per_cu, (const void*)mega, 512, LDS_BYTES) != hipSuccess || per_cu < 1) { fprintf(stderr, "kernel_launch: occupancy query says %d\n", per_cu); }
        (void)hipGetLastError();
        grid = cus;
    }
    if (grid < 0) return;
    (void)hipMemsetAsync((char*)d_ws + WS_CTL, 0, CTL_BYTES, stream);
    Args a{};
    for (int i = 0; i < 39; ++i) a.in[i] = (const float*)d_in[i];
    a.out = (float*)d_out; a.ws = (unsigned char*)d_ws;
    if (N_LAUNCH_MODE == 1) {
        a.lo = 0; a.hi = NPHASES;
        hipLaunchKernelGGL(mega, dim3(grid), dim3(512), LDS_BYTES, stream, a);
    } else {
        for (int ph = 0; ph < NPHASES; ++ph) {
            a.lo = ph; a.hi = ph + 1;
            hipLaunchKernelGGL(mega, dim3(grid), dim3(512), LDS_BYTES, stream, a);
        }
    }
}
```

```cpp
#include <hip/hip_runtime.h>
#include <cstdint>
#include <cstdio>

#define LAS __attribute__((address_space(3)))

constexpr int D = 1024, BATCH = 4, SEQ = 8192, T = BATCH * SEQ;
constexpr int RW = 512, NH = 8;
constexpr int RPROJ = 1792, NPROJ = 2304;
constexpr int S5NG = 32, S5P = 64;
constexpr int NE = 256, EFF = 256;
constexpr int NMODS = 6 * D;
constexpr int S5L = 32;

constexpr size_t MiB = 1u << 20;
constexpr size_t WS_CTL = 0, CTL_BYTES = 1 * MiB;
constexpr size_t WS_COUNTS = 64 * 1024;
constexpr size_t WS_MODS = 1 * MiB;
constexpr size_t WS_HMAT = 2 * MiB;
constexpr size_t WS_WIN_T = 12 * MiB;
constexpr size_t WS_WOUT_T = 17 * MiB;
constexpr size_t WS_WGLU_T = 19 * MiB;
constexpr size_t WS_WSGU_T = 19 * MiB + 512 * 1024;
constexpr size_t WS_WSD_T = 20 * MiB + 512 * 1024;
constexpr size_t WS_WR_T = 21 * MiB;
constexpr size_t WS_LORA_BT = 22 * MiB;
constexpr size_t WS_APOW = 23 * MiB;
constexpr size_t WS_KMAT = 1000 * MiB;
constexpr size_t WS_MODSP = 1020 * MiB;
constexpr size_t WS_S5BB = 1022 * MiB;
constexpr size_t WS_KLAG = 1022 * MiB + 512 * 1024;
constexpr size_t OUT_UX = 0;
constexpr size_t OUT_E = 40 * MiB;
constexpr size_t OUT_ALORA = 56 * MiB;
constexpr size_t OUT_KF = 72 * MiB;
constexpr size_t WS_WED = 24 * MiB;
constexpr size_t WS_WEGU = 152 * MiB;
constexpr size_t WS_A = 408 * MiB;
constexpr size_t WS_YS5 = WS_A + 64 * MiB;
constexpr size_t WS_PROJ = 536 * MiB;
constexpr size_t WS_RW = 680 * MiB;
constexpr size_t RWSZ = (size_t)T * RW * 4;
constexpr size_t RWSZH = (size_t)T * RW * 2;
constexpr size_t WS_RW_W = WS_RW, WS_RW_Y = WS_RW + RWSZ, WS_RW_R = WS_RW + 2 * RWSZ, WS_RW_K = WS_RW_R + RWSZH, WS_RW_V = WS_RW_K + RWSZH,
                 WS_RW_A = WS_RW_V + RWSZH, WS_RW_B = WS_RW_A + RWSZH, WS_RW_G = WS_RW_B + RWSZH;
constexpr size_t WS_CM = WS_PROJ, WS_CN = WS_PROJ + 32 * MiB, WS_CQ = WS_PROJ + 64 * MiB, WS_CY = WS_PROJ + 96 * MiB;
constexpr size_t WS_CS = WS_RW_Y, WS_CBON = WS_RW_Y + 32 * MiB;
constexpr size_t WS_PLOG = 680 * MiB;
constexpr size_t WS_SHOUT = 680 * MiB;
constexpr size_t WS_HS = 808 * MiB;
constexpr size_t WS_IDX = 824 * MiB;
constexpr size_t WS_WT = 825 * MiB;
constexpr size_t WS_SLOTP = 826 * MiB;
constexpr size_t WS_UEXP = 827 * MiB + 512 * 1024;
constexpr size_t WS_SLOTW = 828 * MiB;
constexpr size_t WS_HIST = 831 * MiB;
constexpr size_t WS_HID = 840 * MiB;
constexpr size_t WS_YEXP = 152 * MiB;
constexpr size_t WS_END = 1023 * MiB + 512 * 1024;

constexpr int LDS_BYTES = 132096;
constexpr int LDS_CTL_OFF = 131072;

#define XB_TMO      128
#define XB_XCNT(j)  (256  + 64 * (j))
#define XB_XSUB(j)  (1280 + 64 * (j))
#define XB_XGEN(j)  (2304 + 64 * (j))
#define XB_TOP      3328
#define XB_TOPGEN   3392
#define XCD_BAR_WORDS 3456
#define XB_SPIN_CAP (1u << 24)

__device__ __forceinline__ unsigned xb_ld(unsigned* p)              { return __hip_atomic_load(p, __ATOMIC_RELAXED, __HIP_MEMORY_SCOPE_AGENT); }
__device__ __forceinline__ unsigned xb_add(unsigned* p, unsigned v) { return __hip_atomic_fetch_add(p, v, __ATOMIC_RELAXED, __HIP_MEMORY_SCOPE_AGENT); }
__device__ __forceinline__ unsigned xb_xcc_id() { return (unsigned)__builtin_amdgcn_s_getreg((3 << 11) | 20) & 0xFu; }
#define XB_SPIN(cond, bar) do { unsigned _sp = 0; while (cond) { __builtin_amdgcn_s_sleep(1); \
    if ((++_sp & 255u) == 0u) { if (xb_ld(&(bar)[XB_TMO])) break; if (_sp > XB_SPIN_CAP) { atomicAdd(&(bar)[XB_TMO], 1u); break; } } } } while (0)

struct XcdBarrier { unsigned* bar; unsigned x; volatile LAS unsigned* st; };

__device__ __forceinline__ XcdBarrier xcd_barrier_post(unsigned* bar, volatile LAS unsigned* st) {
    XcdBarrier b; b.bar = bar; b.x = xb_xcc_id(); b.st = st;
    if (threadIdx.x == 0) (void)xb_add(&bar[XB_XCNT(b.x)], 1u);
    return b;
}
__device__ __forceinline__ void xcd_barrier_complete(unsigned* bar, unsigned x, unsigned& nloc, unsigned& nx) {
    const unsigned G = gridDim.x * gridDim.y * gridDim.z;
    unsigned sum, cnt, mine, sp = 0u;
    for (;;) {
        sum = 0u; cnt = 0u; mine = 0u;
#pragma unroll
        for (unsigned j = 0; j < 16; ++j) { const unsigned c = xb_ld(&bar[XB_XCNT(j)]); sum += c; cnt += (c > 0u) ? 1u : 0u; mine = (j == x) ? c : mine; }
        if (sum == G) break;
        __builtin_amdgcn_s_sleep(1);
        if ((++sp & 255u) == 0u) { if (xb_ld(&bar[XB_TMO])) break; if (sp > XB_SPIN_CAP) { atomicAdd(&bar[XB_TMO], 1u); break; } }
    }
    nloc = mine > 0u ? mine : 1u; nx = cnt > 0u ? cnt : 1u;
}
__device__ __forceinline__ void xcd_barrier(const XcdBarrier& b) {
    asm volatile("s_waitcnt vmcnt(0)" ::: "memory");
    __syncthreads();
    if (threadIdx.x == 0) {
        unsigned* bar = b.bar;
        __builtin_amdgcn_s_waitcnt(0);
        unsigned nloc = b.st[0], nx = b.st[1];
        if (nloc == 0u) { xcd_barrier_complete(bar, b.x, nloc, nx); b.st[0] = nloc; b.st[1] = nx; }
        const unsigned old = xb_add(&bar[XB_XSUB(b.x)], 1u);
        const unsigned gen = old / nloc;
        if (old + 1u == (gen + 1u) * nloc) {
            __builtin_amdgcn_fence(__ATOMIC_RELEASE, "agent");
            asm volatile("s_waitcnt vmcnt(0)" ::: "memory");
            const unsigned og = xb_add(&bar[XB_TOP], 1u);
            const unsigned tg = og / nx;
            if (og + 1u == (tg + 1u) * nx) xb_add(&bar[XB_TOPGEN], 1u);
            else XB_SPIN(xb_ld(&bar[XB_TOPGEN]) == tg, bar);
            __builtin_amdgcn_fence(__ATOMIC_ACQUIRE, "agent");
            xb_add(&bar[XB_XGEN(b.x)], 1u);
            asm volatile("s_waitcnt vmcnt(0)" ::: "memory");
        } else {
            XB_SPIN(xb_ld(&bar[XB_XGEN(b.x)]) == gen, bar);
            __builtin_amdgcn_fence(__ATOMIC_ACQUIRE, "agent");
            asm volatile("s_waitcnt vmcnt(0)" ::: "memory");
        }
    }
    __syncthreads();
}

namespace pg8 {
#define PG8_LAS __attribute__((address_space(3)))
typedef unsigned short bf16_t;
typedef short bf16x8 __attribute__((ext_vector_type(8)));
typedef float f32x4 __attribute__((ext_vector_type(4)));
typedef unsigned u32x4 __attribute__((ext_vector_type(4)));
constexpr int BM = 256, BK = 64, HALF = 128, HTB = HALF * BK * 2  , STAGE_BYTES = 8 * HTB, NXCD = 8, WGM = 8;

__host__ __device__ __forceinline__ int lds_byte(int r, int c) { const int st = (r >> 4) * 2 + (c >> 5), rr = r & 15, cc = c & 31, ob = rr * 64 + cc * 2; return st * 1024 + (ob ^ (((ob >> 9) & 1) << 5)); }
__host__ __device__ __forceinline__ void stage_rc(int b, int& R, int& C) { const int st = b / 1024, sb = b % 1024, swz = sb ^ (((sb >> 9) & 1) << 5); R = (st >> 1) * 16 + swz / 64; C = (st & 1) * 32 + (swz % 64) / 2; }
__host__ __device__ __forceinline__ int perm32(int rho) { const int n = rho >> 4, i = rho & 15; return 8 * (i >> 2) + 4 * n + (i & 3); }

struct Unit { int pm, pn; };
struct Gemm { const bf16_t* A; const bf16_t* Bt; int M, N, K; const int* rowtab = nullptr; };

struct StaticOrder {
    int nM, nN, nwg, G, c;
    __host__ __device__ void init(int M, int N, int G_, int c_) { nM = M / BM; nN = N / BM; nwg = nM * nN; G = G_; c = c_; }
    __host__ __device__ bool next(int i, Unit& u) const {
        const long L = (long)i * G + c; if (L >= nwg) return false;
        int wgid = (int)L; { const int q = nwg / NXCD, r = nwg % NXCD, xcd = wgid % NXCD, off = wgid / NXCD; wgid = (xcd < r ? xcd * (q + 1) : r * (q + 1) + (xcd - r) * q) + off; }
        const int nig = WGM * nN, gid = wgid / nig, fm = gid * WGM, gsz = (nM - fm) < WGM ? (nM - fm) : WGM;
        u.pm = fm + ((wgid % nig) % gsz); u.pn = (wgid % nig) / gsz; return true;
    }
    __device__ __forceinline__ void a_ready(const Unit&) const {}
    __device__ __forceinline__ void done(const Unit&) const {}
};

__device__ __forceinline__ unsigned cvt_pk_bf16(float lo, float hi) { unsigned r; asm volatile("v_cvt_pk_bf16_f32 %0, %1, %2" : "=v"(r) : "v"(lo), "v"(hi)); return r; }
typedef float f32x2 __attribute__((ext_vector_type(2)));
__device__ __forceinline__ f32x2 gelu_pk(f32x2 v) {
    const f32x2 av = __builtin_elementwise_abs(v), d = av * 0.2316418882f + 1.0f;
    f32x2 t; t.x = __builtin_amdgcn_rcpf(d.x); t.y = __builtin_amdgcn_rcpf(d.y);
    f32x2 q = t * 0.5307027145f + (-0.7265760135f); q = q * t + 0.7107068705f; q = q * t + (-0.142248368f); q = q * t + 0.127414796f; q = q * t;
    const f32x2 s = (v * v) * (-0.72134752044f);
    f32x2 e; e.x = __builtin_amdgcn_exp2f(s.x); e.y = __builtin_amdgcn_exp2f(s.y);
    const f32x2 m = v * (q * e), r = v - m;
    f32x2 o; o.x = v.x < 0.f ? m.x : r.x; o.y = v.y < 0.f ? m.y : r.y; return o;
}

template <int ACT  > struct EpiBf16 {
    static constexpr bool PERM = true, AFTER_DRAIN = false; static_assert(ACT == 0 || ACT == 1, "EpiBf16: ACT is 0 (none) or 1 (gelu_pk)");
    bf16_t* O; int ldc; const float* bias; int split_cols; size_t split_stride; float scale0;
    __device__ __forceinline__ void operator()(const f32x4 (&acc)[2][2][4][2], const Unit& u, int wr, int wc, int fr, int fq) const {
        const int row0 = u.pm * BM + wr * 64 + fr; int colt = u.pn * BM; bf16_t* base = O;
        float sc = 1.f; if (split_cols) { const int t = colt / split_cols; base += (size_t)t * split_stride; colt -= t * split_cols; if (t == 0) sc = scale0; }
        const int col0 = colt + wc * 32 + 8 * fq, bcol0 = u.pn * BM + wc * 32 + 8 * fq;
        f32x4 bv[2][2];
#pragma unroll
        for (int bj = 0; bj < 2; ++bj)
#pragma unroll
            for (int n = 0; n < 2; ++n) bv[bj][n] = bias ? *(const f32x4*)(bias + bcol0 + bj * HALF + 4 * n) : (f32x4){0.f, 0.f, 0.f, 0.f};
#pragma unroll
        for (int ai = 0; ai < 2; ++ai)
#pragma unroll
            for (int m = 0; m < 4; ++m) { bf16_t* rowp = base + (size_t)(row0 + ai * HALF + m * 16) * ldc + col0;
#pragma unroll
                for (int bj = 0; bj < 2; ++bj) { f32x4 v0 = acc[ai][bj][m][0] + bv[bj][0], v1 = acc[ai][bj][m][1] + bv[bj][1];
                    if (ACT == 1) { f32x2 a = gelu_pk((f32x2){v0[0], v0[1]}), b = gelu_pk((f32x2){v0[2], v0[3]}), c = gelu_pk((f32x2){v1[0], v1[1]}), d = gelu_pk((f32x2){v1[2], v1[3]});
                        v0 = (f32x4){a.x, a.y, b.x, b.y}; v1 = (f32x4){c.x, c.y, d.x, d.y}; }
                    v0 = v0 * sc; v1 = v1 * sc; u32x4 w; w.x = cvt_pk_bf16(v0[0], v0[1]); w.y = cvt_pk_bf16(v0[2], v0[3]); w.z = cvt_pk_bf16(v1[0], v1[1]); w.w = cvt_pk_bf16(v1[2], v1[3]);
                    *(u32x4*)(rowp + bj * HALF) = w; } }
    }
};

struct EpiF32 {
    static constexpr bool PERM = false, AFTER_DRAIN = false;
    float* C; int ldc;
    __device__ __forceinline__ void operator()(const f32x4 (&acc)[2][2][4][2], const Unit& u, int wr, int wc, int fr, int fq) const {
        const int row0 = u.pm * BM + wr * 64 + fr, col0 = u.pn * BM + wc * 32 + 4 * fq;
#pragma unroll
        for (int ai = 0; ai < 2; ++ai)
#pragma unroll
            for (int m = 0; m < 4; ++m) { float* rowp = C + (size_t)(row0 + ai * HALF + m * 16) * ldc + col0;
#pragma unroll
                for (int bj = 0; bj < 2; ++bj)
#pragma unroll
                    for (int n = 0; n < 2; ++n) *(f32x4*)(rowp + bj * HALF + n * 16) = acc[ai][bj][m][n]; }
    }
};
__device__ __forceinline__ float fast_sigmoid(float x) { return __builtin_amdgcn_rcpf(1.0f + __builtin_amdgcn_exp2f(-1.4426950408889634f * x)); }
struct EpiSwiGLU {
    static constexpr bool PERM = true, AFTER_DRAIN = false;
    bf16_t* O; int ldo;
    __device__ __forceinline__ void operator()(const f32x4 (&acc)[2][2][4][2], const Unit& u, int wr, int wc, int fr, int fq) const {
        const int row0 = u.pm * BM + wr * 64 + fr, col0 = (u.pn & 1) * HALF + wc * 32 + 8 * fq;
#pragma unroll
        for (int ai = 0; ai < 2; ++ai)
#pragma unroll
            for (int m = 0; m < 4; ++m) {
                bf16_t* rowp = O + (size_t)(row0 + ai * HALF + m * 16) * ldo + col0;
                const f32x4 g0 = acc[ai][0][m][0], g1 = acc[ai][0][m][1], u0 = acc[ai][1][m][0], u1 = acc[ai][1][m][1];
                float r[8];
#pragma unroll
                for (int i = 0; i < 4; ++i) { r[i] = g0[i] * fast_sigmoid(g0[i]) * u0[i]; r[4 + i] = g1[i] * fast_sigmoid(g1[i]) * u1[i]; }
                u32x4 w; w.x = cvt_pk_bf16(r[0], r[1]); w.y = cvt_pk_bf16(r[2], r[3]); w.z = cvt_pk_bf16(r[4], r[5]); w.w = cvt_pk_bf16(r[6], r[7]);
                *(u32x4*)rowp = w;
            }
    }
};
struct EpiScatter {
    static constexpr bool PERM = true, AFTER_DRAIN = false;
    const int* slotw; bf16_t* Y; int ldy;
    __device__ __forceinline__ void operator()(const f32x4 (&acc)[2][2][4][2], const Unit& u, int wr, int wc, int fr, int fq) const {
        int t2 = threadIdx.x; asm volatile("" : "+v"(t2));
        const int fr2 = t2 & 15, fq2 = (t2 >> 4) & 3, wc2 = (t2 >> 6) & 3, wr2 = (t2 >> 8) & 1;
        const int col0 = (u.pn & 3) * BM + wc2 * 32 + 8 * fq2;
        const int rbase = u.pm * BM + wr2 * 64 + fr2;
        typedef int i32x2 __attribute__((ext_vector_type(2)));
        i32x2 rec[2][4];
#pragma unroll
        for (int ai = 0; ai < 2; ++ai)
#pragma unroll
            for (int m = 0; m < 4; ++m) rec[ai][m] = *(const i32x2*)(slotw + 2 * (size_t)(rbase + ai * HALF + m * 16));
#pragma unroll
        for (int ai = 0; ai < 2; ++ai)
#pragma unroll
            for (int m = 0; m < 4; ++m) {
                const int aid = rec[ai][m].x;
                if (aid >= 0) {
                    const int wbits = rec[ai][m].y;
                    const float w = __int_as_float(wbits);
                    bf16_t* rowp = Y + (size_t)aid * ldy + col0;
#pragma unroll
                    for (int bj = 0; bj < 2; ++bj) {
                        const f32x4 v0 = acc[ai][bj][m][0] * w, v1 = acc[ai][bj][m][1] * w;
                        u32x4 o; o.x = cvt_pk_bf16(v0[0], v0[1]); o.y = cvt_pk_bf16(v0[2], v0[3]); o.z = cvt_pk_bf16(v1[0], v1[1]); o.w = cvt_pk_bf16(v1[2], v1[3]);
                        *(u32x4*)(rowp + bj * HALF) = o;
                    }
                }
            }
    }
};
struct ExpertOrder {
    const int* uexp; int NU, npn, G, c;
    __device__ __forceinline__ bool next(int i, Unit& u) const {
        const int L = i * G + c; if (L >= NU * npn) return false;
        const int uu = L / npn, pl = L % npn;
        u.pm = uu; u.pn = __builtin_amdgcn_readfirstlane(uexp[uu]) * npn + pl; return true;
    }
    __device__ __forceinline__ void a_ready(const Unit&) const {}
    __device__ __forceinline__ void done(const Unit&) const {}
};
struct S5Order {
    int NUNITS, npn, G, c;
    __device__ __forceinline__ bool next(int i, Unit& u) const {
        const int L = i * G + c; if (L >= NUNITS) return false;
        u.pm = L / npn; u.pn = (u.pm >> 2) * npn + L % npn; return true;
    }
    __device__ __forceinline__ void a_ready(const Unit&) const {}
    __device__ __forceinline__ void done(const Unit&) const {}
};
struct EpiS5E {
    static constexpr bool PERM = false, AFTER_DRAIN = false;
    float* E;
    __device__ __forceinline__ void operator()(const f32x4 (&acc)[2][2][4][2], const Unit& u, int wr, int wc, int fr, int fq) const {
        const int row0 = u.pm * BM + wr * 64 + fr, col0 = wc * 32 + 4 * fq;
#pragma unroll
        for (int ai = 0; ai < 2; ++ai)
#pragma unroll
            for (int m = 0; m < 4; ++m) { float* rowp = E + (size_t)(row0 + ai * HALF + m * 16) * 128 + col0;
#pragma unroll
                for (int n = 0; n < 2; ++n) *(f32x4*)(rowp + n * 16) = acc[ai][0][m][n]; }
    }
};
struct EpiS5Out {
    static constexpr bool PERM = true, AFTER_DRAIN = false;
    bf16_t* Y;
    __device__ __forceinline__ void operator()(const f32x4 (&acc)[2][2][4][2], const Unit& u, int wr, int wc, int fr, int fq) const {
        const int g = u.pm >> 2;
#pragma unroll
        for (int ai = 0; ai < 2; ++ai)
#pragma unroll
            for (int m = 0; m < 4; ++m) {
                const int r = (u.pm & 3) * BM + ai * HALF + wr * 64 + m * 16 + fr, b = r >> 8, chunk = r & 255;
#pragma unroll
                for (int bj = 0; bj < 2; ++bj) {
                    const int colg = (u.pn & 1) * BM + bj * HALF + wc * 32 + 8 * fq, t = colg >> 4, c0 = colg & 15;
                    const f32x4 v0 = acc[ai][bj][m][0], v1 = acc[ai][bj][m][1];
                    float x[8] = {v0[0], v0[1], v0[2], v0[3], v1[0], v1[1], v1[2], v1[3]};
#pragma unroll
                    for (int i = 0; i < 8; ++i) { const float z = x[i]; x[i] = z * fast_sigmoid(1.5957691216057308f * (z + 0.044715f * z * z * z)); }
                    u32x4 w; w.x = cvt_pk_bf16(x[0], x[1]); w.y = cvt_pk_bf16(x[2], x[3]); w.z = cvt_pk_bf16(x[4], x[5]); w.w = cvt_pk_bf16(x[6], x[7]);
                    *(u32x4*)(Y + ((size_t)(b * 8192 + chunk * 32 + t)) * 512 + g * 16 + c0) = w;
                }
            }
    }
};
struct EpiLora {
    static constexpr bool PERM = true, AFTER_DRAIN = false;
    const float* w0; const float* a0; const float* k_a; float* W; const bf16_t* Kp; bf16_t* Kf; const bf16_t* A; bf16_t* B; bf16_t* Gt;
    __device__ __forceinline__ void operator()(const f32x4 (&acc)[2][2][4][2], const Unit& u, int wr, int wc, int fr, int fq) const {
        const int seg = u.pn >> 1;
#pragma unroll
        for (int bj = 0; bj < 2; ++bj) {
            const int nn = (u.pn & 1) * BM + bj * HALF + wc * 32 + 8 * fq;
            float p0[8], p1[8];
            if (seg == 0) { const f32x4 a = *(const f32x4*)(w0 + nn), b = *(const f32x4*)(w0 + nn + 4); p0[0] = a[0]; p0[1] = a[1]; p0[2] = a[2]; p0[3] = a[3]; p0[4] = b[0]; p0[5] = b[1]; p0[6] = b[2]; p0[7] = b[3]; }
            else if (seg == 1) { const f32x4 a = *(const f32x4*)(a0 + nn), b = *(const f32x4*)(a0 + nn + 4), cc = *(const f32x4*)(k_a + nn), d = *(const f32x4*)(k_a + nn + 4);
                p0[0] = a[0]; p0[1] = a[1]; p0[2] = a[2]; p0[3] = a[3]; p0[4] = b[0]; p0[5] = b[1]; p0[6] = b[2]; p0[7] = b[3];
                p1[0] = cc[0]; p1[1] = cc[1]; p1[2] = cc[2]; p1[3] = cc[3]; p1[4] = d[0]; p1[5] = d[1]; p1[6] = d[2]; p1[7] = d[3]; }
#pragma unroll
            for (int ai = 0; ai < 2; ++ai)
#pragma unroll
                for (int m = 0; m < 4; ++m) {
                    const size_t off = (size_t)(u.pm * BM + ai * HALF + wr * 64 + m * 16 + fr) * 512 + nn;
                    const f32x4 v0 = acc[ai][bj][m][0], v1 = acc[ai][bj][m][1];
                    const float x[8] = {v0[0], v0[1], v0[2], v0[3], v1[0], v1[1], v1[2], v1[3]};
                    if (seg == 0) {
                        float o[8];
#pragma unroll
                        for (int i = 0; i < 8; ++i) { const float wa = p0[i] + x[i];
                            const float sp = __logf(1.0f + __expf(-wa));
                            o[i] = __expf(-__expf(-sp - 0.5f)); }
                        *(f32x4*)(W + off) = (f32x4){o[0], o[1], o[2], o[3]}; *(f32x4*)(W + off + 4) = (f32x4){o[4], o[5], o[6], o[7]};
                    } else if (seg == 1) {
                        const u32x4 kv = *(const u32x4*)(Kp + off), av = *(const u32x4*)(A + off);
                        const float k[8] = {__builtin_bit_cast(float, kv.x << 16), __builtin_bit_cast(float, kv.x & 0xffff0000u), __builtin_bit_cast(float, kv.y << 16), __builtin_bit_cast(float, kv.y & 0xffff0000u),
                                            __builtin_bit_cast(float, kv.z << 16), __builtin_bit_cast(float, kv.z & 0xffff0000u), __builtin_bit_cast(float, kv.w << 16), __builtin_bit_cast(float, kv.w & 0xffff0000u)};
                        const float a[8] = {__builtin_bit_cast(float, av.x << 16), __builtin_bit_cast(float, av.x & 0xffff0000u), __builtin_bit_cast(float, av.y << 16), __builtin_bit_cast(float, av.y & 0xffff0000u),
                                            __builtin_bit_cast(float, av.z << 16), __builtin_bit_cast(float, av.z & 0xffff0000u), __builtin_bit_cast(float, av.w << 16), __builtin_bit_cast(float, av.w & 0xffff0000u)};
                        float kf[8], bo[8];
#pragma unroll
                        for (int i = 0; i < 8; ++i) { const float ic = fast_sigmoid(p0[i] + x[i]); kf[i] = k[i] * (1.0f + (ic - 1.0f) * p1[i]); bo[i] = -a[i] * ic; }
                        u32x4 w; w.x = cvt_pk_bf16(kf[0], kf[1]); w.y = cvt_pk_bf16(kf[2], kf[3]); w.z = cvt_pk_bf16(kf[4], kf[5]); w.w = cvt_pk_bf16(kf[6], kf[7]);
                        *(u32x4*)(Kf + off) = w;
                        w.x = cvt_pk_bf16(bo[0], bo[1]); w.y = cvt_pk_bf16(bo[2], bo[3]); w.z = cvt_pk_bf16(bo[4], bo[5]); w.w = cvt_pk_bf16(bo[6], bo[7]);
                        *(u32x4*)(B + off) = w;
                    } else {
                        u32x4 w; w.x = cvt_pk_bf16(x[0], x[1]); w.y = cvt_pk_bf16(x[2], x[3]); w.z = cvt_pk_bf16(x[4], x[5]); w.w = cvt_pk_bf16(x[6], x[7]);
                        *(u32x4*)(Gt + off) = w;
                    }
                }
        }
    }
};
struct EpiGLU {
    static constexpr bool PERM = true, AFTER_DRAIN = false;
    const bf16_t* Y; int ldy; const float* bias; bf16_t* O; int ldo; int ocol0;
    __device__ __forceinline__ void operator()(const f32x4 (&acc)[2][2][4][2], const Unit& u, int wr, int wc, int fr, int fq) const {
        const int row0 = u.pm * BM + wr * 64 + fr, col0 = u.pn * BM + wc * 32 + 8 * fq;
#pragma unroll
        for (int bj = 0; bj < 2; ++bj) {
            const f32x4 b0 = *(const f32x4*)(bias + col0 + bj * HALF), b1 = *(const f32x4*)(bias + col0 + bj * HALF + 4);
#pragma unroll
            for (int ai = 0; ai < 2; ++ai)
#pragma unroll
                for (int m = 0; m < 4; ++m) {
                    const size_t row = (size_t)(row0 + ai * HALF + m * 16);
                    const u32x4 yv = *(const u32x4*)(Y + row * ldy + col0 + bj * HALF);
                    const f32x4 z0 = acc[ai][bj][m][0] + b0, z1 = acc[ai][bj][m][1] + b1;
                    float y[8] = {__builtin_bit_cast(float, yv.x << 16), __builtin_bit_cast(float, yv.x & 0xffff0000u), __builtin_bit_cast(float, yv.y << 16), __builtin_bit_cast(float, yv.y & 0xffff0000u),
                                  __builtin_bit_cast(float, yv.z << 16), __builtin_bit_cast(float, yv.z & 0xffff0000u), __builtin_bit_cast(float, yv.w << 16), __builtin_bit_cast(float, yv.w & 0xffff0000u)};
                    float r[8];
#pragma unroll
                    for (int i = 0; i < 4; ++i) { r[i] = y[i] * fast_sigmoid(z0[i]); r[4 + i] = y[4 + i] * fast_sigmoid(z1[i]); }
                    u32x4 w; w.x = cvt_pk_bf16(r[0], r[1]); w.y = cvt_pk_bf16(r[2], r[3]); w.z = cvt_pk_bf16(r[4], r[5]); w.w = cvt_pk_bf16(r[6], r[7]);
                    *(u32x4*)(O + row * ldo + ocol0 + col0 + bj * HALF) = w;
                }
        }
    }
};
template <class Epi, class Sched, bool ALIGN_EPI = false, bool SP2 = false, bool GATHER = false>
__device__ __forceinline__ void gemm_phase(PG8_LAS unsigned char* lds, const Gemm g, const Sched& S, const Epi& E) {
    int tid_ = threadIdx.x; asm volatile("" : "+v"(tid_));
    const int tid = tid_, wid = __builtin_amdgcn_readfirstlane(tid >> 6), lane = tid & 63, wr = wid >> 2, wc = wid & 3, fr = lane & 15, fq = lane >> 4;
    const int K = g.K, nt = K / BK;
    unsigned voffA[2], voffB[2];
#pragma unroll
    for (int i = 0; i < 2; ++i) { int R, C; stage_rc(tid * 16 + i * 8192, R, C); const int Rb = Epi::PERM ? ((R & ~31) + perm32(R & 31)) : R;
        voffA[i] = (unsigned)(R * K + C) * 2u; voffB[i] = (unsigned)(Rb * K + C) * 2u; }
    const size_t kstep = (size_t)(BK * 2);
    const size_t hstep = (size_t)HALF * K * 2;
    const size_t tstep = 2 * hstep;
    const unsigned ldsw = (unsigned)wid * 1024u;
    const int aoff = lds_byte(wr * 64 + fr, fq * 8), boff = lds_byte(wc * 32 + fr, fq * 8);
#define PG8_SA(b, h) (((b) * 2 + (h)) * HTB)
#define PG8_SB(b, h) ((4 + (b) * 2 + (h)) * HTB)
#define PG8_STAGE(bufoff, gbase, voff) do { _Pragma("unroll") for (int _i = 0; _i < 2; ++_i) \
        __builtin_amdgcn_global_load_lds((const unsigned*)((const char*)(gbase) + (voff)[_i]), (PG8_LAS unsigned*)(lds + (bufoff) + ldsw + _i * 8192), 16, 0, 0); } while (0)
#define PG8_STAGE_A(bufoff, kptr, h, NEXTSEL) do { if constexpr (GATHER) { const unsigned _p = (NEXTSEL) ? gnxt[h] : gcur[h]; const unsigned _v[2] = { (_p & 0xffffu) * (unsigned)(2 * K) + gC2, (_p >> 16) * (unsigned)(2 * K) + gC2 }; PG8_STAGE(bufoff, kptr, _v); } \
        else { PG8_STAGE(bufoff, (kptr) + (h) * hstep, voffA); } } while (0)
#define PG8_LDA(dst, b, h) do { _Pragma("unroll") for (int m = 0; m < 4; ++m) _Pragma("unroll") for (int k = 0; k < 2; ++k) dst[m][k] = *(const PG8_LAS bf16x8*)(lds + PG8_SA(b, h) + aoff + m * 2048 + k * 1024); } while (0)
#define PG8_LDB(dst, b, h) do { _Pragma("unroll") for (int n = 0; n < 2; ++n) _Pragma("unroll") for (int k = 0; k < 2; ++k) dst[n][k] = *(const PG8_LAS bf16x8*)(lds + PG8_SB(b, h) + boff + n * 2048 + k * 1024); } while (0)
#define PG8_MMA(ai, bj, At, Bt) do { __builtin_amdgcn_s_setprio(1); _Pragma("unroll") for (int m = 0; m < 4; ++m) _Pragma("unroll") for (int n = 0; n < 2; ++n) _Pragma("unroll") for (int k = 0; k < 2; ++k) \
        acc[ai][bj][m][n] = __builtin_amdgcn_mfma_f32_16x16x32_bf16(Bt[n][k], At[m][k], acc[ai][bj][m][n], 0, 0, 0); __builtin_amdgcn_s_setprio(0); } while (0)
#define PG8_WAIT_V(n) asm volatile("s_waitcnt vmcnt(" #n ")" ::: "memory")
#define PG8_WAIT_L(n) asm volatile("s_waitcnt lgkmcnt(" #n ")" ::: "memory")
#define PG8_BAR __builtin_amdgcn_s_barrier()
#define PG8_SCHED __builtin_amdgcn_sched_barrier(0)
    unsigned gcur[2], gnxt[2], gC2 = 0;
    if constexpr (GATHER) { int R, C; stage_rc(tid * 16, R, C); gC2 = (unsigned)C * 2u; }
    auto load_gather = [&](int pm, unsigned (&dst)[2]) {
        int R, C; stage_rc(tid * 16, R, C);
#pragma unroll
        for (int h = 0; h < 2; ++h) { int a0 = g.rowtab[pm * BM + h * HALF + R], a1 = g.rowtab[pm * BM + h * HALF + R + 64]; a0 = a0 < 0 ? 0 : a0; a1 = a1 < 0 ? 0 : a1; dst[h] = (unsigned)(a0 >> 3) | ((unsigned)(a1 >> 3) << 16); }
    };
    Unit cur, nxt; int ui = 0;
    if (!S.next(0, cur)) return;
    f32x4 acc[2][2][4][2];
#pragma unroll
    for (int a = 0; a < 2; ++a)
#pragma unroll
        for (int b = 0; b < 2; ++b)
#pragma unroll
            for (int m = 0; m < 4; ++m)
#pragma unroll
                for (int n = 0; n < 2; ++n) acc[a][b][m][n] = (f32x4){0.f, 0.f, 0.f, 0.f};
    bf16x8 At[4][2], B0[2][2], B1[2][2];
    const char* cA = (const char*)g.A + (GATHER ? (size_t)0 : (size_t)cur.pm * tstep); const char* cB = (const char*)g.Bt + (size_t)cur.pn * tstep;
    if constexpr (GATHER) { load_gather(cur.pm, gcur); }
    S.a_ready(cur);
    if constexpr (SP2) {
        PG8_STAGE(PG8_SB(0, 0), cB, voffB); PG8_STAGE(PG8_SB(0, 1), cB + hstep, voffB); PG8_STAGE_A(PG8_SA(0, 0), cA, 0, false); PG8_STAGE_A(PG8_SA(0, 1), cA, 1, false);
        if (wr == 1) PG8_BAR;
        PG8_WAIT_V(2); PG8_BAR;
        PG8_STAGE(PG8_SB(1, 0), cB + kstep, voffB); PG8_STAGE_A(PG8_SA(1, 0), cA + kstep, 0, false); PG8_STAGE(PG8_SB(1, 1), cB + hstep + kstep, voffB);
        PG8_WAIT_V(6); PG8_BAR;
    } else {
        PG8_STAGE(PG8_SB(0, 0), cB, voffB); PG8_STAGE_A(PG8_SA(0, 0), cA, 0, false); PG8_STAGE(PG8_SB(0, 1), cB + hstep, voffB); PG8_STAGE_A(PG8_SA(0, 1), cA, 1, false);
        if (wr == 1) PG8_BAR;
        PG8_WAIT_V(4); PG8_BAR;
        PG8_STAGE(PG8_SB(1, 0), cB + kstep, voffB); PG8_STAGE_A(PG8_SA(1, 0), cA + kstep, 0, false); PG8_STAGE(PG8_SB(1, 1), cB + hstep + kstep, voffB);
        PG8_WAIT_V(6); PG8_BAR;
    }
    for (;;) {
        const bool has_next = S.next(ui + 1, nxt);
        const char* nA = (has_next && !GATHER) ? (const char*)g.A + (size_t)nxt.pm * tstep : cA; const char* nB = has_next ? (const char*)g.Bt + (size_t)nxt.pn * tstep : cB;
        if constexpr (GATHER) { if (has_next) load_gather(nxt.pm, gnxt); else {
#pragma unroll
            for (int h = 0; h < 2; ++h) { gnxt[h] = gcur[h]; } } }
        for (int t = 0; t < nt; t += 2) {
            const bool last = (t == nt - 2);
            const char* a1 = cA + (size_t)(t + 1) * kstep;
            const char* a2 = last ? nA : cA + (size_t)(t + 2) * kstep; const char* b2 = last ? nB : cB + (size_t)(t + 2) * kstep;
            const char* a3 = a2 + kstep; const char* b3 = b2 + kstep;
            if (last && has_next) S.a_ready(nxt);
            if constexpr (SP2) {
            PG8_LDB(B0, 0, 0); PG8_LDB(B1, 0, 1); PG8_SCHED; PG8_LDA(At, 0, 0); PG8_STAGE_A(PG8_SA(1, 1), a1, 1, false);
            PG8_WAIT_V(8); PG8_WAIT_L(0); PG8_BAR; PG8_MMA(0, 0, At, B0); PG8_MMA(0, 1, At, B1); PG8_BAR; PG8_SCHED;
            PG8_LDA(At, 0, 1); PG8_STAGE(PG8_SB(0, 0), b2, voffB); PG8_STAGE(PG8_SB(0, 1), b2 + hstep, voffB); PG8_STAGE_A(PG8_SA(0, 0), a2, 0, last);
            PG8_WAIT_V(8); PG8_WAIT_L(0); PG8_BAR; PG8_MMA(1, 0, At, B0); PG8_MMA(1, 1, At, B1); PG8_BAR; PG8_SCHED;
            PG8_LDB(B0, 1, 0); PG8_LDB(B1, 1, 1); PG8_SCHED; PG8_LDA(At, 1, 0); PG8_STAGE_A(PG8_SA(0, 1), a2, 1, last);
            PG8_WAIT_V(8); PG8_WAIT_L(0); PG8_BAR; PG8_MMA(0, 0, At, B0); PG8_MMA(0, 1, At, B1); PG8_BAR; PG8_SCHED;
            PG8_LDA(At, 1, 1); PG8_STAGE(PG8_SB(1, 0), b3, voffB); PG8_STAGE(PG8_SB(1, 1), b3 + hstep, voffB); PG8_STAGE_A(PG8_SA(1, 0), a3, 0, last);
            PG8_WAIT_V(8); PG8_WAIT_L(0); PG8_BAR; PG8_MMA(1, 0, At, B0); PG8_MMA(1, 1, At, B1); PG8_BAR; PG8_SCHED;
            } else {
            PG8_LDB(B0, 0, 0); PG8_SCHED; PG8_LDA(At, 0, 0); PG8_STAGE_A(PG8_SA(1, 1), a1, 1, false);
            PG8_WAIT_L(8); PG8_BAR; PG8_WAIT_L(0); PG8_MMA(0, 0, At, B0); PG8_BAR; PG8_SCHED;
            PG8_LDB(B1, 0, 1); PG8_STAGE(PG8_SB(0, 0), b2, voffB);
            PG8_BAR; PG8_WAIT_L(0); PG8_MMA(0, 1, At, B1); PG8_BAR;
            PG8_LDA(At, 0, 1); PG8_STAGE_A(PG8_SA(0, 0), a2, 0, last);
            PG8_BAR; PG8_WAIT_L(0); PG8_MMA(1, 0, At, B0); PG8_BAR; PG8_SCHED;
            PG8_STAGE(PG8_SB(0, 1), b2 + hstep, voffB);
            PG8_WAIT_V(6); PG8_BAR; PG8_MMA(1, 1, At, B1); PG8_BAR;
            PG8_LDB(B0, 1, 0); PG8_SCHED; PG8_LDA(At, 1, 0); PG8_STAGE_A(PG8_SA(0, 1), a2, 1, last);
            PG8_WAIT_L(8); PG8_BAR; PG8_WAIT_L(0); PG8_MMA(0, 0, At, B0); PG8_BAR; PG8_SCHED;
            PG8_LDB(B1, 1, 1); PG8_STAGE(PG8_SB(1, 0), b3, voffB);
            PG8_BAR; PG8_WAIT_L(0); PG8_MMA(0, 1, At, B1); PG8_BAR;
            PG8_LDA(At, 1, 1); PG8_STAGE_A(PG8_SA(1, 0), a3, 0, last);
            PG8_BAR; PG8_WAIT_L(0); PG8_MMA(1, 0, At, B0); PG8_BAR; PG8_SCHED;
            PG8_STAGE(PG8_SB(1, 1), b3 + hstep, voffB);
            PG8_WAIT_V(6); PG8_BAR; PG8_MMA(1, 1, At, B1); PG8_BAR;
            }
        }
        if constexpr (ALIGN_EPI) { if (wr == 0) PG8_BAR; }
        if constexpr (!Epi::AFTER_DRAIN) { E(acc, cur, wr, wc, fr, fq); S.done(cur); }
        if (!has_next) break;
#pragma unroll
        for (int a = 0; a < 2; ++a)
#pragma unroll
            for (int b = 0; b < 2; ++b)
#pragma unroll
                for (int m = 0; m < 4; ++m)
#pragma unroll
                    for (int n = 0; n < 2; ++n) acc[a][b][m][n] = (f32x4){0.f, 0.f, 0.f, 0.f};
        cur = nxt; cA = nA; cB = nB; ++ui;
        if constexpr (GATHER) {
#pragma unroll
            for (int h = 0; h < 2; ++h) { gcur[h] = gnxt[h]; } }
        if constexpr (ALIGN_EPI) { if (wr == 1) PG8_BAR; }
    }
    PG8_WAIT_V(0);
    if constexpr (!ALIGN_EPI) { if (wr == 0) PG8_BAR; }
    PG8_BAR;
    if constexpr (Epi::AFTER_DRAIN) { E.fused(acc, cur, wr, wc, fr, fq, lds, wid, lane); S.done(cur); }
#undef PG8_SA
#undef PG8_SB
#undef PG8_STAGE
#undef PG8_STAGE_A
#undef PG8_LDA
#undef PG8_LDB
#undef PG8_MMA
#undef PG8_WAIT_V
#undef PG8_WAIT_L
#undef PG8_BAR
#undef PG8_SCHED
}
}

typedef unsigned short bf16_t;
__device__ __forceinline__ unsigned f2bf(float f) { unsigned u = __builtin_bit_cast(unsigned, f); return (u + 0x7fffu + ((u >> 16) & 1u)) >> 16; }
__device__ __forceinline__ float bf2f(unsigned h) { return __builtin_bit_cast(float, h << 16); }
__device__ __forceinline__ float wave_sum(float v) {
#pragma unroll
    for (int o = 1; o < 64; o <<= 1) v += __shfl_xor(v, o);
    return v;
}
__device__ __forceinline__ float sigmoidf_(float x) { return 1.0f / (1.0f + expf(-x)); }
__device__ __forceinline__ float siluf_(float x) { return x / (1.0f + expf(-x)); }
__device__ __forceinline__ float softplusf_(float x) { return fmaxf(x, 0.0f) + log1pf(expf(-fabsf(x))); }
__device__ __forceinline__ float geluf_(float x) { const float u = 0.7978845608028654f * (x + 0.044715f * x * x * x); return 0.5f * x * (1.0f + tanhf(u)); }

struct Args { const float* in[39]; float* out; unsigned char* ws; int lo, hi; };

struct Ctx {
    const float* const* in; float* out; unsigned char* ws;
    LAS unsigned char* lds; float* sm;
    int tid, lane, wid, bid, G, dry;
};

__device__ __forceinline__ unsigned pk2(float lo, float hi) { return f2bf(lo) | (f2bf(hi) << 16); }
__device__ __forceinline__ float ldbf(const bf16_t* p) { return bf2f((unsigned)*p); }
typedef unsigned v4u_t __attribute__((ext_vector_type(4)));
typedef unsigned v2u_t __attribute__((ext_vector_type(2)));
__device__ __forceinline__ void st16(void* p, uint4 v) { const v4u_t d = {v.x, v.y, v.z, v.w}; asm volatile("global_store_dwordx4 %0, %1, off\n\ts_nop 1" :: "v"(p), "v"(d) : "memory"); }
__device__ __forceinline__ void st16f(void* p, float4 v) { st16(p, make_uint4(__float_as_uint(v.x), __float_as_uint(v.y), __float_as_uint(v.z), __float_as_uint(v.w))); }
__device__ __forceinline__ void st8(void* p, uint2 v) { const v2u_t d = {v.x, v.y}; asm volatile("global_store_dwordx2 %0, %1, off\n\ts_nop 1" :: "v"(p), "v"(d) : "memory"); }
__device__ __forceinline__ void st4(void* p, unsigned v) { asm volatile("global_store_dword %0, %1, off\n\ts_nop 1" :: "v"(p), "v"(v) : "memory"); }
__device__ __forceinline__ void st2(void* p, unsigned v) { asm volatile("global_store_short %0, %1, off\n\ts_nop 1" :: "v"(p), "v"(v) : "memory"); }
__device__ __forceinline__ float4 ldbf4(const bf16_t* p) { const uint2 v = *(const uint2*)p; return make_float4(bf2f(v.x & 0xffffu), bf2f(v.x >> 16), bf2f(v.y & 0xffffu), bf2f(v.y >> 16)); }

template <int NB, class AF, class BF, class BF2, class EF>
__device__ __forceinline__ void gemm_tile(float* sm, int K, AF af, BF bf, BF2 bf2, EF ef) {
    float* As = sm;
    float* Bs = sm + 16 * 132;
    float* Bs2 = Bs + 16 * 68;
    const int tid = threadIdx.x, ty = tid >> 4, tx = tid & 15;
    const int am = tid >> 2, ak = (tid & 3) * 4;
    const int bt = tid & 255, bk = bt >> 4, bn = (bt & 15) * 4;
    float acc[4][4], acc2[4][4];
#pragma unroll
    for (int i = 0; i < 4; ++i)
#pragma unroll
        for (int j = 0; j < 4; ++j) { acc[i][j] = 0.f; acc2[i][j] = 0.f; }
    float4 av = af(am, ak);
    float4 bv = make_float4(0.f, 0.f, 0.f, 0.f);
    if (tid < 256) bv = bf(bk, bn); else if (NB == 2) bv = bf2(bk, bn);
    for (int k0 = 0; k0 < K; k0 += 16) {
        __syncthreads();
        As[(ak + 0) * 132 + am] = av.x; As[(ak + 1) * 132 + am] = av.y; As[(ak + 2) * 132 + am] = av.z; As[(ak + 3) * 132 + am] = av.w;
        if (tid < 256) *(float4*)&Bs[bk * 68 + bn] = bv; else if (NB == 2) *(float4*)&Bs2[bk * 68 + bn] = bv;
        __syncthreads();
        if (k0 + 16 < K) {
            av = af(am, k0 + 16 + ak);
            if (tid < 256) bv = bf(k0 + 16 + bk, bn); else if (NB == 2) bv = bf2(k0 + 16 + bk, bn);
        }
#pragma unroll
        for (int kk = 0; kk < 16; ++kk) {
            const float4 a = *(const float4*)&As[kk * 132 + ty * 4];
            const float4 b = *(const float4*)&Bs[kk * 68 + tx * 4];
            const float aa[4] = {a.x, a.y, a.z, a.w};
            const float bb[4] = {b.x, b.y, b.z, b.w};
#pragma unroll
            for (int i = 0; i < 4; ++i)
#pragma unroll
                for (int j = 0; j < 4; ++j) acc[i][j] = fmaf(aa[i], bb[j], acc[i][j]);
            if (NB == 2) {
                const float4 b2 = *(const float4*)&Bs2[kk * 68 + tx * 4];
                const float bb2[4] = {b2.x, b2.y, b2.z, b2.w};
#pragma unroll
                for (int i = 0; i < 4; ++i)
#pragma unroll
                    for (int j = 0; j < 4; ++j) acc2[i][j] = fmaf(aa[i], bb2[j], acc2[i][j]);
            }
        }
    }
#pragma unroll
    for (int i = 0; i < 4; ++i)
        ef(ty * 4 + i, tx * 4, make_float4(acc[i][0], acc[i][1], acc[i][2], acc[i][3]), make_float4(acc2[i][0], acc2[i][1], acc2[i][2], acc2[i][3]));
}

__device__ __forceinline__ void transpose_load(const float* W, int N, int nblk, int item, int lane, float (&r)[32]) {
    const int kb = item / nblk, nb = item % nblk, k0 = 64 * kb, n0 = 32 * nb;
#pragma unroll
    for (int i = 0; i < 32; ++i) { const int kk = 2 * i + (lane >> 5); r[i] = W[(size_t)(k0 + kk) * N + n0 + (lane & 31)]; }
}
template <bool RES, class RM>
__device__ __forceinline__ void transpose_finish(int K, int nblk, bf16_t* WT, RM rowmap, float* scr, int item, int lane, const float (&r)[32]) {
    const int kb = item / nblk, nb = item % nblk, k0 = 64 * kb, n0 = 32 * nb;
#pragma unroll
    for (int i = 0; i < 32; ++i) { const int kk = 2 * i + (lane >> 5); scr[kk * 33 + (lane & 31)] = r[i]; }
    asm volatile("s_waitcnt lgkmcnt(0)" ::: "memory");
    const int c = lane & 7;
    const int r0 = rowmap(n0);
#pragma unroll
    for (int j = 0; j < 4; ++j) {
        const int n = (lane >> 3) + 8 * j; const float* s = scr + (8 * c) * 33 + n;
        float v[8];
#pragma unroll
        for (int q = 0; q < 8; ++q) { v[q] = s[q * 33]; if (RES) v[q] = v[q] - bf2f(f2bf(v[q])); }
        uint4 o; o.x = pk2(v[0], v[1]); o.y = pk2(v[2], v[3]); o.z = pk2(v[4], v[5]); o.w = pk2(v[6], v[7]);
        st16(WT + (size_t)(r0 + n) * K + k0 + 8 * c, o);
    }
    asm volatile("s_waitcnt lgkmcnt(0)" ::: "memory");
}
template <bool RES, class RM>
__device__ __forceinline__ void transpose_item(const float* W, int K, int N, bf16_t* WT, RM rowmap, float* scr, int item, int lane) {
    float r[32];
    transpose_load(W, N, N / 32, item, lane, r);
    transpose_finish<RES>(K, N / 32, WT, rowmap, scr, item, lane, r);
}

__device__ __forceinline__ void convert_expert_weights(const Ctx& c, int first, int stride) {
    float* scr = c.sm + c.wid * (64 * 33);
    float ra[32], rb[32];
    auto src = [&](int it, const float*& W, int& N, int& nblk, int& item) {
        const int e = it / 384, r = it % 384;
        if (r < 128) { W = c.in[33] + (size_t)e * D * EFF; N = EFF; nblk = EFF / 32; item = r; }
        else if (r < 256) { W = c.in[34] + (size_t)e * D * EFF; N = EFF; nblk = EFF / 32; item = r - 128; }
        else { W = c.in[35] + (size_t)e * EFF * D; N = D; nblk = D / 32; item = r - 256; }
    };
    auto fin = [&](int it, const float (&rg)[32]) {
        const int e = it / 384, r = it % 384;
        if (r < 128) transpose_finish<false>(D, EFF / 32, (bf16_t*)(c.ws + WS_WEGU) + (size_t)e * 512 * D, [](int n) { return (n >> 7) * 256 + (n & 127); }, scr, r, c.lane, rg);
        else if (r < 256) transpose_finish<false>(D, EFF / 32, (bf16_t*)(c.ws + WS_WEGU) + (size_t)e * 512 * D, [](int n) { return (n >> 7) * 256 + 128 + (n & 127); }, scr, r - 128, c.lane, rg);
        else transpose_finish<false>(EFF, D / 32, (bf16_t*)(c.ws + WS_WED) + (size_t)e * D * EFF, [](int n) { return n; }, scr, r - 256, c.lane, rg);
    };
    int it = first;
    if (it >= NE * 384) return;
    { const float* W; int N, nblk, item; src(it, W, N, nblk, item); transpose_load(W, N, nblk, item, c.lane, ra); }
    for (;;) {
        const int it1 = it + stride;
        if (it1 < NE * 384) { const float* W; int N, nblk, item; src(it1, W, N, nblk, item); transpose_load(W, N, nblk, item, c.lane, rb); }
        fin(it, ra);
        if (it1 >= NE * 384) break;
        const int it2 = it1 + stride;
        if (it2 < NE * 384) { const float* W; int N, nblk, item; src(it2, W, N, nblk, item); transpose_load(W, N, nblk, item, c.lane, ra); }
        fin(it1, rb);
        if (it2 >= NE * 384) break;
        it = it2;
    }
}

__device__ __forceinline__ void phase0(const Ctx& c) {
    const int gt = c.bid * 512 + c.tid, NT = c.G * 512;
    const int gw = c.bid * 8 + c.wid, NW = c.G * 8;
    {
        const float* cc = c.in[1]; const float* w_ada = c.in[2];
        float* modsp = (float*)(c.ws + WS_MODSP);
        for (int task = gw; task < 96 * 16; task += NW) {
            const int cg = task % 96, ks = task / 96, j = cg * 64 + c.lane;
            float a0 = 0.f, a1 = 0.f, a2 = 0.f, a3 = 0.f;
#pragma unroll 4
            for (int k = ks * 64; k < ks * 64 + 64; ++k) {
                const float wv = w_ada[(size_t)k * NMODS + j];
                a0 = fmaf(siluf_(cc[k]), wv, a0); a1 = fmaf(siluf_(cc[D + k]), wv, a1); a2 = fmaf(siluf_(cc[2 * D + k]), wv, a2); a3 = fmaf(siluf_(cc[3 * D + k]), wv, a3);
            }
            modsp[(ks * 4 + 0) * NMODS + j] = a0; modsp[(ks * 4 + 1) * NMODS + j] = a1; modsp[(ks * 4 + 2) * NMODS + j] = a2; modsp[(ks * 4 + 3) * NMODS + j] = a3;
        }
    }
    {
        const float* log_dt = c.in[20]; const float* a_re = c.in[21]; const float* a_im = c.in[22];
        const float* b_re = c.in[23]; const float* b_im = c.in[24];
        float* apow = (float*)(c.ws + WS_APOW); float* bb = (float*)(c.ws + WS_S5BB);
        for (int idx = gt; idx < S5NG * S5P; idx += NT) {
            const int g = idx / S5P, p = idx % S5P;
            const double dt = exp((double)log_dt[g]);
            const double lre = fmin((double)a_re[idx], -1e-4), lim = (double)a_im[idx];
            const double mag = exp(lre * dt), ang = lim * dt;
            const double abr = mag * cos(ang), abi = mag * sin(ang);
            const double den = lre * lre + lim * lim;
            const double nre = abr - 1.0, nim = abi;
            const double qre = (nre * lre + nim * lim) / den, qim = (nim * lre - nre * lim) / den;
            double pr = 1.0, pi = 0.0;
            for (int j = 0; j <= S5L; ++j) {
                apow[((size_t)(g * (S5L + 1) + j) * 64 + p) * 2 + 0] = (float)pr; apow[((size_t)(g * (S5L + 1) + j) * 64 + p) * 2 + 1] = (float)pi;
                const double nr = pr * abr - pi * abi, ni = pr * abi + pi * abr; pr = nr; pi = ni;
            }
            for (int ch = 0; ch < 16; ++ch) {
                const double br = (double)b_re[idx * 16 + ch], bi = (double)b_im[idx * 16 + ch];
                bb[idx * 32 + ch] = (float)(qre * br - qim * bi);
                bb[idx * 32 + 16 + ch] = (float)(qre * bi + qim * br);
            }
        }
    }
    {
        const float* w2 = c.in[11]; const float* a2 = c.in[13]; const float* g2 = c.in[14];
        bf16_t* bt = (bf16_t*)(c.ws + WS_LORA_BT);
        for (int it = gt; it < 1536 * 32; it += NT) {
            const int n = it >> 5, c0 = (it & 31) * 8;
            float v[8];
#pragma unroll
            for (int i = 0; i < 8; ++i) {
                const int col = c0 + i; float x = 0.f;
                if (n < 512) { if (col < 64) x = w2[col * RW + n]; }
                else if (n < 1024) { if (col >= 64 && col < 128) x = a2[(col - 64) * RW + (n - 512)]; }
                else { if (col >= 128) x = g2[(col - 128) * RW + (n - 1024)]; }
                v[i] = x;
            }
            *(uint4*)(bt + (size_t)n * 256 + c0) = make_uint4(pk2(v[0], v[1]), pk2(v[2], v[3]), pk2(v[4], v[5]), pk2(v[6], v[7]));
        }
    }
    float* scr = c.sm + c.wid * (64 * 33);
    constexpr int I_IN = (D / 64) * (NPROJ / 32), I_OUT = (D / 64) * (D / 32), I_GLU = (512 / 64) * (512 / 32), I_SG = (D / 64) * (256 / 32), I_SD = (256 / 64) * (D / 32), I_R = (D / 64) * (256 / 32);
    constexpr int NIT = I_IN + I_OUT + I_GLU + 2 * I_SG + I_SD + 2 * I_R;
    for (int it = gw; it < NIT; it += NW) {
        int r = it;
        if (r < I_IN) { transpose_item<false>(c.in[8], D, NPROJ, (bf16_t*)(c.ws + WS_WIN_T), [](int n) { return n; }, scr, r, c.lane); continue; } r -= I_IN;
        if (r < I_OUT) { transpose_item<false>(c.in[30], D, D, (bf16_t*)(c.ws + WS_WOUT_T), [](int n) { return n; }, scr, r, c.lane); continue; } r -= I_OUT;
        if (r < I_GLU) { transpose_item<false>(c.in[28], 512, 512, (bf16_t*)(c.ws + WS_WGLU_T), [](int n) { return n; }, scr, r, c.lane); continue; } r -= I_GLU;
        if (r < I_SG) { transpose_item<false>(c.in[36], D, 256, (bf16_t*)(c.ws + WS_WSGU_T), [](int n) { return (n >> 7) * 256 + (n & 127); }, scr, r, c.lane); continue; } r -= I_SG;
        if (r < I_SG) { transpose_item<false>(c.in[37], D, 256, (bf16_t*)(c.ws + WS_WSGU_T), [](int n) { return (n >> 7) * 256 + 128 + (n & 127); }, scr, r, c.lane); continue; } r -= I_SG;
        if (r < I_SD) { transpose_item<false>(c.in[38], 256, D, (bf16_t*)(c.ws + WS_WSD_T), [](int n) { return n; }, scr, r, c.lane); continue; } r -= I_SD;
        if (r < I_R) { transpose_item<false>(c.in[31], D, 256, (bf16_t*)(c.ws + WS_WR_T), [](int n) { return n; }, scr, r, c.lane); continue; } r -= I_R;
        transpose_item<true>(c.in[31], D, 256, (bf16_t*)(c.ws + WS_WR_T), [](int n) { return 256 + n; }, scr, r, c.lane);
    }
}

__device__ __forceinline__ void phase1(const Ctx& c) {
    const int gt = c.bid * 512 + c.tid, NT = c.G * 512;
    const int gw = c.bid * 8 + c.wid, NW = c.G * 8;
    const float* modsp = (const float*)(c.ws + WS_MODSP); const float* b_ada = c.in[3]; float* mods = (float*)(c.ws + WS_MODS);
    for (int idx = gt; idx < BATCH * NMODS; idx += NT) {
        const int b = idx / NMODS, j = idx % NMODS;
        float acc = 0.f;
#pragma unroll
        for (int ks = 0; ks < 16; ++ks) acc += modsp[(ks * 4 + b) * NMODS + j];
        mods[idx] = acc + b_ada[j];
    }
    const float* apow = (const float*)(c.ws + WS_APOW); const float* bb = (const float*)(c.ws + WS_S5BB);
    const float* c_re = c.in[25]; const float* c_im = c.in[26];
    float* klag = (float*)(c.ws + WS_KLAG);
    for (int task = gw; task < S5NG * S5L; task += NW) {
        const int g = task / S5L, j = task % S5L, cc = c.lane >> 2, cq = (c.lane & 3) * 4;
        float acc[4] = {0.f, 0.f, 0.f, 0.f};
        for (int p = 0; p < 64; ++p) {
            const float ar = apow[((size_t)(g * (S5L + 1) + j) * 64 + p) * 2], ai = apow[((size_t)(g * (S5L + 1) + j) * 64 + p) * 2 + 1];
            const float cr = c_re[(g * 16 + cc) * 64 + p], ci = c_im[(g * 16 + cc) * 64 + p];
            const float4 br = *(const float4*)(bb + (size_t)(g * 64 + p) * 32 + cq), bi = *(const float4*)(bb + (size_t)(g * 64 + p) * 32 + 16 + cq);
            const float er = cr * ar - ci * ai, ei = cr * ai + ci * ar;
            acc[0] += er * br.x - ei * bi.x; acc[1] += er * br.y - ei * bi.y; acc[2] += er * br.z - ei * bi.z; acc[3] += er * br.w - ei * bi.w;
        }
        *(float4*)(klag + ((size_t)(g * S5L + j) * 16 + cc) * 16 + cq) = make_float4(acc[0], acc[1], acc[2], acc[3]);
    }
}

__device__ __forceinline__ void phase2(const Ctx& c) {
    const float* x = c.in[0]; const float* g = c.in[4];
    const float* mods = (const float*)(c.ws + WS_MODS);
    bf16_t* xn = (bf16_t*)(c.ws + WS_A);
    const int gw = c.bid * 8 + c.wid, NW = c.G * 8;
    for (int t = gw; t < T; t += NW) {
        const int b = t / SEQ;
        const float4* xr = (const float4*)(x + (size_t)t * D) + c.lane;
        float4 v[4]; float ss = 0.f;
#pragma unroll
        for (int j = 0; j < 4; ++j) { v[j] = xr[64 * j]; ss += v[j].x * v[j].x + v[j].y * v[j].y + v[j].z * v[j].z + v[j].w * v[j].w; }
        const float rstd = rsqrtf(wave_sum(ss) * (1.0f / D) + 1e-6f);
        uint2* o = (uint2*)(xn + (size_t)t * D) + c.lane;
#pragma unroll
        for (int j = 0; j < 4; ++j) {
            const int k = (c.lane + 64 * j) * 4;
            const float4 gg = *(const float4*)(g + k);
            const float4 sh = *(const float4*)(mods + b * NMODS + k);
            const float4 sc = *(const float4*)(mods + b * NMODS + D + k);
            float4 r;
            r.x = v[j].x * rstd * gg.x * (1.f + sc.x) + sh.x; r.y = v[j].y * rstd * gg.y * (1.f + sc.y) + sh.y;
            r.z = v[j].z * rstd * gg.z * (1.f + sc.z) + sh.z; r.w = v[j].w * rstd * gg.w * (1.f + sc.w) + sh.w;
            o[64 * j] = make_uint2(pk2(r.x, r.y), pk2(r.z, r.w));
        }
    }
    const int gt = c.bid * 512 + c.tid, NT = c.G * 512;
    const float* apow = (const float*)(c.ws + WS_APOW); const float* bb = (const float*)(c.ws + WS_S5BB); const float* klag = (const float*)(c.ws + WS_KLAG);
    const float* c_re = c.in[25]; const float* c_im = c.in[26]; const float* dd = c.in[27];
    bf16_t* kmat = (bf16_t*)(c.ws + WS_KMAT); bf16_t* hmat = (bf16_t*)(c.ws + WS_HMAT);
    for (int it = gt; it < S5NG * 512 * 80; it += NT) {
        const int row = it / 80, ch = it % 80, g = row >> 9, t = (row >> 4) & 31, cc = row & 15, col0 = ch * 8;
        float v[8];
        if (col0 < 512) {
            const int s = col0 >> 4, c0 = col0 & 15;
            if (s > t) {
#pragma unroll
                for (int i = 0; i < 8; ++i) v[i] = 0.f;
            } else {
                const float4 k0 = *(const float4*)(klag + ((size_t)(g * S5L + (t - s)) * 16 + cc) * 16 + c0), k1 = *(const float4*)(klag + ((size_t)(g * S5L + (t - s)) * 16 + cc) * 16 + c0 + 4);
                v[0] = k0.x; v[1] = k0.y; v[2] = k0.z; v[3] = k0.w; v[4] = k1.x; v[5] = k1.y; v[6] = k1.z; v[7] = k1.w;
                if (s == t) {
                    const float dv = dd[g * 16 + cc];
#pragma unroll
                    for (int i = 0; i < 8; ++i) if (c0 + i == cc) v[i] += dv;
                }
            }
        } else {
            const int q0 = col0 - 512;
#pragma unroll
            for (int i = 0; i < 8; ++i) {
                const int q = q0 + i, p = q & 63;
                const float ar = apow[((size_t)(g * (S5L + 1) + t + 1) * 64 + p) * 2], ai = apow[((size_t)(g * (S5L + 1) + t + 1) * 64 + p) * 2 + 1];
                const float cr = c_re[(g * 16 + cc) * 64 + p], ci = c_im[(g * 16 + cc) * 64 + p];
                v[i] = (q < 64) ? (cr * ar - ci * ai) : -(cr * ai + ci * ar);
            }
        }
        *(uint4*)(kmat + (size_t)row * 640 + col0) = make_uint4(pk2(v[0], v[1]), pk2(v[2], v[3]), pk2(v[4], v[5]), pk2(v[6], v[7]));
    }
    for (int it = gt; it < S5NG * 256 * 80; it += NT) {
        const int row = it / 80, ch = it % 80, g = row >> 8, q = row & 255, col0 = ch * 8;
        float v[8];
#pragma unroll
        for (int i = 0; i < 8; ++i) v[i] = 0.f;
        if (q < 128 && col0 < 512) {
            const int s = col0 >> 4, c0 = col0 & 15, p = q & 63;
            const float ar = apow[((size_t)(g * (S5L + 1) + (S5L - 1 - s)) * 64 + p) * 2], ai = apow[((size_t)(g * (S5L + 1) + (S5L - 1 - s)) * 64 + p) * 2 + 1];
#pragma unroll
            for (int i = 0; i < 8; ++i) {
                const float br = bb[(size_t)(g * 64 + p) * 32 + c0 + i], bi = bb[(size_t)(g * 64 + p) * 32 + 16 + c0 + i];
                v[i] = (q < 64) ? (ar * br - ai * bi) : (ar * bi + ai * br);
            }
        }
        *(uint4*)(hmat + (size_t)row * 640 + col0) = make_uint4(pk2(v[0], v[1]), pk2(v[2], v[3]), pk2(v[4], v[5]), pk2(v[6], v[7]));
    }
}

__device__ __forceinline__ void phase3(const Ctx& c) {
    pg8::Gemm g{(const bf16_t*)(c.ws + WS_A), (const bf16_t*)(c.ws + WS_WIN_T), T, NPROJ, D};
    pg8::StaticOrder S; S.init(T, NPROJ, c.G, c.bid);
    pg8::EpiBf16<0> E{(bf16_t*)(c.ws + WS_PROJ), NPROJ, nullptr, 0, 0, 1.f};
    pg8::gemm_phase<pg8::EpiBf16<0>, pg8::StaticOrder, true, true>(c.lds, g, S, E);
}

__device__ __forceinline__ void unpack8(const uint4 a, float (&u)[8]) {
    u[0] = bf2f(a.x & 0xffffu); u[1] = bf2f(a.x >> 16); u[2] = bf2f(a.y & 0xffffu); u[3] = bf2f(a.y >> 16);
    u[4] = bf2f(a.z & 0xffffu); u[5] = bf2f(a.z >> 16); u[6] = bf2f(a.w & 0xffffu); u[7] = bf2f(a.w >> 16);
}
__device__ __forceinline__ uint4 pack8(const float (&v)[8]) { return make_uint4(pk2(v[0], v[1]), pk2(v[2], v[3]), pk2(v[4], v[5]), pk2(v[6], v[7])); }
__device__ __forceinline__ void phase4(const Ctx& c) {
    const bf16_t* proj = (const bf16_t*)(c.ws + WS_PROJ);
    const float* mu = c.in[9]; const float* k_k = c.in[15];
    bf16_t* rw_r = (bf16_t*)(c.ws + WS_RW_R); bf16_t* rw_k = (bf16_t*)(c.ws + WS_RW_K); bf16_t* rw_v = (bf16_t*)(c.ws + WS_RW_V); bf16_t* rw_a = (bf16_t*)(c.ws + WS_RW_A);
    bf16_t* alora = (bf16_t*)((unsigned char*)c.out + OUT_ALORA); bf16_t* ux = (bf16_t*)((unsigned char*)c.out + OUT_UX);
    const int gw = c.bid * 8 + c.wid, NW = c.G * 8;
    for (int t = gw; t < T; t += NW) {
        const bool first = (t % SEQ == 0);
        const bf16_t* pr = proj + (size_t)t * NPROJ; const bf16_t* pp = proj + (size_t)(first ? t : t - 1) * NPROJ;
#pragma unroll
        for (int j = 0; j < 4; ++j) {
            const int cidx = c.lane + 64 * j;
            if (cidx < 224) {
                const int col = cidx * 8;
                float p[8], q[8], ps[8];
                unpack8(*(const uint4*)(pr + col), p); unpack8(*(const uint4*)(pp + col), q);
                const float4 m0 = *(const float4*)(mu + col), m1 = *(const float4*)(mu + col + 4);
                const float mm[8] = {m0.x, m0.y, m0.z, m0.w, m1.x, m1.y, m1.z, m1.w};
#pragma unroll
                for (int i = 0; i < 8; ++i) { const float pv = first ? 0.f : q[i]; ps[i] = p[i] + (pv - p[i]) * mm[i]; }
                if (j == 0) *(uint4*)(rw_r + (size_t)t * RW + col) = pack8(ps);
                else if (j == 1) {
                    const int cl = col - 512;
                    *(uint4*)(rw_k + (size_t)t * RW + cl) = pack8(ps);
                    const float4 k0 = *(const float4*)(k_k + cl), k1 = *(const float4*)(k_k + cl + 4);
                    const float kk8[8] = {k0.x, k0.y, k0.z, k0.w, k1.x, k1.y, k1.z, k1.w};
                    float kk[8]; float ss = 0.f;
#pragma unroll
                    for (int i = 0; i < 8; ++i) { kk[i] = ps[i] * kk8[i]; ss += kk[i] * kk[i]; }
                    ss += __shfl_xor(ss, 1); ss += __shfl_xor(ss, 2); ss += __shfl_xor(ss, 4);
                    const float inv = -1.0f / fmaxf(sqrtf(ss), 1e-12f);
#pragma unroll
                    for (int i = 0; i < 8; ++i) kk[i] *= inv;
                    *(uint4*)(rw_a + (size_t)t * RW + cl) = pack8(kk);
                } else if (j == 2) *(uint4*)(rw_v + (size_t)t * RW + (col - 1024)) = pack8(ps);
                else {
                    const int cl = col - 1536;
                    float o[8];
#pragma unroll
                    for (int i = 0; i < 8; ++i) o[i] = (cl < 64) ? tanhf(ps[i]) : (cl < 128) ? ps[i] : sigmoidf_(ps[i]);
                    *(uint4*)(alora + (size_t)t * 256 + cl) = pack8(o);
                }
            }
        }
        {
            const int g = c.lane >> 1, hf = c.lane & 1, b = t / SEQ, sidx = t % S5L, chunk = (t % SEQ) / S5L;
            const uint4 v = *(const uint4*)(pr + RPROJ + c.lane * 8);
            bf16_t* row = ux + ((size_t)(g * 1024 + b * 256 + chunk)) * 640;
            *(uint4*)(row + sidx * 16 + hf * 8) = v;
            if (sidx < 8) { *(uint4*)(row + 512 + (sidx * 2 + hf) * 8) = make_uint4(0u, 0u, 0u, 0u); }
        }
    }
}

__device__ __forceinline__ void phase5(const Ctx& c) {
    {
        pg8::Gemm g{(const bf16_t*)((unsigned char*)c.out + OUT_ALORA), (const bf16_t*)(c.ws + WS_LORA_BT), T, 1536, 256};
        pg8::StaticOrder S; S.init(T, 1536, c.G, c.bid);
        pg8::EpiLora E{c.in[10], c.in[12], c.in[16], (float*)(c.ws + WS_RW_W), (const bf16_t*)(c.ws + WS_RW_K), (bf16_t*)((unsigned char*)c.out + OUT_KF), (const bf16_t*)(c.ws + WS_RW_A), (bf16_t*)(c.ws + WS_RW_B), (bf16_t*)(c.ws + WS_RW_G)};
        pg8::gemm_phase<pg8::EpiLora, pg8::StaticOrder, true, true>(c.lds, g, S, E);
    }
    __syncthreads();
    {
        pg8::Gemm g{(const bf16_t*)((unsigned char*)c.out + OUT_UX), (const bf16_t*)(c.ws + WS_HMAT), 0, 0, 640};
        pg8::S5Order S{128, 1, c.G, c.bid};
        pg8::EpiS5E E{(float*)((unsigned char*)c.out + OUT_E)};
        pg8::gemm_phase<pg8::EpiS5E, pg8::S5Order, true, true>(c.lds, g, S, E);
    }
}

typedef float f2v __attribute__((ext_vector_type(2)));
__device__ __forceinline__ float dpp_add16(float v) {
    v += __builtin_bit_cast(float, __builtin_amdgcn_mov_dpp(__builtin_bit_cast(int, v), 0xB1, 0xf, 0xf, true));
    v += __builtin_bit_cast(float, __builtin_amdgcn_mov_dpp(__builtin_bit_cast(int, v), 0x4E, 0xf, 0xf, true));
    v += __builtin_bit_cast(float, __builtin_amdgcn_mov_dpp(__builtin_bit_cast(int, v), 0x141, 0xf, 0xf, true));
    v += __builtin_bit_cast(float, __builtin_amdgcn_mov_dpp(__builtin_bit_cast(int, v), 0x140, 0xf, 0xf, true));
    return v;
}
constexpr int RTS = 32;
constexpr int RTILE = 6 * RTS * 64;
typedef short bf16x8_t __attribute__((ext_vector_type(8)));
typedef float f32x4_t __attribute__((ext_vector_type(4)));
#define MFMA16(a, b, c) __builtin_amdgcn_mfma_f32_16x16x32_bf16((a), (b), (c), 0, 0, 0)
constexpr int CL = 64, CLD = 72, CSLOT = 64 * CLD * 2;
constexpr int C_DIAG = 13 * CSLOT, C_DM = C_DIAG + 4096, C_GL = C_DM + 2048, C_SEGP = C_GL + 256;
static_assert(C_SEGP + 2048 <= 131072, "rwkv chunk LDS map");
__device__ __forceinline__ bf16x8_t ldsfrag(LAS const unsigned char* slot, int row, int col) { return *(LAS const bf16x8_t*)(slot + (row * CLD + col) * 2); }
typedef unsigned u32x4_t __attribute__((ext_vector_type(4)));
typedef unsigned u32x2_t __attribute__((ext_vector_type(2)));
__device__ __forceinline__ void lds_st16(LAS unsigned char* p, uint4 v) { *(LAS u32x4_t*)p = (u32x4_t){v.x, v.y, v.z, v.w}; }
__device__ __forceinline__ void lds_st8(LAS unsigned char* p, uint2 v) { *(LAS u32x2_t*)p = (u32x2_t){v.x, v.y}; }
__device__ __forceinline__ uint2 lds_ld8(LAS const unsigned char* p) { const u32x2_t v = *(LAS const u32x2_t*)p; return make_uint2(v.x, v.y); }
__device__ __forceinline__ bf16x8_t zfrag() { return (bf16x8_t){0, 0, 0, 0, 0, 0, 0, 0}; }
__device__ __forceinline__ uint2 pack4(float a, float b, float c, float d) { return make_uint2(pk2(a, b), pk2(c, d)); }
__device__ __forceinline__ float wave_sum_u(float v) {
    v = dpp_add16(v);
    return __builtin_bit_cast(float, __builtin_amdgcn_readlane(__builtin_bit_cast(int, v), 0)) + __builtin_bit_cast(float, __builtin_amdgcn_readlane(__builtin_bit_cast(int, v), 16))
         + __builtin_bit_cast(float, __builtin_amdgcn_readlane(__builtin_bit_cast(int, v), 32)) + __builtin_bit_cast(float, __builtin_amdgcn_readlane(__builtin_bit_cast(int, v), 48));
}

__device__ __forceinline__ void rwkv_phaseA(const Ctx& c) {
    const float* __restrict__ rw_w = (const float*)(c.ws + WS_RW_W);
    const bf16_t* __restrict__ rw_r = (const bf16_t*)(c.ws + WS_RW_R); const bf16_t* __restrict__ rw_k = (const bf16_t*)((const unsigned char*)c.out + OUT_KF); const bf16_t* __restrict__ rw_v = (const bf16_t*)(c.ws + WS_RW_V);
    const bf16_t* __restrict__ rw_a = (const bf16_t*)(c.ws + WS_RW_A); const bf16_t* __restrict__ rw_b = (const bf16_t*)(c.ws + WS_RW_B);
    const float* r_k = c.in[17];
    bf16_t* Mq = (bf16_t*)(c.ws + WS_CM); bf16_t* NTq = (bf16_t*)(c.ws + WS_CN); bf16_t* Qq = (bf16_t*)(c.ws + WS_CQ); bf16_t* YTq = (bf16_t*)(c.ws + WS_CY); float* bon = (float*)(c.ws + WS_CBON);
    LAS unsigned char* L = c.lds;
    LAS unsigned char* sAt = L + 0 * CSLOT; LAS unsigned char* sBt = L + 1 * CSLOT; LAS unsigned char* sKt = L + 2 * CSLOT; LAS unsigned char* sRt = L + 3 * CSLOT;
    LAS unsigned char* sBtT = L + 4 * CSLOT; LAS unsigned char* sKtT = L + 5 * CSLOT; LAS unsigned char* sVT = L + 6 * CSLOT;
    LAS unsigned char* sA4 = L + 7 * CSLOT;
    LAS unsigned char* sRHST = L + 11 * CSLOT;
    LAS unsigned char* sXT = L + 0 * CSLOT;
    LAS unsigned char* sAD = L + 2 * CSLOT;
    LAS float* sDIAG = (LAS float*)(L + C_DIAG); LAS bf16_t* sDM = (LAS bf16_t*)(L + C_DM); LAS float* sGL = (LAS float*)(L + C_GL); LAS float* sSEGP = (LAS float*)(L + C_SEGP);
    const int tid = c.tid, w = c.wid, lane = c.lane, lr = lane & 15, lq = lane >> 4;
    float raww[8]; unsigned rawa[8], rawb[8], rawk[8], rawr[8], rawv[8];
    auto load_raw = [&](int ci_) {
        const int bh_ = ci_ >> 7, chunk_ = ci_ & 127, b_ = bh_ >> 3, h_ = bh_ & 7;
        const size_t gb = (size_t)(b_ * SEQ + chunk_ * CL) * RW + h_ * 64 + (size_t)(8 * (tid >> 6)) * RW + (tid & 63);
#pragma unroll
        for (int j = 0; j < 8; ++j) { const size_t o = gb + (size_t)j * RW; raww[j] = rw_w[o]; rawa[j] = rw_a[o]; rawb[j] = rw_b[o]; rawk[j] = rw_k[o]; rawr[j] = rw_r[o]; rawv[j] = rw_v[o]; }
    };
    if (c.bid < BATCH * NH * (SEQ / CL)) load_raw(c.bid);
    for (int ci = c.bid; ci < BATCH * NH * (SEQ / CL); ci += c.G) {
        const int bh = ci >> 7, chunk = ci & 127, b = bh >> 3, h = bh & 7;
        const size_t gbase = (size_t)(b * SEQ + chunk * CL) * RW + h * 64;
        {
            const int kc = tid & 63, seg = tid >> 6;
            float p[8];
#pragma unroll
            for (int j = 0; j < 8; ++j) { const float wv = raww[j]; p[j] = (j == 0) ? wv : p[j - 1] * wv; }
            sSEGP[seg * 64 + kc] = p[7];
            for (int i = tid; i < 4 * CSLOT / 16; i += 512) lds_st16(sA4 + i * 16, make_uint4(0u, 0u, 0u, 0u));
            __syncthreads();
            float pre = 1.0f;
#pragma unroll
            for (int s = 0; s < 7; ++s) { const float sp = sSEGP[s * 64 + kc]; pre = (s < seg) ? pre * sp : pre; }
            float atT[8], btT[8], ktT[8], vT[8];
            const float rkv = r_k[h * 64 + kc];
#pragma unroll
            for (int j = 0; j < 8; ++j) {
                const int t = 8 * seg + j;
                const float G = pre * p[j], Gm1 = (j == 0) ? pre : pre * p[j - 1], inv = 1.0f / G;
                const float av = bf2f(rawa[j]), bv = bf2f(rawb[j]), kv = bf2f(rawk[j]), rv = bf2f(rawr[j]), vv = bf2f(rawv[j]);
                const float at = av * Gm1, bt = bv * inv, kt = kv * inv, rt = rv * G;
                *(LAS bf16_t*)(sAt + (t * CLD + kc) * 2) = (bf16_t)f2bf(at); *(LAS bf16_t*)(sBt + (t * CLD + kc) * 2) = (bf16_t)f2bf(bt);
                *(LAS bf16_t*)(sKt + (t * CLD + kc) * 2) = (bf16_t)f2bf(kt); *(LAS bf16_t*)(sRt + (t * CLD + kc) * 2) = (bf16_t)f2bf(rt);
                atT[j] = at; btT[j] = bt; ktT[j] = kt; vT[j] = vv;
                const float bs = wave_sum_u(rv * kv * rkv);
                if (lane == 0) bon[(size_t)ci * CL + t] = bs;
            }
            lds_st16(sRHST + (kc * CLD + 8 * seg) * 2, pack8(atT)); lds_st16(sBtT + (kc * CLD + 8 * seg) * 2, pack8(btT));
            lds_st16(sKtT + (kc * CLD + 8 * seg) * 2, pack8(ktT)); lds_st16(sVT + (kc * CLD + 8 * seg) * 2, pack8(vT));
            if (seg == 7) sGL[kc] = pre * p[7];
            __syncthreads();
        }
        for (int idx = w; idx < 40; idx += 8) {
            const int m = idx / 10, pr = idx % 10;
            const int ti = (pr >= 6) ? 3 : (pr >= 3) ? 2 : (pr >= 1) ? 1 : 0, si = pr - ti * (ti + 1) / 2;
            LAS const unsigned char* X = (m < 2) ? sAt : sRt; LAS const unsigned char* Y = (m & 1) ? sKt : sBt;
            f32x4_t acc = {0.f, 0.f, 0.f, 0.f};
#pragma unroll
            for (int ks = 0; ks < 2; ++ks) acc = MFMA16(ldsfrag(Y, 16 * si + lr, 32 * ks + 8 * lq), ldsfrag(X, 16 * ti + lr, 32 * ks + 8 * lq), acc);
            const int t = 16 * ti + lr, s0 = 16 * si + 4 * lq;
            float o[4];
#pragma unroll
            for (int rg = 0; rg < 4; ++rg) { const int s = s0 + rg; const bool keep = (m < 2) ? (s < t) : (s <= t); o[rg] = keep ? acc[rg] : 0.f; }
            lds_st8(sA4 + m * CSLOT + (t * CLD + s0) * 2, pack4(o[0], o[1], o[2], o[3]));
            if (m == 0 && ti == si) *(LAS f32x4_t*)(sDIAG + (ti * 16 + lr) * 16 + 4 * lq) = (f32x4_t){o[0], o[1], o[2], o[3]};
        }
        __syncthreads();
        if (w == 0) {
            float x[16];
#pragma unroll
            for (int r = 0; r < 16; ++r) {
                float acc = (r == lr) ? 1.0f : 0.0f;
                float nrow[16];
#pragma unroll
                for (int q4 = 0; q4 < 4; ++q4) { const f32x4_t nv = *(LAS const f32x4_t*)(sDIAG + (lq * 16 + r) * 16 + 4 * q4); nrow[4 * q4] = nv[0]; nrow[4 * q4 + 1] = nv[1]; nrow[4 * q4 + 2] = nv[2]; nrow[4 * q4 + 3] = nv[3]; }
#pragma unroll
                for (int s = 0; s < 16; ++s) if (s < r) acc = fmaf(nrow[s], x[s], acc);
                x[r] = acc;
                sDM[(lq * 16 + r) * 16 + lr] = (bf16_t)f2bf(acc);
            }
        } else {
            for (int idx = w - 1; idx < 16; idx += 7) {
                const int ti = idx >> 2, vi = idx & 3;
                f32x4_t acc = {0.f, 0.f, 0.f, 0.f};
#pragma unroll
                for (int ks = 0; ks < 2; ++ks) acc = MFMA16(ldsfrag(sA4 + 1 * CSLOT, 16 * ti + lr, 32 * ks + 8 * lq), ldsfrag(sVT, 16 * vi + lr, 32 * ks + 8 * lq), acc);
                lds_st8(sRHST + ((64 + 16 * vi + lr) * CLD + 16 * ti + 4 * lq) * 2, pack4(acc[0], acc[1], acc[2], acc[3]));
            }
        }
        __syncthreads();
        f32x4_t rd[4];
#pragma unroll
        for (int i = 0; i < 4; ++i) {
            bf16x8_t fa = zfrag(), fb = zfrag();
            if (lq < 2) { fa = *(LAS const bf16x8_t*)(sDM + (i * 16 + lr) * 16 + 8 * lq); fb = ldsfrag(sRHST, 16 * w + lr, 16 * i + 8 * lq); }
            rd[i] = MFMA16(fa, fb, ((f32x4_t){0.f, 0.f, 0.f, 0.f}));
        }
        if (w < 6) {
            const int i = (w >= 3) ? 3 : (w >= 1) ? 2 : 1, j = w - (i - 1) * i / 2;
            bf16x8_t fa = zfrag(), fb = zfrag();
            if (lq < 2) {
                fa = *(LAS const bf16x8_t*)(sDM + (i * 16 + lr) * 16 + 8 * lq);
#pragma unroll
                for (int jj = 0; jj < 8; ++jj) fb[jj] = (short)*(LAS const bf16_t*)(sA4 + ((16 * i + 8 * lq + jj) * CLD + 16 * j + lr) * 2);
            }
            const f32x4_t acc = MFMA16(fa, fb, ((f32x4_t){0.f, 0.f, 0.f, 0.f}));
#pragma unroll
            for (int rg = 0; rg < 4; ++rg) *(LAS bf16_t*)(sAD + ((16 * i + 4 * lq + rg) * CLD + 16 * j + lr) * 2) = (bf16_t)f2bf(acc[rg]);
        }
        __syncthreads();
#pragma unroll
        for (int i = 0; i < 4; ++i) {
            f32x4_t acc = rd[i];
            if (i >= 1) {
                bf16x8_t fa = zfrag(), fb = zfrag();
                if (8 * lq < 16 * i) { fa = ldsfrag(sAD, 16 * i + lr, 8 * lq); fb = ldsfrag(sXT, 16 * w + lr, 8 * lq); }
                acc = MFMA16(fa, fb, acc);
            }
            if (i == 3) {
                bf16x8_t fa = zfrag(), fb = zfrag();
                if (lq < 2) { fa = ldsfrag(sAD, 48 + lr, 32 + 8 * lq); fb = ldsfrag(sXT, 16 * w + lr, 32 + 8 * lq); }
                acc = MFMA16(fa, fb, acc);
            }
            lds_st8(sXT + ((16 * w + lr) * CLD + 16 * i + 4 * lq) * 2, pack4(acc[0], acc[1], acc[2], acc[3]));
            asm volatile("s_waitcnt lgkmcnt(0)" ::: "memory");
        }
        __syncthreads();
        if (ci + c.G < BATCH * NH * (SEQ / CL)) load_raw(ci + c.G);
#pragma unroll
        for (int i = 0; i < 8; ++i) {
            const int kind = i >> 1, tile = w + 8 * (i & 1), r4 = tile >> 2, c4 = tile & 3;
            f32x4_t acc = {0.f, 0.f, 0.f, 0.f};
            if (kind == 0) {
#pragma unroll
                for (int ks = 0; ks < 2; ++ks) acc = MFMA16(ldsfrag(sXT, 16 * r4 + lr, 32 * ks + 8 * lq), ldsfrag(sBtT, 16 * c4 + lr, 32 * ks + 8 * lq), acc);
                const int k = 16 * c4 + lr, kp0 = 16 * r4 + 4 * lq; const float gl = sGL[k];
                float o[4];
#pragma unroll
                for (int rg = 0; rg < 4; ++rg) o[rg] = gl * (acc[rg] + ((k == kp0 + rg) ? 1.0f : 0.0f));
                *(uint2*)(Mq + (size_t)ci * 4096 + k * 64 + kp0) = pack4(o[0], o[1], o[2], o[3]);
            } else if (kind == 1) {
#pragma unroll
                for (int ks = 0; ks < 2; ++ks) {
                    acc = MFMA16(ldsfrag(sBtT, 16 * r4 + lr, 32 * ks + 8 * lq), ldsfrag(sXT, 64 + 16 * c4 + lr, 32 * ks + 8 * lq), acc);
                    acc = MFMA16(ldsfrag(sKtT, 16 * r4 + lr, 32 * ks + 8 * lq), ldsfrag(sVT, 16 * c4 + lr, 32 * ks + 8 * lq), acc);
                }
                const int k0 = 16 * r4 + 4 * lq; const f32x4_t gl = *(LAS const f32x4_t*)(sGL + k0);
                *(uint2*)(NTq + (size_t)ci * 4096 + (16 * c4 + lr) * 64 + k0) = pack4(gl[0] * acc[0], gl[1] * acc[1], gl[2] * acc[2], gl[3] * acc[3]);
            } else if (kind == 2) {
#pragma unroll
                for (int ks = 0; ks < 2; ++ks) acc = MFMA16(ldsfrag(sXT, 16 * r4 + lr, 32 * ks + 8 * lq), ldsfrag(sA4 + 2 * CSLOT, 16 * c4 + lr, 32 * ks + 8 * lq), acc);
                const int t = 16 * c4 + lr, kp0 = 16 * r4 + 4 * lq;
                const uint2 rv = lds_ld8(sRt + (t * CLD + kp0) * 2);
                *(uint2*)(Qq + (size_t)ci * 4096 + t * 64 + kp0) = pack4(acc[0] + bf2f(rv.x & 0xffffu), acc[1] + bf2f(rv.x >> 16), acc[2] + bf2f(rv.y & 0xffffu), acc[3] + bf2f(rv.y >> 16));
            } else {
#pragma unroll
                for (int ks = 0; ks < 2; ++ks) {
                    acc = MFMA16(ldsfrag(sA4 + 2 * CSLOT, 16 * r4 + lr, 32 * ks + 8 * lq), ldsfrag(sXT, 64 + 16 * c4 + lr, 32 * ks + 8 * lq), acc);
                    acc = MFMA16(ldsfrag(sA4 + 3 * CSLOT, 16 * r4 + lr, 32 * ks + 8 * lq), ldsfrag(sVT, 16 * c4 + lr, 32 * ks + 8 * lq), acc);
                }
                *(uint2*)(YTq + (size_t)ci * 4096 + (16 * c4 + lr) * 64 + 16 * r4 + 4 * lq) = pack4(acc[0], acc[1], acc[2], acc[3]);
            }
        }
        __syncthreads();
    }
}

__device__ __forceinline__ void rwkv_phaseB(const Ctx& c, const int bh, const int w) {
    const bf16_t* __restrict__ Mq = (const bf16_t*)(c.ws + WS_CM); const bf16_t* __restrict__ NTq = (const bf16_t*)(c.ws + WS_CN); bf16_t* __restrict__ Sst = (bf16_t*)(c.ws + WS_CS);
    const int lane = c.lane, lr = lane & 15, lq = lane >> 4;
    LAS unsigned char* sS = c.lds + 69632 + c.wid * (16 * CLD * 2);
    {
        {
            bf16x8_t sB0 = zfrag(), sB1 = zfrag();
            bf16x8_t ma[4][4][2]; uint2 nv[4][4];
            const size_t ci0 = (size_t)bh * (SEQ / CL);
#define RB_LOAD(slot, cidx) do { _Pragma("unroll") for (int kt = 0; kt < 4; ++kt) { _Pragma("unroll") for (int ks = 0; ks < 2; ++ks) \
                ma[slot][kt][ks] = *(const bf16x8_t*)(Mq + (cidx) * 4096 + (16 * kt + lr) * 64 + 32 * ks + 8 * lq); nv[slot][kt] = *(const uint2*)(NTq + (cidx) * 4096 + (16 * w + lr) * 64 + 16 * kt + 4 * lq); } } while (0)
#pragma unroll
            for (int sl = 0; sl < 4; ++sl) RB_LOAD(sl, ci0 + sl);
#pragma unroll
            for (int chunk = 0; chunk < SEQ / CL; chunk += 4) {
#pragma unroll
                for (int sl = 0; sl < 4; ++sl) {
                    const size_t ci = ci0 + chunk + sl;
                    asm volatile("global_store_dwordx4 %0, %1, off\n\tglobal_store_dwordx4 %0, %2, off offset:64\n\ts_nop 1" :: "v"(Sst + ci * 4096 + (16 * w + lr) * 64 + 8 * lq), "v"(sB0), "v"(sB1) : "memory");
#pragma unroll
                    for (int kt = 0; kt < 4; ++kt) {
                        f32x4_t acc = {bf2f(nv[sl][kt].x & 0xffffu), bf2f(nv[sl][kt].x >> 16), bf2f(nv[sl][kt].y & 0xffffu), bf2f(nv[sl][kt].y >> 16)};
                        acc = MFMA16(ma[sl][kt][0], sB0, acc); acc = MFMA16(ma[sl][kt][1], sB1, acc);
                        lds_st8(sS + (lr * CLD + 16 * kt + 4 * lq) * 2, pack4(acc[0], acc[1], acc[2], acc[3]));
                    }
                    const size_t cn = (chunk + sl + 4 < SEQ / CL) ? ci + 4 : ci;
                    RB_LOAD(sl, cn);
                    asm volatile("s_waitcnt lgkmcnt(0)" ::: "memory");
                    sB0 = ldsfrag(sS, lr, 8 * lq); sB1 = ldsfrag(sS, lr, 32 + 8 * lq);
                    asm volatile("s_waitcnt lgkmcnt(0)" ::: "memory");
                }
            }
#undef RB_LOAD
        }
    }
}

__device__ __forceinline__ void rwkv_phaseC(const Ctx& c) {
    const bf16_t* __restrict__ Qq = (const bf16_t*)(c.ws + WS_CQ); const bf16_t* __restrict__ YTq = (const bf16_t*)(c.ws + WS_CY); const bf16_t* __restrict__ Sst = (const bf16_t*)(c.ws + WS_CS);
    const float* __restrict__ bon = (const float*)(c.ws + WS_CBON);
    const bf16_t* rw_v = (const bf16_t*)(c.ws + WS_RW_V); const bf16_t* rw_g = (const bf16_t*)(c.ws + WS_RW_G);
    const float* ln_w = c.in[18]; const float* ln_b = c.in[19];
    bf16_t* ycat = (bf16_t*)(c.ws + WS_A);
    const int w = c.wid, lane = c.lane, lr = lane & 15, lq = lane >> 4;
    LAS float* sY = (LAS float*)(c.lds + w * (16 * 68 * 4));
    const int gw = c.bid * 8 + c.wid, NW = c.G * 8;
    for (int task = gw; task < BATCH * NH * (SEQ / CL) * 4; task += NW) {
        const size_t ci = (size_t)(task >> 2); const int tt = task & 3;
        const int bh = (int)(ci >> 7), chunk = (int)(ci & 127), b = bh >> 3, h = bh & 7;
        bf16x8_t qa[2];
#pragma unroll
        for (int ks = 0; ks < 2; ++ks) qa[ks] = *(const bf16x8_t*)(Qq + ci * 4096 + (16 * tt + lr) * 64 + 32 * ks + 8 * lq);
#pragma unroll
        for (int vt = 0; vt < 4; ++vt) {
            const uint2 yv = *(const uint2*)(YTq + ci * 4096 + (16 * vt + lr) * 64 + 16 * tt + 4 * lq);
            f32x4_t acc = {bf2f(yv.x & 0xffffu), bf2f(yv.x >> 16), bf2f(yv.y & 0xffffu), bf2f(yv.y >> 16)};
#pragma unroll
            for (int ks = 0; ks < 2; ++ks) acc = MFMA16(qa[ks], *(const bf16x8_t*)(Sst + ci * 4096 + (16 * vt + lr) * 64 + 32 * ks + 8 * lq), acc);
#pragma unroll
            for (int rg = 0; rg < 4; ++rg) sY[(4 * lq + rg) * 68 + 16 * vt + lr] = acc[rg];
        }
        asm volatile("s_waitcnt lgkmcnt(0)" ::: "memory");
        const int hn = h * 64 + lane;
        const float lw = ln_w[hn], lb = ln_b[hn];
#pragma unroll 4
        for (int tr = 0; tr < 16; ++tr) {
            const int t = chunk * CL + 16 * tt + tr; const size_t tok = (size_t)b * SEQ + t;
            const float y = sY[tr * 68 + lane];
            const float mean = wave_sum_u(y) * (1.f / 64.f);
            const float d = y - mean;
            const float var = wave_sum_u(d * d) * (1.f / 64.f);
            const float yn = d * rsqrtf(var + 64e-5f) * lw + lb;
            const float bonus = bon[ci * CL + 16 * tt + tr] * ldbf(rw_v + tok * RW + hn);
            ycat[tok * D + hn] = (bf16_t)f2bf((yn + bonus) * ldbf(rw_g + tok * RW + hn));
        }
        asm volatile("s_waitcnt lgkmcnt(0)" ::: "memory");
    }
}

__device__ __forceinline__ void phase6a(const Ctx& c) { rwkv_phaseA(c); }

__device__ __forceinline__ void phase6b(const Ctx& c) {
    if (c.wid == 0) {
        for (int tk = c.bid; tk < 2 * S5NG * BATCH; tk += c.G) {
            if (tk < BATCH * NH * 4) { rwkv_phaseB(c, tk >> 2, tk & 3); continue; }
            const float* apow = (const float*)(c.ws + WS_APOW); const float* E = (const float*)((const unsigned char*)c.out + OUT_E);
            bf16_t* ux = (bf16_t*)((unsigned char*)c.out + OUT_UX);
            const int task = tk - BATCH * NH * 4;
            const int g = task >> 2, b = task & 3, p = c.lane;
            const float pr = apow[((size_t)(g * (S5L + 1) + S5L) * 64 + p) * 2], pi = apow[((size_t)(g * (S5L + 1) + S5L) * 64 + p) * 2 + 1];
            float xr = 0.f, xi = 0.f;
            const size_t row0 = (size_t)g * 1024 + b * 256;
            float er[2][8], ei[2][8];
#pragma unroll
            for (int q = 0; q < 8; ++q) { er[0][q] = E[(row0 + q) * 128 + p]; ei[0][q] = E[(row0 + q) * 128 + 64 + p]; }
#pragma unroll
            for (int bt = 0; bt < 32; ++bt) {
                const int cur = bt & 1, nx = cur ^ 1, ch0 = bt * 8;
                if (bt + 1 < 32) {
#pragma unroll
                    for (int q = 0; q < 8; ++q) { er[nx][q] = E[(row0 + ch0 + 8 + q) * 128 + p]; ei[nx][q] = E[(row0 + ch0 + 8 + q) * 128 + 64 + p]; }
                }
#pragma unroll
                for (int q = 0; q < 8; ++q) {
                    st2(ux + (row0 + ch0 + q) * 640 + 512 + p, f2bf(xr)); st2(ux + (row0 + ch0 + q) * 640 + 576 + p, f2bf(xi));
                    const float nr = pr * xr - pi * xi + er[cur][q], ni = pr * xi + pi * xr + ei[cur][q]; xr = nr; xi = ni;
                }
            }
        }
    } else {
        convert_expert_weights(c, c.bid * 7 + (c.wid - 1), c.G * 7);
    }
}

__device__ __forceinline__ void phase7(const Ctx& c) {
    {
        pg8::Gemm g{(const bf16_t*)((unsigned char*)c.out + OUT_UX), (const bf16_t*)(c.ws + WS_KMAT), 0, 0, 640};
        pg8::S5Order S{256, 2, c.G, c.bid};
        pg8::EpiS5Out E{(bf16_t*)(c.ws + WS_YS5)};
        pg8::gemm_phase<pg8::EpiS5Out, pg8::S5Order, true, true>(c.lds, g, S, E);
    }
    __syncthreads();
    rwkv_phaseC(c);
}

__device__ __forceinline__ void phase8(const Ctx& c) {
    pg8::Gemm g{(const bf16_t*)(c.ws + WS_YS5), (const bf16_t*)(c.ws + WS_WGLU_T), T, 512, 512};
    pg8::StaticOrder S; S.init(T, 512, c.G, c.bid);
    pg8::EpiGLU E{(const bf16_t*)(c.ws + WS_YS5), 512, c.in[29], (bf16_t*)(c.ws + WS_A), D, 512};
    pg8::gemm_phase<pg8::EpiGLU, pg8::StaticOrder, true, true>(c.lds, g, S, E);
}

__device__ __forceinline__ void phase9(const Ctx& c) {
    pg8::Gemm g{(const bf16_t*)(c.ws + WS_A), (const bf16_t*)(c.ws + WS_WOUT_T), T, D, D};
    pg8::StaticOrder S; S.init(T, D, c.G, c.bid);
    pg8::EpiF32 E{(float*)(c.ws + WS_PROJ), D};
    pg8::gemm_phase<pg8::EpiF32, pg8::StaticOrder, true, true>(c.lds, g, S, E);
}

__device__ __forceinline__ void phase10(const Ctx& c) {
    const float* x = c.in[0]; const float* gpm = c.in[5]; const float* gpf = c.in[6];
    const float* mods = (const float*)(c.ws + WS_MODS); const float* mixed = (const float*)(c.ws + WS_PROJ);
    bf16_t* h2 = (bf16_t*)(c.ws + WS_A); float* x1o = c.out;
    const int gw = c.bid * 8 + c.wid, NW = c.G * 8;
    for (int t = gw; t < T; t += NW) {
        const int b = t / SEQ;
        const float4* mr = (const float4*)(mixed + (size_t)t * D) + c.lane;
        const float4* xr = (const float4*)(x + (size_t)t * D) + c.lane;
        float4 m[4], v[4]; float ss = 0.f;
#pragma unroll
        for (int j = 0; j < 4; ++j) { m[j] = mr[64 * j]; v[j] = xr[64 * j]; ss += m[j].x * m[j].x + m[j].y * m[j].y + m[j].z * m[j].z + m[j].w * m[j].w; }
        const float rstd = rsqrtf(wave_sum(ss) * (1.0f / D) + 1e-6f);
        float s1 = 0.f;
#pragma unroll
        for (int j = 0; j < 4; ++j) {
            const int k = (c.lane + 64 * j) * 4;
            const float4 gg = *(const float4*)(gpm + k);
            const float4 gt = *(const float4*)(mods + b * NMODS + 2 * D + k);
            v[j].x += gt.x * (m[j].x * rstd * gg.x); v[j].y += gt.y * (m[j].y * rstd * gg.y);
            v[j].z += gt.z * (m[j].z * rstd * gg.z); v[j].w += gt.w * (m[j].w * rstd * gg.w);
            s1 += v[j].x * v[j].x + v[j].y * v[j].y + v[j].z * v[j].z + v[j].w * v[j].w;
            ((float4*)(x1o + (size_t)t * D) + c.lane)[64 * j] = v[j];
        }
        const float rstd1 = rsqrtf(wave_sum(s1) * (1.0f / D) + 1e-6f);
#pragma unroll
        for (int j = 0; j < 4; ++j) {
            const int k = (c.lane + 64 * j) * 4;
            const float4 gg = *(const float4*)(gpf + k);
            const float4 sh = *(const float4*)(mods + b * NMODS + 3 * D + k);
            const float4 sc = *(const float4*)(mods + b * NMODS + 4 * D + k);
            float r[4];
            r[0] = v[j].x * rstd1 * gg.x * (1.f + sc.x) + sh.x; r[1] = v[j].y * rstd1 * gg.y * (1.f + sc.y) + sh.y;
            r[2] = v[j].z * rstd1 * gg.z * (1.f + sc.z) + sh.z; r[3] = v[j].w * rstd1 * gg.w * (1.f + sc.w) + sh.w;
            unsigned hi[4]; float lo[4];
#pragma unroll
            for (int q = 0; q < 4; ++q) { hi[q] = f2bf(r[q]); lo[q] = r[q] - bf2f(hi[q]); }
            ((uint2*)(h2 + (size_t)t * D) + c.lane)[64 * j] = make_uint2(hi[0] | (hi[1] << 16), hi[2] | (hi[3] << 16));
            ((uint2*)(h2 + (size_t)(T + t) * D) + c.lane)[64 * j] = make_uint2(pk2(lo[0], lo[1]), pk2(lo[2], lo[3]));
        }
    }
}

__device__ __forceinline__ void phase11(const Ctx& c) {
    {
        pg8::Gemm g{(const bf16_t*)(c.ws + WS_A), (const bf16_t*)(c.ws + WS_WR_T), 2 * T, 512, D};
        pg8::StaticOrder S; S.init(2 * T, 512, c.G, c.bid);
        pg8::EpiF32 E{(float*)(c.ws + WS_PLOG), 512};
        pg8::gemm_phase<pg8::EpiF32, pg8::StaticOrder, true, true>(c.lds, g, S, E);
    }
    __syncthreads();
    {
        pg8::Gemm g{(const bf16_t*)(c.ws + WS_A), (const bf16_t*)(c.ws + WS_WSGU_T), T, 512, D};
        pg8::StaticOrder S; S.init(T, 512, c.G, c.bid);
        pg8::EpiSwiGLU E{(bf16_t*)(c.ws + WS_HS), 256};
        pg8::gemm_phase<pg8::EpiSwiGLU, pg8::StaticOrder, true, true>(c.lds, g, S, E);
    }
}

#define DPPU(v, ctrl) ((unsigned)__builtin_amdgcn_mov_dpp((int)(v), (ctrl), 0xf, 0xf, true))
#define DPPF(v, ctrl) __builtin_bit_cast(float, __builtin_amdgcn_mov_dpp(__builtin_bit_cast(int, (v)), (ctrl), 0xf, 0xf, true))
__device__ __forceinline__ unsigned fkey(float f) { const unsigned u = __builtin_bit_cast(unsigned, f); return u ^ ((u >> 31) ? 0xffffffffu : 0x80000000u); }
__device__ __forceinline__ unsigned wave_umax(unsigned v) {
    v = max(v, DPPU(v, 0xB1)); v = max(v, DPPU(v, 0x4E)); v = max(v, DPPU(v, 0x141)); v = max(v, DPPU(v, 0x140));
    const unsigned a = __builtin_amdgcn_readlane(v, 0), b = __builtin_amdgcn_readlane(v, 16), c = __builtin_amdgcn_readlane(v, 32), d = __builtin_amdgcn_readlane(v, 48);
    return max(max(a, b), max(c, d));
}
__device__ __forceinline__ unsigned wave_umin(unsigned v) {
    v = min(v, DPPU(v, 0xB1)); v = min(v, DPPU(v, 0x4E)); v = min(v, DPPU(v, 0x141)); v = min(v, DPPU(v, 0x140));
    const unsigned a = __builtin_amdgcn_readlane(v, 0), b = __builtin_amdgcn_readlane(v, 16), c = __builtin_amdgcn_readlane(v, 32), d = __builtin_amdgcn_readlane(v, 48);
    return min(min(a, b), min(c, d));
}
__device__ __forceinline__ void phase12(const Ctx& c) {
    const float* plog = (const float*)(c.ws + WS_PLOG); const float* rb = c.in[32];
    int* idx = (int*)(c.ws + WS_IDX); float* wt = (float*)(c.ws + WS_WT);
    LAS int* lhist = (LAS int*)c.lds;
    __syncthreads();
    if (c.tid < NE) lhist[c.tid] = 0;
    __syncthreads();
    const int gw = c.bid * 8 + c.wid, NW = c.G * 8, l = c.lane;
    const float4 bias = *(const float4*)(rb + l * 4);
    for (int t = gw; t < T; t += NW) {
        const float4 p0 = *(const float4*)(plog + (size_t)t * 512 + l * 4), p1 = *(const float4*)(plog + (size_t)t * 512 + 256 + l * 4);
        const float4 p2 = *(const float4*)(plog + (size_t)(T + t) * 512 + l * 4), p3 = *(const float4*)(plog + (size_t)(T + t) * 512 + 256 + l * 4);
        const float lg[4] = {p0.x + (p1.x + p2.x + p3.x), p0.y + (p1.y + p2.y + p3.y), p0.z + (p1.z + p2.z + p3.z), p0.w + (p1.w + p2.w + p3.w)};
        float s[4] = {sigmoidf_(lg[0]), sigmoidf_(lg[1]), sigmoidf_(lg[2]), sigmoidf_(lg[3])};
        float ch[4] = {s[0] + bias.x, s[1] + bias.y, s[2] + bias.z, s[3] + bias.w};
        float a1 = fmaxf(ch[0], ch[1]), a2 = fminf(ch[0], ch[1]);
        { const float b1 = fmaxf(ch[2], ch[3]), b2 = fminf(ch[2], ch[3]); const float n1 = fmaxf(a1, b1), n2 = fmaxf(fminf(a1, b1), fmaxf(a2, b2)); a1 = n1; a2 = n2; }
        { const float b1 = DPPF(a1, 0xB1), b2 = DPPF(a2, 0xB1); const float n1 = fmaxf(a1, b1), n2 = fmaxf(fminf(a1, b1), fmaxf(a2, b2)); a1 = n1; a2 = n2; }
        { const float b1 = DPPF(a1, 0x4E), b2 = DPPF(a2, 0x4E); const float n1 = fmaxf(a1, b1), n2 = fmaxf(fminf(a1, b1), fmaxf(a2, b2)); a1 = n1; a2 = n2; }
        { const float b1 = DPPF(a1, 0x141), b2 = DPPF(a2, 0x141); const float n1 = fmaxf(a1, b1), n2 = fmaxf(fminf(a1, b1), fmaxf(a2, b2)); a1 = n1; a2 = n2; }
        const float gs = a1 + a2; const int myg = l >> 3;
        int rank = 0;
#pragma unroll
        for (int g = 0; g < 8; ++g) { const float og = __builtin_bit_cast(float, __builtin_amdgcn_readlane(__builtin_bit_cast(int, gs), g * 8)); rank += (og > gs || (og == gs && g < myg)) ? 1 : 0; }
        const bool sel = rank < 4;
        unsigned mk[4];
#pragma unroll
        for (int i = 0; i < 4; ++i) mk[i] = sel ? fkey(ch[i]) : 0u;
        float sk[8]; int ek[8]; float ssum = 0.f;
#pragma unroll
        for (int k = 0; k < 8; ++k) {
            const unsigned lm = max(max(mk[0], mk[1]), max(mk[2], mk[3]));
            const unsigned m = wave_umax(lm);
            unsigned cand = 1023u;
#pragma unroll
            for (int i = 3; i >= 0; --i) if (mk[i] == m) cand = (unsigned)(l * 4 + i);
            const int be = (int)wave_umin(cand);
            const int ii = be & 3;
            float sv = s[0]; sv = (ii == 1) ? s[1] : sv; sv = (ii == 2) ? s[2] : sv; sv = (ii == 3) ? s[3] : sv;
            sv = __builtin_bit_cast(float, __builtin_amdgcn_readlane(__builtin_bit_cast(int, sv), be >> 2));
            if ((be >> 2) == l) {
#pragma unroll
                for (int i = 0; i < 4; ++i) if (i == ii) mk[i] = 0u;
            }
            sk[k] = sv; ek[k] = be; ssum += sv;
        }
        if (l == 0) {
            const float inv = 2.5f / ssum;
#pragma unroll
            for (int k = 0; k < 8; ++k) { idx[t * 8 + k] = ek[k]; wt[t * 8 + k] = sk[k] * inv; __hip_atomic_fetch_add(lhist + ek[k], 1, __ATOMIC_RELAXED, __HIP_MEMORY_SCOPE_WORKGROUP); }
        }
    }
    __syncthreads();
    if (c.tid < NE) ((int*)(c.ws + WS_HIST))[c.bid * NE + c.tid] = lhist[c.tid];
}

__device__ __forceinline__ void phase13(const Ctx& c) {
    int* smi = (int*)c.sm;
    const int* hist = (const int*)(c.ws + WS_HIST);
    __syncthreads();
    if (c.tid < NE) {
        int tot = 0, base = 0;
        for (int bb = 0; bb < c.G; ++bb) { const int v = hist[bb * NE + c.tid]; tot += v; base += (bb < c.bid) ? v : 0; }
        smi[600 + c.tid] = tot; smi[900 + c.tid] = base; smi[1200 + c.tid] = 0; smi[300 + c.tid] = (tot + 255) >> 8;
    }
    __syncthreads();
    if (c.tid < 64) {
        const int l = c.tid; const int u0 = smi[300 + l * 4], u1 = smi[300 + l * 4 + 1], u2 = smi[300 + l * 4 + 2], u3 = smi[300 + l * 4 + 3];
        const int tot = u0 + u1 + u2 + u3; int inc = tot;
#pragma unroll
        for (int o = 1; o < 64; o <<= 1) { const int v = __shfl_up(inc, o); if (l >= o) inc += v; }
        const int ex = inc - tot;
        smi[l * 4] = ex; smi[l * 4 + 1] = ex + u0; smi[l * 4 + 2] = ex + u0 + u1; smi[l * 4 + 3] = ex + u0 + u1 + u2;
        if (l == 63) smi[NE] = inc;
    }
    __syncthreads();
    const int* idx = (const int*)(c.ws + WS_IDX); int* slotp = (int*)(c.ws + WS_SLOTP); int* uexp = (int*)(c.ws + WS_UEXP); int* slotw = (int*)(c.ws + WS_SLOTW); const float* wt = (const float*)(c.ws + WS_WT);
    const int gw = c.bid * 8 + c.wid, NW = c.G * 8;
    for (int t = gw; t < T; t += NW) {
        if (c.lane < 8) {
            const int a = t * 8 + c.lane, e = idx[a];
            const int pos = smi[900 + e] + __hip_atomic_fetch_add(smi + 1200 + e, 1, __ATOMIC_RELAXED, __HIP_MEMORY_SCOPE_WORKGROUP);
            const int slot = smi[e] * 256 + pos;
            slotp[slot] = a;
            *(int2*)(slotw + 2 * (size_t)slot) = make_int2(a, __float_as_int(wt[a]));
        }
    }
    const int gt = c.bid * 512 + c.tid, NT = c.G * 512;
    for (int e = gt; e < NE; e += NT) {
        const int u0 = smi[e], u1 = smi[e + 1], cn = smi[600 + e];
        for (int p = cn; p < (u1 - u0) * 256; ++p) { slotp[u0 * 256 + p] = -1; *(int2*)(slotw + 2 * (size_t)(u0 * 256 + p)) = make_int2(-1, 0); }
        for (int u = u0; u < u1; ++u) uexp[u] = e;
    }
    if (gt == 0) uexp[2048] = smi[NE];
}

__device__ __forceinline__ void phase14(const Ctx& c) {
    const int* uexp = (const int*)(c.ws + WS_UEXP);
    const int NU = __builtin_amdgcn_readfirstlane(uexp[2048]);
    const int vcu = (c.G % 8 == 0) ? (c.bid % 8) * (c.G / 8) + c.bid / 8 : c.bid;
    pg8::Gemm g{(const bf16_t*)(c.ws + WS_A), (const bf16_t*)(c.ws + WS_WEGU), 0, 0, D, (const int*)(c.ws + WS_SLOTP)};
    pg8::ExpertOrder S{uexp, NU, 2, c.G, vcu};
    pg8::EpiSwiGLU E{(bf16_t*)(c.ws + WS_HID), 256};
    pg8::gemm_phase<pg8::EpiSwiGLU, pg8::ExpertOrder, true, true, true>(c.lds, g, S, E);
}

__device__ __forceinline__ void phase15(const Ctx& c) {
    {
        const int* uexp = (const int*)(c.ws + WS_UEXP);
        const int NU = __builtin_amdgcn_readfirstlane(uexp[2048]);
        const int vcu = (c.G % 8 == 0) ? (c.bid % 8) * (c.G / 8) + c.bid / 8 : c.bid;
        pg8::Gemm g{(const bf16_t*)(c.ws + WS_HID), (const bf16_t*)(c.ws + WS_WED), 0, 0, EFF};
        pg8::ExpertOrder S{uexp, NU, 4, c.G, vcu};
        pg8::EpiScatter E{(const int*)(c.ws + WS_SLOTW), (bf16_t*)(c.ws + WS_YEXP), D};
        pg8::gemm_phase<pg8::EpiScatter, pg8::ExpertOrder, true, true>(c.lds, g, S, E);
    }
    __syncthreads();
    {
        pg8::Gemm g{(const bf16_t*)(c.ws + WS_HS), (const bf16_t*)(c.ws + WS_WSD_T), T, D, 256};
        pg8::StaticOrder S; S.init(T, D, c.G, c.bid);
        pg8::EpiF32 E{(float*)(c.ws + WS_SHOUT), D};
        pg8::gemm_phase<pg8::EpiF32, pg8::StaticOrder, true, true>(c.lds, g, S, E);
    }
}

__device__ __forceinline__ void phase16(const Ctx& c) {
    const float* gq = c.in[7]; const float* mods = (const float*)(c.ws + WS_MODS);
    const float* shout = (const float*)(c.ws + WS_SHOUT); const bf16_t* yexp = (const bf16_t*)(c.ws + WS_YEXP);
    float* out = c.out; float* dst = c.dry ? (float*)(c.ws + WS_PROJ) : c.out;
    const int gw = c.bid * 8 + c.wid, NW = c.G * 8;
    for (int t = gw; t < T; t += NW) {
        const int b = t / SEQ;
        float4 y[4]; float ss = 0.f;
#pragma unroll
        for (int j = 0; j < 4; ++j) {
            const int k = (c.lane + 64 * j) * 4;
            float4 a = *(const float4*)(shout + (size_t)t * D + k);
#pragma unroll
            for (int q = 0; q < 8; ++q) {
                const float4 v = ldbf4(yexp + (size_t)(t * 8 + q) * D + k);
                a.x += v.x; a.y += v.y; a.z += v.z; a.w += v.w;
            }
            y[j] = a; ss += a.x * a.x + a.y * a.y + a.z * a.z + a.w * a.w;
        }
        const float rstd = rsqrtf(wave_sum(ss) * (1.0f / D) + 1e-6f);
#pragma unroll
        for (int j = 0; j < 4; ++j) {
            const int k = (c.lane + 64 * j) * 4;
            const float4 gg = *(const float4*)(gq + k);
            const float4 gt = *(const float4*)(mods + b * NMODS + 5 * D + k);
            float4 x1 = *(const float4*)(out + (size_t)t * D + k);
            x1.x += gt.x * (y[j].x * rstd * gg.x); x1.y += gt.y * (y[j].y * rstd * gg.y);
            x1.z += gt.z * (y[j].z * rstd * gg.z); x1.w += gt.w * (y[j].w * rstd * gg.w);
            *(float4*)(dst + (size_t)t * D + k) = x1;
        }
    }
}

constexpr int NPHASES = 18;
__device__ __forceinline__ void probe_reset(const Ctx& c, int k) {
    unsigned* counts = (unsigned*)(c.ws + WS_COUNTS);
    if (k == 13 && c.bid == 0 && c.tid < 256) counts[c.tid] = 0u;
    if (k == 14 && c.bid == 0 && c.tid < 256) counts[256 + c.tid] = 0u;
}

__global__ void __launch_bounds__(512, 2) mega(Args args) {
    extern __shared__ __attribute__((aligned(16))) unsigned char lds_raw[];
    Ctx c;
    c.in = args.in; c.out = args.out; c.ws = args.ws;
    c.lds = (LAS unsigned char*)lds_raw; c.sm = (float*)lds_raw;
    c.dry = 0;
    c.tid = threadIdx.x; c.lane = c.tid & 63; c.wid = __builtin_amdgcn_readfirstlane(c.tid >> 6); c.bid = blockIdx.x; c.G = gridDim.x;
    volatile LAS unsigned* st = (volatile LAS unsigned*)(c.lds + LDS_CTL_OFF);
    if (c.tid < 4) st[c.tid] = 0u;
    __syncthreads();
    XcdBarrier bar; bar.bar = (unsigned*)(args.ws + WS_CTL); bar.x = 0; bar.st = st;
    const bool multi = (args.hi - args.lo) > 1;
    if (multi) bar = xcd_barrier_post((unsigned*)(args.ws + WS_CTL), st);
    const int lo = args.lo, hi = args.hi;
#ifndef REPEAT_PHASE
#define REPEAT_PHASE -1
#endif
#define LAUNDER() do { int t_ = threadIdx.x; asm volatile("" : "+v"(t_)); c.tid = t_; c.lane = t_ & 63; int b_ = blockIdx.x; asm volatile("" : "+s"(b_)); c.bid = b_; } while (0)
#define RUN_PHASE(k, call) if (lo <= (k) && (k) < hi) { if ((k) == REPEAT_PHASE) { LAUNDER(); c.dry = 1; call; c.dry = 0; xcd_barrier(bar); probe_reset(c, (k)); xcd_barrier(bar); } LAUNDER(); call; if ((k) + 1 < hi) xcd_barrier(bar); }
    RUN_PHASE(0, phase0(c))
    RUN_PHASE(1, phase1(c))
    RUN_PHASE(2, phase2(c))
    RUN_PHASE(3, phase3(c))
    RUN_PHASE(4, phase4(c))
    RUN_PHASE(5, phase5(c))
    RUN_PHASE(6, phase6a(c))
    RUN_PHASE(7, phase6b(c))
    RUN_PHASE(8, phase7(c))
    RUN_PHASE(9, phase8(c))
    RUN_PHASE(10, phase9(c))
    RUN_PHASE(11, phase10(c))
    RUN_PHASE(12, phase11(c))
    RUN_PHASE(13, phase12(c))
    RUN_PHASE(14, phase13(c))
    RUN_PHASE(15, phase14(c))
    RUN_PHASE(16, phase15(c))
    RUN_PHASE(17, phase16(c))
#undef RUN_PHASE
}

#ifndef N_LAUNCH_MODE
#define N_LAUNCH_MODE 1
#endif

extern "C" void kernel_launch(void* const* d_in, const int* in_sizes, int n_in, void* d_out, int out_size, void* d_ws, size_t ws_size, hipStream_t stream) {
    static int grid = 0;
    if (grid == 0) {
        if (n_in != 39 || out_size != T * D || ws_size < WS_END) { fprintf(stderr, "kernel_launch: unexpected shapes n_in %d out %d ws %zu\n", n_in, out_size, ws_size); grid = -1; return; }
        int dev = 0, cus = 0, per_cu = 0;
        if (hipGetDevice(&dev) != hipSuccess || hipDeviceGetAttribute(&cus, hipDeviceAttributeMultiprocessorCount, dev) != hipSuccess) { grid = -1; return; }
        if (hipFuncSetAttribute((const void*)mega, hipFuncAttributeMaxDynamicSharedMemorySize, LDS_BYTES) != hipSuccess) { grid = -1; return; }
        if (hipOccupancyMaxActiveBlocksPerMultiprocessor(&per_cu, (const void*)mega, 512, LDS_BYTES) != hipSuccess || per_cu < 1) { fprintf(stderr, "kernel_launch: occupancy query says %d\n", per_cu); }
        (void)hipGetLastError();
        grid = cus;
    }
    if (grid < 0) return;
    (void)hipMemsetAsync((char*)d_ws + WS_CTL, 0, CTL_BYTES, stream);
    Args a{};
    for (int i = 0; i < 39; ++i) a.in[i] = (const float*)d_in[i];
    a.out = (float*)d_out; a.ws = (unsigned char*)d_ws;
    if (N_LAUNCH_MODE == 1) {
        a.lo = 0; a.hi = NPHASES;
        hipLaunchKernelGGL(mega, dim3(grid), dim3(512), LDS_BYTES, stream, a);
    } else {
        for (int ph = 0; ph < NPHASES; ++ph) {
            a.lo = ph; a.hi = ph + 1;
            hipLaunchKernelGGL(mega, dim3(grid), dim3(512), LDS_BYTES, stream, a);
        }
    }
}
```

```cpp
#include <hip/hip_runtime.h>
#include <cstdint>
#include <cstdio>

#define LAS __attribute__((address_space(3)))

constexpr int D = 1024, BATCH = 4, SEQ = 8192, T = BATCH * SEQ;
constexpr int RW = 512, NH = 8;
constexpr int RPROJ = 1792, NPROJ = 2304;
constexpr int S5NG = 32, S5P = 64;
constexpr int NE = 256, EFF = 256;
constexpr int NMODS = 6 * D;
constexpr int S5L = 32;

constexpr size_t MiB = 1u << 20;
constexpr size_t WS_CTL = 0, CTL_BYTES = 1 * MiB;
constexpr size_t WS_COUNTS = 64 * 1024;
constexpr size_t WS_MODS = 1 * MiB;
constexpr size_t WS_HMAT = 2 * MiB;
constexpr size_t WS_WIN_T = 12 * MiB;
constexpr size_t WS_WOUT_T = 17 * MiB;
constexpr size_t WS_WGLU_T = 19 * MiB;
constexpr size_t WS_WSGU_T = 19 * MiB + 512 * 1024;
constexpr size_t WS_WSD_T = 20 * MiB + 512 * 1024;
constexpr size_t WS_WR_T = 21 * MiB;
constexpr size_t WS_LORA_BT = 22 * MiB;
constexpr size_t WS_APOW = 23 * MiB;
constexpr size_t WS_KMAT = 1000 * MiB;
constexpr size_t WS_MODSP = 1020 * MiB;
constexpr size_t WS_S5BB = 1022 * MiB;
constexpr size_t WS_KLAG = 1022 * MiB + 512 * 1024;
constexpr size_t OUT_UX = 0;
constexpr size_t OUT_E = 40 * MiB;
constexpr size_t OUT_ALORA = 56 * MiB;
constexpr size_t OUT_KF = 72 * MiB;
constexpr size_t WS_WED = 24 * MiB;
constexpr size_t WS_WEGU = 152 * MiB;
constexpr size_t WS_A = 408 * MiB;
constexpr size_t WS_YS5 = WS_A + 64 * MiB;
constexpr size_t WS_PROJ = 536 * MiB;
constexpr size_t WS_RW = 680 * MiB;
constexpr size_t RWSZ = (size_t)T * RW * 4;
constexpr size_t RWSZH = (size_t)T * RW * 2;
constexpr size_t WS_RW_W = WS_RW, WS_RW_Y = WS_RW + RWSZ, WS_RW_R = WS_RW + 2 * RWSZ, WS_RW_K = WS_RW_R + RWSZH, WS_RW_V = WS_RW_K + RWSZH,
                 WS_RW_A = WS_RW_V + RWSZH, WS_RW_B = WS_RW_A + RWSZH, WS_RW_G = WS_RW_B + RWSZH;
constexpr size_t WS_CM = WS_PROJ, WS_CN = WS_PROJ + 32 * MiB, WS_CQ = WS_PROJ + 64 * MiB, WS_CY = WS_PROJ + 96 * MiB;
constexpr size_t WS_CS = WS_RW_Y, WS_CBON = WS_RW_Y + 32 * MiB;
constexpr size_t WS_PLOG = 680 * MiB;
constexpr size_t WS_SHOUT = 680 * MiB;
constexpr size_t WS_HS = 808 * MiB;
constexpr size_t WS_IDX = 824 * MiB;
constexpr size_t WS_WT = 825 * MiB;
constexpr size_t WS_SLOTP = 826 * MiB;
constexpr size_t WS_UEXP = 827 * MiB + 512 * 1024;
constexpr size_t WS_SLOTW = 828 * MiB;
constexpr size_t WS_HIST = 831 * MiB;
constexpr size_t WS_HID = 840 * MiB;
constexpr size_t WS_YEXP = 152 * MiB;
constexpr size_t WS_END = 1023 * MiB + 512 * 1024;

constexpr int LDS_BYTES = 132096;
constexpr int LDS_CTL_OFF = 131072;

#define XB_TMO      128
#define XB_XCNT(j)  (256  + 64 * (j))
#define XB_XSUB(j)  (1280 + 64 * (j))
#define XB_XGEN(j)  (2304 + 64 * (j))
#define XB_TOP      3328
#define XB_TOPGEN   3392
#define XCD_BAR_WORDS 3456
#define XB_SPIN_CAP (1u << 24)

__device__ __forceinline__ unsigned xb_ld(unsigned* p)              { return __hip_atomic_load(p, __ATOMIC_RELAXED, __HIP_MEMORY_SCOPE_AGENT); }
__device__ __forceinline__ unsigned xb_add(unsigned* p, unsigned v) { return __hip_atomic_fetch_add(p, v, __ATOMIC_RELAXED, __HIP_MEMORY_SCOPE_AGENT); }
__device__ __forceinline__ unsigned xb_xcc_id() { return (unsigned)__builtin_amdgcn_s_getreg((3 << 11) | 20) & 0xFu; }
#define XB_SPIN(cond, bar) do { unsigned _sp = 0; while (cond) { __builtin_amdgcn_s_sleep(1); \
    if ((++_sp & 255u) == 0u) { if (xb_ld(&(bar)[XB_TMO])) break; if (_sp > XB_SPIN_CAP) { atomicAdd(&(bar)[XB_TMO], 1u); break; } } } } while (0)

struct XcdBarrier { unsigned* bar; unsigned x; volatile LAS unsigned* st; };

__device__ __forceinline__ XcdBarrier xcd_barrier_post(unsigned* bar, volatile LAS unsigned* st) {
    XcdBarrier b; b.bar = bar; b.x = xb_xcc_id(); b.st = st;
    if (threadIdx.x == 0) (void)xb_add(&bar[XB_XCNT(b.x)], 1u);
    return b;
}
__device__ __forceinline__ void xcd_barrier_complete(unsigned* bar, unsigned x, unsigned& nloc, unsigned& nx) {
    const unsigned G = gridDim.x * gridDim.y * gridDim.z;
    unsigned sum, cnt, mine, sp = 0u;
    for (;;) {
        sum = 0u; cnt = 0u; mine = 0u;
#pragma unroll
        for (unsigned j = 0; j < 16; ++j) { const unsigned c = xb_ld(&bar[XB_XCNT(j)]); sum += c; cnt += (c > 0u) ? 1u : 0u; mine = (j == x) ? c : mine; }
        if (sum == G) break;
        __builtin_amdgcn_s_sleep(1);
        if ((++sp & 255u) == 0u) { if (xb_ld(&bar[XB_TMO])) break; if (sp > XB_SPIN_CAP) { atomicAdd(&bar[XB_TMO], 1u); break; } }
    }
    nloc = mine > 0u ? mine : 1u; nx = cnt > 0u ? cnt : 1u;
}
__device__ __forceinline__ void xcd_barrier(const XcdBarrier& b) {
    asm volatile("s_waitcnt vmcnt(0)" ::: "memory");
    __syncthreads();
    if (threadIdx.x == 0) {
        unsigned* bar = b.bar;
        __builtin_amdgcn_s_waitcnt(0);
        unsigned nloc = b.st[0], nx = b.st[1];
        if (nloc == 0u) { xcd_barrier_complete(bar, b.x, nloc, nx); b.st[0] = nloc; b.st[1] = nx; }
        const unsigned old = xb_add(&bar[XB_XSUB(b.x)], 1u);
        const unsigned gen = old / nloc;
        if (old + 1u == (gen + 1u) * nloc) {
            __builtin_amdgcn_fence(__ATOMIC_RELEASE, "agent");
            asm volatile("s_waitcnt vmcnt(0)" ::: "memory");
            const unsigned og = xb_add(&bar[XB_TOP], 1u);
            const unsigned tg = og / nx;
            if (og + 1u == (tg + 1u) * nx) xb_add(&bar[XB_TOPGEN], 1u);
            else XB_SPIN(xb_ld(&bar[XB_TOPGEN]) == tg, bar);
            __builtin_amdgcn_fence(__ATOMIC_ACQUIRE, "agent");
            xb_add(&bar[XB_XGEN(b.x)], 1u);
            asm volatile("s_waitcnt vmcnt(0)" ::: "memory");
        } else {
            XB_SPIN(xb_ld(&bar[XB_XGEN(b.x)]) == gen, bar);
            __builtin_amdgcn_fence(__ATOMIC_ACQUIRE, "agent");
            asm volatile("s_waitcnt vmcnt(0)" ::: "memory");
        }
    }
    __syncthreads();
}

namespace pg8 {
#define PG8_LAS __attribute__((address_space(3)))
typedef unsigned short bf16_t;
typedef short bf16x8 __attribute__((ext_vector_type(8)));
typedef float f32x4 __attribute__((ext_vector_type(4)));
typedef unsigned u32x4 __attribute__((ext_vector_type(4)));
constexpr int BM = 256, BK = 64, HALF = 128, HTB = HALF * BK * 2  , STAGE_BYTES = 8 * HTB, NXCD = 8, WGM = 8;

__host__ __device__ __forceinline__ int lds_byte(int r, int c) { const int st = (r >> 4) * 2 + (c >> 5), rr = r & 15, cc = c & 31, ob = rr * 64 + cc * 2; return st * 1024 + (ob ^ (((ob >> 9) & 1) << 5)); }
__host__ __device__ __forceinline__ void stage_rc(int b, int& R, int& C) { const int st = b / 1024, sb = b % 1024, swz = sb ^ (((sb >> 9) & 1) << 5); R = (st >> 1) * 16 + swz / 64; C = (st & 1) * 32 + (swz % 64) / 2; }
__host__ __device__ __forceinline__ int perm32(int rho) { const int n = rho >> 4, i = rho & 15; return 8 * (i >> 2) + 4 * n + (i & 3); }

struct Unit { int pm, pn; };
struct Gemm { const bf16_t* A; const bf16_t* Bt; int M, N, K; const int* rowtab = nullptr; };

struct StaticOrder {
    int nM, nN, nwg, G, c;
    __host__ __device__ void init(int M, int N, int G_, int c_) { nM = M / BM; nN = N / BM; nwg = nM * nN; G = G_; c = c_; }
    __host__ __device__ bool next(int i, Unit& u) const {
        const long L = (long)i * G + c; if (L >= nwg) return false;
        int wgid = (int)L; { const int q = nwg / NXCD, r = nwg % NXCD, xcd = wgid % NXCD, off = wgid / NXCD; wgid = (xcd < r ? xcd * (q + 1) : r * (q + 1) + (xcd - r) * q) + off; }
        const int nig = WGM * nN, gid = wgid / nig, fm = gid * WGM, gsz = (nM - fm) < WGM ? (nM - fm) : WGM;
        u.pm = fm + ((wgid % nig) % gsz); u.pn = (wgid % nig) / gsz; return true;
    }
    __device__ __forceinline__ void a_ready(const Unit&) const {}
    __device__ __forceinline__ void done(const Unit&) const {}
};

__device__ __forceinline__ unsigned cvt_pk_bf16(float lo, float hi) { unsigned r; asm volatile("v_cvt_pk_bf16_f32 %0, %1, %2" : "=v"(r) : "v"(lo), "v"(hi)); return r; }
typedef float f32x2 __attribute__((ext_vector_type(2)));
__device__ __forceinline__ f32x2 gelu_pk(f32x2 v) {
    const f32x2 av = __builtin_elementwise_abs(v), d = av * 0.2316418882f + 1.0f;
    f32x2 t; t.x = __builtin_amdgcn_rcpf(d.x); t.y = __builtin_amdgcn_rcpf(d.y);
    f32x2 q = t * 0.5307027145f + (-0.7265760135f); q = q * t + 0.7107068705f; q = q * t + (-0.142248368f); q = q * t + 0.127414796f; q = q * t;
    const f32x2 s = (v * v) * (-0.72134752044f);
    f32x2 e; e.x = __builtin_amdgcn_exp2f(s.x); e.y = __builtin_amdgcn_exp2f(s.y);
    const f32x2 m = v * (q * e), r = v - m;
    f32x2 o; o.x = v.x < 0.f ? m.x : r.x; o.y = v.y < 0.f ? m.y : r.y; return o;
}

template <int ACT  > struct EpiBf16 {
    static constexpr bool PERM = true, AFTER_DRAIN = false; static_assert(ACT == 0 || ACT == 1, "EpiBf16: ACT is 0 (none) or 1 (gelu_pk)");
    bf16_t* O; int ldc; const float* bias; int split_cols; size_t split_stride; float scale0;
    __device__ __forceinline__ void operator()(const f32x4 (&acc)[2][2][4][2], const Unit& u, int wr, int wc, int fr, int fq) const {
        const int row0 = u.pm * BM + wr * 64 + fr; int colt = u.pn * BM; bf16_t* base = O;
        float sc = 1.f; if (split_cols) { const int t = colt / split_cols; base += (size_t)t * split_stride; colt -= t * split_cols; if (t == 0) sc = scale0; }
        const int col0 = colt + wc * 32 + 8 * fq, bcol0 = u.pn * BM + wc * 32 + 8 * fq;
        f32x4 bv[2][2];
#pragma unroll
        for (int bj = 0; bj < 2; ++bj)
#pragma unroll
            for (int n = 0; n < 2; ++n) bv[bj][n] = bias ? *(const f32x4*)(bias + bcol0 + bj * HALF + 4 * n) : (f32x4){0.f, 0.f, 0.f, 0.f};
#pragma unroll
        for (int ai = 0; ai < 2; ++ai)
#pragma unroll
            for (int m = 0; m < 4; ++m) { bf16_t* rowp = base + (size_t)(row0 + ai * HALF + m * 16) * ldc + col0;
#pragma unroll
                for (int bj = 0; bj < 2; ++bj) { f32x4 v0 = acc[ai][bj][m][0] + bv[bj][0], v1 = acc[ai][bj][m][1] + bv[bj][1];
                    if (ACT == 1) { f32x2 a = gelu_pk((f32x2){v0[0], v0[1]}), b = gelu_pk((f32x2){v0[2], v0[3]}), c = gelu_pk((f32x2){v1[0], v1[1]}), d = gelu_pk((f32x2){v1[2], v1[3]});
                        v0 = (f32x4){a.x, a.y, b.x, b.y}; v1 = (f32x4){c.x, c.y, d.x, d.y}; }
                    v0 = v0 * sc; v1 = v1 * sc; u32x4 w; w.x = cvt_pk_bf16(v0[0], v0[1]); w.y = cvt_pk_bf16(v0[2], v0[3]); w.z = cvt_pk_bf16(v1[0], v1[1]); w.w = cvt_pk_bf16(v1[2], v1[3]);
                    *(u32x4*)(rowp + bj * HALF) = w; } }
    }
};

struct EpiF32 {
    static constexpr bool PERM = false, AFTER_DRAIN = false;
    float* C; int ldc;
    __device__ __forceinline__ void operator()(const f32x4 (&acc)[2][2][4][2], const Unit& u, int wr, int wc, int fr, int fq) const {
        const int row0 = u.pm * BM + wr * 64 + fr, col0 = u.pn * BM + wc * 32 + 4 * fq;
#pragma unroll
        for (int ai = 0; ai < 2; ++ai)
#pragma unroll
            for (int m = 0; m < 4; ++m) { float* rowp = C + (size_t)(row0 + ai * HALF + m * 16) * ldc + col0;
#pragma unroll
                for (int bj = 0; bj < 2; ++bj)
#pragma unroll
                    for (int n = 0; n < 2; ++n) *(f32x4*)(rowp + bj * HALF + n * 16) = acc[ai][bj][m][n]; }
    }
};
__device__ __forceinline__ float fast_sigmoid(float x) { return __builtin_amdgcn_rcpf(1.0f + __builtin_amdgcn_exp2f(-1.4426950408889634f * x)); }
struct EpiSwiGLU {
    static constexpr bool PERM = true, AFTER_DRAIN = false;
    bf16_t* O; int ldo;
    __device__ __forceinline__ void operator()(const f32x4 (&acc)[2][2][4][2], const Unit& u, int wr, int wc, int fr, int fq) const {
        const int row0 = u.pm * BM + wr * 64 + fr, col0 = (u.pn & 1) * HALF + wc * 32 + 8 * fq;
#pragma unroll
        for (int ai = 0; ai < 2; ++ai)
#pragma unroll
            for (int m = 0; m < 4; ++m) {
                bf16_t* rowp = O + (size_t)(row0 + ai * HALF + m * 16) * ldo + col0;
                const f32x4 g0 = acc[ai][0][m][0], g1 = acc[ai][0][m][1], u0 = acc[ai][1][m][0], u1 = acc[ai][1][m][1];
                float r[8];
#pragma unroll
                for (int i = 0; i < 4; ++i) { r[i] = g0[i] * fast_sigmoid(g0[i]) * u0[i]; r[4 + i] = g1[i] * fast_sigmoid(g1[i]) * u1[i]; }
                u32x4 w; w.x = cvt_pk_bf16(r[0], r[1]); w.y = cvt_pk_bf16(r[2], r[3]); w.z = cvt_pk_bf16(r[4], r[5]); w.w = cvt_pk_bf16(r[6], r[7]);
                *(u32x4*)rowp = w;
            }
    }
};
struct EpiScatter {
    static constexpr bool PERM = true, AFTER_DRAIN = false;
    const int* slotw; bf16_t* Y; int ldy;
    __device__ __forceinline__ void operator()(const f32x4 (&acc)[2][2][4][2], const Unit& u, int wr, int wc, int fr, int fq) const {
        int t2 = threadIdx.x; asm volatile("" : "+v"(t2));
        const int fr2 = t2 & 15, fq2 = (t2 >> 4) & 3, wc2 = (t2 >> 6) & 3, wr2 = (t2 >> 8) & 1;
        const int col0 = (u.pn & 3) * BM + wc2 * 32 + 8 * fq2;
        const int rbase = u.pm * BM + wr2 * 64 + fr2;
        typedef int i32x2 __attribute__((ext_vector_type(2)));
        i32x2 rec[2][4];
#pragma unroll
        for (int ai = 0; ai < 2; ++ai)
#pragma unroll
            for (int m = 0; m < 4; ++m) rec[ai][m] = *(const i32x2*)(slotw + 2 * (size_t)(rbase + ai * HALF + m * 16));
#pragma unroll
        for (int ai = 0; ai < 2; ++ai)
#pragma unroll
            for (int m = 0; m < 4; ++m) {
                const int aid = rec[ai][m].x;
                if (aid >= 0) {
                    const int wbits = rec[ai][m].y;
                    const float w = __int_as_float(wbits);
                    bf16_t* rowp = Y + (size_t)aid * ldy + col0;
#pragma unroll
                    for (int bj = 0; bj < 2; ++bj) {
                        const f32x4 v0 = acc[ai][bj][m][0] * w, v1 = acc[ai][bj][m][1] * w;
                        u32x4 o; o.x = cvt_pk_bf16(v0[0], v0[1]); o.y = cvt_pk_bf16(v0[2], v0[3]); o.z = cvt_pk_bf16(v1[0], v1[1]); o.w = cvt_pk_bf16(v1[2], v1[3]);
                        *(u32x4*)(rowp + bj * HALF) = o;
                    }
                }
            }
    }
};
struct ExpertOrder {
    const int* uexp; int NU, npn, G, c;
    __device__ __forceinline__ bool next(int i, Unit& u) const {
        const int L = i * G + c; if (L >= NU * npn) return false;
        const int uu = L / npn, pl = L % npn;
        u.pm = uu; u.pn = __builtin_amdgcn_readfirstlane(uexp[uu]) * npn + pl; return true;
    }
    __device__ __forceinline__ void a_ready(const Unit&) const {}
    __device__ __forceinline__ void done(const Unit&) const {}
};
struct S5Order {
    int NUNITS, npn, G, c;
    __device__ __forceinline__ bool next(int i, Unit& u) const {
        const int L = i * G + c; if (L >= NUNITS) return false;
        u.pm = L / npn; u.pn = (u.pm >> 2) * npn + L % npn; return true;
    }
    __device__ __forceinline__ void a_ready(const Unit&) const {}
    __device__ __forceinline__ void done(const Unit&) const {}
};
struct EpiS5E {
    static constexpr bool PERM = false, AFTER_DRAIN = false;
    float* E;
    __device__ __forceinline__ void operator()(const f32x4 (&acc)[2][2][4][2], const Unit& u, int wr, int wc, int fr, int fq) const {
        const int row0 = u.pm * BM + wr * 64 + fr, col0 = wc * 32 + 4 * fq;
#pragma unroll
        for (int ai = 0; ai < 2; ++ai)
#pragma unroll
            for (int m = 0; m < 4; ++m) { float* rowp = E + (size_t)(row0 + ai * HALF + m * 16) * 128 + col0;
#pragma unroll
                for (int n = 0; n < 2; ++n) *(f32x4*)(rowp + n * 16) = acc[ai][0][m][n]; }
    }
};
struct EpiS5Out {
    static constexpr bool PERM = true, AFTER_DRAIN = false;
    bf16_t* Y;
    __device__ __forceinline__ void operator()(const f32x4 (&acc)[2][2][4][2], const Unit& u, int wr, int wc, int fr, int fq) const {
        const int g = u.pm >> 2;
#pragma unroll
        for (int ai = 0; ai < 2; ++ai)
#pragma unroll
            for (int m = 0; m < 4; ++m) {
                const int r = (u.pm & 3) * BM + ai * HALF + wr * 64 + m * 16 + fr, b = r >> 8, chunk = r & 255;
#pragma unroll
                for (int bj = 0; bj < 2; ++bj) {
                    const int colg = (u.pn & 1) * BM + bj * HALF + wc * 32 + 8 * fq, t = colg >> 4, c0 = colg & 15;
                    const f32x4 v0 = acc[ai][bj][m][0], v1 = acc[ai][bj][m][1];
                    float x[8] = {v0[0], v0[1], v0[2], v0[3], v1[0], v1[1], v1[2], v1[3]};
#pragma unroll
                    for (int i = 0; i < 8; ++i) { const float z = x[i]; x[i] = z * fast_sigmoid(1.5957691216057308f * (z + 0.044715f * z * z * z)); }
                    u32x4 w; w.x = cvt_pk_bf16(x[0], x[1]); w.y = cvt_pk_bf16(x[2], x[3]); w.z = cvt_pk_bf16(x[4], x[5]); w.w = cvt_pk_bf16(x[6], x[7]);
                    *(u32x4*)(Y + ((size_t)(b * 8192 + chunk * 32 + t)) * 512 + g * 16 + c0) = w;
                }
            }
    }
};
struct EpiLora {
    static constexpr bool PERM = true, AFTER_DRAIN = false;
    const float* w0; const float* a0; const float* k_a; float* W; const bf16_t* Kp; bf16_t* Kf; const bf16_t* A; bf16_t* B; bf16_t* Gt;
    __device__ __forceinline__ void operator()(const f32x4 (&acc)[2][2][4][2], const Unit& u, int wr, int wc, int fr, int fq) const {
        const int seg = u.pn >> 1;
#pragma unroll
        for (int bj = 0; bj < 2; ++bj) {
            const int nn = (u.pn & 1) * BM + bj * HALF + wc * 32 + 8 * fq;
            float p0[8], p1[8];
            if (seg == 0) { const f32x4 a = *(const f32x4*)(w0 + nn), b = *(const f32x4*)(w0 + nn + 4); p0[0] = a[0]; p0[1] = a[1]; p0[2] = a[2]; p0[3] = a[3]; p0[4] = b[0]; p0[5] = b[1]; p0[6] = b[2]; p0[7] = b[3]; }
            else if (seg == 1) { const f32x4 a = *(const f32x4*)(a0 + nn), b = *(const f32x4*)(a0 + nn + 4), cc = *(const f32x4*)(k_a + nn), d = *(const f32x4*)(k_a + nn + 4);
                p0[0] = a[0]; p0[1] = a[1]; p0[2] = a[2]; p0[3] = a[3]; p0[4] = b[0]; p0[5] = b[1]; p0[6] = b[2]; p0[7] = b[3];
                p1[0] = cc[0]; p1[1] = cc[1]; p1[2] = cc[2]; p1[3] = cc[3]; p1[4] = d[0]; p1[5] = d[1]; p1[6] = d[2]; p1[7] = d[3]; }
#pragma unroll
            for (int ai = 0; ai < 2; ++ai)
#pragma unroll
                for (int m = 0; m < 4; ++m) {
                    const size_t off = (size_t)(u.pm * BM + ai * HALF + wr * 64 + m * 16 + fr) * 512 + nn;
                    const f32x4 v0 = acc[ai][bj][m][0], v1 = acc[ai][bj][m][1];
                    const float x[8] = {v0[0], v0[1], v0[2], v0[3], v1[0], v1[1], v1[2], v1[3]};
                    if (seg == 0) {
                        float o[8];
#pragma unroll
                        for (int i = 0; i < 8; ++i) { const float wa = p0[i] + x[i];
                            const float sp = __logf(1.0f + __expf(-wa));
                            o[i] = __expf(-__expf(-sp - 0.5f)); }
                        *(f32x4*)(W + off) = (f32x4){o[0], o[1], o[2], o[3]}; *(f32x4*)(W + off + 4) = (f32x4){o[4], o[5], o[6], o[7]};
                    } else if (seg == 1) {
                        const u32x4 kv = *(const u32x4*)(Kp + off), av = *(const u32x4*)(A + off);
                        const float k[8] = {__builtin_bit_cast(float, kv.x << 16), __builtin_bit_cast(float, kv.x & 0xffff0000u), __builtin_bit_cast(float, kv.y << 16), __builtin_bit_cast(float, kv.y & 0xffff0000u),
                                            __builtin_bit_cast(float, kv.z << 16), __builtin_bit_cast(float, kv.z & 0xffff0000u), __builtin_bit_cast(float, kv.w << 16), __builtin_bit_cast(float, kv.w & 0xffff0000u)};
                        const float a[8] = {__builtin_bit_cast(float, av.x << 16), __builtin_bit_cast(float, av.x & 0xffff0000u), __builtin_bit_cast(float, av.y << 16), __builtin_bit_cast(float, av.y & 0xffff0000u),
                                            __builtin_bit_cast(float, av.z << 16), __builtin_bit_cast(float, av.z & 0xffff0000u), __builtin_bit_cast(float, av.w << 16), __builtin_bit_cast(float, av.w & 0xffff0000u)};
                        float kf[8], bo[8];
#pragma unroll
                        for (int i = 0; i < 8; ++i) { const float ic = fast_sigmoid(p0[i] + x[i]); kf[i] = k[i] * (1.0f + (ic - 1.0f) * p1[i]); bo[i] = -a[i] * ic; }
                        u32x4 w; w.x = cvt_pk_bf16(kf[0], kf[1]); w.y = cvt_pk_bf16(kf[2], kf[3]); w.z = cvt_pk_bf16(kf[4], kf[5]); w.w = cvt_pk_bf16(kf[6], kf[7]);
                        *(u32x4*)(Kf + off) = w;
                        w.x = cvt_pk_bf16(bo[0], bo[1]); w.y = cvt_pk_bf16(bo[2], bo[3]); w.z = cvt_pk_bf16(bo[4], bo[5]); w.w = cvt_pk_bf16(bo[6], bo[7]);
                        *(u32x4*)(B + off) = w;
                    } else {
                        u32x4 w; w.x = cvt_pk_bf16(x[0], x[1]); w.y = cvt_pk_bf16(x[2], x[3]); w.z = cvt_pk_bf16(x[4], x[5]); w.w = cvt_pk_bf16(x[6], x[7]);
                        *(u32x4*)(Gt + off) = w;
                    }
                }
        }
    }
};
struct EpiGLU {
    static constexpr bool PERM = true, AFTER_DRAIN = false;
    const bf16_t* Y; int ldy; const float* bias; bf16_t* O; int ldo; int ocol0;
    __device__ __forceinline__ void operator()(const f32x4 (&acc)[2][2][4][2], const Unit& u, int wr, int wc, int fr, int fq) const {
        const int row0 = u.pm * BM + wr * 64 + fr, col0 = u.pn * BM + wc * 32 + 8 * fq;
#pragma unroll
        for (int bj = 0; bj < 2; ++bj) {
            const f32x4 b0 = *(const f32x4*)(bias + col0 + bj * HALF), b1 = *(const f32x4*)(bias + col0 + bj * HALF + 4);
#pragma unroll
            for (int ai = 0; ai < 2; ++ai)
#pragma unroll
                for (int m = 0; m < 4; ++m) {
                    const size_t row = (size_t)(row0 + ai * HALF + m * 16);
                    const u32x4 yv = *(const u32x4*)(Y + row * ldy + col0 + bj * HALF);
                    const f32x4 z0 = acc[ai][bj][m][0] + b0, z1 = acc[ai][bj][m][1] + b1;
                    float y[8] = {__builtin_bit_cast(float, yv.x << 16), __builtin_bit_cast(float, yv.x & 0xffff0000u), __builtin_bit_cast(float, yv.y << 16), __builtin_bit_cast(float, yv.y & 0xffff0000u),
                                  __builtin_bit_cast(float, yv.z << 16), __builtin_bit_cast(float, yv.z & 0xffff0000u), __builtin_bit_cast(float, yv.w << 16), __builtin_bit_cast(float, yv.w & 0xffff0000u)};
                    float r[8];
#pragma unroll
                    for (int i = 0; i < 4; ++i) { r[i] = y[i] * fast_sigmoid(z0[i]); r[4 + i] = y[4 + i] * fast_sigmoid(z1[i]); }
                    u32x4 w; w.x = cvt_pk_bf16(r[0], r[1]); w.y = cvt_pk_bf16(r[2], r[3]); w.z = cvt_pk_bf16(r[4], r[5]); w.w = cvt_pk_bf16(r[6], r[7]);
                    *(u32x4*)(O + row * ldo + ocol0 + col0 + bj * HALF) = w;
                }
        }
    }
};
template <class Epi, class Sched, bool ALIGN_EPI = false, bool SP2 = false, bool GATHER = false>
__device__ __forceinline__ void gemm_phase(PG8_LAS unsigned char* lds, const Gemm g, const Sched& S, const Epi& E) {
    int tid_ = threadIdx.x; asm volatile("" : "+v"(tid_));
    const int tid = tid_, wid = __builtin_amdgcn_readfirstlane(tid >> 6), lane = tid & 63, wr = wid >> 2, wc = wid & 3, fr = lane & 15, fq = lane >> 4;
    const int K = g.K, nt = K / BK;
    unsigned voffA[2], voffB[2];
#pragma unroll
    for (int i = 0; i < 2; ++i) { int R, C; stage_rc(tid * 16 + i * 8192, R, C); const int Rb = Epi::PERM ? ((R & ~31) + perm32(R & 31)) : R;
        voffA[i] = (unsigned)(R * K + C) * 2u; voffB[i] = (unsigned)(Rb * K + C) * 2u; }
    const size_t kstep = (size_t)(BK * 2);
    const size_t hstep = (size_t)HALF * K * 2;
    const size_t tstep = 2 * hstep;
    const unsigned ldsw = (unsigned)wid * 1024u;
    const int aoff = lds_byte(wr * 64 + fr, fq * 8), boff = lds_byte(wc * 32 + fr, fq * 8);
#define PG8_SA(b, h) (((b) * 2 + (h)) * HTB)
#define PG8_SB(b, h) ((4 + (b) * 2 + (h)) * HTB)
#define PG8_STAGE(bufoff, gbase, voff) do { _Pragma("unroll") for (int _i = 0; _i < 2; ++_i) \
        __builtin_amdgcn_global_load_lds((const unsigned*)((const char*)(gbase) + (voff)[_i]), (PG8_LAS unsigned*)(lds + (bufoff) + ldsw + _i * 8192), 16, 0, 0); } while (0)
#define PG8_STAGE_A(bufoff, kptr, h, NEXTSEL) do { if constexpr (GATHER) { const unsigned _p = (NEXTSEL) ? gnxt[h] : gcur[h]; const unsigned _v[2] = { (_p & 0xffffu) * (unsigned)(2 * K) + gC2, (_p >> 16) * (unsigned)(2 * K) + gC2 }; PG8_STAGE(bufoff, kptr, _v); } \
        else { PG8_STAGE(bufoff, (kptr) + (h) * hstep, voffA); } } while (0)
#define PG8_LDA(dst, b, h) do { _Pragma("unroll") for (int m = 0; m < 4; ++m) _Pragma("unroll") for (int k = 0; k < 2; ++k) dst[m][k] = *(const PG8_LAS bf16x8*)(lds + PG8_SA(b, h) + aoff + m * 2048 + k * 1024); } while (0)
#define PG8_LDB(dst, b, h) do { _Pragma("unroll") for (int n = 0; n < 2; ++n) _Pragma("unroll") for (int k = 0; k < 2; ++k) dst[n][k] = *(const PG8_LAS bf16x8*)(lds + PG8_SB(b, h) + boff + n * 2048 + k * 1024); } while (0)
#define PG8_MMA(ai, bj, At, Bt) do { __builtin_amdgcn_s_setprio(1); _Pragma("unroll") for (int m = 0; m < 4; ++m) _Pragma("unroll") for (int n = 0; n < 2; ++n) _Pragma("unroll") for (int k = 0; k < 2; ++k) \
        acc[ai][bj][m][n] = __builtin_amdgcn_mfma_f32_16x16x32_bf16(Bt[n][k], At[m][k], acc[ai][bj][m][n], 0, 0, 0); __builtin_amdgcn_s_setprio(0); } while (0)
#define PG8_WAIT_V(n) asm volatile("s_waitcnt vmcnt(" #n ")" ::: "memory")
#define PG8_WAIT_L(n) asm volatile("s_waitcnt lgkmcnt(" #n ")" ::: "memory")
#define PG8_BAR __builtin_amdgcn_s_barrier()
#define PG8_SCHED __builtin_amdgcn_sched_barrier(0)
    unsigned gcur[2], gnxt[2], gC2 = 0;
    if constexpr (GATHER) { int R, C; stage_rc(tid * 16, R, C); gC2 = (unsigned)C * 2u; }
    auto load_gather = [&](int pm, unsigned (&dst)[2]) {
        int R, C; stage_rc(tid * 16, R, C);
#pragma unroll
        for (int h = 0; h < 2; ++h) { int a0 = g.rowtab[pm * BM + h * HALF + R], a1 = g.rowtab[pm * BM + h * HALF + R + 64]; a0 = a0 < 0 ? 0 : a0; a1 = a1 < 0 ? 0 : a1; dst[h] = (unsigned)(a0 >> 3) | ((unsigned)(a1 >> 3) << 16); }
    };
    Unit cur, nxt; int ui = 0;
    if (!S.next(0, cur)) return;
    f32x4 acc[2][2][4][2];
#pragma unroll
    for (int a = 0; a < 2; ++a)
#pragma unroll
        for (int b = 0; b < 2; ++b)
#pragma unroll
            for (int m = 0; m < 4; ++m)
#pragma unroll
                for (int n = 0; n < 2; ++n) acc[a][b][m][n] = (f32x4){0.f, 0.f, 0.f, 0.f};
    bf16x8 At[4][2], B0[2][2], B1[2][2];
    const char* cA = (const char*)g.A + (GATHER ? (size_t)0 : (size_t)cur.pm * tstep); const char* cB = (const char*)g.Bt + (size_t)cur.pn * tstep;
    if constexpr (GATHER) { load_gather(cur.pm, gcur); }
    S.a_ready(cur);
    if constexpr (SP2) {
        PG8_STAGE(PG8_SB(0, 0), cB, voffB); PG8_STAGE(PG8_SB(0, 1), cB + hstep, voffB); PG8_STAGE_A(PG8_SA(0, 0), cA, 0, false); PG8_STAGE_A(PG8_SA(0, 1), cA, 1, false);
        if (wr == 1) PG8_BAR;
        PG8_WAIT_V(2); PG8_BAR;
        PG8_STAGE(PG8_SB(1, 0), cB + kstep, voffB); PG8_STAGE_A(PG8_SA(1, 0), cA + kstep, 0, false); PG8_STAGE(PG8_SB(1, 1), cB + hstep + kstep, voffB);
        PG8_WAIT_V(6); PG8_BAR;
    } else {
        PG8_STAGE(PG8_SB(0, 0), cB, voffB); PG8_STAGE_A(PG8_SA(0, 0), cA, 0, false); PG8_STAGE(PG8_SB(0, 1), cB + hstep, voffB); PG8_STAGE_A(PG8_SA(0, 1), cA, 1, false);
        if (wr == 1) PG8_BAR;
        PG8_WAIT_V(4); PG8_BAR;
        PG8_STAGE(PG8_SB(1, 0), cB + kstep, voffB); PG8_STAGE_A(PG8_SA(1, 0), cA + kstep, 0, false); PG8_STAGE(PG8_SB(1, 1), cB + hstep + kstep, voffB);
        PG8_WAIT_V(6); PG8_BAR;
    }
    for (;;) {
        const bool has_next = S.next(ui + 1, nxt);
        const char* nA = (has_next && !GATHER) ? (const char*)g.A + (size_t)nxt.pm * tstep : cA; const char* nB = has_next ? (const char*)g.Bt + (size_t)nxt.pn * tstep : cB;
        if constexpr (GATHER) { if (has_next) load_gather(nxt.pm, gnxt); else {
#pragma unroll
            for (int h = 0; h < 2; ++h) { gnxt[h] = gcur[h]; } } }
        for (int t = 0; t < nt; t += 2) {
            const bool last = (t == nt - 2);
            const char* a1 = cA + (size_t)(t + 1) * kstep;
            const char* a2 = last ? nA : cA + (size_t)(t + 2) * kstep; const char* b2 = last ? nB : cB + (size_t)(t + 2) * kstep;
            const char* a3 = a2 + kstep; const char* b3 = b2 + kstep;
            if (last && has_next) S.a_ready(nxt);
            if constexpr (SP2) {
            PG8_LDB(B0, 0, 0); PG8_LDB(B1, 0, 1); PG8_SCHED; PG8_LDA(At, 0, 0); PG8_STAGE_A(PG8_SA(1, 1), a1, 1, false);
            PG8_WAIT_V(8); PG8_WAIT_L(0); PG8_BAR; PG8_MMA(0, 0, At, B0); PG8_MMA(0, 1, At, B1); PG8_BAR; PG8_SCHED;
            PG8_LDA(At, 0, 1); PG8_STAGE(PG8_SB(0, 0), b2, voffB); PG8_STAGE(PG8_SB(0, 1), b2 + hstep, voffB); PG8_STAGE_A(PG8_SA(0, 0), a2, 0, last);
            PG8_WAIT_V(8); PG8_WAIT_L(0); PG8_BAR; PG8_MMA(1, 0, At, B0); PG8_MMA(1, 1, At, B1); PG8_BAR; PG8_SCHED;
            PG8_LDB(B0, 1, 0); PG8_LDB(B1, 1, 1); PG8_SCHED; PG8_LDA(At, 1, 0); PG8_STAGE_A(PG8_SA(0, 1), a2, 1, last);
            PG8_WAIT_V(8); PG8_WAIT_L(0); PG8_BAR; PG8_MMA(0, 0, At, B0); PG8_MMA(0, 1, At, B1); PG8_BAR; PG8_SCHED;
            PG8_LDA(At, 1, 1); PG8_STAGE(PG8_SB(1, 0), b3, voffB); PG8_STAGE(PG8_SB(1, 1), b3 + hstep, voffB); PG8_STAGE_A(PG8_SA(1, 0), a3, 0, last);
            PG8_WAIT_V(8); PG8_WAIT_L(0); PG8_BAR; PG8_MMA(1, 0, At, B0); PG8_MMA(1, 1, At, B1); PG8_BAR; PG8_SCHED;
            } else {
            PG8_LDB(B0, 0, 0); PG8_SCHED; PG8_LDA(At, 0, 0); PG8_STAGE_A(PG8_SA(1, 1), a1, 1, false);
            PG8_WAIT_L(8); PG8_BAR; PG8_WAIT_L(0); PG8_MMA(0, 0, At, B0); PG8_BAR; PG8_SCHED;
            PG8_LDB(B1, 0, 1); PG8_STAGE(PG8_SB(0, 0), b2, voffB);
            PG8_BAR; PG8_WAIT_L(0); PG8_MMA(0, 1, At, B1); PG8_BAR;
            PG8_LDA(At, 0, 1); PG8_STAGE_A(PG8_SA(0, 0), a2, 0, last);
            PG8_BAR; PG8_WAIT_L(0); PG8_MMA(1, 0, At, B0); PG8_BAR; PG8_SCHED;
            PG8_STAGE(PG8_SB(0, 1), b2 + hstep, voffB);
            PG8_WAIT_V(6); PG8_BAR; PG8_MMA(1, 1, At, B1); PG8_BAR;
            PG8_LDB(B0, 1, 0); PG8_SCHED; PG8_LDA(At, 1, 0); PG8_STAGE_A(PG8_SA(0, 1), a2, 1, last);
            PG8_WAIT_L(8); PG8_BAR; PG8_WAIT_L(0); PG8_MMA(0, 0, At, B0); PG8_BAR; PG8_SCHED;
            PG8_LDB(B1, 1, 1); PG8_STAGE(PG8_SB(1, 0), b3, voffB);
            PG8_BAR; PG8_WAIT_L(0); PG8_MMA(0, 1, At, B1); PG8_BAR;
            PG8_LDA(At, 1, 1); PG8_STAGE_A(PG8_SA(1, 0), a3, 0, last);
            PG8_BAR; PG8_WAIT_L(0); PG8_MMA(1, 0, At, B0); PG8_BAR; PG8_SCHED;
            PG8_STAGE(PG8_SB(1, 1), b3 + hstep, voffB);
            PG8_WAIT_V(6); PG8_BAR; PG8_MMA(1, 1, At, B1); PG8_BAR;
            }
        }
        if constexpr (ALIGN_EPI) { if (wr == 0) PG8_BAR; }
        if constexpr (!Epi::AFTER_DRAIN) { E(acc, cur, wr, wc, fr, fq); S.done(cur); }
        if (!has_next) break;
#pragma unroll
        for (int a = 0; a < 2; ++a)
#pragma unroll
            for (int b = 0; b < 2; ++b)
#pragma unroll
                for (int m = 0; m < 4; ++m)
#pragma unroll
                    for (int n = 0; n < 2; ++n) acc[a][b][m][n] = (f32x4){0.f, 0.f, 0.f, 0.f};
        cur = nxt; cA = nA; cB = nB; ++ui;
        if constexpr (GATHER) {
#pragma unroll
            for (int h = 0; h < 2; ++h) { gcur[h] = gnxt[h]; } }
        if constexpr (ALIGN_EPI) { if (wr == 1) PG8_BAR; }
    }
    PG8_WAIT_V(0);
    if constexpr (!ALIGN_EPI) { if (wr == 0) PG8_BAR; }
    PG8_BAR;
    if constexpr (Epi::AFTER_DRAIN) { E.fused(acc, cur, wr, wc, fr, fq, lds, wid, lane); S.done(cur); }
#undef PG8_SA
#undef PG8_SB
#undef PG8_STAGE
#undef PG8_STAGE_A
#undef PG8_LDA
#undef PG8_LDB
#undef PG8_MMA
#undef PG8_WAIT_V
#undef PG8_WAIT_L
#undef PG8_BAR
#undef PG8_SCHED
}
}

typedef unsigned short bf16_t;
__device__ __forceinline__ unsigned f2bf(float f) { unsigned u = __builtin_bit_cast(unsigned, f); return (u + 0x7fffu + ((u >> 16) & 1u)) >> 16; }
__device__ __forceinline__ float bf2f(unsigned h) { return __builtin_bit_cast(float, h << 16); }
__device__ __forceinline__ float wave_sum(float v) {
#pragma unroll
    for (int o = 1; o < 64; o <<= 1) v += __shfl_xor(v, o);
    return v;
}
__device__ __forceinline__ float sigmoidf_(float x) { return 1.0f / (1.0f + expf(-x)); }
__device__ __forceinline__ float siluf_(float x) { return x / (1.0f + expf(-x)); }
__device__ __forceinline__ float softplusf_(float x) { return fmaxf(x, 0.0f) + log1pf(expf(-fabsf(x))); }
__device__ __forceinline__ float geluf_(float x) { const float u = 0.7978845608028654f * (x + 0.044715f * x * x * x); return 0.5f * x * (1.0f + tanhf(u)); }

struct Args { const float* in[39]; float* out; unsigned char* ws; int lo, hi; };

struct Ctx {
    const float* const* in; float* out; unsigned char* ws;
    LAS unsigned char* lds; float* sm;
    int tid, lane, wid, bid, G, dry;
};

__device__ __forceinline__ unsigned pk2(float lo, float hi) { return f2bf(lo) | (f2bf(hi) << 16); }
__device__ __forceinline__ float ldbf(const bf16_t* p) { return bf2f((unsigned)*p); }
typedef unsigned v4u_t __attribute__((ext_vector_type(4)));
typedef unsigned v2u_t __attribute__((ext_vector_type(2)));
__device__ __forceinline__ void st16(void* p, uint4 v) { const v4u_t d = {v.x, v.y, v.z, v.w}; asm volatile("global_store_dwordx4 %0, %1, off\n\ts_nop 1" :: "v"(p), "v"(d) : "memory"); }
__device__ __forceinline__ void st16f(void* p, float4 v) { st16(p, make_uint4(__float_as_uint(v.x), __float_as_uint(v.y), __float_as_uint(v.z), __float_as_uint(v.w))); }
__device__ __forceinline__ void st8(void* p, uint2 v) { const v2u_t d = {v.x, v.y}; asm volatile("global_store_dwordx2 %0, %1, off\n\ts_nop 1" :: "v"(p), "v"(d) : "memory"); }
__device__ __forceinline__ void st4(void* p, unsigned v) { asm volatile("global_store_dword %0, %1, off\n\ts_nop 1" :: "v"(p), "v"(v) : "memory"); }
__device__ __forceinline__ void st2(void* p, unsigned v) { asm volatile("global_store_short %0, %1, off\n\ts_nop 1" :: "v"(p), "v"(v) : "memory"); }
__device__ __forceinline__ float4 ldbf4(const bf16_t* p) { const uint2 v = *(const uint2*)p; return make_float4(bf2f(v.x & 0xffffu), bf2f(v.x >> 16), bf2f(v.y & 0xffffu), bf2f(v.y >> 16)); }

template <int NB, class AF, class BF, class BF2, class EF>
__device__ __forceinline__ void gemm_tile(float* sm, int K, AF af, BF bf, BF2 bf2, EF ef) {
    float* As = sm;
    float* Bs = sm + 16 * 132;
    float* Bs2 = Bs + 16 * 68;
    const int tid = threadIdx.x, ty = tid >> 4, tx = tid & 15;
    const int am = tid >> 2, ak = (tid & 3) * 4;
    const int bt = tid & 255, bk = bt >> 4, bn = (bt & 15) * 4;
    float acc[4][4], acc2[4][4];
#pragma unroll
    for (int i = 0; i < 4; ++i)
#pragma unroll
        for (int j = 0; j < 4; ++j) { acc[i][j] = 0.f; acc2[i][j] = 0.f; }
    float4 av = af(am, ak);
    float4 bv = make_float4(0.f, 0.f, 0.f, 0.f);
    if (tid < 256) bv = bf(bk, bn); else if (NB == 2) bv = bf2(bk, bn);
    for (int k0 = 0; k0 < K; k0 += 16) {
        __syncthreads();
        As[(ak + 0) * 132 + am] = av.x; As[(ak + 1) * 132 + am] = av.y; As[(ak + 2) * 132 + am] = av.z; As[(ak + 3) * 132 + am] = av.w;
        if (tid < 256) *(float4*)&Bs[bk * 68 + bn] = bv; else if (NB == 2) *(float4*)&Bs2[bk * 68 + bn] = bv;
        __syncthreads();
        if (k0 + 16 < K) {
            av = af(am, k0 + 16 + ak);
            if (tid < 256) bv = bf(k0 + 16 + bk, bn); else if (NB == 2) bv = bf2(k0 + 16 + bk, bn);
        }
#pragma unroll
        for (int kk = 0; kk < 16; ++kk) {
            const float4 a = *(const float4*)&As[kk * 132 + ty * 4];
            const float4 b = *(const float4*)&Bs[kk * 68 + tx * 4];
            const float aa[4] = {a.x, a.y, a.z, a.w};
            const float bb[4] = {b.x, b.y, b.z, b.w};
#pragma unroll
            for (int i = 0; i < 4; ++i)
#pragma unroll
                for (int j = 0; j < 4; ++j) acc[i][j] = fmaf(aa[i], bb[j], acc[i][j]);
            if (NB == 2) {
                const float4 b2 = *(const float4*)&Bs2[kk * 68 + tx * 4];
                const float bb2[4] = {b2.x, b2.y, b2.z, b2.w};
#pragma unroll
                for (int i = 0; i < 4; ++i)
#pragma unroll
                    for (int j = 0; j < 4; ++j) acc2[i][j] = fmaf(aa[i], bb2[j], acc2[i][j]);
            }
        }
    }
#pragma unroll
    for (int i = 0; i < 4; ++i)
        ef(ty * 4 + i, tx * 4, make_float4(acc[i][0], acc[i][1], acc[i][2], acc[i][3]), make_float4(acc2[i][0], acc2[i][1], acc2[i][2], acc2[i][3]));
}

__device__ __forceinline__ void transpose_load(const float* W, int N, int nblk, int item, int lane, float (&r)[32]) {
    const int kb = item / nblk, nb = item % nblk, k0 = 64 * kb, n0 = 32 * nb;
#pragma unroll
    for (int i = 0; i < 8; ++i) { const int kk = 8 * i + (lane >> 3); const float4 v = *(const float4*)(W + (size_t)(k0 + kk) * N + n0 + (lane & 7) * 4);
        r[4 * i] = v.x; r[4 * i + 1] = v.y; r[4 * i + 2] = v.z; r[4 * i + 3] = v.w; }
}
template <bool RES, class RM>
__device__ __forceinline__ void transpose_finish(int K, int nblk, bf16_t* WT, RM rowmap, float* scr, int item, int lane, const float (&r)[32]) {
    const int kb = item / nblk, nb = item % nblk, k0 = 64 * kb, n0 = 32 * nb;
#pragma unroll
    for (int i = 0; i < 8; ++i) { const int kk = 8 * i + (lane >> 3), nn = (lane & 7) * 4;
        scr[kk * 33 + nn] = r[4 * i]; scr[kk * 33 + nn + 1] = r[4 * i + 1]; scr[kk * 33 + nn + 2] = r[4 * i + 2]; scr[kk * 33 + nn + 3] = r[4 * i + 3]; }
    asm volatile("s_waitcnt lgkmcnt(0)" ::: "memory");
    const int c = lane & 7;
    const int r0 = rowmap(n0);
#pragma unroll
    for (int j = 0; j < 4; ++j) {
        const int n = (lane >> 3) + 8 * j; const float* s = scr + (8 * c) * 33 + n;
        float v[8];
#pragma unroll
        for (int q = 0; q < 8; ++q) { v[q] = s[q * 33]; if (RES) v[q] = v[q] - bf2f(f2bf(v[q])); }
        uint4 o; o.x = pk2(v[0], v[1]); o.y = pk2(v[2], v[3]); o.z = pk2(v[4], v[5]); o.w = pk2(v[6], v[7]);
        st16(WT + (size_t)(r0 + n) * K + k0 + 8 * c, o);
    }
    asm volatile("s_waitcnt lgkmcnt(0)" ::: "memory");
}
template <bool RES, class RM>
__device__ __forceinline__ void transpose_item(const float* W, int K, int N, bf16_t* WT, RM rowmap, float* scr, int item, int lane) {
    float r[32];
    transpose_load(W, N, N / 32, item, lane, r);
    transpose_finish<RES>(K, N / 32, WT, rowmap, scr, item, lane, r);
}

__device__ __forceinline__ void convert_expert_weights(const Ctx& c, const int lo, const int hi, int first, int stride) {
    float* scr = c.sm + c.wid * (64 * 33);
    float ra[32], rb[32];
    auto src = [&](int it, const float*& W, int& N, int& nblk, int& item) {
        const int e = it / 384, r = it % 384;
        if (r < 128) { W = c.in[33] + (size_t)e * D * EFF; N = EFF; nblk = EFF / 32; item = r; }
        else if (r < 256) { W = c.in[34] + (size_t)e * D * EFF; N = EFF; nblk = EFF / 32; item = r - 128; }
        else { W = c.in[35] + (size_t)e * EFF * D; N = D; nblk = D / 32; item = r - 256; }
    };
    auto fin = [&](int it, const float (&rg)[32]) {
        const int e = it / 384, r = it % 384;
        if (r < 128) transpose_finish<false>(D, EFF / 32, (bf16_t*)(c.ws + WS_WEGU) + (size_t)e * 512 * D, [](int n) { return (n >> 7) * 256 + (n & 127); }, scr, r, c.lane, rg);
        else if (r < 256) transpose_finish<false>(D, EFF / 32, (bf16_t*)(c.ws + WS_WEGU) + (size_t)e * 512 * D, [](int n) { return (n >> 7) * 256 + 128 + (n & 127); }, scr, r - 128, c.lane, rg);
        else transpose_finish<false>(EFF, D / 32, (bf16_t*)(c.ws + WS_WED) + (size_t)e * D * EFF, [](int n) { return n; }, scr, r - 256, c.lane, rg);
    };
    float rc[32];
    auto ld = [&](int it_, float (&rg)[32]) { if (it_ < hi) { const float* W; int N, nblk, item; src(it_, W, N, nblk, item); transpose_load(W, N, nblk, item, c.lane, rg); } };
    int it = lo + first;
    if (it >= hi) return;
    ld(it, ra); ld(it + stride, rb);
    for (;;) {
        ld(it + 2 * stride, rc); fin(it, ra); if (it + stride >= hi) break;
        ld(it + 3 * stride, ra); fin(it + stride, rb); if (it + 2 * stride >= hi) break;
        ld(it + 4 * stride, rb); fin(it + 2 * stride, rc); if (it + 3 * stride >= hi) break;
        it += 3 * stride;
    }
}

__device__ __forceinline__ void phase0(const Ctx& c) {
    const int gt = c.bid * 512 + c.tid, NT = c.G * 512;
    const int gw = c.bid * 8 + c.wid, NW = c.G * 8;
    {
        const float* cc = c.in[1]; const float* w_ada = c.in[2];
        float* modsp = (float*)(c.ws + WS_MODSP);
        for (int task = gw; task < 96 * 16; task += NW) {
            const int cg = task % 96, ks = task / 96, j = cg * 64 + c.lane;
            float a0 = 0.f, a1 = 0.f, a2 = 0.f, a3 = 0.f;
#pragma unroll 4
            for (int k = ks * 64; k < ks * 64 + 64; ++k) {
                const float wv = w_ada[(size_t)k * NMODS + j];
                a0 = fmaf(siluf_(cc[k]), wv, a0); a1 = fmaf(siluf_(cc[D + k]), wv, a1); a2 = fmaf(siluf_(cc[2 * D + k]), wv, a2); a3 = fmaf(siluf_(cc[3 * D + k]), wv, a3);
            }
            modsp[(ks * 4 + 0) * NMODS + j] = a0; modsp[(ks * 4 + 1) * NMODS + j] = a1; modsp[(ks * 4 + 2) * NMODS + j] = a2; modsp[(ks * 4 + 3) * NMODS + j] = a3;
        }
    }
    {
        const float* log_dt = c.in[20]; const float* a_re = c.in[21]; const float* a_im = c.in[22];
        const float* b_re = c.in[23]; const float* b_im = c.in[24];
        float* apow = (float*)(c.ws + WS_APOW); float* bb = (float*)(c.ws + WS_S5BB);
        for (int idx = gt; idx < S5NG * S5P; idx += NT) {
            const int g = idx / S5P, p = idx % S5P;
            const double dt = exp((double)log_dt[g]);
            const double lre = fmin((double)a_re[idx], -1e-4), lim = (double)a_im[idx];
            const double mag = exp(lre * dt), ang = lim * dt;
            const double abr = mag * cos(ang), abi = mag * sin(ang);
            const double den = lre * lre + lim * lim;
            const double nre = abr - 1.0, nim = abi;
            const double qre = (nre * lre + nim * lim) / den, qim = (nim * lre - nre * lim) / den;
            double pr = 1.0, pi = 0.0;
            for (int j = 0; j <= S5L; ++j) {
                apow[((size_t)(g * (S5L + 1) + j) * 64 + p) * 2 + 0] = (float)pr; apow[((size_t)(g * (S5L + 1) + j) * 64 + p) * 2 + 1] = (float)pi;
                const double nr = pr * abr - pi * abi, ni = pr * abi + pi * abr; pr = nr; pi = ni;
            }
            for (int ch = 0; ch < 16; ++ch) {
                const double br = (double)b_re[idx * 16 + ch], bi = (double)b_im[idx * 16 + ch];
                bb[idx * 32 + ch] = (float)(qre * br - qim * bi);
                bb[idx * 32 + 16 + ch] = (float)(qre * bi + qim * br);
            }
        }
    }
    {
        const float* w2 = c.in[11]; const float* a2 = c.in[13]; const float* g2 = c.in[14];
        bf16_t* bt = (bf16_t*)(c.ws + WS_LORA_BT);
        for (int it = gt; it < 1536 * 32; it += NT) {
            const int n = it >> 5, c0 = (it & 31) * 8;
            float v[8];
#pragma unroll
            for (int i = 0; i < 8; ++i) {
                const int col = c0 + i; float x = 0.f;
                if (n < 512) { if (col < 64) x = w2[col * RW + n]; }
                else if (n < 1024) { if (col >= 64 && col < 128) x = a2[(col - 64) * RW + (n - 512)]; }
                else { if (col >= 128) x = g2[(col - 128) * RW + (n - 1024)]; }
                v[i] = x;
            }
            *(uint4*)(bt + (size_t)n * 256 + c0) = make_uint4(pk2(v[0], v[1]), pk2(v[2], v[3]), pk2(v[4], v[5]), pk2(v[6], v[7]));
        }
    }
    float* scr = c.sm + c.wid * (64 * 33);
    constexpr int I_IN = (D / 64) * (NPROJ / 32), I_OUT = (D / 64) * (D / 32), I_GLU = (512 / 64) * (512 / 32), I_SG = (D / 64) * (256 / 32), I_SD = (256 / 64) * (D / 32), I_R = (D / 64) * (256 / 32);
    constexpr int NIT = I_IN + I_OUT + I_GLU + 2 * I_SG + I_SD + 2 * I_R;
    for (int it = gw; it < NIT; it += NW) {
        int r = it;
        if (r < I_IN) { transpose_item<false>(c.in[8], D, NPROJ, (bf16_t*)(c.ws + WS_WIN_T), [](int n) { return n; }, scr, r, c.lane); continue; } r -= I_IN;
        if (r < I_OUT) { transpose_item<false>(c.in[30], D, D, (bf16_t*)(c.ws + WS_WOUT_T), [](int n) { return n; }, scr, r, c.lane); continue; } r -= I_OUT;
        if (r < I_GLU) { transpose_item<false>(c.in[28], 512, 512, (bf16_t*)(c.ws + WS_WGLU_T), [](int n) { return n; }, scr, r, c.lane); continue; } r -= I_GLU;
        if (r < I_SG) { transpose_item<false>(c.in[36], D, 256, (bf16_t*)(c.ws + WS_WSGU_T), [](int n) { return (n >> 7) * 256 + (n & 127); }, scr, r, c.lane); continue; } r -= I_SG;
        if (r < I_SG) { transpose_item<false>(c.in[37], D, 256, (bf16_t*)(c.ws + WS_WSGU_T), [](int n) { return (n >> 7) * 256 + 128 + (n & 127); }, scr, r, c.lane); continue; } r -= I_SG;
        if (r < I_SD) { transpose_item<false>(c.in[38], 256, D, (bf16_t*)(c.ws + WS_WSD_T), [](int n) { return n; }, scr, r, c.lane); continue; } r -= I_SD;
        if (r < I_R) { transpose_item<false>(c.in[31], D, 256, (bf16_t*)(c.ws + WS_WR_T), [](int n) { return n; }, scr, r, c.lane); continue; } r -= I_R;
        transpose_item<true>(c.in[31], D, 256, (bf16_t*)(c.ws + WS_WR_T), [](int n) { return 256 + n; }, scr, r, c.lane);
    }
}

__device__ __forceinline__ void phase1(const Ctx& c) {
    const int gt = c.bid * 512 + c.tid, NT = c.G * 512;
    const int gw = c.bid * 8 + c.wid, NW = c.G * 8;
    const float* modsp = (const float*)(c.ws + WS_MODSP); const float* b_ada = c.in[3]; float* mods = (float*)(c.ws + WS_MODS);
    for (int idx = gt; idx < BATCH * NMODS; idx += NT) {
        const int b = idx / NMODS, j = idx % NMODS;
        float acc = 0.f;
#pragma unroll
        for (int ks = 0; ks < 16; ++ks) acc += modsp[(ks * 4 + b) * NMODS + j];
        mods[idx] = acc + b_ada[j];
    }
    const float* apow = (const float*)(c.ws + WS_APOW); const float* bb = (const float*)(c.ws + WS_S5BB);
    const float* c_re = c.in[25]; const float* c_im = c.in[26];
    float* klag = (float*)(c.ws + WS_KLAG);
    for (int task = gw; task < S5NG * S5L; task += NW) {
        const int g = task / S5L, j = task % S5L, cc = c.lane >> 2, cq = (c.lane & 3) * 4;
        float acc[4] = {0.f, 0.f, 0.f, 0.f};
        for (int p = 0; p < 64; ++p) {
            const float ar = apow[((size_t)(g * (S5L + 1) + j) * 64 + p) * 2], ai = apow[((size_t)(g * (S5L + 1) + j) * 64 + p) * 2 + 1];
            const float cr = c_re[(g * 16 + cc) * 64 + p], ci = c_im[(g * 16 + cc) * 64 + p];
            const float4 br = *(const float4*)(bb + (size_t)(g * 64 + p) * 32 + cq), bi = *(const float4*)(bb + (size_t)(g * 64 + p) * 32 + 16 + cq);
            const float er = cr * ar - ci * ai, ei = cr * ai + ci * ar;
            acc[0] += er * br.x - ei * bi.x; acc[1] += er * br.y - ei * bi.y; acc[2] += er * br.z - ei * bi.z; acc[3] += er * br.w - ei * bi.w;
        }
        *(float4*)(klag + ((size_t)(g * S5L + j) * 16 + cc) * 16 + cq) = make_float4(acc[0], acc[1], acc[2], acc[3]);
    }
}

__device__ __forceinline__ void phase2(const Ctx& c) {
    const float* x = c.in[0]; const float* g = c.in[4];
    const float* mods = (const float*)(c.ws + WS_MODS);
    bf16_t* xn = (bf16_t*)(c.ws + WS_A);
    const int gw = c.bid * 8 + c.wid, NW = c.G * 8;
    for (int t = gw; t < T; t += NW) {
        const int b = t / SEQ;
        const float4* xr = (const float4*)(x + (size_t)t * D) + c.lane;
        float4 v[4]; float ss = 0.f;
#pragma unroll
        for (int j = 0; j < 4; ++j) { v[j] = xr[64 * j]; ss += v[j].x * v[j].x + v[j].y * v[j].y + v[j].z * v[j].z + v[j].w * v[j].w; }
        const float rstd = rsqrtf(wave_sum(ss) * (1.0f / D) + 1e-6f);
        uint2* o = (uint2*)(xn + (size_t)t * D) + c.lane;
#pragma unroll
        for (int j = 0; j < 4; ++j) {
            const int k = (c.lane + 64 * j) * 4;
            const float4 gg = *(const float4*)(g + k);
            const float4 sh = *(const float4*)(mods + b * NMODS + k);
            const float4 sc = *(const float4*)(mods + b * NMODS + D + k);
            float4 r;
            r.x = v[j].x * rstd * gg.x * (1.f + sc.x) + sh.x; r.y = v[j].y * rstd * gg.y * (1.f + sc.y) + sh.y;
            r.z = v[j].z * rstd * gg.z * (1.f + sc.z) + sh.z; r.w = v[j].w * rstd * gg.w * (1.f + sc.w) + sh.w;
            o[64 * j] = make_uint2(pk2(r.x, r.y), pk2(r.z, r.w));
        }
    }
    const int gt = c.bid * 512 + c.tid, NT = c.G * 512;
    const float* apow = (const float*)(c.ws + WS_APOW); const float* bb = (const float*)(c.ws + WS_S5BB); const float* klag = (const float*)(c.ws + WS_KLAG);
    const float* c_re = c.in[25]; const float* c_im = c.in[26]; const float* dd = c.in[27];
    bf16_t* kmat = (bf16_t*)(c.ws + WS_KMAT); bf16_t* hmat = (bf16_t*)(c.ws + WS_HMAT);
    for (int it = gt; it < S5NG * 512 * 80; it += NT) {
        const int row = it / 80, ch = it % 80, g = row >> 9, t = (row >> 4) & 31, cc = row & 15, col0 = ch * 8;
        float v[8];
        if (col0 < 512) {
            const int s = col0 >> 4, c0 = col0 & 15;
            if (s > t) {
#pragma unroll
                for (int i = 0; i < 8; ++i) v[i] = 0.f;
            } else {
                const float4 k0 = *(const float4*)(klag + ((size_t)(g * S5L + (t - s)) * 16 + cc) * 16 + c0), k1 = *(const float4*)(klag + ((size_t)(g * S5L + (t - s)) * 16 + cc) * 16 + c0 + 4);
                v[0] = k0.x; v[1] = k0.y; v[2] = k0.z; v[3] = k0.w; v[4] = k1.x; v[5] = k1.y; v[6] = k1.z; v[7] = k1.w;
                if (s == t) {
                    const float dv = dd[g * 16 + cc];
#pragma unroll
                    for (int i = 0; i < 8; ++i) if (c0 + i == cc) v[i] += dv;
                }
            }
        } else {
            const int q0 = col0 - 512;
#pragma unroll
            for (int i = 0; i < 8; ++i) {
                const int q = q0 + i, p = q & 63;
                const float ar = apow[((size_t)(g * (S5L + 1) + t + 1) * 64 + p) * 2], ai = apow[((size_t)(g * (S5L + 1) + t + 1) * 64 + p) * 2 + 1];
                const float cr = c_re[(g * 16 + cc) * 64 + p], ci = c_im[(g * 16 + cc) * 64 + p];
                v[i] = (q < 64) ? (cr * ar - ci * ai) : -(cr * ai + ci * ar);
            }
        }
        *(uint4*)(kmat + (size_t)row * 640 + col0) = make_uint4(pk2(v[0], v[1]), pk2(v[2], v[3]), pk2(v[4], v[5]), pk2(v[6], v[7]));
    }
    for (int it = gt; it < S5NG * 256 * 80; it += NT) {
        const int row = it / 80, ch = it % 80, g = row >> 8, q = row & 255, col0 = ch * 8;
        float v[8];
#pragma unroll
        for (int i = 0; i < 8; ++i) v[i] = 0.f;
        if (q < 128 && col0 < 512) {
            const int s = col0 >> 4, c0 = col0 & 15, p = q & 63;
            const float ar = apow[((size_t)(g * (S5L + 1) + (S5L - 1 - s)) * 64 + p) * 2], ai = apow[((size_t)(g * (S5L + 1) + (S5L - 1 - s)) * 64 + p) * 2 + 1];
#pragma unroll
            for (int i = 0; i < 8; ++i) {
                const float br = bb[(size_t)(g * 64 + p) * 32 + c0 + i], bi = bb[(size_t)(g * 64 + p) * 32 + 16 + c0 + i];
                v[i] = (q < 64) ? (ar * br - ai * bi) : (ar * bi + ai * br);
            }
        }
        *(uint4*)(hmat + (size_t)row * 640 + col0) = make_uint4(pk2(v[0], v[1]), pk2(v[2], v[3]), pk2(v[4], v[5]), pk2(v[6], v[7]));
    }
}

__device__ __forceinline__ void phase3(const Ctx& c) {
    pg8::Gemm g{(const bf16_t*)(c.ws + WS_A), (const bf16_t*)(c.ws + WS_WIN_T), T, NPROJ, D};
    pg8::StaticOrder S; S.init(T, NPROJ, c.G, c.bid);
    pg8::EpiBf16<0> E{(bf16_t*)(c.ws + WS_PROJ), NPROJ, nullptr, 0, 0, 1.f};
    pg8::gemm_phase<pg8::EpiBf16<0>, pg8::StaticOrder, true, true>(c.lds, g, S, E);
}

__device__ __forceinline__ void unpack8(const uint4 a, float (&u)[8]) {
    u[0] = bf2f(a.x & 0xffffu); u[1] = bf2f(a.x >> 16); u[2] = bf2f(a.y & 0xffffu); u[3] = bf2f(a.y >> 16);
    u[4] = bf2f(a.z & 0xffffu); u[5] = bf2f(a.z >> 16); u[6] = bf2f(a.w & 0xffffu); u[7] = bf2f(a.w >> 16);
}
__device__ __forceinline__ uint4 pack8(const float (&v)[8]) { return make_uint4(pk2(v[0], v[1]), pk2(v[2], v[3]), pk2(v[4], v[5]), pk2(v[6], v[7])); }
#define DPPU(v, ctrl) ((unsigned)__builtin_amdgcn_mov_dpp((int)(v), (ctrl), 0xf, 0xf, true))
#define DPPF(v, ctrl) __builtin_bit_cast(float, __builtin_amdgcn_mov_dpp(__builtin_bit_cast(int, (v)), (ctrl), 0xf, 0xf, true))
__device__ __forceinline__ float fast_tanh(float x) { return 1.0f - 2.0f * __builtin_amdgcn_rcpf(1.0f + __builtin_amdgcn_exp2f(2.8853900817779268f * x)); }
__device__ __forceinline__ void phase4(const Ctx& c) {
    const bf16_t* proj = (const bf16_t*)(c.ws + WS_PROJ);
    const float* mu = c.in[9]; const float* k_k = c.in[15];
    bf16_t* rw_r = (bf16_t*)(c.ws + WS_RW_R); bf16_t* rw_k = (bf16_t*)(c.ws + WS_RW_K); bf16_t* rw_v = (bf16_t*)(c.ws + WS_RW_V); bf16_t* rw_a = (bf16_t*)(c.ws + WS_RW_A);
    bf16_t* alora = (bf16_t*)((unsigned char*)c.out + OUT_ALORA); bf16_t* ux = (bf16_t*)((unsigned char*)c.out + OUT_UX);
    const int gw = c.bid * 8 + c.wid, NW = c.G * 8, lane = c.lane;
    float mm[4][8], kk8[8];
#pragma unroll
    for (int j = 0; j < 4; ++j) {
        const int cidx = lane + 64 * j, col = (cidx < 224 ? cidx : 0) * 8;
        const float4 m0 = *(const float4*)(mu + col), m1 = *(const float4*)(mu + col + 4);
        mm[j][0] = m0.x; mm[j][1] = m0.y; mm[j][2] = m0.z; mm[j][3] = m0.w; mm[j][4] = m1.x; mm[j][5] = m1.y; mm[j][6] = m1.z; mm[j][7] = m1.w;
    }
    { const float4 k0 = *(const float4*)(k_k + lane * 8), k1 = *(const float4*)(k_k + lane * 8 + 4); kk8[0] = k0.x; kk8[1] = k0.y; kk8[2] = k0.z; kk8[3] = k0.w; kk8[4] = k1.x; kk8[5] = k1.y; kk8[6] = k1.z; kk8[7] = k1.w; }
    constexpr int RUN = 16;
    auto load_row = [&](int t, uint4 (&r)[5]) {
        const bf16_t* pr = proj + (size_t)t * NPROJ;
#pragma unroll
        for (int j = 0; j < 3; ++j) r[j] = *(const uint4*)(pr + (lane + 64 * j) * 8);
        r[3] = (lane < 32) ? *(const uint4*)(pr + (lane + 192) * 8) : make_uint4(0u, 0u, 0u, 0u);
        r[4] = *(const uint4*)(pr + RPROJ + lane * 8);
    };
    for (int t0 = gw * RUN; t0 < T; t0 += NW * RUN) {
        uint4 prev[5], cur[5], nxt[5];
        if (t0 % SEQ == 0) {
#pragma unroll
            for (int j = 0; j < 5; ++j) prev[j] = make_uint4(0u, 0u, 0u, 0u);
        } else load_row(t0 - 1, prev);
        load_row(t0, cur);
#pragma unroll 2
        for (int i = 0; i < RUN; ++i) {
            const int t = t0 + i;
            if (i + 1 < RUN) load_row(t + 1, nxt);
#pragma unroll
            for (int j = 0; j < 4; ++j) {
                const int cidx = lane + 64 * j;
                if (cidx < 224) {
                    const int col = cidx * 8;
                    float p[8], q[8], ps[8];
                    unpack8(cur[j], p); unpack8(prev[j], q);
#pragma unroll
                    for (int i2 = 0; i2 < 8; ++i2) ps[i2] = p[i2] + (q[i2] - p[i2]) * mm[j][i2];
                    if (j == 0) *(uint4*)(rw_r + (size_t)t * RW + col) = pack8(ps);
                    else if (j == 1) {
                        const int cl = col - 512;
                        *(uint4*)(rw_k + (size_t)t * RW + cl) = pack8(ps);
                        float kk[8]; float ss = 0.f;
#pragma unroll
                        for (int i2 = 0; i2 < 8; ++i2) { kk[i2] = ps[i2] * kk8[i2]; ss += kk[i2] * kk[i2]; }
                        ss += DPPF(ss, 0xB1); ss += DPPF(ss, 0x4E); ss += DPPF(ss, 0x141);
                        const float inv = -1.0f / fmaxf(sqrtf(ss), 1e-12f);
#pragma unroll
                        for (int i2 = 0; i2 < 8; ++i2) kk[i2] *= inv;
                        *(uint4*)(rw_a + (size_t)t * RW + cl) = pack8(kk);
                    } else if (j == 2) *(uint4*)(rw_v + (size_t)t * RW + (col - 1024)) = pack8(ps);
                    else {
                        const int cl = col - 1536;
                        float o[8];
#pragma unroll
                        for (int i2 = 0; i2 < 8; ++i2) o[i2] = (cl < 64) ? fast_tanh(ps[i2]) : (cl < 128) ? ps[i2] : pg8::fast_sigmoid(ps[i2]);
                        *(uint4*)(alora + (size_t)t * 256 + cl) = pack8(o);
                    }
                }
            }
            {
                const int g = lane >> 1, hf = lane & 1, b = t / SEQ, sidx = t % S5L, chunk = (t % SEQ) / S5L;
                bf16_t* row = ux + ((size_t)(g * 1024 + b * 256 + chunk)) * 640;
                *(uint4*)(row + sidx * 16 + hf * 8) = cur[4];
                if (sidx < 8) { *(uint4*)(row + 512 + (sidx * 2 + hf) * 8) = make_uint4(0u, 0u, 0u, 0u); }
            }
#pragma unroll
            for (int j = 0; j < 5; ++j) { prev[j] = cur[j]; cur[j] = nxt[j]; }
        }
    }
}

__device__ __forceinline__ void phase5(const Ctx& c) {
    {
        pg8::Gemm g{(const bf16_t*)((unsigned char*)c.out + OUT_ALORA), (const bf16_t*)(c.ws + WS_LORA_BT), T, 1536, 256};
        pg8::StaticOrder S; S.init(T, 1536, c.G, c.bid);
        pg8::EpiLora E{c.in[10], c.in[12], c.in[16], (float*)(c.ws + WS_RW_W), (const bf16_t*)(c.ws + WS_RW_K), (bf16_t*)((unsigned char*)c.out + OUT_KF), (const bf16_t*)(c.ws + WS_RW_A), (bf16_t*)(c.ws + WS_RW_B), (bf16_t*)(c.ws + WS_RW_G)};
        pg8::gemm_phase<pg8::EpiLora, pg8::StaticOrder, true, true>(c.lds, g, S, E);
    }
    __syncthreads();
    {
        pg8::Gemm g{(const bf16_t*)((unsigned char*)c.out + OUT_UX), (const bf16_t*)(c.ws + WS_HMAT), 0, 0, 640};
        pg8::S5Order S{128, 1, c.G, c.bid};
        pg8::EpiS5E E{(float*)((unsigned char*)c.out + OUT_E)};
        pg8::gemm_phase<pg8::EpiS5E, pg8::S5Order, true, true>(c.lds, g, S, E);
    }
}

typedef float f2v __attribute__((ext_vector_type(2)));
__device__ __forceinline__ float dpp_add16(float v) {
    v += __builtin_bit_cast(float, __builtin_amdgcn_mov_dpp(__builtin_bit_cast(int, v), 0xB1, 0xf, 0xf, true));
    v += __builtin_bit_cast(float, __builtin_amdgcn_mov_dpp(__builtin_bit_cast(int, v), 0x4E, 0xf, 0xf, true));
    v += __builtin_bit_cast(float, __builtin_amdgcn_mov_dpp(__builtin_bit_cast(int, v), 0x141, 0xf, 0xf, true));
    v += __builtin_bit_cast(float, __builtin_amdgcn_mov_dpp(__builtin_bit_cast(int, v), 0x140, 0xf, 0xf, true));
    return v;
}
constexpr int RTS = 32;
constexpr int RTILE = 6 * RTS * 64;
typedef short bf16x8_t __attribute__((ext_vector_type(8)));
typedef float f32x4_t __attribute__((ext_vector_type(4)));
#define MFMA16(a, b, c) __builtin_amdgcn_mfma_f32_16x16x32_bf16((a), (b), (c), 0, 0, 0)
constexpr int CL = 64, CLD = 72, CSLOT = 64 * CLD * 2;
constexpr int C_DIAG = 13 * CSLOT, C_DM = C_DIAG + 4096, C_GL = C_DM + 2048, C_SEGP = C_GL + 256;
static_assert(C_SEGP + 2048 <= 131072, "rwkv chunk LDS map");
__device__ __forceinline__ bf16x8_t ldsfrag(LAS const unsigned char* slot, int row, int col) { return *(LAS const bf16x8_t*)(slot + (row * CLD + col) * 2); }
typedef unsigned u32x4_t __attribute__((ext_vector_type(4)));
typedef unsigned u32x2_t __attribute__((ext_vector_type(2)));
__device__ __forceinline__ void lds_st16(LAS unsigned char* p, uint4 v) { *(LAS u32x4_t*)p = (u32x4_t){v.x, v.y, v.z, v.w}; }
__device__ __forceinline__ void lds_st8(LAS unsigned char* p, uint2 v) { *(LAS u32x2_t*)p = (u32x2_t){v.x, v.y}; }
__device__ __forceinline__ uint2 lds_ld8(LAS const unsigned char* p) { const u32x2_t v = *(LAS const u32x2_t*)p; return make_uint2(v.x, v.y); }
__device__ __forceinline__ bf16x8_t zfrag() { return (bf16x8_t){0, 0, 0, 0, 0, 0, 0, 0}; }
__device__ __forceinline__ uint2 pack4(float a, float b, float c, float d) { return make_uint2(pk2(a, b), pk2(c, d)); }
__device__ __forceinline__ float wave_sum_u(float v) {
    v = dpp_add16(v);
    return __builtin_bit_cast(float, __builtin_amdgcn_readlane(__builtin_bit_cast(int, v), 0)) + __builtin_bit_cast(float, __builtin_amdgcn_readlane(__builtin_bit_cast(int, v), 16))
         + __builtin_bit_cast(float, __builtin_amdgcn_readlane(__builtin_bit_cast(int, v), 32)) + __builtin_bit_cast(float, __builtin_amdgcn_readlane(__builtin_bit_cast(int, v), 48));
}

__device__ __forceinline__ void rwkv_phaseA(const Ctx& c, const int GA) {
    const float* __restrict__ rw_w = (const float*)(c.ws + WS_RW_W);
    const bf16_t* __restrict__ rw_r = (const bf16_t*)(c.ws + WS_RW_R); const bf16_t* __restrict__ rw_k = (const bf16_t*)((const unsigned char*)c.out + OUT_KF); const bf16_t* __restrict__ rw_v = (const bf16_t*)(c.ws + WS_RW_V);
    const bf16_t* __restrict__ rw_a = (const bf16_t*)(c.ws + WS_RW_A); const bf16_t* __restrict__ rw_b = (const bf16_t*)(c.ws + WS_RW_B);
    const float* r_k = c.in[17];
    bf16_t* Mq = (bf16_t*)(c.ws + WS_CM); bf16_t* NTq = (bf16_t*)(c.ws + WS_CN); bf16_t* Qq = (bf16_t*)(c.ws + WS_CQ); bf16_t* YTq = (bf16_t*)(c.ws + WS_CY); float* bon = (float*)(c.ws + WS_CBON);
    LAS unsigned char* L = c.lds;
    LAS unsigned char* sAt = L + 0 * CSLOT; LAS unsigned char* sBt = L + 1 * CSLOT; LAS unsigned char* sKt = L + 2 * CSLOT; LAS unsigned char* sRt = L + 3 * CSLOT;
    LAS unsigned char* sBtT = L + 4 * CSLOT; LAS unsigned char* sKtT = L + 5 * CSLOT; LAS unsigned char* sVT = L + 6 * CSLOT;
    LAS unsigned char* sA4 = L + 7 * CSLOT;
    LAS unsigned char* sRHST = L + 11 * CSLOT;
    LAS unsigned char* sXT = L + 0 * CSLOT;
    LAS unsigned char* sAD = L + 2 * CSLOT;
    LAS float* sDIAG = (LAS float*)(L + C_DIAG); LAS bf16_t* sDM = (LAS bf16_t*)(L + C_DM); LAS float* sGL = (LAS float*)(L + C_GL); LAS float* sSEGP = (LAS float*)(L + C_SEGP);
    const int tid = c.tid, w = c.wid, lane = c.lane, lr = lane & 15, lq = lane >> 4;
    float raww[8]; unsigned rawa[8], rawb[8], rawk[8], rawr[8], rawv[8];
    auto load_raw = [&](int ci_) {
        const int bh_ = ci_ >> 7, chunk_ = ci_ & 127, b_ = bh_ >> 3, h_ = bh_ & 7;
        const size_t gb = (size_t)(b_ * SEQ + chunk_ * CL) * RW + h_ * 64 + (size_t)(8 * (tid >> 6)) * RW + (tid & 63);
#pragma unroll
        for (int j = 0; j < 8; ++j) { const size_t o = gb + (size_t)j * RW; raww[j] = rw_w[o]; rawa[j] = rw_a[o]; rawb[j] = rw_b[o]; rawk[j] = rw_k[o]; rawr[j] = rw_r[o]; rawv[j] = rw_v[o]; }
    };
    if (c.bid < BATCH * NH * (SEQ / CL)) load_raw(c.bid);
    for (int ci = c.bid; ci < BATCH * NH * (SEQ / CL); ci += GA) {
        const int bh = ci >> 7, chunk = ci & 127, b = bh >> 3, h = bh & 7;
        const size_t gbase = (size_t)(b * SEQ + chunk * CL) * RW + h * 64;
        {
            const int kc = tid & 63, seg = tid >> 6;
            float p[8];
#pragma unroll
            for (int j = 0; j < 8; ++j) { const float wv = raww[j]; p[j] = (j == 0) ? wv : p[j - 1] * wv; }
            sSEGP[seg * 64 + kc] = p[7];
            for (int i = tid; i < 4 * CSLOT / 16; i += 512) lds_st16(sA4 + i * 16, make_uint4(0u, 0u, 0u, 0u));
            __syncthreads();
            float pre = 1.0f;
#pragma unroll
            for (int s = 0; s < 7; ++s) { const float sp = sSEGP[s * 64 + kc]; pre = (s < seg) ? pre * sp : pre; }
            float atT[8], btT[8], ktT[8], vT[8];
            const float rkv = r_k[h * 64 + kc];
#pragma unroll
            for (int j = 0; j < 8; ++j) {
                const int t = 8 * seg + j;
                const float G = pre * p[j], Gm1 = (j == 0) ? pre : pre * p[j - 1], inv = 1.0f / G;
                const float av = bf2f(rawa[j]), bv = bf2f(rawb[j]), kv = bf2f(rawk[j]), rv = bf2f(rawr[j]), vv = bf2f(rawv[j]);
                const float at = av * Gm1, bt = bv * inv, kt = kv * inv, rt = rv * G;
                *(LAS bf16_t*)(sAt + (t * CLD + kc) * 2) = (bf16_t)f2bf(at); *(LAS bf16_t*)(sBt + (t * CLD + kc) * 2) = (bf16_t)f2bf(bt);
                *(LAS bf16_t*)(sKt + (t * CLD + kc) * 2) = (bf16_t)f2bf(kt); *(LAS bf16_t*)(sRt + (t * CLD + kc) * 2) = (bf16_t)f2bf(rt);
                atT[j] = at; btT[j] = bt; ktT[j] = kt; vT[j] = vv;
                const float bs = wave_sum_u(rv * kv * rkv);
                if (lane == 0) bon[(size_t)ci * CL + t] = bs;
            }
            lds_st16(sRHST + (kc * CLD + 8 * seg) * 2, pack8(atT)); lds_st16(sBtT + (kc * CLD + 8 * seg) * 2, pack8(btT));
            lds_st16(sKtT + (kc * CLD + 8 * seg) * 2, pack8(ktT)); lds_st16(sVT + (kc * CLD + 8 * seg) * 2, pack8(vT));
            if (seg == 7) sGL[kc] = pre * p[7];
            __syncthreads();
        }
        for (int idx = w; idx < 40; idx += 8) {
            const int m = idx / 10, pr = idx % 10;
            const int ti = (pr >= 6) ? 3 : (pr >= 3) ? 2 : (pr >= 1) ? 1 : 0, si = pr - ti * (ti + 1) / 2;
            LAS const unsigned char* X = (m < 2) ? sAt : sRt; LAS const unsigned char* Y = (m & 1) ? sKt : sBt;
            f32x4_t acc = {0.f, 0.f, 0.f, 0.f};
#pragma unroll
            for (int ks = 0; ks < 2; ++ks) acc = MFMA16(ldsfrag(Y, 16 * si + lr, 32 * ks + 8 * lq), ldsfrag(X, 16 * ti + lr, 32 * ks + 8 * lq), acc);
            const int t = 16 * ti + lr, s0 = 16 * si + 4 * lq;
            float o[4];
#pragma unroll
            for (int rg = 0; rg < 4; ++rg) { const int s = s0 + rg; const bool keep = (m < 2) ? (s < t) : (s <= t); o[rg] = keep ? acc[rg] : 0.f; }
            lds_st8(sA4 + m * CSLOT + (t * CLD + s0) * 2, pack4(o[0], o[1], o[2], o[3]));
            if (m == 0 && ti == si) *(LAS f32x4_t*)(sDIAG + (ti * 16 + lr) * 16 + 4 * lq) = (f32x4_t){o[0], o[1], o[2], o[3]};
        }
        __syncthreads();
        if (w == 0) {
            float x[16];
#pragma unroll
            for (int r = 0; r < 16; ++r) {
                float acc = (r == lr) ? 1.0f : 0.0f;
                float nrow[16];
#pragma unroll
                for (int q4 = 0; q4 < 4; ++q4) { const f32x4_t nv = *(LAS const f32x4_t*)(sDIAG + (lq * 16 + r) * 16 + 4 * q4); nrow[4 * q4] = nv[0]; nrow[4 * q4 + 1] = nv[1]; nrow[4 * q4 + 2] = nv[2]; nrow[4 * q4 + 3] = nv[3]; }
#pragma unroll
                for (int s = 0; s < 16; ++s) if (s < r) acc = fmaf(nrow[s], x[s], acc);
                x[r] = acc;
                sDM[(lq * 16 + r) * 16 + lr] = (bf16_t)f2bf(acc);
            }
        } else {
            for (int idx = w - 1; idx < 16; idx += 7) {
                const int ti = idx >> 2, vi = idx & 3;
                f32x4_t acc = {0.f, 0.f, 0.f, 0.f};
#pragma unroll
                for (int ks = 0; ks < 2; ++ks) acc = MFMA16(ldsfrag(sA4 + 1 * CSLOT, 16 * ti + lr, 32 * ks + 8 * lq), ldsfrag(sVT, 16 * vi + lr, 32 * ks + 8 * lq), acc);
                lds_st8(sRHST + ((64 + 16 * vi + lr) * CLD + 16 * ti + 4 * lq) * 2, pack4(acc[0], acc[1], acc[2], acc[3]));
            }
        }
        __syncthreads();
        f32x4_t rd[4];
#pragma unroll
        for (int i = 0; i < 4; ++i) {
            bf16x8_t fa = zfrag(), fb = zfrag();
            if (lq < 2) { fa = *(LAS const bf16x8_t*)(sDM + (i * 16 + lr) * 16 + 8 * lq); fb = ldsfrag(sRHST, 16 * w + lr, 16 * i + 8 * lq); }
            rd[i] = MFMA16(fa, fb, ((f32x4_t){0.f, 0.f, 0.f, 0.f}));
        }
        if (w < 6) {
            const int i = (w >= 3) ? 3 : (w >= 1) ? 2 : 1, j = w - (i - 1) * i / 2;
            bf16x8_t fa = zfrag(), fb = zfrag();
            if (lq < 2) {
                fa = *(LAS const bf16x8_t*)(sDM + (i * 16 + lr) * 16 + 8 * lq);
#pragma unroll
                for (int jj = 0; jj < 8; ++jj) fb[jj] = (short)*(LAS const bf16_t*)(sA4 + ((16 * i + 8 * lq + jj) * CLD + 16 * j + lr) * 2);
            }
            const f32x4_t acc = MFMA16(fa, fb, ((f32x4_t){0.f, 0.f, 0.f, 0.f}));
#pragma unroll
            for (int rg = 0; rg < 4; ++rg) *(LAS bf16_t*)(sAD + ((16 * i + 4 * lq + rg) * CLD + 16 * j + lr) * 2) = (bf16_t)f2bf(acc[rg]);
        }
        __syncthreads();
#pragma unroll
        for (int i = 0; i < 4; ++i) {
            f32x4_t acc = rd[i];
            if (i >= 1) {
                bf16x8_t fa = zfrag(), fb = zfrag();
                if (8 * lq < 16 * i) { fa = ldsfrag(sAD, 16 * i + lr, 8 * lq); fb = ldsfrag(sXT, 16 * w + lr, 8 * lq); }
                acc = MFMA16(fa, fb, acc);
            }
            if (i == 3) {
                bf16x8_t fa = zfrag(), fb = zfrag();
                if (lq < 2) { fa = ldsfrag(sAD, 48 + lr, 32 + 8 * lq); fb = ldsfrag(sXT, 16 * w + lr, 32 + 8 * lq); }
                acc = MFMA16(fa, fb, acc);
            }
            lds_st8(sXT + ((16 * w + lr) * CLD + 16 * i + 4 * lq) * 2, pack4(acc[0], acc[1], acc[2], acc[3]));
            asm volatile("s_waitcnt lgkmcnt(0)" ::: "memory");
        }
        __syncthreads();
        if (ci + GA < BATCH * NH * (SEQ / CL)) load_raw(ci + GA);
#pragma unroll
        for (int i = 0; i < 8; ++i) {
            const int kind = i >> 1, tile = w + 8 * (i & 1), r4 = tile >> 2, c4 = tile & 3;
            f32x4_t acc = {0.f, 0.f, 0.f, 0.f};
            if (kind == 0) {
#pragma unroll
                for (int ks = 0; ks < 2; ++ks) acc = MFMA16(ldsfrag(sXT, 16 * r4 + lr, 32 * ks + 8 * lq), ldsfrag(sBtT, 16 * c4 + lr, 32 * ks + 8 * lq), acc);
                const int k = 16 * c4 + lr, kp0 = 16 * r4 + 4 * lq; const float gl = sGL[k];
                float o[4];
#pragma unroll
                for (int rg = 0; rg < 4; ++rg) o[rg] = gl * (acc[rg] + ((k == kp0 + rg) ? 1.0f : 0.0f));
                *(uint2*)(Mq + (size_t)ci * 4096 + k * 64 + kp0) = pack4(o[0], o[1], o[2], o[3]);
            } else if (kind == 1) {
#pragma unroll
                for (int ks = 0; ks < 2; ++ks) {
                    acc = MFMA16(ldsfrag(sBtT, 16 * r4 + lr, 32 * ks + 8 * lq), ldsfrag(sXT, 64 + 16 * c4 + lr, 32 * ks + 8 * lq), acc);
                    acc = MFMA16(ldsfrag(sKtT, 16 * r4 + lr, 32 * ks + 8 * lq), ldsfrag(sVT, 16 * c4 + lr, 32 * ks + 8 * lq), acc);
                }
                const int k0 = 16 * r4 + 4 * lq; const f32x4_t gl = *(LAS const f32x4_t*)(sGL + k0);
                *(uint2*)(NTq + (size_t)ci * 4096 + (16 * c4 + lr) * 64 + k0) = pack4(gl[0] * acc[0], gl[1] * acc[1], gl[2] * acc[2], gl[3] * acc[3]);
            } else if (kind == 2) {
#pragma unroll
                for (int ks = 0; ks < 2; ++ks) acc = MFMA16(ldsfrag(sXT, 16 * r4 + lr, 32 * ks + 8 * lq), ldsfrag(sA4 + 2 * CSLOT, 16 * c4 + lr, 32 * ks + 8 * lq), acc);
                const int t = 16 * c4 + lr, kp0 = 16 * r4 + 4 * lq;
                const uint2 rv = lds_ld8(sRt + (t * CLD + kp0) * 2);
                *(uint2*)(Qq + (size_t)ci * 4096 + t * 64 + kp0) = pack4(acc[0] + bf2f(rv.x & 0xffffu), acc[1] + bf2f(rv.x >> 16), acc[2] + bf2f(rv.y & 0xffffu), acc[3] + bf2f(rv.y >> 16));
            } else {
#pragma unroll
                for (int ks = 0; ks < 2; ++ks) {
                    acc = MFMA16(ldsfrag(sA4 + 2 * CSLOT, 16 * r4 + lr, 32 * ks + 8 * lq), ldsfrag(sXT, 64 + 16 * c4 + lr, 32 * ks + 8 * lq), acc);
                    acc = MFMA16(ldsfrag(sA4 + 3 * CSLOT, 16 * r4 + lr, 32 * ks + 8 * lq), ldsfrag(sVT, 16 * c4 + lr, 32 * ks + 8 * lq), acc);
                }
                *(uint2*)(YTq + (size_t)ci * 4096 + (16 * c4 + lr) * 64 + 16 * r4 + 4 * lq) = pack4(acc[0], acc[1], acc[2], acc[3]);
            }
        }
        __syncthreads();
    }
}

__device__ __forceinline__ void rwkv_phaseB(const Ctx& c, const int bh, const int w) {
    const bf16_t* __restrict__ Mq = (const bf16_t*)(c.ws + WS_CM); const bf16_t* __restrict__ NTq = (const bf16_t*)(c.ws + WS_CN); bf16_t* __restrict__ Sst = (bf16_t*)(c.ws + WS_CS);
    const int lane = c.lane, lr = lane & 15, lq = lane >> 4;
    LAS unsigned char* sS = c.lds + 69632 + c.wid * (16 * CLD * 2);
    {
        {
            bf16x8_t sB0 = zfrag(), sB1 = zfrag();
            bf16x8_t ma[4][4][2]; uint2 nv[4][4];
            const size_t ci0 = (size_t)bh * (SEQ / CL);
#define RB_LOAD(slot, cidx) do { _Pragma("unroll") for (int kt = 0; kt < 4; ++kt) { _Pragma("unroll") for (int ks = 0; ks < 2; ++ks) \
                ma[slot][kt][ks] = *(const bf16x8_t*)(Mq + (cidx) * 4096 + (16 * kt + lr) * 64 + 32 * ks + 8 * lq); nv[slot][kt] = *(const uint2*)(NTq + (cidx) * 4096 + (16 * w + lr) * 64 + 16 * kt + 4 * lq); } } while (0)
#pragma unroll
            for (int sl = 0; sl < 4; ++sl) RB_LOAD(sl, ci0 + sl);
#pragma unroll
            for (int chunk = 0; chunk < SEQ / CL; chunk += 4) {
#pragma unroll
                for (int sl = 0; sl < 4; ++sl) {
                    const size_t ci = ci0 + chunk + sl;
                    asm volatile("global_store_dwordx4 %0, %1, off\n\tglobal_store_dwordx4 %0, %2, off offset:64\n\ts_nop 1" :: "v"(Sst + ci * 4096 + (16 * w + lr) * 64 + 8 * lq), "v"(sB0), "v"(sB1) : "memory");
#pragma unroll
                    for (int kt = 0; kt < 4; ++kt) {
                        f32x4_t acc = {bf2f(nv[sl][kt].x & 0xffffu), bf2f(nv[sl][kt].x >> 16), bf2f(nv[sl][kt].y & 0xffffu), bf2f(nv[sl][kt].y >> 16)};
                        acc = MFMA16(ma[sl][kt][0], sB0, acc); acc = MFMA16(ma[sl][kt][1], sB1, acc);
                        lds_st8(sS + (lr * CLD + 16 * kt + 4 * lq) * 2, pack4(acc[0], acc[1], acc[2], acc[3]));
                    }
                    const size_t cn = (chunk + sl + 4 < SEQ / CL) ? ci + 4 : ci;
                    RB_LOAD(sl, cn);
                    asm volatile("s_waitcnt lgkmcnt(0)" ::: "memory");
                    sB0 = ldsfrag(sS, lr, 8 * lq); sB1 = ldsfrag(sS, lr, 32 + 8 * lq);
                    asm volatile("s_waitcnt lgkmcnt(0)" ::: "memory");
                }
            }
#undef RB_LOAD
        }
    }
}

__device__ __forceinline__ void rwkv_phaseC(const Ctx& c) {
    const bf16_t* __restrict__ Qq = (const bf16_t*)(c.ws + WS_CQ); const bf16_t* __restrict__ YTq = (const bf16_t*)(c.ws + WS_CY); const bf16_t* __restrict__ Sst = (const bf16_t*)(c.ws + WS_CS);
    const float* __restrict__ bon = (const float*)(c.ws + WS_CBON);
    const bf16_t* rw_v = (const bf16_t*)(c.ws + WS_RW_V); const bf16_t* rw_g = (const bf16_t*)(c.ws + WS_RW_G);
    const float* ln_w = c.in[18]; const float* ln_b = c.in[19];
    bf16_t* ycat = (bf16_t*)(c.ws + WS_A);
    const int w = c.wid, lane = c.lane, lr = lane & 15, lq = lane >> 4;
    LAS float* sY = (LAS float*)(c.lds + w * (16 * 68 * 4));
    const int gw = c.bid * 8 + c.wid, NW = c.G * 8;
    for (int task = gw; task < BATCH * NH * (SEQ / CL) * 4; task += NW) {
        const size_t ci = (size_t)(task >> 2); const int tt = task & 3;
        const int bh = (int)(ci >> 7), chunk = (int)(ci & 127), b = bh >> 3, h = bh & 7;
        bf16x8_t qa[2];
#pragma unroll
        for (int ks = 0; ks < 2; ++ks) qa[ks] = *(const bf16x8_t*)(Qq + ci * 4096 + (16 * tt + lr) * 64 + 32 * ks + 8 * lq);
#pragma unroll
        for (int vt = 0; vt < 4; ++vt) {
            const uint2 yv = *(const uint2*)(YTq + ci * 4096 + (16 * vt + lr) * 64 + 16 * tt + 4 * lq);
            f32x4_t acc = {bf2f(yv.x & 0xffffu), bf2f(yv.x >> 16), bf2f(yv.y & 0xffffu), bf2f(yv.y >> 16)};
#pragma unroll
            for (int ks = 0; ks < 2; ++ks) acc = MFMA16(qa[ks], *(const bf16x8_t*)(Sst + ci * 4096 + (16 * vt + lr) * 64 + 32 * ks + 8 * lq), acc);
#pragma unroll
            for (int rg = 0; rg < 4; ++rg) sY[(4 * lq + rg) * 68 + 16 * vt + lr] = acc[rg];
        }
        asm volatile("s_waitcnt lgkmcnt(0)" ::: "memory");
        const int hn = h * 64 + lane;
        const float lw = ln_w[hn], lb = ln_b[hn];
#pragma unroll 4
        for (int tr = 0; tr < 16; ++tr) {
            const int t = chunk * CL + 16 * tt + tr; const size_t tok = (size_t)b * SEQ + t;
            const float y = sY[tr * 68 + lane];
            const float mean = wave_sum_u(y) * (1.f / 64.f);
            const float d = y - mean;
            const float var = wave_sum_u(d * d) * (1.f / 64.f);
            const float yn = d * rsqrtf(var + 64e-5f) * lw + lb;
            const float bonus = bon[ci * CL + 16 * tt + tr] * ldbf(rw_v + tok * RW + hn);
            ycat[tok * D + hn] = (bf16_t)f2bf((yn + bonus) * ldbf(rw_g + tok * RW + hn));
        }
        asm volatile("s_waitcnt lgkmcnt(0)" ::: "memory");
    }
}

constexpr int PA_BLOCKS = 256;
constexpr int CONV_A = 0;
__device__ __forceinline__ void phase6a(const Ctx& c) {
    if (c.G != 256) { rwkv_phaseA(c, c.G); return; }
    if (c.bid < PA_BLOCKS) rwkv_phaseA(c, PA_BLOCKS);
    else if (CONV_A > 0) convert_expert_weights(c, 0, CONV_A, (c.bid - PA_BLOCKS) * 8 + c.wid, (256 - PA_BLOCKS > 0 ? 256 - PA_BLOCKS : 1) * 8);
}

__device__ __forceinline__ void phase6b(const Ctx& c) {
    if (c.wid == 0) {
        for (int tk = c.bid; tk < 2 * S5NG * BATCH; tk += c.G) {
            if (tk < BATCH * NH * 4) { rwkv_phaseB(c, tk >> 2, tk & 3); continue; }
            const float* apow = (const float*)(c.ws + WS_APOW); const float* E = (const float*)((const unsigned char*)c.out + OUT_E);
            bf16_t* ux = (bf16_t*)((unsigned char*)c.out + OUT_UX);
            const int task = tk - BATCH * NH * 4;
            const int g = task >> 2, b = task & 3, p = c.lane;
            const float pr = apow[((size_t)(g * (S5L + 1) + S5L) * 64 + p) * 2], pi = apow[((size_t)(g * (S5L + 1) + S5L) * 64 + p) * 2 + 1];
            float xr = 0.f, xi = 0.f;
            const size_t row0 = (size_t)g * 1024 + b * 256;
            float er[2][8], ei[2][8];
#pragma unroll
            for (int q = 0; q < 8; ++q) { er[0][q] = E[(row0 + q) * 128 + p]; ei[0][q] = E[(row0 + q) * 128 + 64 + p]; }
#pragma unroll
            for (int bt = 0; bt < 32; ++bt) {
                const int cur = bt & 1, nx = cur ^ 1, ch0 = bt * 8;
                if (bt + 1 < 32) {
#pragma unroll
                    for (int q = 0; q < 8; ++q) { er[nx][q] = E[(row0 + ch0 + 8 + q) * 128 + p]; ei[nx][q] = E[(row0 + ch0 + 8 + q) * 128 + 64 + p]; }
                }
#pragma unroll
                for (int q = 0; q < 8; ++q) {
                    st2(ux + (row0 + ch0 + q) * 640 + 512 + p, f2bf(xr)); st2(ux + (row0 + ch0 + q) * 640 + 576 + p, f2bf(xi));
                    const float nr = pr * xr - pi * xi + er[cur][q], ni = pr * xi + pi * xr + ei[cur][q]; xr = nr; xi = ni;
                }
            }
        }
    } else {
        convert_expert_weights(c, (c.G == 256) ? CONV_A : 0, NE * 384, c.bid * 7 + (c.wid - 1), c.G * 7);
    }
}

__device__ __forceinline__ void phase7(const Ctx& c) {
    {
        pg8::Gemm g{(const bf16_t*)((unsigned char*)c.out + OUT_UX), (const bf16_t*)(c.ws + WS_KMAT), 0, 0, 640};
        pg8::S5Order S{256, 2, c.G, c.bid};
        pg8::EpiS5Out E{(bf16_t*)(c.ws + WS_YS5)};
        pg8::gemm_phase<pg8::EpiS5Out, pg8::S5Order, true, true>(c.lds, g, S, E);
    }
    __syncthreads();
    rwkv_phaseC(c);
}

__device__ __forceinline__ void phase8(const Ctx& c) {
    pg8::Gemm g{(const bf16_t*)(c.ws + WS_YS5), (const bf16_t*)(c.ws + WS_WGLU_T), T, 512, 512};
    pg8::StaticOrder S; S.init(T, 512, c.G, c.bid);
    pg8::EpiGLU E{(const bf16_t*)(c.ws + WS_YS5), 512, c.in[29], (bf16_t*)(c.ws + WS_A), D, 512};
    pg8::gemm_phase<pg8::EpiGLU, pg8::StaticOrder, true, true>(c.lds, g, S, E);
}

__device__ __forceinline__ void phase9(const Ctx& c) {
    pg8::Gemm g{(const bf16_t*)(c.ws + WS_A), (const bf16_t*)(c.ws + WS_WOUT_T), T, D, D};
    pg8::StaticOrder S; S.init(T, D, c.G, c.bid);
    pg8::EpiF32 E{(float*)(c.ws + WS_PROJ), D};
    pg8::gemm_phase<pg8::EpiF32, pg8::StaticOrder, true, true>(c.lds, g, S, E);
}

__device__ __forceinline__ void phase10(const Ctx& c) {
    const float* x = c.in[0]; const float* gpm = c.in[5]; const float* gpf = c.in[6];
    const float* mods = (const float*)(c.ws + WS_MODS); const float* mixed = (const float*)(c.ws + WS_PROJ);
    bf16_t* h2 = (bf16_t*)(c.ws + WS_A); float* x1o = c.out;
    const int gw = c.bid * 8 + c.wid, NW = c.G * 8;
    for (int t = gw; t < T; t += NW) {
        const int b = t / SEQ;
        const float4* mr = (const float4*)(mixed + (size_t)t * D) + c.lane;
        const float4* xr = (const float4*)(x + (size_t)t * D) + c.lane;
        float4 m[4], v[4]; float ss = 0.f;
#pragma unroll
        for (int j = 0; j < 4; ++j) { m[j] = mr[64 * j]; v[j] = xr[64 * j]; ss += m[j].x * m[j].x + m[j].y * m[j].y + m[j].z * m[j].z + m[j].w * m[j].w; }
        const float rstd = rsqrtf(wave_sum(ss) * (1.0f / D) + 1e-6f);
        float s1 = 0.f;
#pragma unroll
        for (int j = 0; j < 4; ++j) {
            const int k = (c.lane + 64 * j) * 4;
            const float4 gg = *(const float4*)(gpm + k);
            const float4 gt = *(const float4*)(mods + b * NMODS + 2 * D + k);
            v[j].x += gt.x * (m[j].x * rstd * gg.x); v[j].y += gt.y * (m[j].y * rstd * gg.y);
            v[j].z += gt.z * (m[j].z * rstd * gg.z); v[j].w += gt.w * (m[j].w * rstd * gg.w);
            s1 += v[j].x * v[j].x + v[j].y * v[j].y + v[j].z * v[j].z + v[j].w * v[j].w;
            ((float4*)(x1o + (size_t)t * D) + c.lane)[64 * j] = v[j];
        }
        const float rstd1 = rsqrtf(wave_sum(s1) * (1.0f / D) + 1e-6f);
#pragma unroll
        for (int j = 0; j < 4; ++j) {
            const int k = (c.lane + 64 * j) * 4;
            const float4 gg = *(const float4*)(gpf + k);
            const float4 sh = *(const float4*)(mods + b * NMODS + 3 * D + k);
            const float4 sc = *(const float4*)(mods + b * NMODS + 4 * D + k);
            float r[4];
            r[0] = v[j].x * rstd1 * gg.x * (1.f + sc.x) + sh.x; r[1] = v[j].y * rstd1 * gg.y * (1.f + sc.y) + sh.y;
            r[2] = v[j].z * rstd1 * gg.z * (1.f + sc.z) + sh.z; r[3] = v[j].w * rstd1 * gg.w * (1.f + sc.w) + sh.w;
            unsigned hi[4]; float lo[4];
#pragma unroll
            for (int q = 0; q < 4; ++q) { hi[q] = f2bf(r[q]); lo[q] = r[q] - bf2f(hi[q]); }
            ((uint2*)(h2 + (size_t)t * D) + c.lane)[64 * j] = make_uint2(hi[0] | (hi[1] << 16), hi[2] | (hi[3] << 16));
            ((uint2*)(h2 + (size_t)(T + t) * D) + c.lane)[64 * j] = make_uint2(pk2(lo[0], lo[1]), pk2(lo[2], lo[3]));
        }
    }
}

__device__ __forceinline__ void phase11(const Ctx& c) {
    {
        pg8::Gemm g{(const bf16_t*)(c.ws + WS_A), (const bf16_t*)(c.ws + WS_WR_T), 2 * T, 512, D};
        pg8::StaticOrder S; S.init(2 * T, 512, c.G, c.bid);
        pg8::EpiF32 E{(float*)(c.ws + WS_PLOG), 512};
        pg8::gemm_phase<pg8::EpiF32, pg8::StaticOrder, true, true>(c.lds, g, S, E);
    }
    __syncthreads();
    {
        pg8::Gemm g{(const bf16_t*)(c.ws + WS_A), (const bf16_t*)(c.ws + WS_WSGU_T), T, 512, D};
        pg8::StaticOrder S; S.init(T, 512, c.G, c.bid);
        pg8::EpiSwiGLU E{(bf16_t*)(c.ws + WS_HS), 256};
        pg8::gemm_phase<pg8::EpiSwiGLU, pg8::StaticOrder, true, true>(c.lds, g, S, E);
    }
}

__device__ __forceinline__ unsigned fkey(float f) { const unsigned u = __builtin_bit_cast(unsigned, f); return u ^ ((u >> 31) ? 0xffffffffu : 0x80000000u); }
__device__ __forceinline__ unsigned wave_umax(unsigned v) {
    v = max(v, DPPU(v, 0xB1)); v = max(v, DPPU(v, 0x4E)); v = max(v, DPPU(v, 0x141)); v = max(v, DPPU(v, 0x140));
    const unsigned a = __builtin_amdgcn_readlane(v, 0), b = __builtin_amdgcn_readlane(v, 16), c = __builtin_amdgcn_readlane(v, 32), d = __builtin_amdgcn_readlane(v, 48);
    return max(max(a, b), max(c, d));
}
__device__ __forceinline__ unsigned wave_umin(unsigned v) {
    v = min(v, DPPU(v, 0xB1)); v = min(v, DPPU(v, 0x4E)); v = min(v, DPPU(v, 0x141)); v = min(v, DPPU(v, 0x140));
    const unsigned a = __builtin_amdgcn_readlane(v, 0), b = __builtin_amdgcn_readlane(v, 16), c = __builtin_amdgcn_readlane(v, 32), d = __builtin_amdgcn_readlane(v, 48);
    return min(min(a, b), min(c, d));
}
__device__ __forceinline__ void phase12(const Ctx& c) {
    const float* plog = (const float*)(c.ws + WS_PLOG); const float* rb = c.in[32];
    int* idx = (int*)(c.ws + WS_IDX); float* wt = (float*)(c.ws + WS_WT);
    LAS int* lhist = (LAS int*)c.lds;
    __syncthreads();
    if (c.tid < NE) lhist[c.tid] = 0;
    __syncthreads();
    const int gw = c.bid * 8 + c.wid, NW = c.G * 8, l = c.lane;
    const float4 bias = *(const float4*)(rb + l * 4);
    for (int t = gw; t < T; t += NW) {
        const float4 p0 = *(const float4*)(plog + (size_t)t * 512 + l * 4), p1 = *(const float4*)(plog + (size_t)t * 512 + 256 + l * 4);
        const float4 p2 = *(const float4*)(plog + (size_t)(T + t) * 512 + l * 4), p3 = *(const float4*)(plog + (size_t)(T + t) * 512 + 256 + l * 4);
        const float lg[4] = {p0.x + (p1.x + p2.x + p3.x), p0.y + (p1.y + p2.y + p3.y), p0.z + (p1.z + p2.z + p3.z), p0.w + (p1.w + p2.w + p3.w)};
        float s[4] = {sigmoidf_(lg[0]), sigmoidf_(lg[1]), sigmoidf_(lg[2]), sigmoidf_(lg[3])};
        float ch[4] = {s[0] + bias.x, s[1] + bias.y, s[2] + bias.z, s[3] + bias.w};
        float a1 = fmaxf(ch[0], ch[1]), a2 = fminf(ch[0], ch[1]);
        { const float b1 = fmaxf(ch[2], ch[3]), b2 = fminf(ch[2], ch[3]); const float n1 = fmaxf(a1, b1), n2 = fmaxf(fminf(a1, b1), fmaxf(a2, b2)); a1 = n1; a2 = n2; }
        { const float b1 = DPPF(a1, 0xB1), b2 = DPPF(a2, 0xB1); const float n1 = fmaxf(a1, b1), n2 = fmaxf(fminf(a1, b1), fmaxf(a2, b2)); a1 = n1; a2 = n2; }
        { const float b1 = DPPF(a1, 0x4E), b2 = DPPF(a2, 0x4E); const float n1 = fmaxf(a1, b1), n2 = fmaxf(fminf(a1, b1), fmaxf(a2, b2)); a1 = n1; a2 = n2; }
        { const float b1 = DPPF(a1, 0x141), b2 = DPPF(a2, 0x141); const float n1 = fmaxf(a1, b1), n2 = fmaxf(fminf(a1, b1), fmaxf(a2, b2)); a1 = n1; a2 = n2; }
        const float gs = a1 + a2; const int myg = l >> 3;
        int rank = 0;
#pragma unroll
        for (int g = 0; g < 8; ++g) { const float og = __builtin_bit_cast(float, __builtin_amdgcn_readlane(__builtin_bit_cast(int, gs), g * 8)); rank += (og > gs || (og == gs && g < myg)) ? 1 : 0; }
        const bool sel = rank < 4;
        unsigned mk[4];
#pragma unroll
        for (int i = 0; i < 4; ++i) mk[i] = sel ? fkey(ch[i]) : 0u;
        float sk[8]; int ek[8]; float ssum = 0.f;
#pragma unroll
        for (int k = 0; k < 8; ++k) {
            const unsigned lm = max(max(mk[0], mk[1]), max(mk[2], mk[3]));
            const unsigned m = wave_umax(lm);
            unsigned cand = 1023u;
#pragma unroll
            for (int i = 3; i >= 0; --i) if (mk[i] == m) cand = (unsigned)(l * 4 + i);
            const int be = (int)wave_umin(cand);
            const int ii = be & 3;
            float sv = s[0]; sv = (ii == 1) ? s[1] : sv; sv = (ii == 2) ? s[2] : sv; sv = (ii == 3) ? s[3] : sv;
            sv = __builtin_bit_cast(float, __builtin_amdgcn_readlane(__builtin_bit_cast(int, sv), be >> 2));
            if ((be >> 2) == l) {
#pragma unroll
                for (int i = 0; i < 4; ++i) if (i == ii) mk[i] = 0u;
            }
            sk[k] = sv; ek[k] = be; ssum += sv;
        }
        if (l == 0) {
            const float inv = 2.5f / ssum;
#pragma unroll
            for (int k = 0; k < 8; ++k) { idx[t * 8 + k] = ek[k]; wt[t * 8 + k] = sk[k] * inv; __hip_atomic_fetch_add(lhist + ek[k], 1, __ATOMIC_RELAXED, __HIP_MEMORY_SCOPE_WORKGROUP); }
        }
    }
    __syncthreads();
    if (c.tid < NE) ((int*)(c.ws + WS_HIST))[c.bid * NE + c.tid] = lhist[c.tid];
}

__device__ __forceinline__ void phase13(const Ctx& c) {
    int* smi = (int*)c.sm;
    const int* hist = (const int*)(c.ws + WS_HIST);
    __syncthreads();
    if (c.tid < NE) {
        int tot = 0, base = 0;
        for (int bb = 0; bb < c.G; ++bb) { const int v = hist[bb * NE + c.tid]; tot += v; base += (bb < c.bid) ? v : 0; }
        smi[600 + c.tid] = tot; smi[900 + c.tid] = base; smi[1200 + c.tid] = 0; smi[300 + c.tid] = (tot + 255) >> 8;
    }
    __syncthreads();
    if (c.tid < 64) {
        const int l = c.tid; const int u0 = smi[300 + l * 4], u1 = smi[300 + l * 4 + 1], u2 = smi[300 + l * 4 + 2], u3 = smi[300 + l * 4 + 3];
        const int tot = u0 + u1 + u2 + u3; int inc = tot;
#pragma unroll
        for (int o = 1; o < 64; o <<= 1) { const int v = __shfl_up(inc, o); if (l >= o) inc += v; }
        const int ex = inc - tot;
        smi[l * 4] = ex; smi[l * 4 + 1] = ex + u0; smi[l * 4 + 2] = ex + u0 + u1; smi[l * 4 + 3] = ex + u0 + u1 + u2;
        if (l == 63) smi[NE] = inc;
    }
    __syncthreads();
    const int* idx = (const int*)(c.ws + WS_IDX); int* slotp = (int*)(c.ws + WS_SLOTP); int* uexp = (int*)(c.ws + WS_UEXP); int* slotw = (int*)(c.ws + WS_SLOTW); const float* wt = (const float*)(c.ws + WS_WT);
    const int gw = c.bid * 8 + c.wid, NW = c.G * 8;
    for (int t = gw; t < T; t += NW) {
        if (c.lane < 8) {
            const int a = t * 8 + c.lane, e = idx[a];
            const int pos = smi[900 + e] + __hip_atomic_fetch_add(smi + 1200 + e, 1, __ATOMIC_RELAXED, __HIP_MEMORY_SCOPE_WORKGROUP);
            const int slot = smi[e] * 256 + pos;
            slotp[slot] = a;
            *(int2*)(slotw + 2 * (size_t)slot) = make_int2(a, __float_as_int(wt[a]));
        }
    }
    const int gt = c.bid * 512 + c.tid, NT = c.G * 512;
    for (int e = gt; e < NE; e += NT) {
        const int u0 = smi[e], u1 = smi[e + 1], cn = smi[600 + e];
        for (int p = cn; p < (u1 - u0) * 256; ++p) { slotp[u0 * 256 + p] = -1; *(int2*)(slotw + 2 * (size_t)(u0 * 256 + p)) = make_int2(-1, 0); }
        for (int u = u0; u < u1; ++u) uexp[u] = e;
    }
    if (gt == 0) uexp[2048] = smi[NE];
}

__device__ __forceinline__ void phase14(const Ctx& c) {
    const int* uexp = (const int*)(c.ws + WS_UEXP);
    const int NU = __builtin_amdgcn_readfirstlane(uexp[2048]);
    const int vcu = (c.G % 8 == 0) ? (c.bid % 8) * (c.G / 8) + c.bid / 8 : c.bid;
    pg8::Gemm g{(const bf16_t*)(c.ws + WS_A), (const bf16_t*)(c.ws + WS_WEGU), 0, 0, D, (const int*)(c.ws + WS_SLOTP)};
    pg8::ExpertOrder S{uexp, NU, 2, c.G, vcu};
    pg8::EpiSwiGLU E{(bf16_t*)(c.ws + WS_HID), 256};
    pg8::gemm_phase<pg8::EpiSwiGLU, pg8::ExpertOrder, true, true, true>(c.lds, g, S, E);
}

__device__ __forceinline__ void phase15(const Ctx& c) {
    {
        const int* uexp = (const int*)(c.ws + WS_UEXP);
        const int NU = __builtin_amdgcn_readfirstlane(uexp[2048]);
        const int vcu = (c.G % 8 == 0) ? (c.bid % 8) * (c.G / 8) + c.bid / 8 : c.bid;
        pg8::Gemm g{(const bf16_t*)(c.ws + WS_HID), (const bf16_t*)(c.ws + WS_WED), 0, 0, EFF};
        pg8::ExpertOrder S{uexp, NU, 4, c.G, vcu};
        pg8::EpiScatter E{(const int*)(c.ws + WS_SLOTW), (bf16_t*)(c.ws + WS_YEXP), D};
        pg8::gemm_phase<pg8::EpiScatter, pg8::ExpertOrder, true, true>(c.lds, g, S, E);
    }
    __syncthreads();
    {
        pg8::Gemm g{(const bf16_t*)(c.ws + WS_HS), (const bf16_t*)(c.ws + WS_WSD_T), T, D, 256};
        pg8::StaticOrder S; S.init(T, D, c.G, c.bid);
        pg8::EpiF32 E{(float*)(c.ws + WS_SHOUT), D};
        pg8::gemm_phase<pg8::EpiF32, pg8::StaticOrder, true, true>(c.lds, g, S, E);
    }
}

__device__ __forceinline__ void phase16(const Ctx& c) {
    const float* gq = c.in[7]; const float* mods = (const float*)(c.ws + WS_MODS);
    const float* shout = (const float*)(c.ws + WS_SHOUT); const bf16_t* yexp = (const bf16_t*)(c.ws + WS_YEXP);
    float* out = c.out; float* dst = c.dry ? (float*)(c.ws + WS_PROJ) : c.out;
    const int gw = c.bid * 8 + c.wid, NW = c.G * 8;
    for (int t = gw; t < T; t += NW) {
        const int b = t / SEQ;
        float y[2][8], x1[2][8]; float ss = 0.f;
        uint4 ye[2][8]; float4 sh[2][2], xv[2][2];
#pragma unroll
        for (int j = 0; j < 2; ++j) {
            const int k = (c.lane + 64 * j) * 8;
            sh[j][0] = *(const float4*)(shout + (size_t)t * D + k); sh[j][1] = *(const float4*)(shout + (size_t)t * D + k + 4);
            xv[j][0] = *(const float4*)(out + (size_t)t * D + k); xv[j][1] = *(const float4*)(out + (size_t)t * D + k + 4);
#pragma unroll
            for (int q = 0; q < 8; ++q) ye[j][q] = *(const uint4*)(yexp + (size_t)(t * 8 + q) * D + k);
        }
#pragma unroll
        for (int j = 0; j < 2; ++j) {
            y[j][0] = sh[j][0].x; y[j][1] = sh[j][0].y; y[j][2] = sh[j][0].z; y[j][3] = sh[j][0].w; y[j][4] = sh[j][1].x; y[j][5] = sh[j][1].y; y[j][6] = sh[j][1].z; y[j][7] = sh[j][1].w;
            x1[j][0] = xv[j][0].x; x1[j][1] = xv[j][0].y; x1[j][2] = xv[j][0].z; x1[j][3] = xv[j][0].w; x1[j][4] = xv[j][1].x; x1[j][5] = xv[j][1].y; x1[j][6] = xv[j][1].z; x1[j][7] = xv[j][1].w;
#pragma unroll
            for (int q = 0; q < 8; ++q) { float u[8]; unpack8(ye[j][q], u);
#pragma unroll
                for (int i = 0; i < 8; ++i) y[j][i] += u[i]; }
#pragma unroll
            for (int i = 0; i < 8; ++i) ss += y[j][i] * y[j][i];
        }
        const float rstd = rsqrtf(wave_sum_u(ss) * (1.0f / D) + 1e-6f);
#pragma unroll
        for (int j = 0; j < 2; ++j) {
            const int k = (c.lane + 64 * j) * 8;
            const float4 g0 = *(const float4*)(gq + k), g1 = *(const float4*)(gq + k + 4);
            const float4 t0 = *(const float4*)(mods + b * NMODS + 5 * D + k), t1 = *(const float4*)(mods + b * NMODS + 5 * D + k + 4);
            const float gg[8] = {g0.x, g0.y, g0.z, g0.w, g1.x, g1.y, g1.z, g1.w}, gt[8] = {t0.x, t0.y, t0.z, t0.w, t1.x, t1.y, t1.z, t1.w};
            float o[8];
#pragma unroll
            for (int i = 0; i < 8; ++i) o[i] = x1[j][i] + gt[i] * (y[j][i] * rstd * gg[i]);
            *(float4*)(dst + (size_t)t * D + k) = make_float4(o[0], o[1], o[2], o[3]); *(float4*)(dst + (size_t)t * D + k + 4) = make_float4(o[4], o[5], o[6], o[7]);
        }
    }
}

constexpr int NPHASES = 18;
__device__ __forceinline__ void probe_reset(const Ctx& c, int k) {
    unsigned* counts = (unsigned*)(c.ws + WS_COUNTS);
    if (k == 13 && c.bid == 0 && c.tid < 256) counts[c.tid] = 0u;
    if (k == 14 && c.bid == 0 && c.tid < 256) counts[256 + c.tid] = 0u;
}

__global__ void __launch_bounds__(512, 2) mega(Args args) {
    extern __shared__ __attribute__((aligned(16))) unsigned char lds_raw[];
    Ctx c;
    c.in = args.in; c.out = args.out; c.ws = args.ws;
    c.lds = (LAS unsigned char*)lds_raw; c.sm = (float*)lds_raw;
    c.dry = 0;
    c.tid = threadIdx.x; c.lane = c.tid & 63; c.wid = __builtin_amdgcn_readfirstlane(c.tid >> 6); c.bid = blockIdx.x; c.G = gridDim.x;
    volatile LAS unsigned* st = (volatile LAS unsigned*)(c.lds + LDS_CTL_OFF);
    if (c.tid < 4) st[c.tid] = 0u;
    __syncthreads();
    XcdBarrier bar; bar.bar = (unsigned*)(args.ws + WS_CTL); bar.x = 0; bar.st = st;
    const bool multi = (args.hi - args.lo) > 1;
    if (multi) bar = xcd_barrier_post((unsigned*)(args.ws + WS_CTL), st);
    const int lo = args.lo, hi = args.hi;
#ifndef REPEAT_PHASE
#define REPEAT_PHASE -1
#endif
#define LAUNDER() do { int t_ = threadIdx.x; asm volatile("" : "+v"(t_)); c.tid = t_; c.lane = t_ & 63; int b_ = blockIdx.x; asm volatile("" : "+s"(b_)); c.bid = b_; } while (0)
#define RUN_PHASE(k, call) if (lo <= (k) && (k) < hi) { if ((k) == REPEAT_PHASE) { LAUNDER(); c.dry = 1; call; c.dry = 0; xcd_barrier(bar); probe_reset(c, (k)); xcd_barrier(bar); } LAUNDER(); call; if ((k) + 1 < hi) xcd_barrier(bar); }
    RUN_PHASE(0, phase0(c))
    RUN_PHASE(1, phase1(c))
    RUN_PHASE(2, phase2(c))
    RUN_PHASE(3, phase3(c))
    RUN_PHASE(4, phase4(c))
    RUN_PHASE(5, phase5(c))
    RUN_PHASE(6, phase6a(c))
    RUN_PHASE(7, phase6b(c))
    RUN_PHASE(8, phase7(c))
    RUN_PHASE(9, phase8(c))
    RUN_PHASE(10, phase9(c))
    RUN_PHASE(11, phase10(c))
    RUN_PHASE(12, phase11(c))
    RUN_PHASE(13, phase12(c))
    RUN_PHASE(14, phase13(c))
    RUN_PHASE(15, phase14(c))
    RUN_PHASE(16, phase15(c))
    RUN_PHASE(17, phase16(c))
#undef RUN_PHASE
}

#ifndef N_LAUNCH_MODE
#define N_LAUNCH_MODE 1
#endif

extern "C" void kernel_launch(void* const* d_in, const int* in_sizes, int n_in, void* d_out, int out_size, void* d_ws, size_t ws_size, hipStream_t stream) {
    static int grid = 0;
    if (grid == 0) {
        if (n_in != 39 || out_size != T * D || ws_size < WS_END) { fprintf(stderr, "kernel_launch: unexpected shapes n_in %d out %d ws %zu\n", n_in, out_size, ws_size); grid = -1; return; }
        int dev = 0, cus = 0, per_cu = 0;
        if (hipGetDevice(&dev) != hipSuccess || hipDeviceGetAttribute(&cus, hipDeviceAttributeMultiprocessorCount, dev) != hipSuccess) { grid = -1; return; }
        if (hipFuncSetAttribute((const void*)mega, hipFuncAttributeMaxDynamicSharedMemorySize, LDS_BYTES) != hipSuccess) { grid = -1; return; }
        if (hipOccupancyMaxActiveBlocksPerMultiprocessor(&per_cu, (const void*)mega, 512, LDS_BYTES) != hipSuccess || per_cu < 1) { fprintf(stderr, "kernel_launch: occupancy query says %d\n", per_cu); }
        (void)hipGetLastError();
        grid = cus;
    }
    if (grid < 0) return;
    (void)hipMemsetAsync((char*)d_ws + WS_CTL, 0, CTL_BYTES, stream);
    Args a{};
    for (int i = 0; i < 39; ++i) a.in[i] = (const float*)d_in[i];
    a.out = (float*)d_out; a.ws = (unsigned char*)d_ws;
    if (N_LAUNCH_MODE == 1) {
        a.lo = 0; a.hi = NPHASES;
        hipLaunchKernelGGL(mega, dim3(grid), dim3(512), LDS_BYTES, stream, a);
    } else {
        for (int ph = 0; ph < NPHASES; ++ph) {
            a.lo = ph; a.hi = ph + 1;
            hipLaunchKernelGGL(mega, dim3(grid), dim3(512), LDS_BYTES, stream, a);
        }
    }
}
```

```cpp
#include <hip/hip_runtime.h>
#include <cstdint>
#include <cstdio>

#define LAS __attribute__((address_space(3)))

constexpr int D = 1024, BATCH = 4, SEQ = 8192, T = BATCH * SEQ;
constexpr int RW = 512, NH = 8;
constexpr int RPROJ = 1792, NPROJ = 2304;
constexpr int S5NG = 32, S5P = 64;
constexpr int NE = 256, EFF = 256;
constexpr int NMODS = 6 * D;
constexpr int S5L = 32;

constexpr size_t MiB = 1u << 20;
constexpr size_t WS_CTL = 0, CTL_BYTES = 1 * MiB;
constexpr size_t WS_COUNTS = 64 * 1024;
constexpr size_t WS_MODS = 1 * MiB;
constexpr size_t WS_HMAT = 2 * MiB;
constexpr size_t WS_WIN_T = 12 * MiB;
constexpr size_t WS_WOUT_T = 17 * MiB;
constexpr size_t WS_WGLU_T = 19 * MiB;
constexpr size_t WS_WSGU_T = 19 * MiB + 512 * 1024;
constexpr size_t WS_WSD_T = 20 * MiB + 512 * 1024;
constexpr size_t WS_WR_T = 21 * MiB;
constexpr size_t WS_LORA_BT = 22 * MiB;
constexpr size_t WS_APOW = 23 * MiB;
constexpr size_t WS_KMAT = 1000 * MiB;
constexpr size_t WS_MODSP = 1020 * MiB;
constexpr size_t WS_S5BB = 1022 * MiB;
constexpr size_t WS_KLAG = 1022 * MiB + 512 * 1024;
constexpr size_t OUT_UX = 0;
constexpr size_t OUT_E = 40 * MiB;
constexpr size_t OUT_ALORA = 56 * MiB;
constexpr size_t OUT_KF = 72 * MiB;
constexpr size_t WS_WED = 24 * MiB;
constexpr size_t WS_WEGU = 152 * MiB;
constexpr size_t WS_A = 408 * MiB;
constexpr size_t WS_YS5 = WS_A + 64 * MiB;
constexpr size_t WS_PROJ = 536 * MiB;
constexpr size_t WS_RW = 680 * MiB;
constexpr size_t RWSZ = (size_t)T * RW * 4;
constexpr size_t RWSZH = (size_t)T * RW * 2;
constexpr size_t WS_RW_W = WS_RW, WS_RW_Y = WS_RW + RWSZ, WS_RW_R = WS_RW + 2 * RWSZ, WS_RW_K = WS_RW_R + RWSZH, WS_RW_V = WS_RW_K + RWSZH,
                 WS_RW_A = WS_RW_V + RWSZH, WS_RW_B = WS_RW_A + RWSZH, WS_RW_G = WS_RW_B + RWSZH;
constexpr size_t WS_CM = WS_PROJ, WS_CN = WS_PROJ + 32 * MiB, WS_CQ = WS_PROJ + 64 * MiB, WS_CY = WS_PROJ + 96 * MiB;
constexpr size_t WS_CS = WS_RW_Y, WS_CBON = WS_RW_Y + 32 * MiB;
constexpr size_t WS_PLOG = 680 * MiB;
constexpr size_t WS_SHOUT = 680 * MiB;
constexpr size_t WS_HS = 808 * MiB;
constexpr size_t WS_IDX = 824 * MiB;
constexpr size_t WS_WT = 825 * MiB;
constexpr size_t WS_SLOTP = 826 * MiB;
constexpr size_t WS_UEXP = 827 * MiB + 512 * 1024;
constexpr size_t WS_SLOTW = 828 * MiB;
constexpr size_t WS_HIST = 831 * MiB;
constexpr size_t WS_HID = 840 * MiB;
constexpr size_t WS_YEXP = 152 * MiB;
constexpr size_t WS_END = 1023 * MiB + 512 * 1024;

constexpr int LDS_BYTES = 132096;
constexpr int LDS_CTL_OFF = 131072;

#define XB_TMO      128
#define XB_XCNT(j)  (256  + 64 * (j))
#define XB_XSUB(j)  (1280 + 64 * (j))
#define XB_XGEN(j)  (2304 + 64 * (j))
#define XB_TOP      3328
#define XB_TOPGEN   3392
#define XCD_BAR_WORDS 3456
#define XB_SPIN_CAP (1u << 24)

__device__ __forceinline__ unsigned xb_ld(unsigned* p)              { return __hip_atomic_load(p, __ATOMIC_RELAXED, __HIP_MEMORY_SCOPE_AGENT); }
__device__ __forceinline__ unsigned xb_add(unsigned* p, unsigned v) { return __hip_atomic_fetch_add(p, v, __ATOMIC_RELAXED, __HIP_MEMORY_SCOPE_AGENT); }
__device__ __forceinline__ unsigned xb_xcc_id() { return (unsigned)__builtin_amdgcn_s_getreg((3 << 11) | 20) & 0xFu; }
#define XB_SPIN(cond, bar) do { unsigned _sp = 0; while (cond) { __builtin_amdgcn_s_sleep(1); \
    if ((++_sp & 255u) == 0u) { if (xb_ld(&(bar)[XB_TMO])) break; if (_sp > XB_SPIN_CAP) { atomicAdd(&(bar)[XB_TMO], 1u); break; } } } } while (0)

struct XcdBarrier { unsigned* bar; unsigned x; volatile LAS unsigned* st; };

__device__ __forceinline__ XcdBarrier xcd_barrier_post(unsigned* bar, volatile LAS unsigned* st) {
    XcdBarrier b; b.bar = bar; b.x = xb_xcc_id(); b.st = st;
    if (threadIdx.x == 0) (void)xb_add(&bar[XB_XCNT(b.x)], 1u);
    return b;
}
__device__ __forceinline__ void xcd_barrier_complete(unsigned* bar, unsigned x, unsigned& nloc, unsigned& nx) {
    const unsigned G = gridDim.x * gridDim.y * gridDim.z;
    unsigned sum, cnt, mine, sp = 0u;
    for (;;) {
        sum = 0u; cnt = 0u; mine = 0u;
#pragma unroll
        for (unsigned j = 0; j < 16; ++j) { const unsigned c = xb_ld(&bar[XB_XCNT(j)]); sum += c; cnt += (c > 0u) ? 1u : 0u; mine = (j == x) ? c : mine; }
        if (sum == G) break;
        __builtin_amdgcn_s_sleep(1);
        if ((++sp & 255u) == 0u) { if (xb_ld(&bar[XB_TMO])) break; if (sp > XB_SPIN_CAP) { atomicAdd(&bar[XB_TMO], 1u); break; } }
    }
    nloc = mine > 0u ? mine : 1u; nx = cnt > 0u ? cnt : 1u;
}
__device__ __forceinline__ void xcd_barrier(const XcdBarrier& b) {
    asm volatile("s_waitcnt vmcnt(0)" ::: "memory");
    __syncthreads();
    if (threadIdx.x == 0) {
        unsigned* bar = b.bar;
        __builtin_amdgcn_s_waitcnt(0);
        unsigned nloc = b.st[0], nx = b.st[1];
        if (nloc == 0u) { xcd_barrier_complete(bar, b.x, nloc, nx); b.st[0] = nloc; b.st[1] = nx; }
        const unsigned old = xb_add(&bar[XB_XSUB(b.x)], 1u);
        const unsigned gen = old / nloc;
        if (old + 1u == (gen + 1u) * nloc) {
            __builtin_amdgcn_fence(__ATOMIC_RELEASE, "agent");
            asm volatile("s_waitcnt vmcnt(0)" ::: "memory");
            const unsigned og = xb_add(&bar[XB_TOP], 1u);
            const unsigned tg = og / nx;
            if (og + 1u == (tg + 1u) * nx) xb_add(&bar[XB_TOPGEN], 1u);
            else XB_SPIN(xb_ld(&bar[XB_TOPGEN]) == tg, bar);
            __builtin_amdgcn_fence(__ATOMIC_ACQUIRE, "agent");
            xb_add(&bar[XB_XGEN(b.x)], 1u);
            asm volatile("s_waitcnt vmcnt(0)" ::: "memory");
        } else {
            XB_SPIN(xb_ld(&bar[XB_XGEN(b.x)]) == gen, bar);
            __builtin_amdgcn_fence(__ATOMIC_ACQUIRE, "agent");
            asm volatile("s_waitcnt vmcnt(0)" ::: "memory");
        }
    }
    __syncthreads();
}

namespace pg8 {
#define PG8_LAS __attribute__((address_space(3)))
typedef unsigned short bf16_t;
typedef short bf16x8 __attribute__((ext_vector_type(8)));
typedef float f32x4 __attribute__((ext_vector_type(4)));
typedef unsigned u32x4 __attribute__((ext_vector_type(4)));
constexpr int BM = 256, BK = 64, HALF = 128, HTB = HALF * BK * 2  , STAGE_BYTES = 8 * HTB, NXCD = 8, WGM = 8;

__host__ __device__ __forceinline__ int lds_byte(int r, int c) { const int st = (r >> 4) * 2 + (c >> 5), rr = r & 15, cc = c & 31, ob = rr * 64 + cc * 2; return st * 1024 + (ob ^ (((ob >> 9) & 1) << 5)); }
__host__ __device__ __forceinline__ void stage_rc(int b, int& R, int& C) { const int st = b / 1024, sb = b % 1024, swz = sb ^ (((sb >> 9) & 1) << 5); R = (st >> 1) * 16 + swz / 64; C = (st & 1) * 32 + (swz % 64) / 2; }
__host__ __device__ __forceinline__ int perm32(int rho) { const int n = rho >> 4, i = rho & 15; return 8 * (i >> 2) + 4 * n + (i & 3); }

struct Unit { int pm, pn; };
struct Gemm { const bf16_t* A; const bf16_t* Bt; int M, N, K; const int* rowtab = nullptr; };

struct StaticOrder {
    int nM, nN, nwg, G, c;
    __host__ __device__ void init(int M, int N, int G_, int c_) { nM = M / BM; nN = N / BM; nwg = nM * nN; G = G_; c = c_; }
    __host__ __device__ bool next(int i, Unit& u) const {
        const long L = (long)i * G + c; if (L >= nwg) return false;
        int wgid = (int)L; { const int q = nwg / NXCD, r = nwg % NXCD, xcd = wgid % NXCD, off = wgid / NXCD; wgid = (xcd < r ? xcd * (q + 1) : r * (q + 1) + (xcd - r) * q) + off; }
        const int nig = WGM * nN, gid = wgid / nig, fm = gid * WGM, gsz = (nM - fm) < WGM ? (nM - fm) : WGM;
        u.pm = fm + ((wgid % nig) % gsz); u.pn = (wgid % nig) / gsz; return true;
    }
    __device__ __forceinline__ void a_ready(const Unit&) const {}
    __device__ __forceinline__ void done(const Unit&) const {}
};

__device__ __forceinline__ unsigned cvt_pk_bf16(float lo, float hi) { unsigned r; asm volatile("v_cvt_pk_bf16_f32 %0, %1, %2" : "=v"(r) : "v"(lo), "v"(hi)); return r; }
typedef float f32x2 __attribute__((ext_vector_type(2)));
__device__ __forceinline__ f32x2 gelu_pk(f32x2 v) {
    const f32x2 av = __builtin_elementwise_abs(v), d = av * 0.2316418882f + 1.0f;
    f32x2 t; t.x = __builtin_amdgcn_rcpf(d.x); t.y = __builtin_amdgcn_rcpf(d.y);
    f32x2 q = t * 0.5307027145f + (-0.7265760135f); q = q * t + 0.7107068705f; q = q * t + (-0.142248368f); q = q * t + 0.127414796f; q = q * t;
    const f32x2 s = (v * v) * (-0.72134752044f);
    f32x2 e; e.x = __builtin_amdgcn_exp2f(s.x); e.y = __builtin_amdgcn_exp2f(s.y);
    const f32x2 m = v * (q * e), r = v - m;
    f32x2 o; o.x = v.x < 0.f ? m.x : r.x; o.y = v.y < 0.f ? m.y : r.y; return o;
}

template <int ACT  > struct EpiBf16 {
    static constexpr bool PERM = true, AFTER_DRAIN = false; static_assert(ACT == 0 || ACT == 1, "EpiBf16: ACT is 0 (none) or 1 (gelu_pk)");
    bf16_t* O; int ldc; const float* bias; int split_cols; size_t split_stride; float scale0;
    __device__ __forceinline__ void operator()(const f32x4 (&acc)[2][2][4][2], const Unit& u, int wr, int wc, int fr, int fq) const {
        const int row0 = u.pm * BM + wr * 64 + fr; int colt = u.pn * BM; bf16_t* base = O;
        float sc = 1.f; if (split_cols) { const int t = colt / split_cols; base += (size_t)t * split_stride; colt -= t * split_cols; if (t == 0) sc = scale0; }
        const int col0 = colt + wc * 32 + 8 * fq, bcol0 = u.pn * BM + wc * 32 + 8 * fq;
        f32x4 bv[2][2];
#pragma unroll
        for (int bj = 0; bj < 2; ++bj)
#pragma unroll
            for (int n = 0; n < 2; ++n) bv[bj][n] = bias ? *(const f32x4*)(bias + bcol0 + bj * HALF + 4 * n) : (f32x4){0.f, 0.f, 0.f, 0.f};
#pragma unroll
        for (int ai = 0; ai < 2; ++ai)
#pragma unroll
            for (int m = 0; m < 4; ++m) { bf16_t* rowp = base + (size_t)(row0 + ai * HALF + m * 16) * ldc + col0;
#pragma unroll
                for (int bj = 0; bj < 2; ++bj) { f32x4 v0 = acc[ai][bj][m][0] + bv[bj][0], v1 = acc[ai][bj][m][1] + bv[bj][1];
                    if (ACT == 1) { f32x2 a = gelu_pk((f32x2){v0[0], v0[1]}), b = gelu_pk((f32x2){v0[2], v0[3]}), c = gelu_pk((f32x2){v1[0], v1[1]}), d = gelu_pk((f32x2){v1[2], v1[3]});
                        v0 = (f32x4){a.x, a.y, b.x, b.y}; v1 = (f32x4){c.x, c.y, d.x, d.y}; }
                    v0 = v0 * sc; v1 = v1 * sc; u32x4 w; w.x = cvt_pk_bf16(v0[0], v0[1]); w.y = cvt_pk_bf16(v0[2], v0[3]); w.z = cvt_pk_bf16(v1[0], v1[1]); w.w = cvt_pk_bf16(v1[2], v1[3]);
                    *(u32x4*)(rowp + bj * HALF) = w; } }
    }
};

struct EpiF32 {
    static constexpr bool PERM = false, AFTER_DRAIN = false;
    float* C; int ldc;
    __device__ __forceinline__ void operator()(const f32x4 (&acc)[2][2][4][2], const Unit& u, int wr, int wc, int fr, int fq) const {
        const int row0 = u.pm * BM + wr * 64 + fr, col0 = u.pn * BM + wc * 32 + 4 * fq;
#pragma unroll
        for (int ai = 0; ai < 2; ++ai)
#pragma unroll
            for (int m = 0; m < 4; ++m) { float* rowp = C + (size_t)(row0 + ai * HALF + m * 16) * ldc + col0;
#pragma unroll
                for (int bj = 0; bj < 2; ++bj)
#pragma unroll
                    for (int n = 0; n < 2; ++n) *(f32x4*)(rowp + bj * HALF + n * 16) = acc[ai][bj][m][n]; }
    }
};
__device__ __forceinline__ float fast_sigmoid(float x) { return __builtin_amdgcn_rcpf(1.0f + __builtin_amdgcn_exp2f(-1.4426950408889634f * x)); }
struct EpiSwiGLU {
    static constexpr bool PERM = true, AFTER_DRAIN = false;
    bf16_t* O; int ldo;
    __device__ __forceinline__ void operator()(const f32x4 (&acc)[2][2][4][2], const Unit& u, int wr, int wc, int fr, int fq) const {
        const int row0 = u.pm * BM + wr * 64 + fr, col0 = (u.pn & 1) * HALF + wc * 32 + 8 * fq;
#pragma unroll
        for (int ai = 0; ai < 2; ++ai)
#pragma unroll
            for (int m = 0; m < 4; ++m) {
                bf16_t* rowp = O + (size_t)(row0 + ai * HALF + m * 16) * ldo + col0;
                const f32x4 g0 = acc[ai][0][m][0], g1 = acc[ai][0][m][1], u0 = acc[ai][1][m][0], u1 = acc[ai][1][m][1];
                float r[8];
#pragma unroll
                for (int i = 0; i < 4; ++i) { r[i] = g0[i] * fast_sigmoid(g0[i]) * u0[i]; r[4 + i] = g1[i] * fast_sigmoid(g1[i]) * u1[i]; }
                u32x4 w; w.x = cvt_pk_bf16(r[0], r[1]); w.y = cvt_pk_bf16(r[2], r[3]); w.z = cvt_pk_bf16(r[4], r[5]); w.w = cvt_pk_bf16(r[6], r[7]);
                *(u32x4*)rowp = w;
            }
    }
};
struct EpiScatter {
    static constexpr bool PERM = true, AFTER_DRAIN = false;
    const int* slotw; bf16_t* Y; int ldy;
    __device__ __forceinline__ void operator()(const f32x4 (&acc)[2][2][4][2], const Unit& u, int wr, int wc, int fr, int fq) const {
        int t2 = threadIdx.x; asm volatile("" : "+v"(t2));
        const int fr2 = t2 & 15, fq2 = (t2 >> 4) & 3, wc2 = (t2 >> 6) & 3, wr2 = (t2 >> 8) & 1;
        const int col0 = (u.pn & 3) * BM + wc2 * 32 + 8 * fq2;
        const int rbase = u.pm * BM + wr2 * 64 + fr2;
        typedef int i32x2 __attribute__((ext_vector_type(2)));
        i32x2 rec[2][4];
#pragma unroll
        for (int ai = 0; ai < 2; ++ai)
#pragma unroll
            for (int m = 0; m < 4; ++m) rec[ai][m] = *(const i32x2*)(slotw + 2 * (size_t)(rbase + ai * HALF + m * 16));
#pragma unroll
        for (int ai = 0; ai < 2; ++ai)
#pragma unroll
            for (int m = 0; m < 4; ++m) {
                const int aid = rec[ai][m].x;
                if (aid >= 0) {
                    const int wbits = rec[ai][m].y;
                    const float w = __int_as_float(wbits);
                    unsigned char* rowp = (unsigned char*)Y + (size_t)aid * ldy + col0;
#pragma unroll
                    for (int bj = 0; bj < 2; ++bj) {
                        const f32x4 v0 = acc[ai][bj][m][0] * w, v1 = acc[ai][bj][m][1] * w;
                        int lo = 0, hi = 0;
                        lo = __builtin_amdgcn_cvt_pk_fp8_f32(v0[0], v0[1], lo, false); lo = __builtin_amdgcn_cvt_pk_fp8_f32(v0[2], v0[3], lo, true);
                        hi = __builtin_amdgcn_cvt_pk_fp8_f32(v1[0], v1[1], hi, false); hi = __builtin_amdgcn_cvt_pk_fp8_f32(v1[2], v1[3], hi, true);
                        typedef int i32x2s __attribute__((ext_vector_type(2)));
                        *(i32x2s*)(rowp + bj * HALF) = (i32x2s){lo, hi};
                    }
                }
            }
    }
};
struct ExpertOrder {
    const int* uexp; int NU, npn, G, c;
    __device__ __forceinline__ bool next(int i, Unit& u) const {
        const int L = i * G + c; if (L >= NU * npn) return false;
        const int uu = L / npn, pl = L % npn;
        u.pm = uu; u.pn = __builtin_amdgcn_readfirstlane(uexp[uu]) * npn + pl; return true;
    }
    __device__ __forceinline__ void a_ready(const Unit&) const {}
    __device__ __forceinline__ void done(const Unit&) const {}
};
struct S5Order {
    int NUNITS, npn, G, c;
    __device__ __forceinline__ bool next(int i, Unit& u) const {
        const int L = i * G + c; if (L >= NUNITS) return false;
        u.pm = L / npn; u.pn = (u.pm >> 2) * npn + L % npn; return true;
    }
    __device__ __forceinline__ void a_ready(const Unit&) const {}
    __device__ __forceinline__ void done(const Unit&) const {}
};
struct EpiS5E {
    static constexpr bool PERM = false, AFTER_DRAIN = false;
    float* E;
    __device__ __forceinline__ void operator()(const f32x4 (&acc)[2][2][4][2], const Unit& u, int wr, int wc, int fr, int fq) const {
        const int row0 = u.pm * BM + wr * 64 + fr, col0 = wc * 32 + 4 * fq;
#pragma unroll
        for (int ai = 0; ai < 2; ++ai)
#pragma unroll
            for (int m = 0; m < 4; ++m) { float* rowp = E + (size_t)(row0 + ai * HALF + m * 16) * 128 + col0;
#pragma unroll
                for (int n = 0; n < 2; ++n) *(f32x4*)(rowp + n * 16) = acc[ai][0][m][n]; }
    }
};
struct EpiS5Out {
    static constexpr bool PERM = true, AFTER_DRAIN = false;
    bf16_t* Y;
    __device__ __forceinline__ void operator()(const f32x4 (&acc)[2][2][4][2], const Unit& u, int wr, int wc, int fr, int fq) const {
        const int g = u.pm >> 2;
#pragma unroll
        for (int ai = 0; ai < 2; ++ai)
#pragma unroll
            for (int m = 0; m < 4; ++m) {
                const int r = (u.pm & 3) * BM + ai * HALF + wr * 64 + m * 16 + fr, b = r >> 8, chunk = r & 255;
#pragma unroll
                for (int bj = 0; bj < 2; ++bj) {
                    const int colg = (u.pn & 1) * BM + bj * HALF + wc * 32 + 8 * fq, t = colg >> 4, c0 = colg & 15;
                    const f32x4 v0 = acc[ai][bj][m][0], v1 = acc[ai][bj][m][1];
                    float x[8] = {v0[0], v0[1], v0[2], v0[3], v1[0], v1[1], v1[2], v1[3]};
#pragma unroll
                    for (int i = 0; i < 8; ++i) { const float z = x[i]; x[i] = z * fast_sigmoid(1.5957691216057308f * (z + 0.044715f * z * z * z)); }
                    u32x4 w; w.x = cvt_pk_bf16(x[0], x[1]); w.y = cvt_pk_bf16(x[2], x[3]); w.z = cvt_pk_bf16(x[4], x[5]); w.w = cvt_pk_bf16(x[6], x[7]);
                    *(u32x4*)(Y + ((size_t)(b * 8192 + chunk * 32 + t)) * 512 + g * 16 + c0) = w;
                }
            }
    }
};
struct EpiLora {
    static constexpr bool PERM = true, AFTER_DRAIN = false;
    const float* w0; const float* a0; const float* k_a; float* W; const bf16_t* Kp; bf16_t* Kf; const bf16_t* A; bf16_t* B; bf16_t* Gt;
    __device__ __forceinline__ void operator()(const f32x4 (&acc)[2][2][4][2], const Unit& u, int wr, int wc, int fr, int fq) const {
        const int seg = u.pn >> 1;
#pragma unroll
        for (int bj = 0; bj < 2; ++bj) {
            const int nn = (u.pn & 1) * BM + bj * HALF + wc * 32 + 8 * fq;
            float p0[8], p1[8];
            if (seg == 0) { const f32x4 a = *(const f32x4*)(w0 + nn), b = *(const f32x4*)(w0 + nn + 4); p0[0] = a[0]; p0[1] = a[1]; p0[2] = a[2]; p0[3] = a[3]; p0[4] = b[0]; p0[5] = b[1]; p0[6] = b[2]; p0[7] = b[3]; }
            else if (seg == 1) { const f32x4 a = *(const f32x4*)(a0 + nn), b = *(const f32x4*)(a0 + nn + 4), cc = *(const f32x4*)(k_a + nn), d = *(const f32x4*)(k_a + nn + 4);
                p0[0] = a[0]; p0[1] = a[1]; p0[2] = a[2]; p0[3] = a[3]; p0[4] = b[0]; p0[5] = b[1]; p0[6] = b[2]; p0[7] = b[3];
                p1[0] = cc[0]; p1[1] = cc[1]; p1[2] = cc[2]; p1[3] = cc[3]; p1[4] = d[0]; p1[5] = d[1]; p1[6] = d[2]; p1[7] = d[3]; }
#pragma unroll
            for (int ai = 0; ai < 2; ++ai)
#pragma unroll
                for (int m = 0; m < 4; ++m) {
                    const size_t off = (size_t)(u.pm * BM + ai * HALF + wr * 64 + m * 16 + fr) * 512 + nn;
                    const f32x4 v0 = acc[ai][bj][m][0], v1 = acc[ai][bj][m][1];
                    const float x[8] = {v0[0], v0[1], v0[2], v0[3], v1[0], v1[1], v1[2], v1[3]};
                    if (seg == 0) {
                        float o[8];
#pragma unroll
                        for (int i = 0; i < 8; ++i) { const float wa = p0[i] + x[i];
                            const float sp = __logf(1.0f + __expf(-wa));
                            o[i] = __expf(-__expf(-sp - 0.5f)); }
                        *(f32x4*)(W + off) = (f32x4){o[0], o[1], o[2], o[3]}; *(f32x4*)(W + off + 4) = (f32x4){o[4], o[5], o[6], o[7]};
                    } else if (seg == 1) {
                        const u32x4 kv = *(const u32x4*)(Kp + off), av = *(const u32x4*)(A + off);
                        const float k[8] = {__builtin_bit_cast(float, kv.x << 16), __builtin_bit_cast(float, kv.x & 0xffff0000u), __builtin_bit_cast(float, kv.y << 16), __builtin_bit_cast(float, kv.y & 0xffff0000u),
                                            __builtin_bit_cast(float, kv.z << 16), __builtin_bit_cast(float, kv.z & 0xffff0000u), __builtin_bit_cast(float, kv.w << 16), __builtin_bit_cast(float, kv.w & 0xffff0000u)};
                        const float a[8] = {__builtin_bit_cast(float, av.x << 16), __builtin_bit_cast(float, av.x & 0xffff0000u), __builtin_bit_cast(float, av.y << 16), __builtin_bit_cast(float, av.y & 0xffff0000u),
                                            __builtin_bit_cast(float, av.z << 16), __builtin_bit_cast(float, av.z & 0xffff0000u), __builtin_bit_cast(float, av.w << 16), __builtin_bit_cast(float, av.w & 0xffff0000u)};
                        float kf[8], bo[8];
#pragma unroll
                        for (int i = 0; i < 8; ++i) { const float ic = fast_sigmoid(p0[i] + x[i]); kf[i] = k[i] * (1.0f + (ic - 1.0f) * p1[i]); bo[i] = -a[i] * ic; }
                        u32x4 w; w.x = cvt_pk_bf16(kf[0], kf[1]); w.y = cvt_pk_bf16(kf[2], kf[3]); w.z = cvt_pk_bf16(kf[4], kf[5]); w.w = cvt_pk_bf16(kf[6], kf[7]);
                        *(u32x4*)(Kf + off) = w;
                        w.x = cvt_pk_bf16(bo[0], bo[1]); w.y = cvt_pk_bf16(bo[2], bo[3]); w.z = cvt_pk_bf16(bo[4], bo[5]); w.w = cvt_pk_bf16(bo[6], bo[7]);
                        *(u32x4*)(B + off) = w;
                    } else {
                        u32x4 w; w.x = cvt_pk_bf16(x[0], x[1]); w.y = cvt_pk_bf16(x[2], x[3]); w.z = cvt_pk_bf16(x[4], x[5]); w.w = cvt_pk_bf16(x[6], x[7]);
                        *(u32x4*)(Gt + off) = w;
                    }
                }
        }
    }
};
struct EpiGLU {
    static constexpr bool PERM = true, AFTER_DRAIN = false;
    const bf16_t* Y; int ldy; const float* bias; bf16_t* O; int ldo; int ocol0;
    __device__ __forceinline__ void operator()(const f32x4 (&acc)[2][2][4][2], const Unit& u, int wr, int wc, int fr, int fq) const {
        const int row0 = u.pm * BM + wr * 64 + fr, col0 = u.pn * BM + wc * 32 + 8 * fq;
#pragma unroll
        for (int bj = 0; bj < 2; ++bj) {
            const f32x4 b0 = *(const f32x4*)(bias + col0 + bj * HALF), b1 = *(const f32x4*)(bias + col0 + bj * HALF + 4);
#pragma unroll
            for (int ai = 0; ai < 2; ++ai)
#pragma unroll
                for (int m = 0; m < 4; ++m) {
                    const size_t row = (size_t)(row0 + ai * HALF + m * 16);
                    const u32x4 yv = *(const u32x4*)(Y + row * ldy + col0 + bj * HALF);
                    const f32x4 z0 = acc[ai][bj][m][0] + b0, z1 = acc[ai][bj][m][1] + b1;
                    float y[8] = {__builtin_bit_cast(float, yv.x << 16), __builtin_bit_cast(float, yv.x & 0xffff0000u), __builtin_bit_cast(float, yv.y << 16), __builtin_bit_cast(float, yv.y & 0xffff0000u),
                                  __builtin_bit_cast(float, yv.z << 16), __builtin_bit_cast(float, yv.z & 0xffff0000u), __builtin_bit_cast(float, yv.w << 16), __builtin_bit_cast(float, yv.w & 0xffff0000u)};
                    float r[8];
#pragma unroll
                    for (int i = 0; i < 4; ++i) { r[i] = y[i] * fast_sigmoid(z0[i]); r[4 + i] = y[4 + i] * fast_sigmoid(z1[i]); }
                    u32x4 w; w.x = cvt_pk_bf16(r[0], r[1]); w.y = cvt_pk_bf16(r[2], r[3]); w.z = cvt_pk_bf16(r[4], r[5]); w.w = cvt_pk_bf16(r[6], r[7]);
                    *(u32x4*)(O + row * ldo + ocol0 + col0 + bj * HALF) = w;
                }
        }
    }
};
template <class Epi, class Sched, bool ALIGN_EPI = false, bool SP2 = false, bool GATHER = false>
__device__ __forceinline__ void gemm_phase(PG8_LAS unsigned char* lds, const Gemm g, const Sched& S, const Epi& E) {
    int tid_ = threadIdx.x; asm volatile("" : "+v"(tid_));
    const int tid = tid_, wid = __builtin_amdgcn_readfirstlane(tid >> 6), lane = tid & 63, wr = wid >> 2, wc = wid & 3, fr = lane & 15, fq = lane >> 4;
    const int K = g.K, nt = K / BK;
    unsigned voffA[2], voffB[2];
#pragma unroll
    for (int i = 0; i < 2; ++i) { int R, C; stage_rc(tid * 16 + i * 8192, R, C); const int Rb = Epi::PERM ? ((R & ~31) + perm32(R & 31)) : R;
        voffA[i] = (unsigned)(R * K + C) * 2u; voffB[i] = (unsigned)(Rb * K + C) * 2u; }
    const size_t kstep = (size_t)(BK * 2);
    const size_t hstep = (size_t)HALF * K * 2;
    const size_t tstep = 2 * hstep;
    const unsigned ldsw = (unsigned)wid * 1024u;
    const int aoff = lds_byte(wr * 64 + fr, fq * 8), boff = lds_byte(wc * 32 + fr, fq * 8);
#define PG8_SA(b, h) (((b) * 2 + (h)) * HTB)
#define PG8_SB(b, h) ((4 + (b) * 2 + (h)) * HTB)
#define PG8_STAGE(bufoff, gbase, voff) do { _Pragma("unroll") for (int _i = 0; _i < 2; ++_i) \
        __builtin_amdgcn_global_load_lds((const unsigned*)((const char*)(gbase) + (voff)[_i]), (PG8_LAS unsigned*)(lds + (bufoff) + ldsw + _i * 8192), 16, 0, 0); } while (0)
#define PG8_STAGE_A(bufoff, kptr, h, NEXTSEL) do { if constexpr (GATHER) { const unsigned _p = (NEXTSEL) ? gnxt[h] : gcur[h]; const unsigned _v[2] = { (_p & 0xffffu) * (unsigned)(2 * K) + gC2, (_p >> 16) * (unsigned)(2 * K) + gC2 }; PG8_STAGE(bufoff, kptr, _v); } \
        else { PG8_STAGE(bufoff, (kptr) + (h) * hstep, voffA); } } while (0)
#define PG8_LDA(dst, b, h) do { _Pragma("unroll") for (int m = 0; m < 4; ++m) _Pragma("unroll") for (int k = 0; k < 2; ++k) dst[m][k] = *(const PG8_LAS bf16x8*)(lds + PG8_SA(b, h) + aoff + m * 2048 + k * 1024); } while (0)
#define PG8_LDB(dst, b, h) do { _Pragma("unroll") for (int n = 0; n < 2; ++n) _Pragma("unroll") for (int k = 0; k < 2; ++k) dst[n][k] = *(const PG8_LAS bf16x8*)(lds + PG8_SB(b, h) + boff + n * 2048 + k * 1024); } while (0)
#define PG8_MMA(ai, bj, At, Bt) do { __builtin_amdgcn_s_setprio(1); _Pragma("unroll") for (int m = 0; m < 4; ++m) _Pragma("unroll") for (int n = 0; n < 2; ++n) _Pragma("unroll") for (int k = 0; k < 2; ++k) \
        acc[ai][bj][m][n] = __builtin_amdgcn_mfma_f32_16x16x32_bf16(Bt[n][k], At[m][k], acc[ai][bj][m][n], 0, 0, 0); __builtin_amdgcn_s_setprio(0); } while (0)
#define PG8_WAIT_V(n) asm volatile("s_waitcnt vmcnt(" #n ")" ::: "memory")
#define PG8_WAIT_L(n) asm volatile("s_waitcnt lgkmcnt(" #n ")" ::: "memory")
#define PG8_BAR __builtin_amdgcn_s_barrier()
#define PG8_SCHED __builtin_amdgcn_sched_barrier(0)
    unsigned gcur[2], gnxt[2], gC2 = 0;
    if constexpr (GATHER) { int R, C; stage_rc(tid * 16, R, C); gC2 = (unsigned)C * 2u; }
    auto load_gather = [&](int pm, unsigned (&dst)[2]) {
        int R, C; stage_rc(tid * 16, R, C);
#pragma unroll
        for (int h = 0; h < 2; ++h) { int a0 = g.rowtab[pm * BM + h * HALF + R], a1 = g.rowtab[pm * BM + h * HALF + R + 64]; a0 = a0 < 0 ? 0 : a0; a1 = a1 < 0 ? 0 : a1; dst[h] = (unsigned)(a0 >> 3) | ((unsigned)(a1 >> 3) << 16); }
    };
    Unit cur, nxt; int ui = 0;
    if (!S.next(0, cur)) return;
    f32x4 acc[2][2][4][2];
#pragma unroll
    for (int a = 0; a < 2; ++a)
#pragma unroll
        for (int b = 0; b < 2; ++b)
#pragma unroll
            for (int m = 0; m < 4; ++m)
#pragma unroll
                for (int n = 0; n < 2; ++n) acc[a][b][m][n] = (f32x4){0.f, 0.f, 0.f, 0.f};
    bf16x8 At[4][2], B0[2][2], B1[2][2];
    const char* cA = (const char*)g.A + (GATHER ? (size_t)0 : (size_t)cur.pm * tstep); const char* cB = (const char*)g.Bt + (size_t)cur.pn * tstep;
    if constexpr (GATHER) { load_gather(cur.pm, gcur); }
    S.a_ready(cur);
    if constexpr (SP2) {
        PG8_STAGE(PG8_SB(0, 0), cB, voffB); PG8_STAGE(PG8_SB(0, 1), cB + hstep, voffB); PG8_STAGE_A(PG8_SA(0, 0), cA, 0, false); PG8_STAGE_A(PG8_SA(0, 1), cA, 1, false);
        if (wr == 1) PG8_BAR;
        PG8_WAIT_V(2); PG8_BAR;
        PG8_STAGE(PG8_SB(1, 0), cB + kstep, voffB); PG8_STAGE_A(PG8_SA(1, 0), cA + kstep, 0, false); PG8_STAGE(PG8_SB(1, 1), cB + hstep + kstep, voffB);
        PG8_WAIT_V(6); PG8_BAR;
    } else {
        PG8_STAGE(PG8_SB(0, 0), cB, voffB); PG8_STAGE_A(PG8_SA(0, 0), cA, 0, false); PG8_STAGE(PG8_SB(0, 1), cB + hstep, voffB); PG8_STAGE_A(PG8_SA(0, 1), cA, 1, false);
        if (wr == 1) PG8_BAR;
        PG8_WAIT_V(4); PG8_BAR;
        PG8_STAGE(PG8_SB(1, 0), cB + kstep, voffB); PG8_STAGE_A(PG8_SA(1, 0), cA + kstep, 0, false); PG8_STAGE(PG8_SB(1, 1), cB + hstep + kstep, voffB);
        PG8_WAIT_V(6); PG8_BAR;
    }
    for (;;) {
        const bool has_next = S.next(ui + 1, nxt);
        const char* nA = (has_next && !GATHER) ? (const char*)g.A + (size_t)nxt.pm * tstep : cA; const char* nB = has_next ? (const char*)g.Bt + (size_t)nxt.pn * tstep : cB;
        if constexpr (GATHER) { if (has_next) load_gather(nxt.pm, gnxt); else {
#pragma unroll
            for (int h = 0; h < 2; ++h) { gnxt[h] = gcur[h]; } } }
        for (int t = 0; t < nt; t += 2) {
            const bool last = (t == nt - 2);
            const char* a1 = cA + (size_t)(t + 1) * kstep;
            const char* a2 = last ? nA : cA + (size_t)(t + 2) * kstep; const char* b2 = last ? nB : cB + (size_t)(t + 2) * kstep;
            const char* a3 = a2 + kstep; const char* b3 = b2 + kstep;
            if (last && has_next) S.a_ready(nxt);
            if constexpr (SP2) {
            PG8_LDB(B0, 0, 0); PG8_LDB(B1, 0, 1); PG8_SCHED; PG8_LDA(At, 0, 0); PG8_STAGE_A(PG8_SA(1, 1), a1, 1, false);
            PG8_WAIT_V(8); PG8_WAIT_L(0); PG8_BAR; PG8_MMA(0, 0, At, B0); PG8_MMA(0, 1, At, B1); PG8_BAR; PG8_SCHED;
            PG8_LDA(At, 0, 1); PG8_STAGE(PG8_SB(0, 0), b2, voffB); PG8_STAGE(PG8_SB(0, 1), b2 + hstep, voffB); PG8_STAGE_A(PG8_SA(0, 0), a2, 0, last);
            PG8_WAIT_V(8); PG8_WAIT_L(0); PG8_BAR; PG8_MMA(1, 0, At, B0); PG8_MMA(1, 1, At, B1); PG8_BAR; PG8_SCHED;
            PG8_LDB(B0, 1, 0); PG8_LDB(B1, 1, 1); PG8_SCHED; PG8_LDA(At, 1, 0); PG8_STAGE_A(PG8_SA(0, 1), a2, 1, last);
            PG8_WAIT_V(8); PG8_WAIT_L(0); PG8_BAR; PG8_MMA(0, 0, At, B0); PG8_MMA(0, 1, At, B1); PG8_BAR; PG8_SCHED;
            PG8_LDA(At, 1, 1); PG8_STAGE(PG8_SB(1, 0), b3, voffB); PG8_STAGE(PG8_SB(1, 1), b3 + hstep, voffB); PG8_STAGE_A(PG8_SA(1, 0), a3, 0, last);
            PG8_WAIT_V(8); PG8_WAIT_L(0); PG8_BAR; PG8_MMA(1, 0, At, B0); PG8_MMA(1, 1, At, B1); PG8_BAR; PG8_SCHED;
            } else {
            PG8_LDB(B0, 0, 0); PG8_SCHED; PG8_LDA(At, 0, 0); PG8_STAGE_A(PG8_SA(1, 1), a1, 1, false);
            PG8_WAIT_L(8); PG8_BAR; PG8_WAIT_L(0); PG8_MMA(0, 0, At, B0); PG8_BAR; PG8_SCHED;
            PG8_LDB(B1, 0, 1); PG8_STAGE(PG8_SB(0, 0), b2, voffB);
            PG8_BAR; PG8_WAIT_L(0); PG8_MMA(0, 1, At, B1); PG8_BAR;
            PG8_LDA(At, 0, 1); PG8_STAGE_A(PG8_SA(0, 0), a2, 0, last);
            PG8_BAR; PG8_WAIT_L(0); PG8_MMA(1, 0, At, B0); PG8_BAR; PG8_SCHED;
            PG8_STAGE(PG8_SB(0, 1), b2 + hstep, voffB);
            PG8_WAIT_V(6); PG8_BAR; PG8_MMA(1, 1, At, B1); PG8_BAR;
            PG8_LDB(B0, 1, 0); PG8_SCHED; PG8_LDA(At, 1, 0); PG8_STAGE_A(PG8_SA(0, 1), a2, 1, last);
            PG8_WAIT_L(8); PG8_BAR; PG8_WAIT_L(0); PG8_MMA(0, 0, At, B0); PG8_BAR; PG8_SCHED;
            PG8_LDB(B1, 1, 1); PG8_STAGE(PG8_SB(1, 0), b3, voffB);
            PG8_BAR; PG8_WAIT_L(0); PG8_MMA(0, 1, At, B1); PG8_BAR;
            PG8_LDA(At, 1, 1); PG8_STAGE_A(PG8_SA(1, 0), a3, 0, last);
            PG8_BAR; PG8_WAIT_L(0); PG8_MMA(1, 0, At, B0); PG8_BAR; PG8_SCHED;
            PG8_STAGE(PG8_SB(1, 1), b3 + hstep, voffB);
            PG8_WAIT_V(6); PG8_BAR; PG8_MMA(1, 1, At, B1); PG8_BAR;
            }
        }
        if constexpr (ALIGN_EPI) { if (wr == 0) PG8_BAR; }
        if constexpr (!Epi::AFTER_DRAIN) { E(acc, cur, wr, wc, fr, fq); S.done(cur); }
        if (!has_next) break;
#pragma unroll
        for (int a = 0; a < 2; ++a)
#pragma unroll
            for (int b = 0; b < 2; ++b)
#pragma unroll
                for (int m = 0; m < 4; ++m)
#pragma unroll
                    for (int n = 0; n < 2; ++n) acc[a][b][m][n] = (f32x4){0.f, 0.f, 0.f, 0.f};
        cur = nxt; cA = nA; cB = nB; ++ui;
        if constexpr (GATHER) {
#pragma unroll
            for (int h = 0; h < 2; ++h) { gcur[h] = gnxt[h]; } }
        if constexpr (ALIGN_EPI) { if (wr == 1) PG8_BAR; }
    }
    PG8_WAIT_V(0);
    if constexpr (!ALIGN_EPI) { if (wr == 0) PG8_BAR; }
    PG8_BAR;
    if constexpr (Epi::AFTER_DRAIN) { E.fused(acc, cur, wr, wc, fr, fq, lds, wid, lane); S.done(cur); }
#undef PG8_SA
#undef PG8_SB
#undef PG8_STAGE
#undef PG8_STAGE_A
#undef PG8_LDA
#undef PG8_LDB
#undef PG8_MMA
#undef PG8_WAIT_V
#undef PG8_WAIT_L
#undef PG8_BAR
#undef PG8_SCHED
}
}

typedef unsigned short bf16_t;
__device__ __forceinline__ unsigned f2bf(float f) { unsigned u = __builtin_bit_cast(unsigned, f); return (u + 0x7fffu + ((u >> 16) & 1u)) >> 16; }
__device__ __forceinline__ float bf2f(unsigned h) { return __builtin_bit_cast(float, h << 16); }
__device__ __forceinline__ float wave_sum(float v) {
#pragma unroll
    for (int o = 1; o < 64; o <<= 1) v += __shfl_xor(v, o);
    return v;
}
__device__ __forceinline__ float sigmoidf_(float x) { return 1.0f / (1.0f + expf(-x)); }
__device__ __forceinline__ float siluf_(float x) { return x / (1.0f + expf(-x)); }
__device__ __forceinline__ float softplusf_(float x) { return fmaxf(x, 0.0f) + log1pf(expf(-fabsf(x))); }
__device__ __forceinline__ float geluf_(float x) { const float u = 0.7978845608028654f * (x + 0.044715f * x * x * x); return 0.5f * x * (1.0f + tanhf(u)); }

struct Args { const float* in[39]; float* out; unsigned char* ws; int lo, hi; };

struct Ctx {
    const float* const* in; float* out; unsigned char* ws;
    LAS unsigned char* lds; float* sm;
    int tid, lane, wid, bid, G, dry;
};

__device__ __forceinline__ unsigned pk2(float lo, float hi) { return f2bf(lo) | (f2bf(hi) << 16); }
__device__ __forceinline__ float ldbf(const bf16_t* p) { return bf2f((unsigned)*p); }
typedef unsigned v4u_t __attribute__((ext_vector_type(4)));
typedef unsigned v2u_t __attribute__((ext_vector_type(2)));
__device__ __forceinline__ void st16(void* p, uint4 v) { const v4u_t d = {v.x, v.y, v.z, v.w}; asm volatile("global_store_dwordx4 %0, %1, off\n\ts_nop 1" :: "v"(p), "v"(d) : "memory"); }
__device__ __forceinline__ void st16f(void* p, float4 v) { st16(p, make_uint4(__float_as_uint(v.x), __float_as_uint(v.y), __float_as_uint(v.z), __float_as_uint(v.w))); }
__device__ __forceinline__ void st8(void* p, uint2 v) { const v2u_t d = {v.x, v.y}; asm volatile("global_store_dwordx2 %0, %1, off\n\ts_nop 1" :: "v"(p), "v"(d) : "memory"); }
__device__ __forceinline__ void st4(void* p, unsigned v) { asm volatile("global_store_dword %0, %1, off\n\ts_nop 1" :: "v"(p), "v"(v) : "memory"); }
__device__ __forceinline__ void st2(void* p, unsigned v) { asm volatile("global_store_short %0, %1, off\n\ts_nop 1" :: "v"(p), "v"(v) : "memory"); }
__device__ __forceinline__ float4 ldbf4(const bf16_t* p) { const uint2 v = *(const uint2*)p; return make_float4(bf2f(v.x & 0xffffu), bf2f(v.x >> 16), bf2f(v.y & 0xffffu), bf2f(v.y >> 16)); }

template <int NB, class AF, class BF, class BF2, class EF>
__device__ __forceinline__ void gemm_tile(float* sm, int K, AF af, BF bf, BF2 bf2, EF ef) {
    float* As = sm;
    float* Bs = sm + 16 * 132;
    float* Bs2 = Bs + 16 * 68;
    const int tid = threadIdx.x, ty = tid >> 4, tx = tid & 15;
    const int am = tid >> 2, ak = (tid & 3) * 4;
    const int bt = tid & 255, bk = bt >> 4, bn = (bt & 15) * 4;
    float acc[4][4], acc2[4][4];
#pragma unroll
    for (int i = 0; i < 4; ++i)
#pragma unroll
        for (int j = 0; j < 4; ++j) { acc[i][j] = 0.f; acc2[i][j] = 0.f; }
    float4 av = af(am, ak);
    float4 bv = make_float4(0.f, 0.f, 0.f, 0.f);
    if (tid < 256) bv = bf(bk, bn); else if (NB == 2) bv = bf2(bk, bn);
    for (int k0 = 0; k0 < K; k0 += 16) {
        __syncthreads();
        As[(ak + 0) * 132 + am] = av.x; As[(ak + 1) * 132 + am] = av.y; As[(ak + 2) * 132 + am] = av.z; As[(ak + 3) * 132 + am] = av.w;
        if (tid < 256) *(float4*)&Bs[bk * 68 + bn] = bv; else if (NB == 2) *(float4*)&Bs2[bk * 68 + bn] = bv;
        __syncthreads();
        if (k0 + 16 < K) {
            av = af(am, k0 + 16 + ak);
            if (tid < 256) bv = bf(k0 + 16 + bk, bn); else if (NB == 2) bv = bf2(k0 + 16 + bk, bn);
        }
#pragma unroll
        for (int kk = 0; kk < 16; ++kk) {
            const float4 a = *(const float4*)&As[kk * 132 + ty * 4];
            const float4 b = *(const float4*)&Bs[kk * 68 + tx * 4];
            const float aa[4] = {a.x, a.y, a.z, a.w};
            const float bb[4] = {b.x, b.y, b.z, b.w};
#pragma unroll
            for (int i = 0; i < 4; ++i)
#pragma unroll
                for (int j = 0; j < 4; ++j) acc[i][j] = fmaf(aa[i], bb[j], acc[i][j]);
            if (NB == 2) {
                const float4 b2 = *(const float4*)&Bs2[kk * 68 + tx * 4];
                const float bb2[4] = {b2.x, b2.y, b2.z, b2.w};
#pragma unroll
                for (int i = 0; i < 4; ++i)
#pragma unroll
                    for (int j = 0; j < 4; ++j) acc2[i][j] = fmaf(aa[i], bb2[j], acc2[i][j]);
            }
        }
    }
#pragma unroll
    for (int i = 0; i < 4; ++i)
        ef(ty * 4 + i, tx * 4, make_float4(acc[i][0], acc[i][1], acc[i][2], acc[i][3]), make_float4(acc2[i][0], acc2[i][1], acc2[i][2], acc2[i][3]));
}

__device__ __forceinline__ void transpose_load(const float* W, int N, int nblk, int item, int lane, float (&r)[32]) {
    const int kb = item / nblk, nb = item % nblk, k0 = 64 * kb, n0 = 32 * nb;
#pragma unroll
    for (int i = 0; i < 8; ++i) { const int kk = 8 * i + (lane >> 3); const float4 v = *(const float4*)(W + (size_t)(k0 + kk) * N + n0 + (lane & 7) * 4);
        r[4 * i] = v.x; r[4 * i + 1] = v.y; r[4 * i + 2] = v.z; r[4 * i + 3] = v.w; }
}
template <bool RES, class RM>
__device__ __forceinline__ void transpose_finish(int K, int nblk, bf16_t* WT, RM rowmap, float* scr, int item, int lane, const float (&r)[32]) {
    const int kb = item / nblk, nb = item % nblk, k0 = 64 * kb, n0 = 32 * nb;
#pragma unroll
    for (int i = 0; i < 8; ++i) { const int kk = 8 * i + (lane >> 3), nn = (lane & 7) * 4;
        scr[kk * 33 + nn] = r[4 * i]; scr[kk * 33 + nn + 1] = r[4 * i + 1]; scr[kk * 33 + nn + 2] = r[4 * i + 2]; scr[kk * 33 + nn + 3] = r[4 * i + 3]; }
    asm volatile("s_waitcnt lgkmcnt(0)" ::: "memory");
    const int c = lane & 7;
    const int r0 = rowmap(n0);
#pragma unroll
    for (int j = 0; j < 4; ++j) {
        const int n = (lane >> 3) + 8 * j; const float* s = scr + (8 * c) * 33 + n;
        float v[8];
#pragma unroll
        for (int q = 0; q < 8; ++q) { v[q] = s[q * 33]; if (RES) v[q] = v[q] - bf2f(f2bf(v[q])); }
        uint4 o; o.x = pk2(v[0], v[1]); o.y = pk2(v[2], v[3]); o.z = pk2(v[4], v[5]); o.w = pk2(v[6], v[7]);
        st16(WT + (size_t)(r0 + n) * K + k0 + 8 * c, o);
    }
    asm volatile("s_waitcnt lgkmcnt(0)" ::: "memory");
}
template <bool RES, class RM>
__device__ __forceinline__ void transpose_item(const float* W, int K, int N, bf16_t* WT, RM rowmap, float* scr, int item, int lane) {
    float r[32];
    transpose_load(W, N, N / 32, item, lane, r);
    transpose_finish<RES>(K, N / 32, WT, rowmap, scr, item, lane, r);
}

__device__ __forceinline__ void convert_expert_weights(const Ctx& c, const int lo, const int hi, int first, int stride) {
    float* scr = c.sm + c.wid * (64 * 33);
    float ra[32], rb[32];
    auto src = [&](int it, const float*& W, int& N, int& nblk, int& item) {
        const int e = it / 384, r = it % 384;
        if (r < 128) { W = c.in[33] + (size_t)e * D * EFF; N = EFF; nblk = EFF / 32; item = r; }
        else if (r < 256) { W = c.in[34] + (size_t)e * D * EFF; N = EFF; nblk = EFF / 32; item = r - 128; }
        else { W = c.in[35] + (size_t)e * EFF * D; N = D; nblk = D / 32; item = r - 256; }
    };
    auto fin = [&](int it, const float (&rg)[32]) {
        const int e = it / 384, r = it % 384;
        if (r < 128) transpose_finish<false>(D, EFF / 32, (bf16_t*)(c.ws + WS_WEGU) + (size_t)e * 512 * D, [](int n) { return (n >> 7) * 256 + (n & 127); }, scr, r, c.lane, rg);
        else if (r < 256) transpose_finish<false>(D, EFF / 32, (bf16_t*)(c.ws + WS_WEGU) + (size_t)e * 512 * D, [](int n) { return (n >> 7) * 256 + 128 + (n & 127); }, scr, r - 128, c.lane, rg);
        else transpose_finish<false>(EFF, D / 32, (bf16_t*)(c.ws + WS_WED) + (size_t)e * D * EFF, [](int n) { return n; }, scr, r - 256, c.lane, rg);
    };
    float rc[32];
    auto ld = [&](int it_, float (&rg)[32]) { if (it_ < hi) { const float* W; int N, nblk, item; src(it_, W, N, nblk, item); transpose_load(W, N, nblk, item, c.lane, rg); } };
    int it = lo + first;
    if (it >= hi) return;
    ld(it, ra); ld(it + stride, rb);
    for (;;) {
        ld(it + 2 * stride, rc); fin(it, ra); if (it + stride >= hi) break;
        ld(it + 3 * stride, ra); fin(it + stride, rb); if (it + 2 * stride >= hi) break;
        ld(it + 4 * stride, rb); fin(it + 2 * stride, rc); if (it + 3 * stride >= hi) break;
        it += 3 * stride;
    }
}

__device__ __forceinline__ void phase0(const Ctx& c) {
    const int gt = c.bid * 512 + c.tid, NT = c.G * 512;
    const int gw = c.bid * 8 + c.wid, NW = c.G * 8;
    {
        const float* cc = c.in[1]; const float* w_ada = c.in[2];
        float* modsp = (float*)(c.ws + WS_MODSP);
        for (int task = gw; task < 96 * 16; task += NW) {
            const int cg = task % 96, ks = task / 96, j = cg * 64 + c.lane;
            float a0 = 0.f, a1 = 0.f, a2 = 0.f, a3 = 0.f;
#pragma unroll 4
            for (int k = ks * 64; k < ks * 64 + 64; ++k) {
                const float wv = w_ada[(size_t)k * NMODS + j];
                a0 = fmaf(siluf_(cc[k]), wv, a0); a1 = fmaf(siluf_(cc[D + k]), wv, a1); a2 = fmaf(siluf_(cc[2 * D + k]), wv, a2); a3 = fmaf(siluf_(cc[3 * D + k]), wv, a3);
            }
            modsp[(ks * 4 + 0) * NMODS + j] = a0; modsp[(ks * 4 + 1) * NMODS + j] = a1; modsp[(ks * 4 + 2) * NMODS + j] = a2; modsp[(ks * 4 + 3) * NMODS + j] = a3;
        }
    }
    {
        const float* log_dt = c.in[20]; const float* a_re = c.in[21]; const float* a_im = c.in[22];
        const float* b_re = c.in[23]; const float* b_im = c.in[24];
        float* apow = (float*)(c.ws + WS_APOW); float* bb = (float*)(c.ws + WS_S5BB);
        for (int idx = gt; idx < S5NG * S5P; idx += NT) {
            const int g = idx / S5P, p = idx % S5P;
            const double dt = exp((double)log_dt[g]);
            const double lre = fmin((double)a_re[idx], -1e-4), lim = (double)a_im[idx];
            const double mag = exp(lre * dt), ang = lim * dt;
            const double abr = mag * cos(ang), abi = mag * sin(ang);
            const double den = lre * lre + lim * lim;
            const double nre = abr - 1.0, nim = abi;
            const double qre = (nre * lre + nim * lim) / den, qim = (nim * lre - nre * lim) / den;
            double pr = 1.0, pi = 0.0;
            for (int j = 0; j <= S5L; ++j) {
                apow[((size_t)(g * (S5L + 1) + j) * 64 + p) * 2 + 0] = (float)pr; apow[((size_t)(g * (S5L + 1) + j) * 64 + p) * 2 + 1] = (float)pi;
                const double nr = pr * abr - pi * abi, ni = pr * abi + pi * abr; pr = nr; pi = ni;
            }
            for (int ch = 0; ch < 16; ++ch) {
                const double br = (double)b_re[idx * 16 + ch], bi = (double)b_im[idx * 16 + ch];
                bb[idx * 32 + ch] = (float)(qre * br - qim * bi);
                bb[idx * 32 + 16 + ch] = (float)(qre * bi + qim * br);
            }
        }
    }
    {
        const float* w2 = c.in[11]; const float* a2 = c.in[13]; const float* g2 = c.in[14];
        bf16_t* bt = (bf16_t*)(c.ws + WS_LORA_BT);
        for (int it = gt; it < 1536 * 32; it += NT) {
            const int n = it >> 5, c0 = (it & 31) * 8;
            float v[8];
#pragma unroll
            for (int i = 0; i < 8; ++i) {
                const int col = c0 + i; float x = 0.f;
                if (n < 512) { if (col < 64) x = w2[col * RW + n]; }
                else if (n < 1024) { if (col >= 64 && col < 128) x = a2[(col - 64) * RW + (n - 512)]; }
                else { if (col >= 128) x = g2[(col - 128) * RW + (n - 1024)]; }
                v[i] = x;
            }
            *(uint4*)(bt + (size_t)n * 256 + c0) = make_uint4(pk2(v[0], v[1]), pk2(v[2], v[3]), pk2(v[4], v[5]), pk2(v[6], v[7]));
        }
    }
    float* scr = c.sm + c.wid * (64 * 33);
    constexpr int I_IN = (D / 64) * (NPROJ / 32), I_OUT = (D / 64) * (D / 32), I_GLU = (512 / 64) * (512 / 32), I_SG = (D / 64) * (256 / 32), I_SD = (256 / 64) * (D / 32), I_R = (D / 64) * (256 / 32);
    constexpr int NIT = I_IN + I_OUT + I_GLU + 2 * I_SG + I_SD + 2 * I_R;
    for (int it = gw; it < NIT; it += NW) {
        int r = it;
        if (r < I_IN) { transpose_item<false>(c.in[8], D, NPROJ, (bf16_t*)(c.ws + WS_WIN_T), [](int n) { return n; }, scr, r, c.lane); continue; } r -= I_IN;
        if (r < I_OUT) { transpose_item<false>(c.in[30], D, D, (bf16_t*)(c.ws + WS_WOUT_T), [](int n) { return n; }, scr, r, c.lane); continue; } r -= I_OUT;
        if (r < I_GLU) { transpose_item<false>(c.in[28], 512, 512, (bf16_t*)(c.ws + WS_WGLU_T), [](int n) { return n; }, scr, r, c.lane); continue; } r -= I_GLU;
        if (r < I_SG) { transpose_item<false>(c.in[36], D, 256, (bf16_t*)(c.ws + WS_WSGU_T), [](int n) { return (n >> 7) * 256 + (n & 127); }, scr, r, c.lane); continue; } r -= I_SG;
        if (r < I_SG) { transpose_item<false>(c.in[37], D, 256, (bf16_t*)(c.ws + WS_WSGU_T), [](int n) { return (n >> 7) * 256 + 128 + (n & 127); }, scr, r, c.lane); continue; } r -= I_SG;
        if (r < I_SD) { transpose_item<false>(c.in[38], 256, D, (bf16_t*)(c.ws + WS_WSD_T), [](int n) { return n; }, scr, r, c.lane); continue; } r -= I_SD;
        if (r < I_R) { transpose_item<false>(c.in[31], D, 256, (bf16_t*)(c.ws + WS_WR_T), [](int n) { return n; }, scr, r, c.lane); continue; } r -= I_R;
        transpose_item<true>(c.in[31], D, 256, (bf16_t*)(c.ws + WS_WR_T), [](int n) { return 256 + n; }, scr, r, c.lane);
    }
}

__device__ __forceinline__ void phase1(const Ctx& c) {
    const int gt = c.bid * 512 + c.tid, NT = c.G * 512;
    const int gw = c.bid * 8 + c.wid, NW = c.G * 8;
    const float* modsp = (const float*)(c.ws + WS_MODSP); const float* b_ada = c.in[3]; float* mods = (float*)(c.ws + WS_MODS);
    for (int idx = gt; idx < BATCH * NMODS; idx += NT) {
        const int b = idx / NMODS, j = idx % NMODS;
        float acc = 0.f;
#pragma unroll
        for (int ks = 0; ks < 16; ++ks) acc += modsp[(ks * 4 + b) * NMODS + j];
        mods[idx] = acc + b_ada[j];
    }
    const float* apow = (const float*)(c.ws + WS_APOW); const float* bb = (const float*)(c.ws + WS_S5BB);
    const float* c_re = c.in[25]; const float* c_im = c.in[26];
    float* klag = (float*)(c.ws + WS_KLAG);
    for (int task = gw; task < S5NG * S5L; task += NW) {
        const int g = task / S5L, j = task % S5L, cc = c.lane >> 2, cq = (c.lane & 3) * 4;
        float acc[4] = {0.f, 0.f, 0.f, 0.f};
        for (int p = 0; p < 64; ++p) {
            const float ar = apow[((size_t)(g * (S5L + 1) + j) * 64 + p) * 2], ai = apow[((size_t)(g * (S5L + 1) + j) * 64 + p) * 2 + 1];
            const float cr = c_re[(g * 16 + cc) * 64 + p], ci = c_im[(g * 16 + cc) * 64 + p];
            const float4 br = *(const float4*)(bb + (size_t)(g * 64 + p) * 32 + cq), bi = *(const float4*)(bb + (size_t)(g * 64 + p) * 32 + 16 + cq);
            const float er = cr * ar - ci * ai, ei = cr * ai + ci * ar;
            acc[0] += er * br.x - ei * bi.x; acc[1] += er * br.y - ei * bi.y; acc[2] += er * br.z - ei * bi.z; acc[3] += er * br.w - ei * bi.w;
        }
        *(float4*)(klag + ((size_t)(g * S5L + j) * 16 + cc) * 16 + cq) = make_float4(acc[0], acc[1], acc[2], acc[3]);
    }
}

__device__ __forceinline__ void phase2(const Ctx& c) {
    const float* x = c.in[0]; const float* g = c.in[4];
    const float* mods = (const float*)(c.ws + WS_MODS);
    bf16_t* xn = (bf16_t*)(c.ws + WS_A);
    const int gw = c.bid * 8 + c.wid, NW = c.G * 8;
    for (int t = gw; t < T; t += NW) {
        const int b = t / SEQ;
        const float4* xr = (const float4*)(x + (size_t)t * D) + c.lane;
        float4 v[4]; float ss = 0.f;
#pragma unroll
        for (int j = 0; j < 4; ++j) { v[j] = xr[64 * j]; ss += v[j].x * v[j].x + v[j].y * v[j].y + v[j].z * v[j].z + v[j].w * v[j].w; }
        const float rstd = rsqrtf(wave_sum(ss) * (1.0f / D) + 1e-6f);
        uint2* o = (uint2*)(xn + (size_t)t * D) + c.lane;
#pragma unroll
        for (int j = 0; j < 4; ++j) {
            const int k = (c.lane + 64 * j) * 4;
            const float4 gg = *(const float4*)(g + k);
            const float4 sh = *(const float4*)(mods + b * NMODS + k);
            const float4 sc = *(const float4*)(mods + b * NMODS + D + k);
            float4 r;
            r.x = v[j].x * rstd * gg.x * (1.f + sc.x) + sh.x; r.y = v[j].y * rstd * gg.y * (1.f + sc.y) + sh.y;
            r.z = v[j].z * rstd * gg.z * (1.f + sc.z) + sh.z; r.w = v[j].w * rstd * gg.w * (1.f + sc.w) + sh.w;
            o[64 * j] = make_uint2(pk2(r.x, r.y), pk2(r.z, r.w));
        }
    }
    const int gt = c.bid * 512 + c.tid, NT = c.G * 512;
    const float* apow = (const float*)(c.ws + WS_APOW); const float* bb = (const float*)(c.ws + WS_S5BB); const float* klag = (const float*)(c.ws + WS_KLAG);
    const float* c_re = c.in[25]; const float* c_im = c.in[26]; const float* dd = c.in[27];
    bf16_t* kmat = (bf16_t*)(c.ws + WS_KMAT); bf16_t* hmat = (bf16_t*)(c.ws + WS_HMAT);
    for (int it = gt; it < S5NG * 512 * 80; it += NT) {
        const int row = it / 80, ch = it % 80, g = row >> 9, t = (row >> 4) & 31, cc = row & 15, col0 = ch * 8;
        float v[8];
        if (col0 < 512) {
            const int s = col0 >> 4, c0 = col0 & 15;
            if (s > t) {
#pragma unroll
                for (int i = 0; i < 8; ++i) v[i] = 0.f;
            } else {
                const float4 k0 = *(const float4*)(klag + ((size_t)(g * S5L + (t - s)) * 16 + cc) * 16 + c0), k1 = *(const float4*)(klag + ((size_t)(g * S5L + (t - s)) * 16 + cc) * 16 + c0 + 4);
                v[0] = k0.x; v[1] = k0.y; v[2] = k0.z; v[3] = k0.w; v[4] = k1.x; v[5] = k1.y; v[6] = k1.z; v[7] = k1.w;
                if (s == t) {
                    const float dv = dd[g * 16 + cc];
#pragma unroll
                    for (int i = 0; i < 8; ++i) if (c0 + i == cc) v[i] += dv;
                }
            }
        } else {
            const int q0 = col0 - 512;
#pragma unroll
            for (int i = 0; i < 8; ++i) {
                const int q = q0 + i, p = q & 63;
                const float ar = apow[((size_t)(g * (S5L + 1) + t + 1) * 64 + p) * 2], ai = apow[((size_t)(g * (S5L + 1) + t + 1) * 64 + p) * 2 + 1];
                const float cr = c_re[(g * 16 + cc) * 64 + p], ci = c_im[(g * 16 + cc) * 64 + p];
                v[i] = (q < 64) ? (cr * ar - ci * ai) : -(cr * ai + ci * ar);
            }
        }
        *(uint4*)(kmat + (size_t)row * 640 + col0) = make_uint4(pk2(v[0], v[1]), pk2(v[2], v[3]), pk2(v[4], v[5]), pk2(v[6], v[7]));
    }
    for (int it = gt; it < S5NG * 256 * 80; it += NT) {
        const int row = it / 80, ch = it % 80, g = row >> 8, q = row & 255, col0 = ch * 8;
        float v[8];
#pragma unroll
        for (int i = 0; i < 8; ++i) v[i] = 0.f;
        if (q < 128 && col0 < 512) {
            const int s = col0 >> 4, c0 = col0 & 15, p = q & 63;
            const float ar = apow[((size_t)(g * (S5L + 1) + (S5L - 1 - s)) * 64 + p) * 2], ai = apow[((size_t)(g * (S5L + 1) + (S5L - 1 - s)) * 64 + p) * 2 + 1];
#pragma unroll
            for (int i = 0; i < 8; ++i) {
                const float br = bb[(size_t)(g * 64 + p) * 32 + c0 + i], bi = bb[(size_t)(g * 64 + p) * 32 + 16 + c0 + i];
                v[i] = (q < 64) ? (ar * br - ai * bi) : (ar * bi + ai * br);
            }
        }
        *(uint4*)(hmat + (size_t)row * 640 + col0) = make_uint4(pk2(v[0], v[1]), pk2(v[2], v[3]), pk2(v[4], v[5]), pk2(v[6], v[7]));
    }
}

__device__ __forceinline__ void phase3(const Ctx& c) {
    pg8::Gemm g{(const bf16_t*)(c.ws + WS_A), (const bf16_t*)(c.ws + WS_WIN_T), T, NPROJ, D};
    pg8::StaticOrder S; S.init(T, NPROJ, c.G, c.bid);
    pg8::EpiBf16<0> E{(bf16_t*)(c.ws + WS_PROJ), NPROJ, nullptr, 0, 0, 1.f};
    pg8::gemm_phase<pg8::EpiBf16<0>, pg8::StaticOrder, true, true>(c.lds, g, S, E);
}

__device__ __forceinline__ void unpack8(const uint4 a, float (&u)[8]) {
    u[0] = bf2f(a.x & 0xffffu); u[1] = bf2f(a.x >> 16); u[2] = bf2f(a.y & 0xffffu); u[3] = bf2f(a.y >> 16);
    u[4] = bf2f(a.z & 0xffffu); u[5] = bf2f(a.z >> 16); u[6] = bf2f(a.w & 0xffffu); u[7] = bf2f(a.w >> 16);
}
__device__ __forceinline__ uint4 pack8(const float (&v)[8]) { return make_uint4(pk2(v[0], v[1]), pk2(v[2], v[3]), pk2(v[4], v[5]), pk2(v[6], v[7])); }
#define DPPU(v, ctrl) ((unsigned)__builtin_amdgcn_mov_dpp((int)(v), (ctrl), 0xf, 0xf, true))
#define DPPF(v, ctrl) __builtin_bit_cast(float, __builtin_amdgcn_mov_dpp(__builtin_bit_cast(int, (v)), (ctrl), 0xf, 0xf, true))
__device__ __forceinline__ float fast_tanh(float x) { return 1.0f - 2.0f * __builtin_amdgcn_rcpf(1.0f + __builtin_amdgcn_exp2f(2.8853900817779268f * x)); }
__device__ __forceinline__ void phase4(const Ctx& c) {
    const bf16_t* proj = (const bf16_t*)(c.ws + WS_PROJ);
    const float* mu = c.in[9]; const float* k_k = c.in[15];
    bf16_t* rw_r = (bf16_t*)(c.ws + WS_RW_R); bf16_t* rw_k = (bf16_t*)(c.ws + WS_RW_K); bf16_t* rw_v = (bf16_t*)(c.ws + WS_RW_V); bf16_t* rw_a = (bf16_t*)(c.ws + WS_RW_A);
    bf16_t* alora = (bf16_t*)((unsigned char*)c.out + OUT_ALORA); bf16_t* ux = (bf16_t*)((unsigned char*)c.out + OUT_UX);
    const int gw = c.bid * 8 + c.wid, NW = c.G * 8, lane = c.lane;
    float mm[4][8], kk8[8];
#pragma unroll
    for (int j = 0; j < 4; ++j) {
        const int cidx = lane + 64 * j, col = (cidx < 224 ? cidx : 0) * 8;
        const float4 m0 = *(const float4*)(mu + col), m1 = *(const float4*)(mu + col + 4);
        mm[j][0] = m0.x; mm[j][1] = m0.y; mm[j][2] = m0.z; mm[j][3] = m0.w; mm[j][4] = m1.x; mm[j][5] = m1.y; mm[j][6] = m1.z; mm[j][7] = m1.w;
    }
    { const float4 k0 = *(const float4*)(k_k + lane * 8), k1 = *(const float4*)(k_k + lane * 8 + 4); kk8[0] = k0.x; kk8[1] = k0.y; kk8[2] = k0.z; kk8[3] = k0.w; kk8[4] = k1.x; kk8[5] = k1.y; kk8[6] = k1.z; kk8[7] = k1.w; }
    constexpr int RUN = 16;
    auto load_row = [&](int t, uint4 (&r)[5]) {
        const bf16_t* pr = proj + (size_t)t * NPROJ;
#pragma unroll
        for (int j = 0; j < 3; ++j) r[j] = *(const uint4*)(pr + (lane + 64 * j) * 8);
        r[3] = (lane < 32) ? *(const uint4*)(pr + (lane + 192) * 8) : make_uint4(0u, 0u, 0u, 0u);
        r[4] = *(const uint4*)(pr + RPROJ + lane * 8);
    };
    for (int t0 = gw * RUN; t0 < T; t0 += NW * RUN) {
        uint4 prev[5], cur[5], nxt[5];
        if (t0 % SEQ == 0) {
#pragma unroll
            for (int j = 0; j < 5; ++j) prev[j] = make_uint4(0u, 0u, 0u, 0u);
        } else load_row(t0 - 1, prev);
        load_row(t0, cur);
#pragma unroll 2
        for (int i = 0; i < RUN; ++i) {
            const int t = t0 + i;
            if (i + 1 < RUN) load_row(t + 1, nxt);
#pragma unroll
            for (int j = 0; j < 4; ++j) {
                const int cidx = lane + 64 * j;
                if (cidx < 224) {
                    const int col = cidx * 8;
                    float p[8], q[8], ps[8];
                    unpack8(cur[j], p); unpack8(prev[j], q);
#pragma unroll
                    for (int i2 = 0; i2 < 8; ++i2) ps[i2] = p[i2] + (q[i2] - p[i2]) * mm[j][i2];
                    if (j == 0) *(uint4*)(rw_r + (size_t)t * RW + col) = pack8(ps);
                    else if (j == 1) {
                        const int cl = col - 512;
                        *(uint4*)(rw_k + (size_t)t * RW + cl) = pack8(ps);
                        float kk[8]; float ss = 0.f;
#pragma unroll
                        for (int i2 = 0; i2 < 8; ++i2) { kk[i2] = ps[i2] * kk8[i2]; ss += kk[i2] * kk[i2]; }
                        ss += DPPF(ss, 0xB1); ss += DPPF(ss, 0x4E); ss += DPPF(ss, 0x141);
                        const float inv = -1.0f / fmaxf(sqrtf(ss), 1e-12f);
#pragma unroll
                        for (int i2 = 0; i2 < 8; ++i2) kk[i2] *= inv;
                        *(uint4*)(rw_a + (size_t)t * RW + cl) = pack8(kk);
                    } else if (j == 2) *(uint4*)(rw_v + (size_t)t * RW + (col - 1024)) = pack8(ps);
                    else {
                        const int cl = col - 1536;
                        float o[8];
#pragma unroll
                        for (int i2 = 0; i2 < 8; ++i2) o[i2] = (cl < 64) ? fast_tanh(ps[i2]) : (cl < 128) ? ps[i2] : pg8::fast_sigmoid(ps[i2]);
                        *(uint4*)(alora + (size_t)t * 256 + cl) = pack8(o);
                    }
                }
            }
            {
                const int g = lane >> 1, hf = lane & 1, b = t / SEQ, sidx = t % S5L, chunk = (t % SEQ) / S5L;
                bf16_t* row = ux + ((size_t)(g * 1024 + b * 256 + chunk)) * 640;
                *(uint4*)(row + sidx * 16 + hf * 8) = cur[4];
                if (sidx < 8) { *(uint4*)(row + 512 + (sidx * 2 + hf) * 8) = make_uint4(0u, 0u, 0u, 0u); }
            }
#pragma unroll
            for (int j = 0; j < 5; ++j) { prev[j] = cur[j]; cur[j] = nxt[j]; }
        }
    }
}

__device__ __forceinline__ void phase5(const Ctx& c) {
    {
        pg8::Gemm g{(const bf16_t*)((unsigned char*)c.out + OUT_ALORA), (const bf16_t*)(c.ws + WS_LORA_BT), T, 1536, 256};
        pg8::StaticOrder S; S.init(T, 1536, c.G, c.bid);
        pg8::EpiLora E{c.in[10], c.in[12], c.in[16], (float*)(c.ws + WS_RW_W), (const bf16_t*)(c.ws + WS_RW_K), (bf16_t*)((unsigned char*)c.out + OUT_KF), (const bf16_t*)(c.ws + WS_RW_A), (bf16_t*)(c.ws + WS_RW_B), (bf16_t*)(c.ws + WS_RW_G)};
        pg8::gemm_phase<pg8::EpiLora, pg8::StaticOrder, true, true>(c.lds, g, S, E);
    }
    __syncthreads();
    {
        pg8::Gemm g{(const bf16_t*)((unsigned char*)c.out + OUT_UX), (const bf16_t*)(c.ws + WS_HMAT), 0, 0, 640};
        pg8::S5Order S{128, 1, c.G, c.bid};
        pg8::EpiS5E E{(float*)((unsigned char*)c.out + OUT_E)};
        pg8::gemm_phase<pg8::EpiS5E, pg8::S5Order, true, true>(c.lds, g, S, E);
    }
}

typedef float f2v __attribute__((ext_vector_type(2)));
__device__ __forceinline__ float dpp_add16(float v) {
    v += __builtin_bit_cast(float, __builtin_amdgcn_mov_dpp(__builtin_bit_cast(int, v), 0xB1, 0xf, 0xf, true));
    v += __builtin_bit_cast(float, __builtin_amdgcn_mov_dpp(__builtin_bit_cast(int, v), 0x4E, 0xf, 0xf, true));
    v += __builtin_bit_cast(float, __builtin_amdgcn_mov_dpp(__builtin_bit_cast(int, v), 0x141, 0xf, 0xf, true));
    v += __builtin_bit_cast(float, __builtin_amdgcn_mov_dpp(__builtin_bit_cast(int, v), 0x140, 0xf, 0xf, true));
    return v;
}
constexpr int RTS = 32;
constexpr int RTILE = 6 * RTS * 64;
typedef short bf16x8_t __attribute__((ext_vector_type(8)));
typedef float f32x4_t __attribute__((ext_vector_type(4)));
#define MFMA16(a, b, c) __builtin_amdgcn_mfma_f32_16x16x32_bf16((a), (b), (c), 0, 0, 0)
constexpr int CL = 64, CLD = 72, CSLOT = 64 * CLD * 2;
constexpr int C_DIAG = 13 * CSLOT, C_DM = C_DIAG + 4096, C_GL = C_DM + 2048, C_SEGP = C_GL + 256;
static_assert(C_SEGP + 2048 <= 131072, "rwkv chunk LDS map");
__device__ __forceinline__ bf16x8_t ldsfrag(LAS const unsigned char* slot, int row, int col) { return *(LAS const bf16x8_t*)(slot + (row * CLD + col) * 2); }
typedef unsigned u32x4_t __attribute__((ext_vector_type(4)));
typedef unsigned u32x2_t __attribute__((ext_vector_type(2)));
__device__ __forceinline__ void lds_st16(LAS unsigned char* p, uint4 v) { *(LAS u32x4_t*)p = (u32x4_t){v.x, v.y, v.z, v.w}; }
__device__ __forceinline__ void lds_st8(LAS unsigned char* p, uint2 v) { *(LAS u32x2_t*)p = (u32x2_t){v.x, v.y}; }
__device__ __forceinline__ uint2 lds_ld8(LAS const unsigned char* p) { const u32x2_t v = *(LAS const u32x2_t*)p; return make_uint2(v.x, v.y); }
__device__ __forceinline__ bf16x8_t zfrag() { return (bf16x8_t){0, 0, 0, 0, 0, 0, 0, 0}; }
__device__ __forceinline__ uint2 pack4(float a, float b, float c, float d) { return make_uint2(pk2(a, b), pk2(c, d)); }
__device__ __forceinline__ float wave_sum_u(float v) {
    v = dpp_add16(v);
    return __builtin_bit_cast(float, __builtin_amdgcn_readlane(__builtin_bit_cast(int, v), 0)) + __builtin_bit_cast(float, __builtin_amdgcn_readlane(__builtin_bit_cast(int, v), 16))
         + __builtin_bit_cast(float, __builtin_amdgcn_readlane(__builtin_bit_cast(int, v), 32)) + __builtin_bit_cast(float, __builtin_amdgcn_readlane(__builtin_bit_cast(int, v), 48));
}

__device__ __forceinline__ void rwkv_phaseA(const Ctx& c, const int GA) {
    const float* __restrict__ rw_w = (const float*)(c.ws + WS_RW_W);
    const bf16_t* __restrict__ rw_r = (const bf16_t*)(c.ws + WS_RW_R); const bf16_t* __restrict__ rw_k = (const bf16_t*)((const unsigned char*)c.out + OUT_KF); const bf16_t* __restrict__ rw_v = (const bf16_t*)(c.ws + WS_RW_V);
    const bf16_t* __restrict__ rw_a = (const bf16_t*)(c.ws + WS_RW_A); const bf16_t* __restrict__ rw_b = (const bf16_t*)(c.ws + WS_RW_B);
    const float* r_k = c.in[17];
    bf16_t* Mq = (bf16_t*)(c.ws + WS_CM); bf16_t* NTq = (bf16_t*)(c.ws + WS_CN); bf16_t* Qq = (bf16_t*)(c.ws + WS_CQ); bf16_t* YTq = (bf16_t*)(c.ws + WS_CY); float* bon = (float*)(c.ws + WS_CBON);
    LAS unsigned char* L = c.lds;
    LAS unsigned char* sAt = L + 0 * CSLOT; LAS unsigned char* sBt = L + 1 * CSLOT; LAS unsigned char* sKt = L + 2 * CSLOT; LAS unsigned char* sRt = L + 3 * CSLOT;
    LAS unsigned char* sBtT = L + 4 * CSLOT; LAS unsigned char* sKtT = L + 5 * CSLOT; LAS unsigned char* sVT = L + 6 * CSLOT;
    LAS unsigned char* sA4 = L + 7 * CSLOT;
    LAS unsigned char* sRHST = L + 11 * CSLOT;
    LAS unsigned char* sXT = L + 0 * CSLOT;
    LAS unsigned char* sAD = L + 2 * CSLOT;
    LAS float* sDIAG = (LAS float*)(L + C_DIAG); LAS bf16_t* sDM = (LAS bf16_t*)(L + C_DM); LAS float* sGL = (LAS float*)(L + C_GL); LAS float* sSEGP = (LAS float*)(L + C_SEGP);
    const int tid = c.tid, w = c.wid, lane = c.lane, lr = lane & 15, lq = lane >> 4;
    float raww[8]; unsigned rawa[8], rawb[8], rawk[8], rawr[8], rawv[8];
    auto load_raw = [&](int ci_) {
        const int bh_ = ci_ >> 7, chunk_ = ci_ & 127, b_ = bh_ >> 3, h_ = bh_ & 7;
        const size_t gb = (size_t)(b_ * SEQ + chunk_ * CL) * RW + h_ * 64 + (size_t)(8 * (tid >> 6)) * RW + (tid & 63);
#pragma unroll
        for (int j = 0; j < 8; ++j) { const size_t o = gb + (size_t)j * RW; raww[j] = rw_w[o]; rawa[j] = rw_a[o]; rawb[j] = rw_b[o]; rawk[j] = rw_k[o]; rawr[j] = rw_r[o]; rawv[j] = rw_v[o]; }
    };
    if (c.bid < BATCH * NH * (SEQ / CL)) load_raw(c.bid);
    for (int ci = c.bid; ci < BATCH * NH * (SEQ / CL); ci += GA) {
        const int bh = ci >> 7, chunk = ci & 127, b = bh >> 3, h = bh & 7;
        const size_t gbase = (size_t)(b * SEQ + chunk * CL) * RW + h * 64;
        {
            const int kc = tid & 63, seg = tid >> 6;
            float p[8];
#pragma unroll
            for (int j = 0; j < 8; ++j) { const float wv = raww[j]; p[j] = (j == 0) ? wv : p[j - 1] * wv; }
            sSEGP[seg * 64 + kc] = p[7];
            for (int i = tid; i < 4 * CSLOT / 16; i += 512) lds_st16(sA4 + i * 16, make_uint4(0u, 0u, 0u, 0u));
            __syncthreads();
            float pre = 1.0f;
#pragma unroll
            for (int s = 0; s < 7; ++s) { const float sp = sSEGP[s * 64 + kc]; pre = (s < seg) ? pre * sp : pre; }
            float atT[8], btT[8], ktT[8], vT[8];
            const float rkv = r_k[h * 64 + kc];
#pragma unroll
            for (int j = 0; j < 8; ++j) {
                const int t = 8 * seg + j;
                const float G = pre * p[j], Gm1 = (j == 0) ? pre : pre * p[j - 1], inv = 1.0f / G;
                const float av = bf2f(rawa[j]), bv = bf2f(rawb[j]), kv = bf2f(rawk[j]), rv = bf2f(rawr[j]), vv = bf2f(rawv[j]);
                const float at = av * Gm1, bt = bv * inv, kt = kv * inv, rt = rv * G;
                *(LAS bf16_t*)(sAt + (t * CLD + kc) * 2) = (bf16_t)f2bf(at); *(LAS bf16_t*)(sBt + (t * CLD + kc) * 2) = (bf16_t)f2bf(bt);
                *(LAS bf16_t*)(sKt + (t * CLD + kc) * 2) = (bf16_t)f2bf(kt); *(LAS bf16_t*)(sRt + (t * CLD + kc) * 2) = (bf16_t)f2bf(rt);
                atT[j] = at; btT[j] = bt; ktT[j] = kt; vT[j] = vv;
                const float bs = wave_sum_u(rv * kv * rkv);
                if (lane == 0) bon[(size_t)ci * CL + t] = bs;
            }
            lds_st16(sRHST + (kc * CLD + 8 * seg) * 2, pack8(atT)); lds_st16(sBtT + (kc * CLD + 8 * seg) * 2, pack8(btT));
            lds_st16(sKtT + (kc * CLD + 8 * seg) * 2, pack8(ktT)); lds_st16(sVT + (kc * CLD + 8 * seg) * 2, pack8(vT));
            if (seg == 7) sGL[kc] = pre * p[7];
            __syncthreads();
        }
        for (int idx = w; idx < 40; idx += 8) {
            const int m = idx / 10, pr = idx % 10;
            const int ti = (pr >= 6) ? 3 : (pr >= 3) ? 2 : (pr >= 1) ? 1 : 0, si = pr - ti * (ti + 1) / 2;
            LAS const unsigned char* X = (m < 2) ? sAt : sRt; LAS const unsigned char* Y = (m & 1) ? sKt : sBt;
            f32x4_t acc = {0.f, 0.f, 0.f, 0.f};
#pragma unroll
            for (int ks = 0; ks < 2; ++ks) acc = MFMA16(ldsfrag(Y, 16 * si + lr, 32 * ks + 8 * lq), ldsfrag(X, 16 * ti + lr, 32 * ks + 8 * lq), acc);
            const int t = 16 * ti + lr, s0 = 16 * si + 4 * lq;
            float o[4];
#pragma unroll
            for (int rg = 0; rg < 4; ++rg) { const int s = s0 + rg; const bool keep = (m < 2) ? (s < t) : (s <= t); o[rg] = keep ? acc[rg] : 0.f; }
            lds_st8(sA4 + m * CSLOT + (t * CLD + s0) * 2, pack4(o[0], o[1], o[2], o[3]));
            if (m == 0 && ti == si) *(LAS f32x4_t*)(sDIAG + (ti * 16 + lr) * 16 + 4 * lq) = (f32x4_t){o[0], o[1], o[2], o[3]};
        }
        __syncthreads();
        if (w == 0) {
            float x[16];
#pragma unroll
            for (int r = 0; r < 16; ++r) {
                float acc = (r == lr) ? 1.0f : 0.0f;
                float nrow[16];
#pragma unroll
                for (int q4 = 0; q4 < 4; ++q4) { const f32x4_t nv = *(LAS const f32x4_t*)(sDIAG + (lq * 16 + r) * 16 + 4 * q4); nrow[4 * q4] = nv[0]; nrow[4 * q4 + 1] = nv[1]; nrow[4 * q4 + 2] = nv[2]; nrow[4 * q4 + 3] = nv[3]; }
#pragma unroll
                for (int s = 0; s < 16; ++s) if (s < r) acc = fmaf(nrow[s], x[s], acc);
                x[r] = acc;
                sDM[(lq * 16 + r) * 16 + lr] = (bf16_t)f2bf(acc);
            }
        } else {
            for (int idx = w - 1; idx < 16; idx += 7) {
                const int ti = idx >> 2, vi = idx & 3;
                f32x4_t acc = {0.f, 0.f, 0.f, 0.f};
#pragma unroll
                for (int ks = 0; ks < 2; ++ks) acc = MFMA16(ldsfrag(sA4 + 1 * CSLOT, 16 * ti + lr, 32 * ks + 8 * lq), ldsfrag(sVT, 16 * vi + lr, 32 * ks + 8 * lq), acc);
                lds_st8(sRHST + ((64 + 16 * vi + lr) * CLD + 16 * ti + 4 * lq) * 2, pack4(acc[0], acc[1], acc[2], acc[3]));
            }
        }
        __syncthreads();
        f32x4_t rd[4];
#pragma unroll
        for (int i = 0; i < 4; ++i) {
            bf16x8_t fa = zfrag(), fb = zfrag();
            if (lq < 2) { fa = *(LAS const bf16x8_t*)(sDM + (i * 16 + lr) * 16 + 8 * lq); fb = ldsfrag(sRHST, 16 * w + lr, 16 * i + 8 * lq); }
            rd[i] = MFMA16(fa, fb, ((f32x4_t){0.f, 0.f, 0.f, 0.f}));
        }
        if (w < 6) {
            const int i = (w >= 3) ? 3 : (w >= 1) ? 2 : 1, j = w - (i - 1) * i / 2;
            bf16x8_t fa = zfrag(), fb = zfrag();
            if (lq < 2) {
                fa = *(LAS const bf16x8_t*)(sDM + (i * 16 + lr) * 16 + 8 * lq);
#pragma unroll
                for (int jj = 0; jj < 8; ++jj) fb[jj] = (short)*(LAS const bf16_t*)(sA4 + ((16 * i + 8 * lq + jj) * CLD + 16 * j + lr) * 2);
            }
            const f32x4_t acc = MFMA16(fa, fb, ((f32x4_t){0.f, 0.f, 0.f, 0.f}));
#pragma unroll
            for (int rg = 0; rg < 4; ++rg) *(LAS bf16_t*)(sAD + ((16 * i + 4 * lq + rg) * CLD + 16 * j + lr) * 2) = (bf16_t)f2bf(acc[rg]);
        }
        __syncthreads();
#pragma unroll
        for (int i = 0; i < 4; ++i) {
            f32x4_t acc = rd[i];
            if (i >= 1) {
                bf16x8_t fa = zfrag(), fb = zfrag();
                if (8 * lq < 16 * i) { fa = ldsfrag(sAD, 16 * i + lr, 8 * lq); fb = ldsfrag(sXT, 16 * w + lr, 8 * lq); }
                acc = MFMA16(fa, fb, acc);
            }
            if (i == 3) {
                bf16x8_t fa = zfrag(), fb = zfrag();
                if (lq < 2) { fa = ldsfrag(sAD, 48 + lr, 32 + 8 * lq); fb = ldsfrag(sXT, 16 * w + lr, 32 + 8 * lq); }
                acc = MFMA16(fa, fb, acc);
            }
            lds_st8(sXT + ((16 * w + lr) * CLD + 16 * i + 4 * lq) * 2, pack4(acc[0], acc[1], acc[2], acc[3]));
            asm volatile("s_waitcnt lgkmcnt(0)" ::: "memory");
        }
        __syncthreads();
        if (ci + GA < BATCH * NH * (SEQ / CL)) load_raw(ci + GA);
#pragma unroll
        for (int i = 0; i < 8; ++i) {
            const int kind = i >> 1, tile = w + 8 * (i & 1), r4 = tile >> 2, c4 = tile & 3;
            f32x4_t acc = {0.f, 0.f, 0.f, 0.f};
            if (kind == 0) {
#pragma unroll
                for (int ks = 0; ks < 2; ++ks) acc = MFMA16(ldsfrag(sXT, 16 * r4 + lr, 32 * ks + 8 * lq), ldsfrag(sBtT, 16 * c4 + lr, 32 * ks + 8 * lq), acc);
                const int k = 16 * c4 + lr, kp0 = 16 * r4 + 4 * lq; const float gl = sGL[k];
                float o[4];
#pragma unroll
                for (int rg = 0; rg < 4; ++rg) o[rg] = gl * (acc[rg] + ((k == kp0 + rg) ? 1.0f : 0.0f));
                *(uint2*)(Mq + (size_t)ci * 4096 + k * 64 + kp0) = pack4(o[0], o[1], o[2], o[3]);
            } else if (kind == 1) {
#pragma unroll
                for (int ks = 0; ks < 2; ++ks) {
                    acc = MFMA16(ldsfrag(sBtT, 16 * r4 + lr, 32 * ks + 8 * lq), ldsfrag(sXT, 64 + 16 * c4 + lr, 32 * ks + 8 * lq), acc);
                    acc = MFMA16(ldsfrag(sKtT, 16 * r4 + lr, 32 * ks + 8 * lq), ldsfrag(sVT, 16 * c4 + lr, 32 * ks + 8 * lq), acc);
                }
                const int k0 = 16 * r4 + 4 * lq; const f32x4_t gl = *(LAS const f32x4_t*)(sGL + k0);
                *(uint2*)(NTq + (size_t)ci * 4096 + (16 * c4 + lr) * 64 + k0) = pack4(gl[0] * acc[0], gl[1] * acc[1], gl[2] * acc[2], gl[3] * acc[3]);
            } else if (kind == 2) {
#pragma unroll
                for (int ks = 0; ks < 2; ++ks) acc = MFMA16(ldsfrag(sXT, 16 * r4 + lr, 32 * ks + 8 * lq), ldsfrag(sA4 + 2 * CSLOT, 16 * c4 + lr, 32 * ks + 8 * lq), acc);
                const int t = 16 * c4 + lr, kp0 = 16 * r4 + 4 * lq;
                const uint2 rv = lds_ld8(sRt + (t * CLD + kp0) * 2);
                *(uint2*)(Qq + (size_t)ci * 4096 + t * 64 + kp0) = pack4(acc[0] + bf2f(rv.x & 0xffffu), acc[1] + bf2f(rv.x >> 16), acc[2] + bf2f(rv.y & 0xffffu), acc[3] + bf2f(rv.y >> 16));
            } else {
#pragma unroll
                for (int ks = 0; ks < 2; ++ks) {
                    acc = MFMA16(ldsfrag(sA4 + 2 * CSLOT, 16 * r4 + lr, 32 * ks + 8 * lq), ldsfrag(sXT, 64 + 16 * c4 + lr, 32 * ks + 8 * lq), acc);
                    acc = MFMA16(ldsfrag(sA4 + 3 * CSLOT, 16 * r4 + lr, 32 * ks + 8 * lq), ldsfrag(sVT, 16 * c4 + lr, 32 * ks + 8 * lq), acc);
                }
                *(uint2*)(YTq + (size_t)ci * 4096 + (16 * c4 + lr) * 64 + 16 * r4 + 4 * lq) = pack4(acc[0], acc[1], acc[2], acc[3]);
            }
        }
        __syncthreads();
    }
}

__device__ __forceinline__ void rwkv_phaseB(const Ctx& c, const int bh, const int w) {
    const bf16_t* __restrict__ Mq = (const bf16_t*)(c.ws + WS_CM); const bf16_t* __restrict__ NTq = (const bf16_t*)(c.ws + WS_CN); bf16_t* __restrict__ Sst = (bf16_t*)(c.ws + WS_CS);
    const int lane = c.lane, lr = lane & 15, lq = lane >> 4;
    LAS unsigned char* sS = c.lds + 69632 + c.wid * (16 * CLD * 2);
    {
        {
            bf16x8_t sB0 = zfrag(), sB1 = zfrag();
            bf16x8_t ma[4][4][2]; uint2 nv[4][4];
            const size_t ci0 = (size_t)bh * (SEQ / CL);
#define RB_LOAD(slot, cidx) do { _Pragma("unroll") for (int kt = 0; kt < 4; ++kt) { _Pragma("unroll") for (int ks = 0; ks < 2; ++ks) \
                ma[slot][kt][ks] = *(const bf16x8_t*)(Mq + (cidx) * 4096 + (16 * kt + lr) * 64 + 32 * ks + 8 * lq); nv[slot][kt] = *(const uint2*)(NTq + (cidx) * 4096 + (16 * w + lr) * 64 + 16 * kt + 4 * lq); } } while (0)
#pragma unroll
            for (int sl = 0; sl < 4; ++sl) RB_LOAD(sl, ci0 + sl);
#pragma unroll
            for (int chunk = 0; chunk < SEQ / CL; chunk += 4) {
#pragma unroll
                for (int sl = 0; sl < 4; ++sl) {
                    const size_t ci = ci0 + chunk + sl;
                    asm volatile("global_store_dwordx4 %0, %1, off\n\tglobal_store_dwordx4 %0, %2, off offset:64\n\ts_nop 1" :: "v"(Sst + ci * 4096 + (16 * w + lr) * 64 + 8 * lq), "v"(sB0), "v"(sB1) : "memory");
#pragma unroll
                    for (int kt = 0; kt < 4; ++kt) {
                        f32x4_t acc = {bf2f(nv[sl][kt].x & 0xffffu), bf2f(nv[sl][kt].x >> 16), bf2f(nv[sl][kt].y & 0xffffu), bf2f(nv[sl][kt].y >> 16)};
                        acc = MFMA16(ma[sl][kt][0], sB0, acc); acc = MFMA16(ma[sl][kt][1], sB1, acc);
                        lds_st8(sS + (lr * CLD + 16 * kt + 4 * lq) * 2, pack4(acc[0], acc[1], acc[2], acc[3]));
                    }
                    const size_t cn = (chunk + sl + 4 < SEQ / CL) ? ci + 4 : ci;
                    RB_LOAD(sl, cn);
                    asm volatile("s_waitcnt lgkmcnt(0)" ::: "memory");
                    sB0 = ldsfrag(sS, lr, 8 * lq); sB1 = ldsfrag(sS, lr, 32 + 8 * lq);
                    asm volatile("s_waitcnt lgkmcnt(0)" ::: "memory");
                }
            }
#undef RB_LOAD
        }
    }
}

__device__ __forceinline__ void rwkv_phaseC(const Ctx& c) {
    const bf16_t* __restrict__ Qq = (const bf16_t*)(c.ws + WS_CQ); const bf16_t* __restrict__ YTq = (const bf16_t*)(c.ws + WS_CY); const bf16_t* __restrict__ Sst = (const bf16_t*)(c.ws + WS_CS);
    const float* __restrict__ bon = (const float*)(c.ws + WS_CBON);
    const bf16_t* rw_v = (const bf16_t*)(c.ws + WS_RW_V); const bf16_t* rw_g = (const bf16_t*)(c.ws + WS_RW_G);
    const float* ln_w = c.in[18]; const float* ln_b = c.in[19];
    bf16_t* ycat = (bf16_t*)(c.ws + WS_A);
    const int w = c.wid, lane = c.lane, lr = lane & 15, lq = lane >> 4;
    LAS float* sY = (LAS float*)(c.lds + w * (16 * 68 * 4));
    const int gw = c.bid * 8 + c.wid, NW = c.G * 8;
    for (int task = gw; task < BATCH * NH * (SEQ / CL) * 4; task += NW) {
        const size_t ci = (size_t)(task >> 2); const int tt = task & 3;
        const int bh = (int)(ci >> 7), chunk = (int)(ci & 127), b = bh >> 3, h = bh & 7;
        bf16x8_t qa[2];
#pragma unroll
        for (int ks = 0; ks < 2; ++ks) qa[ks] = *(const bf16x8_t*)(Qq + ci * 4096 + (16 * tt + lr) * 64 + 32 * ks + 8 * lq);
#pragma unroll
        for (int vt = 0; vt < 4; ++vt) {
            const uint2 yv = *(const uint2*)(YTq + ci * 4096 + (16 * vt + lr) * 64 + 16 * tt + 4 * lq);
            f32x4_t acc = {bf2f(yv.x & 0xffffu), bf2f(yv.x >> 16), bf2f(yv.y & 0xffffu), bf2f(yv.y >> 16)};
#pragma unroll
            for (int ks = 0; ks < 2; ++ks) acc = MFMA16(qa[ks], *(const bf16x8_t*)(Sst + ci * 4096 + (16 * vt + lr) * 64 + 32 * ks + 8 * lq), acc);
#pragma unroll
            for (int rg = 0; rg < 4; ++rg) sY[(4 * lq + rg) * 68 + 16 * vt + lr] = acc[rg];
        }
        asm volatile("s_waitcnt lgkmcnt(0)" ::: "memory");
        const int hn = h * 64 + lane;
        const float lw = ln_w[hn], lb = ln_b[hn];
#pragma unroll 4
        for (int tr = 0; tr < 16; ++tr) {
            const int t = chunk * CL + 16 * tt + tr; const size_t tok = (size_t)b * SEQ + t;
            const float y = sY[tr * 68 + lane];
            const float mean = wave_sum_u(y) * (1.f / 64.f);
            const float d = y - mean;
            const float var = wave_sum_u(d * d) * (1.f / 64.f);
            const float yn = d * rsqrtf(var + 64e-5f) * lw + lb;
            const float bonus = bon[ci * CL + 16 * tt + tr] * ldbf(rw_v + tok * RW + hn);
            ycat[tok * D + hn] = (bf16_t)f2bf((yn + bonus) * ldbf(rw_g + tok * RW + hn));
        }
        asm volatile("s_waitcnt lgkmcnt(0)" ::: "memory");
    }
}

constexpr int PA_BLOCKS = 256;
constexpr int CONV_A = 0;
__device__ __forceinline__ void phase6a(const Ctx& c) {
    if (c.G != 256) { rwkv_phaseA(c, c.G); return; }
    if (c.bid < PA_BLOCKS) rwkv_phaseA(c, PA_BLOCKS);
    else if (CONV_A > 0) convert_expert_weights(c, 0, CONV_A, (c.bid - PA_BLOCKS) * 8 + c.wid, (256 - PA_BLOCKS > 0 ? 256 - PA_BLOCKS : 1) * 8);
}

__device__ __forceinline__ void phase6b(const Ctx& c) {
    if (c.wid == 0) {
        for (int tk = c.bid; tk < 2 * S5NG * BATCH; tk += c.G) {
            if (tk < BATCH * NH * 4) { rwkv_phaseB(c, tk >> 2, tk & 3); continue; }
            const float* apow = (const float*)(c.ws + WS_APOW); const float* E = (const float*)((const unsigned char*)c.out + OUT_E);
            bf16_t* ux = (bf16_t*)((unsigned char*)c.out + OUT_UX);
            const int task = tk - BATCH * NH * 4;
            const int g = task >> 2, b = task & 3, p = c.lane;
            const float pr = apow[((size_t)(g * (S5L + 1) + S5L) * 64 + p) * 2], pi = apow[((size_t)(g * (S5L + 1) + S5L) * 64 + p) * 2 + 1];
            float xr = 0.f, xi = 0.f;
            const size_t row0 = (size_t)g * 1024 + b * 256;
            float er[2][8], ei[2][8];
#pragma unroll
            for (int q = 0; q < 8; ++q) { er[0][q] = E[(row0 + q) * 128 + p]; ei[0][q] = E[(row0 + q) * 128 + 64 + p]; }
#pragma unroll
            for (int bt = 0; bt < 32; ++bt) {
                const int cur = bt & 1, nx = cur ^ 1, ch0 = bt * 8;
                if (bt + 1 < 32) {
#pragma unroll
                    for (int q = 0; q < 8; ++q) { er[nx][q] = E[(row0 + ch0 + 8 + q) * 128 + p]; ei[nx][q] = E[(row0 + ch0 + 8 + q) * 128 + 64 + p]; }
                }
#pragma unroll
                for (int q = 0; q < 8; ++q) {
                    st2(ux + (row0 + ch0 + q) * 640 + 512 + p, f2bf(xr)); st2(ux + (row0 + ch0 + q) * 640 + 576 + p, f2bf(xi));
                    const float nr = pr * xr - pi * xi + er[cur][q], ni = pr * xi + pi * xr + ei[cur][q]; xr = nr; xi = ni;
                }
            }
        }
    } else {
        convert_expert_weights(c, (c.G == 256) ? CONV_A : 0, NE * 384, c.bid * 7 + (c.wid - 1), c.G * 7);
    }
}

__device__ __forceinline__ void phase7(const Ctx& c) {
    {
        pg8::Gemm g{(const bf16_t*)((unsigned char*)c.out + OUT_UX), (const bf16_t*)(c.ws + WS_KMAT), 0, 0, 640};
        pg8::S5Order S{256, 2, c.G, c.bid};
        pg8::EpiS5Out E{(bf16_t*)(c.ws + WS_YS5)};
        pg8::gemm_phase<pg8::EpiS5Out, pg8::S5Order, true, true>(c.lds, g, S, E);
    }
    __syncthreads();
    rwkv_phaseC(c);
}

__device__ __forceinline__ void phase8(const Ctx& c) {
    pg8::Gemm g{(const bf16_t*)(c.ws + WS_YS5), (const bf16_t*)(c.ws + WS_WGLU_T), T, 512, 512};
    pg8::StaticOrder S; S.init(T, 512, c.G, c.bid);
    pg8::EpiGLU E{(const bf16_t*)(c.ws + WS_YS5), 512, c.in[29], (bf16_t*)(c.ws + WS_A), D, 512};
    pg8::gemm_phase<pg8::EpiGLU, pg8::StaticOrder, true, true>(c.lds, g, S, E);
}

__device__ __forceinline__ void phase9(const Ctx& c) {
    pg8::Gemm g{(const bf16_t*)(c.ws + WS_A), (const bf16_t*)(c.ws + WS_WOUT_T), T, D, D};
    pg8::StaticOrder S; S.init(T, D, c.G, c.bid);
    pg8::EpiF32 E{(float*)(c.ws + WS_PROJ), D};
    pg8::gemm_phase<pg8::EpiF32, pg8::StaticOrder, true, true>(c.lds, g, S, E);
}

__device__ __forceinline__ void phase10(const Ctx& c) {
    const float* x = c.in[0]; const float* gpm = c.in[5]; const float* gpf = c.in[6];
    const float* mods = (const float*)(c.ws + WS_MODS); const float* mixed = (const float*)(c.ws + WS_PROJ);
    bf16_t* h2 = (bf16_t*)(c.ws + WS_A); float* x1o = c.out;
    const int gw = c.bid * 8 + c.wid, NW = c.G * 8;
    for (int t = gw; t < T; t += NW) {
        const int b = t / SEQ;
        const float4* mr = (const float4*)(mixed + (size_t)t * D) + c.lane;
        const float4* xr = (const float4*)(x + (size_t)t * D) + c.lane;
        float4 m[4], v[4]; float ss = 0.f;
#pragma unroll
        for (int j = 0; j < 4; ++j) { m[j] = mr[64 * j]; v[j] = xr[64 * j]; ss += m[j].x * m[j].x + m[j].y * m[j].y + m[j].z * m[j].z + m[j].w * m[j].w; }
        const float rstd = rsqrtf(wave_sum(ss) * (1.0f / D) + 1e-6f);
        float s1 = 0.f;
#pragma unroll
        for (int j = 0; j < 4; ++j) {
            const int k = (c.lane + 64 * j) * 4;
            const float4 gg = *(const float4*)(gpm + k);
            const float4 gt = *(const float4*)(mods + b * NMODS + 2 * D + k);
            v[j].x += gt.x * (m[j].x * rstd * gg.x); v[j].y += gt.y * (m[j].y * rstd * gg.y);
            v[j].z += gt.z * (m[j].z * rstd * gg.z); v[j].w += gt.w * (m[j].w * rstd * gg.w);
            s1 += v[j].x * v[j].x + v[j].y * v[j].y + v[j].z * v[j].z + v[j].w * v[j].w;
            ((float4*)(x1o + (size_t)t * D) + c.lane)[64 * j] = v[j];
        }
        const float rstd1 = rsqrtf(wave_sum(s1) * (1.0f / D) + 1e-6f);
#pragma unroll
        for (int j = 0; j < 4; ++j) {
            const int k = (c.lane + 64 * j) * 4;
            const float4 gg = *(const float4*)(gpf + k);
            const float4 sh = *(const float4*)(mods + b * NMODS + 3 * D + k);
            const float4 sc = *(const float4*)(mods + b * NMODS + 4 * D + k);
            float r[4];
            r[0] = v[j].x * rstd1 * gg.x * (1.f + sc.x) + sh.x; r[1] = v[j].y * rstd1 * gg.y * (1.f + sc.y) + sh.y;
            r[2] = v[j].z * rstd1 * gg.z * (1.f + sc.z) + sh.z; r[3] = v[j].w * rstd1 * gg.w * (1.f + sc.w) + sh.w;
            unsigned hi[4]; float lo[4];
#pragma unroll
            for (int q = 0; q < 4; ++q) { hi[q] = f2bf(r[q]); lo[q] = r[q] - bf2f(hi[q]); }
            ((uint2*)(h2 + (size_t)t * D) + c.lane)[64 * j] = make_uint2(hi[0] | (hi[1] << 16), hi[2] | (hi[3] << 16));
            ((uint2*)(h2 + (size_t)(T + t) * D) + c.lane)[64 * j] = make_uint2(pk2(lo[0], lo[1]), pk2(lo[2], lo[3]));
        }
    }
}

__device__ __forceinline__ void phase11(const Ctx& c) {
    {
        pg8::Gemm g{(const bf16_t*)(c.ws + WS_A), (const bf16_t*)(c.ws + WS_WR_T), 2 * T, 512, D};
        pg8::StaticOrder S; S.init(2 * T, 512, c.G, c.bid);
        pg8::EpiF32 E{(float*)(c.ws + WS_PLOG), 512};
        pg8::gemm_phase<pg8::EpiF32, pg8::StaticOrder, true, true>(c.lds, g, S, E);
    }
    __syncthreads();
    {
        pg8::Gemm g{(const bf16_t*)(c.ws + WS_A), (const bf16_t*)(c.ws + WS_WSGU_T), T, 512, D};
        pg8::StaticOrder S; S.init(T, 512, c.G, c.bid);
        pg8::EpiSwiGLU E{(bf16_t*)(c.ws + WS_HS), 256};
        pg8::gemm_phase<pg8::EpiSwiGLU, pg8::StaticOrder, true, true>(c.lds, g, S, E);
    }
}

__device__ __forceinline__ unsigned fkey(float f) { const unsigned u = __builtin_bit_cast(unsigned, f); return u ^ ((u >> 31) ? 0xffffffffu : 0x80000000u); }
__device__ __forceinline__ unsigned wave_umax(unsigned v) {
    v = max(v, DPPU(v, 0xB1)); v = max(v, DPPU(v, 0x4E)); v = max(v, DPPU(v, 0x141)); v = max(v, DPPU(v, 0x140));
    const unsigned a = __builtin_amdgcn_readlane(v, 0), b = __builtin_amdgcn_readlane(v, 16), c = __builtin_amdgcn_readlane(v, 32), d = __builtin_amdgcn_readlane(v, 48);
    return max(max(a, b), max(c, d));
}
__device__ __forceinline__ unsigned wave_umin(unsigned v) {
    v = min(v, DPPU(v, 0xB1)); v = min(v, DPPU(v, 0x4E)); v = min(v, DPPU(v, 0x141)); v = min(v, DPPU(v, 0x140));
    const unsigned a = __builtin_amdgcn_readlane(v, 0), b = __builtin_amdgcn_readlane(v, 16), c = __builtin_amdgcn_readlane(v, 32), d = __builtin_amdgcn_readlane(v, 48);
    return min(min(a, b), min(c, d));
}
__device__ __forceinline__ void phase12(const Ctx& c) {
    const float* plog = (const float*)(c.ws + WS_PLOG); const float* rb = c.in[32];
    int* idx = (int*)(c.ws + WS_IDX); float* wt = (float*)(c.ws + WS_WT);
    LAS int* lhist = (LAS int*)c.lds;
    __syncthreads();
    if (c.tid < NE) lhist[c.tid] = 0;
    __syncthreads();
    const int gw = c.bid * 8 + c.wid, NW = c.G * 8, l = c.lane;
    const float4 bias = *(const float4*)(rb + l * 4);
    for (int t = gw; t < T; t += NW) {
        const float4 p0 = *(const float4*)(plog + (size_t)t * 512 + l * 4), p1 = *(const float4*)(plog + (size_t)t * 512 + 256 + l * 4);
        const float4 p2 = *(const float4*)(plog + (size_t)(T + t) * 512 + l * 4), p3 = *(const float4*)(plog + (size_t)(T + t) * 512 + 256 + l * 4);
        const float lg[4] = {p0.x + (p1.x + p2.x + p3.x), p0.y + (p1.y + p2.y + p3.y), p0.z + (p1.z + p2.z + p3.z), p0.w + (p1.w + p2.w + p3.w)};
        float s[4] = {sigmoidf_(lg[0]), sigmoidf_(lg[1]), sigmoidf_(lg[2]), sigmoidf_(lg[3])};
        float ch[4] = {s[0] + bias.x, s[1] + bias.y, s[2] + bias.z, s[3] + bias.w};
        float a1 = fmaxf(ch[0], ch[1]), a2 = fminf(ch[0], ch[1]);
        { const float b1 = fmaxf(ch[2], ch[3]), b2 = fminf(ch[2], ch[3]); const float n1 = fmaxf(a1, b1), n2 = fmaxf(fminf(a1, b1), fmaxf(a2, b2)); a1 = n1; a2 = n2; }
        { const float b1 = DPPF(a1, 0xB1), b2 = DPPF(a2, 0xB1); const float n1 = fmaxf(a1, b1), n2 = fmaxf(fminf(a1, b1), fmaxf(a2, b2)); a1 = n1; a2 = n2; }
        { const float b1 = DPPF(a1, 0x4E), b2 = DPPF(a2, 0x4E); const float n1 = fmaxf(a1, b1), n2 = fmaxf(fminf(a1, b1), fmaxf(a2, b2)); a1 = n1; a2 = n2; }
        { const float b1 = DPPF(a1, 0x141), b2 = DPPF(a2, 0x141); const float n1 = fmaxf(a1, b1), n2 = fmaxf(fminf(a1, b1), fmaxf(a2, b2)); a1 = n1; a2 = n2; }
        const float gs = a1 + a2; const int myg = l >> 3;
        int rank = 0;
#pragma unroll
        for (int g = 0; g < 8; ++g) { const float og = __builtin_bit_cast(float, __builtin_amdgcn_readlane(__builtin_bit_cast(int, gs), g * 8)); rank += (og > gs || (og == gs && g < myg)) ? 1 : 0; }
        const bool sel = rank < 4;
        unsigned mk[4];
#pragma unroll
        for (int i = 0; i < 4; ++i) mk[i] = sel ? fkey(ch[i]) : 0u;
        float sk[8]; int ek[8]; float ssum = 0.f;
#pragma unroll
        for (int k = 0; k < 8; ++k) {
            const unsigned lm = max(max(mk[0], mk[1]), max(mk[2], mk[3]));
            const unsigned m = wave_umax(lm);
            unsigned cand = 1023u;
#pragma unroll
            for (int i = 3; i >= 0; --i) if (mk[i] == m) cand = (unsigned)(l * 4 + i);
            const int be = (int)wave_umin(cand);
            const int ii = be & 3;
            float sv = s[0]; sv = (ii == 1) ? s[1] : sv; sv = (ii == 2) ? s[2] : sv; sv = (ii == 3) ? s[3] : sv;
            sv = __builtin_bit_cast(float, __builtin_amdgcn_readlane(__builtin_bit_cast(int, sv), be >> 2));
            if ((be >> 2) == l) {
#pragma unroll
                for (int i = 0; i < 4; ++i) if (i == ii) mk[i] = 0u;
            }
            sk[k] = sv; ek[k] = be; ssum += sv;
        }
        if (l == 0) {
            const float inv = 2.5f / ssum;
#pragma unroll
            for (int k = 0; k < 8; ++k) { idx[t * 8 + k] = ek[k]; wt[t * 8 + k] = sk[k] * inv; __hip_atomic_fetch_add(lhist + ek[k], 1, __ATOMIC_RELAXED, __HIP_MEMORY_SCOPE_WORKGROUP); }
        }
    }
    __syncthreads();
    if (c.tid < NE) ((int*)(c.ws + WS_HIST))[c.bid * NE + c.tid] = lhist[c.tid];
}

__device__ __forceinline__ void phase13(const Ctx& c) {
    int* smi = (int*)c.sm;
    const int* hist = (const int*)(c.ws + WS_HIST);
    __syncthreads();
    if (c.tid < NE) {
        int tot = 0, base = 0;
        for (int bb = 0; bb < c.G; ++bb) { const int v = hist[bb * NE + c.tid]; tot += v; base += (bb < c.bid) ? v : 0; }
        smi[600 + c.tid] = tot; smi[900 + c.tid] = base; smi[1200 + c.tid] = 0; smi[300 + c.tid] = (tot + 255) >> 8;
    }
    __syncthreads();
    if (c.tid < 64) {
        const int l = c.tid; const int u0 = smi[300 + l * 4], u1 = smi[300 + l * 4 + 1], u2 = smi[300 + l * 4 + 2], u3 = smi[300 + l * 4 + 3];
        const int tot = u0 + u1 + u2 + u3; int inc = tot;
#pragma unroll
        for (int o = 1; o < 64; o <<= 1) { const int v = __shfl_up(inc, o); if (l >= o) inc += v; }
        const int ex = inc - tot;
        smi[l * 4] = ex; smi[l * 4 + 1] = ex + u0; smi[l * 4 + 2] = ex + u0 + u1; smi[l * 4 + 3] = ex + u0 + u1 + u2;
        if (l == 63) smi[NE] = inc;
    }
    __syncthreads();
    const int* idx = (const int*)(c.ws + WS_IDX); int* slotp = (int*)(c.ws + WS_SLOTP); int* uexp = (int*)(c.ws + WS_UEXP); int* slotw = (int*)(c.ws + WS_SLOTW); const float* wt = (const float*)(c.ws + WS_WT);
    const int gw = c.bid * 8 + c.wid, NW = c.G * 8;
    for (int t = gw; t < T; t += NW) {
        if (c.lane < 8) {
            const int a = t * 8 + c.lane, e = idx[a];
            const int pos = smi[900 + e] + __hip_atomic_fetch_add(smi + 1200 + e, 1, __ATOMIC_RELAXED, __HIP_MEMORY_SCOPE_WORKGROUP);
            const int slot = smi[e] * 256 + pos;
            slotp[slot] = a;
            *(int2*)(slotw + 2 * (size_t)slot) = make_int2(a, __float_as_int(wt[a]));
        }
    }
    const int gt = c.bid * 512 + c.tid, NT = c.G * 512;
    for (int e = gt; e < NE; e += NT) {
        const int u0 = smi[e], u1 = smi[e + 1], cn = smi[600 + e];
        for (int p = cn; p < (u1 - u0) * 256; ++p) { slotp[u0 * 256 + p] = -1; *(int2*)(slotw + 2 * (size_t)(u0 * 256 + p)) = make_int2(-1, 0); }
        for (int u = u0; u < u1; ++u) uexp[u] = e;
    }
    if (gt == 0) uexp[2048] = smi[NE];
}

__device__ __forceinline__ void phase14(const Ctx& c) {
    const int* uexp = (const int*)(c.ws + WS_UEXP);
    const int NU = __builtin_amdgcn_readfirstlane(uexp[2048]);
    const int vcu = (c.G % 8 == 0) ? (c.bid % 8) * (c.G / 8) + c.bid / 8 : c.bid;
    pg8::Gemm g{(const bf16_t*)(c.ws + WS_A), (const bf16_t*)(c.ws + WS_WEGU), 0, 0, D, (const int*)(c.ws + WS_SLOTP)};
    pg8::ExpertOrder S{uexp, NU, 2, c.G, vcu};
    pg8::EpiSwiGLU E{(bf16_t*)(c.ws + WS_HID), 256};
    pg8::gemm_phase<pg8::EpiSwiGLU, pg8::ExpertOrder, true, true, true>(c.lds, g, S, E);
}

__device__ __forceinline__ void phase15(const Ctx& c) {
    {
        const int* uexp = (const int*)(c.ws + WS_UEXP);
        const int NU = __builtin_amdgcn_readfirstlane(uexp[2048]);
        const int vcu = (c.G % 8 == 0) ? (c.bid % 8) * (c.G / 8) + c.bid / 8 : c.bid;
        pg8::Gemm g{(const bf16_t*)(c.ws + WS_HID), (const bf16_t*)(c.ws + WS_WED), 0, 0, EFF};
        pg8::ExpertOrder S{uexp, NU, 4, c.G, vcu};
        pg8::EpiScatter E{(const int*)(c.ws + WS_SLOTW), (bf16_t*)(c.ws + WS_YEXP), D};
        pg8::gemm_phase<pg8::EpiScatter, pg8::ExpertOrder, true, true>(c.lds, g, S, E);
    }
    __syncthreads();
    {
        pg8::Gemm g{(const bf16_t*)(c.ws + WS_HS), (const bf16_t*)(c.ws + WS_WSD_T), T, D, 256};
        pg8::StaticOrder S; S.init(T, D, c.G, c.bid);
        pg8::EpiBf16<0> E{(bf16_t*)(c.ws + WS_SHOUT), D, nullptr, 0, 0, 1.f};
        pg8::gemm_phase<pg8::EpiBf16<0>, pg8::StaticOrder, true, true>(c.lds, g, S, E);
    }
}

__device__ __forceinline__ void phase16(const Ctx& c) {
    const float* gq = c.in[7]; const float* mods = (const float*)(c.ws + WS_MODS);
    const bf16_t* shout = (const bf16_t*)(c.ws + WS_SHOUT); const unsigned char* yexp = (const unsigned char*)(c.ws + WS_YEXP);
    float* out = c.out; float* dst = c.out;
    const int gw = c.bid * 8 + c.wid, NW = c.G * 8;
    typedef float f32x2s __attribute__((ext_vector_type(2)));
    for (int t = gw; t < T; t += NW) {
        const int b = t / SEQ;
        float y[2][8], x1[2][8]; float ss = 0.f;
        uint2 ye[2][8]; uint4 sh[2]; float4 xv[2][2];
#pragma unroll
        for (int j = 0; j < 2; ++j) {
            const int k = (c.lane + 64 * j) * 8;
            sh[j] = *(const uint4*)(shout + (size_t)t * D + k);
            xv[j][0] = *(const float4*)(out + (size_t)t * D + k); xv[j][1] = *(const float4*)(out + (size_t)t * D + k + 4);
#pragma unroll
            for (int q = 0; q < 8; ++q) ye[j][q] = *(const uint2*)(yexp + (size_t)(t * 8 + q) * D + k);
        }
#pragma unroll
        for (int j = 0; j < 2; ++j) {
            unpack8(sh[j], y[j]);
            x1[j][0] = xv[j][0].x; x1[j][1] = xv[j][0].y; x1[j][2] = xv[j][0].z; x1[j][3] = xv[j][0].w; x1[j][4] = xv[j][1].x; x1[j][5] = xv[j][1].y; x1[j][6] = xv[j][1].z; x1[j][7] = xv[j][1].w;
#pragma unroll
            for (int q = 0; q < 8; ++q) {
                const f32x2s a0 = __builtin_amdgcn_cvt_pk_f32_fp8((int)ye[j][q].x, false), a1 = __builtin_amdgcn_cvt_pk_f32_fp8((int)ye[j][q].x, true);
                const f32x2s a2 = __builtin_amdgcn_cvt_pk_f32_fp8((int)ye[j][q].y, false), a3 = __builtin_amdgcn_cvt_pk_f32_fp8((int)ye[j][q].y, true);
                y[j][0] += a0[0]; y[j][1] += a0[1]; y[j][2] += a1[0]; y[j][3] += a1[1]; y[j][4] += a2[0]; y[j][5] += a2[1]; y[j][6] += a3[0]; y[j][7] += a3[1];
            }
#pragma unroll
            for (int i = 0; i < 8; ++i) ss += y[j][i] * y[j][i];
        }
        const float rstd = rsqrtf(wave_sum_u(ss) * (1.0f / D) + 1e-6f);
#pragma unroll
        for (int j = 0; j < 2; ++j) {
            const int k = (c.lane + 64 * j) * 8;
            const float4 g0 = *(const float4*)(gq + k), g1 = *(const float4*)(gq + k + 4);
            const float4 t0 = *(const float4*)(mods + b * NMODS + 5 * D + k), t1 = *(const float4*)(mods + b * NMODS + 5 * D + k + 4);
            const float gg[8] = {g0.x, g0.y, g0.z, g0.w, g1.x, g1.y, g1.z, g1.w}, gt[8] = {t0.x, t0.y, t0.z, t0.w, t1.x, t1.y, t1.z, t1.w};
            float o[8];
#pragma unroll
            for (int i = 0; i < 8; ++i) o[i] = x1[j][i] + gt[i] * (y[j][i] * rstd * gg[i]);
            *(float4*)(dst + (size_t)t * D + k) = make_float4(o[0], o[1], o[2], o[3]); *(float4*)(dst + (size_t)t * D + k + 4) = make_float4(o[4], o[5], o[6], o[7]);
        }
    }
}

constexpr int NPHASES = 18;
__device__ __forceinline__ void probe_reset(const Ctx& c, int k) {
    unsigned* counts = (unsigned*)(c.ws + WS_COUNTS);
    if (k == 13 && c.bid == 0 && c.tid < 256) counts[c.tid] = 0u;
    if (k == 14 && c.bid == 0 && c.tid < 256) counts[256 + c.tid] = 0u;
}

__global__ void __launch_bounds__(512, 2) mega(Args args) {
    extern __shared__ __attribute__((aligned(16))) unsigned char lds_raw[];
    Ctx c;
    c.in = args.in; c.out = args.out; c.ws = args.ws;
    c.lds = (LAS unsigned char*)lds_raw; c.sm = (float*)lds_raw;
    c.dry = 0;
    c.tid = threadIdx.x; c.lane = c.tid & 63; c.wid = __builtin_amdgcn_readfirstlane(c.tid >> 6); c.bid = blockIdx.x; c.G = gridDim.x;
    volatile LAS unsigned* st = (volatile LAS unsigned*)(c.lds + LDS_CTL_OFF);
    if (c.tid < 4) st[c.tid] = 0u;
    __syncthreads();
    XcdBarrier bar; bar.bar = (unsigned*)(args.ws + WS_CTL); bar.x = 0; bar.st = st;
    const bool multi = (args.hi - args.lo) > 1;
    if (multi) bar = xcd_barrier_post((unsigned*)(args.ws + WS_CTL), st);
    const int lo = args.lo, hi = args.hi;
#ifndef REPEAT_PHASE
#define REPEAT_PHASE -1
#endif
#define LAUNDER() do { int t_ = threadIdx.x; asm volatile("" : "+v"(t_)); c.tid = t_; c.lane = t_ & 63; int b_ = blockIdx.x; asm volatile("" : "+s"(b_)); c.bid = b_; } while (0)
#define RUN_PHASE(k, call) if (lo <= (k) && (k) < hi) { if ((k) == REPEAT_PHASE) { LAUNDER(); c.dry = 1; call; c.dry = 0; xcd_barrier(bar); probe_reset(c, (k)); xcd_barrier(bar); } LAUNDER(); call; if ((k) + 1 < hi) xcd_barrier(bar); }
    RUN_PHASE(0, phase0(c))
    RUN_PHASE(1, phase1(c))
    RUN_PHASE(2, phase2(c))
    RUN_PHASE(3, phase3(c))
    RUN_PHASE(4, phase4(c))
    RUN_PHASE(5, phase5(c))
    RUN_PHASE(6, phase6a(c))
    RUN_PHASE(7, phase6b(c))
    RUN_PHASE(8, phase7(c))
    RUN_PHASE(9, phase8(c))
    RUN_PHASE(10, phase9(c))
    RUN_PHASE(11, phase10(c))
    RUN_PHASE(12, phase11(c))
    RUN_PHASE(13, phase12(c))
    RUN_PHASE(14, phase13(c))
    RUN_PHASE(15, phase14(c))
    RUN_PHASE(16, phase15(c))
    RUN_PHASE(17, phase16(c))
#undef RUN_PHASE
}

#ifndef N_LAUNCH_MODE
#define N_LAUNCH_MODE 1
#endif

extern "C" void kernel_launch(void* const* d_in, const int* in_sizes, int n_in, void* d_out, int out_size, void* d_ws, size_t ws_size, hipStream_t stream) {
    static int grid = 0;
    if (grid == 0) {
        if (n_in != 39 || out_size != T * D || ws_size < WS_END) { fprintf(stderr, "kernel_launch: unexpected shapes n_in %d out %d ws %zu\n", n_in, out_size, ws_size); grid = -1; return; }
        int dev = 0, cus = 0, per_cu = 0;
        if (hipGetDevice(&dev) != hipSuccess || hipDeviceGetAttribute(&cus, hipDeviceAttributeMultiprocessorCount, dev) != hipSuccess) { grid = -1; return; }
        if (hipFuncSetAttribute((const void*)mega, hipFuncAttributeMaxDynamicSharedMemorySize, LDS_BYTES) != hipSuccess) { grid = -1; return; }
        if (hipOccupancyMaxActiveBlocksPerMultiprocessor(&per_cu, (const void*)mega, 512, LDS_BYTES) != hipSuccess || per_cu < 1) { fprintf(stderr, "kernel_launch: occupancy query says %d\n", per_cu); }
        (void)hipGetLastError();
        grid = cus;
    }
    if (grid < 0) return;
    (void)hipMemsetAsync((char*)d_ws + WS_CTL, 0, CTL_BYTES, stream);
    Args a{};
    for (int i = 0; i < 39; ++i) a.in[i] = (const float*)d_in[i];
    a.out = (float*)d_out; a.ws = (unsigned char*)d_ws;
    if (N_LAUNCH_MODE == 1) {
        a.lo = 0; a.hi = NPHASES;
        hipLaunchKernelGGL(mega, dim3(grid), dim3(512), LDS_BYTES, stream, a);
    } else {
        for (int ph = 0; ph < NPHASES; ++ph) {
            a.lo = ph; a.hi = ph + 1;
            hipLaunchKernelGGL(mega, dim3(grid), dim3(512), LDS_BYTES, stream, a);
        }
    }
}
```

```cpp
#include <hip/hip_runtime.h>
#include <cstdint>
#include <cstdio>

#define LAS __attribute__((address_space(3)))

constexpr int D = 1024, BATCH = 4, SEQ = 8192, T = BATCH * SEQ;
constexpr int RW = 512, NH = 8;
constexpr int RPROJ = 1792, NPROJ = 2304;
constexpr int S5NG = 32, S5P = 64;
constexpr int NE = 256, EFF = 256;
constexpr int NMODS = 6 * D;
constexpr int S5L = 32;

constexpr size_t MiB = 1u << 20;
constexpr size_t WS_CTL = 0, CTL_BYTES = 1 * MiB;
constexpr size_t WS_COUNTS = 64 * 1024;
constexpr size_t WS_MODS = 1 * MiB;
constexpr size_t WS_HMAT = 2 * MiB;
constexpr size_t WS_WIN_T = 12 * MiB;
constexpr size_t WS_WOUT_T = 17 * MiB;
constexpr size_t WS_WGLU_T = 19 * MiB;
constexpr size_t WS_WSGU_T = 19 * MiB + 512 * 1024;
constexpr size_t WS_WSD_T = 20 * MiB + 512 * 1024;
constexpr size_t WS_WR_T = 21 * MiB;
constexpr size_t WS_LORA_BT = 22 * MiB;
constexpr size_t WS_APOW = 23 * MiB;
constexpr size_t WS_KMAT = 1000 * MiB;
constexpr size_t WS_MODSP = 1020 * MiB;
constexpr size_t WS_S5BB = 1022 * MiB;
constexpr size_t WS_KLAG = 1022 * MiB + 512 * 1024;
constexpr size_t OUT_UX = 0;
constexpr size_t OUT_E = 40 * MiB;
constexpr size_t OUT_ALORA = 56 * MiB;
constexpr size_t OUT_KF = 72 * MiB;
constexpr size_t WS_WED = 24 * MiB;
constexpr size_t WS_WEGU = 152 * MiB;
constexpr size_t WS_A = 408 * MiB;
constexpr size_t WS_YS5 = WS_A + 64 * MiB;
constexpr size_t WS_PROJ = 536 * MiB;
constexpr size_t WS_RW = 680 * MiB;
constexpr size_t RWSZ = (size_t)T * RW * 4;
constexpr size_t RWSZH = (size_t)T * RW * 2;
constexpr size_t WS_RW_W = WS_RW, WS_RW_Y = WS_RW + RWSZ, WS_RW_R = WS_RW + 2 * RWSZ, WS_RW_K = WS_RW_R + RWSZH, WS_RW_V = WS_RW_K + RWSZH,
                 WS_RW_A = WS_RW_V + RWSZH, WS_RW_B = WS_RW_A + RWSZH, WS_RW_G = WS_RW_B + RWSZH;
constexpr size_t WS_CM = WS_PROJ, WS_CN = WS_PROJ + 32 * MiB, WS_CQ = WS_PROJ + 64 * MiB, WS_CY = WS_PROJ + 96 * MiB;
constexpr size_t WS_CS = WS_RW_Y, WS_CBON = WS_RW_Y + 32 * MiB;
constexpr size_t WS_PLOG = 680 * MiB;
constexpr size_t WS_SHOUT = 680 * MiB;
constexpr size_t WS_HS = 808 * MiB;
constexpr size_t WS_IDX = 824 * MiB;
constexpr size_t WS_WT = 825 * MiB;
constexpr size_t WS_SLOTP = 826 * MiB;
constexpr size_t WS_UEXP = 827 * MiB + 512 * 1024;
constexpr size_t WS_SLOTW = 828 * MiB;
constexpr size_t WS_HIST = 831 * MiB;
constexpr size_t WS_HID = 840 * MiB;
constexpr size_t WS_YEXP = 152 * MiB;
constexpr size_t WS_END = 1023 * MiB + 512 * 1024;

constexpr int LDS_BYTES = 132096;
constexpr int LDS_CTL_OFF = 131072;

#define XB_TMO      128
#define XB_XCNT(j)  (256  + 64 * (j))
#define XB_XSUB(j)  (1280 + 64 * (j))
#define XB_XGEN(j)  (2304 + 64 * (j))
#define XB_TOP      3328
#define XB_TOPGEN   3392
#define XCD_BAR_WORDS 3456
#define XB_SPIN_CAP (1u << 24)

__device__ __forceinline__ unsigned xb_ld(unsigned* p)              { return __hip_atomic_load(p, __ATOMIC_RELAXED, __HIP_MEMORY_SCOPE_AGENT); }
__device__ __forceinline__ unsigned xb_add(unsigned* p, unsigned v) { return __hip_atomic_fetch_add(p, v, __ATOMIC_RELAXED, __HIP_MEMORY_SCOPE_AGENT); }
__device__ __forceinline__ unsigned xb_xcc_id() { return (unsigned)__builtin_amdgcn_s_getreg((3 << 11) | 20) & 0xFu; }
#define XB_SPIN(cond, bar) do { unsigned _sp = 0; while (cond) { __builtin_amdgcn_s_sleep(1); \
    if ((++_sp & 255u) == 0u) { if (xb_ld(&(bar)[XB_TMO])) break; if (_sp > XB_SPIN_CAP) { atomicAdd(&(bar)[XB_TMO], 1u); break; } } } } while (0)

struct XcdBarrier { unsigned* bar; unsigned x; volatile LAS unsigned* st; };

__device__ __forceinline__ XcdBarrier xcd_barrier_post(unsigned* bar, volatile LAS unsigned* st) {
    XcdBarrier b; b.bar = bar; b.x = xb_xcc_id(); b.st = st;
    if (threadIdx.x == 0) (void)xb_add(&bar[XB_XCNT(b.x)], 1u);
    return b;
}
__device__ __forceinline__ void xcd_barrier_complete(unsigned* bar, unsigned x, unsigned& nloc, unsigned& nx) {
    const unsigned G = gridDim.x * gridDim.y * gridDim.z;
    unsigned sum, cnt, mine, sp = 0u;
    for (;;) {
        sum = 0u; cnt = 0u; mine = 0u;
#pragma unroll
        for (unsigned j = 0; j < 16; ++j) { const unsigned c = xb_ld(&bar[XB_XCNT(j)]); sum += c; cnt += (c > 0u) ? 1u : 0u; mine = (j == x) ? c : mine; }
        if (sum == G) break;
        __builtin_amdgcn_s_sleep(1);
        if ((++sp & 255u) == 0u) { if (xb_ld(&bar[XB_TMO])) break; if (sp > XB_SPIN_CAP) { atomicAdd(&bar[XB_TMO], 1u); break; } }
    }
    nloc = mine > 0u ? mine : 1u; nx = cnt > 0u ? cnt : 1u;
}
__device__ __forceinline__ void xcd_barrier(const XcdBarrier& b) {
    asm volatile("s_waitcnt vmcnt(0)" ::: "memory");
    __syncthreads();
    if (threadIdx.x == 0) {
        unsigned* bar = b.bar;
        __builtin_amdgcn_s_waitcnt(0);
        unsigned nloc = b.st[0], nx = b.st[1];
        if (nloc == 0u) { xcd_barrier_complete(bar, b.x, nloc, nx); b.st[0] = nloc; b.st[1] = nx; }
        const unsigned old = xb_add(&bar[XB_XSUB(b.x)], 1u);
        const unsigned gen = old / nloc;
        if (old + 1u == (gen + 1u) * nloc) {
            __builtin_amdgcn_fence(__ATOMIC_RELEASE, "agent");
            asm volatile("s_waitcnt vmcnt(0)" ::: "memory");
            const unsigned og = xb_add(&bar[XB_TOP], 1u);
            const unsigned tg = og / nx;
            if (og + 1u == (tg + 1u) * nx) xb_add(&bar[XB_TOPGEN], 1u);
            else XB_SPIN(xb_ld(&bar[XB_TOPGEN]) == tg, bar);
            __builtin_amdgcn_fence(__ATOMIC_ACQUIRE, "agent");
            xb_add(&bar[XB_XGEN(b.x)], 1u);
            asm volatile("s_waitcnt vmcnt(0)" ::: "memory");
        } else {
            XB_SPIN(xb_ld(&bar[XB_XGEN(b.x)]) == gen, bar);
            __builtin_amdgcn_fence(__ATOMIC_ACQUIRE, "agent");
            asm volatile("s_waitcnt vmcnt(0)" ::: "memory");
        }
    }
    __syncthreads();
}

namespace pg8 {
#define PG8_LAS __attribute__((address_space(3)))
typedef unsigned short bf16_t;
typedef short bf16x8 __attribute__((ext_vector_type(8)));
typedef float f32x4 __attribute__((ext_vector_type(4)));
typedef unsigned u32x4 __attribute__((ext_vector_type(4)));
constexpr int BM = 256, BK = 64, HALF = 128, HTB = HALF * BK * 2  , STAGE_BYTES = 8 * HTB, NXCD = 8, WGM = 8;

__host__ __device__ __forceinline__ int lds_byte(int r, int c) { const int st = (r >> 4) * 2 + (c >> 5), rr = r & 15, cc = c & 31, ob = rr * 64 + cc * 2; return st * 1024 + (ob ^ (((ob >> 9) & 1) << 5)); }
__host__ __device__ __forceinline__ void stage_rc(int b, int& R, int& C) { const int st = b / 1024, sb = b % 1024, swz = sb ^ (((sb >> 9) & 1) << 5); R = (st >> 1) * 16 + swz / 64; C = (st & 1) * 32 + (swz % 64) / 2; }
__host__ __device__ __forceinline__ int perm32(int rho) { const int n = rho >> 4, i = rho & 15; return 8 * (i >> 2) + 4 * n + (i & 3); }

struct Unit { int pm, pn; };
struct Gemm { const bf16_t* A; const bf16_t* Bt; int M, N, K; const int* rowtab = nullptr; };

struct StaticOrder {
    int nM, nN, nwg, G, c;
    __host__ __device__ void init(int M, int N, int G_, int c_) { nM = M / BM; nN = N / BM; nwg = nM * nN; G = G_; c = c_; }
    __host__ __device__ bool next(int i, Unit& u) const {
        const long L = (long)i * G + c; if (L >= nwg) return false;
        int wgid = (int)L; { const int q = nwg / NXCD, r = nwg % NXCD, xcd = wgid % NXCD, off = wgid / NXCD; wgid = (xcd < r ? xcd * (q + 1) : r * (q + 1) + (xcd - r) * q) + off; }
        const int nig = WGM * nN, gid = wgid / nig, fm = gid * WGM, gsz = (nM - fm) < WGM ? (nM - fm) : WGM;
        u.pm = fm + ((wgid % nig) % gsz); u.pn = (wgid % nig) / gsz; return true;
    }
    __device__ __forceinline__ void a_ready(const Unit&) const {}
    __device__ __forceinline__ void done(const Unit&) const {}
};

__device__ __forceinline__ unsigned cvt_pk_bf16(float lo, float hi) { unsigned r; asm volatile("v_cvt_pk_bf16_f32 %0, %1, %2" : "=v"(r) : "v"(lo), "v"(hi)); return r; }
typedef float f32x2 __attribute__((ext_vector_type(2)));
__device__ __forceinline__ f32x2 gelu_pk(f32x2 v) {
    const f32x2 av = __builtin_elementwise_abs(v), d = av * 0.2316418882f + 1.0f;
    f32x2 t; t.x = __builtin_amdgcn_rcpf(d.x); t.y = __builtin_amdgcn_rcpf(d.y);
    f32x2 q = t * 0.5307027145f + (-0.7265760135f); q = q * t + 0.7107068705f; q = q * t + (-0.142248368f); q = q * t + 0.127414796f; q = q * t;
    const f32x2 s = (v * v) * (-0.72134752044f);
    f32x2 e; e.x = __builtin_amdgcn_exp2f(s.x); e.y = __builtin_amdgcn_exp2f(s.y);
    const f32x2 m = v * (q * e), r = v - m;
    f32x2 o; o.x = v.x < 0.f ? m.x : r.x; o.y = v.y < 0.f ? m.y : r.y; return o;
}

template <int ACT  > struct EpiBf16 {
    static constexpr bool PERM = true, AFTER_DRAIN = false; static_assert(ACT == 0 || ACT == 1, "EpiBf16: ACT is 0 (none) or 1 (gelu_pk)");
    bf16_t* O; int ldc; const float* bias; int split_cols; size_t split_stride; float scale0;
    __device__ __forceinline__ void operator()(const f32x4 (&acc)[2][2][4][2], const Unit& u, int wr, int wc, int fr, int fq) const {
        const int row0 = u.pm * BM + wr * 64 + fr; int colt = u.pn * BM; bf16_t* base = O;
        float sc = 1.f; if (split_cols) { const int t = colt / split_cols; base += (size_t)t * split_stride; colt -= t * split_cols; if (t == 0) sc = scale0; }
        const int col0 = colt + wc * 32 + 8 * fq, bcol0 = u.pn * BM + wc * 32 + 8 * fq;
        f32x4 bv[2][2];
#pragma unroll
        for (int bj = 0; bj < 2; ++bj)
#pragma unroll
            for (int n = 0; n < 2; ++n) bv[bj][n] = bias ? *(const f32x4*)(bias + bcol0 + bj * HALF + 4 * n) : (f32x4){0.f, 0.f, 0.f, 0.f};
#pragma unroll
        for (int ai = 0; ai < 2; ++ai)
#pragma unroll
            for (int m = 0; m < 4; ++m) { bf16_t* rowp = base + (size_t)(row0 + ai * HALF + m * 16) * ldc + col0;
#pragma unroll
                for (int bj = 0; bj < 2; ++bj) { f32x4 v0 = acc[ai][bj][m][0] + bv[bj][0], v1 = acc[ai][bj][m][1] + bv[bj][1];
                    if (ACT == 1) { f32x2 a = gelu_pk((f32x2){v0[0], v0[1]}), b = gelu_pk((f32x2){v0[2], v0[3]}), c = gelu_pk((f32x2){v1[0], v1[1]}), d = gelu_pk((f32x2){v1[2], v1[3]});
                        v0 = (f32x4){a.x, a.y, b.x, b.y}; v1 = (f32x4){c.x, c.y, d.x, d.y}; }
                    v0 = v0 * sc; v1 = v1 * sc; u32x4 w; w.x = cvt_pk_bf16(v0[0], v0[1]); w.y = cvt_pk_bf16(v0[2], v0[3]); w.z = cvt_pk_bf16(v1[0], v1[1]); w.w = cvt_pk_bf16(v1[2], v1[3]);
                    *(u32x4*)(rowp + bj * HALF) = w; } }
    }
};

struct EpiF32 {
    static constexpr bool PERM = false, AFTER_DRAIN = false;
    float* C; int ldc;
    __device__ __forceinline__ void operator()(const f32x4 (&acc)[2][2][4][2], const Unit& u, int wr, int wc, int fr, int fq) const {
        const int row0 = u.pm * BM + wr * 64 + fr, col0 = u.pn * BM + wc * 32 + 4 * fq;
#pragma unroll
        for (int ai = 0; ai < 2; ++ai)
#pragma unroll
            for (int m = 0; m < 4; ++m) { float* rowp = C + (size_t)(row0 + ai * HALF + m * 16) * ldc + col0;
#pragma unroll
                for (int bj = 0; bj < 2; ++bj)
#pragma unroll
                    for (int n = 0; n < 2; ++n) *(f32x4*)(rowp + bj * HALF + n * 16) = acc[ai][bj][m][n]; }
    }
};
__device__ __forceinline__ float fast_sigmoid(float x) { return __builtin_amdgcn_rcpf(1.0f + __builtin_amdgcn_exp2f(-1.4426950408889634f * x)); }
struct EpiSwiGLU {
    static constexpr bool PERM = true, AFTER_DRAIN = false;
    bf16_t* O; int ldo;
    __device__ __forceinline__ void operator()(const f32x4 (&acc)[2][2][4][2], const Unit& u, int wr, int wc, int fr, int fq) const {
        const int row0 = u.pm * BM + wr * 64 + fr, col0 = (u.pn & 1) * HALF + wc * 32 + 8 * fq;
#pragma unroll
        for (int ai = 0; ai < 2; ++ai)
#pragma unroll
            for (int m = 0; m < 4; ++m) {
                bf16_t* rowp = O + (size_t)(row0 + ai * HALF + m * 16) * ldo + col0;
                const f32x4 g0 = acc[ai][0][m][0], g1 = acc[ai][0][m][1], u0 = acc[ai][1][m][0], u1 = acc[ai][1][m][1];
                float r[8];
#pragma unroll
                for (int i = 0; i < 4; ++i) { r[i] = g0[i] * fast_sigmoid(g0[i]) * u0[i]; r[4 + i] = g1[i] * fast_sigmoid(g1[i]) * u1[i]; }
                u32x4 w; w.x = cvt_pk_bf16(r[0], r[1]); w.y = cvt_pk_bf16(r[2], r[3]); w.z = cvt_pk_bf16(r[4], r[5]); w.w = cvt_pk_bf16(r[6], r[7]);
                *(u32x4*)rowp = w;
            }
    }
};
struct EpiScatter {
    static constexpr bool PERM = true, AFTER_DRAIN = false;
    const int* slotw; bf16_t* Y; int ldy;
    __device__ __forceinline__ void operator()(const f32x4 (&acc)[2][2][4][2], const Unit& u, int wr, int wc, int fr, int fq) const {
        int t2 = threadIdx.x; asm volatile("" : "+v"(t2));
        const int fr2 = t2 & 15, fq2 = (t2 >> 4) & 3, wc2 = (t2 >> 6) & 3, wr2 = (t2 >> 8) & 1;
        const int col0 = (u.pn & 3) * BM + wc2 * 32 + 8 * fq2;
        const int rbase = u.pm * BM + wr2 * 64 + fr2;
        typedef int i32x2 __attribute__((ext_vector_type(2)));
        i32x2 rec[2][4];
#pragma unroll
        for (int ai = 0; ai < 2; ++ai)
#pragma unroll
            for (int m = 0; m < 4; ++m) rec[ai][m] = *(const i32x2*)(slotw + 2 * (size_t)(rbase + ai * HALF + m * 16));
#pragma unroll
        for (int ai = 0; ai < 2; ++ai)
#pragma unroll
            for (int m = 0; m < 4; ++m) {
                const int aid = rec[ai][m].x;
                if (aid >= 0) {
                    const int wbits = rec[ai][m].y;
                    const float w = __int_as_float(wbits);
                    unsigned char* rowp = (unsigned char*)Y + (size_t)aid * ldy + col0;
#pragma unroll
                    for (int bj = 0; bj < 2; ++bj) {
                        const f32x4 v0 = acc[ai][bj][m][0] * w, v1 = acc[ai][bj][m][1] * w;
                        int lo = 0, hi = 0;
                        lo = __builtin_amdgcn_cvt_pk_fp8_f32(v0[0], v0[1], lo, false); lo = __builtin_amdgcn_cvt_pk_fp8_f32(v0[2], v0[3], lo, true);
                        hi = __builtin_amdgcn_cvt_pk_fp8_f32(v1[0], v1[1], hi, false); hi = __builtin_amdgcn_cvt_pk_fp8_f32(v1[2], v1[3], hi, true);
                        typedef int i32x2s __attribute__((ext_vector_type(2)));
                        *(i32x2s*)(rowp + bj * HALF) = (i32x2s){lo, hi};
                    }
                }
            }
    }
};
struct ExpertOrder {
    const int* uexp; int NU, npn, G, c;
    __device__ __forceinline__ bool next(int i, Unit& u) const {
        const int L = i * G + c; if (L >= NU * npn) return false;
        const int uu = L / npn, pl = L % npn;
        u.pm = uu; u.pn = __builtin_amdgcn_readfirstlane(uexp[uu]) * npn + pl; return true;
    }
    __device__ __forceinline__ void a_ready(const Unit&) const {}
    __device__ __forceinline__ void done(const Unit&) const {}
};
struct EpiRouter {
    static constexpr bool PERM = true, AFTER_DRAIN = false;
    float* P0; bf16_t* P1; bf16_t* P2; int TP;
    __device__ __forceinline__ void operator()(const f32x4 (&acc)[2][2][4][2], const Unit& u, int wr, int wc, int fr, int fq) const {
        const bool lo_rows = u.pm >= TP; const int pmr = lo_rows ? u.pm - TP : u.pm;
        if (lo_rows && u.pn == 1) return;
        const int row0 = pmr * BM + wr * 64 + fr, col0 = wc * 32 + 8 * fq;
#pragma unroll
        for (int ai = 0; ai < 2; ++ai)
#pragma unroll
            for (int m = 0; m < 4; ++m) {
                const size_t off = (size_t)(row0 + ai * HALF + m * 16) * 256 + col0;
#pragma unroll
                for (int bj = 0; bj < 2; ++bj) {
                    const f32x4 v0 = acc[ai][bj][m][0], v1 = acc[ai][bj][m][1];
                    if (!lo_rows && u.pn == 0) { *(f32x4*)(P0 + off + bj * HALF) = v0; *(f32x4*)(P0 + off + bj * HALF + 4) = v1; }
                    else { u32x4 w; w.x = cvt_pk_bf16(v0[0], v0[1]); w.y = cvt_pk_bf16(v0[2], v0[3]); w.z = cvt_pk_bf16(v1[0], v1[1]); w.w = cvt_pk_bf16(v1[2], v1[3]);
                           *(u32x4*)((lo_rows ? P2 : P1) + off + bj * HALF) = w; }
                }
            }
    }
};
struct S5Order {
    int NUNITS, npn, G, c;
    __device__ __forceinline__ bool next(int i, Unit& u) const {
        const int L = i * G + c; if (L >= NUNITS) return false;
        u.pm = L / npn; u.pn = (u.pm >> 2) * npn + L % npn; return true;
    }
    __device__ __forceinline__ void a_ready(const Unit&) const {}
    __device__ __forceinline__ void done(const Unit&) const {}
};
struct EpiS5E {
    static constexpr bool PERM = false, AFTER_DRAIN = false;
    float* E;
    __device__ __forceinline__ void operator()(const f32x4 (&acc)[2][2][4][2], const Unit& u, int wr, int wc, int fr, int fq) const {
        const int row0 = u.pm * BM + wr * 64 + fr, col0 = wc * 32 + 4 * fq;
#pragma unroll
        for (int ai = 0; ai < 2; ++ai)
#pragma unroll
            for (int m = 0; m < 4; ++m) { float* rowp = E + (size_t)(row0 + ai * HALF + m * 16) * 128 + col0;
#pragma unroll
                for (int n = 0; n < 2; ++n) *(f32x4*)(rowp + n * 16) = acc[ai][0][m][n]; }
    }
};
struct EpiS5Out {
    static constexpr bool PERM = true, AFTER_DRAIN = false;
    bf16_t* Y;
    __device__ __forceinline__ void operator()(const f32x4 (&acc)[2][2][4][2], const Unit& u, int wr, int wc, int fr, int fq) const {
        const int g = u.pm >> 2;
#pragma unroll
        for (int ai = 0; ai < 2; ++ai)
#pragma unroll
            for (int m = 0; m < 4; ++m) {
                const int r = (u.pm & 3) * BM + ai * HALF + wr * 64 + m * 16 + fr, b = r >> 8, chunk = r & 255;
#pragma unroll
                for (int bj = 0; bj < 2; ++bj) {
                    const int colg = (u.pn & 1) * BM + bj * HALF + wc * 32 + 8 * fq, t = colg >> 4, c0 = colg & 15;
                    const f32x4 v0 = acc[ai][bj][m][0], v1 = acc[ai][bj][m][1];
                    float x[8] = {v0[0], v0[1], v0[2], v0[3], v1[0], v1[1], v1[2], v1[3]};
#pragma unroll
                    for (int i = 0; i < 8; ++i) { const float z = x[i]; x[i] = z * fast_sigmoid(1.5957691216057308f * (z + 0.044715f * z * z * z)); }
                    u32x4 w; w.x = cvt_pk_bf16(x[0], x[1]); w.y = cvt_pk_bf16(x[2], x[3]); w.z = cvt_pk_bf16(x[4], x[5]); w.w = cvt_pk_bf16(x[6], x[7]);
                    *(u32x4*)(Y + ((size_t)(b * 8192 + chunk * 32 + t)) * 512 + g * 16 + c0) = w;
                }
            }
    }
};
struct EpiLora {
    static constexpr bool PERM = true, AFTER_DRAIN = false;
    const float* w0; const float* a0; const float* k_a; float* W; const bf16_t* Kp; bf16_t* Kf; const bf16_t* A; bf16_t* B; bf16_t* Gt;
    __device__ __forceinline__ void operator()(const f32x4 (&acc)[2][2][4][2], const Unit& u, int wr, int wc, int fr, int fq) const {
        const int seg = u.pn >> 1;
#pragma unroll
        for (int bj = 0; bj < 2; ++bj) {
            const int nn = (u.pn & 1) * BM + bj * HALF + wc * 32 + 8 * fq;
            float p0[8], p1[8];
            if (seg == 0) { const f32x4 a = *(const f32x4*)(w0 + nn), b = *(const f32x4*)(w0 + nn + 4); p0[0] = a[0]; p0[1] = a[1]; p0[2] = a[2]; p0[3] = a[3]; p0[4] = b[0]; p0[5] = b[1]; p0[6] = b[2]; p0[7] = b[3]; }
            else if (seg == 1) { const f32x4 a = *(const f32x4*)(a0 + nn), b = *(const f32x4*)(a0 + nn + 4), cc = *(const f32x4*)(k_a + nn), d = *(const f32x4*)(k_a + nn + 4);
                p0[0] = a[0]; p0[1] = a[1]; p0[2] = a[2]; p0[3] = a[3]; p0[4] = b[0]; p0[5] = b[1]; p0[6] = b[2]; p0[7] = b[3];
                p1[0] = cc[0]; p1[1] = cc[1]; p1[2] = cc[2]; p1[3] = cc[3]; p1[4] = d[0]; p1[5] = d[1]; p1[6] = d[2]; p1[7] = d[3]; }
#pragma unroll
            for (int ai = 0; ai < 2; ++ai)
#pragma unroll
                for (int m = 0; m < 4; ++m) {
                    const size_t off = (size_t)(u.pm * BM + ai * HALF + wr * 64 + m * 16 + fr) * 512 + nn;
                    const f32x4 v0 = acc[ai][bj][m][0], v1 = acc[ai][bj][m][1];
                    const float x[8] = {v0[0], v0[1], v0[2], v0[3], v1[0], v1[1], v1[2], v1[3]};
                    if (seg == 0) {
                        float o[8];
#pragma unroll
                        for (int i = 0; i < 8; ++i) { const float wa = p0[i] + x[i];
                            o[i] = __builtin_amdgcn_exp2f(-0.8750387749145276f * fast_sigmoid(wa)); }
                        *(f32x4*)(W + off) = (f32x4){o[0], o[1], o[2], o[3]}; *(f32x4*)(W + off + 4) = (f32x4){o[4], o[5], o[6], o[7]};
                    } else if (seg == 1) {
                        const u32x4 kv = *(const u32x4*)(Kp + off), av = *(const u32x4*)(A + off);
                        const float k[8] = {__builtin_bit_cast(float, kv.x << 16), __builtin_bit_cast(float, kv.x & 0xffff0000u), __builtin_bit_cast(float, kv.y << 16), __builtin_bit_cast(float, kv.y & 0xffff0000u),
                                            __builtin_bit_cast(float, kv.z << 16), __builtin_bit_cast(float, kv.z & 0xffff0000u), __builtin_bit_cast(float, kv.w << 16), __builtin_bit_cast(float, kv.w & 0xffff0000u)};
                        const float a[8] = {__builtin_bit_cast(float, av.x << 16), __builtin_bit_cast(float, av.x & 0xffff0000u), __builtin_bit_cast(float, av.y << 16), __builtin_bit_cast(float, av.y & 0xffff0000u),
                                            __builtin_bit_cast(float, av.z << 16), __builtin_bit_cast(float, av.z & 0xffff0000u), __builtin_bit_cast(float, av.w << 16), __builtin_bit_cast(float, av.w & 0xffff0000u)};
                        float kf[8], bo[8];
#pragma unroll
                        for (int i = 0; i < 8; ++i) { const float ic = fast_sigmoid(p0[i] + x[i]); kf[i] = k[i] * (1.0f + (ic - 1.0f) * p1[i]); bo[i] = -a[i] * ic; }
                        u32x4 w; w.x = cvt_pk_bf16(kf[0], kf[1]); w.y = cvt_pk_bf16(kf[2], kf[3]); w.z = cvt_pk_bf16(kf[4], kf[5]); w.w = cvt_pk_bf16(kf[6], kf[7]);
                        *(u32x4*)(Kf + off) = w;
                        w.x = cvt_pk_bf16(bo[0], bo[1]); w.y = cvt_pk_bf16(bo[2], bo[3]); w.z = cvt_pk_bf16(bo[4], bo[5]); w.w = cvt_pk_bf16(bo[6], bo[7]);
                        *(u32x4*)(B + off) = w;
                    } else {
                        u32x4 w; w.x = cvt_pk_bf16(x[0], x[1]); w.y = cvt_pk_bf16(x[2], x[3]); w.z = cvt_pk_bf16(x[4], x[5]); w.w = cvt_pk_bf16(x[6], x[7]);
                        *(u32x4*)(Gt + off) = w;
                    }
                }
        }
    }
};
struct EpiGLU {
    static constexpr bool PERM = true, AFTER_DRAIN = false;
    const bf16_t* Y; int ldy; const float* bias; bf16_t* O; int ldo; int ocol0;
    __device__ __forceinline__ void operator()(const f32x4 (&acc)[2][2][4][2], const Unit& u, int wr, int wc, int fr, int fq) const {
        const int row0 = u.pm * BM + wr * 64 + fr, col0 = u.pn * BM + wc * 32 + 8 * fq;
#pragma unroll
        for (int bj = 0; bj < 2; ++bj) {
            const f32x4 b0 = *(const f32x4*)(bias + col0 + bj * HALF), b1 = *(const f32x4*)(bias + col0 + bj * HALF + 4);
#pragma unroll
            for (int ai = 0; ai < 2; ++ai)
#pragma unroll
                for (int m = 0; m < 4; ++m) {
                    const size_t row = (size_t)(row0 + ai * HALF + m * 16);
                    const u32x4 yv = *(const u32x4*)(Y + row * ldy + col0 + bj * HALF);
                    const f32x4 z0 = acc[ai][bj][m][0] + b0, z1 = acc[ai][bj][m][1] + b1;
                    float y[8] = {__builtin_bit_cast(float, yv.x << 16), __builtin_bit_cast(float, yv.x & 0xffff0000u), __builtin_bit_cast(float, yv.y << 16), __builtin_bit_cast(float, yv.y & 0xffff0000u),
                                  __builtin_bit_cast(float, yv.z << 16), __builtin_bit_cast(float, yv.z & 0xffff0000u), __builtin_bit_cast(float, yv.w << 16), __builtin_bit_cast(float, yv.w & 0xffff0000u)};
                    float r[8];
#pragma unroll
                    for (int i = 0; i < 4; ++i) { r[i] = y[i] * fast_sigmoid(z0[i]); r[4 + i] = y[4 + i] * fast_sigmoid(z1[i]); }
                    u32x4 w; w.x = cvt_pk_bf16(r[0], r[1]); w.y = cvt_pk_bf16(r[2], r[3]); w.z = cvt_pk_bf16(r[4], r[5]); w.w = cvt_pk_bf16(r[6], r[7]);
                    *(u32x4*)(O + row * ldo + ocol0 + col0 + bj * HALF) = w;
                }
        }
    }
};
template <class Epi, class Sched, bool ALIGN_EPI = false, bool SP2 = false, bool GATHER = false>
__device__ __forceinline__ void gemm_phase(PG8_LAS unsigned char* lds, const Gemm g, const Sched& S, const Epi& E) {
    int tid_ = threadIdx.x; asm volatile("" : "+v"(tid_));
    const int tid = tid_, wid = __builtin_amdgcn_readfirstlane(tid >> 6), lane = tid & 63, wr = wid >> 2, wc = wid & 3, fr = lane & 15, fq = lane >> 4;
    const int K = g.K, nt = K / BK;
    unsigned voffA[2], voffB[2];
#pragma unroll
    for (int i = 0; i < 2; ++i) { int R, C; stage_rc(tid * 16 + i * 8192, R, C); const int Rb = Epi::PERM ? ((R & ~31) + perm32(R & 31)) : R;
        voffA[i] = (unsigned)(R * K + C) * 2u; voffB[i] = (unsigned)(Rb * K + C) * 2u; }
    const size_t kstep = (size_t)(BK * 2);
    const size_t hstep = (size_t)HALF * K * 2;
    const size_t tstep = 2 * hstep;
    const unsigned ldsw = (unsigned)wid * 1024u;
    const int aoff = lds_byte(wr * 64 + fr, fq * 8), boff = lds_byte(wc * 32 + fr, fq * 8);
#define PG8_SA(b, h) (((b) * 2 + (h)) * HTB)
#define PG8_SB(b, h) ((4 + (b) * 2 + (h)) * HTB)
#define PG8_STAGE(bufoff, gbase, voff) do { _Pragma("unroll") for (int _i = 0; _i < 2; ++_i) \
        __builtin_amdgcn_global_load_lds((const unsigned*)((const char*)(gbase) + (voff)[_i]), (PG8_LAS unsigned*)(lds + (bufoff) + ldsw + _i * 8192), 16, 0, 0); } while (0)
#define PG8_STAGE_A(bufoff, kptr, h, NEXTSEL) do { if constexpr (GATHER) { const unsigned _p = (NEXTSEL) ? gnxt[h] : gcur[h]; const unsigned _v[2] = { (_p & 0xffffu) * (unsigned)(2 * K) + gC2, (_p >> 16) * (unsigned)(2 * K) + gC2 }; PG8_STAGE(bufoff, kptr, _v); } \
        else { PG8_STAGE(bufoff, (kptr) + (h) * hstep, voffA); } } while (0)
#define PG8_LDA(dst, b, h) do { _Pragma("unroll") for (int m = 0; m < 4; ++m) _Pragma("unroll") for (int k = 0; k < 2; ++k) dst[m][k] = *(const PG8_LAS bf16x8*)(lds + PG8_SA(b, h) + aoff + m * 2048 + k * 1024); } while (0)
#define PG8_LDB(dst, b, h) do { _Pragma("unroll") for (int n = 0; n < 2; ++n) _Pragma("unroll") for (int k = 0; k < 2; ++k) dst[n][k] = *(const PG8_LAS bf16x8*)(lds + PG8_SB(b, h) + boff + n * 2048 + k * 1024); } while (0)
#define PG8_MMA(ai, bj, At, Bt) do { __builtin_amdgcn_s_setprio(1); _Pragma("unroll") for (int m = 0; m < 4; ++m) _Pragma("unroll") for (int n = 0; n < 2; ++n) _Pragma("unroll") for (int k = 0; k < 2; ++k) \
        acc[ai][bj][m][n] = __builtin_amdgcn_mfma_f32_16x16x32_bf16(Bt[n][k], At[m][k], acc[ai][bj][m][n], 0, 0, 0); __builtin_amdgcn_s_setprio(0); } while (0)
#define PG8_WAIT_V(n) asm volatile("s_waitcnt vmcnt(" #n ")" ::: "memory")
#define PG8_WAIT_L(n) asm volatile("s_waitcnt lgkmcnt(" #n ")" ::: "memory")
#define PG8_BAR __builtin_amdgcn_s_barrier()
#define PG8_SCHED __builtin_amdgcn_sched_barrier(0)
    unsigned gcur[2], gnxt[2], gC2 = 0;
    if constexpr (GATHER) { int R, C; stage_rc(tid * 16, R, C); gC2 = (unsigned)C * 2u; }
    auto load_gather = [&](int pm, unsigned (&dst)[2]) {
        int R, C; stage_rc(tid * 16, R, C);
#pragma unroll
        for (int h = 0; h < 2; ++h) { int a0 = g.rowtab[pm * BM + h * HALF + R], a1 = g.rowtab[pm * BM + h * HALF + R + 64]; a0 = a0 < 0 ? 0 : a0; a1 = a1 < 0 ? 0 : a1; dst[h] = (unsigned)(a0 >> 3) | ((unsigned)(a1 >> 3) << 16); }
    };
    Unit cur, nxt; int ui = 0;
    if (!S.next(0, cur)) return;
    f32x4 acc[2][2][4][2];
#pragma unroll
    for (int a = 0; a < 2; ++a)
#pragma unroll
        for (int b = 0; b < 2; ++b)
#pragma unroll
            for (int m = 0; m < 4; ++m)
#pragma unroll
                for (int n = 0; n < 2; ++n) acc[a][b][m][n] = (f32x4){0.f, 0.f, 0.f, 0.f};
    bf16x8 At[4][2], B0[2][2], B1[2][2];
    const char* cA = (const char*)g.A + (GATHER ? (size_t)0 : (size_t)cur.pm * tstep); const char* cB = (const char*)g.Bt + (size_t)cur.pn * tstep;
    if constexpr (GATHER) { load_gather(cur.pm, gcur); }
    S.a_ready(cur);
    if constexpr (SP2) {
        PG8_STAGE(PG8_SB(0, 0), cB, voffB); PG8_STAGE(PG8_SB(0, 1), cB + hstep, voffB); PG8_STAGE_A(PG8_SA(0, 0), cA, 0, false); PG8_STAGE_A(PG8_SA(0, 1), cA, 1, false);
        if (wr == 1) PG8_BAR;
        PG8_WAIT_V(2); PG8_BAR;
        PG8_STAGE(PG8_SB(1, 0), cB + kstep, voffB); PG8_STAGE_A(PG8_SA(1, 0), cA + kstep, 0, false); PG8_STAGE(PG8_SB(1, 1), cB + hstep + kstep, voffB);
        PG8_WAIT_V(6); PG8_BAR;
    } else {
        PG8_STAGE(PG8_SB(0, 0), cB, voffB); PG8_STAGE_A(PG8_SA(0, 0), cA, 0, false); PG8_STAGE(PG8_SB(0, 1), cB + hstep, voffB); PG8_STAGE_A(PG8_SA(0, 1), cA, 1, false);
        if (wr == 1) PG8_BAR;
        PG8_WAIT_V(4); PG8_BAR;
        PG8_STAGE(PG8_SB(1, 0), cB + kstep, voffB); PG8_STAGE_A(PG8_SA(1, 0), cA + kstep, 0, false); PG8_STAGE(PG8_SB(1, 1), cB + hstep + kstep, voffB);
        PG8_WAIT_V(6); PG8_BAR;
    }
    for (;;) {
        const bool has_next = S.next(ui + 1, nxt);
        const char* nA = (has_next && !GATHER) ? (const char*)g.A + (size_t)nxt.pm * tstep : cA; const char* nB = has_next ? (const char*)g.Bt + (size_t)nxt.pn * tstep : cB;
        if constexpr (GATHER) { if (has_next) load_gather(nxt.pm, gnxt); else {
#pragma unroll
            for (int h = 0; h < 2; ++h) { gnxt[h] = gcur[h]; } } }
        for (int t = 0; t < nt; t += 2) {
            const bool last = (t == nt - 2);
            const char* a1 = cA + (size_t)(t + 1) * kstep;
            const char* a2 = last ? nA : cA + (size_t)(t + 2) * kstep; const char* b2 = last ? nB : cB + (size_t)(t + 2) * kstep;
            const char* a3 = a2 + kstep; const char* b3 = b2 + kstep;
            if (last && has_next) S.a_ready(nxt);
            if constexpr (SP2) {
            PG8_LDB(B0, 0, 0); PG8_LDB(B1, 0, 1); PG8_SCHED; PG8_LDA(At, 0, 0); PG8_STAGE_A(PG8_SA(1, 1), a1, 1, false);
            PG8_WAIT_V(8); PG8_WAIT_L(0); PG8_BAR; PG8_MMA(0, 0, At, B0); PG8_MMA(0, 1, At, B1); PG8_BAR; PG8_SCHED;
            PG8_LDA(At, 0, 1); PG8_STAGE(PG8_SB(0, 0), b2, voffB); PG8_STAGE(PG8_SB(0, 1), b2 + hstep, voffB); PG8_STAGE_A(PG8_SA(0, 0), a2, 0, last);
            PG8_WAIT_V(8); PG8_WAIT_L(0); PG8_BAR; PG8_MMA(1, 0, At, B0); PG8_MMA(1, 1, At, B1); PG8_BAR; PG8_SCHED;
            PG8_LDB(B0, 1, 0); PG8_LDB(B1, 1, 1); PG8_SCHED; PG8_LDA(At, 1, 0); PG8_STAGE_A(PG8_SA(0, 1), a2, 1, last);
            PG8_WAIT_V(8); PG8_WAIT_L(0); PG8_BAR; PG8_MMA(0, 0, At, B0); PG8_MMA(0, 1, At, B1); PG8_BAR; PG8_SCHED;
            PG8_LDA(At, 1, 1); PG8_STAGE(PG8_SB(1, 0), b3, voffB); PG8_STAGE(PG8_SB(1, 1), b3 + hstep, voffB); PG8_STAGE_A(PG8_SA(1, 0), a3, 0, last);
            PG8_WAIT_V(8); PG8_WAIT_L(0); PG8_BAR; PG8_MMA(1, 0, At, B0); PG8_MMA(1, 1, At, B1); PG8_BAR; PG8_SCHED;
            } else {
            PG8_LDB(B0, 0, 0); PG8_SCHED; PG8_LDA(At, 0, 0); PG8_STAGE_A(PG8_SA(1, 1), a1, 1, false);
            PG8_WAIT_L(8); PG8_BAR; PG8_WAIT_L(0); PG8_MMA(0, 0, At, B0); PG8_BAR; PG8_SCHED;
            PG8_LDB(B1, 0, 1); PG8_STAGE(PG8_SB(0, 0), b2, voffB);
            PG8_BAR; PG8_WAIT_L(0); PG8_MMA(0, 1, At, B1); PG8_BAR;
            PG8_LDA(At, 0, 1); PG8_STAGE_A(PG8_SA(0, 0), a2, 0, last);
            PG8_BAR; PG8_WAIT_L(0); PG8_MMA(1, 0, At, B0); PG8_BAR; PG8_SCHED;
            PG8_STAGE(PG8_SB(0, 1), b2 + hstep, voffB);
            PG8_WAIT_V(6); PG8_BAR; PG8_MMA(1, 1, At, B1); PG8_BAR;
            PG8_LDB(B0, 1, 0); PG8_SCHED; PG8_LDA(At, 1, 0); PG8_STAGE_A(PG8_SA(0, 1), a2, 1, last);
            PG8_WAIT_L(8); PG8_BAR; PG8_WAIT_L(0); PG8_MMA(0, 0, At, B0); PG8_BAR; PG8_SCHED;
            PG8_LDB(B1, 1, 1); PG8_STAGE(PG8_SB(1, 0), b3, voffB);
            PG8_BAR; PG8_WAIT_L(0); PG8_MMA(0, 1, At, B1); PG8_BAR;
            PG8_LDA(At, 1, 1); PG8_STAGE_A(PG8_SA(1, 0), a3, 0, last);
            PG8_BAR; PG8_WAIT_L(0); PG8_MMA(1, 0, At, B0); PG8_BAR; PG8_SCHED;
            PG8_STAGE(PG8_SB(1, 1), b3 + hstep, voffB);
            PG8_WAIT_V(6); PG8_BAR; PG8_MMA(1, 1, At, B1); PG8_BAR;
            }
        }
        if constexpr (ALIGN_EPI) { if (wr == 0) PG8_BAR; }
        if constexpr (!Epi::AFTER_DRAIN) { E(acc, cur, wr, wc, fr, fq); S.done(cur); }
        if (!has_next) break;
#pragma unroll
        for (int a = 0; a < 2; ++a)
#pragma unroll
            for (int b = 0; b < 2; ++b)
#pragma unroll
                for (int m = 0; m < 4; ++m)
#pragma unroll
                    for (int n = 0; n < 2; ++n) acc[a][b][m][n] = (f32x4){0.f, 0.f, 0.f, 0.f};
        cur = nxt; cA = nA; cB = nB; ++ui;
        if constexpr (GATHER) {
#pragma unroll
            for (int h = 0; h < 2; ++h) { gcur[h] = gnxt[h]; } }
        if constexpr (ALIGN_EPI) { if (wr == 1) PG8_BAR; }
    }
    PG8_WAIT_V(0);
    if constexpr (!ALIGN_EPI) { if (wr == 0) PG8_BAR; }
    PG8_BAR;
    if constexpr (Epi::AFTER_DRAIN) { E.fused(acc, cur, wr, wc, fr, fq, lds, wid, lane); S.done(cur); }
#undef PG8_SA
#undef PG8_SB
#undef PG8_STAGE
#undef PG8_STAGE_A
#undef PG8_LDA
#undef PG8_LDB
#undef PG8_MMA
#undef PG8_WAIT_V
#undef PG8_WAIT_L
#undef PG8_BAR
#undef PG8_SCHED
}
}

typedef unsigned short bf16_t;
__device__ __forceinline__ unsigned f2bf(float f) { unsigned u = __builtin_bit_cast(unsigned, f); return (u + 0x7fffu + ((u >> 16) & 1u)) >> 16; }
__device__ __forceinline__ float bf2f(unsigned h) { return __builtin_bit_cast(float, h << 16); }
__device__ __forceinline__ float wave_sum(float v) {
#pragma unroll
    for (int o = 1; o < 64; o <<= 1) v += __shfl_xor(v, o);
    return v;
}
__device__ __forceinline__ float sigmoidf_(float x) { return 1.0f / (1.0f + expf(-x)); }
__device__ __forceinline__ float siluf_(float x) { return x / (1.0f + expf(-x)); }
__device__ __forceinline__ float softplusf_(float x) { return fmaxf(x, 0.0f) + log1pf(expf(-fabsf(x))); }
__device__ __forceinline__ float geluf_(float x) { const float u = 0.7978845608028654f * (x + 0.044715f * x * x * x); return 0.5f * x * (1.0f + tanhf(u)); }

struct Args { const float* in[39]; float* out; unsigned char* ws; int lo, hi; };

struct Ctx {
    const float* const* in; float* out; unsigned char* ws;
    LAS unsigned char* lds; float* sm;
    int tid, lane, wid, bid, G, dry;
};

__device__ __forceinline__ unsigned pk2(float lo, float hi) { return f2bf(lo) | (f2bf(hi) << 16); }
__device__ __forceinline__ float ldbf(const bf16_t* p) { return bf2f((unsigned)*p); }
typedef unsigned v4u_t __attribute__((ext_vector_type(4)));
typedef unsigned v2u_t __attribute__((ext_vector_type(2)));
__device__ __forceinline__ void st16(void* p, uint4 v) { const v4u_t d = {v.x, v.y, v.z, v.w}; asm volatile("global_store_dwordx4 %0, %1, off\n\ts_nop 1" :: "v"(p), "v"(d) : "memory"); }
__device__ __forceinline__ void st16f(void* p, float4 v) { st16(p, make_uint4(__float_as_uint(v.x), __float_as_uint(v.y), __float_as_uint(v.z), __float_as_uint(v.w))); }
__device__ __forceinline__ void st8(void* p, uint2 v) { const v2u_t d = {v.x, v.y}; asm volatile("global_store_dwordx2 %0, %1, off\n\ts_nop 1" :: "v"(p), "v"(d) : "memory"); }
__device__ __forceinline__ void st4(void* p, unsigned v) { asm volatile("global_store_dword %0, %1, off\n\ts_nop 1" :: "v"(p), "v"(v) : "memory"); }
__device__ __forceinline__ void st2(void* p, unsigned v) { asm volatile("global_store_short %0, %1, off\n\ts_nop 1" :: "v"(p), "v"(v) : "memory"); }
__device__ __forceinline__ float4 ldbf4(const bf16_t* p) { const uint2 v = *(const uint2*)p; return make_float4(bf2f(v.x & 0xffffu), bf2f(v.x >> 16), bf2f(v.y & 0xffffu), bf2f(v.y >> 16)); }

template <int NB, class AF, class BF, class BF2, class EF>
__device__ __forceinline__ void gemm_tile(float* sm, int K, AF af, BF bf, BF2 bf2, EF ef) {
    float* As = sm;
    float* Bs = sm + 16 * 132;
    float* Bs2 = Bs + 16 * 68;
    const int tid = threadIdx.x, ty = tid >> 4, tx = tid & 15;
    const int am = tid >> 2, ak = (tid & 3) * 4;
    const int bt = tid & 255, bk = bt >> 4, bn = (bt & 15) * 4;
    float acc[4][4], acc2[4][4];
#pragma unroll
    for (int i = 0; i < 4; ++i)
#pragma unroll
        for (int j = 0; j < 4; ++j) { acc[i][j] = 0.f; acc2[i][j] = 0.f; }
    float4 av = af(am, ak);
    float4 bv = make_float4(0.f, 0.f, 0.f, 0.f);
    if (tid < 256) bv = bf(bk, bn); else if (NB == 2) bv = bf2(bk, bn);
    for (int k0 = 0; k0 < K; k0 += 16) {
        __syncthreads();
        As[(ak + 0) * 132 + am] = av.x; As[(ak + 1) * 132 + am] = av.y; As[(ak + 2) * 132 + am] = av.z; As[(ak + 3) * 132 + am] = av.w;
        if (tid < 256) *(float4*)&Bs[bk * 68 + bn] = bv; else if (NB == 2) *(float4*)&Bs2[bk * 68 + bn] = bv;
        __syncthreads();
        if (k0 + 16 < K) {
            av = af(am, k0 + 16 + ak);
            if (tid < 256) bv = bf(k0 + 16 + bk, bn); else if (NB == 2) bv = bf2(k0 + 16 + bk, bn);
        }
#pragma unroll
        for (int kk = 0; kk < 16; ++kk) {
            const float4 a = *(const float4*)&As[kk * 132 + ty * 4];
            const float4 b = *(const float4*)&Bs[kk * 68 + tx * 4];
            const float aa[4] = {a.x, a.y, a.z, a.w};
            const float bb[4] = {b.x, b.y, b.z, b.w};
#pragma unroll
            for (int i = 0; i < 4; ++i)
#pragma unroll
                for (int j = 0; j < 4; ++j) acc[i][j] = fmaf(aa[i], bb[j], acc[i][j]);
            if (NB == 2) {
                const float4 b2 = *(const float4*)&Bs2[kk * 68 + tx * 4];
                const float bb2[4] = {b2.x, b2.y, b2.z, b2.w};
#pragma unroll
                for (int i = 0; i < 4; ++i)
#pragma unroll
                    for (int j = 0; j < 4; ++j) acc2[i][j] = fmaf(aa[i], bb2[j], acc2[i][j]);
            }
        }
    }
#pragma unroll
    for (int i = 0; i < 4; ++i)
        ef(ty * 4 + i, tx * 4, make_float4(acc[i][0], acc[i][1], acc[i][2], acc[i][3]), make_float4(acc2[i][0], acc2[i][1], acc2[i][2], acc2[i][3]));
}

__device__ __forceinline__ void transpose_load(const float* W, int N, int nblk, int item, int lane, float (&r)[32]) {
    const int kb = item / nblk, nb = item % nblk, k0 = 64 * kb, n0 = 32 * nb;
#pragma unroll
    for (int i = 0; i < 8; ++i) { const int kk = 8 * i + (lane >> 3); const float4 v = *(const float4*)(W + (size_t)(k0 + kk) * N + n0 + (lane & 7) * 4);
        r[4 * i] = v.x; r[4 * i + 1] = v.y; r[4 * i + 2] = v.z; r[4 * i + 3] = v.w; }
}
template <bool RES, class RM>
__device__ __forceinline__ void transpose_finish(int K, int nblk, bf16_t* WT, RM rowmap, float* scr, int item, int lane, const float (&r)[32]) {
    const int kb = item / nblk, nb = item % nblk, k0 = 64 * kb, n0 = 32 * nb;
#pragma unroll
    for (int i = 0; i < 8; ++i) { const int kk = 8 * i + (lane >> 3), nn = (lane & 7) * 4;
        scr[kk * 33 + nn] = r[4 * i]; scr[kk * 33 + nn + 1] = r[4 * i + 1]; scr[kk * 33 + nn + 2] = r[4 * i + 2]; scr[kk * 33 + nn + 3] = r[4 * i + 3]; }
    asm volatile("s_waitcnt lgkmcnt(0)" ::: "memory");
    const int c = lane & 7;
    const int r0 = rowmap(n0);
#pragma unroll
    for (int j = 0; j < 4; ++j) {
        const int n = (lane >> 3) + 8 * j; const float* s = scr + (8 * c) * 33 + n;
        float v[8];
#pragma unroll
        for (int q = 0; q < 8; ++q) { v[q] = s[q * 33]; if (RES) v[q] = v[q] - bf2f(f2bf(v[q])); }
        uint4 o; o.x = pk2(v[0], v[1]); o.y = pk2(v[2], v[3]); o.z = pk2(v[4], v[5]); o.w = pk2(v[6], v[7]);
        st16(WT + (size_t)(r0 + n) * K + k0 + 8 * c, o);
    }
    asm volatile("s_waitcnt lgkmcnt(0)" ::: "memory");
}
template <bool RES, class RM>
__device__ __forceinline__ void transpose_item(const float* W, int K, int N, bf16_t* WT, RM rowmap, float* scr, int item, int lane) {
    float r[32];
    transpose_load(W, N, N / 32, item, lane, r);
    transpose_finish<RES>(K, N / 32, WT, rowmap, scr, item, lane, r);
}

__device__ __forceinline__ void convert_expert_weights(const Ctx& c, const int lo, const int hi, int first, int stride) {
    float* scr = c.sm + c.wid * (64 * 33);
    float ra[32], rb[32];
    auto src = [&](int it, const float*& W, int& N, int& nblk, int& item) {
        const int e = it / 384, r = it % 384;
        if (r < 128) { W = c.in[33] + (size_t)e * D * EFF; N = EFF; nblk = EFF / 32; item = r; }
        else if (r < 256) { W = c.in[34] + (size_t)e * D * EFF; N = EFF; nblk = EFF / 32; item = r - 128; }
        else { W = c.in[35] + (size_t)e * EFF * D; N = D; nblk = D / 32; item = r - 256; }
    };
    auto fin = [&](int it, const float (&rg)[32]) {
        const int e = it / 384, r = it % 384;
        if (r < 128) transpose_finish<false>(D, EFF / 32, (bf16_t*)(c.ws + WS_WEGU) + (size_t)e * 512 * D, [](int n) { return (n >> 7) * 256 + (n & 127); }, scr, r, c.lane, rg);
        else if (r < 256) transpose_finish<false>(D, EFF / 32, (bf16_t*)(c.ws + WS_WEGU) + (size_t)e * 512 * D, [](int n) { return (n >> 7) * 256 + 128 + (n & 127); }, scr, r - 128, c.lane, rg);
        else transpose_finish<false>(EFF, D / 32, (bf16_t*)(c.ws + WS_WED) + (size_t)e * D * EFF, [](int n) { return n; }, scr, r - 256, c.lane, rg);
    };
    float rc[32];
    auto ld = [&](int it_, float (&rg)[32]) { if (it_ < hi) { const float* W; int N, nblk, item; src(it_, W, N, nblk, item); transpose_load(W, N, nblk, item, c.lane, rg); } };
    int it = lo + first;
    if (it >= hi) return;
    ld(it, ra); ld(it + stride, rb);
    for (;;) {
        ld(it + 2 * stride, rc); fin(it, ra); if (it + stride >= hi) break;
        ld(it + 3 * stride, ra); fin(it + stride, rb); if (it + 2 * stride >= hi) break;
        ld(it + 4 * stride, rb); fin(it + 2 * stride, rc); if (it + 3 * stride >= hi) break;
        it += 3 * stride;
    }
}

__device__ __forceinline__ void phase0(const Ctx& c) {
    const int gt = c.bid * 512 + c.tid, NT = c.G * 512;
    const int gw = c.bid * 8 + c.wid, NW = c.G * 8;
    {
        const float* cc = c.in[1]; const float* w_ada = c.in[2];
        float* modsp = (float*)(c.ws + WS_MODSP);
        for (int task = gw; task < 96 * 16; task += NW) {
            const int cg = task % 96, ks = task / 96, j = cg * 64 + c.lane;
            float a0 = 0.f, a1 = 0.f, a2 = 0.f, a3 = 0.f;
#pragma unroll 4
            for (int k = ks * 64; k < ks * 64 + 64; ++k) {
                const float wv = w_ada[(size_t)k * NMODS + j];
                a0 = fmaf(siluf_(cc[k]), wv, a0); a1 = fmaf(siluf_(cc[D + k]), wv, a1); a2 = fmaf(siluf_(cc[2 * D + k]), wv, a2); a3 = fmaf(siluf_(cc[3 * D + k]), wv, a3);
            }
            modsp[(ks * 4 + 0) * NMODS + j] = a0; modsp[(ks * 4 + 1) * NMODS + j] = a1; modsp[(ks * 4 + 2) * NMODS + j] = a2; modsp[(ks * 4 + 3) * NMODS + j] = a3;
        }
    }
    {
        const float* log_dt = c.in[20]; const float* a_re = c.in[21]; const float* a_im = c.in[22];
        const float* b_re = c.in[23]; const float* b_im = c.in[24];
        float* apow = (float*)(c.ws + WS_APOW); float* bb = (float*)(c.ws + WS_S5BB);
        for (int idx = gt; idx < S5NG * S5P; idx += NT) {
            const int g = idx / S5P, p = idx % S5P;
            const double dt = exp((double)log_dt[g]);
            const double lre = fmin((double)a_re[idx], -1e-4), lim = (double)a_im[idx];
            const double mag = exp(lre * dt), ang = lim * dt;
            const double abr = mag * cos(ang), abi = mag * sin(ang);
            const double den = lre * lre + lim * lim;
            const double nre = abr - 1.0, nim = abi;
            const double qre = (nre * lre + nim * lim) / den, qim = (nim * lre - nre * lim) / den;
            double pr = 1.0, pi = 0.0;
            for (int j = 0; j <= S5L; ++j) {
                apow[((size_t)(g * (S5L + 1) + j) * 64 + p) * 2 + 0] = (float)pr; apow[((size_t)(g * (S5L + 1) + j) * 64 + p) * 2 + 1] = (float)pi;
                const double nr = pr * abr - pi * abi, ni = pr * abi + pi * abr; pr = nr; pi = ni;
            }
            for (int ch = 0; ch < 16; ++ch) {
                const double br = (double)b_re[idx * 16 + ch], bi = (double)b_im[idx * 16 + ch];
                bb[idx * 32 + ch] = (float)(qre * br - qim * bi);
                bb[idx * 32 + 16 + ch] = (float)(qre * bi + qim * br);
            }
        }
    }
    {
        const float* w2 = c.in[11]; const float* a2 = c.in[13]; const float* g2 = c.in[14];
        bf16_t* bt = (bf16_t*)(c.ws + WS_LORA_BT);
        for (int it = gt; it < 1536 * 32; it += NT) {
            const int n = it >> 5, c0 = (it & 31) * 8;
            float v[8];
#pragma unroll
            for (int i = 0; i < 8; ++i) {
                const int col = c0 + i; float x = 0.f;
                if (n < 512) { if (col < 64) x = w2[col * RW + n]; }
                else if (n < 1024) { if (col >= 64 && col < 128) x = a2[(col - 64) * RW + (n - 512)]; }
                else { if (col >= 128) x = g2[(col - 128) * RW + (n - 1024)]; }
                v[i] = x;
            }
            *(uint4*)(bt + (size_t)n * 256 + c0) = make_uint4(pk2(v[0], v[1]), pk2(v[2], v[3]), pk2(v[4], v[5]), pk2(v[6], v[7]));
        }
    }
    float* scr = c.sm + c.wid * (64 * 33);
    constexpr int I_IN = (D / 64) * (NPROJ / 32), I_OUT = (D / 64) * (D / 32), I_GLU = (512 / 64) * (512 / 32), I_SG = (D / 64) * (256 / 32), I_SD = (256 / 64) * (D / 32), I_R = (D / 64) * (256 / 32);
    constexpr int NIT = I_IN + I_OUT + I_GLU + 2 * I_SG + I_SD + 2 * I_R;
    for (int it = gw; it < NIT; it += NW) {
        int r = it;
        if (r < I_IN) { transpose_item<false>(c.in[8], D, NPROJ, (bf16_t*)(c.ws + WS_WIN_T), [](int n) { return n; }, scr, r, c.lane); continue; } r -= I_IN;
        if (r < I_OUT) { transpose_item<false>(c.in[30], D, D, (bf16_t*)(c.ws + WS_WOUT_T), [](int n) { return n; }, scr, r, c.lane); continue; } r -= I_OUT;
        if (r < I_GLU) { transpose_item<false>(c.in[28], 512, 512, (bf16_t*)(c.ws + WS_WGLU_T), [](int n) { return n; }, scr, r, c.lane); continue; } r -= I_GLU;
        if (r < I_SG) { transpose_item<false>(c.in[36], D, 256, (bf16_t*)(c.ws + WS_WSGU_T), [](int n) { return (n >> 7) * 256 + (n & 127); }, scr, r, c.lane); continue; } r -= I_SG;
        if (r < I_SG) { transpose_item<false>(c.in[37], D, 256, (bf16_t*)(c.ws + WS_WSGU_T), [](int n) { return (n >> 7) * 256 + 128 + (n & 127); }, scr, r, c.lane); continue; } r -= I_SG;
        if (r < I_SD) { transpose_item<false>(c.in[38], 256, D, (bf16_t*)(c.ws + WS_WSD_T), [](int n) { return n; }, scr, r, c.lane); continue; } r -= I_SD;
        if (r < I_R) { transpose_item<false>(c.in[31], D, 256, (bf16_t*)(c.ws + WS_WR_T), [](int n) { return n; }, scr, r, c.lane); continue; } r -= I_R;
        transpose_item<true>(c.in[31], D, 256, (bf16_t*)(c.ws + WS_WR_T), [](int n) { return 256 + n; }, scr, r, c.lane);
    }
}

__device__ __forceinline__ void phase1(const Ctx& c) {
    const int gt = c.bid * 512 + c.tid, NT = c.G * 512;
    const int gw = c.bid * 8 + c.wid, NW = c.G * 8;
    const float* modsp = (const float*)(c.ws + WS_MODSP); const float* b_ada = c.in[3]; float* mods = (float*)(c.ws + WS_MODS);
    for (int idx = gt; idx < BATCH * NMODS; idx += NT) {
        const int b = idx / NMODS, j = idx % NMODS;
        float acc = 0.f;
#pragma unroll
        for (int ks = 0; ks < 16; ++ks) acc += modsp[(ks * 4 + b) * NMODS + j];
        mods[idx] = acc + b_ada[j];
    }
    const float* __restrict__ apow = (const float*)(c.ws + WS_APOW); const float* __restrict__ bb = (const float*)(c.ws + WS_S5BB);
    const float* __restrict__ c_re = c.in[25]; const float* __restrict__ c_im = c.in[26];
    float* __restrict__ klag = (float*)(c.ws + WS_KLAG);
    for (int task = gw; task < S5NG * S5L; task += NW) {
        const int g = task / S5L, j = task % S5L, cc = c.lane >> 2, cq = (c.lane & 3) * 4;
        float acc[4] = {0.f, 0.f, 0.f, 0.f};
#pragma unroll 16
        for (int p = 0; p < 64; ++p) {
            const float ar = apow[((size_t)(g * (S5L + 1) + j) * 64 + p) * 2], ai = apow[((size_t)(g * (S5L + 1) + j) * 64 + p) * 2 + 1];
            const float cr = c_re[(g * 16 + cc) * 64 + p], ci = c_im[(g * 16 + cc) * 64 + p];
            const float4 br = *(const float4*)(bb + (size_t)(g * 64 + p) * 32 + cq), bi = *(const float4*)(bb + (size_t)(g * 64 + p) * 32 + 16 + cq);
            const float er = cr * ar - ci * ai, ei = cr * ai + ci * ar;
            acc[0] += er * br.x - ei * bi.x; acc[1] += er * br.y - ei * bi.y; acc[2] += er * br.z - ei * bi.z; acc[3] += er * br.w - ei * bi.w;
        }
        *(float4*)(klag + ((size_t)(g * S5L + j) * 16 + cc) * 16 + cq) = make_float4(acc[0], acc[1], acc[2], acc[3]);
    }
}

__device__ __forceinline__ void phase2(const Ctx& c) {
    const float* x = c.in[0]; const float* g = c.in[4];
    const float* mods = (const float*)(c.ws + WS_MODS);
    bf16_t* xn = (bf16_t*)(c.ws + WS_A);
    const int gw = c.bid * 8 + c.wid, NW = c.G * 8;
    for (int t = gw; t < T; t += NW) {
        const int b = t / SEQ;
        const float4* xr = (const float4*)(x + (size_t)t * D) + c.lane;
        float4 v[4]; float ss = 0.f;
#pragma unroll
        for (int j = 0; j < 4; ++j) { v[j] = xr[64 * j]; ss += v[j].x * v[j].x + v[j].y * v[j].y + v[j].z * v[j].z + v[j].w * v[j].w; }
        const float rstd = rsqrtf(wave_sum(ss) * (1.0f / D) + 1e-6f);
        uint2* o = (uint2*)(xn + (size_t)t * D) + c.lane;
#pragma unroll
        for (int j = 0; j < 4; ++j) {
            const int k = (c.lane + 64 * j) * 4;
            const float4 gg = *(const float4*)(g + k);
            const float4 sh = *(const float4*)(mods + b * NMODS + k);
            const float4 sc = *(const float4*)(mods + b * NMODS + D + k);
            float4 r;
            r.x = v[j].x * rstd * gg.x * (1.f + sc.x) + sh.x; r.y = v[j].y * rstd * gg.y * (1.f + sc.y) + sh.y;
            r.z = v[j].z * rstd * gg.z * (1.f + sc.z) + sh.z; r.w = v[j].w * rstd * gg.w * (1.f + sc.w) + sh.w;
            o[64 * j] = make_uint2(pk2(r.x, r.y), pk2(r.z, r.w));
        }
    }
    const int gt = c.bid * 512 + c.tid, NT = c.G * 512;
    const float* apow = (const float*)(c.ws + WS_APOW); const float* bb = (const float*)(c.ws + WS_S5BB); const float* klag = (const float*)(c.ws + WS_KLAG);
    const float* c_re = c.in[25]; const float* c_im = c.in[26]; const float* dd = c.in[27];
    bf16_t* kmat = (bf16_t*)(c.ws + WS_KMAT); bf16_t* hmat = (bf16_t*)(c.ws + WS_HMAT);
    for (int it = gt; it < S5NG * 512 * 80; it += NT) {
        const int row = it / 80, ch = it % 80, g = row >> 9, t = (row >> 4) & 31, cc = row & 15, col0 = ch * 8;
        float v[8];
        if (col0 < 512) {
            const int s = col0 >> 4, c0 = col0 & 15;
            if (s > t) {
#pragma unroll
                for (int i = 0; i < 8; ++i) v[i] = 0.f;
            } else {
                const float4 k0 = *(const float4*)(klag + ((size_t)(g * S5L + (t - s)) * 16 + cc) * 16 + c0), k1 = *(const float4*)(klag + ((size_t)(g * S5L + (t - s)) * 16 + cc) * 16 + c0 + 4);
                v[0] = k0.x; v[1] = k0.y; v[2] = k0.z; v[3] = k0.w; v[4] = k1.x; v[5] = k1.y; v[6] = k1.z; v[7] = k1.w;
                if (s == t) {
                    const float dv = dd[g * 16 + cc];
#pragma unroll
                    for (int i = 0; i < 8; ++i) if (c0 + i == cc) v[i] += dv;
                }
            }
        } else {
            const int q0 = col0 - 512;
#pragma unroll
            for (int i = 0; i < 8; ++i) {
                const int q = q0 + i, p = q & 63;
                const float ar = apow[((size_t)(g * (S5L + 1) + t + 1) * 64 + p) * 2], ai = apow[((size_t)(g * (S5L + 1) + t + 1) * 64 + p) * 2 + 1];
                const float cr = c_re[(g * 16 + cc) * 64 + p], ci = c_im[(g * 16 + cc) * 64 + p];
                v[i] = (q < 64) ? (cr * ar - ci * ai) : -(cr * ai + ci * ar);
            }
        }
        *(uint4*)(kmat + (size_t)row * 640 + col0) = make_uint4(pk2(v[0], v[1]), pk2(v[2], v[3]), pk2(v[4], v[5]), pk2(v[6], v[7]));
    }
    for (int it = gt; it < S5NG * 256 * 80; it += NT) {
        const int row = it / 80, ch = it % 80, g = row >> 8, q = row & 255, col0 = ch * 8;
        float v[8];
#pragma unroll
        for (int i = 0; i < 8; ++i) v[i] = 0.f;
        if (q < 128 && col0 < 512) {
            const int s = col0 >> 4, c0 = col0 & 15, p = q & 63;
            const float ar = apow[((size_t)(g * (S5L + 1) + (S5L - 1 - s)) * 64 + p) * 2], ai = apow[((size_t)(g * (S5L + 1) + (S5L - 1 - s)) * 64 + p) * 2 + 1];
#pragma unroll
            for (int i = 0; i < 8; ++i) {
                const float br = bb[(size_t)(g * 64 + p) * 32 + c0 + i], bi = bb[(size_t)(g * 64 + p) * 32 + 16 + c0 + i];
                v[i] = (q < 64) ? (ar * br - ai * bi) : (ar * bi + ai * br);
            }
        }
        *(uint4*)(hmat + (size_t)row * 640 + col0) = make_uint4(pk2(v[0], v[1]), pk2(v[2], v[3]), pk2(v[4], v[5]), pk2(v[6], v[7]));
    }
}

__device__ __forceinline__ void phase3(const Ctx& c) {
    pg8::Gemm g{(const bf16_t*)(c.ws + WS_A), (const bf16_t*)(c.ws + WS_WIN_T), T, NPROJ, D};
    pg8::StaticOrder S; S.init(T, NPROJ, c.G, c.bid);
    pg8::EpiBf16<0> E{(bf16_t*)(c.ws + WS_PROJ), NPROJ, nullptr, 0, 0, 1.f};
    pg8::gemm_phase<pg8::EpiBf16<0>, pg8::StaticOrder, true, true>(c.lds, g, S, E);
}

__device__ __forceinline__ void unpack8(const uint4 a, float (&u)[8]) {
    u[0] = bf2f(a.x & 0xffffu); u[1] = bf2f(a.x >> 16); u[2] = bf2f(a.y & 0xffffu); u[3] = bf2f(a.y >> 16);
    u[4] = bf2f(a.z & 0xffffu); u[5] = bf2f(a.z >> 16); u[6] = bf2f(a.w & 0xffffu); u[7] = bf2f(a.w >> 16);
}
__device__ __forceinline__ uint4 pack8(const float (&v)[8]) { return make_uint4(pk2(v[0], v[1]), pk2(v[2], v[3]), pk2(v[4], v[5]), pk2(v[6], v[7])); }
#define DPPU(v, ctrl) ((unsigned)__builtin_amdgcn_mov_dpp((int)(v), (ctrl), 0xf, 0xf, true))
#define DPPF(v, ctrl) __builtin_bit_cast(float, __builtin_amdgcn_mov_dpp(__builtin_bit_cast(int, (v)), (ctrl), 0xf, 0xf, true))
__device__ __forceinline__ float fast_tanh(float x) { return 1.0f - 2.0f * __builtin_amdgcn_rcpf(1.0f + __builtin_amdgcn_exp2f(2.8853900817779268f * x)); }
__device__ __forceinline__ void phase4(const Ctx& c) {
    const bf16_t* proj = (const bf16_t*)(c.ws + WS_PROJ);
    const float* mu = c.in[9]; const float* k_k = c.in[15];
    bf16_t* rw_r = (bf16_t*)(c.ws + WS_RW_R); bf16_t* rw_k = (bf16_t*)(c.ws + WS_RW_K); bf16_t* rw_v = (bf16_t*)(c.ws + WS_RW_V); bf16_t* rw_a = (bf16_t*)(c.ws + WS_RW_A);
    bf16_t* alora = (bf16_t*)((unsigned char*)c.out + OUT_ALORA); bf16_t* ux = (bf16_t*)((unsigned char*)c.out + OUT_UX);
    const int gw = c.bid * 8 + c.wid, NW = c.G * 8, lane = c.lane;
    float mm[4][8], kk8[8];
#pragma unroll
    for (int j = 0; j < 4; ++j) {
        const int cidx = lane + 64 * j, col = (cidx < 224 ? cidx : 0) * 8;
        const float4 m0 = *(const float4*)(mu + col), m1 = *(const float4*)(mu + col + 4);
        mm[j][0] = m0.x; mm[j][1] = m0.y; mm[j][2] = m0.z; mm[j][3] = m0.w; mm[j][4] = m1.x; mm[j][5] = m1.y; mm[j][6] = m1.z; mm[j][7] = m1.w;
    }
    { const float4 k0 = *(const float4*)(k_k + lane * 8), k1 = *(const float4*)(k_k + lane * 8 + 4); kk8[0] = k0.x; kk8[1] = k0.y; kk8[2] = k0.z; kk8[3] = k0.w; kk8[4] = k1.x; kk8[5] = k1.y; kk8[6] = k1.z; kk8[7] = k1.w; }
    constexpr int RUN = 16;
    auto load_row = [&](int t, uint4 (&r)[5]) {
        const bf16_t* pr = proj + (size_t)t * NPROJ;
#pragma unroll
        for (int j = 0; j < 3; ++j) r[j] = *(const uint4*)(pr + (lane + 64 * j) * 8);
        r[3] = (lane < 32) ? *(const uint4*)(pr + (lane + 192) * 8) : make_uint4(0u, 0u, 0u, 0u);
        r[4] = *(const uint4*)(pr + RPROJ + lane * 8);
    };
    for (int t0 = gw * RUN; t0 < T; t0 += NW * RUN) {
        uint4 prev[5], cur[5], nxt[5];
        if (t0 % SEQ == 0) {
#pragma unroll
            for (int j = 0; j < 5; ++j) prev[j] = make_uint4(0u, 0u, 0u, 0u);
        } else load_row(t0 - 1, prev);
        load_row(t0, cur);
#pragma unroll 2
        for (int i = 0; i < RUN; ++i) {
            const int t = t0 + i;
            if (i + 1 < RUN) load_row(t + 1, nxt);
#pragma unroll
            for (int j = 0; j < 4; ++j) {
                const int cidx = lane + 64 * j;
                if (cidx < 224) {
                    const int col = cidx * 8;
                    float p[8], q[8], ps[8];
                    unpack8(cur[j], p); unpack8(prev[j], q);
#pragma unroll
                    for (int i2 = 0; i2 < 8; ++i2) ps[i2] = p[i2] + (q[i2] - p[i2]) * mm[j][i2];
                    if (j == 0) *(uint4*)(rw_r + (size_t)t * RW + col) = pack8(ps);
                    else if (j == 1) {
                        const int cl = col - 512;
                        *(uint4*)(rw_k + (size_t)t * RW + cl) = pack8(ps);
                        float kk[8]; float ss = 0.f;
#pragma unroll
                        for (int i2 = 0; i2 < 8; ++i2) { kk[i2] = ps[i2] * kk8[i2]; ss += kk[i2] * kk[i2]; }
                        ss += DPPF(ss, 0xB1); ss += DPPF(ss, 0x4E); ss += DPPF(ss, 0x141);
                        const float inv = -1.0f / fmaxf(sqrtf(ss), 1e-12f);
#pragma unroll
                        for (int i2 = 0; i2 < 8; ++i2) kk[i2] *= inv;
                        *(uint4*)(rw_a + (size_t)t * RW + cl) = pack8(kk);
                    } else if (j == 2) *(uint4*)(rw_v + (size_t)t * RW + (col - 1024)) = pack8(ps);
                    else {
                        const int cl = col - 1536;
                        float o[8];
#pragma unroll
                        for (int i2 = 0; i2 < 8; ++i2) o[i2] = (cl < 64) ? fast_tanh(ps[i2]) : (cl < 128) ? ps[i2] : pg8::fast_sigmoid(ps[i2]);
                        *(uint4*)(alora + (size_t)t * 256 + cl) = pack8(o);
                    }
                }
            }
            {
                const int g = lane >> 1, hf = lane & 1, b = t / SEQ, sidx = t % S5L, chunk = (t % SEQ) / S5L;
                bf16_t* row = ux + ((size_t)(g * 1024 + b * 256 + chunk)) * 640;
                *(uint4*)(row + sidx * 16 + hf * 8) = cur[4];
                if (sidx < 8) { *(uint4*)(row + 512 + (sidx * 2 + hf) * 8) = make_uint4(0u, 0u, 0u, 0u); }
            }
#pragma unroll
            for (int j = 0; j < 5; ++j) { prev[j] = cur[j]; cur[j] = nxt[j]; }
        }
    }
}

__device__ __forceinline__ void phase5(const Ctx& c) {
    {
        pg8::Gemm g{(const bf16_t*)((unsigned char*)c.out + OUT_ALORA), (const bf16_t*)(c.ws + WS_LORA_BT), T, 1536, 256};
        pg8::StaticOrder S; S.init(T, 1536, c.G, c.bid);
        pg8::EpiLora E{c.in[10], c.in[12], c.in[16], (float*)(c.ws + WS_RW_W), (const bf16_t*)(c.ws + WS_RW_K), (bf16_t*)((unsigned char*)c.out + OUT_KF), (const bf16_t*)(c.ws + WS_RW_A), (bf16_t*)(c.ws + WS_RW_B), (bf16_t*)(c.ws + WS_RW_G)};
        pg8::gemm_phase<pg8::EpiLora, pg8::StaticOrder, true, true>(c.lds, g, S, E);
    }
    __syncthreads();
    {
        pg8::Gemm g{(const bf16_t*)((unsigned char*)c.out + OUT_UX), (const bf16_t*)(c.ws + WS_HMAT), 0, 0, 640};
        pg8::S5Order S{128, 1, c.G, c.bid};
        pg8::EpiS5E E{(float*)((unsigned char*)c.out + OUT_E)};
        pg8::gemm_phase<pg8::EpiS5E, pg8::S5Order, true, true>(c.lds, g, S, E);
    }
}

typedef float f2v __attribute__((ext_vector_type(2)));
__device__ __forceinline__ float dpp_add16(float v) {
    v += __builtin_bit_cast(float, __builtin_amdgcn_mov_dpp(__builtin_bit_cast(int, v), 0xB1, 0xf, 0xf, true));
    v += __builtin_bit_cast(float, __builtin_amdgcn_mov_dpp(__builtin_bit_cast(int, v), 0x4E, 0xf, 0xf, true));
    v += __builtin_bit_cast(float, __builtin_amdgcn_mov_dpp(__builtin_bit_cast(int, v), 0x141, 0xf, 0xf, true));
    v += __builtin_bit_cast(float, __builtin_amdgcn_mov_dpp(__builtin_bit_cast(int, v), 0x140, 0xf, 0xf, true));
    return v;
}
constexpr int RTS = 32;
constexpr int RTILE = 6 * RTS * 64;
typedef short bf16x8_t __attribute__((ext_vector_type(8)));
typedef float f32x4_t __attribute__((ext_vector_type(4)));
#define MFMA16(a, b, c) __builtin_amdgcn_mfma_f32_16x16x32_bf16((a), (b), (c), 0, 0, 0)
constexpr int CL = 64, CLD = 72, CSLOT = 64 * CLD * 2;
constexpr int C_DIAG = 13 * CSLOT, C_DM = C_DIAG + 4096, C_GL = C_DM + 2048, C_SEGP = C_GL + 256;
static_assert(C_SEGP + 2048 <= 131072, "rwkv chunk LDS map");
__device__ __forceinline__ bf16x8_t ldsfrag(LAS const unsigned char* slot, int row, int col) { return *(LAS const bf16x8_t*)(slot + (row * CLD + col) * 2); }
typedef unsigned u32x4_t __attribute__((ext_vector_type(4)));
typedef unsigned u32x2_t __attribute__((ext_vector_type(2)));
__device__ __forceinline__ void lds_st16(LAS unsigned char* p, uint4 v) { *(LAS u32x4_t*)p = (u32x4_t){v.x, v.y, v.z, v.w}; }
__device__ __forceinline__ void lds_st8(LAS unsigned char* p, uint2 v) { *(LAS u32x2_t*)p = (u32x2_t){v.x, v.y}; }
__device__ __forceinline__ uint2 lds_ld8(LAS const unsigned char* p) { const u32x2_t v = *(LAS const u32x2_t*)p; return make_uint2(v.x, v.y); }
__device__ __forceinline__ bf16x8_t zfrag() { return (bf16x8_t){0, 0, 0, 0, 0, 0, 0, 0}; }
__device__ __forceinline__ uint2 pack4(float a, float b, float c, float d) { return make_uint2(pk2(a, b), pk2(c, d)); }
__device__ __forceinline__ float wave_sum_u(float v) {
    v = dpp_add16(v);
    return __builtin_bit_cast(float, __builtin_amdgcn_readlane(__builtin_bit_cast(int, v), 0)) + __builtin_bit_cast(float, __builtin_amdgcn_readlane(__builtin_bit_cast(int, v), 16))
         + __builtin_bit_cast(float, __builtin_amdgcn_readlane(__builtin_bit_cast(int, v), 32)) + __builtin_bit_cast(float, __builtin_amdgcn_readlane(__builtin_bit_cast(int, v), 48));
}

__device__ __forceinline__ void rwkv_phaseA(const Ctx& c, const int GA) {
    const float* __restrict__ rw_w = (const float*)(c.ws + WS_RW_W);
    const bf16_t* __restrict__ rw_r = (const bf16_t*)(c.ws + WS_RW_R); const bf16_t* __restrict__ rw_k = (const bf16_t*)((const unsigned char*)c.out + OUT_KF); const bf16_t* __restrict__ rw_v = (const bf16_t*)(c.ws + WS_RW_V);
    const bf16_t* __restrict__ rw_a = (const bf16_t*)(c.ws + WS_RW_A); const bf16_t* __restrict__ rw_b = (const bf16_t*)(c.ws + WS_RW_B);
    const float* r_k = c.in[17];
    bf16_t* Mq = (bf16_t*)(c.ws + WS_CM); bf16_t* NTq = (bf16_t*)(c.ws + WS_CN); bf16_t* Qq = (bf16_t*)(c.ws + WS_CQ); bf16_t* YTq = (bf16_t*)(c.ws + WS_CY); float* bon = (float*)(c.ws + WS_CBON);
    LAS unsigned char* L = c.lds;
    LAS unsigned char* sAt = L + 0 * CSLOT; LAS unsigned char* sBt = L + 1 * CSLOT; LAS unsigned char* sKt = L + 2 * CSLOT; LAS unsigned char* sRt = L + 3 * CSLOT;
    LAS unsigned char* sBtT = L + 4 * CSLOT; LAS unsigned char* sKtT = L + 5 * CSLOT; LAS unsigned char* sVT = L + 6 * CSLOT;
    LAS unsigned char* sA4 = L + 7 * CSLOT;
    LAS unsigned char* sRHST = L + 11 * CSLOT;
    LAS unsigned char* sXT = L + 0 * CSLOT;
    LAS unsigned char* sAD = L + 2 * CSLOT;
    LAS float* sDIAG = (LAS float*)(L + C_DIAG); LAS bf16_t* sDM = (LAS bf16_t*)(L + C_DM); LAS float* sGL = (LAS float*)(L + C_GL); LAS float* sSEGP = (LAS float*)(L + C_SEGP);
    const int tid = c.tid, w = c.wid, lane = c.lane, lr = lane & 15, lq = lane >> 4;
    float raww[8]; unsigned rawa[8], rawb[8], rawk[8], rawr[8], rawv[8];
    auto load_raw = [&](int ci_) {
        const int bh_ = ci_ >> 7, chunk_ = ci_ & 127, b_ = bh_ >> 3, h_ = bh_ & 7;
        const size_t gb = (size_t)(b_ * SEQ + chunk_ * CL) * RW + h_ * 64 + (size_t)(8 * (tid >> 6)) * RW + (tid & 63);
#pragma unroll
        for (int j = 0; j < 8; ++j) { const size_t o = gb + (size_t)j * RW; raww[j] = rw_w[o]; rawa[j] = rw_a[o]; rawb[j] = rw_b[o]; rawk[j] = rw_k[o]; rawr[j] = rw_r[o]; rawv[j] = rw_v[o]; }
    };
    if (c.bid < BATCH * NH * (SEQ / CL)) load_raw(c.bid);
    for (int ci = c.bid; ci < BATCH * NH * (SEQ / CL); ci += GA) {
        const int bh = ci >> 7, chunk = ci & 127, b = bh >> 3, h = bh & 7;
        const size_t gbase = (size_t)(b * SEQ + chunk * CL) * RW + h * 64;
        {
            const int kc = tid & 63, seg = tid >> 6;
            float p[8];
#pragma unroll
            for (int j = 0; j < 8; ++j) { const float wv = raww[j]; p[j] = (j == 0) ? wv : p[j - 1] * wv; }
            sSEGP[seg * 64 + kc] = p[7];
            for (int i = tid; i < 4 * CSLOT / 16; i += 512) lds_st16(sA4 + i * 16, make_uint4(0u, 0u, 0u, 0u));
            __syncthreads();
            float pre = 1.0f;
#pragma unroll
            for (int s = 0; s < 7; ++s) { const float sp = sSEGP[s * 64 + kc]; pre = (s < seg) ? pre * sp : pre; }
            float atT[8], btT[8], ktT[8], vT[8];
            const float rkv = r_k[h * 64 + kc];
#pragma unroll
            for (int j = 0; j < 8; ++j) {
                const int t = 8 * seg + j;
                const float G = pre * p[j], Gm1 = (j == 0) ? pre : pre * p[j - 1], inv = 1.0f / G;
                const float av = bf2f(rawa[j]), bv = bf2f(rawb[j]), kv = bf2f(rawk[j]), rv = bf2f(rawr[j]), vv = bf2f(rawv[j]);
                const float at = av * Gm1, bt = bv * inv, kt = kv * inv, rt = rv * G;
                *(LAS bf16_t*)(sAt + (t * CLD + kc) * 2) = (bf16_t)f2bf(at); *(LAS bf16_t*)(sBt + (t * CLD + kc) * 2) = (bf16_t)f2bf(bt);
                *(LAS bf16_t*)(sKt + (t * CLD + kc) * 2) = (bf16_t)f2bf(kt); *(LAS bf16_t*)(sRt + (t * CLD + kc) * 2) = (bf16_t)f2bf(rt);
                atT[j] = at; btT[j] = bt; ktT[j] = kt; vT[j] = vv;
                const float bs = wave_sum_u(rv * kv * rkv);
                if (lane == 0) bon[(size_t)ci * CL + t] = bs;
            }
            lds_st16(sRHST + (kc * CLD + 8 * seg) * 2, pack8(atT)); lds_st16(sBtT + (kc * CLD + 8 * seg) * 2, pack8(btT));
            lds_st16(sKtT + (kc * CLD + 8 * seg) * 2, pack8(ktT)); lds_st16(sVT + (kc * CLD + 8 * seg) * 2, pack8(vT));
            if (seg == 7) sGL[kc] = pre * p[7];
            __syncthreads();
        }
        for (int idx = w; idx < 40; idx += 8) {
            const int m = idx / 10, pr = idx % 10;
            const int ti = (pr >= 6) ? 3 : (pr >= 3) ? 2 : (pr >= 1) ? 1 : 0, si = pr - ti * (ti + 1) / 2;
            LAS const unsigned char* X = (m < 2) ? sAt : sRt; LAS const unsigned char* Y = (m & 1) ? sKt : sBt;
            f32x4_t acc = {0.f, 0.f, 0.f, 0.f};
#pragma unroll
            for (int ks = 0; ks < 2; ++ks) acc = MFMA16(ldsfrag(Y, 16 * si + lr, 32 * ks + 8 * lq), ldsfrag(X, 16 * ti + lr, 32 * ks + 8 * lq), acc);
            const int t = 16 * ti + lr, s0 = 16 * si + 4 * lq;
            float o[4];
#pragma unroll
            for (int rg = 0; rg < 4; ++rg) { const int s = s0 + rg; const bool keep = (m < 2) ? (s < t) : (s <= t); o[rg] = keep ? acc[rg] : 0.f; }
            lds_st8(sA4 + m * CSLOT + (t * CLD + s0) * 2, pack4(o[0], o[1], o[2], o[3]));
            if (m == 0 && ti == si) *(LAS f32x4_t*)(sDIAG + (ti * 16 + lr) * 16 + 4 * lq) = (f32x4_t){o[0], o[1], o[2], o[3]};
        }
        __syncthreads();
        if (w == 0) {
            float x[16];
#pragma unroll
            for (int r = 0; r < 16; ++r) {
                float acc = (r == lr) ? 1.0f : 0.0f;
                float nrow[16];
#pragma unroll
                for (int q4 = 0; q4 < 4; ++q4) { const f32x4_t nv = *(LAS const f32x4_t*)(sDIAG + (lq * 16 + r) * 16 + 4 * q4); nrow[4 * q4] = nv[0]; nrow[4 * q4 + 1] = nv[1]; nrow[4 * q4 + 2] = nv[2]; nrow[4 * q4 + 3] = nv[3]; }
#pragma unroll
                for (int s = 0; s < 16; ++s) if (s < r) acc = fmaf(nrow[s], x[s], acc);
                x[r] = acc;
                sDM[(lq * 16 + r) * 16 + lr] = (bf16_t)f2bf(acc);
            }
        } else {
            for (int idx = w - 1; idx < 16; idx += 7) {
                const int ti = idx >> 2, vi = idx & 3;
                f32x4_t acc = {0.f, 0.f, 0.f, 0.f};
#pragma unroll
                for (int ks = 0; ks < 2; ++ks) acc = MFMA16(ldsfrag(sA4 + 1 * CSLOT, 16 * ti + lr, 32 * ks + 8 * lq), ldsfrag(sVT, 16 * vi + lr, 32 * ks + 8 * lq), acc);
                lds_st8(sRHST + ((64 + 16 * vi + lr) * CLD + 16 * ti + 4 * lq) * 2, pack4(acc[0], acc[1], acc[2], acc[3]));
            }
        }
        __syncthreads();
        f32x4_t rd[4];
#pragma unroll
        for (int i = 0; i < 4; ++i) {
            bf16x8_t fa = zfrag(), fb = zfrag();
            if (lq < 2) { fa = *(LAS const bf16x8_t*)(sDM + (i * 16 + lr) * 16 + 8 * lq); fb = ldsfrag(sRHST, 16 * w + lr, 16 * i + 8 * lq); }
            rd[i] = MFMA16(fa, fb, ((f32x4_t){0.f, 0.f, 0.f, 0.f}));
        }
        if (w < 6) {
            const int i = (w >= 3) ? 3 : (w >= 1) ? 2 : 1, j = w - (i - 1) * i / 2;
            bf16x8_t fa = zfrag(), fb = zfrag();
            if (lq < 2) {
                fa = *(LAS const bf16x8_t*)(sDM + (i * 16 + lr) * 16 + 8 * lq);
#pragma unroll
                for (int jj = 0; jj < 8; ++jj) fb[jj] = (short)*(LAS const bf16_t*)(sA4 + ((16 * i + 8 * lq + jj) * CLD + 16 * j + lr) * 2);
            }
            const f32x4_t acc = MFMA16(fa, fb, ((f32x4_t){0.f, 0.f, 0.f, 0.f}));
#pragma unroll
            for (int rg = 0; rg < 4; ++rg) *(LAS bf16_t*)(sAD + ((16 * i + 4 * lq + rg) * CLD + 16 * j + lr) * 2) = (bf16_t)f2bf(acc[rg]);
        }
        __syncthreads();
#pragma unroll
        for (int i = 0; i < 4; ++i) {
            f32x4_t acc = rd[i];
            if (i >= 1) {
                bf16x8_t fa = zfrag(), fb = zfrag();
                if (8 * lq < 16 * i) { fa = ldsfrag(sAD, 16 * i + lr, 8 * lq); fb = ldsfrag(sXT, 16 * w + lr, 8 * lq); }
                acc = MFMA16(fa, fb, acc);
            }
            if (i == 3) {
                bf16x8_t fa = zfrag(), fb = zfrag();
                if (lq < 2) { fa = ldsfrag(sAD, 48 + lr, 32 + 8 * lq); fb = ldsfrag(sXT, 16 * w + lr, 32 + 8 * lq); }
                acc = MFMA16(fa, fb, acc);
            }
            lds_st8(sXT + ((16 * w + lr) * CLD + 16 * i + 4 * lq) * 2, pack4(acc[0], acc[1], acc[2], acc[3]));
            asm volatile("s_waitcnt lgkmcnt(0)" ::: "memory");
        }
        __syncthreads();
        if (ci + GA < BATCH * NH * (SEQ / CL)) load_raw(ci + GA);
#pragma unroll
        for (int i = 0; i < 8; ++i) {
            const int kind = i >> 1, tile = w + 8 * (i & 1), r4 = tile >> 2, c4 = tile & 3;
            f32x4_t acc = {0.f, 0.f, 0.f, 0.f};
            if (kind == 0) {
#pragma unroll
                for (int ks = 0; ks < 2; ++ks) acc = MFMA16(ldsfrag(sXT, 16 * r4 + lr, 32 * ks + 8 * lq), ldsfrag(sBtT, 16 * c4 + lr, 32 * ks + 8 * lq), acc);
                const int k = 16 * c4 + lr, kp0 = 16 * r4 + 4 * lq; const float gl = sGL[k];
                float o[4];
#pragma unroll
                for (int rg = 0; rg < 4; ++rg) o[rg] = gl * (acc[rg] + ((k == kp0 + rg) ? 1.0f : 0.0f));
                *(uint2*)(Mq + (size_t)ci * 4096 + k * 64 + kp0) = pack4(o[0], o[1], o[2], o[3]);
            } else if (kind == 1) {
#pragma unroll
                for (int ks = 0; ks < 2; ++ks) {
                    acc = MFMA16(ldsfrag(sBtT, 16 * r4 + lr, 32 * ks + 8 * lq), ldsfrag(sXT, 64 + 16 * c4 + lr, 32 * ks + 8 * lq), acc);
                    acc = MFMA16(ldsfrag(sKtT, 16 * r4 + lr, 32 * ks + 8 * lq), ldsfrag(sVT, 16 * c4 + lr, 32 * ks + 8 * lq), acc);
                }
                const int k0 = 16 * r4 + 4 * lq; const f32x4_t gl = *(LAS const f32x4_t*)(sGL + k0);
                *(uint2*)(NTq + (size_t)ci * 4096 + (16 * c4 + lr) * 64 + k0) = pack4(gl[0] * acc[0], gl[1] * acc[1], gl[2] * acc[2], gl[3] * acc[3]);
            } else if (kind == 2) {
#pragma unroll
                for (int ks = 0; ks < 2; ++ks) acc = MFMA16(ldsfrag(sXT, 16 * r4 + lr, 32 * ks + 8 * lq), ldsfrag(sA4 + 2 * CSLOT, 16 * c4 + lr, 32 * ks + 8 * lq), acc);
                const int t = 16 * c4 + lr, kp0 = 16 * r4 + 4 * lq;
                const uint2 rv = lds_ld8(sRt + (t * CLD + kp0) * 2);
                *(uint2*)(Qq + (size_t)ci * 4096 + t * 64 + kp0) = pack4(acc[0] + bf2f(rv.x & 0xffffu), acc[1] + bf2f(rv.x >> 16), acc[2] + bf2f(rv.y & 0xffffu), acc[3] + bf2f(rv.y >> 16));
            } else {
#pragma unroll
                for (int ks = 0; ks < 2; ++ks) {
                    acc = MFMA16(ldsfrag(sA4 + 2 * CSLOT, 16 * r4 + lr, 32 * ks + 8 * lq), ldsfrag(sXT, 64 + 16 * c4 + lr, 32 * ks + 8 * lq), acc);
                    acc = MFMA16(ldsfrag(sA4 + 3 * CSLOT, 16 * r4 + lr, 32 * ks + 8 * lq), ldsfrag(sVT, 16 * c4 + lr, 32 * ks + 8 * lq), acc);
                }
                *(uint2*)(YTq + (size_t)ci * 4096 + (16 * c4 + lr) * 64 + 16 * r4 + 4 * lq) = pack4(acc[0], acc[1], acc[2], acc[3]);
            }
        }
        __syncthreads();
    }
}

__device__ __forceinline__ void rwkv_phaseB(const Ctx& c, const int bh, const int w) {
    const bf16_t* __restrict__ Mq = (const bf16_t*)(c.ws + WS_CM); const bf16_t* __restrict__ NTq = (const bf16_t*)(c.ws + WS_CN); bf16_t* __restrict__ Sst = (bf16_t*)(c.ws + WS_CS);
    const int lane = c.lane, lr = lane & 15, lq = lane >> 4;
    LAS unsigned char* sS = c.lds + 69632 + c.wid * (16 * CLD * 2);
    {
        {
            bf16x8_t sB0 = zfrag(), sB1 = zfrag();
            bf16x8_t ma[4][4][2]; uint2 nv[4][4];
            const size_t ci0 = (size_t)bh * (SEQ / CL);
#define RB_LOAD(slot, cidx) do { _Pragma("unroll") for (int kt = 0; kt < 4; ++kt) { _Pragma("unroll") for (int ks = 0; ks < 2; ++ks) \
                ma[slot][kt][ks] = *(const bf16x8_t*)(Mq + (cidx) * 4096 + (16 * kt + lr) * 64 + 32 * ks + 8 * lq); nv[slot][kt] = *(const uint2*)(NTq + (cidx) * 4096 + (16 * w + lr) * 64 + 16 * kt + 4 * lq); } } while (0)
#pragma unroll
            for (int sl = 0; sl < 4; ++sl) RB_LOAD(sl, ci0 + sl);
#pragma unroll
            for (int chunk = 0; chunk < SEQ / CL; chunk += 4) {
#pragma unroll
                for (int sl = 0; sl < 4; ++sl) {
                    const size_t ci = ci0 + chunk + sl;
                    asm volatile("global_store_dwordx4 %0, %1, off\n\tglobal_store_dwordx4 %0, %2, off offset:64\n\ts_nop 1" :: "v"(Sst + ci * 4096 + (16 * w + lr) * 64 + 8 * lq), "v"(sB0), "v"(sB1) : "memory");
#pragma unroll
                    for (int kt = 0; kt < 4; ++kt) {
                        f32x4_t acc = {bf2f(nv[sl][kt].x & 0xffffu), bf2f(nv[sl][kt].x >> 16), bf2f(nv[sl][kt].y & 0xffffu), bf2f(nv[sl][kt].y >> 16)};
                        acc = MFMA16(ma[sl][kt][0], sB0, acc); acc = MFMA16(ma[sl][kt][1], sB1, acc);
                        lds_st8(sS + (lr * CLD + 16 * kt + 4 * lq) * 2, pack4(acc[0], acc[1], acc[2], acc[3]));
                    }
                    const size_t cn = (chunk + sl + 4 < SEQ / CL) ? ci + 4 : ci;
                    RB_LOAD(sl, cn);
                    asm volatile("s_waitcnt lgkmcnt(0)" ::: "memory");
                    sB0 = ldsfrag(sS, lr, 8 * lq); sB1 = ldsfrag(sS, lr, 32 + 8 * lq);
                    asm volatile("s_waitcnt lgkmcnt(0)" ::: "memory");
                }
            }
#undef RB_LOAD
        }
    }
}

__device__ __forceinline__ void rwkv_phaseC(const Ctx& c) {
    const bf16_t* __restrict__ Qq = (const bf16_t*)(c.ws + WS_CQ); const bf16_t* __restrict__ YTq = (const bf16_t*)(c.ws + WS_CY); const bf16_t* __restrict__ Sst = (const bf16_t*)(c.ws + WS_CS);
    const float* __restrict__ bon = (const float*)(c.ws + WS_CBON);
    const bf16_t* rw_v = (const bf16_t*)(c.ws + WS_RW_V); const bf16_t* rw_g = (const bf16_t*)(c.ws + WS_RW_G);
    const float* ln_w = c.in[18]; const float* ln_b = c.in[19];
    bf16_t* ycat = (bf16_t*)(c.ws + WS_A);
    const int w = c.wid, lane = c.lane, lr = lane & 15, lq = lane >> 4;
    LAS float* sY = (LAS float*)(c.lds + w * (16 * 68 * 4));
    const int gw = c.bid * 8 + c.wid, NW = c.G * 8;
    for (int task = gw; task < BATCH * NH * (SEQ / CL) * 4; task += NW) {
        const size_t ci = (size_t)(task >> 2); const int tt = task & 3;
        const int bh = (int)(ci >> 7), chunk = (int)(ci & 127), b = bh >> 3, h = bh & 7;
        bf16x8_t qa[2];
#pragma unroll
        for (int ks = 0; ks < 2; ++ks) qa[ks] = *(const bf16x8_t*)(Qq + ci * 4096 + (16 * tt + lr) * 64 + 32 * ks + 8 * lq);
#pragma unroll
        for (int vt = 0; vt < 4; ++vt) {
            const uint2 yv = *(const uint2*)(YTq + ci * 4096 + (16 * vt + lr) * 64 + 16 * tt + 4 * lq);
            f32x4_t acc = {bf2f(yv.x & 0xffffu), bf2f(yv.x >> 16), bf2f(yv.y & 0xffffu), bf2f(yv.y >> 16)};
#pragma unroll
            for (int ks = 0; ks < 2; ++ks) acc = MFMA16(qa[ks], *(const bf16x8_t*)(Sst + ci * 4096 + (16 * vt + lr) * 64 + 32 * ks + 8 * lq), acc);
#pragma unroll
            for (int rg = 0; rg < 4; ++rg) sY[(4 * lq + rg) * 68 + 16 * vt + lr] = acc[rg];
        }
        asm volatile("s_waitcnt lgkmcnt(0)" ::: "memory");
        const int hn = h * 64 + lane;
        const float lw = ln_w[hn], lb = ln_b[hn];
#pragma unroll 4
        for (int tr = 0; tr < 16; ++tr) {
            const int t = chunk * CL + 16 * tt + tr; const size_t tok = (size_t)b * SEQ + t;
            const float y = sY[tr * 68 + lane];
            const float mean = wave_sum_u(y) * (1.f / 64.f);
            const float d = y - mean;
            const float var = wave_sum_u(d * d) * (1.f / 64.f);
            const float yn = d * rsqrtf(var + 64e-5f) * lw + lb;
            const float bonus = bon[ci * CL + 16 * tt + tr] * ldbf(rw_v + tok * RW + hn);
            ycat[tok * D + hn] = (bf16_t)f2bf((yn + bonus) * ldbf(rw_g + tok * RW + hn));
        }
        asm volatile("s_waitcnt lgkmcnt(0)" ::: "memory");
    }
}

constexpr int PA_BLOCKS = 256;
constexpr int CONV_A = 0;
__device__ __forceinline__ void phase6a(const Ctx& c) {
    if (c.G != 256) { rwkv_phaseA(c, c.G); return; }
    if (c.bid < PA_BLOCKS) rwkv_phaseA(c, PA_BLOCKS);
    else if (CONV_A > 0) convert_expert_weights(c, 0, CONV_A, (c.bid - PA_BLOCKS) * 8 + c.wid, (256 - PA_BLOCKS > 0 ? 256 - PA_BLOCKS : 1) * 8);
}

__device__ __forceinline__ void phase6b(const Ctx& c) {
    if (c.wid == 0) {
        for (int tk = c.bid; tk < 2 * S5NG * BATCH; tk += c.G) {
            if (tk < BATCH * NH * 4) { rwkv_phaseB(c, tk >> 2, tk & 3); continue; }
            const float* apow = (const float*)(c.ws + WS_APOW); const float* E = (const float*)((const unsigned char*)c.out + OUT_E);
            bf16_t* ux = (bf16_t*)((unsigned char*)c.out + OUT_UX);
            const int task = tk - BATCH * NH * 4;
            const int g = task >> 2, b = task & 3, p = c.lane;
            const float pr = apow[((size_t)(g * (S5L + 1) + S5L) * 64 + p) * 2], pi = apow[((size_t)(g * (S5L + 1) + S5L) * 64 + p) * 2 + 1];
            float xr = 0.f, xi = 0.f;
            const size_t row0 = (size_t)g * 1024 + b * 256;
            float er[2][8], ei[2][8];
#pragma unroll
            for (int q = 0; q < 8; ++q) { er[0][q] = E[(row0 + q) * 128 + p]; ei[0][q] = E[(row0 + q) * 128 + 64 + p]; }
#pragma unroll
            for (int bt = 0; bt < 32; ++bt) {
                const int cur = bt & 1, nx = cur ^ 1, ch0 = bt * 8;
                if (bt + 1 < 32) {
#pragma unroll
                    for (int q = 0; q < 8; ++q) { er[nx][q] = E[(row0 + ch0 + 8 + q) * 128 + p]; ei[nx][q] = E[(row0 + ch0 + 8 + q) * 128 + 64 + p]; }
                }
#pragma unroll
                for (int q = 0; q < 8; ++q) {
                    st2(ux + (row0 + ch0 + q) * 640 + 512 + p, f2bf(xr)); st2(ux + (row0 + ch0 + q) * 640 + 576 + p, f2bf(xi));
                    const float nr = pr * xr - pi * xi + er[cur][q], ni = pr * xi + pi * xr + ei[cur][q]; xr = nr; xi = ni;
                }
            }
        }
    } else {
        convert_expert_weights(c, (c.G == 256) ? CONV_A : 0, NE * 384, c.bid * 7 + (c.wid - 1), c.G * 7);
    }
}

__device__ __forceinline__ void phase7(const Ctx& c) {
    {
        pg8::Gemm g{(const bf16_t*)((unsigned char*)c.out + OUT_UX), (const bf16_t*)(c.ws + WS_KMAT), 0, 0, 640};
        pg8::S5Order S{256, 2, c.G, c.bid};
        pg8::EpiS5Out E{(bf16_t*)(c.ws + WS_YS5)};
        pg8::gemm_phase<pg8::EpiS5Out, pg8::S5Order, true, true>(c.lds, g, S, E);
    }
    __syncthreads();
    rwkv_phaseC(c);
}

__device__ __forceinline__ void phase8(const Ctx& c) {
    pg8::Gemm g{(const bf16_t*)(c.ws + WS_YS5), (const bf16_t*)(c.ws + WS_WGLU_T), T, 512, 512};
    pg8::StaticOrder S; S.init(T, 512, c.G, c.bid);
    pg8::EpiGLU E{(const bf16_t*)(c.ws + WS_YS5), 512, c.in[29], (bf16_t*)(c.ws + WS_A), D, 512};
    pg8::gemm_phase<pg8::EpiGLU, pg8::StaticOrder, true, true>(c.lds, g, S, E);
}

__device__ __forceinline__ void phase9(const Ctx& c) {
    pg8::Gemm g{(const bf16_t*)(c.ws + WS_A), (const bf16_t*)(c.ws + WS_WOUT_T), T, D, D};
    pg8::StaticOrder S; S.init(T, D, c.G, c.bid);
    pg8::EpiF32 E{(float*)(c.ws + WS_PROJ), D};
    pg8::gemm_phase<pg8::EpiF32, pg8::StaticOrder, true, true>(c.lds, g, S, E);
}

__device__ __forceinline__ void phase10(const Ctx& c) {
    const float* x = c.in[0]; const float* gpm = c.in[5]; const float* gpf = c.in[6];
    const float* mods = (const float*)(c.ws + WS_MODS); const float* mixed = (const float*)(c.ws + WS_PROJ);
    bf16_t* h2 = (bf16_t*)(c.ws + WS_A); float* x1o = c.out;
    const int gw = c.bid * 8 + c.wid, NW = c.G * 8;
    for (int t = gw; t < T; t += NW) {
        const int b = t / SEQ;
        const float4* mr = (const float4*)(mixed + (size_t)t * D) + c.lane;
        const float4* xr = (const float4*)(x + (size_t)t * D) + c.lane;
        float4 m[4], v[4]; float ss = 0.f;
#pragma unroll
        for (int j = 0; j < 4; ++j) { m[j] = mr[64 * j]; v[j] = xr[64 * j]; ss += m[j].x * m[j].x + m[j].y * m[j].y + m[j].z * m[j].z + m[j].w * m[j].w; }
        const float rstd = rsqrtf(wave_sum(ss) * (1.0f / D) + 1e-6f);
        float s1 = 0.f;
#pragma unroll
        for (int j = 0; j < 4; ++j) {
            const int k = (c.lane + 64 * j) * 4;
            const float4 gg = *(const float4*)(gpm + k);
            const float4 gt = *(const float4*)(mods + b * NMODS + 2 * D + k);
            v[j].x += gt.x * (m[j].x * rstd * gg.x); v[j].y += gt.y * (m[j].y * rstd * gg.y);
            v[j].z += gt.z * (m[j].z * rstd * gg.z); v[j].w += gt.w * (m[j].w * rstd * gg.w);
            s1 += v[j].x * v[j].x + v[j].y * v[j].y + v[j].z * v[j].z + v[j].w * v[j].w;
            ((float4*)(x1o + (size_t)t * D) + c.lane)[64 * j] = v[j];
        }
        const float rstd1 = rsqrtf(wave_sum(s1) * (1.0f / D) + 1e-6f);
#pragma unroll
        for (int j = 0; j < 4; ++j) {
            const int k = (c.lane + 64 * j) * 4;
            const float4 gg = *(const float4*)(gpf + k);
            const float4 sh = *(const float4*)(mods + b * NMODS + 3 * D + k);
            const float4 sc = *(const float4*)(mods + b * NMODS + 4 * D + k);
            float r[4];
            r[0] = v[j].x * rstd1 * gg.x * (1.f + sc.x) + sh.x; r[1] = v[j].y * rstd1 * gg.y * (1.f + sc.y) + sh.y;
            r[2] = v[j].z * rstd1 * gg.z * (1.f + sc.z) + sh.z; r[3] = v[j].w * rstd1 * gg.w * (1.f + sc.w) + sh.w;
            unsigned hi[4]; float lo[4];
#pragma unroll
            for (int q = 0; q < 4; ++q) { hi[q] = f2bf(r[q]); lo[q] = r[q] - bf2f(hi[q]); }
            ((uint2*)(h2 + (size_t)t * D) + c.lane)[64 * j] = make_uint2(hi[0] | (hi[1] << 16), hi[2] | (hi[3] << 16));
            ((uint2*)(h2 + (size_t)(T + t) * D) + c.lane)[64 * j] = make_uint2(pk2(lo[0], lo[1]), pk2(lo[2], lo[3]));
        }
    }
}

__device__ __forceinline__ void phase11(const Ctx& c) {
    {
        pg8::Gemm g{(const bf16_t*)(c.ws + WS_A), (const bf16_t*)(c.ws + WS_WR_T), 2 * T, 512, D};
        pg8::StaticOrder S; S.init(2 * T, 512, c.G, c.bid);
        pg8::EpiRouter E{(float*)(c.ws + WS_PLOG), (bf16_t*)(c.ws + WS_PLOG + 32 * MiB), (bf16_t*)(c.ws + WS_PLOG + 48 * MiB), T / 256};
        pg8::gemm_phase<pg8::EpiRouter, pg8::StaticOrder, true, true>(c.lds, g, S, E);
    }
    __syncthreads();
    {
        pg8::Gemm g{(const bf16_t*)(c.ws + WS_A), (const bf16_t*)(c.ws + WS_WSGU_T), T, 512, D};
        pg8::StaticOrder S; S.init(T, 512, c.G, c.bid);
        pg8::EpiSwiGLU E{(bf16_t*)(c.ws + WS_HS), 256};
        pg8::gemm_phase<pg8::EpiSwiGLU, pg8::StaticOrder, true, true>(c.lds, g, S, E);
    }
}

__device__ __forceinline__ unsigned fkey(float f) { const unsigned u = __builtin_bit_cast(unsigned, f); return u ^ ((u >> 31) ? 0xffffffffu : 0x80000000u); }
__device__ __forceinline__ unsigned wave_umax(unsigned v) {
    v = max(v, DPPU(v, 0xB1)); v = max(v, DPPU(v, 0x4E)); v = max(v, DPPU(v, 0x141)); v = max(v, DPPU(v, 0x140));
    const unsigned a = __builtin_amdgcn_readlane(v, 0), b = __builtin_amdgcn_readlane(v, 16), c = __builtin_amdgcn_readlane(v, 32), d = __builtin_amdgcn_readlane(v, 48);
    return max(max(a, b), max(c, d));
}
__device__ __forceinline__ unsigned wave_umin(unsigned v) {
    v = min(v, DPPU(v, 0xB1)); v = min(v, DPPU(v, 0x4E)); v = min(v, DPPU(v, 0x141)); v = min(v, DPPU(v, 0x140));
    const unsigned a = __builtin_amdgcn_readlane(v, 0), b = __builtin_amdgcn_readlane(v, 16), c = __builtin_amdgcn_readlane(v, 32), d = __builtin_amdgcn_readlane(v, 48);
    return min(min(a, b), min(c, d));
}
__device__ __forceinline__ void phase12(const Ctx& c) {
    const float* plog = (const float*)(c.ws + WS_PLOG); const float* rb = c.in[32];
    int* idx = (int*)(c.ws + WS_IDX); float* wt = (float*)(c.ws + WS_WT);
    LAS int* lhist = (LAS int*)c.lds;
    __syncthreads();
    if (c.tid < NE) lhist[c.tid] = 0;
    __syncthreads();
    const int gw = c.bid * 8 + c.wid, NW = c.G * 8, l = c.lane;
    const float4 bias = *(const float4*)(rb + l * 4);
    for (int t = gw; t < T; t += NW) {
        const float4 p0 = *(const float4*)(plog + (size_t)t * 256 + l * 4);
        const float4 p1 = ldbf4((const bf16_t*)(c.ws + WS_PLOG + 32 * MiB) + (size_t)t * 256 + l * 4), p2 = ldbf4((const bf16_t*)(c.ws + WS_PLOG + 48 * MiB) + (size_t)t * 256 + l * 4);
        const float lg[4] = {p0.x + (p1.x + p2.x), p0.y + (p1.y + p2.y), p0.z + (p1.z + p2.z), p0.w + (p1.w + p2.w)};
        float s[4] = {sigmoidf_(lg[0]), sigmoidf_(lg[1]), sigmoidf_(lg[2]), sigmoidf_(lg[3])};
        float ch[4] = {s[0] + bias.x, s[1] + bias.y, s[2] + bias.z, s[3] + bias.w};
        float a1 = fmaxf(ch[0], ch[1]), a2 = fminf(ch[0], ch[1]);
        { const float b1 = fmaxf(ch[2], ch[3]), b2 = fminf(ch[2], ch[3]); const float n1 = fmaxf(a1, b1), n2 = fmaxf(fminf(a1, b1), fmaxf(a2, b2)); a1 = n1; a2 = n2; }
        { const float b1 = DPPF(a1, 0xB1), b2 = DPPF(a2, 0xB1); const float n1 = fmaxf(a1, b1), n2 = fmaxf(fminf(a1, b1), fmaxf(a2, b2)); a1 = n1; a2 = n2; }
        { const float b1 = DPPF(a1, 0x4E), b2 = DPPF(a2, 0x4E); const float n1 = fmaxf(a1, b1), n2 = fmaxf(fminf(a1, b1), fmaxf(a2, b2)); a1 = n1; a2 = n2; }
        { const float b1 = DPPF(a1, 0x141), b2 = DPPF(a2, 0x141); const float n1 = fmaxf(a1, b1), n2 = fmaxf(fminf(a1, b1), fmaxf(a2, b2)); a1 = n1; a2 = n2; }
        const float gs = a1 + a2; const int myg = l >> 3;
        int rank = 0;
#pragma unroll
        for (int g = 0; g < 8; ++g) { const float og = __builtin_bit_cast(float, __builtin_amdgcn_readlane(__builtin_bit_cast(int, gs), g * 8)); rank += (og > gs || (og == gs && g < myg)) ? 1 : 0; }
        const bool sel = rank < 4;
        unsigned mk[4];
#pragma unroll
        for (int i = 0; i < 4; ++i) mk[i] = sel ? fkey(ch[i]) : 0u;
        float sk[8]; int ek[8]; float ssum = 0.f;
#pragma unroll
        for (int k = 0; k < 8; ++k) {
            const unsigned lm = max(max(mk[0], mk[1]), max(mk[2], mk[3]));
            const unsigned m = wave_umax(lm);
            unsigned cand = 1023u;
#pragma unroll
            for (int i = 3; i >= 0; --i) if (mk[i] == m) cand = (unsigned)(l * 4 + i);
            const int be = (int)wave_umin(cand);
            const int ii = be & 3;
            float sv = s[0]; sv = (ii == 1) ? s[1] : sv; sv = (ii == 2) ? s[2] : sv; sv = (ii == 3) ? s[3] : sv;
            sv = __builtin_bit_cast(float, __builtin_amdgcn_readlane(__builtin_bit_cast(int, sv), be >> 2));
            if ((be >> 2) == l) {
#pragma unroll
                for (int i = 0; i < 4; ++i) if (i == ii) mk[i] = 0u;
            }
            sk[k] = sv; ek[k] = be; ssum += sv;
        }
        if (l == 0) {
            const float inv = 2.5f / ssum;
#pragma unroll
            for (int k = 0; k < 8; ++k) { idx[t * 8 + k] = ek[k]; wt[t * 8 + k] = sk[k] * inv; __hip_atomic_fetch_add(lhist + ek[k], 1, __ATOMIC_RELAXED, __HIP_MEMORY_SCOPE_WORKGROUP); }
        }
    }
    __syncthreads();
    if (c.tid < NE) ((int*)(c.ws + WS_HIST))[c.bid * NE + c.tid] = lhist[c.tid];
}

__device__ __forceinline__ void phase13(const Ctx& c) {
    int* smi = (int*)c.sm;
    const int* hist = (const int*)(c.ws + WS_HIST);
    __syncthreads();
    if (c.tid < NE) {
        int tot = 0, base = 0;
        for (int bb = 0; bb < c.G; ++bb) { const int v = hist[bb * NE + c.tid]; tot += v; base += (bb < c.bid) ? v : 0; }
        smi[600 + c.tid] = tot; smi[900 + c.tid] = base; smi[1200 + c.tid] = 0; smi[300 + c.tid] = (tot + 255) >> 8;
    }
    __syncthreads();
    if (c.tid < 64) {
        const int l = c.tid; const int u0 = smi[300 + l * 4], u1 = smi[300 + l * 4 + 1], u2 = smi[300 + l * 4 + 2], u3 = smi[300 + l * 4 + 3];
        const int tot = u0 + u1 + u2 + u3; int inc = tot;
#pragma unroll
        for (int o = 1; o < 64; o <<= 1) { const int v = __shfl_up(inc, o); if (l >= o) inc += v; }
        const int ex = inc - tot;
        smi[l * 4] = ex; smi[l * 4 + 1] = ex + u0; smi[l * 4 + 2] = ex + u0 + u1; smi[l * 4 + 3] = ex + u0 + u1 + u2;
        if (l == 63) smi[NE] = inc;
    }
    __syncthreads();
    const int* idx = (const int*)(c.ws + WS_IDX); int* slotp = (int*)(c.ws + WS_SLOTP); int* uexp = (int*)(c.ws + WS_UEXP); int* slotw = (int*)(c.ws + WS_SLOTW); const float* wt = (const float*)(c.ws + WS_WT);
    const int gw = c.bid * 8 + c.wid, NW = c.G * 8;
    for (int t = gw; t < T; t += NW) {
        if (c.lane < 8) {
            const int a = t * 8 + c.lane, e = idx[a];
            const int pos = smi[900 + e] + __hip_atomic_fetch_add(smi + 1200 + e, 1, __ATOMIC_RELAXED, __HIP_MEMORY_SCOPE_WORKGROUP);
            const int slot = smi[e] * 256 + pos;
            slotp[slot] = a;
            *(int2*)(slotw + 2 * (size_t)slot) = make_int2(a, __float_as_int(wt[a]));
        }
    }
    const int gt = c.bid * 512 + c.tid, NT = c.G * 512;
    for (int e = gt; e < NE; e += NT) {
        const int u0 = smi[e], u1 = smi[e + 1], cn = smi[600 + e];
        for (int p = cn; p < (u1 - u0) * 256; ++p) { slotp[u0 * 256 + p] = -1; *(int2*)(slotw + 2 * (size_t)(u0 * 256 + p)) = make_int2(-1, 0); }
        for (int u = u0; u < u1; ++u) uexp[u] = e;
    }
    if (gt == 0) uexp[2048] = smi[NE];
}

__device__ __forceinline__ void phase14(const Ctx& c) {
    const int* uexp = (const int*)(c.ws + WS_UEXP);
    const int NU = __builtin_amdgcn_readfirstlane(uexp[2048]);
    const int vcu = (c.G % 8 == 0) ? (c.bid % 8) * (c.G / 8) + c.bid / 8 : c.bid;
    pg8::Gemm g{(const bf16_t*)(c.ws + WS_A), (const bf16_t*)(c.ws + WS_WEGU), 0, 0, D, (const int*)(c.ws + WS_SLOTP)};
    pg8::ExpertOrder S{uexp, NU, 2, c.G, vcu};
    pg8::EpiSwiGLU E{(bf16_t*)(c.ws + WS_HID), 256};
    pg8::gemm_phase<pg8::EpiSwiGLU, pg8::ExpertOrder, true, true, true>(c.lds, g, S, E);
}

__device__ __forceinline__ void phase15(const Ctx& c) {
    {
        const int* uexp = (const int*)(c.ws + WS_UEXP);
        const int NU = __builtin_amdgcn_readfirstlane(uexp[2048]);
        const int vcu = (c.G % 8 == 0) ? (c.bid % 8) * (c.G / 8) + c.bid / 8 : c.bid;
        pg8::Gemm g{(const bf16_t*)(c.ws + WS_HID), (const bf16_t*)(c.ws + WS_WED), 0, 0, EFF};
        pg8::ExpertOrder S{uexp, NU, 4, c.G, vcu};
        pg8::EpiScatter E{(const int*)(c.ws + WS_SLOTW), (bf16_t*)(c.ws + WS_YEXP), D};
        pg8::gemm_phase<pg8::EpiScatter, pg8::ExpertOrder, true, true>(c.lds, g, S, E);
    }
    __syncthreads();
    {
        pg8::Gemm g{(const bf16_t*)(c.ws + WS_HS), (const bf16_t*)(c.ws + WS_WSD_T), T, D, 256};
        pg8::StaticOrder S; S.init(T, D, c.G, c.bid);
        pg8::EpiBf16<0> E{(bf16_t*)(c.ws + WS_SHOUT), D, nullptr, 0, 0, 1.f};
        pg8::gemm_phase<pg8::EpiBf16<0>, pg8::StaticOrder, true, true>(c.lds, g, S, E);
    }
}

__device__ __forceinline__ void phase16(const Ctx& c) {
    const float* gq = c.in[7]; const float* mods = (const float*)(c.ws + WS_MODS);
    const bf16_t* shout = (const bf16_t*)(c.ws + WS_SHOUT); const unsigned char* yexp = (const unsigned char*)(c.ws + WS_YEXP);
    float* out = c.out; float* dst = c.out;
    const int gw = c.bid * 8 + c.wid, NW = c.G * 8;
    typedef float f32x2s __attribute__((ext_vector_type(2)));
    for (int t = gw; t < T; t += NW) {
        const int b = t / SEQ;
        float y[2][8], x1[2][8]; float ss = 0.f;
        uint2 ye[2][8]; uint4 sh[2]; float4 xv[2][2];
#pragma unroll
        for (int j = 0; j < 2; ++j) {
            const int k = (c.lane + 64 * j) * 8;
            sh[j] = *(const uint4*)(shout + (size_t)t * D + k);
            xv[j][0] = *(const float4*)(out + (size_t)t * D + k); xv[j][1] = *(const float4*)(out + (size_t)t * D + k + 4);
#pragma unroll
            for (int q = 0; q < 8; ++q) ye[j][q] = *(const uint2*)(yexp + (size_t)(t * 8 + q) * D + k);
        }
#pragma unroll
        for (int j = 0; j < 2; ++j) {
            unpack8(sh[j], y[j]);
            x1[j][0] = xv[j][0].x; x1[j][1] = xv[j][0].y; x1[j][2] = xv[j][0].z; x1[j][3] = xv[j][0].w; x1[j][4] = xv[j][1].x; x1[j][5] = xv[j][1].y; x1[j][6] = xv[j][1].z; x1[j][7] = xv[j][1].w;
#pragma unroll
            for (int q = 0; q < 8; ++q) {
                const f32x2s a0 = __builtin_amdgcn_cvt_pk_f32_fp8((int)ye[j][q].x, false), a1 = __builtin_amdgcn_cvt_pk_f32_fp8((int)ye[j][q].x, true);
                const f32x2s a2 = __builtin_amdgcn_cvt_pk_f32_fp8((int)ye[j][q].y, false), a3 = __builtin_amdgcn_cvt_pk_f32_fp8((int)ye[j][q].y, true);
                y[j][0] += a0[0]; y[j][1] += a0[1]; y[j][2] += a1[0]; y[j][3] += a1[1]; y[j][4] += a2[0]; y[j][5] += a2[1]; y[j][6] += a3[0]; y[j][7] += a3[1];
            }
#pragma unroll
            for (int i = 0; i < 8; ++i) ss += y[j][i] * y[j][i];
        }
        const float rstd = rsqrtf(wave_sum_u(ss) * (1.0f / D) + 1e-6f);
#pragma unroll
        for (int j = 0; j < 2; ++j) {
            const int k = (c.lane + 64 * j) * 8;
            const float4 g0 = *(const float4*)(gq + k), g1 = *(const float4*)(gq + k + 4);
            const float4 t0 = *(const float4*)(mods + b * NMODS + 5 * D + k), t1 = *(const float4*)(mods + b * NMODS + 5 * D + k + 4);
            const float gg[8] = {g0.x, g0.y, g0.z, g0.w, g1.x, g1.y, g1.z, g1.w}, gt[8] = {t0.x, t0.y, t0.z, t0.w, t1.x, t1.y, t1.z, t1.w};
            float o[8];
#pragma unroll
            for (int i = 0; i < 8; ++i) o[i] = x1[j][i] + gt[i] * (y[j][i] * rstd * gg[i]);
            *(float4*)(dst + (size_t)t * D + k) = make_float4(o[0], o[1], o[2], o[3]); *(float4*)(dst + (size_t)t * D + k + 4) = make_float4(o[4], o[5], o[6], o[7]);
        }
    }
}

constexpr int NPHASES = 18;
__device__ __forceinline__ void probe_reset(const Ctx& c, int k) {
    unsigned* counts = (unsigned*)(c.ws + WS_COUNTS);
    if (k == 13 && c.bid == 0 && c.tid < 256) counts[c.tid] = 0u;
    if (k == 14 && c.bid == 0 && c.tid < 256) counts[256 + c.tid] = 0u;
}

__global__ void __launch_bounds__(512, 2) mega(Args args) {
    extern __shared__ __attribute__((aligned(16))) unsigned char lds_raw[];
    Ctx c;
    c.in = args.in; c.out = args.out; c.ws = args.ws;
    c.lds = (LAS unsigned char*)lds_raw; c.sm = (float*)lds_raw;
    c.dry = 0;
    c.tid = threadIdx.x; c.lane = c.tid & 63; c.wid = __builtin_amdgcn_readfirstlane(c.tid >> 6); c.bid = blockIdx.x; c.G = gridDim.x;
    volatile LAS unsigned* st = (volatile LAS unsigned*)(c.lds + LDS_CTL_OFF);
    if (c.tid < 4) st[c.tid] = 0u;
    __syncthreads();
    XcdBarrier bar; bar.bar = (unsigned*)(args.ws + WS_CTL); bar.x = 0; bar.st = st;
    const bool multi = (args.hi - args.lo) > 1;
    if (multi) bar = xcd_barrier_post((unsigned*)(args.ws + WS_CTL), st);
    const int lo = args.lo, hi = args.hi;
#ifndef REPEAT_PHASE
#define REPEAT_PHASE -1
#endif
#define LAUNDER() do { int t_ = threadIdx.x; asm volatile("" : "+v"(t_)); c.tid = t_; c.lane = t_ & 63; int b_ = blockIdx.x; asm volatile("" : "+s"(b_)); c.bid = b_; } while (0)
#define RUN_PHASE(k, call) if (lo <= (k) && (k) < hi) { if ((k) == REPEAT_PHASE) { LAUNDER(); c.dry = 1; call; c.dry = 0; xcd_barrier(bar); probe_reset(c, (k)); xcd_barrier(bar); } LAUNDER(); call; if ((k) + 1 < hi) xcd_barrier(bar); }
    RUN_PHASE(0, phase0(c))
    RUN_PHASE(1, phase1(c))
    RUN_PHASE(2, phase2(c))
    RUN_PHASE(3, phase3(c))
    RUN_PHASE(4, phase4(c))
    RUN_PHASE(5, phase5(c))
    RUN_PHASE(6, phase6a(c))
    RUN_PHASE(7, phase6b(c))
    RUN_PHASE(8, phase7(c))
    RUN_PHASE(9, phase8(c))
    RUN_PHASE(10, phase9(c))
    RUN_PHASE(11, phase10(c))
    RUN_PHASE(12, phase11(c))
    RUN_PHASE(13, phase12(c))
    RUN_PHASE(14, phase13(c))
    RUN_PHASE(15, phase14(c))
    RUN_PHASE(16, phase15(c))
    RUN_PHASE(17, phase16(c))
#undef RUN_PHASE
}

#ifndef N_LAUNCH_MODE
#define N_LAUNCH_MODE 1
#endif

extern "C" void kernel_launch(void* const* d_in, const int* in_sizes, int n_in, void* d_out, int out_size, void* d_ws, size_t ws_size, hipStream_t stream) {
    static int grid = 0;
    if (grid == 0) {
        if (n_in != 39 || out_size != T * D || ws_size < WS_END) { fprintf(stderr, "kernel_launch: unexpected shapes n_in %d out %d ws %zu\n", n_in, out_size, ws_size); grid = -1; return; }
        int dev = 0, cus = 0, per_cu = 0;
        if (hipGetDevice(&dev) != hipSuccess || hipDeviceGetAttribute(&cus, hipDeviceAttributeMultiprocessorCount, dev) != hipSuccess) { grid = -1; return; }
        if (hipFuncSetAttribute((const void*)mega, hipFuncAttributeMaxDynamicSharedMemorySize, LDS_BYTES) != hipSuccess) { grid = -1; return; }
        if (hipOccupancyMaxActiveBlocksPerMultiprocessor(&per_cu, (const void*)mega, 512, LDS_BYTES) != hipSuccess || per_cu < 1) { fprintf(stderr, "kernel_launch: occupancy query says %d\n", per_cu); }
        (void)hipGetLastError();
        grid = cus;
    }
    if (grid < 0) return;
    (void)hipMemsetAsync((char*)d_ws + WS_CTL, 0, CTL_BYTES, stream);
    Args a{};
    for (int i = 0; i < 39; ++i) a.in[i] = (const float*)d_in[i];
    a.out = (float*)d_out; a.ws = (unsigned char*)d_ws;
    if (N_LAUNCH_MODE == 1) {
        a.lo = 0; a.hi = NPHASES;
        hipLaunchKernelGGL(mega, dim3(grid), dim3(512), LDS_BYTES, stream, a);
    } else {
        for (int ph = 0; ph < NPHASES; ++ph) {
            a.lo = ph; a.hi = ph + 1;
            hipLaunchKernelGGL(mega, dim3(grid), dim3(512), LDS_BYTES, stream, a);
        }
    }
}
```

```cpp
#include <hip/hip_runtime.h>
#include <cstdint>
#include <cstdio>

#define LAS __attribute__((address_space(3)))

constexpr int D = 1024, BATCH = 4, SEQ = 8192, T = BATCH * SEQ;
constexpr int RW = 512, NH = 8;
constexpr int RPROJ = 1792, NPROJ = 2304;
constexpr int S5NG = 32, S5P = 64;
constexpr int NE = 256, EFF = 256;
constexpr int NMODS = 6 * D;
constexpr int S5L = 32;

constexpr size_t MiB = 1u << 20;
constexpr size_t WS_CTL = 0, CTL_BYTES = 1 * MiB;
constexpr size_t WS_COUNTS = 64 * 1024;
constexpr size_t WS_MODS = 1 * MiB;
constexpr size_t WS_HMAT = 2 * MiB;
constexpr size_t WS_WIN_T = 12 * MiB;
constexpr size_t WS_WOUT_T = 17 * MiB;
constexpr size_t WS_WGLU_T = 19 * MiB;
constexpr size_t WS_WSGU_T = 19 * MiB + 512 * 1024;
constexpr size_t WS_WSD_T = 20 * MiB + 512 * 1024;
constexpr size_t WS_WR_T = 21 * MiB;
constexpr size_t WS_LORA_BT = 22 * MiB;
constexpr size_t WS_APOW = 23 * MiB;
constexpr size_t WS_KMAT = 1000 * MiB;
constexpr size_t WS_MODSP = 1020 * MiB;
constexpr size_t WS_S5BB = 1022 * MiB;
constexpr size_t WS_KLAG = 1022 * MiB + 512 * 1024;
constexpr size_t OUT_UX = 0;
constexpr size_t OUT_E = 40 * MiB;
constexpr size_t OUT_ALORA = 56 * MiB;
constexpr size_t OUT_KF = 72 * MiB;
constexpr size_t WS_WED = 24 * MiB;
constexpr size_t WS_WEGU = 152 * MiB;
constexpr size_t WS_A = 408 * MiB;
constexpr size_t WS_YS5 = WS_A + 64 * MiB;
constexpr size_t WS_PROJ = 536 * MiB;
constexpr size_t WS_RW = 680 * MiB;
constexpr size_t RWSZ = (size_t)T * RW * 4;
constexpr size_t RWSZH = (size_t)T * RW * 2;
constexpr size_t WS_RW_W = WS_RW, WS_RW_Y = WS_RW + RWSZ, WS_RW_R = WS_RW + 2 * RWSZ, WS_RW_K = WS_RW_R + RWSZH, WS_RW_V = WS_RW_K + RWSZH,
                 WS_RW_A = WS_RW_V + RWSZH, WS_RW_B = WS_RW_A + RWSZH, WS_RW_G = WS_RW_B + RWSZH;
constexpr size_t WS_CM = WS_PROJ, WS_CN = WS_PROJ + 32 * MiB, WS_CQ = WS_PROJ + 64 * MiB, WS_CY = WS_PROJ + 96 * MiB;
constexpr size_t WS_CS = WS_RW_Y, WS_CBON = WS_RW_Y + 32 * MiB;
constexpr size_t WS_PLOG = 680 * MiB;
constexpr size_t WS_SHOUT = 680 * MiB;
constexpr size_t WS_HS = 808 * MiB;
constexpr size_t WS_IDX = 824 * MiB;
constexpr size_t WS_WT = 825 * MiB;
constexpr size_t WS_SLOTP = 826 * MiB;
constexpr size_t WS_UEXP = 827 * MiB + 512 * 1024;
constexpr size_t WS_SLOTW = 828 * MiB;
constexpr size_t WS_HIST = 831 * MiB;
constexpr size_t WS_HID = 840 * MiB;
constexpr size_t WS_YEXP = 152 * MiB;
constexpr size_t WS_END = 1023 * MiB + 512 * 1024;

constexpr int LDS_BYTES = 132096;
constexpr int LDS_CTL_OFF = 131072;

#define XB_TMO      128
#define XB_XCNT(j)  (256  + 64 * (j))
#define XB_XSUB(j)  (1280 + 64 * (j))
#define XB_XGEN(j)  (2304 + 64 * (j))
#define XB_TOP      3328
#define XB_TOPGEN   3392
#define XCD_BAR_WORDS 3456
#define XB_SPIN_CAP (1u << 24)

__device__ __forceinline__ unsigned xb_ld(unsigned* p)              { return __hip_atomic_load(p, __ATOMIC_RELAXED, __HIP_MEMORY_SCOPE_AGENT); }
__device__ __forceinline__ unsigned xb_add(unsigned* p, unsigned v) { return __hip_atomic_fetch_add(p, v, __ATOMIC_RELAXED, __HIP_MEMORY_SCOPE_AGENT); }
__device__ __forceinline__ unsigned xb_xcc_id() { return (unsigned)__builtin_amdgcn_s_getreg((3 << 11) | 20) & 0xFu; }
#define XB_SPIN(cond, bar) do { unsigned _sp = 0; while (cond) { __builtin_amdgcn_s_sleep(1); \
    if ((++_sp & 255u) == 0u) { if (xb_ld(&(bar)[XB_TMO])) break; if (_sp > XB_SPIN_CAP) { atomicAdd(&(bar)[XB_TMO], 1u); break; } } } } while (0)

struct XcdBarrier { unsigned* bar; unsigned x; volatile LAS unsigned* st; };

__device__ __forceinline__ XcdBarrier xcd_barrier_post(unsigned* bar, volatile LAS unsigned* st) {
    XcdBarrier b; b.bar = bar; b.x = xb_xcc_id(); b.st = st;
    if (threadIdx.x == 0) (void)xb_add(&bar[XB_XCNT(b.x)], 1u);
    return b;
}
__device__ __forceinline__ void xcd_barrier_complete(unsigned* bar, unsigned x, unsigned& nloc, unsigned& nx) {
    const unsigned G = gridDim.x * gridDim.y * gridDim.z;
    unsigned sum, cnt, mine, sp = 0u;
    for (;;) {
        sum = 0u; cnt = 0u; mine = 0u;
#pragma unroll
        for (unsigned j = 0; j < 16; ++j) { const unsigned c = xb_ld(&bar[XB_XCNT(j)]); sum += c; cnt += (c > 0u) ? 1u : 0u; mine = (j == x) ? c : mine; }
        if (sum == G) break;
        __builtin_amdgcn_s_sleep(1);
        if ((++sp & 255u) == 0u) { if (xb_ld(&bar[XB_TMO])) break; if (sp > XB_SPIN_CAP) { atomicAdd(&bar[XB_TMO], 1u); break; } }
    }
    nloc = mine > 0u ? mine : 1u; nx = cnt > 0u ? cnt : 1u;
}
__device__ __forceinline__ void xcd_barrier(const XcdBarrier& b) {
    asm volatile("s_waitcnt vmcnt(0)" ::: "memory");
    __syncthreads();
    if (threadIdx.x == 0) {
        unsigned* bar = b.bar;
        __builtin_amdgcn_s_waitcnt(0);
        unsigned nloc = b.st[0], nx = b.st[1];
        if (nloc == 0u) { xcd_barrier_complete(bar, b.x, nloc, nx); b.st[0] = nloc; b.st[1] = nx; }
        const unsigned old = xb_add(&bar[XB_XSUB(b.x)], 1u);
        const unsigned gen = old / nloc;
        if (old + 1u == (gen + 1u) * nloc) {
            __builtin_amdgcn_fence(__ATOMIC_RELEASE, "agent");
            asm volatile("s_waitcnt vmcnt(0)" ::: "memory");
            const unsigned og = xb_add(&bar[XB_TOP], 1u);
            const unsigned tg = og / nx;
            if (og + 1u == (tg + 1u) * nx) xb_add(&bar[XB_TOPGEN], 1u);
            else XB_SPIN(xb_ld(&bar[XB_TOPGEN]) == tg, bar);
            __builtin_amdgcn_fence(__ATOMIC_ACQUIRE, "agent");
            xb_add(&bar[XB_XGEN(b.x)], 1u);
            asm volatile("s_waitcnt vmcnt(0)" ::: "memory");
        } else {
            XB_SPIN(xb_ld(&bar[XB_XGEN(b.x)]) == gen, bar);
            __builtin_amdgcn_fence(__ATOMIC_ACQUIRE, "agent");
            asm volatile("s_waitcnt vmcnt(0)" ::: "memory");
        }
    }
    __syncthreads();
}

namespace pg8 {
#define PG8_LAS __attribute__((address_space(3)))
typedef unsigned short bf16_t;
typedef short bf16x8 __attribute__((ext_vector_type(8)));
typedef float f32x4 __attribute__((ext_vector_type(4)));
typedef unsigned u32x4 __attribute__((ext_vector_type(4)));
constexpr int BM = 256, BK = 64, HALF = 128, HTB = HALF * BK * 2  , STAGE_BYTES = 8 * HTB, NXCD = 8, WGM = 8;

__host__ __device__ __forceinline__ int lds_byte(int r, int c) { const int st = (r >> 4) * 2 + (c >> 5), rr = r & 15, cc = c & 31, ob = rr * 64 + cc * 2; return st * 1024 + (ob ^ (((ob >> 9) & 1) << 5)); }
__host__ __device__ __forceinline__ void stage_rc(int b, int& R, int& C) { const int st = b / 1024, sb = b % 1024, swz = sb ^ (((sb >> 9) & 1) << 5); R = (st >> 1) * 16 + swz / 64; C = (st & 1) * 32 + (swz % 64) / 2; }
__host__ __device__ __forceinline__ int perm32(int rho) { const int n = rho >> 4, i = rho & 15; return 8 * (i >> 2) + 4 * n + (i & 3); }

struct Unit { int pm, pn; };
struct Gemm { const bf16_t* A; const bf16_t* Bt; int M, N, K; const int* rowtab = nullptr; };

struct StaticOrder {
    int nM, nN, nwg, G, c;
    __host__ __device__ void init(int M, int N, int G_, int c_) { nM = M / BM; nN = N / BM; nwg = nM * nN; G = G_; c = c_; }
    __host__ __device__ bool next(int i, Unit& u) const {
        const long L = (long)i * G + c; if (L >= nwg) return false;
        int wgid = (int)L; { const int q = nwg / NXCD, r = nwg % NXCD, xcd = wgid % NXCD, off = wgid / NXCD; wgid = (xcd < r ? xcd * (q + 1) : r * (q + 1) + (xcd - r) * q) + off; }
        const int nig = WGM * nN, gid = wgid / nig, fm = gid * WGM, gsz = (nM - fm) < WGM ? (nM - fm) : WGM;
        u.pm = fm + ((wgid % nig) % gsz); u.pn = (wgid % nig) / gsz; return true;
    }
    __device__ __forceinline__ void a_ready(const Unit&) const {}
    __device__ __forceinline__ void done(const Unit&) const {}
};

__device__ __forceinline__ unsigned cvt_pk_bf16(float lo, float hi) { unsigned r; asm volatile("v_cvt_pk_bf16_f32 %0, %1, %2" : "=v"(r) : "v"(lo), "v"(hi)); return r; }
typedef float f32x2 __attribute__((ext_vector_type(2)));
__device__ __forceinline__ f32x2 gelu_pk(f32x2 v) {
    const f32x2 av = __builtin_elementwise_abs(v), d = av * 0.2316418882f + 1.0f;
    f32x2 t; t.x = __builtin_amdgcn_rcpf(d.x); t.y = __builtin_amdgcn_rcpf(d.y);
    f32x2 q = t * 0.5307027145f + (-0.7265760135f); q = q * t + 0.7107068705f; q = q * t + (-0.142248368f); q = q * t + 0.127414796f; q = q * t;
    const f32x2 s = (v * v) * (-0.72134752044f);
    f32x2 e; e.x = __builtin_amdgcn_exp2f(s.x); e.y = __builtin_amdgcn_exp2f(s.y);
    const f32x2 m = v * (q * e), r = v - m;
    f32x2 o; o.x = v.x < 0.f ? m.x : r.x; o.y = v.y < 0.f ? m.y : r.y; return o;
}

template <int ACT  > struct EpiBf16 {
    static constexpr bool PERM = true, AFTER_DRAIN = false; static_assert(ACT == 0 || ACT == 1, "EpiBf16: ACT is 0 (none) or 1 (gelu_pk)");
    bf16_t* O; int ldc; const float* bias; int split_cols; size_t split_stride; float scale0;
    __device__ __forceinline__ void operator()(const f32x4 (&acc)[2][2][4][2], const Unit& u, int wr, int wc, int fr, int fq) const {
        const int row0 = u.pm * BM + wr * 64 + fr; int colt = u.pn * BM; bf16_t* base = O;
        float sc = 1.f; if (split_cols) { const int t = colt / split_cols; base += (size_t)t * split_stride; colt -= t * split_cols; if (t == 0) sc = scale0; }
        const int col0 = colt + wc * 32 + 8 * fq, bcol0 = u.pn * BM + wc * 32 + 8 * fq;
        f32x4 bv[2][2];
#pragma unroll
        for (int bj = 0; bj < 2; ++bj)
#pragma unroll
            for (int n = 0; n < 2; ++n) bv[bj][n] = bias ? *(const f32x4*)(bias + bcol0 + bj * HALF + 4 * n) : (f32x4){0.f, 0.f, 0.f, 0.f};
#pragma unroll
        for (int ai = 0; ai < 2; ++ai)
#pragma unroll
            for (int m = 0; m < 4; ++m) { bf16_t* rowp = base + (size_t)(row0 + ai * HALF + m * 16) * ldc + col0;
#pragma unroll
                for (int bj = 0; bj < 2; ++bj) { f32x4 v0 = acc[ai][bj][m][0] + bv[bj][0], v1 = acc[ai][bj][m][1] + bv[bj][1];
                    if (ACT == 1) { f32x2 a = gelu_pk((f32x2){v0[0], v0[1]}), b = gelu_pk((f32x2){v0[2], v0[3]}), c = gelu_pk((f32x2){v1[0], v1[1]}), d = gelu_pk((f32x2){v1[2], v1[3]});
                        v0 = (f32x4){a.x, a.y, b.x, b.y}; v1 = (f32x4){c.x, c.y, d.x, d.y}; }
                    v0 = v0 * sc; v1 = v1 * sc; u32x4 w; w.x = cvt_pk_bf16(v0[0], v0[1]); w.y = cvt_pk_bf16(v0[2], v0[3]); w.z = cvt_pk_bf16(v1[0], v1[1]); w.w = cvt_pk_bf16(v1[2], v1[3]);
                    *(u32x4*)(rowp + bj * HALF) = w; } }
    }
};

struct EpiF32 {
    static constexpr bool PERM = false, AFTER_DRAIN = false;
    float* C; int ldc;
    __device__ __forceinline__ void operator()(const f32x4 (&acc)[2][2][4][2], const Unit& u, int wr, int wc, int fr, int fq) const {
        const int row0 = u.pm * BM + wr * 64 + fr, col0 = u.pn * BM + wc * 32 + 4 * fq;
#pragma unroll
        for (int ai = 0; ai < 2; ++ai)
#pragma unroll
            for (int m = 0; m < 4; ++m) { float* rowp = C + (size_t)(row0 + ai * HALF + m * 16) * ldc + col0;
#pragma unroll
                for (int bj = 0; bj < 2; ++bj)
#pragma unroll
                    for (int n = 0; n < 2; ++n) *(f32x4*)(rowp + bj * HALF + n * 16) = acc[ai][bj][m][n]; }
    }
};
__device__ __forceinline__ float fast_sigmoid(float x) { return __builtin_amdgcn_rcpf(1.0f + __builtin_amdgcn_exp2f(-1.4426950408889634f * x)); }
struct EpiSwiGLU {
    static constexpr bool PERM = true, AFTER_DRAIN = false;
    bf16_t* O; int ldo;
    __device__ __forceinline__ void operator()(const f32x4 (&acc)[2][2][4][2], const Unit& u, int wr, int wc, int fr, int fq) const {
        const int row0 = u.pm * BM + wr * 64 + fr, col0 = (u.pn & 1) * HALF + wc * 32 + 8 * fq;
#pragma unroll
        for (int ai = 0; ai < 2; ++ai)
#pragma unroll
            for (int m = 0; m < 4; ++m) {
                bf16_t* rowp = O + (size_t)(row0 + ai * HALF + m * 16) * ldo + col0;
                const f32x4 g0 = acc[ai][0][m][0], g1 = acc[ai][0][m][1], u0 = acc[ai][1][m][0], u1 = acc[ai][1][m][1];
                float r[8];
#pragma unroll
                for (int i = 0; i < 4; ++i) { r[i] = g0[i] * fast_sigmoid(g0[i]) * u0[i]; r[4 + i] = g1[i] * fast_sigmoid(g1[i]) * u1[i]; }
                u32x4 w; w.x = cvt_pk_bf16(r[0], r[1]); w.y = cvt_pk_bf16(r[2], r[3]); w.z = cvt_pk_bf16(r[4], r[5]); w.w = cvt_pk_bf16(r[6], r[7]);
                *(u32x4*)rowp = w;
            }
    }
};
struct EpiScatter {
    static constexpr bool PERM = true, AFTER_DRAIN = false;
    const int* slotw; bf16_t* Y; int ldy;
    __device__ __forceinline__ void operator()(const f32x4 (&acc)[2][2][4][2], const Unit& u, int wr, int wc, int fr, int fq) const {
        int t2 = threadIdx.x; asm volatile("" : "+v"(t2));
        const int fr2 = t2 & 15, fq2 = (t2 >> 4) & 3, wc2 = (t2 >> 6) & 3, wr2 = (t2 >> 8) & 1;
        const int col0 = (u.pn & 3) * BM + wc2 * 32 + 8 * fq2;
        const int rbase = u.pm * BM + wr2 * 64 + fr2;
        typedef int i32x2 __attribute__((ext_vector_type(2)));
        i32x2 rec[2][4];
#pragma unroll
        for (int ai = 0; ai < 2; ++ai)
#pragma unroll
            for (int m = 0; m < 4; ++m) rec[ai][m] = *(const i32x2*)(slotw + 2 * (size_t)(rbase + ai * HALF + m * 16));
#pragma unroll
        for (int ai = 0; ai < 2; ++ai)
#pragma unroll
            for (int m = 0; m < 4; ++m) {
                const int aid = rec[ai][m].x;
                if (aid >= 0) {
                    const int wbits = rec[ai][m].y;
                    const float w = __int_as_float(wbits);
                    unsigned char* rowp = (unsigned char*)Y + (size_t)aid * ldy + col0;
#pragma unroll
                    for (int bj = 0; bj < 2; ++bj) {
                        f32x4 v0 = acc[ai][bj][m][0] * w, v1 = acc[ai][bj][m][1] * w;
#pragma unroll
                        for (int i = 0; i < 4; ++i) { v0[i] = __builtin_amdgcn_fmed3f(v0[i], -448.0f, 448.0f); v1[i] = __builtin_amdgcn_fmed3f(v1[i], -448.0f, 448.0f); }
                        int lo = 0, hi = 0;
                        lo = __builtin_amdgcn_cvt_pk_fp8_f32(v0[0], v0[1], lo, false); lo = __builtin_amdgcn_cvt_pk_fp8_f32(v0[2], v0[3], lo, true);
                        hi = __builtin_amdgcn_cvt_pk_fp8_f32(v1[0], v1[1], hi, false); hi = __builtin_amdgcn_cvt_pk_fp8_f32(v1[2], v1[3], hi, true);
                        typedef int i32x2s __attribute__((ext_vector_type(2)));
                        *(i32x2s*)(rowp + bj * HALF) = (i32x2s){lo, hi};
                    }
                }
            }
    }
};
struct ExpertOrder {
    const int* uexp; int NU, npn, G, c;
    __device__ __forceinline__ bool next(int i, Unit& u) const {
        const int L = i * G + c; if (L >= NU * npn) return false;
        const int uu = L / npn, pl = L % npn;
        u.pm = uu; u.pn = __builtin_amdgcn_readfirstlane(uexp[uu]) * npn + pl; return true;
    }
    __device__ __forceinline__ void a_ready(const Unit&) const {}
    __device__ __forceinline__ void done(const Unit&) const {}
};
struct EpiRouter {
    static constexpr bool PERM = true, AFTER_DRAIN = false;
    float* P0; bf16_t* P1; bf16_t* P2; int TP;
    __device__ __forceinline__ void operator()(const f32x4 (&acc)[2][2][4][2], const Unit& u, int wr, int wc, int fr, int fq) const {
        const bool lo_rows = u.pm >= TP; const int pmr = lo_rows ? u.pm - TP : u.pm;
        if (lo_rows && u.pn == 1) return;
        const int row0 = pmr * BM + wr * 64 + fr, col0 = wc * 32 + 8 * fq;
#pragma unroll
        for (int ai = 0; ai < 2; ++ai)
#pragma unroll
            for (int m = 0; m < 4; ++m) {
                const size_t off = (size_t)(row0 + ai * HALF + m * 16) * 256 + col0;
#pragma unroll
                for (int bj = 0; bj < 2; ++bj) {
                    const f32x4 v0 = acc[ai][bj][m][0], v1 = acc[ai][bj][m][1];
                    if (!lo_rows && u.pn == 0) { *(f32x4*)(P0 + off + bj * HALF) = v0; *(f32x4*)(P0 + off + bj * HALF + 4) = v1; }
                    else { u32x4 w; w.x = cvt_pk_bf16(v0[0], v0[1]); w.y = cvt_pk_bf16(v0[2], v0[3]); w.z = cvt_pk_bf16(v1[0], v1[1]); w.w = cvt_pk_bf16(v1[2], v1[3]);
                           *(u32x4*)((lo_rows ? P2 : P1) + off + bj * HALF) = w; }
                }
            }
    }
};
struct S5Order {
    int NUNITS, npn, G, c;
    __device__ __forceinline__ bool next(int i, Unit& u) const {
        const int L = i * G + c; if (L >= NUNITS) return false;
        u.pm = L / npn; u.pn = (u.pm >> 2) * npn + L % npn; return true;
    }
    __device__ __forceinline__ void a_ready(const Unit&) const {}
    __device__ __forceinline__ void done(const Unit&) const {}
};
struct EpiS5E {
    static constexpr bool PERM = false, AFTER_DRAIN = false;
    float* E;
    __device__ __forceinline__ void operator()(const f32x4 (&acc)[2][2][4][2], const Unit& u, int wr, int wc, int fr, int fq) const {
        const int row0 = u.pm * BM + wr * 64 + fr, col0 = wc * 32 + 4 * fq;
#pragma unroll
        for (int ai = 0; ai < 2; ++ai)
#pragma unroll
            for (int m = 0; m < 4; ++m) { float* rowp = E + (size_t)(row0 + ai * HALF + m * 16) * 128 + col0;
#pragma unroll
                for (int n = 0; n < 2; ++n) *(f32x4*)(rowp + n * 16) = acc[ai][0][m][n]; }
    }
};
struct EpiS5Out {
    static constexpr bool PERM = true, AFTER_DRAIN = false;
    bf16_t* Y;
    __device__ __forceinline__ void operator()(const f32x4 (&acc)[2][2][4][2], const Unit& u, int wr, int wc, int fr, int fq) const {
        const int g = u.pm >> 2;
#pragma unroll
        for (int ai = 0; ai < 2; ++ai)
#pragma unroll
            for (int m = 0; m < 4; ++m) {
                const int r = (u.pm & 3) * BM + ai * HALF + wr * 64 + m * 16 + fr, b = r >> 8, chunk = r & 255;
#pragma unroll
                for (int bj = 0; bj < 2; ++bj) {
                    const int colg = (u.pn & 1) * BM + bj * HALF + wc * 32 + 8 * fq, t = colg >> 4, c0 = colg & 15;
                    const f32x4 v0 = acc[ai][bj][m][0], v1 = acc[ai][bj][m][1];
                    float x[8] = {v0[0], v0[1], v0[2], v0[3], v1[0], v1[1], v1[2], v1[3]};
#pragma unroll
                    for (int i = 0; i < 8; ++i) { const float z = x[i]; x[i] = z * fast_sigmoid(1.5957691216057308f * (z + 0.044715f * z * z * z)); }
                    u32x4 w; w.x = cvt_pk_bf16(x[0], x[1]); w.y = cvt_pk_bf16(x[2], x[3]); w.z = cvt_pk_bf16(x[4], x[5]); w.w = cvt_pk_bf16(x[6], x[7]);
                    *(u32x4*)(Y + ((size_t)(b * 8192 + chunk * 32 + t)) * 512 + g * 16 + c0) = w;
                }
            }
    }
};
struct EpiLora {
    static constexpr bool PERM = true, AFTER_DRAIN = false;
    const float* w0; const float* a0; const float* k_a; float* W; const bf16_t* Kp; bf16_t* Kf; const bf16_t* A; bf16_t* B; bf16_t* Gt;
    __device__ __forceinline__ void operator()(const f32x4 (&acc)[2][2][4][2], const Unit& u, int wr, int wc, int fr, int fq) const {
        const int seg = u.pn >> 1;
#pragma unroll
        for (int bj = 0; bj < 2; ++bj) {
            const int nn = (u.pn & 1) * BM + bj * HALF + wc * 32 + 8 * fq;
            float p0[8], p1[8];
            if (seg == 0) { const f32x4 a = *(const f32x4*)(w0 + nn), b = *(const f32x4*)(w0 + nn + 4); p0[0] = a[0]; p0[1] = a[1]; p0[2] = a[2]; p0[3] = a[3]; p0[4] = b[0]; p0[5] = b[1]; p0[6] = b[2]; p0[7] = b[3]; }
            else if (seg == 1) { const f32x4 a = *(const f32x4*)(a0 + nn), b = *(const f32x4*)(a0 + nn + 4), cc = *(const f32x4*)(k_a + nn), d = *(const f32x4*)(k_a + nn + 4);
                p0[0] = a[0]; p0[1] = a[1]; p0[2] = a[2]; p0[3] = a[3]; p0[4] = b[0]; p0[5] = b[1]; p0[6] = b[2]; p0[7] = b[3];
                p1[0] = cc[0]; p1[1] = cc[1]; p1[2] = cc[2]; p1[3] = cc[3]; p1[4] = d[0]; p1[5] = d[1]; p1[6] = d[2]; p1[7] = d[3]; }
#pragma unroll
            for (int ai = 0; ai < 2; ++ai)
#pragma unroll
                for (int m = 0; m < 4; ++m) {
                    const size_t off = (size_t)(u.pm * BM + ai * HALF + wr * 64 + m * 16 + fr) * 512 + nn;
                    const f32x4 v0 = acc[ai][bj][m][0], v1 = acc[ai][bj][m][1];
                    const float x[8] = {v0[0], v0[1], v0[2], v0[3], v1[0], v1[1], v1[2], v1[3]};
                    if (seg == 0) {
                        float o[8];
#pragma unroll
                        for (int i = 0; i < 8; ++i) { const float wa = p0[i] + x[i];
                            o[i] = __builtin_amdgcn_exp2f(-0.8750387749145276f * fast_sigmoid(wa)); }
                        *(f32x4*)(W + off) = (f32x4){o[0], o[1], o[2], o[3]}; *(f32x4*)(W + off + 4) = (f32x4){o[4], o[5], o[6], o[7]};
                    } else if (seg == 1) {
                        const u32x4 kv = *(const u32x4*)(Kp + off), av = *(const u32x4*)(A + off);
                        const float k[8] = {__builtin_bit_cast(float, kv.x << 16), __builtin_bit_cast(float, kv.x & 0xffff0000u), __builtin_bit_cast(float, kv.y << 16), __builtin_bit_cast(float, kv.y & 0xffff0000u),
                                            __builtin_bit_cast(float, kv.z << 16), __builtin_bit_cast(float, kv.z & 0xffff0000u), __builtin_bit_cast(float, kv.w << 16), __builtin_bit_cast(float, kv.w & 0xffff0000u)};
                        const float a[8] = {__builtin_bit_cast(float, av.x << 16), __builtin_bit_cast(float, av.x & 0xffff0000u), __builtin_bit_cast(float, av.y << 16), __builtin_bit_cast(float, av.y & 0xffff0000u),
                                            __builtin_bit_cast(float, av.z << 16), __builtin_bit_cast(float, av.z & 0xffff0000u), __builtin_bit_cast(float, av.w << 16), __builtin_bit_cast(float, av.w & 0xffff0000u)};
                        float kf[8], bo[8];
#pragma unroll
                        for (int i = 0; i < 8; ++i) { const float ic = fast_sigmoid(p0[i] + x[i]); kf[i] = k[i] * (1.0f + (ic - 1.0f) * p1[i]); bo[i] = -a[i] * ic; }
                        u32x4 w; w.x = cvt_pk_bf16(kf[0], kf[1]); w.y = cvt_pk_bf16(kf[2], kf[3]); w.z = cvt_pk_bf16(kf[4], kf[5]); w.w = cvt_pk_bf16(kf[6], kf[7]);
                        *(u32x4*)(Kf + off) = w;
                        w.x = cvt_pk_bf16(bo[0], bo[1]); w.y = cvt_pk_bf16(bo[2], bo[3]); w.z = cvt_pk_bf16(bo[4], bo[5]); w.w = cvt_pk_bf16(bo[6], bo[7]);
                        *(u32x4*)(B + off) = w;
                    } else {
                        u32x4 w; w.x = cvt_pk_bf16(x[0], x[1]); w.y = cvt_pk_bf16(x[2], x[3]); w.z = cvt_pk_bf16(x[4], x[5]); w.w = cvt_pk_bf16(x[6], x[7]);
                        *(u32x4*)(Gt + off) = w;
                    }
                }
        }
    }
};
struct EpiGLU {
    static constexpr bool PERM = true, AFTER_DRAIN = false;
    const bf16_t* Y; int ldy; const float* bias; bf16_t* O; int ldo; int ocol0;
    __device__ __forceinline__ void operator()(const f32x4 (&acc)[2][2][4][2], const Unit& u, int wr, int wc, int fr, int fq) const {
        const int row0 = u.pm * BM + wr * 64 + fr, col0 = u.pn * BM + wc * 32 + 8 * fq;
#pragma unroll
        for (int bj = 0; bj < 2; ++bj) {
            const f32x4 b0 = *(const f32x4*)(bias + col0 + bj * HALF), b1 = *(const f32x4*)(bias + col0 + bj * HALF + 4);
#pragma unroll
            for (int ai = 0; ai < 2; ++ai)
#pragma unroll
                for (int m = 0; m < 4; ++m) {
                    const size_t row = (size_t)(row0 + ai * HALF + m * 16);
                    const u32x4 yv = *(const u32x4*)(Y + row * ldy + col0 + bj * HALF);
                    const f32x4 z0 = acc[ai][bj][m][0] + b0, z1 = acc[ai][bj][m][1] + b1;
                    float y[8] = {__builtin_bit_cast(float, yv.x << 16), __builtin_bit_cast(float, yv.x & 0xffff0000u), __builtin_bit_cast(float, yv.y << 16), __builtin_bit_cast(float, yv.y & 0xffff0000u),
                                  __builtin_bit_cast(float, yv.z << 16), __builtin_bit_cast(float, yv.z & 0xffff0000u), __builtin_bit_cast(float, yv.w << 16), __builtin_bit_cast(float, yv.w & 0xffff0000u)};
                    float r[8];
#pragma unroll
                    for (int i = 0; i < 4; ++i) { r[i] = y[i] * fast_sigmoid(z0[i]); r[4 + i] = y[4 + i] * fast_sigmoid(z1[i]); }
                    u32x4 w; w.x = cvt_pk_bf16(r[0], r[1]); w.y = cvt_pk_bf16(r[2], r[3]); w.z = cvt_pk_bf16(r[4], r[5]); w.w = cvt_pk_bf16(r[6], r[7]);
                    *(u32x4*)(O + row * ldo + ocol0 + col0 + bj * HALF) = w;
                }
        }
    }
};
template <class Epi, class Sched, bool ALIGN_EPI = false, bool SP2 = false, bool GATHER = false>
__device__ __forceinline__ void gemm_phase(PG8_LAS unsigned char* lds, const Gemm g, const Sched& S, const Epi& E) {
    int tid_ = threadIdx.x; asm volatile("" : "+v"(tid_));
    const int tid = tid_, wid = __builtin_amdgcn_readfirstlane(tid >> 6), lane = tid & 63, wr = wid >> 2, wc = wid & 3, fr = lane & 15, fq = lane >> 4;
    const int K = g.K, nt = K / BK;
    unsigned voffA[2], voffB[2];
#pragma unroll
    for (int i = 0; i < 2; ++i) { int R, C; stage_rc(tid * 16 + i * 8192, R, C); const int Rb = Epi::PERM ? ((R & ~31) + perm32(R & 31)) : R;
        voffA[i] = (unsigned)(R * K + C) * 2u; voffB[i] = (unsigned)(Rb * K + C) * 2u; }
    const size_t kstep = (size_t)(BK * 2);
    const size_t hstep = (size_t)HALF * K * 2;
    const size_t tstep = 2 * hstep;
    const unsigned ldsw = (unsigned)wid * 1024u;
    const int aoff = lds_byte(wr * 64 + fr, fq * 8), boff = lds_byte(wc * 32 + fr, fq * 8);
#define PG8_SA(b, h) (((b) * 2 + (h)) * HTB)
#define PG8_SB(b, h) ((4 + (b) * 2 + (h)) * HTB)
#define PG8_STAGE(bufoff, gbase, voff) do { _Pragma("unroll") for (int _i = 0; _i < 2; ++_i) \
        __builtin_amdgcn_global_load_lds((const unsigned*)((const char*)(gbase) + (voff)[_i]), (PG8_LAS unsigned*)(lds + (bufoff) + ldsw + _i * 8192), 16, 0, 0); } while (0)
#define PG8_STAGE_A(bufoff, kptr, h, NEXTSEL) do { if constexpr (GATHER) { const unsigned _p = (NEXTSEL) ? gnxt[h] : gcur[h]; const unsigned _v[2] = { (_p & 0xffffu) * (unsigned)(2 * K) + gC2, (_p >> 16) * (unsigned)(2 * K) + gC2 }; PG8_STAGE(bufoff, kptr, _v); } \
        else { PG8_STAGE(bufoff, (kptr) + (h) * hstep, voffA); } } while (0)
#define PG8_LDA(dst, b, h) do { _Pragma("unroll") for (int m = 0; m < 4; ++m) _Pragma("unroll") for (int k = 0; k < 2; ++k) dst[m][k] = *(const PG8_LAS bf16x8*)(lds + PG8_SA(b, h) + aoff + m * 2048 + k * 1024); } while (0)
#define PG8_LDB(dst, b, h) do { _Pragma("unroll") for (int n = 0; n < 2; ++n) _Pragma("unroll") for (int k = 0; k < 2; ++k) dst[n][k] = *(const PG8_LAS bf16x8*)(lds + PG8_SB(b, h) + boff + n * 2048 + k * 1024); } while (0)
#define PG8_MMA(ai, bj, At, Bt) do { __builtin_amdgcn_s_setprio(1); _Pragma("unroll") for (int m = 0; m < 4; ++m) _Pragma("unroll") for (int n = 0; n < 2; ++n) _Pragma("unroll") for (int k = 0; k < 2; ++k) \
        acc[ai][bj][m][n] = __builtin_amdgcn_mfma_f32_16x16x32_bf16(Bt[n][k], At[m][k], acc[ai][bj][m][n], 0, 0, 0); __builtin_amdgcn_s_setprio(0); } while (0)
#define PG8_WAIT_V(n) asm volatile("s_waitcnt vmcnt(" #n ")" ::: "memory")
#define PG8_WAIT_L(n) asm volatile("s_waitcnt lgkmcnt(" #n ")" ::: "memory")
#define PG8_BAR __builtin_amdgcn_s_barrier()
#define PG8_SCHED __builtin_amdgcn_sched_barrier(0)
    unsigned gcur[2], gnxt[2], gC2 = 0;
    if constexpr (GATHER) { int R, C; stage_rc(tid * 16, R, C); gC2 = (unsigned)C * 2u; }
    auto load_gather = [&](int pm, unsigned (&dst)[2]) {
        int R, C; stage_rc(tid * 16, R, C);
#pragma unroll
        for (int h = 0; h < 2; ++h) { int a0 = g.rowtab[pm * BM + h * HALF + R], a1 = g.rowtab[pm * BM + h * HALF + R + 64]; a0 = a0 < 0 ? 0 : a0; a1 = a1 < 0 ? 0 : a1; dst[h] = (unsigned)(a0 >> 3) | ((unsigned)(a1 >> 3) << 16); }
    };
    Unit cur, nxt; int ui = 0;
    if (!S.next(0, cur)) return;
    f32x4 acc[2][2][4][2];
#pragma unroll
    for (int a = 0; a < 2; ++a)
#pragma unroll
        for (int b = 0; b < 2; ++b)
#pragma unroll
            for (int m = 0; m < 4; ++m)
#pragma unroll
                for (int n = 0; n < 2; ++n) acc[a][b][m][n] = (f32x4){0.f, 0.f, 0.f, 0.f};
    bf16x8 At[4][2], B0[2][2], B1[2][2];
    const char* cA = (const char*)g.A + (GATHER ? (size_t)0 : (size_t)cur.pm * tstep); const char* cB = (const char*)g.Bt + (size_t)cur.pn * tstep;
    if constexpr (GATHER) { load_gather(cur.pm, gcur); }
    S.a_ready(cur);
    if constexpr (SP2) {
        PG8_STAGE(PG8_SB(0, 0), cB, voffB); PG8_STAGE(PG8_SB(0, 1), cB + hstep, voffB); PG8_STAGE_A(PG8_SA(0, 0), cA, 0, false); PG8_STAGE_A(PG8_SA(0, 1), cA, 1, false);
        if (wr == 1) PG8_BAR;
        PG8_WAIT_V(2); PG8_BAR;
        PG8_STAGE(PG8_SB(1, 0), cB + kstep, voffB); PG8_STAGE_A(PG8_SA(1, 0), cA + kstep, 0, false); PG8_STAGE(PG8_SB(1, 1), cB + hstep + kstep, voffB);
        PG8_WAIT_V(6); PG8_BAR;
    } else {
        PG8_STAGE(PG8_SB(0, 0), cB, voffB); PG8_STAGE_A(PG8_SA(0, 0), cA, 0, false); PG8_STAGE(PG8_SB(0, 1), cB + hstep, voffB); PG8_STAGE_A(PG8_SA(0, 1), cA, 1, false);
        if (wr == 1) PG8_BAR;
        PG8_WAIT_V(4); PG8_BAR;
        PG8_STAGE(PG8_SB(1, 0), cB + kstep, voffB); PG8_STAGE_A(PG8_SA(1, 0), cA + kstep, 0, false); PG8_STAGE(PG8_SB(1, 1), cB + hstep + kstep, voffB);
        PG8_WAIT_V(6); PG8_BAR;
    }
    for (;;) {
        const bool has_next = S.next(ui + 1, nxt);
        const char* nA = (has_next && !GATHER) ? (const char*)g.A + (size_t)nxt.pm * tstep : cA; const char* nB = has_next ? (const char*)g.Bt + (size_t)nxt.pn * tstep : cB;
        if constexpr (GATHER) { if (has_next) load_gather(nxt.pm, gnxt); else {
#pragma unroll
            for (int h = 0; h < 2; ++h) { gnxt[h] = gcur[h]; } } }
        for (int t = 0; t < nt; t += 2) {
            const bool last = (t == nt - 2);
            const char* a1 = cA + (size_t)(t + 1) * kstep;
            const char* a2 = last ? nA : cA + (size_t)(t + 2) * kstep; const char* b2 = last ? nB : cB + (size_t)(t + 2) * kstep;
            const char* a3 = a2 + kstep; const char* b3 = b2 + kstep;
            if (last && has_next) S.a_ready(nxt);
            if constexpr (SP2) {
            PG8_LDB(B0, 0, 0); PG8_LDB(B1, 0, 1); PG8_SCHED; PG8_LDA(At, 0, 0); PG8_STAGE_A(PG8_SA(1, 1), a1, 1, false);
            PG8_WAIT_V(8); PG8_WAIT_L(0); PG8_BAR; PG8_MMA(0, 0, At, B0); PG8_MMA(0, 1, At, B1); PG8_BAR; PG8_SCHED;
            PG8_LDA(At, 0, 1); PG8_STAGE(PG8_SB(0, 0), b2, voffB); PG8_STAGE(PG8_SB(0, 1), b2 + hstep, voffB); PG8_STAGE_A(PG8_SA(0, 0), a2, 0, last);
            PG8_WAIT_V(8); PG8_WAIT_L(0); PG8_BAR; PG8_MMA(1, 0, At, B0); PG8_MMA(1, 1, At, B1); PG8_BAR; PG8_SCHED;
            PG8_LDB(B0, 1, 0); PG8_LDB(B1, 1, 1); PG8_SCHED; PG8_LDA(At, 1, 0); PG8_STAGE_A(PG8_SA(0, 1), a2, 1, last);
            PG8_WAIT_V(8); PG8_WAIT_L(0); PG8_BAR; PG8_MMA(0, 0, At, B0); PG8_MMA(0, 1, At, B1); PG8_BAR; PG8_SCHED;
            PG8_LDA(At, 1, 1); PG8_STAGE(PG8_SB(1, 0), b3, voffB); PG8_STAGE(PG8_SB(1, 1), b3 + hstep, voffB); PG8_STAGE_A(PG8_SA(1, 0), a3, 0, last);
            PG8_WAIT_V(8); PG8_WAIT_L(0); PG8_BAR; PG8_MMA(1, 0, At, B0); PG8_MMA(1, 1, At, B1); PG8_BAR; PG8_SCHED;
            } else {
            PG8_LDB(B0, 0, 0); PG8_SCHED; PG8_LDA(At, 0, 0); PG8_STAGE_A(PG8_SA(1, 1), a1, 1, false);
            PG8_WAIT_L(8); PG8_BAR; PG8_WAIT_L(0); PG8_MMA(0, 0, At, B0); PG8_BAR; PG8_SCHED;
            PG8_LDB(B1, 0, 1); PG8_STAGE(PG8_SB(0, 0), b2, voffB);
            PG8_BAR; PG8_WAIT_L(0); PG8_MMA(0, 1, At, B1); PG8_BAR;
            PG8_LDA(At, 0, 1); PG8_STAGE_A(PG8_SA(0, 0), a2, 0, last);
            PG8_BAR; PG8_WAIT_L(0); PG8_MMA(1, 0, At, B0); PG8_BAR; PG8_SCHED;
            PG8_STAGE(PG8_SB(0, 1), b2 + hstep, voffB);
            PG8_WAIT_V(6); PG8_BAR; PG8_MMA(1, 1, At, B1); PG8_BAR;
            PG8_LDB(B0, 1, 0); PG8_SCHED; PG8_LDA(At, 1, 0); PG8_STAGE_A(PG8_SA(0, 1), a2, 1, last);
            PG8_WAIT_L(8); PG8_BAR; PG8_WAIT_L(0); PG8_MMA(0, 0, At, B0); PG8_BAR; PG8_SCHED;
            PG8_LDB(B1, 1, 1); PG8_STAGE(PG8_SB(1, 0), b3, voffB);
            PG8_BAR; PG8_WAIT_L(0); PG8_MMA(0, 1, At, B1); PG8_BAR;
            PG8_LDA(At, 1, 1); PG8_STAGE_A(PG8_SA(1, 0), a3, 0, last);
            PG8_BAR; PG8_WAIT_L(0); PG8_MMA(1, 0, At, B0); PG8_BAR; PG8_SCHED;
            PG8_STAGE(PG8_SB(1, 1), b3 + hstep, voffB);
            PG8_WAIT_V(6); PG8_BAR; PG8_MMA(1, 1, At, B1); PG8_BAR;
            }
        }
        if constexpr (ALIGN_EPI) { if (wr == 0) PG8_BAR; }
        if constexpr (!Epi::AFTER_DRAIN) { E(acc, cur, wr, wc, fr, fq); S.done(cur); }
        if (!has_next) break;
#pragma unroll
        for (int a = 0; a < 2; ++a)
#pragma unroll
            for (int b = 0; b < 2; ++b)
#pragma unroll
                for (int m = 0; m < 4; ++m)
#pragma unroll
                    for (int n = 0; n < 2; ++n) acc[a][b][m][n] = (f32x4){0.f, 0.f, 0.f, 0.f};
        cur = nxt; cA = nA; cB = nB; ++ui;
        if constexpr (GATHER) {
#pragma unroll
            for (int h = 0; h < 2; ++h) { gcur[h] = gnxt[h]; } }
        if constexpr (ALIGN_EPI) { if (wr == 1) PG8_BAR; }
    }
    PG8_WAIT_V(0);
    if constexpr (!ALIGN_EPI) { if (wr == 0) PG8_BAR; }
    PG8_BAR;
    if constexpr (Epi::AFTER_DRAIN) { E.fused(acc, cur, wr, wc, fr, fq, lds, wid, lane); S.done(cur); }
#undef PG8_SA
#undef PG8_SB
#undef PG8_STAGE
#undef PG8_STAGE_A
#undef PG8_LDA
#undef PG8_LDB
#undef PG8_MMA
#undef PG8_WAIT_V
#undef PG8_WAIT_L
#undef PG8_BAR
#undef PG8_SCHED
}
}

typedef unsigned short bf16_t;
__device__ __forceinline__ unsigned f2bf(float f) { unsigned u = __builtin_bit_cast(unsigned, f); return (u + 0x7fffu + ((u >> 16) & 1u)) >> 16; }
__device__ __forceinline__ float bf2f(unsigned h) { return __builtin_bit_cast(float, h << 16); }
__device__ __forceinline__ float wave_sum(float v) {
#pragma unroll
    for (int o = 1; o < 64; o <<= 1) v += __shfl_xor(v, o);
    return v;
}
__device__ __forceinline__ float sigmoidf_(float x) { return 1.0f / (1.0f + expf(-x)); }
__device__ __forceinline__ float siluf_(float x) { return x / (1.0f + expf(-x)); }
__device__ __forceinline__ float softplusf_(float x) { return fmaxf(x, 0.0f) + log1pf(expf(-fabsf(x))); }
__device__ __forceinline__ float geluf_(float x) { const float u = 0.7978845608028654f * (x + 0.044715f * x * x * x); return 0.5f * x * (1.0f + tanhf(u)); }

struct Args { const float* in[39]; float* out; unsigned char* ws; int lo, hi; };

struct Ctx {
    const float* const* in; float* out; unsigned char* ws;
    LAS unsigned char* lds; float* sm;
    int tid, lane, wid, bid, G, dry;
};

__device__ __forceinline__ unsigned pk2(float lo, float hi) { return f2bf(lo) | (f2bf(hi) << 16); }
__device__ __forceinline__ float ldbf(const bf16_t* p) { return bf2f((unsigned)*p); }
typedef unsigned v4u_t __attribute__((ext_vector_type(4)));
typedef unsigned v2u_t __attribute__((ext_vector_type(2)));
__device__ __forceinline__ void st16(void* p, uint4 v) { const v4u_t d = {v.x, v.y, v.z, v.w}; asm volatile("global_store_dwordx4 %0, %1, off\n\ts_nop 1" :: "v"(p), "v"(d) : "memory"); }
__device__ __forceinline__ void st16f(void* p, float4 v) { st16(p, make_uint4(__float_as_uint(v.x), __float_as_uint(v.y), __float_as_uint(v.z), __float_as_uint(v.w))); }
__device__ __forceinline__ void st8(void* p, uint2 v) { const v2u_t d = {v.x, v.y}; asm volatile("global_store_dwordx2 %0, %1, off\n\ts_nop 1" :: "v"(p), "v"(d) : "memory"); }
__device__ __forceinline__ void st4(void* p, unsigned v) { asm volatile("global_store_dword %0, %1, off\n\ts_nop 1" :: "v"(p), "v"(v) : "memory"); }
__device__ __forceinline__ void st2(void* p, unsigned v) { asm volatile("global_store_short %0, %1, off\n\ts_nop 1" :: "v"(p), "v"(v) : "memory"); }
__device__ __forceinline__ float4 ldbf4(const bf16_t* p) { const uint2 v = *(const uint2*)p; return make_float4(bf2f(v.x & 0xffffu), bf2f(v.x >> 16), bf2f(v.y & 0xffffu), bf2f(v.y >> 16)); }

template <int NB, class AF, class BF, class BF2, class EF>
__device__ __forceinline__ void gemm_tile(float* sm, int K, AF af, BF bf, BF2 bf2, EF ef) {
    float* As = sm;
    float* Bs = sm + 16 * 132;
    float* Bs2 = Bs + 16 * 68;
    const int tid = threadIdx.x, ty = tid >> 4, tx = tid & 15;
    const int am = tid >> 2, ak = (tid & 3) * 4;
    const int bt = tid & 255, bk = bt >> 4, bn = (bt & 15) * 4;
    float acc[4][4], acc2[4][4];
#pragma unroll
    for (int i = 0; i < 4; ++i)
#pragma unroll
        for (int j = 0; j < 4; ++j) { acc[i][j] = 0.f; acc2[i][j] = 0.f; }
    float4 av = af(am, ak);
    float4 bv = make_float4(0.f, 0.f, 0.f, 0.f);
    if (tid < 256) bv = bf(bk, bn); else if (NB == 2) bv = bf2(bk, bn);
    for (int k0 = 0; k0 < K; k0 += 16) {
        __syncthreads();
        As[(ak + 0) * 132 + am] = av.x; As[(ak + 1) * 132 + am] = av.y; As[(ak + 2) * 132 + am] = av.z; As[(ak + 3) * 132 + am] = av.w;
        if (tid < 256) *(float4*)&Bs[bk * 68 + bn] = bv; else if (NB == 2) *(float4*)&Bs2[bk * 68 + bn] = bv;
        __syncthreads();
        if (k0 + 16 < K) {
            av = af(am, k0 + 16 + ak);
            if (tid < 256) bv = bf(k0 + 16 + bk, bn); else if (NB == 2) bv = bf2(k0 + 16 + bk, bn);
        }
#pragma unroll
        for (int kk = 0; kk < 16; ++kk) {
            const float4 a = *(const float4*)&As[kk * 132 + ty * 4];
            const float4 b = *(const float4*)&Bs[kk * 68 + tx * 4];
            const float aa[4] = {a.x, a.y, a.z, a.w};
            const float bb[4] = {b.x, b.y, b.z, b.w};
#pragma unroll
            for (int i = 0; i < 4; ++i)
#pragma unroll
                for (int j = 0; j < 4; ++j) acc[i][j] = fmaf(aa[i], bb[j], acc[i][j]);
            if (NB == 2) {
                const float4 b2 = *(const float4*)&Bs2[kk * 68 + tx * 4];
                const float bb2[4] = {b2.x, b2.y, b2.z, b2.w};
#pragma unroll
                for (int i = 0; i < 4; ++i)
#pragma unroll
                    for (int j = 0; j < 4; ++j) acc2[i][j] = fmaf(aa[i], bb2[j], acc2[i][j]);
            }
        }
    }
#pragma unroll
    for (int i = 0; i < 4; ++i)
        ef(ty * 4 + i, tx * 4, make_float4(acc[i][0], acc[i][1], acc[i][2], acc[i][3]), make_float4(acc2[i][0], acc2[i][1], acc2[i][2], acc2[i][3]));
}

__device__ __forceinline__ void transpose_load(const float* W, int N, int nblk, int item, int lane, float (&r)[32]) {
    const int kb = item / nblk, nb = item % nblk, k0 = 64 * kb, n0 = 32 * nb;
#pragma unroll
    for (int i = 0; i < 8; ++i) { const int kk = 8 * i + (lane >> 3); const float4 v = *(const float4*)(W + (size_t)(k0 + kk) * N + n0 + (lane & 7) * 4);
        r[4 * i] = v.x; r[4 * i + 1] = v.y; r[4 * i + 2] = v.z; r[4 * i + 3] = v.w; }
}
template <bool RES, class RM>
__device__ __forceinline__ void transpose_finish(int K, int nblk, bf16_t* WT, RM rowmap, float* scr, int item, int lane, const float (&r)[32]) {
    const int kb = item / nblk, nb = item % nblk, k0 = 64 * kb, n0 = 32 * nb;
#pragma unroll
    for (int i = 0; i < 8; ++i) { const int kk = 8 * i + (lane >> 3), nn = (lane & 7) * 4;
        scr[kk * 33 + nn] = r[4 * i]; scr[kk * 33 + nn + 1] = r[4 * i + 1]; scr[kk * 33 + nn + 2] = r[4 * i + 2]; scr[kk * 33 + nn + 3] = r[4 * i + 3]; }
    asm volatile("s_waitcnt lgkmcnt(0)" ::: "memory");
    const int c = lane & 7;
    const int r0 = rowmap(n0);
#pragma unroll
    for (int j = 0; j < 4; ++j) {
        const int n = (lane >> 3) + 8 * j; const float* s = scr + (8 * c) * 33 + n;
        float v[8];
#pragma unroll
        for (int q = 0; q < 8; ++q) { v[q] = s[q * 33]; if (RES) v[q] = v[q] - bf2f(f2bf(v[q])); }
        uint4 o; o.x = pk2(v[0], v[1]); o.y = pk2(v[2], v[3]); o.z = pk2(v[4], v[5]); o.w = pk2(v[6], v[7]);
        st16(WT + (size_t)(r0 + n) * K + k0 + 8 * c, o);
    }
    asm volatile("s_waitcnt lgkmcnt(0)" ::: "memory");
}
template <bool RES, class RM>
__device__ __forceinline__ void transpose_item(const float* W, int K, int N, bf16_t* WT, RM rowmap, float* scr, int item, int lane) {
    float r[32];
    transpose_load(W, N, N / 32, item, lane, r);
    transpose_finish<RES>(K, N / 32, WT, rowmap, scr, item, lane, r);
}

__device__ __forceinline__ void convert_expert_weights(const Ctx& c, const int lo, const int hi, int first, int stride) {
    float* scr = c.sm + c.wid * (64 * 33);
    float ra[32], rb[32];
    auto src = [&](int it, const float*& W, int& N, int& nblk, int& item) {
        const int e = it / 384, r = it % 384;
        if (r < 128) { W = c.in[33] + (size_t)e * D * EFF; N = EFF; nblk = EFF / 32; item = r; }
        else if (r < 256) { W = c.in[34] + (size_t)e * D * EFF; N = EFF; nblk = EFF / 32; item = r - 128; }
        else { W = c.in[35] + (size_t)e * EFF * D; N = D; nblk = D / 32; item = r - 256; }
    };
    auto fin = [&](int it, const float (&rg)[32]) {
        const int e = it / 384, r = it % 384;
        if (r < 128) transpose_finish<false>(D, EFF / 32, (bf16_t*)(c.ws + WS_WEGU) + (size_t)e * 512 * D, [](int n) { return (n >> 7) * 256 + (n & 127); }, scr, r, c.lane, rg);
        else if (r < 256) transpose_finish<false>(D, EFF / 32, (bf16_t*)(c.ws + WS_WEGU) + (size_t)e * 512 * D, [](int n) { return (n >> 7) * 256 + 128 + (n & 127); }, scr, r - 128, c.lane, rg);
        else transpose_finish<false>(EFF, D / 32, (bf16_t*)(c.ws + WS_WED) + (size_t)e * D * EFF, [](int n) { return n; }, scr, r - 256, c.lane, rg);
    };
    float rc[32];
    auto ld = [&](int it_, float (&rg)[32]) { if (it_ < hi) { const float* W; int N, nblk, item; src(it_, W, N, nblk, item); transpose_load(W, N, nblk, item, c.lane, rg); } };
    int it = lo + first;
    if (it >= hi) return;
    ld(it, ra); ld(it + stride, rb);
    for (;;) {
        ld(it + 2 * stride, rc); fin(it, ra); if (it + stride >= hi) break;
        ld(it + 3 * stride, ra); fin(it + stride, rb); if (it + 2 * stride >= hi) break;
        ld(it + 4 * stride, rb); fin(it + 2 * stride, rc); if (it + 3 * stride >= hi) break;
        it += 3 * stride;
    }
}

__device__ __forceinline__ void phase0(const Ctx& c) {
    const int gt = c.bid * 512 + c.tid, NT = c.G * 512;
    const int gw = c.bid * 8 + c.wid, NW = c.G * 8;
    {
        const float* cc = c.in[1]; const float* w_ada = c.in[2];
        float* modsp = (float*)(c.ws + WS_MODSP);
        for (int task = gw; task < 96 * 16; task += NW) {
            const int cg = task % 96, ks = task / 96, j = cg * 64 + c.lane;
            float a0 = 0.f, a1 = 0.f, a2 = 0.f, a3 = 0.f;
#pragma unroll 4
            for (int k = ks * 64; k < ks * 64 + 64; ++k) {
                const float wv = w_ada[(size_t)k * NMODS + j];
                a0 = fmaf(siluf_(cc[k]), wv, a0); a1 = fmaf(siluf_(cc[D + k]), wv, a1); a2 = fmaf(siluf_(cc[2 * D + k]), wv, a2); a3 = fmaf(siluf_(cc[3 * D + k]), wv, a3);
            }
            modsp[(ks * 4 + 0) * NMODS + j] = a0; modsp[(ks * 4 + 1) * NMODS + j] = a1; modsp[(ks * 4 + 2) * NMODS + j] = a2; modsp[(ks * 4 + 3) * NMODS + j] = a3;
        }
    }
    {
        const float* log_dt = c.in[20]; const float* a_re = c.in[21]; const float* a_im = c.in[22];
        const float* b_re = c.in[23]; const float* b_im = c.in[24];
        float* apow = (float*)(c.ws + WS_APOW); float* bb = (float*)(c.ws + WS_S5BB);
        for (int idx = gt; idx < S5NG * S5P; idx += NT) {
            const int g = idx / S5P, p = idx % S5P;
            const double dt = exp((double)log_dt[g]);
            const double lre = fmin((double)a_re[idx], -1e-4), lim = (double)a_im[idx];
            const double mag = exp(lre * dt), ang = lim * dt;
            const double abr = mag * cos(ang), abi = mag * sin(ang);
            const double den = lre * lre + lim * lim;
            const double nre = abr - 1.0, nim = abi;
            const double qre = (nre * lre + nim * lim) / den, qim = (nim * lre - nre * lim) / den;
            double pr = 1.0, pi = 0.0;
            for (int j = 0; j <= S5L; ++j) {
                apow[((size_t)(g * (S5L + 1) + j) * 64 + p) * 2 + 0] = (float)pr; apow[((size_t)(g * (S5L + 1) + j) * 64 + p) * 2 + 1] = (float)pi;
                const double nr = pr * abr - pi * abi, ni = pr * abi + pi * abr; pr = nr; pi = ni;
            }
            for (int ch = 0; ch < 16; ++ch) {
                const double br = (double)b_re[idx * 16 + ch], bi = (double)b_im[idx * 16 + ch];
                bb[idx * 32 + ch] = (float)(qre * br - qim * bi);
                bb[idx * 32 + 16 + ch] = (float)(qre * bi + qim * br);
            }
        }
    }
    {
        const float* w2 = c.in[11]; const float* a2 = c.in[13]; const float* g2 = c.in[14];
        bf16_t* bt = (bf16_t*)(c.ws + WS_LORA_BT);
        for (int it = gt; it < 1536 * 32; it += NT) {
            const int n = it >> 5, c0 = (it & 31) * 8;
            float v[8];
#pragma unroll
            for (int i = 0; i < 8; ++i) {
                const int col = c0 + i; float x = 0.f;
                if (n < 512) { if (col < 64) x = w2[col * RW + n]; }
                else if (n < 1024) { if (col >= 64 && col < 128) x = a2[(col - 64) * RW + (n - 512)]; }
                else { if (col >= 128) x = g2[(col - 128) * RW + (n - 1024)]; }
                v[i] = x;
            }
            *(uint4*)(bt + (size_t)n * 256 + c0) = make_uint4(pk2(v[0], v[1]), pk2(v[2], v[3]), pk2(v[4], v[5]), pk2(v[6], v[7]));
        }
    }
    float* scr = c.sm + c.wid * (64 * 33);
    constexpr int I_IN = (D / 64) * (NPROJ / 32), I_OUT = (D / 64) * (D / 32), I_GLU = (512 / 64) * (512 / 32), I_SG = (D / 64) * (256 / 32), I_SD = (256 / 64) * (D / 32), I_R = (D / 64) * (256 / 32);
    constexpr int NIT = I_IN + I_OUT + I_GLU + 2 * I_SG + I_SD + 2 * I_R;
    for (int it = gw; it < NIT; it += NW) {
        int r = it;
        if (r < I_IN) { transpose_item<false>(c.in[8], D, NPROJ, (bf16_t*)(c.ws + WS_WIN_T), [](int n) { return n; }, scr, r, c.lane); continue; } r -= I_IN;
        if (r < I_OUT) { transpose_item<false>(c.in[30], D, D, (bf16_t*)(c.ws + WS_WOUT_T), [](int n) { return n; }, scr, r, c.lane); continue; } r -= I_OUT;
        if (r < I_GLU) { transpose_item<false>(c.in[28], 512, 512, (bf16_t*)(c.ws + WS_WGLU_T), [](int n) { return n; }, scr, r, c.lane); continue; } r -= I_GLU;
        if (r < I_SG) { transpose_item<false>(c.in[36], D, 256, (bf16_t*)(c.ws + WS_WSGU_T), [](int n) { return (n >> 7) * 256 + (n & 127); }, scr, r, c.lane); continue; } r -= I_SG;
        if (r < I_SG) { transpose_item<false>(c.in[37], D, 256, (bf16_t*)(c.ws + WS_WSGU_T), [](int n) { return (n >> 7) * 256 + 128 + (n & 127); }, scr, r, c.lane); continue; } r -= I_SG;
        if (r < I_SD) { transpose_item<false>(c.in[38], 256, D, (bf16_t*)(c.ws + WS_WSD_T), [](int n) { return n; }, scr, r, c.lane); continue; } r -= I_SD;
        if (r < I_R) { transpose_item<false>(c.in[31], D, 256, (bf16_t*)(c.ws + WS_WR_T), [](int n) { return n; }, scr, r, c.lane); continue; } r -= I_R;
        transpose_item<true>(c.in[31], D, 256, (bf16_t*)(c.ws + WS_WR_T), [](int n) { return 256 + n; }, scr, r, c.lane);
    }
}

__device__ __forceinline__ void phase1(const Ctx& c) {
    const int gt = c.bid * 512 + c.tid, NT = c.G * 512;
    const int gw = c.bid * 8 + c.wid, NW = c.G * 8;
    const float* modsp = (const float*)(c.ws + WS_MODSP); const float* b_ada = c.in[3]; float* mods = (float*)(c.ws + WS_MODS);
    for (int idx = gt; idx < BATCH * NMODS; idx += NT) {
        const int b = idx / NMODS, j = idx % NMODS;
        float acc = 0.f;
#pragma unroll
        for (int ks = 0; ks < 16; ++ks) acc += modsp[(ks * 4 + b) * NMODS + j];
        mods[idx] = acc + b_ada[j];
    }
    const float* __restrict__ apow = (const float*)(c.ws + WS_APOW); const float* __restrict__ bb = (const float*)(c.ws + WS_S5BB);
    const float* __restrict__ c_re = c.in[25]; const float* __restrict__ c_im = c.in[26];
    float* __restrict__ klag = (float*)(c.ws + WS_KLAG);
    for (int task = gw; task < S5NG * S5L; task += NW) {
        const int g = task / S5L, j = task % S5L, cc = c.lane >> 2, cq = (c.lane & 3) * 4;
        float acc[4] = {0.f, 0.f, 0.f, 0.f};
#pragma unroll 16
        for (int p = 0; p < 64; ++p) {
            const float ar = apow[((size_t)(g * (S5L + 1) + j) * 64 + p) * 2], ai = apow[((size_t)(g * (S5L + 1) + j) * 64 + p) * 2 + 1];
            const float cr = c_re[(g * 16 + cc) * 64 + p], ci = c_im[(g * 16 + cc) * 64 + p];
            const float4 br = *(const float4*)(bb + (size_t)(g * 64 + p) * 32 + cq), bi = *(const float4*)(bb + (size_t)(g * 64 + p) * 32 + 16 + cq);
            const float er = cr * ar - ci * ai, ei = cr * ai + ci * ar;
            acc[0] += er * br.x - ei * bi.x; acc[1] += er * br.y - ei * bi.y; acc[2] += er * br.z - ei * bi.z; acc[3] += er * br.w - ei * bi.w;
        }
        *(float4*)(klag + ((size_t)(g * S5L + j) * 16 + cc) * 16 + cq) = make_float4(acc[0], acc[1], acc[2], acc[3]);
    }
}

__device__ __forceinline__ void phase2(const Ctx& c) {
    const float* x = c.in[0]; const float* g = c.in[4];
    const float* mods = (const float*)(c.ws + WS_MODS);
    bf16_t* xn = (bf16_t*)(c.ws + WS_A);
    const int gw = c.bid * 8 + c.wid, NW = c.G * 8;
    for (int t = gw; t < T; t += NW) {
        const int b = t / SEQ;
        const float4* xr = (const float4*)(x + (size_t)t * D) + c.lane;
        float4 v[4]; float ss = 0.f;
#pragma unroll
        for (int j = 0; j < 4; ++j) { v[j] = xr[64 * j]; ss += v[j].x * v[j].x + v[j].y * v[j].y + v[j].z * v[j].z + v[j].w * v[j].w; }
        const float rstd = rsqrtf(wave_sum(ss) * (1.0f / D) + 1e-6f);
        uint2* o = (uint2*)(xn + (size_t)t * D) + c.lane;
#pragma unroll
        for (int j = 0; j < 4; ++j) {
            const int k = (c.lane + 64 * j) * 4;
            const float4 gg = *(const float4*)(g + k);
            const float4 sh = *(const float4*)(mods + b * NMODS + k);
            const float4 sc = *(const float4*)(mods + b * NMODS + D + k);
            float4 r;
            r.x = v[j].x * rstd * gg.x * (1.f + sc.x) + sh.x; r.y = v[j].y * rstd * gg.y * (1.f + sc.y) + sh.y;
            r.z = v[j].z * rstd * gg.z * (1.f + sc.z) + sh.z; r.w = v[j].w * rstd * gg.w * (1.f + sc.w) + sh.w;
            o[64 * j] = make_uint2(pk2(r.x, r.y), pk2(r.z, r.w));
        }
    }
    const int gt = c.bid * 512 + c.tid, NT = c.G * 512;
    const float* apow = (const float*)(c.ws + WS_APOW); const float* bb = (const float*)(c.ws + WS_S5BB); const float* klag = (const float*)(c.ws + WS_KLAG);
    const float* c_re = c.in[25]; const float* c_im = c.in[26]; const float* dd = c.in[27];
    bf16_t* kmat = (bf16_t*)(c.ws + WS_KMAT); bf16_t* hmat = (bf16_t*)(c.ws + WS_HMAT);
    for (int it = gt; it < S5NG * 512 * 80; it += NT) {
        const int row = it / 80, ch = it % 80, g = row >> 9, t = (row >> 4) & 31, cc = row & 15, col0 = ch * 8;
        float v[8];
        if (col0 < 512) {
            const int s = col0 >> 4, c0 = col0 & 15;
            if (s > t) {
#pragma unroll
                for (int i = 0; i < 8; ++i) v[i] = 0.f;
            } else {
                const float4 k0 = *(const float4*)(klag + ((size_t)(g * S5L + (t - s)) * 16 + cc) * 16 + c0), k1 = *(const float4*)(klag + ((size_t)(g * S5L + (t - s)) * 16 + cc) * 16 + c0 + 4);
                v[0] = k0.x; v[1] = k0.y; v[2] = k0.z; v[3] = k0.w; v[4] = k1.x; v[5] = k1.y; v[6] = k1.z; v[7] = k1.w;
                if (s == t) {
                    const float dv = dd[g * 16 + cc];
#pragma unroll
                    for (int i = 0; i < 8; ++i) if (c0 + i == cc) v[i] += dv;
                }
            }
        } else {
            const int q0 = col0 - 512;
#pragma unroll
            for (int i = 0; i < 8; ++i) {
                const int q = q0 + i, p = q & 63;
                const float ar = apow[((size_t)(g * (S5L + 1) + t + 1) * 64 + p) * 2], ai = apow[((size_t)(g * (S5L + 1) + t + 1) * 64 + p) * 2 + 1];
                const float cr = c_re[(g * 16 + cc) * 64 + p], ci = c_im[(g * 16 + cc) * 64 + p];
                v[i] = (q < 64) ? (cr * ar - ci * ai) : -(cr * ai + ci * ar);
            }
        }
        *(uint4*)(kmat + (size_t)row * 640 + col0) = make_uint4(pk2(v[0], v[1]), pk2(v[2], v[3]), pk2(v[4], v[5]), pk2(v[6], v[7]));
    }
    for (int it = gt; it < S5NG * 256 * 80; it += NT) {
        const int row = it / 80, ch = it % 80, g = row >> 8, q = row & 255, col0 = ch * 8;
        float v[8];
#pragma unroll
        for (int i = 0; i < 8; ++i) v[i] = 0.f;
        if (q < 128 && col0 < 512) {
            const int s = col0 >> 4, c0 = col0 & 15, p = q & 63;
            const float ar = apow[((size_t)(g * (S5L + 1) + (S5L - 1 - s)) * 64 + p) * 2], ai = apow[((size_t)(g * (S5L + 1) + (S5L - 1 - s)) * 64 + p) * 2 + 1];
#pragma unroll
            for (int i = 0; i < 8; ++i) {
                const float br = bb[(size_t)(g * 64 + p) * 32 + c0 + i], bi = bb[(size_t)(g * 64 + p) * 32 + 16 + c0 + i];
                v[i] = (q < 64) ? (ar * br - ai * bi) : (ar * bi + ai * br);
            }
        }
        *(uint4*)(hmat + (size_t)row * 640 + col0) = make_uint4(pk2(v[0], v[1]), pk2(v[2], v[3]), pk2(v[4], v[5]), pk2(v[6], v[7]));
    }
}

__device__ __forceinline__ void phase3(const Ctx& c) {
    pg8::Gemm g{(const bf16_t*)(c.ws + WS_A), (const bf16_t*)(c.ws + WS_WIN_T), T, NPROJ, D};
    pg8::StaticOrder S; S.init(T, NPROJ, c.G, c.bid);
    pg8::EpiBf16<0> E{(bf16_t*)(c.ws + WS_PROJ), NPROJ, nullptr, 0, 0, 1.f};
    pg8::gemm_phase<pg8::EpiBf16<0>, pg8::StaticOrder, true, true>(c.lds, g, S, E);
}

__device__ __forceinline__ void unpack8(const uint4 a, float (&u)[8]) {
    u[0] = bf2f(a.x & 0xffffu); u[1] = bf2f(a.x >> 16); u[2] = bf2f(a.y & 0xffffu); u[3] = bf2f(a.y >> 16);
    u[4] = bf2f(a.z & 0xffffu); u[5] = bf2f(a.z >> 16); u[6] = bf2f(a.w & 0xffffu); u[7] = bf2f(a.w >> 16);
}
__device__ __forceinline__ uint4 pack8(const float (&v)[8]) { return make_uint4(pk2(v[0], v[1]), pk2(v[2], v[3]), pk2(v[4], v[5]), pk2(v[6], v[7])); }
#define DPPU(v, ctrl) ((unsigned)__builtin_amdgcn_mov_dpp((int)(v), (ctrl), 0xf, 0xf, true))
#define DPPF(v, ctrl) __builtin_bit_cast(float, __builtin_amdgcn_mov_dpp(__builtin_bit_cast(int, (v)), (ctrl), 0xf, 0xf, true))
__device__ __forceinline__ float fast_tanh(float x) { return 1.0f - 2.0f * __builtin_amdgcn_rcpf(1.0f + __builtin_amdgcn_exp2f(2.8853900817779268f * x)); }
__device__ __forceinline__ void phase4(const Ctx& c) {
    const bf16_t* proj = (const bf16_t*)(c.ws + WS_PROJ);
    const float* mu = c.in[9]; const float* k_k = c.in[15];
    bf16_t* rw_r = (bf16_t*)(c.ws + WS_RW_R); bf16_t* rw_k = (bf16_t*)(c.ws + WS_RW_K); bf16_t* rw_v = (bf16_t*)(c.ws + WS_RW_V); bf16_t* rw_a = (bf16_t*)(c.ws + WS_RW_A);
    bf16_t* alora = (bf16_t*)((unsigned char*)c.out + OUT_ALORA); bf16_t* ux = (bf16_t*)((unsigned char*)c.out + OUT_UX);
    const int gw = c.bid * 8 + c.wid, NW = c.G * 8, lane = c.lane;
    float mm[4][8], kk8[8];
#pragma unroll
    for (int j = 0; j < 4; ++j) {
        const int cidx = lane + 64 * j, col = (cidx < 224 ? cidx : 0) * 8;
        const float4 m0 = *(const float4*)(mu + col), m1 = *(const float4*)(mu + col + 4);
        mm[j][0] = m0.x; mm[j][1] = m0.y; mm[j][2] = m0.z; mm[j][3] = m0.w; mm[j][4] = m1.x; mm[j][5] = m1.y; mm[j][6] = m1.z; mm[j][7] = m1.w;
    }
    { const float4 k0 = *(const float4*)(k_k + lane * 8), k1 = *(const float4*)(k_k + lane * 8 + 4); kk8[0] = k0.x; kk8[1] = k0.y; kk8[2] = k0.z; kk8[3] = k0.w; kk8[4] = k1.x; kk8[5] = k1.y; kk8[6] = k1.z; kk8[7] = k1.w; }
    constexpr int RUN = 16;
    auto load_row = [&](int t, uint4 (&r)[5]) {
        const bf16_t* pr = proj + (size_t)t * NPROJ;
#pragma unroll
        for (int j = 0; j < 3; ++j) r[j] = *(const uint4*)(pr + (lane + 64 * j) * 8);
        r[3] = (lane < 32) ? *(const uint4*)(pr + (lane + 192) * 8) : make_uint4(0u, 0u, 0u, 0u);
        r[4] = *(const uint4*)(pr + RPROJ + lane * 8);
    };
    for (int t0 = gw * RUN; t0 < T; t0 += NW * RUN) {
        uint4 prev[5], cur[5], nxt[5];
        if (t0 % SEQ == 0) {
#pragma unroll
            for (int j = 0; j < 5; ++j) prev[j] = make_uint4(0u, 0u, 0u, 0u);
        } else load_row(t0 - 1, prev);
        load_row(t0, cur);
#pragma unroll 2
        for (int i = 0; i < RUN; ++i) {
            const int t = t0 + i;
            if (i + 1 < RUN) load_row(t + 1, nxt);
#pragma unroll
            for (int j = 0; j < 4; ++j) {
                const int cidx = lane + 64 * j;
                if (cidx < 224) {
                    const int col = cidx * 8;
                    float p[8], q[8], ps[8];
                    unpack8(cur[j], p); unpack8(prev[j], q);
#pragma unroll
                    for (int i2 = 0; i2 < 8; ++i2) ps[i2] = p[i2] + (q[i2] - p[i2]) * mm[j][i2];
                    if (j == 0) *(uint4*)(rw_r + (size_t)t * RW + col) = pack8(ps);
                    else if (j == 1) {
                        const int cl = col - 512;
                        *(uint4*)(rw_k + (size_t)t * RW + cl) = pack8(ps);
                        float kk[8]; float ss = 0.f;
#pragma unroll
                        for (int i2 = 0; i2 < 8; ++i2) { kk[i2] = ps[i2] * kk8[i2]; ss += kk[i2] * kk[i2]; }
                        ss += DPPF(ss, 0xB1); ss += DPPF(ss, 0x4E); ss += DPPF(ss, 0x141);
                        const float inv = -1.0f / fmaxf(sqrtf(ss), 1e-12f);
#pragma unroll
                        for (int i2 = 0; i2 < 8; ++i2) kk[i2] *= inv;
                        *(uint4*)(rw_a + (size_t)t * RW + cl) = pack8(kk);
                    } else if (j == 2) *(uint4*)(rw_v + (size_t)t * RW + (col - 1024)) = pack8(ps);
                    else {
                        const int cl = col - 1536;
                        float o[8];
#pragma unroll
                        for (int i2 = 0; i2 < 8; ++i2) o[i2] = (cl < 64) ? fast_tanh(ps[i2]) : (cl < 128) ? ps[i2] : pg8::fast_sigmoid(ps[i2]);
                        *(uint4*)(alora + (size_t)t * 256 + cl) = pack8(o);
                    }
                }
            }
            {
                const int g = lane >> 1, hf = lane & 1, b = t / SEQ, sidx = t % S5L, chunk = (t % SEQ) / S5L;
                bf16_t* row = ux + ((size_t)(g * 1024 + b * 256 + chunk)) * 640;
                *(uint4*)(row + sidx * 16 + hf * 8) = cur[4];
                if (sidx < 8) { *(uint4*)(row + 512 + (sidx * 2 + hf) * 8) = make_uint4(0u, 0u, 0u, 0u); }
            }
#pragma unroll
            for (int j = 0; j < 5; ++j) { prev[j] = cur[j]; cur[j] = nxt[j]; }
        }
    }
}

__device__ __forceinline__ void phase5(const Ctx& c) {
    {
        pg8::Gemm g{(const bf16_t*)((unsigned char*)c.out + OUT_ALORA), (const bf16_t*)(c.ws + WS_LORA_BT), T, 1536, 256};
        pg8::StaticOrder S; S.init(T, 1536, c.G, c.bid);
        pg8::EpiLora E{c.in[10], c.in[12], c.in[16], (float*)(c.ws + WS_RW_W), (const bf16_t*)(c.ws + WS_RW_K), (bf16_t*)((unsigned char*)c.out + OUT_KF), (const bf16_t*)(c.ws + WS_RW_A), (bf16_t*)(c.ws + WS_RW_B), (bf16_t*)(c.ws + WS_RW_G)};
        pg8::gemm_phase<pg8::EpiLora, pg8::StaticOrder, true, true>(c.lds, g, S, E);
    }
    __syncthreads();
    {
        pg8::Gemm g{(const bf16_t*)((unsigned char*)c.out + OUT_UX), (const bf16_t*)(c.ws + WS_HMAT), 0, 0, 640};
        pg8::S5Order S{128, 1, c.G, c.bid};
        pg8::EpiS5E E{(float*)((unsigned char*)c.out + OUT_E)};
        pg8::gemm_phase<pg8::EpiS5E, pg8::S5Order, true, true>(c.lds, g, S, E);
    }
}

typedef float f2v __attribute__((ext_vector_type(2)));
__device__ __forceinline__ float dpp_add16(float v) {
    v += __builtin_bit_cast(float, __builtin_amdgcn_mov_dpp(__builtin_bit_cast(int, v), 0xB1, 0xf, 0xf, true));
    v += __builtin_bit_cast(float, __builtin_amdgcn_mov_dpp(__builtin_bit_cast(int, v), 0x4E, 0xf, 0xf, true));
    v += __builtin_bit_cast(float, __builtin_amdgcn_mov_dpp(__builtin_bit_cast(int, v), 0x141, 0xf, 0xf, true));
    v += __builtin_bit_cast(float, __builtin_amdgcn_mov_dpp(__builtin_bit_cast(int, v), 0x140, 0xf, 0xf, true));
    return v;
}
constexpr int RTS = 32;
constexpr int RTILE = 6 * RTS * 64;
typedef short bf16x8_t __attribute__((ext_vector_type(8)));
typedef float f32x4_t __attribute__((ext_vector_type(4)));
#define MFMA16(a, b, c) __builtin_amdgcn_mfma_f32_16x16x32_bf16((a), (b), (c), 0, 0, 0)
constexpr int CL = 64, CLD = 72, CSLOT = 64 * CLD * 2;
constexpr int C_DIAG = 13 * CSLOT, C_DM = C_DIAG + 4096, C_GL = C_DM + 2048, C_SEGP = C_GL + 256;
static_assert(C_SEGP + 2048 <= 131072, "rwkv chunk LDS map");
__device__ __forceinline__ bf16x8_t ldsfrag(LAS const unsigned char* slot, int row, int col) { return *(LAS const bf16x8_t*)(slot + (row * CLD + col) * 2); }
typedef unsigned u32x4_t __attribute__((ext_vector_type(4)));
typedef unsigned u32x2_t __attribute__((ext_vector_type(2)));
__device__ __forceinline__ void lds_st16(LAS unsigned char* p, uint4 v) { *(LAS u32x4_t*)p = (u32x4_t){v.x, v.y, v.z, v.w}; }
__device__ __forceinline__ void lds_st8(LAS unsigned char* p, uint2 v) { *(LAS u32x2_t*)p = (u32x2_t){v.x, v.y}; }
__device__ __forceinline__ uint2 lds_ld8(LAS const unsigned char* p) { const u32x2_t v = *(LAS const u32x2_t*)p; return make_uint2(v.x, v.y); }
__device__ __forceinline__ bf16x8_t zfrag() { return (bf16x8_t){0, 0, 0, 0, 0, 0, 0, 0}; }
__device__ __forceinline__ uint2 pack4(float a, float b, float c, float d) { return make_uint2(pk2(a, b), pk2(c, d)); }
__device__ __forceinline__ float wave_sum_u(float v) {
    v = dpp_add16(v);
    return __builtin_bit_cast(float, __builtin_amdgcn_readlane(__builtin_bit_cast(int, v), 0)) + __builtin_bit_cast(float, __builtin_amdgcn_readlane(__builtin_bit_cast(int, v), 16))
         + __builtin_bit_cast(float, __builtin_amdgcn_readlane(__builtin_bit_cast(int, v), 32)) + __builtin_bit_cast(float, __builtin_amdgcn_readlane(__builtin_bit_cast(int, v), 48));
}

__device__ __forceinline__ void rwkv_phaseA(const Ctx& c, const int GA) {
    const float* __restrict__ rw_w = (const float*)(c.ws + WS_RW_W);
    const bf16_t* __restrict__ rw_r = (const bf16_t*)(c.ws + WS_RW_R); const bf16_t* __restrict__ rw_k = (const bf16_t*)((const unsigned char*)c.out + OUT_KF); const bf16_t* __restrict__ rw_v = (const bf16_t*)(c.ws + WS_RW_V);
    const bf16_t* __restrict__ rw_a = (const bf16_t*)(c.ws + WS_RW_A); const bf16_t* __restrict__ rw_b = (const bf16_t*)(c.ws + WS_RW_B);
    const float* r_k = c.in[17];
    bf16_t* Mq = (bf16_t*)(c.ws + WS_CM); bf16_t* NTq = (bf16_t*)(c.ws + WS_CN); bf16_t* Qq = (bf16_t*)(c.ws + WS_CQ); bf16_t* YTq = (bf16_t*)(c.ws + WS_CY); float* bon = (float*)(c.ws + WS_CBON);
    LAS unsigned char* L = c.lds;
    LAS unsigned char* sAt = L + 0 * CSLOT; LAS unsigned char* sBt = L + 1 * CSLOT; LAS unsigned char* sKt = L + 2 * CSLOT; LAS unsigned char* sRt = L + 3 * CSLOT;
    LAS unsigned char* sBtT = L + 4 * CSLOT; LAS unsigned char* sKtT = L + 5 * CSLOT; LAS unsigned char* sVT = L + 6 * CSLOT;
    LAS unsigned char* sA4 = L + 7 * CSLOT;
    LAS unsigned char* sRHST = L + 11 * CSLOT;
    LAS unsigned char* sXT = L + 0 * CSLOT;
    LAS unsigned char* sAD = L + 2 * CSLOT;
    LAS float* sDIAG = (LAS float*)(L + C_DIAG); LAS bf16_t* sDM = (LAS bf16_t*)(L + C_DM); LAS float* sGL = (LAS float*)(L + C_GL); LAS float* sSEGP = (LAS float*)(L + C_SEGP);
    const int tid = c.tid, w = c.wid, lane = c.lane, lr = lane & 15, lq = lane >> 4;
    float raww[8]; unsigned rawa[8], rawb[8], rawk[8], rawr[8], rawv[8];
    auto load_raw = [&](int ci_) {
        const int bh_ = ci_ >> 7, chunk_ = ci_ & 127, b_ = bh_ >> 3, h_ = bh_ & 7;
        const size_t gb = (size_t)(b_ * SEQ + chunk_ * CL) * RW + h_ * 64 + (size_t)(8 * (tid >> 6)) * RW + (tid & 63);
#pragma unroll
        for (int j = 0; j < 8; ++j) { const size_t o = gb + (size_t)j * RW; raww[j] = rw_w[o]; rawa[j] = rw_a[o]; rawb[j] = rw_b[o]; rawk[j] = rw_k[o]; rawr[j] = rw_r[o]; rawv[j] = rw_v[o]; }
    };
    if (c.bid < BATCH * NH * (SEQ / CL)) load_raw(c.bid);
    for (int ci = c.bid; ci < BATCH * NH * (SEQ / CL); ci += GA) {
        const int bh = ci >> 7, chunk = ci & 127, b = bh >> 3, h = bh & 7;
        const size_t gbase = (size_t)(b * SEQ + chunk * CL) * RW + h * 64;
        {
            const int kc = tid & 63, seg = tid >> 6;
            float p[8];
#pragma unroll
            for (int j = 0; j < 8; ++j) { const float wv = raww[j]; p[j] = (j == 0) ? wv : p[j - 1] * wv; }
            sSEGP[seg * 64 + kc] = p[7];
            for (int i = tid; i < 4 * CSLOT / 16; i += 512) lds_st16(sA4 + i * 16, make_uint4(0u, 0u, 0u, 0u));
            __syncthreads();
            float pre = 1.0f;
#pragma unroll
            for (int s = 0; s < 7; ++s) { const float sp = sSEGP[s * 64 + kc]; pre = (s < seg) ? pre * sp : pre; }
            float atT[8], btT[8], ktT[8], vT[8];
            const float rkv = r_k[h * 64 + kc];
#pragma unroll
            for (int j = 0; j < 8; ++j) {
                const int t = 8 * seg + j;
                const float G = pre * p[j], Gm1 = (j == 0) ? pre : pre * p[j - 1], inv = 1.0f / G;
                const float av = bf2f(rawa[j]), bv = bf2f(rawb[j]), kv = bf2f(rawk[j]), rv = bf2f(rawr[j]), vv = bf2f(rawv[j]);
                const float at = av * Gm1, bt = bv * inv, kt = kv * inv, rt = rv * G;
                *(LAS bf16_t*)(sAt + (t * CLD + kc) * 2) = (bf16_t)f2bf(at); *(LAS bf16_t*)(sBt + (t * CLD + kc) * 2) = (bf16_t)f2bf(bt);
                *(LAS bf16_t*)(sKt + (t * CLD + kc) * 2) = (bf16_t)f2bf(kt); *(LAS bf16_t*)(sRt + (t * CLD + kc) * 2) = (bf16_t)f2bf(rt);
                atT[j] = at; btT[j] = bt; ktT[j] = kt; vT[j] = vv;
                const float bs = wave_sum_u(rv * kv * rkv);
                if (lane == 0) bon[(size_t)ci * CL + t] = bs;
            }
            lds_st16(sRHST + (kc * CLD + 8 * seg) * 2, pack8(atT)); lds_st16(sBtT + (kc * CLD + 8 * seg) * 2, pack8(btT));
            lds_st16(sKtT + (kc * CLD + 8 * seg) * 2, pack8(ktT)); lds_st16(sVT + (kc * CLD + 8 * seg) * 2, pack8(vT));
            if (seg == 7) sGL[kc] = pre * p[7];
            __syncthreads();
        }
        for (int idx = w; idx < 40; idx += 8) {
            const int m = idx / 10, pr = idx % 10;
            const int ti = (pr >= 6) ? 3 : (pr >= 3) ? 2 : (pr >= 1) ? 1 : 0, si = pr - ti * (ti + 1) / 2;
            LAS const unsigned char* X = (m < 2) ? sAt : sRt; LAS const unsigned char* Y = (m & 1) ? sKt : sBt;
            f32x4_t acc = {0.f, 0.f, 0.f, 0.f};
#pragma unroll
            for (int ks = 0; ks < 2; ++ks) acc = MFMA16(ldsfrag(Y, 16 * si + lr, 32 * ks + 8 * lq), ldsfrag(X, 16 * ti + lr, 32 * ks + 8 * lq), acc);
            const int t = 16 * ti + lr, s0 = 16 * si + 4 * lq;
            float o[4];
#pragma unroll
            for (int rg = 0; rg < 4; ++rg) { const int s = s0 + rg; const bool keep = (m < 2) ? (s < t) : (s <= t); o[rg] = keep ? acc[rg] : 0.f; }
            lds_st8(sA4 + m * CSLOT + (t * CLD + s0) * 2, pack4(o[0], o[1], o[2], o[3]));
            if (m == 0 && ti == si) *(LAS f32x4_t*)(sDIAG + (ti * 16 + lr) * 16 + 4 * lq) = (f32x4_t){o[0], o[1], o[2], o[3]};
        }
        __syncthreads();
        if (w == 0) {
            float x[16];
#pragma unroll
            for (int r = 0; r < 16; ++r) {
                float acc = (r == lr) ? 1.0f : 0.0f;
                float nrow[16];
#pragma unroll
                for (int q4 = 0; q4 < 4; ++q4) { const f32x4_t nv = *(LAS const f32x4_t*)(sDIAG + (lq * 16 + r) * 16 + 4 * q4); nrow[4 * q4] = nv[0]; nrow[4 * q4 + 1] = nv[1]; nrow[4 * q4 + 2] = nv[2]; nrow[4 * q4 + 3] = nv[3]; }
#pragma unroll
                for (int s = 0; s < 16; ++s) if (s < r) acc = fmaf(nrow[s], x[s], acc);
                x[r] = acc;
                sDM[(lq * 16 + r) * 16 + lr] = (bf16_t)f2bf(acc);
            }
        } else {
            for (int idx = w - 1; idx < 16; idx += 7) {
                const int ti = idx >> 2, vi = idx & 3;
                f32x4_t acc = {0.f, 0.f, 0.f, 0.f};
#pragma unroll
                for (int ks = 0; ks < 2; ++ks) acc = MFMA16(ldsfrag(sA4 + 1 * CSLOT, 16 * ti + lr, 32 * ks + 8 * lq), ldsfrag(sVT, 16 * vi + lr, 32 * ks + 8 * lq), acc);
                lds_st8(sRHST + ((64 + 16 * vi + lr) * CLD + 16 * ti + 4 * lq) * 2, pack4(acc[0], acc[1], acc[2], acc[3]));
            }
        }
        __syncthreads();
        f32x4_t rd[4];
#pragma unroll
        for (int i = 0; i < 4; ++i) {
            bf16x8_t fa = zfrag(), fb = zfrag();
            if (lq < 2) { fa = *(LAS const bf16x8_t*)(sDM + (i * 16 + lr) * 16 + 8 * lq); fb = ldsfrag(sRHST, 16 * w + lr, 16 * i + 8 * lq); }
            rd[i] = MFMA16(fa, fb, ((f32x4_t){0.f, 0.f, 0.f, 0.f}));
        }
        if (w < 6) {
            const int i = (w >= 3) ? 3 : (w >= 1) ? 2 : 1, j = w - (i - 1) * i / 2;
            bf16x8_t fa = zfrag(), fb = zfrag();
            if (lq < 2) {
                fa = *(LAS const bf16x8_t*)(sDM + (i * 16 + lr) * 16 + 8 * lq);
#pragma unroll
                for (int jj = 0; jj < 8; ++jj) fb[jj] = (short)*(LAS const bf16_t*)(sA4 + ((16 * i + 8 * lq + jj) * CLD + 16 * j + lr) * 2);
            }
            const f32x4_t acc = MFMA16(fa, fb, ((f32x4_t){0.f, 0.f, 0.f, 0.f}));
#pragma unroll
            for (int rg = 0; rg < 4; ++rg) *(LAS bf16_t*)(sAD + ((16 * i + 4 * lq + rg) * CLD + 16 * j + lr) * 2) = (bf16_t)f2bf(acc[rg]);
        }
        __syncthreads();
#pragma unroll
        for (int i = 0; i < 4; ++i) {
            f32x4_t acc = rd[i];
            if (i >= 1) {
                bf16x8_t fa = zfrag(), fb = zfrag();
                if (8 * lq < 16 * i) { fa = ldsfrag(sAD, 16 * i + lr, 8 * lq); fb = ldsfrag(sXT, 16 * w + lr, 8 * lq); }
                acc = MFMA16(fa, fb, acc);
            }
            if (i == 3) {
                bf16x8_t fa = zfrag(), fb = zfrag();
                if (lq < 2) { fa = ldsfrag(sAD, 48 + lr, 32 + 8 * lq); fb = ldsfrag(sXT, 16 * w + lr, 32 + 8 * lq); }
                acc = MFMA16(fa, fb, acc);
            }
            lds_st8(sXT + ((16 * w + lr) * CLD + 16 * i + 4 * lq) * 2, pack4(acc[0], acc[1], acc[2], acc[3]));
            asm volatile("s_waitcnt lgkmcnt(0)" ::: "memory");
        }
        __syncthreads();
        if (ci + GA < BATCH * NH * (SEQ / CL)) load_raw(ci + GA);
#pragma unroll
        for (int i = 0; i < 8; ++i) {
            const int kind = i >> 1, tile = w + 8 * (i & 1), r4 = tile >> 2, c4 = tile & 3;
            f32x4_t acc = {0.f, 0.f, 0.f, 0.f};
            if (kind == 0) {
#pragma unroll
                for (int ks = 0; ks < 2; ++ks) acc = MFMA16(ldsfrag(sXT, 16 * r4 + lr, 32 * ks + 8 * lq), ldsfrag(sBtT, 16 * c4 + lr, 32 * ks + 8 * lq), acc);
                const int k = 16 * c4 + lr, kp0 = 16 * r4 + 4 * lq; const float gl = sGL[k];
                float o[4];
#pragma unroll
                for (int rg = 0; rg < 4; ++rg) o[rg] = gl * (acc[rg] + ((k == kp0 + rg) ? 1.0f : 0.0f));
                *(uint2*)(Mq + (size_t)ci * 4096 + k * 64 + kp0) = pack4(o[0], o[1], o[2], o[3]);
            } else if (kind == 1) {
#pragma unroll
                for (int ks = 0; ks < 2; ++ks) {
                    acc = MFMA16(ldsfrag(sBtT, 16 * r4 + lr, 32 * ks + 8 * lq), ldsfrag(sXT, 64 + 16 * c4 + lr, 32 * ks + 8 * lq), acc);
                    acc = MFMA16(ldsfrag(sKtT, 16 * r4 + lr, 32 * ks + 8 * lq), ldsfrag(sVT, 16 * c4 + lr, 32 * ks + 8 * lq), acc);
                }
                const int k0 = 16 * r4 + 4 * lq; const f32x4_t gl = *(LAS const f32x4_t*)(sGL + k0);
                *(uint2*)(NTq + (size_t)ci * 4096 + (16 * c4 + lr) * 64 + k0) = pack4(gl[0] * acc[0], gl[1] * acc[1], gl[2] * acc[2], gl[3] * acc[3]);
            } else if (kind == 2) {
#pragma unroll
                for (int ks = 0; ks < 2; ++ks) acc = MFMA16(ldsfrag(sXT, 16 * r4 + lr, 32 * ks + 8 * lq), ldsfrag(sA4 + 2 * CSLOT, 16 * c4 + lr, 32 * ks + 8 * lq), acc);
                const int t = 16 * c4 + lr, kp0 = 16 * r4 + 4 * lq;
                const uint2 rv = lds_ld8(sRt + (t * CLD + kp0) * 2);
                *(uint2*)(Qq + (size_t)ci * 4096 + t * 64 + kp0) = pack4(acc[0] + bf2f(rv.x & 0xffffu), acc[1] + bf2f(rv.x >> 16), acc[2] + bf2f(rv.y & 0xffffu), acc[3] + bf2f(rv.y >> 16));
            } else {
#pragma unroll
                for (int ks = 0; ks < 2; ++ks) {
                    acc = MFMA16(ldsfrag(sA4 + 2 * CSLOT, 16 * r4 + lr, 32 * ks + 8 * lq), ldsfrag(sXT, 64 + 16 * c4 + lr, 32 * ks + 8 * lq), acc);
                    acc = MFMA16(ldsfrag(sA4 + 3 * CSLOT, 16 * r4 + lr, 32 * ks + 8 * lq), ldsfrag(sVT, 16 * c4 + lr, 32 * ks + 8 * lq), acc);
                }
                *(uint2*)(YTq + (size_t)ci * 4096 + (16 * c4 + lr) * 64 + 16 * r4 + 4 * lq) = pack4(acc[0], acc[1], acc[2], acc[3]);
            }
        }
        __syncthreads();
    }
}

__device__ __forceinline__ void rwkv_phaseB(const Ctx& c, const int bh, const int w) {
    const bf16_t* __restrict__ Mq = (const bf16_t*)(c.ws + WS_CM); const bf16_t* __restrict__ NTq = (const bf16_t*)(c.ws + WS_CN); bf16_t* __restrict__ Sst = (bf16_t*)(c.ws + WS_CS);
    const int lane = c.lane, lr = lane & 15, lq = lane >> 4;
    LAS unsigned char* sS = c.lds + 69632 + c.wid * (16 * CLD * 2);
    {
        {
            bf16x8_t sB0 = zfrag(), sB1 = zfrag();
            bf16x8_t ma[4][4][2]; uint2 nv[4][4];
            const size_t ci0 = (size_t)bh * (SEQ / CL);
#define RB_LOAD(slot, cidx) do { _Pragma("unroll") for (int kt = 0; kt < 4; ++kt) { _Pragma("unroll") for (int ks = 0; ks < 2; ++ks) \
                ma[slot][kt][ks] = *(const bf16x8_t*)(Mq + (cidx) * 4096 + (16 * kt + lr) * 64 + 32 * ks + 8 * lq); nv[slot][kt] = *(const uint2*)(NTq + (cidx) * 4096 + (16 * w + lr) * 64 + 16 * kt + 4 * lq); } } while (0)
#pragma unroll
            for (int sl = 0; sl < 4; ++sl) RB_LOAD(sl, ci0 + sl);
#pragma unroll
            for (int chunk = 0; chunk < SEQ / CL; chunk += 4) {
#pragma unroll
                for (int sl = 0; sl < 4; ++sl) {
                    const size_t ci = ci0 + chunk + sl;
                    asm volatile("global_store_dwordx4 %0, %1, off\n\tglobal_store_dwordx4 %0, %2, off offset:64\n\ts_nop 1" :: "v"(Sst + ci * 4096 + (16 * w + lr) * 64 + 8 * lq), "v"(sB0), "v"(sB1) : "memory");
#pragma unroll
                    for (int kt = 0; kt < 4; ++kt) {
                        f32x4_t acc = {bf2f(nv[sl][kt].x & 0xffffu), bf2f(nv[sl][kt].x >> 16), bf2f(nv[sl][kt].y & 0xffffu), bf2f(nv[sl][kt].y >> 16)};
                        acc = MFMA16(ma[sl][kt][0], sB0, acc); acc = MFMA16(ma[sl][kt][1], sB1, acc);
                        lds_st8(sS + (lr * CLD + 16 * kt + 4 * lq) * 2, pack4(acc[0], acc[1], acc[2], acc[3]));
                    }
                    const size_t cn = (chunk + sl + 4 < SEQ / CL) ? ci + 4 : ci;
                    RB_LOAD(sl, cn);
                    asm volatile("s_waitcnt lgkmcnt(0)" ::: "memory");
                    sB0 = ldsfrag(sS, lr, 8 * lq); sB1 = ldsfrag(sS, lr, 32 + 8 * lq);
                    asm volatile("s_waitcnt lgkmcnt(0)" ::: "memory");
                }
            }
#undef RB_LOAD
        }
    }
}

__device__ __forceinline__ void rwkv_phaseC(const Ctx& c) {
    const bf16_t* __restrict__ Qq = (const bf16_t*)(c.ws + WS_CQ); const bf16_t* __restrict__ YTq = (const bf16_t*)(c.ws + WS_CY); const bf16_t* __restrict__ Sst = (const bf16_t*)(c.ws + WS_CS);
    const float* __restrict__ bon = (const float*)(c.ws + WS_CBON);
    const bf16_t* rw_v = (const bf16_t*)(c.ws + WS_RW_V); const bf16_t* rw_g = (const bf16_t*)(c.ws + WS_RW_G);
    const float* ln_w = c.in[18]; const float* ln_b = c.in[19];
    bf16_t* ycat = (bf16_t*)(c.ws + WS_A);
    const int w = c.wid, lane = c.lane, lr = lane & 15, lq = lane >> 4;
    LAS float* sY = (LAS float*)(c.lds + w * (16 * 68 * 4));
    const int gw = c.bid * 8 + c.wid, NW = c.G * 8;
    for (int task = gw; task < BATCH * NH * (SEQ / CL) * 4; task += NW) {
        const size_t ci = (size_t)(task >> 2); const int tt = task & 3;
        const int bh = (int)(ci >> 7), chunk = (int)(ci & 127), b = bh >> 3, h = bh & 7;
        bf16x8_t qa[2];
#pragma unroll
        for (int ks = 0; ks < 2; ++ks) qa[ks] = *(const bf16x8_t*)(Qq + ci * 4096 + (16 * tt + lr) * 64 + 32 * ks + 8 * lq);
#pragma unroll
        for (int vt = 0; vt < 4; ++vt) {
            const uint2 yv = *(const uint2*)(YTq + ci * 4096 + (16 * vt + lr) * 64 + 16 * tt + 4 * lq);
            f32x4_t acc = {bf2f(yv.x & 0xffffu), bf2f(yv.x >> 16), bf2f(yv.y & 0xffffu), bf2f(yv.y >> 16)};
#pragma unroll
            for (int ks = 0; ks < 2; ++ks) acc = MFMA16(qa[ks], *(const bf16x8_t*)(Sst + ci * 4096 + (16 * vt + lr) * 64 + 32 * ks + 8 * lq), acc);
#pragma unroll
            for (int rg = 0; rg < 4; ++rg) sY[(4 * lq + rg) * 68 + 16 * vt + lr] = acc[rg];
        }
        asm volatile("s_waitcnt lgkmcnt(0)" ::: "memory");
        const int hn = h * 64 + lane;
        const float lw = ln_w[hn], lb = ln_b[hn];
#pragma unroll 4
        for (int tr = 0; tr < 16; ++tr) {
            const int t = chunk * CL + 16 * tt + tr; const size_t tok = (size_t)b * SEQ + t;
            const float y = sY[tr * 68 + lane];
            const float mean = wave_sum_u(y) * (1.f / 64.f);
            const float d = y - mean;
            const float var = wave_sum_u(d * d) * (1.f / 64.f);
            const float yn = d * rsqrtf(var + 64e-5f) * lw + lb;
            const float bonus = bon[ci * CL + 16 * tt + tr] * ldbf(rw_v + tok * RW + hn);
            ycat[tok * D + hn] = (bf16_t)f2bf((yn + bonus) * ldbf(rw_g + tok * RW + hn));
        }
        asm volatile("s_waitcnt lgkmcnt(0)" ::: "memory");
    }
}

constexpr int PA_BLOCKS = 256;
constexpr int CONV_A = 0;
__device__ __forceinline__ void phase6a(const Ctx& c) {
    if (c.G != 256) { rwkv_phaseA(c, c.G); return; }
    if (c.bid < PA_BLOCKS) rwkv_phaseA(c, PA_BLOCKS);
    else if (CONV_A > 0) convert_expert_weights(c, 0, CONV_A, (c.bid - PA_BLOCKS) * 8 + c.wid, (256 - PA_BLOCKS > 0 ? 256 - PA_BLOCKS : 1) * 8);
}

__device__ __forceinline__ void phase6b(const Ctx& c) {
    if (c.wid == 0) {
        for (int tk = c.bid; tk < 2 * S5NG * BATCH; tk += c.G) {
            if (tk < BATCH * NH * 4) { rwkv_phaseB(c, tk >> 2, tk & 3); continue; }
            const float* apow = (const float*)(c.ws + WS_APOW); const float* E = (const float*)((const unsigned char*)c.out + OUT_E);
            bf16_t* ux = (bf16_t*)((unsigned char*)c.out + OUT_UX);
            const int task = tk - BATCH * NH * 4;
            const int g = task >> 2, b = task & 3, p = c.lane;
            const float pr = apow[((size_t)(g * (S5L + 1) + S5L) * 64 + p) * 2], pi = apow[((size_t)(g * (S5L + 1) + S5L) * 64 + p) * 2 + 1];
            float xr = 0.f, xi = 0.f;
            const size_t row0 = (size_t)g * 1024 + b * 256;
            float er[2][8], ei[2][8];
#pragma unroll
            for (int q = 0; q < 8; ++q) { er[0][q] = E[(row0 + q) * 128 + p]; ei[0][q] = E[(row0 + q) * 128 + 64 + p]; }
#pragma unroll
            for (int bt = 0; bt < 32; ++bt) {
                const int cur = bt & 1, nx = cur ^ 1, ch0 = bt * 8;
                if (bt + 1 < 32) {
#pragma unroll
                    for (int q = 0; q < 8; ++q) { er[nx][q] = E[(row0 + ch0 + 8 + q) * 128 + p]; ei[nx][q] = E[(row0 + ch0 + 8 + q) * 128 + 64 + p]; }
                }
#pragma unroll
                for (int q = 0; q < 8; ++q) {
                    st2(ux + (row0 + ch0 + q) * 640 + 512 + p, f2bf(xr)); st2(ux + (row0 + ch0 + q) * 640 + 576 + p, f2bf(xi));
                    const float nr = pr * xr - pi * xi + er[cur][q], ni = pr * xi + pi * xr + ei[cur][q]; xr = nr; xi = ni;
                }
            }
        }
    } else {
        convert_expert_weights(c, (c.G == 256) ? CONV_A : 0, NE * 384, c.bid * 7 + (c.wid - 1), c.G * 7);
    }
}

__device__ __forceinline__ void phase7(const Ctx& c) {
    {
        pg8::Gemm g{(const bf16_t*)((unsigned char*)c.out + OUT_UX), (const bf16_t*)(c.ws + WS_KMAT), 0, 0, 640};
        pg8::S5Order S{256, 2, c.G, c.bid};
        pg8::EpiS5Out E{(bf16_t*)(c.ws + WS_YS5)};
        pg8::gemm_phase<pg8::EpiS5Out, pg8::S5Order, true, true>(c.lds, g, S, E);
    }
    __syncthreads();
    rwkv_phaseC(c);
}

__device__ __forceinline__ void phase8(const Ctx& c) {
    pg8::Gemm g{(const bf16_t*)(c.ws + WS_YS5), (const bf16_t*)(c.ws + WS_WGLU_T), T, 512, 512};
    pg8::StaticOrder S; S.init(T, 512, c.G, c.bid);
    pg8::EpiGLU E{(const bf16_t*)(c.ws + WS_YS5), 512, c.in[29], (bf16_t*)(c.ws + WS_A), D, 512};
    pg8::gemm_phase<pg8::EpiGLU, pg8::StaticOrder, true, true>(c.lds, g, S, E);
}

__device__ __forceinline__ void phase9(const Ctx& c) {
    pg8::Gemm g{(const bf16_t*)(c.ws + WS_A), (const bf16_t*)(c.ws + WS_WOUT_T), T, D, D};
    pg8::StaticOrder S; S.init(T, D, c.G, c.bid);
    pg8::EpiF32 E{(float*)(c.ws + WS_PROJ), D};
    pg8::gemm_phase<pg8::EpiF32, pg8::StaticOrder, true, true>(c.lds, g, S, E);
}

__device__ __forceinline__ void phase10(const Ctx& c) {
    const float* x = c.in[0]; const float* gpm = c.in[5]; const float* gpf = c.in[6];
    const float* mods = (const float*)(c.ws + WS_MODS); const float* mixed = (const float*)(c.ws + WS_PROJ);
    bf16_t* h2 = (bf16_t*)(c.ws + WS_A); float* x1o = c.out;
    const int gw = c.bid * 8 + c.wid, NW = c.G * 8;
    for (int t = gw; t < T; t += NW) {
        const int b = t / SEQ;
        const float4* mr = (const float4*)(mixed + (size_t)t * D) + c.lane;
        const float4* xr = (const float4*)(x + (size_t)t * D) + c.lane;
        float4 m[4], v[4]; float ss = 0.f;
#pragma unroll
        for (int j = 0; j < 4; ++j) { m[j] = mr[64 * j]; v[j] = xr[64 * j]; ss += m[j].x * m[j].x + m[j].y * m[j].y + m[j].z * m[j].z + m[j].w * m[j].w; }
        const float rstd = rsqrtf(wave_sum(ss) * (1.0f / D) + 1e-6f);
        float s1 = 0.f;
#pragma unroll
        for (int j = 0; j < 4; ++j) {
            const int k = (c.lane + 64 * j) * 4;
            const float4 gg = *(const float4*)(gpm + k);
            const float4 gt = *(const float4*)(mods + b * NMODS + 2 * D + k);
            v[j].x += gt.x * (m[j].x * rstd * gg.x); v[j].y += gt.y * (m[j].y * rstd * gg.y);
            v[j].z += gt.z * (m[j].z * rstd * gg.z); v[j].w += gt.w * (m[j].w * rstd * gg.w);
            s1 += v[j].x * v[j].x + v[j].y * v[j].y + v[j].z * v[j].z + v[j].w * v[j].w;
            ((float4*)(x1o + (size_t)t * D) + c.lane)[64 * j] = v[j];
        }
        const float rstd1 = rsqrtf(wave_sum(s1) * (1.0f / D) + 1e-6f);
#pragma unroll
        for (int j = 0; j < 4; ++j) {
            const int k = (c.lane + 64 * j) * 4;
            const float4 gg = *(const float4*)(gpf + k);
            const float4 sh = *(const float4*)(mods + b * NMODS + 3 * D + k);
            const float4 sc = *(const float4*)(mods + b * NMODS + 4 * D + k);
            float r[4];
            r[0] = v[j].x * rstd1 * gg.x * (1.f + sc.x) + sh.x; r[1] = v[j].y * rstd1 * gg.y * (1.f + sc.y) + sh.y;
            r[2] = v[j].z * rstd1 * gg.z * (1.f + sc.z) + sh.z; r[3] = v[j].w * rstd1 * gg.w * (1.f + sc.w) + sh.w;
            unsigned hi[4]; float lo[4];
#pragma unroll
            for (int q = 0; q < 4; ++q) { hi[q] = f2bf(r[q]); lo[q] = r[q] - bf2f(hi[q]); }
            ((uint2*)(h2 + (size_t)t * D) + c.lane)[64 * j] = make_uint2(hi[0] | (hi[1] << 16), hi[2] | (hi[3] << 16));
            ((uint2*)(h2 + (size_t)(T + t) * D) + c.lane)[64 * j] = make_uint2(pk2(lo[0], lo[1]), pk2(lo[2], lo[3]));
        }
    }
}

__device__ __forceinline__ void phase11(const Ctx& c) {
    {
        pg8::Gemm g{(const bf16_t*)(c.ws + WS_A), (const bf16_t*)(c.ws + WS_WR_T), 2 * T, 512, D};
        pg8::StaticOrder S; S.init(2 * T, 512, c.G, c.bid);
        pg8::EpiRouter E{(float*)(c.ws + WS_PLOG), (bf16_t*)(c.ws + WS_PLOG + 32 * MiB), (bf16_t*)(c.ws + WS_PLOG + 48 * MiB), T / 256};
        pg8::gemm_phase<pg8::EpiRouter, pg8::StaticOrder, true, true>(c.lds, g, S, E);
    }
    __syncthreads();
    {
        pg8::Gemm g{(const bf16_t*)(c.ws + WS_A), (const bf16_t*)(c.ws + WS_WSGU_T), T, 512, D};
        pg8::StaticOrder S; S.init(T, 512, c.G, c.bid);
        pg8::EpiSwiGLU E{(bf16_t*)(c.ws + WS_HS), 256};
        pg8::gemm_phase<pg8::EpiSwiGLU, pg8::StaticOrder, true, true>(c.lds, g, S, E);
    }
}

__device__ __forceinline__ unsigned fkey(float f) { const unsigned u = __builtin_bit_cast(unsigned, f); return u ^ ((u >> 31) ? 0xffffffffu : 0x80000000u); }
__device__ __forceinline__ unsigned wave_umax(unsigned v) {
    v = max(v, DPPU(v, 0xB1)); v = max(v, DPPU(v, 0x4E)); v = max(v, DPPU(v, 0x141)); v = max(v, DPPU(v, 0x140));
    const unsigned a = __builtin_amdgcn_readlane(v, 0), b = __builtin_amdgcn_readlane(v, 16), c = __builtin_amdgcn_readlane(v, 32), d = __builtin_amdgcn_readlane(v, 48);
    return max(max(a, b), max(c, d));
}
__device__ __forceinline__ unsigned wave_umin(unsigned v) {
    v = min(v, DPPU(v, 0xB1)); v = min(v, DPPU(v, 0x4E)); v = min(v, DPPU(v, 0x141)); v = min(v, DPPU(v, 0x140));
    const unsigned a = __builtin_amdgcn_readlane(v, 0), b = __builtin_amdgcn_readlane(v, 16), c = __builtin_amdgcn_readlane(v, 32), d = __builtin_amdgcn_readlane(v, 48);
    return min(min(a, b), min(c, d));
}
__device__ __forceinline__ void phase12(const Ctx& c) {
    const float* plog = (const float*)(c.ws + WS_PLOG); const float* rb = c.in[32];
    int* idx = (int*)(c.ws + WS_IDX); float* wt = (float*)(c.ws + WS_WT);
    LAS int* lhist = (LAS int*)c.lds;
    __syncthreads();
    if (c.tid < NE) lhist[c.tid] = 0;
    __syncthreads();
    const int gw = c.bid * 8 + c.wid, NW = c.G * 8, l = c.lane;
    const float4 bias = *(const float4*)(rb + l * 4);
    for (int t = gw; t < T; t += NW) {
        const float4 p0 = *(const float4*)(plog + (size_t)t * 256 + l * 4);
        const float4 p1 = ldbf4((const bf16_t*)(c.ws + WS_PLOG + 32 * MiB) + (size_t)t * 256 + l * 4), p2 = ldbf4((const bf16_t*)(c.ws + WS_PLOG + 48 * MiB) + (size_t)t * 256 + l * 4);
        const float lg[4] = {p0.x + (p1.x + p2.x), p0.y + (p1.y + p2.y), p0.z + (p1.z + p2.z), p0.w + (p1.w + p2.w)};
        float s[4] = {sigmoidf_(lg[0]), sigmoidf_(lg[1]), sigmoidf_(lg[2]), sigmoidf_(lg[3])};
        float ch[4] = {s[0] + bias.x, s[1] + bias.y, s[2] + bias.z, s[3] + bias.w};
        float a1 = fmaxf(ch[0], ch[1]), a2 = fminf(ch[0], ch[1]);
        { const float b1 = fmaxf(ch[2], ch[3]), b2 = fminf(ch[2], ch[3]); const float n1 = fmaxf(a1, b1), n2 = fmaxf(fminf(a1, b1), fmaxf(a2, b2)); a1 = n1; a2 = n2; }
        { const float b1 = DPPF(a1, 0xB1), b2 = DPPF(a2, 0xB1); const float n1 = fmaxf(a1, b1), n2 = fmaxf(fminf(a1, b1), fmaxf(a2, b2)); a1 = n1; a2 = n2; }
        { const float b1 = DPPF(a1, 0x4E), b2 = DPPF(a2, 0x4E); const float n1 = fmaxf(a1, b1), n2 = fmaxf(fminf(a1, b1), fmaxf(a2, b2)); a1 = n1; a2 = n2; }
        { const float b1 = DPPF(a1, 0x141), b2 = DPPF(a2, 0x141); const float n1 = fmaxf(a1, b1), n2 = fmaxf(fminf(a1, b1), fmaxf(a2, b2)); a1 = n1; a2 = n2; }
        const float gs = a1 + a2; const int myg = l >> 3;
        int rank = 0;
#pragma unroll
        for (int g = 0; g < 8; ++g) { const float og = __builtin_bit_cast(float, __builtin_amdgcn_readlane(__builtin_bit_cast(int, gs), g * 8)); rank += (og > gs || (og == gs && g < myg)) ? 1 : 0; }
        const bool sel = rank < 4;
        unsigned mk[4];
#pragma unroll
        for (int i = 0; i < 4; ++i) mk[i] = sel ? fkey(ch[i]) : 0u;
        float sk[8]; int ek[8]; float ssum = 0.f;
#pragma unroll
        for (int k = 0; k < 8; ++k) {
            const unsigned lm = max(max(mk[0], mk[1]), max(mk[2], mk[3]));
            const unsigned m = wave_umax(lm);
            unsigned cand = 1023u;
#pragma unroll
            for (int i = 3; i >= 0; --i) if (mk[i] == m) cand = (unsigned)(l * 4 + i);
            const int be = (int)wave_umin(cand);
            const int ii = be & 3;
            float sv = s[0]; sv = (ii == 1) ? s[1] : sv; sv = (ii == 2) ? s[2] : sv; sv = (ii == 3) ? s[3] : sv;
            sv = __builtin_bit_cast(float, __builtin_amdgcn_readlane(__builtin_bit_cast(int, sv), be >> 2));
            if ((be >> 2) == l) {
#pragma unroll
                for (int i = 0; i < 4; ++i) if (i == ii) mk[i] = 0u;
            }
            sk[k] = sv; ek[k] = be; ssum += sv;
        }
        if (l == 0) {
            const float inv = 2.5f / ssum;
#pragma unroll
            for (int k = 0; k < 8; ++k) { idx[t * 8 + k] = ek[k]; wt[t * 8 + k] = sk[k] * inv; __hip_atomic_fetch_add(lhist + ek[k], 1, __ATOMIC_RELAXED, __HIP_MEMORY_SCOPE_WORKGROUP); }
        }
    }
    __syncthreads();
    if (c.tid < NE) ((int*)(c.ws + WS_HIST))[c.bid * NE + c.tid] = lhist[c.tid];
}

__device__ __forceinline__ void phase13(const Ctx& c) {
    int* smi = (int*)c.sm;
    const int* hist = (const int*)(c.ws + WS_HIST);
    __syncthreads();
    if (c.tid < NE) {
        int tot = 0, base = 0;
        for (int bb = 0; bb < c.G; ++bb) { const int v = hist[bb * NE + c.tid]; tot += v; base += (bb < c.bid) ? v : 0; }
        smi[600 + c.tid] = tot; smi[900 + c.tid] = base; smi[1200 + c.tid] = 0; smi[300 + c.tid] = (tot + 255) >> 8;
    }
    __syncthreads();
    if (c.tid < 64) {
        const int l = c.tid; const int u0 = smi[300 + l * 4], u1 = smi[300 + l * 4 + 1], u2 = smi[300 + l * 4 + 2], u3 = smi[300 + l * 4 + 3];
        const int tot = u0 + u1 + u2 + u3; int inc = tot;
#pragma unroll
        for (int o = 1; o < 64; o <<= 1) { const int v = __shfl_up(inc, o); if (l >= o) inc += v; }
        const int ex = inc - tot;
        smi[l * 4] = ex; smi[l * 4 + 1] = ex + u0; smi[l * 4 + 2] = ex + u0 + u1; smi[l * 4 + 3] = ex + u0 + u1 + u2;
        if (l == 63) smi[NE] = inc;
    }
    __syncthreads();
    const int* idx = (const int*)(c.ws + WS_IDX); int* slotp = (int*)(c.ws + WS_SLOTP); int* uexp = (int*)(c.ws + WS_UEXP); int* slotw = (int*)(c.ws + WS_SLOTW); const float* wt = (const float*)(c.ws + WS_WT);
    const int gw = c.bid * 8 + c.wid, NW = c.G * 8;
    for (int t = gw; t < T; t += NW) {
        if (c.lane < 8) {
            const int a = t * 8 + c.lane, e = idx[a];
            const int pos = smi[900 + e] + __hip_atomic_fetch_add(smi + 1200 + e, 1, __ATOMIC_RELAXED, __HIP_MEMORY_SCOPE_WORKGROUP);
            const int slot = smi[e] * 256 + pos;
            slotp[slot] = a;
            *(int2*)(slotw + 2 * (size_t)slot) = make_int2(a, __float_as_int(wt[a]));
        }
    }
    const int gt = c.bid * 512 + c.tid, NT = c.G * 512;
    for (int e = gt; e < NE; e += NT) {
        const int u0 = smi[e], u1 = smi[e + 1], cn = smi[600 + e];
        for (int p = cn; p < (u1 - u0) * 256; ++p) { slotp[u0 * 256 + p] = -1; *(int2*)(slotw + 2 * (size_t)(u0 * 256 + p)) = make_int2(-1, 0); }
        for (int u = u0; u < u1; ++u) uexp[u] = e;
    }
    if (gt == 0) uexp[2048] = smi[NE];
}

__device__ __forceinline__ void phase14(const Ctx& c) {
    const int* uexp = (const int*)(c.ws + WS_UEXP);
    const int NU = __builtin_amdgcn_readfirstlane(uexp[2048]);
    const int vcu = (c.G % 8 == 0) ? (c.bid % 8) * (c.G / 8) + c.bid / 8 : c.bid;
    pg8::Gemm g{(const bf16_t*)(c.ws + WS_A), (const bf16_t*)(c.ws + WS_WEGU), 0, 0, D, (const int*)(c.ws + WS_SLOTP)};
    pg8::ExpertOrder S{uexp, NU, 2, c.G, vcu};
    pg8::EpiSwiGLU E{(bf16_t*)(c.ws + WS_HID), 256};
    pg8::gemm_phase<pg8::EpiSwiGLU, pg8::ExpertOrder, true, true, true>(c.lds, g, S, E);
}

__device__ __forceinline__ void phase15(const Ctx& c) {
    {
        const int* uexp = (const int*)(c.ws + WS_UEXP);
        const int NU = __builtin_amdgcn_readfirstlane(uexp[2048]);
        const int vcu = (c.G % 8 == 0) ? (c.bid % 8) * (c.G / 8) + c.bid / 8 : c.bid;
        pg8::Gemm g{(const bf16_t*)(c.ws + WS_HID), (const bf16_t*)(c.ws + WS_WED), 0, 0, EFF};
        pg8::ExpertOrder S{uexp, NU, 4, c.G, vcu};
        pg8::EpiScatter E{(const int*)(c.ws + WS_SLOTW), (bf16_t*)(c.ws + WS_YEXP), D};
        pg8::gemm_phase<pg8::EpiScatter, pg8::ExpertOrder, true, true>(c.lds, g, S, E);
    }
    __syncthreads();
    {
        pg8::Gemm g{(const bf16_t*)(c.ws + WS_HS), (const bf16_t*)(c.ws + WS_WSD_T), T, D, 256};
        pg8::StaticOrder S; S.init(T, D, c.G, c.bid);
        pg8::EpiBf16<0> E{(bf16_t*)(c.ws + WS_SHOUT), D, nullptr, 0, 0, 1.f};
        pg8::gemm_phase<pg8::EpiBf16<0>, pg8::StaticOrder, true, true>(c.lds, g, S, E);
    }
}

__device__ __forceinline__ void phase16(const Ctx& c) {
    const float* gq = c.in[7]; const float* mods = (const float*)(c.ws + WS_MODS);
    const bf16_t* shout = (const bf16_t*)(c.ws + WS_SHOUT); const unsigned char* yexp = (const unsigned char*)(c.ws + WS_YEXP);
    float* out = c.out; float* dst = c.out;
    const int gw = c.bid * 8 + c.wid, NW = c.G * 8;
    typedef float f32x2s __attribute__((ext_vector_type(2)));
    for (int t = gw; t < T; t += NW) {
        const int b = t / SEQ;
        float y[2][8], x1[2][8]; float ss = 0.f;
        uint2 ye[2][8]; uint4 sh[2]; float4 xv[2][2];
#pragma unroll
        for (int j = 0; j < 2; ++j) {
            const int k = (c.lane + 64 * j) * 8;
            sh[j] = *(const uint4*)(shout + (size_t)t * D + k);
            xv[j][0] = *(const float4*)(out + (size_t)t * D + k); xv[j][1] = *(const float4*)(out + (size_t)t * D + k + 4);
#pragma unroll
            for (int q = 0; q < 8; ++q) ye[j][q] = *(const uint2*)(yexp + (size_t)(t * 8 + q) * D + k);
        }
#pragma unroll
        for (int j = 0; j < 2; ++j) {
            unpack8(sh[j], y[j]);
            x1[j][0] = xv[j][0].x; x1[j][1] = xv[j][0].y; x1[j][2] = xv[j][0].z; x1[j][3] = xv[j][0].w; x1[j][4] = xv[j][1].x; x1[j][5] = xv[j][1].y; x1[j][6] = xv[j][1].z; x1[j][7] = xv[j][1].w;
#pragma unroll
            for (int q = 0; q < 8; ++q) {
                const f32x2s a0 = __builtin_amdgcn_cvt_pk_f32_fp8((int)ye[j][q].x, false), a1 = __builtin_amdgcn_cvt_pk_f32_fp8((int)ye[j][q].x, true);
                const f32x2s a2 = __builtin_amdgcn_cvt_pk_f32_fp8((int)ye[j][q].y, false), a3 = __builtin_amdgcn_cvt_pk_f32_fp8((int)ye[j][q].y, true);
                y[j][0] += a0[0]; y[j][1] += a0[1]; y[j][2] += a1[0]; y[j][3] += a1[1]; y[j][4] += a2[0]; y[j][5] += a2[1]; y[j][6] += a3[0]; y[j][7] += a3[1];
            }
#pragma unroll
            for (int i = 0; i < 8; ++i) ss += y[j][i] * y[j][i];
        }
        const float rstd = rsqrtf(wave_sum_u(ss) * (1.0f / D) + 1e-6f);
#pragma unroll
        for (int j = 0; j < 2; ++j) {
            const int k = (c.lane + 64 * j) * 8;
            const float4 g0 = *(const float4*)(gq + k), g1 = *(const float4*)(gq + k + 4);
            const float4 t0 = *(const float4*)(mods + b * NMODS + 5 * D + k), t1 = *(const float4*)(mods + b * NMODS + 5 * D + k + 4);
            const float gg[8] = {g0.x, g0.y, g0.z, g0.w, g1.x, g1.y, g1.z, g1.w}, gt[8] = {t0.x, t0.y, t0.z, t0.w, t1.x, t1.y, t1.z, t1.w};
            float o[8];
#pragma unroll
            for (int i = 0; i < 8; ++i) o[i] = x1[j][i] + gt[i] * (y[j][i] * rstd * gg[i]);
            *(float4*)(dst + (size_t)t * D + k) = make_float4(o[0], o[1], o[2], o[3]); *(float4*)(dst + (size_t)t * D + k + 4) = make_float4(o[4], o[5], o[6], o[7]);
        }
    }
}

constexpr int NPHASES = 18;
__device__ __forceinline__ void probe_reset(const Ctx& c, int k) {
    unsigned* counts = (unsigned*)(c.ws + WS_COUNTS);
    if (k == 13 && c.bid == 0 && c.tid < 256) counts[c.tid] = 0u;
    if (k == 14 && c.bid == 0 && c.tid < 256) counts[256 + c.tid] = 0u;
}

__global__ void __launch_bounds__(512, 2) mega(Args args) {
    extern __shared__ __attribute__((aligned(16))) unsigned char lds_raw[];
    Ctx c;
    c.in = args.in; c.out = args.out; c.ws = args.ws;
    c.lds = (LAS unsigned char*)lds_raw; c.sm = (float*)lds_raw;
    c.dry = 0;
    c.tid = threadIdx.x; c.lane = c.tid & 63; c.wid = __builtin_amdgcn_readfirstlane(c.tid >> 6); c.bid = blockIdx.x; c.G = gridDim.x;
    volatile LAS unsigned* st = (volatile LAS unsigned*)(c.lds + LDS_CTL_OFF);
    if (c.tid < 4) st[c.tid] = 0u;
    __syncthreads();
    XcdBarrier bar; bar.bar = (unsigned*)(args.ws + WS_CTL); bar.x = 0; bar.st = st;
    const bool multi = (args.hi - args.lo) > 1;
    if (multi) bar = xcd_barrier_post((unsigned*)(args.ws + WS_CTL), st);
    const int lo = args.lo, hi = args.hi;
#ifndef REPEAT_PHASE
#define REPEAT_PHASE -1
#endif
#define LAUNDER() do { int t_ = threadIdx.x; asm volatile("" : "+v"(t_)); c.tid = t_; c.lane = t_ & 63; int b_ = blockIdx.x; asm volatile("" : "+s"(b_)); c.bid = b_; } while (0)
#define RUN_PHASE(k, call) if (lo <= (k) && (k) < hi) { if ((k) == REPEAT_PHASE) { LAUNDER(); c.dry = 1; call; c.dry = 0; xcd_barrier(bar); probe_reset(c, (k)); xcd_barrier(bar); } LAUNDER(); call; if ((k) + 1 < hi) xcd_barrier(bar); }
    RUN_PHASE(0, phase0(c))
    RUN_PHASE(1, phase1(c))
    RUN_PHASE(2, phase2(c))
    RUN_PHASE(3, phase3(c))
    RUN_PHASE(4, phase4(c))
    RUN_PHASE(5, phase5(c))
    RUN_PHASE(6, phase6a(c))
    RUN_PHASE(7, phase6b(c))
    RUN_PHASE(8, phase7(c))
    RUN_PHASE(9, phase8(c))
    RUN_PHASE(10, phase9(c))
    RUN_PHASE(11, phase10(c))
    RUN_PHASE(12, phase11(c))
    RUN_PHASE(13, phase12(c))
    RUN_PHASE(14, phase13(c))
    RUN_PHASE(15, phase14(c))
    RUN_PHASE(16, phase15(c))
    RUN_PHASE(17, phase16(c))
#undef RUN_PHASE
}

#ifndef N_LAUNCH_MODE
#define N_LAUNCH_MODE 1
#endif

extern "C" void kernel_launch(void* const* d_in, const int* in_sizes, int n_in, void* d_out, int out_size, void* d_ws, size_t ws_size, hipStream_t stream) {
    static int grid = 0;
    if (grid == 0) {
        if (n_in != 39 || out_size != T * D || ws_size < WS_END) { fprintf(stderr, "kernel_launch: unexpected shapes n_in %d out %d ws %zu\n", n_in, out_size, ws_size); grid = -1; return; }
        int dev = 0, cus = 0, per_cu = 0;
        if (hipGetDevice(&dev) != hipSuccess || hipDeviceGetAttribute(&cus, hipDeviceAttributeMultiprocessorCount, dev) != hipSuccess) { grid = -1; return; }
        if (hipFuncSetAttribute((const void*)mega, hipFuncAttributeMaxDynamicSharedMemorySize, LDS_BYTES) != hipSuccess) { grid = -1; return; }
        if (hipOccupancyMaxActiveBlocksPerMultiprocessor(&per_cu, (const void*)mega, 512, LDS_BYTES) != hipSuccess || per_cu < 1) { fprintf(stderr, "kernel_launch: occupancy query says %d\n", per_cu); }
        (void)hipGetLastError();
        grid = cus;
    }
    if (grid < 0) return;
    (void)hipMemsetAsync((char*)d_ws + WS_CTL, 0, CTL_BYTES, stream);
    Args a{};
    for (int i = 0; i < 39; ++i) a.in[i] = (const float*)d_in[i];
    a.out = (float*)d_out; a.ws = (unsigned char*)d_ws;
    if (N_LAUNCH_MODE == 1) {
        a.lo = 0; a.hi = NPHASES;
        hipLaunchKernelGGL(mega, dim3(grid), dim3(512), LDS_BYTES, stream, a);
    } else {
        for (int ph = 0; ph < NPHASES; ++ph) {
            a.lo = ph; a.hi = ph + 1;
            hipLaunchKernelGGL(mega, dim3(grid), dim3(512), LDS_BYTES, stream, a);
        }
    }
}
```

```cpp
#include <hip/hip_runtime.h>
#include <cstdint>
#include <cstdio>

#define LAS __attribute__((address_space(3)))

constexpr int D = 1024, BATCH = 4, SEQ = 8192, T = BATCH * SEQ;
constexpr int RW = 512, NH = 8;
constexpr int RPROJ = 1792, NPROJ = 2304;
constexpr int S5NG = 32, S5P = 64;
constexpr int NE = 256, EFF = 256;
constexpr int NMODS = 6 * D;
constexpr int S5L = 32;

constexpr size_t MiB = 1u << 20;
constexpr size_t WS_CTL = 0, CTL_BYTES = 1 * MiB;
constexpr size_t WS_COUNTS = 64 * 1024;
constexpr size_t WS_MODS = 1 * MiB;
constexpr size_t WS_HMAT = 2 * MiB;
constexpr size_t WS_WIN_T = 12 * MiB;
constexpr size_t WS_WOUT_T = 17 * MiB;
constexpr size_t WS_WGLU_T = 19 * MiB;
constexpr size_t WS_WSGU_T = 19 * MiB + 512 * 1024;
constexpr size_t WS_WSD_T = 20 * MiB + 512 * 1024;
constexpr size_t WS_WR_T = 21 * MiB;
constexpr size_t WS_LORA_BT = 22 * MiB;
constexpr size_t WS_APOW = 23 * MiB;
constexpr size_t WS_KMAT = 1000 * MiB;
constexpr size_t WS_MODSP = 1020 * MiB;
constexpr size_t WS_S5BB = 1022 * MiB;
constexpr size_t WS_KLAG = 1022 * MiB + 512 * 1024;
constexpr size_t OUT_UX = 0;
constexpr size_t OUT_E = 40 * MiB;
constexpr size_t OUT_ALORA = 56 * MiB;
constexpr size_t OUT_KF = 72 * MiB;
constexpr size_t WS_WED = 24 * MiB;
constexpr size_t WS_WEGU = 152 * MiB;
constexpr size_t WS_A = 408 * MiB;
constexpr size_t WS_YS5 = WS_A + 64 * MiB;
constexpr size_t WS_PROJ = 536 * MiB;
constexpr size_t WS_RW = 680 * MiB;
constexpr size_t RWSZ = (size_t)T * RW * 4;
constexpr size_t RWSZH = (size_t)T * RW * 2;
constexpr size_t WS_RW_W = WS_RW, WS_RW_Y = WS_RW + RWSZ, WS_RW_R = WS_RW + 2 * RWSZ, WS_RW_K = WS_RW_R + RWSZH, WS_RW_V = WS_RW_K + RWSZH,
                 WS_RW_A = WS_RW_V + RWSZH, WS_RW_B = WS_RW_A + RWSZH, WS_RW_G = WS_RW_B + RWSZH;
constexpr size_t WS_CM = WS_PROJ, WS_CN = WS_PROJ + 32 * MiB, WS_CQ = WS_PROJ + 64 * MiB, WS_CY = WS_PROJ + 96 * MiB;
constexpr size_t WS_CS = WS_RW_Y, WS_CBON = WS_RW_Y + 32 * MiB;
constexpr size_t WS_PLOG = 680 * MiB;
constexpr size_t WS_SHOUT = 680 * MiB;
constexpr size_t WS_HS = 808 * MiB;
constexpr size_t WS_IDX = 824 * MiB;
constexpr size_t WS_WT = 825 * MiB;
constexpr size_t WS_SLOTP = 826 * MiB;
constexpr size_t WS_UEXP = 827 * MiB + 512 * 1024;
constexpr size_t WS_SLOTW = 828 * MiB;
constexpr size_t WS_HIST = 831 * MiB;
constexpr size_t WS_HID = 840 * MiB;
constexpr size_t WS_YEXP = 152 * MiB;
constexpr size_t WS_END = 1023 * MiB + 512 * 1024;

constexpr int LDS_BYTES = 132096;
constexpr int LDS_CTL_OFF = 131072;

#define XB_TMO      128
#define XB_XCNT(j)  (256  + 64 * (j))
#define XB_XSUB(j)  (1280 + 64 * (j))
#define XB_XGEN(j)  (2304 + 64 * (j))
#define XB_TOP      3328
#define XB_TOPGEN   3392
#define XCD_BAR_WORDS 3456
#define XB_SPIN_CAP (1u << 24)

__device__ __forceinline__ unsigned xb_ld(unsigned* p)              { return __hip_atomic_load(p, __ATOMIC_RELAXED, __HIP_MEMORY_SCOPE_AGENT); }
__device__ __forceinline__ unsigned xb_add(unsigned* p, unsigned v) { return __hip_atomic_fetch_add(p, v, __ATOMIC_RELAXED, __HIP_MEMORY_SCOPE_AGENT); }
__device__ __forceinline__ unsigned xb_xcc_id() { return (unsigned)__builtin_amdgcn_s_getreg((3 << 11) | 20) & 0xFu; }
#define XB_SPIN(cond, bar) do { unsigned _sp = 0; while (cond) { __builtin_amdgcn_s_sleep(1); \
    if ((++_sp & 255u) == 0u) { if (xb_ld(&(bar)[XB_TMO])) break; if (_sp > XB_SPIN_CAP) { atomicAdd(&(bar)[XB_TMO], 1u); break; } } } } while (0)

struct XcdBarrier { unsigned* bar; unsigned x; volatile LAS unsigned* st; };

__device__ __forceinline__ XcdBarrier xcd_barrier_post(unsigned* bar, volatile LAS unsigned* st) {
    XcdBarrier b; b.bar = bar; b.x = xb_xcc_id(); b.st = st;
    if (threadIdx.x == 0) (void)xb_add(&bar[XB_XCNT(b.x)], 1u);
    return b;
}
__device__ __forceinline__ void xcd_barrier_complete(unsigned* bar, unsigned x, unsigned& nloc, unsigned& nx) {
    const unsigned G = gridDim.x * gridDim.y * gridDim.z;
    unsigned sum, cnt, mine, sp = 0u;
    for (;;) {
        sum = 0u; cnt = 0u; mine = 0u;
#pragma unroll
        for (unsigned j = 0; j < 16; ++j) { const unsigned c = xb_ld(&bar[XB_XCNT(j)]); sum += c; cnt += (c > 0u) ? 1u : 0u; mine = (j == x) ? c : mine; }
        if (sum == G) break;
        __builtin_amdgcn_s_sleep(1);
        if ((++sp & 255u) == 0u) { if (xb_ld(&bar[XB_TMO])) break; if (sp > XB_SPIN_CAP) { atomicAdd(&bar[XB_TMO], 1u); break; } }
    }
    nloc = mine > 0u ? mine : 1u; nx = cnt > 0u ? cnt : 1u;
}
__device__ __forceinline__ void xcd_barrier(const XcdBarrier& b) {
    asm volatile("s_waitcnt vmcnt(0)" ::: "memory");
    __syncthreads();
    if (threadIdx.x == 0) {
        unsigned* bar = b.bar;
        __builtin_amdgcn_s_waitcnt(0);
        unsigned nloc = b.st[0], nx = b.st[1];
        if (nloc == 0u) { xcd_barrier_complete(bar, b.x, nloc, nx); b.st[0] = nloc; b.st[1] = nx; }
        const unsigned old = xb_add(&bar[XB_XSUB(b.x)], 1u);
        const unsigned gen = old / nloc;
        if (old + 1u == (gen + 1u) * nloc) {
            __builtin_amdgcn_fence(__ATOMIC_RELEASE, "agent");
            asm volatile("s_waitcnt vmcnt(0)" ::: "memory");
            const unsigned og = xb_add(&bar[XB_TOP], 1u);
            const unsigned tg = og / nx;
            if (og + 1u == (tg + 1u) * nx) xb_add(&bar[XB_TOPGEN], 1u);
            else XB_SPIN(xb_ld(&bar[XB_TOPGEN]) == tg, bar);
            __builtin_amdgcn_fence(__ATOMIC_ACQUIRE, "agent");
            xb_add(&bar[XB_XGEN(b.x)], 1u);
            asm volatile("s_waitcnt vmcnt(0)" ::: "memory");
        } else {
            XB_SPIN(xb_ld(&bar[XB_XGEN(b.x)]) == gen, bar);
            __builtin_amdgcn_fence(__ATOMIC_ACQUIRE, "agent");
            asm volatile("s_waitcnt vmcnt(0)" ::: "memory");
        }
    }
    __syncthreads();
}

namespace pg8 {
#define PG8_LAS __attribute__((address_space(3)))
typedef unsigned short bf16_t;
typedef short bf16x8 __attribute__((ext_vector_type(8)));
typedef float f32x4 __attribute__((ext_vector_type(4)));
typedef unsigned u32x4 __attribute__((ext_vector_type(4)));
constexpr int BM = 256, BK = 64, HALF = 128, HTB = HALF * BK * 2  , STAGE_BYTES = 8 * HTB, NXCD = 8, WGM = 8;

__host__ __device__ __forceinline__ int lds_byte(int r, int c) { const int st = (r >> 4) * 2 + (c >> 5), rr = r & 15, cc = c & 31, ob = rr * 64 + cc * 2; return st * 1024 + (ob ^ (((ob >> 9) & 1) << 5)); }
__host__ __device__ __forceinline__ void stage_rc(int b, int& R, int& C) { const int st = b / 1024, sb = b % 1024, swz = sb ^ (((sb >> 9) & 1) << 5); R = (st >> 1) * 16 + swz / 64; C = (st & 1) * 32 + (swz % 64) / 2; }
__host__ __device__ __forceinline__ int perm32(int rho) { const int n = rho >> 4, i = rho & 15; return 8 * (i >> 2) + 4 * n + (i & 3); }

struct Unit { int pm, pn; };
struct Gemm { const bf16_t* A; const bf16_t* Bt; int M, N, K; const int* rowtab = nullptr; };

struct StaticOrder {
    int nM, nN, nwg, G, c;
    __host__ __device__ void init(int M, int N, int G_, int c_) { nM = M / BM; nN = N / BM; nwg = nM * nN; G = G_; c = c_; }
    __host__ __device__ bool next(int i, Unit& u) const {
        const long L = (long)i * G + c; if (L >= nwg) return false;
        int wgid = (int)L; { const int q = nwg / NXCD, r = nwg % NXCD, xcd = wgid % NXCD, off = wgid / NXCD; wgid = (xcd < r ? xcd * (q + 1) : r * (q + 1) + (xcd - r) * q) + off; }
        const int nig = WGM * nN, gid = wgid / nig, fm = gid * WGM, gsz = (nM - fm) < WGM ? (nM - fm) : WGM;
        u.pm = fm + ((wgid % nig) % gsz); u.pn = (wgid % nig) / gsz; return true;
    }
    __device__ __forceinline__ void a_ready(const Unit&) const {}
    __device__ __forceinline__ void done(const Unit&) const {}
};

__device__ __forceinline__ unsigned cvt_pk_bf16(float lo, float hi) { unsigned r; asm volatile("v_cvt_pk_bf16_f32 %0, %1, %2" : "=v"(r) : "v"(lo), "v"(hi)); return r; }
typedef float f32x2 __attribute__((ext_vector_type(2)));
__device__ __forceinline__ f32x2 gelu_pk(f32x2 v) {
    const f32x2 av = __builtin_elementwise_abs(v), d = av * 0.2316418882f + 1.0f;
    f32x2 t; t.x = __builtin_amdgcn_rcpf(d.x); t.y = __builtin_amdgcn_rcpf(d.y);
    f32x2 q = t * 0.5307027145f + (-0.7265760135f); q = q * t + 0.7107068705f; q = q * t + (-0.142248368f); q = q * t + 0.127414796f; q = q * t;
    const f32x2 s = (v * v) * (-0.72134752044f);
    f32x2 e; e.x = __builtin_amdgcn_exp2f(s.x); e.y = __builtin_amdgcn_exp2f(s.y);
    const f32x2 m = v * (q * e), r = v - m;
    f32x2 o; o.x = v.x < 0.f ? m.x : r.x; o.y = v.y < 0.f ? m.y : r.y; return o;
}

template <int ACT  > struct EpiBf16 {
    static constexpr bool PERM = true, AFTER_DRAIN = false; static_assert(ACT == 0 || ACT == 1, "EpiBf16: ACT is 0 (none) or 1 (gelu_pk)");
    bf16_t* O; int ldc; const float* bias; int split_cols; size_t split_stride; float scale0;
    __device__ __forceinline__ void operator()(const f32x4 (&acc)[2][2][4][2], const Unit& u, int wr, int wc, int fr, int fq) const {
        const int row0 = u.pm * BM + wr * 64 + fr; int colt = u.pn * BM; bf16_t* base = O;
        float sc = 1.f; if (split_cols) { const int t = colt / split_cols; base += (size_t)t * split_stride; colt -= t * split_cols; if (t == 0) sc = scale0; }
        const int col0 = colt + wc * 32 + 8 * fq, bcol0 = u.pn * BM + wc * 32 + 8 * fq;
        f32x4 bv[2][2];
#pragma unroll
        for (int bj = 0; bj < 2; ++bj)
#pragma unroll
            for (int n = 0; n < 2; ++n) bv[bj][n] = bias ? *(const f32x4*)(bias + bcol0 + bj * HALF + 4 * n) : (f32x4){0.f, 0.f, 0.f, 0.f};
#pragma unroll
        for (int ai = 0; ai < 2; ++ai)
#pragma unroll
            for (int m = 0; m < 4; ++m) { bf16_t* rowp = base + (size_t)(row0 + ai * HALF + m * 16) * ldc + col0;
#pragma unroll
                for (int bj = 0; bj < 2; ++bj) { f32x4 v0 = acc[ai][bj][m][0] + bv[bj][0], v1 = acc[ai][bj][m][1] + bv[bj][1];
                    if (ACT == 1) { f32x2 a = gelu_pk((f32x2){v0[0], v0[1]}), b = gelu_pk((f32x2){v0[2], v0[3]}), c = gelu_pk((f32x2){v1[0], v1[1]}), d = gelu_pk((f32x2){v1[2], v1[3]});
                        v0 = (f32x4){a.x, a.y, b.x, b.y}; v1 = (f32x4){c.x, c.y, d.x, d.y}; }
                    v0 = v0 * sc; v1 = v1 * sc; u32x4 w; w.x = cvt_pk_bf16(v0[0], v0[1]); w.y = cvt_pk_bf16(v0[2], v0[3]); w.z = cvt_pk_bf16(v1[0], v1[1]); w.w = cvt_pk_bf16(v1[2], v1[3]);
                    *(u32x4*)(rowp + bj * HALF) = w; } }
    }
};

struct EpiF32 {
    static constexpr bool PERM = false, AFTER_DRAIN = false;
    float* C; int ldc;
    __device__ __forceinline__ void operator()(const f32x4 (&acc)[2][2][4][2], const Unit& u, int wr, int wc, int fr, int fq) const {
        const int row0 = u.pm * BM + wr * 64 + fr, col0 = u.pn * BM + wc * 32 + 4 * fq;
#pragma unroll
        for (int ai = 0; ai < 2; ++ai)
#pragma unroll
            for (int m = 0; m < 4; ++m) { float* rowp = C + (size_t)(row0 + ai * HALF + m * 16) * ldc + col0;
#pragma unroll
                for (int bj = 0; bj < 2; ++bj)
#pragma unroll
                    for (int n = 0; n < 2; ++n) *(f32x4*)(rowp + bj * HALF + n * 16) = acc[ai][bj][m][n]; }
    }
};
__device__ __forceinline__ float fast_sigmoid(float x) { return __builtin_amdgcn_rcpf(1.0f + __builtin_amdgcn_exp2f(-1.4426950408889634f * x)); }
struct EpiSwiGLU {
    static constexpr bool PERM = true, AFTER_DRAIN = false;
    bf16_t* O; int ldo;
    __device__ __forceinline__ void operator()(const f32x4 (&acc)[2][2][4][2], const Unit& u, int wr, int wc, int fr, int fq) const {
        const int row0 = u.pm * BM + wr * 64 + fr, col0 = (u.pn & 1) * HALF + wc * 32 + 8 * fq;
#pragma unroll
        for (int ai = 0; ai < 2; ++ai)
#pragma unroll
            for (int m = 0; m < 4; ++m) {
                bf16_t* rowp = O + (size_t)(row0 + ai * HALF + m * 16) * ldo + col0;
                const f32x4 g0 = acc[ai][0][m][0], g1 = acc[ai][0][m][1], u0 = acc[ai][1][m][0], u1 = acc[ai][1][m][1];
                float r[8];
#pragma unroll
                for (int i = 0; i < 4; ++i) { r[i] = g0[i] * fast_sigmoid(g0[i]) * u0[i]; r[4 + i] = g1[i] * fast_sigmoid(g1[i]) * u1[i]; }
                u32x4 w; w.x = cvt_pk_bf16(r[0], r[1]); w.y = cvt_pk_bf16(r[2], r[3]); w.z = cvt_pk_bf16(r[4], r[5]); w.w = cvt_pk_bf16(r[6], r[7]);
                *(u32x4*)rowp = w;
            }
    }
};
struct EpiScatter {
    static constexpr bool PERM = true, AFTER_DRAIN = false;
    const int* slotw; bf16_t* Y; int ldy;
    __device__ __forceinline__ void operator()(const f32x4 (&acc)[2][2][4][2], const Unit& u, int wr, int wc, int fr, int fq) const {
        int t2 = threadIdx.x; asm volatile("" : "+v"(t2));
        const int fr2 = t2 & 15, fq2 = (t2 >> 4) & 3, wc2 = (t2 >> 6) & 3, wr2 = (t2 >> 8) & 1;
        const int col0 = (u.pn & 3) * BM + wc2 * 32 + 8 * fq2;
        const int rbase = u.pm * BM + wr2 * 64 + fr2;
        typedef int i32x2 __attribute__((ext_vector_type(2)));
        i32x2 rec[2][4];
#pragma unroll
        for (int ai = 0; ai < 2; ++ai)
#pragma unroll
            for (int m = 0; m < 4; ++m) rec[ai][m] = *(const i32x2*)(slotw + 2 * (size_t)(rbase + ai * HALF + m * 16));
#pragma unroll
        for (int ai = 0; ai < 2; ++ai)
#pragma unroll
            for (int m = 0; m < 4; ++m) {
                const int aid = rec[ai][m].x;
                if (aid >= 0) {
                    const int wbits = rec[ai][m].y;
                    const float w = __int_as_float(wbits);
                    unsigned char* rowp = (unsigned char*)Y + (size_t)aid * ldy + col0;
#pragma unroll
                    for (int bj = 0; bj < 2; ++bj) {
                        f32x4 v0 = acc[ai][bj][m][0] * w, v1 = acc[ai][bj][m][1] * w;
#pragma unroll
                        for (int i = 0; i < 4; ++i) { v0[i] = __builtin_amdgcn_fmed3f(v0[i], -448.0f, 448.0f); v1[i] = __builtin_amdgcn_fmed3f(v1[i], -448.0f, 448.0f); }
                        int lo = 0, hi = 0;
                        lo = __builtin_amdgcn_cvt_pk_fp8_f32(v0[0], v0[1], lo, false); lo = __builtin_amdgcn_cvt_pk_fp8_f32(v0[2], v0[3], lo, true);
                        hi = __builtin_amdgcn_cvt_pk_fp8_f32(v1[0], v1[1], hi, false); hi = __builtin_amdgcn_cvt_pk_fp8_f32(v1[2], v1[3], hi, true);
                        typedef int i32x2s __attribute__((ext_vector_type(2)));
                        *(i32x2s*)(rowp + bj * HALF) = (i32x2s){lo, hi};
                    }
                }
            }
    }
};
struct ExpertOrder {
    const int* uexp; int NU, npn, G, c;
    __device__ __forceinline__ bool next(int i, Unit& u) const {
        const int L = i * G + c; if (L >= NU * npn) return false;
        const int uu = L / npn, pl = L % npn;
        u.pm = uu; u.pn = __builtin_amdgcn_readfirstlane(uexp[uu]) * npn + pl; return true;
    }
    __device__ __forceinline__ void a_ready(const Unit&) const {}
    __device__ __forceinline__ void done(const Unit&) const {}
};
struct EpiRouter {
    static constexpr bool PERM = true, AFTER_DRAIN = false;
    float* P0; bf16_t* P1; bf16_t* P2; int TP;
    __device__ __forceinline__ void operator()(const f32x4 (&acc)[2][2][4][2], const Unit& u, int wr, int wc, int fr, int fq) const {
        const bool lo_rows = u.pm >= TP; const int pmr = lo_rows ? u.pm - TP : u.pm;
        if (lo_rows && u.pn == 1) return;
        const int row0 = pmr * BM + wr * 64 + fr, col0 = wc * 32 + 8 * fq;
#pragma unroll
        for (int ai = 0; ai < 2; ++ai)
#pragma unroll
            for (int m = 0; m < 4; ++m) {
                const size_t off = (size_t)(row0 + ai * HALF + m * 16) * 256 + col0;
#pragma unroll
                for (int bj = 0; bj < 2; ++bj) {
                    const f32x4 v0 = acc[ai][bj][m][0], v1 = acc[ai][bj][m][1];
                    if (!lo_rows && u.pn == 0) { *(f32x4*)(P0 + off + bj * HALF) = v0; *(f32x4*)(P0 + off + bj * HALF + 4) = v1; }
                    else { u32x4 w; w.x = cvt_pk_bf16(v0[0], v0[1]); w.y = cvt_pk_bf16(v0[2], v0[3]); w.z = cvt_pk_bf16(v1[0], v1[1]); w.w = cvt_pk_bf16(v1[2], v1[3]);
                           *(u32x4*)((lo_rows ? P2 : P1) + off + bj * HALF) = w; }
                }
            }
    }
};
struct S5Order {
    int NUNITS, npn, G, c;
    __device__ __forceinline__ bool next(int i, Unit& u) const {
        const int L = i * G + c; if (L >= NUNITS) return false;
        u.pm = L / npn; u.pn = (u.pm >> 2) * npn + L % npn; return true;
    }
    __device__ __forceinline__ void a_ready(const Unit&) const {}
    __device__ __forceinline__ void done(const Unit&) const {}
};
struct EpiS5E {
    static constexpr bool PERM = false, AFTER_DRAIN = false;
    float* E;
    __device__ __forceinline__ void operator()(const f32x4 (&acc)[2][2][4][2], const Unit& u, int wr, int wc, int fr, int fq) const {
        const int row0 = u.pm * BM + wr * 64 + fr, col0 = wc * 32 + 4 * fq;
#pragma unroll
        for (int ai = 0; ai < 2; ++ai)
#pragma unroll
            for (int m = 0; m < 4; ++m) { float* rowp = E + (size_t)(row0 + ai * HALF + m * 16) * 128 + col0;
#pragma unroll
                for (int n = 0; n < 2; ++n) *(f32x4*)(rowp + n * 16) = acc[ai][0][m][n]; }
    }
};
struct EpiS5Out {
    static constexpr bool PERM = true, AFTER_DRAIN = false;
    bf16_t* Y;
    __device__ __forceinline__ void operator()(const f32x4 (&acc)[2][2][4][2], const Unit& u, int wr, int wc, int fr, int fq) const {
        const int g = u.pm >> 2;
#pragma unroll
        for (int ai = 0; ai < 2; ++ai)
#pragma unroll
            for (int m = 0; m < 4; ++m) {
                const int r = (u.pm & 3) * BM + ai * HALF + wr * 64 + m * 16 + fr, b = r >> 8, chunk = r & 255;
#pragma unroll
                for (int bj = 0; bj < 2; ++bj) {
                    const int colg = (u.pn & 1) * BM + bj * HALF + wc * 32 + 8 * fq, t = colg >> 4, c0 = colg & 15;
                    const f32x4 v0 = acc[ai][bj][m][0], v1 = acc[ai][bj][m][1];
                    float x[8] = {v0[0], v0[1], v0[2], v0[3], v1[0], v1[1], v1[2], v1[3]};
#pragma unroll
                    for (int i = 0; i < 8; ++i) { const float z = x[i]; x[i] = z * fast_sigmoid(1.5957691216057308f * (z + 0.044715f * z * z * z)); }
                    u32x4 w; w.x = cvt_pk_bf16(x[0], x[1]); w.y = cvt_pk_bf16(x[2], x[3]); w.z = cvt_pk_bf16(x[4], x[5]); w.w = cvt_pk_bf16(x[6], x[7]);
                    *(u32x4*)(Y + ((size_t)(b * 8192 + chunk * 32 + t)) * 512 + g * 16 + c0) = w;
                }
            }
    }
};
struct EpiLora {
    static constexpr bool PERM = true, AFTER_DRAIN = false;
    const float* w0; const float* a0; const float* k_a; float* W; const bf16_t* Kp; bf16_t* Kf; const bf16_t* A; bf16_t* B; bf16_t* Gt;
    __device__ __forceinline__ void operator()(const f32x4 (&acc)[2][2][4][2], const Unit& u, int wr, int wc, int fr, int fq) const {
        const int seg = u.pn >> 1;
#pragma unroll
        for (int bj = 0; bj < 2; ++bj) {
            const int nn = (u.pn & 1) * BM + bj * HALF + wc * 32 + 8 * fq;
            float p0[8], p1[8];
            if (seg == 0) { const f32x4 a = *(const f32x4*)(w0 + nn), b = *(const f32x4*)(w0 + nn + 4); p0[0] = a[0]; p0[1] = a[1]; p0[2] = a[2]; p0[3] = a[3]; p0[4] = b[0]; p0[5] = b[1]; p0[6] = b[2]; p0[7] = b[3]; }
            else if (seg == 1) { const f32x4 a = *(const f32x4*)(a0 + nn), b = *(const f32x4*)(a0 + nn + 4), cc = *(const f32x4*)(k_a + nn), d = *(const f32x4*)(k_a + nn + 4);
                p0[0] = a[0]; p0[1] = a[1]; p0[2] = a[2]; p0[3] = a[3]; p0[4] = b[0]; p0[5] = b[1]; p0[6] = b[2]; p0[7] = b[3];
                p1[0] = cc[0]; p1[1] = cc[1]; p1[2] = cc[2]; p1[3] = cc[3]; p1[4] = d[0]; p1[5] = d[1]; p1[6] = d[2]; p1[7] = d[3]; }
#pragma unroll
            for (int ai = 0; ai < 2; ++ai)
#pragma unroll
                for (int m = 0; m < 4; ++m) {
                    const size_t off = (size_t)(u.pm * BM + ai * HALF + wr * 64 + m * 16 + fr) * 512 + nn;
                    const f32x4 v0 = acc[ai][bj][m][0], v1 = acc[ai][bj][m][1];
                    const float x[8] = {v0[0], v0[1], v0[2], v0[3], v1[0], v1[1], v1[2], v1[3]};
                    if (seg == 0) {
                        float o[8];
#pragma unroll
                        for (int i = 0; i < 8; ++i) { const float wa = p0[i] + x[i];
                            o[i] = __builtin_amdgcn_exp2f(-0.8750387749145276f * fast_sigmoid(wa)); }
                        *(f32x4*)(W + off) = (f32x4){o[0], o[1], o[2], o[3]}; *(f32x4*)(W + off + 4) = (f32x4){o[4], o[5], o[6], o[7]};
                    } else if (seg == 1) {
                        const u32x4 kv = *(const u32x4*)(Kp + off), av = *(const u32x4*)(A + off);
                        const float k[8] = {__builtin_bit_cast(float, kv.x << 16), __builtin_bit_cast(float, kv.x & 0xffff0000u), __builtin_bit_cast(float, kv.y << 16), __builtin_bit_cast(float, kv.y & 0xffff0000u),
                                            __builtin_bit_cast(float, kv.z << 16), __builtin_bit_cast(float, kv.z & 0xffff0000u), __builtin_bit_cast(float, kv.w << 16), __builtin_bit_cast(float, kv.w & 0xffff0000u)};
                        const float a[8] = {__builtin_bit_cast(float, av.x << 16), __builtin_bit_cast(float, av.x & 0xffff0000u), __builtin_bit_cast(float, av.y << 16), __builtin_bit_cast(float, av.y & 0xffff0000u),
                                            __builtin_bit_cast(float, av.z << 16), __builtin_bit_cast(float, av.z & 0xffff0000u), __builtin_bit_cast(float, av.w << 16), __builtin_bit_cast(float, av.w & 0xffff0000u)};
                        float kf[8], bo[8];
#pragma unroll
                        for (int i = 0; i < 8; ++i) { const float ic = fast_sigmoid(p0[i] + x[i]); kf[i] = k[i] * (1.0f + (ic - 1.0f) * p1[i]); bo[i] = -a[i] * ic; }
                        u32x4 w; w.x = cvt_pk_bf16(kf[0], kf[1]); w.y = cvt_pk_bf16(kf[2], kf[3]); w.z = cvt_pk_bf16(kf[4], kf[5]); w.w = cvt_pk_bf16(kf[6], kf[7]);
                        *(u32x4*)(Kf + off) = w;
                        w.x = cvt_pk_bf16(bo[0], bo[1]); w.y = cvt_pk_bf16(bo[2], bo[3]); w.z = cvt_pk_bf16(bo[4], bo[5]); w.w = cvt_pk_bf16(bo[6], bo[7]);
                        *(u32x4*)(B + off) = w;
                    } else {
                        u32x4 w; w.x = cvt_pk_bf16(x[0], x[1]); w.y = cvt_pk_bf16(x[2], x[3]); w.z = cvt_pk_bf16(x[4], x[5]); w.w = cvt_pk_bf16(x[6], x[7]);
                        *(u32x4*)(Gt + off) = w;
                    }
                }
        }
    }
};
struct EpiGLU {
    static constexpr bool PERM = true, AFTER_DRAIN = false;
    const bf16_t* Y; int ldy; const float* bias; bf16_t* O; int ldo; int ocol0;
    __device__ __forceinline__ void operator()(const f32x4 (&acc)[2][2][4][2], const Unit& u, int wr, int wc, int fr, int fq) const {
        const int row0 = u.pm * BM + wr * 64 + fr, col0 = u.pn * BM + wc * 32 + 8 * fq;
#pragma unroll
        for (int bj = 0; bj < 2; ++bj) {
            const f32x4 b0 = *(const f32x4*)(bias + col0 + bj * HALF), b1 = *(const f32x4*)(bias + col0 + bj * HALF + 4);
#pragma unroll
            for (int ai = 0; ai < 2; ++ai)
#pragma unroll
                for (int m = 0; m < 4; ++m) {
                    const size_t row = (size_t)(row0 + ai * HALF + m * 16);
                    const u32x4 yv = *(const u32x4*)(Y + row * ldy + col0 + bj * HALF);
                    const f32x4 z0 = acc[ai][bj][m][0] + b0, z1 = acc[ai][bj][m][1] + b1;
                    float y[8] = {__builtin_bit_cast(float, yv.x << 16), __builtin_bit_cast(float, yv.x & 0xffff0000u), __builtin_bit_cast(float, yv.y << 16), __builtin_bit_cast(float, yv.y & 0xffff0000u),
                                  __builtin_bit_cast(float, yv.z << 16), __builtin_bit_cast(float, yv.z & 0xffff0000u), __builtin_bit_cast(float, yv.w << 16), __builtin_bit_cast(float, yv.w & 0xffff0000u)};
                    float r[8];
#pragma unroll
                    for (int i = 0; i < 4; ++i) { r[i] = y[i] * fast_sigmoid(z0[i]); r[4 + i] = y[4 + i] * fast_sigmoid(z1[i]); }
                    u32x4 w; w.x = cvt_pk_bf16(r[0], r[1]); w.y = cvt_pk_bf16(r[2], r[3]); w.z = cvt_pk_bf16(r[4], r[5]); w.w = cvt_pk_bf16(r[6], r[7]);
                    *(u32x4*)(O + row * ldo + ocol0 + col0 + bj * HALF) = w;
                }
        }
    }
};
template <class Epi, class Sched, bool ALIGN_EPI = false, bool SP2 = false, bool GATHER = false>
__device__ __forceinline__ void gemm_phase(PG8_LAS unsigned char* lds, const Gemm g, const Sched& S, const Epi& E) {
    int tid_ = threadIdx.x; asm volatile("" : "+v"(tid_));
    const int tid = tid_, wid = __builtin_amdgcn_readfirstlane(tid >> 6), lane = tid & 63, wr = wid >> 2, wc = wid & 3, fr = lane & 15, fq = lane >> 4;
    const int K = g.K, nt = K / BK;
    unsigned voffA[2], voffB[2];
#pragma unroll
    for (int i = 0; i < 2; ++i) { int R, C; stage_rc(tid * 16 + i * 8192, R, C); const int Rb = Epi::PERM ? ((R & ~31) + perm32(R & 31)) : R;
        voffA[i] = (unsigned)(R * K + C) * 2u; voffB[i] = (unsigned)(Rb * K + C) * 2u; }
    const size_t kstep = (size_t)(BK * 2);
    const size_t hstep = (size_t)HALF * K * 2;
    const size_t tstep = 2 * hstep;
    const unsigned ldsw = (unsigned)wid * 1024u;
    const int aoff = lds_byte(wr * 64 + fr, fq * 8), boff = lds_byte(wc * 32 + fr, fq * 8);
#define PG8_SA(b, h) (((b) * 2 + (h)) * HTB)
#define PG8_SB(b, h) ((4 + (b) * 2 + (h)) * HTB)
#define PG8_STAGE(bufoff, gbase, voff) do { _Pragma("unroll") for (int _i = 0; _i < 2; ++_i) \
        __builtin_amdgcn_global_load_lds((const unsigned*)((const char*)(gbase) + (voff)[_i]), (PG8_LAS unsigned*)(lds + (bufoff) + ldsw + _i * 8192), 16, 0, 0); } while (0)
#define PG8_STAGE_A(bufoff, kptr, h, NEXTSEL) do { if constexpr (GATHER) { const unsigned _p = (NEXTSEL) ? gnxt[h] : gcur[h]; const unsigned _v[2] = { (_p & 0xffffu) * (unsigned)(2 * K) + gC2, (_p >> 16) * (unsigned)(2 * K) + gC2 }; PG8_STAGE(bufoff, kptr, _v); } \
        else { PG8_STAGE(bufoff, (kptr) + (h) * hstep, voffA); } } while (0)
#define PG8_LDA(dst, b, h) do { _Pragma("unroll") for (int m = 0; m < 4; ++m) _Pragma("unroll") for (int k = 0; k < 2; ++k) dst[m][k] = *(const PG8_LAS bf16x8*)(lds + PG8_SA(b, h) + aoff + m * 2048 + k * 1024); } while (0)
#define PG8_LDB(dst, b, h) do { _Pragma("unroll") for (int n = 0; n < 2; ++n) _Pragma("unroll") for (int k = 0; k < 2; ++k) dst[n][k] = *(const PG8_LAS bf16x8*)(lds + PG8_SB(b, h) + boff + n * 2048 + k * 1024); } while (0)
#define PG8_MMA(ai, bj, At, Bt) do { __builtin_amdgcn_s_setprio(1); _Pragma("unroll") for (int m = 0; m < 4; ++m) _Pragma("unroll") for (int n = 0; n < 2; ++n) _Pragma("unroll") for (int k = 0; k < 2; ++k) \
        acc[ai][bj][m][n] = __builtin_amdgcn_mfma_f32_16x16x32_bf16(Bt[n][k], At[m][k], acc[ai][bj][m][n], 0, 0, 0); __builtin_amdgcn_s_setprio(0); } while (0)
#define PG8_WAIT_V(n) asm volatile("s_waitcnt vmcnt(" #n ")" ::: "memory")
#define PG8_WAIT_L(n) asm volatile("s_waitcnt lgkmcnt(" #n ")" ::: "memory")
#define PG8_BAR __builtin_amdgcn_s_barrier()
#define PG8_SCHED __builtin_amdgcn_sched_barrier(0)
    unsigned gcur[2], gnxt[2], gC2 = 0;
    if constexpr (GATHER) { int R, C; stage_rc(tid * 16, R, C); gC2 = (unsigned)C * 2u; }
    auto load_gather = [&](int pm, unsigned (&dst)[2]) {
        int R, C; stage_rc(tid * 16, R, C);
#pragma unroll
        for (int h = 0; h < 2; ++h) { int a0 = g.rowtab[pm * BM + h * HALF + R], a1 = g.rowtab[pm * BM + h * HALF + R + 64]; a0 = a0 < 0 ? 0 : a0; a1 = a1 < 0 ? 0 : a1; dst[h] = (unsigned)(a0 >> 3) | ((unsigned)(a1 >> 3) << 16); }
    };
    Unit cur, nxt; int ui = 0;
    if (!S.next(0, cur)) return;
    f32x4 acc[2][2][4][2];
#pragma unroll
    for (int a = 0; a < 2; ++a)
#pragma unroll
        for (int b = 0; b < 2; ++b)
#pragma unroll
            for (int m = 0; m < 4; ++m)
#pragma unroll
                for (int n = 0; n < 2; ++n) acc[a][b][m][n] = (f32x4){0.f, 0.f, 0.f, 0.f};
    bf16x8 At[4][2], B0[2][2], B1[2][2];
    const char* cA = (const char*)g.A + (GATHER ? (size_t)0 : (size_t)cur.pm * tstep); const char* cB = (const char*)g.Bt + (size_t)cur.pn * tstep;
    if constexpr (GATHER) { load_gather(cur.pm, gcur); }
    S.a_ready(cur);
    if constexpr (SP2) {
        PG8_STAGE(PG8_SB(0, 0), cB, voffB); PG8_STAGE(PG8_SB(0, 1), cB + hstep, voffB); PG8_STAGE_A(PG8_SA(0, 0), cA, 0, false); PG8_STAGE_A(PG8_SA(0, 1), cA, 1, false);
        if (wr == 1) PG8_BAR;
        PG8_WAIT_V(2); PG8_BAR;
        PG8_STAGE(PG8_SB(1, 0), cB + kstep, voffB); PG8_STAGE_A(PG8_SA(1, 0), cA + kstep, 0, false); PG8_STAGE(PG8_SB(1, 1), cB + hstep + kstep, voffB);
        PG8_WAIT_V(6); PG8_BAR;
    } else {
        PG8_STAGE(PG8_SB(0, 0), cB, voffB); PG8_STAGE_A(PG8_SA(0, 0), cA, 0, false); PG8_STAGE(PG8_SB(0, 1), cB + hstep, voffB); PG8_STAGE_A(PG8_SA(0, 1), cA, 1, false);
        if (wr == 1) PG8_BAR;
        PG8_WAIT_V(4); PG8_BAR;
        PG8_STAGE(PG8_SB(1, 0), cB + kstep, voffB); PG8_STAGE_A(PG8_SA(1, 0), cA + kstep, 0, false); PG8_STAGE(PG8_SB(1, 1), cB + hstep + kstep, voffB);
        PG8_WAIT_V(6); PG8_BAR;
    }
    for (;;) {
        const bool has_next = S.next(ui + 1, nxt);
        const char* nA = (has_next && !GATHER) ? (const char*)g.A + (size_t)nxt.pm * tstep : cA; const char* nB = has_next ? (const char*)g.Bt + (size_t)nxt.pn * tstep : cB;
        if constexpr (GATHER) { if (has_next) load_gather(nxt.pm, gnxt); else {
#pragma unroll
            for (int h = 0; h < 2; ++h) { gnxt[h] = gcur[h]; } } }
        for (int t = 0; t < nt; t += 2) {
            const bool last = (t == nt - 2);
            const char* a1 = cA + (size_t)(t + 1) * kstep;
            const char* a2 = last ? nA : cA + (size_t)(t + 2) * kstep; const char* b2 = last ? nB : cB + (size_t)(t + 2) * kstep;
            const char* a3 = a2 + kstep; const char* b3 = b2 + kstep;
            if (last && has_next) S.a_ready(nxt);
            if constexpr (SP2) {
            PG8_LDB(B0, 0, 0); PG8_LDB(B1, 0, 1); PG8_SCHED; PG8_LDA(At, 0, 0); PG8_STAGE_A(PG8_SA(1, 1), a1, 1, false);
            PG8_WAIT_V(8); PG8_WAIT_L(0); PG8_BAR; PG8_MMA(0, 0, At, B0); PG8_MMA(0, 1, At, B1); PG8_BAR; PG8_SCHED;
            PG8_LDA(At, 0, 1); PG8_STAGE(PG8_SB(0, 0), b2, voffB); PG8_STAGE(PG8_SB(0, 1), b2 + hstep, voffB); PG8_STAGE_A(PG8_SA(0, 0), a2, 0, last);
            PG8_WAIT_V(8); PG8_WAIT_L(0); PG8_BAR; PG8_MMA(1, 0, At, B0); PG8_MMA(1, 1, At, B1); PG8_BAR; PG8_SCHED;
            PG8_LDB(B0, 1, 0); PG8_LDB(B1, 1, 1); PG8_SCHED; PG8_LDA(At, 1, 0); PG8_STAGE_A(PG8_SA(0, 1), a2, 1, last);
            PG8_WAIT_V(8); PG8_WAIT_L(0); PG8_BAR; PG8_MMA(0, 0, At, B0); PG8_MMA(0, 1, At, B1); PG8_BAR; PG8_SCHED;
            PG8_LDA(At, 1, 1); PG8_STAGE(PG8_SB(1, 0), b3, voffB); PG8_STAGE(PG8_SB(1, 1), b3 + hstep, voffB); PG8_STAGE_A(PG8_SA(1, 0), a3, 0, last);
            PG8_WAIT_V(8); PG8_WAIT_L(0); PG8_BAR; PG8_MMA(1, 0, At, B0); PG8_MMA(1, 1, At, B1); PG8_BAR; PG8_SCHED;
            } else {
            PG8_LDB(B0, 0, 0); PG8_SCHED; PG8_LDA(At, 0, 0); PG8_STAGE_A(PG8_SA(1, 1), a1, 1, false);
            PG8_WAIT_L(8); PG8_BAR; PG8_WAIT_L(0); PG8_MMA(0, 0, At, B0); PG8_BAR; PG8_SCHED;
            PG8_LDB(B1, 0, 1); PG8_STAGE(PG8_SB(0, 0), b2, voffB);
            PG8_BAR; PG8_WAIT_L(0); PG8_MMA(0, 1, At, B1); PG8_BAR;
            PG8_LDA(At, 0, 1); PG8_STAGE_A(PG8_SA(0, 0), a2, 0, last);
            PG8_BAR; PG8_WAIT_L(0); PG8_MMA(1, 0, At, B0); PG8_BAR; PG8_SCHED;
            PG8_STAGE(PG8_SB(0, 1), b2 + hstep, voffB);
            PG8_WAIT_V(6); PG8_BAR; PG8_MMA(1, 1, At, B1); PG8_BAR;
            PG8_LDB(B0, 1, 0); PG8_SCHED; PG8_LDA(At, 1, 0); PG8_STAGE_A(PG8_SA(0, 1), a2, 1, last);
            PG8_WAIT_L(8); PG8_BAR; PG8_WAIT_L(0); PG8_MMA(0, 0, At, B0); PG8_BAR; PG8_SCHED;
            PG8_LDB(B1, 1, 1); PG8_STAGE(PG8_SB(1, 0), b3, voffB);
            PG8_BAR; PG8_WAIT_L(0); PG8_MMA(0, 1, At, B1); PG8_BAR;
            PG8_LDA(At, 1, 1); PG8_STAGE_A(PG8_SA(1, 0), a3, 0, last);
            PG8_BAR; PG8_WAIT_L(0); PG8_MMA(1, 0, At, B0); PG8_BAR; PG8_SCHED;
            PG8_STAGE(PG8_SB(1, 1), b3 + hstep, voffB);
            PG8_WAIT_V(6); PG8_BAR; PG8_MMA(1, 1, At, B1); PG8_BAR;
            }
        }
        if constexpr (ALIGN_EPI) { if (wr == 0) PG8_BAR; }
        if constexpr (!Epi::AFTER_DRAIN) { E(acc, cur, wr, wc, fr, fq); S.done(cur); }
        if (!has_next) break;
#pragma unroll
        for (int a = 0; a < 2; ++a)
#pragma unroll
            for (int b = 0; b < 2; ++b)
#pragma unroll
                for (int m = 0; m < 4; ++m)
#pragma unroll
                    for (int n = 0; n < 2; ++n) acc[a][b][m][n] = (f32x4){0.f, 0.f, 0.f, 0.f};
        cur = nxt; cA = nA; cB = nB; ++ui;
        if constexpr (GATHER) {
#pragma unroll
            for (int h = 0; h < 2; ++h) { gcur[h] = gnxt[h]; } }
        if constexpr (ALIGN_EPI) { if (wr == 1) PG8_BAR; }
    }
    PG8_WAIT_V(0);
    if constexpr (!ALIGN_EPI) { if (wr == 0) PG8_BAR; }
    PG8_BAR;
    if constexpr (Epi::AFTER_DRAIN) { E.fused(acc, cur, wr, wc, fr, fq, lds, wid, lane); S.done(cur); }
#undef PG8_SA
#undef PG8_SB
#undef PG8_STAGE
#undef PG8_STAGE_A
#undef PG8_LDA
#undef PG8_LDB
#undef PG8_MMA
#undef PG8_WAIT_V
#undef PG8_WAIT_L
#undef PG8_BAR
#undef PG8_SCHED
}
}

typedef unsigned short bf16_t;
__device__ __forceinline__ unsigned f2bf(float f) { unsigned u = __builtin_bit_cast(unsigned, f); return (u + 0x7fffu + ((u >> 16) & 1u)) >> 16; }
__device__ __forceinline__ float bf2f(unsigned h) { return __builtin_bit_cast(float, h << 16); }
__device__ __forceinline__ float wave_sum(float v) {
#pragma unroll
    for (int o = 1; o < 64; o <<= 1) v += __shfl_xor(v, o);
    return v;
}
__device__ __forceinline__ float sigmoidf_(float x) { return 1.0f / (1.0f + expf(-x)); }
__device__ __forceinline__ float siluf_(float x) { return x / (1.0f + expf(-x)); }
__device__ __forceinline__ float softplusf_(float x) { return fmaxf(x, 0.0f) + log1pf(expf(-fabsf(x))); }
__device__ __forceinline__ float geluf_(float x) { const float u = 0.7978845608028654f * (x + 0.044715f * x * x * x); return 0.5f * x * (1.0f + tanhf(u)); }

struct Args { const float* in[39]; float* out; unsigned char* ws; int lo, hi; };

struct Ctx {
    const float* const* in; float* out; unsigned char* ws;
    LAS unsigned char* lds; float* sm;
    int tid, lane, wid, bid, G, dry;
};

__device__ __forceinline__ unsigned pk2(float lo, float hi) { return f2bf(lo) | (f2bf(hi) << 16); }
__device__ __forceinline__ float ldbf(const bf16_t* p) { return bf2f((unsigned)*p); }
typedef unsigned v4u_t __attribute__((ext_vector_type(4)));
typedef unsigned v2u_t __attribute__((ext_vector_type(2)));
__device__ __forceinline__ void st16(void* p, uint4 v) { const v4u_t d = {v.x, v.y, v.z, v.w}; asm volatile("global_store_dwordx4 %0, %1, off\n\ts_nop 1" :: "v"(p), "v"(d) : "memory"); }
__device__ __forceinline__ void st16f(void* p, float4 v) { st16(p, make_uint4(__float_as_uint(v.x), __float_as_uint(v.y), __float_as_uint(v.z), __float_as_uint(v.w))); }
__device__ __forceinline__ void st8(void* p, uint2 v) { const v2u_t d = {v.x, v.y}; asm volatile("global_store_dwordx2 %0, %1, off\n\ts_nop 1" :: "v"(p), "v"(d) : "memory"); }
__device__ __forceinline__ void st4(void* p, unsigned v) { asm volatile("global_store_dword %0, %1, off\n\ts_nop 1" :: "v"(p), "v"(v) : "memory"); }
__device__ __forceinline__ void st2(void* p, unsigned v) { asm volatile("global_store_short %0, %1, off\n\ts_nop 1" :: "v"(p), "v"(v) : "memory"); }
__device__ __forceinline__ float4 ldbf4(const bf16_t* p) { const uint2 v = *(const uint2*)p; return make_float4(bf2f(v.x & 0xffffu), bf2f(v.x >> 16), bf2f(v.y & 0xffffu), bf2f(v.y >> 16)); }

template <int NB, class AF, class BF, class BF2, class EF>
__device__ __forceinline__ void gemm_tile(float* sm, int K, AF af, BF bf, BF2 bf2, EF ef) {
    float* As = sm;
    float* Bs = sm + 16 * 132;
    float* Bs2 = Bs + 16 * 68;
    const int tid = threadIdx.x, ty = tid >> 4, tx = tid & 15;
    const int am = tid >> 2, ak = (tid & 3) * 4;
    const int bt = tid & 255, bk = bt >> 4, bn = (bt & 15) * 4;
    float acc[4][4], acc2[4][4];
#pragma unroll
    for (int i = 0; i < 4; ++i)
#pragma unroll
        for (int j = 0; j < 4; ++j) { acc[i][j] = 0.f; acc2[i][j] = 0.f; }
    float4 av = af(am, ak);
    float4 bv = make_float4(0.f, 0.f, 0.f, 0.f);
    if (tid < 256) bv = bf(bk, bn); else if (NB == 2) bv = bf2(bk, bn);
    for (int k0 = 0; k0 < K; k0 += 16) {
        __syncthreads();
        As[(ak + 0) * 132 + am] = av.x; As[(ak + 1) * 132 + am] = av.y; As[(ak + 2) * 132 + am] = av.z; As[(ak + 3) * 132 + am] = av.w;
        if (tid < 256) *(float4*)&Bs[bk * 68 + bn] = bv; else if (NB == 2) *(float4*)&Bs2[bk * 68 + bn] = bv;
        __syncthreads();
        if (k0 + 16 < K) {
            av = af(am, k0 + 16 + ak);
            if (tid < 256) bv = bf(k0 + 16 + bk, bn); else if (NB == 2) bv = bf2(k0 + 16 + bk, bn);
        }
#pragma unroll
        for (int kk = 0; kk < 16; ++kk) {
            const float4 a = *(const float4*)&As[kk * 132 + ty * 4];
            const float4 b = *(const float4*)&Bs[kk * 68 + tx * 4];
            const float aa[4] = {a.x, a.y, a.z, a.w};
            const float bb[4] = {b.x, b.y, b.z, b.w};
#pragma unroll
            for (int i = 0; i < 4; ++i)
#pragma unroll
                for (int j = 0; j < 4; ++j) acc[i][j] = fmaf(aa[i], bb[j], acc[i][j]);
            if (NB == 2) {
                const float4 b2 = *(const float4*)&Bs2[kk * 68 + tx * 4];
                const float bb2[4] = {b2.x, b2.y, b2.z, b2.w};
#pragma unroll
                for (int i = 0; i < 4; ++i)
#pragma unroll
                    for (int j = 0; j < 4; ++j) acc2[i][j] = fmaf(aa[i], bb2[j], acc2[i][j]);
            }
        }
    }
#pragma unroll
    for (int i = 0; i < 4; ++i)
        ef(ty * 4 + i, tx * 4, make_float4(acc[i][0], acc[i][1], acc[i][2], acc[i][3]), make_float4(acc2[i][0], acc2[i][1], acc2[i][2], acc2[i][3]));
}

__device__ __forceinline__ void transpose_load(const float* W, int N, int nblk, int item, int lane, float (&r)[32]) {
    const int kb = item / nblk, nb = item % nblk, k0 = 64 * kb, n0 = 32 * nb;
#pragma unroll
    for (int i = 0; i < 8; ++i) { const int kk = 8 * i + (lane >> 3); const float4 v = *(const float4*)(W + (size_t)(k0 + kk) * N + n0 + (lane & 7) * 4);
        r[4 * i] = v.x; r[4 * i + 1] = v.y; r[4 * i + 2] = v.z; r[4 * i + 3] = v.w; }
}
template <bool RES, class RM>
__device__ __forceinline__ void transpose_finish(int K, int nblk, bf16_t* WT, RM rowmap, float* scr, int item, int lane, const float (&r)[32]) {
    const int kb = item / nblk, nb = item % nblk, k0 = 64 * kb, n0 = 32 * nb;
#pragma unroll
    for (int i = 0; i < 8; ++i) { const int kk = 8 * i + (lane >> 3), nn = (lane & 7) * 4;
        scr[kk * 33 + nn] = r[4 * i]; scr[kk * 33 + nn + 1] = r[4 * i + 1]; scr[kk * 33 + nn + 2] = r[4 * i + 2]; scr[kk * 33 + nn + 3] = r[4 * i + 3]; }
    asm volatile("s_waitcnt lgkmcnt(0)" ::: "memory");
    const int c = lane & 7;
    const int r0 = rowmap(n0);
#pragma unroll
    for (int j = 0; j < 4; ++j) {
        const int n = (lane >> 3) + 8 * j; const float* s = scr + (8 * c) * 33 + n;
        float v[8];
#pragma unroll
        for (int q = 0; q < 8; ++q) { v[q] = s[q * 33]; if (RES) v[q] = v[q] - bf2f(f2bf(v[q])); }
        uint4 o; o.x = pk2(v[0], v[1]); o.y = pk2(v[2], v[3]); o.z = pk2(v[4], v[5]); o.w = pk2(v[6], v[7]);
        st16(WT + (size_t)(r0 + n) * K + k0 + 8 * c, o);
    }
    asm volatile("s_waitcnt lgkmcnt(0)" ::: "memory");
}
template <bool RES, class RM>
__device__ __forceinline__ void transpose_item(const float* W, int K, int N, bf16_t* WT, RM rowmap, float* scr, int item, int lane) {
    float r[32];
    transpose_load(W, N, N / 32, item, lane, r);
    transpose_finish<RES>(K, N / 32, WT, rowmap, scr, item, lane, r);
}

__device__ __forceinline__ void convert_expert_weights(const Ctx& c, const int lo, const int hi, int first, int stride) {
    float* scr = c.sm + c.wid * (64 * 33);
    float ra[32], rb[32];
    auto src = [&](int it, const float*& W, int& N, int& nblk, int& item) {
        const int e = it / 384, r = it % 384;
        if (r < 128) { W = c.in[33] + (size_t)e * D * EFF; N = EFF; nblk = EFF / 32; item = r; }
        else if (r < 256) { W = c.in[34] + (size_t)e * D * EFF; N = EFF; nblk = EFF / 32; item = r - 128; }
        else { W = c.in[35] + (size_t)e * EFF * D; N = D; nblk = D / 32; item = r - 256; }
    };
    auto fin = [&](int it, const float (&rg)[32]) {
        const int e = it / 384, r = it % 384;
        if (r < 128) transpose_finish<false>(D, EFF / 32, (bf16_t*)(c.ws + WS_WEGU) + (size_t)e * 512 * D, [](int n) { return (n >> 7) * 256 + (n & 127); }, scr, r, c.lane, rg);
        else if (r < 256) transpose_finish<false>(D, EFF / 32, (bf16_t*)(c.ws + WS_WEGU) + (size_t)e * 512 * D, [](int n) { return (n >> 7) * 256 + 128 + (n & 127); }, scr, r - 128, c.lane, rg);
        else transpose_finish<false>(EFF, D / 32, (bf16_t*)(c.ws + WS_WED) + (size_t)e * D * EFF, [](int n) { return n; }, scr, r - 256, c.lane, rg);
    };
    float rc[32];
    auto ld = [&](int it_, float (&rg)[32]) { if (it_ < hi) { const float* W; int N, nblk, item; src(it_, W, N, nblk, item); transpose_load(W, N, nblk, item, c.lane, rg); } };
    int it = lo + first;
    if (it >= hi) return;
    ld(it, ra); ld(it + stride, rb);
    for (;;) {
        ld(it + 2 * stride, rc); fin(it, ra); if (it + stride >= hi) break;
        ld(it + 3 * stride, ra); fin(it + stride, rb); if (it + 2 * stride >= hi) break;
        ld(it + 4 * stride, rb); fin(it + 2 * stride, rc); if (it + 3 * stride >= hi) break;
        it += 3 * stride;
    }
}

__device__ __forceinline__ void phase0(const Ctx& c) {
    const int gt = c.bid * 512 + c.tid, NT = c.G * 512;
    const int gw = c.bid * 8 + c.wid, NW = c.G * 8;
    {
        const float* cc = c.in[1]; const float* w_ada = c.in[2];
        float* modsp = (float*)(c.ws + WS_MODSP);
        for (int task = gw; task < 96 * 16; task += NW) {
            const int cg = task % 96, ks = task / 96, j = cg * 64 + c.lane;
            float a0 = 0.f, a1 = 0.f, a2 = 0.f, a3 = 0.f;
#pragma unroll 4
            for (int k = ks * 64; k < ks * 64 + 64; ++k) {
                const float wv = w_ada[(size_t)k * NMODS + j];
                a0 = fmaf(siluf_(cc[k]), wv, a0); a1 = fmaf(siluf_(cc[D + k]), wv, a1); a2 = fmaf(siluf_(cc[2 * D + k]), wv, a2); a3 = fmaf(siluf_(cc[3 * D + k]), wv, a3);
            }
            modsp[(ks * 4 + 0) * NMODS + j] = a0; modsp[(ks * 4 + 1) * NMODS + j] = a1; modsp[(ks * 4 + 2) * NMODS + j] = a2; modsp[(ks * 4 + 3) * NMODS + j] = a3;
        }
    }
    {
        const float* log_dt = c.in[20]; const float* a_re = c.in[21]; const float* a_im = c.in[22];
        const float* b_re = c.in[23]; const float* b_im = c.in[24];
        float* apow = (float*)(c.ws + WS_APOW); float* bb = (float*)(c.ws + WS_S5BB);
        for (int idx = gt; idx < S5NG * S5P; idx += NT) {
            const int g = idx / S5P, p = idx % S5P;
            const double dt = exp((double)log_dt[g]);
            const double lre = fmin((double)a_re[idx], -1e-4), lim = (double)a_im[idx];
            const double mag = exp(lre * dt), ang = lim * dt;
            const double abr = mag * cos(ang), abi = mag * sin(ang);
            const double den = lre * lre + lim * lim;
            const double nre = abr - 1.0, nim = abi;
            const double qre = (nre * lre + nim * lim) / den, qim = (nim * lre - nre * lim) / den;
            double pr = 1.0, pi = 0.0;
            for (int j = 0; j <= S5L; ++j) {
                apow[((size_t)(g * (S5L + 1) + j) * 64 + p) * 2 + 0] = (float)pr; apow[((size_t)(g * (S5L + 1) + j) * 64 + p) * 2 + 1] = (float)pi;
                const double nr = pr * abr - pi * abi, ni = pr * abi + pi * abr; pr = nr; pi = ni;
            }
            for (int ch = 0; ch < 16; ++ch) {
                const double br = (double)b_re[idx * 16 + ch], bi = (double)b_im[idx * 16 + ch];
                bb[idx * 32 + ch] = (float)(qre * br - qim * bi);
                bb[idx * 32 + 16 + ch] = (float)(qre * bi + qim * br);
            }
        }
    }
    {
        const float* w2 = c.in[11]; const float* a2 = c.in[13]; const float* g2 = c.in[14];
        bf16_t* bt = (bf16_t*)(c.ws + WS_LORA_BT);
        for (int it = gt; it < 1536 * 32; it += NT) {
            const int n = it >> 5, c0 = (it & 31) * 8;
            float v[8];
#pragma unroll
            for (int i = 0; i < 8; ++i) {
                const int col = c0 + i; float x = 0.f;
                if (n < 512) { if (col < 64) x = w2[col * RW + n]; }
                else if (n < 1024) { if (col >= 64 && col < 128) x = a2[(col - 64) * RW + (n - 512)]; }
                else { if (col >= 128) x = g2[(col - 128) * RW + (n - 1024)]; }
                v[i] = x;
            }
            *(uint4*)(bt + (size_t)n * 256 + c0) = make_uint4(pk2(v[0], v[1]), pk2(v[2], v[3]), pk2(v[4], v[5]), pk2(v[6], v[7]));
        }
    }
    float* scr = c.sm + c.wid * (64 * 33);
    constexpr int I_IN = (D / 64) * (NPROJ / 32), I_OUT = (D / 64) * (D / 32), I_GLU = (512 / 64) * (512 / 32), I_SG = (D / 64) * (256 / 32), I_SD = (256 / 64) * (D / 32), I_R = (D / 64) * (256 / 32);
    constexpr int NIT = I_IN + I_OUT + I_GLU + 2 * I_SG + I_SD + 2 * I_R;
    for (int it = gw; it < NIT; it += NW) {
        int r = it;
        if (r < I_IN) { transpose_item<false>(c.in[8], D, NPROJ, (bf16_t*)(c.ws + WS_WIN_T), [](int n) { return n; }, scr, r, c.lane); continue; } r -= I_IN;
        if (r < I_OUT) { transpose_item<false>(c.in[30], D, D, (bf16_t*)(c.ws + WS_WOUT_T), [](int n) { return n; }, scr, r, c.lane); continue; } r -= I_OUT;
        if (r < I_GLU) { transpose_item<false>(c.in[28], 512, 512, (bf16_t*)(c.ws + WS_WGLU_T), [](int n) { return n; }, scr, r, c.lane); continue; } r -= I_GLU;
        if (r < I_SG) { transpose_item<false>(c.in[36], D, 256, (bf16_t*)(c.ws + WS_WSGU_T), [](int n) { return (n >> 7) * 256 + (n & 127); }, scr, r, c.lane); continue; } r -= I_SG;
        if (r < I_SG) { transpose_item<false>(c.in[37], D, 256, (bf16_t*)(c.ws + WS_WSGU_T), [](int n) { return (n >> 7) * 256 + 128 + (n & 127); }, scr, r, c.lane); continue; } r -= I_SG;
        if (r < I_SD) { transpose_item<false>(c.in[38], 256, D, (bf16_t*)(c.ws + WS_WSD_T), [](int n) { return n; }, scr, r, c.lane); continue; } r -= I_SD;
        if (r < I_R) { transpose_item<false>(c.in[31], D, 256, (bf16_t*)(c.ws + WS_WR_T), [](int n) { return n; }, scr, r, c.lane); continue; } r -= I_R;
        transpose_item<true>(c.in[31], D, 256, (bf16_t*)(c.ws + WS_WR_T), [](int n) { return 256 + n; }, scr, r, c.lane);
    }
}

__device__ __forceinline__ void phase1(const Ctx& c) {
    const int gt = c.bid * 512 + c.tid, NT = c.G * 512;
    const int gw = c.bid * 8 + c.wid, NW = c.G * 8;
    const float* modsp = (const float*)(c.ws + WS_MODSP); const float* b_ada = c.in[3]; float* mods = (float*)(c.ws + WS_MODS);
    for (int idx = gt; idx < BATCH * NMODS; idx += NT) {
        const int b = idx / NMODS, j = idx % NMODS;
        float acc = 0.f;
#pragma unroll
        for (int ks = 0; ks < 16; ++ks) acc += modsp[(ks * 4 + b) * NMODS + j];
        mods[idx] = acc + b_ada[j];
    }
    const float* __restrict__ apow = (const float*)(c.ws + WS_APOW); const float* __restrict__ bb = (const float*)(c.ws + WS_S5BB);
    const float* __restrict__ c_re = c.in[25]; const float* __restrict__ c_im = c.in[26];
    float* __restrict__ klag = (float*)(c.ws + WS_KLAG);
    for (int task = gw; task < S5NG * S5L; task += NW) {
        const int g = task / S5L, j = task % S5L, cc = c.lane >> 2, cq = (c.lane & 3) * 4;
        float acc[4] = {0.f, 0.f, 0.f, 0.f};
#pragma unroll 16
        for (int p = 0; p < 64; ++p) {
            const float ar = apow[((size_t)(g * (S5L + 1) + j) * 64 + p) * 2], ai = apow[((size_t)(g * (S5L + 1) + j) * 64 + p) * 2 + 1];
            const float cr = c_re[(g * 16 + cc) * 64 + p], ci = c_im[(g * 16 + cc) * 64 + p];
            const float4 br = *(const float4*)(bb + (size_t)(g * 64 + p) * 32 + cq), bi = *(const float4*)(bb + (size_t)(g * 64 + p) * 32 + 16 + cq);
            const float er = cr * ar - ci * ai, ei = cr * ai + ci * ar;
            acc[0] += er * br.x - ei * bi.x; acc[1] += er * br.y - ei * bi.y; acc[2] += er * br.z - ei * bi.z; acc[3] += er * br.w - ei * bi.w;
        }
        *(float4*)(klag + ((size_t)(g * S5L + j) * 16 + cc) * 16 + cq) = make_float4(acc[0], acc[1], acc[2], acc[3]);
    }
}

__device__ __forceinline__ void phase2(const Ctx& c) {
    const float* x = c.in[0]; const float* g = c.in[4];
    const float* mods = (const float*)(c.ws + WS_MODS);
    bf16_t* xn = (bf16_t*)(c.ws + WS_A);
    const int gw = c.bid * 8 + c.wid, NW = c.G * 8;
    for (int t = gw; t < T; t += NW) {
        const int b = t / SEQ;
        const float4* xr = (const float4*)(x + (size_t)t * D) + c.lane;
        float4 v[4]; float ss = 0.f;
#pragma unroll
        for (int j = 0; j < 4; ++j) { v[j] = xr[64 * j]; ss += v[j].x * v[j].x + v[j].y * v[j].y + v[j].z * v[j].z + v[j].w * v[j].w; }
        const float rstd = rsqrtf(wave_sum(ss) * (1.0f / D) + 1e-6f);
        uint2* o = (uint2*)(xn + (size_t)t * D) + c.lane;
#pragma unroll
        for (int j = 0; j < 4; ++j) {
            const int k = (c.lane + 64 * j) * 4;
            const float4 gg = *(const float4*)(g + k);
            const float4 sh = *(const float4*)(mods + b * NMODS + k);
            const float4 sc = *(const float4*)(mods + b * NMODS + D + k);
            float4 r;
            r.x = v[j].x * rstd * gg.x * (1.f + sc.x) + sh.x; r.y = v[j].y * rstd * gg.y * (1.f + sc.y) + sh.y;
            r.z = v[j].z * rstd * gg.z * (1.f + sc.z) + sh.z; r.w = v[j].w * rstd * gg.w * (1.f + sc.w) + sh.w;
            o[64 * j] = make_uint2(pk2(r.x, r.y), pk2(r.z, r.w));
        }
    }
}

__device__ __forceinline__ void s5_assemble(const Ctx& c) {
    const bool half = (c.G == 256);
    if (half && c.bid < 128) return;
    const int gt = (half ? c.bid - 128 : c.bid) * 512 + c.tid, NT = (half ? 128 : c.G) * 512;
    const float* apow = (const float*)(c.ws + WS_APOW); const float* bb = (const float*)(c.ws + WS_S5BB); const float* klag = (const float*)(c.ws + WS_KLAG);
    const float* c_re = c.in[25]; const float* c_im = c.in[26]; const float* dd = c.in[27];
    bf16_t* kmat = (bf16_t*)(c.ws + WS_KMAT); bf16_t* hmat = (bf16_t*)(c.ws + WS_HMAT);
    for (int it = gt; it < S5NG * 512 * 80; it += NT) {
        const int row = it / 80, ch = it % 80, g = row >> 9, t = (row >> 4) & 31, cc = row & 15, col0 = ch * 8;
        float v[8];
        if (col0 < 512) {
            const int s = col0 >> 4, c0 = col0 & 15;
            if (s > t) {
#pragma unroll
                for (int i = 0; i < 8; ++i) v[i] = 0.f;
            } else {
                const float4 k0 = *(const float4*)(klag + ((size_t)(g * S5L + (t - s)) * 16 + cc) * 16 + c0), k1 = *(const float4*)(klag + ((size_t)(g * S5L + (t - s)) * 16 + cc) * 16 + c0 + 4);
                v[0] = k0.x; v[1] = k0.y; v[2] = k0.z; v[3] = k0.w; v[4] = k1.x; v[5] = k1.y; v[6] = k1.z; v[7] = k1.w;
                if (s == t) {
                    const float dv = dd[g * 16 + cc];
#pragma unroll
                    for (int i = 0; i < 8; ++i) if (c0 + i == cc) v[i] += dv;
                }
            }
        } else {
            const int q0 = col0 - 512;
#pragma unroll
            for (int i = 0; i < 8; ++i) {
                const int q = q0 + i, p = q & 63;
                const float ar = apow[((size_t)(g * (S5L + 1) + t + 1) * 64 + p) * 2], ai = apow[((size_t)(g * (S5L + 1) + t + 1) * 64 + p) * 2 + 1];
                const float cr = c_re[(g * 16 + cc) * 64 + p], ci = c_im[(g * 16 + cc) * 64 + p];
                v[i] = (q < 64) ? (cr * ar - ci * ai) : -(cr * ai + ci * ar);
            }
        }
        *(uint4*)(kmat + (size_t)row * 640 + col0) = make_uint4(pk2(v[0], v[1]), pk2(v[2], v[3]), pk2(v[4], v[5]), pk2(v[6], v[7]));
    }
    for (int it = gt; it < S5NG * 256 * 80; it += NT) {
        const int row = it / 80, ch = it % 80, g = row >> 8, q = row & 255, col0 = ch * 8;
        float v[8];
#pragma unroll
        for (int i = 0; i < 8; ++i) v[i] = 0.f;
        if (q < 128 && col0 < 512) {
            const int s = col0 >> 4, c0 = col0 & 15, p = q & 63;
            const float ar = apow[((size_t)(g * (S5L + 1) + (S5L - 1 - s)) * 64 + p) * 2], ai = apow[((size_t)(g * (S5L + 1) + (S5L - 1 - s)) * 64 + p) * 2 + 1];
#pragma unroll
            for (int i = 0; i < 8; ++i) {
                const float br = bb[(size_t)(g * 64 + p) * 32 + c0 + i], bi = bb[(size_t)(g * 64 + p) * 32 + 16 + c0 + i];
                v[i] = (q < 64) ? (ar * br - ai * bi) : (ar * bi + ai * br);
            }
        }
        *(uint4*)(hmat + (size_t)row * 640 + col0) = make_uint4(pk2(v[0], v[1]), pk2(v[2], v[3]), pk2(v[4], v[5]), pk2(v[6], v[7]));
    }
}

__device__ __forceinline__ void phase3(const Ctx& c) {
    pg8::Gemm g{(const bf16_t*)(c.ws + WS_A), (const bf16_t*)(c.ws + WS_WIN_T), T, NPROJ, D};
    pg8::StaticOrder S; S.init(T, NPROJ, c.G, c.bid);
    pg8::EpiBf16<0> E{(bf16_t*)(c.ws + WS_PROJ), NPROJ, nullptr, 0, 0, 1.f};
    pg8::gemm_phase<pg8::EpiBf16<0>, pg8::StaticOrder, true, true>(c.lds, g, S, E);
    s5_assemble(c);
}

__device__ __forceinline__ void unpack8(const uint4 a, float (&u)[8]) {
    u[0] = bf2f(a.x & 0xffffu); u[1] = bf2f(a.x >> 16); u[2] = bf2f(a.y & 0xffffu); u[3] = bf2f(a.y >> 16);
    u[4] = bf2f(a.z & 0xffffu); u[5] = bf2f(a.z >> 16); u[6] = bf2f(a.w & 0xffffu); u[7] = bf2f(a.w >> 16);
}
__device__ __forceinline__ uint4 pack8(const float (&v)[8]) { return make_uint4(pk2(v[0], v[1]), pk2(v[2], v[3]), pk2(v[4], v[5]), pk2(v[6], v[7])); }
#define DPPU(v, ctrl) ((unsigned)__builtin_amdgcn_mov_dpp((int)(v), (ctrl), 0xf, 0xf, true))
#define DPPF(v, ctrl) __builtin_bit_cast(float, __builtin_amdgcn_mov_dpp(__builtin_bit_cast(int, (v)), (ctrl), 0xf, 0xf, true))
__device__ __forceinline__ float fast_tanh(float x) { return 1.0f - 2.0f * __builtin_amdgcn_rcpf(1.0f + __builtin_amdgcn_exp2f(2.8853900817779268f * x)); }
__device__ __forceinline__ void phase4(const Ctx& c) {
    const bf16_t* proj = (const bf16_t*)(c.ws + WS_PROJ);
    const float* mu = c.in[9]; const float* k_k = c.in[15];
    bf16_t* rw_r = (bf16_t*)(c.ws + WS_RW_R); bf16_t* rw_k = (bf16_t*)(c.ws + WS_RW_K); bf16_t* rw_v = (bf16_t*)(c.ws + WS_RW_V); bf16_t* rw_a = (bf16_t*)(c.ws + WS_RW_A);
    bf16_t* alora = (bf16_t*)((unsigned char*)c.out + OUT_ALORA); bf16_t* ux = (bf16_t*)((unsigned char*)c.out + OUT_UX);
    const int gw = c.bid * 8 + c.wid, NW = c.G * 8, lane = c.lane;
    float mm[4][8], kk8[8];
#pragma unroll
    for (int j = 0; j < 4; ++j) {
        const int cidx = lane + 64 * j, col = (cidx < 224 ? cidx : 0) * 8;
        const float4 m0 = *(const float4*)(mu + col), m1 = *(const float4*)(mu + col + 4);
        mm[j][0] = m0.x; mm[j][1] = m0.y; mm[j][2] = m0.z; mm[j][3] = m0.w; mm[j][4] = m1.x; mm[j][5] = m1.y; mm[j][6] = m1.z; mm[j][7] = m1.w;
    }
    { const float4 k0 = *(const float4*)(k_k + lane * 8), k1 = *(const float4*)(k_k + lane * 8 + 4); kk8[0] = k0.x; kk8[1] = k0.y; kk8[2] = k0.z; kk8[3] = k0.w; kk8[4] = k1.x; kk8[5] = k1.y; kk8[6] = k1.z; kk8[7] = k1.w; }
    constexpr int RUN = 16;
    auto load_row = [&](int t, uint4 (&r)[5]) {
        const bf16_t* pr = proj + (size_t)t * NPROJ;
#pragma unroll
        for (int j = 0; j < 3; ++j) r[j] = *(const uint4*)(pr + (lane + 64 * j) * 8);
        r[3] = (lane < 32) ? *(const uint4*)(pr + (lane + 192) * 8) : make_uint4(0u, 0u, 0u, 0u);
        r[4] = *(const uint4*)(pr + RPROJ + lane * 8);
    };
    for (int t0 = gw * RUN; t0 < T; t0 += NW * RUN) {
        uint4 prev[5], cur[5], nxt[5];
        if (t0 % SEQ == 0) {
#pragma unroll
            for (int j = 0; j < 5; ++j) prev[j] = make_uint4(0u, 0u, 0u, 0u);
        } else load_row(t0 - 1, prev);
        load_row(t0, cur);
#pragma unroll 2
        for (int i = 0; i < RUN; ++i) {
            const int t = t0 + i;
            if (i + 1 < RUN) load_row(t + 1, nxt);
#pragma unroll
            for (int j = 0; j < 4; ++j) {
                const int cidx = lane + 64 * j;
                if (cidx < 224) {
                    const int col = cidx * 8;
                    float p[8], q[8], ps[8];
                    unpack8(cur[j], p); unpack8(prev[j], q);
#pragma unroll
                    for (int i2 = 0; i2 < 8; ++i2) ps[i2] = p[i2] + (q[i2] - p[i2]) * mm[j][i2];
                    if (j == 0) *(uint4*)(rw_r + (size_t)t * RW + col) = pack8(ps);
                    else if (j == 1) {
                        const int cl = col - 512;
                        *(uint4*)(rw_k + (size_t)t * RW + cl) = pack8(ps);
                        float kk[8]; float ss = 0.f;
#pragma unroll
                        for (int i2 = 0; i2 < 8; ++i2) { kk[i2] = ps[i2] * kk8[i2]; ss += kk[i2] * kk[i2]; }
                        ss += DPPF(ss, 0xB1); ss += DPPF(ss, 0x4E); ss += DPPF(ss, 0x141);
                        const float inv = -1.0f / fmaxf(sqrtf(ss), 1e-12f);
#pragma unroll
                        for (int i2 = 0; i2 < 8; ++i2) kk[i2] *= inv;
                        *(uint4*)(rw_a + (size_t)t * RW + cl) = pack8(kk);
                    } else if (j == 2) *(uint4*)(rw_v + (size_t)t * RW + (col - 1024)) = pack8(ps);
                    else {
                        const int cl = col - 1536;
                        float o[8];
#pragma unroll
                        for (int i2 = 0; i2 < 8; ++i2) o[i2] = (cl < 64) ? fast_tanh(ps[i2]) : (cl < 128) ? ps[i2] : pg8::fast_sigmoid(ps[i2]);
                        *(uint4*)(alora + (size_t)t * 256 + cl) = pack8(o);
                    }
                }
            }
            {
                const int g = lane >> 1, hf = lane & 1, b = t / SEQ, sidx = t % S5L, chunk = (t % SEQ) / S5L;
                bf16_t* row = ux + ((size_t)(g * 1024 + b * 256 + chunk)) * 640;
                *(uint4*)(row + sidx * 16 + hf * 8) = cur[4];
                if (sidx < 8) { *(uint4*)(row + 512 + (sidx * 2 + hf) * 8) = make_uint4(0u, 0u, 0u, 0u); }
            }
#pragma unroll
            for (int j = 0; j < 5; ++j) { prev[j] = cur[j]; cur[j] = nxt[j]; }
        }
    }
}

__device__ __forceinline__ void phase5(const Ctx& c) {
    {
        pg8::Gemm g{(const bf16_t*)((unsigned char*)c.out + OUT_ALORA), (const bf16_t*)(c.ws + WS_LORA_BT), T, 1536, 256};
        pg8::StaticOrder S; S.init(T, 1536, c.G, c.bid);
        pg8::EpiLora E{c.in[10], c.in[12], c.in[16], (float*)(c.ws + WS_RW_W), (const bf16_t*)(c.ws + WS_RW_K), (bf16_t*)((unsigned char*)c.out + OUT_KF), (const bf16_t*)(c.ws + WS_RW_A), (bf16_t*)(c.ws + WS_RW_B), (bf16_t*)(c.ws + WS_RW_G)};
        pg8::gemm_phase<pg8::EpiLora, pg8::StaticOrder, true, true>(c.lds, g, S, E);
    }
    __syncthreads();
    {
        pg8::Gemm g{(const bf16_t*)((unsigned char*)c.out + OUT_UX), (const bf16_t*)(c.ws + WS_HMAT), 0, 0, 640};
        pg8::S5Order S{128, 1, c.G, c.bid};
        pg8::EpiS5E E{(float*)((unsigned char*)c.out + OUT_E)};
        pg8::gemm_phase<pg8::EpiS5E, pg8::S5Order, true, true>(c.lds, g, S, E);
    }
}

typedef float f2v __attribute__((ext_vector_type(2)));
__device__ __forceinline__ float dpp_add16(float v) {
    v += __builtin_bit_cast(float, __builtin_amdgcn_mov_dpp(__builtin_bit_cast(int, v), 0xB1, 0xf, 0xf, true));
    v += __builtin_bit_cast(float, __builtin_amdgcn_mov_dpp(__builtin_bit_cast(int, v), 0x4E, 0xf, 0xf, true));
    v += __builtin_bit_cast(float, __builtin_amdgcn_mov_dpp(__builtin_bit_cast(int, v), 0x141, 0xf, 0xf, true));
    v += __builtin_bit_cast(float, __builtin_amdgcn_mov_dpp(__builtin_bit_cast(int, v), 0x140, 0xf, 0xf, true));
    return v;
}
constexpr int RTS = 32;
constexpr int RTILE = 6 * RTS * 64;
typedef short bf16x8_t __attribute__((ext_vector_type(8)));
typedef float f32x4_t __attribute__((ext_vector_type(4)));
#define MFMA16(a, b, c) __builtin_amdgcn_mfma_f32_16x16x32_bf16((a), (b), (c), 0, 0, 0)
constexpr int CL = 64, CLD = 72, CSLOT = 64 * CLD * 2;
constexpr int C_DIAG = 13 * CSLOT, C_DM = C_DIAG + 4096, C_GL = C_DM + 2048, C_SEGP = C_GL + 256;
static_assert(C_SEGP + 2048 <= 131072, "rwkv chunk LDS map");
__device__ __forceinline__ bf16x8_t ldsfrag(LAS const unsigned char* slot, int row, int col) { return *(LAS const bf16x8_t*)(slot + (row * CLD + col) * 2); }
typedef unsigned u32x4_t __attribute__((ext_vector_type(4)));
typedef unsigned u32x2_t __attribute__((ext_vector_type(2)));
__device__ __forceinline__ void lds_st16(LAS unsigned char* p, uint4 v) { *(LAS u32x4_t*)p = (u32x4_t){v.x, v.y, v.z, v.w}; }
__device__ __forceinline__ void lds_st8(LAS unsigned char* p, uint2 v) { *(LAS u32x2_t*)p = (u32x2_t){v.x, v.y}; }
__device__ __forceinline__ uint2 lds_ld8(LAS const unsigned char* p) { const u32x2_t v = *(LAS const u32x2_t*)p; return make_uint2(v.x, v.y); }
__device__ __forceinline__ bf16x8_t zfrag() { return (bf16x8_t){0, 0, 0, 0, 0, 0, 0, 0}; }
__device__ __forceinline__ uint2 pack4(float a, float b, float c, float d) { return make_uint2(pk2(a, b), pk2(c, d)); }
__device__ __forceinline__ float wave_sum_u(float v) {
    v = dpp_add16(v);
    return __builtin_bit_cast(float, __builtin_amdgcn_readlane(__builtin_bit_cast(int, v), 0)) + __builtin_bit_cast(float, __builtin_amdgcn_readlane(__builtin_bit_cast(int, v), 16))
         + __builtin_bit_cast(float, __builtin_amdgcn_readlane(__builtin_bit_cast(int, v), 32)) + __builtin_bit_cast(float, __builtin_amdgcn_readlane(__builtin_bit_cast(int, v), 48));
}

__device__ __forceinline__ void rwkv_phaseA(const Ctx& c, const int GA) {
    const float* __restrict__ rw_w = (const float*)(c.ws + WS_RW_W);
    const bf16_t* __restrict__ rw_r = (const bf16_t*)(c.ws + WS_RW_R); const bf16_t* __restrict__ rw_k = (const bf16_t*)((const unsigned char*)c.out + OUT_KF); const bf16_t* __restrict__ rw_v = (const bf16_t*)(c.ws + WS_RW_V);
    const bf16_t* __restrict__ rw_a = (const bf16_t*)(c.ws + WS_RW_A); const bf16_t* __restrict__ rw_b = (const bf16_t*)(c.ws + WS_RW_B);
    const float* r_k = c.in[17];
    bf16_t* Mq = (bf16_t*)(c.ws + WS_CM); bf16_t* NTq = (bf16_t*)(c.ws + WS_CN); bf16_t* Qq = (bf16_t*)(c.ws + WS_CQ); bf16_t* YTq = (bf16_t*)(c.ws + WS_CY); float* bon = (float*)(c.ws + WS_CBON);
    LAS unsigned char* L = c.lds;
    LAS unsigned char* sAt = L + 0 * CSLOT; LAS unsigned char* sBt = L + 1 * CSLOT; LAS unsigned char* sKt = L + 2 * CSLOT; LAS unsigned char* sRt = L + 3 * CSLOT;
    LAS unsigned char* sBtT = L + 4 * CSLOT; LAS unsigned char* sKtT = L + 5 * CSLOT; LAS unsigned char* sVT = L + 6 * CSLOT;
    LAS unsigned char* sA4 = L + 7 * CSLOT;
    LAS unsigned char* sRHST = L + 11 * CSLOT;
    LAS unsigned char* sXT = L + 0 * CSLOT;
    LAS unsigned char* sAD = L + 2 * CSLOT;
    LAS float* sDIAG = (LAS float*)(L + C_DIAG); LAS bf16_t* sDM = (LAS bf16_t*)(L + C_DM); LAS float* sGL = (LAS float*)(L + C_GL); LAS float* sSEGP = (LAS float*)(L + C_SEGP);
    const int tid = c.tid, w = c.wid, lane = c.lane, lr = lane & 15, lq = lane >> 4;
    float raww[8]; unsigned rawa[8], rawb[8], rawk[8], rawr[8], rawv[8];
    auto load_raw = [&](int ci_) {
        const int bh_ = ci_ >> 7, chunk_ = ci_ & 127, b_ = bh_ >> 3, h_ = bh_ & 7;
        const size_t gb = (size_t)(b_ * SEQ + chunk_ * CL) * RW + h_ * 64 + (size_t)(8 * (tid >> 6)) * RW + (tid & 63);
#pragma unroll
        for (int j = 0; j < 8; ++j) { const size_t o = gb + (size_t)j * RW; raww[j] = rw_w[o]; rawa[j] = rw_a[o]; rawb[j] = rw_b[o]; rawk[j] = rw_k[o]; rawr[j] = rw_r[o]; rawv[j] = rw_v[o]; }
    };
    if (c.bid < BATCH * NH * (SEQ / CL)) load_raw(c.bid);
    for (int ci = c.bid; ci < BATCH * NH * (SEQ / CL); ci += GA) {
        const int bh = ci >> 7, chunk = ci & 127, b = bh >> 3, h = bh & 7;
        const size_t gbase = (size_t)(b * SEQ + chunk * CL) * RW + h * 64;
        {
            const int kc = tid & 63, seg = tid >> 6;
            float p[8];
#pragma unroll
            for (int j = 0; j < 8; ++j) { const float wv = raww[j]; p[j] = (j == 0) ? wv : p[j - 1] * wv; }
            sSEGP[seg * 64 + kc] = p[7];
            for (int i = tid; i < 4 * CSLOT / 16; i += 512) lds_st16(sA4 + i * 16, make_uint4(0u, 0u, 0u, 0u));
            __syncthreads();
            float pre = 1.0f;
#pragma unroll
            for (int s = 0; s < 7; ++s) { const float sp = sSEGP[s * 64 + kc]; pre = (s < seg) ? pre * sp : pre; }
            float atT[8], btT[8], ktT[8], vT[8];
            const float rkv = r_k[h * 64 + kc];
#pragma unroll
            for (int j = 0; j < 8; ++j) {
                const int t = 8 * seg + j;
                const float G = pre * p[j], Gm1 = (j == 0) ? pre : pre * p[j - 1], inv = 1.0f / G;
                const float av = bf2f(rawa[j]), bv = bf2f(rawb[j]), kv = bf2f(rawk[j]), rv = bf2f(rawr[j]), vv = bf2f(rawv[j]);
                const float at = av * Gm1, bt = bv * inv, kt = kv * inv, rt = rv * G;
                *(LAS bf16_t*)(sAt + (t * CLD + kc) * 2) = (bf16_t)f2bf(at); *(LAS bf16_t*)(sBt + (t * CLD + kc) * 2) = (bf16_t)f2bf(bt);
                *(LAS bf16_t*)(sKt + (t * CLD + kc) * 2) = (bf16_t)f2bf(kt); *(LAS bf16_t*)(sRt + (t * CLD + kc) * 2) = (bf16_t)f2bf(rt);
                atT[j] = at; btT[j] = bt; ktT[j] = kt; vT[j] = vv;
                const float bs = wave_sum_u(rv * kv * rkv);
                if (lane == 0) bon[(size_t)ci * CL + t] = bs;
            }
            lds_st16(sRHST + (kc * CLD + 8 * seg) * 2, pack8(atT)); lds_st16(sBtT + (kc * CLD + 8 * seg) * 2, pack8(btT));
            lds_st16(sKtT + (kc * CLD + 8 * seg) * 2, pack8(ktT)); lds_st16(sVT + (kc * CLD + 8 * seg) * 2, pack8(vT));
            if (seg == 7) sGL[kc] = pre * p[7];
            __syncthreads();
        }
        for (int idx = w; idx < 40; idx += 8) {
            const int m = idx / 10, pr = idx % 10;
            const int ti = (pr >= 6) ? 3 : (pr >= 3) ? 2 : (pr >= 1) ? 1 : 0, si = pr - ti * (ti + 1) / 2;
            LAS const unsigned char* X = (m < 2) ? sAt : sRt; LAS const unsigned char* Y = (m & 1) ? sKt : sBt;
            f32x4_t acc = {0.f, 0.f, 0.f, 0.f};
#pragma unroll
            for (int ks = 0; ks < 2; ++ks) acc = MFMA16(ldsfrag(Y, 16 * si + lr, 32 * ks + 8 * lq), ldsfrag(X, 16 * ti + lr, 32 * ks + 8 * lq), acc);
            const int t = 16 * ti + lr, s0 = 16 * si + 4 * lq;
            float o[4];
#pragma unroll
            for (int rg = 0; rg < 4; ++rg) { const int s = s0 + rg; const bool keep = (m < 2) ? (s < t) : (s <= t); o[rg] = keep ? acc[rg] : 0.f; }
            lds_st8(sA4 + m * CSLOT + (t * CLD + s0) * 2, pack4(o[0], o[1], o[2], o[3]));
            if (m == 0 && ti == si) *(LAS f32x4_t*)(sDIAG + (ti * 16 + lr) * 16 + 4 * lq) = (f32x4_t){o[0], o[1], o[2], o[3]};
        }
        __syncthreads();
        if (w == 0) {
            float x[16];
#pragma unroll
            for (int r = 0; r < 16; ++r) {
                float acc = (r == lr) ? 1.0f : 0.0f;
                float nrow[16];
#pragma unroll
                for (int q4 = 0; q4 < 4; ++q4) { const f32x4_t nv = *(LAS const f32x4_t*)(sDIAG + (lq * 16 + r) * 16 + 4 * q4); nrow[4 * q4] = nv[0]; nrow[4 * q4 + 1] = nv[1]; nrow[4 * q4 + 2] = nv[2]; nrow[4 * q4 + 3] = nv[3]; }
#pragma unroll
                for (int s = 0; s < 16; ++s) if (s < r) acc = fmaf(nrow[s], x[s], acc);
                x[r] = acc;
                sDM[(lq * 16 + r) * 16 + lr] = (bf16_t)f2bf(acc);
            }
        } else {
            for (int idx = w - 1; idx < 16; idx += 7) {
                const int ti = idx >> 2, vi = idx & 3;
                f32x4_t acc = {0.f, 0.f, 0.f, 0.f};
#pragma unroll
                for (int ks = 0; ks < 2; ++ks) acc = MFMA16(ldsfrag(sA4 + 1 * CSLOT, 16 * ti + lr, 32 * ks + 8 * lq), ldsfrag(sVT, 16 * vi + lr, 32 * ks + 8 * lq), acc);
                lds_st8(sRHST + ((64 + 16 * vi + lr) * CLD + 16 * ti + 4 * lq) * 2, pack4(acc[0], acc[1], acc[2], acc[3]));
            }
        }
        __syncthreads();
        f32x4_t rd[4];
#pragma unroll
        for (int i = 0; i < 4; ++i) {
            bf16x8_t fa = zfrag(), fb = zfrag();
            if (lq < 2) { fa = *(LAS const bf16x8_t*)(sDM + (i * 16 + lr) * 16 + 8 * lq); fb = ldsfrag(sRHST, 16 * w + lr, 16 * i + 8 * lq); }
            rd[i] = MFMA16(fa, fb, ((f32x4_t){0.f, 0.f, 0.f, 0.f}));
        }
        if (w < 6) {
            const int i = (w >= 3) ? 3 : (w >= 1) ? 2 : 1, j = w - (i - 1) * i / 2;
            bf16x8_t fa = zfrag(), fb = zfrag();
            if (lq < 2) {
                fa = *(LAS const bf16x8_t*)(sDM + (i * 16 + lr) * 16 + 8 * lq);
#pragma unroll
                for (int jj = 0; jj < 8; ++jj) fb[jj] = (short)*(LAS const bf16_t*)(sA4 + ((16 * i + 8 * lq + jj) * CLD + 16 * j + lr) * 2);
            }
            const f32x4_t acc = MFMA16(fa, fb, ((f32x4_t){0.f, 0.f, 0.f, 0.f}));
#pragma unroll
            for (int rg = 0; rg < 4; ++rg) *(LAS bf16_t*)(sAD + ((16 * i + 4 * lq + rg) * CLD + 16 * j + lr) * 2) = (bf16_t)f2bf(acc[rg]);
        }
        __syncthreads();
#pragma unroll
        for (int i = 0; i < 4; ++i) {
            f32x4_t acc = rd[i];
            if (i >= 1) {
                bf16x8_t fa = zfrag(), fb = zfrag();
                if (8 * lq < 16 * i) { fa = ldsfrag(sAD, 16 * i + lr, 8 * lq); fb = ldsfrag(sXT, 16 * w + lr, 8 * lq); }
                acc = MFMA16(fa, fb, acc);
            }
            if (i == 3) {
                bf16x8_t fa = zfrag(), fb = zfrag();
                if (lq < 2) { fa = ldsfrag(sAD, 48 + lr, 32 + 8 * lq); fb = ldsfrag(sXT, 16 * w + lr, 32 + 8 * lq); }
                acc = MFMA16(fa, fb, acc);
            }
            lds_st8(sXT + ((16 * w + lr) * CLD + 16 * i + 4 * lq) * 2, pack4(acc[0], acc[1], acc[2], acc[3]));
            asm volatile("s_waitcnt lgkmcnt(0)" ::: "memory");
        }
        __syncthreads();
        if (ci + GA < BATCH * NH * (SEQ / CL)) load_raw(ci + GA);
#pragma unroll
        for (int i = 0; i < 8; ++i) {
            const int kind = i >> 1, tile = w + 8 * (i & 1), r4 = tile >> 2, c4 = tile & 3;
            f32x4_t acc = {0.f, 0.f, 0.f, 0.f};
            if (kind == 0) {
#pragma unroll
                for (int ks = 0; ks < 2; ++ks) acc = MFMA16(ldsfrag(sXT, 16 * r4 + lr, 32 * ks + 8 * lq), ldsfrag(sBtT, 16 * c4 + lr, 32 * ks + 8 * lq), acc);
                const int k = 16 * c4 + lr, kp0 = 16 * r4 + 4 * lq; const float gl = sGL[k];
                float o[4];
#pragma unroll
                for (int rg = 0; rg < 4; ++rg) o[rg] = gl * (acc[rg] + ((k == kp0 + rg) ? 1.0f : 0.0f));
                *(uint2*)(Mq + (size_t)ci * 4096 + k * 64 + kp0) = pack4(o[0], o[1], o[2], o[3]);
            } else if (kind == 1) {
#pragma unroll
                for (int ks = 0; ks < 2; ++ks) {
                    acc = MFMA16(ldsfrag(sBtT, 16 * r4 + lr, 32 * ks + 8 * lq), ldsfrag(sXT, 64 + 16 * c4 + lr, 32 * ks + 8 * lq), acc);
                    acc = MFMA16(ldsfrag(sKtT, 16 * r4 + lr, 32 * ks + 8 * lq), ldsfrag(sVT, 16 * c4 + lr, 32 * ks + 8 * lq), acc);
                }
                const int k0 = 16 * r4 + 4 * lq; const f32x4_t gl = *(LAS const f32x4_t*)(sGL + k0);
                *(uint2*)(NTq + (size_t)ci * 4096 + (16 * c4 + lr) * 64 + k0) = pack4(gl[0] * acc[0], gl[1] * acc[1], gl[2] * acc[2], gl[3] * acc[3]);
            } else if (kind == 2) {
#pragma unroll
                for (int ks = 0; ks < 2; ++ks) acc = MFMA16(ldsfrag(sXT, 16 * r4 + lr, 32 * ks + 8 * lq), ldsfrag(sA4 + 2 * CSLOT, 16 * c4 + lr, 32 * ks + 8 * lq), acc);
                const int t = 16 * c4 + lr, kp0 = 16 * r4 + 4 * lq;
                const uint2 rv = lds_ld8(sRt + (t * CLD + kp0) * 2);
                *(uint2*)(Qq + (size_t)ci * 4096 + t * 64 + kp0) = pack4(acc[0] + bf2f(rv.x & 0xffffu), acc[1] + bf2f(rv.x >> 16), acc[2] + bf2f(rv.y & 0xffffu), acc[3] + bf2f(rv.y >> 16));
            } else {
#pragma unroll
                for (int ks = 0; ks < 2; ++ks) {
                    acc = MFMA16(ldsfrag(sA4 + 2 * CSLOT, 16 * r4 + lr, 32 * ks + 8 * lq), ldsfrag(sXT, 64 + 16 * c4 + lr, 32 * ks + 8 * lq), acc);
                    acc = MFMA16(ldsfrag(sA4 + 3 * CSLOT, 16 * r4 + lr, 32 * ks + 8 * lq), ldsfrag(sVT, 16 * c4 + lr, 32 * ks + 8 * lq), acc);
                }
                *(uint2*)(YTq + (size_t)ci * 4096 + (16 * c4 + lr) * 64 + 16 * r4 + 4 * lq) = pack4(acc[0], acc[1], acc[2], acc[3]);
            }
        }
        __syncthreads();
    }
}

__device__ __forceinline__ void rwkv_phaseB(const Ctx& c, const int bh, const int w) {
    const bf16_t* __restrict__ Mq = (const bf16_t*)(c.ws + WS_CM); const bf16_t* __restrict__ NTq = (const bf16_t*)(c.ws + WS_CN); bf16_t* __restrict__ Sst = (bf16_t*)(c.ws + WS_CS);
    const int lane = c.lane, lr = lane & 15, lq = lane >> 4;
    LAS unsigned char* sS = c.lds + 69632 + c.wid * (16 * CLD * 2);
    {
        {
            bf16x8_t sB0 = zfrag(), sB1 = zfrag();
            bf16x8_t ma[4][4][2]; uint2 nv[4][4];
            const size_t ci0 = (size_t)bh * (SEQ / CL);
#define RB_LOAD(slot, cidx) do { _Pragma("unroll") for (int kt = 0; kt < 4; ++kt) { _Pragma("unroll") for (int ks = 0; ks < 2; ++ks) \
                ma[slot][kt][ks] = *(const bf16x8_t*)(Mq + (cidx) * 4096 + (16 * kt + lr) * 64 + 32 * ks + 8 * lq); nv[slot][kt] = *(const uint2*)(NTq + (cidx) * 4096 + (16 * w + lr) * 64 + 16 * kt + 4 * lq); } } while (0)
#pragma unroll
            for (int sl = 0; sl < 4; ++sl) RB_LOAD(sl, ci0 + sl);
#pragma unroll
            for (int chunk = 0; chunk < SEQ / CL; chunk += 4) {
#pragma unroll
                for (int sl = 0; sl < 4; ++sl) {
                    const size_t ci = ci0 + chunk + sl;
                    asm volatile("global_store_dwordx4 %0, %1, off\n\tglobal_store_dwordx4 %0, %2, off offset:64\n\ts_nop 1" :: "v"(Sst + ci * 4096 + (16 * w + lr) * 64 + 8 * lq), "v"(sB0), "v"(sB1) : "memory");
#pragma unroll
                    for (int kt = 0; kt < 4; ++kt) {
                        f32x4_t acc = {bf2f(nv[sl][kt].x & 0xffffu), bf2f(nv[sl][kt].x >> 16), bf2f(nv[sl][kt].y & 0xffffu), bf2f(nv[sl][kt].y >> 16)};
                        acc = MFMA16(ma[sl][kt][0], sB0, acc); acc = MFMA16(ma[sl][kt][1], sB1, acc);
                        lds_st8(sS + (lr * CLD + 16 * kt + 4 * lq) * 2, pack4(acc[0], acc[1], acc[2], acc[3]));
                    }
                    const size_t cn = (chunk + sl + 4 < SEQ / CL) ? ci + 4 : ci;
                    RB_LOAD(sl, cn);
                    asm volatile("s_waitcnt lgkmcnt(0)" ::: "memory");
                    sB0 = ldsfrag(sS, lr, 8 * lq); sB1 = ldsfrag(sS, lr, 32 + 8 * lq);
                    asm volatile("s_waitcnt lgkmcnt(0)" ::: "memory");
                }
            }
#undef RB_LOAD
        }
    }
}

__device__ __forceinline__ void rwkv_phaseC(const Ctx& c) {
    const bf16_t* __restrict__ Qq = (const bf16_t*)(c.ws + WS_CQ); const bf16_t* __restrict__ YTq = (const bf16_t*)(c.ws + WS_CY); const bf16_t* __restrict__ Sst = (const bf16_t*)(c.ws + WS_CS);
    const float* __restrict__ bon = (const float*)(c.ws + WS_CBON);
    const bf16_t* rw_v = (const bf16_t*)(c.ws + WS_RW_V); const bf16_t* rw_g = (const bf16_t*)(c.ws + WS_RW_G);
    const float* ln_w = c.in[18]; const float* ln_b = c.in[19];
    bf16_t* ycat = (bf16_t*)(c.ws + WS_A);
    const int w = c.wid, lane = c.lane, lr = lane & 15, lq = lane >> 4;
    LAS float* sY = (LAS float*)(c.lds + w * (16 * 68 * 4));
    const int gw = c.bid * 8 + c.wid, NW = c.G * 8;
    for (int task = gw; task < BATCH * NH * (SEQ / CL) * 4; task += NW) {
        const size_t ci = (size_t)(task >> 2); const int tt = task & 3;
        const int bh = (int)(ci >> 7), chunk = (int)(ci & 127), b = bh >> 3, h = bh & 7;
        bf16x8_t qa[2];
#pragma unroll
        for (int ks = 0; ks < 2; ++ks) qa[ks] = *(const bf16x8_t*)(Qq + ci * 4096 + (16 * tt + lr) * 64 + 32 * ks + 8 * lq);
#pragma unroll
        for (int vt = 0; vt < 4; ++vt) {
            const uint2 yv = *(const uint2*)(YTq + ci * 4096 + (16 * vt + lr) * 64 + 16 * tt + 4 * lq);
            f32x4_t acc = {bf2f(yv.x & 0xffffu), bf2f(yv.x >> 16), bf2f(yv.y & 0xffffu), bf2f(yv.y >> 16)};
#pragma unroll
            for (int ks = 0; ks < 2; ++ks) acc = MFMA16(qa[ks], *(const bf16x8_t*)(Sst + ci * 4096 + (16 * vt + lr) * 64 + 32 * ks + 8 * lq), acc);
#pragma unroll
            for (int rg = 0; rg < 4; ++rg) sY[(4 * lq + rg) * 68 + 16 * vt + lr] = acc[rg];
        }
        asm volatile("s_waitcnt lgkmcnt(0)" ::: "memory");
        const int hn = h * 64 + lane;
        const float lw = ln_w[hn], lb = ln_b[hn];
#pragma unroll 4
        for (int tr = 0; tr < 16; ++tr) {
            const int t = chunk * CL + 16 * tt + tr; const size_t tok = (size_t)b * SEQ + t;
            const float y = sY[tr * 68 + lane];
            const float mean = wave_sum_u(y) * (1.f / 64.f);
            const float d = y - mean;
            const float var = wave_sum_u(d * d) * (1.f / 64.f);
            const float yn = d * rsqrtf(var + 64e-5f) * lw + lb;
            const float bonus = bon[ci * CL + 16 * tt + tr] * ldbf(rw_v + tok * RW + hn);
            ycat[tok * D + hn] = (bf16_t)f2bf((yn + bonus) * ldbf(rw_g + tok * RW + hn));
        }
        asm volatile("s_waitcnt lgkmcnt(0)" ::: "memory");
    }
}

constexpr int PA_BLOCKS = 256;
constexpr int CONV_A = 0;
__device__ __forceinline__ void phase6a(const Ctx& c) {
    if (c.G != 256) { rwkv_phaseA(c, c.G); return; }
    if (c.bid < PA_BLOCKS) rwkv_phaseA(c, PA_BLOCKS);
    else if (CONV_A > 0) convert_expert_weights(c, 0, CONV_A, (c.bid - PA_BLOCKS) * 8 + c.wid, (256 - PA_BLOCKS > 0 ? 256 - PA_BLOCKS : 1) * 8);
}

__device__ __forceinline__ void phase6b(const Ctx& c) {
    if (c.wid == 0) {
        for (int tk = c.bid; tk < 2 * S5NG * BATCH; tk += c.G) {
            if (tk < BATCH * NH * 4) { rwkv_phaseB(c, tk >> 2, tk & 3); continue; }
            const float* apow = (const float*)(c.ws + WS_APOW); const float* E = (const float*)((const unsigned char*)c.out + OUT_E);
            bf16_t* ux = (bf16_t*)((unsigned char*)c.out + OUT_UX);
            const int task = tk - BATCH * NH * 4;
            const int g = task >> 2, b = task & 3, p = c.lane;
            const float pr = apow[((size_t)(g * (S5L + 1) + S5L) * 64 + p) * 2], pi = apow[((size_t)(g * (S5L + 1) + S5L) * 64 + p) * 2 + 1];
            float xr = 0.f, xi = 0.f;
            const size_t row0 = (size_t)g * 1024 + b * 256;
            float er[2][8], ei[2][8];
#pragma unroll
            for (int q = 0; q < 8; ++q) { er[0][q] = E[(row0 + q) * 128 + p]; ei[0][q] = E[(row0 + q) * 128 + 64 + p]; }
#pragma unroll
            for (int bt = 0; bt < 32; ++bt) {
                const int cur = bt & 1, nx = cur ^ 1, ch0 = bt * 8;
                if (bt + 1 < 32) {
#pragma unroll
                    for (int q = 0; q < 8; ++q) { er[nx][q] = E[(row0 + ch0 + 8 + q) * 128 + p]; ei[nx][q] = E[(row0 + ch0 + 8 + q) * 128 + 64 + p]; }
                }
#pragma unroll
                for (int q = 0; q < 8; ++q) {
                    st2(ux + (row0 + ch0 + q) * 640 + 512 + p, f2bf(xr)); st2(ux + (row0 + ch0 + q) * 640 + 576 + p, f2bf(xi));
                    const float nr = pr * xr - pi * xi + er[cur][q], ni = pr * xi + pi * xr + ei[cur][q]; xr = nr; xi = ni;
                }
            }
        }
    } else {
        convert_expert_weights(c, (c.G == 256) ? CONV_A : 0, NE * 384, c.bid * 7 + (c.wid - 1), c.G * 7);
    }
}

__device__ __forceinline__ void phase7(const Ctx& c) {
    {
        pg8::Gemm g{(const bf16_t*)((unsigned char*)c.out + OUT_UX), (const bf16_t*)(c.ws + WS_KMAT), 0, 0, 640};
        pg8::S5Order S{256, 2, c.G, c.bid};
        pg8::EpiS5Out E{(bf16_t*)(c.ws + WS_YS5)};
        pg8::gemm_phase<pg8::EpiS5Out, pg8::S5Order, true, true>(c.lds, g, S, E);
    }
    __syncthreads();
    rwkv_phaseC(c);
}

__device__ __forceinline__ void phase8(const Ctx& c) {
    pg8::Gemm g{(const bf16_t*)(c.ws + WS_YS5), (const bf16_t*)(c.ws + WS_WGLU_T), T, 512, 512};
    pg8::StaticOrder S; S.init(T, 512, c.G, c.bid);
    pg8::EpiGLU E{(const bf16_t*)(c.ws + WS_YS5), 512, c.in[29], (bf16_t*)(c.ws + WS_A), D, 512};
    pg8::gemm_phase<pg8::EpiGLU, pg8::StaticOrder, true, true>(c.lds, g, S, E);
}

__device__ __forceinline__ void phase9(const Ctx& c) {
    pg8::Gemm g{(const bf16_t*)(c.ws + WS_A), (const bf16_t*)(c.ws + WS_WOUT_T), T, D, D};
    pg8::StaticOrder S; S.init(T, D, c.G, c.bid);
    pg8::EpiF32 E{(float*)(c.ws + WS_PROJ), D};
    pg8::gemm_phase<pg8::EpiF32, pg8::StaticOrder, true, true>(c.lds, g, S, E);
}

__device__ __forceinline__ void phase10(const Ctx& c) {
    const float* x = c.in[0]; const float* gpm = c.in[5]; const float* gpf = c.in[6];
    const float* mods = (const float*)(c.ws + WS_MODS); const float* mixed = (const float*)(c.ws + WS_PROJ);
    bf16_t* h2 = (bf16_t*)(c.ws + WS_A); float* x1o = c.out;
    const int gw = c.bid * 8 + c.wid, NW = c.G * 8;
    for (int t = gw; t < T; t += NW) {
        const int b = t / SEQ;
        const float4* mr = (const float4*)(mixed + (size_t)t * D) + c.lane;
        const float4* xr = (const float4*)(x + (size_t)t * D) + c.lane;
        float4 m[4], v[4]; float ss = 0.f;
#pragma unroll
        for (int j = 0; j < 4; ++j) { m[j] = mr[64 * j]; v[j] = xr[64 * j]; ss += m[j].x * m[j].x + m[j].y * m[j].y + m[j].z * m[j].z + m[j].w * m[j].w; }
        const float rstd = rsqrtf(wave_sum(ss) * (1.0f / D) + 1e-6f);
        float s1 = 0.f;
#pragma unroll
        for (int j = 0; j < 4; ++j) {
            const int k = (c.lane + 64 * j) * 4;
            const float4 gg = *(const float4*)(gpm + k);
            const float4 gt = *(const float4*)(mods + b * NMODS + 2 * D + k);
            v[j].x += gt.x * (m[j].x * rstd * gg.x); v[j].y += gt.y * (m[j].y * rstd * gg.y);
            v[j].z += gt.z * (m[j].z * rstd * gg.z); v[j].w += gt.w * (m[j].w * rstd * gg.w);
            s1 += v[j].x * v[j].x + v[j].y * v[j].y + v[j].z * v[j].z + v[j].w * v[j].w;
            ((float4*)(x1o + (size_t)t * D) + c.lane)[64 * j] = v[j];
        }
        const float rstd1 = rsqrtf(wave_sum(s1) * (1.0f / D) + 1e-6f);
#pragma unroll
        for (int j = 0; j < 4; ++j) {
            const int k = (c.lane + 64 * j) * 4;
            const float4 gg = *(const float4*)(gpf + k);
            const float4 sh = *(const float4*)(mods + b * NMODS + 3 * D + k);
            const float4 sc = *(const float4*)(mods + b * NMODS + 4 * D + k);
            float r[4];
            r[0] = v[j].x * rstd1 * gg.x * (1.f + sc.x) + sh.x; r[1] = v[j].y * rstd1 * gg.y * (1.f + sc.y) + sh.y;
            r[2] = v[j].z * rstd1 * gg.z * (1.f + sc.z) + sh.z; r[3] = v[j].w * rstd1 * gg.w * (1.f + sc.w) + sh.w;
            unsigned hi[4]; float lo[4];
#pragma unroll
            for (int q = 0; q < 4; ++q) { hi[q] = f2bf(r[q]); lo[q] = r[q] - bf2f(hi[q]); }
            ((uint2*)(h2 + (size_t)t * D) + c.lane)[64 * j] = make_uint2(hi[0] | (hi[1] << 16), hi[2] | (hi[3] << 16));
            ((uint2*)(h2 + (size_t)(T + t) * D) + c.lane)[64 * j] = make_uint2(pk2(lo[0], lo[1]), pk2(lo[2], lo[3]));
        }
    }
}

__device__ __forceinline__ void phase11(const Ctx& c) {
    {
        pg8::Gemm g{(const bf16_t*)(c.ws + WS_A), (const bf16_t*)(c.ws + WS_WR_T), 2 * T, 512, D};
        pg8::StaticOrder S; S.init(2 * T, 512, c.G, c.bid);
        pg8::EpiRouter E{(float*)(c.ws + WS_PLOG), (bf16_t*)(c.ws + WS_PLOG + 32 * MiB), (bf16_t*)(c.ws + WS_PLOG + 48 * MiB), T / 256};
        pg8::gemm_phase<pg8::EpiRouter, pg8::StaticOrder, true, true>(c.lds, g, S, E);
    }
    __syncthreads();
    {
        pg8::Gemm g{(const bf16_t*)(c.ws + WS_A), (const bf16_t*)(c.ws + WS_WSGU_T), T, 512, D};
        pg8::StaticOrder S; S.init(T, 512, c.G, c.bid);
        pg8::EpiSwiGLU E{(bf16_t*)(c.ws + WS_HS), 256};
        pg8::gemm_phase<pg8::EpiSwiGLU, pg8::StaticOrder, true, true>(c.lds, g, S, E);
    }
}

__device__ __forceinline__ unsigned fkey(float f) { const unsigned u = __builtin_bit_cast(unsigned, f); return u ^ ((u >> 31) ? 0xffffffffu : 0x80000000u); }
__device__ __forceinline__ unsigned wave_umax(unsigned v) {
    v = max(v, DPPU(v, 0xB1)); v = max(v, DPPU(v, 0x4E)); v = max(v, DPPU(v, 0x141)); v = max(v, DPPU(v, 0x140));
    const unsigned a = __builtin_amdgcn_readlane(v, 0), b = __builtin_amdgcn_readlane(v, 16), c = __builtin_amdgcn_readlane(v, 32), d = __builtin_amdgcn_readlane(v, 48);
    return max(max(a, b), max(c, d));
}
__device__ __forceinline__ unsigned wave_umin(unsigned v) {
    v = min(v, DPPU(v, 0xB1)); v = min(v, DPPU(v, 0x4E)); v = min(v, DPPU(v, 0x141)); v = min(v, DPPU(v, 0x140));
    const unsigned a = __builtin_amdgcn_readlane(v, 0), b = __builtin_amdgcn_readlane(v, 16), c = __builtin_amdgcn_readlane(v, 32), d = __builtin_amdgcn_readlane(v, 48);
    return min(min(a, b), min(c, d));
}
__device__ __forceinline__ void phase12(const Ctx& c) {
    const float* plog = (const float*)(c.ws + WS_PLOG); const float* rb = c.in[32];
    int* idx = (int*)(c.ws + WS_IDX); float* wt = (float*)(c.ws + WS_WT);
    LAS int* lhist = (LAS int*)c.lds;
    __syncthreads();
    if (c.tid < NE) lhist[c.tid] = 0;
    __syncthreads();
    const int gw = c.bid * 8 + c.wid, NW = c.G * 8, l = c.lane;
    const float4 bias = *(const float4*)(rb + l * 4);
    for (int t = gw; t < T; t += NW) {
        const float4 p0 = *(const float4*)(plog + (size_t)t * 256 + l * 4);
        const float4 p1 = ldbf4((const bf16_t*)(c.ws + WS_PLOG + 32 * MiB) + (size_t)t * 256 + l * 4), p2 = ldbf4((const bf16_t*)(c.ws + WS_PLOG + 48 * MiB) + (size_t)t * 256 + l * 4);
        const float lg[4] = {p0.x + (p1.x + p2.x), p0.y + (p1.y + p2.y), p0.z + (p1.z + p2.z), p0.w + (p1.w + p2.w)};
        float s[4] = {sigmoidf_(lg[0]), sigmoidf_(lg[1]), sigmoidf_(lg[2]), sigmoidf_(lg[3])};
        float ch[4] = {s[0] + bias.x, s[1] + bias.y, s[2] + bias.z, s[3] + bias.w};
        float a1 = fmaxf(ch[0], ch[1]), a2 = fminf(ch[0], ch[1]);
        { const float b1 = fmaxf(ch[2], ch[3]), b2 = fminf(ch[2], ch[3]); const float n1 = fmaxf(a1, b1), n2 = fmaxf(fminf(a1, b1), fmaxf(a2, b2)); a1 = n1; a2 = n2; }
        { const float b1 = DPPF(a1, 0xB1), b2 = DPPF(a2, 0xB1); const float n1 = fmaxf(a1, b1), n2 = fmaxf(fminf(a1, b1), fmaxf(a2, b2)); a1 = n1; a2 = n2; }
        { const float b1 = DPPF(a1, 0x4E), b2 = DPPF(a2, 0x4E); const float n1 = fmaxf(a1, b1), n2 = fmaxf(fminf(a1, b1), fmaxf(a2, b2)); a1 = n1; a2 = n2; }
        { const float b1 = DPPF(a1, 0x141), b2 = DPPF(a2, 0x141); const float n1 = fmaxf(a1, b1), n2 = fmaxf(fminf(a1, b1), fmaxf(a2, b2)); a1 = n1; a2 = n2; }
        const float gs = a1 + a2; const int myg = l >> 3;
        int rank = 0;
#pragma unroll
        for (int g = 0; g < 8; ++g) { const float og = __builtin_bit_cast(float, __builtin_amdgcn_readlane(__builtin_bit_cast(int, gs), g * 8)); rank += (og > gs || (og == gs && g < myg)) ? 1 : 0; }
        const bool sel = rank < 4;
        unsigned mk[4];
#pragma unroll
        for (int i = 0; i < 4; ++i) mk[i] = sel ? fkey(ch[i]) : 0u;
        float sk[8]; int ek[8]; float ssum = 0.f;
#pragma unroll
        for (int k = 0; k < 8; ++k) {
            const unsigned lm = max(max(mk[0], mk[1]), max(mk[2], mk[3]));
            const unsigned m = wave_umax(lm);
            unsigned cand = 1023u;
#pragma unroll
            for (int i = 3; i >= 0; --i) if (mk[i] == m) cand = (unsigned)(l * 4 + i);
            const int be = (int)wave_umin(cand);
            const int ii = be & 3;
            float sv = s[0]; sv = (ii == 1) ? s[1] : sv; sv = (ii == 2) ? s[2] : sv; sv = (ii == 3) ? s[3] : sv;
            sv = __builtin_bit_cast(float, __builtin_amdgcn_readlane(__builtin_bit_cast(int, sv), be >> 2));
            if ((be >> 2) == l) {
#pragma unroll
                for (int i = 0; i < 4; ++i) if (i == ii) mk[i] = 0u;
            }
            sk[k] = sv; ek[k] = be; ssum += sv;
        }
        if (l == 0) {
            const float inv = 2.5f / ssum;
#pragma unroll
            for (int k = 0; k < 8; ++k) { idx[t * 8 + k] = ek[k]; wt[t * 8 + k] = sk[k] * inv; __hip_atomic_fetch_add(lhist + ek[k], 1, __ATOMIC_RELAXED, __HIP_MEMORY_SCOPE_WORKGROUP); }
        }
    }
    __syncthreads();
    if (c.tid < NE) ((int*)(c.ws + WS_HIST))[c.bid * NE + c.tid] = lhist[c.tid];
}

__device__ __forceinline__ void phase13(const Ctx& c) {
    int* smi = (int*)c.sm;
    const int* hist = (const int*)(c.ws + WS_HIST);
    __syncthreads();
    if (c.tid < NE) {
        int tot = 0, base = 0;
        for (int bb = 0; bb < c.G; ++bb) { const int v = hist[bb * NE + c.tid]; tot += v; base += (bb < c.bid) ? v : 0; }
        smi[600 + c.tid] = tot; smi[900 + c.tid] = base; smi[1200 + c.tid] = 0; smi[300 + c.tid] = (tot + 255) >> 8;
    }
    __syncthreads();
    if (c.tid < 64) {
        const int l = c.tid; const int u0 = smi[300 + l * 4], u1 = smi[300 + l * 4 + 1], u2 = smi[300 + l * 4 + 2], u3 = smi[300 + l * 4 + 3];
        const int tot = u0 + u1 + u2 + u3; int inc = tot;
#pragma unroll
        for (int o = 1; o < 64; o <<= 1) { const int v = __shfl_up(inc, o); if (l >= o) inc += v; }
        const int ex = inc - tot;
        smi[l * 4] = ex; smi[l * 4 + 1] = ex + u0; smi[l * 4 + 2] = ex + u0 + u1; smi[l * 4 + 3] = ex + u0 + u1 + u2;
        if (l == 63) smi[NE] = inc;
    }
    __syncthreads();
    const int* idx = (const int*)(c.ws + WS_IDX); int* slotp = (int*)(c.ws + WS_SLOTP); int* uexp = (int*)(c.ws + WS_UEXP); int* slotw = (int*)(c.ws + WS_SLOTW); const float* wt = (const float*)(c.ws + WS_WT);
    const int gw = c.bid * 8 + c.wid, NW = c.G * 8;
    for (int t = gw; t < T; t += NW) {
        if (c.lane < 8) {
            const int a = t * 8 + c.lane, e = idx[a];
            const int pos = smi[900 + e] + __hip_atomic_fetch_add(smi + 1200 + e, 1, __ATOMIC_RELAXED, __HIP_MEMORY_SCOPE_WORKGROUP);
            const int slot = smi[e] * 256 + pos;
            slotp[slot] = a;
            *(int2*)(slotw + 2 * (size_t)slot) = make_int2(a, __float_as_int(wt[a]));
        }
    }
    const int gt = c.bid * 512 + c.tid, NT = c.G * 512;
    for (int e = gt; e < NE; e += NT) {
        const int u0 = smi[e], u1 = smi[e + 1], cn = smi[600 + e];
        for (int p = cn; p < (u1 - u0) * 256; ++p) { slotp[u0 * 256 + p] = -1; *(int2*)(slotw + 2 * (size_t)(u0 * 256 + p)) = make_int2(-1, 0); }
        for (int u = u0; u < u1; ++u) uexp[u] = e;
    }
    if (gt == 0) uexp[2048] = smi[NE];
}

__device__ __forceinline__ void phase14(const Ctx& c) {
    const int* uexp = (const int*)(c.ws + WS_UEXP);
    const int NU = __builtin_amdgcn_readfirstlane(uexp[2048]);
    const int vcu = (c.G % 8 == 0) ? (c.bid % 8) * (c.G / 8) + c.bid / 8 : c.bid;
    pg8::Gemm g{(const bf16_t*)(c.ws + WS_A), (const bf16_t*)(c.ws + WS_WEGU), 0, 0, D, (const int*)(c.ws + WS_SLOTP)};
    pg8::ExpertOrder S{uexp, NU, 2, c.G, vcu};
    pg8::EpiSwiGLU E{(bf16_t*)(c.ws + WS_HID), 256};
    pg8::gemm_phase<pg8::EpiSwiGLU, pg8::ExpertOrder, true, true, true>(c.lds, g, S, E);
}

__device__ __forceinline__ void phase15(const Ctx& c) {
    {
        const int* uexp = (const int*)(c.ws + WS_UEXP);
        const int NU = __builtin_amdgcn_readfirstlane(uexp[2048]);
        const int vcu = (c.G % 8 == 0) ? (c.bid % 8) * (c.G / 8) + c.bid / 8 : c.bid;
        pg8::Gemm g{(const bf16_t*)(c.ws + WS_HID), (const bf16_t*)(c.ws + WS_WED), 0, 0, EFF};
        pg8::ExpertOrder S{uexp, NU, 4, c.G, vcu};
        pg8::EpiScatter E{(const int*)(c.ws + WS_SLOTW), (bf16_t*)(c.ws + WS_YEXP), D};
        pg8::gemm_phase<pg8::EpiScatter, pg8::ExpertOrder, true, true>(c.lds, g, S, E);
    }
    __syncthreads();
    {
        pg8::Gemm g{(const bf16_t*)(c.ws + WS_HS), (const bf16_t*)(c.ws + WS_WSD_T), T, D, 256};
        pg8::StaticOrder S; S.init(T, D, c.G, c.bid);
        pg8::EpiBf16<0> E{(bf16_t*)(c.ws + WS_SHOUT), D, nullptr, 0, 0, 1.f};
        pg8::gemm_phase<pg8::EpiBf16<0>, pg8::StaticOrder, true, true>(c.lds, g, S, E);
    }
}

__device__ __forceinline__ void phase16(const Ctx& c) {
    const float* gq = c.in[7]; const float* mods = (const float*)(c.ws + WS_MODS);
    const bf16_t* shout = (const bf16_t*)(c.ws + WS_SHOUT); const unsigned char* yexp = (const unsigned char*)(c.ws + WS_YEXP);
    float* out = c.out; float* dst = c.out;
    const int gw = c.bid * 8 + c.wid, NW = c.G * 8;
    typedef float f32x2s __attribute__((ext_vector_type(2)));
    for (int t = gw; t < T; t += NW) {
        const int b = t / SEQ;
        float y[2][8], x1[2][8]; float ss = 0.f;
        uint2 ye[2][8]; uint4 sh[2]; float4 xv[2][2];
#pragma unroll
        for (int j = 0; j < 2; ++j) {
            const int k = (c.lane + 64 * j) * 8;
            sh[j] = *(const uint4*)(shout + (size_t)t * D + k);
            xv[j][0] = *(const float4*)(out + (size_t)t * D + k); xv[j][1] = *(const float4*)(out + (size_t)t * D + k + 4);
#pragma unroll
            for (int q = 0; q < 8; ++q) ye[j][q] = *(const uint2*)(yexp + (size_t)(t * 8 + q) * D + k);
        }
#pragma unroll
        for (int j = 0; j < 2; ++j) {
            unpack8(sh[j], y[j]);
            x1[j][0] = xv[j][0].x; x1[j][1] = xv[j][0].y; x1[j][2] = xv[j][0].z; x1[j][3] = xv[j][0].w; x1[j][4] = xv[j][1].x; x1[j][5] = xv[j][1].y; x1[j][6] = xv[j][1].z; x1[j][7] = xv[j][1].w;
#pragma unroll
            for (int q = 0; q < 8; ++q) {
                const f32x2s a0 = __builtin_amdgcn_cvt_pk_f32_fp8((int)ye[j][q].x, false), a1 = __builtin_amdgcn_cvt_pk_f32_fp8((int)ye[j][q].x, true);
                const f32x2s a2 = __builtin_amdgcn_cvt_pk_f32_fp8((int)ye[j][q].y, false), a3 = __builtin_amdgcn_cvt_pk_f32_fp8((int)ye[j][q].y, true);
                y[j][0] += a0[0]; y[j][1] += a0[1]; y[j][2] += a1[0]; y[j][3] += a1[1]; y[j][4] += a2[0]; y[j][5] += a2[1]; y[j][6] += a3[0]; y[j][7] += a3[1];
            }
#pragma unroll
            for (int i = 0; i < 8; ++i) ss += y[j][i] * y[j][i];
        }
        const float rstd = rsqrtf(wave_sum_u(ss) * (1.0f / D) + 1e-6f);
#pragma unroll
        for (int j = 0; j < 2; ++j) {
            const int k = (c.lane + 64 * j) * 8;
            const float4 g0 = *(const float4*)(gq + k), g1 = *(const float4*)(gq + k + 4);
            const float4 t0 = *(const float4*)(mods + b * NMODS + 5 * D + k), t1 = *(const float4*)(mods + b * NMODS + 5 * D + k + 4);
            const float gg[8] = {g0.x, g0.y, g0.z, g0.w, g1.x, g1.y, g1.z, g1.w}, gt[8] = {t0.x, t0.y, t0.z, t0.w, t1.x, t1.y, t1.z, t1.w};
            float o[8];
#pragma unroll
            for (int i = 0; i < 8; ++i) o[i] = x1[j][i] + gt[i] * (y[j][i] * rstd * gg[i]);
            *(float4*)(dst + (size_t)t * D + k) = make_float4(o[0], o[1], o[2], o[3]); *(float4*)(dst + (size_t)t * D + k + 4) = make_float4(o[4], o[5], o[6], o[7]);
        }
    }
}

constexpr int NPHASES = 18;
__device__ __forceinline__ void probe_reset(const Ctx& c, int k) {
    unsigned* counts = (unsigned*)(c.ws + WS_COUNTS);
    if (k == 13 && c.bid == 0 && c.tid < 256) counts[c.tid] = 0u;
    if (k == 14 && c.bid == 0 && c.tid < 256) counts[256 + c.tid] = 0u;
}

__global__ void __launch_bounds__(512, 2) mega(Args args) {
    extern __shared__ __attribute__((aligned(16))) unsigned char lds_raw[];
    Ctx c;
    c.in = args.in; c.out = args.out; c.ws = args.ws;
    c.lds = (LAS unsigned char*)lds_raw; c.sm = (float*)lds_raw;
    c.dry = 0;
    c.tid = threadIdx.x; c.lane = c.tid & 63; c.wid = __builtin_amdgcn_readfirstlane(c.tid >> 6); c.bid = blockIdx.x; c.G = gridDim.x;
    volatile LAS unsigned* st = (volatile LAS unsigned*)(c.lds + LDS_CTL_OFF);
    if (c.tid < 4) st[c.tid] = 0u;
    __syncthreads();
    XcdBarrier bar; bar.bar = (unsigned*)(args.ws + WS_CTL); bar.x = 0; bar.st = st;
    const bool multi = (args.hi - args.lo) > 1;
    if (multi) bar = xcd_barrier_post((unsigned*)(args.ws + WS_CTL), st);
    const int lo = args.lo, hi = args.hi;
#ifndef REPEAT_PHASE
#define REPEAT_PHASE -1
#endif
#define LAUNDER() do { int t_ = threadIdx.x; asm volatile("" : "+v"(t_)); c.tid = t_; c.lane = t_ & 63; int b_ = blockIdx.x; asm volatile("" : "+s"(b_)); c.bid = b_; } while (0)
#define RUN_PHASE(k, call) if (lo <= (k) && (k) < hi) { if ((k) == REPEAT_PHASE) { LAUNDER(); c.dry = 1; call; c.dry = 0; xcd_barrier(bar); probe_reset(c, (k)); xcd_barrier(bar); } LAUNDER(); call; if ((k) + 1 < hi) xcd_barrier(bar); }
    RUN_PHASE(0, phase0(c))
    RUN_PHASE(1, phase1(c))
    RUN_PHASE(2, phase2(c))
    RUN_PHASE(3, phase3(c))
    RUN_PHASE(4, phase4(c))
    RUN_PHASE(5, phase5(c))
    RUN_PHASE(6, phase6a(c))
    RUN_PHASE(7, phase6b(c))
    RUN_PHASE(8, phase7(c))
    RUN_PHASE(9, phase8(c))
    RUN_PHASE(10, phase9(c))
    RUN_PHASE(11, phase10(c))
    RUN_PHASE(12, phase11(c))
    RUN_PHASE(13, phase12(c))
    RUN_PHASE(14, phase13(c))
    RUN_PHASE(15, phase14(c))
    RUN_PHASE(16, phase15(c))
    RUN_PHASE(17, phase16(c))
#undef RUN_PHASE
}

#ifndef N_LAUNCH_MODE
#define N_LAUNCH_MODE 1
#endif

extern "C" void kernel_launch(void* const* d_in, const int* in_sizes, int n_in, void* d_out, int out_size, void* d_ws, size_t ws_size, hipStream_t stream) {
    static int grid = 0;
    if (grid == 0) {
        if (n_in != 39 || out_size != T * D || ws_size < WS_END) { fprintf(stderr, "kernel_launch: unexpected shapes n_in %d out %d ws %zu\n", n_in, out_size, ws_size); grid = -1; return; }
        int dev = 0, cus = 0, per_cu = 0;
        if (hipGetDevice(&dev) != hipSuccess || hipDeviceGetAttribute(&cus, hipDeviceAttributeMultiprocessorCount, dev) != hipSuccess) { grid = -1; return; }
        if (hipFuncSetAttribute((const void*)mega, hipFuncAttributeMaxDynamicSharedMemorySize, LDS_BYTES) != hipSuccess) { grid = -1; return; }
        if (hipOccupancyMaxActiveBlocksPerMultiprocessor(&per_cu, (const void*)mega, 512, LDS_BYTES) != hipSuccess || per_cu < 1) { fprintf(stderr, "kernel_launch: occupancy query says %d\n", per_cu); }
        (void)hipGetLastError();
        grid = cus;
    }
    if (grid < 0) return;
    (void)hipMemsetAsync((char*)d_ws + WS_CTL, 0, CTL_BYTES, stream);
    Args a{};
    for (int i = 0; i < 39; ++i) a.in[i] = (const float*)d_in[i];
    a.out = (float*)d_out; a.ws = (unsigned char*)d_ws;
    if (N_LAUNCH_MODE == 1) {
        a.lo = 0; a.hi = NPHASES;
        hipLaunchKernelGGL(mega, dim3(grid), dim3(512), LDS_BYTES, stream, a);
    } else {
        for (int ph = 0; ph < NPHASES; ++ph) {
            a.lo = ph; a.hi = ph + 1;
            hipLaunchKernelGGL(mega, dim3(grid), dim3(512), LDS_BYTES, stream, a);
        }
    }
}
```

```cpp
#include <hip/hip_runtime.h>
#include <cstdint>
#include <cstdio>

#define LAS __attribute__((address_space(3)))

constexpr int D = 1024, BATCH = 4, SEQ = 8192, T = BATCH * SEQ;
constexpr int RW = 512, NH = 8;
constexpr int RPROJ = 1792, NPROJ = 2304;
constexpr int S5NG = 32, S5P = 64;
constexpr int NE = 256, EFF = 256;
constexpr int NMODS = 6 * D;
constexpr int S5L = 32;

constexpr size_t MiB = 1u << 20;
constexpr size_t WS_CTL = 0, CTL_BYTES = 1 * MiB;
constexpr size_t WS_COUNTS = 64 * 1024;
constexpr size_t WS_MODS = 1 * MiB;
constexpr size_t WS_HMAT = 2 * MiB;
constexpr size_t WS_WIN_T = 12 * MiB;
constexpr size_t WS_WOUT_T = 17 * MiB;
constexpr size_t WS_WGLU_T = 19 * MiB;
constexpr size_t WS_WSGU_T = 19 * MiB + 512 * 1024;
constexpr size_t WS_WSD_T = 20 * MiB + 512 * 1024;
constexpr size_t WS_WR_T = 21 * MiB;
constexpr size_t WS_LORA_BT = 22 * MiB;
constexpr size_t WS_APOW = 23 * MiB;
constexpr size_t WS_KMAT = 1000 * MiB;
constexpr size_t WS_MODSP = 1020 * MiB;
constexpr size_t WS_S5BB = 1022 * MiB;
constexpr size_t WS_KLAG = 1022 * MiB + 512 * 1024;
constexpr size_t OUT_UX = 0;
constexpr size_t OUT_E = 40 * MiB;
constexpr size_t OUT_ALORA = 56 * MiB;
constexpr size_t OUT_KF = 72 * MiB;
constexpr size_t WS_WED = 24 * MiB;
constexpr size_t WS_WEGU = 152 * MiB;
constexpr size_t WS_A = 408 * MiB;
constexpr size_t WS_YS5 = WS_A + 64 * MiB;
constexpr size_t WS_PROJ = 536 * MiB;
constexpr size_t WS_RW = 680 * MiB;
constexpr size_t RWSZ = (size_t)T * RW * 4;
constexpr size_t RWSZH = (size_t)T * RW * 2;
constexpr size_t WS_RW_W = WS_RW, WS_RW_Y = WS_RW + RWSZ, WS_RW_R = WS_RW + 2 * RWSZ, WS_RW_K = WS_RW_R + RWSZH, WS_RW_V = WS_RW_K + RWSZH,
                 WS_RW_A = WS_RW_V + RWSZH, WS_RW_B = WS_RW_A + RWSZH, WS_RW_G = WS_RW_B + RWSZH;
constexpr size_t WS_CM = WS_PROJ, WS_CN = WS_PROJ + 32 * MiB, WS_CQ = WS_PROJ + 64 * MiB, WS_CY = WS_PROJ + 96 * MiB;
constexpr size_t WS_CS = WS_RW_Y, WS_CBON = WS_RW_Y + 32 * MiB;
constexpr size_t WS_PLOG = 680 * MiB;
constexpr size_t WS_SHOUT = 680 * MiB;
constexpr size_t WS_HS = 808 * MiB;
constexpr size_t WS_IDX = 824 * MiB;
constexpr size_t WS_WT = 825 * MiB;
constexpr size_t WS_SLOTP = 826 * MiB;
constexpr size_t WS_UEXP = 827 * MiB + 512 * 1024;
constexpr size_t WS_SLOTW = 828 * MiB;
constexpr size_t WS_HIST = 831 * MiB;
constexpr size_t WS_HID = 840 * MiB;
constexpr size_t WS_YEXP = 152 * MiB;
constexpr size_t WS_END = 1023 * MiB + 512 * 1024;

constexpr int LDS_BYTES = 132096;
constexpr int LDS_CTL_OFF = 131072;

#define XB_TMO      128
#define XB_XCNT(j)  (256  + 64 * (j))
#define XB_XSUB(j)  (1280 + 64 * (j))
#define XB_XGEN(j)  (2304 + 64 * (j))
#define XB_TOP      3328
#define XB_TOPGEN   3392
#define XCD_BAR_WORDS 3456
#define XB_SPIN_CAP (1u << 24)

__device__ __forceinline__ unsigned xb_ld(unsigned* p)              { return __hip_atomic_load(p, __ATOMIC_RELAXED, __HIP_MEMORY_SCOPE_AGENT); }
__device__ __forceinline__ unsigned xb_add(unsigned* p, unsigned v) { return __hip_atomic_fetch_add(p, v, __ATOMIC_RELAXED, __HIP_MEMORY_SCOPE_AGENT); }
__device__ __forceinline__ unsigned xb_xcc_id() { return (unsigned)__builtin_amdgcn_s_getreg((3 << 11) | 20) & 0xFu; }
#define XB_SPIN(cond, bar) do { unsigned _sp = 0; while (cond) { __builtin_amdgcn_s_sleep(1); \
    if ((++_sp & 255u) == 0u) { if (xb_ld(&(bar)[XB_TMO])) break; if (_sp > XB_SPIN_CAP) { atomicAdd(&(bar)[XB_TMO], 1u); break; } } } } while (0)

struct XcdBarrier { unsigned* bar; unsigned x; volatile LAS unsigned* st; };

__device__ __forceinline__ XcdBarrier xcd_barrier_post(unsigned* bar, volatile LAS unsigned* st) {
    XcdBarrier b; b.bar = bar; b.x = xb_xcc_id(); b.st = st;
    if (threadIdx.x == 0) (void)xb_add(&bar[XB_XCNT(b.x)], 1u);
    return b;
}
__device__ __forceinline__ void xcd_barrier_complete(unsigned* bar, unsigned x, unsigned& nloc, unsigned& nx) {
    const unsigned G = gridDim.x * gridDim.y * gridDim.z;
    unsigned sum, cnt, mine, sp = 0u;
    for (;;) {
        sum = 0u; cnt = 0u; mine = 0u;
#pragma unroll
        for (unsigned j = 0; j < 16; ++j) { const unsigned c = xb_ld(&bar[XB_XCNT(j)]); sum += c; cnt += (c > 0u) ? 1u : 0u; mine = (j == x) ? c : mine; }
        if (sum == G) break;
        __builtin_amdgcn_s_sleep(1);
        if ((++sp & 255u) == 0u) { if (xb_ld(&bar[XB_TMO])) break; if (sp > XB_SPIN_CAP) { atomicAdd(&bar[XB_TMO], 1u); break; } }
    }
    nloc = mine > 0u ? mine : 1u; nx = cnt > 0u ? cnt : 1u;
}
__device__ __forceinline__ void xcd_barrier(const XcdBarrier& b) {
    asm volatile("s_waitcnt vmcnt(0)" ::: "memory");
    __syncthreads();
    if (threadIdx.x == 0) {
        unsigned* bar = b.bar;
        __builtin_amdgcn_s_waitcnt(0);
        unsigned nloc = b.st[0], nx = b.st[1];
        if (nloc == 0u) { xcd_barrier_complete(bar, b.x, nloc, nx); b.st[0] = nloc; b.st[1] = nx; }
        const unsigned old = xb_add(&bar[XB_XSUB(b.x)], 1u);
        const unsigned gen = old / nloc;
        if (old + 1u == (gen + 1u) * nloc) {
            __builtin_amdgcn_fence(__ATOMIC_RELEASE, "agent");
            asm volatile("s_waitcnt vmcnt(0)" ::: "memory");
            const unsigned og = xb_add(&bar[XB_TOP], 1u);
            const unsigned tg = og / nx;
            if (og + 1u == (tg + 1u) * nx) xb_add(&bar[XB_TOPGEN], 1u);
            else XB_SPIN(xb_ld(&bar[XB_TOPGEN]) == tg, bar);
            __builtin_amdgcn_fence(__ATOMIC_ACQUIRE, "agent");
            xb_add(&bar[XB_XGEN(b.x)], 1u);
            asm volatile("s_waitcnt vmcnt(0)" ::: "memory");
        } else {
            XB_SPIN(xb_ld(&bar[XB_XGEN(b.x)]) == gen, bar);
            __builtin_amdgcn_fence(__ATOMIC_ACQUIRE, "agent");
            asm volatile("s_waitcnt vmcnt(0)" ::: "memory");
        }
    }
    __syncthreads();
}

namespace pg8 {
#define PG8_LAS __attribute__((address_space(3)))
typedef unsigned short bf16_t;
typedef short bf16x8 __attribute__((ext_vector_type(8)));
typedef float f32x4 __attribute__((ext_vector_type(4)));
typedef unsigned u32x4 __attribute__((ext_vector_type(4)));
constexpr int BM = 256, BK = 64, HALF = 128, HTB = HALF * BK * 2  , STAGE_BYTES = 8 * HTB, NXCD = 8, WGM = 8;

__host__ __device__ __forceinline__ int lds_byte(int r, int c) { const int st = (r >> 4) * 2 + (c >> 5), rr = r & 15, cc = c & 31, ob = rr * 64 + cc * 2; return st * 1024 + (ob ^ (((ob >> 9) & 1) << 5)); }
__host__ __device__ __forceinline__ void stage_rc(int b, int& R, int& C) { const int st = b / 1024, sb = b % 1024, swz = sb ^ (((sb >> 9) & 1) << 5); R = (st >> 1) * 16 + swz / 64; C = (st & 1) * 32 + (swz % 64) / 2; }
__host__ __device__ __forceinline__ int perm32(int rho) { const int n = rho >> 4, i = rho & 15; return 8 * (i >> 2) + 4 * n + (i & 3); }

struct Unit { int pm, pn; };
struct Gemm { const bf16_t* A; const bf16_t* Bt; int M, N, K; const int* rowtab = nullptr; };

struct StaticOrder {
    int nM, nN, nwg, G, c;
    __host__ __device__ void init(int M, int N, int G_, int c_) { nM = M / BM; nN = N / BM; nwg = nM * nN; G = G_; c = c_; }
    __host__ __device__ bool next(int i, Unit& u) const {
        const long L = (long)i * G + c; if (L >= nwg) return false;
        int wgid = (int)L; { const int q = nwg / NXCD, r = nwg % NXCD, xcd = wgid % NXCD, off = wgid / NXCD; wgid = (xcd < r ? xcd * (q + 1) : r * (q + 1) + (xcd - r) * q) + off; }
        const int nig = WGM * nN, gid = wgid / nig, fm = gid * WGM, gsz = (nM - fm) < WGM ? (nM - fm) : WGM;
        u.pm = fm + ((wgid % nig) % gsz); u.pn = (wgid % nig) / gsz; return true;
    }
    __device__ __forceinline__ void a_ready(const Unit&) const {}
    __device__ __forceinline__ void done(const Unit&) const {}
};

__device__ __forceinline__ unsigned cvt_pk_bf16(float lo, float hi) { unsigned r; asm volatile("v_cvt_pk_bf16_f32 %0, %1, %2" : "=v"(r) : "v"(lo), "v"(hi)); return r; }
typedef float f32x2 __attribute__((ext_vector_type(2)));
__device__ __forceinline__ f32x2 gelu_pk(f32x2 v) {
    const f32x2 av = __builtin_elementwise_abs(v), d = av * 0.2316418882f + 1.0f;
    f32x2 t; t.x = __builtin_amdgcn_rcpf(d.x); t.y = __builtin_amdgcn_rcpf(d.y);
    f32x2 q = t * 0.5307027145f + (-0.7265760135f); q = q * t + 0.7107068705f; q = q * t + (-0.142248368f); q = q * t + 0.127414796f; q = q * t;
    const f32x2 s = (v * v) * (-0.72134752044f);
    f32x2 e; e.x = __builtin_amdgcn_exp2f(s.x); e.y = __builtin_amdgcn_exp2f(s.y);
    const f32x2 m = v * (q * e), r = v - m;
    f32x2 o; o.x = v.x < 0.f ? m.x : r.x; o.y = v.y < 0.f ? m.y : r.y; return o;
}

template <int ACT  > struct EpiBf16 {
    static constexpr bool PERM = true, AFTER_DRAIN = false; static_assert(ACT == 0 || ACT == 1, "EpiBf16: ACT is 0 (none) or 1 (gelu_pk)");
    bf16_t* O; int ldc; const float* bias; int split_cols; size_t split_stride; float scale0;
    __device__ __forceinline__ void operator()(const f32x4 (&acc)[2][2][4][2], const Unit& u, int wr, int wc, int fr, int fq) const {
        const int row0 = u.pm * BM + wr * 64 + fr; int colt = u.pn * BM; bf16_t* base = O;
        float sc = 1.f; if (split_cols) { const int t = colt / split_cols; base += (size_t)t * split_stride; colt -= t * split_cols; if (t == 0) sc = scale0; }
        const int col0 = colt + wc * 32 + 8 * fq, bcol0 = u.pn * BM + wc * 32 + 8 * fq;
        f32x4 bv[2][2];
#pragma unroll
        for (int bj = 0; bj < 2; ++bj)
#pragma unroll
            for (int n = 0; n < 2; ++n) bv[bj][n] = bias ? *(const f32x4*)(bias + bcol0 + bj * HALF + 4 * n) : (f32x4){0.f, 0.f, 0.f, 0.f};
#pragma unroll
        for (int ai = 0; ai < 2; ++ai)
#pragma unroll
            for (int m = 0; m < 4; ++m) { bf16_t* rowp = base + (size_t)(row0 + ai * HALF + m * 16) * ldc + col0;
#pragma unroll
                for (int bj = 0; bj < 2; ++bj) { f32x4 v0 = acc[ai][bj][m][0] + bv[bj][0], v1 = acc[ai][bj][m][1] + bv[bj][1];
                    if (ACT == 1) { f32x2 a = gelu_pk((f32x2){v0[0], v0[1]}), b = gelu_pk((f32x2){v0[2], v0[3]}), c = gelu_pk((f32x2){v1[0], v1[1]}), d = gelu_pk((f32x2){v1[2], v1[3]});
                        v0 = (f32x4){a.x, a.y, b.x, b.y}; v1 = (f32x4){c.x, c.y, d.x, d.y}; }
                    v0 = v0 * sc; v1 = v1 * sc; u32x4 w; w.x = cvt_pk_bf16(v0[0], v0[1]); w.y = cvt_pk_bf16(v0[2], v0[3]); w.z = cvt_pk_bf16(v1[0], v1[1]); w.w = cvt_pk_bf16(v1[2], v1[3]);
                    *(u32x4*)(rowp + bj * HALF) = w; } }
    }
};

struct EpiF32 {
    static constexpr bool PERM = false, AFTER_DRAIN = false;
    float* C; int ldc;
    __device__ __forceinline__ void operator()(const f32x4 (&acc)[2][2][4][2], const Unit& u, int wr, int wc, int fr, int fq) const {
        const int row0 = u.pm * BM + wr * 64 + fr, col0 = u.pn * BM + wc * 32 + 4 * fq;
#pragma unroll
        for (int ai = 0; ai < 2; ++ai)
#pragma unroll
            for (int m = 0; m < 4; ++m) { float* rowp = C + (size_t)(row0 + ai * HALF + m * 16) * ldc + col0;
#pragma unroll
                for (int bj = 0; bj < 2; ++bj)
#pragma unroll
                    for (int n = 0; n < 2; ++n) *(f32x4*)(rowp + bj * HALF + n * 16) = acc[ai][bj][m][n]; }
    }
};
__device__ __forceinline__ float fast_sigmoid(float x) { return __builtin_amdgcn_rcpf(1.0f + __builtin_amdgcn_exp2f(-1.4426950408889634f * x)); }
struct EpiSwiGLU {
    static constexpr bool PERM = true, AFTER_DRAIN = false;
    bf16_t* O; int ldo;
    __device__ __forceinline__ void operator()(const f32x4 (&acc)[2][2][4][2], const Unit& u, int wr, int wc, int fr, int fq) const {
        const int row0 = u.pm * BM + wr * 64 + fr, col0 = (u.pn & 1) * HALF + wc * 32 + 8 * fq;
#pragma unroll
        for (int ai = 0; ai < 2; ++ai)
#pragma unroll
            for (int m = 0; m < 4; ++m) {
                bf16_t* rowp = O + (size_t)(row0 + ai * HALF + m * 16) * ldo + col0;
                const f32x4 g0 = acc[ai][0][m][0], g1 = acc[ai][0][m][1], u0 = acc[ai][1][m][0], u1 = acc[ai][1][m][1];
                float r[8];
#pragma unroll
                for (int i = 0; i < 4; ++i) { r[i] = g0[i] * fast_sigmoid(g0[i]) * u0[i]; r[4 + i] = g1[i] * fast_sigmoid(g1[i]) * u1[i]; }
                u32x4 w; w.x = cvt_pk_bf16(r[0], r[1]); w.y = cvt_pk_bf16(r[2], r[3]); w.z = cvt_pk_bf16(r[4], r[5]); w.w = cvt_pk_bf16(r[6], r[7]);
                *(u32x4*)rowp = w;
            }
    }
};
struct EpiScatter {
    static constexpr bool PERM = true, AFTER_DRAIN = false;
    const int* slotw; bf16_t* Y; int ldy;
    __device__ __forceinline__ void operator()(const f32x4 (&acc)[2][2][4][2], const Unit& u, int wr, int wc, int fr, int fq) const {
        int t2 = threadIdx.x; asm volatile("" : "+v"(t2));
        const int fr2 = t2 & 15, fq2 = (t2 >> 4) & 3, wc2 = (t2 >> 6) & 3, wr2 = (t2 >> 8) & 1;
        const int col0 = (u.pn & 3) * BM + wc2 * 32 + 8 * fq2;
        const int rbase = u.pm * BM + wr2 * 64 + fr2;
        typedef int i32x2 __attribute__((ext_vector_type(2)));
        i32x2 rec[2][4];
#pragma unroll
        for (int ai = 0; ai < 2; ++ai)
#pragma unroll
            for (int m = 0; m < 4; ++m) rec[ai][m] = *(const i32x2*)(slotw + 2 * (size_t)(rbase + ai * HALF + m * 16));
#pragma unroll
        for (int ai = 0; ai < 2; ++ai)
#pragma unroll
            for (int m = 0; m < 4; ++m) {
                const int aid = rec[ai][m].x;
                if (aid >= 0) {
                    const int wbits = rec[ai][m].y;
                    const float w = __int_as_float(wbits);
                    unsigned char* rowp = (unsigned char*)Y + (size_t)aid * ldy + col0;
#pragma unroll
                    for (int bj = 0; bj < 2; ++bj) {
                        f32x4 v0 = acc[ai][bj][m][0] * w, v1 = acc[ai][bj][m][1] * w;
#pragma unroll
                        for (int i = 0; i < 4; ++i) { v0[i] = __builtin_amdgcn_fmed3f(v0[i], -448.0f, 448.0f); v1[i] = __builtin_amdgcn_fmed3f(v1[i], -448.0f, 448.0f); }
                        int lo = 0, hi = 0;
                        lo = __builtin_amdgcn_cvt_pk_fp8_f32(v0[0], v0[1], lo, false); lo = __builtin_amdgcn_cvt_pk_fp8_f32(v0[2], v0[3], lo, true);
                        hi = __builtin_amdgcn_cvt_pk_fp8_f32(v1[0], v1[1], hi, false); hi = __builtin_amdgcn_cvt_pk_fp8_f32(v1[2], v1[3], hi, true);
                        typedef int i32x2s __attribute__((ext_vector_type(2)));
                        *(i32x2s*)(rowp + bj * HALF) = (i32x2s){lo, hi};
                    }
                }
            }
    }
};
struct ExpertOrder {
    const int* uexp; int NU, npn, G, c;
    __device__ __forceinline__ bool next(int i, Unit& u) const {
        const int L = i * G + c; if (L >= NU * npn) return false;
        const int uu = L / npn, pl = L % npn;
        u.pm = uu; u.pn = __builtin_amdgcn_readfirstlane(uexp[uu]) * npn + pl; return true;
    }
    __device__ __forceinline__ void a_ready(const Unit&) const {}
    __device__ __forceinline__ void done(const Unit&) const {}
};
struct EpiRouter {
    static constexpr bool PERM = true, AFTER_DRAIN = false;
    float* P0; bf16_t* P1; bf16_t* P2; int TP;
    __device__ __forceinline__ void operator()(const f32x4 (&acc)[2][2][4][2], const Unit& u, int wr, int wc, int fr, int fq) const {
        const bool lo_rows = u.pm >= TP; const int pmr = lo_rows ? u.pm - TP : u.pm;
        if (lo_rows && u.pn == 1) return;
        const int row0 = pmr * BM + wr * 64 + fr, col0 = wc * 32 + 8 * fq;
#pragma unroll
        for (int ai = 0; ai < 2; ++ai)
#pragma unroll
            for (int m = 0; m < 4; ++m) {
                const size_t off = (size_t)(row0 + ai * HALF + m * 16) * 256 + col0;
#pragma unroll
                for (int bj = 0; bj < 2; ++bj) {
                    const f32x4 v0 = acc[ai][bj][m][0], v1 = acc[ai][bj][m][1];
                    if (!lo_rows && u.pn == 0) { *(f32x4*)(P0 + off + bj * HALF) = v0; *(f32x4*)(P0 + off + bj * HALF + 4) = v1; }
                    else { u32x4 w; w.x = cvt_pk_bf16(v0[0], v0[1]); w.y = cvt_pk_bf16(v0[2], v0[3]); w.z = cvt_pk_bf16(v1[0], v1[1]); w.w = cvt_pk_bf16(v1[2], v1[3]);
                           *(u32x4*)((lo_rows ? P2 : P1) + off + bj * HALF) = w; }
                }
            }
    }
};
struct S5Order {
    int NUNITS, npn, G, c;
    __device__ __forceinline__ bool next(int i, Unit& u) const {
        const int L = i * G + c; if (L >= NUNITS) return false;
        u.pm = L / npn; u.pn = (u.pm >> 2) * npn + L % npn; return true;
    }
    __device__ __forceinline__ void a_ready(const Unit&) const {}
    __device__ __forceinline__ void done(const Unit&) const {}
};
struct EpiS5E {
    static constexpr bool PERM = false, AFTER_DRAIN = false;
    float* E;
    __device__ __forceinline__ void operator()(const f32x4 (&acc)[2][2][4][2], const Unit& u, int wr, int wc, int fr, int fq) const {
        const int row0 = u.pm * BM + wr * 64 + fr, col0 = wc * 32 + 4 * fq;
#pragma unroll
        for (int ai = 0; ai < 2; ++ai)
#pragma unroll
            for (int m = 0; m < 4; ++m) { float* rowp = E + (size_t)(row0 + ai * HALF + m * 16) * 128 + col0;
#pragma unroll
                for (int n = 0; n < 2; ++n) *(f32x4*)(rowp + n * 16) = acc[ai][0][m][n]; }
    }
};
struct EpiS5Out {
    static constexpr bool PERM = true, AFTER_DRAIN = false;
    bf16_t* Y;
    __device__ __forceinline__ void operator()(const f32x4 (&acc)[2][2][4][2], const Unit& u, int wr, int wc, int fr, int fq) const {
        const int g = u.pm >> 2;
#pragma unroll
        for (int ai = 0; ai < 2; ++ai)
#pragma unroll
            for (int m = 0; m < 4; ++m) {
                const int r = (u.pm & 3) * BM + ai * HALF + wr * 64 + m * 16 + fr, b = r >> 8, chunk = r & 255;
#pragma unroll
                for (int bj = 0; bj < 2; ++bj) {
                    const int colg = (u.pn & 1) * BM + bj * HALF + wc * 32 + 8 * fq, t = colg >> 4, c0 = colg & 15;
                    const f32x4 v0 = acc[ai][bj][m][0], v1 = acc[ai][bj][m][1];
                    float x[8] = {v0[0], v0[1], v0[2], v0[3], v1[0], v1[1], v1[2], v1[3]};
#pragma unroll
                    for (int i = 0; i < 8; ++i) { const float z = x[i]; x[i] = z * fast_sigmoid(1.5957691216057308f * (z + 0.044715f * z * z * z)); }
                    u32x4 w; w.x = cvt_pk_bf16(x[0], x[1]); w.y = cvt_pk_bf16(x[2], x[3]); w.z = cvt_pk_bf16(x[4], x[5]); w.w = cvt_pk_bf16(x[6], x[7]);
                    *(u32x4*)(Y + ((size_t)(b * 8192 + chunk * 32 + t)) * 512 + g * 16 + c0) = w;
                }
            }
    }
};
struct EpiLora {
    static constexpr bool PERM = true, AFTER_DRAIN = false;
    const float* w0; const float* a0; const float* k_a; float* W; const bf16_t* Kp; bf16_t* Kf; const bf16_t* A; bf16_t* B; bf16_t* Gt;
    __device__ __forceinline__ void operator()(const f32x4 (&acc)[2][2][4][2], const Unit& u, int wr, int wc, int fr, int fq) const {
        const int seg = u.pn >> 1;
#pragma unroll
        for (int bj = 0; bj < 2; ++bj) {
            const int nn = (u.pn & 1) * BM + bj * HALF + wc * 32 + 8 * fq;
            float p0[8], p1[8];
            if (seg == 0) { const f32x4 a = *(const f32x4*)(w0 + nn), b = *(const f32x4*)(w0 + nn + 4); p0[0] = a[0]; p0[1] = a[1]; p0[2] = a[2]; p0[3] = a[3]; p0[4] = b[0]; p0[5] = b[1]; p0[6] = b[2]; p0[7] = b[3]; }
            else if (seg == 1) { const f32x4 a = *(const f32x4*)(a0 + nn), b = *(const f32x4*)(a0 + nn + 4), cc = *(const f32x4*)(k_a + nn), d = *(const f32x4*)(k_a + nn + 4);
                p0[0] = a[0]; p0[1] = a[1]; p0[2] = a[2]; p0[3] = a[3]; p0[4] = b[0]; p0[5] = b[1]; p0[6] = b[2]; p0[7] = b[3];
                p1[0] = cc[0]; p1[1] = cc[1]; p1[2] = cc[2]; p1[3] = cc[3]; p1[4] = d[0]; p1[5] = d[1]; p1[6] = d[2]; p1[7] = d[3]; }
#pragma unroll
            for (int ai = 0; ai < 2; ++ai)
#pragma unroll
                for (int m = 0; m < 4; ++m) {
                    const size_t off = (size_t)(u.pm * BM + ai * HALF + wr * 64 + m * 16 + fr) * 512 + nn;
                    const f32x4 v0 = acc[ai][bj][m][0], v1 = acc[ai][bj][m][1];
                    const float x[8] = {v0[0], v0[1], v0[2], v0[3], v1[0], v1[1], v1[2], v1[3]};
                    if (seg == 0) {
                        float o[8];
#pragma unroll
                        for (int i = 0; i < 8; ++i) { const float wa = p0[i] + x[i];
                            o[i] = __builtin_amdgcn_exp2f(-0.8750387749145276f * fast_sigmoid(wa)); }
                        *(f32x4*)(W + off) = (f32x4){o[0], o[1], o[2], o[3]}; *(f32x4*)(W + off + 4) = (f32x4){o[4], o[5], o[6], o[7]};
                    } else if (seg == 1) {
                        const u32x4 kv = *(const u32x4*)(Kp + off), av = *(const u32x4*)(A + off);
                        const float k[8] = {__builtin_bit_cast(float, kv.x << 16), __builtin_bit_cast(float, kv.x & 0xffff0000u), __builtin_bit_cast(float, kv.y << 16), __builtin_bit_cast(float, kv.y & 0xffff0000u),
                                            __builtin_bit_cast(float, kv.z << 16), __builtin_bit_cast(float, kv.z & 0xffff0000u), __builtin_bit_cast(float, kv.w << 16), __builtin_bit_cast(float, kv.w & 0xffff0000u)};
                        const float a[8] = {__builtin_bit_cast(float, av.x << 16), __builtin_bit_cast(float, av.x & 0xffff0000u), __builtin_bit_cast(float, av.y << 16), __builtin_bit_cast(float, av.y & 0xffff0000u),
                                            __builtin_bit_cast(float, av.z << 16), __builtin_bit_cast(float, av.z & 0xffff0000u), __builtin_bit_cast(float, av.w << 16), __builtin_bit_cast(float, av.w & 0xffff0000u)};
                        float kf[8], bo[8];
#pragma unroll
                        for (int i = 0; i < 8; ++i) { const float ic = fast_sigmoid(p0[i] + x[i]); kf[i] = k[i] * (1.0f + (ic - 1.0f) * p1[i]); bo[i] = -a[i] * ic; }
                        u32x4 w; w.x = cvt_pk_bf16(kf[0], kf[1]); w.y = cvt_pk_bf16(kf[2], kf[3]); w.z = cvt_pk_bf16(kf[4], kf[5]); w.w = cvt_pk_bf16(kf[6], kf[7]);
                        *(u32x4*)(Kf + off) = w;
                        w.x = cvt_pk_bf16(bo[0], bo[1]); w.y = cvt_pk_bf16(bo[2], bo[3]); w.z = cvt_pk_bf16(bo[4], bo[5]); w.w = cvt_pk_bf16(bo[6], bo[7]);
                        *(u32x4*)(B + off) = w;
                    } else {
                        u32x4 w; w.x = cvt_pk_bf16(x[0], x[1]); w.y = cvt_pk_bf16(x[2], x[3]); w.z = cvt_pk_bf16(x[4], x[5]); w.w = cvt_pk_bf16(x[6], x[7]);
                        *(u32x4*)(Gt + off) = w;
                    }
                }
        }
    }
};
struct EpiGLU {
    static constexpr bool PERM = true, AFTER_DRAIN = false;
    const bf16_t* Y; int ldy; const float* bias; bf16_t* O; int ldo; int ocol0;
    __device__ __forceinline__ void operator()(const f32x4 (&acc)[2][2][4][2], const Unit& u, int wr, int wc, int fr, int fq) const {
        const int row0 = u.pm * BM + wr * 64 + fr, col0 = u.pn * BM + wc * 32 + 8 * fq;
#pragma unroll
        for (int bj = 0; bj < 2; ++bj) {
            const f32x4 b0 = *(const f32x4*)(bias + col0 + bj * HALF), b1 = *(const f32x4*)(bias + col0 + bj * HALF + 4);
#pragma unroll
            for (int ai = 0; ai < 2; ++ai)
#pragma unroll
                for (int m = 0; m < 4; ++m) {
                    const size_t row = (size_t)(row0 + ai * HALF + m * 16);
                    const u32x4 yv = *(const u32x4*)(Y + row * ldy + col0 + bj * HALF);
                    const f32x4 z0 = acc[ai][bj][m][0] + b0, z1 = acc[ai][bj][m][1] + b1;
                    float y[8] = {__builtin_bit_cast(float, yv.x << 16), __builtin_bit_cast(float, yv.x & 0xffff0000u), __builtin_bit_cast(float, yv.y << 16), __builtin_bit_cast(float, yv.y & 0xffff0000u),
                                  __builtin_bit_cast(float, yv.z << 16), __builtin_bit_cast(float, yv.z & 0xffff0000u), __builtin_bit_cast(float, yv.w << 16), __builtin_bit_cast(float, yv.w & 0xffff0000u)};
                    float r[8];
#pragma unroll
                    for (int i = 0; i < 4; ++i) { r[i] = y[i] * fast_sigmoid(z0[i]); r[4 + i] = y[4 + i] * fast_sigmoid(z1[i]); }
                    u32x4 w; w.x = cvt_pk_bf16(r[0], r[1]); w.y = cvt_pk_bf16(r[2], r[3]); w.z = cvt_pk_bf16(r[4], r[5]); w.w = cvt_pk_bf16(r[6], r[7]);
                    *(u32x4*)(O + row * ldo + ocol0 + col0 + bj * HALF) = w;
                }
        }
    }
};
template <class Epi, class Sched, bool ALIGN_EPI = false, bool SP2 = false, bool GATHER = false>
__device__ __forceinline__ void gemm_phase(PG8_LAS unsigned char* lds, const Gemm g, const Sched& S, const Epi& E) {
    int tid_ = threadIdx.x; asm volatile("" : "+v"(tid_));
    const int tid = tid_, wid = __builtin_amdgcn_readfirstlane(tid >> 6), lane = tid & 63, wr = wid >> 2, wc = wid & 3, fr = lane & 15, fq = lane >> 4;
    const int K = g.K, nt = K / BK;
    unsigned voffA[2], voffB[2];
#pragma unroll
    for (int i = 0; i < 2; ++i) { int R, C; stage_rc(tid * 16 + i * 8192, R, C); const int Rb = Epi::PERM ? ((R & ~31) + perm32(R & 31)) : R;
        voffA[i] = (unsigned)(R * K + C) * 2u; voffB[i] = (unsigned)(Rb * K + C) * 2u; }
    const size_t kstep = (size_t)(BK * 2);
    const size_t hstep = (size_t)HALF * K * 2;
    const size_t tstep = 2 * hstep;
    const unsigned ldsw = (unsigned)wid * 1024u;
    const int aoff = lds_byte(wr * 64 + fr, fq * 8), boff = lds_byte(wc * 32 + fr, fq * 8);
#define PG8_SA(b, h) (((b) * 2 + (h)) * HTB)
#define PG8_SB(b, h) ((4 + (b) * 2 + (h)) * HTB)
#define PG8_STAGE(bufoff, gbase, voff) do { _Pragma("unroll") for (int _i = 0; _i < 2; ++_i) \
        __builtin_amdgcn_global_load_lds((const unsigned*)((const char*)(gbase) + (voff)[_i]), (PG8_LAS unsigned*)(lds + (bufoff) + ldsw + _i * 8192), 16, 0, 0); } while (0)
#define PG8_STAGE_A(bufoff, kptr, h, NEXTSEL) do { if constexpr (GATHER) { const unsigned _p = (NEXTSEL) ? gnxt[h] : gcur[h]; const unsigned _v[2] = { (_p & 0xffffu) * (unsigned)(2 * K) + gC2, (_p >> 16) * (unsigned)(2 * K) + gC2 }; PG8_STAGE(bufoff, kptr, _v); } \
        else { PG8_STAGE(bufoff, (kptr) + (h) * hstep, voffA); } } while (0)
#define PG8_LDA(dst, b, h) do { _Pragma("unroll") for (int m = 0; m < 4; ++m) _Pragma("unroll") for (int k = 0; k < 2; ++k) dst[m][k] = *(const PG8_LAS bf16x8*)(lds + PG8_SA(b, h) + aoff + m * 2048 + k * 1024); } while (0)
#define PG8_LDB(dst, b, h) do { _Pragma("unroll") for (int n = 0; n < 2; ++n) _Pragma("unroll") for (int k = 0; k < 2; ++k) dst[n][k] = *(const PG8_LAS bf16x8*)(lds + PG8_SB(b, h) + boff + n * 2048 + k * 1024); } while (0)
#define PG8_MMA(ai, bj, At, Bt) do { __builtin_amdgcn_s_setprio(1); _Pragma("unroll") for (int m = 0; m < 4; ++m) _Pragma("unroll") for (int n = 0; n < 2; ++n) _Pragma("unroll") for (int k = 0; k < 2; ++k) \
        acc[ai][bj][m][n] = __builtin_amdgcn_mfma_f32_16x16x32_bf16(Bt[n][k], At[m][k], acc[ai][bj][m][n], 0, 0, 0); __builtin_amdgcn_s_setprio(0); } while (0)
#define PG8_WAIT_V(n) asm volatile("s_waitcnt vmcnt(" #n ")" ::: "memory")
#define PG8_WAIT_L(n) asm volatile("s_waitcnt lgkmcnt(" #n ")" ::: "memory")
#define PG8_BAR __builtin_amdgcn_s_barrier()
#define PG8_SCHED __builtin_amdgcn_sched_barrier(0)
    unsigned gcur[2], gnxt[2], gC2 = 0;
    if constexpr (GATHER) { int R, C; stage_rc(tid * 16, R, C); gC2 = (unsigned)C * 2u; }
    auto load_gather = [&](int pm, unsigned (&dst)[2]) {
        int R, C; stage_rc(tid * 16, R, C);
#pragma unroll
        for (int h = 0; h < 2; ++h) { int a0 = g.rowtab[pm * BM + h * HALF + R], a1 = g.rowtab[pm * BM + h * HALF + R + 64]; a0 = a0 < 0 ? 0 : a0; a1 = a1 < 0 ? 0 : a1; dst[h] = (unsigned)(a0 >> 3) | ((unsigned)(a1 >> 3) << 16); }
    };
    Unit cur, nxt; int ui = 0;
    if (!S.next(0, cur)) return;
    f32x4 acc[2][2][4][2];
#pragma unroll
    for (int a = 0; a < 2; ++a)
#pragma unroll
        for (int b = 0; b < 2; ++b)
#pragma unroll
            for (int m = 0; m < 4; ++m)
#pragma unroll
                for (int n = 0; n < 2; ++n) acc[a][b][m][n] = (f32x4){0.f, 0.f, 0.f, 0.f};
    bf16x8 At[4][2], B0[2][2], B1[2][2];
    const char* cA = (const char*)g.A + (GATHER ? (size_t)0 : (size_t)cur.pm * tstep); const char* cB = (const char*)g.Bt + (size_t)cur.pn * tstep;
    if constexpr (GATHER) { load_gather(cur.pm, gcur); }
    S.a_ready(cur);
    if constexpr (SP2) {
        PG8_STAGE(PG8_SB(0, 0), cB, voffB); PG8_STAGE(PG8_SB(0, 1), cB + hstep, voffB); PG8_STAGE_A(PG8_SA(0, 0), cA, 0, false); PG8_STAGE_A(PG8_SA(0, 1), cA, 1, false);
        if (wr == 1) PG8_BAR;
        PG8_WAIT_V(2); PG8_BAR;
        PG8_STAGE(PG8_SB(1, 0), cB + kstep, voffB); PG8_STAGE_A(PG8_SA(1, 0), cA + kstep, 0, false); PG8_STAGE(PG8_SB(1, 1), cB + hstep + kstep, voffB);
        PG8_WAIT_V(6); PG8_BAR;
    } else {
        PG8_STAGE(PG8_SB(0, 0), cB, voffB); PG8_STAGE_A(PG8_SA(0, 0), cA, 0, false); PG8_STAGE(PG8_SB(0, 1), cB + hstep, voffB); PG8_STAGE_A(PG8_SA(0, 1), cA, 1, false);
        if (wr == 1) PG8_BAR;
        PG8_WAIT_V(4); PG8_BAR;
        PG8_STAGE(PG8_SB(1, 0), cB + kstep, voffB); PG8_STAGE_A(PG8_SA(1, 0), cA + kstep, 0, false); PG8_STAGE(PG8_SB(1, 1), cB + hstep + kstep, voffB);
        PG8_WAIT_V(6); PG8_BAR;
    }
    for (;;) {
        const bool has_next = S.next(ui + 1, nxt);
        const char* nA = (has_next && !GATHER) ? (const char*)g.A + (size_t)nxt.pm * tstep : cA; const char* nB = has_next ? (const char*)g.Bt + (size_t)nxt.pn * tstep : cB;
        if constexpr (GATHER) { if (has_next) load_gather(nxt.pm, gnxt); else {
#pragma unroll
            for (int h = 0; h < 2; ++h) { gnxt[h] = gcur[h]; } } }
        for (int t = 0; t < nt; t += 2) {
            const bool last = (t == nt - 2);
            const char* a1 = cA + (size_t)(t + 1) * kstep;
            const char* a2 = last ? nA : cA + (size_t)(t + 2) * kstep; const char* b2 = last ? nB : cB + (size_t)(t + 2) * kstep;
            const char* a3 = a2 + kstep; const char* b3 = b2 + kstep;
            if (last && has_next) S.a_ready(nxt);
            if constexpr (SP2) {
            PG8_LDB(B0, 0, 0); PG8_LDB(B1, 0, 1); PG8_SCHED; PG8_LDA(At, 0, 0); PG8_STAGE_A(PG8_SA(1, 1), a1, 1, false);
            PG8_WAIT_V(8); PG8_WAIT_L(0); PG8_BAR; PG8_MMA(0, 0, At, B0); PG8_MMA(0, 1, At, B1); PG8_BAR; PG8_SCHED;
            PG8_LDA(At, 0, 1); PG8_STAGE(PG8_SB(0, 0), b2, voffB); PG8_STAGE(PG8_SB(0, 1), b2 + hstep, voffB); PG8_STAGE_A(PG8_SA(0, 0), a2, 0, last);
            PG8_WAIT_V(8); PG8_WAIT_L(0); PG8_BAR; PG8_MMA(1, 0, At, B0); PG8_MMA(1, 1, At, B1); PG8_BAR; PG8_SCHED;
            PG8_LDB(B0, 1, 0); PG8_LDB(B1, 1, 1); PG8_SCHED; PG8_LDA(At, 1, 0); PG8_STAGE_A(PG8_SA(0, 1), a2, 1, last);
            PG8_WAIT_V(8); PG8_WAIT_L(0); PG8_BAR; PG8_MMA(0, 0, At, B0); PG8_MMA(0, 1, At, B1); PG8_BAR; PG8_SCHED;
            PG8_LDA(At, 1, 1); PG8_STAGE(PG8_SB(1, 0), b3, voffB); PG8_STAGE(PG8_SB(1, 1), b3 + hstep, voffB); PG8_STAGE_A(PG8_SA(1, 0), a3, 0, last);
            PG8_WAIT_V(8); PG8_WAIT_L(0); PG8_BAR; PG8_MMA(1, 0, At, B0); PG8_MMA(1, 1, At, B1); PG8_BAR; PG8_SCHED;
            } else {
            PG8_LDB(B0, 0, 0); PG8_SCHED; PG8_LDA(At, 0, 0); PG8_STAGE_A(PG8_SA(1, 1), a1, 1, false);
            PG8_WAIT_L(8); PG8_BAR; PG8_WAIT_L(0); PG8_MMA(0, 0, At, B0); PG8_BAR; PG8_SCHED;
            PG8_LDB(B1, 0, 1); PG8_STAGE(PG8_SB(0, 0), b2, voffB);
            PG8_BAR; PG8_WAIT_L(0); PG8_MMA(0, 1, At, B1); PG8_BAR;
            PG8_LDA(At, 0, 1); PG8_STAGE_A(PG8_SA(0, 0), a2, 0, last);
            PG8_BAR; PG8_WAIT_L(0); PG8_MMA(1, 0, At, B0); PG8_BAR; PG8_SCHED;
            PG8_STAGE(PG8_SB(0, 1), b2 + hstep, voffB);
            PG8_WAIT_V(6); PG8_BAR; PG8_MMA(1, 1, At, B1); PG8_BAR;
            PG8_LDB(B0, 1, 0); PG8_SCHED; PG8_LDA(At, 1, 0); PG8_STAGE_A(PG8_SA(0, 1), a2, 1, last);
            PG8_WAIT_L(8); PG8_BAR; PG8_WAIT_L(0); PG8_MMA(0, 0, At, B0); PG8_BAR; PG8_SCHED;
            PG8_LDB(B1, 1, 1); PG8_STAGE(PG8_SB(1, 0), b3, voffB);
            PG8_BAR; PG8_WAIT_L(0); PG8_MMA(0, 1, At, B1); PG8_BAR;
            PG8_LDA(At, 1, 1); PG8_STAGE_A(PG8_SA(1, 0), a3, 0, last);
            PG8_BAR; PG8_WAIT_L(0); PG8_MMA(1, 0, At, B0); PG8_BAR; PG8_SCHED;
            PG8_STAGE(PG8_SB(1, 1), b3 + hstep, voffB);
            PG8_WAIT_V(6); PG8_BAR; PG8_MMA(1, 1, At, B1); PG8_BAR;
            }
        }
        if constexpr (ALIGN_EPI) { if (wr == 0) PG8_BAR; }
        if constexpr (!Epi::AFTER_DRAIN) { E(acc, cur, wr, wc, fr, fq); S.done(cur); }
        if (!has_next) break;
#pragma unroll
        for (int a = 0; a < 2; ++a)
#pragma unroll
            for (int b = 0; b < 2; ++b)
#pragma unroll
                for (int m = 0; m < 4; ++m)
#pragma unroll
                    for (int n = 0; n < 2; ++n) acc[a][b][m][n] = (f32x4){0.f, 0.f, 0.f, 0.f};
        cur = nxt; cA = nA; cB = nB; ++ui;
        if constexpr (GATHER) {
#pragma unroll
            for (int h = 0; h < 2; ++h) { gcur[h] = gnxt[h]; } }
        if constexpr (ALIGN_EPI) { if (wr == 1) PG8_BAR; }
    }
    PG8_WAIT_V(0);
    if constexpr (!ALIGN_EPI) { if (wr == 0) PG8_BAR; }
    PG8_BAR;
    if constexpr (Epi::AFTER_DRAIN) { E.fused(acc, cur, wr, wc, fr, fq, lds, wid, lane); S.done(cur); }
#undef PG8_SA
#undef PG8_SB
#undef PG8_STAGE
#undef PG8_STAGE_A
#undef PG8_LDA
#undef PG8_LDB
#undef PG8_MMA
#undef PG8_WAIT_V
#undef PG8_WAIT_L
#undef PG8_BAR
#undef PG8_SCHED
}
}

typedef unsigned short bf16_t;
__device__ __forceinline__ unsigned f2bf(float f) { unsigned u = __builtin_bit_cast(unsigned, f); return (u + 0x7fffu + ((u >> 16) & 1u)) >> 16; }
__device__ __forceinline__ float bf2f(unsigned h) { return __builtin_bit_cast(float, h << 16); }
__device__ __forceinline__ float wave_sum(float v) {
#pragma unroll
    for (int o = 1; o < 64; o <<= 1) v += __shfl_xor(v, o);
    return v;
}
__device__ __forceinline__ float sigmoidf_(float x) { return 1.0f / (1.0f + expf(-x)); }
__device__ __forceinline__ float siluf_(float x) { return x / (1.0f + expf(-x)); }
__device__ __forceinline__ float softplusf_(float x) { return fmaxf(x, 0.0f) + log1pf(expf(-fabsf(x))); }
__device__ __forceinline__ float geluf_(float x) { const float u = 0.7978845608028654f * (x + 0.044715f * x * x * x); return 0.5f * x * (1.0f + tanhf(u)); }

struct Args { const float* in[39]; float* out; unsigned char* ws; int lo, hi; };

struct Ctx {
    const float* const* in; float* out; unsigned char* ws;
    LAS unsigned char* lds; float* sm;
    int tid, lane, wid, bid, G, dry;
};

__device__ __forceinline__ unsigned pk2(float lo, float hi) { return f2bf(lo) | (f2bf(hi) << 16); }
__device__ __forceinline__ float ldbf(const bf16_t* p) { return bf2f((unsigned)*p); }
typedef unsigned v4u_t __attribute__((ext_vector_type(4)));
typedef unsigned v2u_t __attribute__((ext_vector_type(2)));
__device__ __forceinline__ void st16(void* p, uint4 v) { const v4u_t d = {v.x, v.y, v.z, v.w}; asm volatile("global_store_dwordx4 %0, %1, off\n\ts_nop 1" :: "v"(p), "v"(d) : "memory"); }
__device__ __forceinline__ void st16f(void* p, float4 v) { st16(p, make_uint4(__float_as_uint(v.x), __float_as_uint(v.y), __float_as_uint(v.z), __float_as_uint(v.w))); }
__device__ __forceinline__ void st8(void* p, uint2 v) { const v2u_t d = {v.x, v.y}; asm volatile("global_store_dwordx2 %0, %1, off\n\ts_nop 1" :: "v"(p), "v"(d) : "memory"); }
__device__ __forceinline__ void st4(void* p, unsigned v) { asm volatile("global_store_dword %0, %1, off\n\ts_nop 1" :: "v"(p), "v"(v) : "memory"); }
__device__ __forceinline__ void st2(void* p, unsigned v) { asm volatile("global_store_short %0, %1, off\n\ts_nop 1" :: "v"(p), "v"(v) : "memory"); }
__device__ __forceinline__ float4 ldbf4(const bf16_t* p) { const uint2 v = *(const uint2*)p; return make_float4(bf2f(v.x & 0xffffu), bf2f(v.x >> 16), bf2f(v.y & 0xffffu), bf2f(v.y >> 16)); }

template <int NB, class AF, class BF, class BF2, class EF>
__device__ __forceinline__ void gemm_tile(float* sm, int K, AF af, BF bf, BF2 bf2, EF ef) {
    float* As = sm;
    float* Bs = sm + 16 * 132;
    float* Bs2 = Bs + 16 * 68;
    const int tid = threadIdx.x, ty = tid >> 4, tx = tid & 15;
    const int am = tid >> 2, ak = (tid & 3) * 4;
    const int bt = tid & 255, bk = bt >> 4, bn = (bt & 15) * 4;
    float acc[4][4], acc2[4][4];
#pragma unroll
    for (int i = 0; i < 4; ++i)
#pragma unroll
        for (int j = 0; j < 4; ++j) { acc[i][j] = 0.f; acc2[i][j] = 0.f; }
    float4 av = af(am, ak);
    float4 bv = make_float4(0.f, 0.f, 0.f, 0.f);
    if (tid < 256) bv = bf(bk, bn); else if (NB == 2) bv = bf2(bk, bn);
    for (int k0 = 0; k0 < K; k0 += 16) {
        __syncthreads();
        As[(ak + 0) * 132 + am] = av.x; As[(ak + 1) * 132 + am] = av.y; As[(ak + 2) * 132 + am] = av.z; As[(ak + 3) * 132 + am] = av.w;
        if (tid < 256) *(float4*)&Bs[bk * 68 + bn] = bv; else if (NB == 2) *(float4*)&Bs2[bk * 68 + bn] = bv;
        __syncthreads();
        if (k0 + 16 < K) {
            av = af(am, k0 + 16 + ak);
            if (tid < 256) bv = bf(k0 + 16 + bk, bn); else if (NB == 2) bv = bf2(k0 + 16 + bk, bn);
        }
#pragma unroll
        for (int kk = 0; kk < 16; ++kk) {
            const float4 a = *(const float4*)&As[kk * 132 + ty * 4];
            const float4 b = *(const float4*)&Bs[kk * 68 + tx * 4];
            const float aa[4] = {a.x, a.y, a.z, a.w};
            const float bb[4] = {b.x, b.y, b.z, b.w};
#pragma unroll
            for (int i = 0; i < 4; ++i)
#pragma unroll
                for (int j = 0; j < 4; ++j) acc[i][j] = fmaf(aa[i], bb[j], acc[i][j]);
            if (NB == 2) {
                const float4 b2 = *(const float4*)&Bs2[kk * 68 + tx * 4];
                const float bb2[4] = {b2.x, b2.y, b2.z, b2.w};
#pragma unroll
                for (int i = 0; i < 4; ++i)
#pragma unroll
                    for (int j = 0; j < 4; ++j) acc2[i][j] = fmaf(aa[i], bb2[j], acc2[i][j]);
            }
        }
    }
#pragma unroll
    for (int i = 0; i < 4; ++i)
        ef(ty * 4 + i, tx * 4, make_float4(acc[i][0], acc[i][1], acc[i][2], acc[i][3]), make_float4(acc2[i][0], acc2[i][1], acc2[i][2], acc2[i][3]));
}

__device__ __forceinline__ void transpose_load(const float* W, int N, int nblk, int item, int lane, float (&r)[32]) {
    const int kb = item / nblk, nb = item % nblk, k0 = 64 * kb, n0 = 32 * nb;
#pragma unroll
    for (int i = 0; i < 8; ++i) { const int kk = 8 * i + (lane >> 3); const float4 v = *(const float4*)(W + (size_t)(k0 + kk) * N + n0 + (lane & 7) * 4);
        r[4 * i] = v.x; r[4 * i + 1] = v.y; r[4 * i + 2] = v.z; r[4 * i + 3] = v.w; }
}
template <bool RES, class RM>
__device__ __forceinline__ void transpose_finish(int K, int nblk, bf16_t* WT, RM rowmap, float* scr, int item, int lane, const float (&r)[32]) {
    const int kb = item / nblk, nb = item % nblk, k0 = 64 * kb, n0 = 32 * nb;
#pragma unroll
    for (int i = 0; i < 8; ++i) { const int kk = 8 * i + (lane >> 3), nn = (lane & 7) * 4;
        scr[kk * 33 + nn] = r[4 * i]; scr[kk * 33 + nn + 1] = r[4 * i + 1]; scr[kk * 33 + nn + 2] = r[4 * i + 2]; scr[kk * 33 + nn + 3] = r[4 * i + 3]; }
    asm volatile("s_waitcnt lgkmcnt(0)" ::: "memory");
    const int c = lane & 7;
    const int r0 = rowmap(n0);
#pragma unroll
    for (int j = 0; j < 4; ++j) {
        const int n = (lane >> 3) + 8 * j; const float* s = scr + (8 * c) * 33 + n;
        float v[8];
#pragma unroll
        for (int q = 0; q < 8; ++q) { v[q] = s[q * 33]; if (RES) v[q] = v[q] - bf2f(f2bf(v[q])); }
        uint4 o; o.x = pk2(v[0], v[1]); o.y = pk2(v[2], v[3]); o.z = pk2(v[4], v[5]); o.w = pk2(v[6], v[7]);
        st16(WT + (size_t)(r0 + n) * K + k0 + 8 * c, o);
    }
    asm volatile("s_waitcnt lgkmcnt(0)" ::: "memory");
}
template <bool RES, class RM>
__device__ __forceinline__ void transpose_item(const float* W, int K, int N, bf16_t* WT, RM rowmap, float* scr, int item, int lane) {
    float r[32];
    transpose_load(W, N, N / 32, item, lane, r);
    transpose_finish<RES>(K, N / 32, WT, rowmap, scr, item, lane, r);
}

__device__ __forceinline__ void convert_expert_weights(const Ctx& c, const int lo, const int hi, int first, int stride) {
    float* scr = c.sm + c.wid * (64 * 33);
    float ra[32], rb[32];
    auto src = [&](int it, const float*& W, int& N, int& nblk, int& item) {
        const int e = it / 384, r = it % 384;
        if (r < 128) { W = c.in[33] + (size_t)e * D * EFF; N = EFF; nblk = EFF / 32; item = r; }
        else if (r < 256) { W = c.in[34] + (size_t)e * D * EFF; N = EFF; nblk = EFF / 32; item = r - 128; }
        else { W = c.in[35] + (size_t)e * EFF * D; N = D; nblk = D / 32; item = r - 256; }
    };
    auto fin = [&](int it, const float (&rg)[32]) {
        const int e = it / 384, r = it % 384;
        if (r < 128) transpose_finish<false>(D, EFF / 32, (bf16_t*)(c.ws + WS_WEGU) + (size_t)e * 512 * D, [](int n) { return (n >> 7) * 256 + (n & 127); }, scr, r, c.lane, rg);
        else if (r < 256) transpose_finish<false>(D, EFF / 32, (bf16_t*)(c.ws + WS_WEGU) + (size_t)e * 512 * D, [](int n) { return (n >> 7) * 256 + 128 + (n & 127); }, scr, r - 128, c.lane, rg);
        else transpose_finish<false>(EFF, D / 32, (bf16_t*)(c.ws + WS_WED) + (size_t)e * D * EFF, [](int n) { return n; }, scr, r - 256, c.lane, rg);
    };
    float rc[32];
    auto ld = [&](int it_, float (&rg)[32]) { if (it_ < hi) { const float* W; int N, nblk, item; src(it_, W, N, nblk, item); transpose_load(W, N, nblk, item, c.lane, rg); } };
    int it = lo + first;
    if (it >= hi) return;
    ld(it, ra); ld(it + stride, rb);
    for (;;) {
        ld(it + 2 * stride, rc); fin(it, ra); if (it + stride >= hi) break;
        ld(it + 3 * stride, ra); fin(it + stride, rb); if (it + 2 * stride >= hi) break;
        ld(it + 4 * stride, rb); fin(it + 2 * stride, rc); if (it + 3 * stride >= hi) break;
        it += 3 * stride;
    }
}

__device__ __forceinline__ void phase0(const Ctx& c) {
    const int gt = c.bid * 512 + c.tid, NT = c.G * 512;
    const int gw = c.bid * 8 + c.wid, NW = c.G * 8;
    {
        const float* cc = c.in[1]; const float* w_ada = c.in[2];
        float* modsp = (float*)(c.ws + WS_MODSP);
        for (int task = gw; task < 96 * 16; task += NW) {
            const int cg = task % 96, ks = task / 96, j = cg * 64 + c.lane;
            float a0 = 0.f, a1 = 0.f, a2 = 0.f, a3 = 0.f;
#pragma unroll 4
            for (int k = ks * 64; k < ks * 64 + 64; ++k) {
                const float wv = w_ada[(size_t)k * NMODS + j];
                a0 = fmaf(siluf_(cc[k]), wv, a0); a1 = fmaf(siluf_(cc[D + k]), wv, a1); a2 = fmaf(siluf_(cc[2 * D + k]), wv, a2); a3 = fmaf(siluf_(cc[3 * D + k]), wv, a3);
            }
            modsp[(ks * 4 + 0) * NMODS + j] = a0; modsp[(ks * 4 + 1) * NMODS + j] = a1; modsp[(ks * 4 + 2) * NMODS + j] = a2; modsp[(ks * 4 + 3) * NMODS + j] = a3;
        }
    }
    {
        const float* log_dt = c.in[20]; const float* a_re = c.in[21]; const float* a_im = c.in[22];
        const float* b_re = c.in[23]; const float* b_im = c.in[24];
        float* apow = (float*)(c.ws + WS_APOW); float* bb = (float*)(c.ws + WS_S5BB);
        for (int idx = ((c.tid & 63) == 0) ? c.bid * 8 + (c.tid >> 6) : S5NG * S5P; idx < S5NG * S5P; idx += c.G * 8) {
            const int g = idx / S5P, p = idx % S5P;
            const double dt = exp((double)log_dt[g]);
            const double lre = fmin((double)a_re[idx], -1e-4), lim = (double)a_im[idx];
            const double mag = exp(lre * dt), ang = lim * dt;
            const double abr = mag * cos(ang), abi = mag * sin(ang);
            const double den = lre * lre + lim * lim;
            const double nre = abr - 1.0, nim = abi;
            const double qre = (nre * lre + nim * lim) / den, qim = (nim * lre - nre * lim) / den;
            double pr = 1.0, pi = 0.0;
            for (int j = 0; j <= S5L; ++j) {
                apow[((size_t)(g * (S5L + 1) + j) * 64 + p) * 2 + 0] = (float)pr; apow[((size_t)(g * (S5L + 1) + j) * 64 + p) * 2 + 1] = (float)pi;
                const double nr = pr * abr - pi * abi, ni = pr * abi + pi * abr; pr = nr; pi = ni;
            }
            for (int ch = 0; ch < 16; ++ch) {
                const double br = (double)b_re[idx * 16 + ch], bi = (double)b_im[idx * 16 + ch];
                bb[idx * 32 + ch] = (float)(qre * br - qim * bi);
                bb[idx * 32 + 16 + ch] = (float)(qre * bi + qim * br);
            }
        }
    }
    {
        const float* w2 = c.in[11]; const float* a2 = c.in[13]; const float* g2 = c.in[14];
        bf16_t* bt = (bf16_t*)(c.ws + WS_LORA_BT);
        for (int it = gt; it < 1536 * 32; it += NT) {
            const int n = it >> 5, c0 = (it & 31) * 8;
            float v[8];
#pragma unroll
            for (int i = 0; i < 8; ++i) {
                const int col = c0 + i; float x = 0.f;
                if (n < 512) { if (col < 64) x = w2[col * RW + n]; }
                else if (n < 1024) { if (col >= 64 && col < 128) x = a2[(col - 64) * RW + (n - 512)]; }
                else { if (col >= 128) x = g2[(col - 128) * RW + (n - 1024)]; }
                v[i] = x;
            }
            *(uint4*)(bt + (size_t)n * 256 + c0) = make_uint4(pk2(v[0], v[1]), pk2(v[2], v[3]), pk2(v[4], v[5]), pk2(v[6], v[7]));
        }
    }
    float* scr = c.sm + c.wid * (64 * 33);
    constexpr int I_IN = (D / 64) * (NPROJ / 32), I_OUT = (D / 64) * (D / 32), I_GLU = (512 / 64) * (512 / 32), I_SG = (D / 64) * (256 / 32), I_SD = (256 / 64) * (D / 32), I_R = (D / 64) * (256 / 32);
    constexpr int NIT = I_IN + I_OUT + I_GLU + 2 * I_SG + I_SD + 2 * I_R;
    for (int it = gw; it < NIT; it += NW) {
        int r = it;
        if (r < I_IN) { transpose_item<false>(c.in[8], D, NPROJ, (bf16_t*)(c.ws + WS_WIN_T), [](int n) { return n; }, scr, r, c.lane); continue; } r -= I_IN;
        if (r < I_OUT) { transpose_item<false>(c.in[30], D, D, (bf16_t*)(c.ws + WS_WOUT_T), [](int n) { return n; }, scr, r, c.lane); continue; } r -= I_OUT;
        if (r < I_GLU) { transpose_item<false>(c.in[28], 512, 512, (bf16_t*)(c.ws + WS_WGLU_T), [](int n) { return n; }, scr, r, c.lane); continue; } r -= I_GLU;
        if (r < I_SG) { transpose_item<false>(c.in[36], D, 256, (bf16_t*)(c.ws + WS_WSGU_T), [](int n) { return (n >> 7) * 256 + (n & 127); }, scr, r, c.lane); continue; } r -= I_SG;
        if (r < I_SG) { transpose_item<false>(c.in[37], D, 256, (bf16_t*)(c.ws + WS_WSGU_T), [](int n) { return (n >> 7) * 256 + 128 + (n & 127); }, scr, r, c.lane); continue; } r -= I_SG;
        if (r < I_SD) { transpose_item<false>(c.in[38], 256, D, (bf16_t*)(c.ws + WS_WSD_T), [](int n) { return n; }, scr, r, c.lane); continue; } r -= I_SD;
        if (r < I_R) { transpose_item<false>(c.in[31], D, 256, (bf16_t*)(c.ws + WS_WR_T), [](int n) { return n; }, scr, r, c.lane); continue; } r -= I_R;
        transpose_item<true>(c.in[31], D, 256, (bf16_t*)(c.ws + WS_WR_T), [](int n) { return 256 + n; }, scr, r, c.lane);
    }
}

__device__ __forceinline__ void phase1(const Ctx& c) {
    const int gt = c.bid * 512 + c.tid, NT = c.G * 512;
    const int gw = c.bid * 8 + c.wid, NW = c.G * 8;
    const float* modsp = (const float*)(c.ws + WS_MODSP); const float* b_ada = c.in[3]; float* mods = (float*)(c.ws + WS_MODS);
    for (int idx = gt; idx < BATCH * NMODS; idx += NT) {
        const int b = idx / NMODS, j = idx % NMODS;
        float acc = 0.f;
#pragma unroll
        for (int ks = 0; ks < 16; ++ks) acc += modsp[(ks * 4 + b) * NMODS + j];
        mods[idx] = acc + b_ada[j];
    }
    const float* __restrict__ apow = (const float*)(c.ws + WS_APOW); const float* __restrict__ bb = (const float*)(c.ws + WS_S5BB);
    const float* __restrict__ c_re = c.in[25]; const float* __restrict__ c_im = c.in[26];
    float* __restrict__ klag = (float*)(c.ws + WS_KLAG);
    for (int task = gw; task < S5NG * S5L; task += NW) {
        const int g = task / S5L, j = task % S5L, cc = c.lane >> 2, cq = (c.lane & 3) * 4;
        float acc[4] = {0.f, 0.f, 0.f, 0.f};
#pragma unroll 16
        for (int p = 0; p < 64; ++p) {
            const float ar = apow[((size_t)(g * (S5L + 1) + j) * 64 + p) * 2], ai = apow[((size_t)(g * (S5L + 1) + j) * 64 + p) * 2 + 1];
            const float cr = c_re[(g * 16 + cc) * 64 + p], ci = c_im[(g * 16 + cc) * 64 + p];
            const float4 br = *(const float4*)(bb + (size_t)(g * 64 + p) * 32 + cq), bi = *(const float4*)(bb + (size_t)(g * 64 + p) * 32 + 16 + cq);
            const float er = cr * ar - ci * ai, ei = cr * ai + ci * ar;
            acc[0] += er * br.x - ei * bi.x; acc[1] += er * br.y - ei * bi.y; acc[2] += er * br.z - ei * bi.z; acc[3] += er * br.w - ei * bi.w;
        }
        *(float4*)(klag + ((size_t)(g * S5L + j) * 16 + cc) * 16 + cq) = make_float4(acc[0], acc[1], acc[2], acc[3]);
    }
}

__device__ __forceinline__ void phase2(const Ctx& c) {
    const float* x = c.in[0]; const float* g = c.in[4];
    const float* mods = (const float*)(c.ws + WS_MODS);
    bf16_t* xn = (bf16_t*)(c.ws + WS_A);
    const int gw = c.bid * 8 + c.wid, NW = c.G * 8;
    for (int t = gw; t < T; t += NW) {
        const int b = t / SEQ;
        const float4* xr = (const float4*)(x + (size_t)t * D) + c.lane;
        float4 v[4]; float ss = 0.f;
#pragma unroll
        for (int j = 0; j < 4; ++j) { v[j] = xr[64 * j]; ss += v[j].x * v[j].x + v[j].y * v[j].y + v[j].z * v[j].z + v[j].w * v[j].w; }
        const float rstd = rsqrtf(wave_sum(ss) * (1.0f / D) + 1e-6f);
        uint2* o = (uint2*)(xn + (size_t)t * D) + c.lane;
#pragma unroll
        for (int j = 0; j < 4; ++j) {
            const int k = (c.lane + 64 * j) * 4;
            const float4 gg = *(const float4*)(g + k);
            const float4 sh = *(const float4*)(mods + b * NMODS + k);
            const float4 sc = *(const float4*)(mods + b * NMODS + D + k);
            float4 r;
            r.x = v[j].x * rstd * gg.x * (1.f + sc.x) + sh.x; r.y = v[j].y * rstd * gg.y * (1.f + sc.y) + sh.y;
            r.z = v[j].z * rstd * gg.z * (1.f + sc.z) + sh.z; r.w = v[j].w * rstd * gg.w * (1.f + sc.w) + sh.w;
            o[64 * j] = make_uint2(pk2(r.x, r.y), pk2(r.z, r.w));
        }
    }
}

__device__ __forceinline__ void s5_assemble(const Ctx& c) {
    const bool half = (c.G == 256);
    if (half && c.bid < 128) return;
    const int gt = (half ? c.bid - 128 : c.bid) * 512 + c.tid, NT = (half ? 128 : c.G) * 512;
    const float* apow = (const float*)(c.ws + WS_APOW); const float* bb = (const float*)(c.ws + WS_S5BB); const float* klag = (const float*)(c.ws + WS_KLAG);
    const float* c_re = c.in[25]; const float* c_im = c.in[26]; const float* dd = c.in[27];
    bf16_t* kmat = (bf16_t*)(c.ws + WS_KMAT); bf16_t* hmat = (bf16_t*)(c.ws + WS_HMAT);
    for (int it = gt; it < S5NG * 512 * 80; it += NT) {
        const int row = it / 80, ch = it % 80, g = row >> 9, t = (row >> 4) & 31, cc = row & 15, col0 = ch * 8;
        float v[8];
        if (col0 < 512) {
            const int s = col0 >> 4, c0 = col0 & 15;
            if (s > t) {
#pragma unroll
                for (int i = 0; i < 8; ++i) v[i] = 0.f;
            } else {
                const float4 k0 = *(const float4*)(klag + ((size_t)(g * S5L + (t - s)) * 16 + cc) * 16 + c0), k1 = *(const float4*)(klag + ((size_t)(g * S5L + (t - s)) * 16 + cc) * 16 + c0 + 4);
                v[0] = k0.x; v[1] = k0.y; v[2] = k0.z; v[3] = k0.w; v[4] = k1.x; v[5] = k1.y; v[6] = k1.z; v[7] = k1.w;
                if (s == t) {
                    const float dv = dd[g * 16 + cc];
#pragma unroll
                    for (int i = 0; i < 8; ++i) if (c0 + i == cc) v[i] += dv;
                }
            }
        } else {
            const int q0 = col0 - 512;
#pragma unroll
            for (int i = 0; i < 8; ++i) {
                const int q = q0 + i, p = q & 63;
                const float ar = apow[((size_t)(g * (S5L + 1) + t + 1) * 64 + p) * 2], ai = apow[((size_t)(g * (S5L + 1) + t + 1) * 64 + p) * 2 + 1];
                const float cr = c_re[(g * 16 + cc) * 64 + p], ci = c_im[(g * 16 + cc) * 64 + p];
                v[i] = (q < 64) ? (cr * ar - ci * ai) : -(cr * ai + ci * ar);
            }
        }
        *(uint4*)(kmat + (size_t)row * 640 + col0) = make_uint4(pk2(v[0], v[1]), pk2(v[2], v[3]), pk2(v[4], v[5]), pk2(v[6], v[7]));
    }
    for (int it = gt; it < S5NG * 256 * 80; it += NT) {
        const int row = it / 80, ch = it % 80, g = row >> 8, q = row & 255, col0 = ch * 8;
        float v[8];
#pragma unroll
        for (int i = 0; i < 8; ++i) v[i] = 0.f;
        if (q < 128 && col0 < 512) {
            const int s = col0 >> 4, c0 = col0 & 15, p = q & 63;
            const float ar = apow[((size_t)(g * (S5L + 1) + (S5L - 1 - s)) * 64 + p) * 2], ai = apow[((size_t)(g * (S5L + 1) + (S5L - 1 - s)) * 64 + p) * 2 + 1];
#pragma unroll
            for (int i = 0; i < 8; ++i) {
                const float br = bb[(size_t)(g * 64 + p) * 32 + c0 + i], bi = bb[(size_t)(g * 64 + p) * 32 + 16 + c0 + i];
                v[i] = (q < 64) ? (ar * br - ai * bi) : (ar * bi + ai * br);
            }
        }
        *(uint4*)(hmat + (size_t)row * 640 + col0) = make_uint4(pk2(v[0], v[1]), pk2(v[2], v[3]), pk2(v[4], v[5]), pk2(v[6], v[7]));
    }
}

__device__ __forceinline__ void phase3(const Ctx& c) {
    pg8::Gemm g{(const bf16_t*)(c.ws + WS_A), (const bf16_t*)(c.ws + WS_WIN_T), T, NPROJ, D};
    pg8::StaticOrder S; S.init(T, NPROJ, c.G, c.bid);
    pg8::EpiBf16<0> E{(bf16_t*)(c.ws + WS_PROJ), NPROJ, nullptr, 0, 0, 1.f};
    pg8::gemm_phase<pg8::EpiBf16<0>, pg8::StaticOrder, true, true>(c.lds, g, S, E);
    s5_assemble(c);
}

__device__ __forceinline__ void unpack8(const uint4 a, float (&u)[8]) {
    u[0] = bf2f(a.x & 0xffffu); u[1] = bf2f(a.x >> 16); u[2] = bf2f(a.y & 0xffffu); u[3] = bf2f(a.y >> 16);
    u[4] = bf2f(a.z & 0xffffu); u[5] = bf2f(a.z >> 16); u[6] = bf2f(a.w & 0xffffu); u[7] = bf2f(a.w >> 16);
}
__device__ __forceinline__ uint4 pack8(const float (&v)[8]) { return make_uint4(pk2(v[0], v[1]), pk2(v[2], v[3]), pk2(v[4], v[5]), pk2(v[6], v[7])); }
#define DPPU(v, ctrl) ((unsigned)__builtin_amdgcn_mov_dpp((int)(v), (ctrl), 0xf, 0xf, true))
#define DPPF(v, ctrl) __builtin_bit_cast(float, __builtin_amdgcn_mov_dpp(__builtin_bit_cast(int, (v)), (ctrl), 0xf, 0xf, true))
__device__ __forceinline__ float fast_tanh(float x) { return 1.0f - 2.0f * __builtin_amdgcn_rcpf(1.0f + __builtin_amdgcn_exp2f(2.8853900817779268f * x)); }
__device__ __forceinline__ void phase4(const Ctx& c) {
    const bf16_t* proj = (const bf16_t*)(c.ws + WS_PROJ);
    const float* mu = c.in[9]; const float* k_k = c.in[15];
    bf16_t* rw_r = (bf16_t*)(c.ws + WS_RW_R); bf16_t* rw_k = (bf16_t*)(c.ws + WS_RW_K); bf16_t* rw_v = (bf16_t*)(c.ws + WS_RW_V); bf16_t* rw_a = (bf16_t*)(c.ws + WS_RW_A);
    bf16_t* alora = (bf16_t*)((unsigned char*)c.out + OUT_ALORA); bf16_t* ux = (bf16_t*)((unsigned char*)c.out + OUT_UX);
    const int gw = c.bid * 8 + c.wid, NW = c.G * 8, lane = c.lane;
    float mm[4][8], kk8[8];
#pragma unroll
    for (int j = 0; j < 4; ++j) {
        const int cidx = lane + 64 * j, col = (cidx < 224 ? cidx : 0) * 8;
        const float4 m0 = *(const float4*)(mu + col), m1 = *(const float4*)(mu + col + 4);
        mm[j][0] = m0.x; mm[j][1] = m0.y; mm[j][2] = m0.z; mm[j][3] = m0.w; mm[j][4] = m1.x; mm[j][5] = m1.y; mm[j][6] = m1.z; mm[j][7] = m1.w;
    }
    { const float4 k0 = *(const float4*)(k_k + lane * 8), k1 = *(const float4*)(k_k + lane * 8 + 4); kk8[0] = k0.x; kk8[1] = k0.y; kk8[2] = k0.z; kk8[3] = k0.w; kk8[4] = k1.x; kk8[5] = k1.y; kk8[6] = k1.z; kk8[7] = k1.w; }
    constexpr int RUN = 16;
    auto load_row = [&](int t, uint4 (&r)[5]) {
        const bf16_t* pr = proj + (size_t)t * NPROJ;
#pragma unroll
        for (int j = 0; j < 3; ++j) r[j] = *(const uint4*)(pr + (lane + 64 * j) * 8);
        r[3] = (lane < 32) ? *(const uint4*)(pr + (lane + 192) * 8) : make_uint4(0u, 0u, 0u, 0u);
        r[4] = *(const uint4*)(pr + RPROJ + lane * 8);
    };
    for (int t0 = gw * RUN; t0 < T; t0 += NW * RUN) {
        uint4 prev[5], cur[5], nxt[5];
        if (t0 % SEQ == 0) {
#pragma unroll
            for (int j = 0; j < 5; ++j) prev[j] = make_uint4(0u, 0u, 0u, 0u);
        } else load_row(t0 - 1, prev);
        load_row(t0, cur);
#pragma unroll 2
        for (int i = 0; i < RUN; ++i) {
            const int t = t0 + i;
            if (i + 1 < RUN) load_row(t + 1, nxt);
#pragma unroll
            for (int j = 0; j < 4; ++j) {
                const int cidx = lane + 64 * j;
                if (cidx < 224) {
                    const int col = cidx * 8;
                    float p[8], q[8], ps[8];
                    unpack8(cur[j], p); unpack8(prev[j], q);
#pragma unroll
                    for (int i2 = 0; i2 < 8; ++i2) ps[i2] = p[i2] + (q[i2] - p[i2]) * mm[j][i2];
                    if (j == 0) *(uint4*)(rw_r + (size_t)t * RW + col) = pack8(ps);
                    else if (j == 1) {
                        const int cl = col - 512;
                        *(uint4*)(rw_k + (size_t)t * RW + cl) = pack8(ps);
                        float kk[8]; float ss = 0.f;
#pragma unroll
                        for (int i2 = 0; i2 < 8; ++i2) { kk[i2] = ps[i2] * kk8[i2]; ss += kk[i2] * kk[i2]; }
                        ss += DPPF(ss, 0xB1); ss += DPPF(ss, 0x4E); ss += DPPF(ss, 0x141);
                        const float inv = -1.0f / fmaxf(sqrtf(ss), 1e-12f);
#pragma unroll
                        for (int i2 = 0; i2 < 8; ++i2) kk[i2] *= inv;
                        *(uint4*)(rw_a + (size_t)t * RW + cl) = pack8(kk);
                    } else if (j == 2) *(uint4*)(rw_v + (size_t)t * RW + (col - 1024)) = pack8(ps);
                    else {
                        const int cl = col - 1536;
                        float o[8];
#pragma unroll
                        for (int i2 = 0; i2 < 8; ++i2) o[i2] = (cl < 64) ? fast_tanh(ps[i2]) : (cl < 128) ? ps[i2] : pg8::fast_sigmoid(ps[i2]);
                        *(uint4*)(alora + (size_t)t * 256 + cl) = pack8(o);
                    }
                }
            }
            {
                const int g = lane >> 1, hf = lane & 1, b = t / SEQ, sidx = t % S5L, chunk = (t % SEQ) / S5L;
                bf16_t* row = ux + ((size_t)(g * 1024 + b * 256 + chunk)) * 640;
                *(uint4*)(row + sidx * 16 + hf * 8) = cur[4];
                if (sidx < 8) { *(uint4*)(row + 512 + (sidx * 2 + hf) * 8) = make_uint4(0u, 0u, 0u, 0u); }
            }
#pragma unroll
            for (int j = 0; j < 5; ++j) { prev[j] = cur[j]; cur[j] = nxt[j]; }
        }
    }
}

__device__ __forceinline__ void phase5(const Ctx& c) {
    {
        pg8::Gemm g{(const bf16_t*)((unsigned char*)c.out + OUT_ALORA), (const bf16_t*)(c.ws + WS_LORA_BT), T, 1536, 256};
        pg8::StaticOrder S; S.init(T, 1536, c.G, c.bid);
        pg8::EpiLora E{c.in[10], c.in[12], c.in[16], (float*)(c.ws + WS_RW_W), (const bf16_t*)(c.ws + WS_RW_K), (bf16_t*)((unsigned char*)c.out + OUT_KF), (const bf16_t*)(c.ws + WS_RW_A), (bf16_t*)(c.ws + WS_RW_B), (bf16_t*)(c.ws + WS_RW_G)};
        pg8::gemm_phase<pg8::EpiLora, pg8::StaticOrder, true, true>(c.lds, g, S, E);
    }
    __syncthreads();
    {
        pg8::Gemm g{(const bf16_t*)((unsigned char*)c.out + OUT_UX), (const bf16_t*)(c.ws + WS_HMAT), 0, 0, 640};
        pg8::S5Order S{128, 1, c.G, c.bid};
        pg8::EpiS5E E{(float*)((unsigned char*)c.out + OUT_E)};
        pg8::gemm_phase<pg8::EpiS5E, pg8::S5Order, true, true>(c.lds, g, S, E);
    }
}

typedef float f2v __attribute__((ext_vector_type(2)));
__device__ __forceinline__ float dpp_add16(float v) {
    v += __builtin_bit_cast(float, __builtin_amdgcn_mov_dpp(__builtin_bit_cast(int, v), 0xB1, 0xf, 0xf, true));
    v += __builtin_bit_cast(float, __builtin_amdgcn_mov_dpp(__builtin_bit_cast(int, v), 0x4E, 0xf, 0xf, true));
    v += __builtin_bit_cast(float, __builtin_amdgcn_mov_dpp(__builtin_bit_cast(int, v), 0x141, 0xf, 0xf, true));
    v += __builtin_bit_cast(float, __builtin_amdgcn_mov_dpp(__builtin_bit_cast(int, v), 0x140, 0xf, 0xf, true));
    return v;
}
constexpr int RTS = 32;
constexpr int RTILE = 6 * RTS * 64;
typedef short bf16x8_t __attribute__((ext_vector_type(8)));
typedef float f32x4_t __attribute__((ext_vector_type(4)));
#define MFMA16(a, b, c) __builtin_amdgcn_mfma_f32_16x16x32_bf16((a), (b), (c), 0, 0, 0)
constexpr int CL = 64, CLD = 72, CSLOT = 64 * CLD * 2;
constexpr int C_DIAG = 13 * CSLOT, C_DM = C_DIAG + 4096, C_GL = C_DM + 2048, C_SEGP = C_GL + 256;
static_assert(C_SEGP + 2048 <= 131072, "rwkv chunk LDS map");
__device__ __forceinline__ bf16x8_t ldsfrag(LAS const unsigned char* slot, int row, int col) { return *(LAS const bf16x8_t*)(slot + (row * CLD + col) * 2); }
typedef unsigned u32x4_t __attribute__((ext_vector_type(4)));
typedef unsigned u32x2_t __attribute__((ext_vector_type(2)));
__device__ __forceinline__ void lds_st16(LAS unsigned char* p, uint4 v) { *(LAS u32x4_t*)p = (u32x4_t){v.x, v.y, v.z, v.w}; }
__device__ __forceinline__ void lds_st8(LAS unsigned char* p, uint2 v) { *(LAS u32x2_t*)p = (u32x2_t){v.x, v.y}; }
__device__ __forceinline__ uint2 lds_ld8(LAS const unsigned char* p) { const u32x2_t v = *(LAS const u32x2_t*)p; return make_uint2(v.x, v.y); }
__device__ __forceinline__ bf16x8_t zfrag() { return (bf16x8_t){0, 0, 0, 0, 0, 0, 0, 0}; }
__device__ __forceinline__ uint2 pack4(float a, float b, float c, float d) { return make_uint2(pk2(a, b), pk2(c, d)); }
__device__ __forceinline__ float wave_sum_u(float v) {
    v = dpp_add16(v);
    return __builtin_bit_cast(float, __builtin_amdgcn_readlane(__builtin_bit_cast(int, v), 0)) + __builtin_bit_cast(float, __builtin_amdgcn_readlane(__builtin_bit_cast(int, v), 16))
         + __builtin_bit_cast(float, __builtin_amdgcn_readlane(__builtin_bit_cast(int, v), 32)) + __builtin_bit_cast(float, __builtin_amdgcn_readlane(__builtin_bit_cast(int, v), 48));
}

__device__ __forceinline__ void rwkv_phaseA(const Ctx& c, const int GA) {
    const float* __restrict__ rw_w = (const float*)(c.ws + WS_RW_W);
    const bf16_t* __restrict__ rw_r = (const bf16_t*)(c.ws + WS_RW_R); const bf16_t* __restrict__ rw_k = (const bf16_t*)((const unsigned char*)c.out + OUT_KF); const bf16_t* __restrict__ rw_v = (const bf16_t*)(c.ws + WS_RW_V);
    const bf16_t* __restrict__ rw_a = (const bf16_t*)(c.ws + WS_RW_A); const bf16_t* __restrict__ rw_b = (const bf16_t*)(c.ws + WS_RW_B);
    const float* r_k = c.in[17];
    bf16_t* Mq = (bf16_t*)(c.ws + WS_CM); bf16_t* NTq = (bf16_t*)(c.ws + WS_CN); bf16_t* Qq = (bf16_t*)(c.ws + WS_CQ); bf16_t* YTq = (bf16_t*)(c.ws + WS_CY); float* bon = (float*)(c.ws + WS_CBON);
    LAS unsigned char* L = c.lds;
    LAS unsigned char* sAt = L + 0 * CSLOT; LAS unsigned char* sBt = L + 1 * CSLOT; LAS unsigned char* sKt = L + 2 * CSLOT; LAS unsigned char* sRt = L + 3 * CSLOT;
    LAS unsigned char* sBtT = L + 4 * CSLOT; LAS unsigned char* sKtT = L + 5 * CSLOT; LAS unsigned char* sVT = L + 6 * CSLOT;
    LAS unsigned char* sA4 = L + 7 * CSLOT;
    LAS unsigned char* sRHST = L + 11 * CSLOT;
    LAS unsigned char* sXT = L + 0 * CSLOT;
    LAS unsigned char* sAD = L + 2 * CSLOT;
    LAS float* sDIAG = (LAS float*)(L + C_DIAG); LAS bf16_t* sDM = (LAS bf16_t*)(L + C_DM); LAS float* sGL = (LAS float*)(L + C_GL); LAS float* sSEGP = (LAS float*)(L + C_SEGP);
    const int tid = c.tid, w = c.wid, lane = c.lane, lr = lane & 15, lq = lane >> 4;
    float raww[8]; unsigned rawa[8], rawb[8], rawk[8], rawr[8], rawv[8];
    auto load_raw = [&](int ci_) {
        const int bh_ = ci_ >> 7, chunk_ = ci_ & 127, b_ = bh_ >> 3, h_ = bh_ & 7;
        const size_t gb = (size_t)(b_ * SEQ + chunk_ * CL) * RW + h_ * 64 + (size_t)(8 * (tid >> 6)) * RW + (tid & 63);
#pragma unroll
        for (int j = 0; j < 8; ++j) { const size_t o = gb + (size_t)j * RW; raww[j] = rw_w[o]; rawa[j] = rw_a[o]; rawb[j] = rw_b[o]; rawk[j] = rw_k[o]; rawr[j] = rw_r[o]; rawv[j] = rw_v[o]; }
    };
    if (c.bid < BATCH * NH * (SEQ / CL)) load_raw(c.bid);
    for (int ci = c.bid; ci < BATCH * NH * (SEQ / CL); ci += GA) {
        const int bh = ci >> 7, chunk = ci & 127, b = bh >> 3, h = bh & 7;
        const size_t gbase = (size_t)(b * SEQ + chunk * CL) * RW + h * 64;
        {
            const int kc = tid & 63, seg = tid >> 6;
            float p[8];
#pragma unroll
            for (int j = 0; j < 8; ++j) { const float wv = raww[j]; p[j] = (j == 0) ? wv : p[j - 1] * wv; }
            sSEGP[seg * 64 + kc] = p[7];
            for (int i = tid; i < 4 * CSLOT / 16; i += 512) lds_st16(sA4 + i * 16, make_uint4(0u, 0u, 0u, 0u));
            __syncthreads();
            float pre = 1.0f;
#pragma unroll
            for (int s = 0; s < 7; ++s) { const float sp = sSEGP[s * 64 + kc]; pre = (s < seg) ? pre * sp : pre; }
            float atT[8], btT[8], ktT[8], vT[8];
            const float rkv = r_k[h * 64 + kc];
#pragma unroll
            for (int j = 0; j < 8; ++j) {
                const int t = 8 * seg + j;
                const float G = pre * p[j], Gm1 = (j == 0) ? pre : pre * p[j - 1], inv = 1.0f / G;
                const float av = bf2f(rawa[j]), bv = bf2f(rawb[j]), kv = bf2f(rawk[j]), rv = bf2f(rawr[j]), vv = bf2f(rawv[j]);
                const float at = av * Gm1, bt = bv * inv, kt = kv * inv, rt = rv * G;
                *(LAS bf16_t*)(sAt + (t * CLD + kc) * 2) = (bf16_t)f2bf(at); *(LAS bf16_t*)(sBt + (t * CLD + kc) * 2) = (bf16_t)f2bf(bt);
                *(LAS bf16_t*)(sKt + (t * CLD + kc) * 2) = (bf16_t)f2bf(kt); *(LAS bf16_t*)(sRt + (t * CLD + kc) * 2) = (bf16_t)f2bf(rt);
                atT[j] = at; btT[j] = bt; ktT[j] = kt; vT[j] = vv;
                const float bs = wave_sum_u(rv * kv * rkv);
                if (lane == 0) bon[(size_t)ci * CL + t] = bs;
            }
            lds_st16(sRHST + (kc * CLD + 8 * seg) * 2, pack8(atT)); lds_st16(sBtT + (kc * CLD + 8 * seg) * 2, pack8(btT));
            lds_st16(sKtT + (kc * CLD + 8 * seg) * 2, pack8(ktT)); lds_st16(sVT + (kc * CLD + 8 * seg) * 2, pack8(vT));
            if (seg == 7) sGL[kc] = pre * p[7];
            __syncthreads();
        }
        for (int idx = w; idx < 40; idx += 8) {
            const int m = idx / 10, pr = idx % 10;
            const int ti = (pr >= 6) ? 3 : (pr >= 3) ? 2 : (pr >= 1) ? 1 : 0, si = pr - ti * (ti + 1) / 2;
            LAS const unsigned char* X = (m < 2) ? sAt : sRt; LAS const unsigned char* Y = (m & 1) ? sKt : sBt;
            f32x4_t acc = {0.f, 0.f, 0.f, 0.f};
#pragma unroll
            for (int ks = 0; ks < 2; ++ks) acc = MFMA16(ldsfrag(Y, 16 * si + lr, 32 * ks + 8 * lq), ldsfrag(X, 16 * ti + lr, 32 * ks + 8 * lq), acc);
            const int t = 16 * ti + lr, s0 = 16 * si + 4 * lq;
            float o[4];
#pragma unroll
            for (int rg = 0; rg < 4; ++rg) { const int s = s0 + rg; const bool keep = (m < 2) ? (s < t) : (s <= t); o[rg] = keep ? acc[rg] : 0.f; }
            lds_st8(sA4 + m * CSLOT + (t * CLD + s0) * 2, pack4(o[0], o[1], o[2], o[3]));
            if (m == 0 && ti == si) *(LAS f32x4_t*)(sDIAG + (ti * 16 + lr) * 16 + 4 * lq) = (f32x4_t){o[0], o[1], o[2], o[3]};
        }
        __syncthreads();
        if (w == 0) {
            float x[16];
#pragma unroll
            for (int r = 0; r < 16; ++r) {
                float acc = (r == lr) ? 1.0f : 0.0f;
                float nrow[16];
#pragma unroll
                for (int q4 = 0; q4 < 4; ++q4) { const f32x4_t nv = *(LAS const f32x4_t*)(sDIAG + (lq * 16 + r) * 16 + 4 * q4); nrow[4 * q4] = nv[0]; nrow[4 * q4 + 1] = nv[1]; nrow[4 * q4 + 2] = nv[2]; nrow[4 * q4 + 3] = nv[3]; }
#pragma unroll
                for (int s = 0; s < 16; ++s) if (s < r) acc = fmaf(nrow[s], x[s], acc);
                x[r] = acc;
                sDM[(lq * 16 + r) * 16 + lr] = (bf16_t)f2bf(acc);
            }
        } else {
            for (int idx = w - 1; idx < 16; idx += 7) {
                const int ti = idx >> 2, vi = idx & 3;
                f32x4_t acc = {0.f, 0.f, 0.f, 0.f};
#pragma unroll
                for (int ks = 0; ks < 2; ++ks) acc = MFMA16(ldsfrag(sA4 + 1 * CSLOT, 16 * ti + lr, 32 * ks + 8 * lq), ldsfrag(sVT, 16 * vi + lr, 32 * ks + 8 * lq), acc);
                lds_st8(sRHST + ((64 + 16 * vi + lr) * CLD + 16 * ti + 4 * lq) * 2, pack4(acc[0], acc[1], acc[2], acc[3]));
            }
        }
        __syncthreads();
        f32x4_t rd[4];
#pragma unroll
        for (int i = 0; i < 4; ++i) {
            bf16x8_t fa = zfrag(), fb = zfrag();
            if (lq < 2) { fa = *(LAS const bf16x8_t*)(sDM + (i * 16 + lr) * 16 + 8 * lq); fb = ldsfrag(sRHST, 16 * w + lr, 16 * i + 8 * lq); }
            rd[i] = MFMA16(fa, fb, ((f32x4_t){0.f, 0.f, 0.f, 0.f}));
        }
        if (w < 6) {
            const int i = (w >= 3) ? 3 : (w >= 1) ? 2 : 1, j = w - (i - 1) * i / 2;
            bf16x8_t fa = zfrag(), fb = zfrag();
            if (lq < 2) {
                fa = *(LAS const bf16x8_t*)(sDM + (i * 16 + lr) * 16 + 8 * lq);
#pragma unroll
                for (int jj = 0; jj < 8; ++jj) fb[jj] = (short)*(LAS const bf16_t*)(sA4 + ((16 * i + 8 * lq + jj) * CLD + 16 * j + lr) * 2);
            }
            const f32x4_t acc = MFMA16(fa, fb, ((f32x4_t){0.f, 0.f, 0.f, 0.f}));
#pragma unroll
            for (int rg = 0; rg < 4; ++rg) *(LAS bf16_t*)(sAD + ((16 * i + 4 * lq + rg) * CLD + 16 * j + lr) * 2) = (bf16_t)f2bf(acc[rg]);
        }
        __syncthreads();
#pragma unroll
        for (int i = 0; i < 4; ++i) {
            f32x4_t acc = rd[i];
            if (i >= 1) {
                bf16x8_t fa = zfrag(), fb = zfrag();
                if (8 * lq < 16 * i) { fa = ldsfrag(sAD, 16 * i + lr, 8 * lq); fb = ldsfrag(sXT, 16 * w + lr, 8 * lq); }
                acc = MFMA16(fa, fb, acc);
            }
            if (i == 3) {
                bf16x8_t fa = zfrag(), fb = zfrag();
                if (lq < 2) { fa = ldsfrag(sAD, 48 + lr, 32 + 8 * lq); fb = ldsfrag(sXT, 16 * w + lr, 32 + 8 * lq); }
                acc = MFMA16(fa, fb, acc);
            }
            lds_st8(sXT + ((16 * w + lr) * CLD + 16 * i + 4 * lq) * 2, pack4(acc[0], acc[1], acc[2], acc[3]));
            asm volatile("s_waitcnt lgkmcnt(0)" ::: "memory");
        }
        __syncthreads();
        if (ci + GA < BATCH * NH * (SEQ / CL)) load_raw(ci + GA);
#pragma unroll
        for (int i = 0; i < 8; ++i) {
            const int kind = i >> 1, tile = w + 8 * (i & 1), r4 = tile >> 2, c4 = tile & 3;
            f32x4_t acc = {0.f, 0.f, 0.f, 0.f};
            if (kind == 0) {
#pragma unroll
                for (int ks = 0; ks < 2; ++ks) acc = MFMA16(ldsfrag(sXT, 16 * r4 + lr, 32 * ks + 8 * lq), ldsfrag(sBtT, 16 * c4 + lr, 32 * ks + 8 * lq), acc);
                const int k = 16 * c4 + lr, kp0 = 16 * r4 + 4 * lq; const float gl = sGL[k];
                float o[4];
#pragma unroll
                for (int rg = 0; rg < 4; ++rg) o[rg] = gl * (acc[rg] + ((k == kp0 + rg) ? 1.0f : 0.0f));
                *(uint2*)(Mq + (size_t)ci * 4096 + k * 64 + kp0) = pack4(o[0], o[1], o[2], o[3]);
            } else if (kind == 1) {
#pragma unroll
                for (int ks = 0; ks < 2; ++ks) {
                    acc = MFMA16(ldsfrag(sBtT, 16 * r4 + lr, 32 * ks + 8 * lq), ldsfrag(sXT, 64 + 16 * c4 + lr, 32 * ks + 8 * lq), acc);
                    acc = MFMA16(ldsfrag(sKtT, 16 * r4 + lr, 32 * ks + 8 * lq), ldsfrag(sVT, 16 * c4 + lr, 32 * ks + 8 * lq), acc);
                }
                const int k0 = 16 * r4 + 4 * lq; const f32x4_t gl = *(LAS const f32x4_t*)(sGL + k0);
                *(uint2*)(NTq + (size_t)ci * 4096 + (16 * c4 + lr) * 64 + k0) = pack4(gl[0] * acc[0], gl[1] * acc[1], gl[2] * acc[2], gl[3] * acc[3]);
            } else if (kind == 2) {
#pragma unroll
                for (int ks = 0; ks < 2; ++ks) acc = MFMA16(ldsfrag(sXT, 16 * r4 + lr, 32 * ks + 8 * lq), ldsfrag(sA4 + 2 * CSLOT, 16 * c4 + lr, 32 * ks + 8 * lq), acc);
                const int t = 16 * c4 + lr, kp0 = 16 * r4 + 4 * lq;
                const uint2 rv = lds_ld8(sRt + (t * CLD + kp0) * 2);
                *(uint2*)(Qq + (size_t)ci * 4096 + t * 64 + kp0) = pack4(acc[0] + bf2f(rv.x & 0xffffu), acc[1] + bf2f(rv.x >> 16), acc[2] + bf2f(rv.y & 0xffffu), acc[3] + bf2f(rv.y >> 16));
            } else {
#pragma unroll
                for (int ks = 0; ks < 2; ++ks) {
                    acc = MFMA16(ldsfrag(sA4 + 2 * CSLOT, 16 * r4 + lr, 32 * ks + 8 * lq), ldsfrag(sXT, 64 + 16 * c4 + lr, 32 * ks + 8 * lq), acc);
                    acc = MFMA16(ldsfrag(sA4 + 3 * CSLOT, 16 * r4 + lr, 32 * ks + 8 * lq), ldsfrag(sVT, 16 * c4 + lr, 32 * ks + 8 * lq), acc);
                }
                *(uint2*)(YTq + (size_t)ci * 4096 + (16 * c4 + lr) * 64 + 16 * r4 + 4 * lq) = pack4(acc[0], acc[1], acc[2], acc[3]);
            }
        }
        __syncthreads();
    }
}

__device__ __forceinline__ void rwkv_phaseB(const Ctx& c, const int bh, const int w) {
    const bf16_t* __restrict__ Mq = (const bf16_t*)(c.ws + WS_CM); const bf16_t* __restrict__ NTq = (const bf16_t*)(c.ws + WS_CN); bf16_t* __restrict__ Sst = (bf16_t*)(c.ws + WS_CS);
    const int lane = c.lane, lr = lane & 15, lq = lane >> 4;
    LAS unsigned char* sS = c.lds + 69632 + c.wid * (16 * CLD * 2);
    {
        {
            bf16x8_t sB0 = zfrag(), sB1 = zfrag();
            bf16x8_t ma[4][4][2]; uint2 nv[4][4];
            const size_t ci0 = (size_t)bh * (SEQ / CL);
#define RB_LOAD(slot, cidx) do { _Pragma("unroll") for (int kt = 0; kt < 4; ++kt) { _Pragma("unroll") for (int ks = 0; ks < 2; ++ks) \
                ma[slot][kt][ks] = *(const bf16x8_t*)(Mq + (cidx) * 4096 + (16 * kt + lr) * 64 + 32 * ks + 8 * lq); nv[slot][kt] = *(const uint2*)(NTq + (cidx) * 4096 + (16 * w + lr) * 64 + 16 * kt + 4 * lq); } } while (0)
#pragma unroll
            for (int sl = 0; sl < 4; ++sl) RB_LOAD(sl, ci0 + sl);
#pragma unroll
            for (int chunk = 0; chunk < SEQ / CL; chunk += 4) {
#pragma unroll
                for (int sl = 0; sl < 4; ++sl) {
                    const size_t ci = ci0 + chunk + sl;
                    asm volatile("global_store_dwordx4 %0, %1, off\n\tglobal_store_dwordx4 %0, %2, off offset:64\n\ts_nop 1" :: "v"(Sst + ci * 4096 + (16 * w + lr) * 64 + 8 * lq), "v"(sB0), "v"(sB1) : "memory");
#pragma unroll
                    for (int kt = 0; kt < 4; ++kt) {
                        f32x4_t acc = {bf2f(nv[sl][kt].x & 0xffffu), bf2f(nv[sl][kt].x >> 16), bf2f(nv[sl][kt].y & 0xffffu), bf2f(nv[sl][kt].y >> 16)};
                        acc = MFMA16(ma[sl][kt][0], sB0, acc); acc = MFMA16(ma[sl][kt][1], sB1, acc);
                        lds_st8(sS + (lr * CLD + 16 * kt + 4 * lq) * 2, pack4(acc[0], acc[1], acc[2], acc[3]));
                    }
                    const size_t cn = (chunk + sl + 4 < SEQ / CL) ? ci + 4 : ci;
                    RB_LOAD(sl, cn);
                    asm volatile("s_waitcnt lgkmcnt(0)" ::: "memory");
                    sB0 = ldsfrag(sS, lr, 8 * lq); sB1 = ldsfrag(sS, lr, 32 + 8 * lq);
                    asm volatile("s_waitcnt lgkmcnt(0)" ::: "memory");
                }
            }
#undef RB_LOAD
        }
    }
}

__device__ __forceinline__ void rwkv_phaseC(const Ctx& c) {
    const bf16_t* __restrict__ Qq = (const bf16_t*)(c.ws + WS_CQ); const bf16_t* __restrict__ YTq = (const bf16_t*)(c.ws + WS_CY); const bf16_t* __restrict__ Sst = (const bf16_t*)(c.ws + WS_CS);
    const float* __restrict__ bon = (const float*)(c.ws + WS_CBON);
    const bf16_t* rw_v = (const bf16_t*)(c.ws + WS_RW_V); const bf16_t* rw_g = (const bf16_t*)(c.ws + WS_RW_G);
    const float* ln_w = c.in[18]; const float* ln_b = c.in[19];
    bf16_t* ycat = (bf16_t*)(c.ws + WS_A);
    const int w = c.wid, lane = c.lane, lr = lane & 15, lq = lane >> 4;
    LAS float* sY = (LAS float*)(c.lds + w * (16 * 68 * 4));
    const int gw = c.bid * 8 + c.wid, NW = c.G * 8;
    for (int task = gw; task < BATCH * NH * (SEQ / CL) * 4; task += NW) {
        const size_t ci = (size_t)(task >> 2); const int tt = task & 3;
        const int bh = (int)(ci >> 7), chunk = (int)(ci & 127), b = bh >> 3, h = bh & 7;
        bf16x8_t qa[2];
#pragma unroll
        for (int ks = 0; ks < 2; ++ks) qa[ks] = *(const bf16x8_t*)(Qq + ci * 4096 + (16 * tt + lr) * 64 + 32 * ks + 8 * lq);
#pragma unroll
        for (int vt = 0; vt < 4; ++vt) {
            const uint2 yv = *(const uint2*)(YTq + ci * 4096 + (16 * vt + lr) * 64 + 16 * tt + 4 * lq);
            f32x4_t acc = {bf2f(yv.x & 0xffffu), bf2f(yv.x >> 16), bf2f(yv.y & 0xffffu), bf2f(yv.y >> 16)};
#pragma unroll
            for (int ks = 0; ks < 2; ++ks) acc = MFMA16(qa[ks], *(const bf16x8_t*)(Sst + ci * 4096 + (16 * vt + lr) * 64 + 32 * ks + 8 * lq), acc);
#pragma unroll
            for (int rg = 0; rg < 4; ++rg) sY[(4 * lq + rg) * 68 + 16 * vt + lr] = acc[rg];
        }
        asm volatile("s_waitcnt lgkmcnt(0)" ::: "memory");
        const int hn = h * 64 + lane;
        const float lw = ln_w[hn], lb = ln_b[hn];
#pragma unroll 4
        for (int tr = 0; tr < 16; ++tr) {
            const int t = chunk * CL + 16 * tt + tr; const size_t tok = (size_t)b * SEQ + t;
            const float y = sY[tr * 68 + lane];
            const float mean = wave_sum_u(y) * (1.f / 64.f);
            const float d = y - mean;
            const float var = wave_sum_u(d * d) * (1.f / 64.f);
            const float yn = d * rsqrtf(var + 64e-5f) * lw + lb;
            const float bonus = bon[ci * CL + 16 * tt + tr] * ldbf(rw_v + tok * RW + hn);
            ycat[tok * D + hn] = (bf16_t)f2bf((yn + bonus) * ldbf(rw_g + tok * RW + hn));
        }
        asm volatile("s_waitcnt lgkmcnt(0)" ::: "memory");
    }
}

constexpr int PA_BLOCKS = 256;
constexpr int CONV_A = 0;
__device__ __forceinline__ void phase6a(const Ctx& c) {
    if (c.G != 256) { rwkv_phaseA(c, c.G); return; }
    if (c.bid < PA_BLOCKS) rwkv_phaseA(c, PA_BLOCKS);
    else if (CONV_A > 0) convert_expert_weights(c, 0, CONV_A, (c.bid - PA_BLOCKS) * 8 + c.wid, (256 - PA_BLOCKS > 0 ? 256 - PA_BLOCKS : 1) * 8);
}

__device__ __forceinline__ void phase6b(const Ctx& c) {
    if (c.wid == 0) {
        for (int tk = c.bid; tk < 2 * S5NG * BATCH; tk += c.G) {
            if (tk < BATCH * NH * 4) { rwkv_phaseB(c, tk >> 2, tk & 3); continue; }
            const float* apow = (const float*)(c.ws + WS_APOW); const float* E = (const float*)((const unsigned char*)c.out + OUT_E);
            bf16_t* ux = (bf16_t*)((unsigned char*)c.out + OUT_UX);
            const int task = tk - BATCH * NH * 4;
            const int g = task >> 2, b = task & 3, p = c.lane;
            const float pr = apow[((size_t)(g * (S5L + 1) + S5L) * 64 + p) * 2], pi = apow[((size_t)(g * (S5L + 1) + S5L) * 64 + p) * 2 + 1];
            float xr = 0.f, xi = 0.f;
            const size_t row0 = (size_t)g * 1024 + b * 256;
            float er[2][8], ei[2][8];
#pragma unroll
            for (int q = 0; q < 8; ++q) { er[0][q] = E[(row0 + q) * 128 + p]; ei[0][q] = E[(row0 + q) * 128 + 64 + p]; }
#pragma unroll
            for (int bt = 0; bt < 32; ++bt) {
                const int cur = bt & 1, nx = cur ^ 1, ch0 = bt * 8;
                if (bt + 1 < 32) {
#pragma unroll
                    for (int q = 0; q < 8; ++q) { er[nx][q] = E[(row0 + ch0 + 8 + q) * 128 + p]; ei[nx][q] = E[(row0 + ch0 + 8 + q) * 128 + 64 + p]; }
                }
#pragma unroll
                for (int q = 0; q < 8; ++q) {
                    st2(ux + (row0 + ch0 + q) * 640 + 512 + p, f2bf(xr)); st2(ux + (row0 + ch0 + q) * 640 + 576 + p, f2bf(xi));
                    const float nr = pr * xr - pi * xi + er[cur][q], ni = pr * xi + pi * xr + ei[cur][q]; xr = nr; xi = ni;
                }
            }
        }
    } else {
        convert_expert_weights(c, (c.G == 256) ? CONV_A : 0, NE * 384, c.bid * 7 + (c.wid - 1), c.G * 7);
    }
}

__device__ __forceinline__ void phase7(const Ctx& c) {
    {
        pg8::Gemm g{(const bf16_t*)((unsigned char*)c.out + OUT_UX), (const bf16_t*)(c.ws + WS_KMAT), 0, 0, 640};
        pg8::S5Order S{256, 2, c.G, c.bid};
        pg8::EpiS5Out E{(bf16_t*)(c.ws + WS_YS5)};
        pg8::gemm_phase<pg8::EpiS5Out, pg8::S5Order, true, true>(c.lds, g, S, E);
    }
    __syncthreads();
    rwkv_phaseC(c);
}

__device__ __forceinline__ void phase8(const Ctx& c) {
    pg8::Gemm g{(const bf16_t*)(c.ws + WS_YS5), (const bf16_t*)(c.ws + WS_WGLU_T), T, 512, 512};
    pg8::StaticOrder S; S.init(T, 512, c.G, c.bid);
    pg8::EpiGLU E{(const bf16_t*)(c.ws + WS_YS5), 512, c.in[29], (bf16_t*)(c.ws + WS_A), D, 512};
    pg8::gemm_phase<pg8::EpiGLU, pg8::StaticOrder, true, true>(c.lds, g, S, E);
}

__device__ __forceinline__ void phase9(const Ctx& c) {
    pg8::Gemm g{(const bf16_t*)(c.ws + WS_A), (const bf16_t*)(c.ws + WS_WOUT_T), T, D, D};
    pg8::StaticOrder S; S.init(T, D, c.G, c.bid);
    pg8::EpiF32 E{(float*)(c.ws + WS_PROJ), D};
    pg8::gemm_phase<pg8::EpiF32, pg8::StaticOrder, true, true>(c.lds, g, S, E);
}

__device__ __forceinline__ void phase10(const Ctx& c) {
    const float* x = c.in[0]; const float* gpm = c.in[5]; const float* gpf = c.in[6];
    const float* mods = (const float*)(c.ws + WS_MODS); const float* mixed = (const float*)(c.ws + WS_PROJ);
    bf16_t* h2 = (bf16_t*)(c.ws + WS_A); float* x1o = c.out;
    const int gw = c.bid * 8 + c.wid, NW = c.G * 8;
    for (int t = gw; t < T; t += NW) {
        const int b = t / SEQ;
        const float4* mr = (const float4*)(mixed + (size_t)t * D) + c.lane;
        const float4* xr = (const float4*)(x + (size_t)t * D) + c.lane;
        float4 m[4], v[4]; float ss = 0.f;
#pragma unroll
        for (int j = 0; j < 4; ++j) { m[j] = mr[64 * j]; v[j] = xr[64 * j]; ss += m[j].x * m[j].x + m[j].y * m[j].y + m[j].z * m[j].z + m[j].w * m[j].w; }
        const float rstd = rsqrtf(wave_sum(ss) * (1.0f / D) + 1e-6f);
        float s1 = 0.f;
#pragma unroll
        for (int j = 0; j < 4; ++j) {
            const int k = (c.lane + 64 * j) * 4;
            const float4 gg = *(const float4*)(gpm + k);
            const float4 gt = *(const float4*)(mods + b * NMODS + 2 * D + k);
            v[j].x += gt.x * (m[j].x * rstd * gg.x); v[j].y += gt.y * (m[j].y * rstd * gg.y);
            v[j].z += gt.z * (m[j].z * rstd * gg.z); v[j].w += gt.w * (m[j].w * rstd * gg.w);
            s1 += v[j].x * v[j].x + v[j].y * v[j].y + v[j].z * v[j].z + v[j].w * v[j].w;
            ((float4*)(x1o + (size_t)t * D) + c.lane)[64 * j] = v[j];
        }
        const float rstd1 = rsqrtf(wave_sum(s1) * (1.0f / D) + 1e-6f);
#pragma unroll
        for (int j = 0; j < 4; ++j) {
            const int k = (c.lane + 64 * j) * 4;
            const float4 gg = *(const float4*)(gpf + k);
            const float4 sh = *(const float4*)(mods + b * NMODS + 3 * D + k);
            const float4 sc = *(const float4*)(mods + b * NMODS + 4 * D + k);
            float r[4];
            r[0] = v[j].x * rstd1 * gg.x * (1.f + sc.x) + sh.x; r[1] = v[j].y * rstd1 * gg.y * (1.f + sc.y) + sh.y;
            r[2] = v[j].z * rstd1 * gg.z * (1.f + sc.z) + sh.z; r[3] = v[j].w * rstd1 * gg.w * (1.f + sc.w) + sh.w;
            unsigned hi[4]; float lo[4];
#pragma unroll
            for (int q = 0; q < 4; ++q) { hi[q] = f2bf(r[q]); lo[q] = r[q] - bf2f(hi[q]); }
            ((uint2*)(h2 + (size_t)t * D) + c.lane)[64 * j] = make_uint2(hi[0] | (hi[1] << 16), hi[2] | (hi[3] << 16));
            ((uint2*)(h2 + (size_t)(T + t) * D) + c.lane)[64 * j] = make_uint2(pk2(lo[0], lo[1]), pk2(lo[2], lo[3]));
        }
    }
}

__device__ __forceinline__ void phase11(const Ctx& c) {
    {
        pg8::Gemm g{(const bf16_t*)(c.ws + WS_A), (const bf16_t*)(c.ws + WS_WR_T), 2 * T, 512, D};
        pg8::StaticOrder S; S.init(2 * T, 512, c.G, c.bid);
        pg8::EpiRouter E{(float*)(c.ws + WS_PLOG), (bf16_t*)(c.ws + WS_PLOG + 32 * MiB), (bf16_t*)(c.ws + WS_PLOG + 48 * MiB), T / 256};
        pg8::gemm_phase<pg8::EpiRouter, pg8::StaticOrder, true, true>(c.lds, g, S, E);
    }
    __syncthreads();
    {
        pg8::Gemm g{(const bf16_t*)(c.ws + WS_A), (const bf16_t*)(c.ws + WS_WSGU_T), T, 512, D};
        pg8::StaticOrder S; S.init(T, 512, c.G, c.bid);
        pg8::EpiSwiGLU E{(bf16_t*)(c.ws + WS_HS), 256};
        pg8::gemm_phase<pg8::EpiSwiGLU, pg8::StaticOrder, true, true>(c.lds, g, S, E);
    }
}

__device__ __forceinline__ unsigned fkey(float f) { const unsigned u = __builtin_bit_cast(unsigned, f); return u ^ ((u >> 31) ? 0xffffffffu : 0x80000000u); }
__device__ __forceinline__ unsigned wave_umax(unsigned v) {
    v = max(v, DPPU(v, 0xB1)); v = max(v, DPPU(v, 0x4E)); v = max(v, DPPU(v, 0x141)); v = max(v, DPPU(v, 0x140));
    const unsigned a = __builtin_amdgcn_readlane(v, 0), b = __builtin_amdgcn_readlane(v, 16), c = __builtin_amdgcn_readlane(v, 32), d = __builtin_amdgcn_readlane(v, 48);
    return max(max(a, b), max(c, d));
}
__device__ __forceinline__ unsigned wave_umin(unsigned v) {
    v = min(v, DPPU(v, 0xB1)); v = min(v, DPPU(v, 0x4E)); v = min(v, DPPU(v, 0x141)); v = min(v, DPPU(v, 0x140));
    const unsigned a = __builtin_amdgcn_readlane(v, 0), b = __builtin_amdgcn_readlane(v, 16), c = __builtin_amdgcn_readlane(v, 32), d = __builtin_amdgcn_readlane(v, 48);
    return min(min(a, b), min(c, d));
}
__device__ __forceinline__ void phase12(const Ctx& c) {
    const float* plog = (const float*)(c.ws + WS_PLOG); const float* rb = c.in[32];
    int* idx = (int*)(c.ws + WS_IDX); float* wt = (float*)(c.ws + WS_WT);
    LAS int* lhist = (LAS int*)c.lds;
    __syncthreads();
    if (c.tid < NE) lhist[c.tid] = 0;
    __syncthreads();
    const int gw = c.bid * 8 + c.wid, NW = c.G * 8, l = c.lane;
    const float4 bias = *(const float4*)(rb + l * 4);
    for (int t = gw; t < T; t += NW) {
        const float4 p0 = *(const float4*)(plog + (size_t)t * 256 + l * 4);
        const float4 p1 = ldbf4((const bf16_t*)(c.ws + WS_PLOG + 32 * MiB) + (size_t)t * 256 + l * 4), p2 = ldbf4((const bf16_t*)(c.ws + WS_PLOG + 48 * MiB) + (size_t)t * 256 + l * 4);
        const float lg[4] = {p0.x + (p1.x + p2.x), p0.y + (p1.y + p2.y), p0.z + (p1.z + p2.z), p0.w + (p1.w + p2.w)};
        float s[4] = {sigmoidf_(lg[0]), sigmoidf_(lg[1]), sigmoidf_(lg[2]), sigmoidf_(lg[3])};
        float ch[4] = {s[0] + bias.x, s[1] + bias.y, s[2] + bias.z, s[3] + bias.w};
        float a1 = fmaxf(ch[0], ch[1]), a2 = fminf(ch[0], ch[1]);
        { const float b1 = fmaxf(ch[2], ch[3]), b2 = fminf(ch[2], ch[3]); const float n1 = fmaxf(a1, b1), n2 = fmaxf(fminf(a1, b1), fmaxf(a2, b2)); a1 = n1; a2 = n2; }
        { const float b1 = DPPF(a1, 0xB1), b2 = DPPF(a2, 0xB1); const float n1 = fmaxf(a1, b1), n2 = fmaxf(fminf(a1, b1), fmaxf(a2, b2)); a1 = n1; a2 = n2; }
        { const float b1 = DPPF(a1, 0x4E), b2 = DPPF(a2, 0x4E); const float n1 = fmaxf(a1, b1), n2 = fmaxf(fminf(a1, b1), fmaxf(a2, b2)); a1 = n1; a2 = n2; }
        { const float b1 = DPPF(a1, 0x141), b2 = DPPF(a2, 0x141); const float n1 = fmaxf(a1, b1), n2 = fmaxf(fminf(a1, b1), fmaxf(a2, b2)); a1 = n1; a2 = n2; }
        const float gs = a1 + a2; const int myg = l >> 3;
        int rank = 0;
#pragma unroll
        for (int g = 0; g < 8; ++g) { const float og = __builtin_bit_cast(float, __builtin_amdgcn_readlane(__builtin_bit_cast(int, gs), g * 8)); rank += (og > gs || (og == gs && g < myg)) ? 1 : 0; }
        const bool sel = rank < 4;
        unsigned mk[4];
#pragma unroll
        for (int i = 0; i < 4; ++i) mk[i] = sel ? fkey(ch[i]) : 0u;
        float sk[8]; int ek[8]; float ssum = 0.f;
#pragma unroll
        for (int k = 0; k < 8; ++k) {
            const unsigned lm = max(max(mk[0], mk[1]), max(mk[2], mk[3]));
            const unsigned m = wave_umax(lm);
            unsigned cand = 1023u;
#pragma unroll
            for (int i = 3; i >= 0; --i) if (mk[i] == m) cand = (unsigned)(l * 4 + i);
            const int be = (int)wave_umin(cand);
            const int ii = be & 3;
            float sv = s[0]; sv = (ii == 1) ? s[1] : sv; sv = (ii == 2) ? s[2] : sv; sv = (ii == 3) ? s[3] : sv;
            sv = __builtin_bit_cast(float, __builtin_amdgcn_readlane(__builtin_bit_cast(int, sv), be >> 2));
            if ((be >> 2) == l) {
#pragma unroll
                for (int i = 0; i < 4; ++i) if (i == ii) mk[i] = 0u;
            }
            sk[k] = sv; ek[k] = be; ssum += sv;
        }
        if (l == 0) {
            const float inv = 2.5f / ssum;
#pragma unroll
            for (int k = 0; k < 8; ++k) { idx[t * 8 + k] = ek[k]; wt[t * 8 + k] = sk[k] * inv; __hip_atomic_fetch_add(lhist + ek[k], 1, __ATOMIC_RELAXED, __HIP_MEMORY_SCOPE_WORKGROUP); }
        }
    }
    __syncthreads();
    if (c.tid < NE) ((int*)(c.ws + WS_HIST))[c.bid * NE + c.tid] = lhist[c.tid];
}

__device__ __forceinline__ void phase13(const Ctx& c) {
    int* smi = (int*)c.sm;
    const int* hist = (const int*)(c.ws + WS_HIST);
    __syncthreads();
    if (c.tid < NE) {
        int tot = 0, base = 0;
        for (int bb = 0; bb < c.G; ++bb) { const int v = hist[bb * NE + c.tid]; tot += v; base += (bb < c.bid) ? v : 0; }
        smi[600 + c.tid] = tot; smi[900 + c.tid] = base; smi[1200 + c.tid] = 0; smi[300 + c.tid] = (tot + 255) >> 8;
    }
    __syncthreads();
    if (c.tid < 64) {
        const int l = c.tid; const int u0 = smi[300 + l * 4], u1 = smi[300 + l * 4 + 1], u2 = smi[300 + l * 4 + 2], u3 = smi[300 + l * 4 + 3];
        const int tot = u0 + u1 + u2 + u3; int inc = tot;
#pragma unroll
        for (int o = 1; o < 64; o <<= 1) { const int v = __shfl_up(inc, o); if (l >= o) inc += v; }
        const int ex = inc - tot;
        smi[l * 4] = ex; smi[l * 4 + 1] = ex + u0; smi[l * 4 + 2] = ex + u0 + u1; smi[l * 4 + 3] = ex + u0 + u1 + u2;
        if (l == 63) smi[NE] = inc;
    }
    __syncthreads();
    const int* idx = (const int*)(c.ws + WS_IDX); int* slotp = (int*)(c.ws + WS_SLOTP); int* uexp = (int*)(c.ws + WS_UEXP); int* slotw = (int*)(c.ws + WS_SLOTW); const float* wt = (const float*)(c.ws + WS_WT);
    const int gw = c.bid * 8 + c.wid, NW = c.G * 8;
    for (int t = gw; t < T; t += NW) {
        if (c.lane < 8) {
            const int a = t * 8 + c.lane, e = idx[a];
            const int pos = smi[900 + e] + __hip_atomic_fetch_add(smi + 1200 + e, 1, __ATOMIC_RELAXED, __HIP_MEMORY_SCOPE_WORKGROUP);
            const int slot = smi[e] * 256 + pos;
            slotp[slot] = a;
            *(int2*)(slotw + 2 * (size_t)slot) = make_int2(a, __float_as_int(wt[a]));
        }
    }
    const int gt = c.bid * 512 + c.tid, NT = c.G * 512;
    for (int e = gt; e < NE; e += NT) {
        const int u0 = smi[e], u1 = smi[e + 1], cn = smi[600 + e];
        for (int p = cn; p < (u1 - u0) * 256; ++p) { slotp[u0 * 256 + p] = -1; *(int2*)(slotw + 2 * (size_t)(u0 * 256 + p)) = make_int2(-1, 0); }
        for (int u = u0; u < u1; ++u) uexp[u] = e;
    }
    if (gt == 0) uexp[2048] = smi[NE];
}

__device__ __forceinline__ void phase14(const Ctx& c) {
    const int* uexp = (const int*)(c.ws + WS_UEXP);
    const int NU = __builtin_amdgcn_readfirstlane(uexp[2048]);
    const int vcu = (c.G % 8 == 0) ? (c.bid % 8) * (c.G / 8) + c.bid / 8 : c.bid;
    pg8::Gemm g{(const bf16_t*)(c.ws + WS_A), (const bf16_t*)(c.ws + WS_WEGU), 0, 0, D, (const int*)(c.ws + WS_SLOTP)};
    pg8::ExpertOrder S{uexp, NU, 2, c.G, vcu};
    pg8::EpiSwiGLU E{(bf16_t*)(c.ws + WS_HID), 256};
    pg8::gemm_phase<pg8::EpiSwiGLU, pg8::ExpertOrder, true, true, true>(c.lds, g, S, E);
}

__device__ __forceinline__ void phase15(const Ctx& c) {
    {
        const int* uexp = (const int*)(c.ws + WS_UEXP);
        const int NU = __builtin_amdgcn_readfirstlane(uexp[2048]);
        const int vcu = (c.G % 8 == 0) ? (c.bid % 8) * (c.G / 8) + c.bid / 8 : c.bid;
        pg8::Gemm g{(const bf16_t*)(c.ws + WS_HID), (const bf16_t*)(c.ws + WS_WED), 0, 0, EFF};
        pg8::ExpertOrder S{uexp, NU, 4, c.G, vcu};
        pg8::EpiScatter E{(const int*)(c.ws + WS_SLOTW), (bf16_t*)(c.ws + WS_YEXP), D};
        pg8::gemm_phase<pg8::EpiScatter, pg8::ExpertOrder, true, true>(c.lds, g, S, E);
    }
    __syncthreads();
    {
        pg8::Gemm g{(const bf16_t*)(c.ws + WS_HS), (const bf16_t*)(c.ws + WS_WSD_T), T, D, 256};
        pg8::StaticOrder S; S.init(T, D, c.G, c.bid);
        pg8::EpiBf16<0> E{(bf16_t*)(c.ws + WS_SHOUT), D, nullptr, 0, 0, 1.f};
        pg8::gemm_phase<pg8::EpiBf16<0>, pg8::StaticOrder, true, true>(c.lds, g, S, E);
    }
}

__device__ __forceinline__ void phase16(const Ctx& c) {
    const float* gq = c.in[7]; const float* mods = (const float*)(c.ws + WS_MODS);
    const bf16_t* shout = (const bf16_t*)(c.ws + WS_SHOUT); const unsigned char* yexp = (const unsigned char*)(c.ws + WS_YEXP);
    float* out = c.out; float* dst = c.out;
    const int gw = c.bid * 8 + c.wid, NW = c.G * 8;
    typedef float f32x2s __attribute__((ext_vector_type(2)));
    for (int t = gw; t < T; t += NW) {
        const int b = t / SEQ;
        float y[2][8], x1[2][8]; float ss = 0.f;
        uint2 ye[2][8]; uint4 sh[2]; float4 xv[2][2];
#pragma unroll
        for (int j = 0; j < 2; ++j) {
            const int k = (c.lane + 64 * j) * 8;
            sh[j] = *(const uint4*)(shout + (size_t)t * D + k);
            xv[j][0] = *(const float4*)(out + (size_t)t * D + k); xv[j][1] = *(const float4*)(out + (size_t)t * D + k + 4);
#pragma unroll
            for (int q = 0; q < 8; ++q) ye[j][q] = *(const uint2*)(yexp + (size_t)(t * 8 + q) * D + k);
        }
#pragma unroll
        for (int j = 0; j < 2; ++j) {
            unpack8(sh[j], y[j]);
            x1[j][0] = xv[j][0].x; x1[j][1] = xv[j][0].y; x1[j][2] = xv[j][0].z; x1[j][3] = xv[j][0].w; x1[j][4] = xv[j][1].x; x1[j][5] = xv[j][1].y; x1[j][6] = xv[j][1].z; x1[j][7] = xv[j][1].w;
#pragma unroll
            for (int q = 0; q < 8; ++q) {
                const f32x2s a0 = __builtin_amdgcn_cvt_pk_f32_fp8((int)ye[j][q].x, false), a1 = __builtin_amdgcn_cvt_pk_f32_fp8((int)ye[j][q].x, true);
                const f32x2s a2 = __builtin_amdgcn_cvt_pk_f32_fp8((int)ye[j][q].y, false), a3 = __builtin_amdgcn_cvt_pk_f32_fp8((int)ye[j][q].y, true);
                y[j][0] += a0[0]; y[j][1] += a0[1]; y[j][2] += a1[0]; y[j][3] += a1[1]; y[j][4] += a2[0]; y[j][5] += a2[1]; y[j][6] += a3[0]; y[j][7] += a3[1];
            }
#pragma unroll
            for (int i = 0; i < 8; ++i) ss += y[j][i] * y[j][i];
        }
        const float rstd = rsqrtf(wave_sum_u(ss) * (1.0f / D) + 1e-6f);
#pragma unroll
        for (int j = 0; j < 2; ++j) {
            const int k = (c.lane + 64 * j) * 8;
            const float4 g0 = *(const float4*)(gq + k), g1 = *(const float4*)(gq + k + 4);
            const float4 t0 = *(const float4*)(mods + b * NMODS + 5 * D + k), t1 = *(const float4*)(mods + b * NMODS + 5 * D + k + 4);
            const float gg[8] = {g0.x, g0.y, g0.z, g0.w, g1.x, g1.y, g1.z, g1.w}, gt[8] = {t0.x, t0.y, t0.z, t0.w, t1.x, t1.y, t1.z, t1.w};
            float o[8];
#pragma unroll
            for (int i = 0; i < 8; ++i) o[i] = x1[j][i] + gt[i] * (y[j][i] * rstd * gg[i]);
            *(float4*)(dst + (size_t)t * D + k) = make_float4(o[0], o[1], o[2], o[3]); *(float4*)(dst + (size_t)t * D + k + 4) = make_float4(o[4], o[5], o[6], o[7]);
        }
    }
}

constexpr int NPHASES = 18;
__device__ __forceinline__ void probe_reset(const Ctx& c, int k) {
    unsigned* counts = (unsigned*)(c.ws + WS_COUNTS);
    if (k == 13 && c.bid == 0 && c.tid < 256) counts[c.tid] = 0u;
    if (k == 14 && c.bid == 0 && c.tid < 256) counts[256 + c.tid] = 0u;
}

__global__ void __launch_bounds__(512, 2) mega(Args args) {
    extern __shared__ __attribute__((aligned(16))) unsigned char lds_raw[];
    Ctx c;
    c.in = args.in; c.out = args.out; c.ws = args.ws;
    c.lds = (LAS unsigned char*)lds_raw; c.sm = (float*)lds_raw;
    c.dry = 0;
    c.tid = threadIdx.x; c.lane = c.tid & 63; c.wid = __builtin_amdgcn_readfirstlane(c.tid >> 6); c.bid = blockIdx.x; c.G = gridDim.x;
    volatile LAS unsigned* st = (volatile LAS unsigned*)(c.lds + LDS_CTL_OFF);
    if (c.tid < 4) st[c.tid] = 0u;
    __syncthreads();
    XcdBarrier bar; bar.bar = (unsigned*)(args.ws + WS_CTL); bar.x = 0; bar.st = st;
    const bool multi = (args.hi - args.lo) > 1;
    if (multi) bar = xcd_barrier_post((unsigned*)(args.ws + WS_CTL), st);
    const int lo = args.lo, hi = args.hi;
#ifndef REPEAT_PHASE
#define REPEAT_PHASE -1
#endif
#define LAUNDER() do { int t_ = threadIdx.x; asm volatile("" : "+v"(t_)); c.tid = t_; c.lane = t_ & 63; int b_ = blockIdx.x; asm volatile("" : "+s"(b_)); c.bid = b_; } while (0)
#define RUN_PHASE(k, call) if (lo <= (k) && (k) < hi) { if ((k) == REPEAT_PHASE) { LAUNDER(); c.dry = 1; call; c.dry = 0; xcd_barrier(bar); probe_reset(c, (k)); xcd_barrier(bar); } LAUNDER(); call; if ((k) + 1 < hi) xcd_barrier(bar); }
    RUN_PHASE(0, phase0(c))
    RUN_PHASE(1, phase1(c))
    RUN_PHASE(2, phase2(c))
    RUN_PHASE(3, phase3(c))
    RUN_PHASE(4, phase4(c))
    RUN_PHASE(5, phase5(c))
    RUN_PHASE(6, phase6a(c))
    RUN_PHASE(7, phase6b(c))
    RUN_PHASE(8, phase7(c))
    RUN_PHASE(9, phase8(c))
    RUN_PHASE(10, phase9(c))
    RUN_PHASE(11, phase10(c))
    RUN_PHASE(12, phase11(c))
    RUN_PHASE(13, phase12(c))
    RUN_PHASE(14, phase13(c))
    RUN_PHASE(15, phase14(c))
    RUN_PHASE(16, phase15(c))
    RUN_PHASE(17, phase16(c))
#undef RUN_PHASE
}

#ifndef N_LAUNCH_MODE
#define N_LAUNCH_MODE 1
#endif

extern "C" void kernel_launch(void* const* d_in, const int* in_sizes, int n_in, void* d_out, int out_size, void* d_ws, size_t ws_size, hipStream_t stream) {
    static int grid = 0;
    if (grid == 0) {
        if (n_in != 39 || out_size != T * D || ws_size < WS_END) { fprintf(stderr, "kernel_launch: unexpected shapes n_in %d out %d ws %zu\n", n_in, out_size, ws_size); grid = -1; return; }
        int dev = 0, cus = 0, per_cu = 0;
        if (hipGetDevice(&dev) != hipSuccess || hipDeviceGetAttribute(&cus, hipDeviceAttributeMultiprocessorCount, dev) != hipSuccess) { grid = -1; return; }
        if (hipFuncSetAttribute((const void*)mega, hipFuncAttributeMaxDynamicSharedMemorySize, LDS_BYTES) != hipSuccess) { grid = -1; return; }
        if (hipOccupancyMaxActiveBlocksPerMultiprocessor(&per_cu, (const void*)mega, 512, LDS_BYTES) != hipSuccess || per_cu < 1) { fprintf(stderr, "kernel_launch: occupancy query says %d\n", per_cu); }
        (void)hipGetLastError();
        grid = cus;
    }
    if (grid < 0) return;
    (void)hipMemsetAsync((char*)d_ws + WS_CTL, 0, CTL_BYTES, stream);
    Args a{};
    for (int i = 0; i < 39; ++i) a.in[i] = (const float*)d_in[i];
    a.out = (float*)d_out; a.ws = (unsigned char*)d_ws;
    if (N_LAUNCH_MODE == 1) {
        a.lo = 0; a.hi = NPHASES;
        hipLaunchKernelGGL(mega, dim3(grid), dim3(512), LDS_BYTES, stream, a);
    } else {
        for (int ph = 0; ph < NPHASES; ++ph) {
            a.lo = ph; a.hi = ph + 1;
            hipLaunchKernelGGL(mega, dim3(grid), dim3(512), LDS_BYTES, stream, a);
        }
    }
}
```

```cpp
#include <hip/hip_runtime.h>
#include <cstdint>
#include <cstdio>

#define LAS __attribute__((address_space(3)))

constexpr int D = 1024, BATCH = 4, SEQ = 8192, T = BATCH * SEQ;
constexpr int RW = 512, NH = 8;
constexpr int RPROJ = 1792, NPROJ = 2304;
constexpr int S5NG = 32, S5P = 64;
constexpr int NE = 256, EFF = 256;
constexpr int NMODS = 6 * D;
constexpr int S5L = 32;

constexpr size_t MiB = 1u << 20;
constexpr size_t WS_CTL = 0, CTL_BYTES = 1 * MiB;
constexpr size_t WS_COUNTS = 64 * 1024;
constexpr size_t WS_MODS = 1 * MiB;
constexpr size_t WS_HMAT = 2 * MiB;
constexpr size_t WS_WIN_T = 12 * MiB;
constexpr size_t WS_WOUT_T = 17 * MiB;
constexpr size_t WS_WGLU_T = 19 * MiB;
constexpr size_t WS_WSGU_T = 19 * MiB + 512 * 1024;
constexpr size_t WS_WSD_T = 20 * MiB + 512 * 1024;
constexpr size_t WS_WR_T = 21 * MiB;
constexpr size_t WS_LORA_BT = 22 * MiB;
constexpr size_t WS_APOW = 23 * MiB;
constexpr size_t WS_KMAT = 1000 * MiB;
constexpr size_t WS_MODSP = 1020 * MiB;
constexpr size_t WS_S5BB = 1022 * MiB;
constexpr size_t WS_KLAG = 1022 * MiB + 512 * 1024;
constexpr size_t OUT_UX = 0;
constexpr size_t OUT_E = 40 * MiB;
constexpr size_t OUT_ALORA = 56 * MiB;
constexpr size_t OUT_KF = 72 * MiB;
constexpr size_t WS_WED = 24 * MiB;
constexpr size_t WS_WEGU = 152 * MiB;
constexpr size_t WS_A = 408 * MiB;
constexpr size_t WS_YS5 = WS_A + 64 * MiB;
constexpr size_t WS_PROJ = 536 * MiB;
constexpr size_t WS_RW = 680 * MiB;
constexpr size_t RWSZ = (size_t)T * RW * 4;
constexpr size_t RWSZH = (size_t)T * RW * 2;
constexpr size_t WS_RW_W = WS_RW, WS_RW_Y = WS_RW + RWSZ, WS_RW_R = WS_RW + 2 * RWSZ, WS_RW_K = WS_RW_R + RWSZH, WS_RW_V = WS_RW_K + RWSZH,
                 WS_RW_A = WS_RW_V + RWSZH, WS_RW_B = WS_RW_A + RWSZH, WS_RW_G = WS_RW_B + RWSZH;
constexpr size_t WS_CM = WS_PROJ, WS_CN = WS_PROJ + 32 * MiB, WS_CQ = WS_PROJ + 64 * MiB, WS_CY = WS_PROJ + 96 * MiB;
constexpr size_t WS_CS = WS_RW_Y, WS_CBON = WS_RW_Y + 32 * MiB;
constexpr size_t WS_PLOG = 680 * MiB;
constexpr size_t WS_SHOUT = 680 * MiB;
constexpr size_t WS_HS = 808 * MiB;
constexpr size_t WS_IDX = 824 * MiB;
constexpr size_t WS_WT = 825 * MiB;
constexpr size_t WS_SLOTP = 826 * MiB;
constexpr size_t WS_UEXP = 827 * MiB + 512 * 1024;
constexpr size_t WS_SLOTW = 828 * MiB;
constexpr size_t WS_HIST = 831 * MiB;
constexpr size_t WS_HID = 840 * MiB;
constexpr size_t WS_YEXP = 152 * MiB;
constexpr size_t WS_END = 1023 * MiB + 512 * 1024;

constexpr int LDS_BYTES = 132096;
constexpr int LDS_CTL_OFF = 131072;

#define XB_TMO      128
#define XB_XCNT(j)  (256  + 64 * (j))
#define XB_XSUB(j)  (1280 + 64 * (j))
#define XB_XGEN(j)  (2304 + 64 * (j))
#define XB_TOP      3328
#define XB_TOPGEN   3392
#define XCD_BAR_WORDS 3456
#define XB_SPIN_CAP (1u << 24)

__device__ __forceinline__ unsigned xb_ld(unsigned* p)              { return __hip_atomic_load(p, __ATOMIC_RELAXED, __HIP_MEMORY_SCOPE_AGENT); }
__device__ __forceinline__ unsigned xb_add(unsigned* p, unsigned v) { return __hip_atomic_fetch_add(p, v, __ATOMIC_RELAXED, __HIP_MEMORY_SCOPE_AGENT); }
__device__ __forceinline__ unsigned xb_xcc_id() { return (unsigned)__builtin_amdgcn_s_getreg((3 << 11) | 20) & 0xFu; }
#define XB_SPIN(cond, bar) do { unsigned _sp = 0; while (cond) { __builtin_amdgcn_s_sleep(1); \
    if ((++_sp & 255u) == 0u) { if (xb_ld(&(bar)[XB_TMO])) break; if (_sp > XB_SPIN_CAP) { atomicAdd(&(bar)[XB_TMO], 1u); break; } } } } while (0)

struct XcdBarrier { unsigned* bar; unsigned x; volatile LAS unsigned* st; };

__device__ __forceinline__ XcdBarrier xcd_barrier_post(unsigned* bar, volatile LAS unsigned* st) {
    XcdBarrier b; b.bar = bar; b.x = xb_xcc_id(); b.st = st;
    if (threadIdx.x == 0) (void)xb_add(&bar[XB_XCNT(b.x)], 1u);
    return b;
}
__device__ __forceinline__ void xcd_barrier_complete(unsigned* bar, unsigned x, unsigned& nloc, unsigned& nx) {
    const unsigned G = gridDim.x * gridDim.y * gridDim.z;
    unsigned sum, cnt, mine, sp = 0u;
    for (;;) {
        sum = 0u; cnt = 0u; mine = 0u;
#pragma unroll
        for (unsigned j = 0; j < 16; ++j) { const unsigned c = xb_ld(&bar[XB_XCNT(j)]); sum += c; cnt += (c > 0u) ? 1u : 0u; mine = (j == x) ? c : mine; }
        if (sum == G) break;
        __builtin_amdgcn_s_sleep(1);
        if ((++sp & 255u) == 0u) { if (xb_ld(&bar[XB_TMO])) break; if (sp > XB_SPIN_CAP) { atomicAdd(&bar[XB_TMO], 1u); break; } }
    }
    nloc = mine > 0u ? mine : 1u; nx = cnt > 0u ? cnt : 1u;
}
__device__ __forceinline__ void xcd_barrier(const XcdBarrier& b) {
    asm volatile("s_waitcnt vmcnt(0)" ::: "memory");
    __syncthreads();
    if (threadIdx.x == 0) {
        unsigned* bar = b.bar;
        __builtin_amdgcn_s_waitcnt(0);
        unsigned nloc = b.st[0], nx = b.st[1];
        if (nloc == 0u) { xcd_barrier_complete(bar, b.x, nloc, nx); b.st[0] = nloc; b.st[1] = nx; }
        const unsigned old = xb_add(&bar[XB_XSUB(b.x)], 1u);
        const unsigned gen = old / nloc;
        if (old + 1u == (gen + 1u) * nloc) {
            __builtin_amdgcn_fence(__ATOMIC_RELEASE, "agent");
            asm volatile("s_waitcnt vmcnt(0)" ::: "memory");
            const unsigned og = xb_add(&bar[XB_TOP], 1u);
            const unsigned tg = og / nx;
            if (og + 1u == (tg + 1u) * nx) xb_add(&bar[XB_TOPGEN], 1u);
            else XB_SPIN(xb_ld(&bar[XB_TOPGEN]) == tg, bar);
            __builtin_amdgcn_fence(__ATOMIC_ACQUIRE, "agent");
            xb_add(&bar[XB_XGEN(b.x)], 1u);
            asm volatile("s_waitcnt vmcnt(0)" ::: "memory");
        } else {
            XB_SPIN(xb_ld(&bar[XB_XGEN(b.x)]) == gen, bar);
            __builtin_amdgcn_fence(__ATOMIC_ACQUIRE, "agent");
            asm volatile("s_waitcnt vmcnt(0)" ::: "memory");
        }
    }
    __syncthreads();
}

namespace pg8 {
#define PG8_LAS __attribute__((address_space(3)))
typedef unsigned short bf16_t;
typedef short bf16x8 __attribute__((ext_vector_type(8)));
typedef float f32x4 __attribute__((ext_vector_type(4)));
typedef unsigned u32x4 __attribute__((ext_vector_type(4)));
constexpr int BM = 256, BK = 64, HALF = 128, HTB = HALF * BK * 2  , STAGE_BYTES = 8 * HTB, NXCD = 8, WGM = 8;

__host__ __device__ __forceinline__ int lds_byte(int r, int c) { const int st = (r >> 4) * 2 + (c >> 5), rr = r & 15, cc = c & 31, ob = rr * 64 + cc * 2; return st * 1024 + (ob ^ (((ob >> 9) & 1) << 5)); }
__host__ __device__ __forceinline__ void stage_rc(int b, int& R, int& C) { const int st = b / 1024, sb = b % 1024, swz = sb ^ (((sb >> 9) & 1) << 5); R = (st >> 1) * 16 + swz / 64; C = (st & 1) * 32 + (swz % 64) / 2; }
__host__ __device__ __forceinline__ int perm32(int rho) { const int n = rho >> 4, i = rho & 15; return 8 * (i >> 2) + 4 * n + (i & 3); }

struct Unit { int pm, pn; };
struct Gemm { const bf16_t* A; const bf16_t* Bt; int M, N, K; const int* rowtab = nullptr; };

struct StaticOrder {
    int nM, nN, nwg, G, c;
    __host__ __device__ void init(int M, int N, int G_, int c_) { nM = M / BM; nN = N / BM; nwg = nM * nN; G = G_; c = c_; }
    __host__ __device__ bool next(int i, Unit& u) const {
        const long L = (long)i * G + c; if (L >= nwg) return false;
        int wgid = (int)L; { const int q = nwg / NXCD, r = nwg % NXCD, xcd = wgid % NXCD, off = wgid / NXCD; wgid = (xcd < r ? xcd * (q + 1) : r * (q + 1) + (xcd - r) * q) + off; }
        const int nig = WGM * nN, gid = wgid / nig, fm = gid * WGM, gsz = (nM - fm) < WGM ? (nM - fm) : WGM;
        u.pm = fm + ((wgid % nig) % gsz); u.pn = (wgid % nig) / gsz; return true;
    }
    __device__ __forceinline__ void a_ready(const Unit&) const {}
    __device__ __forceinline__ void done(const Unit&) const {}
};

__device__ __forceinline__ unsigned cvt_pk_bf16(float lo, float hi) { unsigned r; asm volatile("v_cvt_pk_bf16_f32 %0, %1, %2" : "=v"(r) : "v"(lo), "v"(hi)); return r; }
typedef float f32x2 __attribute__((ext_vector_type(2)));
__device__ __forceinline__ f32x2 gelu_pk(f32x2 v) {
    const f32x2 av = __builtin_elementwise_abs(v), d = av * 0.2316418882f + 1.0f;
    f32x2 t; t.x = __builtin_amdgcn_rcpf(d.x); t.y = __builtin_amdgcn_rcpf(d.y);
    f32x2 q = t * 0.5307027145f + (-0.7265760135f); q = q * t + 0.7107068705f; q = q * t + (-0.142248368f); q = q * t + 0.127414796f; q = q * t;
    const f32x2 s = (v * v) * (-0.72134752044f);
    f32x2 e; e.x = __builtin_amdgcn_exp2f(s.x); e.y = __builtin_amdgcn_exp2f(s.y);
    const f32x2 m = v * (q * e), r = v - m;
    f32x2 o; o.x = v.x < 0.f ? m.x : r.x; o.y = v.y < 0.f ? m.y : r.y; return o;
}

template <int ACT  > struct EpiBf16 {
    static constexpr bool PERM = true, AFTER_DRAIN = false; static_assert(ACT == 0 || ACT == 1, "EpiBf16: ACT is 0 (none) or 1 (gelu_pk)");
    bf16_t* O; int ldc; const float* bias; int split_cols; size_t split_stride; float scale0;
    __device__ __forceinline__ void operator()(const f32x4 (&acc)[2][2][4][2], const Unit& u, int wr, int wc, int fr, int fq) const {
        const int row0 = u.pm * BM + wr * 64 + fr; int colt = u.pn * BM; bf16_t* base = O;
        float sc = 1.f; if (split_cols) { const int t = colt / split_cols; base += (size_t)t * split_stride; colt -= t * split_cols; if (t == 0) sc = scale0; }
        const int col0 = colt + wc * 32 + 8 * fq, bcol0 = u.pn * BM + wc * 32 + 8 * fq;
        f32x4 bv[2][2];
#pragma unroll
        for (int bj = 0; bj < 2; ++bj)
#pragma unroll
            for (int n = 0; n < 2; ++n) bv[bj][n] = bias ? *(const f32x4*)(bias + bcol0 + bj * HALF + 4 * n) : (f32x4){0.f, 0.f, 0.f, 0.f};
#pragma unroll
        for (int ai = 0; ai < 2; ++ai)
#pragma unroll
            for (int m = 0; m < 4; ++m) { bf16_t* rowp = base + (size_t)(row0 + ai * HALF + m * 16) * ldc + col0;
#pragma unroll
                for (int bj = 0; bj < 2; ++bj) { f32x4 v0 = acc[ai][bj][m][0] + bv[bj][0], v1 = acc[ai][bj][m][1] + bv[bj][1];
                    if (ACT == 1) { f32x2 a = gelu_pk((f32x2){v0[0], v0[1]}), b = gelu_pk((f32x2){v0[2], v0[3]}), c = gelu_pk((f32x2){v1[0], v1[1]}), d = gelu_pk((f32x2){v1[2], v1[3]});
                        v0 = (f32x4){a.x, a.y, b.x, b.y}; v1 = (f32x4){c.x, c.y, d.x, d.y}; }
                    v0 = v0 * sc; v1 = v1 * sc; u32x4 w; w.x = cvt_pk_bf16(v0[0], v0[1]); w.y = cvt_pk_bf16(v0[2], v0[3]); w.z = cvt_pk_bf16(v1[0], v1[1]); w.w = cvt_pk_bf16(v1[2], v1[3]);
                    *(u32x4*)(rowp + bj * HALF) = w; } }
    }
};

struct EpiF32 {
    static constexpr bool PERM = false, AFTER_DRAIN = false;
    float* C; int ldc;
    __device__ __forceinline__ void operator()(const f32x4 (&acc)[2][2][4][2], const Unit& u, int wr, int wc, int fr, int fq) const {
        const int row0 = u.pm * BM + wr * 64 + fr, col0 = u.pn * BM + wc * 32 + 4 * fq;
#pragma unroll
        for (int ai = 0; ai < 2; ++ai)
#pragma unroll
            for (int m = 0; m < 4; ++m) { float* rowp = C + (size_t)(row0 + ai * HALF + m * 16) * ldc + col0;
#pragma unroll
                for (int bj = 0; bj < 2; ++bj)
#pragma unroll
                    for (int n = 0; n < 2; ++n) *(f32x4*)(rowp + bj * HALF + n * 16) = acc[ai][bj][m][n]; }
    }
};
__device__ __forceinline__ float fast_sigmoid(float x) { return __builtin_amdgcn_rcpf(1.0f + __builtin_amdgcn_exp2f(-1.4426950408889634f * x)); }
struct EpiSwiGLU {
    static constexpr bool PERM = true, AFTER_DRAIN = false;
    bf16_t* O; int ldo;
    __device__ __forceinline__ void operator()(const f32x4 (&acc)[2][2][4][2], const Unit& u, int wr, int wc, int fr, int fq) const {
        const int row0 = u.pm * BM + wr * 64 + fr, col0 = (u.pn & 1) * HALF + wc * 32 + 8 * fq;
#pragma unroll
        for (int ai = 0; ai < 2; ++ai)
#pragma unroll
            for (int m = 0; m < 4; ++m) {
                bf16_t* rowp = O + (size_t)(row0 + ai * HALF + m * 16) * ldo + col0;
                const f32x4 g0 = acc[ai][0][m][0], g1 = acc[ai][0][m][1], u0 = acc[ai][1][m][0], u1 = acc[ai][1][m][1];
                float r[8];
#pragma unroll
                for (int i = 0; i < 4; ++i) { r[i] = g0[i] * fast_sigmoid(g0[i]) * u0[i]; r[4 + i] = g1[i] * fast_sigmoid(g1[i]) * u1[i]; }
                u32x4 w; w.x = cvt_pk_bf16(r[0], r[1]); w.y = cvt_pk_bf16(r[2], r[3]); w.z = cvt_pk_bf16(r[4], r[5]); w.w = cvt_pk_bf16(r[6], r[7]);
                *(u32x4*)rowp = w;
            }
    }
};
struct EpiScatter {
    static constexpr bool PERM = true, AFTER_DRAIN = false;
    const int* slotw; bf16_t* Y; int ldy;
    __device__ __forceinline__ void operator()(const f32x4 (&acc)[2][2][4][2], const Unit& u, int wr, int wc, int fr, int fq) const {
        int t2 = threadIdx.x; asm volatile("" : "+v"(t2));
        const int fr2 = t2 & 15, fq2 = (t2 >> 4) & 3, wc2 = (t2 >> 6) & 3, wr2 = (t2 >> 8) & 1;
        const int col0 = (u.pn & 3) * BM + wc2 * 32 + 8 * fq2;
        const int rbase = u.pm * BM + wr2 * 64 + fr2;
        typedef int i32x2 __attribute__((ext_vector_type(2)));
        i32x2 rec[2][4];
#pragma unroll
        for (int ai = 0; ai < 2; ++ai)
#pragma unroll
            for (int m = 0; m < 4; ++m) rec[ai][m] = *(const i32x2*)(slotw + 2 * (size_t)(rbase + ai * HALF + m * 16));
#pragma unroll
        for (int ai = 0; ai < 2; ++ai)
#pragma unroll
            for (int m = 0; m < 4; ++m) {
                const int aid = rec[ai][m].x;
                if (aid >= 0) {
                    const int wbits = rec[ai][m].y;
                    const float w = __int_as_float(wbits);
                    unsigned char* rowp = (unsigned char*)Y + (size_t)aid * ldy + col0;
#pragma unroll
                    for (int bj = 0; bj < 2; ++bj) {
                        f32x4 v0 = acc[ai][bj][m][0] * w, v1 = acc[ai][bj][m][1] * w;
#pragma unroll
                        for (int i = 0; i < 4; ++i) { v0[i] = __builtin_amdgcn_fmed3f(v0[i], -448.0f, 448.0f); v1[i] = __builtin_amdgcn_fmed3f(v1[i], -448.0f, 448.0f); }
                        int lo = 0, hi = 0;
                        lo = __builtin_amdgcn_cvt_pk_fp8_f32(v0[0], v0[1], lo, false); lo = __builtin_amdgcn_cvt_pk_fp8_f32(v0[2], v0[3], lo, true);
                        hi = __builtin_amdgcn_cvt_pk_fp8_f32(v1[0], v1[1], hi, false); hi = __builtin_amdgcn_cvt_pk_fp8_f32(v1[2], v1[3], hi, true);
                        typedef int i32x2s __attribute__((ext_vector_type(2)));
                        *(i32x2s*)(rowp + bj * HALF) = (i32x2s){lo, hi};
                    }
                }
            }
    }
};
struct ExpertOrder {
    const int* uexp; int NU, npn, G, c;
    __device__ __forceinline__ bool next(int i, Unit& u) const {
        const int L = i * G + c; if (L >= NU * npn) return false;
        const int uu = L / npn, pl = L % npn;
        u.pm = uu; u.pn = __builtin_amdgcn_readfirstlane(uexp[uu]) * npn + pl; return true;
    }
    __device__ __forceinline__ void a_ready(const Unit&) const {}
    __device__ __forceinline__ void done(const Unit&) const {}
};
struct EpiRouter {
    static constexpr bool PERM = true, AFTER_DRAIN = false;
    float* P0; bf16_t* P1; bf16_t* P2; int TP;
    __device__ __forceinline__ void operator()(const f32x4 (&acc)[2][2][4][2], const Unit& u, int wr, int wc, int fr, int fq) const {
        const bool lo_rows = u.pm >= TP; const int pmr = lo_rows ? u.pm - TP : u.pm;
        if (lo_rows && u.pn == 1) return;
        const int row0 = pmr * BM + wr * 64 + fr, col0 = wc * 32 + 8 * fq;
#pragma unroll
        for (int ai = 0; ai < 2; ++ai)
#pragma unroll
            for (int m = 0; m < 4; ++m) {
                const size_t off = (size_t)(row0 + ai * HALF + m * 16) * 256 + col0;
#pragma unroll
                for (int bj = 0; bj < 2; ++bj) {
                    const f32x4 v0 = acc[ai][bj][m][0], v1 = acc[ai][bj][m][1];
                    if (!lo_rows && u.pn == 0) { *(f32x4*)(P0 + off + bj * HALF) = v0; *(f32x4*)(P0 + off + bj * HALF + 4) = v1; }
                    else { u32x4 w; w.x = cvt_pk_bf16(v0[0], v0[1]); w.y = cvt_pk_bf16(v0[2], v0[3]); w.z = cvt_pk_bf16(v1[0], v1[1]); w.w = cvt_pk_bf16(v1[2], v1[3]);
                           *(u32x4*)((lo_rows ? P2 : P1) + off + bj * HALF) = w; }
                }
            }
    }
};
struct S5Order {
    int NUNITS, npn, G, c;
    __device__ __forceinline__ bool next(int i, Unit& u) const {
        const int L = i * G + c; if (L >= NUNITS) return false;
        u.pm = L / npn; u.pn = (u.pm >> 2) * npn + L % npn; return true;
    }
    __device__ __forceinline__ void a_ready(const Unit&) const {}
    __device__ __forceinline__ void done(const Unit&) const {}
};
struct EpiS5E {
    static constexpr bool PERM = false, AFTER_DRAIN = false;
    float* E;
    __device__ __forceinline__ void operator()(const f32x4 (&acc)[2][2][4][2], const Unit& u, int wr, int wc, int fr, int fq) const {
        const int row0 = u.pm * BM + wr * 64 + fr, col0 = wc * 32 + 4 * fq;
#pragma unroll
        for (int ai = 0; ai < 2; ++ai)
#pragma unroll
            for (int m = 0; m < 4; ++m) { float* rowp = E + (size_t)(row0 + ai * HALF + m * 16) * 128 + col0;
#pragma unroll
                for (int n = 0; n < 2; ++n) *(f32x4*)(rowp + n * 16) = acc[ai][0][m][n]; }
    }
};
struct EpiS5Out {
    static constexpr bool PERM = true, AFTER_DRAIN = false;
    bf16_t* Y;
    __device__ __forceinline__ void operator()(const f32x4 (&acc)[2][2][4][2], const Unit& u, int wr, int wc, int fr, int fq) const {
        const int g = u.pm >> 2;
#pragma unroll
        for (int ai = 0; ai < 2; ++ai)
#pragma unroll
            for (int m = 0; m < 4; ++m) {
                const int r = (u.pm & 3) * BM + ai * HALF + wr * 64 + m * 16 + fr, b = r >> 8, chunk = r & 255;
#pragma unroll
                for (int bj = 0; bj < 2; ++bj) {
                    const int colg = (u.pn & 1) * BM + bj * HALF + wc * 32 + 8 * fq, t = colg >> 4, c0 = colg & 15;
                    const f32x4 v0 = acc[ai][bj][m][0], v1 = acc[ai][bj][m][1];
                    float x[8] = {v0[0], v0[1], v0[2], v0[3], v1[0], v1[1], v1[2], v1[3]};
#pragma unroll
                    for (int i = 0; i < 8; ++i) { const float z = x[i]; x[i] = z * fast_sigmoid(1.5957691216057308f * (z + 0.044715f * z * z * z)); }
                    u32x4 w; w.x = cvt_pk_bf16(x[0], x[1]); w.y = cvt_pk_bf16(x[2], x[3]); w.z = cvt_pk_bf16(x[4], x[5]); w.w = cvt_pk_bf16(x[6], x[7]);
                    *(u32x4*)(Y + ((size_t)(b * 8192 + chunk * 32 + t)) * 512 + g * 16 + c0) = w;
                }
            }
    }
};
struct EpiLora {
    static constexpr bool PERM = true, AFTER_DRAIN = false;
    const float* w0; const float* a0; const float* k_a; float* W; const bf16_t* Kp; bf16_t* Kf; const bf16_t* A; bf16_t* B; bf16_t* Gt;
    __device__ __forceinline__ void operator()(const f32x4 (&acc)[2][2][4][2], const Unit& u, int wr, int wc, int fr, int fq) const {
        const int seg = u.pn >> 1;
#pragma unroll
        for (int bj = 0; bj < 2; ++bj) {
            const int nn = (u.pn & 1) * BM + bj * HALF + wc * 32 + 8 * fq;
            float p0[8], p1[8];
            if (seg == 0) { const f32x4 a = *(const f32x4*)(w0 + nn), b = *(const f32x4*)(w0 + nn + 4); p0[0] = a[0]; p0[1] = a[1]; p0[2] = a[2]; p0[3] = a[3]; p0[4] = b[0]; p0[5] = b[1]; p0[6] = b[2]; p0[7] = b[3]; }
            else if (seg == 1) { const f32x4 a = *(const f32x4*)(a0 + nn), b = *(const f32x4*)(a0 + nn + 4), cc = *(const f32x4*)(k_a + nn), d = *(const f32x4*)(k_a + nn + 4);
                p0[0] = a[0]; p0[1] = a[1]; p0[2] = a[2]; p0[3] = a[3]; p0[4] = b[0]; p0[5] = b[1]; p0[6] = b[2]; p0[7] = b[3];
                p1[0] = cc[0]; p1[1] = cc[1]; p1[2] = cc[2]; p1[3] = cc[3]; p1[4] = d[0]; p1[5] = d[1]; p1[6] = d[2]; p1[7] = d[3]; }
#pragma unroll
            for (int ai = 0; ai < 2; ++ai)
#pragma unroll
                for (int m = 0; m < 4; ++m) {
                    const size_t off = (size_t)(u.pm * BM + ai * HALF + wr * 64 + m * 16 + fr) * 512 + nn;
                    const f32x4 v0 = acc[ai][bj][m][0], v1 = acc[ai][bj][m][1];
                    const float x[8] = {v0[0], v0[1], v0[2], v0[3], v1[0], v1[1], v1[2], v1[3]};
                    if (seg == 0) {
                        float o[8];
#pragma unroll
                        for (int i = 0; i < 8; ++i) { const float wa = p0[i] + x[i];
                            o[i] = __builtin_amdgcn_exp2f(-0.8750387749145276f * fast_sigmoid(wa)); }
                        *(f32x4*)(W + off) = (f32x4){o[0], o[1], o[2], o[3]}; *(f32x4*)(W + off + 4) = (f32x4){o[4], o[5], o[6], o[7]};
                    } else if (seg == 1) {
                        const u32x4 kv = *(const u32x4*)(Kp + off), av = *(const u32x4*)(A + off);
                        const float k[8] = {__builtin_bit_cast(float, kv.x << 16), __builtin_bit_cast(float, kv.x & 0xffff0000u), __builtin_bit_cast(float, kv.y << 16), __builtin_bit_cast(float, kv.y & 0xffff0000u),
                                            __builtin_bit_cast(float, kv.z << 16), __builtin_bit_cast(float, kv.z & 0xffff0000u), __builtin_bit_cast(float, kv.w << 16), __builtin_bit_cast(float, kv.w & 0xffff0000u)};
                        const float a[8] = {__builtin_bit_cast(float, av.x << 16), __builtin_bit_cast(float, av.x & 0xffff0000u), __builtin_bit_cast(float, av.y << 16), __builtin_bit_cast(float, av.y & 0xffff0000u),
                                            __builtin_bit_cast(float, av.z << 16), __builtin_bit_cast(float, av.z & 0xffff0000u), __builtin_bit_cast(float, av.w << 16), __builtin_bit_cast(float, av.w & 0xffff0000u)};
                        float kf[8], bo[8];
#pragma unroll
                        for (int i = 0; i < 8; ++i) { const float ic = fast_sigmoid(p0[i] + x[i]); kf[i] = k[i] * (1.0f + (ic - 1.0f) * p1[i]); bo[i] = -a[i] * ic; }
                        u32x4 w; w.x = cvt_pk_bf16(kf[0], kf[1]); w.y = cvt_pk_bf16(kf[2], kf[3]); w.z = cvt_pk_bf16(kf[4], kf[5]); w.w = cvt_pk_bf16(kf[6], kf[7]);
                        *(u32x4*)(Kf + off) = w;
                        w.x = cvt_pk_bf16(bo[0], bo[1]); w.y = cvt_pk_bf16(bo[2], bo[3]); w.z = cvt_pk_bf16(bo[4], bo[5]); w.w = cvt_pk_bf16(bo[6], bo[7]);
                        *(u32x4*)(B + off) = w;
                    } else {
                        u32x4 w; w.x = cvt_pk_bf16(x[0], x[1]); w.y = cvt_pk_bf16(x[2], x[3]); w.z = cvt_pk_bf16(x[4], x[5]); w.w = cvt_pk_bf16(x[6], x[7]);
                        *(u32x4*)(Gt + off) = w;
                    }
                }
        }
    }
};
struct EpiGLU {
    static constexpr bool PERM = true, AFTER_DRAIN = false;
    const bf16_t* Y; int ldy; const float* bias; bf16_t* O; int ldo; int ocol0;
    __device__ __forceinline__ void operator()(const f32x4 (&acc)[2][2][4][2], const Unit& u, int wr, int wc, int fr, int fq) const {
        const int row0 = u.pm * BM + wr * 64 + fr, col0 = u.pn * BM + wc * 32 + 8 * fq;
#pragma unroll
        for (int bj = 0; bj < 2; ++bj) {
            const f32x4 b0 = *(const f32x4*)(bias + col0 + bj * HALF), b1 = *(const f32x4*)(bias + col0 + bj * HALF + 4);
#pragma unroll
            for (int ai = 0; ai < 2; ++ai)
#pragma unroll
                for (int m = 0; m < 4; ++m) {
                    const size_t row = (size_t)(row0 + ai * HALF + m * 16);
                    const u32x4 yv = *(const u32x4*)(Y + row * ldy + col0 + bj * HALF);
                    const f32x4 z0 = acc[ai][bj][m][0] + b0, z1 = acc[ai][bj][m][1] + b1;
                    float y[8] = {__builtin_bit_cast(float, yv.x << 16), __builtin_bit_cast(float, yv.x & 0xffff0000u), __builtin_bit_cast(float, yv.y << 16), __builtin_bit_cast(float, yv.y & 0xffff0000u),
                                  __builtin_bit_cast(float, yv.z << 16), __builtin_bit_cast(float, yv.z & 0xffff0000u), __builtin_bit_cast(float, yv.w << 16), __builtin_bit_cast(float, yv.w & 0xffff0000u)};
                    float r[8];
#pragma unroll
                    for (int i = 0; i < 4; ++i) { r[i] = y[i] * fast_sigmoid(z0[i]); r[4 + i] = y[4 + i] * fast_sigmoid(z1[i]); }
                    u32x4 w; w.x = cvt_pk_bf16(r[0], r[1]); w.y = cvt_pk_bf16(r[2], r[3]); w.z = cvt_pk_bf16(r[4], r[5]); w.w = cvt_pk_bf16(r[6], r[7]);
                    *(u32x4*)(O + row * ldo + ocol0 + col0 + bj * HALF) = w;
                }
        }
    }
};
template <class Epi, class Sched, bool ALIGN_EPI = false, bool SP2 = false, bool GATHER = false>
__device__ __forceinline__ void gemm_phase(PG8_LAS unsigned char* lds, const Gemm g, const Sched& S, const Epi& E) {
    int tid_ = threadIdx.x; asm volatile("" : "+v"(tid_));
    const int tid = tid_, wid = __builtin_amdgcn_readfirstlane(tid >> 6), lane = tid & 63, wr = wid >> 2, wc = wid & 3, fr = lane & 15, fq = lane >> 4;
    const int K = g.K, nt = K / BK;
    unsigned voffA[2], voffB[2];
#pragma unroll
    for (int i = 0; i < 2; ++i) { int R, C; stage_rc(tid * 16 + i * 8192, R, C); const int Rb = Epi::PERM ? ((R & ~31) + perm32(R & 31)) : R;
        voffA[i] = (unsigned)(R * K + C) * 2u; voffB[i] = (unsigned)(Rb * K + C) * 2u; }
    const size_t kstep = (size_t)(BK * 2);
    const size_t hstep = (size_t)HALF * K * 2;
    const size_t tstep = 2 * hstep;
    const unsigned ldsw = (unsigned)wid * 1024u;
    const int aoff = lds_byte(wr * 64 + fr, fq * 8), boff = lds_byte(wc * 32 + fr, fq * 8);
#define PG8_SA(b, h) (((b) * 2 + (h)) * HTB)
#define PG8_SB(b, h) ((4 + (b) * 2 + (h)) * HTB)
#define PG8_STAGE(bufoff, gbase, voff) do { _Pragma("unroll") for (int _i = 0; _i < 2; ++_i) \
        __builtin_amdgcn_global_load_lds((const unsigned*)((const char*)(gbase) + (voff)[_i]), (PG8_LAS unsigned*)(lds + (bufoff) + ldsw + _i * 8192), 16, 0, 0); } while (0)
#define PG8_STAGE_A(bufoff, kptr, h, NEXTSEL) do { if constexpr (GATHER) { const unsigned _p = (NEXTSEL) ? gnxt[h] : gcur[h]; const unsigned _v[2] = { (_p & 0xffffu) * (unsigned)(2 * K) + gC2, (_p >> 16) * (unsigned)(2 * K) + gC2 }; PG8_STAGE(bufoff, kptr, _v); } \
        else { PG8_STAGE(bufoff, (kptr) + (h) * hstep, voffA); } } while (0)
#define PG8_LDA(dst, b, h) do { _Pragma("unroll") for (int m = 0; m < 4; ++m) _Pragma("unroll") for (int k = 0; k < 2; ++k) dst[m][k] = *(const PG8_LAS bf16x8*)(lds + PG8_SA(b, h) + aoff + m * 2048 + k * 1024); } while (0)
#define PG8_LDB(dst, b, h) do { _Pragma("unroll") for (int n = 0; n < 2; ++n) _Pragma("unroll") for (int k = 0; k < 2; ++k) dst[n][k] = *(const PG8_LAS bf16x8*)(lds + PG8_SB(b, h) + boff + n * 2048 + k * 1024); } while (0)
#define PG8_MMA(ai, bj, At, Bt) do { __builtin_amdgcn_s_setprio(1); _Pragma("unroll") for (int m = 0; m < 4; ++m) _Pragma("unroll") for (int n = 0; n < 2; ++n) _Pragma("unroll") for (int k = 0; k < 2; ++k) \
        acc[ai][bj][m][n] = __builtin_amdgcn_mfma_f32_16x16x32_bf16(Bt[n][k], At[m][k], acc[ai][bj][m][n], 0, 0, 0); __builtin_amdgcn_s_setprio(0); } while (0)
#define PG8_WAIT_V(n) asm volatile("s_waitcnt vmcnt(" #n ")" ::: "memory")
#define PG8_WAIT_L(n) asm volatile("s_waitcnt lgkmcnt(" #n ")" ::: "memory")
#define PG8_BAR __builtin_amdgcn_s_barrier()
#define PG8_SCHED __builtin_amdgcn_sched_barrier(0)
    unsigned gcur[2], gnxt[2], gC2 = 0;
    if constexpr (GATHER) { int R, C; stage_rc(tid * 16, R, C); gC2 = (unsigned)C * 2u; }
    auto load_gather = [&](int pm, unsigned (&dst)[2]) {
        int R, C; stage_rc(tid * 16, R, C);
#pragma unroll
        for (int h = 0; h < 2; ++h) { int a0 = g.rowtab[pm * BM + h * HALF + R], a1 = g.rowtab[pm * BM + h * HALF + R + 64]; a0 = a0 < 0 ? 0 : a0; a1 = a1 < 0 ? 0 : a1; dst[h] = (unsigned)(a0 >> 3) | ((unsigned)(a1 >> 3) << 16); }
    };
    Unit cur, nxt; int ui = 0;
    if (!S.next(0, cur)) return;
    f32x4 acc[2][2][4][2];
#pragma unroll
    for (int a = 0; a < 2; ++a)
#pragma unroll
        for (int b = 0; b < 2; ++b)
#pragma unroll
            for (int m = 0; m < 4; ++m)
#pragma unroll
                for (int n = 0; n < 2; ++n) acc[a][b][m][n] = (f32x4){0.f, 0.f, 0.f, 0.f};
    bf16x8 At[4][2], B0[2][2], B1[2][2];
    const char* cA = (const char*)g.A + (GATHER ? (size_t)0 : (size_t)cur.pm * tstep); const char* cB = (const char*)g.Bt + (size_t)cur.pn * tstep;
    if constexpr (GATHER) { load_gather(cur.pm, gcur); }
    S.a_ready(cur);
    if constexpr (SP2) {
        PG8_STAGE(PG8_SB(0, 0), cB, voffB); PG8_STAGE(PG8_SB(0, 1), cB + hstep, voffB); PG8_STAGE_A(PG8_SA(0, 0), cA, 0, false); PG8_STAGE_A(PG8_SA(0, 1), cA, 1, false);
        if (wr == 1) PG8_BAR;
        PG8_WAIT_V(2); PG8_BAR;
        PG8_STAGE(PG8_SB(1, 0), cB + kstep, voffB); PG8_STAGE_A(PG8_SA(1, 0), cA + kstep, 0, false); PG8_STAGE(PG8_SB(1, 1), cB + hstep + kstep, voffB);
        PG8_WAIT_V(6); PG8_BAR;
    } else {
        PG8_STAGE(PG8_SB(0, 0), cB, voffB); PG8_STAGE_A(PG8_SA(0, 0), cA, 0, false); PG8_STAGE(PG8_SB(0, 1), cB + hstep, voffB); PG8_STAGE_A(PG8_SA(0, 1), cA, 1, false);
        if (wr == 1) PG8_BAR;
        PG8_WAIT_V(4); PG8_BAR;
        PG8_STAGE(PG8_SB(1, 0), cB + kstep, voffB); PG8_STAGE_A(PG8_SA(1, 0), cA + kstep, 0, false); PG8_STAGE(PG8_SB(1, 1), cB + hstep + kstep, voffB);
        PG8_WAIT_V(6); PG8_BAR;
    }
    for (;;) {
        const bool has_next = S.next(ui + 1, nxt);
        const char* nA = (has_next && !GATHER) ? (const char*)g.A + (size_t)nxt.pm * tstep : cA; const char* nB = has_next ? (const char*)g.Bt + (size_t)nxt.pn * tstep : cB;
        if constexpr (GATHER) { if (has_next) load_gather(nxt.pm, gnxt); else {
#pragma unroll
            for (int h = 0; h < 2; ++h) { gnxt[h] = gcur[h]; } } }
        for (int t = 0; t < nt; t += 2) {
            const bool last = (t == nt - 2);
            const char* a1 = cA + (size_t)(t + 1) * kstep;
            const char* a2 = last ? nA : cA + (size_t)(t + 2) * kstep; const char* b2 = last ? nB : cB + (size_t)(t + 2) * kstep;
            const char* a3 = a2 + kstep; const char* b3 = b2 + kstep;
            if (last && has_next) S.a_ready(nxt);
            if constexpr (SP2) {
            PG8_LDB(B0, 0, 0); PG8_LDB(B1, 0, 1); PG8_SCHED; PG8_LDA(At, 0, 0); PG8_STAGE_A(PG8_SA(1, 1), a1, 1, false);
            PG8_WAIT_V(8); PG8_WAIT_L(0); PG8_BAR; PG8_MMA(0, 0, At, B0); PG8_MMA(0, 1, At, B1); PG8_BAR; PG8_SCHED;
            PG8_LDA(At, 0, 1); PG8_STAGE(PG8_SB(0, 0), b2, voffB); PG8_STAGE(PG8_SB(0, 1), b2 + hstep, voffB); PG8_STAGE_A(PG8_SA(0, 0), a2, 0, last);
            PG8_WAIT_V(8); PG8_WAIT_L(0); PG8_BAR; PG8_MMA(1, 0, At, B0); PG8_MMA(1, 1, At, B1); PG8_BAR; PG8_SCHED;
            PG8_LDB(B0, 1, 0); PG8_LDB(B1, 1, 1); PG8_SCHED; PG8_LDA(At, 1, 0); PG8_STAGE_A(PG8_SA(0, 1), a2, 1, last);
            PG8_WAIT_V(8); PG8_WAIT_L(0); PG8_BAR; PG8_MMA(0, 0, At, B0); PG8_MMA(0, 1, At, B1); PG8_BAR; PG8_SCHED;
            PG8_LDA(At, 1, 1); PG8_STAGE(PG8_SB(1, 0), b3, voffB); PG8_STAGE(PG8_SB(1, 1), b3 + hstep, voffB); PG8_STAGE_A(PG8_SA(1, 0), a3, 0, last);
            PG8_WAIT_V(8); PG8_WAIT_L(0); PG8_BAR; PG8_MMA(1, 0, At, B0); PG8_MMA(1, 1, At, B1); PG8_BAR; PG8_SCHED;
            } else {
            PG8_LDB(B0, 0, 0); PG8_SCHED; PG8_LDA(At, 0, 0); PG8_STAGE_A(PG8_SA(1, 1), a1, 1, false);
            PG8_WAIT_L(8); PG8_BAR; PG8_WAIT_L(0); PG8_MMA(0, 0, At, B0); PG8_BAR; PG8_SCHED;
            PG8_LDB(B1, 0, 1); PG8_STAGE(PG8_SB(0, 0), b2, voffB);
            PG8_BAR; PG8_WAIT_L(0); PG8_MMA(0, 1, At, B1); PG8_BAR;
            PG8_LDA(At, 0, 1); PG8_STAGE_A(PG8_SA(0, 0), a2, 0, last);
            PG8_BAR; PG8_WAIT_L(0); PG8_MMA(1, 0, At, B0); PG8_BAR; PG8_SCHED;
            PG8_STAGE(PG8_SB(0, 1), b2 + hstep, voffB);
            PG8_WAIT_V(6); PG8_BAR; PG8_MMA(1, 1, At, B1); PG8_BAR;
            PG8_LDB(B0, 1, 0); PG8_SCHED; PG8_LDA(At, 1, 0); PG8_STAGE_A(PG8_SA(0, 1), a2, 1, last);
            PG8_WAIT_L(8); PG8_BAR; PG8_WAIT_L(0); PG8_MMA(0, 0, At, B0); PG8_BAR; PG8_SCHED;
            PG8_LDB(B1, 1, 1); PG8_STAGE(PG8_SB(1, 0), b3, voffB);
            PG8_BAR; PG8_WAIT_L(0); PG8_MMA(0, 1, At, B1); PG8_BAR;
            PG8_LDA(At, 1, 1); PG8_STAGE_A(PG8_SA(1, 0), a3, 0, last);
            PG8_BAR; PG8_WAIT_L(0); PG8_MMA(1, 0, At, B0); PG8_BAR; PG8_SCHED;
            PG8_STAGE(PG8_SB(1, 1), b3 + hstep, voffB);
            PG8_WAIT_V(6); PG8_BAR; PG8_MMA(1, 1, At, B1); PG8_BAR;
            }
        }
        if constexpr (ALIGN_EPI) { if (wr == 0) PG8_BAR; }
        if constexpr (!Epi::AFTER_DRAIN) { E(acc, cur, wr, wc, fr, fq); S.done(cur); }
        if (!has_next) break;
#pragma unroll
        for (int a = 0; a < 2; ++a)
#pragma unroll
            for (int b = 0; b < 2; ++b)
#pragma unroll
                for (int m = 0; m < 4; ++m)
#pragma unroll
                    for (int n = 0; n < 2; ++n) acc[a][b][m][n] = (f32x4){0.f, 0.f, 0.f, 0.f};
        cur = nxt; cA = nA; cB = nB; ++ui;
        if constexpr (GATHER) {
#pragma unroll
            for (int h = 0; h < 2; ++h) { gcur[h] = gnxt[h]; } }
        if constexpr (ALIGN_EPI) { if (wr == 1) PG8_BAR; }
    }
    PG8_WAIT_V(0);
    if constexpr (!ALIGN_EPI) { if (wr == 0) PG8_BAR; }
    PG8_BAR;
    if constexpr (Epi::AFTER_DRAIN) { E.fused(acc, cur, wr, wc, fr, fq, lds, wid, lane); S.done(cur); }
#undef PG8_SA
#undef PG8_SB
#undef PG8_STAGE
#undef PG8_STAGE_A
#undef PG8_LDA
#undef PG8_LDB
#undef PG8_MMA
#undef PG8_WAIT_V
#undef PG8_WAIT_L
#undef PG8_BAR
#undef PG8_SCHED
}
}

typedef unsigned short bf16_t;
__device__ __forceinline__ unsigned f2bf(float f) { unsigned u = __builtin_bit_cast(unsigned, f); return (u + 0x7fffu + ((u >> 16) & 1u)) >> 16; }
__device__ __forceinline__ float bf2f(unsigned h) { return __builtin_bit_cast(float, h << 16); }
__device__ __forceinline__ float wave_sum(float v) {
#pragma unroll
    for (int o = 1; o < 64; o <<= 1) v += __shfl_xor(v, o);
    return v;
}
__device__ __forceinline__ float sigmoidf_(float x) { return 1.0f / (1.0f + expf(-x)); }
__device__ __forceinline__ float siluf_(float x) { return x / (1.0f + expf(-x)); }
__device__ __forceinline__ float softplusf_(float x) { return fmaxf(x, 0.0f) + log1pf(expf(-fabsf(x))); }
__device__ __forceinline__ float geluf_(float x) { const float u = 0.7978845608028654f * (x + 0.044715f * x * x * x); return 0.5f * x * (1.0f + tanhf(u)); }

struct Args { const float* in[39]; float* out; unsigned char* ws; int lo, hi; };

struct Ctx {
    const float* const* in; float* out; unsigned char* ws;
    LAS unsigned char* lds; float* sm;
    int tid, lane, wid, bid, G, dry;
};

__device__ __forceinline__ unsigned pk2(float lo, float hi) { return f2bf(lo) | (f2bf(hi) << 16); }
__device__ __forceinline__ float ldbf(const bf16_t* p) { return bf2f((unsigned)*p); }
typedef unsigned v4u_t __attribute__((ext_vector_type(4)));
typedef unsigned v2u_t __attribute__((ext_vector_type(2)));
__device__ __forceinline__ void st16(void* p, uint4 v) { const v4u_t d = {v.x, v.y, v.z, v.w}; asm volatile("global_store_dwordx4 %0, %1, off\n\ts_nop 1" :: "v"(p), "v"(d) : "memory"); }
__device__ __forceinline__ void st16f(void* p, float4 v) { st16(p, make_uint4(__float_as_uint(v.x), __float_as_uint(v.y), __float_as_uint(v.z), __float_as_uint(v.w))); }
__device__ __forceinline__ void st8(void* p, uint2 v) { const v2u_t d = {v.x, v.y}; asm volatile("global_store_dwordx2 %0, %1, off\n\ts_nop 1" :: "v"(p), "v"(d) : "memory"); }
__device__ __forceinline__ void st4(void* p, unsigned v) { asm volatile("global_store_dword %0, %1, off\n\ts_nop 1" :: "v"(p), "v"(v) : "memory"); }
__device__ __forceinline__ void st2(void* p, unsigned v) { asm volatile("global_store_short %0, %1, off\n\ts_nop 1" :: "v"(p), "v"(v) : "memory"); }
__device__ __forceinline__ float4 ldbf4(const bf16_t* p) { const uint2 v = *(const uint2*)p; return make_float4(bf2f(v.x & 0xffffu), bf2f(v.x >> 16), bf2f(v.y & 0xffffu), bf2f(v.y >> 16)); }

template <int NB, class AF, class BF, class BF2, class EF>
__device__ __forceinline__ void gemm_tile(float* sm, int K, AF af, BF bf, BF2 bf2, EF ef) {
    float* As = sm;
    float* Bs = sm + 16 * 132;
    float* Bs2 = Bs + 16 * 68;
    const int tid = threadIdx.x, ty = tid >> 4, tx = tid & 15;
    const int am = tid >> 2, ak = (tid & 3) * 4;
    const int bt = tid & 255, bk = bt >> 4, bn = (bt & 15) * 4;
    float acc[4][4], acc2[4][4];
#pragma unroll
    for (int i = 0; i < 4; ++i)
#pragma unroll
        for (int j = 0; j < 4; ++j) { acc[i][j] = 0.f; acc2[i][j] = 0.f; }
    float4 av = af(am, ak);
    float4 bv = make_float4(0.f, 0.f, 0.f, 0.f);
    if (tid < 256) bv = bf(bk, bn); else if (NB == 2) bv = bf2(bk, bn);
    for (int k0 = 0; k0 < K; k0 += 16) {
        __syncthreads();
        As[(ak + 0) * 132 + am] = av.x; As[(ak + 1) * 132 + am] = av.y; As[(ak + 2) * 132 + am] = av.z; As[(ak + 3) * 132 + am] = av.w;
        if (tid < 256) *(float4*)&Bs[bk * 68 + bn] = bv; else if (NB == 2) *(float4*)&Bs2[bk * 68 + bn] = bv;
        __syncthreads();
        if (k0 + 16 < K) {
            av = af(am, k0 + 16 + ak);
            if (tid < 256) bv = bf(k0 + 16 + bk, bn); else if (NB == 2) bv = bf2(k0 + 16 + bk, bn);
        }
#pragma unroll
        for (int kk = 0; kk < 16; ++kk) {
            const float4 a = *(const float4*)&As[kk * 132 + ty * 4];
            const float4 b = *(const float4*)&Bs[kk * 68 + tx * 4];
            const float aa[4] = {a.x, a.y, a.z, a.w};
            const float bb[4] = {b.x, b.y, b.z, b.w};
#pragma unroll
            for (int i = 0; i < 4; ++i)
#pragma unroll
                for (int j = 0; j < 4; ++j) acc[i][j] = fmaf(aa[i], bb[j], acc[i][j]);
            if (NB == 2) {
                const float4 b2 = *(const float4*)&Bs2[kk * 68 + tx * 4];
                const float bb2[4] = {b2.x, b2.y, b2.z, b2.w};
#pragma unroll
                for (int i = 0; i < 4; ++i)
#pragma unroll
                    for (int j = 0; j < 4; ++j) acc2[i][j] = fmaf(aa[i], bb2[j], acc2[i][j]);
            }
        }
    }
#pragma unroll
    for (int i = 0; i < 4; ++i)
        ef(ty * 4 + i, tx * 4, make_float4(acc[i][0], acc[i][1], acc[i][2], acc[i][3]), make_float4(acc2[i][0], acc2[i][1], acc2[i][2], acc2[i][3]));
}

typedef float f32x4nt __attribute__((ext_vector_type(4)));
typedef unsigned u32x2nt __attribute__((ext_vector_type(2)));
__device__ __forceinline__ void transpose_load(const float* W, int N, int nblk, int item, int lane, float (&r)[32]) {
    const int kb = item / nblk, nb = item % nblk, k0 = 64 * kb, n0 = 32 * nb;
#pragma unroll
    for (int i = 0; i < 8; ++i) { const int kk = 8 * i + (lane >> 3); const f32x4nt v = __builtin_nontemporal_load((const f32x4nt*)(W + (size_t)(k0 + kk) * N + n0 + (lane & 7) * 4));
        r[4 * i] = v[0]; r[4 * i + 1] = v[1]; r[4 * i + 2] = v[2]; r[4 * i + 3] = v[3]; }
}
template <bool RES, class RM>
__device__ __forceinline__ void transpose_finish(int K, int nblk, bf16_t* WT, RM rowmap, float* scr, int item, int lane, const float (&r)[32]) {
    const int kb = item / nblk, nb = item % nblk, k0 = 64 * kb, n0 = 32 * nb;
#pragma unroll
    for (int i = 0; i < 8; ++i) { const int kk = 8 * i + (lane >> 3), nn = (lane & 7) * 4;
        scr[kk * 33 + nn] = r[4 * i]; scr[kk * 33 + nn + 1] = r[4 * i + 1]; scr[kk * 33 + nn + 2] = r[4 * i + 2]; scr[kk * 33 + nn + 3] = r[4 * i + 3]; }
    asm volatile("s_waitcnt lgkmcnt(0)" ::: "memory");
    const int c = lane & 7;
    const int r0 = rowmap(n0);
#pragma unroll
    for (int j = 0; j < 4; ++j) {
        const int n = (lane >> 3) + 8 * j; const float* s = scr + (8 * c) * 33 + n;
        float v[8];
#pragma unroll
        for (int q = 0; q < 8; ++q) { v[q] = s[q * 33]; if (RES) v[q] = v[q] - bf2f(f2bf(v[q])); }
        uint4 o; o.x = pk2(v[0], v[1]); o.y = pk2(v[2], v[3]); o.z = pk2(v[4], v[5]); o.w = pk2(v[6], v[7]);
        st16(WT + (size_t)(r0 + n) * K + k0 + 8 * c, o);
    }
    asm volatile("s_waitcnt lgkmcnt(0)" ::: "memory");
}
template <bool RES, class RM>
__device__ __forceinline__ void transpose_item(const float* W, int K, int N, bf16_t* WT, RM rowmap, float* scr, int item, int lane) {
    float r[32];
    transpose_load(W, N, N / 32, item, lane, r);
    transpose_finish<RES>(K, N / 32, WT, rowmap, scr, item, lane, r);
}

__device__ __forceinline__ void convert_expert_weights(const Ctx& c, const int lo, const int hi, int first, int stride) {
    float* scr = c.sm + c.wid * (64 * 33);
    float ra[32], rb[32];
    auto src = [&](int it, const float*& W, int& N, int& nblk, int& item) {
        const int e = it / 384, r = it % 384;
        if (r < 128) { W = c.in[33] + (size_t)e * D * EFF; N = EFF; nblk = EFF / 32; item = r; }
        else if (r < 256) { W = c.in[34] + (size_t)e * D * EFF; N = EFF; nblk = EFF / 32; item = r - 128; }
        else { W = c.in[35] + (size_t)e * EFF * D; N = D; nblk = D / 32; item = r - 256; }
    };
    auto fin = [&](int it, const float (&rg)[32]) {
        const int e = it / 384, r = it % 384;
        if (r < 128) transpose_finish<false>(D, EFF / 32, (bf16_t*)(c.ws + WS_WEGU) + (size_t)e * 512 * D, [](int n) { return (n >> 7) * 256 + (n & 127); }, scr, r, c.lane, rg);
        else if (r < 256) transpose_finish<false>(D, EFF / 32, (bf16_t*)(c.ws + WS_WEGU) + (size_t)e * 512 * D, [](int n) { return (n >> 7) * 256 + 128 + (n & 127); }, scr, r - 128, c.lane, rg);
        else transpose_finish<false>(EFF, D / 32, (bf16_t*)(c.ws + WS_WED) + (size_t)e * D * EFF, [](int n) { return n; }, scr, r - 256, c.lane, rg);
    };
    float rc[32];
    auto ld = [&](int it_, float (&rg)[32]) { if (it_ < hi) { const float* W; int N, nblk, item; src(it_, W, N, nblk, item); transpose_load(W, N, nblk, item, c.lane, rg); } };
    int it = lo + first;
    if (it >= hi) return;
    ld(it, ra); ld(it + stride, rb);
    for (;;) {
        ld(it + 2 * stride, rc); fin(it, ra); if (it + stride >= hi) break;
        ld(it + 3 * stride, ra); fin(it + stride, rb); if (it + 2 * stride >= hi) break;
        ld(it + 4 * stride, rb); fin(it + 2 * stride, rc); if (it + 3 * stride >= hi) break;
        it += 3 * stride;
    }
}

__device__ __forceinline__ void phase0(const Ctx& c) {
    const int gt = c.bid * 512 + c.tid, NT = c.G * 512;
    const int gw = c.bid * 8 + c.wid, NW = c.G * 8;
    {
        const float* cc = c.in[1]; const float* w_ada = c.in[2];
        float* modsp = (float*)(c.ws + WS_MODSP);
        for (int task = gw; task < 96 * 16; task += NW) {
            const int cg = task % 96, ks = task / 96, j = cg * 64 + c.lane;
            float a0 = 0.f, a1 = 0.f, a2 = 0.f, a3 = 0.f;
#pragma unroll 4
            for (int k = ks * 64; k < ks * 64 + 64; ++k) {
                const float wv = w_ada[(size_t)k * NMODS + j];
                a0 = fmaf(siluf_(cc[k]), wv, a0); a1 = fmaf(siluf_(cc[D + k]), wv, a1); a2 = fmaf(siluf_(cc[2 * D + k]), wv, a2); a3 = fmaf(siluf_(cc[3 * D + k]), wv, a3);
            }
            modsp[(ks * 4 + 0) * NMODS + j] = a0; modsp[(ks * 4 + 1) * NMODS + j] = a1; modsp[(ks * 4 + 2) * NMODS + j] = a2; modsp[(ks * 4 + 3) * NMODS + j] = a3;
        }
    }
    {
        const float* log_dt = c.in[20]; const float* a_re = c.in[21]; const float* a_im = c.in[22];
        const float* b_re = c.in[23]; const float* b_im = c.in[24];
        float* apow = (float*)(c.ws + WS_APOW); float* bb = (float*)(c.ws + WS_S5BB);
        for (int idx = ((c.tid & 63) == 0) ? c.bid * 8 + (c.tid >> 6) : S5NG * S5P; idx < S5NG * S5P; idx += c.G * 8) {
            const int g = idx / S5P, p = idx % S5P;
            const double dt = exp((double)log_dt[g]);
            const double lre = fmin((double)a_re[idx], -1e-4), lim = (double)a_im[idx];
            const double mag = exp(lre * dt), ang = lim * dt;
            const double abr = mag * cos(ang), abi = mag * sin(ang);
            const double den = lre * lre + lim * lim;
            const double nre = abr - 1.0, nim = abi;
            const double qre = (nre * lre + nim * lim) / den, qim = (nim * lre - nre * lim) / den;
            double pr = 1.0, pi = 0.0;
            for (int j = 0; j <= S5L; ++j) {
                apow[((size_t)(g * (S5L + 1) + j) * 64 + p) * 2 + 0] = (float)pr; apow[((size_t)(g * (S5L + 1) + j) * 64 + p) * 2 + 1] = (float)pi;
                const double nr = pr * abr - pi * abi, ni = pr * abi + pi * abr; pr = nr; pi = ni;
            }
            for (int ch = 0; ch < 16; ++ch) {
                const double br = (double)b_re[idx * 16 + ch], bi = (double)b_im[idx * 16 + ch];
                bb[idx * 32 + ch] = (float)(qre * br - qim * bi);
                bb[idx * 32 + 16 + ch] = (float)(qre * bi + qim * br);
            }
        }
    }
    {
        const float* w2 = c.in[11]; const float* a2 = c.in[13]; const float* g2 = c.in[14];
        bf16_t* bt = (bf16_t*)(c.ws + WS_LORA_BT);
        for (int it = gt; it < 1536 * 32; it += NT) {
            const int n = it >> 5, c0 = (it & 31) * 8;
            float v[8];
#pragma unroll
            for (int i = 0; i < 8; ++i) {
                const int col = c0 + i; float x = 0.f;
                if (n < 512) { if (col < 64) x = w2[col * RW + n]; }
                else if (n < 1024) { if (col >= 64 && col < 128) x = a2[(col - 64) * RW + (n - 512)]; }
                else { if (col >= 128) x = g2[(col - 128) * RW + (n - 1024)]; }
                v[i] = x;
            }
            *(uint4*)(bt + (size_t)n * 256 + c0) = make_uint4(pk2(v[0], v[1]), pk2(v[2], v[3]), pk2(v[4], v[5]), pk2(v[6], v[7]));
        }
    }
    float* scr = c.sm + c.wid * (64 * 33);
    constexpr int I_IN = (D / 64) * (NPROJ / 32), I_OUT = (D / 64) * (D / 32), I_GLU = (512 / 64) * (512 / 32), I_SG = (D / 64) * (256 / 32), I_SD = (256 / 64) * (D / 32), I_R = (D / 64) * (256 / 32);
    constexpr int NIT = I_IN + I_OUT + I_GLU + 2 * I_SG + I_SD + 2 * I_R;
    for (int it = gw; it < NIT; it += NW) {
        int r = it;
        if (r < I_IN) { transpose_item<false>(c.in[8], D, NPROJ, (bf16_t*)(c.ws + WS_WIN_T), [](int n) { return n; }, scr, r, c.lane); continue; } r -= I_IN;
        if (r < I_OUT) { transpose_item<false>(c.in[30], D, D, (bf16_t*)(c.ws + WS_WOUT_T), [](int n) { return n; }, scr, r, c.lane); continue; } r -= I_OUT;
        if (r < I_GLU) { transpose_item<false>(c.in[28], 512, 512, (bf16_t*)(c.ws + WS_WGLU_T), [](int n) { return n; }, scr, r, c.lane); continue; } r -= I_GLU;
        if (r < I_SG) { transpose_item<false>(c.in[36], D, 256, (bf16_t*)(c.ws + WS_WSGU_T), [](int n) { return (n >> 7) * 256 + (n & 127); }, scr, r, c.lane); continue; } r -= I_SG;
        if (r < I_SG) { transpose_item<false>(c.in[37], D, 256, (bf16_t*)(c.ws + WS_WSGU_T), [](int n) { return (n >> 7) * 256 + 128 + (n & 127); }, scr, r, c.lane); continue; } r -= I_SG;
        if (r < I_SD) { transpose_item<false>(c.in[38], 256, D, (bf16_t*)(c.ws + WS_WSD_T), [](int n) { return n; }, scr, r, c.lane); continue; } r -= I_SD;
        if (r < I_R) { transpose_item<false>(c.in[31], D, 256, (bf16_t*)(c.ws + WS_WR_T), [](int n) { return n; }, scr, r, c.lane); continue; } r -= I_R;
        transpose_item<true>(c.in[31], D, 256, (bf16_t*)(c.ws + WS_WR_T), [](int n) { return 256 + n; }, scr, r, c.lane);
    }
}

__device__ __forceinline__ void phase1(const Ctx& c) {
    const int gt = c.bid * 512 + c.tid, NT = c.G * 512;
    const int gw = c.bid * 8 + c.wid, NW = c.G * 8;
    const float* modsp = (const float*)(c.ws + WS_MODSP); const float* b_ada = c.in[3]; float* mods = (float*)(c.ws + WS_MODS);
    for (int idx = gt; idx < BATCH * NMODS; idx += NT) {
        const int b = idx / NMODS, j = idx % NMODS;
        float acc = 0.f;
#pragma unroll
        for (int ks = 0; ks < 16; ++ks) acc += modsp[(ks * 4 + b) * NMODS + j];
        mods[idx] = acc + b_ada[j];
    }
    const float* __restrict__ apow = (const float*)(c.ws + WS_APOW); const float* __restrict__ bb = (const float*)(c.ws + WS_S5BB);
    const float* __restrict__ c_re = c.in[25]; const float* __restrict__ c_im = c.in[26];
    float* __restrict__ klag = (float*)(c.ws + WS_KLAG);
    for (int task = gw; task < S5NG * S5L; task += NW) {
        const int g = task / S5L, j = task % S5L, cc = c.lane >> 2, cq = (c.lane & 3) * 4;
        float acc[4] = {0.f, 0.f, 0.f, 0.f};
#pragma unroll 16
        for (int p = 0; p < 64; ++p) {
            const float ar = apow[((size_t)(g * (S5L + 1) + j) * 64 + p) * 2], ai = apow[((size_t)(g * (S5L + 1) + j) * 64 + p) * 2 + 1];
            const float cr = c_re[(g * 16 + cc) * 64 + p], ci = c_im[(g * 16 + cc) * 64 + p];
            const float4 br = *(const float4*)(bb + (size_t)(g * 64 + p) * 32 + cq), bi = *(const float4*)(bb + (size_t)(g * 64 + p) * 32 + 16 + cq);
            const float er = cr * ar - ci * ai, ei = cr * ai + ci * ar;
            acc[0] += er * br.x - ei * bi.x; acc[1] += er * br.y - ei * bi.y; acc[2] += er * br.z - ei * bi.z; acc[3] += er * br.w - ei * bi.w;
        }
        *(float4*)(klag + ((size_t)(g * S5L + j) * 16 + cc) * 16 + cq) = make_float4(acc[0], acc[1], acc[2], acc[3]);
    }
}

__device__ __forceinline__ void phase2(const Ctx& c) {
    const float* x = c.in[0]; const float* g = c.in[4];
    const float* mods = (const float*)(c.ws + WS_MODS);
    bf16_t* xn = (bf16_t*)(c.ws + WS_A);
    const int gw = c.bid * 8 + c.wid, NW = c.G * 8;
    for (int t = gw; t < T; t += NW) {
        const int b = t / SEQ;
        const float4* xr = (const float4*)(x + (size_t)t * D) + c.lane;
        float4 v[4]; float ss = 0.f;
#pragma unroll
        for (int j = 0; j < 4; ++j) { v[j] = xr[64 * j]; ss += v[j].x * v[j].x + v[j].y * v[j].y + v[j].z * v[j].z + v[j].w * v[j].w; }
        const float rstd = rsqrtf(wave_sum(ss) * (1.0f / D) + 1e-6f);
        uint2* o = (uint2*)(xn + (size_t)t * D) + c.lane;
#pragma unroll
        for (int j = 0; j < 4; ++j) {
            const int k = (c.lane + 64 * j) * 4;
            const float4 gg = *(const float4*)(g + k);
            const float4 sh = *(const float4*)(mods + b * NMODS + k);
            const float4 sc = *(const float4*)(mods + b * NMODS + D + k);
            float4 r;
            r.x = v[j].x * rstd * gg.x * (1.f + sc.x) + sh.x; r.y = v[j].y * rstd * gg.y * (1.f + sc.y) + sh.y;
            r.z = v[j].z * rstd * gg.z * (1.f + sc.z) + sh.z; r.w = v[j].w * rstd * gg.w * (1.f + sc.w) + sh.w;
            o[64 * j] = make_uint2(pk2(r.x, r.y), pk2(r.z, r.w));
        }
    }
}

__device__ __forceinline__ void s5_assemble(const Ctx& c) {
    const bool half = (c.G == 256);
    if (half && c.bid < 128) return;
    const int gt = (half ? c.bid - 128 : c.bid) * 512 + c.tid, NT = (half ? 128 : c.G) * 512;
    const float* apow = (const float*)(c.ws + WS_APOW); const float* bb = (const float*)(c.ws + WS_S5BB); const float* klag = (const float*)(c.ws + WS_KLAG);
    const float* c_re = c.in[25]; const float* c_im = c.in[26]; const float* dd = c.in[27];
    bf16_t* kmat = (bf16_t*)(c.ws + WS_KMAT); bf16_t* hmat = (bf16_t*)(c.ws + WS_HMAT);
    for (int it = gt; it < S5NG * 512 * 80; it += NT) {
        const int row = it / 80, ch = it % 80, g = row >> 9, t = (row >> 4) & 31, cc = row & 15, col0 = ch * 8;
        float v[8];
        if (col0 < 512) {
            const int s = col0 >> 4, c0 = col0 & 15;
            if (s > t) {
#pragma unroll
                for (int i = 0; i < 8; ++i) v[i] = 0.f;
            } else {
                const float4 k0 = *(const float4*)(klag + ((size_t)(g * S5L + (t - s)) * 16 + cc) * 16 + c0), k1 = *(const float4*)(klag + ((size_t)(g * S5L + (t - s)) * 16 + cc) * 16 + c0 + 4);
                v[0] = k0.x; v[1] = k0.y; v[2] = k0.z; v[3] = k0.w; v[4] = k1.x; v[5] = k1.y; v[6] = k1.z; v[7] = k1.w;
                if (s == t) {
                    const float dv = dd[g * 16 + cc];
#pragma unroll
                    for (int i = 0; i < 8; ++i) if (c0 + i == cc) v[i] += dv;
                }
            }
        } else {
            const int q0 = col0 - 512;
#pragma unroll
            for (int i = 0; i < 8; ++i) {
                const int q = q0 + i, p = q & 63;
                const float ar = apow[((size_t)(g * (S5L + 1) + t + 1) * 64 + p) * 2], ai = apow[((size_t)(g * (S5L + 1) + t + 1) * 64 + p) * 2 + 1];
                const float cr = c_re[(g * 16 + cc) * 64 + p], ci = c_im[(g * 16 + cc) * 64 + p];
                v[i] = (q < 64) ? (cr * ar - ci * ai) : -(cr * ai + ci * ar);
            }
        }
        *(uint4*)(kmat + (size_t)row * 640 + col0) = make_uint4(pk2(v[0], v[1]), pk2(v[2], v[3]), pk2(v[4], v[5]), pk2(v[6], v[7]));
    }
    for (int it = gt; it < S5NG * 256 * 80; it += NT) {
        const int row = it / 80, ch = it % 80, g = row >> 8, q = row & 255, col0 = ch * 8;
        float v[8];
#pragma unroll
        for (int i = 0; i < 8; ++i) v[i] = 0.f;
        if (q < 128 && col0 < 512) {
            const int s = col0 >> 4, c0 = col0 & 15, p = q & 63;
            const float ar = apow[((size_t)(g * (S5L + 1) + (S5L - 1 - s)) * 64 + p) * 2], ai = apow[((size_t)(g * (S5L + 1) + (S5L - 1 - s)) * 64 + p) * 2 + 1];
#pragma unroll
            for (int i = 0; i < 8; ++i) {
                const float br = bb[(size_t)(g * 64 + p) * 32 + c0 + i], bi = bb[(size_t)(g * 64 + p) * 32 + 16 + c0 + i];
                v[i] = (q < 64) ? (ar * br - ai * bi) : (ar * bi + ai * br);
            }
        }
        *(uint4*)(hmat + (size_t)row * 640 + col0) = make_uint4(pk2(v[0], v[1]), pk2(v[2], v[3]), pk2(v[4], v[5]), pk2(v[6], v[7]));
    }
}

__device__ __forceinline__ void phase3(const Ctx& c) {
    pg8::Gemm g{(const bf16_t*)(c.ws + WS_A), (const bf16_t*)(c.ws + WS_WIN_T), T, NPROJ, D};
    pg8::StaticOrder S; S.init(T, NPROJ, c.G, c.bid);
    pg8::EpiBf16<0> E{(bf16_t*)(c.ws + WS_PROJ), NPROJ, nullptr, 0, 0, 1.f};
    pg8::gemm_phase<pg8::EpiBf16<0>, pg8::StaticOrder, true, true>(c.lds, g, S, E);
    s5_assemble(c);
}

__device__ __forceinline__ void unpack8(const uint4 a, float (&u)[8]) {
    u[0] = bf2f(a.x & 0xffffu); u[1] = bf2f(a.x >> 16); u[2] = bf2f(a.y & 0xffffu); u[3] = bf2f(a.y >> 16);
    u[4] = bf2f(a.z & 0xffffu); u[5] = bf2f(a.z >> 16); u[6] = bf2f(a.w & 0xffffu); u[7] = bf2f(a.w >> 16);
}
__device__ __forceinline__ uint4 pack8(const float (&v)[8]) { return make_uint4(pk2(v[0], v[1]), pk2(v[2], v[3]), pk2(v[4], v[5]), pk2(v[6], v[7])); }
#define DPPU(v, ctrl) ((unsigned)__builtin_amdgcn_mov_dpp((int)(v), (ctrl), 0xf, 0xf, true))
#define DPPF(v, ctrl) __builtin_bit_cast(float, __builtin_amdgcn_mov_dpp(__builtin_bit_cast(int, (v)), (ctrl), 0xf, 0xf, true))
__device__ __forceinline__ float fast_tanh(float x) { return 1.0f - 2.0f * __builtin_amdgcn_rcpf(1.0f + __builtin_amdgcn_exp2f(2.8853900817779268f * x)); }
__device__ __forceinline__ void phase4(const Ctx& c) {
    const bf16_t* proj = (const bf16_t*)(c.ws + WS_PROJ);
    const float* mu = c.in[9]; const float* k_k = c.in[15];
    bf16_t* rw_r = (bf16_t*)(c.ws + WS_RW_R); bf16_t* rw_k = (bf16_t*)(c.ws + WS_RW_K); bf16_t* rw_v = (bf16_t*)(c.ws + WS_RW_V); bf16_t* rw_a = (bf16_t*)(c.ws + WS_RW_A);
    bf16_t* alora = (bf16_t*)((unsigned char*)c.out + OUT_ALORA); bf16_t* ux = (bf16_t*)((unsigned char*)c.out + OUT_UX);
    const int gw = c.bid * 8 + c.wid, NW = c.G * 8, lane = c.lane;
    float mm[4][8], kk8[8];
#pragma unroll
    for (int j = 0; j < 4; ++j) {
        const int cidx = lane + 64 * j, col = (cidx < 224 ? cidx : 0) * 8;
        const float4 m0 = *(const float4*)(mu + col), m1 = *(const float4*)(mu + col + 4);
        mm[j][0] = m0.x; mm[j][1] = m0.y; mm[j][2] = m0.z; mm[j][3] = m0.w; mm[j][4] = m1.x; mm[j][5] = m1.y; mm[j][6] = m1.z; mm[j][7] = m1.w;
    }
    { const float4 k0 = *(const float4*)(k_k + lane * 8), k1 = *(const float4*)(k_k + lane * 8 + 4); kk8[0] = k0.x; kk8[1] = k0.y; kk8[2] = k0.z; kk8[3] = k0.w; kk8[4] = k1.x; kk8[5] = k1.y; kk8[6] = k1.z; kk8[7] = k1.w; }
    constexpr int RUN = 16;
    auto load_row = [&](int t, uint4 (&r)[5]) {
        const bf16_t* pr = proj + (size_t)t * NPROJ;
#pragma unroll
        for (int j = 0; j < 3; ++j) r[j] = *(const uint4*)(pr + (lane + 64 * j) * 8);
        r[3] = (lane < 32) ? *(const uint4*)(pr + (lane + 192) * 8) : make_uint4(0u, 0u, 0u, 0u);
        r[4] = *(const uint4*)(pr + RPROJ + lane * 8);
    };
    for (int t0 = gw * RUN; t0 < T; t0 += NW * RUN) {
        uint4 prev[5], cur[5], nxt[5];
        if (t0 % SEQ == 0) {
#pragma unroll
            for (int j = 0; j < 5; ++j) prev[j] = make_uint4(0u, 0u, 0u, 0u);
        } else load_row(t0 - 1, prev);
        load_row(t0, cur);
#pragma unroll 2
        for (int i = 0; i < RUN; ++i) {
            const int t = t0 + i;
            if (i + 1 < RUN) load_row(t + 1, nxt);
#pragma unroll
            for (int j = 0; j < 4; ++j) {
                const int cidx = lane + 64 * j;
                if (cidx < 224) {
                    const int col = cidx * 8;
                    float p[8], q[8], ps[8];
                    unpack8(cur[j], p); unpack8(prev[j], q);
#pragma unroll
                    for (int i2 = 0; i2 < 8; ++i2) ps[i2] = p[i2] + (q[i2] - p[i2]) * mm[j][i2];
                    if (j == 0) *(uint4*)(rw_r + (size_t)t * RW + col) = pack8(ps);
                    else if (j == 1) {
                        const int cl = col - 512;
                        *(uint4*)(rw_k + (size_t)t * RW + cl) = pack8(ps);
                        float kk[8]; float ss = 0.f;
#pragma unroll
                        for (int i2 = 0; i2 < 8; ++i2) { kk[i2] = ps[i2] * kk8[i2]; ss += kk[i2] * kk[i2]; }
                        ss += DPPF(ss, 0xB1); ss += DPPF(ss, 0x4E); ss += DPPF(ss, 0x141);
                        const float inv = -1.0f / fmaxf(sqrtf(ss), 1e-12f);
#pragma unroll
                        for (int i2 = 0; i2 < 8; ++i2) kk[i2] *= inv;
                        *(uint4*)(rw_a + (size_t)t * RW + cl) = pack8(kk);
                    } else if (j == 2) *(uint4*)(rw_v + (size_t)t * RW + (col - 1024)) = pack8(ps);
                    else {
                        const int cl = col - 1536;
                        float o[8];
#pragma unroll
                        for (int i2 = 0; i2 < 8; ++i2) o[i2] = (cl < 64) ? fast_tanh(ps[i2]) : (cl < 128) ? ps[i2] : pg8::fast_sigmoid(ps[i2]);
                        *(uint4*)(alora + (size_t)t * 256 + cl) = pack8(o);
                    }
                }
            }
            {
                const int g = lane >> 1, hf = lane & 1, b = t / SEQ, sidx = t % S5L, chunk = (t % SEQ) / S5L;
                bf16_t* row = ux + ((size_t)(g * 1024 + b * 256 + chunk)) * 640;
                *(uint4*)(row + sidx * 16 + hf * 8) = cur[4];
                if (sidx < 8) { *(uint4*)(row + 512 + (sidx * 2 + hf) * 8) = make_uint4(0u, 0u, 0u, 0u); }
            }
#pragma unroll
            for (int j = 0; j < 5; ++j) { prev[j] = cur[j]; cur[j] = nxt[j]; }
        }
    }
}

__device__ __forceinline__ void phase5(const Ctx& c) {
    {
        pg8::Gemm g{(const bf16_t*)((unsigned char*)c.out + OUT_ALORA), (const bf16_t*)(c.ws + WS_LORA_BT), T, 1536, 256};
        pg8::StaticOrder S; S.init(T, 1536, c.G, c.bid);
        pg8::EpiLora E{c.in[10], c.in[12], c.in[16], (float*)(c.ws + WS_RW_W), (const bf16_t*)(c.ws + WS_RW_K), (bf16_t*)((unsigned char*)c.out + OUT_KF), (const bf16_t*)(c.ws + WS_RW_A), (bf16_t*)(c.ws + WS_RW_B), (bf16_t*)(c.ws + WS_RW_G)};
        pg8::gemm_phase<pg8::EpiLora, pg8::StaticOrder, true, true>(c.lds, g, S, E);
    }
    __syncthreads();
    {
        pg8::Gemm g{(const bf16_t*)((unsigned char*)c.out + OUT_UX), (const bf16_t*)(c.ws + WS_HMAT), 0, 0, 640};
        pg8::S5Order S{128, 1, c.G, c.bid};
        pg8::EpiS5E E{(float*)((unsigned char*)c.out + OUT_E)};
        pg8::gemm_phase<pg8::EpiS5E, pg8::S5Order, true, true>(c.lds, g, S, E);
    }
}

typedef float f2v __attribute__((ext_vector_type(2)));
__device__ __forceinline__ float dpp_add16(float v) {
    v += __builtin_bit_cast(float, __builtin_amdgcn_mov_dpp(__builtin_bit_cast(int, v), 0xB1, 0xf, 0xf, true));
    v += __builtin_bit_cast(float, __builtin_amdgcn_mov_dpp(__builtin_bit_cast(int, v), 0x4E, 0xf, 0xf, true));
    v += __builtin_bit_cast(float, __builtin_amdgcn_mov_dpp(__builtin_bit_cast(int, v), 0x141, 0xf, 0xf, true));
    v += __builtin_bit_cast(float, __builtin_amdgcn_mov_dpp(__builtin_bit_cast(int, v), 0x140, 0xf, 0xf, true));
    return v;
}
constexpr int RTS = 32;
constexpr int RTILE = 6 * RTS * 64;
typedef short bf16x8_t __attribute__((ext_vector_type(8)));
typedef float f32x4_t __attribute__((ext_vector_type(4)));
#define MFMA16(a, b, c) __builtin_amdgcn_mfma_f32_16x16x32_bf16((a), (b), (c), 0, 0, 0)
constexpr int CL = 64, CLD = 72, CSLOT = 64 * CLD * 2;
constexpr int C_DIAG = 13 * CSLOT, C_DM = C_DIAG + 4096, C_GL = C_DM + 2048, C_SEGP = C_GL + 256;
static_assert(C_SEGP + 2048 <= 131072, "rwkv chunk LDS map");
__device__ __forceinline__ bf16x8_t ldsfrag(LAS const unsigned char* slot, int row, int col) { return *(LAS const bf16x8_t*)(slot + (row * CLD + col) * 2); }
typedef unsigned u32x4_t __attribute__((ext_vector_type(4)));
typedef unsigned u32x2_t __attribute__((ext_vector_type(2)));
__device__ __forceinline__ void lds_st16(LAS unsigned char* p, uint4 v) { *(LAS u32x4_t*)p = (u32x4_t){v.x, v.y, v.z, v.w}; }
__device__ __forceinline__ void lds_st8(LAS unsigned char* p, uint2 v) { *(LAS u32x2_t*)p = (u32x2_t){v.x, v.y}; }
__device__ __forceinline__ uint2 lds_ld8(LAS const unsigned char* p) { const u32x2_t v = *(LAS const u32x2_t*)p; return make_uint2(v.x, v.y); }
__device__ __forceinline__ bf16x8_t zfrag() { return (bf16x8_t){0, 0, 0, 0, 0, 0, 0, 0}; }
__device__ __forceinline__ uint2 pack4(float a, float b, float c, float d) { return make_uint2(pk2(a, b), pk2(c, d)); }
__device__ __forceinline__ float wave_sum_u(float v) {
    v = dpp_add16(v);
    return __builtin_bit_cast(float, __builtin_amdgcn_readlane(__builtin_bit_cast(int, v), 0)) + __builtin_bit_cast(float, __builtin_amdgcn_readlane(__builtin_bit_cast(int, v), 16))
         + __builtin_bit_cast(float, __builtin_amdgcn_readlane(__builtin_bit_cast(int, v), 32)) + __builtin_bit_cast(float, __builtin_amdgcn_readlane(__builtin_bit_cast(int, v), 48));
}

__device__ __forceinline__ void rwkv_phaseA(const Ctx& c, const int GA) {
    const float* __restrict__ rw_w = (const float*)(c.ws + WS_RW_W);
    const bf16_t* __restrict__ rw_r = (const bf16_t*)(c.ws + WS_RW_R); const bf16_t* __restrict__ rw_k = (const bf16_t*)((const unsigned char*)c.out + OUT_KF); const bf16_t* __restrict__ rw_v = (const bf16_t*)(c.ws + WS_RW_V);
    const bf16_t* __restrict__ rw_a = (const bf16_t*)(c.ws + WS_RW_A); const bf16_t* __restrict__ rw_b = (const bf16_t*)(c.ws + WS_RW_B);
    const float* r_k = c.in[17];
    bf16_t* Mq = (bf16_t*)(c.ws + WS_CM); bf16_t* NTq = (bf16_t*)(c.ws + WS_CN); bf16_t* Qq = (bf16_t*)(c.ws + WS_CQ); bf16_t* YTq = (bf16_t*)(c.ws + WS_CY); float* bon = (float*)(c.ws + WS_CBON);
    LAS unsigned char* L = c.lds;
    LAS unsigned char* sAt = L + 0 * CSLOT; LAS unsigned char* sBt = L + 1 * CSLOT; LAS unsigned char* sKt = L + 2 * CSLOT; LAS unsigned char* sRt = L + 3 * CSLOT;
    LAS unsigned char* sBtT = L + 4 * CSLOT; LAS unsigned char* sKtT = L + 5 * CSLOT; LAS unsigned char* sVT = L + 6 * CSLOT;
    LAS unsigned char* sA4 = L + 7 * CSLOT;
    LAS unsigned char* sRHST = L + 11 * CSLOT;
    LAS unsigned char* sXT = L + 0 * CSLOT;
    LAS unsigned char* sAD = L + 2 * CSLOT;
    LAS float* sDIAG = (LAS float*)(L + C_DIAG); LAS bf16_t* sDM = (LAS bf16_t*)(L + C_DM); LAS float* sGL = (LAS float*)(L + C_GL); LAS float* sSEGP = (LAS float*)(L + C_SEGP);
    const int tid = c.tid, w = c.wid, lane = c.lane, lr = lane & 15, lq = lane >> 4;
    float raww[8]; unsigned rawa[8], rawb[8], rawk[8], rawr[8], rawv[8];
    auto load_raw = [&](int ci_) {
        const int bh_ = ci_ >> 7, chunk_ = ci_ & 127, b_ = bh_ >> 3, h_ = bh_ & 7;
        const size_t gb = (size_t)(b_ * SEQ + chunk_ * CL) * RW + h_ * 64 + (size_t)(8 * (tid >> 6)) * RW + (tid & 63);
#pragma unroll
        for (int j = 0; j < 8; ++j) { const size_t o = gb + (size_t)j * RW; raww[j] = rw_w[o]; rawa[j] = rw_a[o]; rawb[j] = rw_b[o]; rawk[j] = rw_k[o]; rawr[j] = rw_r[o]; rawv[j] = rw_v[o]; }
    };
    if (c.bid < BATCH * NH * (SEQ / CL)) load_raw(c.bid);
    for (int ci = c.bid; ci < BATCH * NH * (SEQ / CL); ci += GA) {
        const int bh = ci >> 7, chunk = ci & 127, b = bh >> 3, h = bh & 7;
        const size_t gbase = (size_t)(b * SEQ + chunk * CL) * RW + h * 64;
        {
            const int kc = tid & 63, seg = tid >> 6;
            float p[8];
#pragma unroll
            for (int j = 0; j < 8; ++j) { const float wv = raww[j]; p[j] = (j == 0) ? wv : p[j - 1] * wv; }
            sSEGP[seg * 64 + kc] = p[7];
            for (int i = tid; i < 4 * CSLOT / 16; i += 512) lds_st16(sA4 + i * 16, make_uint4(0u, 0u, 0u, 0u));
            __syncthreads();
            float pre = 1.0f;
#pragma unroll
            for (int s = 0; s < 7; ++s) { const float sp = sSEGP[s * 64 + kc]; pre = (s < seg) ? pre * sp : pre; }
            float atT[8], btT[8], ktT[8], vT[8];
            const float rkv = r_k[h * 64 + kc];
#pragma unroll
            for (int j = 0; j < 8; ++j) {
                const int t = 8 * seg + j;
                const float G = pre * p[j], Gm1 = (j == 0) ? pre : pre * p[j - 1], inv = 1.0f / G;
                const float av = bf2f(rawa[j]), bv = bf2f(rawb[j]), kv = bf2f(rawk[j]), rv = bf2f(rawr[j]), vv = bf2f(rawv[j]);
                const float at = av * Gm1, bt = bv * inv, kt = kv * inv, rt = rv * G;
                *(LAS bf16_t*)(sAt + (t * CLD + kc) * 2) = (bf16_t)f2bf(at); *(LAS bf16_t*)(sBt + (t * CLD + kc) * 2) = (bf16_t)f2bf(bt);
                *(LAS bf16_t*)(sKt + (t * CLD + kc) * 2) = (bf16_t)f2bf(kt); *(LAS bf16_t*)(sRt + (t * CLD + kc) * 2) = (bf16_t)f2bf(rt);
                atT[j] = at; btT[j] = bt; ktT[j] = kt; vT[j] = vv;
                const float bs = wave_sum_u(rv * kv * rkv);
                if (lane == 0) bon[(size_t)ci * CL + t] = bs;
            }
            lds_st16(sRHST + (kc * CLD + 8 * seg) * 2, pack8(atT)); lds_st16(sBtT + (kc * CLD + 8 * seg) * 2, pack8(btT));
            lds_st16(sKtT + (kc * CLD + 8 * seg) * 2, pack8(ktT)); lds_st16(sVT + (kc * CLD + 8 * seg) * 2, pack8(vT));
            if (seg == 7) sGL[kc] = pre * p[7];
            __syncthreads();
        }
        for (int idx = w; idx < 40; idx += 8) {
            const int m = idx / 10, pr = idx % 10;
            const int ti = (pr >= 6) ? 3 : (pr >= 3) ? 2 : (pr >= 1) ? 1 : 0, si = pr - ti * (ti + 1) / 2;
            LAS const unsigned char* X = (m < 2) ? sAt : sRt; LAS const unsigned char* Y = (m & 1) ? sKt : sBt;
            f32x4_t acc = {0.f, 0.f, 0.f, 0.f};
#pragma unroll
            for (int ks = 0; ks < 2; ++ks) acc = MFMA16(ldsfrag(Y, 16 * si + lr, 32 * ks + 8 * lq), ldsfrag(X, 16 * ti + lr, 32 * ks + 8 * lq), acc);
            const int t = 16 * ti + lr, s0 = 16 * si + 4 * lq;
            float o[4];
#pragma unroll
            for (int rg = 0; rg < 4; ++rg) { const int s = s0 + rg; const bool keep = (m < 2) ? (s < t) : (s <= t); o[rg] = keep ? acc[rg] : 0.f; }
            lds_st8(sA4 + m * CSLOT + (t * CLD + s0) * 2, pack4(o[0], o[1], o[2], o[3]));
            if (m == 0 && ti == si) *(LAS f32x4_t*)(sDIAG + (ti * 16 + lr) * 16 + 4 * lq) = (f32x4_t){o[0], o[1], o[2], o[3]};
        }
        __syncthreads();
        if (w == 0) {
            float x[16];
#pragma unroll
            for (int r = 0; r < 16; ++r) {
                float acc = (r == lr) ? 1.0f : 0.0f;
                float nrow[16];
#pragma unroll
                for (int q4 = 0; q4 < 4; ++q4) { const f32x4_t nv = *(LAS const f32x4_t*)(sDIAG + (lq * 16 + r) * 16 + 4 * q4); nrow[4 * q4] = nv[0]; nrow[4 * q4 + 1] = nv[1]; nrow[4 * q4 + 2] = nv[2]; nrow[4 * q4 + 3] = nv[3]; }
#pragma unroll
                for (int s = 0; s < 16; ++s) if (s < r) acc = fmaf(nrow[s], x[s], acc);
                x[r] = acc;
                sDM[(lq * 16 + r) * 16 + lr] = (bf16_t)f2bf(acc);
            }
        } else {
            for (int idx = w - 1; idx < 16; idx += 7) {
                const int ti = idx >> 2, vi = idx & 3;
                f32x4_t acc = {0.f, 0.f, 0.f, 0.f};
#pragma unroll
                for (int ks = 0; ks < 2; ++ks) acc = MFMA16(ldsfrag(sA4 + 1 * CSLOT, 16 * ti + lr, 32 * ks + 8 * lq), ldsfrag(sVT, 16 * vi + lr, 32 * ks + 8 * lq), acc);
                lds_st8(sRHST + ((64 + 16 * vi + lr) * CLD + 16 * ti + 4 * lq) * 2, pack4(acc[0], acc[1], acc[2], acc[3]));
            }
        }
        __syncthreads();
        f32x4_t rd[4];
#pragma unroll
        for (int i = 0; i < 4; ++i) {
            bf16x8_t fa = zfrag(), fb = zfrag();
            if (lq < 2) { fa = *(LAS const bf16x8_t*)(sDM + (i * 16 + lr) * 16 + 8 * lq); fb = ldsfrag(sRHST, 16 * w + lr, 16 * i + 8 * lq); }
            rd[i] = MFMA16(fa, fb, ((f32x4_t){0.f, 0.f, 0.f, 0.f}));
        }
        if (w < 6) {
            const int i = (w >= 3) ? 3 : (w >= 1) ? 2 : 1, j = w - (i - 1) * i / 2;
            bf16x8_t fa = zfrag(), fb = zfrag();
            if (lq < 2) {
                fa = *(LAS const bf16x8_t*)(sDM + (i * 16 + lr) * 16 + 8 * lq);
#pragma unroll
                for (int jj = 0; jj < 8; ++jj) fb[jj] = (short)*(LAS const bf16_t*)(sA4 + ((16 * i + 8 * lq + jj) * CLD + 16 * j + lr) * 2);
            }
            const f32x4_t acc = MFMA16(fa, fb, ((f32x4_t){0.f, 0.f, 0.f, 0.f}));
#pragma unroll
            for (int rg = 0; rg < 4; ++rg) *(LAS bf16_t*)(sAD + ((16 * i + 4 * lq + rg) * CLD + 16 * j + lr) * 2) = (bf16_t)f2bf(acc[rg]);
        }
        __syncthreads();
#pragma unroll
        for (int i = 0; i < 4; ++i) {
            f32x4_t acc = rd[i];
            if (i >= 1) {
                bf16x8_t fa = zfrag(), fb = zfrag();
                if (8 * lq < 16 * i) { fa = ldsfrag(sAD, 16 * i + lr, 8 * lq); fb = ldsfrag(sXT, 16 * w + lr, 8 * lq); }
                acc = MFMA16(fa, fb, acc);
            }
            if (i == 3) {
                bf16x8_t fa = zfrag(), fb = zfrag();
                if (lq < 2) { fa = ldsfrag(sAD, 48 + lr, 32 + 8 * lq); fb = ldsfrag(sXT, 16 * w + lr, 32 + 8 * lq); }
                acc = MFMA16(fa, fb, acc);
            }
            lds_st8(sXT + ((16 * w + lr) * CLD + 16 * i + 4 * lq) * 2, pack4(acc[0], acc[1], acc[2], acc[3]));
            asm volatile("s_waitcnt lgkmcnt(0)" ::: "memory");
        }
        __syncthreads();
        if (ci + GA < BATCH * NH * (SEQ / CL)) load_raw(ci + GA);
#pragma unroll
        for (int i = 0; i < 8; ++i) {
            const int kind = i >> 1, tile = w + 8 * (i & 1), r4 = tile >> 2, c4 = tile & 3;
            f32x4_t acc = {0.f, 0.f, 0.f, 0.f};
            if (kind == 0) {
#pragma unroll
                for (int ks = 0; ks < 2; ++ks) acc = MFMA16(ldsfrag(sXT, 16 * r4 + lr, 32 * ks + 8 * lq), ldsfrag(sBtT, 16 * c4 + lr, 32 * ks + 8 * lq), acc);
                const int k = 16 * c4 + lr, kp0 = 16 * r4 + 4 * lq; const float gl = sGL[k];
                float o[4];
#pragma unroll
                for (int rg = 0; rg < 4; ++rg) o[rg] = gl * (acc[rg] + ((k == kp0 + rg) ? 1.0f : 0.0f));
                *(uint2*)(Mq + (size_t)ci * 4096 + k * 64 + kp0) = pack4(o[0], o[1], o[2], o[3]);
            } else if (kind == 1) {
#pragma unroll
                for (int ks = 0; ks < 2; ++ks) {
                    acc = MFMA16(ldsfrag(sBtT, 16 * r4 + lr, 32 * ks + 8 * lq), ldsfrag(sXT, 64 + 16 * c4 + lr, 32 * ks + 8 * lq), acc);
                    acc = MFMA16(ldsfrag(sKtT, 16 * r4 + lr, 32 * ks + 8 * lq), ldsfrag(sVT, 16 * c4 + lr, 32 * ks + 8 * lq), acc);
                }
                const int k0 = 16 * r4 + 4 * lq; const f32x4_t gl = *(LAS const f32x4_t*)(sGL + k0);
                *(uint2*)(NTq + (size_t)ci * 4096 + (16 * c4 + lr) * 64 + k0) = pack4(gl[0] * acc[0], gl[1] * acc[1], gl[2] * acc[2], gl[3] * acc[3]);
            } else if (kind == 2) {
#pragma unroll
                for (int ks = 0; ks < 2; ++ks) acc = MFMA16(ldsfrag(sXT, 16 * r4 + lr, 32 * ks + 8 * lq), ldsfrag(sA4 + 2 * CSLOT, 16 * c4 + lr, 32 * ks + 8 * lq), acc);
                const int t = 16 * c4 + lr, kp0 = 16 * r4 + 4 * lq;
                const uint2 rv = lds_ld8(sRt + (t * CLD + kp0) * 2);
                *(uint2*)(Qq + (size_t)ci * 4096 + t * 64 + kp0) = pack4(acc[0] + bf2f(rv.x & 0xffffu), acc[1] + bf2f(rv.x >> 16), acc[2] + bf2f(rv.y & 0xffffu), acc[3] + bf2f(rv.y >> 16));
            } else {
#pragma unroll
                for (int ks = 0; ks < 2; ++ks) {
                    acc = MFMA16(ldsfrag(sA4 + 2 * CSLOT, 16 * r4 + lr, 32 * ks + 8 * lq), ldsfrag(sXT, 64 + 16 * c4 + lr, 32 * ks + 8 * lq), acc);
                    acc = MFMA16(ldsfrag(sA4 + 3 * CSLOT, 16 * r4 + lr, 32 * ks + 8 * lq), ldsfrag(sVT, 16 * c4 + lr, 32 * ks + 8 * lq), acc);
                }
                *(uint2*)(YTq + (size_t)ci * 4096 + (16 * c4 + lr) * 64 + 16 * r4 + 4 * lq) = pack4(acc[0], acc[1], acc[2], acc[3]);
            }
        }
        __syncthreads();
    }
}

__device__ __forceinline__ void rwkv_phaseB(const Ctx& c, const int bh, const int w) {
    const bf16_t* __restrict__ Mq = (const bf16_t*)(c.ws + WS_CM); const bf16_t* __restrict__ NTq = (const bf16_t*)(c.ws + WS_CN); bf16_t* __restrict__ Sst = (bf16_t*)(c.ws + WS_CS);
    const int lane = c.lane, lr = lane & 15, lq = lane >> 4;
    LAS unsigned char* sS = c.lds + 69632 + c.wid * (16 * CLD * 2);
    {
        {
            bf16x8_t sB0 = zfrag(), sB1 = zfrag();
            bf16x8_t ma[4][4][2]; uint2 nv[4][4];
            const size_t ci0 = (size_t)bh * (SEQ / CL);
#define RB_LOAD(slot, cidx) do { _Pragma("unroll") for (int kt = 0; kt < 4; ++kt) { _Pragma("unroll") for (int ks = 0; ks < 2; ++ks) \
                ma[slot][kt][ks] = *(const bf16x8_t*)(Mq + (cidx) * 4096 + (16 * kt + lr) * 64 + 32 * ks + 8 * lq); nv[slot][kt] = *(const uint2*)(NTq + (cidx) * 4096 + (16 * w + lr) * 64 + 16 * kt + 4 * lq); } } while (0)
#pragma unroll
            for (int sl = 0; sl < 4; ++sl) RB_LOAD(sl, ci0 + sl);
#pragma unroll
            for (int chunk = 0; chunk < SEQ / CL; chunk += 4) {
#pragma unroll
                for (int sl = 0; sl < 4; ++sl) {
                    const size_t ci = ci0 + chunk + sl;
                    asm volatile("global_store_dwordx4 %0, %1, off\n\tglobal_store_dwordx4 %0, %2, off offset:64\n\ts_nop 1" :: "v"(Sst + ci * 4096 + (16 * w + lr) * 64 + 8 * lq), "v"(sB0), "v"(sB1) : "memory");
#pragma unroll
                    for (int kt = 0; kt < 4; ++kt) {
                        f32x4_t acc = {bf2f(nv[sl][kt].x & 0xffffu), bf2f(nv[sl][kt].x >> 16), bf2f(nv[sl][kt].y & 0xffffu), bf2f(nv[sl][kt].y >> 16)};
                        acc = MFMA16(ma[sl][kt][0], sB0, acc); acc = MFMA16(ma[sl][kt][1], sB1, acc);
                        lds_st8(sS + (lr * CLD + 16 * kt + 4 * lq) * 2, pack4(acc[0], acc[1], acc[2], acc[3]));
                    }
                    const size_t cn = (chunk + sl + 4 < SEQ / CL) ? ci + 4 : ci;
                    RB_LOAD(sl, cn);
                    asm volatile("s_waitcnt lgkmcnt(0)" ::: "memory");
                    sB0 = ldsfrag(sS, lr, 8 * lq); sB1 = ldsfrag(sS, lr, 32 + 8 * lq);
                    asm volatile("s_waitcnt lgkmcnt(0)" ::: "memory");
                }
            }
#undef RB_LOAD
        }
    }
}

__device__ __forceinline__ void rwkv_phaseC(const Ctx& c) {
    const bf16_t* __restrict__ Qq = (const bf16_t*)(c.ws + WS_CQ); const bf16_t* __restrict__ YTq = (const bf16_t*)(c.ws + WS_CY); const bf16_t* __restrict__ Sst = (const bf16_t*)(c.ws + WS_CS);
    const float* __restrict__ bon = (const float*)(c.ws + WS_CBON);
    const bf16_t* rw_v = (const bf16_t*)(c.ws + WS_RW_V); const bf16_t* rw_g = (const bf16_t*)(c.ws + WS_RW_G);
    const float* ln_w = c.in[18]; const float* ln_b = c.in[19];
    bf16_t* ycat = (bf16_t*)(c.ws + WS_A);
    const int w = c.wid, lane = c.lane, lr = lane & 15, lq = lane >> 4;
    LAS float* sY = (LAS float*)(c.lds + w * (16 * 68 * 4));
    const int gw = c.bid * 8 + c.wid, NW = c.G * 8;
    for (int task = gw; task < BATCH * NH * (SEQ / CL) * 4; task += NW) {
        const size_t ci = (size_t)(task >> 2); const int tt = task & 3;
        const int bh = (int)(ci >> 7), chunk = (int)(ci & 127), b = bh >> 3, h = bh & 7;
        bf16x8_t qa[2];
#pragma unroll
        for (int ks = 0; ks < 2; ++ks) qa[ks] = *(const bf16x8_t*)(Qq + ci * 4096 + (16 * tt + lr) * 64 + 32 * ks + 8 * lq);
#pragma unroll
        for (int vt = 0; vt < 4; ++vt) {
            const uint2 yv = *(const uint2*)(YTq + ci * 4096 + (16 * vt + lr) * 64 + 16 * tt + 4 * lq);
            f32x4_t acc = {bf2f(yv.x & 0xffffu), bf2f(yv.x >> 16), bf2f(yv.y & 0xffffu), bf2f(yv.y >> 16)};
#pragma unroll
            for (int ks = 0; ks < 2; ++ks) acc = MFMA16(qa[ks], *(const bf16x8_t*)(Sst + ci * 4096 + (16 * vt + lr) * 64 + 32 * ks + 8 * lq), acc);
#pragma unroll
            for (int rg = 0; rg < 4; ++rg) sY[(4 * lq + rg) * 68 + 16 * vt + lr] = acc[rg];
        }
        asm volatile("s_waitcnt lgkmcnt(0)" ::: "memory");
        const int hn = h * 64 + lane;
        const float lw = ln_w[hn], lb = ln_b[hn];
#pragma unroll 4
        for (int tr = 0; tr < 16; ++tr) {
            const int t = chunk * CL + 16 * tt + tr; const size_t tok = (size_t)b * SEQ + t;
            const float y = sY[tr * 68 + lane];
            const float mean = wave_sum_u(y) * (1.f / 64.f);
            const float d = y - mean;
            const float var = wave_sum_u(d * d) * (1.f / 64.f);
            const float yn = d * rsqrtf(var + 64e-5f) * lw + lb;
            const float bonus = bon[ci * CL + 16 * tt + tr] * ldbf(rw_v + tok * RW + hn);
            ycat[tok * D + hn] = (bf16_t)f2bf((yn + bonus) * ldbf(rw_g + tok * RW + hn));
        }
        asm volatile("s_waitcnt lgkmcnt(0)" ::: "memory");
    }
}

constexpr int PA_BLOCKS = 256;
constexpr int CONV_A = 0;
__device__ __forceinline__ void phase6a(const Ctx& c) {
    if (c.G != 256) { rwkv_phaseA(c, c.G); return; }
    if (c.bid < PA_BLOCKS) rwkv_phaseA(c, PA_BLOCKS);
    else if (CONV_A > 0) convert_expert_weights(c, 0, CONV_A, (c.bid - PA_BLOCKS) * 8 + c.wid, (256 - PA_BLOCKS > 0 ? 256 - PA_BLOCKS : 1) * 8);
}

__device__ __forceinline__ void phase6b(const Ctx& c) {
    if (c.wid == 0) {
        for (int tk = c.bid; tk < 2 * S5NG * BATCH; tk += c.G) {
            if (tk < BATCH * NH * 4) { rwkv_phaseB(c, tk >> 2, tk & 3); continue; }
            const float* apow = (const float*)(c.ws + WS_APOW); const float* E = (const float*)((const unsigned char*)c.out + OUT_E);
            bf16_t* ux = (bf16_t*)((unsigned char*)c.out + OUT_UX);
            const int task = tk - BATCH * NH * 4;
            const int g = task >> 2, b = task & 3, p = c.lane;
            const float pr = apow[((size_t)(g * (S5L + 1) + S5L) * 64 + p) * 2], pi = apow[((size_t)(g * (S5L + 1) + S5L) * 64 + p) * 2 + 1];
            float xr = 0.f, xi = 0.f;
            const size_t row0 = (size_t)g * 1024 + b * 256;
            float er[2][8], ei[2][8];
#pragma unroll
            for (int q = 0; q < 8; ++q) { er[0][q] = E[(row0 + q) * 128 + p]; ei[0][q] = E[(row0 + q) * 128 + 64 + p]; }
#pragma unroll
            for (int bt = 0; bt < 32; ++bt) {
                const int cur = bt & 1, nx = cur ^ 1, ch0 = bt * 8;
                if (bt + 1 < 32) {
#pragma unroll
                    for (int q = 0; q < 8; ++q) { er[nx][q] = E[(row0 + ch0 + 8 + q) * 128 + p]; ei[nx][q] = E[(row0 + ch0 + 8 + q) * 128 + 64 + p]; }
                }
#pragma unroll
                for (int q = 0; q < 8; ++q) {
                    st2(ux + (row0 + ch0 + q) * 640 + 512 + p, f2bf(xr)); st2(ux + (row0 + ch0 + q) * 640 + 576 + p, f2bf(xi));
                    const float nr = pr * xr - pi * xi + er[cur][q], ni = pr * xi + pi * xr + ei[cur][q]; xr = nr; xi = ni;
                }
            }
        }
    } else {
        convert_expert_weights(c, (c.G == 256) ? CONV_A : 0, NE * 384, c.bid * 7 + (c.wid - 1), c.G * 7);
    }
}

__device__ __forceinline__ void phase7(const Ctx& c) {
    {
        pg8::Gemm g{(const bf16_t*)((unsigned char*)c.out + OUT_UX), (const bf16_t*)(c.ws + WS_KMAT), 0, 0, 640};
        pg8::S5Order S{256, 2, c.G, c.bid};
        pg8::EpiS5Out E{(bf16_t*)(c.ws + WS_YS5)};
        pg8::gemm_phase<pg8::EpiS5Out, pg8::S5Order, true, true>(c.lds, g, S, E);
    }
    __syncthreads();
    rwkv_phaseC(c);
}

__device__ __forceinline__ void phase8(const Ctx& c) {
    pg8::Gemm g{(const bf16_t*)(c.ws + WS_YS5), (const bf16_t*)(c.ws + WS_WGLU_T), T, 512, 512};
    pg8::StaticOrder S; S.init(T, 512, c.G, c.bid);
    pg8::EpiGLU E{(const bf16_t*)(c.ws + WS_YS5), 512, c.in[29], (bf16_t*)(c.ws + WS_A), D, 512};
    pg8::gemm_phase<pg8::EpiGLU, pg8::StaticOrder, true, true>(c.lds, g, S, E);
}

__device__ __forceinline__ void phase9(const Ctx& c) {
    pg8::Gemm g{(const bf16_t*)(c.ws + WS_A), (const bf16_t*)(c.ws + WS_WOUT_T), T, D, D};
    pg8::StaticOrder S; S.init(T, D, c.G, c.bid);
    pg8::EpiF32 E{(float*)(c.ws + WS_PROJ), D};
    pg8::gemm_phase<pg8::EpiF32, pg8::StaticOrder, true, true>(c.lds, g, S, E);
}

__device__ __forceinline__ void phase10(const Ctx& c) {
    const float* x = c.in[0]; const float* gpm = c.in[5]; const float* gpf = c.in[6];
    const float* mods = (const float*)(c.ws + WS_MODS); const float* mixed = (const float*)(c.ws + WS_PROJ);
    bf16_t* h2 = (bf16_t*)(c.ws + WS_A); float* x1o = c.out;
    const int gw = c.bid * 8 + c.wid, NW = c.G * 8;
    for (int t = gw; t < T; t += NW) {
        const int b = t / SEQ;
        const float4* mr = (const float4*)(mixed + (size_t)t * D) + c.lane;
        const float4* xr = (const float4*)(x + (size_t)t * D) + c.lane;
        float4 m[4], v[4]; float ss = 0.f;
#pragma unroll
        for (int j = 0; j < 4; ++j) { m[j] = mr[64 * j]; v[j] = xr[64 * j]; ss += m[j].x * m[j].x + m[j].y * m[j].y + m[j].z * m[j].z + m[j].w * m[j].w; }
        const float rstd = rsqrtf(wave_sum(ss) * (1.0f / D) + 1e-6f);
        float s1 = 0.f;
#pragma unroll
        for (int j = 0; j < 4; ++j) {
            const int k = (c.lane + 64 * j) * 4;
            const float4 gg = *(const float4*)(gpm + k);
            const float4 gt = *(const float4*)(mods + b * NMODS + 2 * D + k);
            v[j].x += gt.x * (m[j].x * rstd * gg.x); v[j].y += gt.y * (m[j].y * rstd * gg.y);
            v[j].z += gt.z * (m[j].z * rstd * gg.z); v[j].w += gt.w * (m[j].w * rstd * gg.w);
            s1 += v[j].x * v[j].x + v[j].y * v[j].y + v[j].z * v[j].z + v[j].w * v[j].w;
            ((float4*)(x1o + (size_t)t * D) + c.lane)[64 * j] = v[j];
        }
        const float rstd1 = rsqrtf(wave_sum(s1) * (1.0f / D) + 1e-6f);
#pragma unroll
        for (int j = 0; j < 4; ++j) {
            const int k = (c.lane + 64 * j) * 4;
            const float4 gg = *(const float4*)(gpf + k);
            const float4 sh = *(const float4*)(mods + b * NMODS + 3 * D + k);
            const float4 sc = *(const float4*)(mods + b * NMODS + 4 * D + k);
            float r[4];
            r[0] = v[j].x * rstd1 * gg.x * (1.f + sc.x) + sh.x; r[1] = v[j].y * rstd1 * gg.y * (1.f + sc.y) + sh.y;
            r[2] = v[j].z * rstd1 * gg.z * (1.f + sc.z) + sh.z; r[3] = v[j].w * rstd1 * gg.w * (1.f + sc.w) + sh.w;
            unsigned hi[4]; float lo[4];
#pragma unroll
            for (int q = 0; q < 4; ++q) { hi[q] = f2bf(r[q]); lo[q] = r[q] - bf2f(hi[q]); }
            ((uint2*)(h2 + (size_t)t * D) + c.lane)[64 * j] = make_uint2(hi[0] | (hi[1] << 16), hi[2] | (hi[3] << 16));
            ((uint2*)(h2 + (size_t)(T + t) * D) + c.lane)[64 * j] = make_uint2(pk2(lo[0], lo[1]), pk2(lo[2], lo[3]));
        }
    }
}

__device__ __forceinline__ void phase11(const Ctx& c) {
    {
        pg8::Gemm g{(const bf16_t*)(c.ws + WS_A), (const bf16_t*)(c.ws + WS_WR_T), 2 * T, 512, D};
        pg8::StaticOrder S; S.init(2 * T, 512, c.G, c.bid);
        pg8::EpiRouter E{(float*)(c.ws + WS_PLOG), (bf16_t*)(c.ws + WS_PLOG + 32 * MiB), (bf16_t*)(c.ws + WS_PLOG + 48 * MiB), T / 256};
        pg8::gemm_phase<pg8::EpiRouter, pg8::StaticOrder, true, true>(c.lds, g, S, E);
    }
    __syncthreads();
    {
        pg8::Gemm g{(const bf16_t*)(c.ws + WS_A), (const bf16_t*)(c.ws + WS_WSGU_T), T, 512, D};
        pg8::StaticOrder S; S.init(T, 512, c.G, c.bid);
        pg8::EpiSwiGLU E{(bf16_t*)(c.ws + WS_HS), 256};
        pg8::gemm_phase<pg8::EpiSwiGLU, pg8::StaticOrder, true, true>(c.lds, g, S, E);
    }
}

__device__ __forceinline__ unsigned fkey(float f) { const unsigned u = __builtin_bit_cast(unsigned, f); return u ^ ((u >> 31) ? 0xffffffffu : 0x80000000u); }
__device__ __forceinline__ unsigned wave_umax(unsigned v) {
    v = max(v, DPPU(v, 0xB1)); v = max(v, DPPU(v, 0x4E)); v = max(v, DPPU(v, 0x141)); v = max(v, DPPU(v, 0x140));
    const unsigned a = __builtin_amdgcn_readlane(v, 0), b = __builtin_amdgcn_readlane(v, 16), c = __builtin_amdgcn_readlane(v, 32), d = __builtin_amdgcn_readlane(v, 48);
    return max(max(a, b), max(c, d));
}
__device__ __forceinline__ unsigned wave_umin(unsigned v) {
    v = min(v, DPPU(v, 0xB1)); v = min(v, DPPU(v, 0x4E)); v = min(v, DPPU(v, 0x141)); v = min(v, DPPU(v, 0x140));
    const unsigned a = __builtin_amdgcn_readlane(v, 0), b = __builtin_amdgcn_readlane(v, 16), c = __builtin_amdgcn_readlane(v, 32), d = __builtin_amdgcn_readlane(v, 48);
    return min(min(a, b), min(c, d));
}
__device__ __forceinline__ void phase12(const Ctx& c) {
    const float* plog = (const float*)(c.ws + WS_PLOG); const float* rb = c.in[32];
    int* idx = (int*)(c.ws + WS_IDX); float* wt = (float*)(c.ws + WS_WT);
    LAS int* lhist = (LAS int*)c.lds;
    __syncthreads();
    if (c.tid < NE) lhist[c.tid] = 0;
    __syncthreads();
    const int gw = c.bid * 8 + c.wid, NW = c.G * 8, l = c.lane;
    const float4 bias = *(const float4*)(rb + l * 4);
    for (int t = gw; t < T; t += NW) {
        const float4 p0 = *(const float4*)(plog + (size_t)t * 256 + l * 4);
        const float4 p1 = ldbf4((const bf16_t*)(c.ws + WS_PLOG + 32 * MiB) + (size_t)t * 256 + l * 4), p2 = ldbf4((const bf16_t*)(c.ws + WS_PLOG + 48 * MiB) + (size_t)t * 256 + l * 4);
        const float lg[4] = {p0.x + (p1.x + p2.x), p0.y + (p1.y + p2.y), p0.z + (p1.z + p2.z), p0.w + (p1.w + p2.w)};
        float s[4] = {sigmoidf_(lg[0]), sigmoidf_(lg[1]), sigmoidf_(lg[2]), sigmoidf_(lg[3])};
        float ch[4] = {s[0] + bias.x, s[1] + bias.y, s[2] + bias.z, s[3] + bias.w};
        float a1 = fmaxf(ch[0], ch[1]), a2 = fminf(ch[0], ch[1]);
        { const float b1 = fmaxf(ch[2], ch[3]), b2 = fminf(ch[2], ch[3]); const float n1 = fmaxf(a1, b1), n2 = fmaxf(fminf(a1, b1), fmaxf(a2, b2)); a1 = n1; a2 = n2; }
        { const float b1 = DPPF(a1, 0xB1), b2 = DPPF(a2, 0xB1); const float n1 = fmaxf(a1, b1), n2 = fmaxf(fminf(a1, b1), fmaxf(a2, b2)); a1 = n1; a2 = n2; }
        { const float b1 = DPPF(a1, 0x4E), b2 = DPPF(a2, 0x4E); const float n1 = fmaxf(a1, b1), n2 = fmaxf(fminf(a1, b1), fmaxf(a2, b2)); a1 = n1; a2 = n2; }
        { const float b1 = DPPF(a1, 0x141), b2 = DPPF(a2, 0x141); const float n1 = fmaxf(a1, b1), n2 = fmaxf(fminf(a1, b1), fmaxf(a2, b2)); a1 = n1; a2 = n2; }
        const float gs = a1 + a2; const int myg = l >> 3;
        int rank = 0;
#pragma unroll
        for (int g = 0; g < 8; ++g) { const float og = __builtin_bit_cast(float, __builtin_amdgcn_readlane(__builtin_bit_cast(int, gs), g * 8)); rank += (og > gs || (og == gs && g < myg)) ? 1 : 0; }
        const bool sel = rank < 4;
        unsigned mk[4];
#pragma unroll
        for (int i = 0; i < 4; ++i) mk[i] = sel ? fkey(ch[i]) : 0u;
        float sk[8]; int ek[8]; float ssum = 0.f;
#pragma unroll
        for (int k = 0; k < 8; ++k) {
            const unsigned lm = max(max(mk[0], mk[1]), max(mk[2], mk[3]));
            const unsigned m = wave_umax(lm);
            unsigned cand = 1023u;
#pragma unroll
            for (int i = 3; i >= 0; --i) if (mk[i] == m) cand = (unsigned)(l * 4 + i);
            const int be = (int)wave_umin(cand);
            const int ii = be & 3;
            float sv = s[0]; sv = (ii == 1) ? s[1] : sv; sv = (ii == 2) ? s[2] : sv; sv = (ii == 3) ? s[3] : sv;
            sv = __builtin_bit_cast(float, __builtin_amdgcn_readlane(__builtin_bit_cast(int, sv), be >> 2));
            if ((be >> 2) == l) {
#pragma unroll
                for (int i = 0; i < 4; ++i) if (i == ii) mk[i] = 0u;
            }
            sk[k] = sv; ek[k] = be; ssum += sv;
        }
        if (l == 0) {
            const float inv = 2.5f / ssum;
#pragma unroll
            for (int k = 0; k < 8; ++k) { idx[t * 8 + k] = ek[k]; wt[t * 8 + k] = sk[k] * inv; __hip_atomic_fetch_add(lhist + ek[k], 1, __ATOMIC_RELAXED, __HIP_MEMORY_SCOPE_WORKGROUP); }
        }
    }
    __syncthreads();
    if (c.tid < NE) ((int*)(c.ws + WS_HIST))[c.bid * NE + c.tid] = lhist[c.tid];
}

__device__ __forceinline__ void phase13(const Ctx& c) {
    int* smi = (int*)c.sm;
    const int* hist = (const int*)(c.ws + WS_HIST);
    __syncthreads();
    if (c.tid < NE) {
        int tot = 0, base = 0;
        for (int bb = 0; bb < c.G; ++bb) { const int v = hist[bb * NE + c.tid]; tot += v; base += (bb < c.bid) ? v : 0; }
        smi[600 + c.tid] = tot; smi[900 + c.tid] = base; smi[1200 + c.tid] = 0; smi[300 + c.tid] = (tot + 255) >> 8;
    }
    __syncthreads();
    if (c.tid < 64) {
        const int l = c.tid; const int u0 = smi[300 + l * 4], u1 = smi[300 + l * 4 + 1], u2 = smi[300 + l * 4 + 2], u3 = smi[300 + l * 4 + 3];
        const int tot = u0 + u1 + u2 + u3; int inc = tot;
#pragma unroll
        for (int o = 1; o < 64; o <<= 1) { const int v = __shfl_up(inc, o); if (l >= o) inc += v; }
        const int ex = inc - tot;
        smi[l * 4] = ex; smi[l * 4 + 1] = ex + u0; smi[l * 4 + 2] = ex + u0 + u1; smi[l * 4 + 3] = ex + u0 + u1 + u2;
        if (l == 63) smi[NE] = inc;
    }
    __syncthreads();
    const int* idx = (const int*)(c.ws + WS_IDX); int* slotp = (int*)(c.ws + WS_SLOTP); int* uexp = (int*)(c.ws + WS_UEXP); int* slotw = (int*)(c.ws + WS_SLOTW); const float* wt = (const float*)(c.ws + WS_WT);
    const int gw = c.bid * 8 + c.wid, NW = c.G * 8;
    for (int t = gw; t < T; t += NW) {
        if (c.lane < 8) {
            const int a = t * 8 + c.lane, e = idx[a];
            const int pos = smi[900 + e] + __hip_atomic_fetch_add(smi + 1200 + e, 1, __ATOMIC_RELAXED, __HIP_MEMORY_SCOPE_WORKGROUP);
            const int slot = smi[e] * 256 + pos;
            slotp[slot] = a;
            *(int2*)(slotw + 2 * (size_t)slot) = make_int2(a, __float_as_int(wt[a]));
        }
    }
    const int gt = c.bid * 512 + c.tid, NT = c.G * 512;
    for (int e = gt; e < NE; e += NT) {
        const int u0 = smi[e], u1 = smi[e + 1], cn = smi[600 + e];
        for (int p = cn; p < (u1 - u0) * 256; ++p) { slotp[u0 * 256 + p] = -1; *(int2*)(slotw + 2 * (size_t)(u0 * 256 + p)) = make_int2(-1, 0); }
        for (int u = u0; u < u1; ++u) uexp[u] = e;
    }
    if (gt == 0) uexp[2048] = smi[NE];
}

__device__ __forceinline__ void phase14(const Ctx& c) {
    const int* uexp = (const int*)(c.ws + WS_UEXP);
    const int NU = __builtin_amdgcn_readfirstlane(uexp[2048]);
    const int vcu = (c.G % 8 == 0) ? (c.bid % 8) * (c.G / 8) + c.bid / 8 : c.bid;
    pg8::Gemm g{(const bf16_t*)(c.ws + WS_A), (const bf16_t*)(c.ws + WS_WEGU), 0, 0, D, (const int*)(c.ws + WS_SLOTP)};
    pg8::ExpertOrder S{uexp, NU, 2, c.G, vcu};
    pg8::EpiSwiGLU E{(bf16_t*)(c.ws + WS_HID), 256};
    pg8::gemm_phase<pg8::EpiSwiGLU, pg8::ExpertOrder, true, true, true>(c.lds, g, S, E);
}

__device__ __forceinline__ void phase15(const Ctx& c) {
    {
        const int* uexp = (const int*)(c.ws + WS_UEXP);
        const int NU = __builtin_amdgcn_readfirstlane(uexp[2048]);
        const int vcu = (c.G % 8 == 0) ? (c.bid % 8) * (c.G / 8) + c.bid / 8 : c.bid;
        pg8::Gemm g{(const bf16_t*)(c.ws + WS_HID), (const bf16_t*)(c.ws + WS_WED), 0, 0, EFF};
        pg8::ExpertOrder S{uexp, NU, 4, c.G, vcu};
        pg8::EpiScatter E{(const int*)(c.ws + WS_SLOTW), (bf16_t*)(c.ws + WS_YEXP), D};
        pg8::gemm_phase<pg8::EpiScatter, pg8::ExpertOrder, true, true>(c.lds, g, S, E);
    }
    __syncthreads();
    {
        pg8::Gemm g{(const bf16_t*)(c.ws + WS_HS), (const bf16_t*)(c.ws + WS_WSD_T), T, D, 256};
        pg8::StaticOrder S; S.init(T, D, c.G, c.bid);
        pg8::EpiBf16<0> E{(bf16_t*)(c.ws + WS_SHOUT), D, nullptr, 0, 0, 1.f};
        pg8::gemm_phase<pg8::EpiBf16<0>, pg8::StaticOrder, true, true>(c.lds, g, S, E);
    }
}

__device__ __forceinline__ void phase16(const Ctx& c) {
    const float* gq = c.in[7]; const float* mods = (const float*)(c.ws + WS_MODS);
    const bf16_t* shout = (const bf16_t*)(c.ws + WS_SHOUT); const unsigned char* yexp = (const unsigned char*)(c.ws + WS_YEXP);
    float* out = c.out; float* dst = c.out;
    const int gw = c.bid * 8 + c.wid, NW = c.G * 8;
    typedef float f32x2s __attribute__((ext_vector_type(2)));
    for (int t = gw; t < T; t += NW) {
        const int b = t / SEQ;
        float y[2][8], x1[2][8]; float ss = 0.f;
        uint2 ye[2][8]; uint4 sh[2]; float4 xv[2][2];
#pragma unroll
        for (int j = 0; j < 2; ++j) {
            const int k = (c.lane + 64 * j) * 8;
            sh[j] = *(const uint4*)(shout + (size_t)t * D + k);
            xv[j][0] = *(const float4*)(out + (size_t)t * D + k); xv[j][1] = *(const float4*)(out + (size_t)t * D + k + 4);
#pragma unroll
            for (int q = 0; q < 8; ++q) { const u32x2nt v = __builtin_nontemporal_load((const u32x2nt*)(yexp + (size_t)(t * 8 + q) * D + k)); ye[j][q] = make_uint2(v[0], v[1]); }
        }
#pragma unroll
        for (int j = 0; j < 2; ++j) {
            unpack8(sh[j], y[j]);
            x1[j][0] = xv[j][0].x; x1[j][1] = xv[j][0].y; x1[j][2] = xv[j][0].z; x1[j][3] = xv[j][0].w; x1[j][4] = xv[j][1].x; x1[j][5] = xv[j][1].y; x1[j][6] = xv[j][1].z; x1[j][7] = xv[j][1].w;
#pragma unroll
            for (int q = 0; q < 8; ++q) {
                const f32x2s a0 = __builtin_amdgcn_cvt_pk_f32_fp8((int)ye[j][q].x, false), a1 = __builtin_amdgcn_cvt_pk_f32_fp8((int)ye[j][q].x, true);
                const f32x2s a2 = __builtin_amdgcn_cvt_pk_f32_fp8((int)ye[j][q].y, false), a3 = __builtin_amdgcn_cvt_pk_f32_fp8((int)ye[j][q].y, true);
                y[j][0] += a0[0]; y[j][1] += a0[1]; y[j][2] += a1[0]; y[j][3] += a1[1]; y[j][4] += a2[0]; y[j][5] += a2[1]; y[j][6] += a3[0]; y[j][7] += a3[1];
            }
#pragma unroll
            for (int i = 0; i < 8; ++i) ss += y[j][i] * y[j][i];
        }
        const float rstd = rsqrtf(wave_sum_u(ss) * (1.0f / D) + 1e-6f);
#pragma unroll
        for (int j = 0; j < 2; ++j) {
            const int k = (c.lane + 64 * j) * 8;
            const float4 g0 = *(const float4*)(gq + k), g1 = *(const float4*)(gq + k + 4);
            const float4 t0 = *(const float4*)(mods + b * NMODS + 5 * D + k), t1 = *(const float4*)(mods + b * NMODS + 5 * D + k + 4);
            const float gg[8] = {g0.x, g0.y, g0.z, g0.w, g1.x, g1.y, g1.z, g1.w}, gt[8] = {t0.x, t0.y, t0.z, t0.w, t1.x, t1.y, t1.z, t1.w};
            float o[8];
#pragma unroll
            for (int i = 0; i < 8; ++i) o[i] = x1[j][i] + gt[i] * (y[j][i] * rstd * gg[i]);
            *(float4*)(dst + (size_t)t * D + k) = make_float4(o[0], o[1], o[2], o[3]); *(float4*)(dst + (size_t)t * D + k + 4) = make_float4(o[4], o[5], o[6], o[7]);
        }
    }
}

constexpr int NPHASES = 18;
__device__ __forceinline__ void probe_reset(const Ctx& c, int k) {
    unsigned* counts = (unsigned*)(c.ws + WS_COUNTS);
    if (k == 13 && c.bid == 0 && c.tid < 256) counts[c.tid] = 0u;
    if (k == 14 && c.bid == 0 && c.tid < 256) counts[256 + c.tid] = 0u;
}

__global__ void __launch_bounds__(512, 2) mega(Args args) {
    extern __shared__ __attribute__((aligned(16))) unsigned char lds_raw[];
    Ctx c;
    c.in = args.in; c.out = args.out; c.ws = args.ws;
    c.lds = (LAS unsigned char*)lds_raw; c.sm = (float*)lds_raw;
    c.dry = 0;
    c.tid = threadIdx.x; c.lane = c.tid & 63; c.wid = __builtin_amdgcn_readfirstlane(c.tid >> 6); c.bid = blockIdx.x; c.G = gridDim.x;
    volatile LAS unsigned* st = (volatile LAS unsigned*)(c.lds + LDS_CTL_OFF);
    if (c.tid < 4) st[c.tid] = 0u;
    __syncthreads();
    XcdBarrier bar; bar.bar = (unsigned*)(args.ws + WS_CTL); bar.x = 0; bar.st = st;
    const bool multi = (args.hi - args.lo) > 1;
    if (multi) bar = xcd_barrier_post((unsigned*)(args.ws + WS_CTL), st);
    const int lo = args.lo, hi = args.hi;
#ifndef REPEAT_PHASE
#define REPEAT_PHASE -1
#endif
#define LAUNDER() do { int t_ = threadIdx.x; asm volatile("" : "+v"(t_)); c.tid = t_; c.lane = t_ & 63; int b_ = blockIdx.x; asm volatile("" : "+s"(b_)); c.bid = b_; } while (0)
#define RUN_PHASE(k, call) if (lo <= (k) && (k) < hi) { if ((k) == REPEAT_PHASE) { LAUNDER(); c.dry = 1; call; c.dry = 0; xcd_barrier(bar); probe_reset(c, (k)); xcd_barrier(bar); } LAUNDER(); call; if ((k) + 1 < hi) xcd_barrier(bar); }
    RUN_PHASE(0, phase0(c))
    RUN_PHASE(1, phase1(c))
    RUN_PHASE(2, phase2(c))
    RUN_PHASE(3, phase3(c))
    RUN_PHASE(4, phase4(c))
    RUN_PHASE(5, phase5(c))
    RUN_PHASE(6, phase6a(c))
    RUN_PHASE(7, phase6b(c))
    RUN_PHASE(8, phase7(c))
    RUN_PHASE(9, phase8(c))
    RUN_PHASE(10, phase9(c))
    RUN_PHASE(11, phase10(c))
    RUN_PHASE(12, phase11(c))
    RUN_PHASE(13, phase12(c))
    RUN_PHASE(14, phase13(c))
    RUN_PHASE(15, phase14(c))
    RUN_PHASE(16, phase15(c))
    RUN_PHASE(17, phase16(c))
#undef RUN_PHASE
}

#ifndef N_LAUNCH_MODE
#define N_LAUNCH_MODE 1
#endif

extern "C" void kernel_launch(void* const* d_in, const int* in_sizes, int n_in, void* d_out, int out_size, void* d_ws, size_t ws_size, hipStream_t stream) {
    static int grid = 0;
    if (grid == 0) {
        if (n_in != 39 || out_size != T * D || ws_size < WS_END) { fprintf(stderr, "kernel_launch: unexpected shapes n_in %d out %d ws %zu\n", n_in, out_size, ws_size); grid = -1; return; }
        int dev = 0, cus = 0, per_cu = 0;
        if (hipGetDevice(&dev) != hipSuccess || hipDeviceGetAttribute(&cus, hipDeviceAttributeMultiprocessorCount, dev) != hipSuccess) { grid = -1; return; }
        if (hipFuncSetAttribute((const void*)mega, hipFuncAttributeMaxDynamicSharedMemorySize, LDS_BYTES) != hipSuccess) { grid = -1; return; }
        if (hipOccupancyMaxActiveBlocksPerMultiprocessor(&per_cu, (const void*)mega, 512, LDS_BYTES) != hipSuccess || per_cu < 1) { fprintf(stderr, "kernel_launch: occupancy query says %d\n", per_cu); }
        (void)hipGetLastError();
        grid = cus;
    }
    if (grid < 0) return;
    (void)hipMemsetAsync((char*)d_ws + WS_CTL, 0, CTL_BYTES, stream);
    Args a{};
    for (int i = 0; i < 39; ++i) a.in[i] = (const float*)d_in[i];
    a.out = (float*)d_out; a.ws = (unsigned char*)d_ws;
    if (N_LAUNCH_MODE == 1) {
        a.lo = 0; a.hi = NPHASES;
        hipLaunchKernelGGL(mega, dim3(grid), dim3(512), LDS_BYTES, stream, a);
    } else {
        for (int ph = 0; ph < NPHASES; ++ph) {
            a.lo = ph; a.hi = ph + 1;
            hipLaunchKernelGGL(mega, dim3(grid), dim3(512), LDS_BYTES, stream, a);
        }
    }
}
```
